# Optimizing an MI355X kernel written in HIP

```python
import math
import jax, jax.numpy as jnp
from jax import lax
import numpy as np

D_MODEL = 1024
BATCH = 4
SEQ = 8192
DEPTH = 1

GRID_W = 64
CTX_LEN = 256
LN_EPS = 1e-6
DEEPNORM_ALPHA = (2 * DEPTH) ** 0.25
DEEPNORM_BETA = (8 * DEPTH) ** -0.25

GLA_HEADS = 4
GLA_DK = 64
GLA_DV = 128
GLA_KEY = GLA_HEADS * GLA_DK
GLA_VAL = GLA_HEADS * GLA_DV
GLA_RANK = 16
GLA_TAU = 16.0
GLA_CHUNK = 64

HY_WIDTH = D_MODEL - GLA_VAL
HY_ORDER = 2
HY_CONV = 3
HY_EMB = 33
HY_FH = 64
HY_TARGET = 1e-2
HY_FAST = 0.3
HY_SLOW = 1.5

MIX_WIDTH = GLA_VAL + HY_WIDTH
IN_SIZES = (GLA_KEY, GLA_KEY, GLA_VAL, GLA_VAL, GLA_RANK, GLA_RANK, (HY_ORDER + 1) * HY_WIDTH)
IN_WIDTH = sum(IN_SIZES)

N_EXPERTS = 32
TOP_K = 4
D_EXPERT = D_MODEL
SWIGLU_ALPHA = 1.702
SWIGLU_LIMIT = 7.0

kernel_name = 'hybrid_gla_hyena_moe_dit_block'


def _ln_stats(x):
    xf = x.astype(jnp.float32)
    mu = jnp.mean(xf, -1, keepdims=True)
    xc = xf - mu
    return xc * lax.rsqrt(jnp.mean(jnp.square(xc), -1, keepdims=True) + LN_EPS)


def modulate(x, shift, scale):
    return _ln_stats(x).astype(x.dtype) * (1 + scale) + shift


def post_norm(x, gain, bias):
    return (_ln_stats(x) * gain.astype(jnp.float32) + bias.astype(jnp.float32)).astype(x.dtype)


def mod_part(m, i):
    return m[..., i * D_MODEL:(i + 1) * D_MODEL]


def split_projection(u):
    return jnp.split(u, np.cumsum(IN_SIZES)[:-1].tolist(), axis=-1)


def to_heads(t, d):
    b, l, _ = t.shape
    return t.reshape(b, l, GLA_HEADS, d).transpose(0, 2, 1, 3)


def log_decay(a_low, wa, ba):
    z = a_low.astype(jnp.float32) @ wa.astype(jnp.float32) + ba.astype(jnp.float32)
    return to_heads(jax.nn.log_sigmoid(z) / GLA_TAU, GLA_DK)


def gla_chunked(q, k, v, log_a, s0):
    b, h, l, _ = q.shape
    n = l // GLA_CHUNK

    def chunks(t):
        return jnp.moveaxis(t.astype(jnp.float32).reshape(b, h, n, GLA_CHUNK, t.shape[-1]), 2, 0)

    lower = jnp.tril(jnp.ones((GLA_CHUNK, GLA_CHUNK), dtype=bool))[None, None, :, :, None]

    def step(s, inp):
        qc, kc, vc, gc = inp
        cum = jnp.cumsum(gc, axis=2)
        last = cum[:, :, -1:, :]
        o = jnp.einsum('bhid,bhdv->bhiv', qc * jnp.exp(cum), s)
        decay = jnp.exp(jnp.where(lower, cum[:, :, :, None, :] - cum[:, :, None, :, :], -jnp.inf))
        scores = jnp.einsum('bhid,bhjd,bhijd->bhij', qc, kc, decay)
        o = o + jnp.einsum('bhij,bhjv->bhiv', scores, vc)
        s = jnp.exp(last[:, :, 0, :])[..., None] * s + jnp.einsum('bhjd,bhjv->bhdv', kc * jnp.exp(last - cum), vc)
        return s, o

    s_fin, o = lax.scan(step, s0, (chunks(q), chunks(k), chunks(v), chunks(log_a)))
    return jnp.moveaxis(o, 0, 2).reshape(b, h, l, GLA_DV), s_fin


def gla_bidirectional(q, k, v, la_f, la_b, s0_f, s0_b):
    o_f, s_f = gla_chunked(q, k, v, la_f, s0_f)
    flip = lambda t: jnp.flip(t, axis=2)
    o_b, s_b = gla_chunked(flip(q), flip(k), flip(v), flip(la_b), s0_b)
    return o_f + flip(o_b), s_f, s_b


def gla_heads(q, k, v):
    return to_heads(q, GLA_DK) * (GLA_DK ** -0.5), to_heads(k, GLA_DK), to_heads(v, GLA_DV)


def gla_output(o, g, norm_g):
    o = o * lax.rsqrt(jnp.mean(jnp.square(o), -1, keepdims=True) + LN_EPS) * norm_g.astype(jnp.float32)
    b, _, l, _ = o.shape
    o = o.transpose(0, 2, 1, 3).reshape(b, l, GLA_VAL).astype(g.dtype)
    return o * jax.nn.silu(g)


def short_conv_rows(u, w, bias, rows):
    b, l, ch = u.shape
    row_len = l // rows
    up = jnp.pad(u.reshape(b, rows, row_len, ch), ((0, 0), (0, 0), (1, 1), (0, 0)))
    y = sum(up[:, :, i:i + row_len] * w[i] for i in range(HY_CONV)) + bias
    return y.reshape(b, l, ch)


def hyena_filters(length, w1, b1, w2, b2, w_out, freq):
    f32 = jnp.float32
    t = jnp.arange(length, dtype=f32)
    t_norm = t / (length - 1)
    bands = (HY_EMB - 1) // 2
    f = jnp.linspace(1e-4, bands - 1, bands, dtype=f32)
    ang = (2.0 * math.pi * t / length)[:, None] * f[None, :]
    z = jnp.concatenate([t_norm[:, None], jnp.cos(ang), -jnp.sin(ang)], -1)
    fr = freq.astype(f32)
    hid = jnp.sin(fr * (z @ w1.astype(f32) + b1.astype(f32)))
    hid = jnp.sin(fr * (hid @ w2.astype(f32) + b2.astype(f32)))
    h = (hid @ w_out.astype(f32)).reshape(length, HY_ORDER, 2, HY_WIDTH)
    deltas = jnp.linspace(math.log(HY_TARGET) / HY_SLOW, math.log(HY_TARGET) / HY_FAST, HY_WIDTH, dtype=f32)
    window = jnp.exp(-t_norm[:, None] * jnp.abs(deltas)[None, :])
    return h * window[:, None, None, :]


def long_conv_bidir(u, h_fwd, h_bwd, d_bias):
    l = u.shape[1]
    two_sided = jnp.concatenate([h_fwd, jnp.zeros_like(h_fwd[:1]), jnp.flip(h_bwd[1:], 0)], 0)
    uf = u.astype(jnp.float32)
    spec = jnp.fft.rfft(uf, n=2 * l, axis=1) * jnp.fft.rfft(two_sided, axis=0)[None]
    y = jnp.fft.irfft(spec, n=2 * l, axis=1)[:, :l]
    return (y + uf * d_bias.astype(jnp.float32)).astype(u.dtype)


def hyena(u, filters, conv_w, conv_b, d_bias, rows):
    u = short_conv_rows(u, conv_w, conv_b, rows)
    v, x1, x2 = jnp.split(u, HY_ORDER + 1, axis=-1)
    z = x1 * long_conv_bidir(v, filters[:, 0, 0], filters[:, 0, 1], d_bias[0])
    return x2 * long_conv_bidir(z, filters[:, 1, 0], filters[:, 1, 1], d_bias[1])


def clamped_swiglu(hid):
    glu, lin = hid[..., ::2], hid[..., 1::2]
    glu = jnp.minimum(glu, SWIGLU_LIMIT)
    lin = jnp.clip(lin, -SWIGLU_LIMIT, SWIGLU_LIMIT)
    return glu * jax.nn.sigmoid(SWIGLU_ALPHA * glu) * (lin + 1)


def moe(h, router_w, router_b, w1, b1, w2, b2):
    b, l, d = h.shape
    t = h.reshape(b * l, d)
    logits = (t @ router_w + router_b).astype(jnp.float32)
    top_v, top_i = lax.top_k(logits, TOP_K)
    top_w = jax.nn.softmax(top_v, axis=-1)
    gates = jnp.sum(jax.nn.one_hot(top_i, N_EXPERTS, dtype=jnp.float32) * top_w[..., None], axis=1)
    out = jnp.zeros((b * l, d), jnp.float32)
    for e in range(N_EXPERTS):
        y_e = clamped_swiglu(t @ w1[e] + b1[e]) @ w2[e] + b2[e]
        out = out + gates[:, e:e + 1] * y_e.astype(jnp.float32)
    return out.astype(h.dtype).reshape(b, l, d)


def setup_inputs(seed: int = 0) -> dict:
    key = jax.random.key(seed)
    ks = iter(jax.random.split(key, 40))
    nrm = lambda shape, std: std * jax.random.normal(next(ks), shape, jnp.float32)
    D = D_MODEL
    return {
        'x': nrm((BATCH, SEQ, D), 1.0),
        'c': nrm((BATCH, D), 1.0),
        'ctx': nrm((BATCH, CTX_LEN, D), 1.0),
        'c_ctx': nrm((D,), 1.0),
        'ada_w': nrm((DEPTH, D, 6 * D), 0.5 * D ** -0.5),
        'ada_b': nrm((DEPTH, 6 * D), 0.01),
        'w_in': nrm((DEPTH, D, IN_WIDTH), D ** -0.5),
        'gla_wa_f': nrm((DEPTH, GLA_RANK, GLA_KEY), GLA_RANK ** -0.5),
        'gla_ba_f': nrm((DEPTH, GLA_KEY), 0.1),
        'gla_wa_b': nrm((DEPTH, GLA_RANK, GLA_KEY), GLA_RANK ** -0.5),
        'gla_ba_b': nrm((DEPTH, GLA_KEY), 0.1),
        'gla_norm_g': 1.0 + nrm((DEPTH, GLA_DV), 0.01),
        'hy_conv_w': nrm((DEPTH, HY_CONV, (HY_ORDER + 1) * HY_WIDTH), HY_CONV ** -0.5),
        'hy_conv_b': nrm((DEPTH, (HY_ORDER + 1) * HY_WIDTH), 0.01),
        'hy_flt_w1': nrm((DEPTH, HY_EMB, HY_FH), HY_EMB ** -0.5),
        'hy_flt_b1': nrm((DEPTH, HY_FH), 0.1),
        'hy_flt_w2': nrm((DEPTH, HY_FH, HY_FH), HY_FH ** -0.5),
        'hy_flt_b2': nrm((DEPTH, HY_FH), 0.1),
        'hy_flt_wout': nrm((DEPTH, HY_FH, HY_ORDER * 2 * HY_WIDTH), 0.05 * HY_FH ** -0.5),
        'hy_flt_freq': 1.0 + nrm((DEPTH, HY_FH), 0.01),
        'hy_bias_d': nrm((DEPTH, HY_ORDER, HY_WIDTH), 1.0),
        'w_out': nrm((DEPTH, MIX_WIDTH, D), DEEPNORM_BETA * MIX_WIDTH ** -0.5),
        'ln1_g': 1.0 + nrm((DEPTH, D), 0.01),
        'ln1_b': nrm((DEPTH, D), 0.01),
        'router_w': nrm((DEPTH, D, N_EXPERTS), D ** -0.5),
        'router_b': nrm((DEPTH, N_EXPERTS), 0.01),
        'exp_w1': nrm((DEPTH, N_EXPERTS, D, 2 * D_EXPERT), D ** -0.5),
        'exp_b1': nrm((DEPTH, N_EXPERTS, 2 * D_EXPERT), 0.01),
        'exp_w2': nrm((DEPTH, N_EXPERTS, D_EXPERT, D), DEEPNORM_BETA * D_EXPERT ** -0.5),
        'exp_b2': nrm((DEPTH, N_EXPERTS, D), 0.01),
        'ln2_g': 1.0 + nrm((DEPTH, D), 0.01),
        'ln2_b': nrm((DEPTH, D), 0.01),
    }


def reference(x, c, ctx, c_ctx, ada_w, ada_b, w_in, gla_wa_f, gla_ba_f, gla_wa_b, gla_ba_b, gla_norm_g,
              hy_conv_w, hy_conv_b, hy_flt_w1, hy_flt_b1, hy_flt_w2, hy_flt_b2, hy_flt_wout, hy_flt_freq,
              hy_bias_d, w_out, ln1_g, ln1_b, router_w, router_b, exp_w1, exp_b1, exp_w2, exp_b2, ln2_g, ln2_b):
    batch, seq_len, _ = x.shape
    ctx_len = ctx.shape[1]
    rows = seq_len // GRID_W
    for l in range(DEPTH):
        update_ctx = l < DEPTH - 1
        mod_x = (jax.nn.silu(c) @ ada_w[l] + ada_b[l])[:, None, :]
        mod_c = (jax.nn.silu(c_ctx) @ ada_w[l] + ada_b[l])[None, None, :]
        flt = functools_free = (hy_flt_w1[l], hy_flt_b1[l], hy_flt_w2[l], hy_flt_b2[l], hy_flt_wout[l], hy_flt_freq[l])

        h = modulate(x, mod_part(mod_x, 0), mod_part(mod_x, 1))
        hc = modulate(ctx, mod_part(mod_c, 0), mod_part(mod_c, 1))
        q, k, v, g, a_f, a_b, hy_u = split_projection(h @ w_in[l])
        qc, kc, vc, gc, a_fc, a_bc, hy_uc = split_projection(hc @ w_in[l])

        zero = jnp.zeros((batch, GLA_HEADS, GLA_DK, GLA_DV), jnp.float32)
        oc, s_f, s_b = gla_bidirectional(*gla_heads(qc, kc, vc), log_decay(a_fc, gla_wa_f[l], gla_ba_f[l]),
                                         log_decay(a_bc, gla_wa_b[l], gla_ba_b[l]), zero, zero)
        o, _, _ = gla_bidirectional(*gla_heads(q, k, v), log_decay(a_f, gla_wa_f[l], gla_ba_f[l]),
                                    log_decay(a_b, gla_wa_b[l], gla_ba_b[l]), s_f, s_b)
        y_gla = gla_output(o, g, gla_norm_g[l])

        y_hy = hyena(hy_u, hyena_filters(seq_len, *flt), hy_conv_w[l], hy_conv_b[l], hy_bias_d[l], rows)
        f = jnp.concatenate([y_gla, y_hy], axis=-1) @ w_out[l]
        x_mid = post_norm(DEEPNORM_ALPHA * x + mod_part(mod_x, 2) * f, ln1_g[l], ln1_b[l])

        h2 = modulate(x_mid, mod_part(mod_x, 3), mod_part(mod_x, 4))
        y_moe = moe(h2, router_w[l], router_b[l], exp_w1[l], exp_b1[l], exp_w2[l], exp_b2[l])
        x_new = post_norm(DEEPNORM_ALPHA * x_mid + mod_part(mod_x, 5) * y_moe, ln2_g[l], ln2_b[l])

        if update_ctx:
            yc_hy = hyena(hy_uc, hyena_filters(ctx_len, *flt), hy_conv_w[l], hy_conv_b[l], hy_bias_d[l], 1)
            fc = jnp.concatenate([gla_output(oc, gc, gla_norm_g[l]), yc_hy], axis=-1) @ w_out[l]
            ctx_mid = post_norm(DEEPNORM_ALPHA * ctx + mod_part(mod_c, 2) * fc, ln1_g[l], ln1_b[l])
            hc2 = modulate(ctx_mid, mod_part(mod_c, 3), mod_part(mod_c, 4))
            yc_moe = moe(hc2, router_w[l], router_b[l], exp_w1[l], exp_b1[l], exp_w2[l], exp_b2[l])
            ctx = post_norm(DEEPNORM_ALPHA * ctx_mid + mod_part(mod_c, 5) * yc_moe, ln2_g[l], ln2_b[l])
        x = x_new
    return x
```

```cpp
#include <hip/hip_runtime.h>
#include <cstdio>
#include <cstdint>
#include <cstddef>

#define LAS __attribute__((address_space(3)))
#define GAS __attribute__((address_space(1)))
typedef unsigned short bf16_t;
typedef short bf16x8 __attribute__((ext_vector_type(8)));
typedef float f32x4 __attribute__((ext_vector_type(4)));
typedef float f32x2 __attribute__((ext_vector_type(2)));
typedef unsigned u32x4 __attribute__((ext_vector_type(4)));
typedef unsigned u32x2 __attribute__((ext_vector_type(2)));

#ifndef N_LAUNCH_PER_PHASE
#define N_LAUNCH_PER_PHASE 0
#endif

constexpr int D = 1024, NB = 4, SEQ = 8192, T = NB * SEQ, CTXL = 256, TC = NB * CTXL, TT = T + TC;
constexpr int NH = 4, DK = 64, DV = 128, CH = 64, NCHUNK = SEQ / CH, NCC = CTXL / CH, NCT = NCHUNK + NCC;
constexpr int HYW = 512, HYC = 3 * HYW, INW = 3104;
constexpr int NE = 32, DE = 1024, CAP = T;
constexpr float LN_EPS = 1e-6f, ALPHA = 1.189207115002721f;
constexpr int NTHREADS = 512, NWAVES = 8;
constexpr int FFTN = 16384;

constexpr size_t al256(size_t x) { return (x + 255) & ~(size_t)255; }
constexpr size_t WS_BAR   = 0;
constexpr size_t WS_MOD   = 16384;
constexpr size_t WS_CNT   = WS_MOD + 5 * 6144 * 4;
constexpr size_t WS_ZERO_BYTES = al256(WS_CNT + 256);
constexpr size_t WS_LIST  = 262144;
constexpr size_t WS_PW    = WS_LIST + (size_t)NE * CAP * 4;
constexpr size_t WS_B1R   = WS_PW + (size_t)T * 4 * 4;
constexpr size_t WS_HID2  = WS_B1R + (size_t)NE * 2048 * 4;
constexpr size_t WS_BTIN  = WS_HID2 + (size_t)SEQ * 64 * 4;
constexpr size_t WS_BTOUT = WS_BTIN + (size_t)3584 * 1024 * 2;
constexpr size_t WS_W1T   = WS_BTOUT + (size_t)1024 * 1024 * 2;
constexpr size_t WS_W2T   = WS_W1T + (size_t)NE * 2048 * 1024 * 2;
constexpr size_t WS_PRE1  = WS_W2T + (size_t)NE * 1024 * 1024 * 2;
constexpr size_t WS_RA    = WS_PRE1 + (size_t)T * 1024 * 4;
constexpr size_t WS_H     = WS_RA;
constexpr size_t WS_Q     = WS_H + (size_t)TT * 1024 * 2;
constexpr size_t WS_K     = WS_Q + (size_t)T * 256 * 2;
constexpr size_t WS_V     = WS_K + (size_t)TT * 256 * 2;
constexpr size_t WS_G     = WS_V + (size_t)TT * 512 * 2;
constexpr size_t WS_GF    = WS_G + (size_t)T * 512 * 2;
constexpr size_t WS_GB    = WS_GF + (size_t)TT * 256 * 4;
constexpr size_t WS_UT    = WS_GB + (size_t)TT * 256 * 4;
constexpr size_t WS_RA_END= WS_UT + (size_t)NB * HYC * SEQ * 2;
constexpr size_t WS_H2    = WS_RA;
constexpr size_t WS_SLOTS = WS_RA;
constexpr size_t WS_RB    = al256(WS_RA_END > WS_RA + (size_t)T * 4 * 1024 * 2 ? WS_RA_END : WS_RA + (size_t)T * 4 * 1024 * 2);
constexpr size_t WS_KV    = WS_RB;
constexpr size_t WS_AV    = WS_KV + (size_t)2 * 16 * NCT * 8192 * 2;
constexpr size_t WS_SP    = WS_AV + (size_t)2 * 16 * NCT * 64 * 4;
constexpr size_t WS_HSPEC = WS_SP + (size_t)2 * 16 * NCHUNK * 8192 * 2;
constexpr size_t HSPEC_PER_WG = (size_t)2 * FFTN * 8 + (size_t)SEQ * 8 + (size_t)2 * SEQ * 4;
constexpr int MAX_GRID = 256;
constexpr size_t WS_YHYT  = WS_HSPEC + (size_t)MAX_GRID * HSPEC_PER_WG;
constexpr size_t WS_MIX   = WS_YHYT + (size_t)NB * HYW * SEQ * 2;
constexpr size_t WS_RB_END= WS_MIX + (size_t)T * 1024 * 2;
constexpr size_t WS_ACT   = WS_RB;
constexpr size_t WS_END   = al256(WS_RB_END > WS_RB + (size_t)T * 4 * 1024 * 2 ? WS_RB_END : WS_RB + (size_t)T * 4 * 1024 * 2);

constexpr int LDS_BYTES = 147456;
constexpr int LDS_MISC  = 145408;

typedef __bf16 bf16n2 __attribute__((ext_vector_type(2)));
__device__ __forceinline__ unsigned pk2(float lo, float hi) { bf16n2 v = {(__bf16)lo, (__bf16)hi}; return __builtin_bit_cast(unsigned, v); }
__device__ __forceinline__ bf16_t f2bf(float f) { __bf16 b = (__bf16)f; return __builtin_bit_cast(unsigned short, b); }
__device__ __forceinline__ float bf2f(bf16_t b) { return __uint_as_float(((unsigned)b) << 16); }
__device__ __forceinline__ float bflo(unsigned w) { return __uint_as_float(w << 16); }
__device__ __forceinline__ float bfhi(unsigned w) { return __uint_as_float(w & 0xffff0000u); }
__device__ __forceinline__ float wave_sum(float v) {
#pragma unroll
    for (int o = 1; o < 64; o <<= 1) v += __shfl_xor(v, o);
    return v;
}
__device__ __forceinline__ float silu_f(float x) { return x / (1.f + __expf(-x)); }
__device__ __forceinline__ float log_sigmoid_f(float z) { return fminf(z, 0.f) - log1pf(__expf(-fabsf(z))); }

#define XB_TMO      128
#define XB_XCNT(j)  (256  + 64 * (j))
#define XB_XSUB(j)  (1280 + 64 * (j))
#define XB_XGEN(j)  (2304 + 64 * (j))
#define XB_TOP      3328
#define XB_TOPGEN   3392
#define XCD_BAR_WORDS 3456
#define XB_SPIN_CAP (1u << 22)
__device__ __forceinline__ unsigned xb_ld(unsigned* p)              { return __hip_atomic_load(p, __ATOMIC_RELAXED, __HIP_MEMORY_SCOPE_AGENT); }
__device__ __forceinline__ unsigned xb_add(unsigned* p, unsigned v) { return __hip_atomic_fetch_add(p, v, __ATOMIC_RELAXED, __HIP_MEMORY_SCOPE_AGENT); }
__device__ __forceinline__ unsigned xb_xcc_id() { return (unsigned)__builtin_amdgcn_s_getreg((3 << 11) | 20) & 0xFu; }
#define XB_SPIN(cond, bar) do { unsigned _sp = 0; while (cond) { __builtin_amdgcn_s_sleep(1); \
    if ((++_sp & 255u) == 0u) { if (xb_ld(&(bar)[XB_TMO])) break; if (_sp > XB_SPIN_CAP) { atomicAdd(&(bar)[XB_TMO], 1u); break; } } } } while (0)
struct XcdBarrier { unsigned* bar; unsigned x; volatile LAS unsigned* st; };
__device__ __forceinline__ XcdBarrier xcd_barrier_post(unsigned* bar, volatile LAS unsigned* st) {
    XcdBarrier b; b.bar = bar; b.x = xb_xcc_id(); b.st = st;
    if (threadIdx.x == 0) (void)xb_add(&bar[XB_XCNT(b.x)], 1u);
    return b;
}
__device__ __forceinline__ void xcd_barrier_complete(unsigned* bar, unsigned x, unsigned& nloc, unsigned& nx) {
    const unsigned G = gridDim.x * gridDim.y * gridDim.z;
    unsigned sum, cnt, mine, sp = 0u;
    for (;;) {
        sum = 0u; cnt = 0u; mine = 0u;
#pragma unroll
        for (unsigned j = 0; j < 16; ++j) { const unsigned c = xb_ld(&bar[XB_XCNT(j)]); sum += c; cnt += (c > 0u) ? 1u : 0u; mine = (j == x) ? c : mine; }
        if (sum == G) break;
        __builtin_amdgcn_s_sleep(1);
        if ((++sp & 255u) == 0u) { if (xb_ld(&bar[XB_TMO])) break; if (sp > XB_SPIN_CAP) { atomicAdd(&bar[XB_TMO], 1u); break; } }
    }
    nloc = mine > 0u ? mine : 1u; nx = cnt > 0u ? cnt : 1u;
}
__device__ __forceinline__ void xcd_barrier(const XcdBarrier& b) {
    asm volatile("s_waitcnt vmcnt(0)" ::: "memory");
    __syncthreads();
    if (threadIdx.x == 0) {
        unsigned* bar = b.bar;
        __builtin_amdgcn_s_waitcnt(0);
        unsigned nloc = b.st[0], nx = b.st[1];
        if (nloc == 0u) { xcd_barrier_complete(bar, b.x, nloc, nx); b.st[0] = nloc; b.st[1] = nx; }
        const unsigned old = xb_add(&bar[XB_XSUB(b.x)], 1u);
        const unsigned gen = old / nloc;
        if (old + 1u == (gen + 1u) * nloc) {
            __builtin_amdgcn_fence(__ATOMIC_RELEASE, "agent");
            asm volatile("s_waitcnt vmcnt(0)" ::: "memory");
            const unsigned og = xb_add(&bar[XB_TOP], 1u);
            const unsigned tg = og / nx;
            if (og + 1u == (tg + 1u) * nx) xb_add(&bar[XB_TOPGEN], 1u);
            else XB_SPIN(xb_ld(&bar[XB_TOPGEN]) == tg, bar);
            __builtin_amdgcn_fence(__ATOMIC_ACQUIRE, "agent");
            xb_add(&bar[XB_XGEN(b.x)], 1u);
            asm volatile("s_waitcnt vmcnt(0)" ::: "memory");
        } else {
            XB_SPIN(xb_ld(&bar[XB_XGEN(b.x)]) == gen, bar);
            __builtin_amdgcn_fence(__ATOMIC_ACQUIRE, "agent");
            asm volatile("s_waitcnt vmcnt(0)" ::: "memory");
        }
    }
    __syncthreads();
}

struct Args {
    const float* in[32];
    float* out;
    unsigned char* ws;
    int ph_lo, ph_hi;
};
enum { I_X = 0, I_C, I_CTX, I_CCTX, I_ADAW, I_ADAB, I_WIN, I_WAF, I_BAF, I_WAB, I_BAB, I_NORMG, I_CONVW, I_CONVB, I_FW1, I_FB1, I_FW2, I_FB2, I_FWOUT, I_FFREQ,
       I_BIASD, I_WOUT, I_LN1G, I_LN1B, I_RW, I_RB, I_EW1, I_EB1, I_EW2, I_EB2, I_LN2G, I_LN2B };


namespace gm {
constexpr int BM = 256, BK = 64, HALF = 128, HTB = HALF * BK * 2, STAGE_BYTES = 8 * HTB, KD = 1024, NT = KD / BK;
constexpr int ROWB = KD * 2;
__device__ __forceinline__ int lds_byte(int r, int c) { const int st = (r >> 4) * 2 + (c >> 5), rr = r & 15, cc = c & 31, ob = rr * 64 + cc * 2; return st * 1024 + (ob ^ (((ob >> 9) & 1) << 5)); }
__device__ __forceinline__ void stage_rc(int b, int& R, int& C) { const int st = b / 1024, sb = b % 1024, swz = sb ^ (((sb >> 9) & 1) << 5); R = (st >> 1) * 16 + swz / 64; C = (st & 1) * 32 + (swz % 64) / 2; }
__device__ __forceinline__ int perm32(int rho) { const int n = rho >> 4, i = rho & 15; return 8 * (i >> 2) + 4 * n + (i & 3); }

struct Unit {
    const char* A;
    const char* B;
    const int* list;
    int type, row0, col0, valid, aux;
};

template <bool GATHER, int GSHIFT>
__device__ __forceinline__ void a_offsets(const Unit& u, const int (&R)[2], const int (&Cb)[2], unsigned (&o)[2][2]) {
#pragma unroll
    for (int h = 0; h < 2; ++h)
#pragma unroll
        for (int i = 0; i < 2; ++i) {
            const int r = h * HALF + R[i];
            if (!GATHER) o[h][i] = (unsigned)(r * ROWB + Cb[i]);
            else { const int idx = u.list[r < u.valid ? r : 0]; o[h][i] = (unsigned)(idx >> GSHIFT) * (unsigned)ROWB + (unsigned)Cb[i]; }
        }
}

template <bool GATHER, int GSHIFT, class Sched, class Epi>
__device__ __forceinline__ void gemm_stream(LAS unsigned char* lds, const Sched& S, const Epi& E) {
    const int tid = threadIdx.x, wid = __builtin_amdgcn_readfirstlane(tid >> 6), lane = tid & 63, wr = wid >> 2, wc = wid & 3, fr = lane & 15, fq = lane >> 4;
    int R[2], Cb[2]; unsigned voffB[2];
#pragma unroll
    for (int i = 0; i < 2; ++i) { int r, c; stage_rc(tid * 16 + i * 8192, r, c); R[i] = r; Cb[i] = c * 2; const int rb = (r & ~31) + perm32(r & 31); voffB[i] = (unsigned)(rb * ROWB + c * 2); }
    const size_t kstep = (size_t)(BK * 2), hstep = (size_t)HALF * ROWB;
    const unsigned ldsw = (unsigned)wid * 1024u;
    const int aoff = lds_byte(wr * 64 + fr, fq * 8), boff = lds_byte(wc * 32 + fr, fq * 8);
#define GM_SA(b, h) (((b) * 2 + (h)) * HTB)
#define GM_SB(b, h) ((4 + (b) * 2 + (h)) * HTB)
#define GM_STAGE(bufoff, gbase, vo0, vo1) do { \
        __builtin_amdgcn_global_load_lds((const unsigned*)((const char*)(gbase) + (vo0)), (LAS unsigned*)(lds + (bufoff) + ldsw), 16, 0, 0); \
        __builtin_amdgcn_global_load_lds((const unsigned*)((const char*)(gbase) + (vo1)), (LAS unsigned*)(lds + (bufoff) + ldsw + 8192), 16, 0, 0); } while (0)
#define GM_LDA(dst, b, h) do { _Pragma("unroll") for (int m = 0; m < 4; ++m) _Pragma("unroll") for (int k = 0; k < 2; ++k) dst[m][k] = *(const LAS bf16x8*)(lds + GM_SA(b, h) + aoff + m * 2048 + k * 1024); } while (0)
#define GM_LDB(dst, b, h) do { _Pragma("unroll") for (int n = 0; n < 2; ++n) _Pragma("unroll") for (int k = 0; k < 2; ++k) dst[n][k] = *(const LAS bf16x8*)(lds + GM_SB(b, h) + boff + n * 2048 + k * 1024); } while (0)
#define GM_MMA(ai, bj, At, Bt) do { __builtin_amdgcn_s_setprio(1); _Pragma("unroll") for (int m = 0; m < 4; ++m) _Pragma("unroll") for (int n = 0; n < 2; ++n) _Pragma("unroll") for (int k = 0; k < 2; ++k) \
        acc[ai][bj][m][n] = __builtin_amdgcn_mfma_f32_16x16x32_bf16(Bt[n][k], At[m][k], acc[ai][bj][m][n], 0, 0, 0); __builtin_amdgcn_s_setprio(0); } while (0)
#define GM_WAIT_V(n) asm volatile("s_waitcnt vmcnt(" #n ")" ::: "memory")
#define GM_WAIT_L(n) asm volatile("s_waitcnt lgkmcnt(" #n ")" ::: "memory")
#define GM_BAR __builtin_amdgcn_s_barrier()
#define GM_SCHED __builtin_amdgcn_sched_barrier(0)
    Unit cur, nxt; int ui = 0;
    if (!S.next(0, cur)) return;
    f32x4 acc[2][2][4][2];
#pragma unroll
    for (int a = 0; a < 2; ++a)
#pragma unroll
        for (int b = 0; b < 2; ++b)
#pragma unroll
            for (int m = 0; m < 4; ++m)
#pragma unroll
                for (int n = 0; n < 2; ++n) acc[a][b][m][n] = (f32x4){0.f, 0.f, 0.f, 0.f};
    bf16x8 At[4][2], B0[2][2], B1[2][2];
    unsigned ca[2][2], na[2][2];
    a_offsets<GATHER, GSHIFT>(cur, R, Cb, ca);
    const char* cA = cur.A; const char* cB = cur.B;
    GM_STAGE(GM_SB(0, 0), cB, voffB[0], voffB[1]); GM_STAGE(GM_SA(0, 0), cA, ca[0][0], ca[0][1]); GM_STAGE(GM_SB(0, 1), cB + hstep, voffB[0], voffB[1]); GM_STAGE(GM_SA(0, 1), cA, ca[1][0], ca[1][1]);
    if (wr == 1) GM_BAR;
    GM_WAIT_V(4); GM_BAR;
    GM_STAGE(GM_SB(1, 0), cB + kstep, voffB[0], voffB[1]); GM_STAGE(GM_SA(1, 0), cA + kstep, ca[0][0], ca[0][1]); GM_STAGE(GM_SB(1, 1), cB + hstep + kstep, voffB[0], voffB[1]);
    GM_WAIT_V(6); GM_BAR;
    for (;;) {
        const bool has_next = S.next(ui + 1, nxt);
        if (has_next) a_offsets<GATHER, GSHIFT>(nxt, R, Cb, na);
        else {
#pragma unroll
            for (int h = 0; h < 2; ++h)
#pragma unroll
                for (int i = 0; i < 2; ++i) na[h][i] = ca[h][i];
        }
        const char* nA = has_next ? nxt.A : cA; const char* nB = has_next ? nxt.B : cB;
        for (int t = 0; t < NT; t += 2) {
            const bool last = (t == NT - 2);
            const char* a1 = cA + (size_t)(t + 1) * kstep;
            const char* a2 = last ? nA : cA + (size_t)(t + 2) * kstep; const char* b2 = last ? nB : cB + (size_t)(t + 2) * kstep;
            const char* a3 = a2 + kstep; const char* b3 = b2 + kstep;
            const unsigned x00 = last ? na[0][0] : ca[0][0], x01 = last ? na[0][1] : ca[0][1], x10 = last ? na[1][0] : ca[1][0], x11 = last ? na[1][1] : ca[1][1];
            GM_LDB(B0, 0, 0); GM_SCHED; GM_LDA(At, 0, 0); GM_STAGE(GM_SA(1, 1), a1, ca[1][0], ca[1][1]);
            GM_WAIT_L(8); GM_BAR; GM_WAIT_L(0); GM_MMA(0, 0, At, B0); GM_BAR; GM_SCHED;
            GM_LDB(B1, 0, 1); GM_STAGE(GM_SB(0, 0), b2, voffB[0], voffB[1]);
            GM_BAR; GM_WAIT_L(0); GM_MMA(0, 1, At, B1); GM_BAR;
            GM_LDA(At, 0, 1); GM_STAGE(GM_SA(0, 0), a2, x00, x01);
            GM_BAR; GM_WAIT_L(0); GM_MMA(1, 0, At, B0); GM_BAR; GM_SCHED;
            GM_STAGE(GM_SB(0, 1), b2 + hstep, voffB[0], voffB[1]);
            GM_WAIT_V(6); GM_BAR; GM_MMA(1, 1, At, B1); GM_BAR;
            GM_LDB(B0, 1, 0); GM_SCHED; GM_LDA(At, 1, 0); GM_STAGE(GM_SA(0, 1), a2, x10, x11);
            GM_WAIT_L(8); GM_BAR; GM_WAIT_L(0); GM_MMA(0, 0, At, B0); GM_BAR; GM_SCHED;
            GM_LDB(B1, 1, 1); GM_STAGE(GM_SB(1, 0), b3, voffB[0], voffB[1]);
            GM_BAR; GM_WAIT_L(0); GM_MMA(0, 1, At, B1); GM_BAR;
            GM_LDA(At, 1, 1); GM_STAGE(GM_SA(1, 0), a3, x00, x01);
            GM_BAR; GM_WAIT_L(0); GM_MMA(1, 0, At, B0); GM_BAR; GM_SCHED;
            GM_STAGE(GM_SB(1, 1), b3 + hstep, voffB[0], voffB[1]);
            GM_WAIT_V(6); GM_BAR; GM_MMA(1, 1, At, B1); GM_BAR;
        }
        E(acc, cur, wr, wc, fr, fq);
        if (!has_next) break;
#pragma unroll
        for (int a = 0; a < 2; ++a)
#pragma unroll
            for (int b = 0; b < 2; ++b)
#pragma unroll
                for (int m = 0; m < 4; ++m)
#pragma unroll
                    for (int n = 0; n < 2; ++n) acc[a][b][m][n] = (f32x4){0.f, 0.f, 0.f, 0.f};
        cur = nxt; cA = nA; cB = nB; ++ui;
#pragma unroll
        for (int h = 0; h < 2; ++h)
#pragma unroll
            for (int i = 0; i < 2; ++i) ca[h][i] = na[h][i];
    }
    GM_WAIT_V(0);
    if (wr == 0) GM_BAR;
    GM_BAR;
#undef GM_SA
#undef GM_SB
#undef GM_STAGE
#undef GM_LDA
#undef GM_LDB
#undef GM_MMA
#undef GM_WAIT_V
#undef GM_WAIT_L
#undef GM_BAR
#undef GM_SCHED
}

__device__ __forceinline__ u32x4 pack8(f32x4 a, f32x4 b) { u32x4 w; w.x = pk2(a[0], a[1]); w.y = pk2(a[2], a[3]); w.z = pk2(b[0], b[1]); w.w = pk2(b[2], b[3]); return w; }

struct SchedIn {
    unsigned char* ws; int G, c;
    __device__ __forceinline__ bool next(int i, Unit& u) const {
        int L = i * G + c;
        u.list = nullptr; u.valid = 256; u.aux = 0;
        if (L < 768) {
            const int pa = L % 6, pb = L / 6;
            u.A = (const char*)(ws + WS_BTIN) + (size_t)(2048 + 256 * pa) * ROWB; u.B = (const char*)(ws + WS_H) + (size_t)(256 * pb) * ROWB;
            u.type = 2; u.row0 = 256 * pa; u.col0 = 256 * pb; return true;
        }
        L -= 768;
        if (L < 1024) {
            const int pm = L >> 3, pn = L & 7;
            u.A = (const char*)(ws + WS_H) + (size_t)(256 * pm) * ROWB; u.B = (const char*)(ws + WS_BTIN) + (size_t)(256 * pn) * ROWB;
            u.type = pn < 6 ? 0 : 1; u.row0 = 256 * pm; u.col0 = pn; return true;
        }
        L -= 1024;
        if (L < 20) {
            const int pm = L / 5, j = L % 5, pn = j == 0 ? 1 : (j == 1 ? 2 : (j == 2 ? 3 : (j == 3 ? 6 : 7)));
            u.A = (const char*)(ws + WS_H) + (size_t)(T + 256 * pm) * ROWB; u.B = (const char*)(ws + WS_BTIN) + (size_t)(256 * pn) * ROWB;
            u.type = pn < 6 ? 0 : 1; u.row0 = T + 256 * pm; u.col0 = pn; return true;
        }
        return false;
    }
};
struct EpiIn {
    unsigned char* ws; const float* baf; const float* bab;
    __device__ __forceinline__ void operator()(const f32x4 (&acc)[2][2][4][2], const Unit& u, int wr, int wc, int fr, int fq) const {
        const int rl = wr * 64 + fr, cl = wc * 32 + 8 * fq;
        if (u.type == 0) {
            const int pn = u.col0;
            bf16_t* dst; int ld, cb;
            if (pn == 0) { dst = (bf16_t*)(ws + WS_Q); ld = 256; cb = 0; }
            else if (pn == 1) { dst = (bf16_t*)(ws + WS_K); ld = 256; cb = 0; }
            else if (pn < 4) { dst = (bf16_t*)(ws + WS_V); ld = 512; cb = (pn - 2) * 256; }
            else { dst = (bf16_t*)(ws + WS_G); ld = 512; cb = (pn - 4) * 256; }
#pragma unroll
            for (int ai = 0; ai < 2; ++ai)
#pragma unroll
                for (int m = 0; m < 4; ++m) { bf16_t* rowp = dst + (size_t)(u.row0 + rl + ai * 128 + m * 16) * ld + cb + cl;
#pragma unroll
                    for (int bj = 0; bj < 2; ++bj) *(u32x4*)(rowp + bj * 128) = pack8(acc[ai][bj][m][0], acc[ai][bj][m][1]); }
        } else if (u.type == 1) {
            float* dst = (float*)(ws + (u.col0 == 6 ? WS_GF : WS_GB)); const float* ba = (u.col0 == 6) ? baf : bab;
            f32x4 bv[2][2];
#pragma unroll
            for (int bj = 0; bj < 2; ++bj)
#pragma unroll
                for (int n = 0; n < 2; ++n) bv[bj][n] = *(const f32x4*)(ba + cl + bj * 128 + 4 * n);
#pragma unroll
            for (int ai = 0; ai < 2; ++ai)
#pragma unroll
                for (int m = 0; m < 4; ++m) { float* rowp = dst + (size_t)(u.row0 + rl + ai * 128 + m * 16) * 256 + cl;
#pragma unroll
                    for (int bj = 0; bj < 2; ++bj)
#pragma unroll
                        for (int n = 0; n < 2; ++n) { f32x4 z = acc[ai][bj][m][n] + bv[bj][n], o;
#pragma unroll
                            for (int j = 0; j < 4; ++j) o[j] = log_sigmoid_f(z[j]) * (1.f / 16.f);
                            *(f32x4*)(rowp + bj * 128 + 4 * n) = o; } }
        } else {
            const int b = u.col0 >> 13, l0 = u.col0 & 8191;
            bf16_t* dst = (bf16_t*)(ws + WS_UT) + ((size_t)b * HYC) * SEQ + l0 + cl;
#pragma unroll
            for (int ai = 0; ai < 2; ++ai)
#pragma unroll
                for (int m = 0; m < 4; ++m) { bf16_t* rowp = dst + (size_t)(u.row0 + rl + ai * 128 + m * 16) * SEQ;
#pragma unroll
                    for (int bj = 0; bj < 2; ++bj) *(u32x4*)(rowp + bj * 128) = pack8(acc[ai][bj][m][0], acc[ai][bj][m][1]); }
        }
    }
};

struct SchedOut {
    unsigned char* ws; int G, c;
    __device__ __forceinline__ bool next(int i, Unit& u) const {
        const int L = i * G + c; if (L >= 512) return false;
        const int pm = L >> 2, pn = L & 3;
        u.A = (const char*)(ws + WS_MIX) + (size_t)(256 * pm) * ROWB; u.B = (const char*)(ws + WS_BTOUT) + (size_t)(256 * pn) * ROWB;
        u.list = nullptr; u.valid = 256; u.aux = 0; u.type = 3; u.row0 = 256 * pm; u.col0 = 256 * pn; return true;
    }
};
struct EpiOut {
    unsigned char* ws; const float* x;
    __device__ __forceinline__ void operator()(const f32x4 (&acc)[2][2][4][2], const Unit& u, int wr, int wc, int fr, int fq) const {
        const int rl = wr * 64 + fr, cl = u.col0 + wc * 32 + 8 * fq;
        const int b = u.row0 >> 13;
        const float* gate = (const float*)(ws + WS_MOD) + b * 6144 + 2 * 1024;
        float* pre = (float*)(ws + WS_PRE1);
        f32x4 gv[2][2];
#pragma unroll
        for (int bj = 0; bj < 2; ++bj)
#pragma unroll
            for (int n = 0; n < 2; ++n) gv[bj][n] = *(const f32x4*)(gate + cl + bj * 128 + 4 * n);
#pragma unroll
        for (int ai = 0; ai < 2; ++ai)
#pragma unroll
            for (int m = 0; m < 4; ++m) { const size_t ro = (size_t)(u.row0 + rl + ai * 128 + m * 16) * 1024 + cl;
#pragma unroll
                for (int bj = 0; bj < 2; ++bj)
#pragma unroll
                    for (int n = 0; n < 2; ++n) { const f32x4 xv = *(const f32x4*)(x + ro + bj * 128 + 4 * n);
                        *(f32x4*)(pre + ro + bj * 128 + 4 * n) = xv * ALPHA + gv[bj][n] * acc[ai][bj][m][n]; } }
    }
};

constexpr int LDS_TAB = STAGE_BYTES;
template <int WHICH>
struct SchedMoe {
    unsigned char* ws; const LAS int* tab; int G, c;
    __device__ __forceinline__ bool next(int i, Unit& u) const {
        constexpr int NCT_ = WHICH == 1 ? 8 : 4;
        const int L = i * G + c; const int nrt = tab[32];
        if (L >= nrt * NCT_) return false;
        const int rt = L / NCT_, ct = L % NCT_;
        const int info = tab[64 + rt], e = info & 255, r0 = (info >> 8) * 256;
        const int cnt = tab[e];
        u.valid = (cnt - r0) < 256 ? (cnt - r0) : 256;
        u.list = (const int*)(ws + WS_LIST) + (size_t)e * CAP + r0;
        u.A = (const char*)(ws + (WHICH == 1 ? WS_H2 : WS_ACT));
        u.B = (const char*)(ws + (WHICH == 1 ? WS_W1T : WS_W2T)) + ((size_t)e * (WHICH == 1 ? 2048 : 1024) + 256 * ct) * ROWB;
        u.type = 3 + WHICH; u.row0 = r0; u.col0 = ct; u.aux = e; return true;
    }
};
__device__ __forceinline__ float swiglu_f(float glu, float lin) {
    glu = fminf(glu, 7.f); lin = fminf(fmaxf(lin, -7.f), 7.f);
    return glu * (1.f / (1.f + __expf(-1.702f * glu))) * (lin + 1.f);
}
struct EpiMoe1 {
    unsigned char* ws;
    __device__ __forceinline__ void operator()(const f32x4 (&acc)[2][2][4][2], const Unit& u, int wr, int wc, int fr, int fq) const {
        const int rl = wr * 64 + fr, cl = wc * 32 + 8 * fq, e = u.aux, ct = u.col0;
        const float* b1 = (const float*)(ws + WS_B1R) + (size_t)e * 2048 + 256 * ct + cl;
        bf16_t* act = (bf16_t*)(ws + WS_ACT);
        f32x4 bg[2], bl[2];
#pragma unroll
        for (int n = 0; n < 2; ++n) { bg[n] = *(const f32x4*)(b1 + 4 * n); bl[n] = *(const f32x4*)(b1 + 128 + 4 * n); }
#pragma unroll
        for (int ai = 0; ai < 2; ++ai)
#pragma unroll
            for (int m = 0; m < 4; ++m) { const int r = rl + ai * 128 + m * 16;
                if (r < u.valid) { const int pair = u.list[r];
                    f32x4 o[2];
#pragma unroll
                    for (int n = 0; n < 2; ++n) { const f32x4 gl = acc[ai][0][m][n] + bg[n], li = acc[ai][1][m][n] + bl[n];
#pragma unroll
                        for (int j = 0; j < 4; ++j) o[n][j] = swiglu_f(gl[j], li[j]); }
                    *(u32x4*)(act + (size_t)pair * 1024 + 128 * ct + cl) = pack8(o[0], o[1]); } }
    }
};
struct EpiMoe2 {
    unsigned char* ws; const float* b2;
    __device__ __forceinline__ void operator()(const f32x4 (&acc)[2][2][4][2], const Unit& u, int wr, int wc, int fr, int fq) const {
        const int rl = wr * 64 + fr, cl = wc * 32 + 8 * fq, e = u.aux, ct = u.col0;
        const float* bb = b2 + (size_t)e * 1024 + 256 * ct + cl;
        const float* pw = (const float*)(ws + WS_PW);
        bf16_t* slots = (bf16_t*)(ws + WS_SLOTS);
        f32x4 bv[2][2];
#pragma unroll
        for (int bj = 0; bj < 2; ++bj)
#pragma unroll
            for (int n = 0; n < 2; ++n) bv[bj][n] = *(const f32x4*)(bb + bj * 128 + 4 * n);
#pragma unroll
        for (int ai = 0; ai < 2; ++ai)
#pragma unroll
            for (int m = 0; m < 4; ++m) { const int r = rl + ai * 128 + m * 16;
                if (r < u.valid) { const int pair = u.list[r]; const float w = pw[pair];
#pragma unroll
                    for (int bj = 0; bj < 2; ++bj)
                        *(u32x4*)(slots + (size_t)pair * 1024 + 256 * ct + bj * 128 + cl) = pack8((acc[ai][bj][m][0] + bv[bj][0]) * w, (acc[ai][bj][m][1] + bv[bj][1]) * w); } }
    }
};
}

__device__ __forceinline__ void p0_mod_and_filter(const Args& a, LAS unsigned char* lds) {
    const int tid = threadIdx.x, lane = tid & 63, wave = tid >> 6;
    const float* c = a.in[I_C]; const float* cctx = a.in[I_CCTX]; const float* adaw = a.in[I_ADAW]; const float* adab = a.in[I_ADAB];
    float* mod = (float*)(a.ws + WS_MOD);
    LAS float* sl = (LAS float*)lds;
    LAS float* pt = (LAS float*)lds + 5 * 1024;
    for (int i = tid; i < 5 * 1024; i += NTHREADS) { const int r = i >> 10, k = i & 1023; sl[i] = silu_f(r < 4 ? c[r * 1024 + k] : cctx[k]); }
    for (int it = blockIdx.x; it < 256; it += gridDim.x) {
        __syncthreads();
        if (tid < 504) {
            const int col = tid % 24, ks = tid / 24, n = it * 24 + col, kbeg = ks * 49, kend = (kbeg + 49 < 1024) ? kbeg + 49 : 1024;
            float acc[5] = {0.f, 0.f, 0.f, 0.f, 0.f};
            for (int k = kbeg; k < kend; ++k) { const float w = adaw[(size_t)k * 6144 + n];
#pragma unroll
                for (int r = 0; r < 5; ++r) acc[r] += sl[r * 1024 + k] * w; }
#pragma unroll
            for (int r = 0; r < 5; ++r) pt[(ks * 5 + r) * 24 + col] = acc[r];
        }
        __syncthreads();
        if (tid < 120) { const int r = tid / 24, col = tid % 24, n = it * 24 + col; float s = adab[n];
            for (int ks = 0; ks < 21; ++ks) s += pt[(ks * 5 + r) * 24 + col];
            mod[r * 6144 + n] = s; }
    }
    __syncthreads();
    const float* w1 = a.in[I_FW1]; const float* b1 = a.in[I_FB1]; const float* w2 = a.in[I_FW2]; const float* b2 = a.in[I_FB2]; const float* fq = a.in[I_FFREQ];
    float* hid2 = (float*)(a.ws + WS_HID2);
    LAS float* zs = (LAS float*)lds + 8192 + wave * 128;
    const float frq = fq[lane], bb1 = b1[lane], bb2 = b2[lane];
    for (int t = (blockIdx.x * NWAVES + wave); t < SEQ; t += gridDim.x * NWAVES) {
        float z = 0.f;
        if (lane == 0) z = (float)t / (float)(SEQ - 1);
        else if (lane < 33) { const int i = (lane - 1) & 15; const float f = 1e-4f + (float)i * ((15.f - 1e-4f) / 15.f);
            const float ang = (6.283185307179586f * (float)t / (float)SEQ) * f; z = (lane < 17) ? cosf(ang) : -sinf(ang); }
        if (lane < 33) zs[lane] = z;
        __builtin_amdgcn_wave_barrier(); asm volatile("s_waitcnt lgkmcnt(0)" ::: "memory");
        float s = bb1;
#pragma unroll
        for (int e = 0; e < 33; ++e) s += zs[e] * w1[e * 64 + lane];
        const float h1 = sinf(frq * s);
        zs[64 + lane] = h1;
        __builtin_amdgcn_wave_barrier(); asm volatile("s_waitcnt lgkmcnt(0)" ::: "memory");
        float s2 = bb2;
#pragma unroll 16
        for (int g = 0; g < 64; ++g) s2 += zs[64 + g] * w2[g * 64 + lane];
        hid2[(size_t)t * 64 + lane] = sinf(frq * s2);
        __builtin_amdgcn_wave_barrier(); asm volatile("s_waitcnt lgkmcnt(0)" ::: "memory");
    }
}

__device__ __forceinline__ void tr_item(const float* W, int ldw, int k0, int c0, int cstride, float scale, bf16_t* dstrow0, LAS float* scr, int lane) {
#pragma unroll 8
    for (int i = 0; i < 32; ++i) { const int kk = 2 * i + (lane >> 5); scr[kk * 33 + (lane & 31)] = W[(size_t)(k0 + kk) * ldw + c0 + (lane & 31) * cstride] * scale; }
    asm volatile("s_waitcnt lgkmcnt(0)" ::: "memory"); __builtin_amdgcn_wave_barrier();
    const int c = lane & 7;
#pragma unroll
    for (int j = 0; j < 4; ++j) { const int n = (lane >> 3) + 8 * j; const LAS float* s = scr + (8 * c) * 33 + n;
        u32x4 o; o.x = pk2(s[0 * 33], s[1 * 33]); o.y = pk2(s[2 * 33], s[3 * 33]); o.z = pk2(s[4 * 33], s[5 * 33]); o.w = pk2(s[6 * 33], s[7 * 33]);
        *(u32x4*)(dstrow0 + (size_t)n * 1024 + k0 + 8 * c) = o; }
    asm volatile("s_waitcnt lgkmcnt(0)" ::: "memory"); __builtin_amdgcn_wave_barrier();
}
__device__ __forceinline__ void fold_item(const float* win, const float* wa, int dir, int k0, int j0, bf16_t* dstrow0, LAS float* scr, int lane) {
#pragma unroll 4
    for (int i = 0; i < 32; ++i) { const int kk = 2 * i + (lane >> 5); const float* wr = win + (size_t)(k0 + kk) * INW + 1536 + 16 * dir; float s = 0.f;
#pragma unroll
        for (int r = 0; r < 16; ++r) s += wr[r] * wa[r * 256 + j0 + (lane & 31)];
        scr[kk * 33 + (lane & 31)] = s; }
    asm volatile("s_waitcnt lgkmcnt(0)" ::: "memory"); __builtin_amdgcn_wave_barrier();
    const int c = lane & 7;
#pragma unroll
    for (int j = 0; j < 4; ++j) { const int n = (lane >> 3) + 8 * j; const LAS float* s = scr + (8 * c) * 33 + n;
        u32x4 o; o.x = pk2(s[0 * 33], s[1 * 33]); o.y = pk2(s[2 * 33], s[3 * 33]); o.z = pk2(s[4 * 33], s[5 * 33]); o.w = pk2(s[6 * 33], s[7 * 33]);
        *(u32x4*)(dstrow0 + (size_t)n * 1024 + k0 + 8 * c) = o; }
    asm volatile("s_waitcnt lgkmcnt(0)" ::: "memory"); __builtin_amdgcn_wave_barrier();
}
__device__ __forceinline__ void ln_mod_row(const float* xrow, const float* shift, const float* scale, bf16_t* orow, int lane) {
    const f32x4* xr = (const f32x4*)xrow + lane;
    f32x4 v[4]; float s = 0.f;
#pragma unroll
    for (int j = 0; j < 4; ++j) { v[j] = xr[64 * j]; s += (v[j][0] + v[j][1]) + (v[j][2] + v[j][3]); }
    const float mean = wave_sum(s) * (1.f / D); float s2 = 0.f;
#pragma unroll
    for (int j = 0; j < 4; ++j) { v[j] = v[j] - mean; s2 += (v[j][0] * v[j][0] + v[j][1] * v[j][1]) + (v[j][2] * v[j][2] + v[j][3] * v[j][3]); }
    const float rstd = 1.f / sqrtf(wave_sum(s2) * (1.f / D) + LN_EPS);
    u32x2* o8 = (u32x2*)orow + lane;
#pragma unroll
    for (int j = 0; j < 4; ++j) { const f32x4 sh = ((const f32x4*)shift)[64 * j + lane], sc = ((const f32x4*)scale)[64 * j + lane];
        const f32x4 y = v[j] * rstd * (sc + 1.f) + sh;
        u32x2 w; w.x = pk2(y[0], y[1]); w.y = pk2(y[2], y[3]); o8[64 * j] = w; }
}
__device__ __forceinline__ void p1_prep(const Args& a, LAS unsigned char* lds) {
    const int tid = threadIdx.x, lane = tid & 63, wave = tid >> 6;
    LAS float* scr = (LAS float*)(lds + wave * 16384);
    const int gw = blockIdx.x * NWAVES + wave, NGW = gridDim.x * NWAVES;
    const float* win = a.in[I_WIN];
    bf16_t* btin = (bf16_t*)(a.ws + WS_BTIN); bf16_t* btout = (bf16_t*)(a.ws + WS_BTOUT); bf16_t* w1t = (bf16_t*)(a.ws + WS_W1T); bf16_t* w2t = (bf16_t*)(a.ws + WS_W2T);
    const float* mod = (const float*)(a.ws + WS_MOD);
    bf16_t* H = (bf16_t*)(a.ws + WS_H);
    for (int row = gw; row < TT; row += NGW) {
        const float* xr; int mr;
        if (row < T) { xr = a.in[I_X] + (size_t)row * D; mr = row >> 13; } else { xr = a.in[I_CTX] + (size_t)(row - T) * D; mr = 4; }
        ln_mod_row(xr, mod + mr * 6144, mod + mr * 6144 + 1024, H + (size_t)row * D, lane);
    }
    constexpr int I_IN = 16 * 96, I_FOLD = 16 * 8 * 2, I_OUT = 16 * 32, I_W1 = NE * 16 * 64, I_W2 = NE * 16 * 32;
    constexpr int NITEMS = I_IN + I_FOLD + I_OUT + I_W1 + I_W2;
    for (int it = gw; it < NITEMS; it += NGW) {
        int r = it;
        if (r < I_IN) {
            const int kb = r / 96, nb = r % 96;
            if (nb < 48) tr_item(win, INW, 64 * kb, 32 * nb, 1, nb < 8 ? 0.125f : 1.f, btin + (size_t)(32 * nb) * 1024, scr, lane);
            else tr_item(win, INW, 64 * kb, 1568 + 32 * (nb - 48), 1, 1.f, btin + (size_t)(2048 + 32 * (nb - 48)) * 1024, scr, lane);
            continue; }
        r -= I_IN;
        if (r < I_FOLD) { const int dir = r & 1, jb = (r >> 1) & 7, kb = r >> 4;
            fold_item(win, dir ? a.in[I_WAB] : a.in[I_WAF], dir, 64 * kb, 32 * jb, btin + (size_t)(1536 + 256 * dir + 32 * jb) * 1024, scr, lane); continue; }
        r -= I_FOLD;
        if (r < I_OUT) { const int kb = r / 32, nb = r % 32; tr_item(a.in[I_WOUT], 1024, 64 * kb, 32 * nb, 1, 1.f, btout + (size_t)(32 * nb) * 1024, scr, lane); continue; }
        r -= I_OUT;
        if (r < I_W1) {
            const int e = r / 1024, q = r % 1024, s = q & 1, nb = (q >> 1) & 31, kb = q >> 6;
            const int ct = nb >> 2, jj0 = (nb & 3) * 32;
            tr_item(a.in[I_EW1] + (size_t)e * 1024 * 2048, 2048, 64 * kb, 2 * (128 * ct + jj0) + s, 2, 1.f, w1t + ((size_t)e * 2048 + 256 * ct + 128 * s + jj0) * 1024, scr, lane);
            continue; }
        r -= I_W1;
        { const int e = r / 512, q = r % 512, kb = q / 32, nb = q % 32;
          tr_item(a.in[I_EW2] + (size_t)e * 1024 * 1024, 1024, 64 * kb, 32 * nb, 1, 1.f, w2t + ((size_t)e * 1024 + 32 * nb) * 1024, scr, lane); }
    }
    float* b1r = (float*)(a.ws + WS_B1R); const float* eb1 = a.in[I_EB1];
    for (int i = blockIdx.x * NTHREADS + tid; i < NE * 2048; i += gridDim.x * NTHREADS) {
        const int e = i >> 11, n = i & 2047, ct = n >> 8, s = (n >> 7) & 1, jj = n & 127;
        b1r[i] = eb1[(size_t)e * 2048 + 2 * (128 * ct + jj) + s];
    }
}

namespace gla {
constexpr int RS = 72;
constexpr int L_TOTF = 0, L_TOTB = 2048, L_SSQ = 4096;
constexpr int L_T0 = 8192;
constexpr int L_T1 = L_T0 + 9216, L_T2 = L_T1 + 9216, L_T3 = L_T2 + 9216;
constexpr int L_VT = L_T3 + 9216;
constexpr int L_P  = L_VT + 18432;
constexpr int L_END = L_P + 9216;

__device__ __forceinline__ bf16x8 frag(const LAS unsigned char* tile, int row, int k0, int lane) {
    return *(const LAS bf16x8*)(tile + ((row + (lane & 15)) * RS + k0 + 8 * (lane >> 4)) * 2);
}
__device__ __forceinline__ void chunk_cums(LAS unsigned char* L, const float* GF, const float* GB, size_t tok0, int h, int wave, int lane, float (&cumf)[8], float (&cumb)[8], float& allf, float& allb) {
    LAS float* totf = (LAS float*)(L + L_TOTF); LAS float* totb = (LAS float*)(L + L_TOTB);
    float gf[8], gb[8];
#pragma unroll
    for (int r = 0; r < 8; ++r) { const size_t o = (tok0 + 8 * wave + r) * 256 + h * 64 + lane; gf[r] = GF[o]; gb[r] = GB[o]; }
    cumf[0] = gf[0];
#pragma unroll
    for (int r = 1; r < 8; ++r) cumf[r] = cumf[r - 1] + gf[r];
    cumb[7] = gb[7];
#pragma unroll
    for (int r = 6; r >= 0; --r) cumb[r] = cumb[r + 1] + gb[r];
    totf[wave * 64 + lane] = cumf[7]; totb[wave * 64 + lane] = cumb[0];
    __syncthreads();
    float of = 0.f, ob = 0.f, af = 0.f, ab = 0.f;
#pragma unroll
    for (int w = 0; w < 8; ++w) { const float tf = totf[w * 64 + lane], tb = totb[w * 64 + lane]; af += tf; ab += tb; of += (w < wave) ? tf : 0.f; ob += (w > wave) ? tb : 0.f; }
#pragma unroll
    for (int r = 0; r < 8; ++r) { cumf[r] += of; cumb[r] += ob; }
    allf = af; allb = ab;
}
__device__ __forceinline__ void load_vt(LAS unsigned char* L, const bf16_t* V, size_t tok0, int h, int tid) {
    LAS bf16_t* vt = (LAS bf16_t*)(L + L_VT);
    const int j = tid >> 3, c8 = tid & 7;
#pragma unroll
    for (int q = 0; q < 2; ++q) { const int dv0 = 8 * (c8 + 8 * q);
        const u32x4 w = *(const u32x4*)(V + (tok0 + j) * 512 + h * 128 + dv0);
        const unsigned ww[4] = {w.x, w.y, w.z, w.w};
#pragma unroll
        for (int e = 0; e < 4; ++e) { vt[(dv0 + 2 * e) * RS + j] = (bf16_t)(ww[e] & 0xffffu); vt[(dv0 + 2 * e + 1) * RS + j] = (bf16_t)(ww[e] >> 16); } }
}

__device__ __forceinline__ void g1_unit(const Args& a, LAS unsigned char* L, int bh, int chunk  ) {
    const int tid = threadIdx.x, lane = tid & 63, wave = __builtin_amdgcn_readfirstlane(tid >> 6);
    const int b = bh >> 2, h = bh & 3;
    const size_t tok0 = chunk < NCHUNK ? (size_t)b * SEQ + (size_t)chunk * CH : (size_t)T + (size_t)b * CTXL + (size_t)(chunk - NCHUNK) * CH;
    const float* GF = (const float*)(a.ws + WS_GF); const float* GB = (const float*)(a.ws + WS_GB);
    const bf16_t* Kb = (const bf16_t*)(a.ws + WS_K); const bf16_t* Vb = (const bf16_t*)(a.ws + WS_V);
    float cumf[8], cumb[8], allf, allb;
    __syncthreads();
    chunk_cums(L, GF, GB, tok0, h, wave, lane, cumf, cumb, allf, allb);
    LAS bf16_t* ketf = (LAS bf16_t*)(L + L_T0); LAS bf16_t* ketb = (LAS bf16_t*)(L + L_T1);
#pragma unroll
    for (int r = 0; r < 8; ++r) { const int i = 8 * wave + r; const float kv = bf2f(Kb[(tok0 + i) * 256 + h * 64 + lane]);
        ketf[lane * RS + i] = f2bf(kv * __expf(allf - cumf[r])); ketb[lane * RS + i] = f2bf(kv * __expf(allb - cumb[r])); }
    load_vt(L, Vb, tok0, h, tid);
    if (wave == 0) { float* av = (float*)(a.ws + WS_AV); av[((size_t)(0 * 16 + bh) * NCT + chunk) * 64 + lane] = __expf(allf); av[((size_t)(1 * 16 + bh) * NCT + chunk) * 64 + lane] = __expf(allb); }
    __syncthreads();
    bf16_t* KV = (bf16_t*)(a.ws + WS_KV);
#pragma unroll
    for (int dir = 0; dir < 2; ++dir) {
        const LAS unsigned char* ket = L + (dir ? L_T1 : L_T0);
        bf16_t* dst = KV + ((size_t)(dir * 16 + bh) * NCT + chunk) * 8192;
#pragma unroll
        for (int nt = 0; nt < 4; ++nt) { f32x4 acc = {0.f, 0.f, 0.f, 0.f};
#pragma unroll
            for (int ks = 0; ks < 2; ++ks) acc = __builtin_amdgcn_mfma_f32_16x16x32_bf16(frag(L + L_VT, 16 * wave, 32 * ks, lane), frag(ket, 16 * nt, 32 * ks, lane), acc, 0, 0, 0);
#pragma unroll
            for (int r = 0; r < 4; ++r) dst[(16 * wave + 4 * (lane >> 4) + r) * 64 + 16 * nt + (lane & 15)] = f2bf(acc[r]); }
    }
}

__device__ __forceinline__ void g2_scan(const Args& a) {
    const bf16_t* KV = (const bf16_t*)(a.ws + WS_KV); const float* AV = (const float*)(a.ws + WS_AV); bf16_t* SP = (bf16_t*)(a.ws + WS_SP);
    for (int id = blockIdx.x * NTHREADS + threadIdx.x; id < 32 * 4096; id += gridDim.x * NTHREADS) {
        const int db = id >> 12, e2 = id & 4095, dir = db >> 4, dk = (2 * e2) & 63;
        const unsigned* kv = (const unsigned*)(KV + (size_t)db * NCT * 8192) + e2;
        const float* av = AV + (size_t)db * NCT * 64 + dk;
        unsigned* sp = (unsigned*)(SP + (size_t)db * NCHUNK * 8192) + e2;
        float s0 = 0.f, s1 = 0.f;
#pragma unroll
        for (int q = 0; q < NCC; ++q) { const int c = NCHUNK + (dir ? (NCC - 1 - q) : q);
            const unsigned w = kv[(size_t)c * 4096]; const f32x2 aa = *(const f32x2*)(av + (size_t)c * 64);
            s0 = aa[0] * s0 + bflo(w); s1 = aa[1] * s1 + bfhi(w); }
        for (int q0 = 0; q0 < NCHUNK; q0 += 8) {
            unsigned w[8]; f32x2 aa[8];
#pragma unroll
            for (int u = 0; u < 8; ++u) { const int c = dir ? (NCHUNK - 1 - (q0 + u)) : (q0 + u); w[u] = kv[(size_t)c * 4096]; aa[u] = *(const f32x2*)(av + (size_t)c * 64); }
#pragma unroll
            for (int u = 0; u < 8; ++u) { const int c = dir ? (NCHUNK - 1 - (q0 + u)) : (q0 + u);
                sp[(size_t)c * 4096] = pk2(s0, s1);
                s0 = aa[u][0] * s0 + bflo(w[u]); s1 = aa[u][1] * s1 + bfhi(w[u]); }
        }
    }
}

__device__ __forceinline__ void g3_unit(const Args& a, LAS unsigned char* L, int bh, int chunk  ) {
    const int tid = threadIdx.x, lane = tid & 63, wave = __builtin_amdgcn_readfirstlane(tid >> 6);
    const int b = bh >> 2, h = bh & 3;
    const size_t tok0 = (size_t)b * SEQ + (size_t)chunk * CH;
    const float* GF = (const float*)(a.ws + WS_GF); const float* GB = (const float*)(a.ws + WS_GB);
    const bf16_t* Qb = (const bf16_t*)(a.ws + WS_Q); const bf16_t* Kb = (const bf16_t*)(a.ws + WS_K); const bf16_t* Vb = (const bf16_t*)(a.ws + WS_V); const bf16_t* Gt = (const bf16_t*)(a.ws + WS_G);
    float cumf[8], cumb[8], allf, allb;
    __syncthreads();
    chunk_cums(L, GF, GB, tok0, h, wave, lane, cumf, cumb, allf, allb);
    LAS bf16_t* qf = (LAS bf16_t*)(L + L_T0); LAS bf16_t* kf = (LAS bf16_t*)(L + L_T1); LAS bf16_t* qb = (LAS bf16_t*)(L + L_T2); LAS bf16_t* kb = (LAS bf16_t*)(L + L_T3);
#pragma unroll
    for (int r = 0; r < 8; ++r) { const int i = 8 * wave + r; const size_t o = (tok0 + i) * 256 + h * 64 + lane;
        const float qv = bf2f(Qb[o]), kv = bf2f(Kb[o]);
        qf[i * RS + lane] = f2bf(qv * __expf(cumf[r])); kf[i * RS + lane] = f2bf(kv * __expf(-cumf[r]));
        qb[i * RS + lane] = f2bf(qv * __expf(cumb[r])); kb[i * RS + lane] = f2bf(kv * __expf(-cumb[r])); }
    load_vt(L, Vb, tok0, h, tid);
    __syncthreads();
    const int mt = wave >> 1, fr = lane & 15, fq = lane >> 4;
    {
        LAS bf16_t* P = (LAS bf16_t*)(L + L_P);
#pragma unroll
        for (int q = 0; q < 2; ++q) { const int nt = 2 * (wave & 1) + q;
            f32x4 sf = {0.f, 0.f, 0.f, 0.f}, sb = {0.f, 0.f, 0.f, 0.f};
#pragma unroll
            for (int ks = 0; ks < 2; ++ks) {
                sf = __builtin_amdgcn_mfma_f32_16x16x32_bf16(frag(L + L_T0, 16 * mt, 32 * ks, lane), frag(L + L_T1, 16 * nt, 32 * ks, lane), sf, 0, 0, 0);
                sb = __builtin_amdgcn_mfma_f32_16x16x32_bf16(frag(L + L_T2, 16 * mt, 32 * ks, lane), frag(L + L_T3, 16 * nt, 32 * ks, lane), sb, 0, 0, 0); }
#pragma unroll
            for (int r = 0; r < 4; ++r) { const int i = 16 * mt + 4 * fq + r, j = 16 * nt + fr;
                P[i * RS + j] = f2bf((j <= i ? sf[r] : 0.f) + (j >= i ? sb[r] : 0.f)); } }
    }
    __syncthreads();
    const bf16_t* SPf = (const bf16_t*)(a.ws + WS_SP) + ((size_t)(0 * 16 + bh) * NCHUNK + chunk) * 8192;
    const bf16_t* SPb = (const bf16_t*)(a.ws + WS_SP) + ((size_t)(1 * 16 + bh) * NCHUNK + chunk) * 8192;
    f32x4 o[4]; float ssq[4] = {0.f, 0.f, 0.f, 0.f};
#pragma unroll
    for (int q = 0; q < 4; ++q) { const int nt = 4 * (wave & 1) + q;
        f32x4 acc = {0.f, 0.f, 0.f, 0.f};
#pragma unroll
        for (int ks = 0; ks < 2; ++ks) {
            acc = __builtin_amdgcn_mfma_f32_16x16x32_bf16(frag(L + L_P, 16 * mt, 32 * ks, lane), frag(L + L_VT, 16 * nt, 32 * ks, lane), acc, 0, 0, 0);
            const bf16x8 sfv = *(const bf16x8*)(SPf + (16 * nt + fr) * 64 + 32 * ks + 8 * fq);
            const bf16x8 sbv = *(const bf16x8*)(SPb + (16 * nt + fr) * 64 + 32 * ks + 8 * fq);
            acc = __builtin_amdgcn_mfma_f32_16x16x32_bf16(frag(L + L_T0, 16 * mt, 32 * ks, lane), sfv, acc, 0, 0, 0);
            acc = __builtin_amdgcn_mfma_f32_16x16x32_bf16(frag(L + L_T2, 16 * mt, 32 * ks, lane), sbv, acc, 0, 0, 0); }
        o[q] = acc;
#pragma unroll
        for (int r = 0; r < 4; ++r) ssq[r] += acc[r] * acc[r]; }
    LAS float* SSQ = (LAS float*)(L + L_SSQ);
#pragma unroll
    for (int r = 0; r < 4; ++r) { float s = ssq[r]; s += __shfl_xor(s, 1); s += __shfl_xor(s, 2); s += __shfl_xor(s, 4); s += __shfl_xor(s, 8); ssq[r] = s; }
    if (fr == 0) {
#pragma unroll
        for (int r = 0; r < 4; ++r) SSQ[(wave & 1) * 64 + 16 * mt + 4 * fq + r] = ssq[r]; }
    __syncthreads();
    const float* ng = a.in[I_NORMG];
    bf16_t* mix = (bf16_t*)(a.ws + WS_MIX);
#pragma unroll
    for (int r = 0; r < 4; ++r) { const int i = 16 * mt + 4 * fq + r;
        const float rstd = 1.f / sqrtf((SSQ[i] + SSQ[64 + i]) * (1.f / DV) + LN_EPS);
#pragma unroll
        for (int q = 0; q < 4; ++q) { const int dv = 16 * (4 * (wave & 1) + q) + fr;
            const float g = bf2f(Gt[(tok0 + i) * 512 + h * 128 + dv]);
            mix[(tok0 + i) * 1024 + h * 128 + dv] = f2bf(o[q][r] * rstd * ng[dv] * silu_f(g)); } }
}
}

namespace hy {
__device__ __forceinline__ int phys(int n) { return n + (n >> 4) + ((n >> 9) << 4); }
constexpr int XSIZE = 16384 + 1024 + 512;
constexpr int L_WCOL = XSIZE * 8;

__device__ __forceinline__ float tw_c(int i) {
    constexpr float t[16] = {1.f, 0.98078528040323043f, 0.92387953251128674f, 0.83146961230254524f, 0.70710678118654752f, 0.55557023301960218f, 0.38268343236508977f, 0.19509032201612825f,
                             0.f, -0.19509032201612825f, -0.38268343236508977f, -0.55557023301960218f, -0.70710678118654752f, -0.83146961230254524f, -0.92387953251128674f, -0.98078528040323043f};
    return t[i];
}
__device__ __forceinline__ float tw_s(int i) {
    constexpr float t[16] = {0.f, 0.19509032201612825f, 0.38268343236508977f, 0.55557023301960218f, 0.70710678118654752f, 0.83146961230254524f, 0.92387953251128674f, 0.98078528040323043f,
                             1.f, 0.98078528040323043f, 0.92387953251128674f, 0.83146961230254524f, 0.70710678118654752f, 0.55557023301960218f, 0.38268343236508977f, 0.19509032201612825f};
    return t[i];
}
__host__ __device__ constexpr int brev(int p, int bits) { int r = 0; for (int i = 0; i < bits; ++i) r |= ((p >> i) & 1) << (bits - 1 - i); return r; }

template <int R, bool INV>
__device__ __forceinline__ void fft_reg(f32x2 (&v)[R]) {
#pragma unroll
    for (int s = R / 2; s >= 1; s >>= 1) {
#pragma unroll
        for (int g = 0; g < R; g += 2 * s) {
#pragma unroll
            for (int k = 0; k < s; ++k) {
                const f32x2 a = v[g + k], b = v[g + k + s];
                v[g + k] = a + b;
                const f32x2 t = a - b;
                const int ti = k * (16 / s);
                f32x2 o;
                if (ti == 0) o = t;
                else if (ti == 8) { if (INV) { o[0] = -t[1]; o[1] = t[0]; } else { o[0] = t[1]; o[1] = -t[0]; } }
                else { const float c = tw_c(ti), sn = tw_s(ti);
                    if (INV) { o[0] = t[0] * c - t[1] * sn; o[1] = t[1] * c + t[0] * sn; }
                    else     { o[0] = t[0] * c + t[1] * sn; o[1] = t[1] * c - t[0] * sn; } }
                v[g + k + s] = o;
            }
        }
    }
}
__device__ __forceinline__ f32x2 cmul(f32x2 a, f32x2 b) { f32x2 r; r[0] = a[0] * b[0] - a[1] * b[1]; r[1] = a[0] * b[1] + a[1] * b[0]; return r; }

template <int M>
__device__ __forceinline__ void pass_fwd32(LAS f32x2* X, int tid) {
    int j = (M == 512) ? tid : (tid & 15);
    asm volatile("" : "+v"(j));
    const int p0 = (M == 512) ? (tid + (tid >> 4)) : (560 * (tid >> 4) + (tid & 15));
    constexpr int PS = (M == 512) ? 560 : 17;
    f32x2 v[32];
#pragma unroll
    for (int r = 0; r < 32; ++r) v[r] = X[p0 + PS * r];
    fft_reg<32, false>(v);
    float sn, cs; sincospif(-2.f * (float)j / (float)(32 * M), &sn, &cs);
    const f32x2 w1 = {cs, sn}; f32x2 w = w1;
    X[p0] = v[0];
#pragma unroll
    for (int rp = 1; rp < 32; ++rp) { X[p0 + PS * rp] = cmul(v[brev(rp, 5)], w); w = cmul(w, w1); }
}
template <int M>
__device__ __forceinline__ void pass_inv32(LAS f32x2* X, int tid) {
    int j = (M == 512) ? tid : (tid & 15);
    asm volatile("" : "+v"(j));
    const int p0 = (M == 512) ? (tid + (tid >> 4)) : (560 * (tid >> 4) + (tid & 15));
    constexpr int PS = (M == 512) ? 560 : 17;
    float sn, cs; sincospif(2.f * (float)j / (float)(32 * M), &sn, &cs);
    const f32x2 w1 = {cs, sn}; f32x2 w = w1;
    f32x2 v[32];
    v[0] = X[p0];
#pragma unroll
    for (int rp = 1; rp < 32; ++rp) { v[rp] = cmul(X[p0 + PS * rp], w); w = cmul(w, w1); }
    fft_reg<32, true>(v);
#pragma unroll
    for (int p = 0; p < 32; ++p) X[p0 + PS * brev(p, 5)] = v[p];
}
__device__ __forceinline__ void pass_c_store(const LAS f32x2* X, f32x2* Hs, int tid, float scale) {
#pragma unroll
    for (int u = 0; u < 2; ++u) { const int blk = tid + 512 * u, p0 = 17 * blk + 16 * (blk >> 5);
        f32x2 v[16];
#pragma unroll
        for (int r = 0; r < 16; ++r) v[r] = X[p0 + r];
        fft_reg<16, false>(v);
#pragma unroll
        for (int q = 0; q < 8; ++q) { const f32x2 x0 = v[brev(2 * q, 4)] * scale, x1 = v[brev(2 * q + 1, 4)] * scale;
            *(f32x4*)(Hs + 16 * blk + 2 * q) = (f32x4){x0[0], x0[1], x1[0], x1[1]}; } }
}
__device__ __forceinline__ void pass_c_mul_inv(LAS f32x2* X, const f32x2* Hs, int tid) {
#pragma unroll
    for (int u = 0; u < 2; ++u) { const int blk = tid + 512 * u, p0 = 17 * blk + 16 * (blk >> 5);
        f32x2 v[16], w[16];
#pragma unroll
        for (int r = 0; r < 16; ++r) v[r] = X[p0 + r];
        f32x4 hh[8];
#pragma unroll
        for (int q = 0; q < 8; ++q) hh[q] = *(const f32x4*)(Hs + 16 * blk + 2 * q);
        fft_reg<16, false>(v);
#pragma unroll
        for (int q = 0; q < 8; ++q) { w[2 * q] = cmul(v[brev(2 * q, 4)], (f32x2){hh[q][0], hh[q][1]}); w[2 * q + 1] = cmul(v[brev(2 * q + 1, 4)], (f32x2){hh[q][2], hh[q][3]}); }
        fft_reg<16, true>(w);
#pragma unroll
        for (int p = 0; p < 16; ++p) X[p0 + brev(p, 4)] = w[p]; }
}
__device__ __forceinline__ float sconv(const bf16_t* u, int l, float w0, float w1, float w2, float bias) {
    const int pos = l & 63;
    const float c = bf2f(u[l]);
    const float lf = pos > 0 ? bf2f(u[l - 1]) : 0.f, rt = pos < 63 ? bf2f(u[l + 1]) : 0.f;
    return w0 * lf + w1 * c + w2 * rt + bias;
}

__device__ __forceinline__ void channel(const Args& a, LAS unsigned char* lds, int c, unsigned char* scratch) {
    const int tid = threadIdx.x;
    LAS f32x2* X = (LAS f32x2*)lds;
    LAS f32x4* wcol = (LAS f32x4*)(lds + L_WCOL);
    f32x2* Hs = (f32x2*)scratch;
    f32x2* zs = (f32x2*)(scratch + (size_t)2 * FFTN * 8);
    float* fst = (float*)(scratch + (size_t)2 * FFTN * 8 + (size_t)SEQ * 8);
    const float* hid2 = (const float*)(a.ws + WS_HID2);
    const float* fwout = a.in[I_FWOUT];
    const int px = tid + (tid >> 4);
    __syncthreads();
    if (tid < 256) { const int f = tid >> 2, q = tid & 3; ((LAS float*)wcol)[tid] = fwout[(size_t)f * 2048 + q * 512 + c]; }
    __syncthreads();
    {
        const float dlt = fabsf(-3.0701134573253945f + (float)c * ((-15.350567286626973f + 3.0701134573253945f) / 511.f));
#pragma unroll 1
        for (int i = 0; i < 16; ++i) { const int t = tid + 512 * i;
            asm volatile("" ::: "memory");
            const f32x4* hr = (const f32x4*)(hid2 + (size_t)t * 64);
            f32x4 acc = {0.f, 0.f, 0.f, 0.f};
#pragma unroll
            for (int f4 = 0; f4 < 16; ++f4) { const f32x4 hv = hr[f4];
#pragma unroll
                for (int e = 0; e < 4; ++e) acc += wcol[4 * f4 + e] * hv[e]; }
            const float win = __expf(-((float)t / (float)(SEQ - 1)) * dlt);
            acc *= win;
            X[px + 560 * i] = (f32x2){acc[0], 0.f};
            if (t >= 1) X[phys(FFTN - t)] = (f32x2){acc[1], 0.f};
            fst[t] = acc[2]; fst[SEQ + t] = acc[3]; }
        if (tid == 0) X[phys(SEQ)] = (f32x2){0.f, 0.f};
    }
    __syncthreads();
    pass_fwd32<512>(X, tid); __syncthreads(); pass_fwd32<16>(X, tid); __syncthreads(); pass_c_store(X, Hs, tid, 1.f / (float)FFTN); __syncthreads();
#pragma unroll 1
    for (int i = 0; i < 16; ++i) { const int t = tid + 512 * i;
        X[px + 560 * i] = (f32x2){fst[t], 0.f};
        if (t >= 1) X[phys(FFTN - t)] = (f32x2){fst[SEQ + t], 0.f}; }
    if (tid == 0) X[phys(SEQ)] = (f32x2){0.f, 0.f};
    __syncthreads();
    pass_fwd32<512>(X, tid); __syncthreads(); pass_fwd32<16>(X, tid); __syncthreads(); pass_c_store(X, Hs + FFTN, tid, 1.f / (float)FFTN); __syncthreads();
    const float* cw = a.in[I_CONVW]; const float* cbv = a.in[I_CONVB]; const float* dbias = a.in[I_BIASD];
    const float d1 = dbias[c], d2 = dbias[HYW + c];
    float wv[3][3], bv[3];
#pragma unroll
    for (int s = 0; s < 3; ++s) { bv[s] = cbv[s * HYW + c];
#pragma unroll
        for (int i = 0; i < 3; ++i) wv[s][i] = cw[i * HYC + s * HYW + c]; }
    const bf16_t* UT = (const bf16_t*)(a.ws + WS_UT);
    bf16_t* YT = (bf16_t*)(a.ws + WS_YHYT);
#pragma unroll 1
    for (int bp = 0; bp < 2; ++bp) {
        const bf16_t* u0 = UT + ((size_t)(2 * bp) * HYC + c) * SEQ; const bf16_t* u1 = UT + ((size_t)(2 * bp + 1) * HYC + c) * SEQ;
#pragma unroll 1
        for (int i = 0; i < 16; ++i) { const int n = tid + 512 * i;
            X[px + 560 * i] = (f32x2){sconv(u0, n, wv[0][0], wv[0][1], wv[0][2], bv[0]), sconv(u1, n, wv[0][0], wv[0][1], wv[0][2], bv[0])};
            X[px + 560 * (i + 16)] = (f32x2){0.f, 0.f}; }
        __syncthreads();
        pass_fwd32<512>(X, tid); __syncthreads(); pass_fwd32<16>(X, tid); __syncthreads(); pass_c_mul_inv(X, Hs, tid); __syncthreads(); pass_inv32<16>(X, tid); __syncthreads(); pass_inv32<512>(X, tid); __syncthreads();
#pragma unroll 1
        for (int i = 0; i < 16; ++i) { const int n = tid + 512 * i;
            const f32x2 y1 = X[px + 560 * i];
            const float v0 = sconv(u0, n, wv[0][0], wv[0][1], wv[0][2], bv[0]), v1 = sconv(u1, n, wv[0][0], wv[0][1], wv[0][2], bv[0]);
            const float x10 = sconv(u0 + (size_t)HYW * SEQ, n, wv[1][0], wv[1][1], wv[1][2], bv[1]), x11 = sconv(u1 + (size_t)HYW * SEQ, n, wv[1][0], wv[1][1], wv[1][2], bv[1]);
            const f32x2 z = {x10 * (y1[0] + d1 * v0), x11 * (y1[1] + d1 * v1)};
            X[px + 560 * i] = z; X[px + 560 * (i + 16)] = (f32x2){0.f, 0.f}; zs[n] = z; }
        __syncthreads();
        pass_fwd32<512>(X, tid); __syncthreads(); pass_fwd32<16>(X, tid); __syncthreads(); pass_c_mul_inv(X, Hs + FFTN, tid); __syncthreads(); pass_inv32<16>(X, tid); __syncthreads(); pass_inv32<512>(X, tid); __syncthreads();
#pragma unroll 1
        for (int i = 0; i < 16; ++i) { const int n = tid + 512 * i;
            const f32x2 y2 = X[px + 560 * i], z = zs[n];
            const float x20 = sconv(u0 + (size_t)2 * HYW * SEQ, n, wv[2][0], wv[2][1], wv[2][2], bv[2]), x21 = sconv(u1 + (size_t)2 * HYW * SEQ, n, wv[2][0], wv[2][1], wv[2][2], bv[2]);
            YT[((size_t)(2 * bp) * HYW + c) * SEQ + n] = f2bf(x20 * (y2[0] + d2 * z[0]));
            YT[((size_t)(2 * bp + 1) * HYW + c) * SEQ + n] = f2bf(x21 * (y2[1] + d2 * z[1])); }
        __syncthreads();
    }
}

__device__ __forceinline__ void transpose_item(const Args& a, int item, int lane) {
    const int lt = item & 127, ct = (item >> 7) & 7, b = item >> 10;
    const bf16_t* src = (const bf16_t*)(a.ws + WS_YHYT) + ((size_t)b * HYW + 64 * ct) * SEQ + 64 * lt + lane;
    bf16_t* dst = (bf16_t*)(a.ws + WS_MIX) + ((size_t)b * SEQ + 64 * lt + lane) * 1024 + 512 + 64 * ct;
#pragma unroll
    for (int q = 0; q < 8; ++q) { unsigned w[4];
#pragma unroll
        for (int e = 0; e < 4; ++e) { const unsigned lo = src[(size_t)(8 * q + 2 * e) * SEQ], hi = src[(size_t)(8 * q + 2 * e + 1) * SEQ]; w[e] = lo | (hi << 16); }
        *(u32x4*)(dst + 8 * q) = (u32x4){w[0], w[1], w[2], w[3]}; }
}
}

namespace rt {
constexpr int HS = 1028;
constexpr int L_H2 = 0;
constexpr int L_PART = 65792;
constexpr int L_LCNT = L_PART + 16384;
constexpr int L_REC = L_LCNT + 256;

__device__ __forceinline__ void phase(const Args& a, LAS unsigned char* lds) {
    const int tid = threadIdx.x, lane = tid & 63, wave = __builtin_amdgcn_readfirstlane(tid >> 6);
    float* pre = (float*)(a.ws + WS_PRE1); bf16_t* H2 = (bf16_t*)(a.ws + WS_H2);
    const float* mod = (const float*)(a.ws + WS_MOD);
    const float* rw = a.in[I_RW]; const float* rb = a.in[I_RB];
    LAS float* h2s = (LAS float*)(lds + L_H2); LAS float* part = (LAS float*)(lds + L_PART);
    LAS int* lcnt = (LAS int*)(lds + L_LCNT); LAS int* lbase = lcnt + 32; LAS int* rec = (LAS int*)(lds + L_REC);
    unsigned* cnt = (unsigned*)(a.ws + WS_CNT); int* list = (int*)(a.ws + WS_LIST); float* pw = (float*)(a.ws + WS_PW);
    float rwr[32][2];
#pragma unroll
    for (int s = 0; s < 32; ++s)
#pragma unroll
        for (int nt = 0; nt < 2; ++nt) rwr[s][nt] = rw[(size_t)(128 * wave + 4 * s + (lane >> 4)) * 32 + 16 * nt + (lane & 15)];
    const f32x4* g1 = (const f32x4*)a.in[I_LN1G]; const f32x4* bb1 = (const f32x4*)a.in[I_LN1B];
    if (tid < 32) lcnt[tid] = 0;
    for (int grp = blockIdx.x; grp < T / 16; grp += gridDim.x) {
        __syncthreads();
#pragma unroll 1
        for (int rr = 0; rr < 2; ++rr) {
            const int lr = 2 * wave + rr, t = grp * 16 + lr, b = t >> 13;
            f32x4* pr = (f32x4*)(pre + (size_t)t * D) + lane;
            f32x4 v[4]; float s = 0.f;
#pragma unroll
            for (int j = 0; j < 4; ++j) { v[j] = pr[64 * j]; s += (v[j][0] + v[j][1]) + (v[j][2] + v[j][3]); }
            float mean = wave_sum(s) * (1.f / D), s2 = 0.f;
#pragma unroll
            for (int j = 0; j < 4; ++j) { v[j] = v[j] - mean; s2 += (v[j][0] * v[j][0] + v[j][1] * v[j][1]) + (v[j][2] * v[j][2] + v[j][3] * v[j][3]); }
            float rstd = 1.f / sqrtf(wave_sum(s2) * (1.f / D) + LN_EPS);
            s = 0.f;
#pragma unroll
            for (int j = 0; j < 4; ++j) { v[j] = v[j] * rstd * g1[64 * j + lane] + bb1[64 * j + lane]; pr[64 * j] = v[j]; s += (v[j][0] + v[j][1]) + (v[j][2] + v[j][3]); }
            mean = wave_sum(s) * (1.f / D); s2 = 0.f;
#pragma unroll
            for (int j = 0; j < 4; ++j) { v[j] = v[j] - mean; s2 += (v[j][0] * v[j][0] + v[j][1] * v[j][1]) + (v[j][2] * v[j][2] + v[j][3] * v[j][3]); }
            rstd = 1.f / sqrtf(wave_sum(s2) * (1.f / D) + LN_EPS);
            const f32x4* sh = (const f32x4*)(mod + b * 6144 + 3 * 1024); const f32x4* sc = (const f32x4*)(mod + b * 6144 + 4 * 1024);
            u32x2* o8 = (u32x2*)(H2 + (size_t)t * D) + lane;
#pragma unroll
            for (int j = 0; j < 4; ++j) { const f32x4 y = v[j] * rstd * (sc[64 * j + lane] + 1.f) + sh[64 * j + lane];
                u32x2 w; w.x = pk2(y[0], y[1]); w.y = pk2(y[2], y[3]); o8[64 * j] = w;
                *(LAS f32x4*)(h2s + lr * HS + 256 * j + 4 * lane) = y; }
        }
        __syncthreads();
        {
            f32x4 acc0 = {0.f, 0.f, 0.f, 0.f}, acc1 = {0.f, 0.f, 0.f, 0.f};
            const LAS float* ap = h2s + (lane & 15) * HS + 128 * wave + (lane >> 4);
#pragma unroll
            for (int s = 0; s < 32; ++s) { const float av = ap[4 * s];
                acc0 = __builtin_amdgcn_mfma_f32_16x16x4f32(av, rwr[s][0], acc0, 0, 0, 0);
                acc1 = __builtin_amdgcn_mfma_f32_16x16x4f32(av, rwr[s][1], acc1, 0, 0, 0); }
#pragma unroll
            for (int r = 0; r < 4; ++r) { part[(wave * 16 + 4 * (lane >> 4) + r) * 32 + (lane & 15)] = acc0[r]; part[(wave * 16 + 4 * (lane >> 4) + r) * 32 + 16 + (lane & 15)] = acc1[r]; }
        }
        __syncthreads();
        {
            const int lr = 2 * wave + (lane >> 5), e = lane & 31, t = grp * 16 + lr;
            float lg = rb[e];
#pragma unroll
            for (int w = 0; w < 8; ++w) lg += part[(w * 16 + lr) * 32 + e];
            float cur = lg, tv[4]; int ti[4];
#pragma unroll
            for (int k = 0; k < 4; ++k) { float bv = cur; int bi = e;
#pragma unroll
                for (int o = 1; o < 32; o <<= 1) { const float ov = __shfl_xor(bv, o); const int oi = __shfl_xor(bi, o); if (ov > bv || (ov == bv && oi < bi)) { bv = ov; bi = oi; } }
                tv[k] = bv; ti[k] = bi; if (bi == e) cur = -3.0e38f; }
            const float e1 = __expf(tv[1] - tv[0]), e2 = __expf(tv[2] - tv[0]), e3 = __expf(tv[3] - tv[0]);
            const float inv = 1.f / (1.f + e1 + e2 + e3);
            if (e < 4) { const float wk = (e == 0 ? 1.f : (e == 1 ? e1 : (e == 2 ? e2 : e3))) * inv; const int ek = (e == 0 ? ti[0] : (e == 1 ? ti[1] : (e == 2 ? ti[2] : ti[3])));
                const int pair = t * 4 + e;
                pw[pair] = wk;
                const int rank = __hip_atomic_fetch_add((LAS int*)&lcnt[ek], 1, __ATOMIC_RELAXED, __HIP_MEMORY_SCOPE_WORKGROUP);
                rec[lr * 4 + e] = ek | (rank << 8); }
        }
        __syncthreads();
        if (tid < 32) { const int n = lcnt[tid]; lbase[tid] = n ? (int)atomicAdd(&cnt[tid], (unsigned)n) : 0; }
        __syncthreads();
        if (tid < 64) { const int rc = rec[tid], ek = rc & 255, rank = rc >> 8; list[(size_t)ek * CAP + lbase[ek] + rank] = (grp * 16 + (tid >> 2)) * 4 + (tid & 3); }
        __syncthreads();
        if (tid < 32) lcnt[tid] = 0;
    }
}
}

__device__ __forceinline__ void p_final(const Args& a) {
    const int tid = threadIdx.x, lane = tid & 63, wave = tid >> 6;
    const float* xm = (const float*)(a.ws + WS_PRE1); const bf16_t* slots = (const bf16_t*)(a.ws + WS_SLOTS); const float* mod = (const float*)(a.ws + WS_MOD);
    const f32x4* g2 = (const f32x4*)a.in[I_LN2G]; const f32x4* b2 = (const f32x4*)a.in[I_LN2B];
    for (int t = blockIdx.x * NWAVES + wave; t < T; t += gridDim.x * NWAVES) {
        const int b = t >> 13;
        const f32x4* xr = (const f32x4*)(xm + (size_t)t * D) + lane; const f32x4* gt = (const f32x4*)(mod + b * 6144 + 5 * 1024);
        f32x4 v[4]; float s = 0.f;
#pragma unroll
        for (int j = 0; j < 4; ++j) { f32x4 y = {0.f, 0.f, 0.f, 0.f};
#pragma unroll
            for (int sl = 0; sl < 4; ++sl) { const u32x2 w = *((const u32x2*)(slots + ((size_t)t * 4 + sl) * D) + 64 * j + lane); y[0] += bflo(w.x); y[1] += bfhi(w.x); y[2] += bflo(w.y); y[3] += bfhi(w.y); }
            v[j] = xr[64 * j] * ALPHA + gt[64 * j + lane] * y; s += (v[j][0] + v[j][1]) + (v[j][2] + v[j][3]); }
        const float mean = wave_sum(s) * (1.f / D); float s2 = 0.f;
#pragma unroll
        for (int j = 0; j < 4; ++j) { v[j] = v[j] - mean; s2 += (v[j][0] * v[j][0] + v[j][1] * v[j][1]) + (v[j][2] * v[j][2] + v[j][3] * v[j][3]); }
        const float rstd = 1.f / sqrtf(wave_sum(s2) * (1.f / D) + LN_EPS);
        f32x4* o = (f32x4*)(a.out + (size_t)t * D) + lane;
#pragma unroll
        for (int j = 0; j < 4; ++j) o[64 * j] = v[j] * rstd * g2[64 * j + lane] + b2[64 * j + lane];
    }
}


constexpr int N_PHASES = 11;
__global__ void __launch_bounds__(NTHREADS, 2) mega_fwd(Args a) {
    extern __shared__ __attribute__((aligned(16))) unsigned char lds_raw[];
    LAS unsigned char* lds = (LAS unsigned char*)lds_raw;
    const int tid = threadIdx.x;
    volatile LAS unsigned* misc = (volatile LAS unsigned*)(lds + LDS_MISC);
    if (tid < 4) misc[tid] = 0u;
    __syncthreads();
    XcdBarrier bar; bar.bar = (unsigned*)(a.ws + WS_BAR); bar.x = 0; bar.st = misc;
    const bool multi = (a.ph_hi - a.ph_lo) > 1;
    if (multi) bar = xcd_barrier_post((unsigned*)(a.ws + WS_BAR), misc);
    const int lo = a.ph_lo, hi = a.ph_hi;
#ifdef ONLY_PHASE
#define IN(k) ((k) == ONLY_PHASE && lo <= (k) && (k) < hi)
#else
#define IN(k) (lo <= (k) && (k) < hi)
#endif
#define SEAM(k) do { if (IN(k) && IN((k) + 1)) xcd_barrier(bar); } while (0)

    if (IN(0)) { p0_mod_and_filter(a, lds); }
    SEAM(0);
    if (IN(1)) { p1_prep(a, lds); }
    SEAM(1);
    if (IN(2)) { gm::SchedIn S{a.ws, (int)gridDim.x, (int)blockIdx.x}; gm::EpiIn E{a.ws, a.in[I_BAF], a.in[I_BAB]}; gm::gemm_stream<false, 0>(lds, S, E); }
    SEAM(2);
    if (IN(3)) { for (int u = blockIdx.x; u < 16 * NCT; u += gridDim.x) gla::g1_unit(a, lds, u / NCT, u % NCT); }
    SEAM(3);
    if (IN(4)) { gla::g2_scan(a);
        for (int c = blockIdx.x; c < HYW; c += gridDim.x) hy::channel(a, lds, c, a.ws + WS_HSPEC + (size_t)blockIdx.x * HSPEC_PER_WG); }
    SEAM(4);
    if (IN(5)) { for (int u = blockIdx.x; u < 16 * NCHUNK; u += gridDim.x) gla::g3_unit(a, lds, u >> 7, u & 127);
        const int wave = tid >> 6;
        for (int it = blockIdx.x * NWAVES + wave; it < 4096; it += gridDim.x * NWAVES) hy::transpose_item(a, it, tid & 63); }
    SEAM(5);
    if (IN(6)) { gm::SchedOut S{a.ws, (int)gridDim.x, (int)blockIdx.x}; gm::EpiOut E{a.ws, a.in[I_X]}; gm::gemm_stream<false, 0>(lds, S, E); }
    SEAM(6);
    if (IN(7)) { rt::phase(a, lds); }
    SEAM(7);
    if (IN(8) || IN(9)) {
        LAS int* tab = (LAS int*)(lds + gm::LDS_TAB);
        __syncthreads();
        if (tid == 0) { const unsigned* cnt = (const unsigned*)(a.ws + WS_CNT); int nrt = 0;
            for (int e = 0; e < NE; ++e) { const int n = (int)cnt[e]; tab[e] = n; const int nt = (n + 255) >> 8; for (int k = 0; k < nt; ++k) tab[64 + nrt + k] = e | (k << 8); nrt += nt; }
            tab[32] = nrt; }
        __syncthreads();
    }
    if (IN(8)) { gm::SchedMoe<1> S{a.ws, (const LAS int*)(lds + gm::LDS_TAB), (int)gridDim.x, (int)blockIdx.x}; gm::EpiMoe1 E{a.ws}; gm::gemm_stream<true, 2>(lds, S, E); }
    SEAM(8);
    if (IN(9)) { gm::SchedMoe<2> S{a.ws, (const LAS int*)(lds + gm::LDS_TAB), (int)gridDim.x, (int)blockIdx.x}; gm::EpiMoe2 E{a.ws, a.in[I_EB2]}; gm::gemm_stream<true, 0>(lds, S, E); }
    SEAM(9);
    if (IN(10)) { p_final(a); }
#undef IN
#undef SEAM
}

extern "C" void kernel_launch(void* const* d_in, const int* in_sizes, int n_in, void* d_out, int out_size, void* d_ws, size_t ws_size, hipStream_t stream) {
    static int grid = 0;
    if (grid == 0) {
        if (n_in != 32 || out_size != T * D || ws_size < WS_END) { fprintf(stderr, "kernel_launch: unexpected shapes (n_in %d out %d ws %zu need %zu)\n", n_in, out_size, ws_size, (size_t)WS_END); grid = -1; return; }
        int dev = 0, cus = 0;
        if (hipGetDevice(&dev) != hipSuccess || hipDeviceGetAttribute(&cus, hipDeviceAttributeMultiprocessorCount, dev) != hipSuccess) { grid = -1; return; }
        if (hipFuncSetAttribute((const void*)mega_fwd, hipFuncAttributeMaxDynamicSharedMemorySize, LDS_BYTES) != hipSuccess) { fprintf(stderr, "kernel_launch: hipFuncSetAttribute failed\n"); grid = -1; return; }
        int per_cu = 0;
        if (hipOccupancyMaxActiveBlocksPerMultiprocessor(&per_cu, (const void*)mega_fwd, NTHREADS, LDS_BYTES) != hipSuccess || per_cu < 1) fprintf(stderr, "kernel_launch: occupancy query says %d\n", per_cu);
        (void)hipGetLastError();
        grid = cus;
        if (grid > MAX_GRID) grid = MAX_GRID;
    }
    if (grid < 0) return;
    (void)hipMemsetAsync(d_ws, 0, WS_ZERO_BYTES, stream);
    Args a{};
    for (int i = 0; i < 32; ++i) a.in[i] = (const float*)d_in[i];
    a.out = (float*)d_out; a.ws = (unsigned char*)d_ws;
#ifdef DBG
    (void)hipMemsetAsync((char*)d_ws + WS_DBG, 0, 512, stream);
    for (int p = 0; p < N_PHASES; ++p) { a.ph_lo = p; a.ph_hi = p + 1; hipLaunchKernelGGL(mega_fwd, dim3(grid), dim3(NTHREADS), LDS_BYTES, stream, a);
        hipLaunchKernelGGL(dbg_check, dim3(64), dim3(512), 0, stream, a, p); }
    hipLaunchKernelGGL(dbg_encode, dim3(1024), dim3(256), 0, stream, a);
#elif N_LAUNCH_PER_PHASE
    for (int p = 0; p < N_PHASES; ++p) { a.ph_lo = p; a.ph_hi = p + 1; hipLaunchKernelGGL(mega_fwd, dim3(grid), dim3(NTHREADS), LDS_BYTES, stream, a); }
#else
    a.ph_lo = 0; a.ph_hi = N_PHASES;
    hipLaunchKernelGGL(mega_fwd, dim3(grid), dim3(NTHREADS), LDS_BYTES, stream, a);
#endif
}
```

```cpp
#include <hip/hip_runtime.h>
#include <cstdio>
#include <cstdint>
#include <cstddef>

#define LAS __attribute__((address_space(3)))
#define GAS __attribute__((address_space(1)))
typedef unsigned short bf16_t;
typedef short bf16x8 __attribute__((ext_vector_type(8)));
typedef float f32x4 __attribute__((ext_vector_type(4)));
typedef float f32x2 __attribute__((ext_vector_type(2)));
typedef unsigned u32x4 __attribute__((ext_vector_type(4)));
typedef unsigned u32x2 __attribute__((ext_vector_type(2)));

#ifndef N_LAUNCH_PER_PHASE
#define N_LAUNCH_PER_PHASE 0
#endif

constexpr int D = 1024, NB = 4, SEQ = 8192, T = NB * SEQ, CTXL = 256, TC = NB * CTXL, TT = T + TC;
constexpr int NH = 4, DK = 64, DV = 128, CH = 64, NCHUNK = SEQ / CH, NCC = CTXL / CH, NCT = NCHUNK + NCC;
constexpr int HYW = 512, HYC = 3 * HYW, INW = 3104;
constexpr int NE = 32, DE = 1024, CAP = T;
constexpr float LN_EPS = 1e-6f, ALPHA = 1.189207115002721f;
constexpr int NTHREADS = 512, NWAVES = 8;
constexpr int FFTN = 16384;

constexpr size_t al256(size_t x) { return (x + 255) & ~(size_t)255; }
constexpr size_t WS_BAR   = 0;
constexpr size_t WS_MOD   = 16384;
constexpr size_t WS_CNT   = WS_MOD + 5 * 6144 * 4;
constexpr size_t WS_ZERO_BYTES = al256(WS_CNT + 256);
constexpr size_t WS_LIST  = 262144;
constexpr size_t WS_PW    = WS_LIST + (size_t)NE * CAP * 4;
constexpr size_t WS_B1R   = WS_PW + (size_t)T * 4 * 4;
constexpr size_t WS_HID2  = WS_B1R + (size_t)NE * 2048 * 4;
constexpr size_t WS_BTIN  = WS_HID2 + (size_t)SEQ * 64 * 4;
constexpr size_t WS_BTOUT = WS_BTIN + (size_t)3584 * 1024 * 2;
constexpr size_t WS_W1T   = WS_BTOUT + (size_t)1024 * 1024 * 2;
constexpr size_t WS_W2T   = WS_W1T + (size_t)NE * 2048 * 1024 * 2;
constexpr size_t WS_PRE1  = WS_W2T + (size_t)NE * 1024 * 1024 * 2;
constexpr size_t WS_RA    = WS_PRE1 + (size_t)T * 1024 * 4;
constexpr size_t WS_H     = WS_RA;
constexpr size_t WS_Q     = WS_H + (size_t)TT * 1024 * 2;
constexpr size_t WS_K     = WS_Q + (size_t)T * 256 * 2;
constexpr size_t WS_V     = WS_K + (size_t)TT * 256 * 2;
constexpr size_t WS_G     = WS_V + (size_t)TT * 512 * 2;
constexpr size_t WS_GF    = WS_G + (size_t)T * 512 * 2;
constexpr size_t WS_GB    = WS_GF + (size_t)TT * 256 * 4;
constexpr size_t WS_UT    = WS_GB + (size_t)TT * 256 * 4;
constexpr size_t WS_RA_END= WS_UT + (size_t)NB * HYC * SEQ * 2;
constexpr size_t WS_H2    = WS_RA;
constexpr size_t WS_SLOTS = WS_RA;
constexpr size_t WS_RB    = al256(WS_RA_END > WS_RA + (size_t)T * 4 * 1024 * 2 ? WS_RA_END : WS_RA + (size_t)T * 4 * 1024 * 2);
constexpr size_t WS_KV    = WS_RB;
constexpr size_t WS_AV    = WS_KV + (size_t)2 * 16 * NCT * 8192 * 2;
constexpr size_t WS_SP    = WS_AV + (size_t)2 * 16 * NCT * 64 * 4;
constexpr size_t WS_HSPEC = WS_SP + (size_t)2 * 16 * NCHUNK * 8192 * 2;
constexpr size_t HSPEC_PER_WG = (size_t)2 * FFTN * 8;
constexpr int MAX_GRID = 256;
constexpr size_t WS_YHYT  = WS_HSPEC + (size_t)MAX_GRID * HSPEC_PER_WG;
constexpr size_t WS_MIX   = WS_YHYT + (size_t)NB * HYW * SEQ * 2;
constexpr size_t WS_RB_END= WS_MIX + (size_t)T * 1024 * 2;
constexpr size_t WS_HF    = WS_MIX;
constexpr size_t WS_ACT   = WS_RB;
constexpr size_t WS_END   = al256(WS_RB_END > WS_RB + (size_t)T * 4 * 1024 * 2 ? WS_RB_END : WS_RB + (size_t)T * 4 * 1024 * 2);

constexpr int LDS_BYTES = 147456;
constexpr int LDS_MISC  = 145408;

typedef __bf16 bf16n2 __attribute__((ext_vector_type(2)));
__device__ __forceinline__ unsigned pk2(float lo, float hi) { bf16n2 v = {(__bf16)lo, (__bf16)hi}; return __builtin_bit_cast(unsigned, v); }
__device__ __forceinline__ bf16_t f2bf(float f) { __bf16 b = (__bf16)f; return __builtin_bit_cast(unsigned short, b); }
__device__ __forceinline__ float bf2f(bf16_t b) { return __uint_as_float(((unsigned)b) << 16); }
__device__ __forceinline__ float bflo(unsigned w) { return __uint_as_float(w << 16); }
__device__ __forceinline__ float bfhi(unsigned w) { return __uint_as_float(w & 0xffff0000u); }
__device__ __forceinline__ float wave_sum(float v) {
#pragma unroll
    for (int o = 1; o < 64; o <<= 1) v += __shfl_xor(v, o);
    return v;
}
__device__ __forceinline__ float silu_f(float x) { return x / (1.f + __expf(-x)); }
__device__ __forceinline__ float log_sigmoid_f(float z) { return fminf(z, 0.f) - __logf(1.f + __expf(-fabsf(z))); }

#define XB_TMO      128
#define XB_XCNT(j)  (256  + 64 * (j))
#define XB_XSUB(j)  (1280 + 64 * (j))
#define XB_XGEN(j)  (2304 + 64 * (j))
#define XB_TOP      3328
#define XB_TOPGEN   3392
#define XCD_BAR_WORDS 3456
#define XB_SPIN_CAP (1u << 22)
__device__ __forceinline__ unsigned xb_ld(unsigned* p)              { return __hip_atomic_load(p, __ATOMIC_RELAXED, __HIP_MEMORY_SCOPE_AGENT); }
__device__ __forceinline__ unsigned xb_add(unsigned* p, unsigned v) { return __hip_atomic_fetch_add(p, v, __ATOMIC_RELAXED, __HIP_MEMORY_SCOPE_AGENT); }
__device__ __forceinline__ unsigned xb_xcc_id() { return (unsigned)__builtin_amdgcn_s_getreg((3 << 11) | 20) & 0xFu; }
#define XB_SPIN(cond, bar) do { unsigned _sp = 0; while (cond) { __builtin_amdgcn_s_sleep(1); \
    if ((++_sp & 255u) == 0u) { if (xb_ld(&(bar)[XB_TMO])) break; if (_sp > XB_SPIN_CAP) { atomicAdd(&(bar)[XB_TMO], 1u); break; } } } } while (0)
struct XcdBarrier { unsigned* bar; unsigned x; volatile LAS unsigned* st; };
__device__ __forceinline__ XcdBarrier xcd_barrier_post(unsigned* bar, volatile LAS unsigned* st) {
    XcdBarrier b; b.bar = bar; b.x = xb_xcc_id(); b.st = st;
    if (threadIdx.x == 0) (void)xb_add(&bar[XB_XCNT(b.x)], 1u);
    return b;
}
__device__ __forceinline__ void xcd_barrier_complete(unsigned* bar, unsigned x, unsigned& nloc, unsigned& nx) {
    const unsigned G = gridDim.x * gridDim.y * gridDim.z;
    unsigned sum, cnt, mine, sp = 0u;
    for (;;) {
        sum = 0u; cnt = 0u; mine = 0u;
#pragma unroll
        for (unsigned j = 0; j < 16; ++j) { const unsigned c = xb_ld(&bar[XB_XCNT(j)]); sum += c; cnt += (c > 0u) ? 1u : 0u; mine = (j == x) ? c : mine; }
        if (sum == G) break;
        __builtin_amdgcn_s_sleep(1);
        if ((++sp & 255u) == 0u) { if (xb_ld(&bar[XB_TMO])) break; if (sp > XB_SPIN_CAP) { atomicAdd(&bar[XB_TMO], 1u); break; } }
    }
    nloc = mine > 0u ? mine : 1u; nx = cnt > 0u ? cnt : 1u;
}
__device__ __forceinline__ void xcd_barrier(const XcdBarrier& b) {
    asm volatile("s_waitcnt vmcnt(0)" ::: "memory");
    __syncthreads();
    if (threadIdx.x == 0) {
        unsigned* bar = b.bar;
        __builtin_amdgcn_s_waitcnt(0);
        unsigned nloc = b.st[0], nx = b.st[1];
        if (nloc == 0u) { xcd_barrier_complete(bar, b.x, nloc, nx); b.st[0] = nloc; b.st[1] = nx; }
        const unsigned old = xb_add(&bar[XB_XSUB(b.x)], 1u);
        const unsigned gen = old / nloc;
        if (old + 1u == (gen + 1u) * nloc) {
            __builtin_amdgcn_fence(__ATOMIC_RELEASE, "agent");
            asm volatile("s_waitcnt vmcnt(0)" ::: "memory");
            const unsigned og = xb_add(&bar[XB_TOP], 1u);
            const unsigned tg = og / nx;
            if (og + 1u == (tg + 1u) * nx) xb_add(&bar[XB_TOPGEN], 1u);
            else XB_SPIN(xb_ld(&bar[XB_TOPGEN]) == tg, bar);
            __builtin_amdgcn_fence(__ATOMIC_ACQUIRE, "agent");
            xb_add(&bar[XB_XGEN(b.x)], 1u);
            asm volatile("s_waitcnt vmcnt(0)" ::: "memory");
        } else {
            XB_SPIN(xb_ld(&bar[XB_XGEN(b.x)]) == gen, bar);
            __builtin_amdgcn_fence(__ATOMIC_ACQUIRE, "agent");
            asm volatile("s_waitcnt vmcnt(0)" ::: "memory");
        }
    }
    __syncthreads();
}

struct Args {
    const float* in[32];
    float* out;
    unsigned char* ws;
    int ph_lo, ph_hi;
};
enum { I_X = 0, I_C, I_CTX, I_CCTX, I_ADAW, I_ADAB, I_WIN, I_WAF, I_BAF, I_WAB, I_BAB, I_NORMG, I_CONVW, I_CONVB, I_FW1, I_FB1, I_FW2, I_FB2, I_FWOUT, I_FFREQ,
       I_BIASD, I_WOUT, I_LN1G, I_LN1B, I_RW, I_RB, I_EW1, I_EB1, I_EW2, I_EB2, I_LN2G, I_LN2B };


namespace gm {
constexpr int BM = 256, BK = 64, HALF = 128, HTB = HALF * BK * 2, STAGE_BYTES = 8 * HTB, KD = 1024, NT = KD / BK;
constexpr int ROWB = KD * 2;
__device__ __forceinline__ int lds_byte(int r, int c) { const int st = (r >> 4) * 2 + (c >> 5), rr = r & 15, cc = c & 31, ob = rr * 64 + cc * 2; return st * 1024 + (ob ^ (((ob >> 9) & 1) << 5)); }
__device__ __forceinline__ void stage_rc(int b, int& R, int& C) { const int st = b / 1024, sb = b % 1024, swz = sb ^ (((sb >> 9) & 1) << 5); R = (st >> 1) * 16 + swz / 64; C = (st & 1) * 32 + (swz % 64) / 2; }
__device__ __forceinline__ int perm32(int rho) { const int n = rho >> 4, i = rho & 15; return 8 * (i >> 2) + 4 * n + (i & 3); }

struct Unit {
    const char* A;
    const char* B;
    const int* list;
    int type, row0, col0, valid, aux;
};

template <bool GATHER, int GSHIFT>
__device__ __forceinline__ void a_offsets(const Unit& u, const int (&R)[2], const int (&Cb)[2], unsigned (&o)[2][2]) {
#pragma unroll
    for (int h = 0; h < 2; ++h)
#pragma unroll
        for (int i = 0; i < 2; ++i) {
            const int r = h * HALF + R[i];
            if (!GATHER) o[h][i] = (unsigned)(r * ROWB + Cb[i]);
            else { const int idx = u.list[r < u.valid ? r : 0]; o[h][i] = (unsigned)(idx >> GSHIFT) * (unsigned)ROWB + (unsigned)Cb[i]; }
        }
}

template <bool GATHER, int GSHIFT, class Sched, class Epi>
__device__ __forceinline__ void gemm_stream(LAS unsigned char* lds, const Sched& S, const Epi& E) {
    const int tid = threadIdx.x, wid = __builtin_amdgcn_readfirstlane(tid >> 6), lane = tid & 63, wr = wid >> 2, wc = wid & 3, fr = lane & 15, fq = lane >> 4;
    int R[2], Cb[2]; unsigned voffB[2];
#pragma unroll
    for (int i = 0; i < 2; ++i) { int r, c; stage_rc(tid * 16 + i * 8192, r, c); R[i] = r; Cb[i] = c * 2; const int rb = (r & ~31) + perm32(r & 31); voffB[i] = (unsigned)(rb * ROWB + c * 2); }
    const size_t kstep = (size_t)(BK * 2), hstep = (size_t)HALF * ROWB;
    const unsigned ldsw = (unsigned)wid * 1024u;
    const int aoff = lds_byte(wr * 64 + fr, fq * 8), boff = lds_byte(wc * 32 + fr, fq * 8);
#define GM_SA(b, h) (((b) * 2 + (h)) * HTB)
#define GM_SB(b, h) ((4 + (b) * 2 + (h)) * HTB)
#define GM_STAGE(bufoff, gbase, vo0, vo1) do { \
        __builtin_amdgcn_global_load_lds((const unsigned*)((const char*)(gbase) + (vo0)), (LAS unsigned*)(lds + (bufoff) + ldsw), 16, 0, 0); \
        __builtin_amdgcn_global_load_lds((const unsigned*)((const char*)(gbase) + (vo1)), (LAS unsigned*)(lds + (bufoff) + ldsw + 8192), 16, 0, 0); } while (0)
#define GM_LDA(dst, b, h) do { _Pragma("unroll") for (int m = 0; m < 4; ++m) _Pragma("unroll") for (int k = 0; k < 2; ++k) dst[m][k] = *(const LAS bf16x8*)(lds + GM_SA(b, h) + aoff + m * 2048 + k * 1024); } while (0)
#define GM_LDB(dst, b, h) do { _Pragma("unroll") for (int n = 0; n < 2; ++n) _Pragma("unroll") for (int k = 0; k < 2; ++k) dst[n][k] = *(const LAS bf16x8*)(lds + GM_SB(b, h) + boff + n * 2048 + k * 1024); } while (0)
#define GM_MMA(ai, bj, At, Bt) do { __builtin_amdgcn_s_setprio(1); _Pragma("unroll") for (int m = 0; m < 4; ++m) _Pragma("unroll") for (int n = 0; n < 2; ++n) _Pragma("unroll") for (int k = 0; k < 2; ++k) \
        acc[ai][bj][m][n] = __builtin_amdgcn_mfma_f32_16x16x32_bf16(Bt[n][k], At[m][k], acc[ai][bj][m][n], 0, 0, 0); __builtin_amdgcn_s_setprio(0); } while (0)
#define GM_WAIT_V(n) asm volatile("s_waitcnt vmcnt(" #n ")" ::: "memory")
#define GM_WAIT_L(n) asm volatile("s_waitcnt lgkmcnt(" #n ")" ::: "memory")
#define GM_BAR __builtin_amdgcn_s_barrier()
#define GM_SCHED __builtin_amdgcn_sched_barrier(0)
    Unit cur, nxt; int ui = 0;
    if (!S.next(0, cur)) return;
    f32x4 acc[2][2][4][2];
#pragma unroll
    for (int a = 0; a < 2; ++a)
#pragma unroll
        for (int b = 0; b < 2; ++b)
#pragma unroll
            for (int m = 0; m < 4; ++m)
#pragma unroll
                for (int n = 0; n < 2; ++n) acc[a][b][m][n] = (f32x4){0.f, 0.f, 0.f, 0.f};
    bf16x8 At[4][2], B0[2][2], B1[2][2];
    unsigned ca[2][2], na[2][2];
    a_offsets<GATHER, GSHIFT>(cur, R, Cb, ca);
    const char* cA = cur.A; const char* cB = cur.B;
    GM_STAGE(GM_SB(0, 0), cB, voffB[0], voffB[1]); GM_STAGE(GM_SA(0, 0), cA, ca[0][0], ca[0][1]); GM_STAGE(GM_SB(0, 1), cB + hstep, voffB[0], voffB[1]); GM_STAGE(GM_SA(0, 1), cA, ca[1][0], ca[1][1]);
    if (wr == 1) GM_BAR;
    GM_WAIT_V(4); GM_BAR;
    GM_STAGE(GM_SB(1, 0), cB + kstep, voffB[0], voffB[1]); GM_STAGE(GM_SA(1, 0), cA + kstep, ca[0][0], ca[0][1]); GM_STAGE(GM_SB(1, 1), cB + hstep + kstep, voffB[0], voffB[1]);
    GM_WAIT_V(6); GM_BAR;
    for (;;) {
        const bool has_next = S.next(ui + 1, nxt);
        if (has_next) a_offsets<GATHER, GSHIFT>(nxt, R, Cb, na);
        else {
#pragma unroll
            for (int h = 0; h < 2; ++h)
#pragma unroll
                for (int i = 0; i < 2; ++i) na[h][i] = ca[h][i];
        }
        const char* nA = has_next ? nxt.A : cA; const char* nB = has_next ? nxt.B : cB;
        for (int t = 0; t < NT; t += 2) {
            const bool last = (t == NT - 2);
            const char* a1 = cA + (size_t)(t + 1) * kstep;
            const char* a2 = last ? nA : cA + (size_t)(t + 2) * kstep; const char* b2 = last ? nB : cB + (size_t)(t + 2) * kstep;
            const char* a3 = a2 + kstep; const char* b3 = b2 + kstep;
            const unsigned x00 = last ? na[0][0] : ca[0][0], x01 = last ? na[0][1] : ca[0][1], x10 = last ? na[1][0] : ca[1][0], x11 = last ? na[1][1] : ca[1][1];
            GM_LDB(B0, 0, 0); GM_SCHED; GM_LDA(At, 0, 0); GM_STAGE(GM_SA(1, 1), a1, ca[1][0], ca[1][1]);
            GM_WAIT_L(8); GM_BAR; GM_WAIT_L(0); GM_MMA(0, 0, At, B0); GM_BAR; GM_SCHED;
            GM_LDB(B1, 0, 1); GM_STAGE(GM_SB(0, 0), b2, voffB[0], voffB[1]);
            GM_BAR; GM_WAIT_L(0); GM_MMA(0, 1, At, B1); GM_BAR;
            GM_LDA(At, 0, 1); GM_STAGE(GM_SA(0, 0), a2, x00, x01);
            GM_BAR; GM_WAIT_L(0); GM_MMA(1, 0, At, B0); GM_BAR; GM_SCHED;
            GM_STAGE(GM_SB(0, 1), b2 + hstep, voffB[0], voffB[1]);
            GM_WAIT_V(6); GM_BAR; GM_MMA(1, 1, At, B1); GM_BAR;
            GM_LDB(B0, 1, 0); GM_SCHED; GM_LDA(At, 1, 0); GM_STAGE(GM_SA(0, 1), a2, x10, x11);
            GM_WAIT_L(8); GM_BAR; GM_WAIT_L(0); GM_MMA(0, 0, At, B0); GM_BAR; GM_SCHED;
            GM_LDB(B1, 1, 1); GM_STAGE(GM_SB(1, 0), b3, voffB[0], voffB[1]);
            GM_BAR; GM_WAIT_L(0); GM_MMA(0, 1, At, B1); GM_BAR;
            GM_LDA(At, 1, 1); GM_STAGE(GM_SA(1, 0), a3, x00, x01);
            GM_BAR; GM_WAIT_L(0); GM_MMA(1, 0, At, B0); GM_BAR; GM_SCHED;
            GM_STAGE(GM_SB(1, 1), b3 + hstep, voffB[0], voffB[1]);
            GM_WAIT_V(6); GM_BAR; GM_MMA(1, 1, At, B1); GM_BAR;
        }
        E(acc, cur, wr, wc, fr, fq);
        if (!has_next) break;
#pragma unroll
        for (int a = 0; a < 2; ++a)
#pragma unroll
            for (int b = 0; b < 2; ++b)
#pragma unroll
                for (int m = 0; m < 4; ++m)
#pragma unroll
                    for (int n = 0; n < 2; ++n) acc[a][b][m][n] = (f32x4){0.f, 0.f, 0.f, 0.f};
        cur = nxt; cA = nA; cB = nB; ++ui;
#pragma unroll
        for (int h = 0; h < 2; ++h)
#pragma unroll
            for (int i = 0; i < 2; ++i) ca[h][i] = na[h][i];
    }
    GM_WAIT_V(0);
    if (wr == 0) GM_BAR;
    GM_BAR;
#undef GM_SA
#undef GM_SB
#undef GM_STAGE
#undef GM_LDA
#undef GM_LDB
#undef GM_MMA
#undef GM_WAIT_V
#undef GM_WAIT_L
#undef GM_BAR
#undef GM_SCHED
}

__device__ __forceinline__ u32x4 pack8(f32x4 a, f32x4 b) { u32x4 w; w.x = pk2(a[0], a[1]); w.y = pk2(a[2], a[3]); w.z = pk2(b[0], b[1]); w.w = pk2(b[2], b[3]); return w; }

struct SchedIn {
    unsigned char* ws; int G, c;
    __device__ __forceinline__ bool next(int i, Unit& u) const {
        int L = i * G + c;
        u.list = nullptr; u.valid = 256; u.aux = 0;
        if (L < 768) {
            const int pa = L % 6, pb = L / 6;
            u.A = (const char*)(ws + WS_BTIN) + (size_t)(2048 + 256 * pa) * ROWB; u.B = (const char*)(ws + WS_H) + (size_t)(256 * pb) * ROWB;
            u.type = 2; u.row0 = 256 * pa; u.col0 = 256 * pb; return true;
        }
        L -= 768;
        if (L < 1024) {
            const int pm = L >> 3, pn = ((L & 7) + (L >> 8)) & 7;
            u.A = (const char*)(ws + WS_H) + (size_t)(256 * pm) * ROWB; u.B = (const char*)(ws + WS_BTIN) + (size_t)(256 * pn) * ROWB;
            u.type = pn < 6 ? 0 : 1; u.row0 = 256 * pm; u.col0 = pn; return true;
        }
        L -= 1024;
        if (L < 20) {
            const int pm = L / 5, j = L % 5, pn = j == 0 ? 1 : (j == 1 ? 2 : (j == 2 ? 3 : (j == 3 ? 6 : 7)));
            u.A = (const char*)(ws + WS_H) + (size_t)(T + 256 * pm) * ROWB; u.B = (const char*)(ws + WS_BTIN) + (size_t)(256 * pn) * ROWB;
            u.type = pn < 6 ? 0 : 1; u.row0 = T + 256 * pm; u.col0 = pn; return true;
        }
        return false;
    }
};
struct EpiIn {
    unsigned char* ws; const float* baf; const float* bab;
    __device__ __forceinline__ void operator()(const f32x4 (&acc)[2][2][4][2], const Unit& u, int wr, int wc, int fr, int fq) const {
        const int rl = wr * 64 + fr, cl = wc * 32 + 8 * fq;
        if (u.type == 0) {
            const int pn = u.col0;
            bf16_t* dst; int ld, cb;
            if (pn == 0) { dst = (bf16_t*)(ws + WS_Q); ld = 256; cb = 0; }
            else if (pn == 1) { dst = (bf16_t*)(ws + WS_K); ld = 256; cb = 0; }
            else if (pn < 4) { dst = (bf16_t*)(ws + WS_V); ld = 512; cb = (pn - 2) * 256; }
            else { dst = (bf16_t*)(ws + WS_G); ld = 512; cb = (pn - 4) * 256; }
#pragma unroll
            for (int ai = 0; ai < 2; ++ai)
#pragma unroll
                for (int m = 0; m < 4; ++m) { bf16_t* rowp = dst + (size_t)(u.row0 + rl + ai * 128 + m * 16) * ld + cb + cl;
#pragma unroll
                    for (int bj = 0; bj < 2; ++bj) *(u32x4*)(rowp + bj * 128) = pack8(acc[ai][bj][m][0], acc[ai][bj][m][1]); }
        } else if (u.type == 1) {
            float* dst = (float*)(ws + (u.col0 == 6 ? WS_GF : WS_GB)); const float* ba = (u.col0 == 6) ? baf : bab;
            f32x4 bv[2][2];
#pragma unroll
            for (int bj = 0; bj < 2; ++bj)
#pragma unroll
                for (int n = 0; n < 2; ++n) bv[bj][n] = *(const f32x4*)(ba + cl + bj * 128 + 4 * n);
#pragma unroll
            for (int ai = 0; ai < 2; ++ai)
#pragma unroll
                for (int m = 0; m < 4; ++m) { float* rowp = dst + (size_t)(u.row0 + rl + ai * 128 + m * 16) * 256 + cl;
#pragma unroll
                    for (int bj = 0; bj < 2; ++bj)
#pragma unroll
                        for (int n = 0; n < 2; ++n) { f32x4 z = acc[ai][bj][m][n] + bv[bj][n], o;
#pragma unroll
                            for (int j = 0; j < 4; ++j) o[j] = log_sigmoid_f(z[j]) * (1.f / 16.f);
                            *(f32x4*)(rowp + bj * 128 + 4 * n) = o; } }
        } else {
            const int b = u.col0 >> 13, l0 = u.col0 & 8191;
            bf16_t* dst = (bf16_t*)(ws + WS_UT) + ((size_t)b * HYC) * SEQ + l0 + cl;
#pragma unroll
            for (int ai = 0; ai < 2; ++ai)
#pragma unroll
                for (int m = 0; m < 4; ++m) { bf16_t* rowp = dst + (size_t)(u.row0 + rl + ai * 128 + m * 16) * SEQ;
#pragma unroll
                    for (int bj = 0; bj < 2; ++bj) *(u32x4*)(rowp + bj * 128) = pack8(acc[ai][bj][m][0], acc[ai][bj][m][1]); }
        }
    }
};

struct SchedOut {
    unsigned char* ws; int G, c;
    __device__ __forceinline__ bool next(int i, Unit& u) const {
        const int L = i * G + c; if (L >= 512) return false;
        const int pm = L >> 2, pn = L & 3;
        u.A = (const char*)(ws + WS_MIX) + (size_t)(256 * pm) * ROWB; u.B = (const char*)(ws + WS_BTOUT) + (size_t)(256 * pn) * ROWB;
        u.list = nullptr; u.valid = 256; u.aux = 0; u.type = 3; u.row0 = 256 * pm; u.col0 = 256 * pn; return true;
    }
};
struct EpiOut {
    unsigned char* ws; const float* x;
    __device__ __forceinline__ void operator()(const f32x4 (&acc)[2][2][4][2], const Unit& u, int wr, int wc, int fr, int fq) const {
        const int rl = wr * 64 + fr, cl = u.col0 + wc * 32 + 8 * fq;
        const int b = u.row0 >> 13;
        const float* gate = (const float*)(ws + WS_MOD) + b * 6144 + 2 * 1024;
        float* pre = (float*)(ws + WS_PRE1);
        f32x4 gv[2][2];
#pragma unroll
        for (int bj = 0; bj < 2; ++bj)
#pragma unroll
            for (int n = 0; n < 2; ++n) gv[bj][n] = *(const f32x4*)(gate + cl + bj * 128 + 4 * n);
#pragma unroll
        for (int ai = 0; ai < 2; ++ai)
#pragma unroll
            for (int m = 0; m < 4; ++m) { const size_t ro = (size_t)(u.row0 + rl + ai * 128 + m * 16) * 1024 + cl;
#pragma unroll
                for (int bj = 0; bj < 2; ++bj)
#pragma unroll
                    for (int n = 0; n < 2; ++n) { const f32x4 xv = *(const f32x4*)(x + ro + bj * 128 + 4 * n);
                        *(f32x4*)(pre + ro + bj * 128 + 4 * n) = xv * ALPHA + gv[bj][n] * acc[ai][bj][m][n]; } }
    }
};

constexpr int LDS_TAB = STAGE_BYTES;
template <int WHICH>
struct SchedMoe {
    unsigned char* ws; const LAS int* tab; int G, c;
    __device__ __forceinline__ bool next(int i, Unit& u) const {
        constexpr int NCT_ = WHICH == 1 ? 8 : 4;
        const int L = i * G + c; const int nrt = tab[32];
        if (L >= nrt * NCT_) return false;
        const int rt = L / NCT_, ct = L % NCT_;
        const int info = tab[64 + rt], e = info & 255, r0 = (info >> 8) * 256;
        const int cnt = tab[e];
        u.valid = (cnt - r0) < 256 ? (cnt - r0) : 256;
        u.list = (const int*)(ws + WS_LIST) + (size_t)e * CAP + r0;
        u.A = (const char*)(ws + (WHICH == 1 ? WS_H2 : WS_ACT));
        u.B = (const char*)(ws + (WHICH == 1 ? WS_W1T : WS_W2T)) + ((size_t)e * (WHICH == 1 ? 2048 : 1024) + 256 * ct) * ROWB;
        u.type = 3 + WHICH; u.row0 = r0; u.col0 = ct; u.aux = e; return true;
    }
};
__device__ __forceinline__ float swiglu_f(float glu, float lin) {
    glu = fminf(glu, 7.f); lin = fminf(fmaxf(lin, -7.f), 7.f);
    return glu * (1.f / (1.f + __expf(-1.702f * glu))) * (lin + 1.f);
}
struct EpiMoe1 {
    unsigned char* ws;
    __device__ __forceinline__ void operator()(const f32x4 (&acc)[2][2][4][2], const Unit& u, int wr, int wc, int fr, int fq) const {
        const int rl = wr * 64 + fr, cl = wc * 32 + 8 * fq, e = u.aux, ct = u.col0;
        const float* b1 = (const float*)(ws + WS_B1R) + (size_t)e * 2048 + 256 * ct + cl;
        bf16_t* act = (bf16_t*)(ws + WS_ACT);
        f32x4 bg[2], bl[2];
#pragma unroll
        for (int n = 0; n < 2; ++n) { bg[n] = *(const f32x4*)(b1 + 4 * n); bl[n] = *(const f32x4*)(b1 + 128 + 4 * n); }
#pragma unroll
        for (int ai = 0; ai < 2; ++ai)
#pragma unroll
            for (int m = 0; m < 4; ++m) { const int r = rl + ai * 128 + m * 16;
                if (r < u.valid) { const int pair = u.list[r];
                    f32x4 o[2];
#pragma unroll
                    for (int n = 0; n < 2; ++n) { const f32x4 gl = acc[ai][0][m][n] + bg[n], li = acc[ai][1][m][n] + bl[n];
#pragma unroll
                        for (int j = 0; j < 4; ++j) o[n][j] = swiglu_f(gl[j], li[j]); }
                    *(u32x4*)(act + (size_t)pair * 1024 + 128 * ct + cl) = pack8(o[0], o[1]); } }
    }
};
struct EpiMoe2 {
    unsigned char* ws; const float* b2;
    __device__ __forceinline__ void operator()(const f32x4 (&acc)[2][2][4][2], const Unit& u, int wr, int wc, int fr, int fq) const {
        const int rl = wr * 64 + fr, cl = wc * 32 + 8 * fq, e = u.aux, ct = u.col0;
        const float* bb = b2 + (size_t)e * 1024 + 256 * ct + cl;
        const float* pw = (const float*)(ws + WS_PW);
        bf16_t* slots = (bf16_t*)(ws + WS_SLOTS);
        f32x4 bv[2][2];
#pragma unroll
        for (int bj = 0; bj < 2; ++bj)
#pragma unroll
            for (int n = 0; n < 2; ++n) bv[bj][n] = *(const f32x4*)(bb + bj * 128 + 4 * n);
#pragma unroll
        for (int ai = 0; ai < 2; ++ai)
#pragma unroll
            for (int m = 0; m < 4; ++m) { const int r = rl + ai * 128 + m * 16;
                if (r < u.valid) { const int pair = u.list[r]; const float w = pw[pair];
#pragma unroll
                    for (int bj = 0; bj < 2; ++bj)
                        *(u32x4*)(slots + (size_t)pair * 1024 + 256 * ct + bj * 128 + cl) = pack8((acc[ai][bj][m][0] + bv[bj][0]) * w, (acc[ai][bj][m][1] + bv[bj][1]) * w); } }
    }
};
}

namespace hy {
__device__ __forceinline__ int phys(int n) { return n + (n >> 4) + ((n >> 9) << 4); }
constexpr int XSIZE = 16384 + 1024 + 512;

__device__ __forceinline__ float tw_c(int i) {
    constexpr float t[16] = {1.f, 0.98078528040323043f, 0.92387953251128674f, 0.83146961230254524f, 0.70710678118654752f, 0.55557023301960218f, 0.38268343236508977f, 0.19509032201612825f,
                             0.f, -0.19509032201612825f, -0.38268343236508977f, -0.55557023301960218f, -0.70710678118654752f, -0.83146961230254524f, -0.92387953251128674f, -0.98078528040323043f};
    return t[i];
}
__device__ __forceinline__ float tw_s(int i) {
    constexpr float t[16] = {0.f, 0.19509032201612825f, 0.38268343236508977f, 0.55557023301960218f, 0.70710678118654752f, 0.83146961230254524f, 0.92387953251128674f, 0.98078528040323043f,
                             1.f, 0.98078528040323043f, 0.92387953251128674f, 0.83146961230254524f, 0.70710678118654752f, 0.55557023301960218f, 0.38268343236508977f, 0.19509032201612825f};
    return t[i];
}
__host__ __device__ constexpr int brev(int p, int bits) { int r = 0; for (int i = 0; i < bits; ++i) r |= ((p >> i) & 1) << (bits - 1 - i); return r; }

template <int R, bool INV>
__device__ __forceinline__ void fft_reg(f32x2 (&v)[R]) {
#pragma unroll
    for (int s = R / 2; s >= 1; s >>= 1) {
#pragma unroll
        for (int g = 0; g < R; g += 2 * s) {
#pragma unroll
            for (int k = 0; k < s; ++k) {
                const f32x2 a = v[g + k], b = v[g + k + s];
                v[g + k] = a + b;
                const f32x2 t = a - b;
                const int ti = k * (16 / s);
                f32x2 o;
                if (ti == 0) o = t;
                else if (ti == 8) { if (INV) { o[0] = -t[1]; o[1] = t[0]; } else { o[0] = t[1]; o[1] = -t[0]; } }
                else { const float c = tw_c(ti), sn = tw_s(ti);
                    if (INV) { o[0] = t[0] * c - t[1] * sn; o[1] = t[1] * c + t[0] * sn; }
                    else     { o[0] = t[0] * c + t[1] * sn; o[1] = t[1] * c - t[0] * sn; } }
                v[g + k + s] = o;
            }
        }
    }
}
__device__ __forceinline__ f32x2 cmul(f32x2 a, f32x2 b) { f32x2 r; r[0] = a[0] * b[0] - a[1] * b[1]; r[1] = a[0] * b[1] + a[1] * b[0]; return r; }

template <int M, bool ZPAD = false>
__device__ __forceinline__ void pass_fwd32(LAS f32x2* X, int tid) {
    int j = (M == 512) ? tid : (tid & 15);
    asm volatile("" : "+v"(j));
    const int p0 = (M == 512) ? (tid + (tid >> 4)) : (560 * (tid >> 4) + (tid & 15));
    constexpr int PS = (M == 512) ? 560 : 17;
    f32x2 v[32];
#pragma unroll
    for (int r = 0; r < 32; ++r) { if (ZPAD && r >= 16) v[r] = (f32x2){0.f, 0.f}; else v[r] = X[p0 + PS * r]; }
    fft_reg<32, false>(v);
    float sn, cs; sincospif(-2.f * (float)j / (float)(32 * M), &sn, &cs);
    const f32x2 w1 = {cs, sn}; f32x2 w = w1;
    X[p0] = v[0];
#pragma unroll
    for (int rp = 1; rp < 32; ++rp) { X[p0 + PS * rp] = cmul(v[brev(rp, 5)], w); w = cmul(w, w1); }
}
template <int M, bool HALF = false>
__device__ __forceinline__ void pass_inv32(LAS f32x2* X, int tid) {
    int j = (M == 512) ? tid : (tid & 15);
    asm volatile("" : "+v"(j));
    const int p0 = (M == 512) ? (tid + (tid >> 4)) : (560 * (tid >> 4) + (tid & 15));
    constexpr int PS = (M == 512) ? 560 : 17;
    float sn, cs; sincospif(2.f * (float)j / (float)(32 * M), &sn, &cs);
    const f32x2 w1 = {cs, sn}; f32x2 w = w1;
    f32x2 v[32];
    v[0] = X[p0];
#pragma unroll
    for (int rp = 1; rp < 32; ++rp) { v[rp] = cmul(X[p0 + PS * rp], w); w = cmul(w, w1); }
    fft_reg<32, true>(v);
#pragma unroll
    for (int p = 0; p < 32; ++p) { if (!HALF || brev(p, 5) < 16) X[p0 + PS * brev(p, 5)] = v[p]; }
}
__device__ __forceinline__ void pass_c_store(const LAS f32x2* X, f32x2* Hs, int tid, float scale) {
#pragma unroll
    for (int u = 0; u < 2; ++u) { const int blk = tid + 512 * u, p0 = 17 * blk + 16 * (blk >> 5);
        f32x2 v[16];
#pragma unroll
        for (int r = 0; r < 16; ++r) v[r] = X[p0 + r];
        fft_reg<16, false>(v);
#pragma unroll
        for (int q = 0; q < 8; ++q) { const f32x2 x0 = v[brev(2 * q, 4)] * scale, x1 = v[brev(2 * q + 1, 4)] * scale;
            *(f32x4*)(Hs + 16 * blk + 2 * q) = (f32x4){x0[0], x0[1], x1[0], x1[1]}; } }
}
__device__ __forceinline__ void pass_c_mul_inv(LAS f32x2* X, const f32x2* Hs, int tid) {
#pragma unroll
    for (int u = 0; u < 2; ++u) { const int blk = tid + 512 * u, p0 = 17 * blk + 16 * (blk >> 5);
        f32x2 v[16], w[16];
#pragma unroll
        for (int r = 0; r < 16; ++r) v[r] = X[p0 + r];
        f32x4 hh[8];
#pragma unroll
        for (int q = 0; q < 8; ++q) hh[q] = *(const f32x4*)(Hs + 16 * blk + 2 * q);
        fft_reg<16, false>(v);
#pragma unroll
        for (int q = 0; q < 8; ++q) { w[2 * q] = cmul(v[brev(2 * q, 4)], (f32x2){hh[q][0], hh[q][1]}); w[2 * q + 1] = cmul(v[brev(2 * q + 1, 4)], (f32x2){hh[q][2], hh[q][3]}); }
        fft_reg<16, true>(w);
#pragma unroll
        for (int p = 0; p < 16; ++p) X[p0 + brev(p, 4)] = w[p]; }
}
__device__ __forceinline__ void load16(const bf16_t* u, float (&e)[16]) {
    const u32x4 a = *(const u32x4*)u, b = *(const u32x4*)(u + 8);
    e[0] = bflo(a.x); e[1] = bfhi(a.x); e[2] = bflo(a.y); e[3] = bfhi(a.y); e[4] = bflo(a.z); e[5] = bfhi(a.z); e[6] = bflo(a.w); e[7] = bfhi(a.w);
    e[8] = bflo(b.x); e[9] = bfhi(b.x); e[10] = bflo(b.y); e[11] = bfhi(b.y); e[12] = bflo(b.z); e[13] = bfhi(b.z); e[14] = bflo(b.w); e[15] = bfhi(b.w);
}
__device__ __forceinline__ void sconv16(const bf16_t* u, int tid, float w0, float w1, float w2, float bias, float (&o)[16]) {
    float e[16]; load16(u + 16 * tid, e);
    float lf = __shfl_up(e[15], 1), rt = __shfl_down(e[0], 1);
    if ((tid & 3) == 0) lf = 0.f;
    if ((tid & 3) == 3) rt = 0.f;
    o[0] = w0 * lf + w1 * e[0] + w2 * e[1] + bias;
#pragma unroll
    for (int i = 1; i < 15; ++i) o[i] = w0 * e[i - 1] + w1 * e[i] + w2 * e[i + 1] + bias;
    o[15] = w0 * e[14] + w1 * e[15] + w2 * rt + bias;
}

__device__ __forceinline__ void channel(const Args& a, LAS unsigned char* lds, int c, unsigned char* scratch) {
    const int tid = threadIdx.x;
    LAS f32x2* X = (LAS f32x2*)lds;
    f32x2* Hs = (f32x2*)scratch;
    const float* HF = (const float*)(a.ws + WS_HF);
    const int pc = 17 * tid + 16 * (tid >> 5);
    __syncthreads();
#pragma unroll 1
    for (int o = 0; o < 2; ++o) {
        const f32x4* hf = (const f32x4*)(HF + ((size_t)(2 * o) * HYW + c) * SEQ + 16 * tid); const f32x4* hb = (const f32x4*)(HF + ((size_t)(2 * o + 1) * HYW + c) * SEQ + 16 * tid);
#pragma unroll
        for (int q = 0; q < 4; ++q) { const f32x4 f = hf[q], b = hb[q];
#pragma unroll
            for (int e = 0; e < 4; ++e) { const int i = 4 * q + e, t = 16 * tid + i;
                X[pc + i] = (f32x2){f[e], 0.f};
                if (t >= 1) X[phys(FFTN - t)] = (f32x2){b[e], 0.f}; } }
        if (tid == 0) X[phys(SEQ)] = (f32x2){0.f, 0.f};
        __syncthreads();
        pass_fwd32<512>(X, tid); __syncthreads(); pass_fwd32<16>(X, tid); __syncthreads(); pass_c_store(X, Hs + (size_t)o * FFTN, tid, 1.f / (float)FFTN); __syncthreads();
    }
    const float* cw = a.in[I_CONVW]; const float* cbv = a.in[I_CONVB]; const float* dbias = a.in[I_BIASD];
    const float d1 = dbias[c], d2 = dbias[HYW + c];
    float wv[3][3], bv[3];
#pragma unroll
    for (int s = 0; s < 3; ++s) { bv[s] = cbv[s * HYW + c];
#pragma unroll
        for (int i = 0; i < 3; ++i) wv[s][i] = cw[i * HYC + s * HYW + c]; }
    const bf16_t* UT = (const bf16_t*)(a.ws + WS_UT);
    bf16_t* YT = (bf16_t*)(a.ws + WS_YHYT);
#pragma unroll 1
    for (int bp = 0; bp < 2; ++bp) {
        const bf16_t* u0 = UT + ((size_t)(2 * bp) * HYC + c) * SEQ; const bf16_t* u1 = UT + ((size_t)(2 * bp + 1) * HYC + c) * SEQ;
        float z0[16], z1[16];
        {
            float v0[16], v1[16]; sconv16(u0, tid, wv[0][0], wv[0][1], wv[0][2], bv[0], v0); sconv16(u1, tid, wv[0][0], wv[0][1], wv[0][2], bv[0], v1);
#pragma unroll
            for (int i = 0; i < 16; ++i) X[pc + i] = (f32x2){v0[i], v1[i]};
        }
        __syncthreads();
        pass_fwd32<512, true>(X, tid); __syncthreads(); pass_fwd32<16>(X, tid); __syncthreads(); pass_c_mul_inv(X, Hs, tid); __syncthreads(); pass_inv32<16>(X, tid); __syncthreads(); pass_inv32<512, true>(X, tid); __syncthreads();
        {
            float v0[16], v1[16], x0[16], x1[16];
            sconv16(u0, tid, wv[0][0], wv[0][1], wv[0][2], bv[0], v0); sconv16(u1, tid, wv[0][0], wv[0][1], wv[0][2], bv[0], v1);
            sconv16(u0 + (size_t)HYW * SEQ, tid, wv[1][0], wv[1][1], wv[1][2], bv[1], x0); sconv16(u1 + (size_t)HYW * SEQ, tid, wv[1][0], wv[1][1], wv[1][2], bv[1], x1);
#pragma unroll
            for (int i = 0; i < 16; ++i) { const f32x2 y1 = X[pc + i]; z0[i] = x0[i] * (y1[0] + d1 * v0[i]); z1[i] = x1[i] * (y1[1] + d1 * v1[i]); X[pc + i] = (f32x2){z0[i], z1[i]}; }
        }
        __syncthreads();
        pass_fwd32<512, true>(X, tid); __syncthreads(); pass_fwd32<16>(X, tid); __syncthreads(); pass_c_mul_inv(X, Hs + FFTN, tid); __syncthreads(); pass_inv32<16>(X, tid); __syncthreads(); pass_inv32<512, true>(X, tid); __syncthreads();
        {
            float x0[16], x1[16];
            sconv16(u0 + (size_t)2 * HYW * SEQ, tid, wv[2][0], wv[2][1], wv[2][2], bv[2], x0); sconv16(u1 + (size_t)2 * HYW * SEQ, tid, wv[2][0], wv[2][1], wv[2][2], bv[2], x1);
            unsigned w0[8], w1[8];
#pragma unroll
            for (int i = 0; i < 8; ++i) { const f32x2 ya = X[pc + 2 * i], yb = X[pc + 2 * i + 1];
                w0[i] = pk2(x0[2 * i] * (ya[0] + d2 * z0[2 * i]), x0[2 * i + 1] * (yb[0] + d2 * z0[2 * i + 1]));
                w1[i] = pk2(x1[2 * i] * (ya[1] + d2 * z1[2 * i]), x1[2 * i + 1] * (yb[1] + d2 * z1[2 * i + 1])); }
            u32x4* y0p = (u32x4*)(YT + ((size_t)(2 * bp) * HYW + c) * SEQ + 16 * tid); u32x4* y1p = (u32x4*)(YT + ((size_t)(2 * bp + 1) * HYW + c) * SEQ + 16 * tid);
            y0p[0] = (u32x4){w0[0], w0[1], w0[2], w0[3]}; y0p[1] = (u32x4){w0[4], w0[5], w0[6], w0[7]};
            y1p[0] = (u32x4){w1[0], w1[1], w1[2], w1[3]}; y1p[1] = (u32x4){w1[4], w1[5], w1[6], w1[7]};
        }
        __syncthreads();
    }
}

__device__ __forceinline__ void filter_item(const Args& a, int item, int lane) {
    const int ct = item & 127, tc = item >> 7;
    const float* hid2 = (const float*)(a.ws + WS_HID2); const float* wout = a.in[I_FWOUT]; float* HF = (float*)(a.ws + WS_HF);
    const int col = 16 * ct + (lane & 15), kq = lane >> 4, cch = col & 511;
    float bf[16];
#pragma unroll
    for (int s = 0; s < 16; ++s) bf[s] = wout[(size_t)(16 * kq + s) * 2048 + col];
    const float dlt = fabsf(-3.0701134573253945f + (float)cch * ((-15.350567286626973f + 3.0701134573253945f) / 511.f));
#pragma unroll 2
    for (int tt = 0; tt < 32; ++tt) { const int t0 = 512 * tc + 16 * tt;
        const f32x4* ar = (const f32x4*)(hid2 + (size_t)(t0 + (lane & 15)) * 64 + 16 * kq);
        const f32x4 a0 = ar[0], a1 = ar[1], a2 = ar[2], a3 = ar[3];
        f32x4 acc = {0.f, 0.f, 0.f, 0.f};
#pragma unroll
        for (int e = 0; e < 4; ++e) { acc = __builtin_amdgcn_mfma_f32_16x16x4f32(a0[e], bf[e], acc, 0, 0, 0); }
#pragma unroll
        for (int e = 0; e < 4; ++e) { acc = __builtin_amdgcn_mfma_f32_16x16x4f32(a1[e], bf[4 + e], acc, 0, 0, 0); }
#pragma unroll
        for (int e = 0; e < 4; ++e) { acc = __builtin_amdgcn_mfma_f32_16x16x4f32(a2[e], bf[8 + e], acc, 0, 0, 0); }
#pragma unroll
        for (int e = 0; e < 4; ++e) { acc = __builtin_amdgcn_mfma_f32_16x16x4f32(a3[e], bf[12 + e], acc, 0, 0, 0); }
        f32x4 o;
#pragma unroll
        for (int r = 0; r < 4; ++r) o[r] = acc[r] * __expf(-((float)(t0 + 4 * kq + r) / (float)(SEQ - 1)) * dlt);
        *(f32x4*)(HF + (size_t)col * SEQ + t0 + 4 * kq) = o; }
}

__device__ __forceinline__ void transpose_item(const Args& a, int item, int lane) {
    const int lt = item & 127, ct = (item >> 7) & 7, b = item >> 10;
    const bf16_t* src = (const bf16_t*)(a.ws + WS_YHYT) + ((size_t)b * HYW + 64 * ct) * SEQ + 64 * lt + lane;
    bf16_t* dst = (bf16_t*)(a.ws + WS_MIX) + ((size_t)b * SEQ + 64 * lt + lane) * 1024 + 512 + 64 * ct;
#pragma unroll
    for (int q = 0; q < 8; ++q) { unsigned w[4];
#pragma unroll
        for (int e = 0; e < 4; ++e) { const unsigned lo = src[(size_t)(8 * q + 2 * e) * SEQ], hi = src[(size_t)(8 * q + 2 * e + 1) * SEQ]; w[e] = lo | (hi << 16); }
        *(u32x4*)(dst + 8 * q) = (u32x4){w[0], w[1], w[2], w[3]}; }
}
}

__device__ __forceinline__ void p0_mod_and_filter(const Args& a, LAS unsigned char* lds) {
    const int tid = threadIdx.x, lane = tid & 63, wave = tid >> 6;
    const float* c = a.in[I_C]; const float* cctx = a.in[I_CCTX]; const float* adaw = a.in[I_ADAW]; const float* adab = a.in[I_ADAB];
    float* mod = (float*)(a.ws + WS_MOD);
    LAS float* sl = (LAS float*)lds;
    LAS float* pt = (LAS float*)lds + 5 * 1024;
    for (int i = tid; i < 5 * 1024; i += NTHREADS) { const int r = i >> 10, k = i & 1023; sl[i] = silu_f(r < 4 ? c[r * 1024 + k] : cctx[k]); }
    for (int it = blockIdx.x; it < 256; it += gridDim.x) {
        __syncthreads();
        if (tid < 504) {
            const int col = tid % 24, ks = tid / 24, n = it * 24 + col, kbeg = ks * 49, kend = (kbeg + 49 < 1024) ? kbeg + 49 : 1024;
            float acc[5] = {0.f, 0.f, 0.f, 0.f, 0.f};
            for (int k = kbeg; k < kend; ++k) { const float w = adaw[(size_t)k * 6144 + n];
#pragma unroll
                for (int r = 0; r < 5; ++r) acc[r] += sl[r * 1024 + k] * w; }
#pragma unroll
            for (int r = 0; r < 5; ++r) pt[(ks * 5 + r) * 24 + col] = acc[r];
        }
        __syncthreads();
        if (tid < 120) { const int r = tid / 24, col = tid % 24, n = it * 24 + col; float s = adab[n];
            for (int ks = 0; ks < 21; ++ks) s += pt[(ks * 5 + r) * 24 + col];
            mod[r * 6144 + n] = s; }
    }
    __syncthreads();
    const float* w1 = a.in[I_FW1]; const float* b1 = a.in[I_FB1]; const float* w2 = a.in[I_FW2]; const float* b2 = a.in[I_FB2]; const float* fq = a.in[I_FFREQ];
    float* hid2 = (float*)(a.ws + WS_HID2);
    LAS float* zs = (LAS float*)lds + 8192 + wave * 128;
    const float frq = fq[lane], bb1 = b1[lane], bb2 = b2[lane];
    for (int t = (blockIdx.x * NWAVES + wave); t < SEQ; t += gridDim.x * NWAVES) {
        float z = 0.f;
        if (lane == 0) z = (float)t / (float)(SEQ - 1);
        else if (lane < 33) { const int i = (lane - 1) & 15; const float f = 1e-4f + (float)i * ((15.f - 1e-4f) / 15.f);
            const float ang = (6.283185307179586f * (float)t / (float)SEQ) * f; z = (lane < 17) ? cosf(ang) : -sinf(ang); }
        if (lane < 33) zs[lane] = z;
        __builtin_amdgcn_wave_barrier(); asm volatile("s_waitcnt lgkmcnt(0)" ::: "memory");
        float s = bb1;
#pragma unroll
        for (int e = 0; e < 33; ++e) s += zs[e] * w1[e * 64 + lane];
        const float h1 = sinf(frq * s);
        zs[64 + lane] = h1;
        __builtin_amdgcn_wave_barrier(); asm volatile("s_waitcnt lgkmcnt(0)" ::: "memory");
        float s2 = bb2;
#pragma unroll 16
        for (int g = 0; g < 64; ++g) s2 += zs[64 + g] * w2[g * 64 + lane];
        hid2[(size_t)t * 64 + lane] = sinf(frq * s2);
        __builtin_amdgcn_wave_barrier(); asm volatile("s_waitcnt lgkmcnt(0)" ::: "memory");
    }
}

__device__ __forceinline__ void tr_item(const float* W, int ldw, int k0, int c0, int cstride, float scale, bf16_t* dstrow0, LAS float* scr, int lane) {
#pragma unroll 8
    for (int i = 0; i < 32; ++i) { const int kk = 2 * i + (lane >> 5); scr[kk * 33 + (lane & 31)] = W[(size_t)(k0 + kk) * ldw + c0 + (lane & 31) * cstride] * scale; }
    asm volatile("s_waitcnt lgkmcnt(0)" ::: "memory"); __builtin_amdgcn_wave_barrier();
    const int c = lane & 7;
#pragma unroll
    for (int j = 0; j < 4; ++j) { const int n = (lane >> 3) + 8 * j; const LAS float* s = scr + (8 * c) * 33 + n;
        u32x4 o; o.x = pk2(s[0 * 33], s[1 * 33]); o.y = pk2(s[2 * 33], s[3 * 33]); o.z = pk2(s[4 * 33], s[5 * 33]); o.w = pk2(s[6 * 33], s[7 * 33]);
        *(u32x4*)(dstrow0 + (size_t)n * 1024 + k0 + 8 * c) = o; }
    asm volatile("s_waitcnt lgkmcnt(0)" ::: "memory"); __builtin_amdgcn_wave_barrier();
}
__device__ __forceinline__ void fold_item(const float* win, const float* wa, int dir, int k0, int j0, bf16_t* dstrow0, LAS float* scr, int lane) {
#pragma unroll 4
    for (int i = 0; i < 32; ++i) { const int kk = 2 * i + (lane >> 5); const float* wr = win + (size_t)(k0 + kk) * INW + 1536 + 16 * dir; float s = 0.f;
#pragma unroll
        for (int r = 0; r < 16; ++r) s += wr[r] * wa[r * 256 + j0 + (lane & 31)];
        scr[kk * 33 + (lane & 31)] = s; }
    asm volatile("s_waitcnt lgkmcnt(0)" ::: "memory"); __builtin_amdgcn_wave_barrier();
    const int c = lane & 7;
#pragma unroll
    for (int j = 0; j < 4; ++j) { const int n = (lane >> 3) + 8 * j; const LAS float* s = scr + (8 * c) * 33 + n;
        u32x4 o; o.x = pk2(s[0 * 33], s[1 * 33]); o.y = pk2(s[2 * 33], s[3 * 33]); o.z = pk2(s[4 * 33], s[5 * 33]); o.w = pk2(s[6 * 33], s[7 * 33]);
        *(u32x4*)(dstrow0 + (size_t)n * 1024 + k0 + 8 * c) = o; }
    asm volatile("s_waitcnt lgkmcnt(0)" ::: "memory"); __builtin_amdgcn_wave_barrier();
}
__device__ __forceinline__ void ln_mod_row(const float* xrow, const float* shift, const float* scale, bf16_t* orow, int lane) {
    const f32x4* xr = (const f32x4*)xrow + lane;
    f32x4 v[4]; float s = 0.f;
#pragma unroll
    for (int j = 0; j < 4; ++j) { v[j] = xr[64 * j]; s += (v[j][0] + v[j][1]) + (v[j][2] + v[j][3]); }
    const float mean = wave_sum(s) * (1.f / D); float s2 = 0.f;
#pragma unroll
    for (int j = 0; j < 4; ++j) { v[j] = v[j] - mean; s2 += (v[j][0] * v[j][0] + v[j][1] * v[j][1]) + (v[j][2] * v[j][2] + v[j][3] * v[j][3]); }
    const float rstd = 1.f / sqrtf(wave_sum(s2) * (1.f / D) + LN_EPS);
    u32x2* o8 = (u32x2*)orow + lane;
#pragma unroll
    for (int j = 0; j < 4; ++j) { const f32x4 sh = ((const f32x4*)shift)[64 * j + lane], sc = ((const f32x4*)scale)[64 * j + lane];
        const f32x4 y = v[j] * rstd * (sc + 1.f) + sh;
        u32x2 w; w.x = pk2(y[0], y[1]); w.y = pk2(y[2], y[3]); o8[64 * j] = w; }
}
__device__ __forceinline__ void p1_prep(const Args& a, LAS unsigned char* lds) {
    const int tid = threadIdx.x, lane = tid & 63, wave = tid >> 6;
    LAS float* scr = (LAS float*)(lds + wave * 16384);
    const int gw = blockIdx.x * NWAVES + wave, NGW = gridDim.x * NWAVES;
    const float* win = a.in[I_WIN];
    bf16_t* btin = (bf16_t*)(a.ws + WS_BTIN); bf16_t* btout = (bf16_t*)(a.ws + WS_BTOUT); bf16_t* w1t = (bf16_t*)(a.ws + WS_W1T); bf16_t* w2t = (bf16_t*)(a.ws + WS_W2T);
    const float* mod = (const float*)(a.ws + WS_MOD);
    bf16_t* H = (bf16_t*)(a.ws + WS_H);
    for (int row = gw; row < TT; row += NGW) {
        const float* xr; int mr;
        if (row < T) { xr = a.in[I_X] + (size_t)row * D; mr = row >> 13; } else { xr = a.in[I_CTX] + (size_t)(row - T) * D; mr = 4; }
        ln_mod_row(xr, mod + mr * 6144, mod + mr * 6144 + 1024, H + (size_t)row * D, lane);
    }
    constexpr int I_IN = 16 * 96, I_FOLD = 16 * 8 * 2, I_OUT = 16 * 32, I_W1 = NE * 16 * 64, I_W2 = NE * 16 * 32;
    constexpr int NITEMS = I_IN + I_FOLD + I_OUT + I_W1 + I_W2;
    for (int it = gw; it < NITEMS; it += NGW) {
        int r = it;
        if (r < I_IN) {
            const int kb = r / 96, nb = r % 96;
            if (nb < 48) tr_item(win, INW, 64 * kb, 32 * nb, 1, nb < 8 ? 0.125f : 1.f, btin + (size_t)(32 * nb) * 1024, scr, lane);
            else tr_item(win, INW, 64 * kb, 1568 + 32 * (nb - 48), 1, 1.f, btin + (size_t)(2048 + 32 * (nb - 48)) * 1024, scr, lane);
            continue; }
        r -= I_IN;
        if (r < I_FOLD) { const int dir = r & 1, jb = (r >> 1) & 7, kb = r >> 4;
            fold_item(win, dir ? a.in[I_WAB] : a.in[I_WAF], dir, 64 * kb, 32 * jb, btin + (size_t)(1536 + 256 * dir + 32 * jb) * 1024, scr, lane); continue; }
        r -= I_FOLD;
        if (r < I_OUT) { const int kb = r / 32, nb = r % 32; tr_item(a.in[I_WOUT], 1024, 64 * kb, 32 * nb, 1, 1.f, btout + (size_t)(32 * nb) * 1024, scr, lane); continue; }
        r -= I_OUT;
        if (r < I_W1) {
            const int e = r / 1024, q = r % 1024, s = q & 1, nb = (q >> 1) & 31, kb = q >> 6;
            const int ct = nb >> 2, jj0 = (nb & 3) * 32;
            tr_item(a.in[I_EW1] + (size_t)e * 1024 * 2048, 2048, 64 * kb, 2 * (128 * ct + jj0) + s, 2, 1.f, w1t + ((size_t)e * 2048 + 256 * ct + 128 * s + jj0) * 1024, scr, lane);
            continue; }
        r -= I_W1;
        { const int e = r / 512, q = r % 512, kb = q / 32, nb = q % 32;
          tr_item(a.in[I_EW2] + (size_t)e * 1024 * 1024, 1024, 64 * kb, 32 * nb, 1, 1.f, w2t + ((size_t)e * 1024 + 32 * nb) * 1024, scr, lane); }
    }
    for (int it = gw; it < 2048; it += NGW) hy::filter_item(a, it, lane);
    float* b1r = (float*)(a.ws + WS_B1R); const float* eb1 = a.in[I_EB1];
    for (int i = blockIdx.x * NTHREADS + tid; i < NE * 2048; i += gridDim.x * NTHREADS) {
        const int e = i >> 11, n = i & 2047, ct = n >> 8, s = (n >> 7) & 1, jj = n & 127;
        b1r[i] = eb1[(size_t)e * 2048 + 2 * (128 * ct + jj) + s];
    }
}

namespace gla {
constexpr int RS = 72;
constexpr int L_TOTF = 0, L_TOTB = 2048, L_SSQ = 4096;
constexpr int L_T0 = 8192;
constexpr int L_T1 = L_T0 + 9216, L_T2 = L_T1 + 9216, L_T3 = L_T2 + 9216;
constexpr int L_VT = L_T3 + 9216;
constexpr int L_P  = L_VT + 18432;
constexpr int L_END = L_P + 9216;

__device__ __forceinline__ bf16x8 frag(const LAS unsigned char* tile, int row, int k0, int lane) {
    return *(const LAS bf16x8*)(tile + ((row + (lane & 15)) * RS + k0 + 8 * (lane >> 4)) * 2);
}
__device__ __forceinline__ void chunk_cums(LAS unsigned char* L, const float* GF, const float* GB, size_t tok0, int h, int wave, int lane, float (&cumf)[8], float (&cumb)[8], float& allf, float& allb) {
    LAS float* totf = (LAS float*)(L + L_TOTF); LAS float* totb = (LAS float*)(L + L_TOTB);
    float gf[8], gb[8];
#pragma unroll
    for (int r = 0; r < 8; ++r) { const size_t o = (tok0 + 8 * wave + r) * 256 + h * 64 + lane; gf[r] = GF[o]; gb[r] = GB[o]; }
    cumf[0] = gf[0];
#pragma unroll
    for (int r = 1; r < 8; ++r) cumf[r] = cumf[r - 1] + gf[r];
    cumb[7] = gb[7];
#pragma unroll
    for (int r = 6; r >= 0; --r) cumb[r] = cumb[r + 1] + gb[r];
    totf[wave * 64 + lane] = cumf[7]; totb[wave * 64 + lane] = cumb[0];
    __syncthreads();
    float of = 0.f, ob = 0.f, af = 0.f, ab = 0.f;
#pragma unroll
    for (int w = 0; w < 8; ++w) { const float tf = totf[w * 64 + lane], tb = totb[w * 64 + lane]; af += tf; ab += tb; of += (w < wave) ? tf : 0.f; ob += (w > wave) ? tb : 0.f; }
#pragma unroll
    for (int r = 0; r < 8; ++r) { cumf[r] += of; cumb[r] += ob; }
    allf = af; allb = ab;
}
__device__ __forceinline__ void load_vt(LAS unsigned char* L, const bf16_t* V, size_t tok0, int h, int tid) {
    LAS bf16_t* vt = (LAS bf16_t*)(L + L_VT);
    const int j = tid >> 3, c8 = tid & 7;
#pragma unroll
    for (int q = 0; q < 2; ++q) { const int dv0 = 8 * (c8 + 8 * q);
        const u32x4 w = *(const u32x4*)(V + (tok0 + j) * 512 + h * 128 + dv0);
        const unsigned ww[4] = {w.x, w.y, w.z, w.w};
#pragma unroll
        for (int e = 0; e < 4; ++e) { vt[(dv0 + 2 * e) * RS + j] = (bf16_t)(ww[e] & 0xffffu); vt[(dv0 + 2 * e + 1) * RS + j] = (bf16_t)(ww[e] >> 16); } }
}

__device__ __forceinline__ void g1_unit(const Args& a, LAS unsigned char* L, int bh, int chunk  ) {
    const int tid = threadIdx.x, lane = tid & 63, wave = __builtin_amdgcn_readfirstlane(tid >> 6);
    const int b = bh >> 2, h = bh & 3;
    const size_t tok0 = chunk < NCHUNK ? (size_t)b * SEQ + (size_t)chunk * CH : (size_t)T + (size_t)b * CTXL + (size_t)(chunk - NCHUNK) * CH;
    const float* GF = (const float*)(a.ws + WS_GF); const float* GB = (const float*)(a.ws + WS_GB);
    const bf16_t* Kb = (const bf16_t*)(a.ws + WS_K); const bf16_t* Vb = (const bf16_t*)(a.ws + WS_V);
    float cumf[8], cumb[8], allf, allb;
    __syncthreads();
    chunk_cums(L, GF, GB, tok0, h, wave, lane, cumf, cumb, allf, allb);
    LAS bf16_t* ketf = (LAS bf16_t*)(L + L_T0); LAS bf16_t* ketb = (LAS bf16_t*)(L + L_T1);
#pragma unroll
    for (int r = 0; r < 8; ++r) { const int i = 8 * wave + r; const float kv = bf2f(Kb[(tok0 + i) * 256 + h * 64 + lane]);
        ketf[lane * RS + i] = f2bf(kv * __expf(allf - cumf[r])); ketb[lane * RS + i] = f2bf(kv * __expf(allb - cumb[r])); }
    load_vt(L, Vb, tok0, h, tid);
    if (wave == 0) { float* av = (float*)(a.ws + WS_AV); av[((size_t)(0 * 16 + bh) * NCT + chunk) * 64 + lane] = __expf(allf); av[((size_t)(1 * 16 + bh) * NCT + chunk) * 64 + lane] = __expf(allb); }
    __syncthreads();
    bf16_t* KV = (bf16_t*)(a.ws + WS_KV);
#pragma unroll
    for (int dir = 0; dir < 2; ++dir) {
        const LAS unsigned char* ket = L + (dir ? L_T1 : L_T0);
        bf16_t* dst = KV + ((size_t)(dir * 16 + bh) * NCT + chunk) * 8192;
#pragma unroll
        for (int nt = 0; nt < 4; ++nt) { f32x4 acc = {0.f, 0.f, 0.f, 0.f};
#pragma unroll
            for (int ks = 0; ks < 2; ++ks) acc = __builtin_amdgcn_mfma_f32_16x16x32_bf16(frag(L + L_VT, 16 * wave, 32 * ks, lane), frag(ket, 16 * nt, 32 * ks, lane), acc, 0, 0, 0);
#pragma unroll
            for (int r = 0; r < 4; ++r) dst[(16 * wave + 4 * (lane >> 4) + r) * 64 + 16 * nt + (lane & 15)] = f2bf(acc[r]); }
    }
}

__device__ __forceinline__ void g2_scan(const Args& a) {
    const bf16_t* KV = (const bf16_t*)(a.ws + WS_KV); const float* AV = (const float*)(a.ws + WS_AV); bf16_t* SP = (bf16_t*)(a.ws + WS_SP);
    for (int id = blockIdx.x * NTHREADS + threadIdx.x; id < 32 * 4096; id += gridDim.x * NTHREADS) {
        const int db = id >> 12, e2 = id & 4095, dir = db >> 4, dk = (2 * e2) & 63;
        const unsigned* kv = (const unsigned*)(KV + (size_t)db * NCT * 8192) + e2;
        const float* av = AV + (size_t)db * NCT * 64 + dk;
        unsigned* sp = (unsigned*)(SP + (size_t)db * NCHUNK * 8192) + e2;
        float s0 = 0.f, s1 = 0.f;
#pragma unroll
        for (int q = 0; q < NCC; ++q) { const int c = NCHUNK + (dir ? (NCC - 1 - q) : q);
            const unsigned w = kv[(size_t)c * 4096]; const f32x2 aa = *(const f32x2*)(av + (size_t)c * 64);
            s0 = aa[0] * s0 + bflo(w); s1 = aa[1] * s1 + bfhi(w); }
        for (int q0 = 0; q0 < NCHUNK; q0 += 8) {
            unsigned w[8]; f32x2 aa[8];
#pragma unroll
            for (int u = 0; u < 8; ++u) { const int c = dir ? (NCHUNK - 1 - (q0 + u)) : (q0 + u); w[u] = kv[(size_t)c * 4096]; aa[u] = *(const f32x2*)(av + (size_t)c * 64); }
#pragma unroll
            for (int u = 0; u < 8; ++u) { const int c = dir ? (NCHUNK - 1 - (q0 + u)) : (q0 + u);
                sp[(size_t)c * 4096] = pk2(s0, s1);
                s0 = aa[u][0] * s0 + bflo(w[u]); s1 = aa[u][1] * s1 + bfhi(w[u]); }
        }
    }
}

__device__ __forceinline__ void g3_unit(const Args& a, LAS unsigned char* L, int bh, int chunk  ) {
    const int tid = threadIdx.x, lane = tid & 63, wave = __builtin_amdgcn_readfirstlane(tid >> 6);
    const int b = bh >> 2, h = bh & 3;
    const size_t tok0 = (size_t)b * SEQ + (size_t)chunk * CH;
    const float* GF = (const float*)(a.ws + WS_GF); const float* GB = (const float*)(a.ws + WS_GB);
    const bf16_t* Qb = (const bf16_t*)(a.ws + WS_Q); const bf16_t* Kb = (const bf16_t*)(a.ws + WS_K); const bf16_t* Vb = (const bf16_t*)(a.ws + WS_V); const bf16_t* Gt = (const bf16_t*)(a.ws + WS_G);
    float cumf[8], cumb[8], allf, allb;
    __syncthreads();
    chunk_cums(L, GF, GB, tok0, h, wave, lane, cumf, cumb, allf, allb);
    LAS bf16_t* qf = (LAS bf16_t*)(L + L_T0); LAS bf16_t* kf = (LAS bf16_t*)(L + L_T1); LAS bf16_t* qb = (LAS bf16_t*)(L + L_T2); LAS bf16_t* kb = (LAS bf16_t*)(L + L_T3);
#pragma unroll
    for (int r = 0; r < 8; ++r) { const int i = 8 * wave + r; const size_t o = (tok0 + i) * 256 + h * 64 + lane;
        const float qv = bf2f(Qb[o]), kv = bf2f(Kb[o]);
        qf[i * RS + lane] = f2bf(qv * __expf(cumf[r])); kf[i * RS + lane] = f2bf(kv * __expf(-cumf[r]));
        qb[i * RS + lane] = f2bf(qv * __expf(cumb[r])); kb[i * RS + lane] = f2bf(kv * __expf(-cumb[r])); }
    load_vt(L, Vb, tok0, h, tid);
    __syncthreads();
    const int mt = wave >> 1, fr = lane & 15, fq = lane >> 4;
    {
        LAS bf16_t* P = (LAS bf16_t*)(L + L_P);
#pragma unroll
        for (int q = 0; q < 2; ++q) { const int nt = 2 * (wave & 1) + q;
            f32x4 sf = {0.f, 0.f, 0.f, 0.f}, sb = {0.f, 0.f, 0.f, 0.f};
#pragma unroll
            for (int ks = 0; ks < 2; ++ks) {
                sf = __builtin_amdgcn_mfma_f32_16x16x32_bf16(frag(L + L_T0, 16 * mt, 32 * ks, lane), frag(L + L_T1, 16 * nt, 32 * ks, lane), sf, 0, 0, 0);
                sb = __builtin_amdgcn_mfma_f32_16x16x32_bf16(frag(L + L_T2, 16 * mt, 32 * ks, lane), frag(L + L_T3, 16 * nt, 32 * ks, lane), sb, 0, 0, 0); }
#pragma unroll
            for (int r = 0; r < 4; ++r) { const int i = 16 * mt + 4 * fq + r, j = 16 * nt + fr;
                P[i * RS + j] = f2bf((j <= i ? sf[r] : 0.f) + (j >= i ? sb[r] : 0.f)); } }
    }
    __syncthreads();
    const bf16_t* SPf = (const bf16_t*)(a.ws + WS_SP) + ((size_t)(0 * 16 + bh) * NCHUNK + chunk) * 8192;
    const bf16_t* SPb = (const bf16_t*)(a.ws + WS_SP) + ((size_t)(1 * 16 + bh) * NCHUNK + chunk) * 8192;
    f32x4 o[4]; float ssq[4] = {0.f, 0.f, 0.f, 0.f};
#pragma unroll
    for (int q = 0; q < 4; ++q) { const int nt = 4 * (wave & 1) + q;
        f32x4 acc = {0.f, 0.f, 0.f, 0.f};
#pragma unroll
        for (int ks = 0; ks < 2; ++ks) {
            acc = __builtin_amdgcn_mfma_f32_16x16x32_bf16(frag(L + L_P, 16 * mt, 32 * ks, lane), frag(L + L_VT, 16 * nt, 32 * ks, lane), acc, 0, 0, 0);
            const bf16x8 sfv = *(const bf16x8*)(SPf + (16 * nt + fr) * 64 + 32 * ks + 8 * fq);
            const bf16x8 sbv = *(const bf16x8*)(SPb + (16 * nt + fr) * 64 + 32 * ks + 8 * fq);
            acc = __builtin_amdgcn_mfma_f32_16x16x32_bf16(frag(L + L_T0, 16 * mt, 32 * ks, lane), sfv, acc, 0, 0, 0);
            acc = __builtin_amdgcn_mfma_f32_16x16x32_bf16(frag(L + L_T2, 16 * mt, 32 * ks, lane), sbv, acc, 0, 0, 0); }
        o[q] = acc;
#pragma unroll
        for (int r = 0; r < 4; ++r) ssq[r] += acc[r] * acc[r]; }
    LAS float* SSQ = (LAS float*)(L + L_SSQ);
#pragma unroll
    for (int r = 0; r < 4; ++r) { float s = ssq[r]; s += __shfl_xor(s, 1); s += __shfl_xor(s, 2); s += __shfl_xor(s, 4); s += __shfl_xor(s, 8); ssq[r] = s; }
    if (fr == 0) {
#pragma unroll
        for (int r = 0; r < 4; ++r) SSQ[(wave & 1) * 64 + 16 * mt + 4 * fq + r] = ssq[r]; }
    __syncthreads();
    const float* ng = a.in[I_NORMG];
    bf16_t* mix = (bf16_t*)(a.ws + WS_MIX);
#pragma unroll
    for (int r = 0; r < 4; ++r) { const int i = 16 * mt + 4 * fq + r;
        const float rstd = 1.f / sqrtf((SSQ[i] + SSQ[64 + i]) * (1.f / DV) + LN_EPS);
#pragma unroll
        for (int q = 0; q < 4; ++q) { const int dv = 16 * (4 * (wave & 1) + q) + fr;
            const float g = bf2f(Gt[(tok0 + i) * 512 + h * 128 + dv]);
            mix[(tok0 + i) * 1024 + h * 128 + dv] = f2bf(o[q][r] * rstd * ng[dv] * silu_f(g)); } }
}
}

namespace rt {
constexpr int HS = 1028;
constexpr int L_H2 = 0;
constexpr int L_PART = 65792;
constexpr int L_LCNT = L_PART + 16384;
constexpr int L_REC = L_LCNT + 256;

__device__ __forceinline__ void phase(const Args& a, LAS unsigned char* lds) {
    const int tid = threadIdx.x, lane = tid & 63, wave = __builtin_amdgcn_readfirstlane(tid >> 6);
    float* pre = (float*)(a.ws + WS_PRE1); bf16_t* H2 = (bf16_t*)(a.ws + WS_H2);
    const float* mod = (const float*)(a.ws + WS_MOD);
    const float* rw = a.in[I_RW]; const float* rb = a.in[I_RB];
    LAS float* h2s = (LAS float*)(lds + L_H2); LAS float* part = (LAS float*)(lds + L_PART);
    LAS int* lcnt = (LAS int*)(lds + L_LCNT); LAS int* lbase = lcnt + 32; LAS int* rec = (LAS int*)(lds + L_REC);
    unsigned* cnt = (unsigned*)(a.ws + WS_CNT); int* list = (int*)(a.ws + WS_LIST); float* pw = (float*)(a.ws + WS_PW);
    float rwr[32][2];
#pragma unroll
    for (int s = 0; s < 32; ++s)
#pragma unroll
        for (int nt = 0; nt < 2; ++nt) rwr[s][nt] = rw[(size_t)(128 * wave + 4 * s + (lane >> 4)) * 32 + 16 * nt + (lane & 15)];
    const f32x4* g1 = (const f32x4*)a.in[I_LN1G]; const f32x4* bb1 = (const f32x4*)a.in[I_LN1B];
    if (tid < 32) lcnt[tid] = 0;
    for (int grp = blockIdx.x; grp < T / 16; grp += gridDim.x) {
        __syncthreads();
#pragma unroll 1
        for (int rr = 0; rr < 2; ++rr) {
            const int lr = 2 * wave + rr, t = grp * 16 + lr, b = t >> 13;
            f32x4* pr = (f32x4*)(pre + (size_t)t * D) + lane;
            f32x4 v[4]; float s = 0.f;
#pragma unroll
            for (int j = 0; j < 4; ++j) { v[j] = pr[64 * j]; s += (v[j][0] + v[j][1]) + (v[j][2] + v[j][3]); }
            float mean = wave_sum(s) * (1.f / D), s2 = 0.f;
#pragma unroll
            for (int j = 0; j < 4; ++j) { v[j] = v[j] - mean; s2 += (v[j][0] * v[j][0] + v[j][1] * v[j][1]) + (v[j][2] * v[j][2] + v[j][3] * v[j][3]); }
            float rstd = 1.f / sqrtf(wave_sum(s2) * (1.f / D) + LN_EPS);
            s = 0.f;
#pragma unroll
            for (int j = 0; j < 4; ++j) { v[j] = v[j] * rstd * g1[64 * j + lane] + bb1[64 * j + lane]; pr[64 * j] = v[j]; s += (v[j][0] + v[j][1]) + (v[j][2] + v[j][3]); }
            mean = wave_sum(s) * (1.f / D); s2 = 0.f;
#pragma unroll
            for (int j = 0; j < 4; ++j) { v[j] = v[j] - mean; s2 += (v[j][0] * v[j][0] + v[j][1] * v[j][1]) + (v[j][2] * v[j][2] + v[j][3] * v[j][3]); }
            rstd = 1.f / sqrtf(wave_sum(s2) * (1.f / D) + LN_EPS);
            const f32x4* sh = (const f32x4*)(mod + b * 6144 + 3 * 1024); const f32x4* sc = (const f32x4*)(mod + b * 6144 + 4 * 1024);
            u32x2* o8 = (u32x2*)(H2 + (size_t)t * D) + lane;
#pragma unroll
            for (int j = 0; j < 4; ++j) { const f32x4 y = v[j] * rstd * (sc[64 * j + lane] + 1.f) + sh[64 * j + lane];
                u32x2 w; w.x = pk2(y[0], y[1]); w.y = pk2(y[2], y[3]); o8[64 * j] = w;
                *(LAS f32x4*)(h2s + lr * HS + 256 * j + 4 * lane) = y; }
        }
        __syncthreads();
        {
            f32x4 acc0 = {0.f, 0.f, 0.f, 0.f}, acc1 = {0.f, 0.f, 0.f, 0.f};
            const LAS float* ap = h2s + (lane & 15) * HS + 128 * wave + (lane >> 4);
#pragma unroll
            for (int s = 0; s < 32; ++s) { const float av = ap[4 * s];
                acc0 = __builtin_amdgcn_mfma_f32_16x16x4f32(av, rwr[s][0], acc0, 0, 0, 0);
                acc1 = __builtin_amdgcn_mfma_f32_16x16x4f32(av, rwr[s][1], acc1, 0, 0, 0); }
#pragma unroll
            for (int r = 0; r < 4; ++r) { part[(wave * 16 + 4 * (lane >> 4) + r) * 32 + (lane & 15)] = acc0[r]; part[(wave * 16 + 4 * (lane >> 4) + r) * 32 + 16 + (lane & 15)] = acc1[r]; }
        }
        __syncthreads();
        {
            const int lr = 2 * wave + (lane >> 5), e = lane & 31, t = grp * 16 + lr;
            float lg = rb[e];
#pragma unroll
            for (int w = 0; w < 8; ++w) lg += part[(w * 16 + lr) * 32 + e];
            float cur = lg, tv[4]; int ti[4];
#pragma unroll
            for (int k = 0; k < 4; ++k) { float bv = cur; int bi = e;
#pragma unroll
                for (int o = 1; o < 32; o <<= 1) { const float ov = __shfl_xor(bv, o); const int oi = __shfl_xor(bi, o); if (ov > bv || (ov == bv && oi < bi)) { bv = ov; bi = oi; } }
                tv[k] = bv; ti[k] = bi; if (bi == e) cur = -3.0e38f; }
            const float e1 = __expf(tv[1] - tv[0]), e2 = __expf(tv[2] - tv[0]), e3 = __expf(tv[3] - tv[0]);
            const float inv = 1.f / (1.f + e1 + e2 + e3);
            if (e < 4) { const float wk = (e == 0 ? 1.f : (e == 1 ? e1 : (e == 2 ? e2 : e3))) * inv; const int ek = (e == 0 ? ti[0] : (e == 1 ? ti[1] : (e == 2 ? ti[2] : ti[3])));
                const int pair = t * 4 + e;
                pw[pair] = wk;
                const int rank = __hip_atomic_fetch_add((LAS int*)&lcnt[ek], 1, __ATOMIC_RELAXED, __HIP_MEMORY_SCOPE_WORKGROUP);
                rec[lr * 4 + e] = ek | (rank << 8); }
        }
        __syncthreads();
        if (tid < 32) { const int n = lcnt[tid]; lbase[tid] = n ? (int)atomicAdd(&cnt[tid], (unsigned)n) : 0; }
        __syncthreads();
        if (tid < 64) { const int rc = rec[tid], ek = rc & 255, rank = rc >> 8; list[(size_t)ek * CAP + lbase[ek] + rank] = (grp * 16 + (tid >> 2)) * 4 + (tid & 3); }
        __syncthreads();
        if (tid < 32) lcnt[tid] = 0;
    }
}
}

__device__ __forceinline__ void p_final(const Args& a) {
    const int tid = threadIdx.x, lane = tid & 63, wave = tid >> 6;
    const float* xm = (const float*)(a.ws + WS_PRE1); const bf16_t* slots = (const bf16_t*)(a.ws + WS_SLOTS); const float* mod = (const float*)(a.ws + WS_MOD);
    const f32x4* g2 = (const f32x4*)a.in[I_LN2G]; const f32x4* b2 = (const f32x4*)a.in[I_LN2B];
    for (int t = blockIdx.x * NWAVES + wave; t < T; t += gridDim.x * NWAVES) {
        const int b = t >> 13;
        const f32x4* xr = (const f32x4*)(xm + (size_t)t * D) + lane; const f32x4* gt = (const f32x4*)(mod + b * 6144 + 5 * 1024);
        f32x4 v[4]; float s = 0.f;
#pragma unroll
        for (int j = 0; j < 4; ++j) { f32x4 y = {0.f, 0.f, 0.f, 0.f};
#pragma unroll
            for (int sl = 0; sl < 4; ++sl) { const u32x2 w = *((const u32x2*)(slots + ((size_t)t * 4 + sl) * D) + 64 * j + lane); y[0] += bflo(w.x); y[1] += bfhi(w.x); y[2] += bflo(w.y); y[3] += bfhi(w.y); }
            v[j] = xr[64 * j] * ALPHA + gt[64 * j + lane] * y; s += (v[j][0] + v[j][1]) + (v[j][2] + v[j][3]); }
        const float mean = wave_sum(s) * (1.f / D); float s2 = 0.f;
#pragma unroll
        for (int j = 0; j < 4; ++j) { v[j] = v[j] - mean; s2 += (v[j][0] * v[j][0] + v[j][1] * v[j][1]) + (v[j][2] * v[j][2] + v[j][3] * v[j][3]); }
        const float rstd = 1.f / sqrtf(wave_sum(s2) * (1.f / D) + LN_EPS);
        f32x4* o = (f32x4*)(a.out + (size_t)t * D) + lane;
#pragma unroll
        for (int j = 0; j < 4; ++j) o[64 * j] = v[j] * rstd * g2[64 * j + lane] + b2[64 * j + lane];
    }
}


constexpr int N_PHASES = 11;
__global__ void __launch_bounds__(NTHREADS, 2) mega_fwd(Args a) {
    extern __shared__ __attribute__((aligned(16))) unsigned char lds_raw[];
    LAS unsigned char* lds = (LAS unsigned char*)lds_raw;
    const int tid = threadIdx.x;
    volatile LAS unsigned* misc = (volatile LAS unsigned*)(lds + LDS_MISC);
    if (tid < 4) misc[tid] = 0u;
    __syncthreads();
    XcdBarrier bar; bar.bar = (unsigned*)(a.ws + WS_BAR); bar.x = 0; bar.st = misc;
    const bool multi = (a.ph_hi - a.ph_lo) > 1;
    if (multi) bar = xcd_barrier_post((unsigned*)(a.ws + WS_BAR), misc);
    const int lo = a.ph_lo, hi = a.ph_hi;
#ifdef ONLY_PHASE
#define IN(k) ((k) == ONLY_PHASE && lo <= (k) && (k) < hi)
#else
#define IN(k) (lo <= (k) && (k) < hi)
#endif
#define SEAM(k) do { if (IN(k) && IN((k) + 1)) xcd_barrier(bar); } while (0)

#ifndef REPEAT_PHASE
#define REPEAT_PHASE -1
#endif
#define RUNPH(k, ...) do { if (IN(k)) { __VA_ARGS__; if (REPEAT_PHASE == (k)) { xcd_barrier(bar); __VA_ARGS__; } } } while (0)
    RUNPH(0, p0_mod_and_filter(a, lds));
    SEAM(0);
    RUNPH(1, p1_prep(a, lds));
    SEAM(1);
    RUNPH(2, { gm::SchedIn S{a.ws, (int)gridDim.x, (int)blockIdx.x}; gm::EpiIn E{a.ws, a.in[I_BAF], a.in[I_BAB]}; gm::gemm_stream<false, 0>(lds, S, E); });
    SEAM(2);
    RUNPH(3, { for (int u = blockIdx.x; u < 16 * NCT; u += gridDim.x) gla::g1_unit(a, lds, u / NCT, u % NCT); });
    SEAM(3);
    RUNPH(4, { gla::g2_scan(a);
        for (int c = blockIdx.x; c < HYW; c += gridDim.x) hy::channel(a, lds, c, a.ws + WS_HSPEC + (size_t)blockIdx.x * HSPEC_PER_WG); });
    SEAM(4);
    RUNPH(5, { for (int u = blockIdx.x; u < 16 * NCHUNK; u += gridDim.x) gla::g3_unit(a, lds, u >> 7, u & 127);
        const int wave = tid >> 6;
        for (int it = blockIdx.x * NWAVES + wave; it < 4096; it += gridDim.x * NWAVES) hy::transpose_item(a, it, tid & 63); });
    SEAM(5);
    RUNPH(6, { gm::SchedOut S{a.ws, (int)gridDim.x, (int)blockIdx.x}; gm::EpiOut E{a.ws, a.in[I_X]}; gm::gemm_stream<false, 0>(lds, S, E); });
    SEAM(6);
    RUNPH(7, rt::phase(a, lds));
    SEAM(7);
    if (IN(8) || IN(9)) {
        LAS int* tab = (LAS int*)(lds + gm::LDS_TAB);
        __syncthreads();
        if (tid == 0) { const unsigned* cnt = (const unsigned*)(a.ws + WS_CNT); int nrt = 0;
            for (int e = 0; e < NE; ++e) { const int n = (int)cnt[e]; tab[e] = n; const int nt = (n + 255) >> 8; for (int k = 0; k < nt; ++k) tab[64 + nrt + k] = e | (k << 8); nrt += nt; }
            tab[32] = nrt; }
        __syncthreads();
    }
    RUNPH(8, { gm::SchedMoe<1> S{a.ws, (const LAS int*)(lds + gm::LDS_TAB), (int)gridDim.x, (int)blockIdx.x}; gm::EpiMoe1 E{a.ws}; gm::gemm_stream<true, 2>(lds, S, E); });
    SEAM(8);
    RUNPH(9, { gm::SchedMoe<2> S{a.ws, (const LAS int*)(lds + gm::LDS_TAB), (int)gridDim.x, (int)blockIdx.x}; gm::EpiMoe2 E{a.ws, a.in[I_EB2]}; gm::gemm_stream<true, 0>(lds, S, E); });
    SEAM(9);
    RUNPH(10, p_final(a));
#undef RUNPH
#undef IN
#undef SEAM
}

extern "C" void kernel_launch(void* const* d_in, const int* in_sizes, int n_in, void* d_out, int out_size, void* d_ws, size_t ws_size, hipStream_t stream) {
    static int grid = 0;
    if (grid == 0) {
        if (n_in != 32 || out_size != T * D || ws_size < WS_END) { fprintf(stderr, "kernel_launch: unexpected shapes (n_in %d out %d ws %zu need %zu)\n", n_in, out_size, ws_size, (size_t)WS_END); grid = -1; return; }
        int dev = 0, cus = 0;
        if (hipGetDevice(&dev) != hipSuccess || hipDeviceGetAttribute(&cus, hipDeviceAttributeMultiprocessorCount, dev) != hipSuccess) { grid = -1; return; }
        if (hipFuncSetAttribute((const void*)mega_fwd, hipFuncAttributeMaxDynamicSharedMemorySize, LDS_BYTES) != hipSuccess) { fprintf(stderr, "kernel_launch: hipFuncSetAttribute failed\n"); grid = -1; return; }
        int per_cu = 0;
        if (hipOccupancyMaxActiveBlocksPerMultiprocessor(&per_cu, (const void*)mega_fwd, NTHREADS, LDS_BYTES) != hipSuccess || per_cu < 1) fprintf(stderr, "kernel_launch: occupancy query says %d\n", per_cu);
        (void)hipGetLastError();
        grid = cus;
        if (grid > MAX_GRID) grid = MAX_GRID;
    }
    if (grid < 0) return;
    (void)hipMemsetAsync(d_ws, 0, WS_ZERO_BYTES, stream);
    Args a{};
    for (int i = 0; i < 32; ++i) a.in[i] = (const float*)d_in[i];
    a.out = (float*)d_out; a.ws = (unsigned char*)d_ws;
#ifdef DBG
    (void)hipMemsetAsync((char*)d_ws + WS_DBG, 0, 512, stream);
    for (int p = 0; p < N_PHASES; ++p) { a.ph_lo = p; a.ph_hi = p + 1; hipLaunchKernelGGL(mega_fwd, dim3(grid), dim3(NTHREADS), LDS_BYTES, stream, a);
        hipLaunchKernelGGL(dbg_check, dim3(64), dim3(512), 0, stream, a, p); }
    hipLaunchKernelGGL(dbg_encode, dim3(1024), dim3(256), 0, stream, a);
#elif N_LAUNCH_PER_PHASE
    for (int p = 0; p < N_PHASES; ++p) { a.ph_lo = p; a.ph_hi = p + 1; hipLaunchKernelGGL(mega_fwd, dim3(grid), dim3(NTHREADS), LDS_BYTES, stream, a); }
#else
    a.ph_lo = 0; a.ph_hi = N_PHASES;
    hipLaunchKernelGGL(mega_fwd, dim3(grid), dim3(NTHREADS), LDS_BYTES, stream, a);
#endif
}
```

```cpp
#include <hip/hip_runtime.h>
#include <cstdio>
#include <cstdint>
#include <cstddef>

#define LAS __attribute__((address_space(3)))
#define GAS __attribute__((address_space(1)))
typedef unsigned short bf16_t;
typedef short bf16x8 __attribute__((ext_vector_type(8)));
typedef float f32x4 __attribute__((ext_vector_type(4)));
typedef float f32x2 __attribute__((ext_vector_type(2)));
typedef unsigned u32x4 __attribute__((ext_vector_type(4)));
typedef unsigned u32x2 __attribute__((ext_vector_type(2)));

#ifndef N_LAUNCH_PER_PHASE
#define N_LAUNCH_PER_PHASE 0
#endif

constexpr int D = 1024, NB = 4, SEQ = 8192, T = NB * SEQ, CTXL = 256, TC = NB * CTXL, TT = T + TC;
constexpr int NH = 4, DK = 64, DV = 128, CH = 64, NCHUNK = SEQ / CH, NCC = CTXL / CH, NCT = NCHUNK + NCC;
constexpr int HYW = 512, HYC = 3 * HYW, INW = 3104;
constexpr int NE = 32, DE = 1024, CAP = T;
constexpr float LN_EPS = 1e-6f, ALPHA = 1.189207115002721f;
constexpr int NTHREADS = 512, NWAVES = 8;
constexpr int FFTN = 16384;

constexpr size_t al256(size_t x) { return (x + 255) & ~(size_t)255; }
constexpr size_t WS_BAR   = 0;
constexpr size_t WS_MOD   = 16384;
constexpr size_t WS_CNT   = WS_MOD + 5 * 6144 * 4;
constexpr size_t WS_ZERO_BYTES = al256(WS_CNT + 256);
constexpr size_t WS_LIST  = 262144;
constexpr size_t WS_PW    = WS_LIST + (size_t)NE * CAP * 4;
constexpr size_t WS_PLOC  = WS_PW + (size_t)T * 4 * 4;
constexpr size_t WS_B1R   = WS_PLOC + (size_t)T * 4 * 4;
constexpr size_t WS_HID2  = WS_B1R + (size_t)NE * 2048 * 4;
constexpr size_t WS_BTIN  = WS_HID2 + (size_t)SEQ * 64 * 4;
constexpr size_t WS_BTOUT = WS_BTIN + (size_t)3584 * 1024 * 2;
constexpr size_t WS_W1T   = WS_BTOUT + (size_t)1024 * 1024 * 2;
constexpr size_t WS_W2T   = WS_W1T + (size_t)NE * 2048 * 1024 * 2;
constexpr size_t WS_PRE1  = WS_W2T + (size_t)NE * 1024 * 1024 * 2;
constexpr size_t WS_RA    = WS_PRE1 + (size_t)T * 1024 * 4;
constexpr size_t WS_H     = WS_RA;
constexpr size_t WS_Q     = WS_H + (size_t)TT * 1024 * 2;
constexpr size_t WS_K     = WS_Q + (size_t)T * 256 * 2;
constexpr size_t WS_V     = WS_K + (size_t)TT * 256 * 2;
constexpr size_t WS_G     = WS_V + (size_t)TT * 512 * 2;
constexpr size_t WS_GF    = WS_G + (size_t)T * 512 * 2;
constexpr size_t WS_GB    = WS_GF + (size_t)TT * 256 * 4;
constexpr size_t WS_UT    = WS_GB + (size_t)TT * 256 * 4;
constexpr size_t WS_RA_END= WS_UT + (size_t)NB * HYC * SEQ * 2;
constexpr size_t WS_H2    = WS_RA;
constexpr size_t WS_FG    = WS_RA + (size_t)T * 1024 * 2;
constexpr size_t WS_SLOTS = WS_RA;
constexpr size_t SORTED_BYTES_ = (size_t)(T * 4 / 256 + NE) * 256 * 1024 * 2;
constexpr size_t WS_RB    = al256(WS_RA_END > WS_RA + SORTED_BYTES_ ? WS_RA_END : WS_RA + SORTED_BYTES_);
constexpr size_t WS_KV    = WS_RB;
constexpr size_t WS_AV    = WS_KV + (size_t)2 * 16 * NCT * 8192 * 2;
constexpr size_t WS_SP    = WS_AV + (size_t)2 * 16 * NCT * 64 * 4;
constexpr size_t WS_HSPEC = WS_SP + (size_t)2 * 16 * NCHUNK * 8192 * 2;
constexpr size_t HSPEC_PER_WG = (size_t)2 * FFTN * 8;
constexpr int MAX_GRID = 256;
constexpr size_t WS_YHYT  = WS_HSPEC + (size_t)MAX_GRID * HSPEC_PER_WG;
constexpr size_t WS_MIX   = WS_YHYT + (size_t)NB * HYW * SEQ * 2;
constexpr size_t WS_RB_END= WS_MIX + (size_t)T * 1024 * 2;
constexpr size_t WS_HF    = WS_MIX;
constexpr size_t WS_ACT   = WS_RB;
constexpr size_t SORTED_BYTES = (size_t)(T * 4 / 256 + NE) * 256 * 1024 * 2;
constexpr size_t WS_END   = al256(WS_RB_END > WS_RB + SORTED_BYTES ? WS_RB_END : WS_RB + SORTED_BYTES);

constexpr int LDS_BYTES = 147456;
constexpr int LDS_MISC  = 145408;

typedef __bf16 bf16n2 __attribute__((ext_vector_type(2)));
__device__ __forceinline__ unsigned pk2(float lo, float hi) { bf16n2 v = {(__bf16)lo, (__bf16)hi}; return __builtin_bit_cast(unsigned, v); }
__device__ __forceinline__ bf16_t f2bf(float f) { __bf16 b = (__bf16)f; return __builtin_bit_cast(unsigned short, b); }
__device__ __forceinline__ float bf2f(bf16_t b) { return __uint_as_float(((unsigned)b) << 16); }
__device__ __forceinline__ float bflo(unsigned w) { return __uint_as_float(w << 16); }
__device__ __forceinline__ float bfhi(unsigned w) { return __uint_as_float(w & 0xffff0000u); }
__device__ __forceinline__ float wave_sum(float v) {
#pragma unroll
    for (int o = 1; o < 64; o <<= 1) v += __shfl_xor(v, o);
    return v;
}
__device__ __forceinline__ float silu_f(float x) { return x / (1.f + __expf(-x)); }
__device__ __forceinline__ float log_sigmoid_f(float z) { return fminf(z, 0.f) - __logf(1.f + __expf(-fabsf(z))); }

#define XB_TMO      128
#define XB_XCNT(j)  (256  + 64 * (j))
#define XB_XSUB(j)  (1280 + 64 * (j))
#define XB_XGEN(j)  (2304 + 64 * (j))
#define XB_TOP      3328
#define XB_TOPGEN   3392
#define XCD_BAR_WORDS 3456
#define XB_SPIN_CAP (1u << 22)
__device__ __forceinline__ unsigned xb_ld(unsigned* p)              { return __hip_atomic_load(p, __ATOMIC_RELAXED, __HIP_MEMORY_SCOPE_AGENT); }
__device__ __forceinline__ unsigned xb_add(unsigned* p, unsigned v) { return __hip_atomic_fetch_add(p, v, __ATOMIC_RELAXED, __HIP_MEMORY_SCOPE_AGENT); }
__device__ __forceinline__ unsigned xb_xcc_id() { return (unsigned)__builtin_amdgcn_s_getreg((3 << 11) | 20) & 0xFu; }
#define XB_SPIN(cond, bar) do { unsigned _sp = 0; while (cond) { __builtin_amdgcn_s_sleep(1); \
    if ((++_sp & 255u) == 0u) { if (xb_ld(&(bar)[XB_TMO])) break; if (_sp > XB_SPIN_CAP) { atomicAdd(&(bar)[XB_TMO], 1u); break; } } } } while (0)
struct XcdBarrier { unsigned* bar; unsigned x; volatile LAS unsigned* st; };
__device__ __forceinline__ XcdBarrier xcd_barrier_post(unsigned* bar, volatile LAS unsigned* st) {
    XcdBarrier b; b.bar = bar; b.x = xb_xcc_id(); b.st = st;
    if (threadIdx.x == 0) (void)xb_add(&bar[XB_XCNT(b.x)], 1u);
    return b;
}
__device__ __forceinline__ void xcd_barrier_complete(unsigned* bar, unsigned x, unsigned& nloc, unsigned& nx) {
    const unsigned G = gridDim.x * gridDim.y * gridDim.z;
    unsigned sum, cnt, mine, sp = 0u;
    for (;;) {
        sum = 0u; cnt = 0u; mine = 0u;
#pragma unroll
        for (unsigned j = 0; j < 16; ++j) { const unsigned c = xb_ld(&bar[XB_XCNT(j)]); sum += c; cnt += (c > 0u) ? 1u : 0u; mine = (j == x) ? c : mine; }
        if (sum == G) break;
        __builtin_amdgcn_s_sleep(1);
        if ((++sp & 255u) == 0u) { if (xb_ld(&bar[XB_TMO])) break; if (sp > XB_SPIN_CAP) { atomicAdd(&bar[XB_TMO], 1u); break; } }
    }
    nloc = mine > 0u ? mine : 1u; nx = cnt > 0u ? cnt : 1u;
}
__device__ __forceinline__ void xcd_barrier(const XcdBarrier& b) {
    asm volatile("s_waitcnt vmcnt(0)" ::: "memory");
    __syncthreads();
    if (threadIdx.x == 0) {
        unsigned* bar = b.bar;
        __builtin_amdgcn_s_waitcnt(0);
        unsigned nloc = b.st[0], nx = b.st[1];
        if (nloc == 0u) { xcd_barrier_complete(bar, b.x, nloc, nx); b.st[0] = nloc; b.st[1] = nx; }
        const unsigned old = xb_add(&bar[XB_XSUB(b.x)], 1u);
        const unsigned gen = old / nloc;
        if (old + 1u == (gen + 1u) * nloc) {
            __builtin_amdgcn_fence(__ATOMIC_RELEASE, "agent");
            asm volatile("s_waitcnt vmcnt(0)" ::: "memory");
            const unsigned og = xb_add(&bar[XB_TOP], 1u);
            const unsigned tg = og / nx;
            if (og + 1u == (tg + 1u) * nx) xb_add(&bar[XB_TOPGEN], 1u);
            else XB_SPIN(xb_ld(&bar[XB_TOPGEN]) == tg, bar);
            __builtin_amdgcn_fence(__ATOMIC_ACQUIRE, "agent");
            xb_add(&bar[XB_XGEN(b.x)], 1u);
            asm volatile("s_waitcnt vmcnt(0)" ::: "memory");
        } else {
            XB_SPIN(xb_ld(&bar[XB_XGEN(b.x)]) == gen, bar);
            __builtin_amdgcn_fence(__ATOMIC_ACQUIRE, "agent");
            asm volatile("s_waitcnt vmcnt(0)" ::: "memory");
        }
    }
    __syncthreads();
}

struct Args {
    const float* in[32];
    float* out;
    unsigned char* ws;
    int ph_lo, ph_hi;
};
enum { I_X = 0, I_C, I_CTX, I_CCTX, I_ADAW, I_ADAB, I_WIN, I_WAF, I_BAF, I_WAB, I_BAB, I_NORMG, I_CONVW, I_CONVB, I_FW1, I_FB1, I_FW2, I_FB2, I_FWOUT, I_FFREQ,
       I_BIASD, I_WOUT, I_LN1G, I_LN1B, I_RW, I_RB, I_EW1, I_EB1, I_EW2, I_EB2, I_LN2G, I_LN2B };


namespace gm {
constexpr int BM = 256, BK = 64, HALF = 128, HTB = HALF * BK * 2, STAGE_BYTES = 8 * HTB, KD = 1024, NT = KD / BK;
constexpr int ROWB = KD * 2;
__device__ __forceinline__ int lds_byte(int r, int c) { const int st = (r >> 4) * 2 + (c >> 5), rr = r & 15, cc = c & 31, ob = rr * 64 + cc * 2; return st * 1024 + (ob ^ (((ob >> 9) & 1) << 5)); }
__device__ __forceinline__ void stage_rc(int b, int& R, int& C) { const int st = b / 1024, sb = b % 1024, swz = sb ^ (((sb >> 9) & 1) << 5); R = (st >> 1) * 16 + swz / 64; C = (st & 1) * 32 + (swz % 64) / 2; }
__device__ __forceinline__ int perm32(int rho) { const int n = rho >> 4, i = rho & 15; return 8 * (i >> 2) + 4 * n + (i & 3); }

struct Unit {
    const char* A;
    const char* B;
    const int* list;
    int type, row0, col0, valid, aux;
};

template <bool GATHER, int GSHIFT>
__device__ __forceinline__ void a_offsets(const Unit& u, const int (&R)[2], const int (&Cb)[2], unsigned (&o)[2][2]) {
#pragma unroll
    for (int h = 0; h < 2; ++h)
#pragma unroll
        for (int i = 0; i < 2; ++i) {
            const int r = h * HALF + R[i];
            if (!GATHER) o[h][i] = (unsigned)(r * ROWB + Cb[i]);
            else { const int idx = u.list[r < u.valid ? r : 0]; o[h][i] = (unsigned)(idx >> GSHIFT) * (unsigned)ROWB + (unsigned)Cb[i]; }
        }
}

template <bool GATHER, int GSHIFT, class Sched, class Epi>
__device__ __forceinline__ void gemm_stream(LAS unsigned char* lds, const Sched& S, const Epi& E) {
    const int tid = threadIdx.x, wid = __builtin_amdgcn_readfirstlane(tid >> 6), lane = tid & 63, wr = wid >> 2, wc = wid & 3, fr = lane & 15, fq = lane >> 4;
    int R[2], Cb[2]; unsigned voffB[2];
#pragma unroll
    for (int i = 0; i < 2; ++i) { int r, c; stage_rc(tid * 16 + i * 8192, r, c); R[i] = r; Cb[i] = c * 2; const int rb = (r & ~31) + perm32(r & 31); voffB[i] = (unsigned)(rb * ROWB + c * 2); }
    const size_t kstep = (size_t)(BK * 2), hstep = (size_t)HALF * ROWB;
    const unsigned ldsw = (unsigned)wid * 1024u;
    const int aoff = lds_byte(wr * 64 + fr, fq * 8), boff = lds_byte(wc * 32 + fr, fq * 8);
#define GM_SA(b, h) (((b) * 2 + (h)) * HTB)
#define GM_SB(b, h) ((4 + (b) * 2 + (h)) * HTB)
#define GM_STAGE(bufoff, gbase, vo0, vo1) do { \
        __builtin_amdgcn_global_load_lds((const unsigned*)((const char*)(gbase) + (vo0)), (LAS unsigned*)(lds + (bufoff) + ldsw), 16, 0, 0); \
        __builtin_amdgcn_global_load_lds((const unsigned*)((const char*)(gbase) + (vo1)), (LAS unsigned*)(lds + (bufoff) + ldsw + 8192), 16, 0, 0); } while (0)
#define GM_LDA(dst, b, h) do { _Pragma("unroll") for (int m = 0; m < 4; ++m) _Pragma("unroll") for (int k = 0; k < 2; ++k) dst[m][k] = *(const LAS bf16x8*)(lds + GM_SA(b, h) + aoff + m * 2048 + k * 1024); } while (0)
#define GM_LDB(dst, b, h) do { _Pragma("unroll") for (int n = 0; n < 2; ++n) _Pragma("unroll") for (int k = 0; k < 2; ++k) dst[n][k] = *(const LAS bf16x8*)(lds + GM_SB(b, h) + boff + n * 2048 + k * 1024); } while (0)
#define GM_MMA(ai, bj, At, Bt) do { __builtin_amdgcn_s_setprio(1); _Pragma("unroll") for (int m = 0; m < 4; ++m) _Pragma("unroll") for (int n = 0; n < 2; ++n) _Pragma("unroll") for (int k = 0; k < 2; ++k) \
        acc[ai][bj][m][n] = __builtin_amdgcn_mfma_f32_16x16x32_bf16(Bt[n][k], At[m][k], acc[ai][bj][m][n], 0, 0, 0); __builtin_amdgcn_s_setprio(0); } while (0)
#define GM_WAIT_V(n) asm volatile("s_waitcnt vmcnt(" #n ")" ::: "memory")
#define GM_WAIT_L(n) asm volatile("s_waitcnt lgkmcnt(" #n ")" ::: "memory")
#define GM_BAR __builtin_amdgcn_s_barrier()
#define GM_SCHED __builtin_amdgcn_sched_barrier(0)
    Unit cur, nxt; int ui = 0;
    if (!S.next(0, cur)) return;
    f32x4 acc[2][2][4][2];
#pragma unroll
    for (int a = 0; a < 2; ++a)
#pragma unroll
        for (int b = 0; b < 2; ++b)
#pragma unroll
            for (int m = 0; m < 4; ++m)
#pragma unroll
                for (int n = 0; n < 2; ++n) acc[a][b][m][n] = (f32x4){0.f, 0.f, 0.f, 0.f};
    bf16x8 At[4][2], B0[2][2], B1[2][2];
    unsigned ca[2][2], na[2][2];
    a_offsets<GATHER, GSHIFT>(cur, R, Cb, ca);
    const char* cA = cur.A; const char* cB = cur.B;
    GM_STAGE(GM_SB(0, 0), cB, voffB[0], voffB[1]); GM_STAGE(GM_SA(0, 0), cA, ca[0][0], ca[0][1]); GM_STAGE(GM_SB(0, 1), cB + hstep, voffB[0], voffB[1]); GM_STAGE(GM_SA(0, 1), cA, ca[1][0], ca[1][1]);
    if (wr == 1) GM_BAR;
    GM_WAIT_V(4); GM_BAR;
    GM_STAGE(GM_SB(1, 0), cB + kstep, voffB[0], voffB[1]); GM_STAGE(GM_SA(1, 0), cA + kstep, ca[0][0], ca[0][1]); GM_STAGE(GM_SB(1, 1), cB + hstep + kstep, voffB[0], voffB[1]);
    GM_WAIT_V(6); GM_BAR;
    for (;;) {
        const bool has_next = S.next(ui + 1, nxt);
        if (has_next) a_offsets<GATHER, GSHIFT>(nxt, R, Cb, na);
        else {
#pragma unroll
            for (int h = 0; h < 2; ++h)
#pragma unroll
                for (int i = 0; i < 2; ++i) na[h][i] = ca[h][i];
        }
        const char* nA = has_next ? nxt.A : cA; const char* nB = has_next ? nxt.B : cB;
        for (int t = 0; t < NT; t += 2) {
            const bool last = (t == NT - 2);
            const char* a1 = cA + (size_t)(t + 1) * kstep;
            const char* a2 = last ? nA : cA + (size_t)(t + 2) * kstep; const char* b2 = last ? nB : cB + (size_t)(t + 2) * kstep;
            const char* a3 = a2 + kstep; const char* b3 = b2 + kstep;
            const unsigned x00 = last ? na[0][0] : ca[0][0], x01 = last ? na[0][1] : ca[0][1], x10 = last ? na[1][0] : ca[1][0], x11 = last ? na[1][1] : ca[1][1];
            GM_LDB(B0, 0, 0); GM_SCHED; GM_LDA(At, 0, 0); GM_STAGE(GM_SA(1, 1), a1, ca[1][0], ca[1][1]);
            GM_WAIT_L(8); GM_BAR; GM_WAIT_L(0); GM_MMA(0, 0, At, B0); GM_BAR; GM_SCHED;
            GM_LDB(B1, 0, 1); GM_STAGE(GM_SB(0, 0), b2, voffB[0], voffB[1]);
            GM_BAR; GM_WAIT_L(0); GM_MMA(0, 1, At, B1); GM_BAR;
            GM_LDA(At, 0, 1); GM_STAGE(GM_SA(0, 0), a2, x00, x01);
            GM_BAR; GM_WAIT_L(0); GM_MMA(1, 0, At, B0); GM_BAR; GM_SCHED;
            GM_STAGE(GM_SB(0, 1), b2 + hstep, voffB[0], voffB[1]);
            GM_WAIT_V(6); GM_BAR; GM_MMA(1, 1, At, B1); GM_BAR;
            GM_LDB(B0, 1, 0); GM_SCHED; GM_LDA(At, 1, 0); GM_STAGE(GM_SA(0, 1), a2, x10, x11);
            GM_WAIT_L(8); GM_BAR; GM_WAIT_L(0); GM_MMA(0, 0, At, B0); GM_BAR; GM_SCHED;
            GM_LDB(B1, 1, 1); GM_STAGE(GM_SB(1, 0), b3, voffB[0], voffB[1]);
            GM_BAR; GM_WAIT_L(0); GM_MMA(0, 1, At, B1); GM_BAR;
            GM_LDA(At, 1, 1); GM_STAGE(GM_SA(1, 0), a3, x00, x01);
            GM_BAR; GM_WAIT_L(0); GM_MMA(1, 0, At, B0); GM_BAR; GM_SCHED;
            GM_STAGE(GM_SB(1, 1), b3 + hstep, voffB[0], voffB[1]);
            GM_WAIT_V(6); GM_BAR; GM_MMA(1, 1, At, B1); GM_BAR;
        }
        E(acc, cur, wr, wc, fr, fq);
        if (!has_next) break;
#pragma unroll
        for (int a = 0; a < 2; ++a)
#pragma unroll
            for (int b = 0; b < 2; ++b)
#pragma unroll
                for (int m = 0; m < 4; ++m)
#pragma unroll
                    for (int n = 0; n < 2; ++n) acc[a][b][m][n] = (f32x4){0.f, 0.f, 0.f, 0.f};
        cur = nxt; cA = nA; cB = nB; ++ui;
#pragma unroll
        for (int h = 0; h < 2; ++h)
#pragma unroll
            for (int i = 0; i < 2; ++i) ca[h][i] = na[h][i];
    }
    GM_WAIT_V(0);
    if (wr == 0) GM_BAR;
    GM_BAR;
#undef GM_SA
#undef GM_SB
#undef GM_STAGE
#undef GM_LDA
#undef GM_LDB
#undef GM_MMA
#undef GM_WAIT_V
#undef GM_WAIT_L
#undef GM_BAR
#undef GM_SCHED
}

__device__ __forceinline__ u32x4 pack8(f32x4 a, f32x4 b) { u32x4 w; w.x = pk2(a[0], a[1]); w.y = pk2(a[2], a[3]); w.z = pk2(b[0], b[1]); w.w = pk2(b[2], b[3]); return w; }

struct SchedIn {
    unsigned char* ws; int G, c;
    __device__ __forceinline__ bool next(int i, Unit& u) const {
        int L = i * G + c;
        u.list = nullptr; u.valid = 256; u.aux = 0;
        if (L < 768) {
            const int pa = L % 6, pb = L / 6;
            u.A = (const char*)(ws + WS_BTIN) + (size_t)(2048 + 256 * pa) * ROWB; u.B = (const char*)(ws + WS_H) + (size_t)(256 * pb) * ROWB;
            u.type = 2; u.row0 = 256 * pa; u.col0 = 256 * pb; return true;
        }
        L -= 768;
        if (L < 1024) {
            const int pm = L >> 3, pn = ((L & 7) + (L >> 8)) & 7;
            u.A = (const char*)(ws + WS_H) + (size_t)(256 * pm) * ROWB; u.B = (const char*)(ws + WS_BTIN) + (size_t)(256 * pn) * ROWB;
            u.type = pn < 6 ? 0 : 1; u.row0 = 256 * pm; u.col0 = pn; return true;
        }
        L -= 1024;
        if (L < 20) {
            const int pm = L / 5, j = L % 5, pn = j == 0 ? 1 : (j == 1 ? 2 : (j == 2 ? 3 : (j == 3 ? 6 : 7)));
            u.A = (const char*)(ws + WS_H) + (size_t)(T + 256 * pm) * ROWB; u.B = (const char*)(ws + WS_BTIN) + (size_t)(256 * pn) * ROWB;
            u.type = pn < 6 ? 0 : 1; u.row0 = T + 256 * pm; u.col0 = pn; return true;
        }
        return false;
    }
};
struct EpiIn {
    unsigned char* ws; const float* baf; const float* bab;
    __device__ __forceinline__ void operator()(const f32x4 (&acc)[2][2][4][2], const Unit& u, int wr, int wc, int fr, int fq) const {
        const int rl = wr * 64 + fr, cl = wc * 32 + 8 * fq;
        if (u.type == 0) {
            const int pn = u.col0;
            bf16_t* dst; int ld, cb;
            if (pn == 0) { dst = (bf16_t*)(ws + WS_Q); ld = 256; cb = 0; }
            else if (pn == 1) { dst = (bf16_t*)(ws + WS_K); ld = 256; cb = 0; }
            else if (pn < 4) { dst = (bf16_t*)(ws + WS_V); ld = 512; cb = (pn - 2) * 256; }
            else { dst = (bf16_t*)(ws + WS_G); ld = 512; cb = (pn - 4) * 256; }
#pragma unroll
            for (int ai = 0; ai < 2; ++ai)
#pragma unroll
                for (int m = 0; m < 4; ++m) { bf16_t* rowp = dst + (size_t)(u.row0 + rl + ai * 128 + m * 16) * ld + cb + cl;
#pragma unroll
                    for (int bj = 0; bj < 2; ++bj) *(u32x4*)(rowp + bj * 128) = pack8(acc[ai][bj][m][0], acc[ai][bj][m][1]); }
        } else if (u.type == 1) {
            float* dst = (float*)(ws + (u.col0 == 6 ? WS_GF : WS_GB)); const float* ba = (u.col0 == 6) ? baf : bab;
            f32x4 bv[2][2];
#pragma unroll
            for (int bj = 0; bj < 2; ++bj)
#pragma unroll
                for (int n = 0; n < 2; ++n) bv[bj][n] = *(const f32x4*)(ba + cl + bj * 128 + 4 * n);
#pragma unroll
            for (int ai = 0; ai < 2; ++ai)
#pragma unroll
                for (int m = 0; m < 4; ++m) { float* rowp = dst + (size_t)(u.row0 + rl + ai * 128 + m * 16) * 256 + cl;
#pragma unroll
                    for (int bj = 0; bj < 2; ++bj)
#pragma unroll
                        for (int n = 0; n < 2; ++n) { f32x4 z = acc[ai][bj][m][n] + bv[bj][n], o;
#pragma unroll
                            for (int j = 0; j < 4; ++j) o[j] = log_sigmoid_f(z[j]) * (1.f / 16.f);
                            *(f32x4*)(rowp + bj * 128 + 4 * n) = o; } }
        } else {
            const int b = u.col0 >> 13, l0 = u.col0 & 8191;
            bf16_t* dst = (bf16_t*)(ws + WS_UT) + ((size_t)b * HYC) * SEQ + l0 + cl;
#pragma unroll
            for (int ai = 0; ai < 2; ++ai)
#pragma unroll
                for (int m = 0; m < 4; ++m) { bf16_t* rowp = dst + (size_t)(u.row0 + rl + ai * 128 + m * 16) * SEQ;
#pragma unroll
                    for (int bj = 0; bj < 2; ++bj) *(u32x4*)(rowp + bj * 128) = pack8(acc[ai][bj][m][0], acc[ai][bj][m][1]); }
        }
    }
};

struct SchedOut {
    unsigned char* ws; int G, c;
    __device__ __forceinline__ bool next(int i, Unit& u) const {
        const int L = i * G + c; if (L >= 512) return false;
        const int pm = L >> 2, pn = L & 3;
        u.A = (const char*)(ws + WS_MIX) + (size_t)(256 * pm) * ROWB; u.B = (const char*)(ws + WS_BTOUT) + (size_t)(256 * pn) * ROWB;
        u.list = nullptr; u.valid = 256; u.aux = 0; u.type = 3; u.row0 = 256 * pm; u.col0 = 256 * pn; return true;
    }
};
struct EpiOut {
    unsigned char* ws;
    __device__ __forceinline__ void operator()(const f32x4 (&acc)[2][2][4][2], const Unit& u, int wr, int wc, int fr, int fq) const {
        const int rl = wr * 64 + fr, cl = u.col0 + wc * 32 + 8 * fq;
        const int b = u.row0 >> 13;
        const float* gate = (const float*)(ws + WS_MOD) + b * 6144 + 2 * 1024;
        bf16_t* fg = (bf16_t*)(ws + WS_FG);
        f32x4 gv[2][2];
#pragma unroll
        for (int bj = 0; bj < 2; ++bj)
#pragma unroll
            for (int n = 0; n < 2; ++n) gv[bj][n] = *(const f32x4*)(gate + cl + bj * 128 + 4 * n);
#pragma unroll
        for (int ai = 0; ai < 2; ++ai)
#pragma unroll
            for (int m = 0; m < 4; ++m) { bf16_t* rowp = fg + (size_t)(u.row0 + rl + ai * 128 + m * 16) * 1024 + cl;
#pragma unroll
                for (int bj = 0; bj < 2; ++bj) *(u32x4*)(rowp + bj * 128) = pack8(gv[bj][0] * acc[ai][bj][m][0], gv[bj][1] * acc[ai][bj][m][1]); }
    }
};

constexpr int LDS_TAB = STAGE_BYTES;
template <int WHICH>
struct SchedMoe {
    unsigned char* ws; const LAS int* tab; int G, c;
    __device__ __forceinline__ bool next(int i, Unit& u) const {
        constexpr int NCT_ = WHICH == 1 ? 8 : 4;
        const int L = i * G + c; const int nrt = tab[32];
        if (L >= nrt * NCT_) return false;
        const int rt = L / NCT_, ct = L % NCT_;
        const int info = tab[64 + rt], e = info & 255, r0 = (info >> 8) * 256;
        const int cnt = tab[e];
        u.valid = (cnt - r0) < 256 ? (cnt - r0) : 256;
        u.list = (const int*)(ws + WS_LIST) + (size_t)e * CAP + r0;
        u.A = (WHICH == 1) ? (const char*)(ws + WS_H2) : (const char*)(ws + WS_ACT) + (size_t)(256 * rt) * ROWB;
        u.B = (const char*)(ws + (WHICH == 1 ? WS_W1T : WS_W2T)) + ((size_t)e * (WHICH == 1 ? 2048 : 1024) + 256 * ct) * ROWB;
        u.type = 3 + WHICH; u.row0 = 256 * rt; u.col0 = ct; u.aux = e; return true;
    }
};
__device__ __forceinline__ float swiglu_f(float glu, float lin) {
    glu = fminf(glu, 7.f); lin = fminf(fmaxf(lin, -7.f), 7.f);
    return glu * (1.f / (1.f + __expf(-1.702f * glu))) * (lin + 1.f);
}
struct EpiMoe1 {
    unsigned char* ws;
    __device__ __forceinline__ void operator()(const f32x4 (&acc)[2][2][4][2], const Unit& u, int wr, int wc, int fr, int fq) const {
        const int rl = wr * 64 + fr, cl = wc * 32 + 8 * fq, e = u.aux, ct = u.col0;
        const float* b1 = (const float*)(ws + WS_B1R) + (size_t)e * 2048 + 256 * ct + cl;
        bf16_t* act = (bf16_t*)(ws + WS_ACT) + (size_t)u.row0 * 1024 + 128 * ct + cl;
        f32x4 bg[2], bl[2];
#pragma unroll
        for (int n = 0; n < 2; ++n) { bg[n] = *(const f32x4*)(b1 + 4 * n); bl[n] = *(const f32x4*)(b1 + 128 + 4 * n); }
#pragma unroll
        for (int ai = 0; ai < 2; ++ai)
#pragma unroll
            for (int m = 0; m < 4; ++m) { const int r = rl + ai * 128 + m * 16;
                f32x4 o[2];
#pragma unroll
                for (int n = 0; n < 2; ++n) { const f32x4 gl = acc[ai][0][m][n] + bg[n], li = acc[ai][1][m][n] + bl[n];
#pragma unroll
                    for (int j = 0; j < 4; ++j) o[n][j] = swiglu_f(gl[j], li[j]); }
                *(u32x4*)(act + (size_t)r * 1024) = pack8(o[0], o[1]); }
    }
};
struct EpiMoe2 {
    unsigned char* ws; const float* b2;
    __device__ __forceinline__ void operator()(const f32x4 (&acc)[2][2][4][2], const Unit& u, int wr, int wc, int fr, int fq) const {
        const int rl = wr * 64 + fr, cl = wc * 32 + 8 * fq, e = u.aux, ct = u.col0;
        const float* bb = b2 + (size_t)e * 1024 + 256 * ct + cl;
        bf16_t* slots = (bf16_t*)(ws + WS_SLOTS) + (size_t)u.row0 * 1024 + 256 * ct + cl;
        f32x4 bv[2][2];
#pragma unroll
        for (int bj = 0; bj < 2; ++bj)
#pragma unroll
            for (int n = 0; n < 2; ++n) bv[bj][n] = *(const f32x4*)(bb + bj * 128 + 4 * n);
#pragma unroll
        for (int ai = 0; ai < 2; ++ai)
#pragma unroll
            for (int m = 0; m < 4; ++m) { const int r = rl + ai * 128 + m * 16;
#pragma unroll
                for (int bj = 0; bj < 2; ++bj)
                    *(u32x4*)(slots + (size_t)r * 1024 + bj * 128) = pack8(acc[ai][bj][m][0] + bv[bj][0], acc[ai][bj][m][1] + bv[bj][1]); }
    }
};
}

namespace hy {
__device__ __forceinline__ int phys(int n) { return n + (n >> 4) + ((n >> 9) << 4); }
constexpr int XSIZE = 16384 + 1024 + 512;

__device__ __forceinline__ float tw_c(int i) {
    constexpr float t[16] = {1.f, 0.98078528040323043f, 0.92387953251128674f, 0.83146961230254524f, 0.70710678118654752f, 0.55557023301960218f, 0.38268343236508977f, 0.19509032201612825f,
                             0.f, -0.19509032201612825f, -0.38268343236508977f, -0.55557023301960218f, -0.70710678118654752f, -0.83146961230254524f, -0.92387953251128674f, -0.98078528040323043f};
    return t[i];
}
__device__ __forceinline__ float tw_s(int i) {
    constexpr float t[16] = {0.f, 0.19509032201612825f, 0.38268343236508977f, 0.55557023301960218f, 0.70710678118654752f, 0.83146961230254524f, 0.92387953251128674f, 0.98078528040323043f,
                             1.f, 0.98078528040323043f, 0.92387953251128674f, 0.83146961230254524f, 0.70710678118654752f, 0.55557023301960218f, 0.38268343236508977f, 0.19509032201612825f};
    return t[i];
}
__host__ __device__ constexpr int brev(int p, int bits) { int r = 0; for (int i = 0; i < bits; ++i) r |= ((p >> i) & 1) << (bits - 1 - i); return r; }

template <int R, bool INV>
__device__ __forceinline__ void fft_reg(f32x2 (&v)[R]) {
#pragma unroll
    for (int s = R / 2; s >= 1; s >>= 1) {
#pragma unroll
        for (int g = 0; g < R; g += 2 * s) {
#pragma unroll
            for (int k = 0; k < s; ++k) {
                const f32x2 a = v[g + k], b = v[g + k + s];
                v[g + k] = a + b;
                const f32x2 t = a - b;
                const int ti = k * (16 / s);
                f32x2 o;
                if (ti == 0) o = t;
                else if (ti == 8) { if (INV) { o[0] = -t[1]; o[1] = t[0]; } else { o[0] = t[1]; o[1] = -t[0]; } }
                else { const float c = tw_c(ti), sn = tw_s(ti);
                    if (INV) { o[0] = t[0] * c - t[1] * sn; o[1] = t[1] * c + t[0] * sn; }
                    else     { o[0] = t[0] * c + t[1] * sn; o[1] = t[1] * c - t[0] * sn; } }
                v[g + k + s] = o;
            }
        }
    }
}
__device__ __forceinline__ f32x2 cmul(f32x2 a, f32x2 b) { f32x2 r; r[0] = a[0] * b[0] - a[1] * b[1]; r[1] = a[0] * b[1] + a[1] * b[0]; return r; }

template <int M, bool ZPAD = false>
__device__ __forceinline__ void pass_fwd32(LAS f32x2* X, int tid) {
    int j = (M == 512) ? tid : (tid & 15);
    asm volatile("" : "+v"(j));
    const int p0 = (M == 512) ? (tid + (tid >> 4)) : (560 * (tid >> 4) + (tid & 15));
    constexpr int PS = (M == 512) ? 560 : 17;
    f32x2 v[32];
#pragma unroll
    for (int r = 0; r < 32; ++r) { if (ZPAD && r >= 16) v[r] = (f32x2){0.f, 0.f}; else v[r] = X[p0 + PS * r]; }
    fft_reg<32, false>(v);
    float sn, cs; sincospif(-2.f * (float)j / (float)(32 * M), &sn, &cs);
    const f32x2 w1 = {cs, sn}; f32x2 w = w1;
    X[p0] = v[0];
#pragma unroll
    for (int rp = 1; rp < 32; ++rp) { X[p0 + PS * rp] = cmul(v[brev(rp, 5)], w); w = cmul(w, w1); }
}
template <int M, bool HALF = false>
__device__ __forceinline__ void pass_inv32(LAS f32x2* X, int tid) {
    int j = (M == 512) ? tid : (tid & 15);
    asm volatile("" : "+v"(j));
    const int p0 = (M == 512) ? (tid + (tid >> 4)) : (560 * (tid >> 4) + (tid & 15));
    constexpr int PS = (M == 512) ? 560 : 17;
    float sn, cs; sincospif(2.f * (float)j / (float)(32 * M), &sn, &cs);
    const f32x2 w1 = {cs, sn}; f32x2 w = w1;
    f32x2 v[32];
    v[0] = X[p0];
#pragma unroll
    for (int rp = 1; rp < 32; ++rp) { v[rp] = cmul(X[p0 + PS * rp], w); w = cmul(w, w1); }
    fft_reg<32, true>(v);
#pragma unroll
    for (int p = 0; p < 32; ++p) { if (!HALF || brev(p, 5) < 16) X[p0 + PS * brev(p, 5)] = v[p]; }
}
__device__ __forceinline__ void pass_c_store(const LAS f32x2* X, f32x2* Hs, int tid, float scale) {
#pragma unroll
    for (int u = 0; u < 2; ++u) { const int blk = tid + 512 * u, p0 = 17 * blk + 16 * (blk >> 5);
        f32x2 v[16];
#pragma unroll
        for (int r = 0; r < 16; ++r) v[r] = X[p0 + r];
        fft_reg<16, false>(v);
#pragma unroll
        for (int q = 0; q < 8; ++q) { const f32x2 x0 = v[brev(2 * q, 4)] * scale, x1 = v[brev(2 * q + 1, 4)] * scale;
            *(f32x4*)(Hs + 16 * blk + 2 * q) = (f32x4){x0[0], x0[1], x1[0], x1[1]}; } }
}
__device__ __forceinline__ void pass_c_mul_inv(LAS f32x2* X, const f32x2* Hs, int tid) {
#pragma unroll
    for (int u = 0; u < 2; ++u) { const int blk = tid + 512 * u, p0 = 17 * blk + 16 * (blk >> 5);
        f32x2 v[16], w[16];
#pragma unroll
        for (int r = 0; r < 16; ++r) v[r] = X[p0 + r];
        f32x4 hh[8];
#pragma unroll
        for (int q = 0; q < 8; ++q) hh[q] = *(const f32x4*)(Hs + 16 * blk + 2 * q);
        fft_reg<16, false>(v);
#pragma unroll
        for (int q = 0; q < 8; ++q) { w[2 * q] = cmul(v[brev(2 * q, 4)], (f32x2){hh[q][0], hh[q][1]}); w[2 * q + 1] = cmul(v[brev(2 * q + 1, 4)], (f32x2){hh[q][2], hh[q][3]}); }
        fft_reg<16, true>(w);
#pragma unroll
        for (int p = 0; p < 16; ++p) X[p0 + brev(p, 4)] = w[p]; }
}
__device__ __forceinline__ void load16(const bf16_t* u, float (&e)[16]) {
    const u32x4 a = *(const u32x4*)u, b = *(const u32x4*)(u + 8);
    e[0] = bflo(a.x); e[1] = bfhi(a.x); e[2] = bflo(a.y); e[3] = bfhi(a.y); e[4] = bflo(a.z); e[5] = bfhi(a.z); e[6] = bflo(a.w); e[7] = bfhi(a.w);
    e[8] = bflo(b.x); e[9] = bfhi(b.x); e[10] = bflo(b.y); e[11] = bfhi(b.y); e[12] = bflo(b.z); e[13] = bfhi(b.z); e[14] = bflo(b.w); e[15] = bfhi(b.w);
}
__device__ __forceinline__ void sconv16(const bf16_t* u, int tid, float w0, float w1, float w2, float bias, float (&o)[16]) {
    float e[16]; load16(u + 16 * tid, e);
    float lf = __shfl_up(e[15], 1), rt = __shfl_down(e[0], 1);
    if ((tid & 3) == 0) lf = 0.f;
    if ((tid & 3) == 3) rt = 0.f;
    o[0] = w0 * lf + w1 * e[0] + w2 * e[1] + bias;
#pragma unroll
    for (int i = 1; i < 15; ++i) o[i] = w0 * e[i - 1] + w1 * e[i] + w2 * e[i + 1] + bias;
    o[15] = w0 * e[14] + w1 * e[15] + w2 * rt + bias;
}

__device__ __forceinline__ void channel(const Args& a, LAS unsigned char* lds, int c, unsigned char* scratch) {
    const int tid = threadIdx.x;
    LAS f32x2* X = (LAS f32x2*)lds;
    f32x2* Hs = (f32x2*)scratch;
    const float* HF = (const float*)(a.ws + WS_HF);
    const int pc = 17 * tid + 16 * (tid >> 5);
    __syncthreads();
#pragma unroll 1
    for (int o = 0; o < 2; ++o) {
        const f32x4* hf = (const f32x4*)(HF + ((size_t)(2 * o) * HYW + c) * SEQ + 16 * tid); const f32x4* hb = (const f32x4*)(HF + ((size_t)(2 * o + 1) * HYW + c) * SEQ + 16 * tid);
#pragma unroll
        for (int q = 0; q < 4; ++q) { const f32x4 f = hf[q], b = hb[q];
#pragma unroll
            for (int e = 0; e < 4; ++e) { const int i = 4 * q + e, t = 16 * tid + i;
                X[pc + i] = (f32x2){f[e], 0.f};
                if (t >= 1) X[phys(FFTN - t)] = (f32x2){b[e], 0.f}; } }
        if (tid == 0) X[phys(SEQ)] = (f32x2){0.f, 0.f};
        __syncthreads();
        pass_fwd32<512>(X, tid); __syncthreads(); pass_fwd32<16>(X, tid); __syncthreads(); pass_c_store(X, Hs + (size_t)o * FFTN, tid, 1.f / (float)FFTN); __syncthreads();
    }
    const float* cw = a.in[I_CONVW]; const float* cbv = a.in[I_CONVB]; const float* dbias = a.in[I_BIASD];
    const float d1 = dbias[c], d2 = dbias[HYW + c];
    float wv[3][3], bv[3];
#pragma unroll
    for (int s = 0; s < 3; ++s) { bv[s] = cbv[s * HYW + c];
#pragma unroll
        for (int i = 0; i < 3; ++i) wv[s][i] = cw[i * HYC + s * HYW + c]; }
    const bf16_t* UT = (const bf16_t*)(a.ws + WS_UT);
    bf16_t* YT = (bf16_t*)(a.ws + WS_YHYT);
#pragma unroll 1
    for (int bp = 0; bp < 2; ++bp) {
        const bf16_t* u0 = UT + ((size_t)(2 * bp) * HYC + c) * SEQ; const bf16_t* u1 = UT + ((size_t)(2 * bp + 1) * HYC + c) * SEQ;
        float z0[16], z1[16];
        {
            float v0[16], v1[16]; sconv16(u0, tid, wv[0][0], wv[0][1], wv[0][2], bv[0], v0); sconv16(u1, tid, wv[0][0], wv[0][1], wv[0][2], bv[0], v1);
#pragma unroll
            for (int i = 0; i < 16; ++i) X[pc + i] = (f32x2){v0[i], v1[i]};
        }
        __syncthreads();
        pass_fwd32<512, true>(X, tid); __syncthreads(); pass_fwd32<16>(X, tid); __syncthreads(); pass_c_mul_inv(X, Hs, tid); __syncthreads(); pass_inv32<16>(X, tid); __syncthreads(); pass_inv32<512, true>(X, tid); __syncthreads();
        {
            float v0[16], v1[16], x0[16], x1[16];
            sconv16(u0, tid, wv[0][0], wv[0][1], wv[0][2], bv[0], v0); sconv16(u1, tid, wv[0][0], wv[0][1], wv[0][2], bv[0], v1);
            sconv16(u0 + (size_t)HYW * SEQ, tid, wv[1][0], wv[1][1], wv[1][2], bv[1], x0); sconv16(u1 + (size_t)HYW * SEQ, tid, wv[1][0], wv[1][1], wv[1][2], bv[1], x1);
#pragma unroll
            for (int i = 0; i < 16; ++i) { const f32x2 y1 = X[pc + i]; z0[i] = x0[i] * (y1[0] + d1 * v0[i]); z1[i] = x1[i] * (y1[1] + d1 * v1[i]); X[pc + i] = (f32x2){z0[i], z1[i]}; }
        }
        __syncthreads();
        pass_fwd32<512, true>(X, tid); __syncthreads(); pass_fwd32<16>(X, tid); __syncthreads(); pass_c_mul_inv(X, Hs + FFTN, tid); __syncthreads(); pass_inv32<16>(X, tid); __syncthreads(); pass_inv32<512, true>(X, tid); __syncthreads();
        {
            float x0[16], x1[16];
            sconv16(u0 + (size_t)2 * HYW * SEQ, tid, wv[2][0], wv[2][1], wv[2][2], bv[2], x0); sconv16(u1 + (size_t)2 * HYW * SEQ, tid, wv[2][0], wv[2][1], wv[2][2], bv[2], x1);
            unsigned w0[8], w1[8];
#pragma unroll
            for (int i = 0; i < 8; ++i) { const f32x2 ya = X[pc + 2 * i], yb = X[pc + 2 * i + 1];
                w0[i] = pk2(x0[2 * i] * (ya[0] + d2 * z0[2 * i]), x0[2 * i + 1] * (yb[0] + d2 * z0[2 * i + 1]));
                w1[i] = pk2(x1[2 * i] * (ya[1] + d2 * z1[2 * i]), x1[2 * i + 1] * (yb[1] + d2 * z1[2 * i + 1])); }
            u32x4* y0p = (u32x4*)(YT + ((size_t)(2 * bp) * HYW + c) * SEQ + 16 * tid); u32x4* y1p = (u32x4*)(YT + ((size_t)(2 * bp + 1) * HYW + c) * SEQ + 16 * tid);
            y0p[0] = (u32x4){w0[0], w0[1], w0[2], w0[3]}; y0p[1] = (u32x4){w0[4], w0[5], w0[6], w0[7]};
            y1p[0] = (u32x4){w1[0], w1[1], w1[2], w1[3]}; y1p[1] = (u32x4){w1[4], w1[5], w1[6], w1[7]};
        }
        __syncthreads();
    }
}

__device__ __forceinline__ void filter_item(const Args& a, int item, int lane) {
    const int ct = item & 127, tc = item >> 7;
    const float* hid2 = (const float*)(a.ws + WS_HID2); const float* wout = a.in[I_FWOUT]; float* HF = (float*)(a.ws + WS_HF);
    const int col = 16 * ct + (lane & 15), kq = lane >> 4, cch = col & 511;
    float bf[16];
#pragma unroll
    for (int s = 0; s < 16; ++s) bf[s] = wout[(size_t)(16 * kq + s) * 2048 + col];
    const float dlt = fabsf(-3.0701134573253945f + (float)cch * ((-15.350567286626973f + 3.0701134573253945f) / 511.f));
#pragma unroll 2
    for (int tt = 0; tt < 32; ++tt) { const int t0 = 512 * tc + 16 * tt;
        const f32x4* ar = (const f32x4*)(hid2 + (size_t)(t0 + (lane & 15)) * 64 + 16 * kq);
        const f32x4 a0 = ar[0], a1 = ar[1], a2 = ar[2], a3 = ar[3];
        f32x4 acc = {0.f, 0.f, 0.f, 0.f};
#pragma unroll
        for (int e = 0; e < 4; ++e) { acc = __builtin_amdgcn_mfma_f32_16x16x4f32(a0[e], bf[e], acc, 0, 0, 0); }
#pragma unroll
        for (int e = 0; e < 4; ++e) { acc = __builtin_amdgcn_mfma_f32_16x16x4f32(a1[e], bf[4 + e], acc, 0, 0, 0); }
#pragma unroll
        for (int e = 0; e < 4; ++e) { acc = __builtin_amdgcn_mfma_f32_16x16x4f32(a2[e], bf[8 + e], acc, 0, 0, 0); }
#pragma unroll
        for (int e = 0; e < 4; ++e) { acc = __builtin_amdgcn_mfma_f32_16x16x4f32(a3[e], bf[12 + e], acc, 0, 0, 0); }
        f32x4 o;
#pragma unroll
        for (int r = 0; r < 4; ++r) o[r] = acc[r] * __expf(-((float)(t0 + 4 * kq + r) / (float)(SEQ - 1)) * dlt);
        *(f32x4*)(HF + (size_t)col * SEQ + t0 + 4 * kq) = o; }
}

__device__ __forceinline__ void transpose_item(const Args& a, int item, int lane) {
    const int lt = item & 127, ct = (item >> 7) & 7, b = item >> 10;
    const bf16_t* src = (const bf16_t*)(a.ws + WS_YHYT) + ((size_t)b * HYW + 64 * ct) * SEQ + 64 * lt + lane;
    bf16_t* dst = (bf16_t*)(a.ws + WS_MIX) + ((size_t)b * SEQ + 64 * lt + lane) * 1024 + 512 + 64 * ct;
#pragma unroll
    for (int q = 0; q < 8; ++q) { unsigned w[4];
#pragma unroll
        for (int e = 0; e < 4; ++e) { const unsigned lo = src[(size_t)(8 * q + 2 * e) * SEQ], hi = src[(size_t)(8 * q + 2 * e + 1) * SEQ]; w[e] = lo | (hi << 16); }
        *(u32x4*)(dst + 8 * q) = (u32x4){w[0], w[1], w[2], w[3]}; }
}
}

__device__ __forceinline__ void p0_mod_and_filter(const Args& a, LAS unsigned char* lds) {
    const int tid = threadIdx.x, lane = tid & 63, wave = tid >> 6;
    const float* c = a.in[I_C]; const float* cctx = a.in[I_CCTX]; const float* adaw = a.in[I_ADAW]; const float* adab = a.in[I_ADAB];
    float* mod = (float*)(a.ws + WS_MOD);
    LAS float* sl = (LAS float*)lds;
    LAS float* pt = (LAS float*)lds + 5 * 1024;
    for (int i = tid; i < 5 * 1024; i += NTHREADS) { const int r = i >> 10, k = i & 1023; sl[i] = silu_f(r < 4 ? c[r * 1024 + k] : cctx[k]); }
    for (int it = blockIdx.x; it < 256; it += gridDim.x) {
        __syncthreads();
        if (tid < 504) {
            const int col = tid % 24, ks = tid / 24, n = it * 24 + col, kbeg = ks * 49, kend = (kbeg + 49 < 1024) ? kbeg + 49 : 1024;
            float acc[5] = {0.f, 0.f, 0.f, 0.f, 0.f};
#pragma unroll 7
            for (int k = kbeg; k < kend; ++k) { const float w = adaw[(size_t)k * 6144 + n];
#pragma unroll
                for (int r = 0; r < 5; ++r) acc[r] += sl[r * 1024 + k] * w; }
#pragma unroll
            for (int r = 0; r < 5; ++r) pt[(ks * 5 + r) * 24 + col] = acc[r];
        }
        __syncthreads();
        if (tid < 120) { const int r = tid / 24, col = tid % 24, n = it * 24 + col; float s = adab[n];
            for (int ks = 0; ks < 21; ++ks) s += pt[(ks * 5 + r) * 24 + col];
            mod[r * 6144 + n] = s; }
    }
    __syncthreads();
    const float* w1 = a.in[I_FW1]; const float* b1 = a.in[I_FB1]; const float* w2 = a.in[I_FW2]; const float* b2 = a.in[I_FB2]; const float* fq = a.in[I_FFREQ];
    float* hid2 = (float*)(a.ws + WS_HID2);
    LAS float* zs = (LAS float*)lds + 8192 + wave * 128;
    const float frq = fq[lane], bb1 = b1[lane], bb2 = b2[lane];
    for (int t = (blockIdx.x * NWAVES + wave); t < SEQ; t += gridDim.x * NWAVES) {
        float z = 0.f;
        if (lane == 0) z = (float)t / (float)(SEQ - 1);
        else if (lane < 33) { const int i = (lane - 1) & 15; const float f = 1e-4f + (float)i * ((15.f - 1e-4f) / 15.f);
            const float ang = (6.283185307179586f * (float)t / (float)SEQ) * f; z = (lane < 17) ? cosf(ang) : -sinf(ang); }
        if (lane < 33) zs[lane] = z;
        __builtin_amdgcn_wave_barrier(); asm volatile("s_waitcnt lgkmcnt(0)" ::: "memory");
        float s = bb1;
#pragma unroll
        for (int e = 0; e < 33; ++e) s += zs[e] * w1[e * 64 + lane];
        const float h1 = sinf(frq * s);
        zs[64 + lane] = h1;
        __builtin_amdgcn_wave_barrier(); asm volatile("s_waitcnt lgkmcnt(0)" ::: "memory");
        float s2 = bb2;
#pragma unroll 16
        for (int g = 0; g < 64; ++g) s2 += zs[64 + g] * w2[g * 64 + lane];
        hid2[(size_t)t * 64 + lane] = sinf(frq * s2);
        __builtin_amdgcn_wave_barrier(); asm volatile("s_waitcnt lgkmcnt(0)" ::: "memory");
    }
}

__device__ __forceinline__ void tr_item(const float* W, int ldw, int k0, int c0, int cstride, float scale, bf16_t* dstrow0, LAS float* scr, int lane) {
#pragma unroll 8
    for (int i = 0; i < 32; ++i) { const int kk = 2 * i + (lane >> 5); scr[kk * 33 + (lane & 31)] = W[(size_t)(k0 + kk) * ldw + c0 + (lane & 31) * cstride] * scale; }
    asm volatile("s_waitcnt lgkmcnt(0)" ::: "memory"); __builtin_amdgcn_wave_barrier();
    const int c = lane & 7;
#pragma unroll
    for (int j = 0; j < 4; ++j) { const int n = (lane >> 3) + 8 * j; const LAS float* s = scr + (8 * c) * 33 + n;
        u32x4 o; o.x = pk2(s[0 * 33], s[1 * 33]); o.y = pk2(s[2 * 33], s[3 * 33]); o.z = pk2(s[4 * 33], s[5 * 33]); o.w = pk2(s[6 * 33], s[7 * 33]);
        *(u32x4*)(dstrow0 + (size_t)n * 1024 + k0 + 8 * c) = o; }
    asm volatile("s_waitcnt lgkmcnt(0)" ::: "memory"); __builtin_amdgcn_wave_barrier();
}
__device__ __forceinline__ void fold_item(const float* win, const float* wa, int dir, int k0, int j0, bf16_t* dstrow0, LAS float* scr, int lane) {
#pragma unroll 4
    for (int i = 0; i < 32; ++i) { const int kk = 2 * i + (lane >> 5); const float* wr = win + (size_t)(k0 + kk) * INW + 1536 + 16 * dir; float s = 0.f;
#pragma unroll
        for (int r = 0; r < 16; ++r) s += wr[r] * wa[r * 256 + j0 + (lane & 31)];
        scr[kk * 33 + (lane & 31)] = s; }
    asm volatile("s_waitcnt lgkmcnt(0)" ::: "memory"); __builtin_amdgcn_wave_barrier();
    const int c = lane & 7;
#pragma unroll
    for (int j = 0; j < 4; ++j) { const int n = (lane >> 3) + 8 * j; const LAS float* s = scr + (8 * c) * 33 + n;
        u32x4 o; o.x = pk2(s[0 * 33], s[1 * 33]); o.y = pk2(s[2 * 33], s[3 * 33]); o.z = pk2(s[4 * 33], s[5 * 33]); o.w = pk2(s[6 * 33], s[7 * 33]);
        *(u32x4*)(dstrow0 + (size_t)n * 1024 + k0 + 8 * c) = o; }
    asm volatile("s_waitcnt lgkmcnt(0)" ::: "memory"); __builtin_amdgcn_wave_barrier();
}
__device__ __forceinline__ void ln_mod_row(const float* xrow, const float* shift, const float* scale, bf16_t* orow, int lane) {
    const f32x4* xr = (const f32x4*)xrow + lane;
    f32x4 v[4]; float s = 0.f;
#pragma unroll
    for (int j = 0; j < 4; ++j) { v[j] = xr[64 * j]; s += (v[j][0] + v[j][1]) + (v[j][2] + v[j][3]); }
    const float mean = wave_sum(s) * (1.f / D); float s2 = 0.f;
#pragma unroll
    for (int j = 0; j < 4; ++j) { v[j] = v[j] - mean; s2 += (v[j][0] * v[j][0] + v[j][1] * v[j][1]) + (v[j][2] * v[j][2] + v[j][3] * v[j][3]); }
    const float rstd = 1.f / sqrtf(wave_sum(s2) * (1.f / D) + LN_EPS);
    u32x2* o8 = (u32x2*)orow + lane;
#pragma unroll
    for (int j = 0; j < 4; ++j) { const f32x4 sh = ((const f32x4*)shift)[64 * j + lane], sc = ((const f32x4*)scale)[64 * j + lane];
        const f32x4 y = v[j] * rstd * (sc + 1.f) + sh;
        u32x2 w; w.x = pk2(y[0], y[1]); w.y = pk2(y[2], y[3]); o8[64 * j] = w; }
}
__device__ __forceinline__ void p1_prep(const Args& a, LAS unsigned char* lds) {
    const int tid = threadIdx.x, lane = tid & 63, wave = tid >> 6;
    LAS float* scr = (LAS float*)(lds + wave * 16384);
    const int gw = blockIdx.x * NWAVES + wave, NGW = gridDim.x * NWAVES;
    const float* win = a.in[I_WIN];
    bf16_t* btin = (bf16_t*)(a.ws + WS_BTIN); bf16_t* btout = (bf16_t*)(a.ws + WS_BTOUT); bf16_t* w1t = (bf16_t*)(a.ws + WS_W1T); bf16_t* w2t = (bf16_t*)(a.ws + WS_W2T);
    const float* mod = (const float*)(a.ws + WS_MOD);
    bf16_t* H = (bf16_t*)(a.ws + WS_H);
    for (int row = gw; row < TT; row += NGW) {
        const float* xr; int mr;
        if (row < T) { xr = a.in[I_X] + (size_t)row * D; mr = row >> 13; } else { xr = a.in[I_CTX] + (size_t)(row - T) * D; mr = 4; }
        ln_mod_row(xr, mod + mr * 6144, mod + mr * 6144 + 1024, H + (size_t)row * D, lane);
    }
    constexpr int I_IN = 16 * 96, I_FOLD = 16 * 8 * 2, I_OUT = 16 * 32, I_W1 = NE * 16 * 64, I_W2 = NE * 16 * 32;
    constexpr int NITEMS = I_IN + I_FOLD + I_OUT + I_W1 + I_W2;
    for (int it = gw; it < NITEMS; it += NGW) {
        int r = it;
        if (r < I_IN) {
            const int kb = r / 96, nb = r % 96;
            if (nb < 48) tr_item(win, INW, 64 * kb, 32 * nb, 1, nb < 8 ? 0.125f : 1.f, btin + (size_t)(32 * nb) * 1024, scr, lane);
            else tr_item(win, INW, 64 * kb, 1568 + 32 * (nb - 48), 1, 1.f, btin + (size_t)(2048 + 32 * (nb - 48)) * 1024, scr, lane);
            continue; }
        r -= I_IN;
        if (r < I_FOLD) { const int dir = r & 1, jb = (r >> 1) & 7, kb = r >> 4;
            fold_item(win, dir ? a.in[I_WAB] : a.in[I_WAF], dir, 64 * kb, 32 * jb, btin + (size_t)(1536 + 256 * dir + 32 * jb) * 1024, scr, lane); continue; }
        r -= I_FOLD;
        if (r < I_OUT) { const int kb = r / 32, nb = r % 32; tr_item(a.in[I_WOUT], 1024, 64 * kb, 32 * nb, 1, 1.f, btout + (size_t)(32 * nb) * 1024, scr, lane); continue; }
        r -= I_OUT;
        if (r < I_W1) {
            const int e = r / 1024, q = r % 1024, s = q & 1, nb = (q >> 1) & 31, kb = q >> 6;
            const int ct = nb >> 2, jj0 = (nb & 3) * 32;
            tr_item(a.in[I_EW1] + (size_t)e * 1024 * 2048, 2048, 64 * kb, 2 * (128 * ct + jj0) + s, 2, 1.f, w1t + ((size_t)e * 2048 + 256 * ct + 128 * s + jj0) * 1024, scr, lane);
            continue; }
        r -= I_W1;
        { const int e = r / 512, q = r % 512, kb = q / 32, nb = q % 32;
          tr_item(a.in[I_EW2] + (size_t)e * 1024 * 1024, 1024, 64 * kb, 32 * nb, 1, 1.f, w2t + ((size_t)e * 1024 + 32 * nb) * 1024, scr, lane); }
    }
    for (int it = gw; it < 2048; it += NGW) hy::filter_item(a, it, lane);
    float* b1r = (float*)(a.ws + WS_B1R); const float* eb1 = a.in[I_EB1];
    for (int i = blockIdx.x * NTHREADS + tid; i < NE * 2048; i += gridDim.x * NTHREADS) {
        const int e = i >> 11, n = i & 2047, ct = n >> 8, s = (n >> 7) & 1, jj = n & 127;
        b1r[i] = eb1[(size_t)e * 2048 + 2 * (128 * ct + jj) + s];
    }
}

namespace gla {
constexpr int RS = 72;
constexpr int L_TOTF = 0, L_TOTB = 2048, L_SSQ = 4096;
constexpr int L_T0 = 8192;
constexpr int L_T1 = L_T0 + 9216, L_T2 = L_T1 + 9216, L_T3 = L_T2 + 9216;
constexpr int L_VT = L_T3 + 9216;
constexpr int L_P  = L_VT + 18432;
constexpr int L_END = L_P + 9216;

__device__ __forceinline__ bf16x8 frag(const LAS unsigned char* tile, int row, int k0, int lane) {
    return *(const LAS bf16x8*)(tile + ((row + (lane & 15)) * RS + k0 + 8 * (lane >> 4)) * 2);
}
__device__ __forceinline__ void chunk_cums_pre(LAS unsigned char* L, const float (&gf)[8], const float (&gb)[8], int wave, int lane, float (&cumf)[8], float (&cumb)[8], float& allf, float& allb) {
    LAS float* totf = (LAS float*)(L + L_TOTF); LAS float* totb = (LAS float*)(L + L_TOTB);
    cumf[0] = gf[0];
#pragma unroll
    for (int r = 1; r < 8; ++r) cumf[r] = cumf[r - 1] + gf[r];
    cumb[7] = gb[7];
#pragma unroll
    for (int r = 6; r >= 0; --r) cumb[r] = cumb[r + 1] + gb[r];
    totf[wave * 64 + lane] = cumf[7]; totb[wave * 64 + lane] = cumb[0];
    __syncthreads();
    float of = 0.f, ob = 0.f, af = 0.f, ab = 0.f;
#pragma unroll
    for (int w = 0; w < 8; ++w) { const float tf = totf[w * 64 + lane], tb = totb[w * 64 + lane]; af += tf; ab += tb; of += (w < wave) ? tf : 0.f; ob += (w > wave) ? tb : 0.f; }
#pragma unroll
    for (int r = 0; r < 8; ++r) { cumf[r] += of; cumb[r] += ob; }
    allf = af; allb = ab;
}
__device__ __forceinline__ void chunk_cums(LAS unsigned char* L, const float* GF, const float* GB, size_t tok0, int h, int wave, int lane, float (&cumf)[8], float (&cumb)[8], float& allf, float& allb) {
    float gf[8], gb[8];
#pragma unroll
    for (int r = 0; r < 8; ++r) { const size_t o = (tok0 + 8 * wave + r) * 256 + h * 64 + lane; gf[r] = GF[o]; gb[r] = GB[o]; }
    chunk_cums_pre(L, gf, gb, wave, lane, cumf, cumb, allf, allb);
}
__device__ __forceinline__ void store_vt(LAS unsigned char* L, const u32x4 (&vr)[2], int tid) {
    LAS bf16_t* vt = (LAS bf16_t*)(L + L_VT);
    const int j = tid >> 3, c8 = tid & 7;
#pragma unroll
    for (int q = 0; q < 2; ++q) { const int dv0 = 8 * (c8 + 8 * q);
        const unsigned ww[4] = {vr[q].x, vr[q].y, vr[q].z, vr[q].w};
#pragma unroll
        for (int e = 0; e < 4; ++e) { vt[(dv0 + 2 * e) * RS + j] = (bf16_t)(ww[e] & 0xffffu); vt[(dv0 + 2 * e + 1) * RS + j] = (bf16_t)(ww[e] >> 16); } }
}
__device__ __forceinline__ void load_vt(LAS unsigned char* L, const bf16_t* V, size_t tok0, int h, int tid) {
    const int j = tid >> 3, c8 = tid & 7; u32x4 vr[2];
#pragma unroll
    for (int q = 0; q < 2; ++q) vr[q] = *(const u32x4*)(V + (tok0 + j) * 512 + h * 128 + 8 * (c8 + 8 * q));
    store_vt(L, vr, tid);
}

__device__ __forceinline__ void g1_unit(const Args& a, LAS unsigned char* L, int bh, int chunk  ) {
    const int tid = threadIdx.x, lane = tid & 63, wave = __builtin_amdgcn_readfirstlane(tid >> 6);
    const int b = bh >> 2, h = bh & 3;
    const size_t tok0 = chunk < NCHUNK ? (size_t)b * SEQ + (size_t)chunk * CH : (size_t)T + (size_t)b * CTXL + (size_t)(chunk - NCHUNK) * CH;
    const float* GF = (const float*)(a.ws + WS_GF); const float* GB = (const float*)(a.ws + WS_GB);
    const bf16_t* Kb = (const bf16_t*)(a.ws + WS_K); const bf16_t* Vb = (const bf16_t*)(a.ws + WS_V);
    float cumf[8], cumb[8], allf, allb;
    __syncthreads();
    chunk_cums(L, GF, GB, tok0, h, wave, lane, cumf, cumb, allf, allb);
    LAS bf16_t* ketf = (LAS bf16_t*)(L + L_T0); LAS bf16_t* ketb = (LAS bf16_t*)(L + L_T1);
#pragma unroll
    for (int r = 0; r < 8; ++r) { const int i = 8 * wave + r; const float kv = bf2f(Kb[(tok0 + i) * 256 + h * 64 + lane]);
        ketf[lane * RS + i] = f2bf(kv * __expf(allf - cumf[r])); ketb[lane * RS + i] = f2bf(kv * __expf(allb - cumb[r])); }
    load_vt(L, Vb, tok0, h, tid);
    if (wave == 0) { float* av = (float*)(a.ws + WS_AV); av[((size_t)(0 * 16 + bh) * NCT + chunk) * 64 + lane] = __expf(allf); av[((size_t)(1 * 16 + bh) * NCT + chunk) * 64 + lane] = __expf(allb); }
    __syncthreads();
    bf16_t* KV = (bf16_t*)(a.ws + WS_KV);
#pragma unroll
    for (int dir = 0; dir < 2; ++dir) {
        const LAS unsigned char* ket = L + (dir ? L_T1 : L_T0);
        bf16_t* dst = KV + ((size_t)(dir * 16 + bh) * NCT + chunk) * 8192;
#pragma unroll
        for (int nt = 0; nt < 4; ++nt) { f32x4 acc = {0.f, 0.f, 0.f, 0.f};
#pragma unroll
            for (int ks = 0; ks < 2; ++ks) acc = __builtin_amdgcn_mfma_f32_16x16x32_bf16(frag(L + L_VT, 16 * wave, 32 * ks, lane), frag(ket, 16 * nt, 32 * ks, lane), acc, 0, 0, 0);
#pragma unroll
            for (int r = 0; r < 4; ++r) dst[(16 * wave + 4 * (lane >> 4) + r) * 64 + 16 * nt + (lane & 15)] = f2bf(acc[r]); }
    }
}

__device__ __forceinline__ void g2_scan(const Args& a) {
    const bf16_t* KV = (const bf16_t*)(a.ws + WS_KV); const float* AV = (const float*)(a.ws + WS_AV); bf16_t* SP = (bf16_t*)(a.ws + WS_SP);
    for (int id = blockIdx.x * NTHREADS + threadIdx.x; id < 32 * 4096; id += gridDim.x * NTHREADS) {
        const int db = id >> 12, e2 = id & 4095, dir = db >> 4, dk = (2 * e2) & 63;
        const unsigned* kv = (const unsigned*)(KV + (size_t)db * NCT * 8192) + e2;
        const float* av = AV + (size_t)db * NCT * 64 + dk;
        unsigned* sp = (unsigned*)(SP + (size_t)db * NCHUNK * 8192) + e2;
        float s0 = 0.f, s1 = 0.f;
#pragma unroll
        for (int q = 0; q < NCC; ++q) { const int c = NCHUNK + (dir ? (NCC - 1 - q) : q);
            const unsigned w = kv[(size_t)c * 4096]; const f32x2 aa = *(const f32x2*)(av + (size_t)c * 64);
            s0 = aa[0] * s0 + bflo(w); s1 = aa[1] * s1 + bfhi(w); }
        for (int q0 = 0; q0 < NCHUNK; q0 += 8) {
            unsigned w[8]; f32x2 aa[8];
#pragma unroll
            for (int u = 0; u < 8; ++u) { const int c = dir ? (NCHUNK - 1 - (q0 + u)) : (q0 + u); w[u] = kv[(size_t)c * 4096]; aa[u] = *(const f32x2*)(av + (size_t)c * 64); }
#pragma unroll
            for (int u = 0; u < 8; ++u) { const int c = dir ? (NCHUNK - 1 - (q0 + u)) : (q0 + u);
                sp[(size_t)c * 4096] = pk2(s0, s1);
                s0 = aa[u][0] * s0 + bflo(w[u]); s1 = aa[u][1] * s1 + bfhi(w[u]); }
        }
    }
}

__device__ __forceinline__ void g3_unit(const Args& a, LAS unsigned char* L, int bh, int chunk  ) {
    const int tid = threadIdx.x, lane = tid & 63, wave = __builtin_amdgcn_readfirstlane(tid >> 6);
    const int b = bh >> 2, h = bh & 3;
    const size_t tok0 = (size_t)b * SEQ + (size_t)chunk * CH;
    const float* GF = (const float*)(a.ws + WS_GF); const float* GB = (const float*)(a.ws + WS_GB);
    const bf16_t* Qb = (const bf16_t*)(a.ws + WS_Q); const bf16_t* Kb = (const bf16_t*)(a.ws + WS_K); const bf16_t* Vb = (const bf16_t*)(a.ws + WS_V); const bf16_t* Gt = (const bf16_t*)(a.ws + WS_G);
    const int mt = wave >> 1, fr = lane & 15, fq = lane >> 4;
    const bf16_t* SPf = (const bf16_t*)(a.ws + WS_SP) + ((size_t)(0 * 16 + bh) * NCHUNK + chunk) * 8192;
    const bf16_t* SPb = (const bf16_t*)(a.ws + WS_SP) + ((size_t)(1 * 16 + bh) * NCHUNK + chunk) * 8192;
    float gfr[8], gbr[8]; bf16_t qr[8], kr[8]; u32x4 vr[2]; bf16x8 sfv[4][2], sbv[4][2]; bf16_t gr[4][4];
#pragma unroll
    for (int r = 0; r < 8; ++r) { const size_t o = (tok0 + 8 * wave + r) * 256 + h * 64 + lane; gfr[r] = GF[o]; gbr[r] = GB[o]; qr[r] = Qb[o]; kr[r] = Kb[o]; }
#pragma unroll
    for (int q = 0; q < 2; ++q) vr[q] = *(const u32x4*)(Vb + (tok0 + (tid >> 3)) * 512 + h * 128 + 8 * ((tid & 7) + 8 * q));
#pragma unroll
    for (int q = 0; q < 4; ++q) { const int nt = 4 * (wave & 1) + q;
#pragma unroll
        for (int ks = 0; ks < 2; ++ks) { sfv[q][ks] = *(const bf16x8*)(SPf + (16 * nt + fr) * 64 + 32 * ks + 8 * fq); sbv[q][ks] = *(const bf16x8*)(SPb + (16 * nt + fr) * 64 + 32 * ks + 8 * fq); }
#pragma unroll
        for (int r = 0; r < 4; ++r) gr[r][q] = Gt[(tok0 + 16 * mt + 4 * fq + r) * 512 + h * 128 + 16 * nt + fr]; }
    float cumf[8], cumb[8], allf, allb;
    __syncthreads();
    chunk_cums_pre(L, gfr, gbr, wave, lane, cumf, cumb, allf, allb);
    LAS bf16_t* qf = (LAS bf16_t*)(L + L_T0); LAS bf16_t* kf = (LAS bf16_t*)(L + L_T1); LAS bf16_t* qb = (LAS bf16_t*)(L + L_T2); LAS bf16_t* kb = (LAS bf16_t*)(L + L_T3);
#pragma unroll
    for (int r = 0; r < 8; ++r) { const int i = 8 * wave + r;
        const float qv = bf2f(qr[r]), kv = bf2f(kr[r]);
        qf[i * RS + lane] = f2bf(qv * __expf(cumf[r])); kf[i * RS + lane] = f2bf(kv * __expf(-cumf[r]));
        qb[i * RS + lane] = f2bf(qv * __expf(cumb[r])); kb[i * RS + lane] = f2bf(kv * __expf(-cumb[r])); }
    store_vt(L, vr, tid);
    __syncthreads();
    {
        LAS bf16_t* P = (LAS bf16_t*)(L + L_P);
#pragma unroll
        for (int q = 0; q < 2; ++q) { const int nt = 2 * (wave & 1) + q;
            f32x4 sf = {0.f, 0.f, 0.f, 0.f}, sb = {0.f, 0.f, 0.f, 0.f};
#pragma unroll
            for (int ks = 0; ks < 2; ++ks) {
                sf = __builtin_amdgcn_mfma_f32_16x16x32_bf16(frag(L + L_T0, 16 * mt, 32 * ks, lane), frag(L + L_T1, 16 * nt, 32 * ks, lane), sf, 0, 0, 0);
                sb = __builtin_amdgcn_mfma_f32_16x16x32_bf16(frag(L + L_T2, 16 * mt, 32 * ks, lane), frag(L + L_T3, 16 * nt, 32 * ks, lane), sb, 0, 0, 0); }
#pragma unroll
            for (int r = 0; r < 4; ++r) { const int i = 16 * mt + 4 * fq + r, j = 16 * nt + fr;
                P[i * RS + j] = f2bf((j <= i ? sf[r] : 0.f) + (j >= i ? sb[r] : 0.f)); } }
    }
    __syncthreads();
    f32x4 o[4]; float ssq[4] = {0.f, 0.f, 0.f, 0.f};
#pragma unroll
    for (int q = 0; q < 4; ++q) { const int nt = 4 * (wave & 1) + q;
        f32x4 acc = {0.f, 0.f, 0.f, 0.f};
#pragma unroll
        for (int ks = 0; ks < 2; ++ks) {
            acc = __builtin_amdgcn_mfma_f32_16x16x32_bf16(frag(L + L_P, 16 * mt, 32 * ks, lane), frag(L + L_VT, 16 * nt, 32 * ks, lane), acc, 0, 0, 0);
            acc = __builtin_amdgcn_mfma_f32_16x16x32_bf16(frag(L + L_T0, 16 * mt, 32 * ks, lane), sfv[q][ks], acc, 0, 0, 0);
            acc = __builtin_amdgcn_mfma_f32_16x16x32_bf16(frag(L + L_T2, 16 * mt, 32 * ks, lane), sbv[q][ks], acc, 0, 0, 0); }
        o[q] = acc;
#pragma unroll
        for (int r = 0; r < 4; ++r) ssq[r] += acc[r] * acc[r]; }
    LAS float* SSQ = (LAS float*)(L + L_SSQ);
#pragma unroll
    for (int r = 0; r < 4; ++r) { float s = ssq[r]; s += __shfl_xor(s, 1); s += __shfl_xor(s, 2); s += __shfl_xor(s, 4); s += __shfl_xor(s, 8); ssq[r] = s; }
    if (fr == 0) {
#pragma unroll
        for (int r = 0; r < 4; ++r) SSQ[(wave & 1) * 64 + 16 * mt + 4 * fq + r] = ssq[r]; }
    __syncthreads();
    const float* ng = a.in[I_NORMG];
    bf16_t* mix = (bf16_t*)(a.ws + WS_MIX);
#pragma unroll
    for (int r = 0; r < 4; ++r) { const int i = 16 * mt + 4 * fq + r;
        const float rstd = 1.f / sqrtf((SSQ[i] + SSQ[64 + i]) * (1.f / DV) + LN_EPS);
#pragma unroll
        for (int q = 0; q < 4; ++q) { const int dv = 16 * (4 * (wave & 1) + q) + fr;
            const float g = bf2f(gr[r][q]);
            mix[(tok0 + i) * 1024 + h * 128 + dv] = f2bf(o[q][r] * rstd * ng[dv] * silu_f(g)); } }
}
}

namespace rt {
constexpr int HS = 1028;
constexpr int L_H2 = 0;
constexpr int L_PART = 65792;
constexpr int L_LCNT = L_PART + 16384;
constexpr int L_REC = L_LCNT + 256;

__device__ __forceinline__ void phase(const Args& a, LAS unsigned char* lds) {
    const int tid = threadIdx.x, lane = tid & 63, wave = __builtin_amdgcn_readfirstlane(tid >> 6);
    float* pre = (float*)(a.ws + WS_PRE1); bf16_t* H2 = (bf16_t*)(a.ws + WS_H2); const bf16_t* FG = (const bf16_t*)(a.ws + WS_FG);
    const float* mod = (const float*)(a.ws + WS_MOD);
    const float* rw = a.in[I_RW]; const float* rb = a.in[I_RB];
    LAS float* h2s = (LAS float*)(lds + L_H2); LAS float* part = (LAS float*)(lds + L_PART);
    LAS int* lcnt = (LAS int*)(lds + L_LCNT); LAS int* lbase = lcnt + 32; LAS int* rec = (LAS int*)(lds + L_REC);
    unsigned* cnt = (unsigned*)(a.ws + WS_CNT); int* list = (int*)(a.ws + WS_LIST); float* pw = (float*)(a.ws + WS_PW); int* ploc = (int*)(a.ws + WS_PLOC);
    float rwr[32][2];
#pragma unroll
    for (int s = 0; s < 32; ++s)
#pragma unroll
        for (int nt = 0; nt < 2; ++nt) rwr[s][nt] = rw[(size_t)(128 * wave + 4 * s + (lane >> 4)) * 32 + 16 * nt + (lane & 15)];
    const f32x4* g1 = (const f32x4*)a.in[I_LN1G]; const f32x4* bb1 = (const f32x4*)a.in[I_LN1B];
    if (tid < 32) lcnt[tid] = 0;
    for (int grp = blockIdx.x; grp < T / 16; grp += gridDim.x) {
        __syncthreads();
#pragma unroll 1
        for (int rr = 0; rr < 2; ++rr) {
            const int lr = 2 * wave + rr, t = grp * 16 + lr, b = t >> 13;
            f32x4* pr = (f32x4*)(pre + (size_t)t * D) + lane;
            const f32x4* xr = (const f32x4*)(a.in[I_X] + (size_t)t * D) + lane; const u32x2* fr_ = (const u32x2*)(FG + (size_t)t * D) + lane;
            f32x4 v[4]; float s = 0.f;
#pragma unroll
            for (int j = 0; j < 4; ++j) { const u32x2 fw = fr_[64 * j]; const f32x4 ff = {bflo(fw.x), bfhi(fw.x), bflo(fw.y), bfhi(fw.y)};
                v[j] = xr[64 * j] * ALPHA + ff; s += (v[j][0] + v[j][1]) + (v[j][2] + v[j][3]); }
            float mean = wave_sum(s) * (1.f / D), s2 = 0.f;
#pragma unroll
            for (int j = 0; j < 4; ++j) { v[j] = v[j] - mean; s2 += (v[j][0] * v[j][0] + v[j][1] * v[j][1]) + (v[j][2] * v[j][2] + v[j][3] * v[j][3]); }
            float rstd = 1.f / sqrtf(wave_sum(s2) * (1.f / D) + LN_EPS);
            s = 0.f;
#pragma unroll
            for (int j = 0; j < 4; ++j) { v[j] = v[j] * rstd * g1[64 * j + lane] + bb1[64 * j + lane]; pr[64 * j] = v[j]; s += (v[j][0] + v[j][1]) + (v[j][2] + v[j][3]); }
            mean = wave_sum(s) * (1.f / D); s2 = 0.f;
#pragma unroll
            for (int j = 0; j < 4; ++j) { v[j] = v[j] - mean; s2 += (v[j][0] * v[j][0] + v[j][1] * v[j][1]) + (v[j][2] * v[j][2] + v[j][3] * v[j][3]); }
            rstd = 1.f / sqrtf(wave_sum(s2) * (1.f / D) + LN_EPS);
            const f32x4* sh = (const f32x4*)(mod + b * 6144 + 3 * 1024); const f32x4* sc = (const f32x4*)(mod + b * 6144 + 4 * 1024);
            u32x2* o8 = (u32x2*)(H2 + (size_t)t * D) + lane;
#pragma unroll
            for (int j = 0; j < 4; ++j) { const f32x4 y = v[j] * rstd * (sc[64 * j + lane] + 1.f) + sh[64 * j + lane];
                u32x2 w; w.x = pk2(y[0], y[1]); w.y = pk2(y[2], y[3]); o8[64 * j] = w;
                *(LAS f32x4*)(h2s + lr * HS + 256 * j + 4 * lane) = y; }
        }
        __syncthreads();
        {
            f32x4 acc0 = {0.f, 0.f, 0.f, 0.f}, acc1 = {0.f, 0.f, 0.f, 0.f};
            const LAS float* ap = h2s + (lane & 15) * HS + 128 * wave + (lane >> 4);
#pragma unroll
            for (int s = 0; s < 32; ++s) { const float av = ap[4 * s];
                acc0 = __builtin_amdgcn_mfma_f32_16x16x4f32(av, rwr[s][0], acc0, 0, 0, 0);
                acc1 = __builtin_amdgcn_mfma_f32_16x16x4f32(av, rwr[s][1], acc1, 0, 0, 0); }
#pragma unroll
            for (int r = 0; r < 4; ++r) { part[(wave * 16 + 4 * (lane >> 4) + r) * 32 + (lane & 15)] = acc0[r]; part[(wave * 16 + 4 * (lane >> 4) + r) * 32 + 16 + (lane & 15)] = acc1[r]; }
        }
        __syncthreads();
        {
            const int lr = 2 * wave + (lane >> 5), e = lane & 31, t = grp * 16 + lr;
            float lg = rb[e];
#pragma unroll
            for (int w = 0; w < 8; ++w) lg += part[(w * 16 + lr) * 32 + e];
            float cur = lg, tv[4]; int ti[4];
#pragma unroll
            for (int k = 0; k < 4; ++k) { float bv = cur; int bi = e;
#pragma unroll
                for (int o = 1; o < 32; o <<= 1) { const float ov = __shfl_xor(bv, o); const int oi = __shfl_xor(bi, o); if (ov > bv || (ov == bv && oi < bi)) { bv = ov; bi = oi; } }
                tv[k] = bv; ti[k] = bi; if (bi == e) cur = -3.0e38f; }
            const float e1 = __expf(tv[1] - tv[0]), e2 = __expf(tv[2] - tv[0]), e3 = __expf(tv[3] - tv[0]);
            const float inv = 1.f / (1.f + e1 + e2 + e3);
            if (e < 4) { const float wk = (e == 0 ? 1.f : (e == 1 ? e1 : (e == 2 ? e2 : e3))) * inv; const int ek = (e == 0 ? ti[0] : (e == 1 ? ti[1] : (e == 2 ? ti[2] : ti[3])));
                const int pair = t * 4 + e;
                pw[pair] = wk;
                const int rank = __hip_atomic_fetch_add((LAS int*)&lcnt[ek], 1, __ATOMIC_RELAXED, __HIP_MEMORY_SCOPE_WORKGROUP);
                rec[lr * 4 + e] = ek | (rank << 8); }
        }
        __syncthreads();
        if (tid < 32) { const int n = lcnt[tid]; lbase[tid] = n ? (int)atomicAdd(&cnt[tid], (unsigned)n) : 0; }
        __syncthreads();
        if (tid < 64) { const int rc = rec[tid], ek = rc & 255, rank = rc >> 8, pos = lbase[ek] + rank, pair = (grp * 16 + (tid >> 2)) * 4 + (tid & 3);
            list[(size_t)ek * CAP + pos] = pair; ploc[pair] = ek | (pos << 5); }
        __syncthreads();
        if (tid < 32) lcnt[tid] = 0;
    }
}
}

__device__ __forceinline__ void p_final(const Args& a, LAS unsigned char* lds) {
    const int tid = threadIdx.x, lane = tid & 63, wave = tid >> 6;
    const float* xm = (const float*)(a.ws + WS_PRE1); const bf16_t* slots = (const bf16_t*)(a.ws + WS_SLOTS); const float* mod = (const float*)(a.ws + WS_MOD);
    const int* ploc = (const int*)(a.ws + WS_PLOC); const float* pw = (const float*)(a.ws + WS_PW);
    const f32x4* g2 = (const f32x4*)a.in[I_LN2G]; const f32x4* b2 = (const f32x4*)a.in[I_LN2B];
    LAS int* tstart = (LAS int*)lds;
    __syncthreads();
    if (tid == 0) { const unsigned* cnt = (const unsigned*)(a.ws + WS_CNT); int nrt = 0; for (int e = 0; e < NE; ++e) { tstart[e] = 256 * nrt; nrt += ((int)cnt[e] + 255) >> 8; } }
    __syncthreads();
    for (int t = blockIdx.x * NWAVES + wave; t < T; t += gridDim.x * NWAVES) {
        const int b = t >> 13;
        const f32x4* xr = (const f32x4*)(xm + (size_t)t * D) + lane; const f32x4* gt = (const f32x4*)(mod + b * 6144 + 5 * 1024);
        const u32x2* sr[4]; float w[4];
#pragma unroll
        for (int sl = 0; sl < 4; ++sl) { const int pl = ploc[t * 4 + sl]; w[sl] = pw[t * 4 + sl]; sr[sl] = (const u32x2*)(slots + (size_t)(tstart[pl & 31] + (pl >> 5)) * D) + lane; }
        f32x4 v[4]; float s = 0.f;
#pragma unroll
        for (int j = 0; j < 4; ++j) { f32x4 y = {0.f, 0.f, 0.f, 0.f};
#pragma unroll
            for (int sl = 0; sl < 4; ++sl) { const u32x2 q = sr[sl][64 * j]; y[0] += w[sl] * bflo(q.x); y[1] += w[sl] * bfhi(q.x); y[2] += w[sl] * bflo(q.y); y[3] += w[sl] * bfhi(q.y); }
            v[j] = xr[64 * j] * ALPHA + gt[64 * j + lane] * y; s += (v[j][0] + v[j][1]) + (v[j][2] + v[j][3]); }
        const float mean = wave_sum(s) * (1.f / D); float s2 = 0.f;
#pragma unroll
        for (int j = 0; j < 4; ++j) { v[j] = v[j] - mean; s2 += (v[j][0] * v[j][0] + v[j][1] * v[j][1]) + (v[j][2] * v[j][2] + v[j][3] * v[j][3]); }
        const float rstd = 1.f / sqrtf(wave_sum(s2) * (1.f / D) + LN_EPS);
        f32x4* o = (f32x4*)(a.out + (size_t)t * D) + lane;
#pragma unroll
        for (int j = 0; j < 4; ++j) o[64 * j] = v[j] * rstd * g2[64 * j + lane] + b2[64 * j + lane];
    }
}

constexpr int N_PHASES = 11;
__global__ void __launch_bounds__(NTHREADS, 2) mega_fwd(Args a) {
    extern __shared__ __attribute__((aligned(16))) unsigned char lds_raw[];
    LAS unsigned char* lds = (LAS unsigned char*)lds_raw;
    const int tid = threadIdx.x;
    volatile LAS unsigned* misc = (volatile LAS unsigned*)(lds + LDS_MISC);
    if (tid < 4) misc[tid] = 0u;
    __syncthreads();
    XcdBarrier bar; bar.bar = (unsigned*)(a.ws + WS_BAR); bar.x = 0; bar.st = misc;
    const bool multi = (a.ph_hi - a.ph_lo) > 1;
    if (multi) bar = xcd_barrier_post((unsigned*)(a.ws + WS_BAR), misc);
    const int lo = a.ph_lo, hi = a.ph_hi;
    const int vcu = (gridDim.x % 8 == 0) ? (int)((blockIdx.x % 8) * (gridDim.x / 8) + blockIdx.x / 8) : (int)blockIdx.x;
#ifdef ONLY_PHASE
#define IN(k) ((k) == ONLY_PHASE && lo <= (k) && (k) < hi)
#else
#define IN(k) (lo <= (k) && (k) < hi)
#endif
#define SEAM(k) do { if (IN(k) && IN((k) + 1)) xcd_barrier(bar); } while (0)

#ifndef REPEAT_PHASE
#define REPEAT_PHASE -1
#endif
#define RUNPH(k, ...) do { if (IN(k)) { __VA_ARGS__; if (REPEAT_PHASE == (k)) { xcd_barrier(bar); __VA_ARGS__; } } } while (0)
    RUNPH(0, p0_mod_and_filter(a, lds));
    SEAM(0);
    RUNPH(1, p1_prep(a, lds));
    SEAM(1);
    RUNPH(2, { gm::SchedIn S{a.ws, (int)gridDim.x, vcu}; gm::EpiIn E{a.ws, a.in[I_BAF], a.in[I_BAB]}; gm::gemm_stream<false, 0>(lds, S, E); });
    SEAM(2);
    RUNPH(3, { for (int u = blockIdx.x; u < 16 * NCT; u += gridDim.x) gla::g1_unit(a, lds, u / NCT, u % NCT); });
    SEAM(3);
    RUNPH(4, { gla::g2_scan(a);
        for (int c = blockIdx.x; c < HYW; c += gridDim.x) hy::channel(a, lds, c, a.ws + WS_HSPEC + (size_t)blockIdx.x * HSPEC_PER_WG); });
    SEAM(4);
    RUNPH(5, { for (int u = blockIdx.x; u < 16 * NCHUNK; u += gridDim.x) gla::g3_unit(a, lds, u >> 7, u & 127);
        const int wave = tid >> 6;
        for (int it = blockIdx.x * NWAVES + wave; it < 4096; it += gridDim.x * NWAVES) hy::transpose_item(a, it, tid & 63); });
    SEAM(5);
    RUNPH(6, { gm::SchedOut S{a.ws, (int)gridDim.x, vcu}; gm::EpiOut E{a.ws}; gm::gemm_stream<false, 0>(lds, S, E); });
    SEAM(6);
    RUNPH(7, rt::phase(a, lds));
    SEAM(7);
    if (IN(8) || IN(9)) {
        LAS int* tab = (LAS int*)(lds + gm::LDS_TAB);
        __syncthreads();
        if (tid == 0) { const unsigned* cnt = (const unsigned*)(a.ws + WS_CNT); int nrt = 0;
            for (int e = 0; e < NE; ++e) { const int n = (int)cnt[e]; tab[e] = n; const int nt = (n + 255) >> 8; for (int k = 0; k < nt; ++k) tab[64 + nrt + k] = e | (k << 8); nrt += nt; }
            tab[32] = nrt; }
        __syncthreads();
    }
    RUNPH(8, { gm::SchedMoe<1> S{a.ws, (const LAS int*)(lds + gm::LDS_TAB), (int)gridDim.x, vcu}; gm::EpiMoe1 E{a.ws}; gm::gemm_stream<true, 2>(lds, S, E); });
    SEAM(8);
    RUNPH(9, { gm::SchedMoe<2> S{a.ws, (const LAS int*)(lds + gm::LDS_TAB), (int)gridDim.x, vcu}; gm::EpiMoe2 E{a.ws, a.in[I_EB2]}; gm::gemm_stream<false, 0>(lds, S, E); });
    SEAM(9);
    RUNPH(10, p_final(a, lds));
#undef RUNPH
#undef IN
#undef SEAM
}

extern "C" void kernel_launch(void* const* d_in, const int* in_sizes, int n_in, void* d_out, int out_size, void* d_ws, size_t ws_size, hipStream_t stream) {
    static int grid = 0;
    if (grid == 0) {
        if (n_in != 32 || out_size != T * D || ws_size < WS_END) { fprintf(stderr, "kernel_launch: unexpected shapes (n_in %d out %d ws %zu need %zu)\n", n_in, out_size, ws_size, (size_t)WS_END); grid = -1; return; }
        int dev = 0, cus = 0;
        if (hipGetDevice(&dev) != hipSuccess || hipDeviceGetAttribute(&cus, hipDeviceAttributeMultiprocessorCount, dev) != hipSuccess) { grid = -1; return; }
        if (hipFuncSetAttribute((const void*)mega_fwd, hipFuncAttributeMaxDynamicSharedMemorySize, LDS_BYTES) != hipSuccess) { fprintf(stderr, "kernel_launch: hipFuncSetAttribute failed\n"); grid = -1; return; }
        int per_cu = 0;
        if (hipOccupancyMaxActiveBlocksPerMultiprocessor(&per_cu, (const void*)mega_fwd, NTHREADS, LDS_BYTES) != hipSuccess || per_cu < 1) fprintf(stderr, "kernel_launch: occupancy query says %d\n", per_cu);
        (void)hipGetLastError();
        grid = cus;
        if (grid > MAX_GRID) grid = MAX_GRID;
    }
    if (grid < 0) return;
    (void)hipMemsetAsync(d_ws, 0, WS_ZERO_BYTES, stream);
    Args a{};
    for (int i = 0; i < 32; ++i) a.in[i] = (const float*)d_in[i];
    a.out = (float*)d_out; a.ws = (unsigned char*)d_ws;
#ifdef DBG
    (void)hipMemsetAsync((char*)d_ws + WS_DBG, 0, 512, stream);
    for (int p = 0; p < N_PHASES; ++p) { a.ph_lo = p; a.ph_hi = p + 1; hipLaunchKernelGGL(mega_fwd, dim3(grid), dim3(NTHREADS), LDS_BYTES, stream, a);
        hipLaunchKernelGGL(dbg_check, dim3(64), dim3(512), 0, stream, a, p); }
    hipLaunchKernelGGL(dbg_encode, dim3(1024), dim3(256), 0, stream, a);
#elif N_LAUNCH_PER_PHASE
    for (int p = 0; p < N_PHASES; ++p) { a.ph_lo = p; a.ph_hi = p + 1; hipLaunchKernelGGL(mega_fwd, dim3(grid), dim3(NTHREADS), LDS_BYTES, stream, a); }
#else
    a.ph_lo = 0; a.ph_hi = N_PHASES;
    hipLaunchKernelGGL(mega_fwd, dim3(grid), dim3(NTHREADS), LDS_BYTES, stream, a);
#endif
}
```

```cpp
#include <hip/hip_runtime.h>
#include <cstdio>
#include <cstdint>
#include <cstddef>

#define LAS __attribute__((address_space(3)))
#define GAS __attribute__((address_space(1)))
typedef unsigned short bf16_t;
typedef short bf16x8 __attribute__((ext_vector_type(8)));
typedef float f32x4 __attribute__((ext_vector_type(4)));
typedef float f32x2 __attribute__((ext_vector_type(2)));
typedef unsigned u32x4 __attribute__((ext_vector_type(4)));
typedef unsigned u32x2 __attribute__((ext_vector_type(2)));

#ifndef N_LAUNCH_PER_PHASE
#define N_LAUNCH_PER_PHASE 0
#endif

constexpr int D = 1024, NB = 4, SEQ = 8192, T = NB * SEQ, CTXL = 256, TC = NB * CTXL, TT = T + TC;
constexpr int NH = 4, DK = 64, DV = 128, CH = 64, NCHUNK = SEQ / CH, NCC = CTXL / CH, NCT = NCHUNK + NCC;
constexpr int HYW = 512, HYC = 3 * HYW, INW = 3104;
constexpr int NE = 32, DE = 1024, CAP = T;
constexpr float LN_EPS = 1e-6f, ALPHA = 1.189207115002721f;
constexpr int NTHREADS = 512, NWAVES = 8;
constexpr int FFTN = 16384;

constexpr size_t al256(size_t x) { return (x + 255) & ~(size_t)255; }
constexpr size_t WS_BAR   = 0;
constexpr size_t WS_MOD   = 16384;
constexpr size_t WS_CNT   = WS_MOD + 5 * 6144 * 4;
constexpr size_t WS_ZERO_BYTES = al256(WS_CNT + 256);
constexpr size_t WS_LIST  = 262144;
constexpr size_t WS_PW    = WS_LIST + (size_t)NE * CAP * 4;
constexpr size_t WS_PLOC  = WS_PW + (size_t)T * 4 * 4;
constexpr size_t WS_B1R   = WS_PLOC + (size_t)T * 4 * 4;
constexpr size_t WS_HID2  = WS_B1R + (size_t)NE * 2048 * 4;
constexpr size_t WS_BTIN  = WS_HID2 + (size_t)SEQ * 64 * 4;
constexpr size_t WS_BTOUT = WS_BTIN + (size_t)3584 * 1024 * 2;
constexpr size_t WS_W1T   = WS_BTOUT + (size_t)1024 * 1024 * 2;
constexpr size_t WS_W2T   = WS_W1T + (size_t)NE * 2048 * 1024 * 2;
constexpr size_t WS_PRE1  = WS_W2T + (size_t)NE * 1024 * 1024 * 2;
constexpr size_t WS_RA    = WS_PRE1 + (size_t)T * 1024 * 4;
constexpr size_t WS_H     = WS_RA;
constexpr size_t WS_Q     = WS_H + (size_t)TT * 1024 * 2;
constexpr size_t WS_K     = WS_Q + (size_t)T * 256 * 2;
constexpr size_t WS_V     = WS_K + (size_t)TT * 256 * 2;
constexpr size_t WS_G     = WS_V + (size_t)TT * 512 * 2;
constexpr size_t WS_GF    = WS_G + (size_t)T * 512 * 2;
constexpr size_t WS_GB    = WS_GF + (size_t)TT * 256 * 4;
constexpr size_t WS_UT    = WS_GB + (size_t)TT * 256 * 4;
constexpr size_t WS_RA_END= WS_UT + (size_t)NB * HYC * SEQ * 2;
constexpr size_t WS_H2    = WS_RA;
constexpr size_t WS_FG    = WS_RA + (size_t)T * 1024 * 2;
constexpr size_t WS_SLOTS = WS_RA;
constexpr size_t SORTED_BYTES_ = (size_t)(T * 4 / 256 + NE) * 256 * 1024 * 2;
constexpr size_t WS_RB    = al256(WS_RA_END > WS_RA + SORTED_BYTES_ ? WS_RA_END : WS_RA + SORTED_BYTES_);
constexpr size_t WS_KV    = WS_RB;
constexpr size_t WS_AV    = WS_KV + (size_t)2 * 16 * NCT * 8192 * 2;
constexpr size_t WS_SP    = WS_AV + (size_t)2 * 16 * NCT * 64 * 4;
constexpr size_t WS_HSPEC = WS_SP + (size_t)2 * 16 * NCHUNK * 8192 * 2;
constexpr size_t HSPEC_PER_WG = (size_t)2 * FFTN * 8;
constexpr int MAX_GRID = 256;
constexpr size_t WS_YHYT  = WS_HSPEC + (size_t)MAX_GRID * HSPEC_PER_WG;
constexpr size_t WS_MIX   = WS_YHYT + (size_t)NB * HYW * SEQ * 2;
constexpr size_t WS_RB_END= WS_MIX + (size_t)T * 1024 * 2;
constexpr size_t WS_HF    = WS_MIX;
constexpr size_t WS_ACT   = WS_RB;
constexpr size_t SORTED_BYTES = (size_t)(T * 4 / 256 + NE) * 256 * 1024 * 2;
constexpr size_t WS_END   = al256(WS_RB_END > WS_RB + SORTED_BYTES ? WS_RB_END : WS_RB + SORTED_BYTES);

constexpr int LDS_BYTES = 147456;
constexpr int LDS_MISC  = 145408;

typedef __bf16 bf16n2 __attribute__((ext_vector_type(2)));
__device__ __forceinline__ unsigned pk2(float lo, float hi) { bf16n2 v = {(__bf16)lo, (__bf16)hi}; return __builtin_bit_cast(unsigned, v); }
__device__ __forceinline__ bf16_t f2bf(float f) { __bf16 b = (__bf16)f; return __builtin_bit_cast(unsigned short, b); }
__device__ __forceinline__ float bf2f(bf16_t b) { return __uint_as_float(((unsigned)b) << 16); }
__device__ __forceinline__ float bflo(unsigned w) { return __uint_as_float(w << 16); }
__device__ __forceinline__ float bfhi(unsigned w) { return __uint_as_float(w & 0xffff0000u); }
__device__ __forceinline__ float wave_sum(float v) {
#pragma unroll
    for (int o = 1; o < 64; o <<= 1) v += __shfl_xor(v, o);
    return v;
}
__device__ __forceinline__ float silu_f(float x) { return x * __builtin_amdgcn_rcpf(1.f + __expf(-x)); }
__device__ __forceinline__ float log_sigmoid_f(float z) { return fminf(z, 0.f) - __logf(1.f + __expf(-fabsf(z))); }

#define XB_TMO      128
#define XB_XCNT(j)  (256  + 64 * (j))
#define XB_XSUB(j)  (1280 + 64 * (j))
#define XB_XGEN(j)  (2304 + 64 * (j))
#define XB_TOP      3328
#define XB_TOPGEN   3392
#define XCD_BAR_WORDS 3456
#define XB_SPIN_CAP (1u << 22)
__device__ __forceinline__ unsigned xb_ld(unsigned* p)              { return __hip_atomic_load(p, __ATOMIC_RELAXED, __HIP_MEMORY_SCOPE_AGENT); }
__device__ __forceinline__ unsigned xb_add(unsigned* p, unsigned v) { return __hip_atomic_fetch_add(p, v, __ATOMIC_RELAXED, __HIP_MEMORY_SCOPE_AGENT); }
__device__ __forceinline__ unsigned xb_xcc_id() { return (unsigned)__builtin_amdgcn_s_getreg((3 << 11) | 20) & 0xFu; }
#define XB_SPIN(cond, bar) do { unsigned _sp = 0; while (cond) { __builtin_amdgcn_s_sleep(1); \
    if ((++_sp & 255u) == 0u) { if (xb_ld(&(bar)[XB_TMO])) break; if (_sp > XB_SPIN_CAP) { atomicAdd(&(bar)[XB_TMO], 1u); break; } } } } while (0)
struct XcdBarrier { unsigned* bar; unsigned x; volatile LAS unsigned* st; };
__device__ __forceinline__ XcdBarrier xcd_barrier_post(unsigned* bar, volatile LAS unsigned* st) {
    XcdBarrier b; b.bar = bar; b.x = xb_xcc_id(); b.st = st;
    if (threadIdx.x == 0) (void)xb_add(&bar[XB_XCNT(b.x)], 1u);
    return b;
}
__device__ __forceinline__ void xcd_barrier_complete(unsigned* bar, unsigned x, unsigned& nloc, unsigned& nx) {
    const unsigned G = gridDim.x * gridDim.y * gridDim.z;
    unsigned sum, cnt, mine, sp = 0u;
    for (;;) {
        sum = 0u; cnt = 0u; mine = 0u;
#pragma unroll
        for (unsigned j = 0; j < 16; ++j) { const unsigned c = xb_ld(&bar[XB_XCNT(j)]); sum += c; cnt += (c > 0u) ? 1u : 0u; mine = (j == x) ? c : mine; }
        if (sum == G) break;
        __builtin_amdgcn_s_sleep(1);
        if ((++sp & 255u) == 0u) { if (xb_ld(&bar[XB_TMO])) break; if (sp > XB_SPIN_CAP) { atomicAdd(&bar[XB_TMO], 1u); break; } }
    }
    nloc = mine > 0u ? mine : 1u; nx = cnt > 0u ? cnt : 1u;
}
__device__ __forceinline__ void xcd_barrier(const XcdBarrier& b) {
    asm volatile("s_waitcnt vmcnt(0)" ::: "memory");
    __syncthreads();
    if (threadIdx.x == 0) {
        unsigned* bar = b.bar;
        __builtin_amdgcn_s_waitcnt(0);
        unsigned nloc = b.st[0], nx = b.st[1];
        if (nloc == 0u) { xcd_barrier_complete(bar, b.x, nloc, nx); b.st[0] = nloc; b.st[1] = nx; }
        const unsigned old = xb_add(&bar[XB_XSUB(b.x)], 1u);
        const unsigned gen = old / nloc;
        if (old + 1u == (gen + 1u) * nloc) {
            __builtin_amdgcn_fence(__ATOMIC_RELEASE, "agent");
            asm volatile("s_waitcnt vmcnt(0)" ::: "memory");
            const unsigned og = xb_add(&bar[XB_TOP], 1u);
            const unsigned tg = og / nx;
            if (og + 1u == (tg + 1u) * nx) xb_add(&bar[XB_TOPGEN], 1u);
            else XB_SPIN(xb_ld(&bar[XB_TOPGEN]) == tg, bar);
            __builtin_amdgcn_fence(__ATOMIC_ACQUIRE, "agent");
            xb_add(&bar[XB_XGEN(b.x)], 1u);
            asm volatile("s_waitcnt vmcnt(0)" ::: "memory");
        } else {
            XB_SPIN(xb_ld(&bar[XB_XGEN(b.x)]) == gen, bar);
            __builtin_amdgcn_fence(__ATOMIC_ACQUIRE, "agent");
            asm volatile("s_waitcnt vmcnt(0)" ::: "memory");
        }
    }
    __syncthreads();
}

struct Args {
    const float* in[32];
    float* out;
    unsigned char* ws;
    int ph_lo, ph_hi;
};
enum { I_X = 0, I_C, I_CTX, I_CCTX, I_ADAW, I_ADAB, I_WIN, I_WAF, I_BAF, I_WAB, I_BAB, I_NORMG, I_CONVW, I_CONVB, I_FW1, I_FB1, I_FW2, I_FB2, I_FWOUT, I_FFREQ,
       I_BIASD, I_WOUT, I_LN1G, I_LN1B, I_RW, I_RB, I_EW1, I_EB1, I_EW2, I_EB2, I_LN2G, I_LN2B };


namespace gm {
constexpr int BM = 256, BK = 64, HALF = 128, HTB = HALF * BK * 2, STAGE_BYTES = 8 * HTB, KD = 1024, NT = KD / BK;
constexpr int ROWB = KD * 2;
__device__ __forceinline__ int lds_byte(int r, int c) { const int st = (r >> 4) * 2 + (c >> 5), rr = r & 15, cc = c & 31, ob = rr * 64 + cc * 2; return st * 1024 + (ob ^ (((ob >> 9) & 1) << 5)); }
__device__ __forceinline__ void stage_rc(int b, int& R, int& C) { const int st = b / 1024, sb = b % 1024, swz = sb ^ (((sb >> 9) & 1) << 5); R = (st >> 1) * 16 + swz / 64; C = (st & 1) * 32 + (swz % 64) / 2; }
__device__ __forceinline__ int perm32(int rho) { const int n = rho >> 4, i = rho & 15; return 8 * (i >> 2) + 4 * n + (i & 3); }

constexpr int LDS_BIAS = STAGE_BYTES + 4096;
struct Unit {
    const char* A;
    const char* B;
    const int* list;
    int type, row0, col0, valid, aux;
};

template <bool GATHER, int GSHIFT>
__device__ __forceinline__ void a_offsets(const Unit& u, unsigned (&o)[2][2]) {
    int R[2], Cb[2];
    int tz = threadIdx.x; asm volatile("" : "+v"(tz));
#pragma unroll
    for (int i = 0; i < 2; ++i) { int r, c; stage_rc(tz * 16 + i * 8192, r, c); R[i] = r; Cb[i] = c * 2; }
#pragma unroll
    for (int h = 0; h < 2; ++h)
#pragma unroll
        for (int i = 0; i < 2; ++i) {
            const int r = h * HALF + R[i];
            if (!GATHER) o[h][i] = (unsigned)(r * ROWB + Cb[i]);
            else { const int idx = u.list[r < u.valid ? r : 0]; o[h][i] = (unsigned)(idx >> GSHIFT) * (unsigned)ROWB + (unsigned)Cb[i]; }
        }
}

template <bool GATHER, int GSHIFT, class Sched, class Epi>
__device__ __forceinline__ void gemm_stream(LAS unsigned char* lds, const Sched& S, const Epi& E) {
    const int tid = threadIdx.x, wid = __builtin_amdgcn_readfirstlane(tid >> 6), lane = tid & 63, wr = wid >> 2, wc = wid & 3, fr = lane & 15, fq = lane >> 4;
    unsigned voffB[2];
#pragma unroll
    for (int i = 0; i < 2; ++i) { int r, c; stage_rc(tid * 16 + i * 8192, r, c); const int rb = (r & ~31) + perm32(r & 31); voffB[i] = (unsigned)(rb * ROWB + c * 2); }
    const size_t kstep = (size_t)(BK * 2), hstep = (size_t)HALF * ROWB;
    const unsigned ldsw = (unsigned)wid * 1024u;
    const int aoff = lds_byte(wr * 64 + fr, fq * 8), boff = lds_byte(wc * 32 + fr, fq * 8);
#define GM_SA(b, h) (((b) * 2 + (h)) * HTB)
#define GM_SB(b, h) ((4 + (b) * 2 + (h)) * HTB)
#define GM_STAGE(bufoff, gbase, vo0, vo1) do { \
        __builtin_amdgcn_global_load_lds((const unsigned*)((const char*)(gbase) + (vo0)), (LAS unsigned*)(lds + (bufoff) + ldsw), 16, 0, 0); \
        __builtin_amdgcn_global_load_lds((const unsigned*)((const char*)(gbase) + (vo1)), (LAS unsigned*)(lds + (bufoff) + ldsw + 8192), 16, 0, 0); } while (0)
#define GM_LDA(dst, b, h) do { _Pragma("unroll") for (int m = 0; m < 4; ++m) _Pragma("unroll") for (int k = 0; k < 2; ++k) dst[m][k] = *(const LAS bf16x8*)(lds + GM_SA(b, h) + aoff + m * 2048 + k * 1024); } while (0)
#define GM_LDB(dst, b, h) do { _Pragma("unroll") for (int n = 0; n < 2; ++n) _Pragma("unroll") for (int k = 0; k < 2; ++k) dst[n][k] = *(const LAS bf16x8*)(lds + GM_SB(b, h) + boff + n * 2048 + k * 1024); } while (0)
#define GM_MMA(ai, bj, At, Bt) do { __builtin_amdgcn_s_setprio(1); _Pragma("unroll") for (int m = 0; m < 4; ++m) _Pragma("unroll") for (int n = 0; n < 2; ++n) _Pragma("unroll") for (int k = 0; k < 2; ++k) \
        acc[ai][bj][m][n] = __builtin_amdgcn_mfma_f32_16x16x32_bf16(Bt[n][k], At[m][k], acc[ai][bj][m][n], 0, 0, 0); __builtin_amdgcn_s_setprio(0); } while (0)
#define GM_WAIT_V(n) asm volatile("s_waitcnt vmcnt(" #n ")" ::: "memory")
#define GM_WAIT_L(n) asm volatile("s_waitcnt lgkmcnt(" #n ")" ::: "memory")
#define GM_BAR __builtin_amdgcn_s_barrier()
#define GM_SCHED __builtin_amdgcn_sched_barrier(0)
    Unit cur, nxt; int ui = 0;
    if (!S.next(0, cur)) return;
    f32x4 acc[2][2][4][2];
#pragma unroll
    for (int a = 0; a < 2; ++a)
#pragma unroll
        for (int b = 0; b < 2; ++b)
#pragma unroll
            for (int m = 0; m < 4; ++m)
#pragma unroll
                for (int n = 0; n < 2; ++n) acc[a][b][m][n] = (f32x4){0.f, 0.f, 0.f, 0.f};
    bf16x8 At[4][2], B0[2][2], B1[2][2];
    unsigned ca[2][2], na[2][2];
    a_offsets<GATHER, GSHIFT>(cur, ca);
    const char* cA = cur.A; const char* cB = cur.B;
    GM_STAGE(GM_SB(0, 0), cB, voffB[0], voffB[1]); GM_STAGE(GM_SA(0, 0), cA, ca[0][0], ca[0][1]); GM_STAGE(GM_SB(0, 1), cB + hstep, voffB[0], voffB[1]); GM_STAGE(GM_SA(0, 1), cA, ca[1][0], ca[1][1]);
    if (wr == 1) GM_BAR;
    GM_WAIT_V(4); GM_BAR;
    GM_STAGE(GM_SB(1, 0), cB + kstep, voffB[0], voffB[1]); GM_STAGE(GM_SA(1, 0), cA + kstep, ca[0][0], ca[0][1]); GM_STAGE(GM_SB(1, 1), cB + hstep + kstep, voffB[0], voffB[1]);
    GM_WAIT_V(6); GM_BAR;
    for (;;) {
        const bool has_next = S.next(ui + 1, nxt);
        if (has_next) a_offsets<GATHER, GSHIFT>(nxt, na);
        else {
#pragma unroll
            for (int h = 0; h < 2; ++h)
#pragma unroll
                for (int i = 0; i < 2; ++i) na[h][i] = ca[h][i];
        }
        const char* nA = has_next ? nxt.A : cA; const char* nB = has_next ? nxt.B : cB;
        if (wid == 0)
            __builtin_amdgcn_global_load_lds((const unsigned*)(S.bias(cur) + 4 * lane), (LAS unsigned*)(lds + LDS_BIAS + (ui & 1) * 1024), 16, 0, 0);
        for (int t = 0; t < NT; t += 2) {
            const bool last = (t == NT - 2);

            const char* a1 = cA + (size_t)(t + 1) * kstep;
            const char* a2 = last ? nA : cA + (size_t)(t + 2) * kstep; const char* b2 = last ? nB : cB + (size_t)(t + 2) * kstep;
            const char* a3 = a2 + kstep; const char* b3 = b2 + kstep;
            const unsigned x00 = last ? na[0][0] : ca[0][0], x01 = last ? na[0][1] : ca[0][1], x10 = last ? na[1][0] : ca[1][0], x11 = last ? na[1][1] : ca[1][1];
            GM_LDB(B0, 0, 0); GM_SCHED; GM_LDA(At, 0, 0); GM_STAGE(GM_SA(1, 1), a1, ca[1][0], ca[1][1]);
            GM_WAIT_L(8); GM_BAR; GM_WAIT_L(0); GM_MMA(0, 0, At, B0); GM_BAR; GM_SCHED;
            GM_LDB(B1, 0, 1); GM_STAGE(GM_SB(0, 0), b2, voffB[0], voffB[1]);
            GM_BAR; GM_WAIT_L(0); GM_MMA(0, 1, At, B1); GM_BAR;
            GM_LDA(At, 0, 1); GM_STAGE(GM_SA(0, 0), a2, x00, x01);
            GM_BAR; GM_WAIT_L(0); GM_MMA(1, 0, At, B0); GM_BAR; GM_SCHED;
            GM_STAGE(GM_SB(0, 1), b2 + hstep, voffB[0], voffB[1]);
            GM_WAIT_V(6); GM_BAR; GM_MMA(1, 1, At, B1); GM_BAR;
            GM_LDB(B0, 1, 0); GM_SCHED; GM_LDA(At, 1, 0); GM_STAGE(GM_SA(0, 1), a2, x10, x11);
            GM_WAIT_L(8); GM_BAR; GM_WAIT_L(0); GM_MMA(0, 0, At, B0); GM_BAR; GM_SCHED;
            GM_LDB(B1, 1, 1); GM_STAGE(GM_SB(1, 0), b3, voffB[0], voffB[1]);
            GM_BAR; GM_WAIT_L(0); GM_MMA(0, 1, At, B1); GM_BAR;
            GM_LDA(At, 1, 1); GM_STAGE(GM_SA(1, 0), a3, x00, x01);
            GM_BAR; GM_WAIT_L(0); GM_MMA(1, 0, At, B0); GM_BAR; GM_SCHED;
            GM_STAGE(GM_SB(1, 1), b3 + hstep, voffB[0], voffB[1]);
            GM_WAIT_V(6); GM_BAR; GM_MMA(1, 1, At, B1); GM_BAR;
        }
        E(acc, cur, wr, wc, fr, fq, (const LAS float*)(lds + LDS_BIAS + (ui & 1) * 1024));
        if (!has_next) break;
#pragma unroll
        for (int a = 0; a < 2; ++a)
#pragma unroll
            for (int b = 0; b < 2; ++b)
#pragma unroll
                for (int m = 0; m < 4; ++m)
#pragma unroll
                    for (int n = 0; n < 2; ++n) acc[a][b][m][n] = (f32x4){0.f, 0.f, 0.f, 0.f};
        cur = nxt; cA = nA; cB = nB; ++ui;
#pragma unroll
        for (int h = 0; h < 2; ++h)
#pragma unroll
            for (int i = 0; i < 2; ++i) ca[h][i] = na[h][i];
    }
    GM_WAIT_V(0);
    if (wr == 0) GM_BAR;
    GM_BAR;
#undef GM_SA
#undef GM_SB
#undef GM_STAGE
#undef GM_LDA
#undef GM_LDB
#undef GM_MMA
#undef GM_WAIT_V
#undef GM_WAIT_L
#undef GM_BAR
#undef GM_SCHED
}

__device__ __forceinline__ u32x4 pack8(f32x4 a, f32x4 b) { u32x4 w; w.x = pk2(a[0], a[1]); w.y = pk2(a[2], a[3]); w.z = pk2(b[0], b[1]); w.w = pk2(b[2], b[3]); return w; }

struct SchedIn {
    unsigned char* ws; int G, c; const float* baf; const float* bab;
    __device__ __forceinline__ bool next(int i, Unit& u) const {
        int L = i * G + c;
        u.list = nullptr; u.valid = 256; u.aux = 0;
        if (L < 768) {
            const int pa = L % 6, pb = L / 6;
            u.A = (const char*)(ws + WS_BTIN) + (size_t)(2048 + 256 * pa) * ROWB; u.B = (const char*)(ws + WS_H) + (size_t)(256 * pb) * ROWB;
            u.type = 2; u.row0 = 256 * pa; u.col0 = 256 * pb; return true;
        }
        L -= 768;
        if (L < 1024) {
            const int pm = L >> 3, pn = ((L & 7) + (L >> 8)) & 7;
            u.A = (const char*)(ws + WS_H) + (size_t)(256 * pm) * ROWB; u.B = (const char*)(ws + WS_BTIN) + (size_t)(256 * pn) * ROWB;
            u.type = pn < 6 ? 0 : 1; u.row0 = 256 * pm; u.col0 = pn; return true;
        }
        L -= 1024;
        if (L < 20) {
            const int pm = L / 5, j = L % 5, pn = j == 0 ? 1 : (j == 1 ? 2 : (j == 2 ? 3 : (j == 3 ? 6 : 7)));
            u.A = (const char*)(ws + WS_H) + (size_t)(T + 256 * pm) * ROWB; u.B = (const char*)(ws + WS_BTIN) + (size_t)(256 * pn) * ROWB;
            u.type = pn < 6 ? 0 : 1; u.row0 = T + 256 * pm; u.col0 = pn; return true;
        }
        return false;
    }
    __device__ __forceinline__ const float* bias(const Unit& u) const { return (u.type == 1 && u.col0 == 7) ? bab : baf; }
};
struct EpiIn {
    unsigned char* ws;
    __device__ __forceinline__ void operator()(const f32x4 (&acc)[2][2][4][2], const Unit& u, int wr, int wc, int fr, int fq, const LAS float* bs) const {
        const int rl = wr * 64 + fr, cl = wc * 32 + 8 * fq;
        if (u.type == 0) {
            const int pn = u.col0;
            bf16_t* dst; int ld, cb;
            if (pn == 0) { dst = (bf16_t*)(ws + WS_Q); ld = 256; cb = 0; }
            else if (pn == 1) { dst = (bf16_t*)(ws + WS_K); ld = 256; cb = 0; }
            else if (pn < 4) { dst = (bf16_t*)(ws + WS_V); ld = 512; cb = (pn - 2) * 256; }
            else { dst = (bf16_t*)(ws + WS_G); ld = 512; cb = (pn - 4) * 256; }
#pragma unroll
            for (int ai = 0; ai < 2; ++ai)
#pragma unroll
                for (int m = 0; m < 4; ++m) { bf16_t* rowp = dst + (size_t)(u.row0 + rl + ai * 128 + m * 16) * ld + cb + cl;
#pragma unroll
                    for (int bj = 0; bj < 2; ++bj) *(u32x4*)(rowp + bj * 128) = pack8(acc[ai][bj][m][0], acc[ai][bj][m][1]); }
        } else if (u.type == 1) {
            float* dst = (float*)(ws + (u.col0 == 6 ? WS_GF : WS_GB));
            f32x4 bv[2][2];
#pragma unroll
            for (int bj = 0; bj < 2; ++bj)
#pragma unroll
                for (int n = 0; n < 2; ++n) bv[bj][n] = *(const LAS f32x4*)(bs + cl + bj * 128 + 4 * n);
#pragma unroll
            for (int ai = 0; ai < 2; ++ai)
#pragma unroll
                for (int m = 0; m < 4; ++m) { float* rowp = dst + (size_t)(u.row0 + rl + ai * 128 + m * 16) * 256 + cl;
#pragma unroll
                    for (int bj = 0; bj < 2; ++bj)
#pragma unroll
                        for (int n = 0; n < 2; ++n) { f32x4 z = acc[ai][bj][m][n] + bv[bj][n], o;
#pragma unroll
                            for (int j = 0; j < 4; ++j) o[j] = log_sigmoid_f(z[j]) * (1.f / 16.f);
                            *(f32x4*)(rowp + bj * 128 + 4 * n) = o; } }
        } else {
            const int b = u.col0 >> 13, l0 = u.col0 & 8191;
            bf16_t* dst = (bf16_t*)(ws + WS_UT) + ((size_t)b * HYC) * SEQ + l0 + cl;
#pragma unroll
            for (int ai = 0; ai < 2; ++ai)
#pragma unroll
                for (int m = 0; m < 4; ++m) { bf16_t* rowp = dst + (size_t)(u.row0 + rl + ai * 128 + m * 16) * SEQ;
#pragma unroll
                    for (int bj = 0; bj < 2; ++bj) *(u32x4*)(rowp + bj * 128) = pack8(acc[ai][bj][m][0], acc[ai][bj][m][1]); }
        }
    }
};

struct SchedOut {
    unsigned char* ws; int G, c;
    __device__ __forceinline__ bool next(int i, Unit& u) const {
        const int L = i * G + c; if (L >= 512) return false;
        const int pm = L >> 2, pn = L & 3;
        u.A = (const char*)(ws + WS_MIX) + (size_t)(256 * pm) * ROWB; u.B = (const char*)(ws + WS_BTOUT) + (size_t)(256 * pn) * ROWB;
        u.list = nullptr; u.valid = 256; u.aux = 0; u.type = 3; u.row0 = 256 * pm; u.col0 = 256 * pn; return true;
    }
    __device__ __forceinline__ const float* bias(const Unit& u) const { return (const float*)(ws + WS_MOD) + (u.row0 >> 13) * 6144 + 2 * 1024 + u.col0; }
};
struct EpiOut {
    unsigned char* ws;
    __device__ __forceinline__ void operator()(const f32x4 (&acc)[2][2][4][2], const Unit& u, int wr, int wc, int fr, int fq, const LAS float* bs) const {
        const int rl = wr * 64 + fr, cl = u.col0 + wc * 32 + 8 * fq;
        bf16_t* fg = (bf16_t*)(ws + WS_FG);
        f32x4 gv[2][2];
#pragma unroll
        for (int bj = 0; bj < 2; ++bj)
#pragma unroll
            for (int n = 0; n < 2; ++n) gv[bj][n] = *(const LAS f32x4*)(bs + wc * 32 + 8 * fq + bj * 128 + 4 * n);
#pragma unroll
        for (int ai = 0; ai < 2; ++ai)
#pragma unroll
            for (int m = 0; m < 4; ++m) { bf16_t* rowp = fg + (size_t)(u.row0 + rl + ai * 128 + m * 16) * 1024 + cl;
#pragma unroll
                for (int bj = 0; bj < 2; ++bj) *(u32x4*)(rowp + bj * 128) = pack8(gv[bj][0] * acc[ai][bj][m][0], gv[bj][1] * acc[ai][bj][m][1]); }
    }
};

constexpr int LDS_TAB = STAGE_BYTES;
template <int WHICH>
struct SchedMoe {
    unsigned char* ws; const LAS int* tab; int G, c; const float* b2;
    __device__ __forceinline__ bool next(int i, Unit& u) const {
        constexpr int NCT_ = WHICH == 1 ? 8 : 4;
        const int L = i * G + c; const int nrt = tab[32];
        if (L >= nrt * NCT_) return false;
        const int rt = L / NCT_, ct = L % NCT_;
        const int info = tab[64 + rt], e = info & 255, r0 = (info >> 8) * 256;
        const int cnt = tab[e];
        u.valid = (cnt - r0) < 256 ? (cnt - r0) : 256;
        u.list = (const int*)(ws + WS_LIST) + (size_t)e * CAP + r0;
        u.A = (WHICH == 1) ? (const char*)(ws + WS_H2) : (const char*)(ws + WS_ACT) + (size_t)(256 * rt) * ROWB;
        u.B = (const char*)(ws + (WHICH == 1 ? WS_W1T : WS_W2T)) + ((size_t)e * (WHICH == 1 ? 2048 : 1024) + 256 * ct) * ROWB;
        u.type = 3 + WHICH; u.row0 = 256 * rt; u.col0 = ct; u.aux = e; return true;
    }
    __device__ __forceinline__ const float* bias(const Unit& u) const { return (WHICH == 1) ? (const float*)(ws + WS_B1R) + (size_t)u.aux * 2048 + 256 * u.col0 : b2 + (size_t)u.aux * 1024 + 256 * u.col0; }
};
__device__ __forceinline__ float swiglu_f(float glu, float lin) {
    glu = fminf(glu, 7.f); lin = fminf(fmaxf(lin, -7.f), 7.f);
    return glu * __builtin_amdgcn_rcpf(1.f + __expf(-1.702f * glu)) * (lin + 1.f);
}
struct EpiMoe1 {
    unsigned char* ws;
    __device__ __forceinline__ void operator()(const f32x4 (&acc)[2][2][4][2], const Unit& u, int wr, int wc, int fr, int fq, const LAS float* bs) const {
        const int rl = wr * 64 + fr, cl = wc * 32 + 8 * fq, ct = u.col0;
        const LAS float* b1 = bs + cl;
        bf16_t* act = (bf16_t*)(ws + WS_ACT) + (size_t)u.row0 * 1024 + 128 * ct + cl;
        f32x4 bg[2], bl[2];
#pragma unroll
        for (int n = 0; n < 2; ++n) { bg[n] = *(const LAS f32x4*)(b1 + 4 * n); bl[n] = *(const LAS f32x4*)(b1 + 128 + 4 * n); }
#pragma unroll
        for (int ai = 0; ai < 2; ++ai)
#pragma unroll
            for (int m = 0; m < 4; ++m) { const int r = rl + ai * 128 + m * 16;
                f32x4 o[2];
#pragma unroll
                for (int n = 0; n < 2; ++n) { const f32x4 gl = acc[ai][0][m][n] + bg[n], li = acc[ai][1][m][n] + bl[n];
#pragma unroll
                    for (int j = 0; j < 4; ++j) o[n][j] = swiglu_f(gl[j], li[j]); }
                *(u32x4*)(act + (size_t)r * 1024) = pack8(o[0], o[1]); }
    }
};
struct EpiMoe2 {
    unsigned char* ws;
    __device__ __forceinline__ void operator()(const f32x4 (&acc)[2][2][4][2], const Unit& u, int wr, int wc, int fr, int fq, const LAS float* bs) const {
        const int rl = wr * 64 + fr, cl = wc * 32 + 8 * fq, ct = u.col0;
        const LAS float* bb = bs + cl;
        bf16_t* slots = (bf16_t*)(ws + WS_SLOTS) + (size_t)u.row0 * 1024 + 256 * ct + cl;
        f32x4 bv[2][2];
#pragma unroll
        for (int bj = 0; bj < 2; ++bj)
#pragma unroll
            for (int n = 0; n < 2; ++n) bv[bj][n] = *(const LAS f32x4*)(bb + bj * 128 + 4 * n);
#pragma unroll
        for (int ai = 0; ai < 2; ++ai)
#pragma unroll
            for (int m = 0; m < 4; ++m) { const int r = rl + ai * 128 + m * 16;
#pragma unroll
                for (int bj = 0; bj < 2; ++bj)
                    *(u32x4*)(slots + (size_t)r * 1024 + bj * 128) = pack8(acc[ai][bj][m][0] + bv[bj][0], acc[ai][bj][m][1] + bv[bj][1]); }
    }
};
}

namespace hy {
__device__ __forceinline__ int phys(int n) { return n + (n >> 4) + ((n >> 9) << 4); }
constexpr int XSIZE = 16384 + 1024 + 512;

__device__ __forceinline__ float tw_c(int i) {
    constexpr float t[16] = {1.f, 0.98078528040323043f, 0.92387953251128674f, 0.83146961230254524f, 0.70710678118654752f, 0.55557023301960218f, 0.38268343236508977f, 0.19509032201612825f,
                             0.f, -0.19509032201612825f, -0.38268343236508977f, -0.55557023301960218f, -0.70710678118654752f, -0.83146961230254524f, -0.92387953251128674f, -0.98078528040323043f};
    return t[i];
}
__device__ __forceinline__ float tw_s(int i) {
    constexpr float t[16] = {0.f, 0.19509032201612825f, 0.38268343236508977f, 0.55557023301960218f, 0.70710678118654752f, 0.83146961230254524f, 0.92387953251128674f, 0.98078528040323043f,
                             1.f, 0.98078528040323043f, 0.92387953251128674f, 0.83146961230254524f, 0.70710678118654752f, 0.55557023301960218f, 0.38268343236508977f, 0.19509032201612825f};
    return t[i];
}
__host__ __device__ constexpr int brev(int p, int bits) { int r = 0; for (int i = 0; i < bits; ++i) r |= ((p >> i) & 1) << (bits - 1 - i); return r; }

template <int R, bool INV>
__device__ __forceinline__ void fft_reg(f32x2 (&v)[R]) {
#pragma unroll
    for (int s = R / 2; s >= 1; s >>= 1) {
#pragma unroll
        for (int g = 0; g < R; g += 2 * s) {
#pragma unroll
            for (int k = 0; k < s; ++k) {
                const f32x2 a = v[g + k], b = v[g + k + s];
                v[g + k] = a + b;
                const f32x2 t = a - b;
                const int ti = k * (16 / s);
                f32x2 o;
                if (ti == 0) o = t;
                else if (ti == 8) { if (INV) { o[0] = -t[1]; o[1] = t[0]; } else { o[0] = t[1]; o[1] = -t[0]; } }
                else { const float c = tw_c(ti), sn = tw_s(ti);
                    if (INV) { o[0] = t[0] * c - t[1] * sn; o[1] = t[1] * c + t[0] * sn; }
                    else     { o[0] = t[0] * c + t[1] * sn; o[1] = t[1] * c - t[0] * sn; } }
                v[g + k + s] = o;
            }
        }
    }
}
__device__ __forceinline__ f32x2 cmul(f32x2 a, f32x2 b) { f32x2 r; r[0] = a[0] * b[0] - a[1] * b[1]; r[1] = a[0] * b[1] + a[1] * b[0]; return r; }

template <int M, bool ZPAD = false>
__device__ __forceinline__ void pass_fwd32(LAS f32x2* X, int tid) {
    int j = (M == 512) ? tid : (tid & 15);
    asm volatile("" : "+v"(j));
    const int p0 = (M == 512) ? (tid + (tid >> 4)) : (560 * (tid >> 4) + (tid & 15));
    constexpr int PS = (M == 512) ? 560 : 17;
    f32x2 v[32];
#pragma unroll
    for (int r = 0; r < 32; ++r) { if (ZPAD && r >= 16) v[r] = (f32x2){0.f, 0.f}; else v[r] = X[p0 + PS * r]; }
    fft_reg<32, false>(v);
    float sn, cs; sincospif(-2.f * (float)j / (float)(32 * M), &sn, &cs);
    const f32x2 w1 = {cs, sn}; f32x2 w = w1;
    X[p0] = v[0];
#pragma unroll
    for (int rp = 1; rp < 32; ++rp) { X[p0 + PS * rp] = cmul(v[brev(rp, 5)], w); w = cmul(w, w1); }
}
template <int M, bool HALF = false>
__device__ __forceinline__ void pass_inv32(LAS f32x2* X, int tid) {
    int j = (M == 512) ? tid : (tid & 15);
    asm volatile("" : "+v"(j));
    const int p0 = (M == 512) ? (tid + (tid >> 4)) : (560 * (tid >> 4) + (tid & 15));
    constexpr int PS = (M == 512) ? 560 : 17;
    float sn, cs; sincospif(2.f * (float)j / (float)(32 * M), &sn, &cs);
    const f32x2 w1 = {cs, sn}; f32x2 w = w1;
    f32x2 v[32];
    v[0] = X[p0];
#pragma unroll
    for (int rp = 1; rp < 32; ++rp) { v[rp] = cmul(X[p0 + PS * rp], w); w = cmul(w, w1); }
    fft_reg<32, true>(v);
#pragma unroll
    for (int p = 0; p < 32; ++p) { if (!HALF || brev(p, 5) < 16) X[p0 + PS * brev(p, 5)] = v[p]; }
}
__device__ __forceinline__ void pass_c_store(const LAS f32x2* X, f32x2* Hs, int tid, float scale) {
#pragma unroll
    for (int u = 0; u < 2; ++u) { const int blk = tid + 512 * u, p0 = 17 * blk + 16 * (blk >> 5);
        f32x2 v[16];
#pragma unroll
        for (int r = 0; r < 16; ++r) v[r] = X[p0 + r];
        fft_reg<16, false>(v);
#pragma unroll
        for (int q = 0; q < 8; ++q) { const f32x2 x0 = v[brev(2 * q, 4)] * scale, x1 = v[brev(2 * q + 1, 4)] * scale;
            *(f32x4*)(Hs + 16 * blk + 2 * q) = (f32x4){x0[0], x0[1], x1[0], x1[1]}; } }
}
__device__ __forceinline__ void pass_c_mul_inv(LAS f32x2* X, const f32x2* Hs, int tid) {
#pragma unroll
    for (int u = 0; u < 2; ++u) { const int blk = tid + 512 * u, p0 = 17 * blk + 16 * (blk >> 5);
        f32x2 v[16], w[16];
#pragma unroll
        for (int r = 0; r < 16; ++r) v[r] = X[p0 + r];
        f32x4 hh[8];
#pragma unroll
        for (int q = 0; q < 8; ++q) hh[q] = *(const f32x4*)(Hs + 16 * blk + 2 * q);
        fft_reg<16, false>(v);
#pragma unroll
        for (int q = 0; q < 8; ++q) { w[2 * q] = cmul(v[brev(2 * q, 4)], (f32x2){hh[q][0], hh[q][1]}); w[2 * q + 1] = cmul(v[brev(2 * q + 1, 4)], (f32x2){hh[q][2], hh[q][3]}); }
        fft_reg<16, true>(w);
#pragma unroll
        for (int p = 0; p < 16; ++p) X[p0 + brev(p, 4)] = w[p]; }
}
__device__ __forceinline__ void load16(const bf16_t* u, float (&e)[16]) {
    const u32x4 a = *(const u32x4*)u, b = *(const u32x4*)(u + 8);
    e[0] = bflo(a.x); e[1] = bfhi(a.x); e[2] = bflo(a.y); e[3] = bfhi(a.y); e[4] = bflo(a.z); e[5] = bfhi(a.z); e[6] = bflo(a.w); e[7] = bfhi(a.w);
    e[8] = bflo(b.x); e[9] = bfhi(b.x); e[10] = bflo(b.y); e[11] = bfhi(b.y); e[12] = bflo(b.z); e[13] = bfhi(b.z); e[14] = bflo(b.w); e[15] = bfhi(b.w);
}
__device__ __forceinline__ void sconv16(const bf16_t* u, int tid, float w0, float w1, float w2, float bias, float (&o)[16]) {
    float e[16]; load16(u + 16 * tid, e);
    float lf = __shfl_up(e[15], 1), rt = __shfl_down(e[0], 1);
    if ((tid & 3) == 0) lf = 0.f;
    if ((tid & 3) == 3) rt = 0.f;
    o[0] = w0 * lf + w1 * e[0] + w2 * e[1] + bias;
#pragma unroll
    for (int i = 1; i < 15; ++i) o[i] = w0 * e[i - 1] + w1 * e[i] + w2 * e[i + 1] + bias;
    o[15] = w0 * e[14] + w1 * e[15] + w2 * rt + bias;
}

__device__ __forceinline__ void channel(const Args& a, LAS unsigned char* lds, int c, unsigned char* scratch) {
    const int tid = threadIdx.x;
    LAS f32x2* X = (LAS f32x2*)lds;
    f32x2* Hs = (f32x2*)scratch;
    const float* HF = (const float*)(a.ws + WS_HF);
    const int pc = 17 * tid + 16 * (tid >> 5);
    __syncthreads();
#pragma unroll 1
    for (int o = 0; o < 2; ++o) {
        const f32x4* hf = (const f32x4*)(HF + ((size_t)(2 * o) * HYW + c) * SEQ + 16 * tid); const f32x4* hb = (const f32x4*)(HF + ((size_t)(2 * o + 1) * HYW + c) * SEQ + 16 * tid);
#pragma unroll
        for (int q = 0; q < 4; ++q) { const f32x4 f = hf[q], b = hb[q];
#pragma unroll
            for (int e = 0; e < 4; ++e) { const int i = 4 * q + e, t = 16 * tid + i;
                X[pc + i] = (f32x2){f[e], 0.f};
                if (t >= 1) X[phys(FFTN - t)] = (f32x2){b[e], 0.f}; } }
        if (tid == 0) X[phys(SEQ)] = (f32x2){0.f, 0.f};
        __syncthreads();
        pass_fwd32<512>(X, tid); __syncthreads(); pass_fwd32<16>(X, tid); __syncthreads(); pass_c_store(X, Hs + (size_t)o * FFTN, tid, 1.f / (float)FFTN); __syncthreads();
    }
    const float* cw = a.in[I_CONVW]; const float* cbv = a.in[I_CONVB]; const float* dbias = a.in[I_BIASD];
    const float d1 = dbias[c], d2 = dbias[HYW + c];
    float wv[3][3], bv[3];
#pragma unroll
    for (int s = 0; s < 3; ++s) { bv[s] = cbv[s * HYW + c];
#pragma unroll
        for (int i = 0; i < 3; ++i) wv[s][i] = cw[i * HYC + s * HYW + c]; }
    const bf16_t* UT = (const bf16_t*)(a.ws + WS_UT);
    bf16_t* YT = (bf16_t*)(a.ws + WS_YHYT);
#pragma unroll 1
    for (int bp = 0; bp < 2; ++bp) {
        const bf16_t* u0 = UT + ((size_t)(2 * bp) * HYC + c) * SEQ; const bf16_t* u1 = UT + ((size_t)(2 * bp + 1) * HYC + c) * SEQ;
        float z0[16], z1[16];
        {
            float v0[16], v1[16]; sconv16(u0, tid, wv[0][0], wv[0][1], wv[0][2], bv[0], v0); sconv16(u1, tid, wv[0][0], wv[0][1], wv[0][2], bv[0], v1);
#pragma unroll
            for (int i = 0; i < 16; ++i) X[pc + i] = (f32x2){v0[i], v1[i]};
        }
        __syncthreads();
        pass_fwd32<512, true>(X, tid); __syncthreads(); pass_fwd32<16>(X, tid); __syncthreads(); pass_c_mul_inv(X, Hs, tid); __syncthreads(); pass_inv32<16>(X, tid); __syncthreads(); pass_inv32<512, true>(X, tid); __syncthreads();
        {
            float v0[16], v1[16], x0[16], x1[16];
            sconv16(u0, tid, wv[0][0], wv[0][1], wv[0][2], bv[0], v0); sconv16(u1, tid, wv[0][0], wv[0][1], wv[0][2], bv[0], v1);
            sconv16(u0 + (size_t)HYW * SEQ, tid, wv[1][0], wv[1][1], wv[1][2], bv[1], x0); sconv16(u1 + (size_t)HYW * SEQ, tid, wv[1][0], wv[1][1], wv[1][2], bv[1], x1);
#pragma unroll
            for (int i = 0; i < 16; ++i) { const f32x2 y1 = X[pc + i]; z0[i] = x0[i] * (y1[0] + d1 * v0[i]); z1[i] = x1[i] * (y1[1] + d1 * v1[i]); X[pc + i] = (f32x2){z0[i], z1[i]}; }
        }
        __syncthreads();
        pass_fwd32<512, true>(X, tid); __syncthreads(); pass_fwd32<16>(X, tid); __syncthreads(); pass_c_mul_inv(X, Hs + FFTN, tid); __syncthreads(); pass_inv32<16>(X, tid); __syncthreads(); pass_inv32<512, true>(X, tid); __syncthreads();
        {
            float x0[16], x1[16];
            sconv16(u0 + (size_t)2 * HYW * SEQ, tid, wv[2][0], wv[2][1], wv[2][2], bv[2], x0); sconv16(u1 + (size_t)2 * HYW * SEQ, tid, wv[2][0], wv[2][1], wv[2][2], bv[2], x1);
            unsigned w0[8], w1[8];
#pragma unroll
            for (int i = 0; i < 8; ++i) { const f32x2 ya = X[pc + 2 * i], yb = X[pc + 2 * i + 1];
                w0[i] = pk2(x0[2 * i] * (ya[0] + d2 * z0[2 * i]), x0[2 * i + 1] * (yb[0] + d2 * z0[2 * i + 1]));
                w1[i] = pk2(x1[2 * i] * (ya[1] + d2 * z1[2 * i]), x1[2 * i + 1] * (yb[1] + d2 * z1[2 * i + 1])); }
            u32x4* y0p = (u32x4*)(YT + ((size_t)(2 * bp) * HYW + c) * SEQ + 16 * tid); u32x4* y1p = (u32x4*)(YT + ((size_t)(2 * bp + 1) * HYW + c) * SEQ + 16 * tid);
            y0p[0] = (u32x4){w0[0], w0[1], w0[2], w0[3]}; y0p[1] = (u32x4){w0[4], w0[5], w0[6], w0[7]};
            y1p[0] = (u32x4){w1[0], w1[1], w1[2], w1[3]}; y1p[1] = (u32x4){w1[4], w1[5], w1[6], w1[7]};
        }
        __syncthreads();
    }
}

__device__ __forceinline__ void filter_item(const Args& a, int item, int lane) {
    const int ct = item & 127, tc = item >> 7;
    const float* hid2 = (const float*)(a.ws + WS_HID2); const float* wout = a.in[I_FWOUT]; float* HF = (float*)(a.ws + WS_HF);
    const int col = 16 * ct + (lane & 15), kq = lane >> 4, cch = col & 511;
    float bf[16];
#pragma unroll
    for (int s = 0; s < 16; ++s) bf[s] = wout[(size_t)(16 * kq + s) * 2048 + col];
    const float dlt = fabsf(-3.0701134573253945f + (float)cch * ((-15.350567286626973f + 3.0701134573253945f) / 511.f));
#pragma unroll 2
    for (int tt = 0; tt < 32; ++tt) { const int t0 = 512 * tc + 16 * tt;
        const f32x4* ar = (const f32x4*)(hid2 + (size_t)(t0 + (lane & 15)) * 64 + 16 * kq);
        const f32x4 a0 = ar[0], a1 = ar[1], a2 = ar[2], a3 = ar[3];
        f32x4 acc = {0.f, 0.f, 0.f, 0.f};
#pragma unroll
        for (int e = 0; e < 4; ++e) { acc = __builtin_amdgcn_mfma_f32_16x16x4f32(a0[e], bf[e], acc, 0, 0, 0); }
#pragma unroll
        for (int e = 0; e < 4; ++e) { acc = __builtin_amdgcn_mfma_f32_16x16x4f32(a1[e], bf[4 + e], acc, 0, 0, 0); }
#pragma unroll
        for (int e = 0; e < 4; ++e) { acc = __builtin_amdgcn_mfma_f32_16x16x4f32(a2[e], bf[8 + e], acc, 0, 0, 0); }
#pragma unroll
        for (int e = 0; e < 4; ++e) { acc = __builtin_amdgcn_mfma_f32_16x16x4f32(a3[e], bf[12 + e], acc, 0, 0, 0); }
        f32x4 o;
#pragma unroll
        for (int r = 0; r < 4; ++r) o[r] = acc[r] * __expf(-((float)(t0 + 4 * kq + r) / (float)(SEQ - 1)) * dlt);
        *(f32x4*)(HF + (size_t)col * SEQ + t0 + 4 * kq) = o; }
}

__device__ __forceinline__ void transpose_item(const Args& a, int item, int lane) {
    const int lt = item & 127, ct = (item >> 7) & 7, b = item >> 10;
    const bf16_t* src = (const bf16_t*)(a.ws + WS_YHYT) + ((size_t)b * HYW + 64 * ct) * SEQ + 64 * lt + lane;
    bf16_t* dst = (bf16_t*)(a.ws + WS_MIX) + ((size_t)b * SEQ + 64 * lt + lane) * 1024 + 512 + 64 * ct;
    unsigned short v[64];
#pragma unroll
    for (int cc = 0; cc < 64; ++cc) v[cc] = src[(size_t)cc * SEQ];
#pragma unroll
    for (int q = 0; q < 8; ++q)
        *(u32x4*)(dst + 8 * q) = (u32x4){(unsigned)v[8 * q] | ((unsigned)v[8 * q + 1] << 16), (unsigned)v[8 * q + 2] | ((unsigned)v[8 * q + 3] << 16),
                                         (unsigned)v[8 * q + 4] | ((unsigned)v[8 * q + 5] << 16), (unsigned)v[8 * q + 6] | ((unsigned)v[8 * q + 7] << 16)};
}
}

__device__ __forceinline__ void p0_mod_and_filter(const Args& a, LAS unsigned char* lds) {
    const int tid = threadIdx.x, lane = tid & 63, wave = tid >> 6;
    const float* c = a.in[I_C]; const float* cctx = a.in[I_CCTX]; const float* adaw = a.in[I_ADAW]; const float* adab = a.in[I_ADAB];
    float* mod = (float*)(a.ws + WS_MOD);
    LAS float* sl = (LAS float*)lds;
    LAS float* pt = (LAS float*)lds + 5 * 1024;
    for (int i = tid; i < 5 * 1024; i += NTHREADS) { const int r = i >> 10, k = i & 1023; sl[i] = silu_f(r < 4 ? c[r * 1024 + k] : cctx[k]); }
    for (int it = blockIdx.x; it < 256; it += gridDim.x) {
        __syncthreads();
        if (tid < 504) {
            const int col = tid % 24, ks = tid / 24, n = it * 24 + col, kbeg = ks * 49, kend = (kbeg + 49 < 1024) ? kbeg + 49 : 1024;
            float acc[5] = {0.f, 0.f, 0.f, 0.f, 0.f};
#pragma unroll 7
            for (int k = kbeg; k < kend; ++k) { const float w = adaw[(size_t)k * 6144 + n];
#pragma unroll
                for (int r = 0; r < 5; ++r) acc[r] += sl[r * 1024 + k] * w; }
#pragma unroll
            for (int r = 0; r < 5; ++r) pt[(ks * 5 + r) * 24 + col] = acc[r];
        }
        __syncthreads();
        if (tid < 120) { const int r = tid / 24, col = tid % 24, n = it * 24 + col; float s = adab[n];
            for (int ks = 0; ks < 21; ++ks) s += pt[(ks * 5 + r) * 24 + col];
            mod[r * 6144 + n] = s; }
    }
    __syncthreads();
    const float* w1 = a.in[I_FW1]; const float* b1 = a.in[I_FB1]; const float* w2 = a.in[I_FW2]; const float* b2 = a.in[I_FB2]; const float* fq = a.in[I_FFREQ];
    float* hid2 = (float*)(a.ws + WS_HID2);
    LAS float* zs = (LAS float*)lds + 8192 + wave * 128;
    const float frq = fq[lane], bb1 = b1[lane], bb2 = b2[lane];
    for (int t = (blockIdx.x * NWAVES + wave); t < SEQ; t += gridDim.x * NWAVES) {
        float z = 0.f;
        if (lane == 0) z = (float)t / (float)(SEQ - 1);
        else if (lane < 33) { const int i = (lane - 1) & 15; const float f = 1e-4f + (float)i * ((15.f - 1e-4f) / 15.f);
            const float ang = (6.283185307179586f * (float)t / (float)SEQ) * f; z = (lane < 17) ? cosf(ang) : -sinf(ang); }
        if (lane < 33) zs[lane] = z;
        __builtin_amdgcn_wave_barrier(); asm volatile("s_waitcnt lgkmcnt(0)" ::: "memory");
        float s = bb1;
#pragma unroll
        for (int e = 0; e < 33; ++e) s += zs[e] * w1[e * 64 + lane];
        const float h1 = sinf(frq * s);
        zs[64 + lane] = h1;
        __builtin_amdgcn_wave_barrier(); asm volatile("s_waitcnt lgkmcnt(0)" ::: "memory");
        float s2 = bb2;
#pragma unroll 16
        for (int g = 0; g < 64; ++g) s2 += zs[64 + g] * w2[g * 64 + lane];
        hid2[(size_t)t * 64 + lane] = sinf(frq * s2);
        __builtin_amdgcn_wave_barrier(); asm volatile("s_waitcnt lgkmcnt(0)" ::: "memory");
    }
}

__device__ __forceinline__ void tr_item(const float* W, int ldw, int k0, int c0, int cstride, float scale, bf16_t* dstrow0, LAS float* scr, int lane) {
#pragma unroll 8
    for (int i = 0; i < 32; ++i) { const int kk = 2 * i + (lane >> 5); scr[kk * 33 + (lane & 31)] = W[(size_t)(k0 + kk) * ldw + c0 + (lane & 31) * cstride] * scale; }
    asm volatile("s_waitcnt lgkmcnt(0)" ::: "memory"); __builtin_amdgcn_wave_barrier();
    const int c = lane & 7;
#pragma unroll
    for (int j = 0; j < 4; ++j) { const int n = (lane >> 3) + 8 * j; const LAS float* s = scr + (8 * c) * 33 + n;
        u32x4 o; o.x = pk2(s[0 * 33], s[1 * 33]); o.y = pk2(s[2 * 33], s[3 * 33]); o.z = pk2(s[4 * 33], s[5 * 33]); o.w = pk2(s[6 * 33], s[7 * 33]);
        *(u32x4*)(dstrow0 + (size_t)n * 1024 + k0 + 8 * c) = o; }
    asm volatile("s_waitcnt lgkmcnt(0)" ::: "memory"); __builtin_amdgcn_wave_barrier();
}
__device__ __forceinline__ void fold_item(const float* win, const float* wa, int dir, int k0, int j0, bf16_t* dstrow0, LAS float* scr, int lane) {
#pragma unroll 4
    for (int i = 0; i < 32; ++i) { const int kk = 2 * i + (lane >> 5); const float* wr = win + (size_t)(k0 + kk) * INW + 1536 + 16 * dir; float s = 0.f;
#pragma unroll
        for (int r = 0; r < 16; ++r) s += wr[r] * wa[r * 256 + j0 + (lane & 31)];
        scr[kk * 33 + (lane & 31)] = s; }
    asm volatile("s_waitcnt lgkmcnt(0)" ::: "memory"); __builtin_amdgcn_wave_barrier();
    const int c = lane & 7;
#pragma unroll
    for (int j = 0; j < 4; ++j) { const int n = (lane >> 3) + 8 * j; const LAS float* s = scr + (8 * c) * 33 + n;
        u32x4 o; o.x = pk2(s[0 * 33], s[1 * 33]); o.y = pk2(s[2 * 33], s[3 * 33]); o.z = pk2(s[4 * 33], s[5 * 33]); o.w = pk2(s[6 * 33], s[7 * 33]);
        *(u32x4*)(dstrow0 + (size_t)n * 1024 + k0 + 8 * c) = o; }
    asm volatile("s_waitcnt lgkmcnt(0)" ::: "memory"); __builtin_amdgcn_wave_barrier();
}
__device__ __forceinline__ void ln_mod_row(const float* xrow, const float* shift, const float* scale, bf16_t* orow, int lane) {
    const f32x4* xr = (const f32x4*)xrow + lane;
    f32x4 v[4]; float s = 0.f;
#pragma unroll
    for (int j = 0; j < 4; ++j) { v[j] = xr[64 * j]; s += (v[j][0] + v[j][1]) + (v[j][2] + v[j][3]); }
    const float mean = wave_sum(s) * (1.f / D); float s2 = 0.f;
#pragma unroll
    for (int j = 0; j < 4; ++j) { v[j] = v[j] - mean; s2 += (v[j][0] * v[j][0] + v[j][1] * v[j][1]) + (v[j][2] * v[j][2] + v[j][3] * v[j][3]); }
    const float rstd = 1.f / sqrtf(wave_sum(s2) * (1.f / D) + LN_EPS);
    u32x2* o8 = (u32x2*)orow + lane;
#pragma unroll
    for (int j = 0; j < 4; ++j) { const f32x4 sh = ((const f32x4*)shift)[64 * j + lane], sc = ((const f32x4*)scale)[64 * j + lane];
        const f32x4 y = v[j] * rstd * (sc + 1.f) + sh;
        u32x2 w; w.x = pk2(y[0], y[1]); w.y = pk2(y[2], y[3]); o8[64 * j] = w; }
}
__device__ __forceinline__ void p1_prep(const Args& a, LAS unsigned char* lds) {
    const int tid = threadIdx.x, lane = tid & 63, wave = tid >> 6;
    LAS float* scr = (LAS float*)(lds + wave * 16384);
    const int gw = blockIdx.x * NWAVES + wave, NGW = gridDim.x * NWAVES;
    const float* win = a.in[I_WIN];
    bf16_t* btin = (bf16_t*)(a.ws + WS_BTIN); bf16_t* btout = (bf16_t*)(a.ws + WS_BTOUT); bf16_t* w1t = (bf16_t*)(a.ws + WS_W1T); bf16_t* w2t = (bf16_t*)(a.ws + WS_W2T);
    const float* mod = (const float*)(a.ws + WS_MOD);
    bf16_t* H = (bf16_t*)(a.ws + WS_H);
    for (int row = gw; row < TT; row += NGW) {
        const float* xr; int mr;
        if (row < T) { xr = a.in[I_X] + (size_t)row * D; mr = row >> 13; } else { xr = a.in[I_CTX] + (size_t)(row - T) * D; mr = 4; }
        ln_mod_row(xr, mod + mr * 6144, mod + mr * 6144 + 1024, H + (size_t)row * D, lane);
    }
    constexpr int I_IN = 16 * 96, I_FOLD = 16 * 8 * 2, I_OUT = 16 * 32, I_W1 = NE * 16 * 64, I_W2 = NE * 16 * 32;
    constexpr int NITEMS = I_IN + I_FOLD + I_OUT + I_W1 + I_W2;
    for (int it = gw; it < NITEMS; it += NGW) {
        int r = it;
        if (r < I_IN) {
            const int kb = r / 96, nb = r % 96;
            if (nb < 48) tr_item(win, INW, 64 * kb, 32 * nb, 1, nb < 8 ? 0.125f : 1.f, btin + (size_t)(32 * nb) * 1024, scr, lane);
            else tr_item(win, INW, 64 * kb, 1568 + 32 * (nb - 48), 1, 1.f, btin + (size_t)(2048 + 32 * (nb - 48)) * 1024, scr, lane);
            continue; }
        r -= I_IN;
        if (r < I_FOLD) { const int dir = r & 1, jb = (r >> 1) & 7, kb = r >> 4;
            fold_item(win, dir ? a.in[I_WAB] : a.in[I_WAF], dir, 64 * kb, 32 * jb, btin + (size_t)(1536 + 256 * dir + 32 * jb) * 1024, scr, lane); continue; }
        r -= I_FOLD;
        if (r < I_OUT) { const int kb = r / 32, nb = r % 32; tr_item(a.in[I_WOUT], 1024, 64 * kb, 32 * nb, 1, 1.f, btout + (size_t)(32 * nb) * 1024, scr, lane); continue; }
        r -= I_OUT;
        if (r < I_W1) {
            const int e = r / 1024, q = r % 1024, s = q & 1, nb = (q >> 1) & 31, kb = q >> 6;
            const int ct = nb >> 2, jj0 = (nb & 3) * 32;
            tr_item(a.in[I_EW1] + (size_t)e * 1024 * 2048, 2048, 64 * kb, 2 * (128 * ct + jj0) + s, 2, 1.f, w1t + ((size_t)e * 2048 + 256 * ct + 128 * s + jj0) * 1024, scr, lane);
            continue; }
        r -= I_W1;
        { const int e = r / 512, q = r % 512, kb = q / 32, nb = q % 32;
          tr_item(a.in[I_EW2] + (size_t)e * 1024 * 1024, 1024, 64 * kb, 32 * nb, 1, 1.f, w2t + ((size_t)e * 1024 + 32 * nb) * 1024, scr, lane); }
    }
    for (int it = gw; it < 2048; it += NGW) hy::filter_item(a, it, lane);
    float* b1r = (float*)(a.ws + WS_B1R); const float* eb1 = a.in[I_EB1];
    for (int i = blockIdx.x * NTHREADS + tid; i < NE * 2048; i += gridDim.x * NTHREADS) {
        const int e = i >> 11, n = i & 2047, ct = n >> 8, s = (n >> 7) & 1, jj = n & 127;
        b1r[i] = eb1[(size_t)e * 2048 + 2 * (128 * ct + jj) + s];
    }
}

namespace gla {
constexpr int RS = 72;
constexpr int L_TOTF = 0, L_TOTB = 2048, L_SSQ = 4096;
constexpr int L_T0 = 8192;
constexpr int L_T1 = L_T0 + 9216, L_T2 = L_T1 + 9216, L_T3 = L_T2 + 9216;
constexpr int L_VT = L_T3 + 9216;
constexpr int L_P  = L_VT + 18432;
constexpr int L_END = L_P + 9216;

__device__ __forceinline__ bf16x8 frag(const LAS unsigned char* tile, int row, int k0, int lane) {
    return *(const LAS bf16x8*)(tile + ((row + (lane & 15)) * RS + k0 + 8 * (lane >> 4)) * 2);
}
__device__ __forceinline__ void chunk_cums_pre(LAS unsigned char* L, const float (&gf)[8], const float (&gb)[8], int wave, int lane, float (&cumf)[8], float (&cumb)[8], float& allf, float& allb) {
    LAS float* totf = (LAS float*)(L + L_TOTF); LAS float* totb = (LAS float*)(L + L_TOTB);
    cumf[0] = gf[0];
#pragma unroll
    for (int r = 1; r < 8; ++r) cumf[r] = cumf[r - 1] + gf[r];
    cumb[7] = gb[7];
#pragma unroll
    for (int r = 6; r >= 0; --r) cumb[r] = cumb[r + 1] + gb[r];
    totf[wave * 64 + lane] = cumf[7]; totb[wave * 64 + lane] = cumb[0];
    __syncthreads();
    float of = 0.f, ob = 0.f, af = 0.f, ab = 0.f;
#pragma unroll
    for (int w = 0; w < 8; ++w) { const float tf = totf[w * 64 + lane], tb = totb[w * 64 + lane]; af += tf; ab += tb; of += (w < wave) ? tf : 0.f; ob += (w > wave) ? tb : 0.f; }
#pragma unroll
    for (int r = 0; r < 8; ++r) { cumf[r] += of; cumb[r] += ob; }
    allf = af; allb = ab;
}
__device__ __forceinline__ void chunk_cums(LAS unsigned char* L, const float* GF, const float* GB, size_t tok0, int h, int wave, int lane, float (&cumf)[8], float (&cumb)[8], float& allf, float& allb) {
    float gf[8], gb[8];
#pragma unroll
    for (int r = 0; r < 8; ++r) { const size_t o = (tok0 + 8 * wave + r) * 256 + h * 64 + lane; gf[r] = GF[o]; gb[r] = GB[o]; }
    chunk_cums_pre(L, gf, gb, wave, lane, cumf, cumb, allf, allb);
}
__device__ __forceinline__ void store_vt(LAS unsigned char* L, const u32x4 (&vr)[2], int tid) {
    LAS bf16_t* vt = (LAS bf16_t*)(L + L_VT);
    const int j = tid >> 3, c8 = tid & 7;
#pragma unroll
    for (int q = 0; q < 2; ++q) { const int dv0 = 8 * (c8 + 8 * q);
        const unsigned ww[4] = {vr[q].x, vr[q].y, vr[q].z, vr[q].w};
#pragma unroll
        for (int e = 0; e < 4; ++e) { vt[(dv0 + 2 * e) * RS + j] = (bf16_t)(ww[e] & 0xffffu); vt[(dv0 + 2 * e + 1) * RS + j] = (bf16_t)(ww[e] >> 16); } }
}
__device__ __forceinline__ void load_vt(LAS unsigned char* L, const bf16_t* V, size_t tok0, int h, int tid) {
    const int j = tid >> 3, c8 = tid & 7; u32x4 vr[2];
#pragma unroll
    for (int q = 0; q < 2; ++q) vr[q] = *(const u32x4*)(V + (tok0 + j) * 512 + h * 128 + 8 * (c8 + 8 * q));
    store_vt(L, vr, tid);
}

__device__ __forceinline__ void g1_unit(const Args& a, LAS unsigned char* L, int bh, int chunk  ) {
    const int tid = threadIdx.x, lane = tid & 63, wave = __builtin_amdgcn_readfirstlane(tid >> 6);
    const int b = bh >> 2, h = bh & 3;
    const size_t tok0 = chunk < NCHUNK ? (size_t)b * SEQ + (size_t)chunk * CH : (size_t)T + (size_t)b * CTXL + (size_t)(chunk - NCHUNK) * CH;
    const float* GF = (const float*)(a.ws + WS_GF); const float* GB = (const float*)(a.ws + WS_GB);
    const bf16_t* Kb = (const bf16_t*)(a.ws + WS_K); const bf16_t* Vb = (const bf16_t*)(a.ws + WS_V);
    float cumf[8], cumb[8], allf, allb;
    __syncthreads();
    chunk_cums(L, GF, GB, tok0, h, wave, lane, cumf, cumb, allf, allb);
    LAS bf16_t* ketf = (LAS bf16_t*)(L + L_T0); LAS bf16_t* ketb = (LAS bf16_t*)(L + L_T1);
#pragma unroll
    for (int r = 0; r < 8; ++r) { const int i = 8 * wave + r; const float kv = bf2f(Kb[(tok0 + i) * 256 + h * 64 + lane]);
        ketf[lane * RS + i] = f2bf(kv * __expf(allf - cumf[r])); ketb[lane * RS + i] = f2bf(kv * __expf(allb - cumb[r])); }
    load_vt(L, Vb, tok0, h, tid);
    if (wave == 0) { float* av = (float*)(a.ws + WS_AV); av[((size_t)(0 * 16 + bh) * NCT + chunk) * 64 + lane] = __expf(allf); av[((size_t)(1 * 16 + bh) * NCT + chunk) * 64 + lane] = __expf(allb); }
    __syncthreads();
    bf16_t* KV = (bf16_t*)(a.ws + WS_KV);
#pragma unroll
    for (int dir = 0; dir < 2; ++dir) {
        const LAS unsigned char* ket = L + (dir ? L_T1 : L_T0);
        bf16_t* dst = KV + ((size_t)(dir * 16 + bh) * NCT + chunk) * 8192;
#pragma unroll
        for (int nt = 0; nt < 4; ++nt) { f32x4 acc = {0.f, 0.f, 0.f, 0.f};
#pragma unroll
            for (int ks = 0; ks < 2; ++ks) acc = __builtin_amdgcn_mfma_f32_16x16x32_bf16(frag(L + L_VT, 16 * wave, 32 * ks, lane), frag(ket, 16 * nt, 32 * ks, lane), acc, 0, 0, 0);
#pragma unroll
            for (int r = 0; r < 4; ++r) dst[(16 * wave + 4 * (lane >> 4) + r) * 64 + 16 * nt + (lane & 15)] = f2bf(acc[r]); }
    }
}

__device__ __forceinline__ void g2_scan(const Args& a) {
    const bf16_t* KV = (const bf16_t*)(a.ws + WS_KV); const float* AV = (const float*)(a.ws + WS_AV); bf16_t* SP = (bf16_t*)(a.ws + WS_SP);
    for (int id = blockIdx.x * NTHREADS + threadIdx.x; id < 32 * 4096; id += gridDim.x * NTHREADS) {
        const int db = id >> 12, e2 = id & 4095, dir = db >> 4, dk = (2 * e2) & 63;
        const unsigned* kv = (const unsigned*)(KV + (size_t)db * NCT * 8192) + e2;
        const float* av = AV + (size_t)db * NCT * 64 + dk;
        unsigned* sp = (unsigned*)(SP + (size_t)db * NCHUNK * 8192) + e2;
        float s0 = 0.f, s1 = 0.f;
#pragma unroll
        for (int q = 0; q < NCC; ++q) { const int c = NCHUNK + (dir ? (NCC - 1 - q) : q);
            const unsigned w = kv[(size_t)c * 4096]; const f32x2 aa = *(const f32x2*)(av + (size_t)c * 64);
            s0 = aa[0] * s0 + bflo(w); s1 = aa[1] * s1 + bfhi(w); }
        for (int q0 = 0; q0 < NCHUNK; q0 += 16) {
            unsigned w[16]; f32x2 aa[16];
#pragma unroll
            for (int u = 0; u < 16; ++u) { const int c = dir ? (NCHUNK - 1 - (q0 + u)) : (q0 + u); w[u] = kv[(size_t)c * 4096]; aa[u] = *(const f32x2*)(av + (size_t)c * 64); }
#pragma unroll
            for (int u = 0; u < 16; ++u) { const int c = dir ? (NCHUNK - 1 - (q0 + u)) : (q0 + u);
                sp[(size_t)c * 4096] = pk2(s0, s1);
                s0 = aa[u][0] * s0 + bflo(w[u]); s1 = aa[u][1] * s1 + bfhi(w[u]); }
        }
    }
}

struct G3In { float gf[8], gb[8]; bf16_t q[8], k[8]; u32x4 v[2]; };
__device__ __forceinline__ void g3_load(const Args& a, int bh, int chunk, G3In& in) {
    const int tid = threadIdx.x, lane = tid & 63, wave = __builtin_amdgcn_readfirstlane(tid >> 6);
    const int b = bh >> 2, h = bh & 3;
    const size_t tok0 = (size_t)b * SEQ + (size_t)chunk * CH;
    const float* GF = (const float*)(a.ws + WS_GF); const float* GB = (const float*)(a.ws + WS_GB);
    const bf16_t* Qb = (const bf16_t*)(a.ws + WS_Q); const bf16_t* Kb = (const bf16_t*)(a.ws + WS_K); const bf16_t* Vb = (const bf16_t*)(a.ws + WS_V);
#pragma unroll
    for (int r = 0; r < 8; ++r) { const size_t o = (tok0 + 8 * wave + r) * 256 + h * 64 + lane; in.gf[r] = GF[o]; in.gb[r] = GB[o]; in.q[r] = Qb[o]; in.k[r] = Kb[o]; }
#pragma unroll
    for (int q = 0; q < 2; ++q) in.v[q] = *(const u32x4*)(Vb + (tok0 + (tid >> 3)) * 512 + h * 128 + 8 * ((tid & 7) + 8 * q));
}
__device__ __forceinline__ void g3_unit(const Args& a, LAS unsigned char* L, int bh, int chunk  , const G3In& in) {
    const int tid = threadIdx.x, lane = tid & 63, wave = __builtin_amdgcn_readfirstlane(tid >> 6);
    const int b = bh >> 2, h = bh & 3;
    const size_t tok0 = (size_t)b * SEQ + (size_t)chunk * CH;
    const bf16_t* Gt = (const bf16_t*)(a.ws + WS_G);
    const int mt = wave >> 1, fr = lane & 15, fq = lane >> 4;
    const bf16_t* SPf = (const bf16_t*)(a.ws + WS_SP) + ((size_t)(0 * 16 + bh) * NCHUNK + chunk) * 8192;
    const bf16_t* SPb = (const bf16_t*)(a.ws + WS_SP) + ((size_t)(1 * 16 + bh) * NCHUNK + chunk) * 8192;
    bf16x8 sfv[4][2], sbv[4][2]; bf16_t gr[4][4];
#pragma unroll
    for (int q = 0; q < 4; ++q) { const int nt = 4 * (wave & 1) + q;
#pragma unroll
        for (int ks = 0; ks < 2; ++ks) { sfv[q][ks] = *(const bf16x8*)(SPf + (16 * nt + fr) * 64 + 32 * ks + 8 * fq); sbv[q][ks] = *(const bf16x8*)(SPb + (16 * nt + fr) * 64 + 32 * ks + 8 * fq); }
#pragma unroll
        for (int r = 0; r < 4; ++r) gr[r][q] = Gt[(tok0 + 16 * mt + 4 * fq + r) * 512 + h * 128 + 16 * nt + fr]; }
    float cumf[8], cumb[8], allf, allb;
    __syncthreads();
    chunk_cums_pre(L, in.gf, in.gb, wave, lane, cumf, cumb, allf, allb);
    LAS bf16_t* qf = (LAS bf16_t*)(L + L_T0); LAS bf16_t* kf = (LAS bf16_t*)(L + L_T1); LAS bf16_t* qb = (LAS bf16_t*)(L + L_T2); LAS bf16_t* kb = (LAS bf16_t*)(L + L_T3);
#pragma unroll
    for (int r = 0; r < 8; ++r) { const int i = 8 * wave + r;
        const float qv = bf2f(in.q[r]), kv = bf2f(in.k[r]);
        qf[i * RS + lane] = f2bf(qv * __expf(cumf[r])); kf[i * RS + lane] = f2bf(kv * __expf(-cumf[r]));
        qb[i * RS + lane] = f2bf(qv * __expf(cumb[r])); kb[i * RS + lane] = f2bf(kv * __expf(-cumb[r])); }
    store_vt(L, in.v, tid);
    __syncthreads();
    {
        LAS bf16_t* P = (LAS bf16_t*)(L + L_P);
#pragma unroll
        for (int q = 0; q < 2; ++q) { const int nt = 2 * (wave & 1) + q;
            f32x4 sf = {0.f, 0.f, 0.f, 0.f}, sb = {0.f, 0.f, 0.f, 0.f};
#pragma unroll
            for (int ks = 0; ks < 2; ++ks) {
                sf = __builtin_amdgcn_mfma_f32_16x16x32_bf16(frag(L + L_T0, 16 * mt, 32 * ks, lane), frag(L + L_T1, 16 * nt, 32 * ks, lane), sf, 0, 0, 0);
                sb = __builtin_amdgcn_mfma_f32_16x16x32_bf16(frag(L + L_T2, 16 * mt, 32 * ks, lane), frag(L + L_T3, 16 * nt, 32 * ks, lane), sb, 0, 0, 0); }
#pragma unroll
            for (int r = 0; r < 4; ++r) { const int i = 16 * mt + 4 * fq + r, j = 16 * nt + fr;
                P[i * RS + j] = f2bf((j <= i ? sf[r] : 0.f) + (j >= i ? sb[r] : 0.f)); } }
    }
    __syncthreads();
    f32x4 o[4]; float ssq[4] = {0.f, 0.f, 0.f, 0.f};
#pragma unroll
    for (int q = 0; q < 4; ++q) { const int nt = 4 * (wave & 1) + q;
        f32x4 acc = {0.f, 0.f, 0.f, 0.f};
#pragma unroll
        for (int ks = 0; ks < 2; ++ks) {
            acc = __builtin_amdgcn_mfma_f32_16x16x32_bf16(frag(L + L_P, 16 * mt, 32 * ks, lane), frag(L + L_VT, 16 * nt, 32 * ks, lane), acc, 0, 0, 0);
            acc = __builtin_amdgcn_mfma_f32_16x16x32_bf16(frag(L + L_T0, 16 * mt, 32 * ks, lane), sfv[q][ks], acc, 0, 0, 0);
            acc = __builtin_amdgcn_mfma_f32_16x16x32_bf16(frag(L + L_T2, 16 * mt, 32 * ks, lane), sbv[q][ks], acc, 0, 0, 0); }
        o[q] = acc;
#pragma unroll
        for (int r = 0; r < 4; ++r) ssq[r] += acc[r] * acc[r]; }
    LAS float* SSQ = (LAS float*)(L + L_SSQ);
#pragma unroll
    for (int r = 0; r < 4; ++r) { float s = ssq[r]; s += __shfl_xor(s, 1); s += __shfl_xor(s, 2); s += __shfl_xor(s, 4); s += __shfl_xor(s, 8); ssq[r] = s; }
    if (fr == 0) {
#pragma unroll
        for (int r = 0; r < 4; ++r) SSQ[(wave & 1) * 64 + 16 * mt + 4 * fq + r] = ssq[r]; }
    __syncthreads();
    const float* ng = a.in[I_NORMG];
    bf16_t* mix = (bf16_t*)(a.ws + WS_MIX);
#pragma unroll
    for (int r = 0; r < 4; ++r) { const int i = 16 * mt + 4 * fq + r;
        const float rstd = 1.f / sqrtf((SSQ[i] + SSQ[64 + i]) * (1.f / DV) + LN_EPS);
#pragma unroll
        for (int q = 0; q < 4; ++q) { const int dv = 16 * (4 * (wave & 1) + q) + fr;
            const float g = bf2f(gr[r][q]);
            mix[(tok0 + i) * 1024 + h * 128 + dv] = f2bf(o[q][r] * rstd * ng[dv] * silu_f(g)); } }
}
}

namespace rt {
constexpr int HS = 1028;
constexpr int L_H2 = 0;
constexpr int L_PART = 65792;
constexpr int L_LCNT = L_PART + 16384;
constexpr int L_REC = L_LCNT + 256;

__device__ __forceinline__ void phase(const Args& a, LAS unsigned char* lds) {
    const int tid = threadIdx.x, lane = tid & 63, wave = __builtin_amdgcn_readfirstlane(tid >> 6);
    bf16_t* xmid = (bf16_t*)(a.ws + WS_PRE1); bf16_t* H2 = (bf16_t*)(a.ws + WS_H2); const bf16_t* FG = (const bf16_t*)(a.ws + WS_FG);
    const float* mod = (const float*)(a.ws + WS_MOD);
    const float* rw = a.in[I_RW]; const float* rb = a.in[I_RB];
    LAS float* h2s = (LAS float*)(lds + L_H2); LAS float* part = (LAS float*)(lds + L_PART);
    LAS int* lcnt = (LAS int*)(lds + L_LCNT); LAS int* lbase = lcnt + 32; LAS int* rec = (LAS int*)(lds + L_REC);
    unsigned* cnt = (unsigned*)(a.ws + WS_CNT); int* list = (int*)(a.ws + WS_LIST); float* pw = (float*)(a.ws + WS_PW); int* ploc = (int*)(a.ws + WS_PLOC);
    float rwr[32][2];
#pragma unroll
    for (int s = 0; s < 32; ++s)
#pragma unroll
        for (int nt = 0; nt < 2; ++nt) rwr[s][nt] = rw[(size_t)(128 * wave + 4 * s + (lane >> 4)) * 32 + 16 * nt + (lane & 15)];
    const f32x4* g1 = (const f32x4*)a.in[I_LN1G]; const f32x4* bb1 = (const f32x4*)a.in[I_LN1B];
    if (tid < 32) lcnt[tid] = 0;
    for (int grp = blockIdx.x; grp < T / 16; grp += gridDim.x) {
        __syncthreads();
#pragma unroll 1
        for (int rr = 0; rr < 2; ++rr) {
            const int lr = 2 * wave + rr, t = grp * 16 + lr, b = t >> 13;
            u32x2* pr = (u32x2*)(xmid + (size_t)t * D) + lane;
            const f32x4* xr = (const f32x4*)(a.in[I_X] + (size_t)t * D) + lane; const u32x2* fr_ = (const u32x2*)(FG + (size_t)t * D) + lane;
            f32x4 v[4]; float s = 0.f;
#pragma unroll
            for (int j = 0; j < 4; ++j) { const u32x2 fw = fr_[64 * j]; const f32x4 ff = {bflo(fw.x), bfhi(fw.x), bflo(fw.y), bfhi(fw.y)};
                v[j] = xr[64 * j] * ALPHA + ff; s += (v[j][0] + v[j][1]) + (v[j][2] + v[j][3]); }
            float mean = wave_sum(s) * (1.f / D), s2 = 0.f;
#pragma unroll
            for (int j = 0; j < 4; ++j) { v[j] = v[j] - mean; s2 += (v[j][0] * v[j][0] + v[j][1] * v[j][1]) + (v[j][2] * v[j][2] + v[j][3] * v[j][3]); }
            float rstd = 1.f / sqrtf(wave_sum(s2) * (1.f / D) + LN_EPS);
            s = 0.f;
#pragma unroll
            for (int j = 0; j < 4; ++j) { v[j] = v[j] * rstd * g1[64 * j + lane] + bb1[64 * j + lane]; u32x2 w; w.x = pk2(v[j][0], v[j][1]); w.y = pk2(v[j][2], v[j][3]); pr[64 * j] = w;
                v[j] = (f32x4){bflo(w.x), bfhi(w.x), bflo(w.y), bfhi(w.y)}; s += (v[j][0] + v[j][1]) + (v[j][2] + v[j][3]); }
            mean = wave_sum(s) * (1.f / D); s2 = 0.f;
#pragma unroll
            for (int j = 0; j < 4; ++j) { v[j] = v[j] - mean; s2 += (v[j][0] * v[j][0] + v[j][1] * v[j][1]) + (v[j][2] * v[j][2] + v[j][3] * v[j][3]); }
            rstd = 1.f / sqrtf(wave_sum(s2) * (1.f / D) + LN_EPS);
            const f32x4* sh = (const f32x4*)(mod + b * 6144 + 3 * 1024); const f32x4* sc = (const f32x4*)(mod + b * 6144 + 4 * 1024);
            u32x2* o8 = (u32x2*)(H2 + (size_t)t * D) + lane;
#pragma unroll
            for (int j = 0; j < 4; ++j) { const f32x4 y = v[j] * rstd * (sc[64 * j + lane] + 1.f) + sh[64 * j + lane];
                u32x2 w; w.x = pk2(y[0], y[1]); w.y = pk2(y[2], y[3]); o8[64 * j] = w;
                *(LAS f32x4*)(h2s + lr * HS + 256 * j + 4 * lane) = y; }
        }
        __syncthreads();
        {
            f32x4 acc0 = {0.f, 0.f, 0.f, 0.f}, acc1 = {0.f, 0.f, 0.f, 0.f};
            const LAS float* ap = h2s + (lane & 15) * HS + 128 * wave + (lane >> 4);
#pragma unroll
            for (int s = 0; s < 32; ++s) { const float av = ap[4 * s];
                acc0 = __builtin_amdgcn_mfma_f32_16x16x4f32(av, rwr[s][0], acc0, 0, 0, 0);
                acc1 = __builtin_amdgcn_mfma_f32_16x16x4f32(av, rwr[s][1], acc1, 0, 0, 0); }
#pragma unroll
            for (int r = 0; r < 4; ++r) { part[(wave * 16 + 4 * (lane >> 4) + r) * 32 + (lane & 15)] = acc0[r]; part[(wave * 16 + 4 * (lane >> 4) + r) * 32 + 16 + (lane & 15)] = acc1[r]; }
        }
        __syncthreads();
        {
            const int lr = 2 * wave + (lane >> 5), e = lane & 31, t = grp * 16 + lr;
            float lg = rb[e];
#pragma unroll
            for (int w = 0; w < 8; ++w) lg += part[(w * 16 + lr) * 32 + e];
            float cur = lg, tv[4]; int ti[4];
#pragma unroll
            for (int k = 0; k < 4; ++k) { float bv = cur; int bi = e;
#pragma unroll
                for (int o = 1; o < 32; o <<= 1) { const float ov = __shfl_xor(bv, o); const int oi = __shfl_xor(bi, o); if (ov > bv || (ov == bv && oi < bi)) { bv = ov; bi = oi; } }
                tv[k] = bv; ti[k] = bi; if (bi == e) cur = -3.0e38f; }
            const float e1 = __expf(tv[1] - tv[0]), e2 = __expf(tv[2] - tv[0]), e3 = __expf(tv[3] - tv[0]);
            const float inv = 1.f / (1.f + e1 + e2 + e3);
            if (e < 4) { const float wk = (e == 0 ? 1.f : (e == 1 ? e1 : (e == 2 ? e2 : e3))) * inv; const int ek = (e == 0 ? ti[0] : (e == 1 ? ti[1] : (e == 2 ? ti[2] : ti[3])));
                const int pair = t * 4 + e;
                pw[pair] = wk;
                const int rank = __hip_atomic_fetch_add((LAS int*)&lcnt[ek], 1, __ATOMIC_RELAXED, __HIP_MEMORY_SCOPE_WORKGROUP);
                rec[lr * 4 + e] = ek | (rank << 8); }
        }
        __syncthreads();
        if (tid < 32) { const int n = lcnt[tid]; lbase[tid] = n ? (int)atomicAdd(&cnt[tid], (unsigned)n) : 0; }
        __syncthreads();
        if (tid < 64) { const int rc = rec[tid], ek = rc & 255, rank = rc >> 8, pos = lbase[ek] + rank, pair = (grp * 16 + (tid >> 2)) * 4 + (tid & 3);
            list[(size_t)ek * CAP + pos] = pair; ploc[pair] = ek | (pos << 5); }
        __syncthreads();
        if (tid < 32) lcnt[tid] = 0;
    }
}
}

__device__ __forceinline__ void p_final(const Args& a, LAS unsigned char* lds) {
    const int tid = threadIdx.x, lane = tid & 63, wave = tid >> 6;
    const bf16_t* xm = (const bf16_t*)(a.ws + WS_PRE1); const bf16_t* slots = (const bf16_t*)(a.ws + WS_SLOTS); const float* mod = (const float*)(a.ws + WS_MOD);
    const int* ploc = (const int*)(a.ws + WS_PLOC); const float* pw = (const float*)(a.ws + WS_PW);
    const f32x4* g2 = (const f32x4*)a.in[I_LN2G]; const f32x4* b2 = (const f32x4*)a.in[I_LN2B];
    LAS int* tstart = (LAS int*)lds;
    __syncthreads();
    if (tid == 0) { const unsigned* cnt = (const unsigned*)(a.ws + WS_CNT); int nrt = 0; for (int e = 0; e < NE; ++e) { tstart[e] = 256 * nrt; nrt += ((int)cnt[e] + 255) >> 8; } }
    __syncthreads();
    for (int t = blockIdx.x * NWAVES + wave; t < T; t += gridDim.x * NWAVES) {
        const int b = t >> 13;
        const u32x2* xr = (const u32x2*)(xm + (size_t)t * D) + lane; const f32x4* gt = (const f32x4*)(mod + b * 6144 + 5 * 1024);
        const u32x2* sr[4]; float w[4];
#pragma unroll
        for (int sl = 0; sl < 4; ++sl) { const int pl = ploc[t * 4 + sl]; w[sl] = pw[t * 4 + sl]; sr[sl] = (const u32x2*)(slots + (size_t)(tstart[pl & 31] + (pl >> 5)) * D) + lane; }
        f32x4 v[4]; float s = 0.f;
#pragma unroll
        for (int j = 0; j < 4; ++j) { f32x4 y = {0.f, 0.f, 0.f, 0.f};
#pragma unroll
            for (int sl = 0; sl < 4; ++sl) { const u32x2 q = sr[sl][64 * j]; y[0] += w[sl] * bflo(q.x); y[1] += w[sl] * bfhi(q.x); y[2] += w[sl] * bflo(q.y); y[3] += w[sl] * bfhi(q.y); }
            const u32x2 xw = xr[64 * j]; const f32x4 xv = {bflo(xw.x), bfhi(xw.x), bflo(xw.y), bfhi(xw.y)};
            v[j] = xv * ALPHA + gt[64 * j + lane] * y; s += (v[j][0] + v[j][1]) + (v[j][2] + v[j][3]); }
        const float mean = wave_sum(s) * (1.f / D); float s2 = 0.f;
#pragma unroll
        for (int j = 0; j < 4; ++j) { v[j] = v[j] - mean; s2 += (v[j][0] * v[j][0] + v[j][1] * v[j][1]) + (v[j][2] * v[j][2] + v[j][3] * v[j][3]); }
        const float rstd = 1.f / sqrtf(wave_sum(s2) * (1.f / D) + LN_EPS);
        f32x4* o = (f32x4*)(a.out + (size_t)t * D) + lane;
#pragma unroll
        for (int j = 0; j < 4; ++j) o[64 * j] = v[j] * rstd * g2[64 * j + lane] + b2[64 * j + lane];
    }
}

constexpr int N_PHASES = 11;
__global__ void __launch_bounds__(NTHREADS, 2) mega_fwd(Args a) {
    extern __shared__ __attribute__((aligned(16))) unsigned char lds_raw[];
    LAS unsigned char* lds = (LAS unsigned char*)lds_raw;
    const int tid = threadIdx.x;
    volatile LAS unsigned* misc = (volatile LAS unsigned*)(lds + LDS_MISC);
    if (tid < 4) misc[tid] = 0u;
    __syncthreads();
    XcdBarrier bar; bar.bar = (unsigned*)(a.ws + WS_BAR); bar.x = 0; bar.st = misc;
    const bool multi = (a.ph_hi - a.ph_lo) > 1;
    if (multi) bar = xcd_barrier_post((unsigned*)(a.ws + WS_BAR), misc);
    const int lo = a.ph_lo, hi = a.ph_hi;
#define vcu ((gridDim.x % 8 == 0) ? (int)((blockIdx.x % 8) * (gridDim.x / 8) + blockIdx.x / 8) : (int)blockIdx.x)
#ifdef ONLY_PHASE
#define IN(k) ((k) == ONLY_PHASE && lo <= (k) && (k) < hi)
#else
#define IN(k) (lo <= (k) && (k) < hi)
#endif
#define SEAM(k) do { if (IN(k) && IN((k) + 1)) xcd_barrier(bar); } while (0)

#ifndef REPEAT_PHASE
#define REPEAT_PHASE -1
#endif
#define RUNPH(k, ...) do { if (IN(k)) { __VA_ARGS__; if (REPEAT_PHASE == (k)) { xcd_barrier(bar); __VA_ARGS__; } } } while (0)
    RUNPH(0, p0_mod_and_filter(a, lds));
    SEAM(0);
    RUNPH(1, p1_prep(a, lds));
    SEAM(1);
    RUNPH(2, { gm::SchedIn S{a.ws, (int)gridDim.x, vcu, a.in[I_BAF], a.in[I_BAB]}; gm::EpiIn E{a.ws}; gm::gemm_stream<false, 0>(lds, S, E); });
    SEAM(2);
    RUNPH(3, { for (int u = blockIdx.x; u < 16 * NCT; u += gridDim.x) gla::g1_unit(a, lds, u / NCT, u % NCT); });
    SEAM(3);
    RUNPH(4, { gla::g2_scan(a);
        for (int c = blockIdx.x; c < HYW; c += gridDim.x) hy::channel(a, lds, c, a.ws + WS_HSPEC + (size_t)blockIdx.x * HSPEC_PER_WG); });
    SEAM(4);
    RUNPH(5, { { int u = blockIdx.x; gla::G3In cur, nxt;
            if (u < 16 * NCHUNK) { gla::g3_load(a, u >> 7, u & 127, cur);
                for (;;) { const int un = u + (int)gridDim.x; const bool hn = un < 16 * NCHUNK; if (hn) gla::g3_load(a, un >> 7, un & 127, nxt);
                    gla::g3_unit(a, lds, u >> 7, u & 127, cur); if (!hn) break; cur = nxt; u = un; } } }
        const int wave = tid >> 6;
        for (int it = blockIdx.x * NWAVES + wave; it < 4096; it += gridDim.x * NWAVES) hy::transpose_item(a, it, tid & 63); });
    SEAM(5);
    RUNPH(6, { gm::SchedOut S{a.ws, (int)gridDim.x, vcu}; gm::EpiOut E{a.ws}; gm::gemm_stream<false, 0>(lds, S, E); });
    SEAM(6);
    RUNPH(7, rt::phase(a, lds));
    SEAM(7);
    if (IN(8) || IN(9)) {
        LAS int* tab = (LAS int*)(lds + gm::LDS_TAB);
        __syncthreads();
        if (tid == 0) { const unsigned* cnt = (const unsigned*)(a.ws + WS_CNT); int nrt = 0;
            for (int e = 0; e < NE; ++e) { const int n = (int)cnt[e]; tab[e] = n; const int nt = (n + 255) >> 8; for (int k = 0; k < nt; ++k) tab[64 + nrt + k] = e | (k << 8); nrt += nt; }
            tab[32] = nrt; }
        __syncthreads();
    }
    RUNPH(8, { gm::SchedMoe<1> S{a.ws, (const LAS int*)(lds + gm::LDS_TAB), (int)gridDim.x, vcu, a.in[I_EB2]}; gm::EpiMoe1 E{a.ws}; gm::gemm_stream<true, 2>(lds, S, E); });
    SEAM(8);
    RUNPH(9, { gm::SchedMoe<2> S{a.ws, (const LAS int*)(lds + gm::LDS_TAB), (int)gridDim.x, vcu, a.in[I_EB2]}; gm::EpiMoe2 E{a.ws}; gm::gemm_stream<false, 0>(lds, S, E); });
    SEAM(9);
    RUNPH(10, p_final(a, lds));
#undef RUNPH
#undef vcu
#undef IN
#undef SEAM
}

extern "C" void kernel_launch(void* const* d_in, const int* in_sizes, int n_in, void* d_out, int out_size, void* d_ws, size_t ws_size, hipStream_t stream) {
    static int grid = 0;
    if (grid == 0) {
        if (n_in != 32 || out_size != T * D || ws_size < WS_END) { fprintf(stderr, "kernel_launch: unexpected shapes (n_in %d out %d ws %zu need %zu)\n", n_in, out_size, ws_size, (size_t)WS_END); grid = -1; return; }
        int dev = 0, cus = 0;
        if (hipGetDevice(&dev) != hipSuccess || hipDeviceGetAttribute(&cus, hipDeviceAttributeMultiprocessorCount, dev) != hipSuccess) { grid = -1; return; }
        if (hipFuncSetAttribute((const void*)mega_fwd, hipFuncAttributeMaxDynamicSharedMemorySize, LDS_BYTES) != hipSuccess) { fprintf(stderr, "kernel_launch: hipFuncSetAttribute failed\n"); grid = -1; return; }
        int per_cu = 0;
        if (hipOccupancyMaxActiveBlocksPerMultiprocessor(&per_cu, (const void*)mega_fwd, NTHREADS, LDS_BYTES) != hipSuccess || per_cu < 1) fprintf(stderr, "kernel_launch: occupancy query says %d\n", per_cu);
        (void)hipGetLastError();
        grid = cus;
        if (grid > MAX_GRID) grid = MAX_GRID;
    }
    if (grid < 0) return;
    (void)hipMemsetAsync(d_ws, 0, WS_ZERO_BYTES, stream);
    Args a{};
    for (int i = 0; i < 32; ++i) a.in[i] = (const float*)d_in[i];
    a.out = (float*)d_out; a.ws = (unsigned char*)d_ws;
#ifdef DBG
    (void)hipMemsetAsync((char*)d_ws + WS_DBG, 0, 512, stream);
    for (int p = 0; p < N_PHASES; ++p) { a.ph_lo = p; a.ph_hi = p + 1; hipLaunchKernelGGL(mega_fwd, dim3(grid), dim3(NTHREADS), LDS_BYTES, stream, a);
        hipLaunchKernelGGL(dbg_check, dim3(64), dim3(512), 0, stream, a, p); }
    hipLaunchKernelGGL(dbg_encode, dim3(1024), dim3(256), 0, stream, a);
#elif N_LAUNCH_PER_PHASE
    for (int p = 0; p < N_PHASES; ++p) { a.ph_lo = p; a.ph_hi = p + 1; hipLaunchKernelGGL(mega_fwd, dim3(grid), dim3(NTHREADS), LDS_BYTES, stream, a); }
#else
    a.ph_lo = 0; a.ph_hi = N_PHASES;
    hipLaunchKernelGGL(mega_fwd, dim3(grid), dim3(NTHREADS), LDS_BYTES, stream, a);
#endif
}
```

```cpp
#include <hip/hip_runtime.h>
#include <cstdio>
#include <cstdint>
#include <cstddef>

#define LAS __attribute__((address_space(3)))
#define GAS __attribute__((address_space(1)))
typedef unsigned short bf16_t;
typedef short bf16x8 __attribute__((ext_vector_type(8)));
typedef float f32x4 __attribute__((ext_vector_type(4)));
typedef float f32x2 __attribute__((ext_vector_type(2)));
typedef unsigned u32x4 __attribute__((ext_vector_type(4)));
typedef unsigned u32x2 __attribute__((ext_vector_type(2)));

#ifndef N_LAUNCH_PER_PHASE
#define N_LAUNCH_PER_PHASE 0
#endif

constexpr int D = 1024, NB = 4, SEQ = 8192, T = NB * SEQ, CTXL = 256, TC = NB * CTXL, TT = T + TC;
constexpr int NH = 4, DK = 64, DV = 128, CH = 64, NCHUNK = SEQ / CH, NCC = CTXL / CH, NCT = NCHUNK + NCC;
constexpr int HYW = 512, HYC = 3 * HYW, INW = 3104;
constexpr int NE = 32, DE = 1024, CAP = T;
constexpr float LN_EPS = 1e-6f, ALPHA = 1.189207115002721f;
constexpr int NTHREADS = 512, NWAVES = 8;
constexpr int FFTN = 16384;

constexpr size_t al256(size_t x) { return (x + 255) & ~(size_t)255; }
constexpr size_t WS_BAR   = 0;
constexpr size_t WS_MOD   = 16384;
constexpr size_t WS_CNT   = WS_MOD + 5 * 6144 * 4;
constexpr size_t WS_ZERO_BYTES = al256(WS_CNT + 256);
constexpr size_t WS_LIST  = 262144;
constexpr size_t WS_PW    = WS_LIST + (size_t)NE * CAP * 4;
constexpr size_t WS_PLOC  = WS_PW + (size_t)T * 4 * 4;
constexpr size_t WS_B1R   = WS_PLOC + (size_t)T * 4 * 4;
constexpr size_t WS_HID2  = WS_B1R + (size_t)NE * 2048 * 4;
constexpr size_t WS_BTIN  = WS_HID2 + (size_t)SEQ * 64 * 4;
constexpr size_t WS_BTOUT = WS_BTIN + (size_t)3584 * 1024 * 2;
constexpr size_t WS_W1T   = WS_BTOUT + (size_t)1024 * 1024 * 2;
constexpr size_t WS_W2T   = WS_W1T + (size_t)NE * 2048 * 1024 * 2;
constexpr size_t WS_PRE1  = WS_W2T + (size_t)NE * 1024 * 1024 * 2;
constexpr size_t WS_RA    = WS_PRE1 + (size_t)T * 1024 * 4;
constexpr size_t WS_H     = WS_RA;
constexpr size_t WS_Q     = WS_H + (size_t)TT * 1024 * 2;
constexpr size_t WS_K     = WS_Q + (size_t)T * 256 * 2;
constexpr size_t WS_V     = WS_K + (size_t)TT * 256 * 2;
constexpr size_t WS_G     = WS_V + (size_t)TT * 512 * 2;
constexpr size_t WS_GF    = WS_G + (size_t)T * 512 * 2;
constexpr size_t WS_GB    = WS_GF + (size_t)TT * 256 * 4;
constexpr size_t WS_UT    = WS_GB + (size_t)TT * 256 * 4;
constexpr size_t WS_RA_END= WS_UT + (size_t)NB * HYC * SEQ * 2;
constexpr size_t WS_H2    = WS_RA;
constexpr size_t WS_FG    = WS_RA + (size_t)T * 1024 * 2;
constexpr size_t WS_SLOTS = WS_RA;
constexpr size_t SORTED_BYTES_ = (size_t)(T * 4 / 256 + NE) * 256 * 1024 * 2;
constexpr size_t WS_RB    = al256(WS_RA_END > WS_RA + SORTED_BYTES_ ? WS_RA_END : WS_RA + SORTED_BYTES_);
constexpr size_t WS_KV    = WS_RB;
constexpr size_t WS_AV    = WS_KV + (size_t)2 * 16 * NCT * 8192 * 2;
constexpr size_t WS_SP    = WS_AV + (size_t)2 * 16 * NCT * 64 * 4;
constexpr size_t WS_HSPEC = WS_SP + (size_t)2 * 16 * NCHUNK * 8192 * 2;
constexpr size_t HSPEC_PER_WG = (size_t)2 * FFTN * 8;
constexpr int MAX_GRID = 256;
constexpr size_t WS_YHYT  = WS_HSPEC + (size_t)MAX_GRID * HSPEC_PER_WG;
constexpr size_t WS_MIX   = WS_YHYT + (size_t)NB * HYW * SEQ * 2;
constexpr size_t WS_RB_END= WS_MIX + (size_t)T * 1024 * 2;
constexpr size_t WS_HF    = WS_MIX;
constexpr size_t WS_ACT   = WS_RB;
constexpr size_t SORTED_BYTES = (size_t)(T * 4 / 256 + NE) * 256 * 1024 * 2;
constexpr size_t WS_END   = al256(WS_RB_END > WS_RB + SORTED_BYTES ? WS_RB_END : WS_RB + SORTED_BYTES);

constexpr int LDS_BYTES = 147456;
constexpr int LDS_MISC  = 145408;

typedef __bf16 bf16n2 __attribute__((ext_vector_type(2)));
__device__ __forceinline__ unsigned pk2(float lo, float hi) { bf16n2 v = {(__bf16)lo, (__bf16)hi}; return __builtin_bit_cast(unsigned, v); }
__device__ __forceinline__ bf16_t f2bf(float f) { __bf16 b = (__bf16)f; return __builtin_bit_cast(unsigned short, b); }
__device__ __forceinline__ float bf2f(bf16_t b) { return __uint_as_float(((unsigned)b) << 16); }
__device__ __forceinline__ float bflo(unsigned w) { return __uint_as_float(w << 16); }
__device__ __forceinline__ float bfhi(unsigned w) { return __uint_as_float(w & 0xffff0000u); }
__device__ __forceinline__ float wave_sum(float v) {
#pragma unroll
    for (int o = 1; o < 64; o <<= 1) v += __shfl_xor(v, o);
    return v;
}
__device__ __forceinline__ float silu_f(float x) { return x * __builtin_amdgcn_rcpf(1.f + __expf(-x)); }
__device__ __forceinline__ float log_sigmoid_f(float z) { return fminf(z, 0.f) - __logf(1.f + __expf(-fabsf(z))); }

#define XB_TMO      128
#define XB_XCNT(j)  (256  + 64 * (j))
#define XB_XSUB(j)  (1280 + 64 * (j))
#define XB_XGEN(j)  (2304 + 64 * (j))
#define XB_TOP      3328
#define XB_TOPGEN   3392
#define XCD_BAR_WORDS 3456
#define XB_SPIN_CAP (1u << 22)
__device__ __forceinline__ unsigned xb_ld(unsigned* p)              { return __hip_atomic_load(p, __ATOMIC_RELAXED, __HIP_MEMORY_SCOPE_AGENT); }
__device__ __forceinline__ unsigned xb_add(unsigned* p, unsigned v) { return __hip_atomic_fetch_add(p, v, __ATOMIC_RELAXED, __HIP_MEMORY_SCOPE_AGENT); }
__device__ __forceinline__ unsigned xb_xcc_id() { return (unsigned)__builtin_amdgcn_s_getreg((3 << 11) | 20) & 0xFu; }
#define XB_SPIN(cond, bar) do { unsigned _sp = 0; while (cond) { __builtin_amdgcn_s_sleep(1); \
    if ((++_sp & 255u) == 0u) { if (xb_ld(&(bar)[XB_TMO])) break; if (_sp > XB_SPIN_CAP) { atomicAdd(&(bar)[XB_TMO], 1u); break; } } } } while (0)
struct XcdBarrier { unsigned* bar; unsigned x; volatile LAS unsigned* st; };
__device__ __forceinline__ XcdBarrier xcd_barrier_post(unsigned* bar, volatile LAS unsigned* st) {
    XcdBarrier b; b.bar = bar; b.x = xb_xcc_id(); b.st = st;
    if (threadIdx.x == 0) (void)xb_add(&bar[XB_XCNT(b.x)], 1u);
    return b;
}
__device__ __forceinline__ void xcd_barrier_complete(unsigned* bar, unsigned x, unsigned& nloc, unsigned& nx) {
    const unsigned G = gridDim.x * gridDim.y * gridDim.z;
    unsigned sum, cnt, mine, sp = 0u;
    for (;;) {
        sum = 0u; cnt = 0u; mine = 0u;
#pragma unroll
        for (unsigned j = 0; j < 16; ++j) { const unsigned c = xb_ld(&bar[XB_XCNT(j)]); sum += c; cnt += (c > 0u) ? 1u : 0u; mine = (j == x) ? c : mine; }
        if (sum == G) break;
        __builtin_amdgcn_s_sleep(1);
        if ((++sp & 255u) == 0u) { if (xb_ld(&bar[XB_TMO])) break; if (sp > XB_SPIN_CAP) { atomicAdd(&bar[XB_TMO], 1u); break; } }
    }
    nloc = mine > 0u ? mine : 1u; nx = cnt > 0u ? cnt : 1u;
}
__device__ __forceinline__ void xcd_barrier(const XcdBarrier& b) {
    asm volatile("s_waitcnt vmcnt(0)" ::: "memory");
    __syncthreads();
    if (threadIdx.x == 0) {
        unsigned* bar = b.bar;
        __builtin_amdgcn_s_waitcnt(0);
        unsigned nloc = b.st[0], nx = b.st[1];
        if (nloc == 0u) { xcd_barrier_complete(bar, b.x, nloc, nx); b.st[0] = nloc; b.st[1] = nx; }
        const unsigned old = xb_add(&bar[XB_XSUB(b.x)], 1u);
        const unsigned gen = old / nloc;
        if (old + 1u == (gen + 1u) * nloc) {
            __builtin_amdgcn_fence(__ATOMIC_RELEASE, "agent");
            asm volatile("s_waitcnt vmcnt(0)" ::: "memory");
            const unsigned og = xb_add(&bar[XB_TOP], 1u);
            const unsigned tg = og / nx;
            if (og + 1u == (tg + 1u) * nx) xb_add(&bar[XB_TOPGEN], 1u);
            else XB_SPIN(xb_ld(&bar[XB_TOPGEN]) == tg, bar);
            __builtin_amdgcn_fence(__ATOMIC_ACQUIRE, "agent");
            xb_add(&bar[XB_XGEN(b.x)], 1u);
            asm volatile("s_waitcnt vmcnt(0)" ::: "memory");
        } else {
            XB_SPIN(xb_ld(&bar[XB_XGEN(b.x)]) == gen, bar);
            __builtin_amdgcn_fence(__ATOMIC_ACQUIRE, "agent");
            asm volatile("s_waitcnt vmcnt(0)" ::: "memory");
        }
    }
    __syncthreads();
}

struct Args {
    const float* in[32];
    float* out;
    unsigned char* ws;
    int ph_lo, ph_hi;
    int rep_k, pad_;
};
enum { I_X = 0, I_C, I_CTX, I_CCTX, I_ADAW, I_ADAB, I_WIN, I_WAF, I_BAF, I_WAB, I_BAB, I_NORMG, I_CONVW, I_CONVB, I_FW1, I_FB1, I_FW2, I_FB2, I_FWOUT, I_FFREQ,
       I_BIASD, I_WOUT, I_LN1G, I_LN1B, I_RW, I_RB, I_EW1, I_EB1, I_EW2, I_EB2, I_LN2G, I_LN2B };


namespace gm {
constexpr int BM = 256, BK = 64, HALF = 128, HTB = HALF * BK * 2, STAGE_BYTES = 8 * HTB, KD = 1024, NT = KD / BK;
constexpr int ROWB = KD * 2;
typedef int i32x8 __attribute__((ext_vector_type(8)));
__device__ __forceinline__ int lds_off8(int r, int fq) { const int rr = r & 15; return ((r >> 4) * 2 + (fq >> 1)) * 1024 + ((rr * 64 + 32 * (fq & 1)) ^ (((rr >> 3) & 1) << 5)); }
__device__ __forceinline__ int lds_byte(int r, int c) { const int st = (r >> 4) * 2 + (c >> 5), rr = r & 15, cc = c & 31, ob = rr * 64 + cc * 2; return st * 1024 + (ob ^ (((ob >> 9) & 1) << 5)); }
__device__ __forceinline__ void stage_rc(int b, int& R, int& C) { const int st = b / 1024, sb = b % 1024, swz = sb ^ (((sb >> 9) & 1) << 5); R = (st >> 1) * 16 + swz / 64; C = (st & 1) * 32 + (swz % 64) / 2; }
__device__ __forceinline__ int perm32(int rho) { const int n = rho >> 4, i = rho & 15; return 8 * (i >> 2) + 4 * n + (i & 3); }

constexpr int LDS_BIAS = STAGE_BYTES + 4096;
struct Unit {
    const char* A;
    const char* B;
    const int* list;
    int type, row0, col0, valid, aux;
};

__device__ __forceinline__ i32x8 cat8(bf16x8 lo, bf16x8 hi) { typedef int i32x4 __attribute__((ext_vector_type(4))); const i32x4 a = __builtin_bit_cast(i32x4, lo), b = __builtin_bit_cast(i32x4, hi); return (i32x8){a[0], a[1], a[2], a[3], b[0], b[1], b[2], b[3]}; }
template <bool GATHER, int GSHIFT, int RB>
__device__ __forceinline__ void a_offsets(const Unit& u, unsigned (&o)[2][2]) {
    int R[2], Cb[2];
    int tz = threadIdx.x; asm volatile("" : "+v"(tz));
#pragma unroll
    for (int i = 0; i < 2; ++i) { int r, c; stage_rc(tz * 16 + i * 8192, r, c); R[i] = r; Cb[i] = c * 2; }
#pragma unroll
    for (int h = 0; h < 2; ++h)
#pragma unroll
        for (int i = 0; i < 2; ++i) {
            const int r = h * HALF + R[i];
            if (!GATHER) o[h][i] = (unsigned)(r * RB + Cb[i]);
            else { const int idx = u.list[r < u.valid ? r : 0]; o[h][i] = (unsigned)(idx >> GSHIFT) * (unsigned)RB + (unsigned)Cb[i]; }
        }
}

template <bool GATHER, int GSHIFT, bool FP8, class Sched, class Epi>
__device__ __forceinline__ void gemm_stream(LAS unsigned char* lds, const Sched& S, const Epi& E) {
    constexpr int RB = FP8 ? KD : ROWB, NTL = FP8 ? NT / 2 : NT;
    const int tid = threadIdx.x, wid = __builtin_amdgcn_readfirstlane(tid >> 6), lane = tid & 63, wr = wid >> 2, wc = wid & 3, fr = lane & 15, fq = lane >> 4;
    unsigned voffB[2], voffA[2];
#pragma unroll
    for (int i = 0; i < 2; ++i) { int r, c; stage_rc(tid * 16 + i * 8192, r, c); const int rb = (r & ~31) + perm32(r & 31); voffB[i] = (unsigned)(rb * RB + c * 2); voffA[i] = (unsigned)(r * RB + c * 2); }
    const size_t kstep = (size_t)(BK * 2), hstep = (size_t)HALF * RB;
    const unsigned ldsw = (unsigned)wid * 1024u;
    const int aoff = FP8 ? lds_off8(wr * 64 + fr, fq) : lds_byte(wr * 64 + fr, fq * 8), boff = FP8 ? lds_off8(wc * 32 + fr, fq) : lds_byte(wc * 32 + fr, fq * 8);
#define GM_SA(b, h) (((b) * 2 + (h)) * HTB)
#define GM_SB(b, h) ((4 + (b) * 2 + (h)) * HTB)
#define GM_STAGE(bufoff, gbase, vo0, vo1) do { \
        __builtin_amdgcn_global_load_lds((const unsigned*)((const char*)(gbase) + (vo0)), (LAS unsigned*)(lds + (bufoff) + ldsw), 16, 0, 0); \
        __builtin_amdgcn_global_load_lds((const unsigned*)((const char*)(gbase) + (vo1)), (LAS unsigned*)(lds + (bufoff) + ldsw + 8192), 16, 0, 0); } while (0)
#define GM_STAGE_A(bufoff, gbase, h, o0, o1) do { if constexpr (GATHER) GM_STAGE(bufoff, gbase, o0, o1); else GM_STAGE(bufoff, (gbase) + (h) * hstep, voffA[0], voffA[1]); } while (0)
#define GM_LD32(p) ({ const i32x4 lo_ = *(const LAS i32x4*)(p), hi_ = *(const LAS i32x4*)((p) + 16); (i32x8){lo_[0], lo_[1], lo_[2], lo_[3], hi_[0], hi_[1], hi_[2], hi_[3]}; })
#define GM_LDA(dst, b, h) do { if constexpr (FP8) { _Pragma("unroll") for (int m = 0; m < 4; ++m) dst##8[m] = GM_LD32(lds + GM_SA(b, h) + aoff + m * 2048); } \
        else { _Pragma("unroll") for (int m = 0; m < 4; ++m) _Pragma("unroll") for (int k = 0; k < 2; ++k) dst[m][k] = *(const LAS bf16x8*)(lds + GM_SA(b, h) + aoff + m * 2048 + k * 1024); } } while (0)
#define GM_LDB(dst, b, h) do { if constexpr (FP8) { _Pragma("unroll") for (int n = 0; n < 2; ++n) dst##8[n] = GM_LD32(lds + GM_SB(b, h) + boff + n * 2048); } \
        else { _Pragma("unroll") for (int n = 0; n < 2; ++n) _Pragma("unroll") for (int k = 0; k < 2; ++k) dst[n][k] = *(const LAS bf16x8*)(lds + GM_SB(b, h) + boff + n * 2048 + k * 1024); } } while (0)
#define GM_MMA(ai, bj, At, Bt) do { __builtin_amdgcn_s_setprio(1); _Pragma("unroll") for (int m = 0; m < 4; ++m) _Pragma("unroll") for (int n = 0; n < 2; ++n) { \
        if constexpr (FP8) asm volatile("v_mfma_scale_f32_16x16x128_f8f6f4 %0, %1, %2, %0, %3, %3 op_sel_hi:[0,0,0]" : "+v"(acc[ai][bj][m][n]) : "v"(Bt##8[n]), "v"(At##8[m]), "v"(sc1_)); \
        else { _Pragma("unroll") for (int k = 0; k < 2; ++k) acc[ai][bj][m][n] = __builtin_amdgcn_mfma_f32_16x16x32_bf16(Bt[n][k], At[m][k], acc[ai][bj][m][n], 0, 0, 0); } } \
        __builtin_amdgcn_s_setprio(0); } while (0)
#define GM_WAIT_V(n) asm volatile("s_waitcnt vmcnt(" #n ")" ::: "memory")
#define GM_WAIT_L(n) asm volatile("s_waitcnt lgkmcnt(" #n ")" ::: "memory")
#define GM_BAR __builtin_amdgcn_s_barrier()
#define GM_SCHED __builtin_amdgcn_sched_barrier(0)
    Unit cur, nxt; int ui = 0;
    if (!S.next(0, cur)) return;
    f32x4 acc[2][2][4][2];
#pragma unroll
    for (int a = 0; a < 2; ++a)
#pragma unroll
        for (int b = 0; b < 2; ++b)
#pragma unroll
            for (int m = 0; m < 4; ++m)
#pragma unroll
                for (int n = 0; n < 2; ++n) acc[a][b][m][n] = (f32x4){0.f, 0.f, 0.f, 0.f};
    typedef int i32x4 __attribute__((ext_vector_type(4)));
    int sc1_ = 0x7f7f7f7f; asm volatile("" : "+v"(sc1_));
    bf16x8 At[4][2], B0[2][2], B1[2][2];
    i32x8 At8[4], B08[2], B18[2];
    unsigned ca[2][2], na[2][2];
    if constexpr (GATHER) a_offsets<GATHER, GSHIFT, RB>(cur, ca);
    const char* cA = cur.A; const char* cB = cur.B;
    GM_STAGE(GM_SB(0, 0), cB, voffB[0], voffB[1]); GM_STAGE_A(GM_SA(0, 0), cA, 0, ca[0][0], ca[0][1]); GM_STAGE(GM_SB(0, 1), cB + hstep, voffB[0], voffB[1]); GM_STAGE_A(GM_SA(0, 1), cA, 1, ca[1][0], ca[1][1]);
    if (wr == 1) GM_BAR;
    GM_WAIT_V(4); GM_BAR;
    GM_STAGE(GM_SB(1, 0), cB + kstep, voffB[0], voffB[1]); GM_STAGE_A(GM_SA(1, 0), cA + kstep, 0, ca[0][0], ca[0][1]); GM_STAGE(GM_SB(1, 1), cB + hstep + kstep, voffB[0], voffB[1]);
    GM_WAIT_V(6); GM_BAR;
    for (;;) {
        const bool has_next = S.next(ui + 1, nxt);
        if constexpr (GATHER) {
            if (has_next) a_offsets<GATHER, GSHIFT, RB>(nxt, na);
            else {
#pragma unroll
                for (int h = 0; h < 2; ++h)
#pragma unroll
                    for (int i = 0; i < 2; ++i) na[h][i] = ca[h][i];
            }
        }
        const char* nA = has_next ? nxt.A : cA; const char* nB = has_next ? nxt.B : cB;
        if (wid == 0)
            __builtin_amdgcn_global_load_lds((const unsigned*)(S.bias(cur) + 4 * lane), (LAS unsigned*)(lds + LDS_BIAS + (ui & 1) * 1024), 16, 0, 0);
        for (int t = 0; t < NTL; t += 2) {
            const bool last = (t == NTL - 2);

            const char* a1 = cA + (size_t)(t + 1) * kstep;
            const char* a2 = last ? nA : cA + (size_t)(t + 2) * kstep; const char* b2 = last ? nB : cB + (size_t)(t + 2) * kstep;
            const char* a3 = a2 + kstep; const char* b3 = b2 + kstep;
            unsigned x00 = 0, x01 = 0, x10 = 0, x11 = 0;
            if constexpr (GATHER) { x00 = last ? na[0][0] : ca[0][0]; x01 = last ? na[0][1] : ca[0][1]; x10 = last ? na[1][0] : ca[1][0]; x11 = last ? na[1][1] : ca[1][1]; }
            GM_LDB(B0, 0, 0); GM_SCHED; GM_LDA(At, 0, 0); GM_STAGE_A(GM_SA(1, 1), a1, 1, ca[1][0], ca[1][1]);
            GM_WAIT_L(8); GM_BAR; GM_WAIT_L(0); GM_MMA(0, 0, At, B0); GM_BAR; GM_SCHED;
            GM_LDB(B1, 0, 1); GM_STAGE(GM_SB(0, 0), b2, voffB[0], voffB[1]);
            GM_BAR; GM_WAIT_L(0); GM_MMA(0, 1, At, B1); GM_BAR;
            GM_LDA(At, 0, 1); GM_STAGE_A(GM_SA(0, 0), a2, 0, x00, x01);
            GM_BAR; GM_WAIT_L(0); GM_MMA(1, 0, At, B0); GM_BAR; GM_SCHED;
            GM_STAGE(GM_SB(0, 1), b2 + hstep, voffB[0], voffB[1]);
            GM_WAIT_V(6); GM_BAR; GM_MMA(1, 1, At, B1); GM_BAR;
            GM_LDB(B0, 1, 0); GM_SCHED; GM_LDA(At, 1, 0); GM_STAGE_A(GM_SA(0, 1), a2, 1, x10, x11);
            GM_WAIT_L(8); GM_BAR; GM_WAIT_L(0); GM_MMA(0, 0, At, B0); GM_BAR; GM_SCHED;
            GM_LDB(B1, 1, 1); GM_STAGE(GM_SB(1, 0), b3, voffB[0], voffB[1]);
            GM_BAR; GM_WAIT_L(0); GM_MMA(0, 1, At, B1); GM_BAR;
            GM_LDA(At, 1, 1); GM_STAGE_A(GM_SA(1, 0), a3, 0, x00, x01);
            GM_BAR; GM_WAIT_L(0); GM_MMA(1, 0, At, B0); GM_BAR; GM_SCHED;
            GM_STAGE(GM_SB(1, 1), b3 + hstep, voffB[0], voffB[1]);
            GM_WAIT_V(6); GM_BAR; GM_MMA(1, 1, At, B1); GM_BAR;
        }
        if constexpr (FP8) asm volatile("s_nop 7\n\ts_nop 7" ::: "memory");
        {
          int tz = threadIdx.x; asm volatile("" : "+v"(tz)); const int wz = tz >> 6, lz = tz & 63;
          E(acc, cur, wz >> 2, wz & 3, lz & 15, lz >> 4, (const LAS float*)(lds + LDS_BIAS + (ui & 1) * 1024)); }
        if (!has_next) break;
#pragma unroll
        for (int a = 0; a < 2; ++a)
#pragma unroll
            for (int b = 0; b < 2; ++b)
#pragma unroll
                for (int m = 0; m < 4; ++m)
#pragma unroll
                    for (int n = 0; n < 2; ++n) acc[a][b][m][n] = (f32x4){0.f, 0.f, 0.f, 0.f};
        cur = nxt; cA = nA; cB = nB; ++ui;
        if constexpr (GATHER) {
#pragma unroll
            for (int h = 0; h < 2; ++h)
#pragma unroll
                for (int i = 0; i < 2; ++i) ca[h][i] = na[h][i];
        }
    }
    GM_WAIT_V(0);
    if (wr == 0) GM_BAR;
    GM_BAR;
#undef GM_SA
#undef GM_SB
#undef GM_STAGE
#undef GM_STAGE_A
#undef GM_LD32
#undef GM_LDA
#undef GM_LDB
#undef GM_MMA
#undef GM_WAIT_V
#undef GM_WAIT_L
#undef GM_BAR
#undef GM_SCHED
}

__device__ __forceinline__ u32x4 pack8(f32x4 a, f32x4 b) { u32x4 w; w.x = pk2(a[0], a[1]); w.y = pk2(a[2], a[3]); w.z = pk2(b[0], b[1]); w.w = pk2(b[2], b[3]); return w; }

struct SchedIn {
    unsigned char* ws; int G, c; const float* baf; const float* bab;
    __device__ __forceinline__ bool next(int i, Unit& u) const {
        int L = i * G + c;
        u.list = nullptr; u.valid = 256; u.aux = 0;
        if (L < 768) {
            const int pa = L % 6, pb = L / 6;
            u.A = (const char*)(ws + WS_BTIN) + (size_t)(2048 + 256 * pa) * ROWB; u.B = (const char*)(ws + WS_H) + (size_t)(256 * pb) * ROWB;
            u.type = 2; u.row0 = 256 * pa; u.col0 = 256 * pb; return true;
        }
        L -= 768;
        if (L < 1024) {
            const int pm = L >> 3, pn = ((L & 7) + (L >> 8)) & 7;
            u.A = (const char*)(ws + WS_H) + (size_t)(256 * pm) * ROWB; u.B = (const char*)(ws + WS_BTIN) + (size_t)(256 * pn) * ROWB;
            u.type = pn < 6 ? 0 : 1; u.row0 = 256 * pm; u.col0 = pn; return true;
        }
        L -= 1024;
        if (L < 20) {
            const int pm = L / 5, j = L % 5, pn = j == 0 ? 1 : (j == 1 ? 2 : (j == 2 ? 3 : (j == 3 ? 6 : 7)));
            u.A = (const char*)(ws + WS_H) + (size_t)(T + 256 * pm) * ROWB; u.B = (const char*)(ws + WS_BTIN) + (size_t)(256 * pn) * ROWB;
            u.type = pn < 6 ? 0 : 1; u.row0 = T + 256 * pm; u.col0 = pn; return true;
        }
        return false;
    }
    __device__ __forceinline__ const float* bias(const Unit& u) const { return (u.type == 1 && u.col0 == 7) ? bab : baf; }
};
struct EpiIn {
    unsigned char* ws;
    __device__ __forceinline__ void operator()(const f32x4 (&acc)[2][2][4][2], const Unit& u, int wr, int wc, int fr, int fq, const LAS float* bs) const {
        const int rl = wr * 64 + fr, cl = wc * 32 + 8 * fq;
        if (u.type == 0) {
            const int pn = u.col0;
            bf16_t* dst; int ld, cb;
            if (pn == 0) { dst = (bf16_t*)(ws + WS_Q); ld = 256; cb = 0; }
            else if (pn == 1) { dst = (bf16_t*)(ws + WS_K); ld = 256; cb = 0; }
            else if (pn < 4) { dst = (bf16_t*)(ws + WS_V); ld = 512; cb = (pn - 2) * 256; }
            else { dst = (bf16_t*)(ws + WS_G); ld = 512; cb = (pn - 4) * 256; }
#pragma unroll
            for (int ai = 0; ai < 2; ++ai)
#pragma unroll
                for (int m = 0; m < 4; ++m) { bf16_t* rowp = dst + (size_t)(u.row0 + rl + ai * 128 + m * 16) * ld + cb + cl;
#pragma unroll
                    for (int bj = 0; bj < 2; ++bj) *(u32x4*)(rowp + bj * 128) = pack8(acc[ai][bj][m][0], acc[ai][bj][m][1]); }
        } else if (u.type == 1) {
            float* dst = (float*)(ws + (u.col0 == 6 ? WS_GF : WS_GB));
            f32x4 bv[2][2];
#pragma unroll
            for (int bj = 0; bj < 2; ++bj)
#pragma unroll
                for (int n = 0; n < 2; ++n) bv[bj][n] = *(const LAS f32x4*)(bs + cl + bj * 128 + 4 * n);
#pragma unroll
            for (int ai = 0; ai < 2; ++ai)
#pragma unroll
                for (int m = 0; m < 4; ++m) { float* rowp = dst + (size_t)(u.row0 + rl + ai * 128 + m * 16) * 256 + cl;
#pragma unroll
                    for (int bj = 0; bj < 2; ++bj)
#pragma unroll
                        for (int n = 0; n < 2; ++n) { f32x4 z = acc[ai][bj][m][n] + bv[bj][n], o;
#pragma unroll
                            for (int j = 0; j < 4; ++j) o[j] = log_sigmoid_f(z[j]) * (1.f / 16.f);
                            *(f32x4*)(rowp + bj * 128 + 4 * n) = o; } }
        } else {
            const int b = u.col0 >> 13, l0 = u.col0 & 8191;
            bf16_t* dst = (bf16_t*)(ws + WS_UT) + ((size_t)b * HYC) * SEQ + l0 + cl;
#pragma unroll
            for (int ai = 0; ai < 2; ++ai)
#pragma unroll
                for (int m = 0; m < 4; ++m) { bf16_t* rowp = dst + (size_t)(u.row0 + rl + ai * 128 + m * 16) * SEQ;
#pragma unroll
                    for (int bj = 0; bj < 2; ++bj) *(u32x4*)(rowp + bj * 128) = pack8(acc[ai][bj][m][0], acc[ai][bj][m][1]); }
        }
    }
};

struct SchedOut {
    unsigned char* ws; int G, c;
    __device__ __forceinline__ bool next(int i, Unit& u) const {
        const int L = i * G + c; if (L >= 512) return false;
        const int pm = L >> 2, pn = L & 3;
        u.A = (const char*)(ws + WS_MIX) + (size_t)(256 * pm) * ROWB; u.B = (const char*)(ws + WS_BTOUT) + (size_t)(256 * pn) * ROWB;
        u.list = nullptr; u.valid = 256; u.aux = 0; u.type = 3; u.row0 = 256 * pm; u.col0 = 256 * pn; return true;
    }
    __device__ __forceinline__ const float* bias(const Unit& u) const { return (const float*)(ws + WS_MOD) + (u.row0 >> 13) * 6144 + 2 * 1024 + u.col0; }
};
struct EpiOut {
    unsigned char* ws;
    __device__ __forceinline__ void operator()(const f32x4 (&acc)[2][2][4][2], const Unit& u, int wr, int wc, int fr, int fq, const LAS float* bs) const {
        const int rl = wr * 64 + fr, cl = u.col0 + wc * 32 + 8 * fq;
        bf16_t* fg = (bf16_t*)(ws + WS_FG);
        f32x4 gv[2][2];
#pragma unroll
        for (int bj = 0; bj < 2; ++bj)
#pragma unroll
            for (int n = 0; n < 2; ++n) gv[bj][n] = *(const LAS f32x4*)(bs + wc * 32 + 8 * fq + bj * 128 + 4 * n);
#pragma unroll
        for (int ai = 0; ai < 2; ++ai)
#pragma unroll
            for (int m = 0; m < 4; ++m) { bf16_t* rowp = fg + (size_t)(u.row0 + rl + ai * 128 + m * 16) * 1024 + cl;
#pragma unroll
                for (int bj = 0; bj < 2; ++bj) *(u32x4*)(rowp + bj * 128) = pack8(gv[bj][0] * acc[ai][bj][m][0], gv[bj][1] * acc[ai][bj][m][1]); }
    }
};

constexpr int LDS_TAB = STAGE_BYTES;
template <int WHICH>
struct SchedMoe {
    unsigned char* ws; const LAS int* tab; int G, c; const float* b2;
    __device__ __forceinline__ bool next(int i, Unit& u) const {
        constexpr int NCT_ = WHICH == 1 ? 8 : 4;
        const int L = i * G + c; const int nrt = __builtin_amdgcn_readfirstlane(tab[32]);
        if (L >= nrt * NCT_) return false;
        const int rt = L / NCT_, ct = L % NCT_;
        const int info = __builtin_amdgcn_readfirstlane(tab[64 + rt]), e = info & 255, r0 = (info >> 8) * 256;
        const int cnt = __builtin_amdgcn_readfirstlane(tab[e]);
        u.valid = (cnt - r0) < 256 ? (cnt - r0) : 256;
        u.list = (const int*)(ws + WS_LIST) + (size_t)e * CAP + r0;
        u.A = (WHICH == 1) ? (const char*)(ws + WS_H2) : (const char*)(ws + WS_ACT) + (size_t)(256 * rt) * KD;
        u.B = (const char*)(ws + (WHICH == 1 ? WS_W1T : WS_W2T)) + ((size_t)e * (WHICH == 1 ? 2048 : 1024) + 256 * ct) * KD;
        u.type = 3 + WHICH; u.row0 = 256 * rt; u.col0 = ct; u.aux = e; return true;
    }
    __device__ __forceinline__ const float* bias(const Unit& u) const { return (WHICH == 1) ? (const float*)(ws + WS_B1R) + (size_t)u.aux * 2048 + 256 * u.col0 : b2 + (size_t)u.aux * 1024 + 256 * u.col0; }
};
__device__ __forceinline__ float swiglu_f(float glu, float lin) {
    glu = fminf(glu, 7.f); lin = fminf(fmaxf(lin, -7.f), 7.f);
    return glu * __builtin_amdgcn_rcpf(1.f + __expf(-1.702f * glu)) * (lin + 1.f);
}
constexpr float S_H2 = 4.f, S_ACT = 8.f, S_W = 64.f;
__device__ __forceinline__ unsigned pk4_fp8(float a, float b, float c, float d) {
    a = fminf(fmaxf(a, -448.f), 448.f); b = fminf(fmaxf(b, -448.f), 448.f); c = fminf(fmaxf(c, -448.f), 448.f); d = fminf(fmaxf(d, -448.f), 448.f);
    int p = __builtin_amdgcn_cvt_pk_fp8_f32(a, b, 0, false); p = __builtin_amdgcn_cvt_pk_fp8_f32(c, d, p, true); return (unsigned)p; }
struct EpiMoe1 {
    unsigned char* ws;
    __device__ __forceinline__ void operator()(const f32x4 (&acc)[2][2][4][2], const Unit& u, int wr, int wc, int fr, int fq, const LAS float* bs) const {
        const int rl = wr * 64 + fr, cl = wc * 32 + 8 * fq, ct = u.col0;
        const LAS float* b1 = bs + cl;
        unsigned char* act = (unsigned char*)(ws + WS_ACT) + (size_t)u.row0 * 1024 + 128 * ct + cl;
        f32x4 bg[2], bl[2];
#pragma unroll
        for (int n = 0; n < 2; ++n) { bg[n] = *(const LAS f32x4*)(b1 + 4 * n); bl[n] = *(const LAS f32x4*)(b1 + 128 + 4 * n); }
#pragma unroll
        for (int ai = 0; ai < 2; ++ai)
#pragma unroll
            for (int m = 0; m < 4; ++m) { const int r = rl + ai * 128 + m * 16;
                f32x4 o[2];
#pragma unroll
                for (int n = 0; n < 2; ++n) { const f32x4 gl = acc[ai][0][m][n] * (1.f / (S_H2 * S_W)) + bg[n], li = acc[ai][1][m][n] * (1.f / (S_H2 * S_W)) + bl[n];
#pragma unroll
                    for (int j = 0; j < 4; ++j) o[n][j] = swiglu_f(gl[j], li[j]) * S_ACT; }
                u32x2 w; w.x = pk4_fp8(o[0][0], o[0][1], o[0][2], o[0][3]); w.y = pk4_fp8(o[1][0], o[1][1], o[1][2], o[1][3]);
                *(u32x2*)(act + (size_t)r * 1024) = w; }
    }
};
struct EpiMoe2 {
    unsigned char* ws;
    __device__ __forceinline__ void operator()(const f32x4 (&acc)[2][2][4][2], const Unit& u, int wr, int wc, int fr, int fq, const LAS float* bs) const {
        const int rl = wr * 64 + fr, cl = wc * 32 + 8 * fq, ct = u.col0;
        const LAS float* bb = bs + cl;
        bf16_t* slots = (bf16_t*)(ws + WS_SLOTS) + (size_t)u.row0 * 1024 + 256 * ct + cl;
        f32x4 bv[2][2];
#pragma unroll
        for (int bj = 0; bj < 2; ++bj)
#pragma unroll
            for (int n = 0; n < 2; ++n) bv[bj][n] = *(const LAS f32x4*)(bb + bj * 128 + 4 * n);
#pragma unroll
        for (int ai = 0; ai < 2; ++ai)
#pragma unroll
            for (int m = 0; m < 4; ++m) { const int r = rl + ai * 128 + m * 16;
#pragma unroll
                for (int bj = 0; bj < 2; ++bj)
                    *(u32x4*)(slots + (size_t)r * 1024 + bj * 128) = pack8(acc[ai][bj][m][0] * (1.f / (S_ACT * S_W)) + bv[bj][0], acc[ai][bj][m][1] * (1.f / (S_ACT * S_W)) + bv[bj][1]); }
    }
};
}

namespace hy {
__device__ __forceinline__ int phys(int n) { return n + (n >> 4) + ((n >> 9) << 4); }
constexpr int XSIZE = 16384 + 1024 + 512;

__device__ __forceinline__ float tw_c(int i) {
    constexpr float t[16] = {1.f, 0.98078528040323043f, 0.92387953251128674f, 0.83146961230254524f, 0.70710678118654752f, 0.55557023301960218f, 0.38268343236508977f, 0.19509032201612825f,
                             0.f, -0.19509032201612825f, -0.38268343236508977f, -0.55557023301960218f, -0.70710678118654752f, -0.83146961230254524f, -0.92387953251128674f, -0.98078528040323043f};
    return t[i];
}
__device__ __forceinline__ float tw_s(int i) {
    constexpr float t[16] = {0.f, 0.19509032201612825f, 0.38268343236508977f, 0.55557023301960218f, 0.70710678118654752f, 0.83146961230254524f, 0.92387953251128674f, 0.98078528040323043f,
                             1.f, 0.98078528040323043f, 0.92387953251128674f, 0.83146961230254524f, 0.70710678118654752f, 0.55557023301960218f, 0.38268343236508977f, 0.19509032201612825f};
    return t[i];
}
__host__ __device__ constexpr int brev(int p, int bits) { int r = 0; for (int i = 0; i < bits; ++i) r |= ((p >> i) & 1) << (bits - 1 - i); return r; }

template <int R, bool INV>
__device__ __forceinline__ void fft_reg(f32x2 (&v)[R]) {
#pragma unroll
    for (int s = R / 2; s >= 1; s >>= 1) {
#pragma unroll
        for (int g = 0; g < R; g += 2 * s) {
#pragma unroll
            for (int k = 0; k < s; ++k) {
                const f32x2 a = v[g + k], b = v[g + k + s];
                v[g + k] = a + b;
                const f32x2 t = a - b;
                const int ti = k * (16 / s);
                f32x2 o;
                if (ti == 0) o = t;
                else if (ti == 8) { if (INV) { o[0] = -t[1]; o[1] = t[0]; } else { o[0] = t[1]; o[1] = -t[0]; } }
                else { const float c = tw_c(ti), sn = tw_s(ti);
                    if (INV) { o[0] = t[0] * c - t[1] * sn; o[1] = t[1] * c + t[0] * sn; }
                    else     { o[0] = t[0] * c + t[1] * sn; o[1] = t[1] * c - t[0] * sn; } }
                v[g + k + s] = o;
            }
        }
    }
}
__device__ __forceinline__ f32x2 cmul(f32x2 a, f32x2 b) { f32x2 r; r[0] = a[0] * b[0] - a[1] * b[1]; r[1] = a[0] * b[1] + a[1] * b[0]; return r; }

template <int M, bool ZPAD = false>
__device__ __forceinline__ void pass_fwd32(LAS f32x2* X, int tid) {
    int j = (M == 512) ? tid : (tid & 15);
    asm volatile("" : "+v"(j));
    const int p0 = (M == 512) ? (tid + (tid >> 4)) : (560 * (tid >> 4) + (tid & 15));
    constexpr int PS = (M == 512) ? 560 : 17;
    f32x2 v[32];
#pragma unroll
    for (int r = 0; r < 32; ++r) { if (ZPAD && r >= 16) v[r] = (f32x2){0.f, 0.f}; else v[r] = X[p0 + PS * r]; }
    fft_reg<32, false>(v);
    float sn, cs; sincospif(-2.f * (float)j / (float)(32 * M), &sn, &cs);
    const f32x2 w1 = {cs, sn}; f32x2 w = w1;
    X[p0] = v[0];
#pragma unroll
    for (int rp = 1; rp < 32; ++rp) { X[p0 + PS * rp] = cmul(v[brev(rp, 5)], w); w = cmul(w, w1); }
}
template <int M, bool HALF = false>
__device__ __forceinline__ void pass_inv32(LAS f32x2* X, int tid) {
    int j = (M == 512) ? tid : (tid & 15);
    asm volatile("" : "+v"(j));
    const int p0 = (M == 512) ? (tid + (tid >> 4)) : (560 * (tid >> 4) + (tid & 15));
    constexpr int PS = (M == 512) ? 560 : 17;
    float sn, cs; sincospif(2.f * (float)j / (float)(32 * M), &sn, &cs);
    const f32x2 w1 = {cs, sn}; f32x2 w = w1;
    f32x2 v[32];
    v[0] = X[p0];
#pragma unroll
    for (int rp = 1; rp < 32; ++rp) { v[rp] = cmul(X[p0 + PS * rp], w); w = cmul(w, w1); }
    fft_reg<32, true>(v);
#pragma unroll
    for (int p = 0; p < 32; ++p) { if (!HALF || brev(p, 5) < 16) X[p0 + PS * brev(p, 5)] = v[p]; }
}
__device__ __forceinline__ void pass_c_store(const LAS f32x2* X, f32x2* Hs, int tid, float scale) {
#pragma unroll
    for (int u = 0; u < 2; ++u) { const int blk = tid + 512 * u, p0 = 17 * blk + 16 * (blk >> 5);
        f32x2 v[16];
#pragma unroll
        for (int r = 0; r < 16; ++r) v[r] = X[p0 + r];
        fft_reg<16, false>(v);
#pragma unroll
        for (int q = 0; q < 8; ++q) { const f32x2 x0 = v[brev(2 * q, 4)] * scale, x1 = v[brev(2 * q + 1, 4)] * scale;
            *(f32x4*)(Hs + 16 * blk + 2 * q) = (f32x4){x0[0], x0[1], x1[0], x1[1]}; } }
}
__device__ __forceinline__ void pass_c_mul_inv(LAS f32x2* X, const f32x2* Hs, int tid) {
#pragma unroll
    for (int u = 0; u < 2; ++u) { const int blk = tid + 512 * u, p0 = 17 * blk + 16 * (blk >> 5);
        f32x2 v[16], w[16];
#pragma unroll
        for (int r = 0; r < 16; ++r) v[r] = X[p0 + r];
        f32x4 hh[8];
#pragma unroll
        for (int q = 0; q < 8; ++q) hh[q] = *(const f32x4*)(Hs + 16 * blk + 2 * q);
        fft_reg<16, false>(v);
#pragma unroll
        for (int q = 0; q < 8; ++q) { w[2 * q] = cmul(v[brev(2 * q, 4)], (f32x2){hh[q][0], hh[q][1]}); w[2 * q + 1] = cmul(v[brev(2 * q + 1, 4)], (f32x2){hh[q][2], hh[q][3]}); }
        fft_reg<16, true>(w);
#pragma unroll
        for (int p = 0; p < 16; ++p) X[p0 + brev(p, 4)] = w[p]; }
}
__device__ __forceinline__ void load16(const bf16_t* u, float (&e)[16]) {
    const u32x4 a = *(const u32x4*)u, b = *(const u32x4*)(u + 8);
    e[0] = bflo(a.x); e[1] = bfhi(a.x); e[2] = bflo(a.y); e[3] = bfhi(a.y); e[4] = bflo(a.z); e[5] = bfhi(a.z); e[6] = bflo(a.w); e[7] = bfhi(a.w);
    e[8] = bflo(b.x); e[9] = bfhi(b.x); e[10] = bflo(b.y); e[11] = bfhi(b.y); e[12] = bflo(b.z); e[13] = bfhi(b.z); e[14] = bflo(b.w); e[15] = bfhi(b.w);
}
__device__ __forceinline__ void sconv16(const bf16_t* u, int tid, float w0, float w1, float w2, float bias, float (&o)[16]) {
    float e[16]; load16(u + 16 * tid, e);
    float lf = __shfl_up(e[15], 1), rt = __shfl_down(e[0], 1);
    if ((tid & 3) == 0) lf = 0.f;
    if ((tid & 3) == 3) rt = 0.f;
    o[0] = w0 * lf + w1 * e[0] + w2 * e[1] + bias;
#pragma unroll
    for (int i = 1; i < 15; ++i) o[i] = w0 * e[i - 1] + w1 * e[i] + w2 * e[i + 1] + bias;
    o[15] = w0 * e[14] + w1 * e[15] + w2 * rt + bias;
}

__device__ __forceinline__ void channel(const Args& a, LAS unsigned char* lds, int c, unsigned char* scratch) {
    const int tid = threadIdx.x;
    LAS f32x2* X = (LAS f32x2*)lds;
    f32x2* Hs = (f32x2*)scratch;
    const float* HF = (const float*)(a.ws + WS_HF);
    const int pc = 17 * tid + 16 * (tid >> 5);
    __syncthreads();
#pragma unroll 1
    for (int o = 0; o < 2; ++o) {
        const f32x4* hf = (const f32x4*)(HF + ((size_t)(2 * o) * HYW + c) * SEQ + 16 * tid); const f32x4* hb = (const f32x4*)(HF + ((size_t)(2 * o + 1) * HYW + c) * SEQ + 16 * tid);
#pragma unroll
        for (int q = 0; q < 4; ++q) { const f32x4 f = hf[q], b = hb[q];
#pragma unroll
            for (int e = 0; e < 4; ++e) { const int i = 4 * q + e, t = 16 * tid + i;
                X[pc + i] = (f32x2){f[e], 0.f};
                if (t >= 1) X[phys(FFTN - t)] = (f32x2){b[e], 0.f}; } }
        if (tid == 0) X[phys(SEQ)] = (f32x2){0.f, 0.f};
        __syncthreads();
        pass_fwd32<512>(X, tid); __syncthreads(); pass_fwd32<16>(X, tid); __syncthreads(); pass_c_store(X, Hs + (size_t)o * FFTN, tid, 1.f / (float)FFTN); __syncthreads();
    }
    const float* cw = a.in[I_CONVW]; const float* cbv = a.in[I_CONVB]; const float* dbias = a.in[I_BIASD];
    const float d1 = dbias[c], d2 = dbias[HYW + c];
    float wv[3][3], bv[3];
#pragma unroll
    for (int s = 0; s < 3; ++s) { bv[s] = cbv[s * HYW + c];
#pragma unroll
        for (int i = 0; i < 3; ++i) wv[s][i] = cw[i * HYC + s * HYW + c]; }
    const bf16_t* UT = (const bf16_t*)(a.ws + WS_UT);
    bf16_t* YT = (bf16_t*)(a.ws + WS_YHYT);
#pragma unroll 1
    for (int bp = 0; bp < 2; ++bp) {
        const bf16_t* u0 = UT + ((size_t)(2 * bp) * HYC + c) * SEQ; const bf16_t* u1 = UT + ((size_t)(2 * bp + 1) * HYC + c) * SEQ;
        float z0[16], z1[16];
        {
            float v0[16], v1[16]; sconv16(u0, tid, wv[0][0], wv[0][1], wv[0][2], bv[0], v0); sconv16(u1, tid, wv[0][0], wv[0][1], wv[0][2], bv[0], v1);
#pragma unroll
            for (int i = 0; i < 16; ++i) X[pc + i] = (f32x2){v0[i], v1[i]};
        }
        __syncthreads();
        pass_fwd32<512, true>(X, tid); __syncthreads(); pass_fwd32<16>(X, tid); __syncthreads(); pass_c_mul_inv(X, Hs, tid); __syncthreads(); pass_inv32<16>(X, tid); __syncthreads(); pass_inv32<512, true>(X, tid); __syncthreads();
        {
            float v0[16], v1[16], x0[16], x1[16];
            sconv16(u0, tid, wv[0][0], wv[0][1], wv[0][2], bv[0], v0); sconv16(u1, tid, wv[0][0], wv[0][1], wv[0][2], bv[0], v1);
            sconv16(u0 + (size_t)HYW * SEQ, tid, wv[1][0], wv[1][1], wv[1][2], bv[1], x0); sconv16(u1 + (size_t)HYW * SEQ, tid, wv[1][0], wv[1][1], wv[1][2], bv[1], x1);
#pragma unroll
            for (int i = 0; i < 16; ++i) { const f32x2 y1 = X[pc + i]; z0[i] = x0[i] * (y1[0] + d1 * v0[i]); z1[i] = x1[i] * (y1[1] + d1 * v1[i]); X[pc + i] = (f32x2){z0[i], z1[i]}; }
        }
        __syncthreads();
        pass_fwd32<512, true>(X, tid); __syncthreads(); pass_fwd32<16>(X, tid); __syncthreads(); pass_c_mul_inv(X, Hs + FFTN, tid); __syncthreads(); pass_inv32<16>(X, tid); __syncthreads(); pass_inv32<512, true>(X, tid); __syncthreads();
        {
            float x0[16], x1[16];
            sconv16(u0 + (size_t)2 * HYW * SEQ, tid, wv[2][0], wv[2][1], wv[2][2], bv[2], x0); sconv16(u1 + (size_t)2 * HYW * SEQ, tid, wv[2][0], wv[2][1], wv[2][2], bv[2], x1);
            unsigned w0[8], w1[8];
#pragma unroll
            for (int i = 0; i < 8; ++i) { const f32x2 ya = X[pc + 2 * i], yb = X[pc + 2 * i + 1];
                w0[i] = pk2(x0[2 * i] * (ya[0] + d2 * z0[2 * i]), x0[2 * i + 1] * (yb[0] + d2 * z0[2 * i + 1]));
                w1[i] = pk2(x1[2 * i] * (ya[1] + d2 * z1[2 * i]), x1[2 * i + 1] * (yb[1] + d2 * z1[2 * i + 1])); }
            u32x4* y0p = (u32x4*)(YT + ((size_t)(2 * bp) * HYW + c) * SEQ + 16 * tid); u32x4* y1p = (u32x4*)(YT + ((size_t)(2 * bp + 1) * HYW + c) * SEQ + 16 * tid);
            y0p[0] = (u32x4){w0[0], w0[1], w0[2], w0[3]}; y0p[1] = (u32x4){w0[4], w0[5], w0[6], w0[7]};
            y1p[0] = (u32x4){w1[0], w1[1], w1[2], w1[3]}; y1p[1] = (u32x4){w1[4], w1[5], w1[6], w1[7]};
        }
        __syncthreads();
    }
}

__device__ __forceinline__ void filter_item(const Args& a, int item, int lane) {
    const int ct = item & 127, tc = item >> 7;
    const float* hid2 = (const float*)(a.ws + WS_HID2); const float* wout = a.in[I_FWOUT]; float* HF = (float*)(a.ws + WS_HF);
    const int col = 16 * ct + (lane & 15), kq = lane >> 4, cch = col & 511;
    float bf[16];
#pragma unroll
    for (int s = 0; s < 16; ++s) bf[s] = wout[(size_t)(16 * kq + s) * 2048 + col];
    const float dlt = fabsf(-3.0701134573253945f + (float)cch * ((-15.350567286626973f + 3.0701134573253945f) / 511.f));
#pragma unroll 2
    for (int tt = 0; tt < 32; ++tt) { const int t0 = 512 * tc + 16 * tt;
        const f32x4* ar = (const f32x4*)(hid2 + (size_t)(t0 + (lane & 15)) * 64 + 16 * kq);
        const f32x4 a0 = ar[0], a1 = ar[1], a2 = ar[2], a3 = ar[3];
        f32x4 acc = {0.f, 0.f, 0.f, 0.f};
#pragma unroll
        for (int e = 0; e < 4; ++e) { acc = __builtin_amdgcn_mfma_f32_16x16x4f32(a0[e], bf[e], acc, 0, 0, 0); }
#pragma unroll
        for (int e = 0; e < 4; ++e) { acc = __builtin_amdgcn_mfma_f32_16x16x4f32(a1[e], bf[4 + e], acc, 0, 0, 0); }
#pragma unroll
        for (int e = 0; e < 4; ++e) { acc = __builtin_amdgcn_mfma_f32_16x16x4f32(a2[e], bf[8 + e], acc, 0, 0, 0); }
#pragma unroll
        for (int e = 0; e < 4; ++e) { acc = __builtin_amdgcn_mfma_f32_16x16x4f32(a3[e], bf[12 + e], acc, 0, 0, 0); }
        f32x4 o;
#pragma unroll
        for (int r = 0; r < 4; ++r) o[r] = acc[r] * __expf(-((float)(t0 + 4 * kq + r) / (float)(SEQ - 1)) * dlt);
        *(f32x4*)(HF + (size_t)col * SEQ + t0 + 4 * kq) = o; }
}

__device__ __forceinline__ void transpose_item(const Args& a, int item, int lane) {
    const int lt = item & 127, ct = (item >> 7) & 7, b = item >> 10;
    const bf16_t* src = (const bf16_t*)(a.ws + WS_YHYT) + ((size_t)b * HYW + 64 * ct) * SEQ + 64 * lt + lane;
    bf16_t* dst = (bf16_t*)(a.ws + WS_MIX) + ((size_t)b * SEQ + 64 * lt + lane) * 1024 + 512 + 64 * ct;
    unsigned short v[64];
#pragma unroll
    for (int cc = 0; cc < 64; ++cc) v[cc] = src[(size_t)cc * SEQ];
#pragma unroll
    for (int q = 0; q < 8; ++q)
        *(u32x4*)(dst + 8 * q) = (u32x4){(unsigned)v[8 * q] | ((unsigned)v[8 * q + 1] << 16), (unsigned)v[8 * q + 2] | ((unsigned)v[8 * q + 3] << 16),
                                         (unsigned)v[8 * q + 4] | ((unsigned)v[8 * q + 5] << 16), (unsigned)v[8 * q + 6] | ((unsigned)v[8 * q + 7] << 16)};
}
}

__device__ __forceinline__ void p0_mod_and_filter(const Args& a, LAS unsigned char* lds) {
    const int tid = threadIdx.x, lane = tid & 63, wave = tid >> 6;
    const float* c = a.in[I_C]; const float* cctx = a.in[I_CCTX]; const float* adaw = a.in[I_ADAW]; const float* adab = a.in[I_ADAB];
    float* mod = (float*)(a.ws + WS_MOD);
    LAS float* sl = (LAS float*)lds;
    LAS float* pt = (LAS float*)lds + 5 * 1024;
    for (int i = tid; i < 5 * 1024; i += NTHREADS) { const int r = i >> 10, k = i & 1023; sl[i] = silu_f(r < 4 ? c[r * 1024 + k] : cctx[k]); }
    for (int it = blockIdx.x; it < 256; it += gridDim.x) {
        __syncthreads();
        if (tid < 504) {
            const int col = tid % 24, ks = tid / 24, n = it * 24 + col, kbeg = ks * 49, kend = (kbeg + 49 < 1024) ? kbeg + 49 : 1024;
            float acc[5] = {0.f, 0.f, 0.f, 0.f, 0.f};
#pragma unroll 7
            for (int k = kbeg; k < kend; ++k) { const float w = adaw[(size_t)k * 6144 + n];
#pragma unroll
                for (int r = 0; r < 5; ++r) acc[r] += sl[r * 1024 + k] * w; }
#pragma unroll
            for (int r = 0; r < 5; ++r) pt[(ks * 5 + r) * 24 + col] = acc[r];
        }
        __syncthreads();
        if (tid < 120) { const int r = tid / 24, col = tid % 24, n = it * 24 + col; float s = adab[n];
            for (int ks = 0; ks < 21; ++ks) s += pt[(ks * 5 + r) * 24 + col];
            mod[r * 6144 + n] = s; }
    }
    __syncthreads();
    const float* w1 = a.in[I_FW1]; const float* b1 = a.in[I_FB1]; const float* w2 = a.in[I_FW2]; const float* b2 = a.in[I_FB2]; const float* fq = a.in[I_FFREQ];
    float* hid2 = (float*)(a.ws + WS_HID2);
    LAS float* zs = (LAS float*)lds + 8192 + wave * 128;
    const float frq = fq[lane], bb1 = b1[lane], bb2 = b2[lane];
    for (int t = (blockIdx.x * NWAVES + wave); t < SEQ; t += gridDim.x * NWAVES) {
        float z = 0.f;
        if (lane == 0) z = (float)t / (float)(SEQ - 1);
        else if (lane < 33) { const int i = (lane - 1) & 15; const float f = 1e-4f + (float)i * ((15.f - 1e-4f) / 15.f);
            const float ang = (6.283185307179586f * (float)t / (float)SEQ) * f; z = (lane < 17) ? cosf(ang) : -sinf(ang); }
        if (lane < 33) zs[lane] = z;
        __builtin_amdgcn_wave_barrier(); asm volatile("s_waitcnt lgkmcnt(0)" ::: "memory");
        float s = bb1;
#pragma unroll
        for (int e = 0; e < 33; ++e) s += zs[e] * w1[e * 64 + lane];
        const float h1 = sinf(frq * s);
        zs[64 + lane] = h1;
        __builtin_amdgcn_wave_barrier(); asm volatile("s_waitcnt lgkmcnt(0)" ::: "memory");
        float s2 = bb2;
#pragma unroll 16
        for (int g = 0; g < 64; ++g) s2 += zs[64 + g] * w2[g * 64 + lane];
        hid2[(size_t)t * 64 + lane] = sinf(frq * s2);
        __builtin_amdgcn_wave_barrier(); asm volatile("s_waitcnt lgkmcnt(0)" ::: "memory");
    }
}

template <bool FP8 = false>
__device__ __forceinline__ void tr_item(const float* W, int ldw, int k0, int c0, int cstride, float scale, bf16_t* dstrow0, LAS float* scr, int lane) {
#pragma unroll 8
    for (int i = 0; i < 32; ++i) { const int kk = 2 * i + (lane >> 5); scr[kk * 33 + (lane & 31)] = W[(size_t)(k0 + kk) * ldw + c0 + (lane & 31) * cstride] * scale; }
    asm volatile("s_waitcnt lgkmcnt(0)" ::: "memory"); __builtin_amdgcn_wave_barrier();
    const int c = lane & 7;
#pragma unroll
    for (int j = 0; j < 4; ++j) { const int n = (lane >> 3) + 8 * j; const LAS float* s = scr + (8 * c) * 33 + n;
        if (FP8) { u32x2 o; o.x = gm::pk4_fp8(s[0 * 33], s[1 * 33], s[2 * 33], s[3 * 33]); o.y = gm::pk4_fp8(s[4 * 33], s[5 * 33], s[6 * 33], s[7 * 33]);
            *(u32x2*)((unsigned char*)dstrow0 + (size_t)n * 1024 + k0 + 8 * c) = o; }
        else { u32x4 o; o.x = pk2(s[0 * 33], s[1 * 33]); o.y = pk2(s[2 * 33], s[3 * 33]); o.z = pk2(s[4 * 33], s[5 * 33]); o.w = pk2(s[6 * 33], s[7 * 33]);
            *(u32x4*)(dstrow0 + (size_t)n * 1024 + k0 + 8 * c) = o; } }
    asm volatile("s_waitcnt lgkmcnt(0)" ::: "memory"); __builtin_amdgcn_wave_barrier();
}
__device__ __forceinline__ void fold_item(const float* win, const float* wa, int dir, int k0, int j0, bf16_t* dstrow0, LAS float* scr, int lane) {
#pragma unroll 4
    for (int i = 0; i < 32; ++i) { const int kk = 2 * i + (lane >> 5); const float* wr = win + (size_t)(k0 + kk) * INW + 1536 + 16 * dir; float s = 0.f;
#pragma unroll
        for (int r = 0; r < 16; ++r) s += wr[r] * wa[r * 256 + j0 + (lane & 31)];
        scr[kk * 33 + (lane & 31)] = s; }
    asm volatile("s_waitcnt lgkmcnt(0)" ::: "memory"); __builtin_amdgcn_wave_barrier();
    const int c = lane & 7;
#pragma unroll
    for (int j = 0; j < 4; ++j) { const int n = (lane >> 3) + 8 * j; const LAS float* s = scr + (8 * c) * 33 + n;
        u32x4 o; o.x = pk2(s[0 * 33], s[1 * 33]); o.y = pk2(s[2 * 33], s[3 * 33]); o.z = pk2(s[4 * 33], s[5 * 33]); o.w = pk2(s[6 * 33], s[7 * 33]);
        *(u32x4*)(dstrow0 + (size_t)n * 1024 + k0 + 8 * c) = o; }
    asm volatile("s_waitcnt lgkmcnt(0)" ::: "memory"); __builtin_amdgcn_wave_barrier();
}
__device__ __forceinline__ void ln_mod_row(const float* xrow, const float* shift, const float* scale, bf16_t* orow, int lane) {
    const f32x4* xr = (const f32x4*)xrow + lane;
    f32x4 v[4]; float s = 0.f;
#pragma unroll
    for (int j = 0; j < 4; ++j) { v[j] = xr[64 * j]; s += (v[j][0] + v[j][1]) + (v[j][2] + v[j][3]); }
    const float mean = wave_sum(s) * (1.f / D); float s2 = 0.f;
#pragma unroll
    for (int j = 0; j < 4; ++j) { v[j] = v[j] - mean; s2 += (v[j][0] * v[j][0] + v[j][1] * v[j][1]) + (v[j][2] * v[j][2] + v[j][3] * v[j][3]); }
    const float rstd = 1.f / sqrtf(wave_sum(s2) * (1.f / D) + LN_EPS);
    u32x2* o8 = (u32x2*)orow + lane;
#pragma unroll
    for (int j = 0; j < 4; ++j) { const f32x4 sh = ((const f32x4*)shift)[64 * j + lane], sc = ((const f32x4*)scale)[64 * j + lane];
        const f32x4 y = v[j] * rstd * (sc + 1.f) + sh;
        u32x2 w; w.x = pk2(y[0], y[1]); w.y = pk2(y[2], y[3]); o8[64 * j] = w; }
}
constexpr int PREP_I_IN = 16 * 96, PREP_I_FOLD = 16 * 8 * 2, PREP_I_OUT = 16 * 32, PREP_I_W1 = NE * 16 * 64, PREP_I_W2 = NE * 16 * 32;
constexpr int PREP_NITEMS = PREP_I_IN + PREP_I_FOLD + PREP_I_OUT + PREP_I_W1 + PREP_I_W2;
constexpr int PREP_DEFER = 10880;
__device__ __forceinline__ void prep_items(const Args& a, LAS float* scr, int first, int last, int rank, int nranks, int lane) {
    constexpr int I_IN = PREP_I_IN, I_FOLD = PREP_I_FOLD, I_OUT = PREP_I_OUT, I_W1 = PREP_I_W1;
    const float* win = a.in[I_WIN];
    bf16_t* btin = (bf16_t*)(a.ws + WS_BTIN); bf16_t* btout = (bf16_t*)(a.ws + WS_BTOUT); bf16_t* w1t = (bf16_t*)(a.ws + WS_W1T); bf16_t* w2t = (bf16_t*)(a.ws + WS_W2T);
    for (int it = first + rank; it < last; it += nranks) {
        int r = it;
        if (r < I_IN) {
            const int kb = r / 96, nb = r % 96;
            if (nb < 48) tr_item(win, INW, 64 * kb, 32 * nb, 1, nb < 8 ? 0.125f : 1.f, btin + (size_t)(32 * nb) * 1024, scr, lane);
            else tr_item(win, INW, 64 * kb, 1568 + 32 * (nb - 48), 1, 1.f, btin + (size_t)(2048 + 32 * (nb - 48)) * 1024, scr, lane);
            continue; }
        r -= I_IN;
        if (r < I_FOLD) { const int dir = r & 1, jb = (r >> 1) & 7, kb = r >> 4;
            fold_item(win, dir ? a.in[I_WAB] : a.in[I_WAF], dir, 64 * kb, 32 * jb, btin + (size_t)(1536 + 256 * dir + 32 * jb) * 1024, scr, lane); continue; }
        r -= I_FOLD;
        if (r < I_OUT) { const int kb = r / 32, nb = r % 32; tr_item(a.in[I_WOUT], 1024, 64 * kb, 32 * nb, 1, 1.f, btout + (size_t)(32 * nb) * 1024, scr, lane); continue; }
        r -= I_OUT;
        if (r < I_W1) {
            const int e = r / 1024, q = r % 1024, s = q & 1, nb = (q >> 1) & 31, kb = q >> 6;
            const int ct = nb >> 2, jj0 = (nb & 3) * 32;
            tr_item<true>(a.in[I_EW1] + (size_t)e * 1024 * 2048, 2048, 64 * kb, 2 * (128 * ct + jj0) + s, 2, gm::S_W, (bf16_t*)((unsigned char*)w1t + ((size_t)e * 2048 + 256 * ct + 128 * s + jj0) * 1024), scr, lane);
            continue; }
        r -= I_W1;
        { const int e = r / 512, q = r % 512, kb = q / 32, nb = q % 32;
          tr_item<true>(a.in[I_EW2] + (size_t)e * 1024 * 1024, 1024, 64 * kb, 32 * nb, 1, gm::S_W, (bf16_t*)((unsigned char*)w2t + ((size_t)e * 1024 + 32 * nb) * 1024), scr, lane); }
    }
}
__device__ __forceinline__ void p1_prep(const Args& a, LAS unsigned char* lds) {
    const int tid = threadIdx.x, lane = tid & 63, wave = tid >> 6;
    LAS float* scr = (LAS float*)(lds + wave * 16384);
    const int gw = blockIdx.x * NWAVES + wave, NGW = gridDim.x * NWAVES;
    const float* win = a.in[I_WIN];
    bf16_t* btin = (bf16_t*)(a.ws + WS_BTIN); bf16_t* btout = (bf16_t*)(a.ws + WS_BTOUT); bf16_t* w1t = (bf16_t*)(a.ws + WS_W1T); bf16_t* w2t = (bf16_t*)(a.ws + WS_W2T);
    const float* mod = (const float*)(a.ws + WS_MOD);
    bf16_t* H = (bf16_t*)(a.ws + WS_H);
    for (int row = gw; row < TT; row += NGW) {
        const float* xr; int mr;
        if (row < T) { xr = a.in[I_X] + (size_t)row * D; mr = row >> 13; } else { xr = a.in[I_CTX] + (size_t)(row - T) * D; mr = 4; }
        ln_mod_row(xr, mod + mr * 6144, mod + mr * 6144 + 1024, H + (size_t)row * D, lane);
    }
    prep_items(a, scr, 0, PREP_NITEMS - PREP_DEFER, gw, NGW, lane);
    for (int it = gw; it < 2048; it += NGW) hy::filter_item(a, it, lane);
    float* b1r = (float*)(a.ws + WS_B1R); const float* eb1 = a.in[I_EB1];
    for (int i = blockIdx.x * NTHREADS + tid; i < NE * 2048; i += gridDim.x * NTHREADS) {
        const int e = i >> 11, n = i & 2047, ct = n >> 8, s = (n >> 7) & 1, jj = n & 127;
        b1r[i] = eb1[(size_t)e * 2048 + 2 * (128 * ct + jj) + s];
    }
}

namespace gla {
constexpr int RS = 72;
constexpr int L_TOTF = 0, L_TOTB = 2048, L_SSQ = 4096;
constexpr int L_T0 = 8192;
constexpr int L_T1 = L_T0 + 9216, L_T2 = L_T1 + 9216, L_T3 = L_T2 + 9216;
constexpr int L_VT = L_T3 + 9216;
constexpr int L_P  = L_VT + 18432;
constexpr int L_END = L_P + 9216;

__device__ __forceinline__ bf16x8 frag(const LAS unsigned char* tile, int row, int k0, int lane) {
    return *(const LAS bf16x8*)(tile + ((row + (lane & 15)) * RS + k0 + 8 * (lane >> 4)) * 2);
}
__device__ __forceinline__ void chunk_cums_pre(LAS unsigned char* L, const float (&gf)[8], const float (&gb)[8], int wave, int lane, float (&cumf)[8], float (&cumb)[8], float& allf, float& allb) {
    LAS float* totf = (LAS float*)(L + L_TOTF); LAS float* totb = (LAS float*)(L + L_TOTB);
    cumf[0] = gf[0];
#pragma unroll
    for (int r = 1; r < 8; ++r) cumf[r] = cumf[r - 1] + gf[r];
    cumb[7] = gb[7];
#pragma unroll
    for (int r = 6; r >= 0; --r) cumb[r] = cumb[r + 1] + gb[r];
    totf[wave * 64 + lane] = cumf[7]; totb[wave * 64 + lane] = cumb[0];
    __syncthreads();
    float of = 0.f, ob = 0.f, af = 0.f, ab = 0.f;
#pragma unroll
    for (int w = 0; w < 8; ++w) { const float tf = totf[w * 64 + lane], tb = totb[w * 64 + lane]; af += tf; ab += tb; of += (w < wave) ? tf : 0.f; ob += (w > wave) ? tb : 0.f; }
#pragma unroll
    for (int r = 0; r < 8; ++r) { cumf[r] += of; cumb[r] += ob; }
    allf = af; allb = ab;
}
__device__ __forceinline__ void chunk_cums(LAS unsigned char* L, const float* GF, const float* GB, size_t tok0, int h, int wave, int lane, float (&cumf)[8], float (&cumb)[8], float& allf, float& allb) {
    float gf[8], gb[8];
#pragma unroll
    for (int r = 0; r < 8; ++r) { const size_t o = (tok0 + 8 * wave + r) * 256 + h * 64 + lane; gf[r] = GF[o]; gb[r] = GB[o]; }
    chunk_cums_pre(L, gf, gb, wave, lane, cumf, cumb, allf, allb);
}
__device__ __forceinline__ void store_vt(LAS unsigned char* L, const u32x4 (&vr)[2], int tid) {
    LAS bf16_t* vt = (LAS bf16_t*)(L + L_VT);
    const int j = tid >> 3, c8 = tid & 7;
#pragma unroll
    for (int q = 0; q < 2; ++q) { const int dv0 = 8 * (c8 + 8 * q);
        const unsigned ww[4] = {vr[q].x, vr[q].y, vr[q].z, vr[q].w};
#pragma unroll
        for (int e = 0; e < 4; ++e) { vt[(dv0 + 2 * e) * RS + j] = (bf16_t)(ww[e] & 0xffffu); vt[(dv0 + 2 * e + 1) * RS + j] = (bf16_t)(ww[e] >> 16); } }
}
__device__ __forceinline__ void load_vt(LAS unsigned char* L, const bf16_t* V, size_t tok0, int h, int tid) {
    const int j = tid >> 3, c8 = tid & 7; u32x4 vr[2];
#pragma unroll
    for (int q = 0; q < 2; ++q) vr[q] = *(const u32x4*)(V + (tok0 + j) * 512 + h * 128 + 8 * (c8 + 8 * q));
    store_vt(L, vr, tid);
}

__device__ __forceinline__ void g1_unit(const Args& a, LAS unsigned char* L, int bh, int chunk  ) {
    const int tid = threadIdx.x, lane = tid & 63, wave = __builtin_amdgcn_readfirstlane(tid >> 6);
    const int b = bh >> 2, h = bh & 3;
    const size_t tok0 = chunk < NCHUNK ? (size_t)b * SEQ + (size_t)chunk * CH : (size_t)T + (size_t)b * CTXL + (size_t)(chunk - NCHUNK) * CH;
    const float* GF = (const float*)(a.ws + WS_GF); const float* GB = (const float*)(a.ws + WS_GB);
    const bf16_t* Kb = (const bf16_t*)(a.ws + WS_K); const bf16_t* Vb = (const bf16_t*)(a.ws + WS_V);
    float cumf[8], cumb[8], allf, allb;
    __syncthreads();
    chunk_cums(L, GF, GB, tok0, h, wave, lane, cumf, cumb, allf, allb);
    LAS bf16_t* ketf = (LAS bf16_t*)(L + L_T0); LAS bf16_t* ketb = (LAS bf16_t*)(L + L_T1);
#pragma unroll
    for (int r = 0; r < 8; ++r) { const int i = 8 * wave + r; const float kv = bf2f(Kb[(tok0 + i) * 256 + h * 64 + lane]);
        ketf[lane * RS + i] = f2bf(kv * __expf(allf - cumf[r])); ketb[lane * RS + i] = f2bf(kv * __expf(allb - cumb[r])); }
    load_vt(L, Vb, tok0, h, tid);
    if (wave == 0) { float* av = (float*)(a.ws + WS_AV); av[((size_t)(0 * 16 + bh) * NCT + chunk) * 64 + lane] = __expf(allf); av[((size_t)(1 * 16 + bh) * NCT + chunk) * 64 + lane] = __expf(allb); }
    __syncthreads();
    bf16_t* KV = (bf16_t*)(a.ws + WS_KV);
#pragma unroll
    for (int dir = 0; dir < 2; ++dir) {
        const LAS unsigned char* ket = L + (dir ? L_T1 : L_T0);
        bf16_t* dst = KV + ((size_t)(dir * 16 + bh) * NCT + chunk) * 8192;
#pragma unroll
        for (int nt = 0; nt < 4; ++nt) { f32x4 acc = {0.f, 0.f, 0.f, 0.f};
#pragma unroll
            for (int ks = 0; ks < 2; ++ks) acc = __builtin_amdgcn_mfma_f32_16x16x32_bf16(frag(L + L_VT, 16 * wave, 32 * ks, lane), frag(ket, 16 * nt, 32 * ks, lane), acc, 0, 0, 0);
#pragma unroll
            for (int r = 0; r < 4; ++r) dst[(16 * wave + 4 * (lane >> 4) + r) * 64 + 16 * nt + (lane & 15)] = f2bf(acc[r]); }
    }
}

__device__ __forceinline__ void g2_scan(const Args& a) {
    const bf16_t* KV = (const bf16_t*)(a.ws + WS_KV); const float* AV = (const float*)(a.ws + WS_AV); bf16_t* SP = (bf16_t*)(a.ws + WS_SP);
    for (int id = blockIdx.x * NTHREADS + threadIdx.x; id < 32 * 4096; id += gridDim.x * NTHREADS) {
        const int db = id >> 12, e2 = id & 4095, dir = db >> 4, dk = (2 * e2) & 63;
        const unsigned* kv = (const unsigned*)(KV + (size_t)db * NCT * 8192) + e2;
        const float* av = AV + (size_t)db * NCT * 64 + dk;
        unsigned* sp = (unsigned*)(SP + (size_t)db * NCHUNK * 8192) + e2;
        float s0 = 0.f, s1 = 0.f;
#pragma unroll
        for (int q = 0; q < NCC; ++q) { const int c = NCHUNK + (dir ? (NCC - 1 - q) : q);
            const unsigned w = kv[(size_t)c * 4096]; const f32x2 aa = *(const f32x2*)(av + (size_t)c * 64);
            s0 = aa[0] * s0 + bflo(w); s1 = aa[1] * s1 + bfhi(w); }
        for (int q0 = 0; q0 < NCHUNK; q0 += 16) {
            unsigned w[16]; f32x2 aa[16];
#pragma unroll
            for (int u = 0; u < 16; ++u) { const int c = dir ? (NCHUNK - 1 - (q0 + u)) : (q0 + u); w[u] = kv[(size_t)c * 4096]; aa[u] = *(const f32x2*)(av + (size_t)c * 64); }
#pragma unroll
            for (int u = 0; u < 16; ++u) { const int c = dir ? (NCHUNK - 1 - (q0 + u)) : (q0 + u);
                sp[(size_t)c * 4096] = pk2(s0, s1);
                s0 = aa[u][0] * s0 + bflo(w[u]); s1 = aa[u][1] * s1 + bfhi(w[u]); }
        }
    }
}

struct G3In { float gf[8], gb[8]; bf16_t q[8], k[8]; u32x4 v[2]; };
__device__ __forceinline__ void g3_load(const Args& a, int bh, int chunk, G3In& in) {
    const int tid = threadIdx.x, lane = tid & 63, wave = __builtin_amdgcn_readfirstlane(tid >> 6);
    const int b = bh >> 2, h = bh & 3;
    const size_t tok0 = (size_t)b * SEQ + (size_t)chunk * CH;
    const float* GF = (const float*)(a.ws + WS_GF); const float* GB = (const float*)(a.ws + WS_GB);
    const bf16_t* Qb = (const bf16_t*)(a.ws + WS_Q); const bf16_t* Kb = (const bf16_t*)(a.ws + WS_K); const bf16_t* Vb = (const bf16_t*)(a.ws + WS_V);
#pragma unroll
    for (int r = 0; r < 8; ++r) { const size_t o = (tok0 + 8 * wave + r) * 256 + h * 64 + lane; in.gf[r] = GF[o]; in.gb[r] = GB[o]; in.q[r] = Qb[o]; in.k[r] = Kb[o]; }
#pragma unroll
    for (int q = 0; q < 2; ++q) in.v[q] = *(const u32x4*)(Vb + (tok0 + (tid >> 3)) * 512 + h * 128 + 8 * ((tid & 7) + 8 * q));
}
__device__ __forceinline__ void g3_unit(const Args& a, LAS unsigned char* L, int bh, int chunk  , const G3In& in) {
    const int tid = threadIdx.x, lane = tid & 63, wave = __builtin_amdgcn_readfirstlane(tid >> 6);
    const int b = bh >> 2, h = bh & 3;
    const size_t tok0 = (size_t)b * SEQ + (size_t)chunk * CH;
    const bf16_t* Gt = (const bf16_t*)(a.ws + WS_G);
    const int mt = wave >> 1, fr = lane & 15, fq = lane >> 4;
    const bf16_t* SPf = (const bf16_t*)(a.ws + WS_SP) + ((size_t)(0 * 16 + bh) * NCHUNK + chunk) * 8192;
    const bf16_t* SPb = (const bf16_t*)(a.ws + WS_SP) + ((size_t)(1 * 16 + bh) * NCHUNK + chunk) * 8192;
    bf16x8 sfv[4][2], sbv[4][2]; bf16_t gr[4][4];
#pragma unroll
    for (int q = 0; q < 4; ++q) { const int nt = 4 * (wave & 1) + q;
#pragma unroll
        for (int ks = 0; ks < 2; ++ks) { sfv[q][ks] = *(const bf16x8*)(SPf + (16 * nt + fr) * 64 + 32 * ks + 8 * fq); sbv[q][ks] = *(const bf16x8*)(SPb + (16 * nt + fr) * 64 + 32 * ks + 8 * fq); }
#pragma unroll
        for (int r = 0; r < 4; ++r) gr[r][q] = Gt[(tok0 + 16 * mt + 4 * fq + r) * 512 + h * 128 + 16 * nt + fr]; }
    float cumf[8], cumb[8], allf, allb;
    __syncthreads();
    chunk_cums_pre(L, in.gf, in.gb, wave, lane, cumf, cumb, allf, allb);
    LAS bf16_t* qf = (LAS bf16_t*)(L + L_T0); LAS bf16_t* kf = (LAS bf16_t*)(L + L_T1); LAS bf16_t* qb = (LAS bf16_t*)(L + L_T2); LAS bf16_t* kb = (LAS bf16_t*)(L + L_T3);
#pragma unroll
    for (int r = 0; r < 8; ++r) { const int i = 8 * wave + r;
        const float qv = bf2f(in.q[r]), kv = bf2f(in.k[r]);
        qf[i * RS + lane] = f2bf(qv * __expf(cumf[r])); kf[i * RS + lane] = f2bf(kv * __expf(-cumf[r]));
        qb[i * RS + lane] = f2bf(qv * __expf(cumb[r])); kb[i * RS + lane] = f2bf(kv * __expf(-cumb[r])); }
    store_vt(L, in.v, tid);
    __syncthreads();
    {
        LAS bf16_t* P = (LAS bf16_t*)(L + L_P);
#pragma unroll
        for (int q = 0; q < 2; ++q) { const int nt = 2 * (wave & 1) + q;
            f32x4 sf = {0.f, 0.f, 0.f, 0.f}, sb = {0.f, 0.f, 0.f, 0.f};
#pragma unroll
            for (int ks = 0; ks < 2; ++ks) {
                sf = __builtin_amdgcn_mfma_f32_16x16x32_bf16(frag(L + L_T0, 16 * mt, 32 * ks, lane), frag(L + L_T1, 16 * nt, 32 * ks, lane), sf, 0, 0, 0);
                sb = __builtin_amdgcn_mfma_f32_16x16x32_bf16(frag(L + L_T2, 16 * mt, 32 * ks, lane), frag(L + L_T3, 16 * nt, 32 * ks, lane), sb, 0, 0, 0); }
#pragma unroll
            for (int r = 0; r < 4; ++r) { const int i = 16 * mt + 4 * fq + r, j = 16 * nt + fr;
                P[i * RS + j] = f2bf((j <= i ? sf[r] : 0.f) + (j >= i ? sb[r] : 0.f)); } }
    }
    __syncthreads();
    f32x4 o[4]; float ssq[4] = {0.f, 0.f, 0.f, 0.f};
#pragma unroll
    for (int q = 0; q < 4; ++q) { const int nt = 4 * (wave & 1) + q;
        f32x4 acc = {0.f, 0.f, 0.f, 0.f};
#pragma unroll
        for (int ks = 0; ks < 2; ++ks) {
            acc = __builtin_amdgcn_mfma_f32_16x16x32_bf16(frag(L + L_P, 16 * mt, 32 * ks, lane), frag(L + L_VT, 16 * nt, 32 * ks, lane), acc, 0, 0, 0);
            acc = __builtin_amdgcn_mfma_f32_16x16x32_bf16(frag(L + L_T0, 16 * mt, 32 * ks, lane), sfv[q][ks], acc, 0, 0, 0);
            acc = __builtin_amdgcn_mfma_f32_16x16x32_bf16(frag(L + L_T2, 16 * mt, 32 * ks, lane), sbv[q][ks], acc, 0, 0, 0); }
        o[q] = acc;
#pragma unroll
        for (int r = 0; r < 4; ++r) ssq[r] += acc[r] * acc[r]; }
    LAS float* SSQ = (LAS float*)(L + L_SSQ);
#pragma unroll
    for (int r = 0; r < 4; ++r) { float s = ssq[r]; s += __shfl_xor(s, 1); s += __shfl_xor(s, 2); s += __shfl_xor(s, 4); s += __shfl_xor(s, 8); ssq[r] = s; }
    if (fr == 0) {
#pragma unroll
        for (int r = 0; r < 4; ++r) SSQ[(wave & 1) * 64 + 16 * mt + 4 * fq + r] = ssq[r]; }
    __syncthreads();
    const float* ng = a.in[I_NORMG];
    bf16_t* mix = (bf16_t*)(a.ws + WS_MIX);
#pragma unroll
    for (int r = 0; r < 4; ++r) { const int i = 16 * mt + 4 * fq + r;
        const float rstd = 1.f / sqrtf((SSQ[i] + SSQ[64 + i]) * (1.f / DV) + LN_EPS);
#pragma unroll
        for (int q = 0; q < 4; ++q) { const int dv = 16 * (4 * (wave & 1) + q) + fr;
            const float g = bf2f(gr[r][q]);
            mix[(tok0 + i) * 1024 + h * 128 + dv] = f2bf(o[q][r] * rstd * ng[dv] * silu_f(g)); } }
}
}

namespace rt {
constexpr int HS = 1028;
constexpr int L_H2 = 0;
constexpr int L_PART = 65792;
constexpr int L_LCNT = L_PART + 16384;
constexpr int L_REC = L_LCNT + 256;

__device__ __forceinline__ void phase(const Args& a, LAS unsigned char* lds) {
    const int tid = threadIdx.x, lane = tid & 63, wave = __builtin_amdgcn_readfirstlane(tid >> 6);
    bf16_t* xmid = (bf16_t*)(a.ws + WS_PRE1); bf16_t* H2 = (bf16_t*)(a.ws + WS_H2); const bf16_t* FG = (const bf16_t*)(a.ws + WS_FG);
    const float* mod = (const float*)(a.ws + WS_MOD);
    const float* rw = a.in[I_RW]; const float* rb = a.in[I_RB];
    LAS float* h2s = (LAS float*)(lds + L_H2); LAS float* part = (LAS float*)(lds + L_PART);
    LAS int* lcnt = (LAS int*)(lds + L_LCNT); LAS int* lbase = lcnt + 32; LAS int* rec = (LAS int*)(lds + L_REC);
    unsigned* cnt = (unsigned*)(a.ws + WS_CNT); int* list = (int*)(a.ws + WS_LIST); float* pw = (float*)(a.ws + WS_PW); int* ploc = (int*)(a.ws + WS_PLOC);
    float rwr[32][2];
#pragma unroll
    for (int s = 0; s < 32; ++s)
#pragma unroll
        for (int nt = 0; nt < 2; ++nt) rwr[s][nt] = rw[(size_t)(128 * wave + 4 * s + (lane >> 4)) * 32 + 16 * nt + (lane & 15)];
    const f32x4* g1 = (const f32x4*)a.in[I_LN1G]; const f32x4* bb1 = (const f32x4*)a.in[I_LN1B];
    if (tid < 32) lcnt[tid] = 0;
    for (int grp = blockIdx.x; grp < T / 16; grp += gridDim.x) {
        __syncthreads();
#pragma unroll 1
        for (int rr = 0; rr < 2; ++rr) {
            const int lr = 2 * wave + rr, t = grp * 16 + lr, b = t >> 13;
            u32x2* pr = (u32x2*)(xmid + (size_t)t * D) + lane;
            const f32x4* xr = (const f32x4*)(a.in[I_X] + (size_t)t * D) + lane; const u32x2* fr_ = (const u32x2*)(FG + (size_t)t * D) + lane;
            f32x4 v[4]; float s = 0.f;
#pragma unroll
            for (int j = 0; j < 4; ++j) { const u32x2 fw = fr_[64 * j]; const f32x4 ff = {bflo(fw.x), bfhi(fw.x), bflo(fw.y), bfhi(fw.y)};
                v[j] = xr[64 * j] * ALPHA + ff; s += (v[j][0] + v[j][1]) + (v[j][2] + v[j][3]); }
            float mean = wave_sum(s) * (1.f / D), s2 = 0.f;
#pragma unroll
            for (int j = 0; j < 4; ++j) { v[j] = v[j] - mean; s2 += (v[j][0] * v[j][0] + v[j][1] * v[j][1]) + (v[j][2] * v[j][2] + v[j][3] * v[j][3]); }
            float rstd = 1.f / sqrtf(wave_sum(s2) * (1.f / D) + LN_EPS);
            s = 0.f;
#pragma unroll
            for (int j = 0; j < 4; ++j) { v[j] = v[j] * rstd * g1[64 * j + lane] + bb1[64 * j + lane]; u32x2 w; w.x = pk2(v[j][0], v[j][1]); w.y = pk2(v[j][2], v[j][3]); pr[64 * j] = w;
                v[j] = (f32x4){bflo(w.x), bfhi(w.x), bflo(w.y), bfhi(w.y)}; s += (v[j][0] + v[j][1]) + (v[j][2] + v[j][3]); }
            mean = wave_sum(s) * (1.f / D); s2 = 0.f;
#pragma unroll
            for (int j = 0; j < 4; ++j) { v[j] = v[j] - mean; s2 += (v[j][0] * v[j][0] + v[j][1] * v[j][1]) + (v[j][2] * v[j][2] + v[j][3] * v[j][3]); }
            rstd = 1.f / sqrtf(wave_sum(s2) * (1.f / D) + LN_EPS);
            const f32x4* sh = (const f32x4*)(mod + b * 6144 + 3 * 1024); const f32x4* sc = (const f32x4*)(mod + b * 6144 + 4 * 1024);
            unsigned* o4 = (unsigned*)((unsigned char*)H2 + (size_t)t * D) + lane;
#pragma unroll
            for (int j = 0; j < 4; ++j) { const f32x4 y = v[j] * rstd * (sc[64 * j + lane] + 1.f) + sh[64 * j + lane];
                o4[64 * j] = gm::pk4_fp8(y[0] * gm::S_H2, y[1] * gm::S_H2, y[2] * gm::S_H2, y[3] * gm::S_H2);
                *(LAS f32x4*)(h2s + lr * HS + 256 * j + 4 * lane) = y; }
        }
        __syncthreads();
        {
            f32x4 acc0 = {0.f, 0.f, 0.f, 0.f}, acc1 = {0.f, 0.f, 0.f, 0.f};
            const LAS float* ap = h2s + (lane & 15) * HS + 128 * wave + (lane >> 4);
#pragma unroll
            for (int s = 0; s < 32; ++s) { const float av = ap[4 * s];
                acc0 = __builtin_amdgcn_mfma_f32_16x16x4f32(av, rwr[s][0], acc0, 0, 0, 0);
                acc1 = __builtin_amdgcn_mfma_f32_16x16x4f32(av, rwr[s][1], acc1, 0, 0, 0); }
#pragma unroll
            for (int r = 0; r < 4; ++r) { part[(wave * 16 + 4 * (lane >> 4) + r) * 32 + (lane & 15)] = acc0[r]; part[(wave * 16 + 4 * (lane >> 4) + r) * 32 + 16 + (lane & 15)] = acc1[r]; }
        }
        __syncthreads();
        {
            const int lr = 2 * wave + (lane >> 5), e = lane & 31, t = grp * 16 + lr;
            float lg = rb[e];
#pragma unroll
            for (int w = 0; w < 8; ++w) lg += part[(w * 16 + lr) * 32 + e];
            float cur = lg, tv[4]; int ti[4];
#pragma unroll
            for (int k = 0; k < 4; ++k) { float bv = cur; int bi = e;
#pragma unroll
                for (int o = 1; o < 32; o <<= 1) { const float ov = __shfl_xor(bv, o); const int oi = __shfl_xor(bi, o); if (ov > bv || (ov == bv && oi < bi)) { bv = ov; bi = oi; } }
                tv[k] = bv; ti[k] = bi; if (bi == e) cur = -3.0e38f; }
            const float e1 = __expf(tv[1] - tv[0]), e2 = __expf(tv[2] - tv[0]), e3 = __expf(tv[3] - tv[0]);
            const float inv = 1.f / (1.f + e1 + e2 + e3);
            if (e < 4) { const float wk = (e == 0 ? 1.f : (e == 1 ? e1 : (e == 2 ? e2 : e3))) * inv; const int ek = (e == 0 ? ti[0] : (e == 1 ? ti[1] : (e == 2 ? ti[2] : ti[3])));
                const int pair = t * 4 + e;
                pw[pair] = wk;
                const int rank = __hip_atomic_fetch_add((LAS int*)&lcnt[ek], 1, __ATOMIC_RELAXED, __HIP_MEMORY_SCOPE_WORKGROUP);
                rec[lr * 4 + e] = ek | (rank << 8); }
        }
        __syncthreads();
        if (tid < 32) { const int n = lcnt[tid]; lbase[tid] = n ? (int)atomicAdd(&cnt[tid], (unsigned)n) : 0; }
        __syncthreads();
        if (tid < 64) { const int rc = rec[tid], ek = rc & 255, rank = rc >> 8, pos = lbase[ek] + rank, pair = (grp * 16 + (tid >> 2)) * 4 + (tid & 3);
            list[(size_t)ek * CAP + pos] = pair; ploc[pair] = ek | (pos << 5); }
        __syncthreads();
        if (tid < 32) lcnt[tid] = 0;
    }
}
}

__device__ __forceinline__ void p_final(const Args& a, LAS unsigned char* lds) {
    const int tid = threadIdx.x, lane = tid & 63, wave = tid >> 6;
    const bf16_t* xm = (const bf16_t*)(a.ws + WS_PRE1); const bf16_t* slots = (const bf16_t*)(a.ws + WS_SLOTS); const float* mod = (const float*)(a.ws + WS_MOD);
    const int* ploc = (const int*)(a.ws + WS_PLOC); const float* pw = (const float*)(a.ws + WS_PW);
    const f32x4* g2 = (const f32x4*)a.in[I_LN2G]; const f32x4* b2 = (const f32x4*)a.in[I_LN2B];
    LAS int* tstart = (LAS int*)lds;
    __syncthreads();
    if (tid == 0) { const unsigned* cnt = (const unsigned*)(a.ws + WS_CNT); int nrt = 0; for (int e = 0; e < NE; ++e) { tstart[e] = 256 * nrt; nrt += ((int)cnt[e] + 255) >> 8; } }
    __syncthreads();
    for (int t = blockIdx.x * NWAVES + wave; t < T; t += gridDim.x * NWAVES) {
        const int b = t >> 13;
        const u32x2* xr = (const u32x2*)(xm + (size_t)t * D) + lane; const f32x4* gt = (const f32x4*)(mod + b * 6144 + 5 * 1024);
        const u32x2* sr[4]; float w[4];
#pragma unroll
        for (int sl = 0; sl < 4; ++sl) { const int pl = ploc[t * 4 + sl]; w[sl] = pw[t * 4 + sl]; sr[sl] = (const u32x2*)(slots + (size_t)(tstart[pl & 31] + (pl >> 5)) * D) + lane; }
        f32x4 v[4]; float s = 0.f;
#pragma unroll
        for (int j = 0; j < 4; ++j) { f32x4 y = {0.f, 0.f, 0.f, 0.f};
#pragma unroll
            for (int sl = 0; sl < 4; ++sl) { const u32x2 q = sr[sl][64 * j]; y[0] += w[sl] * bflo(q.x); y[1] += w[sl] * bfhi(q.x); y[2] += w[sl] * bflo(q.y); y[3] += w[sl] * bfhi(q.y); }
            const u32x2 xw = xr[64 * j]; const f32x4 xv = {bflo(xw.x), bfhi(xw.x), bflo(xw.y), bfhi(xw.y)};
            v[j] = xv * ALPHA + gt[64 * j + lane] * y; s += (v[j][0] + v[j][1]) + (v[j][2] + v[j][3]); }
        const float mean = wave_sum(s) * (1.f / D); float s2 = 0.f;
#pragma unroll
        for (int j = 0; j < 4; ++j) { v[j] = v[j] - mean; s2 += (v[j][0] * v[j][0] + v[j][1] * v[j][1]) + (v[j][2] * v[j][2] + v[j][3] * v[j][3]); }
        const float rstd = 1.f / sqrtf(wave_sum(s2) * (1.f / D) + LN_EPS);
        f32x4* o = (f32x4*)(a.out + (size_t)t * D) + lane;
#pragma unroll
        for (int j = 0; j < 4; ++j) o[64 * j] = v[j] * rstd * g2[64 * j + lane] + b2[64 * j + lane];
    }
}


constexpr int N_PHASES = 11;
__global__ void __launch_bounds__(NTHREADS, 2) mega_fwd(Args a) {
    extern __shared__ __attribute__((aligned(16))) unsigned char lds_raw[];
    LAS unsigned char* lds = (LAS unsigned char*)lds_raw;
    const int tid = threadIdx.x;
    volatile LAS unsigned* misc = (volatile LAS unsigned*)(lds + LDS_MISC);
    if (tid < 4) misc[tid] = 0u;
    __syncthreads();
    XcdBarrier bar; bar.bar = (unsigned*)(a.ws + WS_BAR); bar.x = 0; bar.st = misc;
    const bool multi = (a.ph_hi - a.ph_lo) > 1;
    if (multi) bar = xcd_barrier_post((unsigned*)(a.ws + WS_BAR), misc);
    const int lo = a.ph_lo, hi = a.ph_hi;
#define vcu ((gridDim.x % 8 == 0) ? (int)((blockIdx.x % 8) * (gridDim.x / 8) + blockIdx.x / 8) : (int)blockIdx.x)
#ifdef ONLY_PHASE
#define IN(k) ((k) == ONLY_PHASE && lo <= (k) && (k) < hi)
#else
#define IN(k) (lo <= (k) && (k) < hi)
#endif
#define SEAM(k) do { if (IN(k) && IN((k) + 1)) xcd_barrier(bar); } while (0)

#ifndef REPEAT_PHASE
#define REPEAT_PHASE -1
#endif
#ifdef PROF_REP
#define RUNPH(k, ...) do { if (IN(k)) { const int nrep_ = (a.rep_k == (k)) ? 2 : 1; for (int rep_ = 0; rep_ < nrep_; ++rep_) { if (rep_) xcd_barrier(bar); __VA_ARGS__; } } } while (0)
#else
#define RUNPH(k, ...) do { if (IN(k)) { __VA_ARGS__; if (REPEAT_PHASE == (k)) { xcd_barrier(bar); __VA_ARGS__; } } } while (0)
#endif
    RUNPH(0, p0_mod_and_filter(a, lds));
    SEAM(0);
    RUNPH(1, p1_prep(a, lds));
    SEAM(1);
    RUNPH(2, { gm::SchedIn S{a.ws, (int)gridDim.x, vcu, a.in[I_BAF], a.in[I_BAB]}; gm::EpiIn E{a.ws}; gm::gemm_stream<false, 0, false>(lds, S, E);
        {
          const int G = (int)gridDim.x, rounds = (1812 + G - 1) / G, extra = 1812 - (rounds - 1) * G, v = vcu;
          if (v >= extra || extra == G) { const int nidle = (extra == G) ? G : G - extra, ridle = (extra == G) ? v : v - extra; __syncthreads();
              prep_items(a, (LAS float*)(lds + (tid >> 6) * 16384), PREP_NITEMS - PREP_DEFER, PREP_NITEMS, ridle * NWAVES + (tid >> 6), nidle * NWAVES, tid & 63); } } });
    SEAM(2);
    RUNPH(3, { for (int u = blockIdx.x; u < 16 * NCT; u += gridDim.x) gla::g1_unit(a, lds, u / NCT, u % NCT); });
    SEAM(3);
    RUNPH(4, { gla::g2_scan(a);
        for (int c = blockIdx.x; c < HYW; c += gridDim.x) hy::channel(a, lds, c, a.ws + WS_HSPEC + (size_t)blockIdx.x * HSPEC_PER_WG); });
    SEAM(4);
    RUNPH(5, { { int u = blockIdx.x; gla::G3In cur, nxt;
            if (u < 16 * NCHUNK) { gla::g3_load(a, u >> 7, u & 127, cur);
                for (;;) { const int un = u + (int)gridDim.x; const bool hn = un < 16 * NCHUNK; if (hn) gla::g3_load(a, un >> 7, un & 127, nxt);
                    gla::g3_unit(a, lds, u >> 7, u & 127, cur); if (!hn) break; cur = nxt; u = un; } } }
        const int wave = tid >> 6;
        for (int it = blockIdx.x * NWAVES + wave; it < 4096; it += gridDim.x * NWAVES) hy::transpose_item(a, it, tid & 63); });
    SEAM(5);
    RUNPH(6, { gm::SchedOut S{a.ws, (int)gridDim.x, vcu}; gm::EpiOut E{a.ws}; gm::gemm_stream<false, 0, false>(lds, S, E); });
    SEAM(6);
    RUNPH(7, rt::phase(a, lds));
    SEAM(7);
    if (IN(8) || IN(9)) {
        LAS int* tab = (LAS int*)(lds + gm::LDS_TAB);
        __syncthreads();
        if (tid == 0) { const unsigned* cnt = (const unsigned*)(a.ws + WS_CNT); int nrt = 0;
            for (int e = 0; e < NE; ++e) { const int n = (int)cnt[e]; tab[e] = n; const int nt = (n + 255) >> 8; for (int k = 0; k < nt; ++k) tab[64 + nrt + k] = e | (k << 8); nrt += nt; }
            tab[32] = nrt; }
        __syncthreads();
    }
    RUNPH(8, { gm::SchedMoe<1> S{a.ws, (const LAS int*)(lds + gm::LDS_TAB), (int)gridDim.x, vcu, a.in[I_EB2]}; gm::EpiMoe1 E{a.ws}; gm::gemm_stream<true, 2, true>(lds, S, E); });
    SEAM(8);
    RUNPH(9, { gm::SchedMoe<2> S{a.ws, (const LAS int*)(lds + gm::LDS_TAB), (int)gridDim.x, vcu, a.in[I_EB2]}; gm::EpiMoe2 E{a.ws}; gm::gemm_stream<false, 0, true>(lds, S, E); });
    SEAM(9);
    RUNPH(10, p_final(a, lds));
#undef RUNPH
#undef vcu
#undef IN
#undef SEAM
}

extern "C" void kernel_launch(void* const* d_in, const int* in_sizes, int n_in, void* d_out, int out_size, void* d_ws, size_t ws_size, hipStream_t stream) {
    static int grid = 0;
    if (grid == 0) {
        if (n_in != 32 || out_size != T * D || ws_size < WS_END) { fprintf(stderr, "kernel_launch: unexpected shapes (n_in %d out %d ws %zu need %zu)\n", n_in, out_size, ws_size, (size_t)WS_END); grid = -1; return; }
        int dev = 0, cus = 0;
        if (hipGetDevice(&dev) != hipSuccess || hipDeviceGetAttribute(&cus, hipDeviceAttributeMultiprocessorCount, dev) != hipSuccess) { grid = -1; return; }
        if (hipFuncSetAttribute((const void*)mega_fwd, hipFuncAttributeMaxDynamicSharedMemorySize, LDS_BYTES) != hipSuccess) { fprintf(stderr, "kernel_launch: hipFuncSetAttribute failed\n"); grid = -1; return; }
        int per_cu = 0;
        if (hipOccupancyMaxActiveBlocksPerMultiprocessor(&per_cu, (const void*)mega_fwd, NTHREADS, LDS_BYTES) != hipSuccess || per_cu < 1) fprintf(stderr, "kernel_launch: occupancy query says %d\n", per_cu);
        (void)hipGetLastError();
        grid = cus;
        if (grid > MAX_GRID) grid = MAX_GRID;
    }
    if (grid < 0) return;
    (void)hipMemsetAsync(d_ws, 0, WS_ZERO_BYTES, stream);
    Args a{};
    for (int i = 0; i < 32; ++i) a.in[i] = (const float*)d_in[i];
    a.out = (float*)d_out; a.ws = (unsigned char*)d_ws;
#ifdef DBG
    (void)hipMemsetAsync((char*)d_ws + WS_DBG, 0, 512, stream);
    for (int p = 0; p < N_PHASES; ++p) { a.ph_lo = p; a.ph_hi = p + 1; hipLaunchKernelGGL(mega_fwd, dim3(grid), dim3(NTHREADS), LDS_BYTES, stream, a);
        hipLaunchKernelGGL(dbg_check, dim3(64), dim3(512), 0, stream, a, p); }
    hipLaunchKernelGGL(dbg_encode, dim3(1024), dim3(256), 0, stream, a);
#elif N_LAUNCH_PER_PHASE
    for (int p = 0; p < N_PHASES; ++p) { a.ph_lo = p; a.ph_hi = p + 1; hipLaunchKernelGGL(mega_fwd, dim3(grid), dim3(NTHREADS), LDS_BYTES, stream, a); }
#else
    a.ph_lo = 0; a.ph_hi = N_PHASES;
#ifdef PROF_REP
    a.rep_k = PROF_REP;
#endif
    hipLaunchKernelGGL(mega_fwd, dim3(grid), dim3(NTHREADS), LDS_BYTES, stream, a);
#endif
}
```

```cpp
#include <hip/hip_runtime.h>
#include <cstdio>
#include <cstdint>
#include <cstddef>

#define LAS __attribute__((address_space(3)))
#define GAS __attribute__((address_space(1)))
typedef unsigned short bf16_t;
typedef short bf16x8 __attribute__((ext_vector_type(8)));
typedef float f32x4 __attribute__((ext_vector_type(4)));
typedef float f32x2 __attribute__((ext_vector_type(2)));
typedef unsigned u32x4 __attribute__((ext_vector_type(4)));
typedef unsigned u32x2 __attribute__((ext_vector_type(2)));

#ifndef N_LAUNCH_PER_PHASE
#define N_LAUNCH_PER_PHASE 0
#endif

constexpr int D = 1024, NB = 4, SEQ = 8192, T = NB * SEQ, CTXL = 256, TC = NB * CTXL, TT = T + TC;
constexpr int NH = 4, DK = 64, DV = 128, CH = 64, NCHUNK = SEQ / CH, NCC = CTXL / CH, NCT = NCHUNK + NCC;
constexpr int HYW = 512, HYC = 3 * HYW, INW = 3104;
constexpr int NE = 32, DE = 1024, CAP = T;
constexpr float LN_EPS = 1e-6f, ALPHA = 1.189207115002721f;
constexpr int NTHREADS = 512, NWAVES = 8;
constexpr int FFTN = 16384;

constexpr size_t al256(size_t x) { return (x + 255) & ~(size_t)255; }
constexpr size_t WS_BAR   = 0;
constexpr size_t WS_MOD   = 16384;
constexpr size_t WS_CNT   = WS_MOD + 5 * 6144 * 4;
constexpr size_t WS_ZERO_BYTES = al256(WS_CNT + 256);
constexpr size_t WS_LIST  = 262144;
constexpr size_t WS_PW    = WS_LIST + (size_t)NE * CAP * 4;
constexpr size_t WS_PLOC  = WS_PW + (size_t)T * 4 * 4;
constexpr size_t WS_B1R   = WS_PLOC + (size_t)T * 4 * 4;
constexpr size_t WS_HID2  = WS_B1R + (size_t)NE * 2048 * 4;
constexpr size_t WS_BTIN  = WS_HID2 + (size_t)SEQ * 64 * 4;
constexpr size_t WS_BTOUT = WS_BTIN + (size_t)3584 * 1024 * 2;
constexpr size_t WS_W1T   = WS_BTOUT + (size_t)1024 * 1024 * 2;
constexpr size_t WS_W2T   = WS_W1T + (size_t)NE * 2048 * 1024 * 2;
constexpr size_t WS_PRE1  = WS_W2T + (size_t)NE * 1024 * 1024 * 2;
constexpr size_t WS_RA    = WS_PRE1 + (size_t)T * 1024 * 4;
constexpr size_t WS_H     = WS_RA;
constexpr size_t WS_Q     = WS_H + (size_t)TT * 1024 * 2;
constexpr size_t WS_K     = WS_Q + (size_t)T * 256 * 2;
constexpr size_t WS_V     = WS_K + (size_t)TT * 256 * 2;
constexpr size_t WS_G     = WS_V + (size_t)TT * 512 * 2;
constexpr size_t WS_GF    = WS_G + (size_t)T * 512 * 2;
constexpr size_t WS_GB    = WS_GF + (size_t)TT * 256 * 4;
constexpr size_t WS_UT    = WS_GB + (size_t)TT * 256 * 4;
constexpr size_t WS_RA_END= WS_UT + (size_t)NB * HYC * SEQ * 2;
constexpr size_t WS_H2    = WS_RA;
constexpr size_t WS_FG    = WS_RA + (size_t)T * 1024 * 2;
constexpr size_t WS_SLOTS = WS_RA;
constexpr size_t SORTED_BYTES_ = (size_t)(T * 4 / 256 + NE) * 256 * 1024 * 2;
constexpr size_t WS_RB    = al256(WS_RA_END > WS_RA + SORTED_BYTES_ ? WS_RA_END : WS_RA + SORTED_BYTES_);
constexpr size_t WS_KV    = WS_RB;
constexpr size_t WS_AV    = WS_KV + (size_t)2 * 16 * NCT * 8192 * 2;
constexpr size_t WS_SP    = WS_AV + (size_t)2 * 16 * NCT * 64 * 4;
constexpr size_t WS_HSPEC = WS_SP + (size_t)2 * 16 * NCHUNK * 8192 * 2;
constexpr size_t HSPEC_PER_WG = (size_t)2 * FFTN * 8;
constexpr int MAX_GRID = 256;
constexpr size_t WS_YHYT  = WS_HSPEC + (size_t)MAX_GRID * HSPEC_PER_WG;
constexpr size_t WS_MIX   = WS_YHYT + (size_t)NB * HYW * SEQ * 2;
constexpr size_t WS_RB_END= WS_MIX + (size_t)T * 1024 * 2;
constexpr size_t WS_HF    = WS_MIX;
constexpr size_t WS_ACT   = WS_RB;
constexpr size_t SORTED_BYTES = (size_t)(T * 4 / 256 + NE) * 256 * 1024 * 2;
constexpr size_t WS_END   = al256(WS_RB_END > WS_RB + SORTED_BYTES ? WS_RB_END : WS_RB + SORTED_BYTES);

constexpr int LDS_BYTES = 147456;
constexpr int LDS_MISC  = 145408;

typedef __bf16 bf16n2 __attribute__((ext_vector_type(2)));
__device__ __forceinline__ unsigned pk2(float lo, float hi) { bf16n2 v = {(__bf16)lo, (__bf16)hi}; return __builtin_bit_cast(unsigned, v); }
__device__ __forceinline__ bf16_t f2bf(float f) { __bf16 b = (__bf16)f; return __builtin_bit_cast(unsigned short, b); }
__device__ __forceinline__ float bf2f(bf16_t b) { return __uint_as_float(((unsigned)b) << 16); }
__device__ __forceinline__ float bflo(unsigned w) { return __uint_as_float(w << 16); }
__device__ __forceinline__ float bfhi(unsigned w) { return __uint_as_float(w & 0xffff0000u); }
__device__ __forceinline__ float wave_sum(float v) {
#pragma unroll
    for (int o = 1; o < 64; o <<= 1) v += __shfl_xor(v, o);
    return v;
}
__device__ __forceinline__ float silu_f(float x) { return x * __builtin_amdgcn_rcpf(1.f + __expf(-x)); }
__device__ __forceinline__ float log_sigmoid_f(float z) { return fminf(z, 0.f) - __logf(1.f + __expf(-fabsf(z))); }

#define XB_TMO      128
#define XB_XCNT(j)  (256  + 64 * (j))
#define XB_XSUB(j)  (1280 + 64 * (j))
#define XB_XGEN(j)  (2304 + 64 * (j))
#define XB_TOP      3328
#define XB_TOPGEN   3392
#define XCD_BAR_WORDS 3456
#define XB_SPIN_CAP (1u << 22)
__device__ __forceinline__ unsigned xb_ld(unsigned* p)              { return __hip_atomic_load(p, __ATOMIC_RELAXED, __HIP_MEMORY_SCOPE_AGENT); }
__device__ __forceinline__ unsigned xb_add(unsigned* p, unsigned v) { return __hip_atomic_fetch_add(p, v, __ATOMIC_RELAXED, __HIP_MEMORY_SCOPE_AGENT); }
__device__ __forceinline__ unsigned xb_xcc_id() { return (unsigned)__builtin_amdgcn_s_getreg((3 << 11) | 20) & 0xFu; }
#define XB_SPIN(cond, bar) do { unsigned _sp = 0; while (cond) { __builtin_amdgcn_s_sleep(1); \
    if ((++_sp & 255u) == 0u) { if (xb_ld(&(bar)[XB_TMO])) break; if (_sp > XB_SPIN_CAP) { atomicAdd(&(bar)[XB_TMO], 1u); break; } } } } while (0)
struct XcdBarrier { unsigned* bar; unsigned x; volatile LAS unsigned* st; };
__device__ __forceinline__ XcdBarrier xcd_barrier_post(unsigned* bar, volatile LAS unsigned* st) {
    XcdBarrier b; b.bar = bar; b.x = xb_xcc_id(); b.st = st;
    if (threadIdx.x == 0) (void)xb_add(&bar[XB_XCNT(b.x)], 1u);
    return b;
}
__device__ __forceinline__ void xcd_barrier_complete(unsigned* bar, unsigned x, unsigned& nloc, unsigned& nx) {
    const unsigned G = gridDim.x * gridDim.y * gridDim.z;
    unsigned sum, cnt, mine, sp = 0u;
    for (;;) {
        sum = 0u; cnt = 0u; mine = 0u;
#pragma unroll
        for (unsigned j = 0; j < 16; ++j) { const unsigned c = xb_ld(&bar[XB_XCNT(j)]); sum += c; cnt += (c > 0u) ? 1u : 0u; mine = (j == x) ? c : mine; }
        if (sum == G) break;
        __builtin_amdgcn_s_sleep(1);
        if ((++sp & 255u) == 0u) { if (xb_ld(&bar[XB_TMO])) break; if (sp > XB_SPIN_CAP) { atomicAdd(&bar[XB_TMO], 1u); break; } }
    }
    nloc = mine > 0u ? mine : 1u; nx = cnt > 0u ? cnt : 1u;
}
__device__ __forceinline__ void xcd_barrier(const XcdBarrier& b) {
    asm volatile("s_waitcnt vmcnt(0)" ::: "memory");
    __syncthreads();
    if (threadIdx.x == 0) {
        unsigned* bar = b.bar;
        __builtin_amdgcn_s_waitcnt(0);
        unsigned nloc = b.st[0], nx = b.st[1];
        if (nloc == 0u) { xcd_barrier_complete(bar, b.x, nloc, nx); b.st[0] = nloc; b.st[1] = nx; }
        const unsigned old = xb_add(&bar[XB_XSUB(b.x)], 1u);
        const unsigned gen = old / nloc;
        if (old + 1u == (gen + 1u) * nloc) {
            __builtin_amdgcn_fence(__ATOMIC_RELEASE, "agent");
            asm volatile("s_waitcnt vmcnt(0)" ::: "memory");
            const unsigned og = xb_add(&bar[XB_TOP], 1u);
            const unsigned tg = og / nx;
            if (og + 1u == (tg + 1u) * nx) xb_add(&bar[XB_TOPGEN], 1u);
            else XB_SPIN(xb_ld(&bar[XB_TOPGEN]) == tg, bar);
            __builtin_amdgcn_fence(__ATOMIC_ACQUIRE, "agent");
            xb_add(&bar[XB_XGEN(b.x)], 1u);
            asm volatile("s_waitcnt vmcnt(0)" ::: "memory");
        } else {
            XB_SPIN(xb_ld(&bar[XB_XGEN(b.x)]) == gen, bar);
            __builtin_amdgcn_fence(__ATOMIC_ACQUIRE, "agent");
            asm volatile("s_waitcnt vmcnt(0)" ::: "memory");
        }
    }
    __syncthreads();
}

struct Args {
    const float* in[32];
    float* out;
    unsigned char* ws;
    int ph_lo, ph_hi;
    int rep_k, pad_;
};
enum { I_X = 0, I_C, I_CTX, I_CCTX, I_ADAW, I_ADAB, I_WIN, I_WAF, I_BAF, I_WAB, I_BAB, I_NORMG, I_CONVW, I_CONVB, I_FW1, I_FB1, I_FW2, I_FB2, I_FWOUT, I_FFREQ,
       I_BIASD, I_WOUT, I_LN1G, I_LN1B, I_RW, I_RB, I_EW1, I_EB1, I_EW2, I_EB2, I_LN2G, I_LN2B };


namespace gm {
constexpr int BM = 256, BK = 64, HALF = 128, HTB = HALF * BK * 2, STAGE_BYTES = 8 * HTB, KD = 1024, NT = KD / BK;
constexpr int ROWB = KD * 2;
typedef int i32x8 __attribute__((ext_vector_type(8)));
__device__ __forceinline__ int lds_off8(int r, int fq) { const int rr = r & 15; return ((r >> 4) * 2 + (fq >> 1)) * 1024 + ((rr * 64 + 32 * (fq & 1)) ^ (((rr >> 3) & 1) << 5)); }
__device__ __forceinline__ int lds_byte(int r, int c) { const int st = (r >> 4) * 2 + (c >> 5), rr = r & 15, cc = c & 31, ob = rr * 64 + cc * 2; return st * 1024 + (ob ^ (((ob >> 9) & 1) << 5)); }
__device__ __forceinline__ void stage_rc(int b, int& R, int& C) { const int st = b / 1024, sb = b % 1024, swz = sb ^ (((sb >> 9) & 1) << 5); R = (st >> 1) * 16 + swz / 64; C = (st & 1) * 32 + (swz % 64) / 2; }
__device__ __forceinline__ int perm32(int rho) { const int n = rho >> 4, i = rho & 15; return 8 * (i >> 2) + 4 * n + (i & 3); }

constexpr int LDS_BIAS = STAGE_BYTES + 4096;
struct Unit {
    const char* A;
    const char* B;
    const int* list;
    int type, row0, col0, valid, aux;
};

__device__ __forceinline__ i32x8 cat8(bf16x8 lo, bf16x8 hi) { typedef int i32x4 __attribute__((ext_vector_type(4))); const i32x4 a = __builtin_bit_cast(i32x4, lo), b = __builtin_bit_cast(i32x4, hi); return (i32x8){a[0], a[1], a[2], a[3], b[0], b[1], b[2], b[3]}; }
template <bool GATHER, int GSHIFT, int RB>
__device__ __forceinline__ void a_offsets(const Unit& u, unsigned (&o)[2][2]) {
    int R[2], Cb[2];
    int tz = threadIdx.x; asm volatile("" : "+v"(tz));
#pragma unroll
    for (int i = 0; i < 2; ++i) { int r, c; stage_rc(tz * 16 + i * 8192, r, c); R[i] = r; Cb[i] = c * 2; }
#pragma unroll
    for (int h = 0; h < 2; ++h)
#pragma unroll
        for (int i = 0; i < 2; ++i) {
            const int r = h * HALF + R[i];
            if (!GATHER) o[h][i] = (unsigned)(r * RB + Cb[i]);
            else { const int idx = u.list[r < u.valid ? r : 0]; o[h][i] = (unsigned)(idx >> GSHIFT) * (unsigned)RB + (unsigned)Cb[i]; }
        }
}

template <bool GATHER, int GSHIFT, bool FP8, class Sched, class Epi>
__device__ __forceinline__ void gemm_stream(LAS unsigned char* lds, const Sched& S, const Epi& E) {
    constexpr int RB = FP8 ? KD : ROWB, NTL = FP8 ? NT / 2 : NT;
    const int tid = threadIdx.x, wid = __builtin_amdgcn_readfirstlane(tid >> 6), lane = tid & 63, wr = wid >> 2, wc = wid & 3, fr = lane & 15, fq = lane >> 4;
    unsigned voffB[2], voffA[2];
#pragma unroll
    for (int i = 0; i < 2; ++i) { int r, c; stage_rc(tid * 16 + i * 8192, r, c); const int rb = (r & ~31) + perm32(r & 31); voffB[i] = (unsigned)(rb * RB + c * 2); voffA[i] = (unsigned)(r * RB + c * 2); }
    const size_t kstep = (size_t)(BK * 2), hstep = (size_t)HALF * RB;
    const unsigned ldsw = (unsigned)wid * 1024u;
    const int aoff = FP8 ? lds_off8(wr * 64 + fr, fq) : lds_byte(wr * 64 + fr, fq * 8), boff = FP8 ? lds_off8(wc * 32 + fr, fq) : lds_byte(wc * 32 + fr, fq * 8);
#define GM_SA(b, h) (((b) * 2 + (h)) * HTB)
#define GM_SB(b, h) ((4 + (b) * 2 + (h)) * HTB)
#define GM_STAGE(bufoff, gbase, vo0, vo1) do { \
        __builtin_amdgcn_global_load_lds((const unsigned*)((const char*)(gbase) + (vo0)), (LAS unsigned*)(lds + (bufoff) + ldsw), 16, 0, 0); \
        __builtin_amdgcn_global_load_lds((const unsigned*)((const char*)(gbase) + (vo1)), (LAS unsigned*)(lds + (bufoff) + ldsw + 8192), 16, 0, 0); } while (0)
#define GM_STAGE_A(bufoff, gbase, h, o0, o1) do { if constexpr (GATHER) GM_STAGE(bufoff, gbase, o0, o1); else GM_STAGE(bufoff, (gbase) + (h) * hstep, voffA[0], voffA[1]); } while (0)
#define GM_LD32(p) ({ const i32x4 lo_ = *(const LAS i32x4*)(p), hi_ = *(const LAS i32x4*)((p) + 16); (i32x8){lo_[0], lo_[1], lo_[2], lo_[3], hi_[0], hi_[1], hi_[2], hi_[3]}; })
#define GM_LDA(dst, b, h) do { if constexpr (FP8) { _Pragma("unroll") for (int m = 0; m < 4; ++m) dst##8[m] = GM_LD32(lds + GM_SA(b, h) + aoff + m * 2048); } \
        else { _Pragma("unroll") for (int m = 0; m < 4; ++m) _Pragma("unroll") for (int k = 0; k < 2; ++k) dst[m][k] = *(const LAS bf16x8*)(lds + GM_SA(b, h) + aoff + m * 2048 + k * 1024); } } while (0)
#define GM_LDB(dst, b, h) do { if constexpr (FP8) { _Pragma("unroll") for (int n = 0; n < 2; ++n) dst##8[n] = GM_LD32(lds + GM_SB(b, h) + boff + n * 2048); } \
        else { _Pragma("unroll") for (int n = 0; n < 2; ++n) _Pragma("unroll") for (int k = 0; k < 2; ++k) dst[n][k] = *(const LAS bf16x8*)(lds + GM_SB(b, h) + boff + n * 2048 + k * 1024); } } while (0)
#define GM_MMA(ai, bj, At, Bt) do { __builtin_amdgcn_s_setprio(1); _Pragma("unroll") for (int m = 0; m < 4; ++m) _Pragma("unroll") for (int n = 0; n < 2; ++n) { \
        if constexpr (FP8) asm volatile("v_mfma_scale_f32_16x16x128_f8f6f4 %0, %1, %2, %0, %3, %3 op_sel_hi:[0,0,0]" : "+v"(acc[ai][bj][m][n]) : "v"(Bt##8[n]), "v"(At##8[m]), "v"(sc1_)); \
        else { _Pragma("unroll") for (int k = 0; k < 2; ++k) acc[ai][bj][m][n] = __builtin_amdgcn_mfma_f32_16x16x32_bf16(Bt[n][k], At[m][k], acc[ai][bj][m][n], 0, 0, 0); } } \
        __builtin_amdgcn_s_setprio(0); } while (0)
#define GM_WAIT_V(n) asm volatile("s_waitcnt vmcnt(" #n ")" ::: "memory")
#define GM_WAIT_L(n) asm volatile("s_waitcnt lgkmcnt(" #n ")" ::: "memory")
#define GM_BAR __builtin_amdgcn_s_barrier()
#define GM_SCHED __builtin_amdgcn_sched_barrier(0)
    Unit cur, nxt; int ui = 0;
    if (!S.next(0, cur)) return;
    f32x4 acc[2][2][4][2];
#pragma unroll
    for (int a = 0; a < 2; ++a)
#pragma unroll
        for (int b = 0; b < 2; ++b)
#pragma unroll
            for (int m = 0; m < 4; ++m)
#pragma unroll
                for (int n = 0; n < 2; ++n) acc[a][b][m][n] = (f32x4){0.f, 0.f, 0.f, 0.f};
    typedef int i32x4 __attribute__((ext_vector_type(4)));
    int sc1_ = 0x7f7f7f7f; asm volatile("" : "+v"(sc1_));
    bf16x8 At[4][2], B0[2][2], B1[2][2];
    i32x8 At8[4], B08[2], B18[2];
    unsigned ca[2][2], na[2][2];
    if constexpr (GATHER) a_offsets<GATHER, GSHIFT, RB>(cur, ca);
    const char* cA = cur.A; const char* cB = cur.B;
    GM_STAGE(GM_SB(0, 0), cB, voffB[0], voffB[1]); GM_STAGE_A(GM_SA(0, 0), cA, 0, ca[0][0], ca[0][1]); GM_STAGE(GM_SB(0, 1), cB + hstep, voffB[0], voffB[1]); GM_STAGE_A(GM_SA(0, 1), cA, 1, ca[1][0], ca[1][1]);
    if (wr == 1) GM_BAR;
    GM_WAIT_V(4); GM_BAR;
    GM_STAGE(GM_SB(1, 0), cB + kstep, voffB[0], voffB[1]); GM_STAGE_A(GM_SA(1, 0), cA + kstep, 0, ca[0][0], ca[0][1]); GM_STAGE(GM_SB(1, 1), cB + hstep + kstep, voffB[0], voffB[1]);
    GM_WAIT_V(6); GM_BAR;
    for (;;) {
        const bool has_next = S.next(ui + 1, nxt);
        if constexpr (GATHER) {
            if (has_next) a_offsets<GATHER, GSHIFT, RB>(nxt, na);
            else {
#pragma unroll
                for (int h = 0; h < 2; ++h)
#pragma unroll
                    for (int i = 0; i < 2; ++i) na[h][i] = ca[h][i];
            }
        }
        const char* nA = has_next ? nxt.A : cA; const char* nB = has_next ? nxt.B : cB;
        if (wid == 0)
            __builtin_amdgcn_global_load_lds((const unsigned*)(S.bias(cur) + 4 * lane), (LAS unsigned*)(lds + LDS_BIAS + (ui & 1) * 1024), 16, 0, 0);
        for (int t = 0; t < NTL; t += 2) {
            const bool last = (t == NTL - 2);

            const char* a1 = cA + (size_t)(t + 1) * kstep;
            const char* a2 = last ? nA : cA + (size_t)(t + 2) * kstep; const char* b2 = last ? nB : cB + (size_t)(t + 2) * kstep;
            const char* a3 = a2 + kstep; const char* b3 = b2 + kstep;
            unsigned x00 = 0, x01 = 0, x10 = 0, x11 = 0;
            if constexpr (GATHER) { x00 = last ? na[0][0] : ca[0][0]; x01 = last ? na[0][1] : ca[0][1]; x10 = last ? na[1][0] : ca[1][0]; x11 = last ? na[1][1] : ca[1][1]; }
            GM_LDB(B0, 0, 0); GM_SCHED; GM_LDA(At, 0, 0); GM_STAGE_A(GM_SA(1, 1), a1, 1, ca[1][0], ca[1][1]);
            GM_WAIT_L(8); GM_BAR; GM_WAIT_L(0); GM_MMA(0, 0, At, B0); GM_BAR; GM_SCHED;
            GM_LDB(B1, 0, 1); GM_STAGE(GM_SB(0, 0), b2, voffB[0], voffB[1]);
            GM_BAR; GM_WAIT_L(0); GM_MMA(0, 1, At, B1); GM_BAR;
            GM_LDA(At, 0, 1); GM_STAGE_A(GM_SA(0, 0), a2, 0, x00, x01);
            GM_BAR; GM_WAIT_L(0); GM_MMA(1, 0, At, B0); GM_BAR; GM_SCHED;
            GM_STAGE(GM_SB(0, 1), b2 + hstep, voffB[0], voffB[1]);
            GM_WAIT_V(6); GM_BAR; GM_MMA(1, 1, At, B1); GM_BAR;
            GM_LDB(B0, 1, 0); GM_SCHED; GM_LDA(At, 1, 0); GM_STAGE_A(GM_SA(0, 1), a2, 1, x10, x11);
            GM_WAIT_L(8); GM_BAR; GM_WAIT_L(0); GM_MMA(0, 0, At, B0); GM_BAR; GM_SCHED;
            GM_LDB(B1, 1, 1); GM_STAGE(GM_SB(1, 0), b3, voffB[0], voffB[1]);
            GM_BAR; GM_WAIT_L(0); GM_MMA(0, 1, At, B1); GM_BAR;
            GM_LDA(At, 1, 1); GM_STAGE_A(GM_SA(1, 0), a3, 0, x00, x01);
            GM_BAR; GM_WAIT_L(0); GM_MMA(1, 0, At, B0); GM_BAR; GM_SCHED;
            GM_STAGE(GM_SB(1, 1), b3 + hstep, voffB[0], voffB[1]);
            GM_WAIT_V(6); GM_BAR; GM_MMA(1, 1, At, B1); GM_BAR;
        }
        if constexpr (FP8) asm volatile("s_nop 7\n\ts_nop 7" ::: "memory");
        {
          int tz = threadIdx.x; asm volatile("" : "+v"(tz)); const int wz = tz >> 6, lz = tz & 63;
          E(acc, cur, wz >> 2, wz & 3, lz & 15, lz >> 4, (const LAS float*)(lds + LDS_BIAS + (ui & 1) * 1024)); }
        if (!has_next) break;
#pragma unroll
        for (int a = 0; a < 2; ++a)
#pragma unroll
            for (int b = 0; b < 2; ++b)
#pragma unroll
                for (int m = 0; m < 4; ++m)
#pragma unroll
                    for (int n = 0; n < 2; ++n) acc[a][b][m][n] = (f32x4){0.f, 0.f, 0.f, 0.f};
        cur = nxt; cA = nA; cB = nB; ++ui;
        if constexpr (GATHER) {
#pragma unroll
            for (int h = 0; h < 2; ++h)
#pragma unroll
                for (int i = 0; i < 2; ++i) ca[h][i] = na[h][i];
        }
    }
    GM_WAIT_V(0);
    if (wr == 0) GM_BAR;
    GM_BAR;
#undef GM_SA
#undef GM_SB
#undef GM_STAGE
#undef GM_STAGE_A
#undef GM_LD32
#undef GM_LDA
#undef GM_LDB
#undef GM_MMA
#undef GM_WAIT_V
#undef GM_WAIT_L
#undef GM_BAR
#undef GM_SCHED
}

__device__ __forceinline__ u32x4 pack8(f32x4 a, f32x4 b) { u32x4 w; w.x = pk2(a[0], a[1]); w.y = pk2(a[2], a[3]); w.z = pk2(b[0], b[1]); w.w = pk2(b[2], b[3]); return w; }

struct SchedIn {
    unsigned char* ws; int G, c; const float* baf; const float* bab;
    __device__ __forceinline__ bool next(int i, Unit& u) const {
        int L = i * G + c;
        u.list = nullptr; u.valid = 256; u.aux = 0;
        if (L < 768) {
            const int pa = L % 6, pb = L / 6;
            u.A = (const char*)(ws + WS_BTIN) + (size_t)(2048 + 256 * pa) * ROWB; u.B = (const char*)(ws + WS_H) + (size_t)(256 * pb) * ROWB;
            u.type = 2; u.row0 = 256 * pa; u.col0 = 256 * pb; return true;
        }
        L -= 768;
        if (L < 1024) {
            const int pm = L >> 3, pn = ((L & 7) + (L >> 8)) & 7;
            u.A = (const char*)(ws + WS_H) + (size_t)(256 * pm) * ROWB; u.B = (const char*)(ws + WS_BTIN) + (size_t)(256 * pn) * ROWB;
            u.type = pn < 6 ? 0 : 1; u.row0 = 256 * pm; u.col0 = pn; return true;
        }
        L -= 1024;
        if (L < 20) {
            const int pm = L / 5, j = L % 5, pn = j == 0 ? 1 : (j == 1 ? 2 : (j == 2 ? 3 : (j == 3 ? 6 : 7)));
            u.A = (const char*)(ws + WS_H) + (size_t)(T + 256 * pm) * ROWB; u.B = (const char*)(ws + WS_BTIN) + (size_t)(256 * pn) * ROWB;
            u.type = pn < 6 ? 0 : 1; u.row0 = T + 256 * pm; u.col0 = pn; return true;
        }
        return false;
    }
    __device__ __forceinline__ const float* bias(const Unit& u) const { return (u.type == 1 && u.col0 == 7) ? bab : baf; }
};
struct EpiIn {
    unsigned char* ws;
    __device__ __forceinline__ void operator()(const f32x4 (&acc)[2][2][4][2], const Unit& u, int wr, int wc, int fr, int fq, const LAS float* bs) const {
        const int rl = wr * 64 + fr, cl = wc * 32 + 8 * fq;
        if (u.type == 0) {
            const int pn = u.col0;
            bf16_t* dst; int ld, cb;
            if (pn == 0) { dst = (bf16_t*)(ws + WS_Q); ld = 256; cb = 0; }
            else if (pn == 1) { dst = (bf16_t*)(ws + WS_K); ld = 256; cb = 0; }
            else if (pn < 4) { dst = (bf16_t*)(ws + WS_V); ld = 512; cb = (pn - 2) * 256; }
            else { dst = (bf16_t*)(ws + WS_G); ld = 512; cb = (pn - 4) * 256; }
#pragma unroll
            for (int ai = 0; ai < 2; ++ai)
#pragma unroll
                for (int m = 0; m < 4; ++m) { bf16_t* rowp = dst + (size_t)(u.row0 + rl + ai * 128 + m * 16) * ld + cb + cl;
#pragma unroll
                    for (int bj = 0; bj < 2; ++bj) *(u32x4*)(rowp + bj * 128) = pack8(acc[ai][bj][m][0], acc[ai][bj][m][1]); }
        } else if (u.type == 1) {
            float* dst = (float*)(ws + (u.col0 == 6 ? WS_GF : WS_GB));
            f32x4 bv[2][2];
#pragma unroll
            for (int bj = 0; bj < 2; ++bj)
#pragma unroll
                for (int n = 0; n < 2; ++n) bv[bj][n] = *(const LAS f32x4*)(bs + cl + bj * 128 + 4 * n);
#pragma unroll
            for (int ai = 0; ai < 2; ++ai)
#pragma unroll
                for (int m = 0; m < 4; ++m) { float* rowp = dst + (size_t)(u.row0 + rl + ai * 128 + m * 16) * 256 + cl;
#pragma unroll
                    for (int bj = 0; bj < 2; ++bj)
#pragma unroll
                        for (int n = 0; n < 2; ++n) { f32x4 z = acc[ai][bj][m][n] + bv[bj][n], o;
#pragma unroll
                            for (int j = 0; j < 4; ++j) o[j] = log_sigmoid_f(z[j]) * (1.f / 16.f);
                            *(f32x4*)(rowp + bj * 128 + 4 * n) = o; } }
        } else {
            const int b = u.col0 >> 13, l0 = u.col0 & 8191;
            bf16_t* dst = (bf16_t*)(ws + WS_UT) + ((size_t)b * HYC) * SEQ + l0 + cl;
#pragma unroll
            for (int ai = 0; ai < 2; ++ai)
#pragma unroll
                for (int m = 0; m < 4; ++m) { bf16_t* rowp = dst + (size_t)(u.row0 + rl + ai * 128 + m * 16) * SEQ;
#pragma unroll
                    for (int bj = 0; bj < 2; ++bj) *(u32x4*)(rowp + bj * 128) = pack8(acc[ai][bj][m][0], acc[ai][bj][m][1]); }
        }
    }
};

struct SchedOut {
    unsigned char* ws; int G, c;
    __device__ __forceinline__ bool next(int i, Unit& u) const {
        const int L = i * G + c; if (L >= 512) return false;
        const int pm = L >> 2, pn = L & 3;
        u.A = (const char*)(ws + WS_MIX) + (size_t)(256 * pm) * ROWB; u.B = (const char*)(ws + WS_BTOUT) + (size_t)(256 * pn) * ROWB;
        u.list = nullptr; u.valid = 256; u.aux = 0; u.type = 3; u.row0 = 256 * pm; u.col0 = 256 * pn; return true;
    }
    __device__ __forceinline__ const float* bias(const Unit& u) const { return (const float*)(ws + WS_MOD) + (u.row0 >> 13) * 6144 + 2 * 1024 + u.col0; }
};
struct EpiOut {
    unsigned char* ws;
    __device__ __forceinline__ void operator()(const f32x4 (&acc)[2][2][4][2], const Unit& u, int wr, int wc, int fr, int fq, const LAS float* bs) const {
        const int rl = wr * 64 + fr, cl = u.col0 + wc * 32 + 8 * fq;
        bf16_t* fg = (bf16_t*)(ws + WS_FG);
        f32x4 gv[2][2];
#pragma unroll
        for (int bj = 0; bj < 2; ++bj)
#pragma unroll
            for (int n = 0; n < 2; ++n) gv[bj][n] = *(const LAS f32x4*)(bs + wc * 32 + 8 * fq + bj * 128 + 4 * n);
#pragma unroll
        for (int ai = 0; ai < 2; ++ai)
#pragma unroll
            for (int m = 0; m < 4; ++m) { bf16_t* rowp = fg + (size_t)(u.row0 + rl + ai * 128 + m * 16) * 1024 + cl;
#pragma unroll
                for (int bj = 0; bj < 2; ++bj) *(u32x4*)(rowp + bj * 128) = pack8(gv[bj][0] * acc[ai][bj][m][0], gv[bj][1] * acc[ai][bj][m][1]); }
    }
};

constexpr int LDS_TAB = STAGE_BYTES;
template <int WHICH>
struct SchedMoe {
    unsigned char* ws; const LAS int* tab; int G, c; const float* b2;
    __device__ __forceinline__ bool next(int i, Unit& u) const {
        constexpr int NCT_ = WHICH == 1 ? 8 : 4;
        const int L = i * G + c; const int nrt = __builtin_amdgcn_readfirstlane(tab[32]);
        if (L >= nrt * NCT_) return false;
        const int rt = L / NCT_, ct = L % NCT_;
        const int info = __builtin_amdgcn_readfirstlane(tab[64 + rt]), e = info & 255, r0 = (info >> 8) * 256;
        const int cnt = __builtin_amdgcn_readfirstlane(tab[e]);
        u.valid = (cnt - r0) < 256 ? (cnt - r0) : 256;
        u.list = (const int*)(ws + WS_LIST) + (size_t)e * CAP + r0;
        u.A = (WHICH == 1) ? (const char*)(ws + WS_H2) : (const char*)(ws + WS_ACT) + (size_t)(256 * rt) * KD;
        u.B = (const char*)(ws + (WHICH == 1 ? WS_W1T : WS_W2T)) + ((size_t)e * (WHICH == 1 ? 2048 : 1024) + 256 * ct) * KD;
        u.type = 3 + WHICH; u.row0 = 256 * rt; u.col0 = ct; u.aux = e; return true;
    }
    __device__ __forceinline__ const float* bias(const Unit& u) const { return (WHICH == 1) ? (const float*)(ws + WS_B1R) + (size_t)u.aux * 2048 + 256 * u.col0 : b2 + (size_t)u.aux * 1024 + 256 * u.col0; }
};
__device__ __forceinline__ float swiglu_f(float glu, float lin) {
    glu = fminf(glu, 7.f); lin = fminf(fmaxf(lin, -7.f), 7.f);
    return glu * __builtin_amdgcn_rcpf(1.f + __expf(-1.702f * glu)) * (lin + 1.f);
}
constexpr float S_H2 = 4.f, S_ACT = 8.f, S_W = 64.f;
__device__ __forceinline__ unsigned pk4_fp8(float a, float b, float c, float d) {
    a = fminf(fmaxf(a, -448.f), 448.f); b = fminf(fmaxf(b, -448.f), 448.f); c = fminf(fmaxf(c, -448.f), 448.f); d = fminf(fmaxf(d, -448.f), 448.f);
    int p = __builtin_amdgcn_cvt_pk_fp8_f32(a, b, 0, false); p = __builtin_amdgcn_cvt_pk_fp8_f32(c, d, p, true); return (unsigned)p; }
struct EpiMoe1 {
    unsigned char* ws;
    __device__ __forceinline__ void operator()(const f32x4 (&acc)[2][2][4][2], const Unit& u, int wr, int wc, int fr, int fq, const LAS float* bs) const {
        const int rl = wr * 64 + fr, cl = wc * 32 + 8 * fq, ct = u.col0;
        const LAS float* b1 = bs + cl;
        unsigned char* act = (unsigned char*)(ws + WS_ACT) + (size_t)u.row0 * 1024 + 128 * ct + cl;
        f32x4 bg[2], bl[2];
#pragma unroll
        for (int n = 0; n < 2; ++n) { bg[n] = *(const LAS f32x4*)(b1 + 4 * n); bl[n] = *(const LAS f32x4*)(b1 + 128 + 4 * n); }
#pragma unroll
        for (int ai = 0; ai < 2; ++ai)
#pragma unroll
            for (int m = 0; m < 4; ++m) { const int r = rl + ai * 128 + m * 16;
                f32x4 o[2];
#pragma unroll
                for (int n = 0; n < 2; ++n) { const f32x4 gl = acc[ai][0][m][n] * (1.f / (S_H2 * S_W)) + bg[n], li = acc[ai][1][m][n] * (1.f / (S_H2 * S_W)) + bl[n];
#pragma unroll
                    for (int j = 0; j < 4; ++j) o[n][j] = swiglu_f(gl[j], li[j]) * S_ACT; }
                u32x2 w; w.x = pk4_fp8(o[0][0], o[0][1], o[0][2], o[0][3]); w.y = pk4_fp8(o[1][0], o[1][1], o[1][2], o[1][3]);
                *(u32x2*)(act + (size_t)r * 1024) = w; }
    }
};
constexpr float S_SL = 16.f;
struct EpiMoe2 {
    unsigned char* ws;
    __device__ __forceinline__ void operator()(const f32x4 (&acc)[2][2][4][2], const Unit& u, int wr, int wc, int fr, int fq, const LAS float* bs) const {
        const int rl = wr * 64 + fr, cl = wc * 32 + 8 * fq, ct = u.col0;
        const LAS float* bb = bs + cl;
        unsigned char* slots = (unsigned char*)(ws + WS_SLOTS) + (size_t)u.row0 * 1024 + 256 * ct + cl;
        f32x4 bv[2][2];
#pragma unroll
        for (int bj = 0; bj < 2; ++bj)
#pragma unroll
            for (int n = 0; n < 2; ++n) bv[bj][n] = *(const LAS f32x4*)(bb + bj * 128 + 4 * n) * S_SL;
#pragma unroll
        for (int ai = 0; ai < 2; ++ai)
#pragma unroll
            for (int m = 0; m < 4; ++m) { const int r = rl + ai * 128 + m * 16;
#pragma unroll
                for (int bj = 0; bj < 2; ++bj) { const f32x4 y0 = acc[ai][bj][m][0] * (S_SL / (S_ACT * S_W)) + bv[bj][0], y1 = acc[ai][bj][m][1] * (S_SL / (S_ACT * S_W)) + bv[bj][1];
                    u32x2 w; w.x = pk4_fp8(y0[0], y0[1], y0[2], y0[3]); w.y = pk4_fp8(y1[0], y1[1], y1[2], y1[3]);
                    *(u32x2*)(slots + (size_t)r * 1024 + bj * 128) = w; } }
    }
};
}

namespace hy {
__device__ __forceinline__ int phys(int n) { return n + (n >> 4) + ((n >> 9) << 4); }
constexpr int XSIZE = 16384 + 1024 + 512;

__device__ __forceinline__ float tw_c(int i) {
    constexpr float t[16] = {1.f, 0.98078528040323043f, 0.92387953251128674f, 0.83146961230254524f, 0.70710678118654752f, 0.55557023301960218f, 0.38268343236508977f, 0.19509032201612825f,
                             0.f, -0.19509032201612825f, -0.38268343236508977f, -0.55557023301960218f, -0.70710678118654752f, -0.83146961230254524f, -0.92387953251128674f, -0.98078528040323043f};
    return t[i];
}
__device__ __forceinline__ float tw_s(int i) {
    constexpr float t[16] = {0.f, 0.19509032201612825f, 0.38268343236508977f, 0.55557023301960218f, 0.70710678118654752f, 0.83146961230254524f, 0.92387953251128674f, 0.98078528040323043f,
                             1.f, 0.98078528040323043f, 0.92387953251128674f, 0.83146961230254524f, 0.70710678118654752f, 0.55557023301960218f, 0.38268343236508977f, 0.19509032201612825f};
    return t[i];
}
__host__ __device__ constexpr int brev(int p, int bits) { int r = 0; for (int i = 0; i < bits; ++i) r |= ((p >> i) & 1) << (bits - 1 - i); return r; }

template <int R, bool INV>
__device__ __forceinline__ void fft_reg(f32x2 (&v)[R]) {
#pragma unroll
    for (int s = R / 2; s >= 1; s >>= 1) {
#pragma unroll
        for (int g = 0; g < R; g += 2 * s) {
#pragma unroll
            for (int k = 0; k < s; ++k) {
                const f32x2 a = v[g + k], b = v[g + k + s];
                v[g + k] = a + b;
                const f32x2 t = a - b;
                const int ti = k * (16 / s);
                f32x2 o;
                if (ti == 0) o = t;
                else if (ti == 8) { if (INV) { o[0] = -t[1]; o[1] = t[0]; } else { o[0] = t[1]; o[1] = -t[0]; } }
                else { const float c = tw_c(ti), sn = tw_s(ti);
                    if (INV) { o[0] = t[0] * c - t[1] * sn; o[1] = t[1] * c + t[0] * sn; }
                    else     { o[0] = t[0] * c + t[1] * sn; o[1] = t[1] * c - t[0] * sn; } }
                v[g + k + s] = o;
            }
        }
    }
}
__device__ __forceinline__ f32x2 cmul(f32x2 a, f32x2 b) { f32x2 r; r[0] = a[0] * b[0] - a[1] * b[1]; r[1] = a[0] * b[1] + a[1] * b[0]; return r; }

template <int M, bool ZPAD = false>
__device__ __forceinline__ void pass_fwd32(LAS f32x2* X, int tid) {
    int j = (M == 512) ? tid : (tid & 15);
    asm volatile("" : "+v"(j));
    const int p0 = (M == 512) ? (tid + (tid >> 4)) : (560 * (tid >> 4) + (tid & 15));
    constexpr int PS = (M == 512) ? 560 : 17;
    f32x2 v[32];
#pragma unroll
    for (int r = 0; r < 32; ++r) { if (ZPAD && r >= 16) v[r] = (f32x2){0.f, 0.f}; else v[r] = X[p0 + PS * r]; }
    fft_reg<32, false>(v);
    float sn, cs; sincospif(-2.f * (float)j / (float)(32 * M), &sn, &cs);
    const f32x2 w1 = {cs, sn}; f32x2 w = w1;
    X[p0] = v[0];
#pragma unroll
    for (int rp = 1; rp < 32; ++rp) { X[p0 + PS * rp] = cmul(v[brev(rp, 5)], w); w = cmul(w, w1); }
}
template <int M, bool HALF = false>
__device__ __forceinline__ void pass_inv32(LAS f32x2* X, int tid) {
    int j = (M == 512) ? tid : (tid & 15);
    asm volatile("" : "+v"(j));
    const int p0 = (M == 512) ? (tid + (tid >> 4)) : (560 * (tid >> 4) + (tid & 15));
    constexpr int PS = (M == 512) ? 560 : 17;
    float sn, cs; sincospif(2.f * (float)j / (float)(32 * M), &sn, &cs);
    const f32x2 w1 = {cs, sn}; f32x2 w = w1;
    f32x2 v[32];
    v[0] = X[p0];
#pragma unroll
    for (int rp = 1; rp < 32; ++rp) { v[rp] = cmul(X[p0 + PS * rp], w); w = cmul(w, w1); }
    fft_reg<32, true>(v);
#pragma unroll
    for (int p = 0; p < 32; ++p) { if (!HALF || brev(p, 5) < 16) X[p0 + PS * brev(p, 5)] = v[p]; }
}
__device__ __forceinline__ void pass_c_store(const LAS f32x2* X, f32x2* Hs, int tid, float scale) {
#pragma unroll
    for (int u = 0; u < 2; ++u) { const int blk = tid + 512 * u, p0 = 17 * blk + 16 * (blk >> 5);
        f32x2 v[16];
#pragma unroll
        for (int r = 0; r < 16; ++r) v[r] = X[p0 + r];
        fft_reg<16, false>(v);
#pragma unroll
        for (int q = 0; q < 8; ++q) { const f32x2 x0 = v[brev(2 * q, 4)] * scale, x1 = v[brev(2 * q + 1, 4)] * scale;
            *(f32x4*)(Hs + 16 * blk + 2 * q) = (f32x4){x0[0], x0[1], x1[0], x1[1]}; } }
}
__device__ __forceinline__ void pass_c_mul_inv(LAS f32x2* X, const f32x2* Hs, int tid) {
#pragma unroll
    for (int u = 0; u < 2; ++u) { const int blk = tid + 512 * u, p0 = 17 * blk + 16 * (blk >> 5);
        f32x2 v[16], w[16];
#pragma unroll
        for (int r = 0; r < 16; ++r) v[r] = X[p0 + r];
        f32x4 hh[8];
#pragma unroll
        for (int q = 0; q < 8; ++q) hh[q] = *(const f32x4*)(Hs + 16 * blk + 2 * q);
        fft_reg<16, false>(v);
#pragma unroll
        for (int q = 0; q < 8; ++q) { w[2 * q] = cmul(v[brev(2 * q, 4)], (f32x2){hh[q][0], hh[q][1]}); w[2 * q + 1] = cmul(v[brev(2 * q + 1, 4)], (f32x2){hh[q][2], hh[q][3]}); }
        fft_reg<16, true>(w);
#pragma unroll
        for (int p = 0; p < 16; ++p) X[p0 + brev(p, 4)] = w[p]; }
}
__device__ __forceinline__ void load16(const bf16_t* u, float (&e)[16]) {
    const u32x4 a = *(const u32x4*)u, b = *(const u32x4*)(u + 8);
    e[0] = bflo(a.x); e[1] = bfhi(a.x); e[2] = bflo(a.y); e[3] = bfhi(a.y); e[4] = bflo(a.z); e[5] = bfhi(a.z); e[6] = bflo(a.w); e[7] = bfhi(a.w);
    e[8] = bflo(b.x); e[9] = bfhi(b.x); e[10] = bflo(b.y); e[11] = bfhi(b.y); e[12] = bflo(b.z); e[13] = bfhi(b.z); e[14] = bflo(b.w); e[15] = bfhi(b.w);
}
__device__ __forceinline__ void sconv16(const bf16_t* u, int tid, float w0, float w1, float w2, float bias, float (&o)[16]) {
    float e[16]; load16(u + 16 * tid, e);
    float lf = __shfl_up(e[15], 1), rt = __shfl_down(e[0], 1);
    if ((tid & 3) == 0) lf = 0.f;
    if ((tid & 3) == 3) rt = 0.f;
    o[0] = w0 * lf + w1 * e[0] + w2 * e[1] + bias;
#pragma unroll
    for (int i = 1; i < 15; ++i) o[i] = w0 * e[i - 1] + w1 * e[i] + w2 * e[i + 1] + bias;
    o[15] = w0 * e[14] + w1 * e[15] + w2 * rt + bias;
}

__device__ __forceinline__ void channel(const Args& a, LAS unsigned char* lds, int c, unsigned char* scratch) {
    const int tid = threadIdx.x;
    LAS f32x2* X = (LAS f32x2*)lds;
    f32x2* Hs = (f32x2*)scratch;
    const float* HF = (const float*)(a.ws + WS_HF);
    const int pc = 17 * tid + 16 * (tid >> 5);
    __syncthreads();
#pragma unroll 1
    for (int o = 0; o < 2; ++o) {
        const f32x4* hf = (const f32x4*)(HF + ((size_t)(2 * o) * HYW + c) * SEQ + 16 * tid); const f32x4* hb = (const f32x4*)(HF + ((size_t)(2 * o + 1) * HYW + c) * SEQ + 16 * tid);
#pragma unroll
        for (int q = 0; q < 4; ++q) { const f32x4 f = hf[q], b = hb[q];
#pragma unroll
            for (int e = 0; e < 4; ++e) { const int i = 4 * q + e, t = 16 * tid + i;
                X[pc + i] = (f32x2){f[e], 0.f};
                if (t >= 1) X[phys(FFTN - t)] = (f32x2){b[e], 0.f}; } }
        if (tid == 0) X[phys(SEQ)] = (f32x2){0.f, 0.f};
        __syncthreads();
        pass_fwd32<512>(X, tid); __syncthreads(); pass_fwd32<16>(X, tid); __syncthreads(); pass_c_store(X, Hs + (size_t)o * FFTN, tid, 1.f / (float)FFTN); __syncthreads();
    }
    const float* cw = a.in[I_CONVW]; const float* cbv = a.in[I_CONVB]; const float* dbias = a.in[I_BIASD];
    const float d1 = dbias[c], d2 = dbias[HYW + c];
    float wv[3][3], bv[3];
#pragma unroll
    for (int s = 0; s < 3; ++s) { bv[s] = cbv[s * HYW + c];
#pragma unroll
        for (int i = 0; i < 3; ++i) wv[s][i] = cw[i * HYC + s * HYW + c]; }
    const bf16_t* UT = (const bf16_t*)(a.ws + WS_UT);
    bf16_t* YT = (bf16_t*)(a.ws + WS_YHYT);
#pragma unroll 1
    for (int bp = 0; bp < 2; ++bp) {
        const bf16_t* u0 = UT + ((size_t)(2 * bp) * HYC + c) * SEQ; const bf16_t* u1 = UT + ((size_t)(2 * bp + 1) * HYC + c) * SEQ;
        float z0[16], z1[16];
        {
            float v0[16], v1[16]; sconv16(u0, tid, wv[0][0], wv[0][1], wv[0][2], bv[0], v0); sconv16(u1, tid, wv[0][0], wv[0][1], wv[0][2], bv[0], v1);
#pragma unroll
            for (int i = 0; i < 16; ++i) X[pc + i] = (f32x2){v0[i], v1[i]};
        }
        __syncthreads();
        pass_fwd32<512, true>(X, tid); __syncthreads(); pass_fwd32<16>(X, tid); __syncthreads(); pass_c_mul_inv(X, Hs, tid); __syncthreads(); pass_inv32<16>(X, tid); __syncthreads(); pass_inv32<512, true>(X, tid); __syncthreads();
        {
            float v0[16], v1[16], x0[16], x1[16];
            sconv16(u0, tid, wv[0][0], wv[0][1], wv[0][2], bv[0], v0); sconv16(u1, tid, wv[0][0], wv[0][1], wv[0][2], bv[0], v1);
            sconv16(u0 + (size_t)HYW * SEQ, tid, wv[1][0], wv[1][1], wv[1][2], bv[1], x0); sconv16(u1 + (size_t)HYW * SEQ, tid, wv[1][0], wv[1][1], wv[1][2], bv[1], x1);
#pragma unroll
            for (int i = 0; i < 16; ++i) { const f32x2 y1 = X[pc + i]; z0[i] = x0[i] * (y1[0] + d1 * v0[i]); z1[i] = x1[i] * (y1[1] + d1 * v1[i]); X[pc + i] = (f32x2){z0[i], z1[i]}; }
        }
        __syncthreads();
        pass_fwd32<512, true>(X, tid); __syncthreads(); pass_fwd32<16>(X, tid); __syncthreads(); pass_c_mul_inv(X, Hs + FFTN, tid); __syncthreads(); pass_inv32<16>(X, tid); __syncthreads(); pass_inv32<512, true>(X, tid); __syncthreads();
        {
            float x0[16], x1[16];
            sconv16(u0 + (size_t)2 * HYW * SEQ, tid, wv[2][0], wv[2][1], wv[2][2], bv[2], x0); sconv16(u1 + (size_t)2 * HYW * SEQ, tid, wv[2][0], wv[2][1], wv[2][2], bv[2], x1);
            unsigned w0[8], w1[8];
#pragma unroll
            for (int i = 0; i < 8; ++i) { const f32x2 ya = X[pc + 2 * i], yb = X[pc + 2 * i + 1];
                w0[i] = pk2(x0[2 * i] * (ya[0] + d2 * z0[2 * i]), x0[2 * i + 1] * (yb[0] + d2 * z0[2 * i + 1]));
                w1[i] = pk2(x1[2 * i] * (ya[1] + d2 * z1[2 * i]), x1[2 * i + 1] * (yb[1] + d2 * z1[2 * i + 1])); }
            u32x4* y0p = (u32x4*)(YT + ((size_t)(2 * bp) * HYW + c) * SEQ + 16 * tid); u32x4* y1p = (u32x4*)(YT + ((size_t)(2 * bp + 1) * HYW + c) * SEQ + 16 * tid);
            y0p[0] = (u32x4){w0[0], w0[1], w0[2], w0[3]}; y0p[1] = (u32x4){w0[4], w0[5], w0[6], w0[7]};
            y1p[0] = (u32x4){w1[0], w1[1], w1[2], w1[3]}; y1p[1] = (u32x4){w1[4], w1[5], w1[6], w1[7]};
        }
        __syncthreads();
    }
}

__device__ __forceinline__ void filter_item(const Args& a, int item, int lane) {
    const int ct = item & 127, tc = item >> 7;
    const float* hid2 = (const float*)(a.ws + WS_HID2); const float* wout = a.in[I_FWOUT]; float* HF = (float*)(a.ws + WS_HF);
    const int col = 16 * ct + (lane & 15), kq = lane >> 4, cch = col & 511;
    float bf[16];
#pragma unroll
    for (int s = 0; s < 16; ++s) bf[s] = wout[(size_t)(16 * kq + s) * 2048 + col];
    const float dlt = fabsf(-3.0701134573253945f + (float)cch * ((-15.350567286626973f + 3.0701134573253945f) / 511.f));
#pragma unroll 2
    for (int tt = 0; tt < 32; ++tt) { const int t0 = 512 * tc + 16 * tt;
        const f32x4* ar = (const f32x4*)(hid2 + (size_t)(t0 + (lane & 15)) * 64 + 16 * kq);
        const f32x4 a0 = ar[0], a1 = ar[1], a2 = ar[2], a3 = ar[3];
        f32x4 acc = {0.f, 0.f, 0.f, 0.f};
#pragma unroll
        for (int e = 0; e < 4; ++e) { acc = __builtin_amdgcn_mfma_f32_16x16x4f32(a0[e], bf[e], acc, 0, 0, 0); }
#pragma unroll
        for (int e = 0; e < 4; ++e) { acc = __builtin_amdgcn_mfma_f32_16x16x4f32(a1[e], bf[4 + e], acc, 0, 0, 0); }
#pragma unroll
        for (int e = 0; e < 4; ++e) { acc = __builtin_amdgcn_mfma_f32_16x16x4f32(a2[e], bf[8 + e], acc, 0, 0, 0); }
#pragma unroll
        for (int e = 0; e < 4; ++e) { acc = __builtin_amdgcn_mfma_f32_16x16x4f32(a3[e], bf[12 + e], acc, 0, 0, 0); }
        f32x4 o;
#pragma unroll
        for (int r = 0; r < 4; ++r) o[r] = acc[r] * __expf(-((float)(t0 + 4 * kq + r) / (float)(SEQ - 1)) * dlt);
        *(f32x4*)(HF + (size_t)col * SEQ + t0 + 4 * kq) = o; }
}

__device__ __forceinline__ void transpose_item(const Args& a, int item, int lane) {
    const int lt = item & 127, ct = (item >> 7) & 7, b = item >> 10;
    const bf16_t* src = (const bf16_t*)(a.ws + WS_YHYT) + ((size_t)b * HYW + 64 * ct) * SEQ + 64 * lt + lane;
    bf16_t* dst = (bf16_t*)(a.ws + WS_MIX) + ((size_t)b * SEQ + 64 * lt + lane) * 1024 + 512 + 64 * ct;
    unsigned short v[64];
#pragma unroll
    for (int cc = 0; cc < 64; ++cc) v[cc] = src[(size_t)cc * SEQ];
#pragma unroll
    for (int q = 0; q < 8; ++q)
        *(u32x4*)(dst + 8 * q) = (u32x4){(unsigned)v[8 * q] | ((unsigned)v[8 * q + 1] << 16), (unsigned)v[8 * q + 2] | ((unsigned)v[8 * q + 3] << 16),
                                         (unsigned)v[8 * q + 4] | ((unsigned)v[8 * q + 5] << 16), (unsigned)v[8 * q + 6] | ((unsigned)v[8 * q + 7] << 16)};
}
}

__device__ __forceinline__ void p0_mod_and_filter(const Args& a, LAS unsigned char* lds) {
    const int tid = threadIdx.x, lane = tid & 63, wave = tid >> 6;
    const float* c = a.in[I_C]; const float* cctx = a.in[I_CCTX]; const float* adaw = a.in[I_ADAW]; const float* adab = a.in[I_ADAB];
    float* mod = (float*)(a.ws + WS_MOD);
    LAS float* sl = (LAS float*)lds;
    LAS float* pt = (LAS float*)lds + 5 * 1024;
    for (int i = tid; i < 5 * 1024; i += NTHREADS) { const int r = i >> 10, k = i & 1023; sl[i] = silu_f(r < 4 ? c[r * 1024 + k] : cctx[k]); }
    for (int it = blockIdx.x; it < 256; it += gridDim.x) {
        __syncthreads();
        if (tid < 504) {
            const int col = tid % 24, ks = tid / 24, n = it * 24 + col, kbeg = ks * 49, kend = (kbeg + 49 < 1024) ? kbeg + 49 : 1024;
            float acc[5] = {0.f, 0.f, 0.f, 0.f, 0.f};
#pragma unroll 7
            for (int k = kbeg; k < kend; ++k) { const float w = adaw[(size_t)k * 6144 + n];
#pragma unroll
                for (int r = 0; r < 5; ++r) acc[r] += sl[r * 1024 + k] * w; }
#pragma unroll
            for (int r = 0; r < 5; ++r) pt[(ks * 5 + r) * 24 + col] = acc[r];
        }
        __syncthreads();
        if (tid < 120) { const int r = tid / 24, col = tid % 24, n = it * 24 + col; float s = adab[n];
            for (int ks = 0; ks < 21; ++ks) s += pt[(ks * 5 + r) * 24 + col];
            mod[r * 6144 + n] = s; }
    }
    __syncthreads();
    const float* w1 = a.in[I_FW1]; const float* b1 = a.in[I_FB1]; const float* w2 = a.in[I_FW2]; const float* b2 = a.in[I_FB2]; const float* fq = a.in[I_FFREQ];
    float* hid2 = (float*)(a.ws + WS_HID2);
    LAS float* zs = (LAS float*)lds + 8192 + wave * 128;
    const float frq = fq[lane], bb1 = b1[lane], bb2 = b2[lane];
    for (int t = (blockIdx.x * NWAVES + wave); t < SEQ; t += gridDim.x * NWAVES) {
        float z = 0.f;
        if (lane == 0) z = (float)t / (float)(SEQ - 1);
        else if (lane < 33) { const int i = (lane - 1) & 15; const float f = 1e-4f + (float)i * ((15.f - 1e-4f) / 15.f);
            const float ang = (6.283185307179586f * (float)t / (float)SEQ) * f; z = (lane < 17) ? cosf(ang) : -sinf(ang); }
        if (lane < 33) zs[lane] = z;
        __builtin_amdgcn_wave_barrier(); asm volatile("s_waitcnt lgkmcnt(0)" ::: "memory");
        float s = bb1;
#pragma unroll
        for (int e = 0; e < 33; ++e) s += zs[e] * w1[e * 64 + lane];
        const float h1 = sinf(frq * s);
        zs[64 + lane] = h1;
        __builtin_amdgcn_wave_barrier(); asm volatile("s_waitcnt lgkmcnt(0)" ::: "memory");
        float s2 = bb2;
#pragma unroll 16
        for (int g = 0; g < 64; ++g) s2 += zs[64 + g] * w2[g * 64 + lane];
        hid2[(size_t)t * 64 + lane] = sinf(frq * s2);
        __builtin_amdgcn_wave_barrier(); asm volatile("s_waitcnt lgkmcnt(0)" ::: "memory");
    }
}

template <bool FP8 = false>
__device__ __forceinline__ void tr_item(const float* W, int ldw, int k0, int c0, int cstride, float scale, bf16_t* dstrow0, LAS float* scr, int lane) {
    float wv_[32];
#pragma unroll
    for (int i = 0; i < 32; ++i) wv_[i] = W[(size_t)(k0 + 2 * i + (lane >> 5)) * ldw + c0 + (lane & 31) * cstride];
#pragma unroll
    for (int i = 0; i < 32; ++i) scr[(2 * i + (lane >> 5)) * 33 + (lane & 31)] = wv_[i] * scale;
    asm volatile("s_waitcnt lgkmcnt(0)" ::: "memory"); __builtin_amdgcn_wave_barrier();
    const int c = lane & 7;
#pragma unroll
    for (int j = 0; j < 4; ++j) { const int n = (lane >> 3) + 8 * j; const LAS float* s = scr + (8 * c) * 33 + n;
        if (FP8) { u32x2 o; o.x = gm::pk4_fp8(s[0 * 33], s[1 * 33], s[2 * 33], s[3 * 33]); o.y = gm::pk4_fp8(s[4 * 33], s[5 * 33], s[6 * 33], s[7 * 33]);
            *(u32x2*)((unsigned char*)dstrow0 + (size_t)n * 1024 + k0 + 8 * c) = o; }
        else { u32x4 o; o.x = pk2(s[0 * 33], s[1 * 33]); o.y = pk2(s[2 * 33], s[3 * 33]); o.z = pk2(s[4 * 33], s[5 * 33]); o.w = pk2(s[6 * 33], s[7 * 33]);
            *(u32x4*)(dstrow0 + (size_t)n * 1024 + k0 + 8 * c) = o; } }
    asm volatile("s_waitcnt lgkmcnt(0)" ::: "memory"); __builtin_amdgcn_wave_barrier();
}
__device__ __forceinline__ void fold_item(const float* win, const float* wa, int dir, int k0, int j0, bf16_t* dstrow0, LAS float* scr, int lane) {
#pragma unroll 4
    for (int i = 0; i < 32; ++i) { const int kk = 2 * i + (lane >> 5); const float* wr = win + (size_t)(k0 + kk) * INW + 1536 + 16 * dir; float s = 0.f;
#pragma unroll
        for (int r = 0; r < 16; ++r) s += wr[r] * wa[r * 256 + j0 + (lane & 31)];
        scr[kk * 33 + (lane & 31)] = s; }
    asm volatile("s_waitcnt lgkmcnt(0)" ::: "memory"); __builtin_amdgcn_wave_barrier();
    const int c = lane & 7;
#pragma unroll
    for (int j = 0; j < 4; ++j) { const int n = (lane >> 3) + 8 * j; const LAS float* s = scr + (8 * c) * 33 + n;
        u32x4 o; o.x = pk2(s[0 * 33], s[1 * 33]); o.y = pk2(s[2 * 33], s[3 * 33]); o.z = pk2(s[4 * 33], s[5 * 33]); o.w = pk2(s[6 * 33], s[7 * 33]);
        *(u32x4*)(dstrow0 + (size_t)n * 1024 + k0 + 8 * c) = o; }
    asm volatile("s_waitcnt lgkmcnt(0)" ::: "memory"); __builtin_amdgcn_wave_barrier();
}
__device__ __forceinline__ void ln_mod_row(const float* xrow, const float* shift, const float* scale, bf16_t* orow, int lane) {
    const f32x4* xr = (const f32x4*)xrow + lane;
    f32x4 v[4]; float s = 0.f;
#pragma unroll
    for (int j = 0; j < 4; ++j) { v[j] = xr[64 * j]; s += (v[j][0] + v[j][1]) + (v[j][2] + v[j][3]); }
    const float mean = wave_sum(s) * (1.f / D); float s2 = 0.f;
#pragma unroll
    for (int j = 0; j < 4; ++j) { v[j] = v[j] - mean; s2 += (v[j][0] * v[j][0] + v[j][1] * v[j][1]) + (v[j][2] * v[j][2] + v[j][3] * v[j][3]); }
    const float rstd = 1.f / sqrtf(wave_sum(s2) * (1.f / D) + LN_EPS);
    u32x2* o8 = (u32x2*)orow + lane;
#pragma unroll
    for (int j = 0; j < 4; ++j) { const f32x4 sh = ((const f32x4*)shift)[64 * j + lane], sc = ((const f32x4*)scale)[64 * j + lane];
        const f32x4 y = v[j] * rstd * (sc + 1.f) + sh;
        u32x2 w; w.x = pk2(y[0], y[1]); w.y = pk2(y[2], y[3]); o8[64 * j] = w; }
}
constexpr int PREP_I_IN = 16 * 96, PREP_I_FOLD = 16 * 8 * 2, PREP_I_OUT = 16 * 32, PREP_I_W1 = NE * 16 * 64, PREP_I_W2 = NE * 16 * 32;
constexpr int PREP_NITEMS = PREP_I_IN + PREP_I_FOLD + PREP_I_OUT + PREP_I_W1 + PREP_I_W2;
constexpr int PREP_DEFER = 10880;
__device__ __forceinline__ void prep_items(const Args& a, LAS float* scr, int first, int last, int rank, int nranks, int lane) {
    constexpr int I_IN = PREP_I_IN, I_FOLD = PREP_I_FOLD, I_OUT = PREP_I_OUT, I_W1 = PREP_I_W1;
    const float* win = a.in[I_WIN];
    bf16_t* btin = (bf16_t*)(a.ws + WS_BTIN); bf16_t* btout = (bf16_t*)(a.ws + WS_BTOUT); bf16_t* w1t = (bf16_t*)(a.ws + WS_W1T); bf16_t* w2t = (bf16_t*)(a.ws + WS_W2T);
    for (int it = first + rank; it < last; it += nranks) {
        int r = it;
        if (r < I_IN) {
            const int kb = r / 96, nb = r % 96;
            if (nb < 48) tr_item(win, INW, 64 * kb, 32 * nb, 1, nb < 8 ? 0.125f : 1.f, btin + (size_t)(32 * nb) * 1024, scr, lane);
            else tr_item(win, INW, 64 * kb, 1568 + 32 * (nb - 48), 1, 1.f, btin + (size_t)(2048 + 32 * (nb - 48)) * 1024, scr, lane);
            continue; }
        r -= I_IN;
        if (r < I_FOLD) { const int dir = r & 1, jb = (r >> 1) & 7, kb = r >> 4;
            fold_item(win, dir ? a.in[I_WAB] : a.in[I_WAF], dir, 64 * kb, 32 * jb, btin + (size_t)(1536 + 256 * dir + 32 * jb) * 1024, scr, lane); continue; }
        r -= I_FOLD;
        if (r < I_OUT) { const int kb = r / 32, nb = r % 32; tr_item(a.in[I_WOUT], 1024, 64 * kb, 32 * nb, 1, 1.f, btout + (size_t)(32 * nb) * 1024, scr, lane); continue; }
        r -= I_OUT;
        if (r < I_W1) {
            const int e = r / 1024, q = r % 1024, s = q & 1, nb = (q >> 1) & 31, kb = q >> 6;
            const int ct = nb >> 2, jj0 = (nb & 3) * 32;
            tr_item<true>(a.in[I_EW1] + (size_t)e * 1024 * 2048, 2048, 64 * kb, 2 * (128 * ct + jj0) + s, 2, gm::S_W, (bf16_t*)((unsigned char*)w1t + ((size_t)e * 2048 + 256 * ct + 128 * s + jj0) * 1024), scr, lane);
            continue; }
        r -= I_W1;
        { const int e = r / 512, q = r % 512, kb = q / 32, nb = q % 32;
          tr_item<true>(a.in[I_EW2] + (size_t)e * 1024 * 1024, 1024, 64 * kb, 32 * nb, 1, gm::S_W, (bf16_t*)((unsigned char*)w2t + ((size_t)e * 1024 + 32 * nb) * 1024), scr, lane); }
    }
}
__device__ __forceinline__ void p1_prep(const Args& a, LAS unsigned char* lds) {
    const int tid = threadIdx.x, lane = tid & 63, wave = tid >> 6;
    LAS float* scr = (LAS float*)(lds + wave * 16384);
    const int gw = blockIdx.x * NWAVES + wave, NGW = gridDim.x * NWAVES;
    const float* win = a.in[I_WIN];
    bf16_t* btin = (bf16_t*)(a.ws + WS_BTIN); bf16_t* btout = (bf16_t*)(a.ws + WS_BTOUT); bf16_t* w1t = (bf16_t*)(a.ws + WS_W1T); bf16_t* w2t = (bf16_t*)(a.ws + WS_W2T);
    const float* mod = (const float*)(a.ws + WS_MOD);
    bf16_t* H = (bf16_t*)(a.ws + WS_H);
#pragma unroll 2
    for (int row = gw; row < TT; row += NGW) {
        const float* xr; int mr;
        if (row < T) { xr = a.in[I_X] + (size_t)row * D; mr = row >> 13; } else { xr = a.in[I_CTX] + (size_t)(row - T) * D; mr = 4; }
        ln_mod_row(xr, mod + mr * 6144, mod + mr * 6144 + 1024, H + (size_t)row * D, lane);
    }
    prep_items(a, scr, 0, PREP_NITEMS - PREP_DEFER, gw, NGW, lane);
    for (int it = gw; it < 2048; it += NGW) hy::filter_item(a, it, lane);
    float* b1r = (float*)(a.ws + WS_B1R); const float* eb1 = a.in[I_EB1];
    for (int i = blockIdx.x * NTHREADS + tid; i < NE * 2048; i += gridDim.x * NTHREADS) {
        const int e = i >> 11, n = i & 2047, ct = n >> 8, s = (n >> 7) & 1, jj = n & 127;
        b1r[i] = eb1[(size_t)e * 2048 + 2 * (128 * ct + jj) + s];
    }
}

namespace gla {
constexpr int RS = 72;
constexpr int L_TOTF = 0, L_TOTB = 2048, L_SSQ = 4096;
constexpr int L_T0 = 8192;
constexpr int L_T1 = L_T0 + 9216, L_T2 = L_T1 + 9216, L_T3 = L_T2 + 9216;
constexpr int L_VT = L_T3 + 9216;
constexpr int L_P  = L_VT + 18432;
constexpr int L_SF = L_P + 9216, L_SB = L_SF + 18432;
constexpr int L_END = L_SB + 18432;

__device__ __forceinline__ bf16x8 frag(const LAS unsigned char* tile, int row, int k0, int lane) {
    return *(const LAS bf16x8*)(tile + ((row + (lane & 15)) * RS + k0 + 8 * (lane >> 4)) * 2);
}
__device__ __forceinline__ void chunk_cums_pre(LAS unsigned char* L, const float (&gf)[8], const float (&gb)[8], int wave, int lane, float (&cumf)[8], float (&cumb)[8], float& allf, float& allb) {
    LAS float* totf = (LAS float*)(L + L_TOTF); LAS float* totb = (LAS float*)(L + L_TOTB);
    cumf[0] = gf[0];
#pragma unroll
    for (int r = 1; r < 8; ++r) cumf[r] = cumf[r - 1] + gf[r];
    cumb[7] = gb[7];
#pragma unroll
    for (int r = 6; r >= 0; --r) cumb[r] = cumb[r + 1] + gb[r];
    totf[wave * 64 + lane] = cumf[7]; totb[wave * 64 + lane] = cumb[0];
    __syncthreads();
    float of = 0.f, ob = 0.f, af = 0.f, ab = 0.f;
#pragma unroll
    for (int w = 0; w < 8; ++w) { const float tf = totf[w * 64 + lane], tb = totb[w * 64 + lane]; af += tf; ab += tb; of += (w < wave) ? tf : 0.f; ob += (w > wave) ? tb : 0.f; }
#pragma unroll
    for (int r = 0; r < 8; ++r) { cumf[r] += of; cumb[r] += ob; }
    allf = af; allb = ab;
}
__device__ __forceinline__ void chunk_cums(LAS unsigned char* L, const float* GF, const float* GB, size_t tok0, int h, int wave, int lane, float (&cumf)[8], float (&cumb)[8], float& allf, float& allb) {
    float gf[8], gb[8];
#pragma unroll
    for (int r = 0; r < 8; ++r) { const size_t o = (tok0 + 8 * wave + r) * 256 + h * 64 + lane; gf[r] = GF[o]; gb[r] = GB[o]; }
    chunk_cums_pre(L, gf, gb, wave, lane, cumf, cumb, allf, allb);
}
__device__ __forceinline__ void store_vt(LAS unsigned char* L, const u32x4 (&vr)[2], int tid) {
    LAS bf16_t* vt = (LAS bf16_t*)(L + L_VT);
    const int j = tid >> 3, c8 = tid & 7;
#pragma unroll
    for (int q = 0; q < 2; ++q) { const int dv0 = 8 * (c8 + 8 * q);
        const unsigned ww[4] = {vr[q].x, vr[q].y, vr[q].z, vr[q].w};
#pragma unroll
        for (int e = 0; e < 4; ++e) { vt[(dv0 + 2 * e) * RS + j] = (bf16_t)(ww[e] & 0xffffu); vt[(dv0 + 2 * e + 1) * RS + j] = (bf16_t)(ww[e] >> 16); } }
}
__device__ __forceinline__ void load_vt(LAS unsigned char* L, const bf16_t* V, size_t tok0, int h, int tid) {
    const int j = tid >> 3, c8 = tid & 7; u32x4 vr[2];
#pragma unroll
    for (int q = 0; q < 2; ++q) vr[q] = *(const u32x4*)(V + (tok0 + j) * 512 + h * 128 + 8 * (c8 + 8 * q));
    store_vt(L, vr, tid);
}

__device__ __forceinline__ void g1_unit(const Args& a, LAS unsigned char* L, int bh, int chunk  ) {
    const int tid = threadIdx.x, lane = tid & 63, wave = __builtin_amdgcn_readfirstlane(tid >> 6);
    const int b = bh >> 2, h = bh & 3;
    const size_t tok0 = chunk < NCHUNK ? (size_t)b * SEQ + (size_t)chunk * CH : (size_t)T + (size_t)b * CTXL + (size_t)(chunk - NCHUNK) * CH;
    const float* GF = (const float*)(a.ws + WS_GF); const float* GB = (const float*)(a.ws + WS_GB);
    const bf16_t* Kb = (const bf16_t*)(a.ws + WS_K); const bf16_t* Vb = (const bf16_t*)(a.ws + WS_V);
    float cumf[8], cumb[8], allf, allb;
    __syncthreads();
    chunk_cums(L, GF, GB, tok0, h, wave, lane, cumf, cumb, allf, allb);
    LAS bf16_t* ketf = (LAS bf16_t*)(L + L_T0); LAS bf16_t* ketb = (LAS bf16_t*)(L + L_T1);
#pragma unroll
    for (int r = 0; r < 8; ++r) { const int i = 8 * wave + r; const float kv = bf2f(Kb[(tok0 + i) * 256 + h * 64 + lane]);
        ketf[lane * RS + i] = f2bf(kv * __expf(allf - cumf[r])); ketb[lane * RS + i] = f2bf(kv * __expf(allb - cumb[r])); }
    load_vt(L, Vb, tok0, h, tid);
    if (wave == 0) { float* av = (float*)(a.ws + WS_AV); av[((size_t)(0 * 16 + bh) * NCT + chunk) * 64 + lane] = __expf(allf); av[((size_t)(1 * 16 + bh) * NCT + chunk) * 64 + lane] = __expf(allb); }
    __syncthreads();
    bf16_t* KV = (bf16_t*)(a.ws + WS_KV);
#pragma unroll
    for (int dir = 0; dir < 2; ++dir) {
        const LAS unsigned char* ket = L + (dir ? L_T1 : L_T0);
        bf16_t* dst = KV + ((size_t)(dir * 16 + bh) * NCT + chunk) * 8192;
#pragma unroll
        for (int nt = 0; nt < 4; ++nt) { f32x4 acc = {0.f, 0.f, 0.f, 0.f};
#pragma unroll
            for (int ks = 0; ks < 2; ++ks) acc = __builtin_amdgcn_mfma_f32_16x16x32_bf16(frag(L + L_VT, 16 * wave, 32 * ks, lane), frag(ket, 16 * nt, 32 * ks, lane), acc, 0, 0, 0);
#pragma unroll
            for (int r = 0; r < 4; ++r) dst[(16 * wave + 4 * (lane >> 4) + r) * 64 + 16 * nt + (lane & 15)] = f2bf(acc[r]); }
    }
}

__device__ __forceinline__ void g2_scan(const Args& a) {
    const bf16_t* KV = (const bf16_t*)(a.ws + WS_KV); const float* AV = (const float*)(a.ws + WS_AV); bf16_t* SP = (bf16_t*)(a.ws + WS_SP);
    for (int id = blockIdx.x * NTHREADS + threadIdx.x; id < 32 * 4096; id += gridDim.x * NTHREADS) {
        const int db = id >> 12, e2 = id & 4095, dir = db >> 4, dk = (2 * e2) & 63;
        const unsigned* kv = (const unsigned*)(KV + (size_t)db * NCT * 8192) + e2;
        const float* av = AV + (size_t)db * NCT * 64 + dk;
        unsigned* sp = (unsigned*)(SP + (size_t)db * NCHUNK * 8192) + e2;
        float s0 = 0.f, s1 = 0.f;
#pragma unroll
        for (int q = 0; q < NCC; ++q) { const int c = NCHUNK + (dir ? (NCC - 1 - q) : q);
            const unsigned w = kv[(size_t)c * 4096]; const f32x2 aa = *(const f32x2*)(av + (size_t)c * 64);
            s0 = aa[0] * s0 + bflo(w); s1 = aa[1] * s1 + bfhi(w); }
        for (int q0 = 0; q0 < NCHUNK; q0 += 16) {
            unsigned w[16]; f32x2 aa[16];
#pragma unroll
            for (int u = 0; u < 16; ++u) { const int c = dir ? (NCHUNK - 1 - (q0 + u)) : (q0 + u); w[u] = kv[(size_t)c * 4096]; aa[u] = *(const f32x2*)(av + (size_t)c * 64); }
#pragma unroll
            for (int u = 0; u < 16; ++u) { const int c = dir ? (NCHUNK - 1 - (q0 + u)) : (q0 + u);
                sp[(size_t)c * 4096] = pk2(s0, s1);
                s0 = aa[u][0] * s0 + bflo(w[u]); s1 = aa[u][1] * s1 + bfhi(w[u]); }
        }
    }
}

struct G3In { float gf[8], gb[8]; bf16_t q[8], k[8]; u32x4 v[2]; u32x4 sraw[4]; bf16_t gr[4][4]; };
__device__ __forceinline__ void g3_load(const Args& a, int bh, int chunk, G3In& in) {
    const int tid = threadIdx.x, lane = tid & 63, wave = __builtin_amdgcn_readfirstlane(tid >> 6);
    const int b = bh >> 2, h = bh & 3;
    const size_t tok0 = (size_t)b * SEQ + (size_t)chunk * CH;
    const float* GF = (const float*)(a.ws + WS_GF); const float* GB = (const float*)(a.ws + WS_GB);
    const bf16_t* Qb = (const bf16_t*)(a.ws + WS_Q); const bf16_t* Kb = (const bf16_t*)(a.ws + WS_K); const bf16_t* Vb = (const bf16_t*)(a.ws + WS_V);
#pragma unroll
    for (int r = 0; r < 8; ++r) { const size_t o = (tok0 + 8 * wave + r) * 256 + h * 64 + lane; in.gf[r] = GF[o]; in.gb[r] = GB[o]; in.q[r] = Qb[o]; in.k[r] = Kb[o]; }
#pragma unroll
    for (int q = 0; q < 2; ++q) in.v[q] = *(const u32x4*)(Vb + (tok0 + (tid >> 3)) * 512 + h * 128 + 8 * ((tid & 7) + 8 * q));
    const bf16_t* SPf = (const bf16_t*)(a.ws + WS_SP) + ((size_t)(0 * 16 + bh) * NCHUNK + chunk) * 8192;
    const bf16_t* SPb = (const bf16_t*)(a.ws + WS_SP) + ((size_t)(1 * 16 + bh) * NCHUNK + chunk) * 8192;
    in.sraw[0] = *(const u32x4*)(SPf + 16 * tid); in.sraw[1] = *(const u32x4*)(SPf + 16 * tid + 8);
    in.sraw[2] = *(const u32x4*)(SPb + 16 * tid); in.sraw[3] = *(const u32x4*)(SPb + 16 * tid + 8);
    const bf16_t* Gt = (const bf16_t*)(a.ws + WS_G);
    const int mt = wave >> 1, fr = lane & 15, fq = lane >> 4;
#pragma unroll
    for (int q = 0; q < 4; ++q)
#pragma unroll
        for (int r = 0; r < 4; ++r) in.gr[r][q] = Gt[(tok0 + 16 * mt + 4 * fq + r) * 512 + h * 128 + 16 * (4 * (wave & 1) + q) + fr];
}
__device__ __forceinline__ void g3_unit(const Args& a, LAS unsigned char* L, int bh, int chunk  , const G3In& in) {
    const int tid = threadIdx.x, lane = tid & 63, wave = __builtin_amdgcn_readfirstlane(tid >> 6);
    const int b = bh >> 2, h = bh & 3;
    const size_t tok0 = (size_t)b * SEQ + (size_t)chunk * CH;
    const int mt = wave >> 1, fr = lane & 15, fq = lane >> 4;
    float cumf[8], cumb[8], allf, allb;
    __syncthreads();
    chunk_cums_pre(L, in.gf, in.gb, wave, lane, cumf, cumb, allf, allb);
    LAS bf16_t* qf = (LAS bf16_t*)(L + L_T0); LAS bf16_t* kf = (LAS bf16_t*)(L + L_T1); LAS bf16_t* qb = (LAS bf16_t*)(L + L_T2); LAS bf16_t* kb = (LAS bf16_t*)(L + L_T3);
#pragma unroll
    for (int r = 0; r < 8; ++r) { const int i = 8 * wave + r;
        const float qv = bf2f(in.q[r]), kv = bf2f(in.k[r]);
        qf[i * RS + lane] = f2bf(qv * __expf(cumf[r])); kf[i * RS + lane] = f2bf(kv * __expf(-cumf[r]));
        qb[i * RS + lane] = f2bf(qv * __expf(cumb[r])); kb[i * RS + lane] = f2bf(kv * __expf(-cumb[r])); }
    store_vt(L, in.v, tid);
    {
      LAS unsigned char* sf_ = L + L_SF + ((tid >> 2) * RS + 16 * (tid & 3)) * 2; LAS unsigned char* sb_ = L + L_SB + ((tid >> 2) * RS + 16 * (tid & 3)) * 2;
      *(LAS u32x4*)sf_ = in.sraw[0]; *(LAS u32x4*)(sf_ + 16) = in.sraw[1]; *(LAS u32x4*)sb_ = in.sraw[2]; *(LAS u32x4*)(sb_ + 16) = in.sraw[3]; }
    __syncthreads();
    {
        LAS bf16_t* P = (LAS bf16_t*)(L + L_P);
#pragma unroll
        for (int q = 0; q < 2; ++q) { const int nt = 2 * (wave & 1) + q;
            f32x4 sf = {0.f, 0.f, 0.f, 0.f}, sb = {0.f, 0.f, 0.f, 0.f};
#pragma unroll
            for (int ks = 0; ks < 2; ++ks) {
                sf = __builtin_amdgcn_mfma_f32_16x16x32_bf16(frag(L + L_T0, 16 * mt, 32 * ks, lane), frag(L + L_T1, 16 * nt, 32 * ks, lane), sf, 0, 0, 0);
                sb = __builtin_amdgcn_mfma_f32_16x16x32_bf16(frag(L + L_T2, 16 * mt, 32 * ks, lane), frag(L + L_T3, 16 * nt, 32 * ks, lane), sb, 0, 0, 0); }
#pragma unroll
            for (int r = 0; r < 4; ++r) { const int i = 16 * mt + 4 * fq + r, j = 16 * nt + fr;
                P[i * RS + j] = f2bf((j <= i ? sf[r] : 0.f) + (j >= i ? sb[r] : 0.f)); } }
    }
    __syncthreads();
    f32x4 o[4]; float ssq[4] = {0.f, 0.f, 0.f, 0.f};
#pragma unroll
    for (int q = 0; q < 4; ++q) { const int nt = 4 * (wave & 1) + q;
        f32x4 acc = {0.f, 0.f, 0.f, 0.f};
#pragma unroll
        for (int ks = 0; ks < 2; ++ks) {
            acc = __builtin_amdgcn_mfma_f32_16x16x32_bf16(frag(L + L_P, 16 * mt, 32 * ks, lane), frag(L + L_VT, 16 * nt, 32 * ks, lane), acc, 0, 0, 0);
            acc = __builtin_amdgcn_mfma_f32_16x16x32_bf16(frag(L + L_T0, 16 * mt, 32 * ks, lane), frag(L + L_SF, 16 * nt, 32 * ks, lane), acc, 0, 0, 0);
            acc = __builtin_amdgcn_mfma_f32_16x16x32_bf16(frag(L + L_T2, 16 * mt, 32 * ks, lane), frag(L + L_SB, 16 * nt, 32 * ks, lane), acc, 0, 0, 0); }
        o[q] = acc;
#pragma unroll
        for (int r = 0; r < 4; ++r) ssq[r] += acc[r] * acc[r]; }
    LAS float* SSQ = (LAS float*)(L + L_SSQ);
#pragma unroll
    for (int r = 0; r < 4; ++r) { float s = ssq[r]; s += __shfl_xor(s, 1); s += __shfl_xor(s, 2); s += __shfl_xor(s, 4); s += __shfl_xor(s, 8); ssq[r] = s; }
    if (fr == 0) {
#pragma unroll
        for (int r = 0; r < 4; ++r) SSQ[(wave & 1) * 64 + 16 * mt + 4 * fq + r] = ssq[r]; }
    __syncthreads();
    const float* ng = a.in[I_NORMG];
    bf16_t* mix = (bf16_t*)(a.ws + WS_MIX);
#pragma unroll
    for (int r = 0; r < 4; ++r) { const int i = 16 * mt + 4 * fq + r;
        const float rstd = 1.f / sqrtf((SSQ[i] + SSQ[64 + i]) * (1.f / DV) + LN_EPS);
#pragma unroll
        for (int q = 0; q < 4; ++q) { const int dv = 16 * (4 * (wave & 1) + q) + fr;
            const float g = bf2f(in.gr[r][q]);
            mix[(tok0 + i) * 1024 + h * 128 + dv] = f2bf(o[q][r] * rstd * ng[dv] * silu_f(g)); } }
}
}

namespace rt {
constexpr int HS = 1028;
constexpr int L_H2 = 0;
constexpr int L_PART = 65792;
constexpr int L_LCNT = L_PART + 16384;
constexpr int L_REC = L_LCNT + 256;

__device__ __forceinline__ void phase(const Args& a, LAS unsigned char* lds) {
    const int tid = threadIdx.x, lane = tid & 63, wave = __builtin_amdgcn_readfirstlane(tid >> 6);
    bf16_t* xmid = (bf16_t*)(a.ws + WS_PRE1); bf16_t* H2 = (bf16_t*)(a.ws + WS_H2); const bf16_t* FG = (const bf16_t*)(a.ws + WS_FG);
    const float* mod = (const float*)(a.ws + WS_MOD);
    const float* rw = a.in[I_RW]; const float* rb = a.in[I_RB];
    LAS float* h2s = (LAS float*)(lds + L_H2); LAS float* part = (LAS float*)(lds + L_PART);
    LAS int* lcnt = (LAS int*)(lds + L_LCNT); LAS int* lbase = lcnt + 32; LAS int* rec = (LAS int*)(lds + L_REC);
    unsigned* cnt = (unsigned*)(a.ws + WS_CNT); int* list = (int*)(a.ws + WS_LIST); float* pw = (float*)(a.ws + WS_PW); int* ploc = (int*)(a.ws + WS_PLOC);
    float rwr[32][2];
#pragma unroll
    for (int s = 0; s < 32; ++s)
#pragma unroll
        for (int nt = 0; nt < 2; ++nt) rwr[s][nt] = rw[(size_t)(128 * wave + 4 * s + (lane >> 4)) * 32 + 16 * nt + (lane & 15)];
    const f32x4* g1 = (const f32x4*)a.in[I_LN1G]; const f32x4* bb1 = (const f32x4*)a.in[I_LN1B];
    if (tid < 32) lcnt[tid] = 0;
    f32x4 xq[2][4]; u32x2 fq_[2][4];
#define RT_LOAD(g_) do { _Pragma("unroll") for (int rr = 0; rr < 2; ++rr) { const int t_ = (g_) * 16 + 2 * wave + rr; \
        const f32x4* xr_ = (const f32x4*)(a.in[I_X] + (size_t)t_ * D) + lane; const u32x2* fr_ = (const u32x2*)(FG + (size_t)t_ * D) + lane; \
        _Pragma("unroll") for (int j = 0; j < 4; ++j) { xq[rr][j] = xr_[64 * j]; fq_[rr][j] = fr_[64 * j]; } } } while (0)
    if ((int)blockIdx.x < T / 16) RT_LOAD((int)blockIdx.x);
    for (int grp = blockIdx.x; grp < T / 16; grp += gridDim.x) {
        __syncthreads();
        f32x4 xv_[2][4]; u32x2 fv_[2][4];
#pragma unroll
        for (int rr = 0; rr < 2; ++rr)
#pragma unroll
            for (int j = 0; j < 4; ++j) { xv_[rr][j] = xq[rr][j]; fv_[rr][j] = fq_[rr][j]; }
        if (grp + (int)gridDim.x < T / 16) RT_LOAD(grp + (int)gridDim.x);
#pragma unroll
        for (int rr = 0; rr < 2; ++rr) {
            const int lr = 2 * wave + rr, t = grp * 16 + lr, b = t >> 13;
            u32x2* pr = (u32x2*)(xmid + (size_t)t * D) + lane;
            f32x4 v[4]; float s = 0.f;
#pragma unroll
            for (int j = 0; j < 4; ++j) { const u32x2 fw = fv_[rr][j]; const f32x4 ff = {bflo(fw.x), bfhi(fw.x), bflo(fw.y), bfhi(fw.y)};
                v[j] = xv_[rr][j] * ALPHA + ff; s += (v[j][0] + v[j][1]) + (v[j][2] + v[j][3]); }
            float mean = wave_sum(s) * (1.f / D), s2 = 0.f;
#pragma unroll
            for (int j = 0; j < 4; ++j) { v[j] = v[j] - mean; s2 += (v[j][0] * v[j][0] + v[j][1] * v[j][1]) + (v[j][2] * v[j][2] + v[j][3] * v[j][3]); }
            float rstd = 1.f / sqrtf(wave_sum(s2) * (1.f / D) + LN_EPS);
            s = 0.f;
#pragma unroll
            for (int j = 0; j < 4; ++j) { v[j] = v[j] * rstd * g1[64 * j + lane] + bb1[64 * j + lane]; u32x2 w; w.x = pk2(v[j][0], v[j][1]); w.y = pk2(v[j][2], v[j][3]); pr[64 * j] = w;
                v[j] = (f32x4){bflo(w.x), bfhi(w.x), bflo(w.y), bfhi(w.y)}; s += (v[j][0] + v[j][1]) + (v[j][2] + v[j][3]); }
            mean = wave_sum(s) * (1.f / D); s2 = 0.f;
#pragma unroll
            for (int j = 0; j < 4; ++j) { v[j] = v[j] - mean; s2 += (v[j][0] * v[j][0] + v[j][1] * v[j][1]) + (v[j][2] * v[j][2] + v[j][3] * v[j][3]); }
            rstd = 1.f / sqrtf(wave_sum(s2) * (1.f / D) + LN_EPS);
            const f32x4* sh = (const f32x4*)(mod + b * 6144 + 3 * 1024); const f32x4* sc = (const f32x4*)(mod + b * 6144 + 4 * 1024);
            unsigned* o4 = (unsigned*)((unsigned char*)H2 + (size_t)t * D) + lane;
#pragma unroll
            for (int j = 0; j < 4; ++j) { const f32x4 y = v[j] * rstd * (sc[64 * j + lane] + 1.f) + sh[64 * j + lane];
                o4[64 * j] = gm::pk4_fp8(y[0] * gm::S_H2, y[1] * gm::S_H2, y[2] * gm::S_H2, y[3] * gm::S_H2);
                *(LAS f32x4*)(h2s + lr * HS + 256 * j + 4 * lane) = y; }
        }
        __syncthreads();
        {
            f32x4 acc0 = {0.f, 0.f, 0.f, 0.f}, acc1 = {0.f, 0.f, 0.f, 0.f};
            const LAS float* ap = h2s + (lane & 15) * HS + 128 * wave + (lane >> 4);
#pragma unroll
            for (int s = 0; s < 32; ++s) { const float av = ap[4 * s];
                acc0 = __builtin_amdgcn_mfma_f32_16x16x4f32(av, rwr[s][0], acc0, 0, 0, 0);
                acc1 = __builtin_amdgcn_mfma_f32_16x16x4f32(av, rwr[s][1], acc1, 0, 0, 0); }
#pragma unroll
            for (int r = 0; r < 4; ++r) { part[(wave * 16 + 4 * (lane >> 4) + r) * 32 + (lane & 15)] = acc0[r]; part[(wave * 16 + 4 * (lane >> 4) + r) * 32 + 16 + (lane & 15)] = acc1[r]; }
        }
        __syncthreads();
        {
            const int lr = 2 * wave + (lane >> 5), e = lane & 31, t = grp * 16 + lr;
            float lg = rb[e];
#pragma unroll
            for (int w = 0; w < 8; ++w) lg += part[(w * 16 + lr) * 32 + e];
            float cur = lg, tv[4]; int ti[4];
#pragma unroll
            for (int k = 0; k < 4; ++k) { float bv = cur; int bi = e;
#pragma unroll
                for (int o = 1; o < 32; o <<= 1) { const float ov = __shfl_xor(bv, o); const int oi = __shfl_xor(bi, o); if (ov > bv || (ov == bv && oi < bi)) { bv = ov; bi = oi; } }
                tv[k] = bv; ti[k] = bi; if (bi == e) cur = -3.0e38f; }
            const float e1 = __expf(tv[1] - tv[0]), e2 = __expf(tv[2] - tv[0]), e3 = __expf(tv[3] - tv[0]);
            const float inv = 1.f / (1.f + e1 + e2 + e3);
            if (e < 4) { const float wk = (e == 0 ? 1.f : (e == 1 ? e1 : (e == 2 ? e2 : e3))) * inv; const int ek = (e == 0 ? ti[0] : (e == 1 ? ti[1] : (e == 2 ? ti[2] : ti[3])));
                const int pair = t * 4 + e;
                pw[pair] = wk;
                const int rank = __hip_atomic_fetch_add((LAS int*)&lcnt[ek], 1, __ATOMIC_RELAXED, __HIP_MEMORY_SCOPE_WORKGROUP);
                rec[lr * 4 + e] = ek | (rank << 8); }
        }
        __syncthreads();
        if (tid < 32) { const int n = lcnt[tid]; lbase[tid] = n ? (int)atomicAdd(&cnt[tid], (unsigned)n) : 0; }
        __syncthreads();
        if (tid < 64) { const int rc = rec[tid], ek = rc & 255, rank = rc >> 8, pos = lbase[ek] + rank, pair = (grp * 16 + (tid >> 2)) * 4 + (tid & 3);
            list[(size_t)ek * CAP + pos] = pair; ploc[pair] = ek | (pos << 5); }
        __syncthreads();
        if (tid < 32) lcnt[tid] = 0;
    }
#undef RT_LOAD
}
}

__device__ __forceinline__ void p_final(const Args& a, LAS unsigned char* lds) {
    const int tid = threadIdx.x, lane = tid & 63, wave = tid >> 6;
    const bf16_t* xm = (const bf16_t*)(a.ws + WS_PRE1); const unsigned char* slots = (const unsigned char*)(a.ws + WS_SLOTS); const float* mod = (const float*)(a.ws + WS_MOD);
    const int* ploc = (const int*)(a.ws + WS_PLOC); const float* pw = (const float*)(a.ws + WS_PW);
    const f32x4* g2 = (const f32x4*)a.in[I_LN2G]; const f32x4* b2 = (const f32x4*)a.in[I_LN2B];
    LAS int* tstart = (LAS int*)lds;
    __syncthreads();
    if (tid == 0) { const unsigned* cnt = (const unsigned*)(a.ws + WS_CNT); int nrt = 0; for (int e = 0; e < NE; ++e) { tstart[e] = 256 * nrt; nrt += ((int)cnt[e] + 255) >> 8; } }
    __syncthreads();
    const int tstep = gridDim.x * NWAVES; int t = blockIdx.x * NWAVES + wave;
    if (t < T) {
        int plc[4], pln[4]; float wc_[4], wn_[4]; unsigned qc[4][4], qn[4][4]; u32x2 xc[4], xn[4];
#define PF_IDX(tt, pl, ww) do { _Pragma("unroll") for (int sl = 0; sl < 4; ++sl) { pl[sl] = ploc[(tt) * 4 + sl]; ww[sl] = pw[(tt) * 4 + sl] * (1.f / gm::S_SL); } } while (0)
#define PF_DATA(tt, pl, qq, xx) do { _Pragma("unroll") for (int sl = 0; sl < 4; ++sl) { const unsigned* sr_ = (const unsigned*)(slots + (size_t)(tstart[pl[sl] & 31] + (pl[sl] >> 5)) * D) + lane; \
            _Pragma("unroll") for (int j = 0; j < 4; ++j) qq[sl][j] = sr_[64 * j]; } \
        { const u32x2* xr_ = (const u32x2*)(xm + (size_t)(tt) * D) + lane; _Pragma("unroll") for (int j = 0; j < 4; ++j) xx[j] = xr_[64 * j]; } } while (0)
        PF_IDX(t, plc, wc_); PF_DATA(t, plc, qc, xc);
        int tn = t + tstep; const bool hn0 = tn < T;
        if (hn0) PF_IDX(tn, pln, wn_);
        for (;;) {
            const bool hn = tn < T;
            if (hn) PF_DATA(tn, pln, qn, xn);
            int pl2[4]; float w2[4]; const int tn2 = tn + tstep; const bool hn2 = hn && tn2 < T;
            if (hn2) PF_IDX(tn2, pl2, w2);
            {
                const int b = t >> 13; const f32x4* gt = (const f32x4*)(mod + b * 6144 + 5 * 1024);
                f32x4 v[4]; float s = 0.f;
#pragma unroll
                for (int j = 0; j < 4; ++j) { f32x4 y = {0.f, 0.f, 0.f, 0.f};
#pragma unroll
                    for (int sl = 0; sl < 4; ++sl) { const int q = (int)qc[sl][j];
                        y[0] += wc_[sl] * __builtin_amdgcn_cvt_f32_fp8(q, 0); y[1] += wc_[sl] * __builtin_amdgcn_cvt_f32_fp8(q, 1); y[2] += wc_[sl] * __builtin_amdgcn_cvt_f32_fp8(q, 2); y[3] += wc_[sl] * __builtin_amdgcn_cvt_f32_fp8(q, 3); }
                    const f32x4 xv = {bflo(xc[j].x), bfhi(xc[j].x), bflo(xc[j].y), bfhi(xc[j].y)};
                    v[j] = xv * ALPHA + gt[64 * j + lane] * y; s += (v[j][0] + v[j][1]) + (v[j][2] + v[j][3]); }
                const float mean = wave_sum(s) * (1.f / D); float s2 = 0.f;
#pragma unroll
                for (int j = 0; j < 4; ++j) { v[j] = v[j] - mean; s2 += (v[j][0] * v[j][0] + v[j][1] * v[j][1]) + (v[j][2] * v[j][2] + v[j][3] * v[j][3]); }
                const float rstd = 1.f / sqrtf(wave_sum(s2) * (1.f / D) + LN_EPS);
                f32x4* o = (f32x4*)(a.out + (size_t)t * D) + lane;
#pragma unroll
                for (int j = 0; j < 4; ++j) o[64 * j] = v[j] * rstd * g2[64 * j + lane] + b2[64 * j + lane];
            }
            if (!hn) break;
            t = tn; tn = tn2;
#pragma unroll
            for (int sl = 0; sl < 4; ++sl) { plc[sl] = pln[sl]; wc_[sl] = wn_[sl]; pln[sl] = pl2[sl]; wn_[sl] = w2[sl];
#pragma unroll
                for (int j = 0; j < 4; ++j) qc[sl][j] = qn[sl][j]; }
#pragma unroll
            for (int j = 0; j < 4; ++j) xc[j] = xn[j];
        }
#undef PF_IDX
#undef PF_DATA
    }
}


constexpr int N_PHASES = 11;
__global__ void __launch_bounds__(NTHREADS, 2) mega_fwd(Args a) {
    extern __shared__ __attribute__((aligned(16))) unsigned char lds_raw[];
    LAS unsigned char* lds = (LAS unsigned char*)lds_raw;
    const int tid = threadIdx.x;
    volatile LAS unsigned* misc = (volatile LAS unsigned*)(lds + LDS_MISC);
    if (tid < 4) misc[tid] = 0u;
    __syncthreads();
    XcdBarrier bar; bar.bar = (unsigned*)(a.ws + WS_BAR); bar.x = 0; bar.st = misc;
    const bool multi = (a.ph_hi - a.ph_lo) > 1;
    if (multi) bar = xcd_barrier_post((unsigned*)(a.ws + WS_BAR), misc);
    const int lo = a.ph_lo, hi = a.ph_hi;
#define vcu ((gridDim.x % 8 == 0) ? (int)((blockIdx.x % 8) * (gridDim.x / 8) + blockIdx.x / 8) : (int)blockIdx.x)
#ifdef ONLY_PHASE
#define IN(k) ((k) == ONLY_PHASE && lo <= (k) && (k) < hi)
#else
#define IN(k) (lo <= (k) && (k) < hi)
#endif
#define SEAM(k) do { if (IN(k) && IN((k) + 1)) xcd_barrier(bar); } while (0)

#ifndef REPEAT_PHASE
#define REPEAT_PHASE -1
#endif
#ifdef PROF_REP
#define RUNPH(k, ...) do { if (IN(k)) { const int nrep_ = (a.rep_k == (k)) ? 2 : 1; for (int rep_ = 0; rep_ < nrep_; ++rep_) { if (rep_) xcd_barrier(bar); __VA_ARGS__; } } } while (0)
#else
#define RUNPH(k, ...) do { if (IN(k)) { __VA_ARGS__; if (REPEAT_PHASE == (k)) { xcd_barrier(bar); __VA_ARGS__; } } } while (0)
#endif
    RUNPH(0, p0_mod_and_filter(a, lds));
    SEAM(0);
    RUNPH(1, p1_prep(a, lds));
    SEAM(1);
    RUNPH(2, { gm::SchedIn S{a.ws, (int)gridDim.x, vcu, a.in[I_BAF], a.in[I_BAB]}; gm::EpiIn E{a.ws}; gm::gemm_stream<false, 0, false>(lds, S, E);
        {
          const int G = (int)gridDim.x, rounds = (1812 + G - 1) / G, extra = 1812 - (rounds - 1) * G, v = vcu;
          if (v >= extra || extra == G) { const int nidle = (extra == G) ? G : G - extra, ridle = (extra == G) ? v : v - extra; __syncthreads();
              prep_items(a, (LAS float*)(lds + (tid >> 6) * 16384), PREP_NITEMS - PREP_DEFER, PREP_NITEMS, ridle * NWAVES + (tid >> 6), nidle * NWAVES, tid & 63); } } });
    SEAM(2);
    RUNPH(3, { for (int u = blockIdx.x; u < 16 * NCT; u += gridDim.x) gla::g1_unit(a, lds, u / NCT, u % NCT); });
    SEAM(3);
    RUNPH(4, { gla::g2_scan(a);
        for (int c = blockIdx.x; c < HYW; c += gridDim.x) hy::channel(a, lds, c, a.ws + WS_HSPEC + (size_t)blockIdx.x * HSPEC_PER_WG); });
    SEAM(4);
    RUNPH(5, { { int u = blockIdx.x; gla::G3In cur, nxt;
            if (u < 16 * NCHUNK) { gla::g3_load(a, u >> 7, u & 127, cur);
                for (;;) { const int un = u + (int)gridDim.x; const bool hn = un < 16 * NCHUNK; if (hn) gla::g3_load(a, un >> 7, un & 127, nxt);
                    gla::g3_unit(a, lds, u >> 7, u & 127, cur); if (!hn) break; cur = nxt; u = un; } } }
        const int wave = tid >> 6;
        for (int it = blockIdx.x * NWAVES + wave; it < 4096; it += gridDim.x * NWAVES) hy::transpose_item(a, it, tid & 63); });
    SEAM(5);
    RUNPH(6, { gm::SchedOut S{a.ws, (int)gridDim.x, vcu}; gm::EpiOut E{a.ws}; gm::gemm_stream<false, 0, false>(lds, S, E); });
    SEAM(6);
    RUNPH(7, rt::phase(a, lds));
    SEAM(7);
    if (IN(8) || IN(9)) {
        LAS int* tab = (LAS int*)(lds + gm::LDS_TAB);
        __syncthreads();
        if (tid == 0) { const unsigned* cnt = (const unsigned*)(a.ws + WS_CNT); int nrt = 0;
            for (int e = 0; e < NE; ++e) { const int n = (int)cnt[e]; tab[e] = n; const int nt = (n + 255) >> 8; for (int k = 0; k < nt; ++k) tab[64 + nrt + k] = e | (k << 8); nrt += nt; }
            tab[32] = nrt; }
        __syncthreads();
    }
    RUNPH(8, { gm::SchedMoe<1> S{a.ws, (const LAS int*)(lds + gm::LDS_TAB), (int)gridDim.x, vcu, a.in[I_EB2]}; gm::EpiMoe1 E{a.ws}; gm::gemm_stream<true, 2, true>(lds, S, E); });
    SEAM(8);
    RUNPH(9, { gm::SchedMoe<2> S{a.ws, (const LAS int*)(lds + gm::LDS_TAB), (int)gridDim.x, vcu, a.in[I_EB2]}; gm::EpiMoe2 E{a.ws}; gm::gemm_stream<false, 0, true>(lds, S, E); });
    SEAM(9);
    RUNPH(10, p_final(a, lds));
#undef RUNPH
#undef vcu
#undef IN
#undef SEAM
}

extern "C" void kernel_launch(void* const* d_in, const int* in_sizes, int n_in, void* d_out, int out_size, void* d_ws, size_t ws_size, hipStream_t stream) {
    static int grid = 0;
    if (grid == 0) {
        if (n_in != 32 || out_size != T * D || ws_size < WS_END) { fprintf(stderr, "kernel_launch: unexpected shapes (n_in %d out %d ws %zu need %zu)\n", n_in, out_size, ws_size, (size_t)WS_END); grid = -1; return; }
        int dev = 0, cus = 0;
        if (hipGetDevice(&dev) != hipSuccess || hipDeviceGetAttribute(&cus, hipDeviceAttributeMultiprocessorCount, dev) != hipSuccess) { grid = -1; return; }
        if (hipFuncSetAttribute((const void*)mega_fwd, hipFuncAttributeMaxDynamicSharedMemorySize, LDS_BYTES) != hipSuccess) { fprintf(stderr, "kernel_launch: hipFuncSetAttribute failed\n"); grid = -1; return; }
        int per_cu = 0;
        if (hipOccupancyMaxActiveBlocksPerMultiprocessor(&per_cu, (const void*)mega_fwd, NTHREADS, LDS_BYTES) != hipSuccess || per_cu < 1) fprintf(stderr, "kernel_launch: occupancy query says %d\n", per_cu);
        (void)hipGetLastError();
        grid = cus;
        if (grid > MAX_GRID) grid = MAX_GRID;
    }
    if (grid < 0) return;
    (void)hipMemsetAsync(d_ws, 0, WS_ZERO_BYTES, stream);
    Args a{};
    for (int i = 0; i < 32; ++i) a.in[i] = (const float*)d_in[i];
    a.out = (float*)d_out; a.ws = (unsigned char*)d_ws;
#ifdef DBG
    (void)hipMemsetAsync((char*)d_ws + WS_DBG, 0, 512, stream);
    for (int p = 0; p < N_PHASES; ++p) { a.ph_lo = p; a.ph_hi = p + 1; hipLaunchKernelGGL(mega_fwd, dim3(grid), dim3(NTHREADS), LDS_BYTES, stream, a);
        hipLaunchKernelGGL(dbg_check, dim3(64), dim3(512), 0, stream, a, p); }
    hipLaunchKernelGGL(dbg_encode, dim3(1024), dim3(256), 0, stream, a);
#elif N_LAUNCH_PER_PHASE
    for (int p = 0; p < N_PHASES; ++p) { a.ph_lo = p; a.ph_hi = p + 1; hipLaunchKernelGGL(mega_fwd, dim3(grid), dim3(NTHREADS), LDS_BYTES, stream, a); }
#else
    a.ph_lo = 0; a.ph_hi = N_PHASES;
#ifdef PROF_REP
    a.rep_k = PROF_REP;
#endif
    hipLaunchKernelGGL(mega_fwd, dim3(grid), dim3(NTHREADS), LDS_BYTES, stream, a);
#endif
}
```

```cpp
#include <hip/hip_runtime.h>
#include <cstdio>
#include <cstdint>
#include <cstddef>

#define LAS __attribute__((address_space(3)))
#define GAS __attribute__((address_space(1)))
typedef unsigned short bf16_t;
typedef short bf16x8 __attribute__((ext_vector_type(8)));
typedef float f32x4 __attribute__((ext_vector_type(4)));
typedef float f32x2 __attribute__((ext_vector_type(2)));
typedef unsigned u32x4 __attribute__((ext_vector_type(4)));
typedef unsigned u32x2 __attribute__((ext_vector_type(2)));

#ifndef N_LAUNCH_PER_PHASE
#define N_LAUNCH_PER_PHASE 0
#endif

constexpr int D = 1024, NB = 4, SEQ = 8192, T = NB * SEQ, CTXL = 256, TC = NB * CTXL, TT = T + TC;
constexpr int NH = 4, DK = 64, DV = 128, CH = 64, NCHUNK = SEQ / CH, NCC = CTXL / CH, NCT = NCHUNK + NCC;
constexpr int HYW = 512, HYC = 3 * HYW, INW = 3104;
constexpr int NE = 32, DE = 1024, CAP = T;
constexpr float LN_EPS = 1e-6f, ALPHA = 1.189207115002721f;
constexpr int NTHREADS = 512, NWAVES = 8;
constexpr int FFTN = 16384;

constexpr size_t al256(size_t x) { return (x + 255) & ~(size_t)255; }
constexpr size_t WS_BAR   = 0;
constexpr size_t WS_MOD   = 16384;
constexpr size_t WS_CNT   = WS_MOD + 5 * 6144 * 4;
constexpr size_t WS_ZERO_BYTES = al256(WS_CNT + 256);
constexpr size_t WS_LIST  = 262144;
constexpr size_t WS_PW    = WS_LIST + (size_t)NE * CAP * 4;
constexpr size_t WS_PLOC  = WS_PW + (size_t)T * 4 * 4;
constexpr size_t WS_B1R   = WS_PLOC + (size_t)T * 4 * 4;
constexpr size_t WS_HID2  = WS_B1R + (size_t)NE * 2048 * 4;
constexpr size_t WS_BTIN  = WS_HID2 + (size_t)SEQ * 64 * 4;
constexpr size_t WS_BTOUT = WS_BTIN + (size_t)3584 * 1024 * 2;
constexpr size_t WS_W1T   = WS_BTOUT + (size_t)1024 * 1024 * 2;
constexpr size_t WS_W2T   = WS_W1T + (size_t)NE * 2048 * 1024 * 2;
constexpr size_t WS_PRE1  = WS_W2T + (size_t)NE * 1024 * 1024 * 2;
constexpr size_t WS_RA    = WS_PRE1 + (size_t)T * 1024 * 4;
constexpr size_t WS_H     = WS_RA;
constexpr size_t WS_Q     = WS_H + (size_t)TT * 1024 * 2;
constexpr size_t WS_K     = WS_Q + (size_t)T * 256 * 2;
constexpr size_t WS_V     = WS_K + (size_t)TT * 256 * 2;
constexpr size_t WS_G     = WS_V + (size_t)TT * 512 * 2;
constexpr size_t WS_GF    = WS_G + (size_t)T * 512 * 2;
constexpr size_t WS_GB    = WS_GF + (size_t)TT * 256 * 4;
constexpr size_t WS_UT    = WS_GB + (size_t)TT * 256 * 4;
constexpr size_t WS_RA_END= WS_UT + (size_t)NB * HYC * SEQ * 2;
constexpr size_t WS_H2    = WS_RA;
constexpr size_t WS_FG    = WS_RA + (size_t)T * 1024 * 2;
constexpr size_t WS_SLOTS = WS_RA;
constexpr size_t SORTED_BYTES_ = (size_t)(T * 4 / 256 + NE) * 256 * 1024 * 2;
constexpr size_t WS_RB    = al256(WS_RA_END > WS_RA + SORTED_BYTES_ ? WS_RA_END : WS_RA + SORTED_BYTES_);
constexpr size_t WS_KV    = WS_RB;
constexpr size_t WS_AV    = WS_KV + (size_t)2 * 16 * NCT * 8192 * 2;
constexpr size_t WS_SP    = WS_AV + (size_t)2 * 16 * NCT * 64 * 4;
constexpr size_t WS_HSPEC = WS_SP + (size_t)2 * 16 * NCHUNK * 8192 * 2;
constexpr size_t HSPEC_PER_WG = (size_t)2 * FFTN * 8;
constexpr int MAX_GRID = 256;
constexpr size_t WS_YHYT  = WS_HSPEC + (size_t)MAX_GRID * HSPEC_PER_WG;
constexpr size_t WS_MIX   = WS_YHYT + (size_t)NB * HYW * SEQ * 2;
constexpr size_t WS_RB_END= WS_MIX + (size_t)T * 1024 * 2;
constexpr size_t WS_HF    = WS_MIX;
constexpr size_t WS_ACT   = WS_RB;
constexpr size_t SORTED_BYTES = (size_t)(T * 4 / 256 + NE) * 256 * 1024 * 2;
constexpr size_t WS_END   = al256(WS_RB_END > WS_RB + SORTED_BYTES ? WS_RB_END : WS_RB + SORTED_BYTES);

constexpr int LDS_BYTES = 147456;
constexpr int LDS_MISC  = 145408;

typedef __bf16 bf16n2 __attribute__((ext_vector_type(2)));
__device__ __forceinline__ unsigned pk2(float lo, float hi) { bf16n2 v = {(__bf16)lo, (__bf16)hi}; return __builtin_bit_cast(unsigned, v); }
__device__ __forceinline__ bf16_t f2bf(float f) { __bf16 b = (__bf16)f; return __builtin_bit_cast(unsigned short, b); }
__device__ __forceinline__ float bf2f(bf16_t b) { return __uint_as_float(((unsigned)b) << 16); }
__device__ __forceinline__ float bflo(unsigned w) { return __uint_as_float(w << 16); }
__device__ __forceinline__ float bfhi(unsigned w) { return __uint_as_float(w & 0xffff0000u); }
__device__ __forceinline__ float wave_sum(float v) {
#pragma unroll
    for (int o = 1; o < 64; o <<= 1) v += __shfl_xor(v, o);
    return v;
}
__device__ __forceinline__ float silu_f(float x) { return x * __builtin_amdgcn_rcpf(1.f + __expf(-x)); }
__device__ __forceinline__ float log_sigmoid_f(float z) { return fminf(z, 0.f) - __logf(1.f + __expf(-fabsf(z))); }

#define XB_TMO      128
#define XB_XCNT(j)  (256  + 64 * (j))
#define XB_XSUB(j)  (1280 + 64 * (j))
#define XB_XGEN(j)  (2304 + 64 * (j))
#define XB_TOP      3328
#define XB_TOPGEN   3392
#define XCD_BAR_WORDS 3456
#define XB_SPIN_CAP (1u << 22)
__device__ __forceinline__ unsigned xb_ld(unsigned* p)              { return __hip_atomic_load(p, __ATOMIC_RELAXED, __HIP_MEMORY_SCOPE_AGENT); }
__device__ __forceinline__ unsigned xb_add(unsigned* p, unsigned v) { return __hip_atomic_fetch_add(p, v, __ATOMIC_RELAXED, __HIP_MEMORY_SCOPE_AGENT); }
__device__ __forceinline__ unsigned xb_xcc_id() { return (unsigned)__builtin_amdgcn_s_getreg((3 << 11) | 20) & 0xFu; }
#define XB_SPIN(cond, bar) do { unsigned _sp = 0; while (cond) { __builtin_amdgcn_s_sleep(1); \
    if ((++_sp & 255u) == 0u) { if (xb_ld(&(bar)[XB_TMO])) break; if (_sp > XB_SPIN_CAP) { atomicAdd(&(bar)[XB_TMO], 1u); break; } } } } while (0)
struct XcdBarrier { unsigned* bar; unsigned x; volatile LAS unsigned* st; };
__device__ __forceinline__ XcdBarrier xcd_barrier_post(unsigned* bar, volatile LAS unsigned* st) {
    XcdBarrier b; b.bar = bar; b.x = xb_xcc_id(); b.st = st;
    if (threadIdx.x == 0) (void)xb_add(&bar[XB_XCNT(b.x)], 1u);
    return b;
}
__device__ __forceinline__ void xcd_barrier_complete(unsigned* bar, unsigned x, unsigned& nloc, unsigned& nx) {
    const unsigned G = gridDim.x * gridDim.y * gridDim.z;
    unsigned sum, cnt, mine, sp = 0u;
    for (;;) {
        sum = 0u; cnt = 0u; mine = 0u;
#pragma unroll
        for (unsigned j = 0; j < 16; ++j) { const unsigned c = xb_ld(&bar[XB_XCNT(j)]); sum += c; cnt += (c > 0u) ? 1u : 0u; mine = (j == x) ? c : mine; }
        if (sum == G) break;
        __builtin_amdgcn_s_sleep(1);
        if ((++sp & 255u) == 0u) { if (xb_ld(&bar[XB_TMO])) break; if (sp > XB_SPIN_CAP) { atomicAdd(&bar[XB_TMO], 1u); break; } }
    }
    nloc = mine > 0u ? mine : 1u; nx = cnt > 0u ? cnt : 1u;
}
__device__ __forceinline__ void xcd_barrier(const XcdBarrier& b) {
    asm volatile("s_waitcnt vmcnt(0)" ::: "memory");
    __syncthreads();
    if (threadIdx.x == 0) {
        unsigned* bar = b.bar;
        __builtin_amdgcn_s_waitcnt(0);
        unsigned nloc = b.st[0], nx = b.st[1];
        if (nloc == 0u) { xcd_barrier_complete(bar, b.x, nloc, nx); b.st[0] = nloc; b.st[1] = nx; }
        const unsigned old = xb_add(&bar[XB_XSUB(b.x)], 1u);
        const unsigned gen = old / nloc;
        if (old + 1u == (gen + 1u) * nloc) {
            __builtin_amdgcn_fence(__ATOMIC_RELEASE, "agent");
            asm volatile("s_waitcnt vmcnt(0)" ::: "memory");
            const unsigned og = xb_add(&bar[XB_TOP], 1u);
            const unsigned tg = og / nx;
            if (og + 1u == (tg + 1u) * nx) xb_add(&bar[XB_TOPGEN], 1u);
            else XB_SPIN(xb_ld(&bar[XB_TOPGEN]) == tg, bar);
            __builtin_amdgcn_fence(__ATOMIC_ACQUIRE, "agent");
            xb_add(&bar[XB_XGEN(b.x)], 1u);
            asm volatile("s_waitcnt vmcnt(0)" ::: "memory");
        } else {
            XB_SPIN(xb_ld(&bar[XB_XGEN(b.x)]) == gen, bar);
            __builtin_amdgcn_fence(__ATOMIC_ACQUIRE, "agent");
            asm volatile("s_waitcnt vmcnt(0)" ::: "memory");
        }
    }
    __syncthreads();
}

struct Args {
    const float* in[32];
    float* out;
    unsigned char* ws;
    int ph_lo, ph_hi;
    int rep_k, pad_;
};
enum { I_X = 0, I_C, I_CTX, I_CCTX, I_ADAW, I_ADAB, I_WIN, I_WAF, I_BAF, I_WAB, I_BAB, I_NORMG, I_CONVW, I_CONVB, I_FW1, I_FB1, I_FW2, I_FB2, I_FWOUT, I_FFREQ,
       I_BIASD, I_WOUT, I_LN1G, I_LN1B, I_RW, I_RB, I_EW1, I_EB1, I_EW2, I_EB2, I_LN2G, I_LN2B };


namespace gm {
constexpr int BM = 256, BK = 64, HALF = 128, HTB = HALF * BK * 2, STAGE_BYTES = 8 * HTB, KD = 1024, NT = KD / BK;
constexpr int ROWB = KD * 2;
typedef int i32x8 __attribute__((ext_vector_type(8)));
__device__ __forceinline__ int lds_off8(int r, int fq) { const int rr = r & 15; return ((r >> 4) * 2 + (fq >> 1)) * 1024 + ((rr * 64 + 32 * (fq & 1)) ^ (((rr >> 3) & 1) << 5)); }
__device__ __forceinline__ int lds_byte(int r, int c) { const int st = (r >> 4) * 2 + (c >> 5), rr = r & 15, cc = c & 31, ob = rr * 64 + cc * 2; return st * 1024 + (ob ^ (((ob >> 9) & 1) << 5)); }
__device__ __forceinline__ void stage_rc(int b, int& R, int& C) { const int st = b / 1024, sb = b % 1024, swz = sb ^ (((sb >> 9) & 1) << 5); R = (st >> 1) * 16 + swz / 64; C = (st & 1) * 32 + (swz % 64) / 2; }
__device__ __forceinline__ int perm32(int rho) { const int n = rho >> 4, i = rho & 15; return 8 * (i >> 2) + 4 * n + (i & 3); }

constexpr int LDS_BIAS = STAGE_BYTES + 4096;
struct Unit {
    const char* A;
    const char* B;
    const int* list;
    int type, row0, col0, valid, aux;
};

__device__ __forceinline__ i32x8 cat8(bf16x8 lo, bf16x8 hi) { typedef int i32x4 __attribute__((ext_vector_type(4))); const i32x4 a = __builtin_bit_cast(i32x4, lo), b = __builtin_bit_cast(i32x4, hi); return (i32x8){a[0], a[1], a[2], a[3], b[0], b[1], b[2], b[3]}; }
template <bool GATHER, int GSHIFT, int RB>
__device__ __forceinline__ void a_offsets(const Unit& u, unsigned (&o)[2][2]) {
    int R[2], Cb[2];
    int tz = threadIdx.x; asm volatile("" : "+v"(tz));
#pragma unroll
    for (int i = 0; i < 2; ++i) { int r, c; stage_rc(tz * 16 + i * 8192, r, c); R[i] = r; Cb[i] = c * 2; }
#pragma unroll
    for (int h = 0; h < 2; ++h)
#pragma unroll
        for (int i = 0; i < 2; ++i) {
            const int r = h * HALF + R[i];
            if (!GATHER) o[h][i] = (unsigned)(r * RB + Cb[i]);
            else { const int idx = u.list[r < u.valid ? r : 0]; o[h][i] = (unsigned)(idx >> GSHIFT) * (unsigned)RB + (unsigned)Cb[i]; }
        }
}

template <bool GATHER, int GSHIFT, bool FP8, class Sched, class Epi>
__device__ __forceinline__ void gemm_stream(LAS unsigned char* lds, const Sched& S, const Epi& E) {
    constexpr int RB = FP8 ? KD : ROWB, NTL = FP8 ? NT / 2 : NT;
    const int tid = threadIdx.x, wid = __builtin_amdgcn_readfirstlane(tid >> 6), lane = tid & 63, wr = wid >> 2, wc = wid & 3, fr = lane & 15, fq = lane >> 4;
    unsigned voffB[2], voffA[2];
#pragma unroll
    for (int i = 0; i < 2; ++i) { int r, c; stage_rc(tid * 16 + i * 8192, r, c); const int rb = (r & ~31) + perm32(r & 31); voffB[i] = (unsigned)(rb * RB + c * 2); voffA[i] = (unsigned)(r * RB + c * 2); }
    const size_t kstep = (size_t)(BK * 2), hstep = (size_t)HALF * RB;
    const unsigned ldsw = (unsigned)wid * 1024u;
    const int aoff = FP8 ? lds_off8(wr * 64 + fr, fq) : lds_byte(wr * 64 + fr, fq * 8), boff = FP8 ? lds_off8(wc * 32 + fr, fq) : lds_byte(wc * 32 + fr, fq * 8);
#define GM_SA(b, h) (((b) * 2 + (h)) * HTB)
#define GM_SB(b, h) ((4 + (b) * 2 + (h)) * HTB)
#define GM_STAGE(bufoff, gbase, vo0, vo1) do { \
        __builtin_amdgcn_global_load_lds((const unsigned*)((const char*)(gbase) + (vo0)), (LAS unsigned*)(lds + (bufoff) + ldsw), 16, 0, 0); \
        __builtin_amdgcn_global_load_lds((const unsigned*)((const char*)(gbase) + (vo1)), (LAS unsigned*)(lds + (bufoff) + ldsw + 8192), 16, 0, 0); } while (0)
#define GM_STAGE_A(bufoff, gbase, h, o0, o1) do { if constexpr (GATHER) GM_STAGE(bufoff, gbase, o0, o1); else GM_STAGE(bufoff, (gbase) + (h) * hstep, voffA[0], voffA[1]); } while (0)
#define GM_LD32(p) ({ const i32x4 lo_ = *(const LAS i32x4*)(p), hi_ = *(const LAS i32x4*)((p) + 16); (i32x8){lo_[0], lo_[1], lo_[2], lo_[3], hi_[0], hi_[1], hi_[2], hi_[3]}; })
#define GM_LDA(dst, b, h) do { if constexpr (FP8) { _Pragma("unroll") for (int m = 0; m < 4; ++m) dst##8[m] = GM_LD32(lds + GM_SA(b, h) + aoff + m * 2048); } \
        else { _Pragma("unroll") for (int m = 0; m < 4; ++m) _Pragma("unroll") for (int k = 0; k < 2; ++k) dst[m][k] = *(const LAS bf16x8*)(lds + GM_SA(b, h) + aoff + m * 2048 + k * 1024); } } while (0)
#define GM_LDB(dst, b, h) do { if constexpr (FP8) { _Pragma("unroll") for (int n = 0; n < 2; ++n) dst##8[n] = GM_LD32(lds + GM_SB(b, h) + boff + n * 2048); } \
        else { _Pragma("unroll") for (int n = 0; n < 2; ++n) _Pragma("unroll") for (int k = 0; k < 2; ++k) dst[n][k] = *(const LAS bf16x8*)(lds + GM_SB(b, h) + boff + n * 2048 + k * 1024); } } while (0)
#define GM_MMA(ai, bj, At, Bt) do { __builtin_amdgcn_s_setprio(1); _Pragma("unroll") for (int m = 0; m < 4; ++m) _Pragma("unroll") for (int n = 0; n < 2; ++n) { \
        if constexpr (FP8) asm volatile("v_mfma_scale_f32_16x16x128_f8f6f4 %0, %1, %2, %0, %3, %3 op_sel_hi:[0,0,0]" : "+v"(acc[ai][bj][m][n]) : "v"(Bt##8[n]), "v"(At##8[m]), "v"(sc1_)); \
        else { _Pragma("unroll") for (int k = 0; k < 2; ++k) acc[ai][bj][m][n] = __builtin_amdgcn_mfma_f32_16x16x32_bf16(Bt[n][k], At[m][k], acc[ai][bj][m][n], 0, 0, 0); } } \
        __builtin_amdgcn_s_setprio(0); } while (0)
#define GM_WAIT_V(n) asm volatile("s_waitcnt vmcnt(" #n ")" ::: "memory")
#define GM_WAIT_L(n) asm volatile("s_waitcnt lgkmcnt(" #n ")" ::: "memory")
#define GM_BAR __builtin_amdgcn_s_barrier()
#define GM_SCHED __builtin_amdgcn_sched_barrier(0)
    Unit cur, nxt; int ui = 0;
    if (!S.next(0, cur)) return;
    f32x4 acc[2][2][4][2];
#pragma unroll
    for (int a = 0; a < 2; ++a)
#pragma unroll
        for (int b = 0; b < 2; ++b)
#pragma unroll
            for (int m = 0; m < 4; ++m)
#pragma unroll
                for (int n = 0; n < 2; ++n) acc[a][b][m][n] = (f32x4){0.f, 0.f, 0.f, 0.f};
    typedef int i32x4 __attribute__((ext_vector_type(4)));
    int sc1_ = 0x7f7f7f7f; asm volatile("" : "+v"(sc1_));
    bf16x8 At[4][2], B0[2][2], B1[2][2];
    i32x8 At8[4], B08[2], B18[2];
    unsigned ca[2][2], na[2][2];
    if constexpr (GATHER) a_offsets<GATHER, GSHIFT, RB>(cur, ca);
    const char* cA = cur.A; const char* cB = cur.B;
    GM_STAGE(GM_SB(0, 0), cB, voffB[0], voffB[1]); GM_STAGE_A(GM_SA(0, 0), cA, 0, ca[0][0], ca[0][1]); GM_STAGE(GM_SB(0, 1), cB + hstep, voffB[0], voffB[1]); GM_STAGE_A(GM_SA(0, 1), cA, 1, ca[1][0], ca[1][1]);
    if (wr == 1) GM_BAR;
    GM_WAIT_V(4); GM_BAR;
    GM_STAGE(GM_SB(1, 0), cB + kstep, voffB[0], voffB[1]); GM_STAGE_A(GM_SA(1, 0), cA + kstep, 0, ca[0][0], ca[0][1]); GM_STAGE(GM_SB(1, 1), cB + hstep + kstep, voffB[0], voffB[1]);
    GM_WAIT_V(6); GM_BAR;
    for (;;) {
        const bool has_next = S.next(ui + 1, nxt);
        if constexpr (GATHER) {
            if (has_next) a_offsets<GATHER, GSHIFT, RB>(nxt, na);
            else {
#pragma unroll
                for (int h = 0; h < 2; ++h)
#pragma unroll
                    for (int i = 0; i < 2; ++i) na[h][i] = ca[h][i];
            }
        }
        const char* nA = has_next ? nxt.A : cA; const char* nB = has_next ? nxt.B : cB;
        if (wid == 0)
            __builtin_amdgcn_global_load_lds((const unsigned*)(S.bias(cur) + 4 * lane), (LAS unsigned*)(lds + LDS_BIAS + (ui & 1) * 1024), 16, 0, 0);
        for (int t = 0; t < NTL; t += 2) {
            const bool last = (t == NTL - 2);

            const char* a1 = cA + (size_t)(t + 1) * kstep;
            const char* a2 = last ? nA : cA + (size_t)(t + 2) * kstep; const char* b2 = last ? nB : cB + (size_t)(t + 2) * kstep;
            const char* a3 = a2 + kstep; const char* b3 = b2 + kstep;
            unsigned x00 = 0, x01 = 0, x10 = 0, x11 = 0;
            if constexpr (GATHER) { x00 = last ? na[0][0] : ca[0][0]; x01 = last ? na[0][1] : ca[0][1]; x10 = last ? na[1][0] : ca[1][0]; x11 = last ? na[1][1] : ca[1][1]; }
            GM_LDB(B0, 0, 0); GM_SCHED; GM_LDA(At, 0, 0); GM_STAGE_A(GM_SA(1, 1), a1, 1, ca[1][0], ca[1][1]);
            GM_WAIT_L(8); GM_BAR; GM_WAIT_L(0); GM_MMA(0, 0, At, B0); GM_BAR; GM_SCHED;
            GM_LDB(B1, 0, 1); GM_STAGE(GM_SB(0, 0), b2, voffB[0], voffB[1]);
            GM_BAR; GM_WAIT_L(0); GM_MMA(0, 1, At, B1); GM_BAR;
            GM_LDA(At, 0, 1); GM_STAGE_A(GM_SA(0, 0), a2, 0, x00, x01);
            GM_BAR; GM_WAIT_L(0); GM_MMA(1, 0, At, B0); GM_BAR; GM_SCHED;
            GM_STAGE(GM_SB(0, 1), b2 + hstep, voffB[0], voffB[1]);
            GM_WAIT_V(6); GM_BAR; GM_MMA(1, 1, At, B1); GM_BAR;
            GM_LDB(B0, 1, 0); GM_SCHED; GM_LDA(At, 1, 0); GM_STAGE_A(GM_SA(0, 1), a2, 1, x10, x11);
            GM_WAIT_L(8); GM_BAR; GM_WAIT_L(0); GM_MMA(0, 0, At, B0); GM_BAR; GM_SCHED;
            GM_LDB(B1, 1, 1); GM_STAGE(GM_SB(1, 0), b3, voffB[0], voffB[1]);
            GM_BAR; GM_WAIT_L(0); GM_MMA(0, 1, At, B1); GM_BAR;
            GM_LDA(At, 1, 1); GM_STAGE_A(GM_SA(1, 0), a3, 0, x00, x01);
            GM_BAR; GM_WAIT_L(0); GM_MMA(1, 0, At, B0); GM_BAR; GM_SCHED;
            GM_STAGE(GM_SB(1, 1), b3 + hstep, voffB[0], voffB[1]);
            GM_WAIT_V(6); GM_BAR; GM_MMA(1, 1, At, B1); GM_BAR;
        }
        if constexpr (FP8) asm volatile("s_nop 7\n\ts_nop 7" ::: "memory");
        {
          int tz = threadIdx.x; asm volatile("" : "+v"(tz)); const int wz = tz >> 6, lz = tz & 63;
          E(acc, cur, wz >> 2, wz & 3, lz & 15, lz >> 4, (const LAS float*)(lds + LDS_BIAS + (ui & 1) * 1024)); }
        if (!has_next) break;
#pragma unroll
        for (int a = 0; a < 2; ++a)
#pragma unroll
            for (int b = 0; b < 2; ++b)
#pragma unroll
                for (int m = 0; m < 4; ++m)
#pragma unroll
                    for (int n = 0; n < 2; ++n) acc[a][b][m][n] = (f32x4){0.f, 0.f, 0.f, 0.f};
        cur = nxt; cA = nA; cB = nB; ++ui;
        if constexpr (GATHER) {
#pragma unroll
            for (int h = 0; h < 2; ++h)
#pragma unroll
                for (int i = 0; i < 2; ++i) ca[h][i] = na[h][i];
        }
    }
    GM_WAIT_V(0);
    if (wr == 0) GM_BAR;
    GM_BAR;
#undef GM_SA
#undef GM_SB
#undef GM_STAGE
#undef GM_STAGE_A
#undef GM_LD32
#undef GM_LDA
#undef GM_LDB
#undef GM_MMA
#undef GM_WAIT_V
#undef GM_WAIT_L
#undef GM_BAR
#undef GM_SCHED
}

__device__ __forceinline__ u32x4 pack8(f32x4 a, f32x4 b) { u32x4 w; w.x = pk2(a[0], a[1]); w.y = pk2(a[2], a[3]); w.z = pk2(b[0], b[1]); w.w = pk2(b[2], b[3]); return w; }

struct SchedIn {
    unsigned char* ws; int G, c; const float* baf; const float* bab;
    __device__ __forceinline__ bool next(int i, Unit& u) const {
        int L = i * G + c;
        u.list = nullptr; u.valid = 256; u.aux = 0;
        if (L < 768) {
            const int pa = L % 6, pb = L / 6;
            u.A = (const char*)(ws + WS_BTIN) + (size_t)(2048 + 256 * pa) * ROWB; u.B = (const char*)(ws + WS_H) + (size_t)(256 * pb) * ROWB;
            u.type = 2; u.row0 = 256 * pa; u.col0 = 256 * pb; return true;
        }
        L -= 768;
        if (L < 1024) {
            const int pm = L >> 3, pn = ((L & 7) + (L >> 8)) & 7;
            u.A = (const char*)(ws + WS_H) + (size_t)(256 * pm) * ROWB; u.B = (const char*)(ws + WS_BTIN) + (size_t)(256 * pn) * ROWB;
            u.type = pn < 6 ? 0 : 1; u.row0 = 256 * pm; u.col0 = pn; return true;
        }
        L -= 1024;
        if (L < 20) {
            const int pm = L / 5, j = L % 5, pn = j == 0 ? 1 : (j == 1 ? 2 : (j == 2 ? 3 : (j == 3 ? 6 : 7)));
            u.A = (const char*)(ws + WS_H) + (size_t)(T + 256 * pm) * ROWB; u.B = (const char*)(ws + WS_BTIN) + (size_t)(256 * pn) * ROWB;
            u.type = pn < 6 ? 0 : 1; u.row0 = T + 256 * pm; u.col0 = pn; return true;
        }
        return false;
    }
    __device__ __forceinline__ const float* bias(const Unit& u) const { return (u.type == 1 && u.col0 == 7) ? bab : baf; }
};
struct EpiIn {
    unsigned char* ws;
    __device__ __forceinline__ void operator()(const f32x4 (&acc)[2][2][4][2], const Unit& u, int wr, int wc, int fr, int fq, const LAS float* bs) const {
        const int rl = wr * 64 + fr, cl = wc * 32 + 8 * fq;
        if (u.type == 0) {
            const int pn = u.col0;
            bf16_t* dst; int ld, cb;
            if (pn == 0) { dst = (bf16_t*)(ws + WS_Q); ld = 256; cb = 0; }
            else if (pn == 1) { dst = (bf16_t*)(ws + WS_K); ld = 256; cb = 0; }
            else if (pn < 4) { dst = (bf16_t*)(ws + WS_V); ld = 512; cb = (pn - 2) * 256; }
            else { dst = (bf16_t*)(ws + WS_G); ld = 512; cb = (pn - 4) * 256; }
#pragma unroll
            for (int ai = 0; ai < 2; ++ai)
#pragma unroll
                for (int m = 0; m < 4; ++m) { bf16_t* rowp = dst + (size_t)(u.row0 + rl + ai * 128 + m * 16) * ld + cb + cl;
#pragma unroll
                    for (int bj = 0; bj < 2; ++bj) *(u32x4*)(rowp + bj * 128) = pack8(acc[ai][bj][m][0], acc[ai][bj][m][1]); }
        } else if (u.type == 1) {
            float* dst = (float*)(ws + (u.col0 == 6 ? WS_GF : WS_GB));
            f32x4 bv[2][2];
#pragma unroll
            for (int bj = 0; bj < 2; ++bj)
#pragma unroll
                for (int n = 0; n < 2; ++n) bv[bj][n] = *(const LAS f32x4*)(bs + cl + bj * 128 + 4 * n);
#pragma unroll
            for (int ai = 0; ai < 2; ++ai)
#pragma unroll
                for (int m = 0; m < 4; ++m) { float* rowp = dst + (size_t)(u.row0 + rl + ai * 128 + m * 16) * 256 + cl;
#pragma unroll
                    for (int bj = 0; bj < 2; ++bj)
#pragma unroll
                        for (int n = 0; n < 2; ++n) { f32x4 z = acc[ai][bj][m][n] + bv[bj][n], o;
#pragma unroll
                            for (int j = 0; j < 4; ++j) o[j] = log_sigmoid_f(z[j]) * (1.f / 16.f);
                            *(f32x4*)(rowp + bj * 128 + 4 * n) = o; } }
        } else {
            const int b = u.col0 >> 13, l0 = u.col0 & 8191;
            bf16_t* dst = (bf16_t*)(ws + WS_UT) + ((size_t)b * HYC) * SEQ + l0 + cl;
#pragma unroll
            for (int ai = 0; ai < 2; ++ai)
#pragma unroll
                for (int m = 0; m < 4; ++m) { bf16_t* rowp = dst + (size_t)(u.row0 + rl + ai * 128 + m * 16) * SEQ;
#pragma unroll
                    for (int bj = 0; bj < 2; ++bj) *(u32x4*)(rowp + bj * 128) = pack8(acc[ai][bj][m][0], acc[ai][bj][m][1]); }
        }
    }
};

struct SchedOut {
    unsigned char* ws; int G, c;
    __device__ __forceinline__ bool next(int i, Unit& u) const {
        const int L = i * G + c; if (L >= 512) return false;
        const int pm = L >> 2, pn = L & 3;
        u.A = (const char*)(ws + WS_MIX) + (size_t)(256 * pm) * ROWB; u.B = (const char*)(ws + WS_BTOUT) + (size_t)(256 * pn) * ROWB;
        u.list = nullptr; u.valid = 256; u.aux = 0; u.type = 3; u.row0 = 256 * pm; u.col0 = 256 * pn; return true;
    }
    __device__ __forceinline__ const float* bias(const Unit& u) const { return (const float*)(ws + WS_MOD) + (u.row0 >> 13) * 6144 + 2 * 1024 + u.col0; }
};
struct EpiOut {
    unsigned char* ws;
    __device__ __forceinline__ void operator()(const f32x4 (&acc)[2][2][4][2], const Unit& u, int wr, int wc, int fr, int fq, const LAS float* bs) const {
        const int rl = wr * 64 + fr, cl = u.col0 + wc * 32 + 8 * fq;
        bf16_t* fg = (bf16_t*)(ws + WS_FG);
        f32x4 gv[2][2];
#pragma unroll
        for (int bj = 0; bj < 2; ++bj)
#pragma unroll
            for (int n = 0; n < 2; ++n) gv[bj][n] = *(const LAS f32x4*)(bs + wc * 32 + 8 * fq + bj * 128 + 4 * n);
#pragma unroll
        for (int ai = 0; ai < 2; ++ai)
#pragma unroll
            for (int m = 0; m < 4; ++m) { bf16_t* rowp = fg + (size_t)(u.row0 + rl + ai * 128 + m * 16) * 1024 + cl;
#pragma unroll
                for (int bj = 0; bj < 2; ++bj) *(u32x4*)(rowp + bj * 128) = pack8(gv[bj][0] * acc[ai][bj][m][0], gv[bj][1] * acc[ai][bj][m][1]); }
    }
};

constexpr int LDS_TAB = STAGE_BYTES;
template <int WHICH>
struct SchedMoe {
    unsigned char* ws; const LAS int* tab; int G, c; const float* b2;
    __device__ __forceinline__ bool next(int i, Unit& u) const {
        constexpr int NCT_ = WHICH == 1 ? 8 : 4;
        const int L = i * G + c; const int nrt = __builtin_amdgcn_readfirstlane(tab[32]);
        if (L >= nrt * NCT_) return false;
        const int rt = L / NCT_, ct = L % NCT_;
        const int info = __builtin_amdgcn_readfirstlane(tab[64 + rt]), e = info & 255, r0 = (info >> 8) * 256;
        const int cnt = __builtin_amdgcn_readfirstlane(tab[e]);
        u.valid = (cnt - r0) < 256 ? (cnt - r0) : 256;
        u.list = (const int*)(ws + WS_LIST) + (size_t)e * CAP + r0;
        u.A = (WHICH == 1) ? (const char*)(ws + WS_H2) : (const char*)(ws + WS_ACT) + (size_t)(256 * rt) * KD;
        u.B = (const char*)(ws + (WHICH == 1 ? WS_W1T : WS_W2T)) + ((size_t)e * (WHICH == 1 ? 2048 : 1024) + 256 * ct) * KD;
        u.type = 3 + WHICH; u.row0 = 256 * rt; u.col0 = ct; u.aux = e; return true;
    }
    __device__ __forceinline__ const float* bias(const Unit& u) const { return (WHICH == 1) ? (const float*)(ws + WS_B1R) + (size_t)u.aux * 2048 + 256 * u.col0 : b2 + (size_t)u.aux * 1024 + 256 * u.col0; }
};
__device__ __forceinline__ float swiglu_f(float glu, float lin) {
    glu = fminf(glu, 7.f); lin = fminf(fmaxf(lin, -7.f), 7.f);
    return glu * __builtin_amdgcn_rcpf(1.f + __expf(-1.702f * glu)) * (lin + 1.f);
}
constexpr float S_H2 = 4.f, S_ACT = 8.f, S_W = 64.f;
__device__ __forceinline__ unsigned pk4_fp8(float a, float b, float c, float d) {
    a = fminf(fmaxf(a, -448.f), 448.f); b = fminf(fmaxf(b, -448.f), 448.f); c = fminf(fmaxf(c, -448.f), 448.f); d = fminf(fmaxf(d, -448.f), 448.f);
    int p = __builtin_amdgcn_cvt_pk_fp8_f32(a, b, 0, false); p = __builtin_amdgcn_cvt_pk_fp8_f32(c, d, p, true); return (unsigned)p; }
__device__ __forceinline__ unsigned pk4_fp8_nc(float a, float b, float c, float d) { int p = __builtin_amdgcn_cvt_pk_fp8_f32(a, b, 0, false); p = __builtin_amdgcn_cvt_pk_fp8_f32(c, d, p, true); return (unsigned)p; }
struct EpiMoe1 {
    unsigned char* ws;
    __device__ __forceinline__ void operator()(const f32x4 (&acc)[2][2][4][2], const Unit& u, int wr, int wc, int fr, int fq, const LAS float* bs) const {
        const int rl = wr * 64 + fr, cl = wc * 32 + 8 * fq, ct = u.col0;
        const LAS float* b1 = bs + cl;
        unsigned char* act = (unsigned char*)(ws + WS_ACT) + (size_t)u.row0 * 1024 + 128 * ct + cl;
        f32x4 bg[2], bl[2];
#pragma unroll
        for (int n = 0; n < 2; ++n) { bg[n] = *(const LAS f32x4*)(b1 + 4 * n); bl[n] = *(const LAS f32x4*)(b1 + 128 + 4 * n); }
#pragma unroll
        for (int ai = 0; ai < 2; ++ai)
#pragma unroll
            for (int m = 0; m < 4; ++m) { const int r = rl + ai * 128 + m * 16;
                f32x4 o[2];
#pragma unroll
                for (int n = 0; n < 2; ++n) { const f32x4 gl = acc[ai][0][m][n] * (1.f / (S_H2 * S_W)) + bg[n], li = acc[ai][1][m][n] * (1.f / (S_H2 * S_W)) + bl[n];
#pragma unroll
                    for (int j = 0; j < 4; ++j) o[n][j] = swiglu_f(gl[j], li[j]) * S_ACT; }
                u32x2 w; w.x = pk4_fp8(o[0][0], o[0][1], o[0][2], o[0][3]); w.y = pk4_fp8(o[1][0], o[1][1], o[1][2], o[1][3]);
                *(u32x2*)(act + (size_t)r * 1024) = w; }
    }
};
constexpr float S_SL = 16.f;
struct EpiMoe2 {
    unsigned char* ws;
    __device__ __forceinline__ void operator()(const f32x4 (&acc)[2][2][4][2], const Unit& u, int wr, int wc, int fr, int fq, const LAS float* bs) const {
        const int rl = wr * 64 + fr, cl = wc * 32 + 8 * fq, ct = u.col0;
        const LAS float* bb = bs + cl;
        unsigned char* slots = (unsigned char*)(ws + WS_SLOTS) + (size_t)u.row0 * 1024 + 256 * ct + cl;
        f32x4 bv[2][2];
#pragma unroll
        for (int bj = 0; bj < 2; ++bj)
#pragma unroll
            for (int n = 0; n < 2; ++n) bv[bj][n] = *(const LAS f32x4*)(bb + bj * 128 + 4 * n) * S_SL;
#pragma unroll
        for (int ai = 0; ai < 2; ++ai)
#pragma unroll
            for (int m = 0; m < 4; ++m) { const int r = rl + ai * 128 + m * 16;
#pragma unroll
                for (int bj = 0; bj < 2; ++bj) { const f32x4 y0 = acc[ai][bj][m][0] * (S_SL / (S_ACT * S_W)) + bv[bj][0], y1 = acc[ai][bj][m][1] * (S_SL / (S_ACT * S_W)) + bv[bj][1];
                    u32x2 w; w.x = pk4_fp8(y0[0], y0[1], y0[2], y0[3]); w.y = pk4_fp8(y1[0], y1[1], y1[2], y1[3]);
                    *(u32x2*)(slots + (size_t)r * 1024 + bj * 128) = w; } }
    }
};
}

namespace hy {
__device__ __forceinline__ int phys(int n) { return n + (n >> 4) + ((n >> 9) << 4); }
constexpr int XSIZE = 16384 + 1024 + 512;

__device__ __forceinline__ float tw_c(int i) {
    constexpr float t[16] = {1.f, 0.98078528040323043f, 0.92387953251128674f, 0.83146961230254524f, 0.70710678118654752f, 0.55557023301960218f, 0.38268343236508977f, 0.19509032201612825f,
                             0.f, -0.19509032201612825f, -0.38268343236508977f, -0.55557023301960218f, -0.70710678118654752f, -0.83146961230254524f, -0.92387953251128674f, -0.98078528040323043f};
    return t[i];
}
__device__ __forceinline__ float tw_s(int i) {
    constexpr float t[16] = {0.f, 0.19509032201612825f, 0.38268343236508977f, 0.55557023301960218f, 0.70710678118654752f, 0.83146961230254524f, 0.92387953251128674f, 0.98078528040323043f,
                             1.f, 0.98078528040323043f, 0.92387953251128674f, 0.83146961230254524f, 0.70710678118654752f, 0.55557023301960218f, 0.38268343236508977f, 0.19509032201612825f};
    return t[i];
}
__host__ __device__ constexpr int brev(int p, int bits) { int r = 0; for (int i = 0; i < bits; ++i) r |= ((p >> i) & 1) << (bits - 1 - i); return r; }

template <int R, bool INV>
__device__ __forceinline__ void fft_reg(f32x2 (&v)[R]) {
#pragma unroll
    for (int s = R / 2; s >= 1; s >>= 1) {
#pragma unroll
        for (int g = 0; g < R; g += 2 * s) {
#pragma unroll
            for (int k = 0; k < s; ++k) {
                const f32x2 a = v[g + k], b = v[g + k + s];
                v[g + k] = a + b;
                const f32x2 t = a - b;
                const int ti = k * (16 / s);
                f32x2 o;
                if (ti == 0) o = t;
                else if (ti == 8) { if (INV) { o[0] = -t[1]; o[1] = t[0]; } else { o[0] = t[1]; o[1] = -t[0]; } }
                else { const float c = tw_c(ti), sn = tw_s(ti);
                    if (INV) { o[0] = t[0] * c - t[1] * sn; o[1] = t[1] * c + t[0] * sn; }
                    else     { o[0] = t[0] * c + t[1] * sn; o[1] = t[1] * c - t[0] * sn; } }
                v[g + k + s] = o;
            }
        }
    }
}
__device__ __forceinline__ f32x2 cmul(f32x2 a, f32x2 b) { f32x2 r; r[0] = a[0] * b[0] - a[1] * b[1]; r[1] = a[0] * b[1] + a[1] * b[0]; return r; }

template <int M, bool ZPAD = false>
__device__ __forceinline__ void pass_fwd32(LAS f32x2* X, int tid) {
    int j = (M == 512) ? tid : (tid & 15);
    asm volatile("" : "+v"(j));
    const int p0 = (M == 512) ? (tid + (tid >> 4)) : (560 * (tid >> 4) + (tid & 15));
    constexpr int PS = (M == 512) ? 560 : 17;
    f32x2 v[32];
#pragma unroll
    for (int r = 0; r < 32; ++r) { if (ZPAD && r >= 16) v[r] = (f32x2){0.f, 0.f}; else v[r] = X[p0 + PS * r]; }
    fft_reg<32, false>(v);
    float sn, cs; sincospif(-2.f * (float)j / (float)(32 * M), &sn, &cs);
    const f32x2 w1 = {cs, sn}; f32x2 w = w1;
    X[p0] = v[0];
#pragma unroll
    for (int rp = 1; rp < 32; ++rp) { X[p0 + PS * rp] = cmul(v[brev(rp, 5)], w); w = cmul(w, w1); }
}
template <int M, bool HALF = false>
__device__ __forceinline__ void pass_inv32(LAS f32x2* X, int tid) {
    int j = (M == 512) ? tid : (tid & 15);
    asm volatile("" : "+v"(j));
    const int p0 = (M == 512) ? (tid + (tid >> 4)) : (560 * (tid >> 4) + (tid & 15));
    constexpr int PS = (M == 512) ? 560 : 17;
    float sn, cs; sincospif(2.f * (float)j / (float)(32 * M), &sn, &cs);
    const f32x2 w1 = {cs, sn}; f32x2 w = w1;
    f32x2 v[32];
    v[0] = X[p0];
#pragma unroll
    for (int rp = 1; rp < 32; ++rp) { v[rp] = cmul(X[p0 + PS * rp], w); w = cmul(w, w1); }
    fft_reg<32, true>(v);
#pragma unroll
    for (int p = 0; p < 32; ++p) { if (!HALF || brev(p, 5) < 16) X[p0 + PS * brev(p, 5)] = v[p]; }
}
__device__ __forceinline__ void pass_c_store(const LAS f32x2* X, f32x2* Hs, int tid, float scale) {
#pragma unroll
    for (int u = 0; u < 2; ++u) { const int blk = tid + 512 * u, p0 = 17 * blk + 16 * (blk >> 5);
        f32x2 v[16];
#pragma unroll
        for (int r = 0; r < 16; ++r) v[r] = X[p0 + r];
        fft_reg<16, false>(v);
#pragma unroll
        for (int q = 0; q < 8; ++q) { const f32x2 x0 = v[brev(2 * q, 4)] * scale, x1 = v[brev(2 * q + 1, 4)] * scale;
            *(f32x4*)(Hs + 16 * blk + 2 * q) = (f32x4){x0[0], x0[1], x1[0], x1[1]}; } }
}
__device__ __forceinline__ void pass_c_mul_inv(LAS f32x2* X, const f32x2* Hs, int tid) {
#pragma unroll
    for (int u = 0; u < 2; ++u) { const int blk = tid + 512 * u, p0 = 17 * blk + 16 * (blk >> 5);
        f32x2 v[16], w[16];
#pragma unroll
        for (int r = 0; r < 16; ++r) v[r] = X[p0 + r];
        f32x4 hh[8];
#pragma unroll
        for (int q = 0; q < 8; ++q) hh[q] = *(const f32x4*)(Hs + 16 * blk + 2 * q);
        fft_reg<16, false>(v);
#pragma unroll
        for (int q = 0; q < 8; ++q) { w[2 * q] = cmul(v[brev(2 * q, 4)], (f32x2){hh[q][0], hh[q][1]}); w[2 * q + 1] = cmul(v[brev(2 * q + 1, 4)], (f32x2){hh[q][2], hh[q][3]}); }
        fft_reg<16, true>(w);
#pragma unroll
        for (int p = 0; p < 16; ++p) X[p0 + brev(p, 4)] = w[p]; }
}
__device__ __forceinline__ void load16(const bf16_t* u, float (&e)[16]) {
    const u32x4 a = *(const u32x4*)u, b = *(const u32x4*)(u + 8);
    e[0] = bflo(a.x); e[1] = bfhi(a.x); e[2] = bflo(a.y); e[3] = bfhi(a.y); e[4] = bflo(a.z); e[5] = bfhi(a.z); e[6] = bflo(a.w); e[7] = bfhi(a.w);
    e[8] = bflo(b.x); e[9] = bfhi(b.x); e[10] = bflo(b.y); e[11] = bfhi(b.y); e[12] = bflo(b.z); e[13] = bfhi(b.z); e[14] = bflo(b.w); e[15] = bfhi(b.w);
}
__device__ __forceinline__ void sconv16(const bf16_t* u, int tid, float w0, float w1, float w2, float bias, float (&o)[16]) {
    float e[16]; load16(u + 16 * tid, e);
    float lf = __shfl_up(e[15], 1), rt = __shfl_down(e[0], 1);
    if ((tid & 3) == 0) lf = 0.f;
    if ((tid & 3) == 3) rt = 0.f;
    o[0] = w0 * lf + w1 * e[0] + w2 * e[1] + bias;
#pragma unroll
    for (int i = 1; i < 15; ++i) o[i] = w0 * e[i - 1] + w1 * e[i] + w2 * e[i + 1] + bias;
    o[15] = w0 * e[14] + w1 * e[15] + w2 * rt + bias;
}

constexpr int CV_ITEMS = NE * 128 * 32;
struct CvJob { float v[8]; int mi; };
__device__ __forceinline__ void cv_issue(const Args& a, CvJob& jb, int mi, int lane) {
    jb.mi = mi;
    if (mi >= 0) { const int e = mi >> 12, kg = (mi >> 5) & 127, nb = mi & 31;
        const float* src = a.in[I_EW1] + ((size_t)e * 1024 + 8 * kg) * 2048 + 64 * nb + lane;
#pragma unroll
        for (int i = 0; i < 8; ++i) jb.v[i] = src[(size_t)i * 2048]; }
}
__device__ __forceinline__ void cv_finish(const Args& a, const CvJob& jb, int lane) {
    if (jb.mi >= 0) { const int mi = jb.mi, e = mi >> 12, kg = (mi >> 5) & 127, nb = mi & 31;
        const int cs = 64 * nb + lane, sgl = cs & 1, ac = cs >> 1, ct = ac >> 7, jj = ac & 127;
        unsigned char* dst = (unsigned char*)(a.ws + WS_W1T) + ((size_t)e * 2048 + 256 * ct + 128 * sgl + jj) * 1024 + 8 * kg;
        u32x2 o; o.x = gm::pk4_fp8_nc(jb.v[0] * gm::S_W, jb.v[1] * gm::S_W, jb.v[2] * gm::S_W, jb.v[3] * gm::S_W); o.y = gm::pk4_fp8_nc(jb.v[4] * gm::S_W, jb.v[5] * gm::S_W, jb.v[6] * gm::S_W, jb.v[7] * gm::S_W);
        *(u32x2*)dst = o; }
}
struct CvState { CvJob jb; int next, stride, end; };
__device__ __forceinline__ void cv_step(const Args& a, CvState& st, int lane) {
    cv_finish(a, st.jb, lane);
    const int mi = st.next < st.end ? st.next : -1;
    cv_issue(a, st.jb, mi, lane);
    st.next += st.stride;
}

__device__ __forceinline__ void channel(const Args& a, LAS unsigned char* lds, int c, unsigned char* scratch, CvState& cvs) {
    const int tid = threadIdx.x;
#define CV_STEP() cv_step(a, cvs, tid & 63)
    LAS f32x2* X = (LAS f32x2*)lds;
    f32x2* Hs = (f32x2*)scratch;
    const float* HF = (const float*)(a.ws + WS_HF);
    const int pc = 17 * tid + 16 * (tid >> 5);
    __syncthreads();
#pragma unroll 1
    for (int o = 0; o < 2; ++o) {
        const f32x4* hf = (const f32x4*)(HF + ((size_t)(2 * o) * HYW + c) * SEQ + 16 * tid); const f32x4* hb = (const f32x4*)(HF + ((size_t)(2 * o + 1) * HYW + c) * SEQ + 16 * tid);
#pragma unroll
        for (int q = 0; q < 4; ++q) { const f32x4 f = hf[q], b = hb[q];
#pragma unroll
            for (int e = 0; e < 4; ++e) { const int i = 4 * q + e, t = 16 * tid + i;
                X[pc + i] = (f32x2){f[e], 0.f};
                if (t >= 1) X[phys(FFTN - t)] = (f32x2){b[e], 0.f}; } }
        if (tid == 0) X[phys(SEQ)] = (f32x2){0.f, 0.f};
        __syncthreads();
        CV_STEP(); pass_fwd32<512>(X, tid); __syncthreads(); CV_STEP(); pass_fwd32<16>(X, tid); __syncthreads(); pass_c_store(X, Hs + (size_t)o * FFTN, tid, 1.f / (float)FFTN); __syncthreads();
    }
    const float* cw = a.in[I_CONVW]; const float* cbv = a.in[I_CONVB]; const float* dbias = a.in[I_BIASD];
    const float d1 = dbias[c], d2 = dbias[HYW + c];
    float wv[3][3], bv[3];
#pragma unroll
    for (int s = 0; s < 3; ++s) { bv[s] = cbv[s * HYW + c];
#pragma unroll
        for (int i = 0; i < 3; ++i) wv[s][i] = cw[i * HYC + s * HYW + c]; }
    const bf16_t* UT = (const bf16_t*)(a.ws + WS_UT);
    bf16_t* YT = (bf16_t*)(a.ws + WS_YHYT);
#pragma unroll 1
    for (int bp = 0; bp < 2; ++bp) {
        const bf16_t* u0 = UT + ((size_t)(2 * bp) * HYC + c) * SEQ; const bf16_t* u1 = UT + ((size_t)(2 * bp + 1) * HYC + c) * SEQ;
        float z0[16], z1[16];
        {
            float v0[16], v1[16]; sconv16(u0, tid, wv[0][0], wv[0][1], wv[0][2], bv[0], v0); sconv16(u1, tid, wv[0][0], wv[0][1], wv[0][2], bv[0], v1);
#pragma unroll
            for (int i = 0; i < 16; ++i) X[pc + i] = (f32x2){v0[i], v1[i]};
        }
        __syncthreads();
        CV_STEP(); pass_fwd32<512, true>(X, tid); __syncthreads(); CV_STEP(); pass_fwd32<16>(X, tid); __syncthreads(); pass_c_mul_inv(X, Hs, tid); __syncthreads(); CV_STEP(); pass_inv32<16>(X, tid); __syncthreads(); CV_STEP(); pass_inv32<512, true>(X, tid); __syncthreads();
        {
            float v0[16], v1[16], x0[16], x1[16];
            sconv16(u0, tid, wv[0][0], wv[0][1], wv[0][2], bv[0], v0); sconv16(u1, tid, wv[0][0], wv[0][1], wv[0][2], bv[0], v1);
            sconv16(u0 + (size_t)HYW * SEQ, tid, wv[1][0], wv[1][1], wv[1][2], bv[1], x0); sconv16(u1 + (size_t)HYW * SEQ, tid, wv[1][0], wv[1][1], wv[1][2], bv[1], x1);
#pragma unroll
            for (int i = 0; i < 16; ++i) { const f32x2 y1 = X[pc + i]; z0[i] = x0[i] * (y1[0] + d1 * v0[i]); z1[i] = x1[i] * (y1[1] + d1 * v1[i]); X[pc + i] = (f32x2){z0[i], z1[i]}; }
        }
        __syncthreads();
        CV_STEP(); pass_fwd32<512, true>(X, tid); __syncthreads(); CV_STEP(); pass_fwd32<16>(X, tid); __syncthreads(); pass_c_mul_inv(X, Hs + FFTN, tid); __syncthreads(); CV_STEP(); pass_inv32<16>(X, tid); __syncthreads(); CV_STEP(); pass_inv32<512, true>(X, tid); __syncthreads();
        {
            float x0[16], x1[16];
            sconv16(u0 + (size_t)2 * HYW * SEQ, tid, wv[2][0], wv[2][1], wv[2][2], bv[2], x0); sconv16(u1 + (size_t)2 * HYW * SEQ, tid, wv[2][0], wv[2][1], wv[2][2], bv[2], x1);
            unsigned w0[8], w1[8];
#pragma unroll
            for (int i = 0; i < 8; ++i) { const f32x2 ya = X[pc + 2 * i], yb = X[pc + 2 * i + 1];
                w0[i] = pk2(x0[2 * i] * (ya[0] + d2 * z0[2 * i]), x0[2 * i + 1] * (yb[0] + d2 * z0[2 * i + 1]));
                w1[i] = pk2(x1[2 * i] * (ya[1] + d2 * z1[2 * i]), x1[2 * i + 1] * (yb[1] + d2 * z1[2 * i + 1])); }
            u32x4* y0p = (u32x4*)(YT + ((size_t)(2 * bp) * HYW + c) * SEQ + 16 * tid); u32x4* y1p = (u32x4*)(YT + ((size_t)(2 * bp + 1) * HYW + c) * SEQ + 16 * tid);
            y0p[0] = (u32x4){w0[0], w0[1], w0[2], w0[3]}; y0p[1] = (u32x4){w0[4], w0[5], w0[6], w0[7]};
            y1p[0] = (u32x4){w1[0], w1[1], w1[2], w1[3]}; y1p[1] = (u32x4){w1[4], w1[5], w1[6], w1[7]};
        }
        __syncthreads();
    }
#undef CV_STEP
}

__device__ __forceinline__ void filter_item(const Args& a, int item, int lane) {
    const int ct = item & 127, tc = item >> 7;
    const float* hid2 = (const float*)(a.ws + WS_HID2); const float* wout = a.in[I_FWOUT]; float* HF = (float*)(a.ws + WS_HF);
    const int col = 16 * ct + (lane & 15), kq = lane >> 4, cch = col & 511;
    float bf[16];
#pragma unroll
    for (int s = 0; s < 16; ++s) bf[s] = wout[(size_t)(16 * kq + s) * 2048 + col];
    const float dlt = fabsf(-3.0701134573253945f + (float)cch * ((-15.350567286626973f + 3.0701134573253945f) / 511.f));
#pragma unroll 2
    for (int tt = 0; tt < 32; ++tt) { const int t0 = 512 * tc + 16 * tt;
        const f32x4* ar = (const f32x4*)(hid2 + (size_t)(t0 + (lane & 15)) * 64 + 16 * kq);
        const f32x4 a0 = ar[0], a1 = ar[1], a2 = ar[2], a3 = ar[3];
        f32x4 acc = {0.f, 0.f, 0.f, 0.f};
#pragma unroll
        for (int e = 0; e < 4; ++e) { acc = __builtin_amdgcn_mfma_f32_16x16x4f32(a0[e], bf[e], acc, 0, 0, 0); }
#pragma unroll
        for (int e = 0; e < 4; ++e) { acc = __builtin_amdgcn_mfma_f32_16x16x4f32(a1[e], bf[4 + e], acc, 0, 0, 0); }
#pragma unroll
        for (int e = 0; e < 4; ++e) { acc = __builtin_amdgcn_mfma_f32_16x16x4f32(a2[e], bf[8 + e], acc, 0, 0, 0); }
#pragma unroll
        for (int e = 0; e < 4; ++e) { acc = __builtin_amdgcn_mfma_f32_16x16x4f32(a3[e], bf[12 + e], acc, 0, 0, 0); }
        f32x4 o;
#pragma unroll
        for (int r = 0; r < 4; ++r) o[r] = acc[r] * __expf(-((float)(t0 + 4 * kq + r) / (float)(SEQ - 1)) * dlt);
        *(f32x4*)(HF + (size_t)col * SEQ + t0 + 4 * kq) = o; }
}

__device__ __forceinline__ void transpose_item(const Args& a, int item, int lane) {
    const int lt = item & 127, ct = (item >> 7) & 7, b = item >> 10;
    const bf16_t* src = (const bf16_t*)(a.ws + WS_YHYT) + ((size_t)b * HYW + 64 * ct) * SEQ + 64 * lt + lane;
    bf16_t* dst = (bf16_t*)(a.ws + WS_MIX) + ((size_t)b * SEQ + 64 * lt + lane) * 1024 + 512 + 64 * ct;
    unsigned short v[64];
#pragma unroll
    for (int cc = 0; cc < 64; ++cc) v[cc] = src[(size_t)cc * SEQ];
#pragma unroll
    for (int q = 0; q < 8; ++q)
        *(u32x4*)(dst + 8 * q) = (u32x4){(unsigned)v[8 * q] | ((unsigned)v[8 * q + 1] << 16), (unsigned)v[8 * q + 2] | ((unsigned)v[8 * q + 3] << 16),
                                         (unsigned)v[8 * q + 4] | ((unsigned)v[8 * q + 5] << 16), (unsigned)v[8 * q + 6] | ((unsigned)v[8 * q + 7] << 16)};
}
}

__device__ __forceinline__ void p0_mod_and_filter(const Args& a, LAS unsigned char* lds) {
    const int tid = threadIdx.x, lane = tid & 63, wave = tid >> 6;
    const float* c = a.in[I_C]; const float* cctx = a.in[I_CCTX]; const float* adaw = a.in[I_ADAW]; const float* adab = a.in[I_ADAB];
    float* mod = (float*)(a.ws + WS_MOD);
    LAS float* sl = (LAS float*)lds;
    LAS float* pt = (LAS float*)lds + 5 * 1024;
    for (int i = tid; i < 5 * 1024; i += NTHREADS) { const int r = i >> 10, k = i & 1023; sl[i] = silu_f(r < 4 ? c[r * 1024 + k] : cctx[k]); }
    for (int it = blockIdx.x; it < 256; it += gridDim.x) {
        __syncthreads();
        if (tid < 504) {
            const int col = tid % 24, ks = tid / 24, n = it * 24 + col, kbeg = ks * 49, kend = (kbeg + 49 < 1024) ? kbeg + 49 : 1024;
            float acc[5] = {0.f, 0.f, 0.f, 0.f, 0.f};
#pragma unroll 7
            for (int k = kbeg; k < kend; ++k) { const float w = adaw[(size_t)k * 6144 + n];
#pragma unroll
                for (int r = 0; r < 5; ++r) acc[r] += sl[r * 1024 + k] * w; }
#pragma unroll
            for (int r = 0; r < 5; ++r) pt[(ks * 5 + r) * 24 + col] = acc[r];
        }
        __syncthreads();
        if (tid < 120) { const int r = tid / 24, col = tid % 24, n = it * 24 + col; float s = adab[n];
            for (int ks = 0; ks < 21; ++ks) s += pt[(ks * 5 + r) * 24 + col];
            mod[r * 6144 + n] = s; }
    }
    __syncthreads();
    const float* w1 = a.in[I_FW1]; const float* b1 = a.in[I_FB1]; const float* w2 = a.in[I_FW2]; const float* b2 = a.in[I_FB2]; const float* fq = a.in[I_FFREQ];
    float* hid2 = (float*)(a.ws + WS_HID2);
    LAS float* zs = (LAS float*)lds + 8192 + wave * 128;
    const float frq = fq[lane], bb1 = b1[lane], bb2 = b2[lane];
    for (int t = (blockIdx.x * NWAVES + wave); t < SEQ; t += gridDim.x * NWAVES) {
        float z = 0.f;
        if (lane == 0) z = (float)t / (float)(SEQ - 1);
        else if (lane < 33) { const int i = (lane - 1) & 15; const float f = 1e-4f + (float)i * ((15.f - 1e-4f) / 15.f);
            const float ang = (6.283185307179586f * (float)t / (float)SEQ) * f; z = (lane < 17) ? cosf(ang) : -sinf(ang); }
        if (lane < 33) zs[lane] = z;
        __builtin_amdgcn_wave_barrier(); asm volatile("s_waitcnt lgkmcnt(0)" ::: "memory");
        float s = bb1;
#pragma unroll
        for (int e = 0; e < 33; ++e) s += zs[e] * w1[e * 64 + lane];
        const float h1 = sinf(frq * s);
        zs[64 + lane] = h1;
        __builtin_amdgcn_wave_barrier(); asm volatile("s_waitcnt lgkmcnt(0)" ::: "memory");
        float s2 = bb2;
#pragma unroll 16
        for (int g = 0; g < 64; ++g) s2 += zs[64 + g] * w2[g * 64 + lane];
        hid2[(size_t)t * 64 + lane] = sinf(frq * s2);
        __builtin_amdgcn_wave_barrier(); asm volatile("s_waitcnt lgkmcnt(0)" ::: "memory");
    }
}

template <bool FP8 = false>
__device__ __forceinline__ void tr_item(const float* W, int ldw, int k0, int c0, int cstride, float scale, bf16_t* dstrow0, LAS float* scr, int lane) {
    float wv_[32];
#pragma unroll
    for (int i = 0; i < 32; ++i) wv_[i] = W[(size_t)(k0 + 2 * i + (lane >> 5)) * ldw + c0 + (lane & 31) * cstride];
#pragma unroll
    for (int i = 0; i < 32; ++i) scr[(2 * i + (lane >> 5)) * 33 + (lane & 31)] = wv_[i] * scale;
    asm volatile("s_waitcnt lgkmcnt(0)" ::: "memory"); __builtin_amdgcn_wave_barrier();
    const int c = lane & 7;
#pragma unroll
    for (int j = 0; j < 4; ++j) { const int n = (lane >> 3) + 8 * j; const LAS float* s = scr + (8 * c) * 33 + n;
        if (FP8) { u32x2 o; o.x = gm::pk4_fp8(s[0 * 33], s[1 * 33], s[2 * 33], s[3 * 33]); o.y = gm::pk4_fp8(s[4 * 33], s[5 * 33], s[6 * 33], s[7 * 33]);
            *(u32x2*)((unsigned char*)dstrow0 + (size_t)n * 1024 + k0 + 8 * c) = o; }
        else { u32x4 o; o.x = pk2(s[0 * 33], s[1 * 33]); o.y = pk2(s[2 * 33], s[3 * 33]); o.z = pk2(s[4 * 33], s[5 * 33]); o.w = pk2(s[6 * 33], s[7 * 33]);
            *(u32x4*)(dstrow0 + (size_t)n * 1024 + k0 + 8 * c) = o; } }
    asm volatile("s_waitcnt lgkmcnt(0)" ::: "memory"); __builtin_amdgcn_wave_barrier();
}
__device__ __forceinline__ void fold_item(const float* win, const float* wa, int dir, int k0, int j0, bf16_t* dstrow0, LAS float* scr, int lane) {
#pragma unroll 4
    for (int i = 0; i < 32; ++i) { const int kk = 2 * i + (lane >> 5); const float* wr = win + (size_t)(k0 + kk) * INW + 1536 + 16 * dir; float s = 0.f;
#pragma unroll
        for (int r = 0; r < 16; ++r) s += wr[r] * wa[r * 256 + j0 + (lane & 31)];
        scr[kk * 33 + (lane & 31)] = s; }
    asm volatile("s_waitcnt lgkmcnt(0)" ::: "memory"); __builtin_amdgcn_wave_barrier();
    const int c = lane & 7;
#pragma unroll
    for (int j = 0; j < 4; ++j) { const int n = (lane >> 3) + 8 * j; const LAS float* s = scr + (8 * c) * 33 + n;
        u32x4 o; o.x = pk2(s[0 * 33], s[1 * 33]); o.y = pk2(s[2 * 33], s[3 * 33]); o.z = pk2(s[4 * 33], s[5 * 33]); o.w = pk2(s[6 * 33], s[7 * 33]);
        *(u32x4*)(dstrow0 + (size_t)n * 1024 + k0 + 8 * c) = o; }
    asm volatile("s_waitcnt lgkmcnt(0)" ::: "memory"); __builtin_amdgcn_wave_barrier();
}
__device__ __forceinline__ void ln_mod_row(const float* xrow, const float* shift, const float* scale, bf16_t* orow, int lane) {
    const f32x4* xr = (const f32x4*)xrow + lane;
    f32x4 v[4]; float s = 0.f;
#pragma unroll
    for (int j = 0; j < 4; ++j) { v[j] = xr[64 * j]; s += (v[j][0] + v[j][1]) + (v[j][2] + v[j][3]); }
    const float mean = wave_sum(s) * (1.f / D); float s2 = 0.f;
#pragma unroll
    for (int j = 0; j < 4; ++j) { v[j] = v[j] - mean; s2 += (v[j][0] * v[j][0] + v[j][1] * v[j][1]) + (v[j][2] * v[j][2] + v[j][3] * v[j][3]); }
    const float rstd = 1.f / sqrtf(wave_sum(s2) * (1.f / D) + LN_EPS);
    u32x2* o8 = (u32x2*)orow + lane;
#pragma unroll
    for (int j = 0; j < 4; ++j) { const f32x4 sh = ((const f32x4*)shift)[64 * j + lane], sc = ((const f32x4*)scale)[64 * j + lane];
        const f32x4 y = v[j] * rstd * (sc + 1.f) + sh;
        u32x2 w; w.x = pk2(y[0], y[1]); w.y = pk2(y[2], y[3]); o8[64 * j] = w; }
}
constexpr int PREP_I_IN = 16 * 96, PREP_I_FOLD = 16 * 8 * 2, PREP_I_OUT = 16 * 32, PREP_I_W1 = NE * 16 * 64, PREP_I_W2 = NE * 16 * 32;
constexpr int PREP_NITEMS = PREP_I_IN + PREP_I_FOLD + PREP_I_OUT + PREP_I_W1 + PREP_I_W2;
constexpr int PREP_DEFER = 10880;
__device__ __forceinline__ void prep_items(const Args& a, LAS float* scr, int first, int last, int rank, int nranks, int lane) {
    constexpr int I_IN = PREP_I_IN, I_FOLD = PREP_I_FOLD, I_OUT = PREP_I_OUT, I_W1 = PREP_I_W1;
    const float* win = a.in[I_WIN];
    bf16_t* btin = (bf16_t*)(a.ws + WS_BTIN); bf16_t* btout = (bf16_t*)(a.ws + WS_BTOUT); bf16_t* w1t = (bf16_t*)(a.ws + WS_W1T); bf16_t* w2t = (bf16_t*)(a.ws + WS_W2T);
    for (int it = first + rank; it < last; it += nranks) {
        int r = it;
        if (r < I_IN) {
            const int kb = r / 96, nb = r % 96;
            if (nb < 48) tr_item(win, INW, 64 * kb, 32 * nb, 1, nb < 8 ? 0.125f : 1.f, btin + (size_t)(32 * nb) * 1024, scr, lane);
            else tr_item(win, INW, 64 * kb, 1568 + 32 * (nb - 48), 1, 1.f, btin + (size_t)(2048 + 32 * (nb - 48)) * 1024, scr, lane);
            continue; }
        r -= I_IN;
        if (r < I_FOLD) { const int dir = r & 1, jb = (r >> 1) & 7, kb = r >> 4;
            fold_item(win, dir ? a.in[I_WAB] : a.in[I_WAF], dir, 64 * kb, 32 * jb, btin + (size_t)(1536 + 256 * dir + 32 * jb) * 1024, scr, lane); continue; }
        r -= I_FOLD;
        if (r < I_OUT) { const int kb = r / 32, nb = r % 32; tr_item(a.in[I_WOUT], 1024, 64 * kb, 32 * nb, 1, 1.f, btout + (size_t)(32 * nb) * 1024, scr, lane); continue; }
        r -= I_OUT;
        if (r < I_W1) {
            const int e = r / 1024, q = r % 1024, s = q & 1, nb = (q >> 1) & 31, kb = q >> 6;
            const int ct = nb >> 2, jj0 = (nb & 3) * 32;
            tr_item<true>(a.in[I_EW1] + (size_t)e * 1024 * 2048, 2048, 64 * kb, 2 * (128 * ct + jj0) + s, 2, gm::S_W, (bf16_t*)((unsigned char*)w1t + ((size_t)e * 2048 + 256 * ct + 128 * s + jj0) * 1024), scr, lane);
            continue; }
        r -= I_W1;
        { const int e = r / 512, q = r % 512, kb = q / 32, nb = q % 32;
          tr_item<true>(a.in[I_EW2] + (size_t)e * 1024 * 1024, 1024, 64 * kb, 32 * nb, 1, gm::S_W, (bf16_t*)((unsigned char*)w2t + ((size_t)e * 1024 + 32 * nb) * 1024), scr, lane); }
    }
}
__device__ __forceinline__ void p1_prep(const Args& a, LAS unsigned char* lds) {
    const int tid = threadIdx.x, lane = tid & 63, wave = tid >> 6;
    LAS float* scr = (LAS float*)(lds + wave * 16384);
    const int gw = blockIdx.x * NWAVES + wave, NGW = gridDim.x * NWAVES;
    const float* win = a.in[I_WIN];
    bf16_t* btin = (bf16_t*)(a.ws + WS_BTIN); bf16_t* btout = (bf16_t*)(a.ws + WS_BTOUT); bf16_t* w1t = (bf16_t*)(a.ws + WS_W1T); bf16_t* w2t = (bf16_t*)(a.ws + WS_W2T);
    const float* mod = (const float*)(a.ws + WS_MOD);
    bf16_t* H = (bf16_t*)(a.ws + WS_H);
#pragma unroll 2
    for (int row = gw; row < TT; row += NGW) {
        const float* xr; int mr;
        if (row < T) { xr = a.in[I_X] + (size_t)row * D; mr = row >> 13; } else { xr = a.in[I_CTX] + (size_t)(row - T) * D; mr = 4; }
        ln_mod_row(xr, mod + mr * 6144, mod + mr * 6144 + 1024, H + (size_t)row * D, lane);
    }
    prep_items(a, scr, 0, PREP_I_IN + PREP_I_FOLD + PREP_I_OUT, gw, NGW, lane);
    prep_items(a, scr, PREP_I_IN + PREP_I_FOLD + PREP_I_OUT + PREP_I_W1, PREP_NITEMS - PREP_DEFER, gw, NGW, lane);
    for (int it = gw; it < 2048; it += NGW) hy::filter_item(a, it, lane);
    float* b1r = (float*)(a.ws + WS_B1R); const float* eb1 = a.in[I_EB1];
    for (int i = blockIdx.x * NTHREADS + tid; i < NE * 2048; i += gridDim.x * NTHREADS) {
        const int e = i >> 11, n = i & 2047, ct = n >> 8, s = (n >> 7) & 1, jj = n & 127;
        b1r[i] = eb1[(size_t)e * 2048 + 2 * (128 * ct + jj) + s];
    }
}

namespace gla {
constexpr int RS = 72;
constexpr int L_TOTF = 0, L_TOTB = 2048, L_SSQ = 4096;
constexpr int L_T0 = 8192;
constexpr int L_T1 = L_T0 + 9216, L_T2 = L_T1 + 9216, L_T3 = L_T2 + 9216;
constexpr int L_VT = L_T3 + 9216;
constexpr int L_P  = L_VT + 18432;
constexpr int L_SF = L_P + 9216, L_SB = L_SF + 18432;
constexpr int L_END = L_SB + 18432;

__device__ __forceinline__ bf16x8 frag(const LAS unsigned char* tile, int row, int k0, int lane) {
    return *(const LAS bf16x8*)(tile + ((row + (lane & 15)) * RS + k0 + 8 * (lane >> 4)) * 2);
}
__device__ __forceinline__ void chunk_cums_pre(LAS unsigned char* L, const float (&gf)[8], const float (&gb)[8], int wave, int lane, float (&cumf)[8], float (&cumb)[8], float& allf, float& allb) {
    LAS float* totf = (LAS float*)(L + L_TOTF); LAS float* totb = (LAS float*)(L + L_TOTB);
    cumf[0] = gf[0];
#pragma unroll
    for (int r = 1; r < 8; ++r) cumf[r] = cumf[r - 1] + gf[r];
    cumb[7] = gb[7];
#pragma unroll
    for (int r = 6; r >= 0; --r) cumb[r] = cumb[r + 1] + gb[r];
    totf[wave * 64 + lane] = cumf[7]; totb[wave * 64 + lane] = cumb[0];
    __syncthreads();
    float of = 0.f, ob = 0.f, af = 0.f, ab = 0.f;
#pragma unroll
    for (int w = 0; w < 8; ++w) { const float tf = totf[w * 64 + lane], tb = totb[w * 64 + lane]; af += tf; ab += tb; of += (w < wave) ? tf : 0.f; ob += (w > wave) ? tb : 0.f; }
#pragma unroll
    for (int r = 0; r < 8; ++r) { cumf[r] += of; cumb[r] += ob; }
    allf = af; allb = ab;
}
__device__ __forceinline__ void chunk_cums(LAS unsigned char* L, const float* GF, const float* GB, size_t tok0, int h, int wave, int lane, float (&cumf)[8], float (&cumb)[8], float& allf, float& allb) {
    float gf[8], gb[8];
#pragma unroll
    for (int r = 0; r < 8; ++r) { const size_t o = (tok0 + 8 * wave + r) * 256 + h * 64 + lane; gf[r] = GF[o]; gb[r] = GB[o]; }
    chunk_cums_pre(L, gf, gb, wave, lane, cumf, cumb, allf, allb);
}
__device__ __forceinline__ void store_vt(LAS unsigned char* L, const u32x4 (&vr)[2], int tid) {
    LAS bf16_t* vt = (LAS bf16_t*)(L + L_VT);
    const int j = tid >> 3, c8 = tid & 7;
#pragma unroll
    for (int q = 0; q < 2; ++q) { const int dv0 = 8 * (c8 + 8 * q);
        const unsigned ww[4] = {vr[q].x, vr[q].y, vr[q].z, vr[q].w};
#pragma unroll
        for (int e = 0; e < 4; ++e) { vt[(dv0 + 2 * e) * RS + j] = (bf16_t)(ww[e] & 0xffffu); vt[(dv0 + 2 * e + 1) * RS + j] = (bf16_t)(ww[e] >> 16); } }
}
__device__ __forceinline__ void load_vt(LAS unsigned char* L, const bf16_t* V, size_t tok0, int h, int tid) {
    const int j = tid >> 3, c8 = tid & 7; u32x4 vr[2];
#pragma unroll
    for (int q = 0; q < 2; ++q) vr[q] = *(const u32x4*)(V + (tok0 + j) * 512 + h * 128 + 8 * (c8 + 8 * q));
    store_vt(L, vr, tid);
}

__device__ __forceinline__ void g1_unit(const Args& a, LAS unsigned char* L, int bh, int chunk  ) {
    const int tid = threadIdx.x, lane = tid & 63, wave = __builtin_amdgcn_readfirstlane(tid >> 6);
    const int b = bh >> 2, h = bh & 3;
    const size_t tok0 = chunk < NCHUNK ? (size_t)b * SEQ + (size_t)chunk * CH : (size_t)T + (size_t)b * CTXL + (size_t)(chunk - NCHUNK) * CH;
    const float* GF = (const float*)(a.ws + WS_GF); const float* GB = (const float*)(a.ws + WS_GB);
    const bf16_t* Kb = (const bf16_t*)(a.ws + WS_K); const bf16_t* Vb = (const bf16_t*)(a.ws + WS_V);
    float cumf[8], cumb[8], allf, allb;
    __syncthreads();
    chunk_cums(L, GF, GB, tok0, h, wave, lane, cumf, cumb, allf, allb);
    LAS bf16_t* ketf = (LAS bf16_t*)(L + L_T0); LAS bf16_t* ketb = (LAS bf16_t*)(L + L_T1);
#pragma unroll
    for (int r = 0; r < 8; ++r) { const int i = 8 * wave + r; const float kv = bf2f(Kb[(tok0 + i) * 256 + h * 64 + lane]);
        ketf[lane * RS + i] = f2bf(kv * __expf(allf - cumf[r])); ketb[lane * RS + i] = f2bf(kv * __expf(allb - cumb[r])); }
    load_vt(L, Vb, tok0, h, tid);
    if (wave == 0) { float* av = (float*)(a.ws + WS_AV); av[((size_t)(0 * 16 + bh) * NCT + chunk) * 64 + lane] = __expf(allf); av[((size_t)(1 * 16 + bh) * NCT + chunk) * 64 + lane] = __expf(allb); }
    __syncthreads();
    bf16_t* KV = (bf16_t*)(a.ws + WS_KV);
#pragma unroll
    for (int dir = 0; dir < 2; ++dir) {
        const LAS unsigned char* ket = L + (dir ? L_T1 : L_T0);
        bf16_t* dst = KV + ((size_t)(dir * 16 + bh) * NCT + chunk) * 8192;
#pragma unroll
        for (int nt = 0; nt < 4; ++nt) { f32x4 acc = {0.f, 0.f, 0.f, 0.f};
#pragma unroll
            for (int ks = 0; ks < 2; ++ks) acc = __builtin_amdgcn_mfma_f32_16x16x32_bf16(frag(L + L_VT, 16 * wave, 32 * ks, lane), frag(ket, 16 * nt, 32 * ks, lane), acc, 0, 0, 0);
#pragma unroll
            for (int r = 0; r < 4; ++r) dst[(16 * wave + 4 * (lane >> 4) + r) * 64 + 16 * nt + (lane & 15)] = f2bf(acc[r]); }
    }
}

__device__ __forceinline__ void g2_scan(const Args& a) {
    const bf16_t* KV = (const bf16_t*)(a.ws + WS_KV); const float* AV = (const float*)(a.ws + WS_AV); bf16_t* SP = (bf16_t*)(a.ws + WS_SP);
    for (int id = blockIdx.x * NTHREADS + threadIdx.x; id < 32 * 4096; id += gridDim.x * NTHREADS) {
        const int db = id >> 12, e2 = id & 4095, dir = db >> 4, dk = (2 * e2) & 63;
        const unsigned* kv = (const unsigned*)(KV + (size_t)db * NCT * 8192) + e2;
        const float* av = AV + (size_t)db * NCT * 64 + dk;
        unsigned* sp = (unsigned*)(SP + (size_t)db * NCHUNK * 8192) + e2;
        float s0 = 0.f, s1 = 0.f;
#pragma unroll
        for (int q = 0; q < NCC; ++q) { const int c = NCHUNK + (dir ? (NCC - 1 - q) : q);
            const unsigned w = kv[(size_t)c * 4096]; const f32x2 aa = *(const f32x2*)(av + (size_t)c * 64);
            s0 = aa[0] * s0 + bflo(w); s1 = aa[1] * s1 + bfhi(w); }
        for (int q0 = 0; q0 < NCHUNK; q0 += 16) {
            unsigned w[16]; f32x2 aa[16];
#pragma unroll
            for (int u = 0; u < 16; ++u) { const int c = dir ? (NCHUNK - 1 - (q0 + u)) : (q0 + u); w[u] = kv[(size_t)c * 4096]; aa[u] = *(const f32x2*)(av + (size_t)c * 64); }
#pragma unroll
            for (int u = 0; u < 16; ++u) { const int c = dir ? (NCHUNK - 1 - (q0 + u)) : (q0 + u);
                sp[(size_t)c * 4096] = pk2(s0, s1);
                s0 = aa[u][0] * s0 + bflo(w[u]); s1 = aa[u][1] * s1 + bfhi(w[u]); }
        }
    }
}

struct G3In { float gf[8], gb[8]; bf16_t q[8], k[8]; u32x4 v[2]; u32x4 sraw[4]; bf16_t gr[4][4]; };
__device__ __forceinline__ void g3_load(const Args& a, int bh, int chunk, G3In& in) {
    const int tid = threadIdx.x, lane = tid & 63, wave = __builtin_amdgcn_readfirstlane(tid >> 6);
    const int b = bh >> 2, h = bh & 3;
    const size_t tok0 = (size_t)b * SEQ + (size_t)chunk * CH;
    const float* GF = (const float*)(a.ws + WS_GF); const float* GB = (const float*)(a.ws + WS_GB);
    const bf16_t* Qb = (const bf16_t*)(a.ws + WS_Q); const bf16_t* Kb = (const bf16_t*)(a.ws + WS_K); const bf16_t* Vb = (const bf16_t*)(a.ws + WS_V);
#pragma unroll
    for (int r = 0; r < 8; ++r) { const size_t o = (tok0 + 8 * wave + r) * 256 + h * 64 + lane; in.gf[r] = GF[o]; in.gb[r] = GB[o]; in.q[r] = Qb[o]; in.k[r] = Kb[o]; }
#pragma unroll
    for (int q = 0; q < 2; ++q) in.v[q] = *(const u32x4*)(Vb + (tok0 + (tid >> 3)) * 512 + h * 128 + 8 * ((tid & 7) + 8 * q));
    const bf16_t* SPf = (const bf16_t*)(a.ws + WS_SP) + ((size_t)(0 * 16 + bh) * NCHUNK + chunk) * 8192;
    const bf16_t* SPb = (const bf16_t*)(a.ws + WS_SP) + ((size_t)(1 * 16 + bh) * NCHUNK + chunk) * 8192;
    in.sraw[0] = *(const u32x4*)(SPf + 16 * tid); in.sraw[1] = *(const u32x4*)(SPf + 16 * tid + 8);
    in.sraw[2] = *(const u32x4*)(SPb + 16 * tid); in.sraw[3] = *(const u32x4*)(SPb + 16 * tid + 8);
    const bf16_t* Gt = (const bf16_t*)(a.ws + WS_G);
    const int mt = wave >> 1, fr = lane & 15, fq = lane >> 4;
#pragma unroll
    for (int q = 0; q < 4; ++q)
#pragma unroll
        for (int r = 0; r < 4; ++r) in.gr[r][q] = Gt[(tok0 + 16 * mt + 4 * fq + r) * 512 + h * 128 + 16 * (4 * (wave & 1) + q) + fr];
}
__device__ __forceinline__ void g3_unit(const Args& a, LAS unsigned char* L, int bh, int chunk  , const G3In& in, hy::CvState& cvs) {
    const int tid = threadIdx.x, lane = tid & 63, wave = __builtin_amdgcn_readfirstlane(tid >> 6);
    const int b = bh >> 2, h = bh & 3;
    const size_t tok0 = (size_t)b * SEQ + (size_t)chunk * CH;
    const int mt = wave >> 1, fr = lane & 15, fq = lane >> 4;
    float cumf[8], cumb[8], allf, allb;
    hy::cv_step(a, cvs, lane);
    __syncthreads();
    chunk_cums_pre(L, in.gf, in.gb, wave, lane, cumf, cumb, allf, allb);
    LAS bf16_t* qf = (LAS bf16_t*)(L + L_T0); LAS bf16_t* kf = (LAS bf16_t*)(L + L_T1); LAS bf16_t* qb = (LAS bf16_t*)(L + L_T2); LAS bf16_t* kb = (LAS bf16_t*)(L + L_T3);
#pragma unroll
    for (int r = 0; r < 8; ++r) { const int i = 8 * wave + r;
        const float qv = bf2f(in.q[r]), kv = bf2f(in.k[r]);
        qf[i * RS + lane] = f2bf(qv * __expf(cumf[r])); kf[i * RS + lane] = f2bf(kv * __expf(-cumf[r]));
        qb[i * RS + lane] = f2bf(qv * __expf(cumb[r])); kb[i * RS + lane] = f2bf(kv * __expf(-cumb[r])); }
    store_vt(L, in.v, tid);
    {
      LAS unsigned char* sf_ = L + L_SF + ((tid >> 2) * RS + 16 * (tid & 3)) * 2; LAS unsigned char* sb_ = L + L_SB + ((tid >> 2) * RS + 16 * (tid & 3)) * 2;
      *(LAS u32x4*)sf_ = in.sraw[0]; *(LAS u32x4*)(sf_ + 16) = in.sraw[1]; *(LAS u32x4*)sb_ = in.sraw[2]; *(LAS u32x4*)(sb_ + 16) = in.sraw[3]; }
    hy::cv_step(a, cvs, lane);
    __syncthreads();
    {
        LAS bf16_t* P = (LAS bf16_t*)(L + L_P);
#pragma unroll
        for (int q = 0; q < 2; ++q) { const int nt = 2 * (wave & 1) + q;
            f32x4 sf = {0.f, 0.f, 0.f, 0.f}, sb = {0.f, 0.f, 0.f, 0.f};
#pragma unroll
            for (int ks = 0; ks < 2; ++ks) {
                sf = __builtin_amdgcn_mfma_f32_16x16x32_bf16(frag(L + L_T0, 16 * mt, 32 * ks, lane), frag(L + L_T1, 16 * nt, 32 * ks, lane), sf, 0, 0, 0);
                sb = __builtin_amdgcn_mfma_f32_16x16x32_bf16(frag(L + L_T2, 16 * mt, 32 * ks, lane), frag(L + L_T3, 16 * nt, 32 * ks, lane), sb, 0, 0, 0); }
#pragma unroll
            for (int r = 0; r < 4; ++r) { const int i = 16 * mt + 4 * fq + r, j = 16 * nt + fr;
                P[i * RS + j] = f2bf((j <= i ? sf[r] : 0.f) + (j >= i ? sb[r] : 0.f)); } }
    }
    hy::cv_step(a, cvs, lane);
    __syncthreads();
    f32x4 o[4]; float ssq[4] = {0.f, 0.f, 0.f, 0.f};
#pragma unroll
    for (int q = 0; q < 4; ++q) { const int nt = 4 * (wave & 1) + q;
        f32x4 acc = {0.f, 0.f, 0.f, 0.f};
#pragma unroll
        for (int ks = 0; ks < 2; ++ks) {
            acc = __builtin_amdgcn_mfma_f32_16x16x32_bf16(frag(L + L_P, 16 * mt, 32 * ks, lane), frag(L + L_VT, 16 * nt, 32 * ks, lane), acc, 0, 0, 0);
            acc = __builtin_amdgcn_mfma_f32_16x16x32_bf16(frag(L + L_T0, 16 * mt, 32 * ks, lane), frag(L + L_SF, 16 * nt, 32 * ks, lane), acc, 0, 0, 0);
            acc = __builtin_amdgcn_mfma_f32_16x16x32_bf16(frag(L + L_T2, 16 * mt, 32 * ks, lane), frag(L + L_SB, 16 * nt, 32 * ks, lane), acc, 0, 0, 0); }
        o[q] = acc;
#pragma unroll
        for (int r = 0; r < 4; ++r) ssq[r] += acc[r] * acc[r]; }
    LAS float* SSQ = (LAS float*)(L + L_SSQ);
#pragma unroll
    for (int r = 0; r < 4; ++r) { float s = ssq[r]; s += __shfl_xor(s, 1); s += __shfl_xor(s, 2); s += __shfl_xor(s, 4); s += __shfl_xor(s, 8); ssq[r] = s; }
    if (fr == 0) {
#pragma unroll
        for (int r = 0; r < 4; ++r) SSQ[(wave & 1) * 64 + 16 * mt + 4 * fq + r] = ssq[r]; }
    hy::cv_step(a, cvs, lane);
    __syncthreads();
    const float* ng = a.in[I_NORMG];
    bf16_t* mix = (bf16_t*)(a.ws + WS_MIX);
#pragma unroll
    for (int r = 0; r < 4; ++r) { const int i = 16 * mt + 4 * fq + r;
        const float rstd = 1.f / sqrtf((SSQ[i] + SSQ[64 + i]) * (1.f / DV) + LN_EPS);
#pragma unroll
        for (int q = 0; q < 4; ++q) { const int dv = 16 * (4 * (wave & 1) + q) + fr;
            const float g = bf2f(in.gr[r][q]);
            mix[(tok0 + i) * 1024 + h * 128 + dv] = f2bf(o[q][r] * rstd * ng[dv] * silu_f(g)); } }
}
}

namespace rt {
constexpr int HS = 1028;
constexpr int L_H2 = 0;
constexpr int L_PART = 65792;
constexpr int L_LCNT = L_PART + 16384;
constexpr int L_REC = L_LCNT + 256;

__device__ __forceinline__ void phase(const Args& a, LAS unsigned char* lds) {
    const int tid = threadIdx.x, lane = tid & 63, wave = __builtin_amdgcn_readfirstlane(tid >> 6);
    bf16_t* xmid = (bf16_t*)(a.ws + WS_PRE1); bf16_t* H2 = (bf16_t*)(a.ws + WS_H2); const bf16_t* FG = (const bf16_t*)(a.ws + WS_FG);
    const float* mod = (const float*)(a.ws + WS_MOD);
    const float* rw = a.in[I_RW]; const float* rb = a.in[I_RB];
    LAS float* h2s = (LAS float*)(lds + L_H2); LAS float* part = (LAS float*)(lds + L_PART);
    LAS int* lcnt = (LAS int*)(lds + L_LCNT); LAS int* lbase = lcnt + 32; LAS int* rec = (LAS int*)(lds + L_REC);
    unsigned* cnt = (unsigned*)(a.ws + WS_CNT); int* list = (int*)(a.ws + WS_LIST); float* pw = (float*)(a.ws + WS_PW); int* ploc = (int*)(a.ws + WS_PLOC);
    float rwr[32][2];
#pragma unroll
    for (int s = 0; s < 32; ++s)
#pragma unroll
        for (int nt = 0; nt < 2; ++nt) rwr[s][nt] = rw[(size_t)(128 * wave + 4 * s + (lane >> 4)) * 32 + 16 * nt + (lane & 15)];
    const f32x4* g1 = (const f32x4*)a.in[I_LN1G]; const f32x4* bb1 = (const f32x4*)a.in[I_LN1B];
    if (tid < 32) lcnt[tid] = 0;
    f32x4 xq[2][4]; u32x2 fq_[2][4];
#define RT_LOAD(g_) do { _Pragma("unroll") for (int rr = 0; rr < 2; ++rr) { const int t_ = (g_) * 16 + 2 * wave + rr; \
        const f32x4* xr_ = (const f32x4*)(a.in[I_X] + (size_t)t_ * D) + lane; const u32x2* fr_ = (const u32x2*)(FG + (size_t)t_ * D) + lane; \
        _Pragma("unroll") for (int j = 0; j < 4; ++j) { xq[rr][j] = xr_[64 * j]; fq_[rr][j] = fr_[64 * j]; } } } while (0)
    if ((int)blockIdx.x < T / 16) RT_LOAD((int)blockIdx.x);
    for (int grp = blockIdx.x; grp < T / 16; grp += gridDim.x) {
        __syncthreads();
        f32x4 xv_[2][4]; u32x2 fv_[2][4];
#pragma unroll
        for (int rr = 0; rr < 2; ++rr)
#pragma unroll
            for (int j = 0; j < 4; ++j) { xv_[rr][j] = xq[rr][j]; fv_[rr][j] = fq_[rr][j]; }
        if (grp + (int)gridDim.x < T / 16) RT_LOAD(grp + (int)gridDim.x);
#pragma unroll
        for (int rr = 0; rr < 2; ++rr) {
            const int lr = 2 * wave + rr, t = grp * 16 + lr, b = t >> 13;
            u32x2* pr = (u32x2*)(xmid + (size_t)t * D) + lane;
            f32x4 v[4]; float s = 0.f;
#pragma unroll
            for (int j = 0; j < 4; ++j) { const u32x2 fw = fv_[rr][j]; const f32x4 ff = {bflo(fw.x), bfhi(fw.x), bflo(fw.y), bfhi(fw.y)};
                v[j] = xv_[rr][j] * ALPHA + ff; s += (v[j][0] + v[j][1]) + (v[j][2] + v[j][3]); }
            float mean = wave_sum(s) * (1.f / D), s2 = 0.f;
#pragma unroll
            for (int j = 0; j < 4; ++j) { v[j] = v[j] - mean; s2 += (v[j][0] * v[j][0] + v[j][1] * v[j][1]) + (v[j][2] * v[j][2] + v[j][3] * v[j][3]); }
            float rstd = 1.f / sqrtf(wave_sum(s2) * (1.f / D) + LN_EPS);
            s = 0.f;
#pragma unroll
            for (int j = 0; j < 4; ++j) { v[j] = v[j] * rstd * g1[64 * j + lane] + bb1[64 * j + lane]; u32x2 w; w.x = pk2(v[j][0], v[j][1]); w.y = pk2(v[j][2], v[j][3]); pr[64 * j] = w;
                v[j] = (f32x4){bflo(w.x), bfhi(w.x), bflo(w.y), bfhi(w.y)}; s += (v[j][0] + v[j][1]) + (v[j][2] + v[j][3]); }
            mean = wave_sum(s) * (1.f / D); s2 = 0.f;
#pragma unroll
            for (int j = 0; j < 4; ++j) { v[j] = v[j] - mean; s2 += (v[j][0] * v[j][0] + v[j][1] * v[j][1]) + (v[j][2] * v[j][2] + v[j][3] * v[j][3]); }
            rstd = 1.f / sqrtf(wave_sum(s2) * (1.f / D) + LN_EPS);
            const f32x4* sh = (const f32x4*)(mod + b * 6144 + 3 * 1024); const f32x4* sc = (const f32x4*)(mod + b * 6144 + 4 * 1024);
            unsigned* o4 = (unsigned*)((unsigned char*)H2 + (size_t)t * D) + lane;
#pragma unroll
            for (int j = 0; j < 4; ++j) { const f32x4 y = v[j] * rstd * (sc[64 * j + lane] + 1.f) + sh[64 * j + lane];
                o4[64 * j] = gm::pk4_fp8(y[0] * gm::S_H2, y[1] * gm::S_H2, y[2] * gm::S_H2, y[3] * gm::S_H2);
                *(LAS f32x4*)(h2s + lr * HS + 256 * j + 4 * lane) = y; }
        }
        __syncthreads();
        {
            f32x4 acc0 = {0.f, 0.f, 0.f, 0.f}, acc1 = {0.f, 0.f, 0.f, 0.f};
            const LAS float* ap = h2s + (lane & 15) * HS + 128 * wave + (lane >> 4);
#pragma unroll
            for (int s = 0; s < 32; ++s) { const float av = ap[4 * s];
                acc0 = __builtin_amdgcn_mfma_f32_16x16x4f32(av, rwr[s][0], acc0, 0, 0, 0);
                acc1 = __builtin_amdgcn_mfma_f32_16x16x4f32(av, rwr[s][1], acc1, 0, 0, 0); }
#pragma unroll
            for (int r = 0; r < 4; ++r) { part[(wave * 16 + 4 * (lane >> 4) + r) * 32 + (lane & 15)] = acc0[r]; part[(wave * 16 + 4 * (lane >> 4) + r) * 32 + 16 + (lane & 15)] = acc1[r]; }
        }
        __syncthreads();
        {
            const int lr = 2 * wave + (lane >> 5), e = lane & 31, t = grp * 16 + lr;
            float lg = rb[e];
#pragma unroll
            for (int w = 0; w < 8; ++w) lg += part[(w * 16 + lr) * 32 + e];
            float cur = lg, tv[4]; int ti[4];
#pragma unroll
            for (int k = 0; k < 4; ++k) { float bv = cur; int bi = e;
#pragma unroll
                for (int o = 1; o < 32; o <<= 1) { const float ov = __shfl_xor(bv, o); const int oi = __shfl_xor(bi, o); if (ov > bv || (ov == bv && oi < bi)) { bv = ov; bi = oi; } }
                tv[k] = bv; ti[k] = bi; if (bi == e) cur = -3.0e38f; }
            const float e1 = __expf(tv[1] - tv[0]), e2 = __expf(tv[2] - tv[0]), e3 = __expf(tv[3] - tv[0]);
            const float inv = 1.f / (1.f + e1 + e2 + e3);
            if (e < 4) { const float wk = (e == 0 ? 1.f : (e == 1 ? e1 : (e == 2 ? e2 : e3))) * inv; const int ek = (e == 0 ? ti[0] : (e == 1 ? ti[1] : (e == 2 ? ti[2] : ti[3])));
                const int pair = t * 4 + e;
                pw[pair] = wk;
                const int rank = __hip_atomic_fetch_add((LAS int*)&lcnt[ek], 1, __ATOMIC_RELAXED, __HIP_MEMORY_SCOPE_WORKGROUP);
                rec[lr * 4 + e] = ek | (rank << 8); }
        }
        __syncthreads();
        if (tid < 32) { const int n = lcnt[tid]; lbase[tid] = n ? (int)atomicAdd(&cnt[tid], (unsigned)n) : 0; }
        __syncthreads();
        if (tid < 64) { const int rc = rec[tid], ek = rc & 255, rank = rc >> 8, pos = lbase[ek] + rank, pair = (grp * 16 + (tid >> 2)) * 4 + (tid & 3);
            list[(size_t)ek * CAP + pos] = pair; ploc[pair] = ek | (pos << 5); }
        __syncthreads();
        if (tid < 32) lcnt[tid] = 0;
    }
#undef RT_LOAD
}
}

__device__ __forceinline__ void p_final(const Args& a, LAS unsigned char* lds) {
    const int tid = threadIdx.x, lane = tid & 63, wave = tid >> 6;
    const bf16_t* xm = (const bf16_t*)(a.ws + WS_PRE1); const unsigned char* slots = (const unsigned char*)(a.ws + WS_SLOTS); const float* mod = (const float*)(a.ws + WS_MOD);
    const int* ploc = (const int*)(a.ws + WS_PLOC); const float* pw = (const float*)(a.ws + WS_PW);
    const f32x4* g2 = (const f32x4*)a.in[I_LN2G]; const f32x4* b2 = (const f32x4*)a.in[I_LN2B];
    LAS int* tstart = (LAS int*)lds;
    __syncthreads();
    if (tid == 0) { const unsigned* cnt = (const unsigned*)(a.ws + WS_CNT); int nrt = 0; for (int e = 0; e < NE; ++e) { tstart[e] = 256 * nrt; nrt += ((int)cnt[e] + 255) >> 8; } }
    __syncthreads();
    const int tstep = gridDim.x * NWAVES; int t = blockIdx.x * NWAVES + wave;
    if (t < T) {
        int plc[4], pln[4]; float wc_[4], wn_[4]; unsigned qc[4][4], qn[4][4]; u32x2 xc[4], xn[4];
#define PF_IDX(tt, pl, ww) do { _Pragma("unroll") for (int sl = 0; sl < 4; ++sl) { pl[sl] = ploc[(tt) * 4 + sl]; ww[sl] = pw[(tt) * 4 + sl] * (1.f / gm::S_SL); } } while (0)
#define PF_DATA(tt, pl, qq, xx) do { _Pragma("unroll") for (int sl = 0; sl < 4; ++sl) { const unsigned* sr_ = (const unsigned*)(slots + (size_t)(tstart[pl[sl] & 31] + (pl[sl] >> 5)) * D) + lane; \
            _Pragma("unroll") for (int j = 0; j < 4; ++j) qq[sl][j] = sr_[64 * j]; } \
        { const u32x2* xr_ = (const u32x2*)(xm + (size_t)(tt) * D) + lane; _Pragma("unroll") for (int j = 0; j < 4; ++j) xx[j] = xr_[64 * j]; } } while (0)
        PF_IDX(t, plc, wc_); PF_DATA(t, plc, qc, xc);
        int tn = t + tstep; const bool hn0 = tn < T;
        if (hn0) PF_IDX(tn, pln, wn_);
        for (;;) {
            const bool hn = tn < T;
            if (hn) PF_DATA(tn, pln, qn, xn);
            int pl2[4]; float w2[4]; const int tn2 = tn + tstep; const bool hn2 = hn && tn2 < T;
            if (hn2) PF_IDX(tn2, pl2, w2);
            {
                const int b = t >> 13; const f32x4* gt = (const f32x4*)(mod + b * 6144 + 5 * 1024);
                f32x4 v[4]; float s = 0.f;
#pragma unroll
                for (int j = 0; j < 4; ++j) { f32x4 y = {0.f, 0.f, 0.f, 0.f};
#pragma unroll
                    for (int sl = 0; sl < 4; ++sl) { const int q = (int)qc[sl][j];
                        y[0] += wc_[sl] * __builtin_amdgcn_cvt_f32_fp8(q, 0); y[1] += wc_[sl] * __builtin_amdgcn_cvt_f32_fp8(q, 1); y[2] += wc_[sl] * __builtin_amdgcn_cvt_f32_fp8(q, 2); y[3] += wc_[sl] * __builtin_amdgcn_cvt_f32_fp8(q, 3); }
                    const f32x4 xv = {bflo(xc[j].x), bfhi(xc[j].x), bflo(xc[j].y), bfhi(xc[j].y)};
                    v[j] = xv * ALPHA + gt[64 * j + lane] * y; s += (v[j][0] + v[j][1]) + (v[j][2] + v[j][3]); }
                const float mean = wave_sum(s) * (1.f / D); float s2 = 0.f;
#pragma unroll
                for (int j = 0; j < 4; ++j) { v[j] = v[j] - mean; s2 += (v[j][0] * v[j][0] + v[j][1] * v[j][1]) + (v[j][2] * v[j][2] + v[j][3] * v[j][3]); }
                const float rstd = 1.f / sqrtf(wave_sum(s2) * (1.f / D) + LN_EPS);
                f32x4* o = (f32x4*)(a.out + (size_t)t * D) + lane;
#pragma unroll
                for (int j = 0; j < 4; ++j) o[64 * j] = v[j] * rstd * g2[64 * j + lane] + b2[64 * j + lane];
            }
            if (!hn) break;
            t = tn; tn = tn2;
#pragma unroll
            for (int sl = 0; sl < 4; ++sl) { plc[sl] = pln[sl]; wc_[sl] = wn_[sl]; pln[sl] = pl2[sl]; wn_[sl] = w2[sl];
#pragma unroll
                for (int j = 0; j < 4; ++j) qc[sl][j] = qn[sl][j]; }
#pragma unroll
            for (int j = 0; j < 4; ++j) xc[j] = xn[j];
        }
#undef PF_IDX
#undef PF_DATA
    }
}


constexpr int N_PHASES = 11;
__global__ void __launch_bounds__(NTHREADS, 2) mega_fwd(Args a) {
    extern __shared__ __attribute__((aligned(16))) unsigned char lds_raw[];
    LAS unsigned char* lds = (LAS unsigned char*)lds_raw;
    const int tid = threadIdx.x;
    volatile LAS unsigned* misc = (volatile LAS unsigned*)(lds + LDS_MISC);
    if (tid < 4) misc[tid] = 0u;
    __syncthreads();
    XcdBarrier bar; bar.bar = (unsigned*)(a.ws + WS_BAR); bar.x = 0; bar.st = misc;
    const bool multi = (a.ph_hi - a.ph_lo) > 1;
    if (multi) bar = xcd_barrier_post((unsigned*)(a.ws + WS_BAR), misc);
    const int lo = a.ph_lo, hi = a.ph_hi;
#define vcu ((gridDim.x % 8 == 0) ? (int)((blockIdx.x % 8) * (gridDim.x / 8) + blockIdx.x / 8) : (int)blockIdx.x)
#ifdef ONLY_PHASE
#define IN(k) ((k) == ONLY_PHASE && lo <= (k) && (k) < hi)
#else
#define IN(k) (lo <= (k) && (k) < hi)
#endif
#define SEAM(k) do { if (IN(k) && IN((k) + 1)) xcd_barrier(bar); } while (0)

#ifndef REPEAT_PHASE
#define REPEAT_PHASE -1
#endif
#ifdef PROF_REP
#define RUNPH(k, ...) do { if (IN(k)) { const int nrep_ = (a.rep_k == (k)) ? 2 : 1; for (int rep_ = 0; rep_ < nrep_; ++rep_) { if (rep_) xcd_barrier(bar); __VA_ARGS__; } } } while (0)
#else
#define RUNPH(k, ...) do { if (IN(k)) { __VA_ARGS__; if (REPEAT_PHASE == (k)) { xcd_barrier(bar); __VA_ARGS__; } } } while (0)
#endif
    RUNPH(0, p0_mod_and_filter(a, lds));
    SEAM(0);
    RUNPH(1, p1_prep(a, lds));
    SEAM(1);
    RUNPH(2, { gm::SchedIn S{a.ws, (int)gridDim.x, vcu, a.in[I_BAF], a.in[I_BAB]}; gm::EpiIn E{a.ws}; gm::gemm_stream<false, 0, false>(lds, S, E);
        {
          const int G = (int)gridDim.x, rounds = (1812 + G - 1) / G, extra = 1812 - (rounds - 1) * G, v = vcu;
          if (v >= extra || extra == G) { const int nidle = (extra == G) ? G : G - extra, ridle = (extra == G) ? v : v - extra; __syncthreads();
              prep_items(a, (LAS float*)(lds + (tid >> 6) * 16384), PREP_NITEMS - PREP_DEFER, PREP_NITEMS, ridle * NWAVES + (tid >> 6), nidle * NWAVES, tid & 63); } } });
    SEAM(2);
    RUNPH(3, { for (int u = blockIdx.x; u < 16 * NCT; u += gridDim.x) gla::g1_unit(a, lds, u / NCT, u % NCT); });
    SEAM(3);
    RUNPH(4, { gla::g2_scan(a);
        hy::CvState cvs; cvs.jb.mi = -1; cvs.next = (int)blockIdx.x * NWAVES + (tid >> 6); cvs.stride = (int)gridDim.x * NWAVES; cvs.end = hy::CV_ITEMS / 2;
        for (int c = blockIdx.x; c < HYW; c += gridDim.x) hy::channel(a, lds, c, a.ws + WS_HSPEC + (size_t)blockIdx.x * HSPEC_PER_WG, cvs);
        while (cvs.jb.mi >= 0 || cvs.next < cvs.end) hy::cv_step(a, cvs, tid & 63); });
    SEAM(4);
    RUNPH(5, { hy::CvState cvs; cvs.jb.mi = -1; cvs.stride = (int)gridDim.x * NWAVES; cvs.end = hy::CV_ITEMS;
        { const int w0_ = (int)blockIdx.x * NWAVES + (tid >> 6), half_ = hy::CV_ITEMS / 2; cvs.next = half_ + ((w0_ - half_ % cvs.stride) % cvs.stride + cvs.stride) % cvs.stride; }
        { int u = blockIdx.x; gla::G3In cur, nxt;
            if (u < 16 * NCHUNK) { gla::g3_load(a, u >> 7, u & 127, cur);
                for (;;) { const int un = u + (int)gridDim.x; const bool hn = un < 16 * NCHUNK; if (hn) gla::g3_load(a, un >> 7, un & 127, nxt);
                    gla::g3_unit(a, lds, u >> 7, u & 127, cur, cvs); if (!hn) break; cur = nxt; u = un; } } }
        while (cvs.jb.mi >= 0 || cvs.next < cvs.end) hy::cv_step(a, cvs, tid & 63);
        const int wave = tid >> 6;
        for (int it = blockIdx.x * NWAVES + wave; it < 4096; it += gridDim.x * NWAVES) hy::transpose_item(a, it, tid & 63); });
    SEAM(5);
    RUNPH(6, { gm::SchedOut S{a.ws, (int)gridDim.x, vcu}; gm::EpiOut E{a.ws}; gm::gemm_stream<false, 0, false>(lds, S, E); });
    SEAM(6);
    RUNPH(7, rt::phase(a, lds));
    SEAM(7);
    if (IN(8) || IN(9)) {
        LAS int* tab = (LAS int*)(lds + gm::LDS_TAB);
        __syncthreads();
        if (tid == 0) { const unsigned* cnt = (const unsigned*)(a.ws + WS_CNT); int nrt = 0;
            for (int e = 0; e < NE; ++e) { const int n = (int)cnt[e]; tab[e] = n; const int nt = (n + 255) >> 8; for (int k = 0; k < nt; ++k) tab[64 + nrt + k] = e | (k << 8); nrt += nt; }
            tab[32] = nrt; }
        __syncthreads();
    }
    RUNPH(8, { gm::SchedMoe<1> S{a.ws, (const LAS int*)(lds + gm::LDS_TAB), (int)gridDim.x, vcu, a.in[I_EB2]}; gm::EpiMoe1 E{a.ws}; gm::gemm_stream<true, 2, true>(lds, S, E); });
    SEAM(8);
    RUNPH(9, { gm::SchedMoe<2> S{a.ws, (const LAS int*)(lds + gm::LDS_TAB), (int)gridDim.x, vcu, a.in[I_EB2]}; gm::EpiMoe2 E{a.ws}; gm::gemm_stream<false, 0, true>(lds, S, E); });
    SEAM(9);
    RUNPH(10, p_final(a, lds));
#undef RUNPH
#undef vcu
#undef IN
#undef SEAM
}

extern "C" void kernel_launch(void* const* d_in, const int* in_sizes, int n_in, void* d_out, int out_size, void* d_ws, size_t ws_size, hipStream_t stream) {
    static int grid = 0;
    if (grid == 0) {
        if (n_in != 32 || out_size != T * D || ws_size < WS_END) { fprintf(stderr, "kernel_launch: unexpected shapes (n_in %d out %d ws %zu need %zu)\n", n_in, out_size, ws_size, (size_t)WS_END); grid = -1; return; }
        int dev = 0, cus = 0;
        if (hipGetDevice(&dev) != hipSuccess || hipDeviceGetAttribute(&cus, hipDeviceAttributeMultiprocessorCount, dev) != hipSuccess) { grid = -1; return; }
        if (hipFuncSetAttribute((const void*)mega_fwd, hipFuncAttributeMaxDynamicSharedMemorySize, LDS_BYTES) != hipSuccess) { fprintf(stderr, "kernel_launch: hipFuncSetAttribute failed\n"); grid = -1; return; }
        int per_cu = 0;
        if (hipOccupancyMaxActiveBlocksPerMultiprocessor(&per_cu, (const void*)mega_fwd, NTHREADS, LDS_BYTES) != hipSuccess || per_cu < 1) fprintf(stderr, "kernel_launch: occupancy query says %d\n", per_cu);
        (void)hipGetLastError();
        grid = cus;
        if (grid > MAX_GRID) grid = MAX_GRID;
    }
    if (grid < 0) return;
    (void)hipMemsetAsync(d_ws, 0, WS_ZERO_BYTES, stream);
    Args a{};
    for (int i = 0; i < 32; ++i) a.in[i] = (const float*)d_in[i];
    a.out = (float*)d_out; a.ws = (unsigned char*)d_ws;
#ifdef DBG
    (void)hipMemsetAsync((char*)d_ws + WS_DBG, 0, 512, stream);
    for (int p = 0; p < N_PHASES; ++p) { a.ph_lo = p; a.ph_hi = p + 1; hipLaunchKernelGGL(mega_fwd, dim3(grid), dim3(NTHREADS), LDS_BYTES, stream, a);
        hipLaunchKernelGGL(dbg_check, dim3(64), dim3(512), 0, stream, a, p); }
    hipLaunchKernelGGL(dbg_encode, dim3(1024), dim3(256), 0, stream, a);
#elif N_LAUNCH_PER_PHASE
    for (int p = 0; p < N_PHASES; ++p) { a.ph_lo = p; a.ph_hi = p + 1; hipLaunchKernelGGL(mega_fwd, dim3(grid), dim3(NTHREADS), LDS_BYTES, stream, a); }
#else
    a.ph_lo = 0; a.ph_hi = N_PHASES;
#ifdef PROF_REP
    a.rep_k = PROF_REP;
#endif
    hipLaunchKernelGGL(mega_fwd, dim3(grid), dim3(NTHREADS), LDS_BYTES, stream, a);
#endif
}
```

```cpp
#include <hip/hip_runtime.h>
#include <cstdio>
#include <cstdint>
#include <cstddef>

#define LAS __attribute__((address_space(3)))
#define GAS __attribute__((address_space(1)))
typedef unsigned short bf16_t;
typedef short bf16x8 __attribute__((ext_vector_type(8)));
typedef float f32x4 __attribute__((ext_vector_type(4)));
typedef float f32x2 __attribute__((ext_vector_type(2)));
typedef unsigned u32x4 __attribute__((ext_vector_type(4)));
typedef unsigned u32x2 __attribute__((ext_vector_type(2)));

#ifndef N_LAUNCH_PER_PHASE
#define N_LAUNCH_PER_PHASE 0
#endif

constexpr int D = 1024, NB = 4, SEQ = 8192, T = NB * SEQ, CTXL = 256, TC = NB * CTXL, TT = T + TC;
constexpr int NH = 4, DK = 64, DV = 128, CH = 64, NCHUNK = SEQ / CH, NCC = CTXL / CH, NCT = NCHUNK + NCC;
constexpr int HYW = 512, HYC = 3 * HYW, INW = 3104;
constexpr int NE = 32, DE = 1024, CAP = T;
constexpr float LN_EPS = 1e-6f, ALPHA = 1.189207115002721f;
constexpr int NTHREADS = 512, NWAVES = 8;
constexpr int FFTN = 16384;

constexpr size_t al256(size_t x) { return (x + 255) & ~(size_t)255; }
constexpr size_t WS_BAR   = 0;
constexpr size_t WS_MOD   = 16384;
constexpr size_t WS_CNT   = WS_MOD + 5 * 6144 * 4;
constexpr size_t WS_ZERO_BYTES = al256(WS_CNT + 256);
constexpr size_t WS_LIST  = 262144;
constexpr size_t WS_PW    = WS_LIST + (size_t)NE * CAP * 4;
constexpr size_t WS_PLOC  = WS_PW + (size_t)T * 4 * 4;
constexpr size_t WS_B1R   = WS_PLOC + (size_t)T * 4 * 4;
constexpr size_t WS_HID2  = WS_B1R + (size_t)NE * 2048 * 4;
constexpr size_t WS_BTIN  = WS_HID2 + (size_t)SEQ * 64 * 4;
constexpr size_t WS_BTOUT = WS_BTIN + (size_t)3584 * 1024 * 2;
constexpr size_t WS_W1T   = WS_BTOUT + (size_t)1024 * 1024 * 2;
constexpr size_t WS_W2T   = WS_W1T + (size_t)NE * 2048 * 1024 * 2;
constexpr size_t WS_PRE1  = WS_W2T + (size_t)NE * 1024 * 1024 * 2;
constexpr size_t WS_RA    = WS_PRE1 + (size_t)T * 1024 * 4;
constexpr size_t WS_H     = WS_RA;
constexpr size_t WS_Q     = WS_H + (size_t)TT * 1024 * 2;
constexpr size_t WS_K     = WS_Q + (size_t)T * 256 * 2;
constexpr size_t WS_V     = WS_K + (size_t)TT * 256 * 2;
constexpr size_t WS_G     = WS_V + (size_t)TT * 512 * 2;
constexpr size_t WS_GF    = WS_G + (size_t)T * 512 * 2;
constexpr size_t WS_GB    = WS_GF + (size_t)TT * 256 * 4;
constexpr size_t WS_UT    = WS_GB + (size_t)TT * 256 * 4;
constexpr size_t WS_RA_END= WS_UT + (size_t)NB * HYC * SEQ * 2;
constexpr size_t WS_H2    = WS_RA;
constexpr size_t WS_FG    = WS_RA + (size_t)T * 1024 * 2;
constexpr size_t WS_SLOTS = WS_RA;
constexpr size_t SORTED_BYTES_ = (size_t)(T * 4 / 256 + NE) * 256 * 1024 * 2;
constexpr size_t WS_RB    = al256(WS_RA_END > WS_RA + SORTED_BYTES_ ? WS_RA_END : WS_RA + SORTED_BYTES_);
constexpr size_t WS_KV    = WS_RB;
constexpr size_t WS_AV    = WS_KV + (size_t)2 * 16 * NCT * 8192 * 2;
constexpr size_t WS_SP    = WS_AV + (size_t)2 * 16 * NCT * 64 * 4;
constexpr size_t WS_HSPEC = WS_SP + (size_t)2 * 16 * NCHUNK * 8192 * 2;
constexpr size_t HSPEC_PER_WG = (size_t)2 * FFTN * 8;
constexpr int MAX_GRID = 256;
constexpr size_t WS_YHYT  = WS_HSPEC + (size_t)MAX_GRID * HSPEC_PER_WG;
constexpr size_t WS_MIX   = WS_YHYT + (size_t)NB * HYW * SEQ * 2;
constexpr size_t WS_RB_END= WS_MIX + (size_t)T * 1024 * 2;
constexpr size_t WS_HF    = WS_MIX;
constexpr size_t WS_ACT   = WS_RB;
constexpr size_t SORTED_BYTES = (size_t)(T * 4 / 256 + NE) * 256 * 1024 * 2;
constexpr size_t WS_END   = al256(WS_RB_END > WS_RB + SORTED_BYTES ? WS_RB_END : WS_RB + SORTED_BYTES);

constexpr int LDS_BYTES = 147456;
constexpr int LDS_MISC  = 145408;

typedef __bf16 bf16n2 __attribute__((ext_vector_type(2)));
__device__ __forceinline__ unsigned pk2(float lo, float hi) { bf16n2 v = {(__bf16)lo, (__bf16)hi}; return __builtin_bit_cast(unsigned, v); }
__device__ __forceinline__ bf16_t f2bf(float f) { __bf16 b = (__bf16)f; return __builtin_bit_cast(unsigned short, b); }
__device__ __forceinline__ float bf2f(bf16_t b) { return __uint_as_float(((unsigned)b) << 16); }
__device__ __forceinline__ float bflo(unsigned w) { return __uint_as_float(w << 16); }
__device__ __forceinline__ float bfhi(unsigned w) { return __uint_as_float(w & 0xffff0000u); }
__device__ __forceinline__ float wave_sum(float v) {
#pragma unroll
    for (int o = 1; o < 64; o <<= 1) v += __shfl_xor(v, o);
    return v;
}
__device__ __forceinline__ float silu_f(float x) { return x * __builtin_amdgcn_rcpf(1.f + __expf(-x)); }
__device__ __forceinline__ float log_sigmoid_f(float z) { return fminf(z, 0.f) - __logf(1.f + __expf(-fabsf(z))); }

#define XB_TMO      128
#define XB_XCNT(j)  (256  + 64 * (j))
#define XB_XSUB(j)  (1280 + 64 * (j))
#define XB_XGEN(j)  (2304 + 64 * (j))
#define XB_TOP      3328
#define XB_TOPGEN   3392
#define XCD_BAR_WORDS 3456
#define XB_SPIN_CAP (1u << 22)
__device__ __forceinline__ unsigned xb_ld(unsigned* p)              { return __hip_atomic_load(p, __ATOMIC_RELAXED, __HIP_MEMORY_SCOPE_AGENT); }
__device__ __forceinline__ unsigned xb_add(unsigned* p, unsigned v) { return __hip_atomic_fetch_add(p, v, __ATOMIC_RELAXED, __HIP_MEMORY_SCOPE_AGENT); }
__device__ __forceinline__ unsigned xb_xcc_id() { return (unsigned)__builtin_amdgcn_s_getreg((3 << 11) | 20) & 0xFu; }
#define XB_SPIN(cond, bar) do { unsigned _sp = 0; while (cond) { __builtin_amdgcn_s_sleep(1); \
    if ((++_sp & 255u) == 0u) { if (xb_ld(&(bar)[XB_TMO])) break; if (_sp > XB_SPIN_CAP) { atomicAdd(&(bar)[XB_TMO], 1u); break; } } } } while (0)
struct XcdBarrier { unsigned* bar; unsigned x; volatile LAS unsigned* st; };
__device__ __forceinline__ XcdBarrier xcd_barrier_post(unsigned* bar, volatile LAS unsigned* st) {
    XcdBarrier b; b.bar = bar; b.x = xb_xcc_id(); b.st = st;
    if (threadIdx.x == 0) (void)xb_add(&bar[XB_XCNT(b.x)], 1u);
    return b;
}
__device__ __forceinline__ void xcd_barrier_complete(unsigned* bar, unsigned x, unsigned& nloc, unsigned& nx) {
    const unsigned G = gridDim.x * gridDim.y * gridDim.z;
    unsigned sum, cnt, mine, sp = 0u;
    for (;;) {
        sum = 0u; cnt = 0u; mine = 0u;
#pragma unroll
        for (unsigned j = 0; j < 16; ++j) { const unsigned c = xb_ld(&bar[XB_XCNT(j)]); sum += c; cnt += (c > 0u) ? 1u : 0u; mine = (j == x) ? c : mine; }
        if (sum == G) break;
        __builtin_amdgcn_s_sleep(1);
        if ((++sp & 255u) == 0u) { if (xb_ld(&bar[XB_TMO])) break; if (sp > XB_SPIN_CAP) { atomicAdd(&bar[XB_TMO], 1u); break; } }
    }
    nloc = mine > 0u ? mine : 1u; nx = cnt > 0u ? cnt : 1u;
}
__device__ __forceinline__ void xcd_barrier(const XcdBarrier& b) {
    asm volatile("s_waitcnt vmcnt(0)" ::: "memory");
    __syncthreads();
    if (threadIdx.x == 0) {
        unsigned* bar = b.bar;
        __builtin_amdgcn_s_waitcnt(0);
        unsigned nloc = b.st[0], nx = b.st[1];
        if (nloc == 0u) { xcd_barrier_complete(bar, b.x, nloc, nx); b.st[0] = nloc; b.st[1] = nx; }
        const unsigned old = xb_add(&bar[XB_XSUB(b.x)], 1u);
        const unsigned gen = old / nloc;
        if (old + 1u == (gen + 1u) * nloc) {
            __builtin_amdgcn_fence(__ATOMIC_RELEASE, "agent");
            asm volatile("s_waitcnt vmcnt(0)" ::: "memory");
            const unsigned og = xb_add(&bar[XB_TOP], 1u);
            const unsigned tg = og / nx;
            if (og + 1u == (tg + 1u) * nx) xb_add(&bar[XB_TOPGEN], 1u);
            else XB_SPIN(xb_ld(&bar[XB_TOPGEN]) == tg, bar);
            __builtin_amdgcn_fence(__ATOMIC_ACQUIRE, "agent");
            xb_add(&bar[XB_XGEN(b.x)], 1u);
            asm volatile("s_waitcnt vmcnt(0)" ::: "memory");
        } else {
            XB_SPIN(xb_ld(&bar[XB_XGEN(b.x)]) == gen, bar);
            __builtin_amdgcn_fence(__ATOMIC_ACQUIRE, "agent");
            asm volatile("s_waitcnt vmcnt(0)" ::: "memory");
        }
    }
    __syncthreads();
}

struct Args {
    const float* in[32];
    float* out;
    unsigned char* ws;
    int ph_lo, ph_hi;
    int rep_k, pad_;
};
enum { I_X = 0, I_C, I_CTX, I_CCTX, I_ADAW, I_ADAB, I_WIN, I_WAF, I_BAF, I_WAB, I_BAB, I_NORMG, I_CONVW, I_CONVB, I_FW1, I_FB1, I_FW2, I_FB2, I_FWOUT, I_FFREQ,
       I_BIASD, I_WOUT, I_LN1G, I_LN1B, I_RW, I_RB, I_EW1, I_EB1, I_EW2, I_EB2, I_LN2G, I_LN2B };


namespace gm {
constexpr int BM = 256, BK = 64, HALF = 128, HTB = HALF * BK * 2, STAGE_BYTES = 8 * HTB, KD = 1024, NT = KD / BK;
constexpr int ROWB = KD * 2;
typedef int i32x8 __attribute__((ext_vector_type(8)));
__device__ __forceinline__ int lds_off8(int r, int fq) { const int rr = r & 15; return ((r >> 4) * 2 + (fq >> 1)) * 1024 + ((rr * 64 + 32 * (fq & 1)) ^ (((rr >> 3) & 1) << 5)); }
__device__ __forceinline__ int lds_byte(int r, int c) { const int st = (r >> 4) * 2 + (c >> 5), rr = r & 15, cc = c & 31, ob = rr * 64 + cc * 2; return st * 1024 + (ob ^ (((ob >> 9) & 1) << 5)); }
__device__ __forceinline__ void stage_rc(int b, int& R, int& C) { const int st = b / 1024, sb = b % 1024, swz = sb ^ (((sb >> 9) & 1) << 5); R = (st >> 1) * 16 + swz / 64; C = (st & 1) * 32 + (swz % 64) / 2; }
__device__ __forceinline__ int perm32(int rho) { const int n = rho >> 4, i = rho & 15; return 8 * (i >> 2) + 4 * n + (i & 3); }

constexpr int LDS_BIAS = STAGE_BYTES + 4096;
struct Unit {
    const char* A;
    const char* B;
    const int* list;
    int type, row0, col0, valid, aux;
};

__device__ __forceinline__ i32x8 cat8(bf16x8 lo, bf16x8 hi) { typedef int i32x4 __attribute__((ext_vector_type(4))); const i32x4 a = __builtin_bit_cast(i32x4, lo), b = __builtin_bit_cast(i32x4, hi); return (i32x8){a[0], a[1], a[2], a[3], b[0], b[1], b[2], b[3]}; }
template <bool GATHER, int GSHIFT, int RB>
__device__ __forceinline__ void a_offsets(const Unit& u, unsigned (&o)[2][2]) {
    int R[2], Cb[2];
    int tz = threadIdx.x; asm volatile("" : "+v"(tz));
#pragma unroll
    for (int i = 0; i < 2; ++i) { int r, c; stage_rc(tz * 16 + i * 8192, r, c); R[i] = r; Cb[i] = c * 2; }
#pragma unroll
    for (int h = 0; h < 2; ++h)
#pragma unroll
        for (int i = 0; i < 2; ++i) {
            const int r = h * HALF + R[i];
            if (!GATHER) o[h][i] = (unsigned)(r * RB + Cb[i]);
            else { const int idx = u.list[r < u.valid ? r : 0]; o[h][i] = (unsigned)(idx >> GSHIFT) * (unsigned)RB + (unsigned)Cb[i]; }
        }
}

template <bool GATHER, int GSHIFT, bool FP8, class Sched, class Epi>
__device__ __forceinline__ void gemm_stream(LAS unsigned char* lds, const Sched& S, const Epi& E) {
    constexpr int RB = FP8 ? KD : ROWB, NTL = FP8 ? NT / 2 : NT;
    const int tid = threadIdx.x, wid = __builtin_amdgcn_readfirstlane(tid >> 6), lane = tid & 63, wr = wid >> 2, wc = wid & 3, fr = lane & 15, fq = lane >> 4;
    unsigned voffB[2], voffA[2];
#pragma unroll
    for (int i = 0; i < 2; ++i) { int r, c; stage_rc(tid * 16 + i * 8192, r, c); const int rb = (r & ~31) + perm32(r & 31); voffB[i] = (unsigned)(rb * RB + c * 2); voffA[i] = (unsigned)(r * RB + c * 2); }
    const size_t kstep = (size_t)(BK * 2), hstep = (size_t)HALF * RB;
    const unsigned ldsw = (unsigned)wid * 1024u;
    const int aoff = FP8 ? lds_off8(wr * 64 + fr, fq) : lds_byte(wr * 64 + fr, fq * 8), boff = FP8 ? lds_off8(wc * 32 + fr, fq) : lds_byte(wc * 32 + fr, fq * 8);
#define GM_SA(b, h) (((b) * 2 + (h)) * HTB)
#define GM_SB(b, h) ((4 + (b) * 2 + (h)) * HTB)
#define GM_STAGE(bufoff, gbase, vo0, vo1) do { \
        __builtin_amdgcn_global_load_lds((const unsigned*)((const char*)(gbase) + (vo0)), (LAS unsigned*)(lds + (bufoff) + ldsw), 16, 0, 0); \
        __builtin_amdgcn_global_load_lds((const unsigned*)((const char*)(gbase) + (vo1)), (LAS unsigned*)(lds + (bufoff) + ldsw + 8192), 16, 0, 0); } while (0)
#define GM_STAGE_A(bufoff, gbase, h, o0, o1) do { if constexpr (GATHER) GM_STAGE(bufoff, gbase, o0, o1); else GM_STAGE(bufoff, (gbase) + (h) * hstep, voffA[0], voffA[1]); } while (0)
#define GM_LD32(p) ({ const i32x4 lo_ = *(const LAS i32x4*)(p), hi_ = *(const LAS i32x4*)((p) + 16); (i32x8){lo_[0], lo_[1], lo_[2], lo_[3], hi_[0], hi_[1], hi_[2], hi_[3]}; })
#define GM_LDA(dst, b, h) do { if constexpr (FP8) { _Pragma("unroll") for (int m = 0; m < 4; ++m) dst##8[m] = GM_LD32(lds + GM_SA(b, h) + aoff + m * 2048); } \
        else { _Pragma("unroll") for (int m = 0; m < 4; ++m) _Pragma("unroll") for (int k = 0; k < 2; ++k) dst[m][k] = *(const LAS bf16x8*)(lds + GM_SA(b, h) + aoff + m * 2048 + k * 1024); } } while (0)
#define GM_LDB(dst, b, h) do { if constexpr (FP8) { _Pragma("unroll") for (int n = 0; n < 2; ++n) dst##8[n] = GM_LD32(lds + GM_SB(b, h) + boff + n * 2048); } \
        else { _Pragma("unroll") for (int n = 0; n < 2; ++n) _Pragma("unroll") for (int k = 0; k < 2; ++k) dst[n][k] = *(const LAS bf16x8*)(lds + GM_SB(b, h) + boff + n * 2048 + k * 1024); } } while (0)
#define GM_MMA(ai, bj, At, Bt) do { __builtin_amdgcn_s_setprio(1); _Pragma("unroll") for (int m = 0; m < 4; ++m) _Pragma("unroll") for (int n = 0; n < 2; ++n) { \
        if constexpr (FP8) asm volatile("v_mfma_scale_f32_16x16x128_f8f6f4 %0, %1, %2, %0, %3, %3 op_sel_hi:[0,0,0]" : "+v"(acc[ai][bj][m][n]) : "v"(Bt##8[n]), "v"(At##8[m]), "v"(sc1_)); \
        else { _Pragma("unroll") for (int k = 0; k < 2; ++k) acc[ai][bj][m][n] = __builtin_amdgcn_mfma_f32_16x16x32_bf16(Bt[n][k], At[m][k], acc[ai][bj][m][n], 0, 0, 0); } } \
        __builtin_amdgcn_s_setprio(0); } while (0)
#define GM_WAIT_V(n) asm volatile("s_waitcnt vmcnt(" #n ")" ::: "memory")
#define GM_WAIT_L(n) asm volatile("s_waitcnt lgkmcnt(" #n ")" ::: "memory")
#define GM_BAR __builtin_amdgcn_s_barrier()
#define GM_SCHED __builtin_amdgcn_sched_barrier(0)
    Unit cur, nxt; int ui = 0;
    if (!S.next(0, cur)) return;
    f32x4 acc[2][2][4][2];
#pragma unroll
    for (int a = 0; a < 2; ++a)
#pragma unroll
        for (int b = 0; b < 2; ++b)
#pragma unroll
            for (int m = 0; m < 4; ++m)
#pragma unroll
                for (int n = 0; n < 2; ++n) acc[a][b][m][n] = (f32x4){0.f, 0.f, 0.f, 0.f};
    typedef int i32x4 __attribute__((ext_vector_type(4)));
    int sc1_ = 0x7f7f7f7f; asm volatile("" : "+v"(sc1_));
    bf16x8 At[4][2], B0[2][2], B1[2][2];
    i32x8 At8[4], B08[2], B18[2];
    unsigned ca[2][2], na[2][2];
    if constexpr (GATHER) a_offsets<GATHER, GSHIFT, RB>(cur, ca);
    const char* cA = cur.A; const char* cB = cur.B;
    GM_STAGE(GM_SB(0, 0), cB, voffB[0], voffB[1]); GM_STAGE_A(GM_SA(0, 0), cA, 0, ca[0][0], ca[0][1]); GM_STAGE(GM_SB(0, 1), cB + hstep, voffB[0], voffB[1]); GM_STAGE_A(GM_SA(0, 1), cA, 1, ca[1][0], ca[1][1]);
    if (wr == 1) GM_BAR;
    GM_WAIT_V(4); GM_BAR;
    GM_STAGE(GM_SB(1, 0), cB + kstep, voffB[0], voffB[1]); GM_STAGE_A(GM_SA(1, 0), cA + kstep, 0, ca[0][0], ca[0][1]); GM_STAGE(GM_SB(1, 1), cB + hstep + kstep, voffB[0], voffB[1]);
    GM_WAIT_V(6); GM_BAR;
    for (;;) {
        const bool has_next = S.next(ui + 1, nxt);
        if constexpr (GATHER) {
            if (has_next) a_offsets<GATHER, GSHIFT, RB>(nxt, na);
            else {
#pragma unroll
                for (int h = 0; h < 2; ++h)
#pragma unroll
                    for (int i = 0; i < 2; ++i) na[h][i] = ca[h][i];
            }
        }
        const char* nA = has_next ? nxt.A : cA; const char* nB = has_next ? nxt.B : cB;
        if (wid == 0)
            __builtin_amdgcn_global_load_lds((const unsigned*)(S.bias(cur) + 4 * lane), (LAS unsigned*)(lds + LDS_BIAS + (ui & 1) * 1024), 16, 0, 0);
        for (int t = 0; t < NTL; t += 2) {
            const bool last = (t == NTL - 2);

            const char* a1 = cA + (size_t)(t + 1) * kstep;
            const char* a2 = last ? nA : cA + (size_t)(t + 2) * kstep; const char* b2 = last ? nB : cB + (size_t)(t + 2) * kstep;
            const char* a3 = a2 + kstep; const char* b3 = b2 + kstep;
            unsigned x00 = 0, x01 = 0, x10 = 0, x11 = 0;
            if constexpr (GATHER) { x00 = last ? na[0][0] : ca[0][0]; x01 = last ? na[0][1] : ca[0][1]; x10 = last ? na[1][0] : ca[1][0]; x11 = last ? na[1][1] : ca[1][1]; }
            GM_LDB(B0, 0, 0); GM_SCHED; GM_LDA(At, 0, 0); GM_STAGE_A(GM_SA(1, 1), a1, 1, ca[1][0], ca[1][1]);
            GM_WAIT_L(8); GM_BAR; GM_WAIT_L(0); GM_MMA(0, 0, At, B0); GM_BAR; GM_SCHED;
            GM_LDB(B1, 0, 1); GM_STAGE(GM_SB(0, 0), b2, voffB[0], voffB[1]);
            GM_BAR; GM_WAIT_L(0); GM_MMA(0, 1, At, B1); GM_BAR;
            GM_LDA(At, 0, 1); GM_STAGE_A(GM_SA(0, 0), a2, 0, x00, x01);
            GM_BAR; GM_WAIT_L(0); GM_MMA(1, 0, At, B0); GM_BAR; GM_SCHED;
            GM_STAGE(GM_SB(0, 1), b2 + hstep, voffB[0], voffB[1]);
            GM_WAIT_V(6); GM_BAR; GM_MMA(1, 1, At, B1); GM_BAR;
            GM_LDB(B0, 1, 0); GM_SCHED; GM_LDA(At, 1, 0); GM_STAGE_A(GM_SA(0, 1), a2, 1, x10, x11);
            GM_WAIT_L(8); GM_BAR; GM_WAIT_L(0); GM_MMA(0, 0, At, B0); GM_BAR; GM_SCHED;
            GM_LDB(B1, 1, 1); GM_STAGE(GM_SB(1, 0), b3, voffB[0], voffB[1]);
            GM_BAR; GM_WAIT_L(0); GM_MMA(0, 1, At, B1); GM_BAR;
            GM_LDA(At, 1, 1); GM_STAGE_A(GM_SA(1, 0), a3, 0, x00, x01);
            GM_BAR; GM_WAIT_L(0); GM_MMA(1, 0, At, B0); GM_BAR; GM_SCHED;
            GM_STAGE(GM_SB(1, 1), b3 + hstep, voffB[0], voffB[1]);
            GM_WAIT_V(6); GM_BAR; GM_MMA(1, 1, At, B1); GM_BAR;
        }
        if constexpr (FP8) asm volatile("s_nop 7\n\ts_nop 7" ::: "memory");
        {
          int tz = threadIdx.x; asm volatile("" : "+v"(tz)); const int wz = tz >> 6, lz = tz & 63;
          E(acc, cur, wz >> 2, wz & 3, lz & 15, lz >> 4, (const LAS float*)(lds + LDS_BIAS + (ui & 1) * 1024)); }
        if (!has_next) break;
#pragma unroll
        for (int a = 0; a < 2; ++a)
#pragma unroll
            for (int b = 0; b < 2; ++b)
#pragma unroll
                for (int m = 0; m < 4; ++m)
#pragma unroll
                    for (int n = 0; n < 2; ++n) acc[a][b][m][n] = (f32x4){0.f, 0.f, 0.f, 0.f};
        cur = nxt; cA = nA; cB = nB; ++ui;
        if constexpr (GATHER) {
#pragma unroll
            for (int h = 0; h < 2; ++h)
#pragma unroll
                for (int i = 0; i < 2; ++i) ca[h][i] = na[h][i];
        }
    }
    GM_WAIT_V(0);
    if (wr == 0) GM_BAR;
    GM_BAR;
#undef GM_SA
#undef GM_SB
#undef GM_STAGE
#undef GM_STAGE_A
#undef GM_LD32
#undef GM_LDA
#undef GM_LDB
#undef GM_MMA
#undef GM_WAIT_V
#undef GM_WAIT_L
#undef GM_BAR
#undef GM_SCHED
}

__device__ __forceinline__ u32x4 pack8(f32x4 a, f32x4 b) { u32x4 w; w.x = pk2(a[0], a[1]); w.y = pk2(a[2], a[3]); w.z = pk2(b[0], b[1]); w.w = pk2(b[2], b[3]); return w; }

struct SchedIn {
    unsigned char* ws; int G, c; const float* baf; const float* bab;
    __device__ __forceinline__ bool next(int i, Unit& u) const {
        int L = i * G + c;
        u.list = nullptr; u.valid = 256; u.aux = 0;
        if (L < 768) {
            const int pa = L % 6, pb = L / 6;
            u.A = (const char*)(ws + WS_BTIN) + (size_t)(2048 + 256 * pa) * ROWB; u.B = (const char*)(ws + WS_H) + (size_t)(256 * pb) * ROWB;
            u.type = 2; u.row0 = 256 * pa; u.col0 = 256 * pb; return true;
        }
        L -= 768;
        if (L < 1024) {
            const int pm = L >> 3, pn = ((L & 7) + (L >> 8)) & 7;
            u.A = (const char*)(ws + WS_H) + (size_t)(256 * pm) * ROWB; u.B = (const char*)(ws + WS_BTIN) + (size_t)(256 * pn) * ROWB;
            u.type = pn < 6 ? 0 : 1; u.row0 = 256 * pm; u.col0 = pn; return true;
        }
        L -= 1024;
        if (L < 20) {
            const int pm = L / 5, j = L % 5, pn = j == 0 ? 1 : (j == 1 ? 2 : (j == 2 ? 3 : (j == 3 ? 6 : 7)));
            u.A = (const char*)(ws + WS_H) + (size_t)(T + 256 * pm) * ROWB; u.B = (const char*)(ws + WS_BTIN) + (size_t)(256 * pn) * ROWB;
            u.type = pn < 6 ? 0 : 1; u.row0 = T + 256 * pm; u.col0 = pn; return true;
        }
        return false;
    }
    __device__ __forceinline__ const float* bias(const Unit& u) const { return (u.type == 1 && u.col0 == 7) ? bab : baf; }
};
struct EpiIn {
    unsigned char* ws;
    __device__ __forceinline__ void operator()(const f32x4 (&acc)[2][2][4][2], const Unit& u, int wr, int wc, int fr, int fq, const LAS float* bs) const {
        const int rl = wr * 64 + fr, cl = wc * 32 + 8 * fq;
        if (u.type == 0) {
            const int pn = u.col0;
            bf16_t* dst; int ld, cb;
            if (pn == 0) { dst = (bf16_t*)(ws + WS_Q); ld = 256; cb = 0; }
            else if (pn == 1) { dst = (bf16_t*)(ws + WS_K); ld = 256; cb = 0; }
            else if (pn < 4) { dst = (bf16_t*)(ws + WS_V); ld = 512; cb = (pn - 2) * 256; }
            else { dst = (bf16_t*)(ws + WS_G); ld = 512; cb = (pn - 4) * 256; }
#pragma unroll
            for (int ai = 0; ai < 2; ++ai)
#pragma unroll
                for (int m = 0; m < 4; ++m) { bf16_t* rowp = dst + (size_t)(u.row0 + rl + ai * 128 + m * 16) * ld + cb + cl;
#pragma unroll
                    for (int bj = 0; bj < 2; ++bj) *(u32x4*)(rowp + bj * 128) = pack8(acc[ai][bj][m][0], acc[ai][bj][m][1]); }
        } else if (u.type == 1) {
            float* dst = (float*)(ws + (u.col0 == 6 ? WS_GF : WS_GB));
            f32x4 bv[2][2];
#pragma unroll
            for (int bj = 0; bj < 2; ++bj)
#pragma unroll
                for (int n = 0; n < 2; ++n) bv[bj][n] = *(const LAS f32x4*)(bs + cl + bj * 128 + 4 * n);
#pragma unroll
            for (int ai = 0; ai < 2; ++ai)
#pragma unroll
                for (int m = 0; m < 4; ++m) { float* rowp = dst + (size_t)(u.row0 + rl + ai * 128 + m * 16) * 256 + cl;
#pragma unroll
                    for (int bj = 0; bj < 2; ++bj)
#pragma unroll
                        for (int n = 0; n < 2; ++n) { f32x4 z = acc[ai][bj][m][n] + bv[bj][n], o;
#pragma unroll
                            for (int j = 0; j < 4; ++j) o[j] = log_sigmoid_f(z[j]) * (1.f / 16.f);
                            *(f32x4*)(rowp + bj * 128 + 4 * n) = o; } }
        } else {
            const int b = u.col0 >> 13, l0 = u.col0 & 8191;
            bf16_t* dst = (bf16_t*)(ws + WS_UT) + ((size_t)b * HYC) * SEQ + l0 + cl;
#pragma unroll
            for (int ai = 0; ai < 2; ++ai)
#pragma unroll
                for (int m = 0; m < 4; ++m) { bf16_t* rowp = dst + (size_t)(u.row0 + rl + ai * 128 + m * 16) * SEQ;
#pragma unroll
                    for (int bj = 0; bj < 2; ++bj) *(u32x4*)(rowp + bj * 128) = pack8(acc[ai][bj][m][0], acc[ai][bj][m][1]); }
        }
    }
};

struct SchedOut {
    unsigned char* ws; int G, c;
    __device__ __forceinline__ bool next(int i, Unit& u) const {
        const int L = i * G + c; if (L >= 512) return false;
        const int pm = L >> 2, pn = L & 3;
        u.A = (const char*)(ws + WS_MIX) + (size_t)(256 * pm) * ROWB; u.B = (const char*)(ws + WS_BTOUT) + (size_t)(256 * pn) * ROWB;
        u.list = nullptr; u.valid = 256; u.aux = 0; u.type = 3; u.row0 = 256 * pm; u.col0 = 256 * pn; return true;
    }
    __device__ __forceinline__ const float* bias(const Unit& u) const { return (const float*)(ws + WS_MOD) + (u.row0 >> 13) * 6144 + 2 * 1024 + u.col0; }
};
struct EpiOut {
    unsigned char* ws;
    __device__ __forceinline__ void operator()(const f32x4 (&acc)[2][2][4][2], const Unit& u, int wr, int wc, int fr, int fq, const LAS float* bs) const {
        const int rl = wr * 64 + fr, cl = u.col0 + wc * 32 + 8 * fq;
        bf16_t* fg = (bf16_t*)(ws + WS_FG);
        f32x4 gv[2][2];
#pragma unroll
        for (int bj = 0; bj < 2; ++bj)
#pragma unroll
            for (int n = 0; n < 2; ++n) gv[bj][n] = *(const LAS f32x4*)(bs + wc * 32 + 8 * fq + bj * 128 + 4 * n);
#pragma unroll
        for (int ai = 0; ai < 2; ++ai)
#pragma unroll
            for (int m = 0; m < 4; ++m) { bf16_t* rowp = fg + (size_t)(u.row0 + rl + ai * 128 + m * 16) * 1024 + cl;
#pragma unroll
                for (int bj = 0; bj < 2; ++bj) *(u32x4*)(rowp + bj * 128) = pack8(gv[bj][0] * acc[ai][bj][m][0], gv[bj][1] * acc[ai][bj][m][1]); }
    }
};

constexpr int LDS_TAB = STAGE_BYTES;
template <int WHICH>
struct SchedMoe {
    unsigned char* ws; const LAS int* tab; int G, c; const float* b2;
    __device__ __forceinline__ bool next(int i, Unit& u) const {
        constexpr int NCT_ = WHICH == 1 ? 8 : 4;
        const int L = i * G + c; const int nrt = __builtin_amdgcn_readfirstlane(tab[32]);
        if (L >= nrt * NCT_) return false;
        const int rt = L / NCT_, ct = L % NCT_;
        const int info = __builtin_amdgcn_readfirstlane(tab[64 + rt]), e = info & 255, r0 = (info >> 8) * 256;
        const int cnt = __builtin_amdgcn_readfirstlane(tab[e]);
        u.valid = (cnt - r0) < 256 ? (cnt - r0) : 256;
        u.list = (const int*)(ws + WS_LIST) + (size_t)e * CAP + r0;
        u.A = (WHICH == 1) ? (const char*)(ws + WS_H2) : (const char*)(ws + WS_ACT) + (size_t)(256 * rt) * KD;
        u.B = (const char*)(ws + (WHICH == 1 ? WS_W1T : WS_W2T)) + ((size_t)e * (WHICH == 1 ? 2048 : 1024) + 256 * ct) * KD;
        u.type = 3 + WHICH; u.row0 = 256 * rt; u.col0 = ct; u.aux = e; return true;
    }
    __device__ __forceinline__ const float* bias(const Unit& u) const { return (WHICH == 1) ? (const float*)(ws + WS_B1R) + (size_t)u.aux * 2048 + 256 * u.col0 : b2 + (size_t)u.aux * 1024 + 256 * u.col0; }
};
__device__ __forceinline__ float swiglu_f(float glu, float lin) {
    glu = fminf(glu, 7.f); lin = fminf(fmaxf(lin, -7.f), 7.f);
    return glu * __builtin_amdgcn_rcpf(1.f + __expf(-1.702f * glu)) * (lin + 1.f);
}
constexpr float S_H2 = 4.f, S_ACT = 8.f, S_W = 64.f;
__device__ __forceinline__ unsigned pk4_fp8(float a, float b, float c, float d) {
    a = fminf(fmaxf(a, -448.f), 448.f); b = fminf(fmaxf(b, -448.f), 448.f); c = fminf(fmaxf(c, -448.f), 448.f); d = fminf(fmaxf(d, -448.f), 448.f);
    int p = __builtin_amdgcn_cvt_pk_fp8_f32(a, b, 0, false); p = __builtin_amdgcn_cvt_pk_fp8_f32(c, d, p, true); return (unsigned)p; }
__device__ __forceinline__ unsigned pk4_fp8_nc(float a, float b, float c, float d) { int p = __builtin_amdgcn_cvt_pk_fp8_f32(a, b, 0, false); p = __builtin_amdgcn_cvt_pk_fp8_f32(c, d, p, true); return (unsigned)p; }
struct EpiMoe1 {
    unsigned char* ws;
    __device__ __forceinline__ void operator()(const f32x4 (&acc)[2][2][4][2], const Unit& u, int wr, int wc, int fr, int fq, const LAS float* bs) const {
        const int rl = wr * 64 + fr, cl = wc * 32 + 8 * fq, ct = u.col0;
        const LAS float* b1 = bs + cl;
        unsigned char* act = (unsigned char*)(ws + WS_ACT) + (size_t)u.row0 * 1024 + 128 * ct + cl;
        f32x4 bg[2], bl[2];
#pragma unroll
        for (int n = 0; n < 2; ++n) { bg[n] = *(const LAS f32x4*)(b1 + 4 * n); bl[n] = *(const LAS f32x4*)(b1 + 128 + 4 * n); }
#pragma unroll
        for (int ai = 0; ai < 2; ++ai)
#pragma unroll
            for (int mp = 0; mp < 2; ++mp) {
                u32x2 w[2];
#pragma unroll
                for (int mm = 0; mm < 2; ++mm) { const int m = 2 * mp + mm; f32x4 o[2];
#pragma unroll
                    for (int n = 0; n < 2; ++n) { const f32x4 gl = acc[ai][0][m][n] * (1.f / (S_H2 * S_W)) + bg[n], li = acc[ai][1][m][n] * (1.f / (S_H2 * S_W)) + bl[n];
#pragma unroll
                        for (int j = 0; j < 4; ++j) o[n][j] = swiglu_f(gl[j], li[j]) * S_ACT; }
                    w[mm].x = pk4_fp8(o[0][0], o[0][1], o[0][2], o[0][3]); w[mm].y = pk4_fp8(o[1][0], o[1][1], o[1][2], o[1][3]); }
                const auto sx = __builtin_amdgcn_permlane16_swap(w[0].x, w[1].x, false, false); const auto sy = __builtin_amdgcn_permlane16_swap(w[0].y, w[1].y, false, false);
                const int r = rl + ai * 128 + (2 * mp + (fq & 1)) * 16;
                *(u32x4*)(act + (size_t)r * 1024 - 8 * (fq & 1)) = (u32x4){sx[0], sy[0], sx[1], sy[1]}; }
    }
};
constexpr float S_SL = 16.f;
struct EpiMoe2 {
    unsigned char* ws;
    __device__ __forceinline__ void operator()(const f32x4 (&acc)[2][2][4][2], const Unit& u, int wr, int wc, int fr, int fq, const LAS float* bs) const {
        const int rl = wr * 64 + fr, cl = wc * 32 + 8 * fq, ct = u.col0;
        const LAS float* bb = bs + cl;
        unsigned char* slots = (unsigned char*)(ws + WS_SLOTS) + (size_t)u.row0 * 1024 + 256 * ct + cl;
        f32x4 bv[2][2];
#pragma unroll
        for (int bj = 0; bj < 2; ++bj)
#pragma unroll
            for (int n = 0; n < 2; ++n) bv[bj][n] = *(const LAS f32x4*)(bb + bj * 128 + 4 * n) * S_SL;
#pragma unroll
        for (int ai = 0; ai < 2; ++ai)
#pragma unroll
            for (int m = 0; m < 4; ++m) { const int r = rl + ai * 128 + m * 16;
                u32x2 w[2];
#pragma unroll
                for (int bj = 0; bj < 2; ++bj) { const f32x4 y0 = acc[ai][bj][m][0] * (S_SL / (S_ACT * S_W)) + bv[bj][0], y1 = acc[ai][bj][m][1] * (S_SL / (S_ACT * S_W)) + bv[bj][1];
                    w[bj].x = pk4_fp8(y0[0], y0[1], y0[2], y0[3]); w[bj].y = pk4_fp8(y1[0], y1[1], y1[2], y1[3]); }
                const auto sx = __builtin_amdgcn_permlane16_swap(w[0].x, w[1].x, false, false); const auto sy = __builtin_amdgcn_permlane16_swap(w[0].y, w[1].y, false, false);
                *(u32x4*)(slots + (size_t)r * 1024 + ((fq & 1) ? 128 - 8 : 0)) = (u32x4){sx[0], sy[0], sx[1], sy[1]}; }
    }
};
}

namespace hy {
__device__ __forceinline__ int phys(int n) { return n + (n >> 4) + ((n >> 9) << 4); }
constexpr int XSIZE = 16384 + 1024 + 512;

__device__ __forceinline__ float tw_c(int i) {
    constexpr float t[16] = {1.f, 0.98078528040323043f, 0.92387953251128674f, 0.83146961230254524f, 0.70710678118654752f, 0.55557023301960218f, 0.38268343236508977f, 0.19509032201612825f,
                             0.f, -0.19509032201612825f, -0.38268343236508977f, -0.55557023301960218f, -0.70710678118654752f, -0.83146961230254524f, -0.92387953251128674f, -0.98078528040323043f};
    return t[i];
}
__device__ __forceinline__ float tw_s(int i) {
    constexpr float t[16] = {0.f, 0.19509032201612825f, 0.38268343236508977f, 0.55557023301960218f, 0.70710678118654752f, 0.83146961230254524f, 0.92387953251128674f, 0.98078528040323043f,
                             1.f, 0.98078528040323043f, 0.92387953251128674f, 0.83146961230254524f, 0.70710678118654752f, 0.55557023301960218f, 0.38268343236508977f, 0.19509032201612825f};
    return t[i];
}
__host__ __device__ constexpr int brev(int p, int bits) { int r = 0; for (int i = 0; i < bits; ++i) r |= ((p >> i) & 1) << (bits - 1 - i); return r; }

template <int R, bool INV>
__device__ __forceinline__ void fft_reg(f32x2 (&v)[R]) {
#pragma unroll
    for (int s = R / 2; s >= 1; s >>= 1) {
#pragma unroll
        for (int g = 0; g < R; g += 2 * s) {
#pragma unroll
            for (int k = 0; k < s; ++k) {
                const f32x2 a = v[g + k], b = v[g + k + s];
                v[g + k] = a + b;
                const f32x2 t = a - b;
                const int ti = k * (16 / s);
                f32x2 o;
                if (ti == 0) o = t;
                else if (ti == 8) { if (INV) { o[0] = -t[1]; o[1] = t[0]; } else { o[0] = t[1]; o[1] = -t[0]; } }
                else { const float c = tw_c(ti), sn = tw_s(ti);
                    if (INV) { o[0] = t[0] * c - t[1] * sn; o[1] = t[1] * c + t[0] * sn; }
                    else     { o[0] = t[0] * c + t[1] * sn; o[1] = t[1] * c - t[0] * sn; } }
                v[g + k + s] = o;
            }
        }
    }
}
__device__ __forceinline__ f32x2 cmul(f32x2 a, f32x2 b) { f32x2 r; r[0] = a[0] * b[0] - a[1] * b[1]; r[1] = a[0] * b[1] + a[1] * b[0]; return r; }

template <int M, bool ZPAD = false>
__device__ __forceinline__ void pass_fwd32(LAS f32x2* X, int tid) {
    int j = (M == 512) ? tid : (tid & 15);
    asm volatile("" : "+v"(j));
    const int p0 = (M == 512) ? (tid + (tid >> 4)) : (560 * (tid >> 4) + (tid & 15));
    constexpr int PS = (M == 512) ? 560 : 17;
    f32x2 v[32];
#pragma unroll
    for (int r = 0; r < 32; ++r) { if (ZPAD && r >= 16) v[r] = (f32x2){0.f, 0.f}; else v[r] = X[p0 + PS * r]; }
    fft_reg<32, false>(v);
    float sn, cs; sincospif(-2.f * (float)j / (float)(32 * M), &sn, &cs);
    const f32x2 w1 = {cs, sn}; f32x2 w = w1;
    X[p0] = v[0];
#pragma unroll
    for (int rp = 1; rp < 32; ++rp) { X[p0 + PS * rp] = cmul(v[brev(rp, 5)], w); w = cmul(w, w1); }
}
template <int M, bool HALF = false>
__device__ __forceinline__ void pass_inv32(LAS f32x2* X, int tid) {
    int j = (M == 512) ? tid : (tid & 15);
    asm volatile("" : "+v"(j));
    const int p0 = (M == 512) ? (tid + (tid >> 4)) : (560 * (tid >> 4) + (tid & 15));
    constexpr int PS = (M == 512) ? 560 : 17;
    float sn, cs; sincospif(2.f * (float)j / (float)(32 * M), &sn, &cs);
    const f32x2 w1 = {cs, sn}; f32x2 w = w1;
    f32x2 v[32];
    v[0] = X[p0];
#pragma unroll
    for (int rp = 1; rp < 32; ++rp) { v[rp] = cmul(X[p0 + PS * rp], w); w = cmul(w, w1); }
    fft_reg<32, true>(v);
#pragma unroll
    for (int p = 0; p < 32; ++p) { if (!HALF || brev(p, 5) < 16) X[p0 + PS * brev(p, 5)] = v[p]; }
}
__device__ __forceinline__ void pass_c_store(const LAS f32x2* X, f32x2* Hs, int tid, float scale) {
#pragma unroll
    for (int u = 0; u < 2; ++u) { const int blk = tid + 512 * u, p0 = 17 * blk + 16 * (blk >> 5);
        f32x2 v[16];
#pragma unroll
        for (int r = 0; r < 16; ++r) v[r] = X[p0 + r];
        fft_reg<16, false>(v);
#pragma unroll
        for (int q = 0; q < 8; ++q) { const f32x2 x0 = v[brev(2 * q, 4)] * scale, x1 = v[brev(2 * q + 1, 4)] * scale;
            *(f32x4*)(Hs + 16 * blk + 2 * q) = (f32x4){x0[0], x0[1], x1[0], x1[1]}; } }
}
__device__ __forceinline__ void pass_c_mul_inv(LAS f32x2* X, const f32x2* Hs, int tid) {
#pragma unroll
    for (int u = 0; u < 2; ++u) { const int blk = tid + 512 * u, p0 = 17 * blk + 16 * (blk >> 5);
        f32x2 v[16], w[16];
#pragma unroll
        for (int r = 0; r < 16; ++r) v[r] = X[p0 + r];
        f32x4 hh[8];
#pragma unroll
        for (int q = 0; q < 8; ++q) hh[q] = *(const f32x4*)(Hs + 16 * blk + 2 * q);
        fft_reg<16, false>(v);
#pragma unroll
        for (int q = 0; q < 8; ++q) { w[2 * q] = cmul(v[brev(2 * q, 4)], (f32x2){hh[q][0], hh[q][1]}); w[2 * q + 1] = cmul(v[brev(2 * q + 1, 4)], (f32x2){hh[q][2], hh[q][3]}); }
        fft_reg<16, true>(w);
#pragma unroll
        for (int p = 0; p < 16; ++p) X[p0 + brev(p, 4)] = w[p]; }
}
__device__ __forceinline__ void load16(const bf16_t* u, float (&e)[16]) {
    const u32x4 a = *(const u32x4*)u, b = *(const u32x4*)(u + 8);
    e[0] = bflo(a.x); e[1] = bfhi(a.x); e[2] = bflo(a.y); e[3] = bfhi(a.y); e[4] = bflo(a.z); e[5] = bfhi(a.z); e[6] = bflo(a.w); e[7] = bfhi(a.w);
    e[8] = bflo(b.x); e[9] = bfhi(b.x); e[10] = bflo(b.y); e[11] = bfhi(b.y); e[12] = bflo(b.z); e[13] = bfhi(b.z); e[14] = bflo(b.w); e[15] = bfhi(b.w);
}
__device__ __forceinline__ void sconv16(const bf16_t* u, int tid, float w0, float w1, float w2, float bias, float (&o)[16]) {
    float e[16]; load16(u + 16 * tid, e);
    float lf = __shfl_up(e[15], 1), rt = __shfl_down(e[0], 1);
    if ((tid & 3) == 0) lf = 0.f;
    if ((tid & 3) == 3) rt = 0.f;
    o[0] = w0 * lf + w1 * e[0] + w2 * e[1] + bias;
#pragma unroll
    for (int i = 1; i < 15; ++i) o[i] = w0 * e[i - 1] + w1 * e[i] + w2 * e[i + 1] + bias;
    o[15] = w0 * e[14] + w1 * e[15] + w2 * rt + bias;
}

constexpr int CV_ITEMS = NE * 128 * 32;
struct CvJob { float v[8]; int mi; };
__device__ __forceinline__ void cv_issue(const Args& a, CvJob& jb, int mi, int lane) {
    jb.mi = mi;
    if (mi >= 0) { const int e = mi >> 12, kg = (mi >> 5) & 127, nb = mi & 31;
        const float* src = a.in[I_EW1] + ((size_t)e * 1024 + 8 * kg) * 2048 + 64 * nb + lane;
#pragma unroll
        for (int i = 0; i < 8; ++i) jb.v[i] = src[(size_t)i * 2048]; }
}
__device__ __forceinline__ void cv_finish(const Args& a, const CvJob& jb, int lane) {
    if (jb.mi >= 0) { const int mi = jb.mi, e = mi >> 12, kg = (mi >> 5) & 127, nb = mi & 31;
        const int cs = 64 * nb + lane, sgl = cs & 1, ac = cs >> 1, ct = ac >> 7, jj = ac & 127;
        unsigned char* dst = (unsigned char*)(a.ws + WS_W1T) + ((size_t)e * 2048 + 256 * ct + 128 * sgl + jj) * 1024 + 8 * kg;
        u32x2 o; o.x = gm::pk4_fp8_nc(jb.v[0] * gm::S_W, jb.v[1] * gm::S_W, jb.v[2] * gm::S_W, jb.v[3] * gm::S_W); o.y = gm::pk4_fp8_nc(jb.v[4] * gm::S_W, jb.v[5] * gm::S_W, jb.v[6] * gm::S_W, jb.v[7] * gm::S_W);
        *(u32x2*)dst = o; }
}
struct CvState { CvJob jb; int next, stride, end; };
__device__ __forceinline__ void cv_step(const Args& a, CvState& st, int lane) {
    cv_finish(a, st.jb, lane);
    const int mi = st.next < st.end ? st.next : -1;
    cv_issue(a, st.jb, mi, lane);
    st.next += st.stride;
}

__device__ __forceinline__ void channel(const Args& a, LAS unsigned char* lds, int c, unsigned char* scratch, CvState& cvs) {
    const int tid = threadIdx.x;
#define CV_STEP() cv_step(a, cvs, tid & 63)
    LAS f32x2* X = (LAS f32x2*)lds;
    f32x2* Hs = (f32x2*)scratch;
    const float* HF = (const float*)(a.ws + WS_HF);
    const int pc = 17 * tid + 16 * (tid >> 5);
    __syncthreads();
#pragma unroll 1
    for (int o = 0; o < 2; ++o) {
        const f32x4* hf = (const f32x4*)(HF + ((size_t)(2 * o) * HYW + c) * SEQ + 16 * tid); const f32x4* hb = (const f32x4*)(HF + ((size_t)(2 * o + 1) * HYW + c) * SEQ + 16 * tid);
#pragma unroll
        for (int q = 0; q < 4; ++q) { const f32x4 f = hf[q], b = hb[q];
#pragma unroll
            for (int e = 0; e < 4; ++e) { const int i = 4 * q + e, t = 16 * tid + i;
                X[pc + i] = (f32x2){f[e], 0.f};
                if (t >= 1) X[phys(FFTN - t)] = (f32x2){b[e], 0.f}; } }
        if (tid == 0) X[phys(SEQ)] = (f32x2){0.f, 0.f};
        __syncthreads();
        CV_STEP(); pass_fwd32<512>(X, tid); __syncthreads(); CV_STEP(); pass_fwd32<16>(X, tid); __syncthreads(); pass_c_store(X, Hs + (size_t)o * FFTN, tid, 1.f / (float)FFTN); __syncthreads();
    }
    const float* cw = a.in[I_CONVW]; const float* cbv = a.in[I_CONVB]; const float* dbias = a.in[I_BIASD];
    const float d1 = dbias[c], d2 = dbias[HYW + c];
    float wv[3][3], bv[3];
#pragma unroll
    for (int s = 0; s < 3; ++s) { bv[s] = cbv[s * HYW + c];
#pragma unroll
        for (int i = 0; i < 3; ++i) wv[s][i] = cw[i * HYC + s * HYW + c]; }
    const bf16_t* UT = (const bf16_t*)(a.ws + WS_UT);
    bf16_t* YT = (bf16_t*)(a.ws + WS_YHYT);
#pragma unroll 1
    for (int bp = 0; bp < 2; ++bp) {
        const bf16_t* u0 = UT + ((size_t)(2 * bp) * HYC + c) * SEQ; const bf16_t* u1 = UT + ((size_t)(2 * bp + 1) * HYC + c) * SEQ;
        float z0[16], z1[16];
        {
            float v0[16], v1[16]; sconv16(u0, tid, wv[0][0], wv[0][1], wv[0][2], bv[0], v0); sconv16(u1, tid, wv[0][0], wv[0][1], wv[0][2], bv[0], v1);
#pragma unroll
            for (int i = 0; i < 16; ++i) X[pc + i] = (f32x2){v0[i], v1[i]};
        }
        __syncthreads();
        CV_STEP(); pass_fwd32<512, true>(X, tid); __syncthreads(); CV_STEP(); pass_fwd32<16>(X, tid); __syncthreads(); pass_c_mul_inv(X, Hs, tid); __syncthreads(); CV_STEP(); pass_inv32<16>(X, tid); __syncthreads(); CV_STEP(); pass_inv32<512, true>(X, tid); __syncthreads();
        {
            float v0[16], v1[16], x0[16], x1[16];
            sconv16(u0, tid, wv[0][0], wv[0][1], wv[0][2], bv[0], v0); sconv16(u1, tid, wv[0][0], wv[0][1], wv[0][2], bv[0], v1);
            sconv16(u0 + (size_t)HYW * SEQ, tid, wv[1][0], wv[1][1], wv[1][2], bv[1], x0); sconv16(u1 + (size_t)HYW * SEQ, tid, wv[1][0], wv[1][1], wv[1][2], bv[1], x1);
#pragma unroll
            for (int i = 0; i < 16; ++i) { const f32x2 y1 = X[pc + i]; z0[i] = x0[i] * (y1[0] + d1 * v0[i]); z1[i] = x1[i] * (y1[1] + d1 * v1[i]); X[pc + i] = (f32x2){z0[i], z1[i]}; }
        }
        __syncthreads();
        CV_STEP(); pass_fwd32<512, true>(X, tid); __syncthreads(); CV_STEP(); pass_fwd32<16>(X, tid); __syncthreads(); pass_c_mul_inv(X, Hs + FFTN, tid); __syncthreads(); CV_STEP(); pass_inv32<16>(X, tid); __syncthreads(); CV_STEP(); pass_inv32<512, true>(X, tid); __syncthreads();
        {
            float x0[16], x1[16];
            sconv16(u0 + (size_t)2 * HYW * SEQ, tid, wv[2][0], wv[2][1], wv[2][2], bv[2], x0); sconv16(u1 + (size_t)2 * HYW * SEQ, tid, wv[2][0], wv[2][1], wv[2][2], bv[2], x1);
            unsigned w0[8], w1[8];
#pragma unroll
            for (int i = 0; i < 8; ++i) { const f32x2 ya = X[pc + 2 * i], yb = X[pc + 2 * i + 1];
                w0[i] = pk2(x0[2 * i] * (ya[0] + d2 * z0[2 * i]), x0[2 * i + 1] * (yb[0] + d2 * z0[2 * i + 1]));
                w1[i] = pk2(x1[2 * i] * (ya[1] + d2 * z1[2 * i]), x1[2 * i + 1] * (yb[1] + d2 * z1[2 * i + 1])); }
            u32x4* y0p = (u32x4*)(YT + ((size_t)(2 * bp) * HYW + c) * SEQ + 16 * tid); u32x4* y1p = (u32x4*)(YT + ((size_t)(2 * bp + 1) * HYW + c) * SEQ + 16 * tid);
            y0p[0] = (u32x4){w0[0], w0[1], w0[2], w0[3]}; y0p[1] = (u32x4){w0[4], w0[5], w0[6], w0[7]};
            y1p[0] = (u32x4){w1[0], w1[1], w1[2], w1[3]}; y1p[1] = (u32x4){w1[4], w1[5], w1[6], w1[7]};
        }
        __syncthreads();
    }
#undef CV_STEP
}

__device__ __forceinline__ void filter_item(const Args& a, int item, int lane) {
    const int ct = item & 127, tc = item >> 7;
    const float* hid2 = (const float*)(a.ws + WS_HID2); const float* wout = a.in[I_FWOUT]; float* HF = (float*)(a.ws + WS_HF);
    const int col = 16 * ct + (lane & 15), kq = lane >> 4, cch = col & 511;
    float bf[16];
#pragma unroll
    for (int s = 0; s < 16; ++s) bf[s] = wout[(size_t)(16 * kq + s) * 2048 + col];
    const float dlt = fabsf(-3.0701134573253945f + (float)cch * ((-15.350567286626973f + 3.0701134573253945f) / 511.f));
#pragma unroll 2
    for (int tt = 0; tt < 32; ++tt) { const int t0 = 512 * tc + 16 * tt;
        const f32x4* ar = (const f32x4*)(hid2 + (size_t)(t0 + (lane & 15)) * 64 + 16 * kq);
        const f32x4 a0 = ar[0], a1 = ar[1], a2 = ar[2], a3 = ar[3];
        f32x4 acc = {0.f, 0.f, 0.f, 0.f};
#pragma unroll
        for (int e = 0; e < 4; ++e) { acc = __builtin_amdgcn_mfma_f32_16x16x4f32(a0[e], bf[e], acc, 0, 0, 0); }
#pragma unroll
        for (int e = 0; e < 4; ++e) { acc = __builtin_amdgcn_mfma_f32_16x16x4f32(a1[e], bf[4 + e], acc, 0, 0, 0); }
#pragma unroll
        for (int e = 0; e < 4; ++e) { acc = __builtin_amdgcn_mfma_f32_16x16x4f32(a2[e], bf[8 + e], acc, 0, 0, 0); }
#pragma unroll
        for (int e = 0; e < 4; ++e) { acc = __builtin_amdgcn_mfma_f32_16x16x4f32(a3[e], bf[12 + e], acc, 0, 0, 0); }
        f32x4 o;
#pragma unroll
        for (int r = 0; r < 4; ++r) o[r] = acc[r] * __expf(-((float)(t0 + 4 * kq + r) / (float)(SEQ - 1)) * dlt);
        *(f32x4*)(HF + (size_t)col * SEQ + t0 + 4 * kq) = o; }
}

__device__ __forceinline__ void transpose_item(const Args& a, int item, int lane) {
    const int lt = item & 127, ct = (item >> 7) & 7, b = item >> 10;
    const bf16_t* src = (const bf16_t*)(a.ws + WS_YHYT) + ((size_t)b * HYW + 64 * ct) * SEQ + 64 * lt + lane;
    bf16_t* dst = (bf16_t*)(a.ws + WS_MIX) + ((size_t)b * SEQ + 64 * lt + lane) * 1024 + 512 + 64 * ct;
    unsigned short v[64];
#pragma unroll
    for (int cc = 0; cc < 64; ++cc) v[cc] = src[(size_t)cc * SEQ];
#pragma unroll
    for (int q = 0; q < 8; ++q)
        *(u32x4*)(dst + 8 * q) = (u32x4){(unsigned)v[8 * q] | ((unsigned)v[8 * q + 1] << 16), (unsigned)v[8 * q + 2] | ((unsigned)v[8 * q + 3] << 16),
                                         (unsigned)v[8 * q + 4] | ((unsigned)v[8 * q + 5] << 16), (unsigned)v[8 * q + 6] | ((unsigned)v[8 * q + 7] << 16)};
}
}

__device__ __forceinline__ void p0_mod_and_filter(const Args& a, LAS unsigned char* lds) {
    const int tid = threadIdx.x, lane = tid & 63, wave = tid >> 6;
    const float* c = a.in[I_C]; const float* cctx = a.in[I_CCTX]; const float* adaw = a.in[I_ADAW]; const float* adab = a.in[I_ADAB];
    float* mod = (float*)(a.ws + WS_MOD);
    LAS float* sl = (LAS float*)lds;
    LAS float* pt = (LAS float*)lds + 5 * 1024;
    for (int i = tid; i < 5 * 1024; i += NTHREADS) { const int r = i >> 10, k = i & 1023; sl[i] = silu_f(r < 4 ? c[r * 1024 + k] : cctx[k]); }
    for (int it = blockIdx.x; it < 256; it += gridDim.x) {
        __syncthreads();
        if (tid < 504) {
            const int col = tid % 24, ks = tid / 24, n = it * 24 + col, kbeg = ks * 49, kend = (kbeg + 49 < 1024) ? kbeg + 49 : 1024;
            float acc[5] = {0.f, 0.f, 0.f, 0.f, 0.f};
#pragma unroll 7
            for (int k = kbeg; k < kend; ++k) { const float w = adaw[(size_t)k * 6144 + n];
#pragma unroll
                for (int r = 0; r < 5; ++r) acc[r] += sl[r * 1024 + k] * w; }
#pragma unroll
            for (int r = 0; r < 5; ++r) pt[(ks * 5 + r) * 24 + col] = acc[r];
        }
        __syncthreads();
        if (tid < 120) { const int r = tid / 24, col = tid % 24, n = it * 24 + col; float s = adab[n];
            for (int ks = 0; ks < 21; ++ks) s += pt[(ks * 5 + r) * 24 + col];
            mod[r * 6144 + n] = s; }
    }
    __syncthreads();
    const float* w1 = a.in[I_FW1]; const float* b1 = a.in[I_FB1]; const float* w2 = a.in[I_FW2]; const float* b2 = a.in[I_FB2]; const float* fq = a.in[I_FFREQ];
    float* hid2 = (float*)(a.ws + WS_HID2);
    LAS float* zs = (LAS float*)lds + 8192 + wave * 128;
    const float frq = fq[lane], bb1 = b1[lane], bb2 = b2[lane];
    for (int t = (blockIdx.x * NWAVES + wave); t < SEQ; t += gridDim.x * NWAVES) {
        float z = 0.f;
        if (lane == 0) z = (float)t / (float)(SEQ - 1);
        else if (lane < 33) { const int i = (lane - 1) & 15; const float f = 1e-4f + (float)i * ((15.f - 1e-4f) / 15.f);
            const float ang = (6.283185307179586f * (float)t / (float)SEQ) * f; z = (lane < 17) ? cosf(ang) : -sinf(ang); }
        if (lane < 33) zs[lane] = z;
        __builtin_amdgcn_wave_barrier(); asm volatile("s_waitcnt lgkmcnt(0)" ::: "memory");
        float s = bb1;
#pragma unroll
        for (int e = 0; e < 33; ++e) s += zs[e] * w1[e * 64 + lane];
        const float h1 = sinf(frq * s);
        zs[64 + lane] = h1;
        __builtin_amdgcn_wave_barrier(); asm volatile("s_waitcnt lgkmcnt(0)" ::: "memory");
        float s2 = bb2;
#pragma unroll 16
        for (int g = 0; g < 64; ++g) s2 += zs[64 + g] * w2[g * 64 + lane];
        hid2[(size_t)t * 64 + lane] = sinf(frq * s2);
        __builtin_amdgcn_wave_barrier(); asm volatile("s_waitcnt lgkmcnt(0)" ::: "memory");
    }
}

template <bool FP8 = false>
__device__ __forceinline__ void tr_item(const float* W, int ldw, int k0, int c0, int cstride, float scale, bf16_t* dstrow0, LAS float* scr, int lane) {
    float wv_[32];
#pragma unroll
    for (int i = 0; i < 32; ++i) wv_[i] = W[(size_t)(k0 + 2 * i + (lane >> 5)) * ldw + c0 + (lane & 31) * cstride];
#pragma unroll
    for (int i = 0; i < 32; ++i) scr[(2 * i + (lane >> 5)) * 33 + (lane & 31)] = wv_[i] * scale;
    asm volatile("s_waitcnt lgkmcnt(0)" ::: "memory"); __builtin_amdgcn_wave_barrier();
    const int c = lane & 7;
#pragma unroll
    for (int j = 0; j < 4; ++j) { const int n = (lane >> 3) + 8 * j; const LAS float* s = scr + (8 * c) * 33 + n;
        if (FP8) { u32x2 o; o.x = gm::pk4_fp8(s[0 * 33], s[1 * 33], s[2 * 33], s[3 * 33]); o.y = gm::pk4_fp8(s[4 * 33], s[5 * 33], s[6 * 33], s[7 * 33]);
            *(u32x2*)((unsigned char*)dstrow0 + (size_t)n * 1024 + k0 + 8 * c) = o; }
        else { u32x4 o; o.x = pk2(s[0 * 33], s[1 * 33]); o.y = pk2(s[2 * 33], s[3 * 33]); o.z = pk2(s[4 * 33], s[5 * 33]); o.w = pk2(s[6 * 33], s[7 * 33]);
            *(u32x4*)(dstrow0 + (size_t)n * 1024 + k0 + 8 * c) = o; } }
    asm volatile("s_waitcnt lgkmcnt(0)" ::: "memory"); __builtin_amdgcn_wave_barrier();
}
__device__ __forceinline__ void fold_item(const float* win, const float* wa, int dir, int k0, int j0, bf16_t* dstrow0, LAS float* scr, int lane) {
#pragma unroll 4
    for (int i = 0; i < 32; ++i) { const int kk = 2 * i + (lane >> 5); const float* wr = win + (size_t)(k0 + kk) * INW + 1536 + 16 * dir; float s = 0.f;
#pragma unroll
        for (int r = 0; r < 16; ++r) s += wr[r] * wa[r * 256 + j0 + (lane & 31)];
        scr[kk * 33 + (lane & 31)] = s; }
    asm volatile("s_waitcnt lgkmcnt(0)" ::: "memory"); __builtin_amdgcn_wave_barrier();
    const int c = lane & 7;
#pragma unroll
    for (int j = 0; j < 4; ++j) { const int n = (lane >> 3) + 8 * j; const LAS float* s = scr + (8 * c) * 33 + n;
        u32x4 o; o.x = pk2(s[0 * 33], s[1 * 33]); o.y = pk2(s[2 * 33], s[3 * 33]); o.z = pk2(s[4 * 33], s[5 * 33]); o.w = pk2(s[6 * 33], s[7 * 33]);
        *(u32x4*)(dstrow0 + (size_t)n * 1024 + k0 + 8 * c) = o; }
    asm volatile("s_waitcnt lgkmcnt(0)" ::: "memory"); __builtin_amdgcn_wave_barrier();
}
__device__ __forceinline__ void ln_mod_row(const float* xrow, const float* shift, const float* scale, bf16_t* orow, int lane) {
    const f32x4* xr = (const f32x4*)xrow + lane;
    f32x4 v[4]; float s = 0.f;
#pragma unroll
    for (int j = 0; j < 4; ++j) { v[j] = xr[64 * j]; s += (v[j][0] + v[j][1]) + (v[j][2] + v[j][3]); }
    const float mean = wave_sum(s) * (1.f / D); float s2 = 0.f;
#pragma unroll
    for (int j = 0; j < 4; ++j) { v[j] = v[j] - mean; s2 += (v[j][0] * v[j][0] + v[j][1] * v[j][1]) + (v[j][2] * v[j][2] + v[j][3] * v[j][3]); }
    const float rstd = 1.f / sqrtf(wave_sum(s2) * (1.f / D) + LN_EPS);
    u32x2* o8 = (u32x2*)orow + lane;
#pragma unroll
    for (int j = 0; j < 4; ++j) { const f32x4 sh = ((const f32x4*)shift)[64 * j + lane], sc = ((const f32x4*)scale)[64 * j + lane];
        const f32x4 y = v[j] * rstd * (sc + 1.f) + sh;
        u32x2 w; w.x = pk2(y[0], y[1]); w.y = pk2(y[2], y[3]); o8[64 * j] = w; }
}
constexpr int PREP_I_IN = 16 * 96, PREP_I_FOLD = 16 * 8 * 2, PREP_I_OUT = 16 * 32, PREP_I_W1 = NE * 16 * 64, PREP_I_W2 = NE * 16 * 32;
constexpr int PREP_NITEMS = PREP_I_IN + PREP_I_FOLD + PREP_I_OUT + PREP_I_W1 + PREP_I_W2;
constexpr int PREP_DEFER = 10880;
__device__ __forceinline__ void prep_items(const Args& a, LAS float* scr, int first, int last, int rank, int nranks, int lane) {
    constexpr int I_IN = PREP_I_IN, I_FOLD = PREP_I_FOLD, I_OUT = PREP_I_OUT, I_W1 = PREP_I_W1;
    const float* win = a.in[I_WIN];
    bf16_t* btin = (bf16_t*)(a.ws + WS_BTIN); bf16_t* btout = (bf16_t*)(a.ws + WS_BTOUT); bf16_t* w1t = (bf16_t*)(a.ws + WS_W1T); bf16_t* w2t = (bf16_t*)(a.ws + WS_W2T);
    for (int it = first + rank; it < last; it += nranks) {
        int r = it;
        if (r < I_IN) {
            const int kb = r / 96, nb = r % 96;
            if (nb < 48) tr_item(win, INW, 64 * kb, 32 * nb, 1, nb < 8 ? 0.125f : 1.f, btin + (size_t)(32 * nb) * 1024, scr, lane);
            else tr_item(win, INW, 64 * kb, 1568 + 32 * (nb - 48), 1, 1.f, btin + (size_t)(2048 + 32 * (nb - 48)) * 1024, scr, lane);
            continue; }
        r -= I_IN;
        if (r < I_FOLD) { const int dir = r & 1, jb = (r >> 1) & 7, kb = r >> 4;
            fold_item(win, dir ? a.in[I_WAB] : a.in[I_WAF], dir, 64 * kb, 32 * jb, btin + (size_t)(1536 + 256 * dir + 32 * jb) * 1024, scr, lane); continue; }
        r -= I_FOLD;
        if (r < I_OUT) { const int kb = r / 32, nb = r % 32; tr_item(a.in[I_WOUT], 1024, 64 * kb, 32 * nb, 1, 1.f, btout + (size_t)(32 * nb) * 1024, scr, lane); continue; }
        r -= I_OUT;
        if (r < I_W1) {
            const int e = r / 1024, q = r % 1024, s = q & 1, nb = (q >> 1) & 31, kb = q >> 6;
            const int ct = nb >> 2, jj0 = (nb & 3) * 32;
            tr_item<true>(a.in[I_EW1] + (size_t)e * 1024 * 2048, 2048, 64 * kb, 2 * (128 * ct + jj0) + s, 2, gm::S_W, (bf16_t*)((unsigned char*)w1t + ((size_t)e * 2048 + 256 * ct + 128 * s + jj0) * 1024), scr, lane);
            continue; }
        r -= I_W1;
        { const int e = r / 512, q = r % 512, kb = q / 32, nb = q % 32;
          tr_item<true>(a.in[I_EW2] + (size_t)e * 1024 * 1024, 1024, 64 * kb, 32 * nb, 1, gm::S_W, (bf16_t*)((unsigned char*)w2t + ((size_t)e * 1024 + 32 * nb) * 1024), scr, lane); }
    }
}
__device__ __forceinline__ void p1_prep(const Args& a, LAS unsigned char* lds) {
    const int tid = threadIdx.x, lane = tid & 63, wave = tid >> 6;
    LAS float* scr = (LAS float*)(lds + wave * 16384);
    const int gw = blockIdx.x * NWAVES + wave, NGW = gridDim.x * NWAVES;
    const float* win = a.in[I_WIN];
    bf16_t* btin = (bf16_t*)(a.ws + WS_BTIN); bf16_t* btout = (bf16_t*)(a.ws + WS_BTOUT); bf16_t* w1t = (bf16_t*)(a.ws + WS_W1T); bf16_t* w2t = (bf16_t*)(a.ws + WS_W2T);
    const float* mod = (const float*)(a.ws + WS_MOD);
    bf16_t* H = (bf16_t*)(a.ws + WS_H);
#pragma unroll 2
    for (int row = gw; row < TT; row += NGW) {
        const float* xr; int mr;
        if (row < T) { xr = a.in[I_X] + (size_t)row * D; mr = row >> 13; } else { xr = a.in[I_CTX] + (size_t)(row - T) * D; mr = 4; }
        ln_mod_row(xr, mod + mr * 6144, mod + mr * 6144 + 1024, H + (size_t)row * D, lane);
    }
    prep_items(a, scr, 0, PREP_I_IN + PREP_I_FOLD + PREP_I_OUT, gw, NGW, lane);
    prep_items(a, scr, PREP_I_IN + PREP_I_FOLD + PREP_I_OUT + PREP_I_W1, PREP_NITEMS - PREP_DEFER, gw, NGW, lane);
    for (int it = gw; it < 2048; it += NGW) hy::filter_item(a, it, lane);
    float* b1r = (float*)(a.ws + WS_B1R); const float* eb1 = a.in[I_EB1];
    for (int i = blockIdx.x * NTHREADS + tid; i < NE * 2048; i += gridDim.x * NTHREADS) {
        const int e = i >> 11, n = i & 2047, ct = n >> 8, s = (n >> 7) & 1, jj = n & 127;
        b1r[i] = eb1[(size_t)e * 2048 + 2 * (128 * ct + jj) + s];
    }
}

namespace gla {
constexpr int RS = 72;
constexpr int L_TOTF = 0, L_TOTB = 2048, L_SSQ = 4096;
constexpr int L_T0 = 8192;
constexpr int L_T1 = L_T0 + 9216, L_T2 = L_T1 + 9216, L_T3 = L_T2 + 9216;
constexpr int L_VT = L_T3 + 9216;
constexpr int L_P  = L_VT + 18432;
constexpr int L_SF = L_P + 9216, L_SB = L_SF + 18432;
constexpr int L_END = L_SB + 18432;

__device__ __forceinline__ bf16x8 frag(const LAS unsigned char* tile, int row, int k0, int lane) {
    return *(const LAS bf16x8*)(tile + ((row + (lane & 15)) * RS + k0 + 8 * (lane >> 4)) * 2);
}
__device__ __forceinline__ void chunk_cums_pre(LAS unsigned char* L, const float (&gf)[8], const float (&gb)[8], int wave, int lane, float (&cumf)[8], float (&cumb)[8], float& allf, float& allb) {
    LAS float* totf = (LAS float*)(L + L_TOTF); LAS float* totb = (LAS float*)(L + L_TOTB);
    cumf[0] = gf[0];
#pragma unroll
    for (int r = 1; r < 8; ++r) cumf[r] = cumf[r - 1] + gf[r];
    cumb[7] = gb[7];
#pragma unroll
    for (int r = 6; r >= 0; --r) cumb[r] = cumb[r + 1] + gb[r];
    totf[wave * 64 + lane] = cumf[7]; totb[wave * 64 + lane] = cumb[0];
    __syncthreads();
    float of = 0.f, ob = 0.f, af = 0.f, ab = 0.f;
#pragma unroll
    for (int w = 0; w < 8; ++w) { const float tf = totf[w * 64 + lane], tb = totb[w * 64 + lane]; af += tf; ab += tb; of += (w < wave) ? tf : 0.f; ob += (w > wave) ? tb : 0.f; }
#pragma unroll
    for (int r = 0; r < 8; ++r) { cumf[r] += of; cumb[r] += ob; }
    allf = af; allb = ab;
}
__device__ __forceinline__ void chunk_cums(LAS unsigned char* L, const float* GF, const float* GB, size_t tok0, int h, int wave, int lane, float (&cumf)[8], float (&cumb)[8], float& allf, float& allb) {
    float gf[8], gb[8];
#pragma unroll
    for (int r = 0; r < 8; ++r) { const size_t o = (tok0 + 8 * wave + r) * 256 + h * 64 + lane; gf[r] = GF[o]; gb[r] = GB[o]; }
    chunk_cums_pre(L, gf, gb, wave, lane, cumf, cumb, allf, allb);
}
__device__ __forceinline__ void store_vt(LAS unsigned char* L, const u32x4 (&vr)[2], int tid) {
    LAS bf16_t* vt = (LAS bf16_t*)(L + L_VT);
    const int j = tid >> 3, c8 = tid & 7;
#pragma unroll
    for (int q = 0; q < 2; ++q) { const int dv0 = 8 * (c8 + 8 * q);
        const unsigned ww[4] = {vr[q].x, vr[q].y, vr[q].z, vr[q].w};
#pragma unroll
        for (int e = 0; e < 4; ++e) { vt[(dv0 + 2 * e) * RS + j] = (bf16_t)(ww[e] & 0xffffu); vt[(dv0 + 2 * e + 1) * RS + j] = (bf16_t)(ww[e] >> 16); } }
}
__device__ __forceinline__ void load_vt(LAS unsigned char* L, const bf16_t* V, size_t tok0, int h, int tid) {
    const int j = tid >> 3, c8 = tid & 7; u32x4 vr[2];
#pragma unroll
    for (int q = 0; q < 2; ++q) vr[q] = *(const u32x4*)(V + (tok0 + j) * 512 + h * 128 + 8 * (c8 + 8 * q));
    store_vt(L, vr, tid);
}

__device__ __forceinline__ void g1_unit(const Args& a, LAS unsigned char* L, int bh, int chunk  ) {
    const int tid = threadIdx.x, lane = tid & 63, wave = __builtin_amdgcn_readfirstlane(tid >> 6);
    const int b = bh >> 2, h = bh & 3;
    const size_t tok0 = chunk < NCHUNK ? (size_t)b * SEQ + (size_t)chunk * CH : (size_t)T + (size_t)b * CTXL + (size_t)(chunk - NCHUNK) * CH;
    const float* GF = (const float*)(a.ws + WS_GF); const float* GB = (const float*)(a.ws + WS_GB);
    const bf16_t* Kb = (const bf16_t*)(a.ws + WS_K); const bf16_t* Vb = (const bf16_t*)(a.ws + WS_V);
    float cumf[8], cumb[8], allf, allb;
    __syncthreads();
    chunk_cums(L, GF, GB, tok0, h, wave, lane, cumf, cumb, allf, allb);
    LAS bf16_t* ketf = (LAS bf16_t*)(L + L_T0); LAS bf16_t* ketb = (LAS bf16_t*)(L + L_T1);
#pragma unroll
    for (int r = 0; r < 8; ++r) { const int i = 8 * wave + r; const float kv = bf2f(Kb[(tok0 + i) * 256 + h * 64 + lane]);
        ketf[lane * RS + i] = f2bf(kv * __expf(allf - cumf[r])); ketb[lane * RS + i] = f2bf(kv * __expf(allb - cumb[r])); }
    load_vt(L, Vb, tok0, h, tid);
    if (wave == 0) { float* av = (float*)(a.ws + WS_AV); av[((size_t)(0 * 16 + bh) * NCT + chunk) * 64 + lane] = __expf(allf); av[((size_t)(1 * 16 + bh) * NCT + chunk) * 64 + lane] = __expf(allb); }
    __syncthreads();
    bf16_t* KV = (bf16_t*)(a.ws + WS_KV);
#pragma unroll
    for (int dir = 0; dir < 2; ++dir) {
        const LAS unsigned char* ket = L + (dir ? L_T1 : L_T0);
        bf16_t* dst = KV + ((size_t)(dir * 16 + bh) * NCT + chunk) * 8192;
#pragma unroll
        for (int nt = 0; nt < 4; ++nt) { f32x4 acc = {0.f, 0.f, 0.f, 0.f};
#pragma unroll
            for (int ks = 0; ks < 2; ++ks) acc = __builtin_amdgcn_mfma_f32_16x16x32_bf16(frag(L + L_VT, 16 * wave, 32 * ks, lane), frag(ket, 16 * nt, 32 * ks, lane), acc, 0, 0, 0);
#pragma unroll
            for (int r = 0; r < 4; ++r) dst[(16 * wave + 4 * (lane >> 4) + r) * 64 + 16 * nt + (lane & 15)] = f2bf(acc[r]); }
    }
}

__device__ __forceinline__ void g2_scan(const Args& a) {
    const bf16_t* KV = (const bf16_t*)(a.ws + WS_KV); const float* AV = (const float*)(a.ws + WS_AV); bf16_t* SP = (bf16_t*)(a.ws + WS_SP);
    for (int id = blockIdx.x * NTHREADS + threadIdx.x; id < 32 * 4096; id += gridDim.x * NTHREADS) {
        const int db = id >> 12, e2 = id & 4095, dir = db >> 4, dk = (2 * e2) & 63;
        const unsigned* kv = (const unsigned*)(KV + (size_t)db * NCT * 8192) + e2;
        const float* av = AV + (size_t)db * NCT * 64 + dk;
        unsigned* sp = (unsigned*)(SP + (size_t)db * NCHUNK * 8192) + e2;
        float s0 = 0.f, s1 = 0.f;
#pragma unroll
        for (int q = 0; q < NCC; ++q) { const int c = NCHUNK + (dir ? (NCC - 1 - q) : q);
            const unsigned w = kv[(size_t)c * 4096]; const f32x2 aa = *(const f32x2*)(av + (size_t)c * 64);
            s0 = aa[0] * s0 + bflo(w); s1 = aa[1] * s1 + bfhi(w); }
        for (int q0 = 0; q0 < NCHUNK; q0 += 16) {
            unsigned w[16]; f32x2 aa[16];
#pragma unroll
            for (int u = 0; u < 16; ++u) { const int c = dir ? (NCHUNK - 1 - (q0 + u)) : (q0 + u); w[u] = kv[(size_t)c * 4096]; aa[u] = *(const f32x2*)(av + (size_t)c * 64); }
#pragma unroll
            for (int u = 0; u < 16; ++u) { const int c = dir ? (NCHUNK - 1 - (q0 + u)) : (q0 + u);
                sp[(size_t)c * 4096] = pk2(s0, s1);
                s0 = aa[u][0] * s0 + bflo(w[u]); s1 = aa[u][1] * s1 + bfhi(w[u]); }
        }
    }
}

struct G3In { float gf[8], gb[8]; bf16_t q[8], k[8]; u32x4 v[2]; u32x4 sraw[4]; bf16_t gr[4][4]; };
__device__ __forceinline__ void g3_load(const Args& a, int bh, int chunk, G3In& in) {
    const int tid = threadIdx.x, lane = tid & 63, wave = __builtin_amdgcn_readfirstlane(tid >> 6);
    const int b = bh >> 2, h = bh & 3;
    const size_t tok0 = (size_t)b * SEQ + (size_t)chunk * CH;
    const float* GF = (const float*)(a.ws + WS_GF); const float* GB = (const float*)(a.ws + WS_GB);
    const bf16_t* Qb = (const bf16_t*)(a.ws + WS_Q); const bf16_t* Kb = (const bf16_t*)(a.ws + WS_K); const bf16_t* Vb = (const bf16_t*)(a.ws + WS_V);
#pragma unroll
    for (int r = 0; r < 8; ++r) { const size_t o = (tok0 + 8 * wave + r) * 256 + h * 64 + lane; in.gf[r] = GF[o]; in.gb[r] = GB[o]; in.q[r] = Qb[o]; in.k[r] = Kb[o]; }
#pragma unroll
    for (int q = 0; q < 2; ++q) in.v[q] = *(const u32x4*)(Vb + (tok0 + (tid >> 3)) * 512 + h * 128 + 8 * ((tid & 7) + 8 * q));
    const bf16_t* SPf = (const bf16_t*)(a.ws + WS_SP) + ((size_t)(0 * 16 + bh) * NCHUNK + chunk) * 8192;
    const bf16_t* SPb = (const bf16_t*)(a.ws + WS_SP) + ((size_t)(1 * 16 + bh) * NCHUNK + chunk) * 8192;
    in.sraw[0] = *(const u32x4*)(SPf + 16 * tid); in.sraw[1] = *(const u32x4*)(SPf + 16 * tid + 8);
    in.sraw[2] = *(const u32x4*)(SPb + 16 * tid); in.sraw[3] = *(const u32x4*)(SPb + 16 * tid + 8);
    const bf16_t* Gt = (const bf16_t*)(a.ws + WS_G);
    const int mt = wave >> 1, fr = lane & 15, fq = lane >> 4;
#pragma unroll
    for (int q = 0; q < 4; ++q)
#pragma unroll
        for (int r = 0; r < 4; ++r) in.gr[r][q] = Gt[(tok0 + 16 * mt + 4 * fq + r) * 512 + h * 128 + 16 * (4 * (wave & 1) + q) + fr];
}
__device__ __forceinline__ void g3_unit(const Args& a, LAS unsigned char* L, int bh, int chunk  , const G3In& in, hy::CvState& cvs) {
    const int tid = threadIdx.x, lane = tid & 63, wave = __builtin_amdgcn_readfirstlane(tid >> 6);
    const int b = bh >> 2, h = bh & 3;
    const size_t tok0 = (size_t)b * SEQ + (size_t)chunk * CH;
    const int mt = wave >> 1, fr = lane & 15, fq = lane >> 4;
    float cumf[8], cumb[8], allf, allb;
    hy::cv_step(a, cvs, lane);
    __syncthreads();
    chunk_cums_pre(L, in.gf, in.gb, wave, lane, cumf, cumb, allf, allb);
    LAS bf16_t* qf = (LAS bf16_t*)(L + L_T0); LAS bf16_t* kf = (LAS bf16_t*)(L + L_T1); LAS bf16_t* qb = (LAS bf16_t*)(L + L_T2); LAS bf16_t* kb = (LAS bf16_t*)(L + L_T3);
#pragma unroll
    for (int r = 0; r < 8; ++r) { const int i = 8 * wave + r;
        const float qv = bf2f(in.q[r]), kv = bf2f(in.k[r]);
        qf[i * RS + lane] = f2bf(qv * __expf(cumf[r])); kf[i * RS + lane] = f2bf(kv * __expf(-cumf[r]));
        qb[i * RS + lane] = f2bf(qv * __expf(cumb[r])); kb[i * RS + lane] = f2bf(kv * __expf(-cumb[r])); }
    store_vt(L, in.v, tid);
    {
      LAS unsigned char* sf_ = L + L_SF + ((tid >> 2) * RS + 16 * (tid & 3)) * 2; LAS unsigned char* sb_ = L + L_SB + ((tid >> 2) * RS + 16 * (tid & 3)) * 2;
      *(LAS u32x4*)sf_ = in.sraw[0]; *(LAS u32x4*)(sf_ + 16) = in.sraw[1]; *(LAS u32x4*)sb_ = in.sraw[2]; *(LAS u32x4*)(sb_ + 16) = in.sraw[3]; }
    hy::cv_step(a, cvs, lane);
    __syncthreads();
    {
        LAS bf16_t* P = (LAS bf16_t*)(L + L_P);
#pragma unroll
        for (int q = 0; q < 2; ++q) { const int nt = 2 * (wave & 1) + q;
            f32x4 sf = {0.f, 0.f, 0.f, 0.f}, sb = {0.f, 0.f, 0.f, 0.f};
#pragma unroll
            for (int ks = 0; ks < 2; ++ks) {
                sf = __builtin_amdgcn_mfma_f32_16x16x32_bf16(frag(L + L_T0, 16 * mt, 32 * ks, lane), frag(L + L_T1, 16 * nt, 32 * ks, lane), sf, 0, 0, 0);
                sb = __builtin_amdgcn_mfma_f32_16x16x32_bf16(frag(L + L_T2, 16 * mt, 32 * ks, lane), frag(L + L_T3, 16 * nt, 32 * ks, lane), sb, 0, 0, 0); }
#pragma unroll
            for (int r = 0; r < 4; ++r) { const int i = 16 * mt + 4 * fq + r, j = 16 * nt + fr;
                P[i * RS + j] = f2bf((j <= i ? sf[r] : 0.f) + (j >= i ? sb[r] : 0.f)); } }
    }
    hy::cv_step(a, cvs, lane);
    __syncthreads();
    f32x4 o[4]; float ssq[4] = {0.f, 0.f, 0.f, 0.f};
#pragma unroll
    for (int q = 0; q < 4; ++q) { const int nt = 4 * (wave & 1) + q;
        f32x4 acc = {0.f, 0.f, 0.f, 0.f};
#pragma unroll
        for (int ks = 0; ks < 2; ++ks) {
            acc = __builtin_amdgcn_mfma_f32_16x16x32_bf16(frag(L + L_P, 16 * mt, 32 * ks, lane), frag(L + L_VT, 16 * nt, 32 * ks, lane), acc, 0, 0, 0);
            acc = __builtin_amdgcn_mfma_f32_16x16x32_bf16(frag(L + L_T0, 16 * mt, 32 * ks, lane), frag(L + L_SF, 16 * nt, 32 * ks, lane), acc, 0, 0, 0);
            acc = __builtin_amdgcn_mfma_f32_16x16x32_bf16(frag(L + L_T2, 16 * mt, 32 * ks, lane), frag(L + L_SB, 16 * nt, 32 * ks, lane), acc, 0, 0, 0); }
        o[q] = acc;
#pragma unroll
        for (int r = 0; r < 4; ++r) ssq[r] += acc[r] * acc[r]; }
    LAS float* SSQ = (LAS float*)(L + L_SSQ);
#pragma unroll
    for (int r = 0; r < 4; ++r) { float s = ssq[r]; s += __shfl_xor(s, 1); s += __shfl_xor(s, 2); s += __shfl_xor(s, 4); s += __shfl_xor(s, 8); ssq[r] = s; }
    if (fr == 0) {
#pragma unroll
        for (int r = 0; r < 4; ++r) SSQ[(wave & 1) * 64 + 16 * mt + 4 * fq + r] = ssq[r]; }
    hy::cv_step(a, cvs, lane);
    __syncthreads();
    const float* ng = a.in[I_NORMG];
    bf16_t* mix = (bf16_t*)(a.ws + WS_MIX);
#pragma unroll
    for (int r = 0; r < 4; ++r) { const int i = 16 * mt + 4 * fq + r;
        const float rstd = 1.f / sqrtf((SSQ[i] + SSQ[64 + i]) * (1.f / DV) + LN_EPS);
#pragma unroll
        for (int q = 0; q < 4; ++q) { const int dv = 16 * (4 * (wave & 1) + q) + fr;
            const float g = bf2f(in.gr[r][q]);
            mix[(tok0 + i) * 1024 + h * 128 + dv] = f2bf(o[q][r] * rstd * ng[dv] * silu_f(g)); } }
}
}

namespace rt {
constexpr int HS = 1028;
constexpr int L_H2 = 0;
constexpr int L_PART = 65792;
constexpr int L_LCNT = L_PART + 16384;
constexpr int L_REC = L_LCNT + 256;

__device__ __forceinline__ void phase(const Args& a, LAS unsigned char* lds) {
    const int tid = threadIdx.x, lane = tid & 63, wave = __builtin_amdgcn_readfirstlane(tid >> 6);
    bf16_t* xmid = (bf16_t*)(a.ws + WS_PRE1); bf16_t* H2 = (bf16_t*)(a.ws + WS_H2); const bf16_t* FG = (const bf16_t*)(a.ws + WS_FG);
    const float* mod = (const float*)(a.ws + WS_MOD);
    const float* rw = a.in[I_RW]; const float* rb = a.in[I_RB];
    LAS float* h2s = (LAS float*)(lds + L_H2); LAS float* part = (LAS float*)(lds + L_PART);
    LAS int* lcnt = (LAS int*)(lds + L_LCNT); LAS int* lbase = lcnt + 32; LAS int* rec = (LAS int*)(lds + L_REC);
    unsigned* cnt = (unsigned*)(a.ws + WS_CNT); int* list = (int*)(a.ws + WS_LIST); float* pw = (float*)(a.ws + WS_PW); int* ploc = (int*)(a.ws + WS_PLOC);
    float rwr[32][2];
#pragma unroll
    for (int s = 0; s < 32; ++s)
#pragma unroll
        for (int nt = 0; nt < 2; ++nt) rwr[s][nt] = rw[(size_t)(128 * wave + 4 * s + (lane >> 4)) * 32 + 16 * nt + (lane & 15)];
    const f32x4* g1 = (const f32x4*)a.in[I_LN1G]; const f32x4* bb1 = (const f32x4*)a.in[I_LN1B];
    if (tid < 32) lcnt[tid] = 0;
    f32x4 xq[2][4]; u32x2 fq_[2][4];
#define RT_LOAD(g_) do { _Pragma("unroll") for (int rr = 0; rr < 2; ++rr) { const int t_ = (g_) * 16 + 2 * wave + rr; \
        const f32x4* xr_ = (const f32x4*)(a.in[I_X] + (size_t)t_ * D) + lane; const u32x2* fr_ = (const u32x2*)(FG + (size_t)t_ * D) + lane; \
        _Pragma("unroll") for (int j = 0; j < 4; ++j) { xq[rr][j] = xr_[64 * j]; fq_[rr][j] = fr_[64 * j]; } } } while (0)
    if ((int)blockIdx.x < T / 16) RT_LOAD((int)blockIdx.x);
    for (int grp = blockIdx.x; grp < T / 16; grp += gridDim.x) {
        __syncthreads();
        f32x4 xv_[2][4]; u32x2 fv_[2][4];
#pragma unroll
        for (int rr = 0; rr < 2; ++rr)
#pragma unroll
            for (int j = 0; j < 4; ++j) { xv_[rr][j] = xq[rr][j]; fv_[rr][j] = fq_[rr][j]; }
        if (grp + (int)gridDim.x < T / 16) RT_LOAD(grp + (int)gridDim.x);
#pragma unroll
        for (int rr = 0; rr < 2; ++rr) {
            const int lr = 2 * wave + rr, t = grp * 16 + lr, b = t >> 13;
            u32x2* pr = (u32x2*)(xmid + (size_t)t * D) + lane;
            f32x4 v[4]; float s = 0.f;
#pragma unroll
            for (int j = 0; j < 4; ++j) { const u32x2 fw = fv_[rr][j]; const f32x4 ff = {bflo(fw.x), bfhi(fw.x), bflo(fw.y), bfhi(fw.y)};
                v[j] = xv_[rr][j] * ALPHA + ff; s += (v[j][0] + v[j][1]) + (v[j][2] + v[j][3]); }
            float mean = wave_sum(s) * (1.f / D), s2 = 0.f;
#pragma unroll
            for (int j = 0; j < 4; ++j) { v[j] = v[j] - mean; s2 += (v[j][0] * v[j][0] + v[j][1] * v[j][1]) + (v[j][2] * v[j][2] + v[j][3] * v[j][3]); }
            float rstd = 1.f / sqrtf(wave_sum(s2) * (1.f / D) + LN_EPS);
            s = 0.f;
#pragma unroll
            for (int j = 0; j < 4; ++j) { v[j] = v[j] * rstd * g1[64 * j + lane] + bb1[64 * j + lane]; u32x2 w; w.x = pk2(v[j][0], v[j][1]); w.y = pk2(v[j][2], v[j][3]); pr[64 * j] = w;
                v[j] = (f32x4){bflo(w.x), bfhi(w.x), bflo(w.y), bfhi(w.y)}; s += (v[j][0] + v[j][1]) + (v[j][2] + v[j][3]); }
            mean = wave_sum(s) * (1.f / D); s2 = 0.f;
#pragma unroll
            for (int j = 0; j < 4; ++j) { v[j] = v[j] - mean; s2 += (v[j][0] * v[j][0] + v[j][1] * v[j][1]) + (v[j][2] * v[j][2] + v[j][3] * v[j][3]); }
            rstd = 1.f / sqrtf(wave_sum(s2) * (1.f / D) + LN_EPS);
            const f32x4* sh = (const f32x4*)(mod + b * 6144 + 3 * 1024); const f32x4* sc = (const f32x4*)(mod + b * 6144 + 4 * 1024);
            unsigned* o4 = (unsigned*)((unsigned char*)H2 + (size_t)t * D) + lane;
#pragma unroll
            for (int j = 0; j < 4; ++j) { const f32x4 y = v[j] * rstd * (sc[64 * j + lane] + 1.f) + sh[64 * j + lane];
                o4[64 * j] = gm::pk4_fp8(y[0] * gm::S_H2, y[1] * gm::S_H2, y[2] * gm::S_H2, y[3] * gm::S_H2);
                *(LAS f32x4*)(h2s + lr * HS + 256 * j + 4 * lane) = y; }
        }
        __syncthreads();
        {
            f32x4 acc0 = {0.f, 0.f, 0.f, 0.f}, acc1 = {0.f, 0.f, 0.f, 0.f};
            const LAS float* ap = h2s + (lane & 15) * HS + 128 * wave + (lane >> 4);
#pragma unroll
            for (int s = 0; s < 32; ++s) { const float av = ap[4 * s];
                acc0 = __builtin_amdgcn_mfma_f32_16x16x4f32(av, rwr[s][0], acc0, 0, 0, 0);
                acc1 = __builtin_amdgcn_mfma_f32_16x16x4f32(av, rwr[s][1], acc1, 0, 0, 0); }
#pragma unroll
            for (int r = 0; r < 4; ++r) { part[(wave * 16 + 4 * (lane >> 4) + r) * 32 + (lane & 15)] = acc0[r]; part[(wave * 16 + 4 * (lane >> 4) + r) * 32 + 16 + (lane & 15)] = acc1[r]; }
        }
        __syncthreads();
        {
            const int lr = 2 * wave + (lane >> 5), e = lane & 31, t = grp * 16 + lr;
            float lg = rb[e];
#pragma unroll
            for (int w = 0; w < 8; ++w) lg += part[(w * 16 + lr) * 32 + e];
            float cur = lg, tv[4]; int ti[4];
#pragma unroll
            for (int k = 0; k < 4; ++k) { float bv = cur; int bi = e;
#pragma unroll
                for (int o = 1; o < 32; o <<= 1) { const float ov = __shfl_xor(bv, o); const int oi = __shfl_xor(bi, o); if (ov > bv || (ov == bv && oi < bi)) { bv = ov; bi = oi; } }
                tv[k] = bv; ti[k] = bi; if (bi == e) cur = -3.0e38f; }
            const float e1 = __expf(tv[1] - tv[0]), e2 = __expf(tv[2] - tv[0]), e3 = __expf(tv[3] - tv[0]);
            const float inv = 1.f / (1.f + e1 + e2 + e3);
            if (e < 4) { const float wk = (e == 0 ? 1.f : (e == 1 ? e1 : (e == 2 ? e2 : e3))) * inv; const int ek = (e == 0 ? ti[0] : (e == 1 ? ti[1] : (e == 2 ? ti[2] : ti[3])));
                const int pair = t * 4 + e;
                pw[pair] = wk;
                const int rank = __hip_atomic_fetch_add((LAS int*)&lcnt[ek], 1, __ATOMIC_RELAXED, __HIP_MEMORY_SCOPE_WORKGROUP);
                rec[lr * 4 + e] = ek | (rank << 8); }
        }
        __syncthreads();
        if (tid < 32) { const int n = lcnt[tid]; lbase[tid] = n ? (int)atomicAdd(&cnt[tid], (unsigned)n) : 0; }
        __syncthreads();
        if (tid < 64) { const int rc = rec[tid], ek = rc & 255, rank = rc >> 8, pos = lbase[ek] + rank, pair = (grp * 16 + (tid >> 2)) * 4 + (tid & 3);
            list[(size_t)ek * CAP + pos] = pair; ploc[pair] = ek | (pos << 5); }
        __syncthreads();
        if (tid < 32) lcnt[tid] = 0;
    }
#undef RT_LOAD
}
}

__device__ __forceinline__ void p_final(const Args& a, LAS unsigned char* lds) {
    const int tid = threadIdx.x, lane = tid & 63, wave = tid >> 6;
    const bf16_t* xm = (const bf16_t*)(a.ws + WS_PRE1); const unsigned char* slots = (const unsigned char*)(a.ws + WS_SLOTS); const float* mod = (const float*)(a.ws + WS_MOD);
    const int* ploc = (const int*)(a.ws + WS_PLOC); const float* pw = (const float*)(a.ws + WS_PW);
    const f32x4* g2 = (const f32x4*)a.in[I_LN2G]; const f32x4* b2 = (const f32x4*)a.in[I_LN2B];
    LAS int* tstart = (LAS int*)lds;
    __syncthreads();
    if (tid == 0) { const unsigned* cnt = (const unsigned*)(a.ws + WS_CNT); int nrt = 0; for (int e = 0; e < NE; ++e) { tstart[e] = 256 * nrt; nrt += ((int)cnt[e] + 255) >> 8; } }
    __syncthreads();
    const int tstep = gridDim.x * NWAVES; int t = blockIdx.x * NWAVES + wave;
    if (t < T) {
        int plc[4], pln[4]; float wc_[4], wn_[4]; unsigned qc[4][4], qn[4][4]; u32x2 xc[4], xn[4];
#define PF_IDX(tt, pl, ww) do { _Pragma("unroll") for (int sl = 0; sl < 4; ++sl) { pl[sl] = ploc[(tt) * 4 + sl]; ww[sl] = pw[(tt) * 4 + sl] * (1.f / gm::S_SL); } } while (0)
#define PF_DATA(tt, pl, qq, xx) do { _Pragma("unroll") for (int sl = 0; sl < 4; ++sl) { const unsigned* sr_ = (const unsigned*)(slots + (size_t)(tstart[pl[sl] & 31] + (pl[sl] >> 5)) * D) + lane; \
            _Pragma("unroll") for (int j = 0; j < 4; ++j) qq[sl][j] = sr_[64 * j]; } \
        { const u32x2* xr_ = (const u32x2*)(xm + (size_t)(tt) * D) + lane; _Pragma("unroll") for (int j = 0; j < 4; ++j) xx[j] = xr_[64 * j]; } } while (0)
        PF_IDX(t, plc, wc_); PF_DATA(t, plc, qc, xc);
        int tn = t + tstep; const bool hn0 = tn < T;
        if (hn0) PF_IDX(tn, pln, wn_);
        for (;;) {
            const bool hn = tn < T;
            if (hn) PF_DATA(tn, pln, qn, xn);
            int pl2[4]; float w2[4]; const int tn2 = tn + tstep; const bool hn2 = hn && tn2 < T;
            if (hn2) PF_IDX(tn2, pl2, w2);
            {
                const int b = t >> 13; const f32x4* gt = (const f32x4*)(mod + b * 6144 + 5 * 1024);
                f32x4 v[4]; float s = 0.f;
#pragma unroll
                for (int j = 0; j < 4; ++j) { f32x4 y = {0.f, 0.f, 0.f, 0.f};
#pragma unroll
                    for (int sl = 0; sl < 4; ++sl) { const int q = (int)qc[sl][j];
                        y[0] += wc_[sl] * __builtin_amdgcn_cvt_f32_fp8(q, 0); y[1] += wc_[sl] * __builtin_amdgcn_cvt_f32_fp8(q, 1); y[2] += wc_[sl] * __builtin_amdgcn_cvt_f32_fp8(q, 2); y[3] += wc_[sl] * __builtin_amdgcn_cvt_f32_fp8(q, 3); }
                    const f32x4 xv = {bflo(xc[j].x), bfhi(xc[j].x), bflo(xc[j].y), bfhi(xc[j].y)};
                    v[j] = xv * ALPHA + gt[64 * j + lane] * y; s += (v[j][0] + v[j][1]) + (v[j][2] + v[j][3]); }
                const float mean = wave_sum(s) * (1.f / D); float s2 = 0.f;
#pragma unroll
                for (int j = 0; j < 4; ++j) { v[j] = v[j] - mean; s2 += (v[j][0] * v[j][0] + v[j][1] * v[j][1]) + (v[j][2] * v[j][2] + v[j][3] * v[j][3]); }
                const float rstd = 1.f / sqrtf(wave_sum(s2) * (1.f / D) + LN_EPS);
                f32x4* o = (f32x4*)(a.out + (size_t)t * D) + lane;
#pragma unroll
                for (int j = 0; j < 4; ++j) o[64 * j] = v[j] * rstd * g2[64 * j + lane] + b2[64 * j + lane];
            }
            if (!hn) break;
            t = tn; tn = tn2;
#pragma unroll
            for (int sl = 0; sl < 4; ++sl) { plc[sl] = pln[sl]; wc_[sl] = wn_[sl]; pln[sl] = pl2[sl]; wn_[sl] = w2[sl];
#pragma unroll
                for (int j = 0; j < 4; ++j) qc[sl][j] = qn[sl][j]; }
#pragma unroll
            for (int j = 0; j < 4; ++j) xc[j] = xn[j];
        }
#undef PF_IDX
#undef PF_DATA
    }
}


constexpr int N_PHASES = 11;
__global__ void __launch_bounds__(NTHREADS, 2) mega_fwd(Args a) {
    extern __shared__ __attribute__((aligned(16))) unsigned char lds_raw[];
    LAS unsigned char* lds = (LAS unsigned char*)lds_raw;
    const int tid = threadIdx.x;
    volatile LAS unsigned* misc = (volatile LAS unsigned*)(lds + LDS_MISC);
    if (tid < 4) misc[tid] = 0u;
    __syncthreads();
    XcdBarrier bar; bar.bar = (unsigned*)(a.ws + WS_BAR); bar.x = 0; bar.st = misc;
    const bool multi = (a.ph_hi - a.ph_lo) > 1;
    if (multi) bar = xcd_barrier_post((unsigned*)(a.ws + WS_BAR), misc);
    const int lo = a.ph_lo, hi = a.ph_hi;
#define vcu ((gridDim.x % 8 == 0) ? (int)((blockIdx.x % 8) * (gridDim.x / 8) + blockIdx.x / 8) : (int)blockIdx.x)
#ifdef ONLY_PHASE
#define IN(k) ((k) == ONLY_PHASE && lo <= (k) && (k) < hi)
#else
#define IN(k) (lo <= (k) && (k) < hi)
#endif
#define SEAM(k) do { if (IN(k) && IN((k) + 1)) xcd_barrier(bar); } while (0)

#ifndef REPEAT_PHASE
#define REPEAT_PHASE -1
#endif
#ifdef PROF_REP
#define RUNPH(k, ...) do { if (IN(k)) { const int nrep_ = (a.rep_k == (k)) ? 2 : 1; for (int rep_ = 0; rep_ < nrep_; ++rep_) { if (rep_) xcd_barrier(bar); __VA_ARGS__; } } } while (0)
#else
#define RUNPH(k, ...) do { if (IN(k)) { __VA_ARGS__; if (REPEAT_PHASE == (k)) { xcd_barrier(bar); __VA_ARGS__; } } } while (0)
#endif
    RUNPH(0, p0_mod_and_filter(a, lds));
    SEAM(0);
    RUNPH(1, p1_prep(a, lds));
    SEAM(1);
    RUNPH(2, { gm::SchedIn S{a.ws, (int)gridDim.x, vcu, a.in[I_BAF], a.in[I_BAB]}; gm::EpiIn E{a.ws}; gm::gemm_stream<false, 0, false>(lds, S, E);
        {
          const int G = (int)gridDim.x, rounds = (1812 + G - 1) / G, extra = 1812 - (rounds - 1) * G, v = vcu;
          if (v >= extra || extra == G) { const int nidle = (extra == G) ? G : G - extra, ridle = (extra == G) ? v : v - extra; __syncthreads();
              prep_items(a, (LAS float*)(lds + (tid >> 6) * 16384), PREP_NITEMS - PREP_DEFER, PREP_NITEMS, ridle * NWAVES + (tid >> 6), nidle * NWAVES, tid & 63); } } });
    SEAM(2);
    RUNPH(3, { for (int u = blockIdx.x; u < 16 * NCT; u += gridDim.x) gla::g1_unit(a, lds, u / NCT, u % NCT); });
    SEAM(3);
    RUNPH(4, { gla::g2_scan(a);
        hy::CvState cvs; cvs.jb.mi = -1; cvs.next = (int)blockIdx.x * NWAVES + (tid >> 6); cvs.stride = (int)gridDim.x * NWAVES; cvs.end = hy::CV_ITEMS / 2;
        for (int c = blockIdx.x; c < HYW; c += gridDim.x) hy::channel(a, lds, c, a.ws + WS_HSPEC + (size_t)blockIdx.x * HSPEC_PER_WG, cvs);
        while (cvs.jb.mi >= 0 || cvs.next < cvs.end) hy::cv_step(a, cvs, tid & 63); });
    SEAM(4);
    RUNPH(5, { hy::CvState cvs; cvs.jb.mi = -1; cvs.stride = (int)gridDim.x * NWAVES; cvs.end = hy::CV_ITEMS;
        { const int w0_ = (int)blockIdx.x * NWAVES + (tid >> 6), half_ = hy::CV_ITEMS / 2; cvs.next = half_ + ((w0_ - half_ % cvs.stride) % cvs.stride + cvs.stride) % cvs.stride; }
        { int u = blockIdx.x; gla::G3In cur, nxt;
            if (u < 16 * NCHUNK) { gla::g3_load(a, u >> 7, u & 127, cur);
                for (;;) { const int un = u + (int)gridDim.x; const bool hn = un < 16 * NCHUNK; if (hn) gla::g3_load(a, un >> 7, un & 127, nxt);
                    gla::g3_unit(a, lds, u >> 7, u & 127, cur, cvs); if (!hn) break; cur = nxt; u = un; } } }
        while (cvs.jb.mi >= 0 || cvs.next < cvs.end) hy::cv_step(a, cvs, tid & 63);
        const int wave = tid >> 6;
        for (int it = blockIdx.x * NWAVES + wave; it < 4096; it += gridDim.x * NWAVES) hy::transpose_item(a, it, tid & 63); });
    SEAM(5);
    RUNPH(6, { gm::SchedOut S{a.ws, (int)gridDim.x, vcu}; gm::EpiOut E{a.ws}; gm::gemm_stream<false, 0, false>(lds, S, E); });
    SEAM(6);
    RUNPH(7, rt::phase(a, lds));
    SEAM(7);
    if (IN(8) || IN(9)) {
        LAS int* tab = (LAS int*)(lds + gm::LDS_TAB);
        __syncthreads();
        if (tid == 0) { const unsigned* cnt = (const unsigned*)(a.ws + WS_CNT); int nrt = 0;
            for (int e = 0; e < NE; ++e) { const int n = (int)cnt[e]; tab[e] = n; const int nt = (n + 255) >> 8; for (int k = 0; k < nt; ++k) tab[64 + nrt + k] = e | (k << 8); nrt += nt; }
            tab[32] = nrt; }
        __syncthreads();
    }
    RUNPH(8, { gm::SchedMoe<1> S{a.ws, (const LAS int*)(lds + gm::LDS_TAB), (int)gridDim.x, vcu, a.in[I_EB2]}; gm::EpiMoe1 E{a.ws}; gm::gemm_stream<true, 2, true>(lds, S, E); });
    SEAM(8);
    RUNPH(9, { gm::SchedMoe<2> S{a.ws, (const LAS int*)(lds + gm::LDS_TAB), (int)gridDim.x, vcu, a.in[I_EB2]}; gm::EpiMoe2 E{a.ws}; gm::gemm_stream<false, 0, true>(lds, S, E); });
    SEAM(9);
    RUNPH(10, p_final(a, lds));
#undef RUNPH
#undef vcu
#undef IN
#undef SEAM
}

extern "C" void kernel_launch(void* const* d_in, const int* in_sizes, int n_in, void* d_out, int out_size, void* d_ws, size_t ws_size, hipStream_t stream) {
    static int grid = 0;
    if (grid == 0) {
        if (n_in != 32 || out_size != T * D || ws_size < WS_END) { fprintf(stderr, "kernel_launch: unexpected shapes (n_in %d out %d ws %zu need %zu)\n", n_in, out_size, ws_size, (size_t)WS_END); grid = -1; return; }
        int dev = 0, cus = 0;
        if (hipGetDevice(&dev) != hipSuccess || hipDeviceGetAttribute(&cus, hipDeviceAttributeMultiprocessorCount, dev) != hipSuccess) { grid = -1; return; }
        if (hipFuncSetAttribute((const void*)mega_fwd, hipFuncAttributeMaxDynamicSharedMemorySize, LDS_BYTES) != hipSuccess) { fprintf(stderr, "kernel_launch: hipFuncSetAttribute failed\n"); grid = -1; return; }
        int per_cu = 0;
        if (hipOccupancyMaxActiveBlocksPerMultiprocessor(&per_cu, (const void*)mega_fwd, NTHREADS, LDS_BYTES) != hipSuccess || per_cu < 1) fprintf(stderr, "kernel_launch: occupancy query says %d\n", per_cu);
        (void)hipGetLastError();
        grid = cus;
        if (grid > MAX_GRID) grid = MAX_GRID;
    }
    if (grid < 0) return;
    (void)hipMemsetAsync(d_ws, 0, WS_ZERO_BYTES, stream);
    Args a{};
    for (int i = 0; i < 32; ++i) a.in[i] = (const float*)d_in[i];
    a.out = (float*)d_out; a.ws = (unsigned char*)d_ws;
#ifdef DBG
    (void)hipMemsetAsync((char*)d_ws + WS_DBG, 0, 512, stream);
    for (int p = 0; p < N_PHASES; ++p) { a.ph_lo = p; a.ph_hi = p + 1; hipLaunchKernelGGL(mega_fwd, dim3(grid), dim3(NTHREADS), LDS_BYTES, stream, a);
        hipLaunchKernelGGL(dbg_check, dim3(64), dim3(512), 0, stream, a, p); }
    hipLaunchKernelGGL(dbg_encode, dim3(1024), dim3(256), 0, stream, a);
#elif N_LAUNCH_PER_PHASE
    for (int p = 0; p < N_PHASES; ++p) { a.ph_lo = p; a.ph_hi = p + 1; hipLaunchKernelGGL(mega_fwd, dim3(grid), dim3(NTHREADS), LDS_BYTES, stream, a); }
#else
    a.ph_lo = 0; a.ph_hi = N_PHASES;
#ifdef PROF_REP
    a.rep_k = PROF_REP;
#endif
    hipLaunchKernelGGL(mega_fwd, dim3(grid), dim3(NTHREADS), LDS_BYTES, stream, a);
#endif
}
```

```cpp
#include <hip/hip_runtime.h>
#include <cstdio>
#include <cstdint>
#include <cstddef>

#define LAS __attribute__((address_space(3)))
#define GAS __attribute__((address_space(1)))
typedef unsigned short bf16_t;
typedef short bf16x8 __attribute__((ext_vector_type(8)));
typedef float f32x4 __attribute__((ext_vector_type(4)));
typedef float f32x2 __attribute__((ext_vector_type(2)));
typedef unsigned u32x4 __attribute__((ext_vector_type(4)));
typedef unsigned u32x2 __attribute__((ext_vector_type(2)));

#ifndef N_LAUNCH_PER_PHASE
#define N_LAUNCH_PER_PHASE 0
#endif

constexpr int D = 1024, NB = 4, SEQ = 8192, T = NB * SEQ, CTXL = 256, TC = NB * CTXL, TT = T + TC;
constexpr int NH = 4, DK = 64, DV = 128, CH = 64, NCHUNK = SEQ / CH, NCC = CTXL / CH, NCT = NCHUNK + NCC;
constexpr int HYW = 512, HYC = 3 * HYW, INW = 3104;
constexpr int NE = 32, DE = 1024, CAP = T;
constexpr float LN_EPS = 1e-6f, ALPHA = 1.189207115002721f;
constexpr int NTHREADS = 512, NWAVES = 8;
constexpr int FFTN = 16384;

constexpr size_t al256(size_t x) { return (x + 255) & ~(size_t)255; }
constexpr size_t WS_BAR   = 0;
constexpr size_t WS_MOD   = 16384;
constexpr size_t WS_CNT   = WS_MOD + 5 * 6144 * 4;
constexpr size_t WS_ZERO_BYTES = al256(WS_CNT + 256);
constexpr size_t WS_LIST  = 262144;
constexpr size_t WS_PW    = WS_LIST + (size_t)NE * CAP * 4;
constexpr size_t WS_PLOC  = WS_PW + (size_t)T * 4 * 4;
constexpr size_t WS_B1R   = WS_PLOC + (size_t)T * 4 * 4;
constexpr size_t WS_HID2  = WS_B1R + (size_t)NE * 2048 * 4;
constexpr size_t WS_BTIN  = WS_HID2 + (size_t)SEQ * 64 * 4;
constexpr size_t WS_BTOUT = WS_BTIN + (size_t)3584 * 1024 * 2;
constexpr size_t WS_W1T   = WS_BTOUT + (size_t)1024 * 1024 * 2;
constexpr size_t WS_W2T   = WS_W1T + (size_t)NE * 2048 * 1024 * 2;
constexpr size_t WS_PRE1  = WS_W2T + (size_t)NE * 1024 * 1024 * 2;
constexpr size_t WS_RA    = WS_PRE1 + (size_t)T * 1024 * 4;
constexpr size_t WS_H     = WS_RA;
constexpr size_t WS_Q     = WS_H + (size_t)TT * 1024 * 2;
constexpr size_t WS_K     = WS_Q + (size_t)T * 256 * 2;
constexpr size_t WS_V     = WS_K + (size_t)TT * 256 * 2;
constexpr size_t WS_G     = WS_V + (size_t)TT * 512 * 2;
constexpr size_t WS_GF    = WS_G + (size_t)T * 512 * 2;
constexpr size_t WS_GB    = WS_GF + (size_t)TT * 256 * 4;
constexpr size_t WS_UT    = WS_GB + (size_t)TT * 256 * 4;
constexpr size_t WS_RA_END= WS_UT + (size_t)NB * HYC * SEQ * 2;
constexpr size_t WS_H2    = WS_RA;
constexpr size_t WS_FG    = WS_RA + (size_t)T * 1024 * 2;
constexpr size_t WS_SLOTS = WS_RA;
constexpr size_t SORTED_BYTES_ = (size_t)(T * 4 / 256 + NE) * 256 * 1024 * 2;
constexpr size_t WS_RB    = al256(WS_RA_END > WS_RA + SORTED_BYTES_ ? WS_RA_END : WS_RA + SORTED_BYTES_);
constexpr size_t WS_KV    = WS_RB;
constexpr size_t WS_AV    = WS_KV + (size_t)2 * 16 * NCT * 8192 * 2;
constexpr size_t WS_SP    = WS_AV + (size_t)2 * 16 * NCT * 64 * 4;
constexpr size_t WS_HSPEC = WS_SP + (size_t)2 * 16 * NCHUNK * 8192 * 2;
constexpr size_t HSPEC_PER_WG = (size_t)2 * FFTN * 8;
constexpr int MAX_GRID = 256;
constexpr size_t WS_YHYT  = WS_HSPEC + (size_t)MAX_GRID * HSPEC_PER_WG;
constexpr size_t WS_MIX   = WS_YHYT + (size_t)NB * HYW * SEQ * 2;
constexpr size_t WS_RB_END= WS_MIX + (size_t)T * 1024 * 2;
constexpr size_t WS_HF    = WS_MIX;
constexpr size_t WS_ACT   = WS_RB;
constexpr size_t SORTED_BYTES = (size_t)(T * 4 / 256 + NE) * 256 * 1024 * 2;
constexpr size_t WS_END   = al256(WS_RB_END > WS_RB + SORTED_BYTES ? WS_RB_END : WS_RB + SORTED_BYTES);

constexpr int LDS_BYTES = 147456;
constexpr int LDS_MISC  = 145408;

typedef __bf16 bf16n2 __attribute__((ext_vector_type(2)));
__device__ __forceinline__ unsigned pk2(float lo, float hi) { bf16n2 v = {(__bf16)lo, (__bf16)hi}; return __builtin_bit_cast(unsigned, v); }
__device__ __forceinline__ bf16_t f2bf(float f) { __bf16 b = (__bf16)f; return __builtin_bit_cast(unsigned short, b); }
__device__ __forceinline__ float bf2f(bf16_t b) { return __uint_as_float(((unsigned)b) << 16); }
__device__ __forceinline__ float bflo(unsigned w) { return __uint_as_float(w << 16); }
__device__ __forceinline__ float bfhi(unsigned w) { return __uint_as_float(w & 0xffff0000u); }
__device__ __forceinline__ float wave_sum(float v) {
#pragma unroll
    for (int o = 1; o < 64; o <<= 1) v += __shfl_xor(v, o);
    return v;
}
__device__ __forceinline__ float silu_f(float x) { return x * __builtin_amdgcn_rcpf(1.f + __expf(-x)); }
__device__ __forceinline__ float log_sigmoid_f(float z) { return fminf(z, 0.f) - __logf(1.f + __expf(-fabsf(z))); }

#define XB_TMO      128
#define XB_XCNT(j)  (256  + 64 * (j))
#define XB_XSUB(j)  (1280 + 64 * (j))
#define XB_XGEN(j)  (2304 + 64 * (j))
#define XB_TOP      3328
#define XB_TOPGEN   3392
#define XCD_BAR_WORDS 3456
#define XB_SPIN_CAP (1u << 22)
__device__ __forceinline__ unsigned xb_ld(unsigned* p)              { return __hip_atomic_load(p, __ATOMIC_RELAXED, __HIP_MEMORY_SCOPE_AGENT); }
__device__ __forceinline__ unsigned xb_add(unsigned* p, unsigned v) { return __hip_atomic_fetch_add(p, v, __ATOMIC_RELAXED, __HIP_MEMORY_SCOPE_AGENT); }
__device__ __forceinline__ unsigned xb_xcc_id() { return (unsigned)__builtin_amdgcn_s_getreg((3 << 11) | 20) & 0xFu; }
#define XB_SPIN(cond, bar) do { unsigned _sp = 0; while (cond) { __builtin_amdgcn_s_sleep(1); \
    if ((++_sp & 255u) == 0u) { if (xb_ld(&(bar)[XB_TMO])) break; if (_sp > XB_SPIN_CAP) { atomicAdd(&(bar)[XB_TMO], 1u); break; } } } } while (0)
struct XcdBarrier { unsigned* bar; unsigned x; volatile LAS unsigned* st; };
__device__ __forceinline__ XcdBarrier xcd_barrier_post(unsigned* bar, volatile LAS unsigned* st) {
    XcdBarrier b; b.bar = bar; b.x = xb_xcc_id(); b.st = st;
    if (threadIdx.x == 0) (void)xb_add(&bar[XB_XCNT(b.x)], 1u);
    return b;
}
__device__ __forceinline__ void xcd_barrier_complete(unsigned* bar, unsigned x, unsigned& nloc, unsigned& nx) {
    const unsigned G = gridDim.x * gridDim.y * gridDim.z;
    unsigned sum, cnt, mine, sp = 0u;
    for (;;) {
        sum = 0u; cnt = 0u; mine = 0u;
#pragma unroll
        for (unsigned j = 0; j < 16; ++j) { const unsigned c = xb_ld(&bar[XB_XCNT(j)]); sum += c; cnt += (c > 0u) ? 1u : 0u; mine = (j == x) ? c : mine; }
        if (sum == G) break;
        __builtin_amdgcn_s_sleep(1);
        if ((++sp & 255u) == 0u) { if (xb_ld(&bar[XB_TMO])) break; if (sp > XB_SPIN_CAP) { atomicAdd(&bar[XB_TMO], 1u); break; } }
    }
    nloc = mine > 0u ? mine : 1u; nx = cnt > 0u ? cnt : 1u;
}
__device__ __forceinline__ void xcd_barrier(const XcdBarrier& b) {
    asm volatile("s_waitcnt vmcnt(0)" ::: "memory");
    __syncthreads();
    if (threadIdx.x == 0) {
        unsigned* bar = b.bar;
        __builtin_amdgcn_s_waitcnt(0);
        unsigned nloc = b.st[0], nx = b.st[1];
        if (nloc == 0u) { xcd_barrier_complete(bar, b.x, nloc, nx); b.st[0] = nloc; b.st[1] = nx; }
        const unsigned old = xb_add(&bar[XB_XSUB(b.x)], 1u);
        const unsigned gen = old / nloc;
        if (old + 1u == (gen + 1u) * nloc) {
            __builtin_amdgcn_fence(__ATOMIC_RELEASE, "agent");
            asm volatile("s_waitcnt vmcnt(0)" ::: "memory");
            const unsigned og = xb_add(&bar[XB_TOP], 1u);
            const unsigned tg = og / nx;
            if (og + 1u == (tg + 1u) * nx) xb_add(&bar[XB_TOPGEN], 1u);
            else XB_SPIN(xb_ld(&bar[XB_TOPGEN]) == tg, bar);
            __builtin_amdgcn_fence(__ATOMIC_ACQUIRE, "agent");
            xb_add(&bar[XB_XGEN(b.x)], 1u);
            asm volatile("s_waitcnt vmcnt(0)" ::: "memory");
        } else {
            XB_SPIN(xb_ld(&bar[XB_XGEN(b.x)]) == gen, bar);
            __builtin_amdgcn_fence(__ATOMIC_ACQUIRE, "agent");
            asm volatile("s_waitcnt vmcnt(0)" ::: "memory");
        }
    }
    __syncthreads();
}

struct Args {
    const float* in[32];
    float* out;
    unsigned char* ws;
    int ph_lo, ph_hi;
    int rep_k, pad_;
};
enum { I_X = 0, I_C, I_CTX, I_CCTX, I_ADAW, I_ADAB, I_WIN, I_WAF, I_BAF, I_WAB, I_BAB, I_NORMG, I_CONVW, I_CONVB, I_FW1, I_FB1, I_FW2, I_FB2, I_FWOUT, I_FFREQ,
       I_BIASD, I_WOUT, I_LN1G, I_LN1B, I_RW, I_RB, I_EW1, I_EB1, I_EW2, I_EB2, I_LN2G, I_LN2B };


namespace gm {
constexpr int BM = 256, BK = 64, HALF = 128, HTB = HALF * BK * 2, STAGE_BYTES = 8 * HTB, KD = 1024, NT = KD / BK;
constexpr int ROWB = KD * 2;
typedef int i32x8 __attribute__((ext_vector_type(8)));
__device__ __forceinline__ int lds_off8(int r, int fq) { const int rr = r & 15; return ((r >> 4) * 2 + (fq >> 1)) * 1024 + ((rr * 64 + 32 * (fq & 1)) ^ (((rr >> 3) & 1) << 5)); }
__device__ __forceinline__ int lds_byte(int r, int c) { const int st = (r >> 4) * 2 + (c >> 5), rr = r & 15, cc = c & 31, ob = rr * 64 + cc * 2; return st * 1024 + (ob ^ (((ob >> 9) & 1) << 5)); }
__device__ __forceinline__ void stage_rc(int b, int& R, int& C) { const int st = b / 1024, sb = b % 1024, swz = sb ^ (((sb >> 9) & 1) << 5); R = (st >> 1) * 16 + swz / 64; C = (st & 1) * 32 + (swz % 64) / 2; }
__device__ __forceinline__ int perm32(int rho) { const int n = rho >> 4, i = rho & 15; return 8 * (i >> 2) + 4 * n + (i & 3); }

constexpr int LDS_BIAS = STAGE_BYTES + 4096;
struct Unit {
    const char* A;
    const char* B;
    const int* list;
    int type, row0, col0, valid, aux;
};

__device__ __forceinline__ i32x8 cat8(bf16x8 lo, bf16x8 hi) { typedef int i32x4 __attribute__((ext_vector_type(4))); const i32x4 a = __builtin_bit_cast(i32x4, lo), b = __builtin_bit_cast(i32x4, hi); return (i32x8){a[0], a[1], a[2], a[3], b[0], b[1], b[2], b[3]}; }
template <bool GATHER, int GSHIFT, int RB>
__device__ __forceinline__ void a_offsets(const Unit& u, unsigned (&o)[2][2]) {
    int R[2], Cb[2];
    int tz = threadIdx.x; asm volatile("" : "+v"(tz));
#pragma unroll
    for (int i = 0; i < 2; ++i) { int r, c; stage_rc(tz * 16 + i * 8192, r, c); R[i] = r; Cb[i] = c * 2; }
#pragma unroll
    for (int h = 0; h < 2; ++h)
#pragma unroll
        for (int i = 0; i < 2; ++i) {
            const int r = h * HALF + R[i];
            if (!GATHER) o[h][i] = (unsigned)(r * RB + Cb[i]);
            else { const int idx = u.list[r < u.valid ? r : 0]; o[h][i] = (unsigned)(idx >> GSHIFT) * (unsigned)RB + (unsigned)Cb[i]; }
        }
}

template <bool GATHER, int GSHIFT, bool FP8, class Sched, class Epi>
__device__ __forceinline__ void gemm_stream(LAS unsigned char* lds, const Sched& S, const Epi& E) {
    constexpr int RB = FP8 ? KD : ROWB, NTL = FP8 ? NT / 2 : NT;
    const int tid = threadIdx.x, wid = __builtin_amdgcn_readfirstlane(tid >> 6), lane = tid & 63, wr = wid >> 2, wc = wid & 3, fr = lane & 15, fq = lane >> 4;
    unsigned voffB[2], voffA[2];
#pragma unroll
    for (int i = 0; i < 2; ++i) { int r, c; stage_rc(tid * 16 + i * 8192, r, c); const int rb = (r & ~31) + perm32(r & 31); voffB[i] = (unsigned)(rb * RB + c * 2); voffA[i] = (unsigned)(r * RB + c * 2); }
    const size_t kstep = (size_t)(BK * 2), hstep = (size_t)HALF * RB;
    const unsigned ldsw = (unsigned)wid * 1024u;
    const int aoff = FP8 ? lds_off8(wr * 64 + fr, fq) : lds_byte(wr * 64 + fr, fq * 8), boff = FP8 ? lds_off8(wc * 32 + fr, fq) : lds_byte(wc * 32 + fr, fq * 8);
#define GM_SA(b, h) (((b) * 2 + (h)) * HTB)
#define GM_SB(b, h) ((4 + (b) * 2 + (h)) * HTB)
#define GM_STAGE(bufoff, gbase, vo0, vo1) do { \
        __builtin_amdgcn_global_load_lds((const unsigned*)((const char*)(gbase) + (vo0)), (LAS unsigned*)(lds + (bufoff) + ldsw), 16, 0, 0); \
        __builtin_amdgcn_global_load_lds((const unsigned*)((const char*)(gbase) + (vo1)), (LAS unsigned*)(lds + (bufoff) + ldsw + 8192), 16, 0, 0); } while (0)
#define GM_STAGE_A(bufoff, gbase, h, o0, o1) do { if constexpr (GATHER) GM_STAGE(bufoff, gbase, o0, o1); else GM_STAGE(bufoff, (gbase) + (h) * hstep, voffA[0], voffA[1]); } while (0)
#define GM_LD32(p) ({ const i32x4 lo_ = *(const LAS i32x4*)(p), hi_ = *(const LAS i32x4*)((p) + 16); (i32x8){lo_[0], lo_[1], lo_[2], lo_[3], hi_[0], hi_[1], hi_[2], hi_[3]}; })
#define GM_LDA(dst, b, h) do { if constexpr (FP8) { _Pragma("unroll") for (int m = 0; m < 4; ++m) dst##8[m] = GM_LD32(lds + GM_SA(b, h) + aoff + m * 2048); } \
        else { _Pragma("unroll") for (int m = 0; m < 4; ++m) _Pragma("unroll") for (int k = 0; k < 2; ++k) dst[m][k] = *(const LAS bf16x8*)(lds + GM_SA(b, h) + aoff + m * 2048 + k * 1024); } } while (0)
#define GM_LDB(dst, b, h) do { if constexpr (FP8) { _Pragma("unroll") for (int n = 0; n < 2; ++n) dst##8[n] = GM_LD32(lds + GM_SB(b, h) + boff + n * 2048); } \
        else { _Pragma("unroll") for (int n = 0; n < 2; ++n) _Pragma("unroll") for (int k = 0; k < 2; ++k) dst[n][k] = *(const LAS bf16x8*)(lds + GM_SB(b, h) + boff + n * 2048 + k * 1024); } } while (0)
#define GM_MMA(ai, bj, At, Bt) do { __builtin_amdgcn_s_setprio(1); _Pragma("unroll") for (int m = 0; m < 4; ++m) _Pragma("unroll") for (int n = 0; n < 2; ++n) { \
        if constexpr (FP8) asm volatile("v_mfma_scale_f32_16x16x128_f8f6f4 %0, %1, %2, %0, %3, %3 op_sel_hi:[0,0,0]" : "+v"(acc[ai][bj][m][n]) : "v"(Bt##8[n]), "v"(At##8[m]), "v"(sc1_)); \
        else { _Pragma("unroll") for (int k = 0; k < 2; ++k) acc[ai][bj][m][n] = __builtin_amdgcn_mfma_f32_16x16x32_bf16(Bt[n][k], At[m][k], acc[ai][bj][m][n], 0, 0, 0); } } \
        __builtin_amdgcn_s_setprio(0); } while (0)
#define GM_WAIT_V(n) asm volatile("s_waitcnt vmcnt(" #n ")" ::: "memory")
#define GM_WAIT_L(n) asm volatile("s_waitcnt lgkmcnt(" #n ")" ::: "memory")
#define GM_BAR __builtin_amdgcn_s_barrier()
#define GM_SCHED __builtin_amdgcn_sched_barrier(0)
    Unit cur, nxt; int ui = 0;
    if (!S.next(0, cur)) return;
    f32x4 acc[2][2][4][2];
#pragma unroll
    for (int a = 0; a < 2; ++a)
#pragma unroll
        for (int b = 0; b < 2; ++b)
#pragma unroll
            for (int m = 0; m < 4; ++m)
#pragma unroll
                for (int n = 0; n < 2; ++n) acc[a][b][m][n] = (f32x4){0.f, 0.f, 0.f, 0.f};
    typedef int i32x4 __attribute__((ext_vector_type(4)));
    int sc1_ = 0x7f7f7f7f; asm volatile("" : "+v"(sc1_));
    bf16x8 At[4][2], B0[2][2], B1[2][2];
    i32x8 At8[4], B08[2], B18[2];
    unsigned ca[2][2], na[2][2];
    if constexpr (GATHER) a_offsets<GATHER, GSHIFT, RB>(cur, ca);
    const char* cA = cur.A; const char* cB = cur.B;
    GM_STAGE(GM_SB(0, 0), cB, voffB[0], voffB[1]); GM_STAGE_A(GM_SA(0, 0), cA, 0, ca[0][0], ca[0][1]); GM_STAGE(GM_SB(0, 1), cB + hstep, voffB[0], voffB[1]); GM_STAGE_A(GM_SA(0, 1), cA, 1, ca[1][0], ca[1][1]);
    if (wr == 1) GM_BAR;
    GM_WAIT_V(4); GM_BAR;
    GM_STAGE(GM_SB(1, 0), cB + kstep, voffB[0], voffB[1]); GM_STAGE_A(GM_SA(1, 0), cA + kstep, 0, ca[0][0], ca[0][1]); GM_STAGE(GM_SB(1, 1), cB + hstep + kstep, voffB[0], voffB[1]);
    GM_WAIT_V(6); GM_BAR;
    for (;;) {
        const bool has_next = S.next(ui + 1, nxt);
        if constexpr (GATHER) {
            if (has_next) a_offsets<GATHER, GSHIFT, RB>(nxt, na);
            else {
#pragma unroll
                for (int h = 0; h < 2; ++h)
#pragma unroll
                    for (int i = 0; i < 2; ++i) na[h][i] = ca[h][i];
            }
        }
        const char* nA = has_next ? nxt.A : cA; const char* nB = has_next ? nxt.B : cB;
        if (wid == 0)
            __builtin_amdgcn_global_load_lds((const unsigned*)(S.bias(cur) + 4 * lane), (LAS unsigned*)(lds + LDS_BIAS + (ui & 1) * 1024), 16, 0, 0);
        for (int t = 0; t < NTL; t += 2) {
            const bool last = (t == NTL - 2);

            const char* a1 = cA + (size_t)(t + 1) * kstep;
            const char* a2 = last ? nA : cA + (size_t)(t + 2) * kstep; const char* b2 = last ? nB : cB + (size_t)(t + 2) * kstep;
            const char* a3 = a2 + kstep; const char* b3 = b2 + kstep;
            unsigned x00 = 0, x01 = 0, x10 = 0, x11 = 0;
            if constexpr (GATHER) { x00 = last ? na[0][0] : ca[0][0]; x01 = last ? na[0][1] : ca[0][1]; x10 = last ? na[1][0] : ca[1][0]; x11 = last ? na[1][1] : ca[1][1]; }
            GM_LDB(B0, 0, 0); GM_SCHED; GM_LDA(At, 0, 0); GM_STAGE_A(GM_SA(1, 1), a1, 1, ca[1][0], ca[1][1]);
            GM_WAIT_L(8); GM_BAR; GM_WAIT_L(0); GM_MMA(0, 0, At, B0); GM_BAR; GM_SCHED;
            GM_LDB(B1, 0, 1); GM_STAGE(GM_SB(0, 0), b2, voffB[0], voffB[1]);
            GM_BAR; GM_WAIT_L(0); GM_MMA(0, 1, At, B1); GM_BAR;
            GM_LDA(At, 0, 1); GM_STAGE_A(GM_SA(0, 0), a2, 0, x00, x01);
            GM_BAR; GM_WAIT_L(0); GM_MMA(1, 0, At, B0); GM_BAR; GM_SCHED;
            GM_STAGE(GM_SB(0, 1), b2 + hstep, voffB[0], voffB[1]);
            GM_WAIT_V(6); GM_BAR; GM_MMA(1, 1, At, B1); GM_BAR;
            GM_LDB(B0, 1, 0); GM_SCHED; GM_LDA(At, 1, 0); GM_STAGE_A(GM_SA(0, 1), a2, 1, x10, x11);
            GM_WAIT_L(8); GM_BAR; GM_WAIT_L(0); GM_MMA(0, 0, At, B0); GM_BAR; GM_SCHED;
            GM_LDB(B1, 1, 1); GM_STAGE(GM_SB(1, 0), b3, voffB[0], voffB[1]);
            GM_BAR; GM_WAIT_L(0); GM_MMA(0, 1, At, B1); GM_BAR;
            GM_LDA(At, 1, 1); GM_STAGE_A(GM_SA(1, 0), a3, 0, x00, x01);
            GM_BAR; GM_WAIT_L(0); GM_MMA(1, 0, At, B0); GM_BAR; GM_SCHED;
            GM_STAGE(GM_SB(1, 1), b3 + hstep, voffB[0], voffB[1]);
            GM_WAIT_V(6); GM_BAR; GM_MMA(1, 1, At, B1); GM_BAR;
        }
        if constexpr (FP8) asm volatile("s_nop 7\n\ts_nop 7" ::: "memory");
        {
          int tz = threadIdx.x; asm volatile("" : "+v"(tz)); const int wz = tz >> 6, lz = tz & 63;
          E(acc, cur, wz >> 2, wz & 3, lz & 15, lz >> 4, (const LAS float*)(lds + LDS_BIAS + (ui & 1) * 1024)); }
        if (!has_next) break;
#pragma unroll
        for (int a = 0; a < 2; ++a)
#pragma unroll
            for (int b = 0; b < 2; ++b)
#pragma unroll
                for (int m = 0; m < 4; ++m)
#pragma unroll
                    for (int n = 0; n < 2; ++n) acc[a][b][m][n] = (f32x4){0.f, 0.f, 0.f, 0.f};
        cur = nxt; cA = nA; cB = nB; ++ui;
        if constexpr (GATHER) {
#pragma unroll
            for (int h = 0; h < 2; ++h)
#pragma unroll
                for (int i = 0; i < 2; ++i) ca[h][i] = na[h][i];
        }
    }
    GM_WAIT_V(0);
    if (wr == 0) GM_BAR;
    GM_BAR;
#undef GM_SA
#undef GM_SB
#undef GM_STAGE
#undef GM_STAGE_A
#undef GM_LD32
#undef GM_LDA
#undef GM_LDB
#undef GM_MMA
#undef GM_WAIT_V
#undef GM_WAIT_L
#undef GM_BAR
#undef GM_SCHED
}

__device__ __forceinline__ u32x4 pack8(f32x4 a, f32x4 b) { u32x4 w; w.x = pk2(a[0], a[1]); w.y = pk2(a[2], a[3]); w.z = pk2(b[0], b[1]); w.w = pk2(b[2], b[3]); return w; }

struct SchedIn {
    unsigned char* ws; int G, c; const float* baf; const float* bab;
    __device__ __forceinline__ bool next(int i, Unit& u) const {
        int L = i * G + c;
        u.list = nullptr; u.valid = 256; u.aux = 0;
        if (L < 768) {
            const int pa = L % 6, pb = L / 6;
            u.A = (const char*)(ws + WS_BTIN) + (size_t)(2048 + 256 * pa) * ROWB; u.B = (const char*)(ws + WS_H) + (size_t)(256 * pb) * ROWB;
            u.type = 2; u.row0 = 256 * pa; u.col0 = 256 * pb; return true;
        }
        L -= 768;
        if (L < 1024) {
            const int pm = L >> 3, pn = ((L & 7) + (L >> 8)) & 7;
            u.A = (const char*)(ws + WS_H) + (size_t)(256 * pm) * ROWB; u.B = (const char*)(ws + WS_BTIN) + (size_t)(256 * pn) * ROWB;
            u.type = pn < 6 ? 0 : 1; u.row0 = 256 * pm; u.col0 = pn; return true;
        }
        L -= 1024;
        if (L < 20) {
            const int pm = L / 5, j = L % 5, pn = j == 0 ? 1 : (j == 1 ? 2 : (j == 2 ? 3 : (j == 3 ? 6 : 7)));
            u.A = (const char*)(ws + WS_H) + (size_t)(T + 256 * pm) * ROWB; u.B = (const char*)(ws + WS_BTIN) + (size_t)(256 * pn) * ROWB;
            u.type = pn < 6 ? 0 : 1; u.row0 = T + 256 * pm; u.col0 = pn; return true;
        }
        return false;
    }
    __device__ __forceinline__ const float* bias(const Unit& u) const { return (u.type == 1 && u.col0 == 7) ? bab : baf; }
};
struct EpiIn {
    unsigned char* ws;
    __device__ __forceinline__ void operator()(const f32x4 (&acc)[2][2][4][2], const Unit& u, int wr, int wc, int fr, int fq, const LAS float* bs) const {
        const int rl = wr * 64 + fr, cl = wc * 32 + 8 * fq;
        if (u.type == 0) {
            const int pn = u.col0;
            bf16_t* dst; int ld, cb;
            if (pn == 0) { dst = (bf16_t*)(ws + WS_Q); ld = 256; cb = 0; }
            else if (pn == 1) { dst = (bf16_t*)(ws + WS_K); ld = 256; cb = 0; }
            else if (pn < 4) { dst = (bf16_t*)(ws + WS_V); ld = 512; cb = (pn - 2) * 256; }
            else { dst = (bf16_t*)(ws + WS_G); ld = 512; cb = (pn - 4) * 256; }
#pragma unroll
            for (int ai = 0; ai < 2; ++ai)
#pragma unroll
                for (int m = 0; m < 4; ++m) { bf16_t* rowp = dst + (size_t)(u.row0 + rl + ai * 128 + m * 16) * ld + cb + cl;
#pragma unroll
                    for (int bj = 0; bj < 2; ++bj) *(u32x4*)(rowp + bj * 128) = pack8(acc[ai][bj][m][0], acc[ai][bj][m][1]); }
        } else if (u.type == 1) {
            _Float16* dst = (_Float16*)(ws + (u.col0 == 6 ? WS_GF : WS_GB));
            f32x4 bv[2][2];
#pragma unroll
            for (int bj = 0; bj < 2; ++bj)
#pragma unroll
                for (int n = 0; n < 2; ++n) bv[bj][n] = *(const LAS f32x4*)(bs + cl + bj * 128 + 4 * n);
            typedef _Float16 f16x8_ __attribute__((ext_vector_type(8)));
#pragma unroll
            for (int ai = 0; ai < 2; ++ai)
#pragma unroll
                for (int m = 0; m < 4; ++m) { _Float16* rowp = dst + (size_t)(u.row0 + rl + ai * 128 + m * 16) * 256 + cl;
#pragma unroll
                    for (int bj = 0; bj < 2; ++bj) { f16x8_ o;
#pragma unroll
                        for (int n = 0; n < 2; ++n) { const f32x4 z = acc[ai][bj][m][n] + bv[bj][n];
#pragma unroll
                            for (int j = 0; j < 4; ++j) o[4 * n + j] = (_Float16)(log_sigmoid_f(z[j]) * (1.f / 16.f)); }
                        *(f16x8_*)(rowp + bj * 128) = o; } }
        } else {
            const int b = u.col0 >> 13, l0 = u.col0 & 8191;
            bf16_t* dst = (bf16_t*)(ws + WS_UT) + ((size_t)b * HYC) * SEQ + l0 + cl;
#pragma unroll
            for (int ai = 0; ai < 2; ++ai)
#pragma unroll
                for (int m = 0; m < 4; ++m) { bf16_t* rowp = dst + (size_t)(u.row0 + rl + ai * 128 + m * 16) * SEQ;
#pragma unroll
                    for (int bj = 0; bj < 2; ++bj) *(u32x4*)(rowp + bj * 128) = pack8(acc[ai][bj][m][0], acc[ai][bj][m][1]); }
        }
    }
};

struct SchedOut {
    unsigned char* ws; int G, c;
    __device__ __forceinline__ bool next(int i, Unit& u) const {
        const int L = i * G + c; if (L >= 512) return false;
        const int pm = L >> 2, pn = L & 3;
        u.A = (const char*)(ws + WS_MIX) + (size_t)(256 * pm) * ROWB; u.B = (const char*)(ws + WS_BTOUT) + (size_t)(256 * pn) * ROWB;
        u.list = nullptr; u.valid = 256; u.aux = 0; u.type = 3; u.row0 = 256 * pm; u.col0 = 256 * pn; return true;
    }
    __device__ __forceinline__ const float* bias(const Unit& u) const { return (const float*)(ws + WS_MOD) + (u.row0 >> 13) * 6144 + 2 * 1024 + u.col0; }
};
struct EpiOut {
    unsigned char* ws;
    __device__ __forceinline__ void operator()(const f32x4 (&acc)[2][2][4][2], const Unit& u, int wr, int wc, int fr, int fq, const LAS float* bs) const {
        const int rl = wr * 64 + fr, cl = u.col0 + wc * 32 + 8 * fq;
        bf16_t* fg = (bf16_t*)(ws + WS_FG);
        f32x4 gv[2][2];
#pragma unroll
        for (int bj = 0; bj < 2; ++bj)
#pragma unroll
            for (int n = 0; n < 2; ++n) gv[bj][n] = *(const LAS f32x4*)(bs + wc * 32 + 8 * fq + bj * 128 + 4 * n);
#pragma unroll
        for (int ai = 0; ai < 2; ++ai)
#pragma unroll
            for (int m = 0; m < 4; ++m) { bf16_t* rowp = fg + (size_t)(u.row0 + rl + ai * 128 + m * 16) * 1024 + cl;
#pragma unroll
                for (int bj = 0; bj < 2; ++bj) *(u32x4*)(rowp + bj * 128) = pack8(gv[bj][0] * acc[ai][bj][m][0], gv[bj][1] * acc[ai][bj][m][1]); }
    }
};

constexpr int LDS_TAB = STAGE_BYTES;
template <int WHICH>
struct SchedMoe {
    unsigned char* ws; const LAS int* tab; int G, c; const float* b2;
    __device__ __forceinline__ bool next(int i, Unit& u) const {
        constexpr int NCT_ = WHICH == 1 ? 8 : 4;
        const int L = i * G + c; const int nrt = __builtin_amdgcn_readfirstlane(tab[32]);
        if (L >= nrt * NCT_) return false;
        const int rt = L / NCT_, ct = L % NCT_;
        const int info = __builtin_amdgcn_readfirstlane(tab[64 + rt]), e = info & 255, r0 = (info >> 8) * 256;
        const int cnt = __builtin_amdgcn_readfirstlane(tab[e]);
        u.valid = (cnt - r0) < 256 ? (cnt - r0) : 256;
        u.list = (const int*)(ws + WS_LIST) + (size_t)e * CAP + r0;
        u.A = (WHICH == 1) ? (const char*)(ws + WS_H2) : (const char*)(ws + WS_ACT) + (size_t)(256 * rt) * KD;
        u.B = (const char*)(ws + (WHICH == 1 ? WS_W1T : WS_W2T)) + ((size_t)e * (WHICH == 1 ? 2048 : 1024) + 256 * ct) * KD;
        u.type = 3 + WHICH; u.row0 = 256 * rt; u.col0 = ct; u.aux = e; return true;
    }
    __device__ __forceinline__ const float* bias(const Unit& u) const { return (WHICH == 1) ? (const float*)(ws + WS_B1R) + (size_t)u.aux * 2048 + 256 * u.col0 : b2 + (size_t)u.aux * 1024 + 256 * u.col0; }
};
__device__ __forceinline__ float swiglu_f(float glu, float lin) {
    glu = fminf(glu, 7.f); lin = fminf(fmaxf(lin, -7.f), 7.f);
    return glu * __builtin_amdgcn_rcpf(1.f + __expf(-1.702f * glu)) * (lin + 1.f);
}
constexpr float S_H2 = 4.f, S_ACT = 8.f, S_W = 64.f;
__device__ __forceinline__ unsigned pk4_fp8(float a, float b, float c, float d) {
    a = fminf(fmaxf(a, -448.f), 448.f); b = fminf(fmaxf(b, -448.f), 448.f); c = fminf(fmaxf(c, -448.f), 448.f); d = fminf(fmaxf(d, -448.f), 448.f);
    int p = __builtin_amdgcn_cvt_pk_fp8_f32(a, b, 0, false); p = __builtin_amdgcn_cvt_pk_fp8_f32(c, d, p, true); return (unsigned)p; }
__device__ __forceinline__ unsigned pk4_fp8_nc(float a, float b, float c, float d) { int p = __builtin_amdgcn_cvt_pk_fp8_f32(a, b, 0, false); p = __builtin_amdgcn_cvt_pk_fp8_f32(c, d, p, true); return (unsigned)p; }
struct EpiMoe1 {
    unsigned char* ws;
    __device__ __forceinline__ void operator()(const f32x4 (&acc)[2][2][4][2], const Unit& u, int wr, int wc, int fr, int fq, const LAS float* bs) const {
        const int rl = wr * 64 + fr, cl = wc * 32 + 8 * fq, ct = u.col0;
        const LAS float* b1 = bs + cl;
        unsigned char* act = (unsigned char*)(ws + WS_ACT) + (size_t)u.row0 * 1024 + 128 * ct + cl;
        f32x4 bg[2], bl[2];
#pragma unroll
        for (int n = 0; n < 2; ++n) { bg[n] = *(const LAS f32x4*)(b1 + 4 * n); bl[n] = *(const LAS f32x4*)(b1 + 128 + 4 * n); }
#pragma unroll
        for (int ai = 0; ai < 2; ++ai)
#pragma unroll
            for (int mp = 0; mp < 2; ++mp) {
                u32x2 w[2];
#pragma unroll
                for (int mm = 0; mm < 2; ++mm) { const int m = 2 * mp + mm; f32x4 o[2];
#pragma unroll
                    for (int n = 0; n < 2; ++n) { const f32x4 gl = acc[ai][0][m][n] * (1.f / (S_H2 * S_W)) + bg[n], li = acc[ai][1][m][n] * (1.f / (S_H2 * S_W)) + bl[n];
#pragma unroll
                        for (int j = 0; j < 4; ++j) o[n][j] = swiglu_f(gl[j], li[j]) * S_ACT; }
                    w[mm].x = pk4_fp8(o[0][0], o[0][1], o[0][2], o[0][3]); w[mm].y = pk4_fp8(o[1][0], o[1][1], o[1][2], o[1][3]); }
                const auto sx = __builtin_amdgcn_permlane16_swap(w[0].x, w[1].x, false, false); const auto sy = __builtin_amdgcn_permlane16_swap(w[0].y, w[1].y, false, false);
                const int r = rl + ai * 128 + (2 * mp + (fq & 1)) * 16;
                *(u32x4*)(act + (size_t)r * 1024 - 8 * (fq & 1)) = (u32x4){sx[0], sy[0], sx[1], sy[1]}; }
    }
};
constexpr float S_SL = 16.f;
struct EpiMoe2 {
    unsigned char* ws;
    __device__ __forceinline__ void operator()(const f32x4 (&acc)[2][2][4][2], const Unit& u, int wr, int wc, int fr, int fq, const LAS float* bs) const {
        const int rl = wr * 64 + fr, cl = wc * 32 + 8 * fq, ct = u.col0;
        const LAS float* bb = bs + cl;
        unsigned char* slots = (unsigned char*)(ws + WS_SLOTS) + (size_t)u.row0 * 1024 + 256 * ct + cl;
        f32x4 bv[2][2];
#pragma unroll
        for (int bj = 0; bj < 2; ++bj)
#pragma unroll
            for (int n = 0; n < 2; ++n) bv[bj][n] = *(const LAS f32x4*)(bb + bj * 128 + 4 * n) * S_SL;
#pragma unroll
        for (int ai = 0; ai < 2; ++ai)
#pragma unroll
            for (int m = 0; m < 4; ++m) { const int r = rl + ai * 128 + m * 16;
                u32x2 w[2];
#pragma unroll
                for (int bj = 0; bj < 2; ++bj) { const f32x4 y0 = acc[ai][bj][m][0] * (S_SL / (S_ACT * S_W)) + bv[bj][0], y1 = acc[ai][bj][m][1] * (S_SL / (S_ACT * S_W)) + bv[bj][1];
                    w[bj].x = pk4_fp8(y0[0], y0[1], y0[2], y0[3]); w[bj].y = pk4_fp8(y1[0], y1[1], y1[2], y1[3]); }
                const auto sx = __builtin_amdgcn_permlane16_swap(w[0].x, w[1].x, false, false); const auto sy = __builtin_amdgcn_permlane16_swap(w[0].y, w[1].y, false, false);
                *(u32x4*)(slots + (size_t)r * 1024 + ((fq & 1) ? 128 - 8 : 0)) = (u32x4){sx[0], sy[0], sx[1], sy[1]}; }
    }
};
}

namespace hy {
__device__ __forceinline__ int phys(int n) { return n + (n >> 4) + ((n >> 9) << 4); }
constexpr int XSIZE = 16384 + 1024 + 512;

__device__ __forceinline__ float tw_c(int i) {
    constexpr float t[16] = {1.f, 0.98078528040323043f, 0.92387953251128674f, 0.83146961230254524f, 0.70710678118654752f, 0.55557023301960218f, 0.38268343236508977f, 0.19509032201612825f,
                             0.f, -0.19509032201612825f, -0.38268343236508977f, -0.55557023301960218f, -0.70710678118654752f, -0.83146961230254524f, -0.92387953251128674f, -0.98078528040323043f};
    return t[i];
}
__device__ __forceinline__ float tw_s(int i) {
    constexpr float t[16] = {0.f, 0.19509032201612825f, 0.38268343236508977f, 0.55557023301960218f, 0.70710678118654752f, 0.83146961230254524f, 0.92387953251128674f, 0.98078528040323043f,
                             1.f, 0.98078528040323043f, 0.92387953251128674f, 0.83146961230254524f, 0.70710678118654752f, 0.55557023301960218f, 0.38268343236508977f, 0.19509032201612825f};
    return t[i];
}
__host__ __device__ constexpr int brev(int p, int bits) { int r = 0; for (int i = 0; i < bits; ++i) r |= ((p >> i) & 1) << (bits - 1 - i); return r; }

template <int R, bool INV>
__device__ __forceinline__ void fft_reg(f32x2 (&v)[R]) {
#pragma unroll
    for (int s = R / 2; s >= 1; s >>= 1) {
#pragma unroll
        for (int g = 0; g < R; g += 2 * s) {
#pragma unroll
            for (int k = 0; k < s; ++k) {
                const f32x2 a = v[g + k], b = v[g + k + s];
                v[g + k] = a + b;
                const f32x2 t = a - b;
                const int ti = k * (16 / s);
                f32x2 o;
                if (ti == 0) o = t;
                else if (ti == 8) { if (INV) { o[0] = -t[1]; o[1] = t[0]; } else { o[0] = t[1]; o[1] = -t[0]; } }
                else { const float c = tw_c(ti), sn = tw_s(ti);
                    if (INV) { o[0] = t[0] * c - t[1] * sn; o[1] = t[1] * c + t[0] * sn; }
                    else     { o[0] = t[0] * c + t[1] * sn; o[1] = t[1] * c - t[0] * sn; } }
                v[g + k + s] = o;
            }
        }
    }
}
__device__ __forceinline__ f32x2 cmul(f32x2 a, f32x2 b) { f32x2 r; r[0] = a[0] * b[0] - a[1] * b[1]; r[1] = a[0] * b[1] + a[1] * b[0]; return r; }

template <int M, bool ZPAD = false>
__device__ __forceinline__ void pass_fwd32(LAS f32x2* X, int tid) {
    int j = (M == 512) ? tid : (tid & 15);
    asm volatile("" : "+v"(j));
    const int p0 = (M == 512) ? (tid + (tid >> 4)) : (560 * (tid >> 4) + (tid & 15));
    constexpr int PS = (M == 512) ? 560 : 17;
    f32x2 v[32];
#pragma unroll
    for (int r = 0; r < 32; ++r) { if (ZPAD && r >= 16) v[r] = (f32x2){0.f, 0.f}; else v[r] = X[p0 + PS * r]; }
    fft_reg<32, false>(v);
    float sn, cs; sincospif(-2.f * (float)j / (float)(32 * M), &sn, &cs);
    const f32x2 w1 = {cs, sn}; f32x2 w = w1;
    X[p0] = v[0];
#pragma unroll
    for (int rp = 1; rp < 32; ++rp) { X[p0 + PS * rp] = cmul(v[brev(rp, 5)], w); w = cmul(w, w1); }
}
template <int M, bool HALF = false>
__device__ __forceinline__ void pass_inv32(LAS f32x2* X, int tid) {
    int j = (M == 512) ? tid : (tid & 15);
    asm volatile("" : "+v"(j));
    const int p0 = (M == 512) ? (tid + (tid >> 4)) : (560 * (tid >> 4) + (tid & 15));
    constexpr int PS = (M == 512) ? 560 : 17;
    float sn, cs; sincospif(2.f * (float)j / (float)(32 * M), &sn, &cs);
    const f32x2 w1 = {cs, sn}; f32x2 w = w1;
    f32x2 v[32];
    v[0] = X[p0];
#pragma unroll
    for (int rp = 1; rp < 32; ++rp) { v[rp] = cmul(X[p0 + PS * rp], w); w = cmul(w, w1); }
    fft_reg<32, true>(v);
#pragma unroll
    for (int p = 0; p < 32; ++p) { if (!HALF || brev(p, 5) < 16) X[p0 + PS * brev(p, 5)] = v[p]; }
}
typedef _Float16 f16x8h __attribute__((ext_vector_type(8)));
__device__ __forceinline__ void pass_c_store(const LAS f32x2* X, f32x2* Hs_, int tid, float scale) {
    _Float16* Hs = (_Float16*)Hs_; (void)scale;
#pragma unroll
    for (int u = 0; u < 2; ++u) { const int blk = tid + 512 * u, p0 = 17 * blk + 16 * (blk >> 5);
        f32x2 v[16];
#pragma unroll
        for (int r = 0; r < 16; ++r) v[r] = X[p0 + r];
        fft_reg<16, false>(v);
#pragma unroll
        for (int q = 0; q < 4; ++q) { f16x8h o;
#pragma unroll
            for (int e = 0; e < 4; ++e) { const f32x2 x = v[brev(4 * q + e, 4)]; o[2 * e] = (_Float16)x[0]; o[2 * e + 1] = (_Float16)x[1]; }
            *(f16x8h*)(Hs + 2 * (16 * blk + 4 * q)) = o; } }
}
__device__ __forceinline__ void pass_c_mul_inv(LAS f32x2* X, const f32x2* Hs_, int tid) {
    const _Float16* Hs = (const _Float16*)Hs_;
#pragma unroll
    for (int u = 0; u < 2; ++u) { const int blk = tid + 512 * u, p0 = 17 * blk + 16 * (blk >> 5);
        f32x2 v[16], w[16];
#pragma unroll
        for (int r = 0; r < 16; ++r) v[r] = X[p0 + r];
        f16x8h hh[4];
#pragma unroll
        for (int q = 0; q < 4; ++q) hh[q] = *(const f16x8h*)(Hs + 2 * (16 * blk + 4 * q));
        fft_reg<16, false>(v);
#pragma unroll
        for (int q = 0; q < 4; ++q)
#pragma unroll
            for (int e = 0; e < 4; ++e) w[4 * q + e] = cmul(v[brev(4 * q + e, 4)], (f32x2){(float)hh[q][2 * e] * (1.f / (float)FFTN), (float)hh[q][2 * e + 1] * (1.f / (float)FFTN)});
        fft_reg<16, true>(w);
#pragma unroll
        for (int p = 0; p < 16; ++p) X[p0 + brev(p, 4)] = w[p]; }
}
__device__ __forceinline__ void load16(const bf16_t* u, float (&e)[16]) {
    const u32x4 a = *(const u32x4*)u, b = *(const u32x4*)(u + 8);
    e[0] = bflo(a.x); e[1] = bfhi(a.x); e[2] = bflo(a.y); e[3] = bfhi(a.y); e[4] = bflo(a.z); e[5] = bfhi(a.z); e[6] = bflo(a.w); e[7] = bfhi(a.w);
    e[8] = bflo(b.x); e[9] = bfhi(b.x); e[10] = bflo(b.y); e[11] = bfhi(b.y); e[12] = bflo(b.z); e[13] = bfhi(b.z); e[14] = bflo(b.w); e[15] = bfhi(b.w);
}
__device__ __forceinline__ void sconv16(const bf16_t* u, int tid, float w0, float w1, float w2, float bias, float (&o)[16]) {
    float e[16]; load16(u + 16 * tid, e);
    float lf = __shfl_up(e[15], 1), rt = __shfl_down(e[0], 1);
    if ((tid & 3) == 0) lf = 0.f;
    if ((tid & 3) == 3) rt = 0.f;
    o[0] = w0 * lf + w1 * e[0] + w2 * e[1] + bias;
#pragma unroll
    for (int i = 1; i < 15; ++i) o[i] = w0 * e[i - 1] + w1 * e[i] + w2 * e[i + 1] + bias;
    o[15] = w0 * e[14] + w1 * e[15] + w2 * rt + bias;
}

constexpr int CV_ITEMS = NE * 128 * 32;
struct CvJob { float v[8]; int mi; };
__device__ __forceinline__ void cv_issue(const Args& a, CvJob& jb, int mi, int lane) {
    jb.mi = mi;
    if (mi >= 0) { const int e = mi >> 12, kg = (mi >> 5) & 127, nb = mi & 31;
        const float* src = a.in[I_EW1] + ((size_t)e * 1024 + 8 * kg) * 2048 + 64 * nb + lane;
#pragma unroll
        for (int i = 0; i < 8; ++i) jb.v[i] = src[(size_t)i * 2048]; }
}
__device__ __forceinline__ void cv_finish(const Args& a, const CvJob& jb, int lane) {
    if (jb.mi >= 0) { const int mi = jb.mi, e = mi >> 12, kg = (mi >> 5) & 127, nb = mi & 31;
        const int cs = 64 * nb + lane, sgl = cs & 1, ac = cs >> 1, ct = ac >> 7, jj = ac & 127;
        unsigned char* dst = (unsigned char*)(a.ws + WS_W1T) + ((size_t)e * 2048 + 256 * ct + 128 * sgl + jj) * 1024 + 8 * kg;
        u32x2 o; o.x = gm::pk4_fp8_nc(jb.v[0] * gm::S_W, jb.v[1] * gm::S_W, jb.v[2] * gm::S_W, jb.v[3] * gm::S_W); o.y = gm::pk4_fp8_nc(jb.v[4] * gm::S_W, jb.v[5] * gm::S_W, jb.v[6] * gm::S_W, jb.v[7] * gm::S_W);
        *(u32x2*)dst = o; }
}
struct CvState { CvJob jb; int next, stride, end; };
__device__ __forceinline__ void cv_step(const Args& a, CvState& st, int lane) {
    cv_finish(a, st.jb, lane);
    const int mi = st.next < st.end ? st.next : -1;
    cv_issue(a, st.jb, mi, lane);
    st.next += st.stride;
}

__device__ __forceinline__ void channel(const Args& a, LAS unsigned char* lds, int c, unsigned char* scratch, CvState& cvs) {
    const int tid = threadIdx.x;
#define CV_STEP() cv_step(a, cvs, tid & 63)
    LAS f32x2* X = (LAS f32x2*)lds;
    f32x2* Hs = (f32x2*)scratch;
    const _Float16* HF = (const _Float16*)(a.ws + WS_HF);
    const int pc = 17 * tid + 16 * (tid >> 5);
    __syncthreads();
#pragma unroll 1
    for (int o = 0; o < 2; ++o) {
        typedef _Float16 f16x8_ __attribute__((ext_vector_type(8)));
        const f16x8_* hf = (const f16x8_*)(HF + ((size_t)(2 * o) * HYW + c) * SEQ + 16 * tid); const f16x8_* hb = (const f16x8_*)(HF + ((size_t)(2 * o + 1) * HYW + c) * SEQ + 16 * tid);
#pragma unroll
        for (int q = 0; q < 2; ++q) { const f16x8_ f = hf[q], b = hb[q];
#pragma unroll
            for (int e = 0; e < 8; ++e) { const int i = 8 * q + e, t = 16 * tid + i;
                X[pc + i] = (f32x2){(float)f[e], 0.f};
                if (t >= 1) X[phys(FFTN - t)] = (f32x2){(float)b[e], 0.f}; } }
        if (tid == 0) X[phys(SEQ)] = (f32x2){0.f, 0.f};
        __syncthreads();
        CV_STEP(); pass_fwd32<512>(X, tid); __syncthreads(); CV_STEP(); pass_fwd32<16>(X, tid); __syncthreads(); pass_c_store(X, Hs + (size_t)o * (FFTN / 2), tid, 1.f); __syncthreads();
    }
    const float* cw = a.in[I_CONVW]; const float* cbv = a.in[I_CONVB]; const float* dbias = a.in[I_BIASD];
    const float d1 = dbias[c], d2 = dbias[HYW + c];
    float wv[3][3], bv[3];
#pragma unroll
    for (int s = 0; s < 3; ++s) { bv[s] = cbv[s * HYW + c];
#pragma unroll
        for (int i = 0; i < 3; ++i) wv[s][i] = cw[i * HYC + s * HYW + c]; }
    const bf16_t* UT = (const bf16_t*)(a.ws + WS_UT);
    bf16_t* YT = (bf16_t*)(a.ws + WS_YHYT);
#pragma unroll 1
    for (int bp = 0; bp < 2; ++bp) {
        const bf16_t* u0 = UT + ((size_t)(2 * bp) * HYC + c) * SEQ; const bf16_t* u1 = UT + ((size_t)(2 * bp + 1) * HYC + c) * SEQ;
        float z0[16], z1[16];
        {
            float v0[16], v1[16]; sconv16(u0, tid, wv[0][0], wv[0][1], wv[0][2], bv[0], v0); sconv16(u1, tid, wv[0][0], wv[0][1], wv[0][2], bv[0], v1);
#pragma unroll
            for (int i = 0; i < 16; ++i) X[pc + i] = (f32x2){v0[i], v1[i]};
        }
        __syncthreads();
        CV_STEP(); pass_fwd32<512, true>(X, tid); __syncthreads(); CV_STEP(); pass_fwd32<16>(X, tid); __syncthreads(); pass_c_mul_inv(X, Hs, tid); __syncthreads(); CV_STEP(); pass_inv32<16>(X, tid); __syncthreads(); CV_STEP(); pass_inv32<512, true>(X, tid); __syncthreads();
        {
            float v0[16], v1[16], x0[16], x1[16];
            sconv16(u0, tid, wv[0][0], wv[0][1], wv[0][2], bv[0], v0); sconv16(u1, tid, wv[0][0], wv[0][1], wv[0][2], bv[0], v1);
            sconv16(u0 + (size_t)HYW * SEQ, tid, wv[1][0], wv[1][1], wv[1][2], bv[1], x0); sconv16(u1 + (size_t)HYW * SEQ, tid, wv[1][0], wv[1][1], wv[1][2], bv[1], x1);
#pragma unroll
            for (int i = 0; i < 16; ++i) { const f32x2 y1 = X[pc + i]; z0[i] = x0[i] * (y1[0] + d1 * v0[i]); z1[i] = x1[i] * (y1[1] + d1 * v1[i]); X[pc + i] = (f32x2){z0[i], z1[i]}; }
        }
        __syncthreads();
        CV_STEP(); pass_fwd32<512, true>(X, tid); __syncthreads(); CV_STEP(); pass_fwd32<16>(X, tid); __syncthreads(); pass_c_mul_inv(X, Hs + FFTN / 2, tid); __syncthreads(); CV_STEP(); pass_inv32<16>(X, tid); __syncthreads(); CV_STEP(); pass_inv32<512, true>(X, tid); __syncthreads();
        {
            float x0[16], x1[16];
            sconv16(u0 + (size_t)2 * HYW * SEQ, tid, wv[2][0], wv[2][1], wv[2][2], bv[2], x0); sconv16(u1 + (size_t)2 * HYW * SEQ, tid, wv[2][0], wv[2][1], wv[2][2], bv[2], x1);
            unsigned w0[8], w1[8];
#pragma unroll
            for (int i = 0; i < 8; ++i) { const f32x2 ya = X[pc + 2 * i], yb = X[pc + 2 * i + 1];
                w0[i] = pk2(x0[2 * i] * (ya[0] + d2 * z0[2 * i]), x0[2 * i + 1] * (yb[0] + d2 * z0[2 * i + 1]));
                w1[i] = pk2(x1[2 * i] * (ya[1] + d2 * z1[2 * i]), x1[2 * i + 1] * (yb[1] + d2 * z1[2 * i + 1])); }
            u32x4* y0p = (u32x4*)(YT + ((size_t)(2 * bp) * HYW + c) * SEQ + 16 * tid); u32x4* y1p = (u32x4*)(YT + ((size_t)(2 * bp + 1) * HYW + c) * SEQ + 16 * tid);
            y0p[0] = (u32x4){w0[0], w0[1], w0[2], w0[3]}; y0p[1] = (u32x4){w0[4], w0[5], w0[6], w0[7]};
            y1p[0] = (u32x4){w1[0], w1[1], w1[2], w1[3]}; y1p[1] = (u32x4){w1[4], w1[5], w1[6], w1[7]};
        }
        __syncthreads();
    }
#undef CV_STEP
}

__device__ __forceinline__ void filter_item(const Args& a, int item, int lane) {
    const int ct = item & 127, tc = item >> 7;
    const float* hid2 = (const float*)(a.ws + WS_HID2); const float* wout = a.in[I_FWOUT]; _Float16* HF = (_Float16*)(a.ws + WS_HF);
    const int col = 16 * ct + (lane & 15), kq = lane >> 4, cch = col & 511;
    float bf[16];
#pragma unroll
    for (int s = 0; s < 16; ++s) bf[s] = wout[(size_t)(16 * kq + s) * 2048 + col];
    const float dlt = fabsf(-3.0701134573253945f + (float)cch * ((-15.350567286626973f + 3.0701134573253945f) / 511.f));
#pragma unroll 2
    for (int tt = 0; tt < 32; ++tt) { const int t0 = 512 * tc + 16 * tt;
        const f32x4* ar = (const f32x4*)(hid2 + (size_t)(t0 + (lane & 15)) * 64 + 16 * kq);
        const f32x4 a0 = ar[0], a1 = ar[1], a2 = ar[2], a3 = ar[3];
        f32x4 acc = {0.f, 0.f, 0.f, 0.f};
#pragma unroll
        for (int e = 0; e < 4; ++e) { acc = __builtin_amdgcn_mfma_f32_16x16x4f32(a0[e], bf[e], acc, 0, 0, 0); }
#pragma unroll
        for (int e = 0; e < 4; ++e) { acc = __builtin_amdgcn_mfma_f32_16x16x4f32(a1[e], bf[4 + e], acc, 0, 0, 0); }
#pragma unroll
        for (int e = 0; e < 4; ++e) { acc = __builtin_amdgcn_mfma_f32_16x16x4f32(a2[e], bf[8 + e], acc, 0, 0, 0); }
#pragma unroll
        for (int e = 0; e < 4; ++e) { acc = __builtin_amdgcn_mfma_f32_16x16x4f32(a3[e], bf[12 + e], acc, 0, 0, 0); }
        f32x4 o;
#pragma unroll
        for (int r = 0; r < 4; ++r) o[r] = acc[r] * __expf(-((float)(t0 + 4 * kq + r) / (float)(SEQ - 1)) * dlt);
        typedef _Float16 f16x4_ __attribute__((ext_vector_type(4)));
        *(f16x4_*)(HF + (size_t)col * SEQ + t0 + 4 * kq) = (f16x4_){(_Float16)o[0], (_Float16)o[1], (_Float16)o[2], (_Float16)o[3]}; }
}

__device__ __forceinline__ void transpose_item(const Args& a, int item, int lane) {
    const int lt = item & 127, ct = (item >> 7) & 7, b = item >> 10;
    const bf16_t* src = (const bf16_t*)(a.ws + WS_YHYT) + ((size_t)b * HYW + 64 * ct) * SEQ + 64 * lt + lane;
    bf16_t* dst = (bf16_t*)(a.ws + WS_MIX) + ((size_t)b * SEQ + 64 * lt + lane) * 1024 + 512 + 64 * ct;
    unsigned short v[64];
#pragma unroll
    for (int cc = 0; cc < 64; ++cc) v[cc] = src[(size_t)cc * SEQ];
#pragma unroll
    for (int q = 0; q < 8; ++q)
        *(u32x4*)(dst + 8 * q) = (u32x4){(unsigned)v[8 * q] | ((unsigned)v[8 * q + 1] << 16), (unsigned)v[8 * q + 2] | ((unsigned)v[8 * q + 3] << 16),
                                         (unsigned)v[8 * q + 4] | ((unsigned)v[8 * q + 5] << 16), (unsigned)v[8 * q + 6] | ((unsigned)v[8 * q + 7] << 16)};
}
}

__device__ __forceinline__ void p0_mod_and_filter(const Args& a, LAS unsigned char* lds) {
    const int tid = threadIdx.x, lane = tid & 63, wave = tid >> 6;
    const float* c = a.in[I_C]; const float* cctx = a.in[I_CCTX]; const float* adaw = a.in[I_ADAW]; const float* adab = a.in[I_ADAB];
    float* mod = (float*)(a.ws + WS_MOD);
    LAS float* sl = (LAS float*)lds;
    LAS float* pt = (LAS float*)lds + 5 * 1024;
    for (int i = tid; i < 5 * 1024; i += NTHREADS) { const int r = i >> 10, k = i & 1023; sl[i] = silu_f(r < 4 ? c[r * 1024 + k] : cctx[k]); }
    for (int it = blockIdx.x; it < 256; it += gridDim.x) {
        __syncthreads();
        if (tid < 504) {
            const int col = tid % 24, ks = tid / 24, n = it * 24 + col, kbeg = ks * 49, kend = (kbeg + 49 < 1024) ? kbeg + 49 : 1024;
            float acc[5] = {0.f, 0.f, 0.f, 0.f, 0.f};
#pragma unroll 7
            for (int k = kbeg; k < kend; ++k) { const float w = adaw[(size_t)k * 6144 + n];
#pragma unroll
                for (int r = 0; r < 5; ++r) acc[r] += sl[r * 1024 + k] * w; }
#pragma unroll
            for (int r = 0; r < 5; ++r) pt[(ks * 5 + r) * 24 + col] = acc[r];
        }
        __syncthreads();
        if (tid < 120) { const int r = tid / 24, col = tid % 24, n = it * 24 + col; float s = adab[n];
            for (int ks = 0; ks < 21; ++ks) s += pt[(ks * 5 + r) * 24 + col];
            mod[r * 6144 + n] = s; }
    }
    __syncthreads();
    const float* w1 = a.in[I_FW1]; const float* b1 = a.in[I_FB1]; const float* w2 = a.in[I_FW2]; const float* b2 = a.in[I_FB2]; const float* fq = a.in[I_FFREQ];
    float* hid2 = (float*)(a.ws + WS_HID2);
    LAS float* zs = (LAS float*)lds + 8192 + wave * 128;
    const float frq = fq[lane], bb1 = b1[lane], bb2 = b2[lane];
    for (int t = (blockIdx.x * NWAVES + wave); t < SEQ; t += gridDim.x * NWAVES) {
        float z = 0.f;
        if (lane == 0) z = (float)t / (float)(SEQ - 1);
        else if (lane < 33) { const int i = (lane - 1) & 15; const float f = 1e-4f + (float)i * ((15.f - 1e-4f) / 15.f);
            const float ang = (6.283185307179586f * (float)t / (float)SEQ) * f; z = (lane < 17) ? cosf(ang) : -sinf(ang); }
        if (lane < 33) zs[lane] = z;
        __builtin_amdgcn_wave_barrier(); asm volatile("s_waitcnt lgkmcnt(0)" ::: "memory");
        float s = bb1;
#pragma unroll
        for (int e = 0; e < 33; ++e) s += zs[e] * w1[e * 64 + lane];
        const float h1 = sinf(frq * s);
        zs[64 + lane] = h1;
        __builtin_amdgcn_wave_barrier(); asm volatile("s_waitcnt lgkmcnt(0)" ::: "memory");
        float s2 = bb2;
#pragma unroll 16
        for (int g = 0; g < 64; ++g) s2 += zs[64 + g] * w2[g * 64 + lane];
        hid2[(size_t)t * 64 + lane] = sinf(frq * s2);
        __builtin_amdgcn_wave_barrier(); asm volatile("s_waitcnt lgkmcnt(0)" ::: "memory");
    }
}

template <bool FP8 = false>
__device__ __forceinline__ void tr_item(const float* W, int ldw, int k0, int c0, int cstride, float scale, bf16_t* dstrow0, LAS float* scr, int lane) {
    float wv_[32];
#pragma unroll
    for (int i = 0; i < 32; ++i) wv_[i] = W[(size_t)(k0 + 2 * i + (lane >> 5)) * ldw + c0 + (lane & 31) * cstride];
#pragma unroll
    for (int i = 0; i < 32; ++i) scr[(2 * i + (lane >> 5)) * 33 + (lane & 31)] = wv_[i] * scale;
    asm volatile("s_waitcnt lgkmcnt(0)" ::: "memory"); __builtin_amdgcn_wave_barrier();
    const int c = lane & 7;
#pragma unroll
    for (int j = 0; j < 4; ++j) { const int n = (lane >> 3) + 8 * j; const LAS float* s = scr + (8 * c) * 33 + n;
        if (FP8) { u32x2 o; o.x = gm::pk4_fp8(s[0 * 33], s[1 * 33], s[2 * 33], s[3 * 33]); o.y = gm::pk4_fp8(s[4 * 33], s[5 * 33], s[6 * 33], s[7 * 33]);
            *(u32x2*)((unsigned char*)dstrow0 + (size_t)n * 1024 + k0 + 8 * c) = o; }
        else { u32x4 o; o.x = pk2(s[0 * 33], s[1 * 33]); o.y = pk2(s[2 * 33], s[3 * 33]); o.z = pk2(s[4 * 33], s[5 * 33]); o.w = pk2(s[6 * 33], s[7 * 33]);
            *(u32x4*)(dstrow0 + (size_t)n * 1024 + k0 + 8 * c) = o; } }
    asm volatile("s_waitcnt lgkmcnt(0)" ::: "memory"); __builtin_amdgcn_wave_barrier();
}
__device__ __forceinline__ void fold_item(const float* win, const float* wa, int dir, int k0, int j0, bf16_t* dstrow0, LAS float* scr, int lane) {
#pragma unroll 4
    for (int i = 0; i < 32; ++i) { const int kk = 2 * i + (lane >> 5); const float* wr = win + (size_t)(k0 + kk) * INW + 1536 + 16 * dir; float s = 0.f;
#pragma unroll
        for (int r = 0; r < 16; ++r) s += wr[r] * wa[r * 256 + j0 + (lane & 31)];
        scr[kk * 33 + (lane & 31)] = s; }
    asm volatile("s_waitcnt lgkmcnt(0)" ::: "memory"); __builtin_amdgcn_wave_barrier();
    const int c = lane & 7;
#pragma unroll
    for (int j = 0; j < 4; ++j) { const int n = (lane >> 3) + 8 * j; const LAS float* s = scr + (8 * c) * 33 + n;
        u32x4 o; o.x = pk2(s[0 * 33], s[1 * 33]); o.y = pk2(s[2 * 33], s[3 * 33]); o.z = pk2(s[4 * 33], s[5 * 33]); o.w = pk2(s[6 * 33], s[7 * 33]);
        *(u32x4*)(dstrow0 + (size_t)n * 1024 + k0 + 8 * c) = o; }
    asm volatile("s_waitcnt lgkmcnt(0)" ::: "memory"); __builtin_amdgcn_wave_barrier();
}
__device__ __forceinline__ void ln_mod_row(const float* xrow, const float* shift, const float* scale, bf16_t* orow, int lane) {
    const f32x4* xr = (const f32x4*)xrow + lane;
    f32x4 v[4]; float s = 0.f;
#pragma unroll
    for (int j = 0; j < 4; ++j) { v[j] = xr[64 * j]; s += (v[j][0] + v[j][1]) + (v[j][2] + v[j][3]); }
    const float mean = wave_sum(s) * (1.f / D); float s2 = 0.f;
#pragma unroll
    for (int j = 0; j < 4; ++j) { v[j] = v[j] - mean; s2 += (v[j][0] * v[j][0] + v[j][1] * v[j][1]) + (v[j][2] * v[j][2] + v[j][3] * v[j][3]); }
    const float rstd = 1.f / sqrtf(wave_sum(s2) * (1.f / D) + LN_EPS);
    u32x2* o8 = (u32x2*)orow + lane;
#pragma unroll
    for (int j = 0; j < 4; ++j) { const f32x4 sh = ((const f32x4*)shift)[64 * j + lane], sc = ((const f32x4*)scale)[64 * j + lane];
        const f32x4 y = v[j] * rstd * (sc + 1.f) + sh;
        u32x2 w; w.x = pk2(y[0], y[1]); w.y = pk2(y[2], y[3]); o8[64 * j] = w; }
}
constexpr int PREP_I_IN = 16 * 96, PREP_I_FOLD = 16 * 8 * 2, PREP_I_OUT = 16 * 32, PREP_I_W1 = NE * 16 * 64, PREP_I_W2 = NE * 16 * 32;
constexpr int PREP_NITEMS = PREP_I_IN + PREP_I_FOLD + PREP_I_OUT + PREP_I_W1 + PREP_I_W2;
constexpr int PREP_DEFER = 10880;
__device__ __forceinline__ void prep_items(const Args& a, LAS float* scr, int first, int last, int rank, int nranks, int lane) {
    constexpr int I_IN = PREP_I_IN, I_FOLD = PREP_I_FOLD, I_OUT = PREP_I_OUT, I_W1 = PREP_I_W1;
    const float* win = a.in[I_WIN];
    bf16_t* btin = (bf16_t*)(a.ws + WS_BTIN); bf16_t* btout = (bf16_t*)(a.ws + WS_BTOUT); bf16_t* w1t = (bf16_t*)(a.ws + WS_W1T); bf16_t* w2t = (bf16_t*)(a.ws + WS_W2T);
    for (int it = first + rank; it < last; it += nranks) {
        int r = it;
        if (r < I_IN) {
            const int kb = r / 96, nb = r % 96;
            if (nb < 48) tr_item(win, INW, 64 * kb, 32 * nb, 1, nb < 8 ? 0.125f : 1.f, btin + (size_t)(32 * nb) * 1024, scr, lane);
            else tr_item(win, INW, 64 * kb, 1568 + 32 * (nb - 48), 1, 1.f, btin + (size_t)(2048 + 32 * (nb - 48)) * 1024, scr, lane);
            continue; }
        r -= I_IN;
        if (r < I_FOLD) { const int dir = r & 1, jb = (r >> 1) & 7, kb = r >> 4;
            fold_item(win, dir ? a.in[I_WAB] : a.in[I_WAF], dir, 64 * kb, 32 * jb, btin + (size_t)(1536 + 256 * dir + 32 * jb) * 1024, scr, lane); continue; }
        r -= I_FOLD;
        if (r < I_OUT) { const int kb = r / 32, nb = r % 32; tr_item(a.in[I_WOUT], 1024, 64 * kb, 32 * nb, 1, 1.f, btout + (size_t)(32 * nb) * 1024, scr, lane); continue; }
        r -= I_OUT;
        if (r < I_W1) {
            const int e = r / 1024, q = r % 1024, s = q & 1, nb = (q >> 1) & 31, kb = q >> 6;
            const int ct = nb >> 2, jj0 = (nb & 3) * 32;
            tr_item<true>(a.in[I_EW1] + (size_t)e * 1024 * 2048, 2048, 64 * kb, 2 * (128 * ct + jj0) + s, 2, gm::S_W, (bf16_t*)((unsigned char*)w1t + ((size_t)e * 2048 + 256 * ct + 128 * s + jj0) * 1024), scr, lane);
            continue; }
        r -= I_W1;
        { const int e = r / 512, q = r % 512, kb = q / 32, nb = q % 32;
          tr_item<true>(a.in[I_EW2] + (size_t)e * 1024 * 1024, 1024, 64 * kb, 32 * nb, 1, gm::S_W, (bf16_t*)((unsigned char*)w2t + ((size_t)e * 1024 + 32 * nb) * 1024), scr, lane); }
    }
}
__device__ __forceinline__ void p1_prep(const Args& a, LAS unsigned char* lds) {
    const int tid = threadIdx.x, lane = tid & 63, wave = tid >> 6;
    LAS float* scr = (LAS float*)(lds + wave * 16384);
    const int gw = blockIdx.x * NWAVES + wave, NGW = gridDim.x * NWAVES;
    const float* win = a.in[I_WIN];
    bf16_t* btin = (bf16_t*)(a.ws + WS_BTIN); bf16_t* btout = (bf16_t*)(a.ws + WS_BTOUT); bf16_t* w1t = (bf16_t*)(a.ws + WS_W1T); bf16_t* w2t = (bf16_t*)(a.ws + WS_W2T);
    const float* mod = (const float*)(a.ws + WS_MOD);
    bf16_t* H = (bf16_t*)(a.ws + WS_H);
#pragma unroll 2
    for (int row = gw; row < TT; row += NGW) {
        const float* xr; int mr;
        if (row < T) { xr = a.in[I_X] + (size_t)row * D; mr = row >> 13; } else { xr = a.in[I_CTX] + (size_t)(row - T) * D; mr = 4; }
        ln_mod_row(xr, mod + mr * 6144, mod + mr * 6144 + 1024, H + (size_t)row * D, lane);
    }
    prep_items(a, scr, 0, PREP_I_IN + PREP_I_FOLD + PREP_I_OUT, gw, NGW, lane);
    prep_items(a, scr, PREP_I_IN + PREP_I_FOLD + PREP_I_OUT + PREP_I_W1, PREP_NITEMS - PREP_DEFER, gw, NGW, lane);
    for (int it = gw; it < 2048; it += NGW) hy::filter_item(a, it, lane);
    float* b1r = (float*)(a.ws + WS_B1R); const float* eb1 = a.in[I_EB1];
    for (int i = blockIdx.x * NTHREADS + tid; i < NE * 2048; i += gridDim.x * NTHREADS) {
        const int e = i >> 11, n = i & 2047, ct = n >> 8, s = (n >> 7) & 1, jj = n & 127;
        b1r[i] = eb1[(size_t)e * 2048 + 2 * (128 * ct + jj) + s];
    }
}

namespace gla {
constexpr int RS = 72;
constexpr int L_TOTF = 0, L_TOTB = 2048, L_SSQ = 4096;
constexpr int L_T0 = 8192;
constexpr int L_T1 = L_T0 + 9216, L_T2 = L_T1 + 9216, L_T3 = L_T2 + 9216;
constexpr int L_VT = L_T3 + 9216;
constexpr int L_P  = L_VT + 18432;
constexpr int L_SF = L_P + 9216, L_SB = L_SF + 18432;
constexpr int L_END = L_SB + 18432;

__device__ __forceinline__ bf16x8 frag(const LAS unsigned char* tile, int row, int k0, int lane) {
    return *(const LAS bf16x8*)(tile + ((row + (lane & 15)) * RS + k0 + 8 * (lane >> 4)) * 2);
}
__device__ __forceinline__ void chunk_cums_pre(LAS unsigned char* L, const float (&gf)[8], const float (&gb)[8], int wave, int lane, float (&cumf)[8], float (&cumb)[8], float& allf, float& allb) {
    LAS float* totf = (LAS float*)(L + L_TOTF); LAS float* totb = (LAS float*)(L + L_TOTB);
    cumf[0] = gf[0];
#pragma unroll
    for (int r = 1; r < 8; ++r) cumf[r] = cumf[r - 1] + gf[r];
    cumb[7] = gb[7];
#pragma unroll
    for (int r = 6; r >= 0; --r) cumb[r] = cumb[r + 1] + gb[r];
    totf[wave * 64 + lane] = cumf[7]; totb[wave * 64 + lane] = cumb[0];
    __syncthreads();
    float of = 0.f, ob = 0.f, af = 0.f, ab = 0.f;
#pragma unroll
    for (int w = 0; w < 8; ++w) { const float tf = totf[w * 64 + lane], tb = totb[w * 64 + lane]; af += tf; ab += tb; of += (w < wave) ? tf : 0.f; ob += (w > wave) ? tb : 0.f; }
#pragma unroll
    for (int r = 0; r < 8; ++r) { cumf[r] += of; cumb[r] += ob; }
    allf = af; allb = ab;
}
__device__ __forceinline__ void chunk_cums(LAS unsigned char* L, const _Float16* GF, const _Float16* GB, size_t tok0, int h, int wave, int lane, float (&cumf)[8], float (&cumb)[8], float& allf, float& allb) {
    float gf[8], gb[8];
#pragma unroll
    for (int r = 0; r < 8; ++r) { const size_t o = (tok0 + 8 * wave + r) * 256 + h * 64 + lane; gf[r] = (float)GF[o]; gb[r] = (float)GB[o]; }
    chunk_cums_pre(L, gf, gb, wave, lane, cumf, cumb, allf, allb);
}
__device__ __forceinline__ void store_vt(LAS unsigned char* L, const u32x4 (&vr)[2], int tid) {
    LAS bf16_t* vt = (LAS bf16_t*)(L + L_VT);
    const int j = tid >> 3, c8 = tid & 7;
#pragma unroll
    for (int q = 0; q < 2; ++q) { const int dv0 = 8 * (c8 + 8 * q);
        const unsigned ww[4] = {vr[q].x, vr[q].y, vr[q].z, vr[q].w};
#pragma unroll
        for (int e = 0; e < 4; ++e) { vt[(dv0 + 2 * e) * RS + j] = (bf16_t)(ww[e] & 0xffffu); vt[(dv0 + 2 * e + 1) * RS + j] = (bf16_t)(ww[e] >> 16); } }
}
__device__ __forceinline__ void load_vt(LAS unsigned char* L, const bf16_t* V, size_t tok0, int h, int tid) {
    const int j = tid >> 3, c8 = tid & 7; u32x4 vr[2];
#pragma unroll
    for (int q = 0; q < 2; ++q) vr[q] = *(const u32x4*)(V + (tok0 + j) * 512 + h * 128 + 8 * (c8 + 8 * q));
    store_vt(L, vr, tid);
}

__device__ __forceinline__ void g1_unit(const Args& a, LAS unsigned char* L, int bh, int chunk  ) {
    const int tid = threadIdx.x, lane = tid & 63, wave = __builtin_amdgcn_readfirstlane(tid >> 6);
    const int b = bh >> 2, h = bh & 3;
    const size_t tok0 = chunk < NCHUNK ? (size_t)b * SEQ + (size_t)chunk * CH : (size_t)T + (size_t)b * CTXL + (size_t)(chunk - NCHUNK) * CH;
    const _Float16* GF = (const _Float16*)(a.ws + WS_GF); const _Float16* GB = (const _Float16*)(a.ws + WS_GB);
    const bf16_t* Kb = (const bf16_t*)(a.ws + WS_K); const bf16_t* Vb = (const bf16_t*)(a.ws + WS_V);
    float cumf[8], cumb[8], allf, allb;
    __syncthreads();
    chunk_cums(L, GF, GB, tok0, h, wave, lane, cumf, cumb, allf, allb);
    LAS bf16_t* ketf = (LAS bf16_t*)(L + L_T0); LAS bf16_t* ketb = (LAS bf16_t*)(L + L_T1);
#pragma unroll
    for (int r = 0; r < 8; ++r) { const int i = 8 * wave + r; const float kv = bf2f(Kb[(tok0 + i) * 256 + h * 64 + lane]);
        ketf[lane * RS + i] = f2bf(kv * __expf(allf - cumf[r])); ketb[lane * RS + i] = f2bf(kv * __expf(allb - cumb[r])); }
    load_vt(L, Vb, tok0, h, tid);
    if (wave == 0) { float* av = (float*)(a.ws + WS_AV); av[((size_t)(0 * 16 + bh) * NCT + chunk) * 64 + lane] = __expf(allf); av[((size_t)(1 * 16 + bh) * NCT + chunk) * 64 + lane] = __expf(allb); }
    __syncthreads();
    bf16_t* KV = (bf16_t*)(a.ws + WS_KV);
#pragma unroll
    for (int dir = 0; dir < 2; ++dir) {
        const LAS unsigned char* ket = L + (dir ? L_T1 : L_T0);
        bf16_t* dst = KV + ((size_t)(dir * 16 + bh) * NCT + chunk) * 8192;
#pragma unroll
        for (int nt = 0; nt < 4; ++nt) { f32x4 acc = {0.f, 0.f, 0.f, 0.f};
#pragma unroll
            for (int ks = 0; ks < 2; ++ks) acc = __builtin_amdgcn_mfma_f32_16x16x32_bf16(frag(L + L_VT, 16 * wave, 32 * ks, lane), frag(ket, 16 * nt, 32 * ks, lane), acc, 0, 0, 0);
#pragma unroll
            for (int r = 0; r < 4; ++r) dst[(16 * wave + 4 * (lane >> 4) + r) * 64 + 16 * nt + (lane & 15)] = f2bf(acc[r]); }
    }
}

__device__ __forceinline__ void g2_scan(const Args& a) {
    const bf16_t* KV = (const bf16_t*)(a.ws + WS_KV); const float* AV = (const float*)(a.ws + WS_AV); bf16_t* SP = (bf16_t*)(a.ws + WS_SP);
    for (int id = blockIdx.x * NTHREADS + threadIdx.x; id < 32 * 4096; id += gridDim.x * NTHREADS) {
        const int db = id >> 12, e2 = id & 4095, dir = db >> 4, dk = (2 * e2) & 63;
        const unsigned* kv = (const unsigned*)(KV + (size_t)db * NCT * 8192) + e2;
        const float* av = AV + (size_t)db * NCT * 64 + dk;
        unsigned* sp = (unsigned*)(SP + (size_t)db * NCHUNK * 8192) + e2;
        float s0 = 0.f, s1 = 0.f;
#pragma unroll
        for (int q = 0; q < NCC; ++q) { const int c = NCHUNK + (dir ? (NCC - 1 - q) : q);
            const unsigned w = kv[(size_t)c * 4096]; const f32x2 aa = *(const f32x2*)(av + (size_t)c * 64);
            s0 = aa[0] * s0 + bflo(w); s1 = aa[1] * s1 + bfhi(w); }
        for (int q0 = 0; q0 < NCHUNK; q0 += 16) {
            unsigned w[16]; f32x2 aa[16];
#pragma unroll
            for (int u = 0; u < 16; ++u) { const int c = dir ? (NCHUNK - 1 - (q0 + u)) : (q0 + u); w[u] = kv[(size_t)c * 4096]; aa[u] = *(const f32x2*)(av + (size_t)c * 64); }
#pragma unroll
            for (int u = 0; u < 16; ++u) { const int c = dir ? (NCHUNK - 1 - (q0 + u)) : (q0 + u);
                sp[(size_t)c * 4096] = pk2(s0, s1);
                s0 = aa[u][0] * s0 + bflo(w[u]); s1 = aa[u][1] * s1 + bfhi(w[u]); }
        }
    }
}

struct G3In { float gf[8], gb[8]; bf16_t q[8], k[8]; u32x4 v[2]; u32x4 sraw[4]; bf16_t gr[4][4]; };
__device__ __forceinline__ void g3_load(const Args& a, int bh, int chunk, G3In& in) {
    const int tid = threadIdx.x, lane = tid & 63, wave = __builtin_amdgcn_readfirstlane(tid >> 6);
    const int b = bh >> 2, h = bh & 3;
    const size_t tok0 = (size_t)b * SEQ + (size_t)chunk * CH;
    const _Float16* GF = (const _Float16*)(a.ws + WS_GF); const _Float16* GB = (const _Float16*)(a.ws + WS_GB);
    const bf16_t* Qb = (const bf16_t*)(a.ws + WS_Q); const bf16_t* Kb = (const bf16_t*)(a.ws + WS_K); const bf16_t* Vb = (const bf16_t*)(a.ws + WS_V);
#pragma unroll
    for (int r = 0; r < 8; ++r) { const size_t o = (tok0 + 8 * wave + r) * 256 + h * 64 + lane; in.gf[r] = (float)GF[o]; in.gb[r] = (float)GB[o]; in.q[r] = Qb[o]; in.k[r] = Kb[o]; }
#pragma unroll
    for (int q = 0; q < 2; ++q) in.v[q] = *(const u32x4*)(Vb + (tok0 + (tid >> 3)) * 512 + h * 128 + 8 * ((tid & 7) + 8 * q));
    const bf16_t* SPf = (const bf16_t*)(a.ws + WS_SP) + ((size_t)(0 * 16 + bh) * NCHUNK + chunk) * 8192;
    const bf16_t* SPb = (const bf16_t*)(a.ws + WS_SP) + ((size_t)(1 * 16 + bh) * NCHUNK + chunk) * 8192;
    in.sraw[0] = *(const u32x4*)(SPf + 16 * tid); in.sraw[1] = *(const u32x4*)(SPf + 16 * tid + 8);
    in.sraw[2] = *(const u32x4*)(SPb + 16 * tid); in.sraw[3] = *(const u32x4*)(SPb + 16 * tid + 8);
    const bf16_t* Gt = (const bf16_t*)(a.ws + WS_G);
    const int mt = wave >> 1, fr = lane & 15, fq = lane >> 4;
#pragma unroll
    for (int q = 0; q < 4; ++q)
#pragma unroll
        for (int r = 0; r < 4; ++r) in.gr[r][q] = Gt[(tok0 + 16 * mt + 4 * fq + r) * 512 + h * 128 + 16 * (4 * (wave & 1) + q) + fr];
}
__device__ __forceinline__ void g3_unit(const Args& a, LAS unsigned char* L, int bh, int chunk  , const G3In& in, hy::CvState& cvs) {
    const int tid = threadIdx.x, lane = tid & 63, wave = __builtin_amdgcn_readfirstlane(tid >> 6);
    const int b = bh >> 2, h = bh & 3;
    const size_t tok0 = (size_t)b * SEQ + (size_t)chunk * CH;
    const int mt = wave >> 1, fr = lane & 15, fq = lane >> 4;
    float cumf[8], cumb[8], allf, allb;
    hy::cv_step(a, cvs, lane);
    __syncthreads();
    chunk_cums_pre(L, in.gf, in.gb, wave, lane, cumf, cumb, allf, allb);
    LAS bf16_t* qf = (LAS bf16_t*)(L + L_T0); LAS bf16_t* kf = (LAS bf16_t*)(L + L_T1); LAS bf16_t* qb = (LAS bf16_t*)(L + L_T2); LAS bf16_t* kb = (LAS bf16_t*)(L + L_T3);
#pragma unroll
    for (int r = 0; r < 8; ++r) { const int i = 8 * wave + r;
        const float qv = bf2f(in.q[r]), kv = bf2f(in.k[r]);
        qf[i * RS + lane] = f2bf(qv * __expf(cumf[r])); kf[i * RS + lane] = f2bf(kv * __expf(-cumf[r]));
        qb[i * RS + lane] = f2bf(qv * __expf(cumb[r])); kb[i * RS + lane] = f2bf(kv * __expf(-cumb[r])); }
    store_vt(L, in.v, tid);
    {
      LAS unsigned char* sf_ = L + L_SF + ((tid >> 2) * RS + 16 * (tid & 3)) * 2; LAS unsigned char* sb_ = L + L_SB + ((tid >> 2) * RS + 16 * (tid & 3)) * 2;
      *(LAS u32x4*)sf_ = in.sraw[0]; *(LAS u32x4*)(sf_ + 16) = in.sraw[1]; *(LAS u32x4*)sb_ = in.sraw[2]; *(LAS u32x4*)(sb_ + 16) = in.sraw[3]; }
    hy::cv_step(a, cvs, lane);
    __syncthreads();
    {
        LAS bf16_t* P = (LAS bf16_t*)(L + L_P);
#pragma unroll
        for (int q = 0; q < 2; ++q) { const int nt = 2 * (wave & 1) + q;
            f32x4 sf = {0.f, 0.f, 0.f, 0.f}, sb = {0.f, 0.f, 0.f, 0.f};
#pragma unroll
            for (int ks = 0; ks < 2; ++ks) {
                sf = __builtin_amdgcn_mfma_f32_16x16x32_bf16(frag(L + L_T0, 16 * mt, 32 * ks, lane), frag(L + L_T1, 16 * nt, 32 * ks, lane), sf, 0, 0, 0);
                sb = __builtin_amdgcn_mfma_f32_16x16x32_bf16(frag(L + L_T2, 16 * mt, 32 * ks, lane), frag(L + L_T3, 16 * nt, 32 * ks, lane), sb, 0, 0, 0); }
#pragma unroll
            for (int r = 0; r < 4; ++r) { const int i = 16 * mt + 4 * fq + r, j = 16 * nt + fr;
                P[i * RS + j] = f2bf((j <= i ? sf[r] : 0.f) + (j >= i ? sb[r] : 0.f)); } }
    }
    hy::cv_step(a, cvs, lane);
    __syncthreads();
    f32x4 o[4]; float ssq[4] = {0.f, 0.f, 0.f, 0.f};
#pragma unroll
    for (int q = 0; q < 4; ++q) { const int nt = 4 * (wave & 1) + q;
        f32x4 acc = {0.f, 0.f, 0.f, 0.f};
#pragma unroll
        for (int ks = 0; ks < 2; ++ks) {
            acc = __builtin_amdgcn_mfma_f32_16x16x32_bf16(frag(L + L_P, 16 * mt, 32 * ks, lane), frag(L + L_VT, 16 * nt, 32 * ks, lane), acc, 0, 0, 0);
            acc = __builtin_amdgcn_mfma_f32_16x16x32_bf16(frag(L + L_T0, 16 * mt, 32 * ks, lane), frag(L + L_SF, 16 * nt, 32 * ks, lane), acc, 0, 0, 0);
            acc = __builtin_amdgcn_mfma_f32_16x16x32_bf16(frag(L + L_T2, 16 * mt, 32 * ks, lane), frag(L + L_SB, 16 * nt, 32 * ks, lane), acc, 0, 0, 0); }
        o[q] = acc;
#pragma unroll
        for (int r = 0; r < 4; ++r) ssq[r] += acc[r] * acc[r]; }
    LAS float* SSQ = (LAS float*)(L + L_SSQ);
#pragma unroll
    for (int r = 0; r < 4; ++r) { float s = ssq[r]; s += __shfl_xor(s, 1); s += __shfl_xor(s, 2); s += __shfl_xor(s, 4); s += __shfl_xor(s, 8); ssq[r] = s; }
    if (fr == 0) {
#pragma unroll
        for (int r = 0; r < 4; ++r) SSQ[(wave & 1) * 64 + 16 * mt + 4 * fq + r] = ssq[r]; }
    hy::cv_step(a, cvs, lane);
    __syncthreads();
    const float* ng = a.in[I_NORMG];
    bf16_t* mix = (bf16_t*)(a.ws + WS_MIX);
#pragma unroll
    for (int r = 0; r < 4; ++r) { const int i = 16 * mt + 4 * fq + r;
        const float rstd = 1.f / sqrtf((SSQ[i] + SSQ[64 + i]) * (1.f / DV) + LN_EPS);
#pragma unroll
        for (int q = 0; q < 4; ++q) { const int dv = 16 * (4 * (wave & 1) + q) + fr;
            const float g = bf2f(in.gr[r][q]);
            mix[(tok0 + i) * 1024 + h * 128 + dv] = f2bf(o[q][r] * rstd * ng[dv] * silu_f(g)); } }
}
}

namespace rt {
constexpr int HS = 1028;
constexpr int L_H2 = 0;
constexpr int L_PART = 65792;
constexpr int L_LCNT = L_PART + 16384;
constexpr int L_REC = L_LCNT + 256;

__device__ __forceinline__ void phase(const Args& a, LAS unsigned char* lds) {
    const int tid = threadIdx.x, lane = tid & 63, wave = __builtin_amdgcn_readfirstlane(tid >> 6);
    bf16_t* xmid = (bf16_t*)(a.ws + WS_PRE1); bf16_t* H2 = (bf16_t*)(a.ws + WS_H2); const bf16_t* FG = (const bf16_t*)(a.ws + WS_FG);
    const float* mod = (const float*)(a.ws + WS_MOD);
    const float* rw = a.in[I_RW]; const float* rb = a.in[I_RB];
    LAS float* h2s = (LAS float*)(lds + L_H2); LAS float* part = (LAS float*)(lds + L_PART);
    LAS int* lcnt = (LAS int*)(lds + L_LCNT); LAS int* lbase = lcnt + 32; LAS int* rec = (LAS int*)(lds + L_REC);
    unsigned* cnt = (unsigned*)(a.ws + WS_CNT); int* list = (int*)(a.ws + WS_LIST); float* pw = (float*)(a.ws + WS_PW); int* ploc = (int*)(a.ws + WS_PLOC);
    float rwr[32][2];
#pragma unroll
    for (int s = 0; s < 32; ++s)
#pragma unroll
        for (int nt = 0; nt < 2; ++nt) rwr[s][nt] = rw[(size_t)(128 * wave + 4 * s + (lane >> 4)) * 32 + 16 * nt + (lane & 15)];
    const f32x4* g1 = (const f32x4*)a.in[I_LN1G]; const f32x4* bb1 = (const f32x4*)a.in[I_LN1B];
    if (tid < 32) lcnt[tid] = 0;
    f32x4 xq[2][4]; u32x2 fq_[2][4];
#define RT_LOAD(g_) do { _Pragma("unroll") for (int rr = 0; rr < 2; ++rr) { const int t_ = (g_) * 16 + 2 * wave + rr; \
        const f32x4* xr_ = (const f32x4*)(a.in[I_X] + (size_t)t_ * D) + lane; const u32x2* fr_ = (const u32x2*)(FG + (size_t)t_ * D) + lane; \
        _Pragma("unroll") for (int j = 0; j < 4; ++j) { xq[rr][j] = xr_[64 * j]; fq_[rr][j] = fr_[64 * j]; } } } while (0)
    if ((int)blockIdx.x < T / 16) RT_LOAD((int)blockIdx.x);
    for (int grp = blockIdx.x; grp < T / 16; grp += gridDim.x) {
        __syncthreads();
        f32x4 xv_[2][4]; u32x2 fv_[2][4];
#pragma unroll
        for (int rr = 0; rr < 2; ++rr)
#pragma unroll
            for (int j = 0; j < 4; ++j) { xv_[rr][j] = xq[rr][j]; fv_[rr][j] = fq_[rr][j]; }
        if (grp + (int)gridDim.x < T / 16) RT_LOAD(grp + (int)gridDim.x);
#pragma unroll
        for (int rr = 0; rr < 2; ++rr) {
            const int lr = 2 * wave + rr, t = grp * 16 + lr, b = t >> 13;
            u32x2* pr = (u32x2*)(xmid + (size_t)t * D) + lane;
            f32x4 v[4]; float s = 0.f;
#pragma unroll
            for (int j = 0; j < 4; ++j) { const u32x2 fw = fv_[rr][j]; const f32x4 ff = {bflo(fw.x), bfhi(fw.x), bflo(fw.y), bfhi(fw.y)};
                v[j] = xv_[rr][j] * ALPHA + ff; s += (v[j][0] + v[j][1]) + (v[j][2] + v[j][3]); }
            float mean = wave_sum(s) * (1.f / D), s2 = 0.f;
#pragma unroll
            for (int j = 0; j < 4; ++j) { v[j] = v[j] - mean; s2 += (v[j][0] * v[j][0] + v[j][1] * v[j][1]) + (v[j][2] * v[j][2] + v[j][3] * v[j][3]); }
            float rstd = 1.f / sqrtf(wave_sum(s2) * (1.f / D) + LN_EPS);
            s = 0.f;
#pragma unroll
            for (int j = 0; j < 4; ++j) { v[j] = v[j] * rstd * g1[64 * j + lane] + bb1[64 * j + lane]; u32x2 w; w.x = pk2(v[j][0], v[j][1]); w.y = pk2(v[j][2], v[j][3]); pr[64 * j] = w;
                v[j] = (f32x4){bflo(w.x), bfhi(w.x), bflo(w.y), bfhi(w.y)}; s += (v[j][0] + v[j][1]) + (v[j][2] + v[j][3]); }
            mean = wave_sum(s) * (1.f / D); s2 = 0.f;
#pragma unroll
            for (int j = 0; j < 4; ++j) { v[j] = v[j] - mean; s2 += (v[j][0] * v[j][0] + v[j][1] * v[j][1]) + (v[j][2] * v[j][2] + v[j][3] * v[j][3]); }
            rstd = 1.f / sqrtf(wave_sum(s2) * (1.f / D) + LN_EPS);
            const f32x4* sh = (const f32x4*)(mod + b * 6144 + 3 * 1024); const f32x4* sc = (const f32x4*)(mod + b * 6144 + 4 * 1024);
            unsigned* o4 = (unsigned*)((unsigned char*)H2 + (size_t)t * D) + lane;
#pragma unroll
            for (int j = 0; j < 4; ++j) { const f32x4 y = v[j] * rstd * (sc[64 * j + lane] + 1.f) + sh[64 * j + lane];
                o4[64 * j] = gm::pk4_fp8(y[0] * gm::S_H2, y[1] * gm::S_H2, y[2] * gm::S_H2, y[3] * gm::S_H2);
                *(LAS f32x4*)(h2s + lr * HS + 256 * j + 4 * lane) = y; }
        }
        __syncthreads();
        {
            f32x4 acc0 = {0.f, 0.f, 0.f, 0.f}, acc1 = {0.f, 0.f, 0.f, 0.f};
            const LAS float* ap = h2s + (lane & 15) * HS + 128 * wave + (lane >> 4);
#pragma unroll
            for (int s = 0; s < 32; ++s) { const float av = ap[4 * s];
                acc0 = __builtin_amdgcn_mfma_f32_16x16x4f32(av, rwr[s][0], acc0, 0, 0, 0);
                acc1 = __builtin_amdgcn_mfma_f32_16x16x4f32(av, rwr[s][1], acc1, 0, 0, 0); }
#pragma unroll
            for (int r = 0; r < 4; ++r) { part[(wave * 16 + 4 * (lane >> 4) + r) * 32 + (lane & 15)] = acc0[r]; part[(wave * 16 + 4 * (lane >> 4) + r) * 32 + 16 + (lane & 15)] = acc1[r]; }
        }
        __syncthreads();
        {
            const int lr = 2 * wave + (lane >> 5), e = lane & 31, t = grp * 16 + lr;
            float lg = rb[e];
#pragma unroll
            for (int w = 0; w < 8; ++w) lg += part[(w * 16 + lr) * 32 + e];
            float cur = lg, tv[4]; int ti[4];
#pragma unroll
            for (int k = 0; k < 4; ++k) { float bv = cur; int bi = e;
#pragma unroll
                for (int o = 1; o < 32; o <<= 1) { const float ov = __shfl_xor(bv, o); const int oi = __shfl_xor(bi, o); if (ov > bv || (ov == bv && oi < bi)) { bv = ov; bi = oi; } }
                tv[k] = bv; ti[k] = bi; if (bi == e) cur = -3.0e38f; }
            const float e1 = __expf(tv[1] - tv[0]), e2 = __expf(tv[2] - tv[0]), e3 = __expf(tv[3] - tv[0]);
            const float inv = 1.f / (1.f + e1 + e2 + e3);
            if (e < 4) { const float wk = (e == 0 ? 1.f : (e == 1 ? e1 : (e == 2 ? e2 : e3))) * inv; const int ek = (e == 0 ? ti[0] : (e == 1 ? ti[1] : (e == 2 ? ti[2] : ti[3])));
                const int pair = t * 4 + e;
                pw[pair] = wk;
                const int rank = __hip_atomic_fetch_add((LAS int*)&lcnt[ek], 1, __ATOMIC_RELAXED, __HIP_MEMORY_SCOPE_WORKGROUP);
                rec[lr * 4 + e] = ek | (rank << 8); }
        }
        __syncthreads();
        if (tid < 32) { const int n = lcnt[tid]; lbase[tid] = n ? (int)atomicAdd(&cnt[tid], (unsigned)n) : 0; }
        __syncthreads();
        if (tid < 64) { const int rc = rec[tid], ek = rc & 255, rank = rc >> 8, pos = lbase[ek] + rank, pair = (grp * 16 + (tid >> 2)) * 4 + (tid & 3);
            list[(size_t)ek * CAP + pos] = pair; ploc[pair] = ek | (pos << 5); }
        __syncthreads();
        if (tid < 32) lcnt[tid] = 0;
    }
#undef RT_LOAD
}
}

__device__ __forceinline__ void p_final(const Args& a, LAS unsigned char* lds) {
    const int tid = threadIdx.x, lane = tid & 63, wave = tid >> 6;
    const bf16_t* xm = (const bf16_t*)(a.ws + WS_PRE1); const unsigned char* slots = (const unsigned char*)(a.ws + WS_SLOTS); const float* mod = (const float*)(a.ws + WS_MOD);
    const int* ploc = (const int*)(a.ws + WS_PLOC); const float* pw = (const float*)(a.ws + WS_PW);
    const f32x4* g2 = (const f32x4*)a.in[I_LN2G]; const f32x4* b2 = (const f32x4*)a.in[I_LN2B];
    LAS int* tstart = (LAS int*)lds;
    __syncthreads();
    if (tid == 0) { const unsigned* cnt = (const unsigned*)(a.ws + WS_CNT); int nrt = 0; for (int e = 0; e < NE; ++e) { tstart[e] = 256 * nrt; nrt += ((int)cnt[e] + 255) >> 8; } }
    __syncthreads();
    const int tstep = gridDim.x * NWAVES; int t = blockIdx.x * NWAVES + wave;
    if (t < T) {
        int plc[4], pln[4]; float wc_[4], wn_[4]; unsigned qc[4][4], qn[4][4]; u32x2 xc[4], xn[4];
#define PF_IDX(tt, pl, ww) do { _Pragma("unroll") for (int sl = 0; sl < 4; ++sl) { pl[sl] = ploc[(tt) * 4 + sl]; ww[sl] = pw[(tt) * 4 + sl] * (1.f / gm::S_SL); } } while (0)
#define PF_DATA(tt, pl, qq, xx) do { _Pragma("unroll") for (int sl = 0; sl < 4; ++sl) { const unsigned* sr_ = (const unsigned*)(slots + (size_t)(tstart[pl[sl] & 31] + (pl[sl] >> 5)) * D) + lane; \
            _Pragma("unroll") for (int j = 0; j < 4; ++j) qq[sl][j] = sr_[64 * j]; } \
        { const u32x2* xr_ = (const u32x2*)(xm + (size_t)(tt) * D) + lane; _Pragma("unroll") for (int j = 0; j < 4; ++j) xx[j] = xr_[64 * j]; } } while (0)
        PF_IDX(t, plc, wc_); PF_DATA(t, plc, qc, xc);
        int tn = t + tstep; const bool hn0 = tn < T;
        if (hn0) PF_IDX(tn, pln, wn_);
        for (;;) {
            const bool hn = tn < T;
            if (hn) PF_DATA(tn, pln, qn, xn);
            int pl2[4]; float w2[4]; const int tn2 = tn + tstep; const bool hn2 = hn && tn2 < T;
            if (hn2) PF_IDX(tn2, pl2, w2);
            {
                const int b = t >> 13; const f32x4* gt = (const f32x4*)(mod + b * 6144 + 5 * 1024);
                f32x4 v[4]; float s = 0.f;
#pragma unroll
                for (int j = 0; j < 4; ++j) { f32x4 y = {0.f, 0.f, 0.f, 0.f};
#pragma unroll
                    for (int sl = 0; sl < 4; ++sl) { const int q = (int)qc[sl][j];
                        y[0] += wc_[sl] * __builtin_amdgcn_cvt_f32_fp8(q, 0); y[1] += wc_[sl] * __builtin_amdgcn_cvt_f32_fp8(q, 1); y[2] += wc_[sl] * __builtin_amdgcn_cvt_f32_fp8(q, 2); y[3] += wc_[sl] * __builtin_amdgcn_cvt_f32_fp8(q, 3); }
                    const f32x4 xv = {bflo(xc[j].x), bfhi(xc[j].x), bflo(xc[j].y), bfhi(xc[j].y)};
                    v[j] = xv * ALPHA + gt[64 * j + lane] * y; s += (v[j][0] + v[j][1]) + (v[j][2] + v[j][3]); }
                const float mean = wave_sum(s) * (1.f / D); float s2 = 0.f;
#pragma unroll
                for (int j = 0; j < 4; ++j) { v[j] = v[j] - mean; s2 += (v[j][0] * v[j][0] + v[j][1] * v[j][1]) + (v[j][2] * v[j][2] + v[j][3] * v[j][3]); }
                const float rstd = 1.f / sqrtf(wave_sum(s2) * (1.f / D) + LN_EPS);
                f32x4* o = (f32x4*)(a.out + (size_t)t * D) + lane;
#pragma unroll
                for (int j = 0; j < 4; ++j) o[64 * j] = v[j] * rstd * g2[64 * j + lane] + b2[64 * j + lane];
            }
            if (!hn) break;
            t = tn; tn = tn2;
#pragma unroll
            for (int sl = 0; sl < 4; ++sl) { plc[sl] = pln[sl]; wc_[sl] = wn_[sl]; pln[sl] = pl2[sl]; wn_[sl] = w2[sl];
#pragma unroll
                for (int j = 0; j < 4; ++j) qc[sl][j] = qn[sl][j]; }
#pragma unroll
            for (int j = 0; j < 4; ++j) xc[j] = xn[j];
        }
#undef PF_IDX
#undef PF_DATA
    }
}


constexpr int N_PHASES = 11;
__global__ void __launch_bounds__(NTHREADS, 2) mega_fwd(Args a) {
    extern __shared__ __attribute__((aligned(16))) unsigned char lds_raw[];
    LAS unsigned char* lds = (LAS unsigned char*)lds_raw;
    const int tid = threadIdx.x;
    volatile LAS unsigned* misc = (volatile LAS unsigned*)(lds + LDS_MISC);
    if (tid < 4) misc[tid] = 0u;
    __syncthreads();
    XcdBarrier bar; bar.bar = (unsigned*)(a.ws + WS_BAR); bar.x = 0; bar.st = misc;
    const bool multi = (a.ph_hi - a.ph_lo) > 1;
    if (multi) bar = xcd_barrier_post((unsigned*)(a.ws + WS_BAR), misc);
    const int lo = a.ph_lo, hi = a.ph_hi;
#define vcu ((gridDim.x % 8 == 0) ? (int)((blockIdx.x % 8) * (gridDim.x / 8) + blockIdx.x / 8) : (int)blockIdx.x)
#ifdef ONLY_PHASE
#define IN(k) ((k) == ONLY_PHASE && lo <= (k) && (k) < hi)
#else
#define IN(k) (lo <= (k) && (k) < hi)
#endif
#define SEAM(k) do { if (IN(k) && IN((k) + 1)) xcd_barrier(bar); } while (0)

#ifndef REPEAT_PHASE
#define REPEAT_PHASE -1
#endif
#ifdef PROF_REP
#define RUNPH(k, ...) do { if (IN(k)) { const int nrep_ = (a.rep_k == (k)) ? 2 : 1; for (int rep_ = 0; rep_ < nrep_; ++rep_) { if (rep_) xcd_barrier(bar); __VA_ARGS__; } } } while (0)
#else
#define RUNPH(k, ...) do { if (IN(k)) { __VA_ARGS__; if (REPEAT_PHASE == (k)) { xcd_barrier(bar); __VA_ARGS__; } } } while (0)
#endif
    RUNPH(0, p0_mod_and_filter(a, lds));
    SEAM(0);
    RUNPH(1, p1_prep(a, lds));
    SEAM(1);
    RUNPH(2, { gm::SchedIn S{a.ws, (int)gridDim.x, vcu, a.in[I_BAF], a.in[I_BAB]}; gm::EpiIn E{a.ws}; gm::gemm_stream<false, 0, false>(lds, S, E);
        {
          const int G = (int)gridDim.x, rounds = (1812 + G - 1) / G, extra = 1812 - (rounds - 1) * G, v = vcu;
          if (v >= extra || extra == G) { const int nidle = (extra == G) ? G : G - extra, ridle = (extra == G) ? v : v - extra; __syncthreads();
              prep_items(a, (LAS float*)(lds + (tid >> 6) * 16384), PREP_NITEMS - PREP_DEFER, PREP_NITEMS, ridle * NWAVES + (tid >> 6), nidle * NWAVES, tid & 63); } } });
    SEAM(2);
    RUNPH(3, { for (int u = blockIdx.x; u < 16 * NCT; u += gridDim.x) gla::g1_unit(a, lds, u / NCT, u % NCT); });
    SEAM(3);
    RUNPH(4, { gla::g2_scan(a);
        hy::CvState cvs; cvs.jb.mi = -1; cvs.next = (int)blockIdx.x * NWAVES + (tid >> 6); cvs.stride = (int)gridDim.x * NWAVES; cvs.end = hy::CV_ITEMS / 2;
        for (int c = blockIdx.x; c < HYW; c += gridDim.x) hy::channel(a, lds, c, a.ws + WS_HSPEC + (size_t)blockIdx.x * HSPEC_PER_WG, cvs);
        while (cvs.jb.mi >= 0 || cvs.next < cvs.end) hy::cv_step(a, cvs, tid & 63); });
    SEAM(4);
    RUNPH(5, { hy::CvState cvs; cvs.jb.mi = -1; cvs.stride = (int)gridDim.x * NWAVES; cvs.end = hy::CV_ITEMS;
        { const int w0_ = (int)blockIdx.x * NWAVES + (tid >> 6), half_ = hy::CV_ITEMS / 2; cvs.next = half_ + ((w0_ - half_ % cvs.stride) % cvs.stride + cvs.stride) % cvs.stride; }
        { int u = blockIdx.x; gla::G3In cur, nxt;
            if (u < 16 * NCHUNK) { gla::g3_load(a, u >> 7, u & 127, cur);
                for (;;) { const int un = u + (int)gridDim.x; const bool hn = un < 16 * NCHUNK; if (hn) gla::g3_load(a, un >> 7, un & 127, nxt);
                    gla::g3_unit(a, lds, u >> 7, u & 127, cur, cvs); if (!hn) break; cur = nxt; u = un; } } }
        while (cvs.jb.mi >= 0 || cvs.next < cvs.end) hy::cv_step(a, cvs, tid & 63);
        const int wave = tid >> 6;
        for (int it = blockIdx.x * NWAVES + wave; it < 4096; it += gridDim.x * NWAVES) hy::transpose_item(a, it, tid & 63); });
    SEAM(5);
    RUNPH(6, { gm::SchedOut S{a.ws, (int)gridDim.x, vcu}; gm::EpiOut E{a.ws}; gm::gemm_stream<false, 0, false>(lds, S, E); });
    SEAM(6);
    RUNPH(7, rt::phase(a, lds));
    SEAM(7);
    if (IN(8) || IN(9)) {
        LAS int* tab = (LAS int*)(lds + gm::LDS_TAB);
        __syncthreads();
        if (tid == 0) { const unsigned* cnt = (const unsigned*)(a.ws + WS_CNT); int nrt = 0;
            for (int e = 0; e < NE; ++e) { const int n = (int)cnt[e]; tab[e] = n; const int nt = (n + 255) >> 8; for (int k = 0; k < nt; ++k) tab[64 + nrt + k] = e | (k << 8); nrt += nt; }
            tab[32] = nrt; }
        __syncthreads();
    }
    RUNPH(8, { gm::SchedMoe<1> S{a.ws, (const LAS int*)(lds + gm::LDS_TAB), (int)gridDim.x, vcu, a.in[I_EB2]}; gm::EpiMoe1 E{a.ws}; gm::gemm_stream<true, 2, true>(lds, S, E); });
    SEAM(8);
    RUNPH(9, { gm::SchedMoe<2> S{a.ws, (const LAS int*)(lds + gm::LDS_TAB), (int)gridDim.x, vcu, a.in[I_EB2]}; gm::EpiMoe2 E{a.ws}; gm::gemm_stream<false, 0, true>(lds, S, E); });
    SEAM(9);
    RUNPH(10, p_final(a, lds));
#undef RUNPH
#undef vcu
#undef IN
#undef SEAM
}

extern "C" void kernel_launch(void* const* d_in, const int* in_sizes, int n_in, void* d_out, int out_size, void* d_ws, size_t ws_size, hipStream_t stream) {
    static int grid = 0;
    if (grid == 0) {
        if (n_in != 32 || out_size != T * D || ws_size < WS_END) { fprintf(stderr, "kernel_launch: unexpected shapes (n_in %d out %d ws %zu need %zu)\n", n_in, out_size, ws_size, (size_t)WS_END); grid = -1; return; }
        int dev = 0, cus = 0;
        if (hipGetDevice(&dev) != hipSuccess || hipDeviceGetAttribute(&cus, hipDeviceAttributeMultiprocessorCount, dev) != hipSuccess) { grid = -1; return; }
        if (hipFuncSetAttribute((const void*)mega_fwd, hipFuncAttributeMaxDynamicSharedMemorySize, LDS_BYTES) != hipSuccess) { fprintf(stderr, "kernel_launch: hipFuncSetAttribute failed\n"); grid = -1; return; }
        int per_cu = 0;
        if (hipOccupancyMaxActiveBlocksPerMultiprocessor(&per_cu, (const void*)mega_fwd, NTHREADS, LDS_BYTES) != hipSuccess || per_cu < 1) fprintf(stderr, "kernel_launch: occupancy query says %d\n", per_cu);
        (void)hipGetLastError();
        grid = cus;
        if (grid > MAX_GRID) grid = MAX_GRID;
    }
    if (grid < 0) return;
    (void)hipMemsetAsync(d_ws, 0, WS_ZERO_BYTES, stream);
    Args a{};
    for (int i = 0; i < 32; ++i) a.in[i] = (const float*)d_in[i];
    a.out = (float*)d_out; a.ws = (unsigned char*)d_ws;
#ifdef DBG
    (void)hipMemsetAsync((char*)d_ws + WS_DBG, 0, 512, stream);
    for (int p = 0; p < N_PHASES; ++p) { a.ph_lo = p; a.ph_hi = p + 1; hipLaunchKernelGGL(mega_fwd, dim3(grid), dim3(NTHREADS), LDS_BYTES, stream, a);
        hipLaunchKernelGGL(dbg_check, dim3(64), dim3(512), 0, stream, a, p); }
    hipLaunchKernelGGL(dbg_encode, dim3(1024), dim3(256), 0, stream, a);
#elif N_LAUNCH_PER_PHASE
    for (int p = 0; p < N_PHASES; ++p) { a.ph_lo = p; a.ph_hi = p + 1; hipLaunchKernelGGL(mega_fwd, dim3(grid), dim3(NTHREADS), LDS_BYTES, stream, a); }
#else
    a.ph_lo = 0; a.ph_hi = N_PHASES;
#ifdef PROF_REP
    a.rep_k = PROF_REP;
#endif
    hipLaunchKernelGGL(mega_fwd, dim3(grid), dim3(NTHREADS), LDS_BYTES, stream, a);
#endif
}
```

```cpp
#include <hip/hip_runtime.h>
#include <cstdio>
#include <cstdint>
#include <cstddef>

#define LAS __attribute__((address_space(3)))
#define GAS __attribute__((address_space(1)))
typedef unsigned short bf16_t;
typedef short bf16x8 __attribute__((ext_vector_type(8)));
typedef float f32x4 __attribute__((ext_vector_type(4)));
typedef float f32x2 __attribute__((ext_vector_type(2)));
typedef unsigned u32x4 __attribute__((ext_vector_type(4)));
typedef unsigned u32x2 __attribute__((ext_vector_type(2)));

#ifndef N_LAUNCH_PER_PHASE
#define N_LAUNCH_PER_PHASE 0
#endif

constexpr int D = 1024, NB = 4, SEQ = 8192, T = NB * SEQ, CTXL = 256, TC = NB * CTXL, TT = T + TC;
constexpr int NH = 4, DK = 64, DV = 128, CH = 64, NCHUNK = SEQ / CH, NCC = CTXL / CH, NCT = NCHUNK + NCC;
constexpr int HYW = 512, HYC = 3 * HYW, INW = 3104;
constexpr int NE = 32, DE = 1024, CAP = T;
constexpr float LN_EPS = 1e-6f, ALPHA = 1.189207115002721f;
constexpr int NTHREADS = 512, NWAVES = 8;
constexpr int FFTN = 16384;

constexpr size_t al256(size_t x) { return (x + 255) & ~(size_t)255; }
constexpr size_t WS_BAR   = 0;
constexpr size_t WS_MOD   = 16384;
constexpr size_t WS_CNT   = WS_MOD + 5 * 6144 * 4;
constexpr size_t WS_ZERO_BYTES = al256(WS_CNT + 256);
constexpr size_t WS_LIST  = 262144;
constexpr size_t WS_PW    = WS_LIST + (size_t)NE * CAP * 4;
constexpr size_t WS_PLOC  = WS_PW + (size_t)T * 4 * 4;
constexpr size_t WS_B1R   = WS_PLOC + (size_t)T * 4 * 4;
constexpr size_t WS_HID2  = WS_B1R + (size_t)NE * 2048 * 4;
constexpr size_t WS_BTIN  = WS_HID2 + (size_t)SEQ * 64 * 4;
constexpr size_t WS_BTOUT = WS_BTIN + (size_t)3584 * 1024 * 2;
constexpr size_t WS_W1T   = WS_BTOUT + (size_t)1024 * 1024 * 2;
constexpr size_t WS_W2T   = WS_W1T + (size_t)NE * 2048 * 1024 * 2;
constexpr size_t WS_PRE1  = WS_W2T + (size_t)NE * 1024 * 1024 * 2;
constexpr size_t WS_RA    = WS_PRE1 + (size_t)T * 1024 * 4;
constexpr size_t WS_H     = WS_RA;
constexpr size_t WS_Q     = WS_H + (size_t)TT * 1024 * 2;
constexpr size_t WS_K     = WS_Q + (size_t)T * 256 * 2;
constexpr size_t WS_V     = WS_K + (size_t)TT * 256 * 2;
constexpr size_t WS_G     = WS_V + (size_t)TT * 512 * 2;
constexpr size_t WS_GF    = WS_G + (size_t)T * 512 * 2;
constexpr size_t WS_GB    = WS_GF + (size_t)TT * 256 * 4;
constexpr size_t WS_UT    = WS_GB + (size_t)TT * 256 * 4;
constexpr size_t WS_RA_END= WS_UT + (size_t)NB * HYC * SEQ * 2;
constexpr size_t WS_H2    = WS_RA;
constexpr size_t WS_FG    = WS_RA + (size_t)T * 1024 * 2;
constexpr size_t WS_SLOTS = WS_RA;
constexpr size_t SORTED_BYTES_ = (size_t)(T * 4 / 256 + NE) * 256 * 1024 * 2;
constexpr size_t WS_RB    = al256(WS_RA_END > WS_RA + SORTED_BYTES_ ? WS_RA_END : WS_RA + SORTED_BYTES_);
constexpr size_t WS_KV    = WS_RB;
constexpr size_t WS_AV    = WS_KV + (size_t)2 * 16 * NCT * 8192 * 2;
constexpr size_t WS_SP    = WS_AV + (size_t)2 * 16 * NCT * 64 * 4;
constexpr size_t WS_HSPEC = WS_SP + (size_t)2 * 16 * NCHUNK * 8192 * 2;
constexpr size_t HSPEC_PER_WG = (size_t)2 * FFTN * 8;
constexpr int MAX_GRID = 256;
constexpr size_t WS_YHYT  = WS_HSPEC + (size_t)MAX_GRID * HSPEC_PER_WG;
constexpr size_t WS_MIX   = WS_YHYT + (size_t)NB * HYW * SEQ * 2;
constexpr size_t WS_RB_END= WS_MIX + (size_t)T * 1024 * 2;
constexpr size_t WS_HF    = WS_MIX;
constexpr size_t WS_ACT   = WS_RB;
constexpr size_t SORTED_BYTES = (size_t)(T * 4 / 256 + NE) * 256 * 1024 * 2;
constexpr size_t WS_END   = al256(WS_RB_END > WS_RB + SORTED_BYTES ? WS_RB_END : WS_RB + SORTED_BYTES);

constexpr int LDS_BYTES = 147456;
constexpr int LDS_MISC  = 145408;

typedef __bf16 bf16n2 __attribute__((ext_vector_type(2)));
__device__ __forceinline__ unsigned pk2(float lo, float hi) { bf16n2 v = {(__bf16)lo, (__bf16)hi}; return __builtin_bit_cast(unsigned, v); }
__device__ __forceinline__ bf16_t f2bf(float f) { __bf16 b = (__bf16)f; return __builtin_bit_cast(unsigned short, b); }
__device__ __forceinline__ float bf2f(bf16_t b) { return __uint_as_float(((unsigned)b) << 16); }
__device__ __forceinline__ float bflo(unsigned w) { return __uint_as_float(w << 16); }
__device__ __forceinline__ float bfhi(unsigned w) { return __uint_as_float(w & 0xffff0000u); }
__device__ __forceinline__ float wave_sum(float v) {
#pragma unroll
    for (int o = 1; o < 64; o <<= 1) v += __shfl_xor(v, o);
    return v;
}
__device__ __forceinline__ float silu_f(float x) { return x * __builtin_amdgcn_rcpf(1.f + __expf(-x)); }
__device__ __forceinline__ float log_sigmoid_f(float z) { return fminf(z, 0.f) - __logf(1.f + __expf(-fabsf(z))); }

#define XB_TMO      128
#define XB_XCNT(j)  (256  + 64 * (j))
#define XB_XSUB(j)  (1280 + 64 * (j))
#define XB_XGEN(j)  (2304 + 64 * (j))
#define XB_TOP      3328
#define XB_TOPGEN   3392
#define XCD_BAR_WORDS 3456
#define XB_SPIN_CAP (1u << 22)
__device__ __forceinline__ unsigned xb_ld(unsigned* p)              { return __hip_atomic_load(p, __ATOMIC_RELAXED, __HIP_MEMORY_SCOPE_AGENT); }
__device__ __forceinline__ unsigned xb_add(unsigned* p, unsigned v) { return __hip_atomic_fetch_add(p, v, __ATOMIC_RELAXED, __HIP_MEMORY_SCOPE_AGENT); }
__device__ __forceinline__ unsigned xb_xcc_id() { return (unsigned)__builtin_amdgcn_s_getreg((3 << 11) | 20) & 0xFu; }
#define XB_SPIN(cond, bar) do { unsigned _sp = 0; while (cond) { __builtin_amdgcn_s_sleep(1); \
    if ((++_sp & 255u) == 0u) { if (xb_ld(&(bar)[XB_TMO])) break; if (_sp > XB_SPIN_CAP) { atomicAdd(&(bar)[XB_TMO], 1u); break; } } } } while (0)
struct XcdBarrier { unsigned* bar; unsigned x; volatile LAS unsigned* st; };
__device__ __forceinline__ XcdBarrier xcd_barrier_post(unsigned* bar, volatile LAS unsigned* st) {
    XcdBarrier b; b.bar = bar; b.x = xb_xcc_id(); b.st = st;
    if (threadIdx.x == 0) (void)xb_add(&bar[XB_XCNT(b.x)], 1u);
    return b;
}
__device__ __forceinline__ void xcd_barrier_complete(unsigned* bar, unsigned x, unsigned& nloc, unsigned& nx) {
    const unsigned G = gridDim.x * gridDim.y * gridDim.z;
    unsigned sum, cnt, mine, sp = 0u;
    for (;;) {
        sum = 0u; cnt = 0u; mine = 0u;
#pragma unroll
        for (unsigned j = 0; j < 16; ++j) { const unsigned c = xb_ld(&bar[XB_XCNT(j)]); sum += c; cnt += (c > 0u) ? 1u : 0u; mine = (j == x) ? c : mine; }
        if (sum == G) break;
        __builtin_amdgcn_s_sleep(1);
        if ((++sp & 255u) == 0u) { if (xb_ld(&bar[XB_TMO])) break; if (sp > XB_SPIN_CAP) { atomicAdd(&bar[XB_TMO], 1u); break; } }
    }
    nloc = mine > 0u ? mine : 1u; nx = cnt > 0u ? cnt : 1u;
}
__device__ __forceinline__ void xcd_barrier(const XcdBarrier& b) {
    asm volatile("s_waitcnt vmcnt(0)" ::: "memory");
    __syncthreads();
    if (threadIdx.x == 0) {
        unsigned* bar = b.bar;
        __builtin_amdgcn_s_waitcnt(0);
        unsigned nloc = b.st[0], nx = b.st[1];
        if (nloc == 0u) { xcd_barrier_complete(bar, b.x, nloc, nx); b.st[0] = nloc; b.st[1] = nx; }
        const unsigned old = xb_add(&bar[XB_XSUB(b.x)], 1u);
        const unsigned gen = old / nloc;
        if (old + 1u == (gen + 1u) * nloc) {
            __builtin_amdgcn_fence(__ATOMIC_RELEASE, "agent");
            asm volatile("s_waitcnt vmcnt(0)" ::: "memory");
            const unsigned og = xb_add(&bar[XB_TOP], 1u);
            const unsigned tg = og / nx;
            if (og + 1u == (tg + 1u) * nx) xb_add(&bar[XB_TOPGEN], 1u);
            else XB_SPIN(xb_ld(&bar[XB_TOPGEN]) == tg, bar);
            __builtin_amdgcn_fence(__ATOMIC_ACQUIRE, "agent");
            xb_add(&bar[XB_XGEN(b.x)], 1u);
            asm volatile("s_waitcnt vmcnt(0)" ::: "memory");
        } else {
            XB_SPIN(xb_ld(&bar[XB_XGEN(b.x)]) == gen, bar);
            __builtin_amdgcn_fence(__ATOMIC_ACQUIRE, "agent");
            asm volatile("s_waitcnt vmcnt(0)" ::: "memory");
        }
    }
    __syncthreads();
}

struct Args {
    const float* in[32];
    float* out;
    unsigned char* ws;
    int ph_lo, ph_hi;
    int rep_k, pad_;
};
enum { I_X = 0, I_C, I_CTX, I_CCTX, I_ADAW, I_ADAB, I_WIN, I_WAF, I_BAF, I_WAB, I_BAB, I_NORMG, I_CONVW, I_CONVB, I_FW1, I_FB1, I_FW2, I_FB2, I_FWOUT, I_FFREQ,
       I_BIASD, I_WOUT, I_LN1G, I_LN1B, I_RW, I_RB, I_EW1, I_EB1, I_EW2, I_EB2, I_LN2G, I_LN2B };


namespace gm {
constexpr int BM = 256, BK = 64, HALF = 128, HTB = HALF * BK * 2, STAGE_BYTES = 8 * HTB, KD = 1024, NT = KD / BK;
constexpr int ROWB = KD * 2;
typedef int i32x8 __attribute__((ext_vector_type(8)));
__device__ __forceinline__ int lds_off8(int r, int fq) { const int rr = r & 15; return ((r >> 4) * 2 + (fq >> 1)) * 1024 + ((rr * 64 + 32 * (fq & 1)) ^ (((rr >> 3) & 1) << 5)); }
__device__ __forceinline__ int lds_byte(int r, int c) { const int st = (r >> 4) * 2 + (c >> 5), rr = r & 15, cc = c & 31, ob = rr * 64 + cc * 2; return st * 1024 + (ob ^ (((ob >> 9) & 1) << 5)); }
__device__ __forceinline__ void stage_rc(int b, int& R, int& C) { const int st = b / 1024, sb = b % 1024, swz = sb ^ (((sb >> 9) & 1) << 5); R = (st >> 1) * 16 + swz / 64; C = (st & 1) * 32 + (swz % 64) / 2; }
__device__ __forceinline__ int perm32(int rho) { const int n = rho >> 4, i = rho & 15; return 8 * (i >> 2) + 4 * n + (i & 3); }

constexpr int LDS_BIAS = STAGE_BYTES + 4096;
struct Unit {
    const char* A;
    const char* B;
    const int* list;
    int type, row0, col0, valid, aux;
};

__device__ __forceinline__ i32x8 cat8(bf16x8 lo, bf16x8 hi) { typedef int i32x4 __attribute__((ext_vector_type(4))); const i32x4 a = __builtin_bit_cast(i32x4, lo), b = __builtin_bit_cast(i32x4, hi); return (i32x8){a[0], a[1], a[2], a[3], b[0], b[1], b[2], b[3]}; }
template <bool GATHER, int GSHIFT, int RB>
__device__ __forceinline__ void a_offsets(const Unit& u, unsigned (&o)[2][2]) {
    int R[2], Cb[2];
    int tz = threadIdx.x; asm volatile("" : "+v"(tz));
#pragma unroll
    for (int i = 0; i < 2; ++i) { int r, c; stage_rc(tz * 16 + i * 8192, r, c); R[i] = r; Cb[i] = c * 2; }
#pragma unroll
    for (int h = 0; h < 2; ++h)
#pragma unroll
        for (int i = 0; i < 2; ++i) {
            const int r = h * HALF + R[i];
            if (!GATHER) o[h][i] = (unsigned)(r * RB + Cb[i]);
            else { const int idx = u.list[r < u.valid ? r : 0]; o[h][i] = (unsigned)(idx >> GSHIFT) * (unsigned)RB + (unsigned)Cb[i]; }
        }
}

template <bool GATHER, int GSHIFT, bool FP8, class Sched, class Epi>
__device__ __forceinline__ void gemm_stream(LAS unsigned char* lds, const Sched& S, const Epi& E) {
    constexpr int RB = FP8 ? KD : ROWB, NTL = FP8 ? NT / 2 : NT;
    const int tid = threadIdx.x, wid = __builtin_amdgcn_readfirstlane(tid >> 6), lane = tid & 63, wr = wid >> 2, wc = wid & 3, fr = lane & 15, fq = lane >> 4;
    unsigned voffB[2], voffA[2];
#pragma unroll
    for (int i = 0; i < 2; ++i) { int r, c; stage_rc(tid * 16 + i * 8192, r, c); const int rb = (r & ~31) + perm32(r & 31); voffB[i] = (unsigned)(rb * RB + c * 2); voffA[i] = (unsigned)(r * RB + c * 2); }
    const size_t kstep = (size_t)(BK * 2), hstep = (size_t)HALF * RB;
    const unsigned ldsw = (unsigned)wid * 1024u;
    const int aoff = FP8 ? lds_off8(wr * 64 + fr, fq) : lds_byte(wr * 64 + fr, fq * 8), boff = FP8 ? lds_off8(wc * 32 + fr, fq) : lds_byte(wc * 32 + fr, fq * 8);
#define GM_SA(b, h) (((b) * 2 + (h)) * HTB)
#define GM_SB(b, h) ((4 + (b) * 2 + (h)) * HTB)
#define GM_STAGE(bufoff, gbase, vo0, vo1) do { \
        __builtin_amdgcn_global_load_lds((const unsigned*)((const char*)(gbase) + (vo0)), (LAS unsigned*)(lds + (bufoff) + ldsw), 16, 0, 0); \
        __builtin_amdgcn_global_load_lds((const unsigned*)((const char*)(gbase) + (vo1)), (LAS unsigned*)(lds + (bufoff) + ldsw + 8192), 16, 0, 0); } while (0)
#define GM_STAGE_A(bufoff, gbase, h, o0, o1) do { if constexpr (GATHER) GM_STAGE(bufoff, gbase, o0, o1); else GM_STAGE(bufoff, (gbase) + (h) * hstep, voffA[0], voffA[1]); } while (0)
#define GM_LD32(p) ({ const i32x4 lo_ = *(const LAS i32x4*)(p), hi_ = *(const LAS i32x4*)((p) + 16); (i32x8){lo_[0], lo_[1], lo_[2], lo_[3], hi_[0], hi_[1], hi_[2], hi_[3]}; })
#define GM_LDA(dst, b, h) do { if constexpr (FP8) { _Pragma("unroll") for (int m = 0; m < 4; ++m) dst##8[m] = GM_LD32(lds + GM_SA(b, h) + aoff + m * 2048); } \
        else { _Pragma("unroll") for (int m = 0; m < 4; ++m) _Pragma("unroll") for (int k = 0; k < 2; ++k) dst[m][k] = *(const LAS bf16x8*)(lds + GM_SA(b, h) + aoff + m * 2048 + k * 1024); } } while (0)
#define GM_LDB(dst, b, h) do { if constexpr (FP8) { _Pragma("unroll") for (int n = 0; n < 2; ++n) dst##8[n] = GM_LD32(lds + GM_SB(b, h) + boff + n * 2048); } \
        else { _Pragma("unroll") for (int n = 0; n < 2; ++n) _Pragma("unroll") for (int k = 0; k < 2; ++k) dst[n][k] = *(const LAS bf16x8*)(lds + GM_SB(b, h) + boff + n * 2048 + k * 1024); } } while (0)
#define GM_MMA(ai, bj, At, Bt) do { __builtin_amdgcn_s_setprio(1); _Pragma("unroll") for (int m = 0; m < 4; ++m) _Pragma("unroll") for (int n = 0; n < 2; ++n) { \
        if constexpr (FP8) asm volatile("v_mfma_scale_f32_16x16x128_f8f6f4 %0, %1, %2, %0, %3, %3 op_sel_hi:[0,0,0]" : "+v"(acc[ai][bj][m][n]) : "v"(Bt##8[n]), "v"(At##8[m]), "v"(sc1_)); \
        else { _Pragma("unroll") for (int k = 0; k < 2; ++k) acc[ai][bj][m][n] = __builtin_amdgcn_mfma_f32_16x16x32_bf16(Bt[n][k], At[m][k], acc[ai][bj][m][n], 0, 0, 0); } } \
        __builtin_amdgcn_s_setprio(0); } while (0)
#define GM_WAIT_V(n) asm volatile("s_waitcnt vmcnt(" #n ")" ::: "memory")
#define GM_WAIT_L(n) asm volatile("s_waitcnt lgkmcnt(" #n ")" ::: "memory")
#define GM_BAR __builtin_amdgcn_s_barrier()
#define GM_SCHED __builtin_amdgcn_sched_barrier(0)
    Unit cur, nxt; int ui = 0;
    if (!S.next(0, cur)) return;
    f32x4 acc[2][2][4][2];
#pragma unroll
    for (int a = 0; a < 2; ++a)
#pragma unroll
        for (int b = 0; b < 2; ++b)
#pragma unroll
            for (int m = 0; m < 4; ++m)
#pragma unroll
                for (int n = 0; n < 2; ++n) acc[a][b][m][n] = (f32x4){0.f, 0.f, 0.f, 0.f};
    typedef int i32x4 __attribute__((ext_vector_type(4)));
    int sc1_ = 0x7f7f7f7f; asm volatile("" : "+v"(sc1_));
    bf16x8 At[4][2], B0[2][2], B1[2][2];
    i32x8 At8[4], B08[2], B18[2];
    unsigned ca[2][2], na[2][2];
    if constexpr (GATHER) a_offsets<GATHER, GSHIFT, RB>(cur, ca);
    const char* cA = cur.A; const char* cB = cur.B;
    GM_STAGE(GM_SB(0, 0), cB, voffB[0], voffB[1]); GM_STAGE_A(GM_SA(0, 0), cA, 0, ca[0][0], ca[0][1]); GM_STAGE(GM_SB(0, 1), cB + hstep, voffB[0], voffB[1]); GM_STAGE_A(GM_SA(0, 1), cA, 1, ca[1][0], ca[1][1]);
    if (wr == 1) GM_BAR;
    GM_WAIT_V(4); GM_BAR;
    GM_STAGE(GM_SB(1, 0), cB + kstep, voffB[0], voffB[1]); GM_STAGE_A(GM_SA(1, 0), cA + kstep, 0, ca[0][0], ca[0][1]); GM_STAGE(GM_SB(1, 1), cB + hstep + kstep, voffB[0], voffB[1]);
    GM_WAIT_V(6); GM_BAR;
    for (;;) {
        const bool has_next = S.next(ui + 1, nxt);
        if constexpr (GATHER) {
            if (has_next) a_offsets<GATHER, GSHIFT, RB>(nxt, na);
            else {
#pragma unroll
                for (int h = 0; h < 2; ++h)
#pragma unroll
                    for (int i = 0; i < 2; ++i) na[h][i] = ca[h][i];
            }
        }
        const char* nA = has_next ? nxt.A : cA; const char* nB = has_next ? nxt.B : cB;
        if (wid == 0)
            __builtin_amdgcn_global_load_lds((const unsigned*)(S.bias(cur) + 4 * lane), (LAS unsigned*)(lds + LDS_BIAS + (ui & 1) * 1024), 16, 0, 0);
        for (int t = 0; t < NTL; t += 2) {
            const bool last = (t == NTL - 2);

            const char* a1 = cA + (size_t)(t + 1) * kstep;
            const char* a2 = last ? nA : cA + (size_t)(t + 2) * kstep; const char* b2 = last ? nB : cB + (size_t)(t + 2) * kstep;
            const char* a3 = a2 + kstep; const char* b3 = b2 + kstep;
            unsigned x00 = 0, x01 = 0, x10 = 0, x11 = 0;
            if constexpr (GATHER) { x00 = last ? na[0][0] : ca[0][0]; x01 = last ? na[0][1] : ca[0][1]; x10 = last ? na[1][0] : ca[1][0]; x11 = last ? na[1][1] : ca[1][1]; }
            GM_LDB(B0, 0, 0); GM_SCHED; GM_LDA(At, 0, 0); GM_STAGE_A(GM_SA(1, 1), a1, 1, ca[1][0], ca[1][1]);
            GM_WAIT_L(8); GM_BAR; GM_WAIT_L(0); GM_MMA(0, 0, At, B0); GM_BAR; GM_SCHED;
            GM_LDB(B1, 0, 1); GM_STAGE(GM_SB(0, 0), b2, voffB[0], voffB[1]);
            GM_BAR; GM_WAIT_L(0); GM_MMA(0, 1, At, B1); GM_BAR;
            GM_LDA(At, 0, 1); GM_STAGE_A(GM_SA(0, 0), a2, 0, x00, x01);
            GM_BAR; GM_WAIT_L(0); GM_MMA(1, 0, At, B0); GM_BAR; GM_SCHED;
            GM_STAGE(GM_SB(0, 1), b2 + hstep, voffB[0], voffB[1]);
            GM_WAIT_V(6); GM_BAR; GM_MMA(1, 1, At, B1); GM_BAR;
            GM_LDB(B0, 1, 0); GM_SCHED; GM_LDA(At, 1, 0); GM_STAGE_A(GM_SA(0, 1), a2, 1, x10, x11);
            GM_WAIT_L(8); GM_BAR; GM_WAIT_L(0); GM_MMA(0, 0, At, B0); GM_BAR; GM_SCHED;
            GM_LDB(B1, 1, 1); GM_STAGE(GM_SB(1, 0), b3, voffB[0], voffB[1]);
            GM_BAR; GM_WAIT_L(0); GM_MMA(0, 1, At, B1); GM_BAR;
            GM_LDA(At, 1, 1); GM_STAGE_A(GM_SA(1, 0), a3, 0, x00, x01);
            GM_BAR; GM_WAIT_L(0); GM_MMA(1, 0, At, B0); GM_BAR; GM_SCHED;
            GM_STAGE(GM_SB(1, 1), b3 + hstep, voffB[0], voffB[1]);
            GM_WAIT_V(6); GM_BAR; GM_MMA(1, 1, At, B1); GM_BAR;
        }
        if constexpr (FP8) asm volatile("s_nop 7\n\ts_nop 7" ::: "memory");
        {
          int tz = threadIdx.x; asm volatile("" : "+v"(tz)); const int wz = tz >> 6, lz = tz & 63;
          E(acc, cur, wz >> 2, wz & 3, lz & 15, lz >> 4, (const LAS float*)(lds + LDS_BIAS + (ui & 1) * 1024)); }
        if (!has_next) break;
#pragma unroll
        for (int a = 0; a < 2; ++a)
#pragma unroll
            for (int b = 0; b < 2; ++b)
#pragma unroll
                for (int m = 0; m < 4; ++m)
#pragma unroll
                    for (int n = 0; n < 2; ++n) acc[a][b][m][n] = (f32x4){0.f, 0.f, 0.f, 0.f};
        cur = nxt; cA = nA; cB = nB; ++ui;
        if constexpr (GATHER) {
#pragma unroll
            for (int h = 0; h < 2; ++h)
#pragma unroll
                for (int i = 0; i < 2; ++i) ca[h][i] = na[h][i];
        }
    }
    GM_WAIT_V(0);
    if (wr == 0) GM_BAR;
    GM_BAR;
#undef GM_SA
#undef GM_SB
#undef GM_STAGE
#undef GM_STAGE_A
#undef GM_LD32
#undef GM_LDA
#undef GM_LDB
#undef GM_MMA
#undef GM_WAIT_V
#undef GM_WAIT_L
#undef GM_BAR
#undef GM_SCHED
}

__device__ __forceinline__ u32x4 pack8(f32x4 a, f32x4 b) { u32x4 w; w.x = pk2(a[0], a[1]); w.y = pk2(a[2], a[3]); w.z = pk2(b[0], b[1]); w.w = pk2(b[2], b[3]); return w; }

struct SchedIn {
    unsigned char* ws; int G, c; const float* baf; const float* bab;
    __device__ __forceinline__ bool next(int i, Unit& u) const {
        int L = i * G + c;
        u.list = nullptr; u.valid = 256; u.aux = 0;
        if (L < 768) {
            const int pa = L % 6, pb = L / 6;
            u.A = (const char*)(ws + WS_BTIN) + (size_t)(2048 + 256 * pa) * ROWB; u.B = (const char*)(ws + WS_H) + (size_t)(256 * pb) * ROWB;
            u.type = 2; u.row0 = 256 * pa; u.col0 = 256 * pb; return true;
        }
        L -= 768;
        if (L < 1024) {
            const int pm = L >> 3, pn = ((L & 7) + (L >> 8)) & 7;
            u.A = (const char*)(ws + WS_H) + (size_t)(256 * pm) * ROWB; u.B = (const char*)(ws + WS_BTIN) + (size_t)(256 * pn) * ROWB;
            u.type = pn < 6 ? 0 : 1; u.row0 = 256 * pm; u.col0 = pn; return true;
        }
        L -= 1024;
        if (L < 20) {
            const int pm = L / 5, j = L % 5, pn = j == 0 ? 1 : (j == 1 ? 2 : (j == 2 ? 3 : (j == 3 ? 6 : 7)));
            u.A = (const char*)(ws + WS_H) + (size_t)(T + 256 * pm) * ROWB; u.B = (const char*)(ws + WS_BTIN) + (size_t)(256 * pn) * ROWB;
            u.type = pn < 6 ? 0 : 1; u.row0 = T + 256 * pm; u.col0 = pn; return true;
        }
        return false;
    }
    __device__ __forceinline__ const float* bias(const Unit& u) const { return (u.type == 1 && u.col0 == 7) ? bab : baf; }
};
struct EpiIn {
    unsigned char* ws;
    __device__ __forceinline__ void operator()(const f32x4 (&acc)[2][2][4][2], const Unit& u, int wr, int wc, int fr, int fq, const LAS float* bs) const {
        const int rl = wr * 64 + fr, cl = wc * 32 + 8 * fq;
        if (u.type == 0) {
            const int pn = u.col0;
            bf16_t* dst; int ld, cb;
            if (pn == 0) { dst = (bf16_t*)(ws + WS_Q); ld = 256; cb = 0; }
            else if (pn == 1) { dst = (bf16_t*)(ws + WS_K); ld = 256; cb = 0; }
            else if (pn < 4) { dst = (bf16_t*)(ws + WS_V); ld = 512; cb = (pn - 2) * 256; }
            else { dst = (bf16_t*)(ws + WS_G); ld = 512; cb = (pn - 4) * 256; }
#pragma unroll
            for (int ai = 0; ai < 2; ++ai)
#pragma unroll
                for (int m = 0; m < 4; ++m) { bf16_t* rowp = dst + (size_t)(u.row0 + rl + ai * 128 + m * 16) * ld + cb + cl;
#pragma unroll
                    for (int bj = 0; bj < 2; ++bj) *(u32x4*)(rowp + bj * 128) = pack8(acc[ai][bj][m][0], acc[ai][bj][m][1]); }
        } else if (u.type == 1) {
            _Float16* dst = (_Float16*)(ws + (u.col0 == 6 ? WS_GF : WS_GB));
            f32x4 bv[2][2];
#pragma unroll
            for (int bj = 0; bj < 2; ++bj)
#pragma unroll
                for (int n = 0; n < 2; ++n) bv[bj][n] = *(const LAS f32x4*)(bs + cl + bj * 128 + 4 * n);
            typedef _Float16 f16x8_ __attribute__((ext_vector_type(8)));
#pragma unroll
            for (int ai = 0; ai < 2; ++ai)
#pragma unroll
                for (int m = 0; m < 4; ++m) { _Float16* rowp = dst + (size_t)(u.row0 + rl + ai * 128 + m * 16) * 256 + cl;
#pragma unroll
                    for (int bj = 0; bj < 2; ++bj) { f16x8_ o;
#pragma unroll
                        for (int n = 0; n < 2; ++n) { const f32x4 z = acc[ai][bj][m][n] + bv[bj][n];
#pragma unroll
                            for (int j = 0; j < 4; ++j) o[4 * n + j] = (_Float16)(log_sigmoid_f(z[j]) * (1.f / 16.f)); }
                        *(f16x8_*)(rowp + bj * 128) = o; } }
        } else {
            const int b = u.col0 >> 13, l0 = u.col0 & 8191;
            bf16_t* dst = (bf16_t*)(ws + WS_UT) + ((size_t)b * HYC) * SEQ + l0 + cl;
#pragma unroll
            for (int ai = 0; ai < 2; ++ai)
#pragma unroll
                for (int m = 0; m < 4; ++m) { bf16_t* rowp = dst + (size_t)(u.row0 + rl + ai * 128 + m * 16) * SEQ;
#pragma unroll
                    for (int bj = 0; bj < 2; ++bj) *(u32x4*)(rowp + bj * 128) = pack8(acc[ai][bj][m][0], acc[ai][bj][m][1]); }
        }
    }
};

struct SchedOut {
    unsigned char* ws; int G, c;
    __device__ __forceinline__ bool next(int i, Unit& u) const {
        const int L = i * G + c; if (L >= 512) return false;
        const int pm = L >> 2, pn = L & 3;
        u.A = (const char*)(ws + WS_MIX) + (size_t)(256 * pm) * ROWB; u.B = (const char*)(ws + WS_BTOUT) + (size_t)(256 * pn) * ROWB;
        u.list = nullptr; u.valid = 256; u.aux = 0; u.type = 3; u.row0 = 256 * pm; u.col0 = 256 * pn; return true;
    }
    __device__ __forceinline__ const float* bias(const Unit& u) const { return (const float*)(ws + WS_MOD) + (u.row0 >> 13) * 6144 + 2 * 1024 + u.col0; }
};
struct EpiOut {
    unsigned char* ws;
    __device__ __forceinline__ void operator()(const f32x4 (&acc)[2][2][4][2], const Unit& u, int wr, int wc, int fr, int fq, const LAS float* bs) const {
        const int rl = wr * 64 + fr, cl = u.col0 + wc * 32 + 8 * fq;
        bf16_t* fg = (bf16_t*)(ws + WS_FG);
        f32x4 gv[2][2];
#pragma unroll
        for (int bj = 0; bj < 2; ++bj)
#pragma unroll
            for (int n = 0; n < 2; ++n) gv[bj][n] = *(const LAS f32x4*)(bs + wc * 32 + 8 * fq + bj * 128 + 4 * n);
#pragma unroll
        for (int ai = 0; ai < 2; ++ai)
#pragma unroll
            for (int m = 0; m < 4; ++m) { bf16_t* rowp = fg + (size_t)(u.row0 + rl + ai * 128 + m * 16) * 1024 + cl;
#pragma unroll
                for (int bj = 0; bj < 2; ++bj) *(u32x4*)(rowp + bj * 128) = pack8(gv[bj][0] * acc[ai][bj][m][0], gv[bj][1] * acc[ai][bj][m][1]); }
    }
};

constexpr int LDS_TAB = STAGE_BYTES;
template <int WHICH>
struct SchedMoe {
    unsigned char* ws; const LAS int* tab; int G, c; const float* b2;
    __device__ __forceinline__ bool next(int i, Unit& u) const {
        constexpr int NCT_ = WHICH == 1 ? 8 : 4;
        const int L = i * G + c; const int nrt = __builtin_amdgcn_readfirstlane(tab[32]);
        if (L >= nrt * NCT_) return false;
        const int rt = L / NCT_, ct = L % NCT_;
        const int info = __builtin_amdgcn_readfirstlane(tab[64 + rt]), e = info & 255, r0 = (info >> 8) * 256;
        const int cnt = __builtin_amdgcn_readfirstlane(tab[e]);
        u.valid = (cnt - r0) < 256 ? (cnt - r0) : 256;
        u.list = (const int*)(ws + WS_LIST) + (size_t)e * CAP + r0;
        u.A = (WHICH == 1) ? (const char*)(ws + WS_H2) : (const char*)(ws + WS_ACT) + (size_t)(256 * rt) * KD;
        u.B = (const char*)(ws + (WHICH == 1 ? WS_W1T : WS_W2T)) + ((size_t)e * (WHICH == 1 ? 2048 : 1024) + 256 * ct) * KD;
        u.type = 3 + WHICH; u.row0 = 256 * rt; u.col0 = ct; u.aux = e; return true;
    }
    __device__ __forceinline__ const float* bias(const Unit& u) const { return (WHICH == 1) ? (const float*)(ws + WS_B1R) + (size_t)u.aux * 2048 + 256 * u.col0 : b2 + (size_t)u.aux * 1024 + 256 * u.col0; }
};
__device__ __forceinline__ float swiglu_f(float glu, float lin) {
    glu = fminf(glu, 7.f); lin = fminf(fmaxf(lin, -7.f), 7.f);
    return glu * __builtin_amdgcn_rcpf(1.f + __expf(-1.702f * glu)) * (lin + 1.f);
}
constexpr float S_H2 = 4.f, S_ACT = 8.f, S_W = 64.f;
__device__ __forceinline__ unsigned pk4_fp8(float a, float b, float c, float d) {
    a = fminf(fmaxf(a, -448.f), 448.f); b = fminf(fmaxf(b, -448.f), 448.f); c = fminf(fmaxf(c, -448.f), 448.f); d = fminf(fmaxf(d, -448.f), 448.f);
    int p = __builtin_amdgcn_cvt_pk_fp8_f32(a, b, 0, false); p = __builtin_amdgcn_cvt_pk_fp8_f32(c, d, p, true); return (unsigned)p; }
__device__ __forceinline__ unsigned pk4_fp8_nc(float a, float b, float c, float d) { int p = __builtin_amdgcn_cvt_pk_fp8_f32(a, b, 0, false); p = __builtin_amdgcn_cvt_pk_fp8_f32(c, d, p, true); return (unsigned)p; }
struct EpiMoe1 {
    unsigned char* ws;
    __device__ __forceinline__ void operator()(const f32x4 (&acc)[2][2][4][2], const Unit& u, int wr, int wc, int fr, int fq, const LAS float* bs) const {
        const int rl = wr * 64 + fr, cl = wc * 32 + 8 * fq, ct = u.col0;
        const LAS float* b1 = bs + cl;
        unsigned char* act = (unsigned char*)(ws + WS_ACT) + (size_t)u.row0 * 1024 + 128 * ct + cl;
        f32x4 bg[2], bl[2];
#pragma unroll
        for (int n = 0; n < 2; ++n) { bg[n] = *(const LAS f32x4*)(b1 + 4 * n); bl[n] = *(const LAS f32x4*)(b1 + 128 + 4 * n); }
#pragma unroll
        for (int ai = 0; ai < 2; ++ai)
#pragma unroll
            for (int mp = 0; mp < 2; ++mp) {
                u32x2 w[2];
#pragma unroll
                for (int mm = 0; mm < 2; ++mm) { const int m = 2 * mp + mm; f32x4 o[2];
#pragma unroll
                    for (int n = 0; n < 2; ++n) { const f32x4 gl = acc[ai][0][m][n] * (1.f / (S_H2 * S_W)) + bg[n], li = acc[ai][1][m][n] * (1.f / (S_H2 * S_W)) + bl[n];
#pragma unroll
                        for (int j = 0; j < 4; ++j) o[n][j] = swiglu_f(gl[j], li[j]) * S_ACT; }
                    w[mm].x = pk4_fp8(o[0][0], o[0][1], o[0][2], o[0][3]); w[mm].y = pk4_fp8(o[1][0], o[1][1], o[1][2], o[1][3]); }
                const auto sx = __builtin_amdgcn_permlane16_swap(w[0].x, w[1].x, false, false); const auto sy = __builtin_amdgcn_permlane16_swap(w[0].y, w[1].y, false, false);
                const int r = rl + ai * 128 + (2 * mp + (fq & 1)) * 16;
                *(u32x4*)(act + (size_t)r * 1024 - 8 * (fq & 1)) = (u32x4){sx[0], sy[0], sx[1], sy[1]}; }
    }
};
constexpr float S_SL = 16.f;
struct EpiMoe2 {
    unsigned char* ws;
    __device__ __forceinline__ void operator()(const f32x4 (&acc)[2][2][4][2], const Unit& u, int wr, int wc, int fr, int fq, const LAS float* bs) const {
        const int rl = wr * 64 + fr, cl = wc * 32 + 8 * fq, ct = u.col0;
        const LAS float* bb = bs + cl;
        unsigned char* slots = (unsigned char*)(ws + WS_SLOTS) + (size_t)u.row0 * 1024 + 256 * ct + cl;
        f32x4 bv[2][2];
#pragma unroll
        for (int bj = 0; bj < 2; ++bj)
#pragma unroll
            for (int n = 0; n < 2; ++n) bv[bj][n] = *(const LAS f32x4*)(bb + bj * 128 + 4 * n) * S_SL;
#pragma unroll
        for (int ai = 0; ai < 2; ++ai)
#pragma unroll
            for (int m = 0; m < 4; ++m) { const int r = rl + ai * 128 + m * 16;
                u32x2 w[2];
#pragma unroll
                for (int bj = 0; bj < 2; ++bj) { const f32x4 y0 = acc[ai][bj][m][0] * (S_SL / (S_ACT * S_W)) + bv[bj][0], y1 = acc[ai][bj][m][1] * (S_SL / (S_ACT * S_W)) + bv[bj][1];
                    w[bj].x = pk4_fp8(y0[0], y0[1], y0[2], y0[3]); w[bj].y = pk4_fp8(y1[0], y1[1], y1[2], y1[3]); }
                const auto sx = __builtin_amdgcn_permlane16_swap(w[0].x, w[1].x, false, false); const auto sy = __builtin_amdgcn_permlane16_swap(w[0].y, w[1].y, false, false);
                *(u32x4*)(slots + (size_t)r * 1024 + ((fq & 1) ? 128 - 8 : 0)) = (u32x4){sx[0], sy[0], sx[1], sy[1]}; }
    }
};
}

namespace hy {
__device__ __forceinline__ int phys(int n) { return n + (n >> 4) + ((n >> 9) << 4); }
constexpr int XSIZE = 16384 + 1024 + 512;

__device__ __forceinline__ float tw_c(int i) {
    constexpr float t[16] = {1.f, 0.98078528040323043f, 0.92387953251128674f, 0.83146961230254524f, 0.70710678118654752f, 0.55557023301960218f, 0.38268343236508977f, 0.19509032201612825f,
                             0.f, -0.19509032201612825f, -0.38268343236508977f, -0.55557023301960218f, -0.70710678118654752f, -0.83146961230254524f, -0.92387953251128674f, -0.98078528040323043f};
    return t[i];
}
__device__ __forceinline__ float tw_s(int i) {
    constexpr float t[16] = {0.f, 0.19509032201612825f, 0.38268343236508977f, 0.55557023301960218f, 0.70710678118654752f, 0.83146961230254524f, 0.92387953251128674f, 0.98078528040323043f,
                             1.f, 0.98078528040323043f, 0.92387953251128674f, 0.83146961230254524f, 0.70710678118654752f, 0.55557023301960218f, 0.38268343236508977f, 0.19509032201612825f};
    return t[i];
}
__host__ __device__ constexpr int brev(int p, int bits) { int r = 0; for (int i = 0; i < bits; ++i) r |= ((p >> i) & 1) << (bits - 1 - i); return r; }

__device__ __forceinline__ f32x2 cmul(f32x2 a, f32x2 w) { f32x2 r;
    asm("v_pk_mul_f32 %0, %1, %2 op_sel_hi:[1,0]\n\tv_pk_fma_f32 %0, %1, %2, %0 op_sel:[1,1,0] op_sel_hi:[0,1,1] neg_lo:[0,1,0]" : "=&v"(r) : "v"(a), "v"(w)); return r; }
__device__ __forceinline__ void cmul_chain(f32x2 a, f32x2 w, f32x2 w1, f32x2& o, f32x2& wn) {
    asm("v_pk_mul_f32 %0, %2, %3 op_sel_hi:[1,0]\n\tv_pk_mul_f32 %1, %3, %4 op_sel_hi:[1,0]\n\t"
        "v_pk_fma_f32 %0, %2, %3, %0 op_sel:[1,1,0] op_sel_hi:[0,1,1] neg_lo:[0,1,0]\n\tv_pk_fma_f32 %1, %3, %4, %1 op_sel:[1,1,0] op_sel_hi:[0,1,1] neg_lo:[0,1,0]"
        : "=&v"(o), "=&v"(wn) : "v"(a), "v"(w), "v"(w1)); }
template <int TI, bool INV>
__device__ __forceinline__ void bf_tw(f32x2& a, f32x2& b) {
    constexpr int T7 = TI < 8 ? TI : 16 - TI;
    const f32x2 W = {tw_c(T7), tw_s(T7)};
    f32x2 sum, o;
#define HY_BF(NEGR, NEGI) asm("v_pk_add_f32 %0, %3, %2\n\tv_pk_add_f32 %2, %3, %2 neg_lo:[0,1] neg_hi:[0,1]\n\tv_pk_mul_f32 %1, %2, %4 op_sel_hi:[1,0]" NEGR "\n\tv_pk_fma_f32 %1, %2, %4, %1 op_sel:[1,1,0] op_sel_hi:[0,1,1] " NEGI : "=&v"(sum), "=&v"(o), "+v"(b) : "v"(a), "s"(W))
    if (TI < 8) { if (!INV) HY_BF("", "neg_hi:[0,1,0]"); else HY_BF("", "neg_lo:[0,1,0]"); }
    else        { if (!INV) HY_BF(" neg_lo:[0,1] neg_hi:[0,1]", "neg_hi:[0,1,0]"); else HY_BF(" neg_lo:[0,1] neg_hi:[0,1]", "neg_lo:[0,1,0]"); }
#undef HY_BF
    a = sum; b = o;
}
template <int TI, bool INV>
__device__ __forceinline__ f32x2 tw_mul(f32x2 t) {
    constexpr int T7 = TI < 8 ? TI : 16 - TI;
    const f32x2 W = {tw_c(T7), tw_s(T7)};
    f32x2 r;
#define HY_TW(NEGR, NEGI) asm("v_pk_mul_f32 %0, %1, %2 op_sel_hi:[1,0]" NEGR "\n\tv_pk_fma_f32 %0, %1, %2, %0 op_sel:[1,1,0] op_sel_hi:[0,1,1] " NEGI : "=&v"(r) : "v"(t), "s"(W))
    if (TI < 8) { if (!INV) HY_TW("", "neg_hi:[0,1,0]"); else HY_TW("", "neg_lo:[0,1,0]"); }
    else        { if (!INV) HY_TW(" neg_lo:[0,1] neg_hi:[0,1]", "neg_hi:[0,1,0]"); else HY_TW(" neg_lo:[0,1] neg_hi:[0,1]", "neg_lo:[0,1,0]"); }
#undef HY_TW
    return r;
}
template <bool INV>
__device__ __forceinline__ void bf_rot(f32x2& a, f32x2& b) { f32x2 sum, o;
    if (!INV) asm("v_pk_add_f32 %0, %2, %3\n\tv_pk_add_f32 %1, %2, %3 op_sel:[1,1] op_sel_hi:[0,0] neg_lo:[0,1] neg_hi:[1,0]" : "=&v"(sum), "=&v"(o) : "v"(a), "v"(b));
    else      asm("v_pk_add_f32 %0, %2, %3\n\tv_pk_add_f32 %1, %2, %3 op_sel:[1,1] op_sel_hi:[0,0] neg_lo:[1,0] neg_hi:[0,1]" : "=&v"(sum), "=&v"(o) : "v"(a), "v"(b));
    a = sum; b = o; }
__device__ __forceinline__ void bf_plain(f32x2& a, f32x2& b) { f32x2 sum, o;
    asm("v_pk_add_f32 %0, %2, %3\n\tv_pk_add_f32 %1, %2, %3 neg_lo:[0,1] neg_hi:[0,1]" : "=&v"(sum), "=&v"(o) : "v"(a), "v"(b));
    a = sum; b = o; }
template <bool INV>
__device__ __forceinline__ f32x2 rot_i(f32x2 t) { f32x2 r;
    if (!INV) asm("v_pk_mul_f32 %0, %1, 1.0 op_sel:[1,0] op_sel_hi:[0,0] neg_hi:[1,0]" : "=v"(r) : "v"(t));
    else      asm("v_pk_mul_f32 %0, %1, 1.0 op_sel:[1,0] op_sel_hi:[0,0] neg_lo:[1,0]" : "=v"(r) : "v"(t));
    return r; }

template <int R, bool INV, bool ZP, int S, int J>
__device__ __forceinline__ void fft_bfly(f32x2 (&v)[R]) {
    constexpr int g = (J / S) * 2 * S, k = J % S, ti = k * (16 / S), i0 = g + k, i1 = g + k + S;
    if constexpr (ZP && S == R / 2) {
        if constexpr (ti == 0) v[i1] = v[i0]; else if constexpr (ti == 8) v[i1] = rot_i<INV>(v[i0]); else v[i1] = tw_mul<ti, INV>(v[i0]);
    } else {
        if constexpr (ti == 0) bf_plain(v[i0], v[i1]); else if constexpr (ti == 8) bf_rot<INV>(v[i0], v[i1]); else bf_tw<ti, INV>(v[i0], v[i1]);
    }
}
template <int R, bool INV, bool ZP, int S, int J>
__device__ __forceinline__ void fft_stage(f32x2 (&v)[R]) { if constexpr (J < R / 2) { fft_bfly<R, INV, ZP, S, J>(v); fft_stage<R, INV, ZP, S, J + 1>(v); } }
template <int R, bool INV, bool ZP, int S>
__device__ __forceinline__ void fft_stages(f32x2 (&v)[R]) { if constexpr (S >= 1) { fft_stage<R, INV, ZP, S, 0>(v); fft_stages<R, INV, ZP, S / 2>(v); } }
template <int R, bool INV, bool ZP = false>
__device__ __forceinline__ void fft_reg(f32x2 (&v)[R]) { fft_stages<R, INV, ZP, R / 2>(v); }
template <int M, bool ZPAD = false>
__device__ __forceinline__ void pass_fwd32(LAS f32x2* X, int tid) {
    int j = (M == 512) ? tid : (tid & 15);
    asm volatile("" : "+v"(j));
    const int p0 = (M == 512) ? (tid + (tid >> 4)) : (560 * (tid >> 4) + (tid & 15));
    constexpr int PS = (M == 512) ? 560 : 17;
    f32x2 v[32];
#pragma unroll
    for (int r = 0; r < 32; ++r) { if (ZPAD && r >= 16) v[r] = (f32x2){0.f, 0.f}; else v[r] = X[p0 + PS * r]; }
    fft_reg<32, false, ZPAD>(v);
    float sn, cs; sincospif(-2.f * (float)j / (float)(32 * M), &sn, &cs);
    const f32x2 w1 = {cs, sn}; f32x2 w = w1;
    X[p0] = v[0];
#pragma unroll
    for (int rp = 1; rp < 32; ++rp) { if (rp < 31) { f32x2 o_, wn_; cmul_chain(v[brev(rp, 5)], w, w1, o_, wn_); X[p0 + PS * rp] = o_; w = wn_; } else X[p0 + PS * rp] = cmul(v[brev(rp, 5)], w); }
}
template <int M, bool HALF = false>
__device__ __forceinline__ void pass_inv32(LAS f32x2* X, int tid) {
    int j = (M == 512) ? tid : (tid & 15);
    asm volatile("" : "+v"(j));
    const int p0 = (M == 512) ? (tid + (tid >> 4)) : (560 * (tid >> 4) + (tid & 15));
    constexpr int PS = (M == 512) ? 560 : 17;
    float sn, cs; sincospif(2.f * (float)j / (float)(32 * M), &sn, &cs);
    const f32x2 w1 = {cs, sn}; f32x2 w = w1;
    f32x2 v[32];
    v[0] = X[p0];
#pragma unroll
    for (int rp = 1; rp < 32; ++rp) { if (rp < 31) { f32x2 wn_; cmul_chain(X[p0 + PS * rp], w, w1, v[rp], wn_); w = wn_; } else v[rp] = cmul(X[p0 + PS * rp], w); }
    fft_reg<32, true>(v);
#pragma unroll
    for (int p = 0; p < 32; ++p) { if (!HALF || brev(p, 5) < 16) X[p0 + PS * brev(p, 5)] = v[p]; }
}
typedef _Float16 f16x8h __attribute__((ext_vector_type(8)));
__device__ __forceinline__ void pass_c_store(const LAS f32x2* X, f32x2* Hs_, int tid, float scale) {
    _Float16* Hs = (_Float16*)Hs_; (void)scale;
#pragma unroll
    for (int u = 0; u < 2; ++u) { const int blk = tid + 512 * u, p0 = 17 * blk + 16 * (blk >> 5);
        f32x2 v[16];
#pragma unroll
        for (int r = 0; r < 16; ++r) v[r] = X[p0 + r];
        fft_reg<16, false>(v);
#pragma unroll
        for (int q = 0; q < 4; ++q) { f16x8h o;
#pragma unroll
            for (int e = 0; e < 4; ++e) { const f32x2 x = v[brev(4 * q + e, 4)]; o[2 * e] = (_Float16)x[0]; o[2 * e + 1] = (_Float16)x[1]; }
            *(f16x8h*)(Hs + 2 * (16 * blk + 4 * q)) = o; } }
}
__device__ __forceinline__ void pass_c_mul_inv(LAS f32x2* X, const f32x2* Hs_, int tid) {
    const _Float16* Hs = (const _Float16*)Hs_;
#pragma unroll
    for (int u = 0; u < 2; ++u) { const int blk = tid + 512 * u, p0 = 17 * blk + 16 * (blk >> 5);
        f32x2 v[16], w[16];
#pragma unroll
        for (int r = 0; r < 16; ++r) v[r] = X[p0 + r];
        f16x8h hh[4];
#pragma unroll
        for (int q = 0; q < 4; ++q) hh[q] = *(const f16x8h*)(Hs + 2 * (16 * blk + 4 * q));
        fft_reg<16, false>(v);
#pragma unroll
        for (int q = 0; q < 4; ++q)
#pragma unroll
            for (int e = 0; e < 4; ++e) w[4 * q + e] = cmul(v[brev(4 * q + e, 4)], (f32x2){(float)hh[q][2 * e], (float)hh[q][2 * e + 1]});
        fft_reg<16, true>(w);
#pragma unroll
        for (int p = 0; p < 16; ++p) X[p0 + brev(p, 4)] = w[p]; }
}
__device__ __forceinline__ void load16(const bf16_t* u, float (&e)[16]) {
    const u32x4 a = *(const u32x4*)u, b = *(const u32x4*)(u + 8);
    e[0] = bflo(a.x); e[1] = bfhi(a.x); e[2] = bflo(a.y); e[3] = bfhi(a.y); e[4] = bflo(a.z); e[5] = bfhi(a.z); e[6] = bflo(a.w); e[7] = bfhi(a.w);
    e[8] = bflo(b.x); e[9] = bfhi(b.x); e[10] = bflo(b.y); e[11] = bfhi(b.y); e[12] = bflo(b.z); e[13] = bfhi(b.z); e[14] = bflo(b.w); e[15] = bfhi(b.w);
}
__device__ __forceinline__ void sconv16(const bf16_t* u, int tid, float w0, float w1, float w2, float bias, float (&o)[16]) {
    float e[16]; load16(u + 16 * tid, e);
    float lf = __shfl_up(e[15], 1), rt = __shfl_down(e[0], 1);
    if ((tid & 3) == 0) lf = 0.f;
    if ((tid & 3) == 3) rt = 0.f;
    o[0] = w0 * lf + w1 * e[0] + w2 * e[1] + bias;
#pragma unroll
    for (int i = 1; i < 15; ++i) o[i] = w0 * e[i - 1] + w1 * e[i] + w2 * e[i + 1] + bias;
    o[15] = w0 * e[14] + w1 * e[15] + w2 * rt + bias;
}

constexpr int CV_SPLIT = NE * 128 * 20;
constexpr int CV_ITEMS = NE * 128 * 32;
struct CvJob { float v[8]; int mi; };
__device__ __forceinline__ void cv_issue(const Args& a, CvJob& jb, int mi, int lane) {
    jb.mi = mi;
    if (mi >= 0) { const int e = mi >> 12, kg = (mi >> 5) & 127, nb = mi & 31;
        const float* src = a.in[I_EW1] + ((size_t)e * 1024 + 8 * kg) * 2048 + 64 * nb + lane;
#pragma unroll
        for (int i = 0; i < 8; ++i) jb.v[i] = src[(size_t)i * 2048]; }
}
__device__ __forceinline__ void cv_finish(const Args& a, const CvJob& jb, int lane) {
    if (jb.mi >= 0) { const int mi = jb.mi, e = mi >> 12, kg = (mi >> 5) & 127, nb = mi & 31;
        const int cs = 64 * nb + lane, sgl = cs & 1, ac = cs >> 1, ct = ac >> 7, jj = ac & 127;
        unsigned char* dst = (unsigned char*)(a.ws + WS_W1T) + ((size_t)e * 2048 + 256 * ct + 128 * sgl + jj) * 1024 + 8 * kg;
        u32x2 o; o.x = gm::pk4_fp8_nc(jb.v[0] * gm::S_W, jb.v[1] * gm::S_W, jb.v[2] * gm::S_W, jb.v[3] * gm::S_W); o.y = gm::pk4_fp8_nc(jb.v[4] * gm::S_W, jb.v[5] * gm::S_W, jb.v[6] * gm::S_W, jb.v[7] * gm::S_W);
        *(u32x2*)dst = o; }
}
struct CvState { CvJob jb; int next, stride, end; };
__device__ __forceinline__ void cv_step(const Args& a, CvState& st, int lane) {
    cv_finish(a, st.jb, lane);
    const int mi = st.next < st.end ? st.next : -1;
    cv_issue(a, st.jb, mi, lane);
    st.next += st.stride;
}

__device__ __forceinline__ void channel(const Args& a, LAS unsigned char* lds, int c, unsigned char* scratch, CvState& cvs) {
    const int tid = threadIdx.x;
#define CV_STEP() cv_step(a, cvs, tid & 63)
    LAS f32x2* X = (LAS f32x2*)lds;
    f32x2* Hs = (f32x2*)scratch;
    const _Float16* HF = (const _Float16*)(a.ws + WS_HF);
    const int pc = 17 * tid + 16 * (tid >> 5);
    __syncthreads();
#pragma unroll 1
    for (int o = 0; o < 2; ++o) {
        typedef _Float16 f16x8_ __attribute__((ext_vector_type(8)));
        const f16x8_* hf = (const f16x8_*)(HF + ((size_t)(2 * o) * HYW + c) * SEQ + 16 * tid); const f16x8_* hb = (const f16x8_*)(HF + ((size_t)(2 * o + 1) * HYW + c) * SEQ + 16 * tid);
#pragma unroll
        for (int q = 0; q < 2; ++q) { const f16x8_ f = hf[q], b = hb[q];
#pragma unroll
            for (int e = 0; e < 8; ++e) { const int i = 8 * q + e, t = 16 * tid + i;
                X[pc + i] = (f32x2){(float)f[e], 0.f};
                if (t >= 1) X[phys(FFTN - t)] = (f32x2){(float)b[e], 0.f}; } }
        if (tid == 0) X[phys(SEQ)] = (f32x2){0.f, 0.f};
        __syncthreads();
        CV_STEP(); pass_fwd32<512>(X, tid); __syncthreads(); CV_STEP(); pass_fwd32<16>(X, tid); __syncthreads(); pass_c_store(X, Hs + (size_t)o * (FFTN / 2), tid, 1.f); __syncthreads();
    }
    const float* cw = a.in[I_CONVW]; const float* cbv = a.in[I_CONVB]; const float* dbias = a.in[I_BIASD];
    const float d1 = dbias[c], d2 = dbias[HYW + c];
    constexpr float INVN = 1.f / (float)FFTN;
    float wv[3][3], bv[3];
#pragma unroll
    for (int s = 0; s < 3; ++s) { bv[s] = cbv[s * HYW + c];
#pragma unroll
        for (int i = 0; i < 3; ++i) wv[s][i] = cw[i * HYC + s * HYW + c]; }
    const bf16_t* UT = (const bf16_t*)(a.ws + WS_UT);
    bf16_t* YT = (bf16_t*)(a.ws + WS_YHYT);
#pragma unroll 1
    for (int bp = 0; bp < 2; ++bp) {
        const bf16_t* u0 = UT + ((size_t)(2 * bp) * HYC + c) * SEQ; const bf16_t* u1 = UT + ((size_t)(2 * bp + 1) * HYC + c) * SEQ;
        float z0[16], z1[16];
        {
            float v0[16], v1[16]; sconv16(u0, tid, wv[0][0], wv[0][1], wv[0][2], bv[0], v0); sconv16(u1, tid, wv[0][0], wv[0][1], wv[0][2], bv[0], v1);
#pragma unroll
            for (int i = 0; i < 16; ++i) X[pc + i] = (f32x2){v0[i], v1[i]};
        }
        __syncthreads();
        CV_STEP(); pass_fwd32<512, true>(X, tid); __syncthreads(); CV_STEP(); pass_fwd32<16>(X, tid); __syncthreads(); pass_c_mul_inv(X, Hs, tid); __syncthreads(); CV_STEP(); pass_inv32<16>(X, tid); __syncthreads(); CV_STEP(); pass_inv32<512, true>(X, tid); __syncthreads();
        {
            float v0[16], v1[16], x0[16], x1[16];
            sconv16(u0, tid, wv[0][0], wv[0][1], wv[0][2], bv[0], v0); sconv16(u1, tid, wv[0][0], wv[0][1], wv[0][2], bv[0], v1);
            sconv16(u0 + (size_t)HYW * SEQ, tid, wv[1][0], wv[1][1], wv[1][2], bv[1], x0); sconv16(u1 + (size_t)HYW * SEQ, tid, wv[1][0], wv[1][1], wv[1][2], bv[1], x1);
#pragma unroll
            for (int i = 0; i < 16; ++i) { const f32x2 y1 = X[pc + i]; z0[i] = x0[i] * (y1[0] * INVN + d1 * v0[i]); z1[i] = x1[i] * (y1[1] * INVN + d1 * v1[i]); X[pc + i] = (f32x2){z0[i], z1[i]}; }
        }
        __syncthreads();
        CV_STEP(); pass_fwd32<512, true>(X, tid); __syncthreads(); CV_STEP(); pass_fwd32<16>(X, tid); __syncthreads(); pass_c_mul_inv(X, Hs + FFTN / 2, tid); __syncthreads(); CV_STEP(); pass_inv32<16>(X, tid); __syncthreads(); CV_STEP(); pass_inv32<512, true>(X, tid); __syncthreads();
        {
            float x0[16], x1[16];
            sconv16(u0 + (size_t)2 * HYW * SEQ, tid, wv[2][0], wv[2][1], wv[2][2], bv[2], x0); sconv16(u1 + (size_t)2 * HYW * SEQ, tid, wv[2][0], wv[2][1], wv[2][2], bv[2], x1);
            unsigned w0[8], w1[8];
#pragma unroll
            for (int i = 0; i < 8; ++i) { const f32x2 ya = X[pc + 2 * i], yb = X[pc + 2 * i + 1];
                w0[i] = pk2(x0[2 * i] * (ya[0] * INVN + d2 * z0[2 * i]), x0[2 * i + 1] * (yb[0] * INVN + d2 * z0[2 * i + 1]));
                w1[i] = pk2(x1[2 * i] * (ya[1] * INVN + d2 * z1[2 * i]), x1[2 * i + 1] * (yb[1] * INVN + d2 * z1[2 * i + 1])); }
            u32x4* y0p = (u32x4*)(YT + ((size_t)(2 * bp) * HYW + c) * SEQ + 16 * tid); u32x4* y1p = (u32x4*)(YT + ((size_t)(2 * bp + 1) * HYW + c) * SEQ + 16 * tid);
            y0p[0] = (u32x4){w0[0], w0[1], w0[2], w0[3]}; y0p[1] = (u32x4){w0[4], w0[5], w0[6], w0[7]};
            y1p[0] = (u32x4){w1[0], w1[1], w1[2], w1[3]}; y1p[1] = (u32x4){w1[4], w1[5], w1[6], w1[7]};
        }
        __syncthreads();
    }
#undef CV_STEP
}

__device__ __forceinline__ void filter_item(const Args& a, int item, int lane) {
    const int ct = item & 127, tc = item >> 7;
    const float* hid2 = (const float*)(a.ws + WS_HID2); const float* wout = a.in[I_FWOUT]; _Float16* HF = (_Float16*)(a.ws + WS_HF);
    const int col = 16 * ct + (lane & 15), kq = lane >> 4, cch = col & 511;
    typedef _Float16 f16x8f __attribute__((ext_vector_type(8)));
    f16x8f bfr[2];
#pragma unroll
    for (int s = 0; s < 2; ++s)
#pragma unroll
        for (int i = 0; i < 8; ++i) bfr[s][i] = (_Float16)wout[(size_t)(32 * s + 8 * kq + i) * 2048 + col];
    const float dlt = fabsf(-3.0701134573253945f + (float)cch * ((-15.350567286626973f + 3.0701134573253945f) / 511.f));
#pragma unroll 4
    for (int tt = 0; tt < 32; ++tt) { const int t0 = 512 * tc + 16 * tt;
        const f32x4* ar = (const f32x4*)(hid2 + (size_t)(t0 + (lane & 15)) * 64 + 8 * kq);
        const f32x4 a0 = ar[0], a1 = ar[1], a2 = ar[8], a3 = ar[9];
        const f16x8f af0 = {(_Float16)a0[0], (_Float16)a0[1], (_Float16)a0[2], (_Float16)a0[3], (_Float16)a1[0], (_Float16)a1[1], (_Float16)a1[2], (_Float16)a1[3]};
        const f16x8f af1 = {(_Float16)a2[0], (_Float16)a2[1], (_Float16)a2[2], (_Float16)a2[3], (_Float16)a3[0], (_Float16)a3[1], (_Float16)a3[2], (_Float16)a3[3]};
        f32x4 acc = {0.f, 0.f, 0.f, 0.f};
        acc = __builtin_amdgcn_mfma_f32_16x16x32_f16(af0, bfr[0], acc, 0, 0, 0);
        acc = __builtin_amdgcn_mfma_f32_16x16x32_f16(af1, bfr[1], acc, 0, 0, 0);
        f32x4 o;
#pragma unroll
        for (int r = 0; r < 4; ++r) o[r] = acc[r] * __expf(-((float)(t0 + 4 * kq + r) / (float)(SEQ - 1)) * dlt);
        typedef _Float16 f16x4_ __attribute__((ext_vector_type(4)));
        *(f16x4_*)(HF + (size_t)col * SEQ + t0 + 4 * kq) = (f16x4_){(_Float16)o[0], (_Float16)o[1], (_Float16)o[2], (_Float16)o[3]}; }
}

__device__ __forceinline__ void transpose_item(const Args& a, int item, int lane) {
    const int lt = item & 127, ct = (item >> 7) & 7, b = item >> 10;
    const bf16_t* src = (const bf16_t*)(a.ws + WS_YHYT) + ((size_t)b * HYW + 64 * ct) * SEQ + 64 * lt + lane;
    bf16_t* dst = (bf16_t*)(a.ws + WS_MIX) + ((size_t)b * SEQ + 64 * lt + lane) * 1024 + 512 + 64 * ct;
    unsigned short v[64];
#pragma unroll
    for (int cc = 0; cc < 64; ++cc) v[cc] = src[(size_t)cc * SEQ];
#pragma unroll
    for (int q = 0; q < 8; ++q)
        *(u32x4*)(dst + 8 * q) = (u32x4){(unsigned)v[8 * q] | ((unsigned)v[8 * q + 1] << 16), (unsigned)v[8 * q + 2] | ((unsigned)v[8 * q + 3] << 16),
                                         (unsigned)v[8 * q + 4] | ((unsigned)v[8 * q + 5] << 16), (unsigned)v[8 * q + 6] | ((unsigned)v[8 * q + 7] << 16)};
}
}

__device__ __forceinline__ void p0_mod_and_filter(const Args& a, LAS unsigned char* lds) {
    const int tid = threadIdx.x, lane = tid & 63, wave = tid >> 6;
    const float* c = a.in[I_C]; const float* cctx = a.in[I_CCTX]; const float* adaw = a.in[I_ADAW]; const float* adab = a.in[I_ADAB];
    float* mod = (float*)(a.ws + WS_MOD);
    LAS float* sl = (LAS float*)lds;
    LAS float* pt = (LAS float*)lds + 5 * 1024;
    for (int i = tid; i < 5 * 1024; i += NTHREADS) { const int r = i >> 10, k = i & 1023; sl[i] = silu_f(r < 4 ? c[r * 1024 + k] : cctx[k]); }
    for (int it = blockIdx.x; it < 256; it += gridDim.x) {
        __syncthreads();
        if (tid < 504) {
            const int col = tid % 24, ks = tid / 24, n = it * 24 + col, kbeg = ks * 49, kend = (kbeg + 49 < 1024) ? kbeg + 49 : 1024;
            float acc[5] = {0.f, 0.f, 0.f, 0.f, 0.f};
#pragma unroll 7
            for (int k = kbeg; k < kend; ++k) { const float w = adaw[(size_t)k * 6144 + n];
#pragma unroll
                for (int r = 0; r < 5; ++r) acc[r] += sl[r * 1024 + k] * w; }
#pragma unroll
            for (int r = 0; r < 5; ++r) pt[(ks * 5 + r) * 24 + col] = acc[r];
        }
        __syncthreads();
        if (tid < 120) { const int r = tid / 24, col = tid % 24, n = it * 24 + col; float s = adab[n];
            for (int ks = 0; ks < 21; ++ks) s += pt[(ks * 5 + r) * 24 + col];
            mod[r * 6144 + n] = s; }
    }
    __syncthreads();
    const float* w1 = a.in[I_FW1]; const float* b1 = a.in[I_FB1]; const float* w2 = a.in[I_FW2]; const float* b2 = a.in[I_FB2]; const float* fq = a.in[I_FFREQ];
    float* hid2 = (float*)(a.ws + WS_HID2);
    LAS float* zs = (LAS float*)lds + 8192 + wave * 128;
    const float frq = fq[lane], bb1 = b1[lane], bb2 = b2[lane];
    for (int t = (blockIdx.x * NWAVES + wave); t < SEQ; t += gridDim.x * NWAVES) {
        float z = 0.f;
        if (lane == 0) z = (float)t / (float)(SEQ - 1);
        else if (lane < 33) { const int i = (lane - 1) & 15; const float f = 1e-4f + (float)i * ((15.f - 1e-4f) / 15.f);
            const float ang = (6.283185307179586f * (float)t / (float)SEQ) * f; z = (lane < 17) ? cosf(ang) : -sinf(ang); }
        if (lane < 33) zs[lane] = z;
        __builtin_amdgcn_wave_barrier(); asm volatile("s_waitcnt lgkmcnt(0)" ::: "memory");
        float s = bb1;
#pragma unroll
        for (int e = 0; e < 33; ++e) s += zs[e] * w1[e * 64 + lane];
        const float h1 = sinf(frq * s);
        zs[64 + lane] = h1;
        __builtin_amdgcn_wave_barrier(); asm volatile("s_waitcnt lgkmcnt(0)" ::: "memory");
        float s2 = bb2;
#pragma unroll 16
        for (int g = 0; g < 64; ++g) s2 += zs[64 + g] * w2[g * 64 + lane];
        hid2[(size_t)t * 64 + lane] = sinf(frq * s2);
        __builtin_amdgcn_wave_barrier(); asm volatile("s_waitcnt lgkmcnt(0)" ::: "memory");
    }
}

template <bool FP8 = false>
__device__ __forceinline__ void tr_item(const float* W, int ldw, int k0, int c0, int cstride, float scale, bf16_t* dstrow0, LAS float* scr, int lane) {
    float wv_[32];
#pragma unroll
    for (int i = 0; i < 32; ++i) wv_[i] = W[(size_t)(k0 + 2 * i + (lane >> 5)) * ldw + c0 + (lane & 31) * cstride];
#pragma unroll
    for (int i = 0; i < 32; ++i) scr[(2 * i + (lane >> 5)) * 33 + (lane & 31)] = wv_[i] * scale;
    asm volatile("s_waitcnt lgkmcnt(0)" ::: "memory"); __builtin_amdgcn_wave_barrier();
    const int c = lane & 7;
#pragma unroll
    for (int j = 0; j < 4; ++j) { const int n = (lane >> 3) + 8 * j; const LAS float* s = scr + (8 * c) * 33 + n;
        if (FP8) { u32x2 o; o.x = gm::pk4_fp8(s[0 * 33], s[1 * 33], s[2 * 33], s[3 * 33]); o.y = gm::pk4_fp8(s[4 * 33], s[5 * 33], s[6 * 33], s[7 * 33]);
            *(u32x2*)((unsigned char*)dstrow0 + (size_t)n * 1024 + k0 + 8 * c) = o; }
        else { u32x4 o; o.x = pk2(s[0 * 33], s[1 * 33]); o.y = pk2(s[2 * 33], s[3 * 33]); o.z = pk2(s[4 * 33], s[5 * 33]); o.w = pk2(s[6 * 33], s[7 * 33]);
            *(u32x4*)(dstrow0 + (size_t)n * 1024 + k0 + 8 * c) = o; } }
    asm volatile("s_waitcnt lgkmcnt(0)" ::: "memory"); __builtin_amdgcn_wave_barrier();
}
__device__ __forceinline__ void fold_item(const float* win, const float* wa, int dir, int k0, int j0, bf16_t* dstrow0, LAS float* scr, int lane) {
#pragma unroll 4
    for (int i = 0; i < 32; ++i) { const int kk = 2 * i + (lane >> 5); const float* wr = win + (size_t)(k0 + kk) * INW + 1536 + 16 * dir; float s = 0.f;
#pragma unroll
        for (int r = 0; r < 16; ++r) s += wr[r] * wa[r * 256 + j0 + (lane & 31)];
        scr[kk * 33 + (lane & 31)] = s; }
    asm volatile("s_waitcnt lgkmcnt(0)" ::: "memory"); __builtin_amdgcn_wave_barrier();
    const int c = lane & 7;
#pragma unroll
    for (int j = 0; j < 4; ++j) { const int n = (lane >> 3) + 8 * j; const LAS float* s = scr + (8 * c) * 33 + n;
        u32x4 o; o.x = pk2(s[0 * 33], s[1 * 33]); o.y = pk2(s[2 * 33], s[3 * 33]); o.z = pk2(s[4 * 33], s[5 * 33]); o.w = pk2(s[6 * 33], s[7 * 33]);
        *(u32x4*)(dstrow0 + (size_t)n * 1024 + k0 + 8 * c) = o; }
    asm volatile("s_waitcnt lgkmcnt(0)" ::: "memory"); __builtin_amdgcn_wave_barrier();
}
__device__ __forceinline__ void ln_mod_row(const float* xrow, const float* shift, const float* scale, bf16_t* orow, int lane) {
    const f32x4* xr = (const f32x4*)xrow + lane;
    f32x4 v[4]; float s = 0.f;
#pragma unroll
    for (int j = 0; j < 4; ++j) { v[j] = xr[64 * j]; s += (v[j][0] + v[j][1]) + (v[j][2] + v[j][3]); }
    const float mean = wave_sum(s) * (1.f / D); float s2 = 0.f;
#pragma unroll
    for (int j = 0; j < 4; ++j) { v[j] = v[j] - mean; s2 += (v[j][0] * v[j][0] + v[j][1] * v[j][1]) + (v[j][2] * v[j][2] + v[j][3] * v[j][3]); }
    const float rstd = 1.f / sqrtf(wave_sum(s2) * (1.f / D) + LN_EPS);
    u32x2* o8 = (u32x2*)orow + lane;
#pragma unroll
    for (int j = 0; j < 4; ++j) { const f32x4 sh = ((const f32x4*)shift)[64 * j + lane], sc = ((const f32x4*)scale)[64 * j + lane];
        const f32x4 y = v[j] * rstd * (sc + 1.f) + sh;
        u32x2 w; w.x = pk2(y[0], y[1]); w.y = pk2(y[2], y[3]); o8[64 * j] = w; }
}
constexpr int PREP_I_IN = 16 * 96, PREP_I_FOLD = 16 * 8 * 2, PREP_I_OUT = 16 * 32, PREP_I_W1 = NE * 16 * 64, PREP_I_W2 = NE * 16 * 32;
constexpr int PREP_NITEMS = PREP_I_IN + PREP_I_FOLD + PREP_I_OUT + PREP_I_W1 + PREP_I_W2;
constexpr int PREP_DEFER = 10880;
__device__ __forceinline__ void prep_items(const Args& a, LAS float* scr, int first, int last, int rank, int nranks, int lane) {
    constexpr int I_IN = PREP_I_IN, I_FOLD = PREP_I_FOLD, I_OUT = PREP_I_OUT, I_W1 = PREP_I_W1;
    const float* win = a.in[I_WIN];
    bf16_t* btin = (bf16_t*)(a.ws + WS_BTIN); bf16_t* btout = (bf16_t*)(a.ws + WS_BTOUT); bf16_t* w1t = (bf16_t*)(a.ws + WS_W1T); bf16_t* w2t = (bf16_t*)(a.ws + WS_W2T);
    for (int it = first + rank; it < last; it += nranks) {
        int r = it;
        if (r < I_IN) {
            const int kb = r / 96, nb = r % 96;
            if (nb < 48) tr_item(win, INW, 64 * kb, 32 * nb, 1, nb < 8 ? 0.125f : 1.f, btin + (size_t)(32 * nb) * 1024, scr, lane);
            else tr_item(win, INW, 64 * kb, 1568 + 32 * (nb - 48), 1, 1.f, btin + (size_t)(2048 + 32 * (nb - 48)) * 1024, scr, lane);
            continue; }
        r -= I_IN;
        if (r < I_FOLD) { const int dir = r & 1, jb = (r >> 1) & 7, kb = r >> 4;
            fold_item(win, dir ? a.in[I_WAB] : a.in[I_WAF], dir, 64 * kb, 32 * jb, btin + (size_t)(1536 + 256 * dir + 32 * jb) * 1024, scr, lane); continue; }
        r -= I_FOLD;
        if (r < I_OUT) { const int kb = r / 32, nb = r % 32; tr_item(a.in[I_WOUT], 1024, 64 * kb, 32 * nb, 1, 1.f, btout + (size_t)(32 * nb) * 1024, scr, lane); continue; }
        r -= I_OUT;
        if (r < I_W1) {
            const int e = r / 1024, q = r % 1024, s = q & 1, nb = (q >> 1) & 31, kb = q >> 6;
            const int ct = nb >> 2, jj0 = (nb & 3) * 32;
            tr_item<true>(a.in[I_EW1] + (size_t)e * 1024 * 2048, 2048, 64 * kb, 2 * (128 * ct + jj0) + s, 2, gm::S_W, (bf16_t*)((unsigned char*)w1t + ((size_t)e * 2048 + 256 * ct + 128 * s + jj0) * 1024), scr, lane);
            continue; }
        r -= I_W1;
        { const int e = r / 512, q = r % 512, kb = q / 32, nb = q % 32;
          tr_item<true>(a.in[I_EW2] + (size_t)e * 1024 * 1024, 1024, 64 * kb, 32 * nb, 1, gm::S_W, (bf16_t*)((unsigned char*)w2t + ((size_t)e * 1024 + 32 * nb) * 1024), scr, lane); }
    }
}
__device__ __forceinline__ void p1_prep(const Args& a, LAS unsigned char* lds) {
    const int tid = threadIdx.x, lane = tid & 63, wave = tid >> 6;
    LAS float* scr = (LAS float*)(lds + wave * 16384);
    const int gw = blockIdx.x * NWAVES + wave, NGW = gridDim.x * NWAVES;
    const float* win = a.in[I_WIN];
    bf16_t* btin = (bf16_t*)(a.ws + WS_BTIN); bf16_t* btout = (bf16_t*)(a.ws + WS_BTOUT); bf16_t* w1t = (bf16_t*)(a.ws + WS_W1T); bf16_t* w2t = (bf16_t*)(a.ws + WS_W2T);
    const float* mod = (const float*)(a.ws + WS_MOD);
    bf16_t* H = (bf16_t*)(a.ws + WS_H);
#pragma unroll 2
    for (int row = gw; row < TT; row += NGW) {
        const float* xr; int mr;
        if (row < T) { xr = a.in[I_X] + (size_t)row * D; mr = row >> 13; } else { xr = a.in[I_CTX] + (size_t)(row - T) * D; mr = 4; }
        ln_mod_row(xr, mod + mr * 6144, mod + mr * 6144 + 1024, H + (size_t)row * D, lane);
    }
    prep_items(a, scr, 0, PREP_I_IN + PREP_I_FOLD + PREP_I_OUT, gw, NGW, lane);
    prep_items(a, scr, PREP_I_IN + PREP_I_FOLD + PREP_I_OUT + PREP_I_W1, PREP_NITEMS - PREP_DEFER, gw, NGW, lane);
    for (int it = gw; it < 2048; it += NGW) hy::filter_item(a, it, lane);
    float* b1r = (float*)(a.ws + WS_B1R); const float* eb1 = a.in[I_EB1];
    for (int i = blockIdx.x * NTHREADS + tid; i < NE * 2048; i += gridDim.x * NTHREADS) {
        const int e = i >> 11, n = i & 2047, ct = n >> 8, s = (n >> 7) & 1, jj = n & 127;
        b1r[i] = eb1[(size_t)e * 2048 + 2 * (128 * ct + jj) + s];
    }
}

namespace gla {
constexpr int RS = 72;
constexpr int L_TOTF = 0, L_TOTB = 2048, L_SSQ = 4096;
constexpr int L_T0 = 8192;
constexpr int L_T1 = L_T0 + 9216, L_T2 = L_T1 + 9216, L_T3 = L_T2 + 9216;
constexpr int L_VT = L_T3 + 9216;
constexpr int L_P  = L_VT + 18432;
constexpr int L_SF = L_P + 9216, L_SB = L_SF + 18432;
constexpr int L_END = L_SB + 18432;

__device__ __forceinline__ bf16x8 frag(const LAS unsigned char* tile, int row, int k0, int lane) {
    return *(const LAS bf16x8*)(tile + ((row + (lane & 15)) * RS + k0 + 8 * (lane >> 4)) * 2);
}
__device__ __forceinline__ void chunk_cums_pre(LAS unsigned char* L, const float (&gf)[8], const float (&gb)[8], int wave, int lane, float (&cumf)[8], float (&cumb)[8], float& allf, float& allb) {
    LAS float* totf = (LAS float*)(L + L_TOTF); LAS float* totb = (LAS float*)(L + L_TOTB);
    cumf[0] = gf[0];
#pragma unroll
    for (int r = 1; r < 8; ++r) cumf[r] = cumf[r - 1] + gf[r];
    cumb[7] = gb[7];
#pragma unroll
    for (int r = 6; r >= 0; --r) cumb[r] = cumb[r + 1] + gb[r];
    totf[wave * 64 + lane] = cumf[7]; totb[wave * 64 + lane] = cumb[0];
    __syncthreads();
    float of = 0.f, ob = 0.f, af = 0.f, ab = 0.f;
#pragma unroll
    for (int w = 0; w < 8; ++w) { const float tf = totf[w * 64 + lane], tb = totb[w * 64 + lane]; af += tf; ab += tb; of += (w < wave) ? tf : 0.f; ob += (w > wave) ? tb : 0.f; }
#pragma unroll
    for (int r = 0; r < 8; ++r) { cumf[r] += of; cumb[r] += ob; }
    allf = af; allb = ab;
}
__device__ __forceinline__ void chunk_cums(LAS unsigned char* L, const _Float16* GF, const _Float16* GB, size_t tok0, int h, int wave, int lane, float (&cumf)[8], float (&cumb)[8], float& allf, float& allb) {
    float gf[8], gb[8];
#pragma unroll
    for (int r = 0; r < 8; ++r) { const size_t o = (tok0 + 8 * wave + r) * 256 + h * 64 + lane; gf[r] = (float)GF[o]; gb[r] = (float)GB[o]; }
    chunk_cums_pre(L, gf, gb, wave, lane, cumf, cumb, allf, allb);
}
__device__ __forceinline__ void store_vt(LAS unsigned char* L, const u32x4 (&vr)[2], int tid) {
    LAS bf16_t* vt = (LAS bf16_t*)(L + L_VT);
    const int j = tid >> 3, c8 = tid & 7;
#pragma unroll
    for (int q = 0; q < 2; ++q) { const int dv0 = 8 * (c8 + 8 * q);
        const unsigned ww[4] = {vr[q].x, vr[q].y, vr[q].z, vr[q].w};
#pragma unroll
        for (int e = 0; e < 4; ++e) { vt[(dv0 + 2 * e) * RS + j] = (bf16_t)(ww[e] & 0xffffu); vt[(dv0 + 2 * e + 1) * RS + j] = (bf16_t)(ww[e] >> 16); } }
}
__device__ __forceinline__ void load_vt(LAS unsigned char* L, const bf16_t* V, size_t tok0, int h, int tid) {
    const int j = tid >> 3, c8 = tid & 7; u32x4 vr[2];
#pragma unroll
    for (int q = 0; q < 2; ++q) vr[q] = *(const u32x4*)(V + (tok0 + j) * 512 + h * 128 + 8 * (c8 + 8 * q));
    store_vt(L, vr, tid);
}

__device__ __forceinline__ void g1_unit(const Args& a, LAS unsigned char* L, int bh, int chunk  ) {
    const int tid = threadIdx.x, lane = tid & 63, wave = __builtin_amdgcn_readfirstlane(tid >> 6);
    const int b = bh >> 2, h = bh & 3;
    const size_t tok0 = chunk < NCHUNK ? (size_t)b * SEQ + (size_t)chunk * CH : (size_t)T + (size_t)b * CTXL + (size_t)(chunk - NCHUNK) * CH;
    const _Float16* GF = (const _Float16*)(a.ws + WS_GF); const _Float16* GB = (const _Float16*)(a.ws + WS_GB);
    const bf16_t* Kb = (const bf16_t*)(a.ws + WS_K); const bf16_t* Vb = (const bf16_t*)(a.ws + WS_V);
    float cumf[8], cumb[8], allf, allb;
    __syncthreads();
    chunk_cums(L, GF, GB, tok0, h, wave, lane, cumf, cumb, allf, allb);
    LAS bf16_t* ketf = (LAS bf16_t*)(L + L_T0); LAS bf16_t* ketb = (LAS bf16_t*)(L + L_T1);
#pragma unroll
    for (int r = 0; r < 8; ++r) { const int i = 8 * wave + r; const float kv = bf2f(Kb[(tok0 + i) * 256 + h * 64 + lane]);
        ketf[lane * RS + i] = f2bf(kv * __expf(allf - cumf[r])); ketb[lane * RS + i] = f2bf(kv * __expf(allb - cumb[r])); }
    load_vt(L, Vb, tok0, h, tid);
    if (wave == 0) { float* av = (float*)(a.ws + WS_AV); av[((size_t)(0 * 16 + bh) * NCT + chunk) * 64 + lane] = __expf(allf); av[((size_t)(1 * 16 + bh) * NCT + chunk) * 64 + lane] = __expf(allb); }
    __syncthreads();
    bf16_t* KV = (bf16_t*)(a.ws + WS_KV);
#pragma unroll
    for (int dir = 0; dir < 2; ++dir) {
        const LAS unsigned char* ket = L + (dir ? L_T1 : L_T0);
        bf16_t* dst = KV + ((size_t)(dir * 16 + bh) * NCT + chunk) * 8192;
#pragma unroll
        for (int nt = 0; nt < 4; ++nt) { f32x4 acc = {0.f, 0.f, 0.f, 0.f};
#pragma unroll
            for (int ks = 0; ks < 2; ++ks) acc = __builtin_amdgcn_mfma_f32_16x16x32_bf16(frag(L + L_VT, 16 * wave, 32 * ks, lane), frag(ket, 16 * nt, 32 * ks, lane), acc, 0, 0, 0);
#pragma unroll
            for (int r = 0; r < 4; ++r) dst[(16 * wave + 4 * (lane >> 4) + r) * 64 + 16 * nt + (lane & 15)] = f2bf(acc[r]); }
    }
}

__device__ __forceinline__ void g2_scan(const Args& a) {
    const bf16_t* KV = (const bf16_t*)(a.ws + WS_KV); const float* AV = (const float*)(a.ws + WS_AV); bf16_t* SP = (bf16_t*)(a.ws + WS_SP);
    for (int id = blockIdx.x * NTHREADS + threadIdx.x; id < 32 * 4096; id += gridDim.x * NTHREADS) {
        const int db = id >> 12, e2 = id & 4095, dir = db >> 4, dk = (2 * e2) & 63;
        const unsigned* kv = (const unsigned*)(KV + (size_t)db * NCT * 8192) + e2;
        const float* av = AV + (size_t)db * NCT * 64 + dk;
        unsigned* sp = (unsigned*)(SP + (size_t)db * NCHUNK * 8192) + e2;
        float s0 = 0.f, s1 = 0.f;
#pragma unroll
        for (int q = 0; q < NCC; ++q) { const int c = NCHUNK + (dir ? (NCC - 1 - q) : q);
            const unsigned w = kv[(size_t)c * 4096]; const f32x2 aa = *(const f32x2*)(av + (size_t)c * 64);
            s0 = aa[0] * s0 + bflo(w); s1 = aa[1] * s1 + bfhi(w); }
        for (int q0 = 0; q0 < NCHUNK; q0 += 16) {
            unsigned w[16]; f32x2 aa[16];
#pragma unroll
            for (int u = 0; u < 16; ++u) { const int c = dir ? (NCHUNK - 1 - (q0 + u)) : (q0 + u); w[u] = kv[(size_t)c * 4096]; aa[u] = *(const f32x2*)(av + (size_t)c * 64); }
#pragma unroll
            for (int u = 0; u < 16; ++u) { const int c = dir ? (NCHUNK - 1 - (q0 + u)) : (q0 + u);
                sp[(size_t)c * 4096] = pk2(s0, s1);
                s0 = aa[u][0] * s0 + bflo(w[u]); s1 = aa[u][1] * s1 + bfhi(w[u]); }
        }
    }
}

struct G3In { float gf[8], gb[8]; bf16_t q[8], k[8]; u32x4 v[2]; u32x4 sraw[4]; bf16_t gr[4][4]; };
__device__ __forceinline__ void g3_load(const Args& a, int bh, int chunk, G3In& in) {
    const int tid = threadIdx.x, lane = tid & 63, wave = __builtin_amdgcn_readfirstlane(tid >> 6);
    const int b = bh >> 2, h = bh & 3;
    const size_t tok0 = (size_t)b * SEQ + (size_t)chunk * CH;
    const _Float16* GF = (const _Float16*)(a.ws + WS_GF); const _Float16* GB = (const _Float16*)(a.ws + WS_GB);
    const bf16_t* Qb = (const bf16_t*)(a.ws + WS_Q); const bf16_t* Kb = (const bf16_t*)(a.ws + WS_K); const bf16_t* Vb = (const bf16_t*)(a.ws + WS_V);
#pragma unroll
    for (int r = 0; r < 8; ++r) { const size_t o = (tok0 + 8 * wave + r) * 256 + h * 64 + lane; in.gf[r] = (float)GF[o]; in.gb[r] = (float)GB[o]; in.q[r] = Qb[o]; in.k[r] = Kb[o]; }
#pragma unroll
    for (int q = 0; q < 2; ++q) in.v[q] = *(const u32x4*)(Vb + (tok0 + (tid >> 3)) * 512 + h * 128 + 8 * ((tid & 7) + 8 * q));
    const bf16_t* SPf = (const bf16_t*)(a.ws + WS_SP) + ((size_t)(0 * 16 + bh) * NCHUNK + chunk) * 8192;
    const bf16_t* SPb = (const bf16_t*)(a.ws + WS_SP) + ((size_t)(1 * 16 + bh) * NCHUNK + chunk) * 8192;
    in.sraw[0] = *(const u32x4*)(SPf + 16 * tid); in.sraw[1] = *(const u32x4*)(SPf + 16 * tid + 8);
    in.sraw[2] = *(const u32x4*)(SPb + 16 * tid); in.sraw[3] = *(const u32x4*)(SPb + 16 * tid + 8);
    const bf16_t* Gt = (const bf16_t*)(a.ws + WS_G);
    const int mt = wave >> 1, fr = lane & 15, fq = lane >> 4;
#pragma unroll
    for (int q = 0; q < 4; ++q)
#pragma unroll
        for (int r = 0; r < 4; ++r) in.gr[r][q] = Gt[(tok0 + 16 * mt + 4 * fq + r) * 512 + h * 128 + 16 * (4 * (wave & 1) + q) + fr];
}
__device__ __forceinline__ void g3_unit(const Args& a, LAS unsigned char* L, int bh, int chunk  , const G3In& in, hy::CvState& cvs) {
    const int tid = threadIdx.x, lane = tid & 63, wave = __builtin_amdgcn_readfirstlane(tid >> 6);
    const int b = bh >> 2, h = bh & 3;
    const size_t tok0 = (size_t)b * SEQ + (size_t)chunk * CH;
    const int mt = wave >> 1, fr = lane & 15, fq = lane >> 4;
    float cumf[8], cumb[8], allf, allb;
    hy::cv_step(a, cvs, lane);
    __syncthreads();
    chunk_cums_pre(L, in.gf, in.gb, wave, lane, cumf, cumb, allf, allb);
    LAS bf16_t* qf = (LAS bf16_t*)(L + L_T0); LAS bf16_t* kf = (LAS bf16_t*)(L + L_T1); LAS bf16_t* qb = (LAS bf16_t*)(L + L_T2); LAS bf16_t* kb = (LAS bf16_t*)(L + L_T3);
#pragma unroll
    for (int r = 0; r < 8; ++r) { const int i = 8 * wave + r;
        const float qv = bf2f(in.q[r]), kv = bf2f(in.k[r]);
        qf[i * RS + lane] = f2bf(qv * __expf(cumf[r])); kf[i * RS + lane] = f2bf(kv * __expf(-cumf[r]));
        qb[i * RS + lane] = f2bf(qv * __expf(cumb[r])); kb[i * RS + lane] = f2bf(kv * __expf(-cumb[r])); }
    store_vt(L, in.v, tid);
    {
      LAS unsigned char* sf_ = L + L_SF + ((tid >> 2) * RS + 16 * (tid & 3)) * 2; LAS unsigned char* sb_ = L + L_SB + ((tid >> 2) * RS + 16 * (tid & 3)) * 2;
      *(LAS u32x4*)sf_ = in.sraw[0]; *(LAS u32x4*)(sf_ + 16) = in.sraw[1]; *(LAS u32x4*)sb_ = in.sraw[2]; *(LAS u32x4*)(sb_ + 16) = in.sraw[3]; }
    hy::cv_step(a, cvs, lane);
    __syncthreads();
    {
        LAS bf16_t* P = (LAS bf16_t*)(L + L_P);
#pragma unroll
        for (int q = 0; q < 2; ++q) { const int nt = 2 * (wave & 1) + q;
            f32x4 sf = {0.f, 0.f, 0.f, 0.f}, sb = {0.f, 0.f, 0.f, 0.f};
#pragma unroll
            for (int ks = 0; ks < 2; ++ks) {
                sf = __builtin_amdgcn_mfma_f32_16x16x32_bf16(frag(L + L_T0, 16 * mt, 32 * ks, lane), frag(L + L_T1, 16 * nt, 32 * ks, lane), sf, 0, 0, 0);
                sb = __builtin_amdgcn_mfma_f32_16x16x32_bf16(frag(L + L_T2, 16 * mt, 32 * ks, lane), frag(L + L_T3, 16 * nt, 32 * ks, lane), sb, 0, 0, 0); }
#pragma unroll
            for (int r = 0; r < 4; ++r) { const int i = 16 * mt + 4 * fq + r, j = 16 * nt + fr;
                P[i * RS + j] = f2bf((j <= i ? sf[r] : 0.f) + (j >= i ? sb[r] : 0.f)); } }
    }
    hy::cv_step(a, cvs, lane);
    __syncthreads();
    f32x4 o[4]; float ssq[4] = {0.f, 0.f, 0.f, 0.f};
#pragma unroll
    for (int q = 0; q < 4; ++q) { const int nt = 4 * (wave & 1) + q;
        f32x4 acc = {0.f, 0.f, 0.f, 0.f};
#pragma unroll
        for (int ks = 0; ks < 2; ++ks) {
            acc = __builtin_amdgcn_mfma_f32_16x16x32_bf16(frag(L + L_P, 16 * mt, 32 * ks, lane), frag(L + L_VT, 16 * nt, 32 * ks, lane), acc, 0, 0, 0);
            acc = __builtin_amdgcn_mfma_f32_16x16x32_bf16(frag(L + L_T0, 16 * mt, 32 * ks, lane), frag(L + L_SF, 16 * nt, 32 * ks, lane), acc, 0, 0, 0);
            acc = __builtin_amdgcn_mfma_f32_16x16x32_bf16(frag(L + L_T2, 16 * mt, 32 * ks, lane), frag(L + L_SB, 16 * nt, 32 * ks, lane), acc, 0, 0, 0); }
        o[q] = acc;
#pragma unroll
        for (int r = 0; r < 4; ++r) ssq[r] += acc[r] * acc[r]; }
    LAS float* SSQ = (LAS float*)(L + L_SSQ);
#pragma unroll
    for (int r = 0; r < 4; ++r) { float s = ssq[r]; s += __shfl_xor(s, 1); s += __shfl_xor(s, 2); s += __shfl_xor(s, 4); s += __shfl_xor(s, 8); ssq[r] = s; }
    if (fr == 0) {
#pragma unroll
        for (int r = 0; r < 4; ++r) SSQ[(wave & 1) * 64 + 16 * mt + 4 * fq + r] = ssq[r]; }
    hy::cv_step(a, cvs, lane);
    __syncthreads();
    const float* ng = a.in[I_NORMG];
    bf16_t* mix = (bf16_t*)(a.ws + WS_MIX);
#pragma unroll
    for (int r = 0; r < 4; ++r) { const int i = 16 * mt + 4 * fq + r;
        const float rstd = 1.f / sqrtf((SSQ[i] + SSQ[64 + i]) * (1.f / DV) + LN_EPS);
#pragma unroll
        for (int q = 0; q < 4; ++q) { const int dv = 16 * (4 * (wave & 1) + q) + fr;
            const float g = bf2f(in.gr[r][q]);
            mix[(tok0 + i) * 1024 + h * 128 + dv] = f2bf(o[q][r] * rstd * ng[dv] * silu_f(g)); } }
}
}

namespace rt {
constexpr int HS = 1028;
constexpr int L_H2 = 0;
constexpr int L_PART = 65792;
constexpr int L_LCNT = L_PART + 16384;
constexpr int L_REC = L_LCNT + 256;

__device__ __forceinline__ void phase(const Args& a, LAS unsigned char* lds) {
    const int tid = threadIdx.x, lane = tid & 63, wave = __builtin_amdgcn_readfirstlane(tid >> 6);
    bf16_t* xmid = (bf16_t*)(a.ws + WS_PRE1); bf16_t* H2 = (bf16_t*)(a.ws + WS_H2); const bf16_t* FG = (const bf16_t*)(a.ws + WS_FG);
    const float* mod = (const float*)(a.ws + WS_MOD);
    const float* rw = a.in[I_RW]; const float* rb = a.in[I_RB];
    LAS float* h2s = (LAS float*)(lds + L_H2); LAS float* part = (LAS float*)(lds + L_PART);
    LAS int* lcnt = (LAS int*)(lds + L_LCNT); LAS int* lbase = lcnt + 32; LAS int* rec = (LAS int*)(lds + L_REC);
    unsigned* cnt = (unsigned*)(a.ws + WS_CNT); int* list = (int*)(a.ws + WS_LIST); float* pw = (float*)(a.ws + WS_PW); int* ploc = (int*)(a.ws + WS_PLOC);
    float rwr[32][2];
#pragma unroll
    for (int s = 0; s < 32; ++s)
#pragma unroll
        for (int nt = 0; nt < 2; ++nt) rwr[s][nt] = rw[(size_t)(128 * wave + 4 * s + (lane >> 4)) * 32 + 16 * nt + (lane & 15)];
    const f32x4* g1 = (const f32x4*)a.in[I_LN1G]; const f32x4* bb1 = (const f32x4*)a.in[I_LN1B];
    if (tid < 32) lcnt[tid] = 0;
    f32x4 xq[2][4]; u32x2 fq_[2][4];
#define RT_LOAD(g_) do { _Pragma("unroll") for (int rr = 0; rr < 2; ++rr) { const int t_ = (g_) * 16 + 2 * wave + rr; \
        const f32x4* xr_ = (const f32x4*)(a.in[I_X] + (size_t)t_ * D) + lane; const u32x2* fr_ = (const u32x2*)(FG + (size_t)t_ * D) + lane; \
        _Pragma("unroll") for (int j = 0; j < 4; ++j) { xq[rr][j] = xr_[64 * j]; fq_[rr][j] = fr_[64 * j]; } } } while (0)
    if ((int)blockIdx.x < T / 16) RT_LOAD((int)blockIdx.x);
    for (int grp = blockIdx.x; grp < T / 16; grp += gridDim.x) {
        __syncthreads();
        f32x4 xv_[2][4]; u32x2 fv_[2][4];
#pragma unroll
        for (int rr = 0; rr < 2; ++rr)
#pragma unroll
            for (int j = 0; j < 4; ++j) { xv_[rr][j] = xq[rr][j]; fv_[rr][j] = fq_[rr][j]; }
        if (grp + (int)gridDim.x < T / 16) RT_LOAD(grp + (int)gridDim.x);
#pragma unroll
        for (int rr = 0; rr < 2; ++rr) {
            const int lr = 2 * wave + rr, t = grp * 16 + lr, b = t >> 13;
            u32x2* pr = (u32x2*)(xmid + (size_t)t * D) + lane;
            f32x4 v[4]; float s = 0.f;
#pragma unroll
            for (int j = 0; j < 4; ++j) { const u32x2 fw = fv_[rr][j]; const f32x4 ff = {bflo(fw.x), bfhi(fw.x), bflo(fw.y), bfhi(fw.y)};
                v[j] = xv_[rr][j] * ALPHA + ff; s += (v[j][0] + v[j][1]) + (v[j][2] + v[j][3]); }
            float mean = wave_sum(s) * (1.f / D), s2 = 0.f;
#pragma unroll
            for (int j = 0; j < 4; ++j) { v[j] = v[j] - mean; s2 += (v[j][0] * v[j][0] + v[j][1] * v[j][1]) + (v[j][2] * v[j][2] + v[j][3] * v[j][3]); }
            float rstd = 1.f / sqrtf(wave_sum(s2) * (1.f / D) + LN_EPS);
            s = 0.f;
#pragma unroll
            for (int j = 0; j < 4; ++j) { v[j] = v[j] * rstd * g1[64 * j + lane] + bb1[64 * j + lane]; u32x2 w; w.x = pk2(v[j][0], v[j][1]); w.y = pk2(v[j][2], v[j][3]); pr[64 * j] = w;
                v[j] = (f32x4){bflo(w.x), bfhi(w.x), bflo(w.y), bfhi(w.y)}; s += (v[j][0] + v[j][1]) + (v[j][2] + v[j][3]); }
            mean = wave_sum(s) * (1.f / D); s2 = 0.f;
#pragma unroll
            for (int j = 0; j < 4; ++j) { v[j] = v[j] - mean; s2 += (v[j][0] * v[j][0] + v[j][1] * v[j][1]) + (v[j][2] * v[j][2] + v[j][3] * v[j][3]); }
            rstd = 1.f / sqrtf(wave_sum(s2) * (1.f / D) + LN_EPS);
            const f32x4* sh = (const f32x4*)(mod + b * 6144 + 3 * 1024); const f32x4* sc = (const f32x4*)(mod + b * 6144 + 4 * 1024);
            unsigned* o4 = (unsigned*)((unsigned char*)H2 + (size_t)t * D) + lane;
#pragma unroll
            for (int j = 0; j < 4; ++j) { const f32x4 y = v[j] * rstd * (sc[64 * j + lane] + 1.f) + sh[64 * j + lane];
                o4[64 * j] = gm::pk4_fp8(y[0] * gm::S_H2, y[1] * gm::S_H2, y[2] * gm::S_H2, y[3] * gm::S_H2);
                *(LAS f32x4*)(h2s + lr * HS + 256 * j + 4 * lane) = y; }
        }
        __syncthreads();
        {
            f32x4 acc0 = {0.f, 0.f, 0.f, 0.f}, acc1 = {0.f, 0.f, 0.f, 0.f};
            const LAS float* ap = h2s + (lane & 15) * HS + 128 * wave + (lane >> 4);
#pragma unroll
            for (int s = 0; s < 32; ++s) { const float av = ap[4 * s];
                acc0 = __builtin_amdgcn_mfma_f32_16x16x4f32(av, rwr[s][0], acc0, 0, 0, 0);
                acc1 = __builtin_amdgcn_mfma_f32_16x16x4f32(av, rwr[s][1], acc1, 0, 0, 0); }
#pragma unroll
            for (int r = 0; r < 4; ++r) { part[(wave * 16 + 4 * (lane >> 4) + r) * 32 + (lane & 15)] = acc0[r]; part[(wave * 16 + 4 * (lane >> 4) + r) * 32 + 16 + (lane & 15)] = acc1[r]; }
        }
        __syncthreads();
        {
            const int lr = 2 * wave + (lane >> 5), e = lane & 31, t = grp * 16 + lr;
            float lg = rb[e];
#pragma unroll
            for (int w = 0; w < 8; ++w) lg += part[(w * 16 + lr) * 32 + e];
            float cur = lg, tv[4]; int ti[4];
#pragma unroll
            for (int k = 0; k < 4; ++k) { float bv = cur; int bi = e;
#pragma unroll
                for (int o = 1; o < 32; o <<= 1) { const float ov = __shfl_xor(bv, o); const int oi = __shfl_xor(bi, o); if (ov > bv || (ov == bv && oi < bi)) { bv = ov; bi = oi; } }
                tv[k] = bv; ti[k] = bi; if (bi == e) cur = -3.0e38f; }
            const float e1 = __expf(tv[1] - tv[0]), e2 = __expf(tv[2] - tv[0]), e3 = __expf(tv[3] - tv[0]);
            const float inv = 1.f / (1.f + e1 + e2 + e3);
            if (e < 4) { const float wk = (e == 0 ? 1.f : (e == 1 ? e1 : (e == 2 ? e2 : e3))) * inv; const int ek = (e == 0 ? ti[0] : (e == 1 ? ti[1] : (e == 2 ? ti[2] : ti[3])));
                const int pair = t * 4 + e;
                pw[pair] = wk;
                const int rank = __hip_atomic_fetch_add((LAS int*)&lcnt[ek], 1, __ATOMIC_RELAXED, __HIP_MEMORY_SCOPE_WORKGROUP);
                rec[lr * 4 + e] = ek | (rank << 8); }
        }
        __syncthreads();
        if (tid < 32) { const int n = lcnt[tid]; lbase[tid] = n ? (int)atomicAdd(&cnt[tid], (unsigned)n) : 0; }
        __syncthreads();
        if (tid < 64) { const int rc = rec[tid], ek = rc & 255, rank = rc >> 8, pos = lbase[ek] + rank, pair = (grp * 16 + (tid >> 2)) * 4 + (tid & 3);
            list[(size_t)ek * CAP + pos] = pair; ploc[pair] = ek | (pos << 5); }
        __syncthreads();
        if (tid < 32) lcnt[tid] = 0;
    }
#undef RT_LOAD
}
}

__device__ __forceinline__ void p_final(const Args& a, LAS unsigned char* lds) {
    const int tid = threadIdx.x, lane = tid & 63, wave = tid >> 6;
    const bf16_t* xm = (const bf16_t*)(a.ws + WS_PRE1); const unsigned char* slots = (const unsigned char*)(a.ws + WS_SLOTS); const float* mod = (const float*)(a.ws + WS_MOD);
    const int* ploc = (const int*)(a.ws + WS_PLOC); const float* pw = (const float*)(a.ws + WS_PW);
    const f32x4* g2 = (const f32x4*)a.in[I_LN2G]; const f32x4* b2 = (const f32x4*)a.in[I_LN2B];
    LAS int* tstart = (LAS int*)lds;
    __syncthreads();
    if (tid == 0) { const unsigned* cnt = (const unsigned*)(a.ws + WS_CNT); int nrt = 0; for (int e = 0; e < NE; ++e) { tstart[e] = 256 * nrt; nrt += ((int)cnt[e] + 255) >> 8; } }
    __syncthreads();
    const int tstep = gridDim.x * NWAVES; int t = blockIdx.x * NWAVES + wave;
    if (t < T) {
        int plc[4], pln[4]; float wc_[4], wn_[4]; unsigned qc[4][4], qn[4][4]; u32x2 xc[4], xn[4];
#define PF_IDX(tt, pl, ww) do { _Pragma("unroll") for (int sl = 0; sl < 4; ++sl) { pl[sl] = ploc[(tt) * 4 + sl]; ww[sl] = pw[(tt) * 4 + sl] * (1.f / gm::S_SL); } } while (0)
#define PF_DATA(tt, pl, qq, xx) do { _Pragma("unroll") for (int sl = 0; sl < 4; ++sl) { const unsigned* sr_ = (const unsigned*)(slots + (size_t)(tstart[pl[sl] & 31] + (pl[sl] >> 5)) * D) + lane; \
            _Pragma("unroll") for (int j = 0; j < 4; ++j) qq[sl][j] = sr_[64 * j]; } \
        { const u32x2* xr_ = (const u32x2*)(xm + (size_t)(tt) * D) + lane; _Pragma("unroll") for (int j = 0; j < 4; ++j) xx[j] = xr_[64 * j]; } } while (0)
        PF_IDX(t, plc, wc_); PF_DATA(t, plc, qc, xc);
        int tn = t + tstep; const bool hn0 = tn < T;
        if (hn0) PF_IDX(tn, pln, wn_);
        for (;;) {
            const bool hn = tn < T;
            if (hn) PF_DATA(tn, pln, qn, xn);
            int pl2[4]; float w2[4]; const int tn2 = tn + tstep; const bool hn2 = hn && tn2 < T;
            if (hn2) PF_IDX(tn2, pl2, w2);
            {
                const int b = t >> 13; const f32x4* gt = (const f32x4*)(mod + b * 6144 + 5 * 1024);
                f32x4 v[4]; float s = 0.f;
#pragma unroll
                for (int j = 0; j < 4; ++j) { f32x4 y = {0.f, 0.f, 0.f, 0.f};
#pragma unroll
                    for (int sl = 0; sl < 4; ++sl) { const int q = (int)qc[sl][j];
                        y[0] += wc_[sl] * __builtin_amdgcn_cvt_f32_fp8(q, 0); y[1] += wc_[sl] * __builtin_amdgcn_cvt_f32_fp8(q, 1); y[2] += wc_[sl] * __builtin_amdgcn_cvt_f32_fp8(q, 2); y[3] += wc_[sl] * __builtin_amdgcn_cvt_f32_fp8(q, 3); }
                    const f32x4 xv = {bflo(xc[j].x), bfhi(xc[j].x), bflo(xc[j].y), bfhi(xc[j].y)};
                    v[j] = xv * ALPHA + gt[64 * j + lane] * y; s += (v[j][0] + v[j][1]) + (v[j][2] + v[j][3]); }
                const float mean = wave_sum(s) * (1.f / D); float s2 = 0.f;
#pragma unroll
                for (int j = 0; j < 4; ++j) { v[j] = v[j] - mean; s2 += (v[j][0] * v[j][0] + v[j][1] * v[j][1]) + (v[j][2] * v[j][2] + v[j][3] * v[j][3]); }
                const float rstd = 1.f / sqrtf(wave_sum(s2) * (1.f / D) + LN_EPS);
                f32x4* o = (f32x4*)(a.out + (size_t)t * D) + lane;
#pragma unroll
                for (int j = 0; j < 4; ++j) o[64 * j] = v[j] * rstd * g2[64 * j + lane] + b2[64 * j + lane];
            }
            if (!hn) break;
            t = tn; tn = tn2;
#pragma unroll
            for (int sl = 0; sl < 4; ++sl) { plc[sl] = pln[sl]; wc_[sl] = wn_[sl]; pln[sl] = pl2[sl]; wn_[sl] = w2[sl];
#pragma unroll
                for (int j = 0; j < 4; ++j) qc[sl][j] = qn[sl][j]; }
#pragma unroll
            for (int j = 0; j < 4; ++j) xc[j] = xn[j];
        }
#undef PF_IDX
#undef PF_DATA
    }
}


constexpr int N_PHASES = 11;
__global__ void __launch_bounds__(NTHREADS, 2) mega_fwd(Args a) {
    extern __shared__ __attribute__((aligned(16))) unsigned char lds_raw[];
    LAS unsigned char* lds = (LAS unsigned char*)lds_raw;
    const int tid = threadIdx.x;
    volatile LAS unsigned* misc = (volatile LAS unsigned*)(lds + LDS_MISC);
    if (tid < 4) misc[tid] = 0u;
    __syncthreads();
    XcdBarrier bar; bar.bar = (unsigned*)(a.ws + WS_BAR); bar.x = 0; bar.st = misc;
    const bool multi = (a.ph_hi - a.ph_lo) > 1;
    if (multi) bar = xcd_barrier_post((unsigned*)(a.ws + WS_BAR), misc);
    const int lo = a.ph_lo, hi = a.ph_hi;
#define vcu ((gridDim.x % 8 == 0) ? (int)((blockIdx.x % 8) * (gridDim.x / 8) + blockIdx.x / 8) : (int)blockIdx.x)
#ifdef ONLY_PHASE
#define IN(k) ((k) == ONLY_PHASE && lo <= (k) && (k) < hi)
#else
#define IN(k) (lo <= (k) && (k) < hi)
#endif
#define SEAM(k) do { if (IN(k) && IN((k) + 1)) xcd_barrier(bar); } while (0)

#ifndef REPEAT_PHASE
#define REPEAT_PHASE -1
#endif
#ifdef PROF_REP
#define RUNPH(k, ...) do { if (IN(k)) { const int nrep_ = (a.rep_k == (k)) ? 2 : 1; for (int rep_ = 0; rep_ < nrep_; ++rep_) { if (rep_) xcd_barrier(bar); __VA_ARGS__; } } } while (0)
#else
#define RUNPH(k, ...) do { if (IN(k)) { __VA_ARGS__; if (REPEAT_PHASE == (k)) { xcd_barrier(bar); __VA_ARGS__; } } } while (0)
#endif
    RUNPH(0, p0_mod_and_filter(a, lds));
    SEAM(0);
    RUNPH(1, p1_prep(a, lds));
    SEAM(1);
    RUNPH(2, { gm::SchedIn S{a.ws, (int)gridDim.x, vcu, a.in[I_BAF], a.in[I_BAB]}; gm::EpiIn E{a.ws}; gm::gemm_stream<false, 0, false>(lds, S, E);
        {
          const int G = (int)gridDim.x, rounds = (1812 + G - 1) / G, extra = 1812 - (rounds - 1) * G, v = vcu;
          if (v >= extra || extra == G) { const int nidle = (extra == G) ? G : G - extra, ridle = (extra == G) ? v : v - extra; __syncthreads();
              prep_items(a, (LAS float*)(lds + (tid >> 6) * 16384), PREP_NITEMS - PREP_DEFER, PREP_NITEMS, ridle * NWAVES + (tid >> 6), nidle * NWAVES, tid & 63); } } });
    SEAM(2);
    RUNPH(3, { for (int u = blockIdx.x; u < 16 * NCT; u += gridDim.x) gla::g1_unit(a, lds, u / NCT, u % NCT); });
    SEAM(3);
    RUNPH(4, { gla::g2_scan(a);
        hy::CvState cvs; cvs.jb.mi = -1; cvs.next = (int)blockIdx.x * NWAVES + (tid >> 6); cvs.stride = (int)gridDim.x * NWAVES; cvs.end = hy::CV_SPLIT;
        for (int c = blockIdx.x; c < HYW; c += gridDim.x) hy::channel(a, lds, c, a.ws + WS_HSPEC + (size_t)blockIdx.x * HSPEC_PER_WG, cvs);
        while (cvs.jb.mi >= 0 || cvs.next < cvs.end) hy::cv_step(a, cvs, tid & 63); });
    SEAM(4);
    RUNPH(5, { hy::CvState cvs; cvs.jb.mi = -1; cvs.stride = (int)gridDim.x * NWAVES; cvs.end = hy::CV_ITEMS;
        { const int w0_ = (int)blockIdx.x * NWAVES + (tid >> 6), half_ = hy::CV_SPLIT; cvs.next = half_ + ((w0_ - half_ % cvs.stride) % cvs.stride + cvs.stride) % cvs.stride; }
        { int u = blockIdx.x; gla::G3In cur, nxt;
            if (u < 16 * NCHUNK) { gla::g3_load(a, u >> 7, u & 127, cur);
                for (;;) { const int un = u + (int)gridDim.x; const bool hn = un < 16 * NCHUNK; if (hn) gla::g3_load(a, un >> 7, un & 127, nxt);
                    gla::g3_unit(a, lds, u >> 7, u & 127, cur, cvs); if (!hn) break; cur = nxt; u = un; } } }
        while (cvs.jb.mi >= 0 || cvs.next < cvs.end) hy::cv_step(a, cvs, tid & 63);
        const int wave = tid >> 6;
        for (int it = blockIdx.x * NWAVES + wave; it < 4096; it += gridDim.x * NWAVES) hy::transpose_item(a, it, tid & 63); });
    SEAM(5);
    RUNPH(6, { gm::SchedOut S{a.ws, (int)gridDim.x, vcu}; gm::EpiOut E{a.ws}; gm::gemm_stream<false, 0, false>(lds, S, E); });
    SEAM(6);
    RUNPH(7, rt::phase(a, lds));
    SEAM(7);
    if (IN(8) || IN(9)) {
        LAS int* tab = (LAS int*)(lds + gm::LDS_TAB);
        __syncthreads();
        if (tid == 0) { const unsigned* cnt = (const unsigned*)(a.ws + WS_CNT); int nrt = 0;
            for (int e = 0; e < NE; ++e) { const int n = (int)cnt[e]; tab[e] = n; const int nt = (n + 255) >> 8; for (int k = 0; k < nt; ++k) tab[64 + nrt + k] = e | (k << 8); nrt += nt; }
            tab[32] = nrt; }
        __syncthreads();
    }
    RUNPH(8, { gm::SchedMoe<1> S{a.ws, (const LAS int*)(lds + gm::LDS_TAB), (int)gridDim.x, vcu, a.in[I_EB2]}; gm::EpiMoe1 E{a.ws}; gm::gemm_stream<true, 2, true>(lds, S, E); });
    SEAM(8);
    RUNPH(9, { gm::SchedMoe<2> S{a.ws, (const LAS int*)(lds + gm::LDS_TAB), (int)gridDim.x, vcu, a.in[I_EB2]}; gm::EpiMoe2 E{a.ws}; gm::gemm_stream<false, 0, true>(lds, S, E); });
    SEAM(9);
    RUNPH(10, p_final(a, lds));
#undef RUNPH
#undef vcu
#undef IN
#undef SEAM
}

extern "C" void kernel_launch(void* const* d_in, const int* in_sizes, int n_in, void* d_out, int out_size, void* d_ws, size_t ws_size, hipStream_t stream) {
    static int grid = 0;
    if (grid == 0) {
        if (n_in != 32 || out_size != T * D || ws_size < WS_END) { fprintf(stderr, "kernel_launch: unexpected shapes (n_in %d out %d ws %zu need %zu)\n", n_in, out_size, ws_size, (size_t)WS_END); grid = -1; return; }
        int dev = 0, cus = 0;
        if (hipGetDevice(&dev) != hipSuccess || hipDeviceGetAttribute(&cus, hipDeviceAttributeMultiprocessorCount, dev) != hipSuccess) { grid = -1; return; }
        if (hipFuncSetAttribute((const void*)mega_fwd, hipFuncAttributeMaxDynamicSharedMemorySize, LDS_BYTES) != hipSuccess) { fprintf(stderr, "kernel_launch: hipFuncSetAttribute failed\n"); grid = -1; return; }
        int per_cu = 0;
        if (hipOccupancyMaxActiveBlocksPerMultiprocessor(&per_cu, (const void*)mega_fwd, NTHREADS, LDS_BYTES) != hipSuccess || per_cu < 1) fprintf(stderr, "kernel_launch: occupancy query says %d\n", per_cu);
        (void)hipGetLastError();
        grid = cus;
        if (grid > MAX_GRID) grid = MAX_GRID;
    }
    if (grid < 0) return;
    (void)hipMemsetAsync(d_ws, 0, WS_ZERO_BYTES, stream);
    Args a{};
    for (int i = 0; i < 32; ++i) a.in[i] = (const float*)d_in[i];
    a.out = (float*)d_out; a.ws = (unsigned char*)d_ws;
#ifdef DBG
    (void)hipMemsetAsync((char*)d_ws + WS_DBG, 0, 512, stream);
    for (int p = 0; p < N_PHASES; ++p) { a.ph_lo = p; a.ph_hi = p + 1; hipLaunchKernelGGL(mega_fwd, dim3(grid), dim3(NTHREADS), LDS_BYTES, stream, a);
        hipLaunchKernelGGL(dbg_check, dim3(64), dim3(512), 0, stream, a, p); }
    hipLaunchKernelGGL(dbg_encode, dim3(1024), dim3(256), 0, stream, a);
#elif N_LAUNCH_PER_PHASE
    for (int p = 0; p < N_PHASES; ++p) { a.ph_lo = p; a.ph_hi = p + 1; hipLaunchKernelGGL(mega_fwd, dim3(grid), dim3(NTHREADS), LDS_BYTES, stream, a); }
#else
    a.ph_lo = 0; a.ph_hi = N_PHASES;
#ifdef PROF_REP
    a.rep_k = PROF_REP;
#endif
    hipLaunchKernelGGL(mega_fwd, dim3(grid), dim3(NTHREADS), LDS_BYTES, stream, a);
#endif
}
```

```cpp
#include <hip/hip_runtime.h>
#include <cstdio>
#include <cstdint>
#include <cstddef>

#define LAS __attribute__((address_space(3)))
#define GAS __attribute__((address_space(1)))
typedef unsigned short bf16_t;
typedef short bf16x8 __attribute__((ext_vector_type(8)));
typedef float f32x4 __attribute__((ext_vector_type(4)));
typedef float f32x2 __attribute__((ext_vector_type(2)));
typedef unsigned u32x4 __attribute__((ext_vector_type(4)));
typedef unsigned u32x2 __attribute__((ext_vector_type(2)));

#ifndef N_LAUNCH_PER_PHASE
#define N_LAUNCH_PER_PHASE 0
#endif

constexpr int D = 1024, NB = 4, SEQ = 8192, T = NB * SEQ, CTXL = 256, TC = NB * CTXL, TT = T + TC;
constexpr int NH = 4, DK = 64, DV = 128, CH = 64, NCHUNK = SEQ / CH, NCC = CTXL / CH, NCT = NCHUNK + NCC;
constexpr int HYW = 512, HYC = 3 * HYW, INW = 3104;
constexpr int NE = 32, DE = 1024, CAP = T;
constexpr float LN_EPS = 1e-6f, ALPHA = 1.189207115002721f;
constexpr int NTHREADS = 512, NWAVES = 8;
constexpr int FFTN = 16384;

constexpr size_t al256(size_t x) { return (x + 255) & ~(size_t)255; }
constexpr size_t WS_BAR   = 0;
constexpr size_t WS_MOD   = 16384;
constexpr size_t WS_CNT   = WS_MOD + 5 * 6144 * 4;
constexpr size_t WS_ZERO_BYTES = al256(WS_CNT + 256);
constexpr size_t WS_LIST  = 262144;
constexpr size_t WS_PW    = WS_LIST + (size_t)NE * CAP * 4;
constexpr size_t WS_PLOC  = WS_PW + (size_t)T * 4 * 4;
constexpr size_t WS_B1R   = WS_PLOC + (size_t)T * 4 * 4;
constexpr size_t WS_HID2  = WS_B1R + (size_t)NE * 2048 * 4;
constexpr size_t WS_BTIN  = WS_HID2 + (size_t)SEQ * 64 * 4;
constexpr size_t WS_BTOUT = WS_BTIN + (size_t)3584 * 1024 * 2;
constexpr size_t WS_W1T   = WS_BTOUT + (size_t)1024 * 1024 * 2;
constexpr size_t WS_W2T   = WS_W1T + (size_t)NE * 2048 * 1024 * 2;
constexpr size_t WS_PRE1  = WS_W2T + (size_t)NE * 1024 * 1024 * 2;
constexpr size_t WS_RA    = WS_PRE1 + (size_t)T * 1024 * 4;
constexpr size_t WS_H     = WS_RA;
constexpr size_t WS_Q     = WS_H + (size_t)TT * 1024 * 2;
constexpr size_t WS_K     = WS_Q + (size_t)T * 256 * 2;
constexpr size_t WS_V     = WS_K + (size_t)TT * 256 * 2;
constexpr size_t WS_G     = WS_V + (size_t)TT * 512 * 2;
constexpr size_t WS_GF    = WS_G + (size_t)T * 512 * 2;
constexpr size_t WS_GB    = WS_GF + (size_t)TT * 256 * 4;
constexpr size_t WS_UT    = WS_GB + (size_t)TT * 256 * 4;
constexpr size_t WS_RA_END= WS_UT + (size_t)NB * HYC * SEQ * 2;
constexpr size_t WS_H2    = WS_RA;
constexpr size_t WS_FG    = WS_RA + (size_t)T * 1024 * 2;
constexpr size_t WS_SLOTS = WS_RA;
constexpr size_t SORTED_BYTES_ = (size_t)(T * 4 / 256 + NE) * 256 * 1024 * 2;
constexpr size_t WS_RB    = al256(WS_RA_END > WS_RA + SORTED_BYTES_ ? WS_RA_END : WS_RA + SORTED_BYTES_);
constexpr size_t WS_KV    = WS_RB;
constexpr size_t WS_AV    = WS_KV + (size_t)2 * 16 * NCT * 8192 * 2;
constexpr size_t WS_SP    = WS_AV + (size_t)2 * 16 * NCT * 64 * 4;
constexpr size_t WS_HSPEC = WS_SP + (size_t)2 * 16 * NCHUNK * 8192 * 2;
constexpr size_t HSPEC_PER_WG = (size_t)2 * FFTN * 8;
constexpr int MAX_GRID = 256;
constexpr size_t WS_YHYT  = WS_HSPEC + (size_t)MAX_GRID * HSPEC_PER_WG;
constexpr size_t WS_MIX   = WS_YHYT + (size_t)NB * HYW * SEQ * 2;
constexpr size_t WS_RB_END= WS_MIX + (size_t)T * 1024 * 2;
constexpr size_t WS_HF    = WS_MIX;
constexpr size_t WS_ACT   = WS_RB;
constexpr size_t SORTED_BYTES = (size_t)(T * 4 / 256 + NE) * 256 * 1024 * 2;
constexpr size_t WS_END   = al256(WS_RB_END > WS_RB + SORTED_BYTES ? WS_RB_END : WS_RB + SORTED_BYTES);

constexpr int LDS_BYTES = 147456;
constexpr int LDS_MISC  = 145408;

typedef __bf16 bf16n2 __attribute__((ext_vector_type(2)));
__device__ __forceinline__ unsigned pk2(float lo, float hi) { bf16n2 v = {(__bf16)lo, (__bf16)hi}; return __builtin_bit_cast(unsigned, v); }
__device__ __forceinline__ bf16_t f2bf(float f) { __bf16 b = (__bf16)f; return __builtin_bit_cast(unsigned short, b); }
__device__ __forceinline__ float bf2f(bf16_t b) { return __uint_as_float(((unsigned)b) << 16); }
__device__ __forceinline__ float bflo(unsigned w) { return __uint_as_float(w << 16); }
__device__ __forceinline__ float bfhi(unsigned w) { return __uint_as_float(w & 0xffff0000u); }
__device__ __forceinline__ float wave_sum(float v) {
#pragma unroll
    for (int o = 1; o < 64; o <<= 1) v += __shfl_xor(v, o);
    return v;
}
__device__ __forceinline__ float silu_f(float x) { return x * __builtin_amdgcn_rcpf(1.f + __expf(-x)); }
__device__ __forceinline__ float log_sigmoid_f(float z) { return fminf(z, 0.f) - __logf(1.f + __expf(-fabsf(z))); }

#define XB_TMO      128
#define XB_XCNT(j)  (256  + 64 * (j))
#define XB_XSUB(j)  (1280 + 64 * (j))
#define XB_XGEN(j)  (2304 + 64 * (j))
#define XB_TOP      3328
#define XB_TOPGEN   3392
#define XCD_BAR_WORDS 3456
#define XB_SPIN_CAP (1u << 22)
__device__ __forceinline__ unsigned xb_ld(unsigned* p)              { return __hip_atomic_load(p, __ATOMIC_RELAXED, __HIP_MEMORY_SCOPE_AGENT); }
__device__ __forceinline__ unsigned xb_add(unsigned* p, unsigned v) { return __hip_atomic_fetch_add(p, v, __ATOMIC_RELAXED, __HIP_MEMORY_SCOPE_AGENT); }
__device__ __forceinline__ unsigned xb_xcc_id() { return (unsigned)__builtin_amdgcn_s_getreg((3 << 11) | 20) & 0xFu; }
#define XB_SPIN(cond, bar) do { unsigned _sp = 0; while (cond) { __builtin_amdgcn_s_sleep(1); \
    if ((++_sp & 255u) == 0u) { if (xb_ld(&(bar)[XB_TMO])) break; if (_sp > XB_SPIN_CAP) { atomicAdd(&(bar)[XB_TMO], 1u); break; } } } } while (0)
struct XcdBarrier { unsigned* bar; unsigned x; volatile LAS unsigned* st; };
__device__ __forceinline__ XcdBarrier xcd_barrier_post(unsigned* bar, volatile LAS unsigned* st) {
    XcdBarrier b; b.bar = bar; b.x = xb_xcc_id(); b.st = st;
    if (threadIdx.x == 0) (void)xb_add(&bar[XB_XCNT(b.x)], 1u);
    return b;
}
__device__ __forceinline__ void xcd_barrier_complete(unsigned* bar, unsigned x, unsigned& nloc, unsigned& nx) {
    const unsigned G = gridDim.x * gridDim.y * gridDim.z;
    unsigned sum, cnt, mine, sp = 0u;
    for (;;) {
        sum = 0u; cnt = 0u; mine = 0u;
#pragma unroll
        for (unsigned j = 0; j < 16; ++j) { const unsigned c = xb_ld(&bar[XB_XCNT(j)]); sum += c; cnt += (c > 0u) ? 1u : 0u; mine = (j == x) ? c : mine; }
        if (sum == G) break;
        __builtin_amdgcn_s_sleep(1);
        if ((++sp & 255u) == 0u) { if (xb_ld(&bar[XB_TMO])) break; if (sp > XB_SPIN_CAP) { atomicAdd(&bar[XB_TMO], 1u); break; } }
    }
    nloc = mine > 0u ? mine : 1u; nx = cnt > 0u ? cnt : 1u;
}
__device__ __forceinline__ void xcd_barrier(const XcdBarrier& b) {
    asm volatile("s_waitcnt vmcnt(0)" ::: "memory");
    __syncthreads();
    if (threadIdx.x == 0) {
        unsigned* bar = b.bar;
        __builtin_amdgcn_s_waitcnt(0);
        unsigned nloc = b.st[0], nx = b.st[1];
        if (nloc == 0u) { xcd_barrier_complete(bar, b.x, nloc, nx); b.st[0] = nloc; b.st[1] = nx; }
        const unsigned old = xb_add(&bar[XB_XSUB(b.x)], 1u);
        const unsigned gen = old / nloc;
        if (old + 1u == (gen + 1u) * nloc) {
            __builtin_amdgcn_fence(__ATOMIC_RELEASE, "agent");
            asm volatile("s_waitcnt vmcnt(0)" ::: "memory");
            const unsigned og = xb_add(&bar[XB_TOP], 1u);
            const unsigned tg = og / nx;
            if (og + 1u == (tg + 1u) * nx) xb_add(&bar[XB_TOPGEN], 1u);
            else XB_SPIN(xb_ld(&bar[XB_TOPGEN]) == tg, bar);
            __builtin_amdgcn_fence(__ATOMIC_ACQUIRE, "agent");
            xb_add(&bar[XB_XGEN(b.x)], 1u);
            asm volatile("s_waitcnt vmcnt(0)" ::: "memory");
        } else {
            XB_SPIN(xb_ld(&bar[XB_XGEN(b.x)]) == gen, bar);
            __builtin_amdgcn_fence(__ATOMIC_ACQUIRE, "agent");
            asm volatile("s_waitcnt vmcnt(0)" ::: "memory");
        }
    }
    __syncthreads();
}

struct Args {
    const float* in[32];
    float* out;
    unsigned char* ws;
    int ph_lo, ph_hi;
    int rep_k, pad_;
};
enum { I_X = 0, I_C, I_CTX, I_CCTX, I_ADAW, I_ADAB, I_WIN, I_WAF, I_BAF, I_WAB, I_BAB, I_NORMG, I_CONVW, I_CONVB, I_FW1, I_FB1, I_FW2, I_FB2, I_FWOUT, I_FFREQ,
       I_BIASD, I_WOUT, I_LN1G, I_LN1B, I_RW, I_RB, I_EW1, I_EB1, I_EW2, I_EB2, I_LN2G, I_LN2B };


namespace gm {
constexpr int BM = 256, BK = 64, HALF = 128, HTB = HALF * BK * 2, STAGE_BYTES = 8 * HTB, KD = 1024, NT = KD / BK;
constexpr int ROWB = KD * 2;
typedef int i32x8 __attribute__((ext_vector_type(8)));
__device__ __forceinline__ int gray2(int q) { return q ^ (q >> 1); }
__device__ __forceinline__ int lds_off8(int r, int fq) { const int rr = r & 15; return ((r >> 4) * 2 + (fq >> 1)) * 1024 + rr * 64 + 16 * ((2 * (fq & 1)) ^ gray2(rr >> 2)); }
__device__ __forceinline__ void stage_rc8(int b, int& R, int& C) { const int st = b / 1024, sb = b % 1024, swz = sb ^ (gray2((sb >> 8) & 3) << 4); R = (st >> 1) * 16 + swz / 64; C = (st & 1) * 32 + (swz % 64) / 2; }
__device__ __forceinline__ int lds_byte(int r, int c) { const int st = (r >> 4) * 2 + (c >> 5), rr = r & 15, cc = c & 31, ob = rr * 64 + cc * 2; return st * 1024 + (ob ^ (((ob >> 9) & 1) << 5)); }
__device__ __forceinline__ void stage_rc(int b, int& R, int& C) { const int st = b / 1024, sb = b % 1024, swz = sb ^ (((sb >> 9) & 1) << 5); R = (st >> 1) * 16 + swz / 64; C = (st & 1) * 32 + (swz % 64) / 2; }
__device__ __forceinline__ int perm32(int rho) { const int n = rho >> 4, i = rho & 15; return 8 * (i >> 2) + 4 * n + (i & 3); }

constexpr int LDS_BIAS = STAGE_BYTES + 4096;
struct Unit {
    const char* A;
    const char* B;
    const int* list;
    int type, row0, col0, valid, aux;
};

__device__ __forceinline__ i32x8 cat8(bf16x8 lo, bf16x8 hi) { typedef int i32x4 __attribute__((ext_vector_type(4))); const i32x4 a = __builtin_bit_cast(i32x4, lo), b = __builtin_bit_cast(i32x4, hi); return (i32x8){a[0], a[1], a[2], a[3], b[0], b[1], b[2], b[3]}; }
template <bool GATHER, int GSHIFT, int RB, bool FP8>
__device__ __forceinline__ void a_offsets(const Unit& u, unsigned (&o)[2][2]) {
    int R[2], Cb[2];
    int tz = threadIdx.x; asm volatile("" : "+v"(tz));
#pragma unroll
    for (int i = 0; i < 2; ++i) { int r, c; if (FP8) stage_rc8(tz * 16 + i * 8192, r, c); else stage_rc(tz * 16 + i * 8192, r, c); R[i] = r; Cb[i] = c * 2; }
#pragma unroll
    for (int h = 0; h < 2; ++h)
#pragma unroll
        for (int i = 0; i < 2; ++i) {
            const int r = h * HALF + R[i];
            if (!GATHER) o[h][i] = (unsigned)(r * RB + Cb[i]);
            else { const int idx = u.list[r < u.valid ? r : 0]; o[h][i] = (unsigned)(idx >> GSHIFT) * (unsigned)RB + (unsigned)Cb[i]; }
        }
}

template <bool GATHER, int GSHIFT, bool FP8, class Sched, class Epi>
__device__ __forceinline__ void gemm_stream(LAS unsigned char* lds, const Sched& S, const Epi& E) {
    constexpr int RB = FP8 ? KD : ROWB, NTL = FP8 ? NT / 2 : NT;
    const int tid = threadIdx.x, wid = __builtin_amdgcn_readfirstlane(tid >> 6), lane = tid & 63, wr = wid >> 2, wc = wid & 3, fr = lane & 15, fq = lane >> 4;
    unsigned voffB[2], voffA[2];
#pragma unroll
    for (int i = 0; i < 2; ++i) { int r, c; if (FP8) stage_rc8(tid * 16 + i * 8192, r, c); else stage_rc(tid * 16 + i * 8192, r, c); const int rb = (r & ~31) + perm32(r & 31); voffB[i] = (unsigned)(rb * RB + c * 2); voffA[i] = (unsigned)(r * RB + c * 2); }
    const size_t kstep = (size_t)(BK * 2), hstep = (size_t)HALF * RB;
    const unsigned ldsw = (unsigned)wid * 1024u;
    const int aoff = FP8 ? lds_off8(wr * 64 + fr, fq) : lds_byte(wr * 64 + fr, fq * 8), boff = FP8 ? lds_off8(wc * 32 + fr, fq) : lds_byte(wc * 32 + fr, fq * 8);
    const int aoffh = aoff ^ 16, boffh = boff ^ 16;
#define GM_SA(b, h) (((b) * 2 + (h)) * HTB)
#define GM_SB(b, h) ((4 + (b) * 2 + (h)) * HTB)
#define GM_STAGE(bufoff, gbase, vo0, vo1) do { \
        __builtin_amdgcn_global_load_lds((const unsigned*)((const char*)(gbase) + (vo0)), (LAS unsigned*)(lds + (bufoff) + ldsw), 16, 0, 0); \
        __builtin_amdgcn_global_load_lds((const unsigned*)((const char*)(gbase) + (vo1)), (LAS unsigned*)(lds + (bufoff) + ldsw + 8192), 16, 0, 0); } while (0)
#define GM_STAGE_A(bufoff, gbase, h, o0, o1) do { if constexpr (GATHER) GM_STAGE(bufoff, gbase, o0, o1); else GM_STAGE(bufoff, (gbase) + (h) * hstep, voffA[0], voffA[1]); } while (0)
#define GM_LD32(p, ol, oh) ({ const i32x4 lo_ = *(const LAS i32x4*)((p) + (ol)), hi_ = *(const LAS i32x4*)((p) + (oh)); (i32x8){lo_[0], lo_[1], lo_[2], lo_[3], hi_[0], hi_[1], hi_[2], hi_[3]}; })
#define GM_LDA(dst, b, h) do { if constexpr (FP8) { _Pragma("unroll") for (int m = 0; m < 4; ++m) dst##8[m] = GM_LD32(lds + GM_SA(b, h) + m * 2048, aoff, aoffh); } \
        else { _Pragma("unroll") for (int m = 0; m < 4; ++m) _Pragma("unroll") for (int k = 0; k < 2; ++k) dst[m][k] = *(const LAS bf16x8*)(lds + GM_SA(b, h) + aoff + m * 2048 + k * 1024); } } while (0)
#define GM_LDB(dst, b, h) do { if constexpr (FP8) { _Pragma("unroll") for (int n = 0; n < 2; ++n) dst##8[n] = GM_LD32(lds + GM_SB(b, h) + n * 2048, boff, boffh); } \
        else { _Pragma("unroll") for (int n = 0; n < 2; ++n) _Pragma("unroll") for (int k = 0; k < 2; ++k) dst[n][k] = *(const LAS bf16x8*)(lds + GM_SB(b, h) + boff + n * 2048 + k * 1024); } } while (0)
#define GM_MMA(ai, bj, At, Bt) do { __builtin_amdgcn_s_setprio(1); _Pragma("unroll") for (int m = 0; m < 4; ++m) _Pragma("unroll") for (int n = 0; n < 2; ++n) { \
        if constexpr (FP8) asm volatile("v_mfma_scale_f32_16x16x128_f8f6f4 %0, %1, %2, %0, %3, %3 op_sel_hi:[0,0,0]" : "+v"(acc[ai][bj][m][n]) : "v"(Bt##8[n]), "v"(At##8[m]), "v"(sc1_)); \
        else { _Pragma("unroll") for (int k = 0; k < 2; ++k) acc[ai][bj][m][n] = __builtin_amdgcn_mfma_f32_16x16x32_bf16(Bt[n][k], At[m][k], acc[ai][bj][m][n], 0, 0, 0); } } \
        __builtin_amdgcn_s_setprio(0); } while (0)
#define GM_WAIT_V(n) asm volatile("s_waitcnt vmcnt(" #n ")" ::: "memory")
#define GM_WAIT_L(n) asm volatile("s_waitcnt lgkmcnt(" #n ")" ::: "memory")
#define GM_BAR __builtin_amdgcn_s_barrier()
#define GM_SCHED __builtin_amdgcn_sched_barrier(0)
    Unit cur, nxt; int ui = 0;
    if (!S.next(0, cur)) return;
    f32x4 acc[2][2][4][2];
#pragma unroll
    for (int a = 0; a < 2; ++a)
#pragma unroll
        for (int b = 0; b < 2; ++b)
#pragma unroll
            for (int m = 0; m < 4; ++m)
#pragma unroll
                for (int n = 0; n < 2; ++n) acc[a][b][m][n] = (f32x4){0.f, 0.f, 0.f, 0.f};
    typedef int i32x4 __attribute__((ext_vector_type(4)));
    int sc1_ = 0x7f7f7f7f; asm volatile("" : "+v"(sc1_));
    bf16x8 At[4][2], B0[2][2], B1[2][2];
    i32x8 At8[4], B08[2], B18[2];
    unsigned ca[2][2], na[2][2];
    if constexpr (GATHER) a_offsets<GATHER, GSHIFT, RB, FP8>(cur, ca);
    const char* cA = cur.A; const char* cB = cur.B;
    GM_STAGE(GM_SB(0, 0), cB, voffB[0], voffB[1]); GM_STAGE_A(GM_SA(0, 0), cA, 0, ca[0][0], ca[0][1]); GM_STAGE(GM_SB(0, 1), cB + hstep, voffB[0], voffB[1]); GM_STAGE_A(GM_SA(0, 1), cA, 1, ca[1][0], ca[1][1]);
    if (wr == 1) GM_BAR;
    GM_WAIT_V(4); GM_BAR;
    GM_STAGE(GM_SB(1, 0), cB + kstep, voffB[0], voffB[1]); GM_STAGE_A(GM_SA(1, 0), cA + kstep, 0, ca[0][0], ca[0][1]); GM_STAGE(GM_SB(1, 1), cB + hstep + kstep, voffB[0], voffB[1]);
    GM_WAIT_V(6); GM_BAR;
    for (;;) {
        const bool has_next = S.next(ui + 1, nxt);
        if constexpr (GATHER) {
            if (has_next) a_offsets<GATHER, GSHIFT, RB, FP8>(nxt, na);
            else {
#pragma unroll
                for (int h = 0; h < 2; ++h)
#pragma unroll
                    for (int i = 0; i < 2; ++i) na[h][i] = ca[h][i];
            }
        }
        const char* nA = has_next ? nxt.A : cA; const char* nB = has_next ? nxt.B : cB;
        if (wid == 0)
            __builtin_amdgcn_global_load_lds((const unsigned*)(S.bias(cur) + 4 * lane), (LAS unsigned*)(lds + LDS_BIAS + (ui & 1) * 1024), 16, 0, 0);
        for (int t = 0; t < NTL; t += 2) {
            const bool last = (t == NTL - 2);

            const char* a1 = cA + (size_t)(t + 1) * kstep;
            const char* a2 = last ? nA : cA + (size_t)(t + 2) * kstep; const char* b2 = last ? nB : cB + (size_t)(t + 2) * kstep;
            const char* a3 = a2 + kstep; const char* b3 = b2 + kstep;
            unsigned x00 = 0, x01 = 0, x10 = 0, x11 = 0;
            if constexpr (GATHER) { x00 = last ? na[0][0] : ca[0][0]; x01 = last ? na[0][1] : ca[0][1]; x10 = last ? na[1][0] : ca[1][0]; x11 = last ? na[1][1] : ca[1][1]; }
            GM_LDB(B0, 0, 0); GM_SCHED; GM_LDA(At, 0, 0); GM_STAGE_A(GM_SA(1, 1), a1, 1, ca[1][0], ca[1][1]);
            GM_WAIT_L(8); GM_BAR; GM_WAIT_L(0); GM_MMA(0, 0, At, B0); GM_BAR; GM_SCHED;
            GM_LDB(B1, 0, 1); GM_STAGE(GM_SB(0, 0), b2, voffB[0], voffB[1]);
            GM_BAR; GM_WAIT_L(0); GM_MMA(0, 1, At, B1); GM_BAR;
            GM_LDA(At, 0, 1); GM_STAGE_A(GM_SA(0, 0), a2, 0, x00, x01);
            GM_BAR; GM_WAIT_L(0); GM_MMA(1, 0, At, B0); GM_BAR; GM_SCHED;
            GM_STAGE(GM_SB(0, 1), b2 + hstep, voffB[0], voffB[1]);
            GM_WAIT_V(6); GM_BAR; GM_MMA(1, 1, At, B1); GM_BAR;
            GM_LDB(B0, 1, 0); GM_SCHED; GM_LDA(At, 1, 0); GM_STAGE_A(GM_SA(0, 1), a2, 1, x10, x11);
            GM_WAIT_L(8); GM_BAR; GM_WAIT_L(0); GM_MMA(0, 0, At, B0); GM_BAR; GM_SCHED;
            GM_LDB(B1, 1, 1); GM_STAGE(GM_SB(1, 0), b3, voffB[0], voffB[1]);
            GM_BAR; GM_WAIT_L(0); GM_MMA(0, 1, At, B1); GM_BAR;
            GM_LDA(At, 1, 1); GM_STAGE_A(GM_SA(1, 0), a3, 0, x00, x01);
            GM_BAR; GM_WAIT_L(0); GM_MMA(1, 0, At, B0); GM_BAR; GM_SCHED;
            GM_STAGE(GM_SB(1, 1), b3 + hstep, voffB[0], voffB[1]);
            GM_WAIT_V(6); GM_BAR; GM_MMA(1, 1, At, B1); GM_BAR;
        }
        if constexpr (FP8) asm volatile("s_nop 7\n\ts_nop 7" ::: "memory");
        {
          int tz = threadIdx.x; asm volatile("" : "+v"(tz)); const int wz = tz >> 6, lz = tz & 63;
          E(acc, cur, wz >> 2, wz & 3, lz & 15, lz >> 4, (const LAS float*)(lds + LDS_BIAS + (ui & 1) * 1024)); }
        if (!has_next) break;
#pragma unroll
        for (int a = 0; a < 2; ++a)
#pragma unroll
            for (int b = 0; b < 2; ++b)
#pragma unroll
                for (int m = 0; m < 4; ++m)
#pragma unroll
                    for (int n = 0; n < 2; ++n) acc[a][b][m][n] = (f32x4){0.f, 0.f, 0.f, 0.f};
        cur = nxt; cA = nA; cB = nB; ++ui;
        if constexpr (GATHER) {
#pragma unroll
            for (int h = 0; h < 2; ++h)
#pragma unroll
                for (int i = 0; i < 2; ++i) ca[h][i] = na[h][i];
        }
    }
    GM_WAIT_V(0);
    if (wr == 0) GM_BAR;
    GM_BAR;
#undef GM_SA
#undef GM_SB
#undef GM_STAGE
#undef GM_STAGE_A
#undef GM_LD32
#undef GM_LDA
#undef GM_LDB
#undef GM_MMA
#undef GM_WAIT_V
#undef GM_WAIT_L
#undef GM_BAR
#undef GM_SCHED
}

__device__ __forceinline__ u32x4 pack8(f32x4 a, f32x4 b) { u32x4 w; w.x = pk2(a[0], a[1]); w.y = pk2(a[2], a[3]); w.z = pk2(b[0], b[1]); w.w = pk2(b[2], b[3]); return w; }

struct SchedIn {
    unsigned char* ws; int G, c; const float* baf; const float* bab;
    __device__ __forceinline__ bool next(int i, Unit& u) const {
        int L = i * G + c;
        u.list = nullptr; u.valid = 256; u.aux = 0;
        if (L < 768) {
            const int pa = L % 6, pb = L / 6;
            u.A = (const char*)(ws + WS_BTIN) + (size_t)(2048 + 256 * pa) * ROWB; u.B = (const char*)(ws + WS_H) + (size_t)(256 * pb) * ROWB;
            u.type = 2; u.row0 = 256 * pa; u.col0 = 256 * pb; return true;
        }
        L -= 768;
        if (L < 1024) {
            const int pm = L >> 3, pn = ((L & 7) + (L >> 8)) & 7;
            u.A = (const char*)(ws + WS_H) + (size_t)(256 * pm) * ROWB; u.B = (const char*)(ws + WS_BTIN) + (size_t)(256 * pn) * ROWB;
            u.type = pn < 6 ? 0 : 1; u.row0 = 256 * pm; u.col0 = pn; return true;
        }
        L -= 1024;
        if (L < 20) {
            const int pm = L / 5, j = L % 5, pn = j == 0 ? 1 : (j == 1 ? 2 : (j == 2 ? 3 : (j == 3 ? 6 : 7)));
            u.A = (const char*)(ws + WS_H) + (size_t)(T + 256 * pm) * ROWB; u.B = (const char*)(ws + WS_BTIN) + (size_t)(256 * pn) * ROWB;
            u.type = pn < 6 ? 0 : 1; u.row0 = T + 256 * pm; u.col0 = pn; return true;
        }
        return false;
    }
    __device__ __forceinline__ const float* bias(const Unit& u) const { return (u.type == 1 && u.col0 == 7) ? bab : baf; }
};
struct EpiIn {
    unsigned char* ws;
    __device__ __forceinline__ void operator()(const f32x4 (&acc)[2][2][4][2], const Unit& u, int wr, int wc, int fr, int fq, const LAS float* bs) const {
        const int rl = wr * 64 + fr, cl = wc * 32 + 8 * fq;
        if (u.type == 0) {
            const int pn = u.col0;
            bf16_t* dst; int ld, cb;
            if (pn == 0) { dst = (bf16_t*)(ws + WS_Q); ld = 256; cb = 0; }
            else if (pn == 1) { dst = (bf16_t*)(ws + WS_K); ld = 256; cb = 0; }
            else if (pn < 4) { dst = (bf16_t*)(ws + WS_V); ld = 512; cb = (pn - 2) * 256; }
            else { dst = (bf16_t*)(ws + WS_G); ld = 512; cb = (pn - 4) * 256; }
#pragma unroll
            for (int ai = 0; ai < 2; ++ai)
#pragma unroll
                for (int m = 0; m < 4; ++m) { bf16_t* rowp = dst + (size_t)(u.row0 + rl + ai * 128 + m * 16) * ld + cb + cl;
#pragma unroll
                    for (int bj = 0; bj < 2; ++bj) *(u32x4*)(rowp + bj * 128) = pack8(acc[ai][bj][m][0], acc[ai][bj][m][1]); }
        } else if (u.type == 1) {
            _Float16* dst = (_Float16*)(ws + (u.col0 == 6 ? WS_GF : WS_GB));
            f32x4 bv[2][2];
#pragma unroll
            for (int bj = 0; bj < 2; ++bj)
#pragma unroll
                for (int n = 0; n < 2; ++n) bv[bj][n] = *(const LAS f32x4*)(bs + cl + bj * 128 + 4 * n);
            typedef _Float16 f16x8_ __attribute__((ext_vector_type(8)));
#pragma unroll
            for (int ai = 0; ai < 2; ++ai)
#pragma unroll
                for (int m = 0; m < 4; ++m) { _Float16* rowp = dst + (size_t)(u.row0 + rl + ai * 128 + m * 16) * 256 + cl;
#pragma unroll
                    for (int bj = 0; bj < 2; ++bj) { f16x8_ o;
#pragma unroll
                        for (int n = 0; n < 2; ++n) { const f32x4 z = acc[ai][bj][m][n] + bv[bj][n];
#pragma unroll
                            for (int j = 0; j < 4; ++j) o[4 * n + j] = (_Float16)(log_sigmoid_f(z[j]) * (1.f / 16.f)); }
                        *(f16x8_*)(rowp + bj * 128) = o; } }
        } else {
            const int b = u.col0 >> 13, l0 = u.col0 & 8191;
            bf16_t* dst = (bf16_t*)(ws + WS_UT) + ((size_t)b * HYC) * SEQ + l0 + cl;
#pragma unroll
            for (int ai = 0; ai < 2; ++ai)
#pragma unroll
                for (int m = 0; m < 4; ++m) { bf16_t* rowp = dst + (size_t)(u.row0 + rl + ai * 128 + m * 16) * SEQ;
#pragma unroll
                    for (int bj = 0; bj < 2; ++bj) *(u32x4*)(rowp + bj * 128) = pack8(acc[ai][bj][m][0], acc[ai][bj][m][1]); }
        }
    }
};

struct SchedOut {
    unsigned char* ws; int G, c;
    __device__ __forceinline__ bool next(int i, Unit& u) const {
        const int L = i * G + c; if (L >= 512) return false;
        const int pm = L >> 2, pn = L & 3;
        u.A = (const char*)(ws + WS_MIX) + (size_t)(256 * pm) * ROWB; u.B = (const char*)(ws + WS_BTOUT) + (size_t)(256 * pn) * ROWB;
        u.list = nullptr; u.valid = 256; u.aux = 0; u.type = 3; u.row0 = 256 * pm; u.col0 = 256 * pn; return true;
    }
    __device__ __forceinline__ const float* bias(const Unit& u) const { return (const float*)(ws + WS_MOD) + (u.row0 >> 13) * 6144 + 2 * 1024 + u.col0; }
};
struct EpiOut {
    unsigned char* ws;
    __device__ __forceinline__ void operator()(const f32x4 (&acc)[2][2][4][2], const Unit& u, int wr, int wc, int fr, int fq, const LAS float* bs) const {
        const int rl = wr * 64 + fr, cl = u.col0 + wc * 32 + 8 * fq;
        bf16_t* fg = (bf16_t*)(ws + WS_FG);
        f32x4 gv[2][2];
#pragma unroll
        for (int bj = 0; bj < 2; ++bj)
#pragma unroll
            for (int n = 0; n < 2; ++n) gv[bj][n] = *(const LAS f32x4*)(bs + wc * 32 + 8 * fq + bj * 128 + 4 * n);
#pragma unroll
        for (int ai = 0; ai < 2; ++ai)
#pragma unroll
            for (int m = 0; m < 4; ++m) { bf16_t* rowp = fg + (size_t)(u.row0 + rl + ai * 128 + m * 16) * 1024 + cl;
#pragma unroll
                for (int bj = 0; bj < 2; ++bj) *(u32x4*)(rowp + bj * 128) = pack8(gv[bj][0] * acc[ai][bj][m][0], gv[bj][1] * acc[ai][bj][m][1]); }
    }
};

constexpr int LDS_TAB = STAGE_BYTES;
template <int WHICH>
struct SchedMoe {
    unsigned char* ws; const LAS int* tab; int G, c; const float* b2;
    __device__ __forceinline__ bool next(int i, Unit& u) const {
        constexpr int NCT_ = WHICH == 1 ? 8 : 4;
        const int L = i * G + c; const int nrt = __builtin_amdgcn_readfirstlane(tab[32]);
        if (L >= nrt * NCT_) return false;
        const int rt = L / NCT_, ct = L % NCT_;
        const int info = __builtin_amdgcn_readfirstlane(tab[64 + rt]), e = info & 255, r0 = (info >> 8) * 256;
        const int cnt = __builtin_amdgcn_readfirstlane(tab[e]);
        u.valid = (cnt - r0) < 256 ? (cnt - r0) : 256;
        u.list = (const int*)(ws + WS_LIST) + (size_t)e * CAP + r0;
        u.A = (WHICH == 1) ? (const char*)(ws + WS_H2) : (const char*)(ws + WS_ACT) + (size_t)(256 * rt) * KD;
        u.B = (const char*)(ws + (WHICH == 1 ? WS_W1T : WS_W2T)) + ((size_t)e * (WHICH == 1 ? 2048 : 1024) + 256 * ct) * KD;
        u.type = 3 + WHICH; u.row0 = 256 * rt; u.col0 = ct; u.aux = e; return true;
    }
    __device__ __forceinline__ const float* bias(const Unit& u) const { return (WHICH == 1) ? (const float*)(ws + WS_B1R) + (size_t)u.aux * 2048 + 256 * u.col0 : b2 + (size_t)u.aux * 1024 + 256 * u.col0; }
};
__device__ __forceinline__ float swiglu_f(float glu, float lin) {
    glu = fminf(glu, 7.f); lin = fminf(fmaxf(lin, -7.f), 7.f);
    return glu * __builtin_amdgcn_rcpf(1.f + __expf(-1.702f * glu)) * (lin + 1.f);
}
constexpr float S_H2 = 4.f, S_ACT = 8.f, S_W = 64.f;
__device__ __forceinline__ f32x2 swiglu2(f32x2 ag, f32x2 al, f32x2 bg, f32x2 bl) {
    f32x2 g = ag * (1.f / (S_H2 * S_W)) + bg, l = al * (1.f / (S_H2 * S_W)) + bl;
    g[0] = fminf(g[0], 7.f); g[1] = fminf(g[1], 7.f);
    l[0] = __builtin_amdgcn_fmed3f(l[0], -7.f, 7.f); l[1] = __builtin_amdgcn_fmed3f(l[1], -7.f, 7.f);
    const f32x2 t = g * (-1.702f * 1.4426950408889634f);
    const f32x2 d = (f32x2){__builtin_amdgcn_exp2f(t[0]), __builtin_amdgcn_exp2f(t[1])} + 1.f;
    const f32x2 r = {__builtin_amdgcn_rcpf(d[0]), __builtin_amdgcn_rcpf(d[1])};
    return (g * r) * (l * S_ACT + S_ACT);
}
__device__ __forceinline__ unsigned pk4_fp8(float a, float b, float c, float d) {
    a = fminf(fmaxf(a, -448.f), 448.f); b = fminf(fmaxf(b, -448.f), 448.f); c = fminf(fmaxf(c, -448.f), 448.f); d = fminf(fmaxf(d, -448.f), 448.f);
    int p = __builtin_amdgcn_cvt_pk_fp8_f32(a, b, 0, false); p = __builtin_amdgcn_cvt_pk_fp8_f32(c, d, p, true); return (unsigned)p; }
__device__ __forceinline__ unsigned pk4_fp8_nc(float a, float b, float c, float d) { int p = __builtin_amdgcn_cvt_pk_fp8_f32(a, b, 0, false); p = __builtin_amdgcn_cvt_pk_fp8_f32(c, d, p, true); return (unsigned)p; }
struct EpiMoe1 {
    unsigned char* ws;
    __device__ __forceinline__ void operator()(const f32x4 (&acc)[2][2][4][2], const Unit& u, int wr, int wc, int fr, int fq, const LAS float* bs) const {
        const int rl = wr * 64 + fr, cl = wc * 32 + 8 * fq, ct = u.col0;
        const LAS float* b1 = bs + cl;
        unsigned char* act = (unsigned char*)(ws + WS_ACT) + (size_t)u.row0 * 1024 + 128 * ct + cl;
        f32x4 bg[2], bl[2];
#pragma unroll
        for (int n = 0; n < 2; ++n) { bg[n] = *(const LAS f32x4*)(b1 + 4 * n); bl[n] = *(const LAS f32x4*)(b1 + 128 + 4 * n); }
#pragma unroll
        for (int ai = 0; ai < 2; ++ai)
#pragma unroll
            for (int mp = 0; mp < 2; ++mp) {
                u32x2 w[2];
#pragma unroll
                for (int mm = 0; mm < 2; ++mm) { const int m = 2 * mp + mm;
#pragma unroll
                    for (int n = 0; n < 2; ++n) { int p = 0;
#pragma unroll
                        for (int hh = 0; hh < 2; ++hh) {
                            const f32x2 o = swiglu2((f32x2){acc[ai][0][m][n][2 * hh], acc[ai][0][m][n][2 * hh + 1]}, (f32x2){acc[ai][1][m][n][2 * hh], acc[ai][1][m][n][2 * hh + 1]},
                                                    (f32x2){bg[n][2 * hh], bg[n][2 * hh + 1]}, (f32x2){bl[n][2 * hh], bl[n][2 * hh + 1]});
                            p = hh ? __builtin_amdgcn_cvt_pk_fp8_f32(o[0], o[1], p, true) : __builtin_amdgcn_cvt_pk_fp8_f32(o[0], o[1], p, false); }
                        if (n == 0) w[mm].x = (unsigned)p; else w[mm].y = (unsigned)p; } }
                const auto sx = __builtin_amdgcn_permlane16_swap(w[0].x, w[1].x, false, false); const auto sy = __builtin_amdgcn_permlane16_swap(w[0].y, w[1].y, false, false);
                const int r = rl + ai * 128 + (2 * mp + (fq & 1)) * 16;
                *(u32x4*)(act + (size_t)r * 1024 - 8 * (fq & 1)) = (u32x4){sx[0], sy[0], sx[1], sy[1]}; }
    }
};
constexpr float S_SL = 16.f;
struct EpiMoe2 {
    unsigned char* ws;
    __device__ __forceinline__ void operator()(const f32x4 (&acc)[2][2][4][2], const Unit& u, int wr, int wc, int fr, int fq, const LAS float* bs) const {
        const int rl = wr * 64 + fr, cl = wc * 32 + 8 * fq, ct = u.col0;
        const LAS float* bb = bs + cl;
        unsigned char* slots = (unsigned char*)(ws + WS_SLOTS) + (size_t)u.row0 * 1024 + 256 * ct + cl;
        f32x4 bv[2][2];
#pragma unroll
        for (int bj = 0; bj < 2; ++bj)
#pragma unroll
            for (int n = 0; n < 2; ++n) bv[bj][n] = *(const LAS f32x4*)(bb + bj * 128 + 4 * n) * S_SL;
#pragma unroll
        for (int ai = 0; ai < 2; ++ai)
#pragma unroll
            for (int m = 0; m < 4; ++m) { const int r = rl + ai * 128 + m * 16;
                u32x2 w[2];
#pragma unroll
                for (int bj = 0; bj < 2; ++bj) { const f32x4 y0 = acc[ai][bj][m][0] * (S_SL / (S_ACT * S_W)) + bv[bj][0], y1 = acc[ai][bj][m][1] * (S_SL / (S_ACT * S_W)) + bv[bj][1];
                    w[bj].x = pk4_fp8(y0[0], y0[1], y0[2], y0[3]); w[bj].y = pk4_fp8(y1[0], y1[1], y1[2], y1[3]); }
                const auto sx = __builtin_amdgcn_permlane16_swap(w[0].x, w[1].x, false, false); const auto sy = __builtin_amdgcn_permlane16_swap(w[0].y, w[1].y, false, false);
                *(u32x4*)(slots + (size_t)r * 1024 + ((fq & 1) ? 128 - 8 : 0)) = (u32x4){sx[0], sy[0], sx[1], sy[1]}; }
    }
};
}

namespace hy {
__device__ __forceinline__ int phys(int n) { return n + (n >> 4) + ((n >> 9) << 4); }
constexpr int XSIZE = 16384 + 1024 + 512;

__device__ __forceinline__ float tw_c(int i) {
    constexpr float t[16] = {1.f, 0.98078528040323043f, 0.92387953251128674f, 0.83146961230254524f, 0.70710678118654752f, 0.55557023301960218f, 0.38268343236508977f, 0.19509032201612825f,
                             0.f, -0.19509032201612825f, -0.38268343236508977f, -0.55557023301960218f, -0.70710678118654752f, -0.83146961230254524f, -0.92387953251128674f, -0.98078528040323043f};
    return t[i];
}
__device__ __forceinline__ float tw_s(int i) {
    constexpr float t[16] = {0.f, 0.19509032201612825f, 0.38268343236508977f, 0.55557023301960218f, 0.70710678118654752f, 0.83146961230254524f, 0.92387953251128674f, 0.98078528040323043f,
                             1.f, 0.98078528040323043f, 0.92387953251128674f, 0.83146961230254524f, 0.70710678118654752f, 0.55557023301960218f, 0.38268343236508977f, 0.19509032201612825f};
    return t[i];
}
__host__ __device__ constexpr int brev(int p, int bits) { int r = 0; for (int i = 0; i < bits; ++i) r |= ((p >> i) & 1) << (bits - 1 - i); return r; }

__device__ __forceinline__ f32x2 cmul(f32x2 a, f32x2 w) { f32x2 r;
    asm("v_pk_mul_f32 %0, %1, %2 op_sel_hi:[1,0]\n\tv_pk_fma_f32 %0, %1, %2, %0 op_sel:[1,1,0] op_sel_hi:[0,1,1] neg_lo:[0,1,0]" : "=&v"(r) : "v"(a), "v"(w)); return r; }
__device__ __forceinline__ void cmul_chain(f32x2 a, f32x2 w, f32x2 w1, f32x2& o, f32x2& wn) {
    asm("v_pk_mul_f32 %0, %2, %3 op_sel_hi:[1,0]\n\tv_pk_mul_f32 %1, %3, %4 op_sel_hi:[1,0]\n\t"
        "v_pk_fma_f32 %0, %2, %3, %0 op_sel:[1,1,0] op_sel_hi:[0,1,1] neg_lo:[0,1,0]\n\tv_pk_fma_f32 %1, %3, %4, %1 op_sel:[1,1,0] op_sel_hi:[0,1,1] neg_lo:[0,1,0]"
        : "=&v"(o), "=&v"(wn) : "v"(a), "v"(w), "v"(w1)); }
template <int TI, bool INV>
__device__ __forceinline__ void bf_tw(f32x2& a, f32x2& b) {
    constexpr int T7 = TI < 8 ? TI : 16 - TI;
    const f32x2 W = {tw_c(T7), tw_s(T7)};
    f32x2 sum, o;
#define HY_BF(NEGR, NEGI) asm("v_pk_add_f32 %0, %3, %2\n\tv_pk_add_f32 %2, %3, %2 neg_lo:[0,1] neg_hi:[0,1]\n\tv_pk_mul_f32 %1, %2, %4 op_sel_hi:[1,0]" NEGR "\n\tv_pk_fma_f32 %1, %2, %4, %1 op_sel:[1,1,0] op_sel_hi:[0,1,1] " NEGI : "=&v"(sum), "=&v"(o), "+v"(b) : "v"(a), "s"(W))
    if (TI < 8) { if (!INV) HY_BF("", "neg_hi:[0,1,0]"); else HY_BF("", "neg_lo:[0,1,0]"); }
    else        { if (!INV) HY_BF(" neg_lo:[0,1] neg_hi:[0,1]", "neg_hi:[0,1,0]"); else HY_BF(" neg_lo:[0,1] neg_hi:[0,1]", "neg_lo:[0,1,0]"); }
#undef HY_BF
    a = sum; b = o;
}
template <int TI, bool INV>
__device__ __forceinline__ f32x2 tw_mul(f32x2 t) {
    constexpr int T7 = TI < 8 ? TI : 16 - TI;
    const f32x2 W = {tw_c(T7), tw_s(T7)};
    f32x2 r;
#define HY_TW(NEGR, NEGI) asm("v_pk_mul_f32 %0, %1, %2 op_sel_hi:[1,0]" NEGR "\n\tv_pk_fma_f32 %0, %1, %2, %0 op_sel:[1,1,0] op_sel_hi:[0,1,1] " NEGI : "=&v"(r) : "v"(t), "s"(W))
    if (TI < 8) { if (!INV) HY_TW("", "neg_hi:[0,1,0]"); else HY_TW("", "neg_lo:[0,1,0]"); }
    else        { if (!INV) HY_TW(" neg_lo:[0,1] neg_hi:[0,1]", "neg_hi:[0,1,0]"); else HY_TW(" neg_lo:[0,1] neg_hi:[0,1]", "neg_lo:[0,1,0]"); }
#undef HY_TW
    return r;
}
template <bool INV>
__device__ __forceinline__ void bf_rot(f32x2& a, f32x2& b) { f32x2 sum, o;
    if (!INV) asm("v_pk_add_f32 %0, %2, %3\n\tv_pk_add_f32 %1, %2, %3 op_sel:[1,1] op_sel_hi:[0,0] neg_lo:[0,1] neg_hi:[1,0]" : "=&v"(sum), "=&v"(o) : "v"(a), "v"(b));
    else      asm("v_pk_add_f32 %0, %2, %3\n\tv_pk_add_f32 %1, %2, %3 op_sel:[1,1] op_sel_hi:[0,0] neg_lo:[1,0] neg_hi:[0,1]" : "=&v"(sum), "=&v"(o) : "v"(a), "v"(b));
    a = sum; b = o; }
__device__ __forceinline__ void bf_plain(f32x2& a, f32x2& b) { f32x2 sum, o;
    asm("v_pk_add_f32 %0, %2, %3\n\tv_pk_add_f32 %1, %2, %3 neg_lo:[0,1] neg_hi:[0,1]" : "=&v"(sum), "=&v"(o) : "v"(a), "v"(b));
    a = sum; b = o; }
template <bool INV>
__device__ __forceinline__ f32x2 rot_i(f32x2 t) { f32x2 r;
    if (!INV) asm("v_pk_mul_f32 %0, %1, 1.0 op_sel:[1,0] op_sel_hi:[0,0] neg_hi:[1,0]" : "=v"(r) : "v"(t));
    else      asm("v_pk_mul_f32 %0, %1, 1.0 op_sel:[1,0] op_sel_hi:[0,0] neg_lo:[1,0]" : "=v"(r) : "v"(t));
    return r; }

template <int R, bool INV, bool ZP, int S, int J>
__device__ __forceinline__ void fft_bfly(f32x2 (&v)[R]) {
    constexpr int g = (J / S) * 2 * S, k = J % S, ti = k * (16 / S), i0 = g + k, i1 = g + k + S;
    if constexpr (ZP && S == R / 2) {
        if constexpr (ti == 0) v[i1] = v[i0]; else if constexpr (ti == 8) v[i1] = rot_i<INV>(v[i0]); else v[i1] = tw_mul<ti, INV>(v[i0]);
    } else {
        if constexpr (ti == 0) bf_plain(v[i0], v[i1]); else if constexpr (ti == 8) bf_rot<INV>(v[i0], v[i1]); else bf_tw<ti, INV>(v[i0], v[i1]);
    }
}
template <int R, bool INV, bool ZP, int S, int J>
__device__ __forceinline__ void fft_stage(f32x2 (&v)[R]) { if constexpr (J < R / 2) { fft_bfly<R, INV, ZP, S, J>(v); fft_stage<R, INV, ZP, S, J + 1>(v); } }
template <int R, bool INV, bool ZP, int S>
__device__ __forceinline__ void fft_stages(f32x2 (&v)[R]) { if constexpr (S >= 1) { fft_stage<R, INV, ZP, S, 0>(v); fft_stages<R, INV, ZP, S / 2>(v); } }
template <int R, bool INV, bool ZP = false>
__device__ __forceinline__ void fft_reg(f32x2 (&v)[R]) { fft_stages<R, INV, ZP, R / 2>(v); }
#define XV(X) ((const volatile LAS f32x2*)(X))
template <int M, bool ZPAD = false>
__device__ __forceinline__ void pass_fwd32(LAS f32x2* X, int tid) {
    int j = (M == 512) ? (16 * ((tid >> 5) + 16 * ((tid >> 4) & 1)) + (tid & 15)) : (tid & 15);
    asm volatile("" : "+v"(j));
    const int p0 = (M == 512) ? (j + (j >> 4)) : (560 * (tid >> 4) + (tid & 15));
    constexpr int PS = (M == 512) ? 560 : 17;
    f32x2 v[32];
#pragma unroll
    for (int r = 0; r < 32; ++r) { if (ZPAD && r >= 16) v[r] = (f32x2){0.f, 0.f}; else v[r] = XV(X)[p0 + PS * r]; }
    fft_reg<32, false, ZPAD>(v);
    float sn, cs; sincospif(-2.f * (float)j / (float)(32 * M), &sn, &cs);
    const f32x2 w1 = {cs, sn}; f32x2 w = w1;
    X[p0] = v[0];
#pragma unroll
    for (int rp = 1; rp < 32; ++rp) { if (rp < 31) { f32x2 o_, wn_; cmul_chain(v[brev(rp, 5)], w, w1, o_, wn_); X[p0 + PS * rp] = o_; w = wn_; } else X[p0 + PS * rp] = cmul(v[brev(rp, 5)], w); }
}
template <int M, bool HALF = false>
__device__ __forceinline__ void pass_inv32(LAS f32x2* X, int tid) {
    int j = (M == 512) ? (16 * ((tid >> 5) + 16 * ((tid >> 4) & 1)) + (tid & 15)) : (tid & 15);
    asm volatile("" : "+v"(j));
    const int p0 = (M == 512) ? (j + (j >> 4)) : (560 * (tid >> 4) + (tid & 15));
    constexpr int PS = (M == 512) ? 560 : 17;
    float sn, cs; sincospif(2.f * (float)j / (float)(32 * M), &sn, &cs);
    const f32x2 w1 = {cs, sn}; f32x2 w = w1;
    f32x2 v[32];
    v[0] = XV(X)[p0];
#pragma unroll
    for (int rp = 1; rp < 32; ++rp) { if (rp < 31) { f32x2 wn_; cmul_chain(XV(X)[p0 + PS * rp], w, w1, v[rp], wn_); w = wn_; } else v[rp] = cmul(XV(X)[p0 + PS * rp], w); }
    fft_reg<32, true>(v);
#pragma unroll
    for (int p = 0; p < 32; ++p) { if (!HALF || brev(p, 5) < 16) X[p0 + PS * brev(p, 5)] = v[p]; }
}
typedef _Float16 f16x8h __attribute__((ext_vector_type(8)));
__device__ __forceinline__ void pass_c_store(const LAS f32x2* X, f32x2* Hs_, int tid, float scale) {
    _Float16* Hs = (_Float16*)Hs_; (void)scale;
#pragma unroll
    for (int u = 0; u < 2; ++u) { const int blk = tid + 512 * u, p0 = 17 * blk + 16 * (blk >> 5);
        f32x2 v[16];
#pragma unroll
        for (int r = 0; r < 16; ++r) v[r] = XV(X)[p0 + r];
        fft_reg<16, false>(v);
#pragma unroll
        for (int q = 0; q < 4; ++q) { f16x8h o;
#pragma unroll
            for (int e = 0; e < 4; ++e) { const f32x2 x = v[brev(4 * q + e, 4)]; o[2 * e] = (_Float16)x[0]; o[2 * e + 1] = (_Float16)x[1]; }
            *(f16x8h*)(Hs + 2 * (16 * blk + 4 * q)) = o; } }
}
__device__ __forceinline__ void pass_c_mul_inv(LAS f32x2* X, const f32x2* Hs_, int tid) {
    const _Float16* Hs = (const _Float16*)Hs_;
#pragma unroll
    for (int u = 0; u < 2; ++u) { const int blk = tid + 512 * u, p0 = 17 * blk + 16 * (blk >> 5);
        f32x2 v[16], w[16];
#pragma unroll
        for (int r = 0; r < 16; ++r) v[r] = XV(X)[p0 + r];
        f16x8h hh[4];
#pragma unroll
        for (int q = 0; q < 4; ++q) hh[q] = *(const f16x8h*)(Hs + 2 * (16 * blk + 4 * q));
        fft_reg<16, false>(v);
#pragma unroll
        for (int q = 0; q < 4; ++q)
#pragma unroll
            for (int e = 0; e < 4; ++e) w[4 * q + e] = cmul(v[brev(4 * q + e, 4)], (f32x2){(float)hh[q][2 * e], (float)hh[q][2 * e + 1]});
        fft_reg<16, true>(w);
#pragma unroll
        for (int p = 0; p < 16; ++p) X[p0 + brev(p, 4)] = w[p]; }
}
__device__ __forceinline__ void load16(const bf16_t* u, float (&e)[16]) {
    const u32x4 a = *(const u32x4*)u, b = *(const u32x4*)(u + 8);
    e[0] = bflo(a.x); e[1] = bfhi(a.x); e[2] = bflo(a.y); e[3] = bfhi(a.y); e[4] = bflo(a.z); e[5] = bfhi(a.z); e[6] = bflo(a.w); e[7] = bfhi(a.w);
    e[8] = bflo(b.x); e[9] = bfhi(b.x); e[10] = bflo(b.y); e[11] = bfhi(b.y); e[12] = bflo(b.z); e[13] = bfhi(b.z); e[14] = bflo(b.w); e[15] = bfhi(b.w);
}
__device__ __forceinline__ void sconv16(const bf16_t* u, int tid, float w0, float w1, float w2, float bias, float (&o)[16]) {
    float e[16]; load16(u + 16 * tid, e);
    float lf = __shfl_up(e[15], 1), rt = __shfl_down(e[0], 1);
    if ((tid & 3) == 0) lf = 0.f;
    if ((tid & 3) == 3) rt = 0.f;
    o[0] = w0 * lf + w1 * e[0] + w2 * e[1] + bias;
#pragma unroll
    for (int i = 1; i < 15; ++i) o[i] = w0 * e[i - 1] + w1 * e[i] + w2 * e[i + 1] + bias;
    o[15] = w0 * e[14] + w1 * e[15] + w2 * rt + bias;
}

constexpr int CV_SPLIT = NE * 128 * 20;
constexpr int CV_ITEMS = NE * 128 * 32;
struct CvJob { float v[8]; int mi; };
__device__ __forceinline__ void cv_issue(const Args& a, CvJob& jb, int mi, int lane) {
    jb.mi = mi;
    if (mi >= 0) { const int e = mi >> 12, kg = (mi >> 5) & 127, nb = mi & 31;
        const float* src = a.in[I_EW1] + ((size_t)e * 1024 + 8 * kg) * 2048 + 64 * nb + lane;
#pragma unroll
        for (int i = 0; i < 8; ++i) jb.v[i] = src[(size_t)i * 2048]; }
}
__device__ __forceinline__ void cv_finish(const Args& a, const CvJob& jb, int lane) {
    if (jb.mi >= 0) { const int mi = jb.mi, e = mi >> 12, kg = (mi >> 5) & 127, nb = mi & 31;
        const int cs = 64 * nb + lane, sgl = cs & 1, ac = cs >> 1, ct = ac >> 7, jj = ac & 127;
        unsigned char* dst = (unsigned char*)(a.ws + WS_W1T) + ((size_t)e * 2048 + 256 * ct + 128 * sgl + jj) * 1024 + 8 * kg;
        u32x2 o; o.x = gm::pk4_fp8_nc(jb.v[0] * gm::S_W, jb.v[1] * gm::S_W, jb.v[2] * gm::S_W, jb.v[3] * gm::S_W); o.y = gm::pk4_fp8_nc(jb.v[4] * gm::S_W, jb.v[5] * gm::S_W, jb.v[6] * gm::S_W, jb.v[7] * gm::S_W);
        *(u32x2*)dst = o; }
}
struct CvState { CvJob jb; int next, stride, end; };
__device__ __forceinline__ void cv_step(const Args& a, CvState& st, int lane) {
    cv_finish(a, st.jb, lane);
    const int mi = st.next < st.end ? st.next : -1;
    cv_issue(a, st.jb, mi, lane);
    st.next += st.stride;
}

__device__ __forceinline__ void channel(const Args& a, LAS unsigned char* lds, int c, unsigned char* scratch, CvState& cvs) {
    const int tid = threadIdx.x;
#define CV_STEP() cv_step(a, cvs, tid & 63)
    LAS f32x2* X = (LAS f32x2*)lds;
    f32x2* Hs = (f32x2*)scratch;
    const _Float16* HF = (const _Float16*)(a.ws + WS_HF);
    const int pc = 17 * tid + 16 * (tid >> 5);
    __syncthreads();
#pragma unroll 1
    for (int o = 0; o < 2; ++o) {
        typedef _Float16 f16x8_ __attribute__((ext_vector_type(8)));
        const f16x8_* hf = (const f16x8_*)(HF + ((size_t)(2 * o) * HYW + c) * SEQ + 16 * tid); const f16x8_* hb = (const f16x8_*)(HF + ((size_t)(2 * o + 1) * HYW + c) * SEQ + 16 * tid);
#pragma unroll
        for (int q = 0; q < 2; ++q) { const f16x8_ f = hf[q], b = hb[q];
#pragma unroll
            for (int e = 0; e < 8; ++e) { const int i = 8 * q + e, t = 16 * tid + i;
                X[pc + i] = (f32x2){(float)f[e], 0.f};
                if (t >= 1) X[phys(FFTN - t)] = (f32x2){(float)b[e], 0.f}; } }
        if (tid == 0) X[phys(SEQ)] = (f32x2){0.f, 0.f};
        __syncthreads();
        CV_STEP(); pass_fwd32<512>(X, tid); __syncthreads(); CV_STEP(); pass_fwd32<16>(X, tid); __syncthreads(); pass_c_store(X, Hs + (size_t)o * (FFTN / 2), tid, 1.f); __syncthreads();
    }
    const float* cw = a.in[I_CONVW]; const float* cbv = a.in[I_CONVB]; const float* dbias = a.in[I_BIASD];
    const float d1 = dbias[c], d2 = dbias[HYW + c];
    constexpr float INVN = 1.f / (float)FFTN;
    float wv[3][3], bv[3];
#pragma unroll
    for (int s = 0; s < 3; ++s) { bv[s] = cbv[s * HYW + c];
#pragma unroll
        for (int i = 0; i < 3; ++i) wv[s][i] = cw[i * HYC + s * HYW + c]; }
    const bf16_t* UT = (const bf16_t*)(a.ws + WS_UT);
    bf16_t* YT = (bf16_t*)(a.ws + WS_YHYT);
#pragma unroll 1
    for (int bp = 0; bp < 2; ++bp) {
        const bf16_t* u0 = UT + ((size_t)(2 * bp) * HYC + c) * SEQ; const bf16_t* u1 = UT + ((size_t)(2 * bp + 1) * HYC + c) * SEQ;
        float z0[16], z1[16];
        {
            float v0[16], v1[16]; sconv16(u0, tid, wv[0][0], wv[0][1], wv[0][2], bv[0], v0); sconv16(u1, tid, wv[0][0], wv[0][1], wv[0][2], bv[0], v1);
#pragma unroll
            for (int i = 0; i < 16; ++i) X[pc + i] = (f32x2){v0[i], v1[i]};
        }
        __syncthreads();
        CV_STEP(); pass_fwd32<512, true>(X, tid); __syncthreads(); CV_STEP(); pass_fwd32<16>(X, tid); __syncthreads(); pass_c_mul_inv(X, Hs, tid); __syncthreads(); CV_STEP(); pass_inv32<16>(X, tid); __syncthreads(); CV_STEP(); pass_inv32<512, true>(X, tid); __syncthreads();
        {
            float v0[16], v1[16], x0[16], x1[16];
            sconv16(u0, tid, wv[0][0], wv[0][1], wv[0][2], bv[0], v0); sconv16(u1, tid, wv[0][0], wv[0][1], wv[0][2], bv[0], v1);
            sconv16(u0 + (size_t)HYW * SEQ, tid, wv[1][0], wv[1][1], wv[1][2], bv[1], x0); sconv16(u1 + (size_t)HYW * SEQ, tid, wv[1][0], wv[1][1], wv[1][2], bv[1], x1);
#pragma unroll
            for (int i = 0; i < 16; ++i) { const f32x2 y1 = X[pc + i]; z0[i] = x0[i] * (y1[0] * INVN + d1 * v0[i]); z1[i] = x1[i] * (y1[1] * INVN + d1 * v1[i]); X[pc + i] = (f32x2){z0[i], z1[i]}; }
        }
        __syncthreads();
        CV_STEP(); pass_fwd32<512, true>(X, tid); __syncthreads(); CV_STEP(); pass_fwd32<16>(X, tid); __syncthreads(); pass_c_mul_inv(X, Hs + FFTN / 2, tid); __syncthreads(); CV_STEP(); pass_inv32<16>(X, tid); __syncthreads(); CV_STEP(); pass_inv32<512, true>(X, tid); __syncthreads();
        {
            float x0[16], x1[16];
            sconv16(u0 + (size_t)2 * HYW * SEQ, tid, wv[2][0], wv[2][1], wv[2][2], bv[2], x0); sconv16(u1 + (size_t)2 * HYW * SEQ, tid, wv[2][0], wv[2][1], wv[2][2], bv[2], x1);
            unsigned w0[8], w1[8];
#pragma unroll
            for (int i = 0; i < 8; ++i) { const f32x2 ya = X[pc + 2 * i], yb = X[pc + 2 * i + 1];
                w0[i] = pk2(x0[2 * i] * (ya[0] * INVN + d2 * z0[2 * i]), x0[2 * i + 1] * (yb[0] * INVN + d2 * z0[2 * i + 1]));
                w1[i] = pk2(x1[2 * i] * (ya[1] * INVN + d2 * z1[2 * i]), x1[2 * i + 1] * (yb[1] * INVN + d2 * z1[2 * i + 1])); }
            u32x4* y0p = (u32x4*)(YT + ((size_t)(2 * bp) * HYW + c) * SEQ + 16 * tid); u32x4* y1p = (u32x4*)(YT + ((size_t)(2 * bp + 1) * HYW + c) * SEQ + 16 * tid);
            y0p[0] = (u32x4){w0[0], w0[1], w0[2], w0[3]}; y0p[1] = (u32x4){w0[4], w0[5], w0[6], w0[7]};
            y1p[0] = (u32x4){w1[0], w1[1], w1[2], w1[3]}; y1p[1] = (u32x4){w1[4], w1[5], w1[6], w1[7]};
        }
        __syncthreads();
    }
#undef CV_STEP
}

__device__ __forceinline__ void filter_item(const Args& a, int item, int lane) {
    const int ct = item & 127, tc = item >> 7;
    const float* hid2 = (const float*)(a.ws + WS_HID2); const float* wout = a.in[I_FWOUT]; _Float16* HF = (_Float16*)(a.ws + WS_HF);
    const int col = 16 * ct + (lane & 15), kq = lane >> 4, cch = col & 511;
    typedef _Float16 f16x8f __attribute__((ext_vector_type(8)));
    f16x8f bfr[2];
#pragma unroll
    for (int s = 0; s < 2; ++s)
#pragma unroll
        for (int i = 0; i < 8; ++i) bfr[s][i] = (_Float16)wout[(size_t)(32 * s + 8 * kq + i) * 2048 + col];
    const float dlt = fabsf(-3.0701134573253945f + (float)cch * ((-15.350567286626973f + 3.0701134573253945f) / 511.f));
#pragma unroll 4
    for (int tt = 0; tt < 32; ++tt) { const int t0 = 512 * tc + 16 * tt;
        const f32x4* ar = (const f32x4*)(hid2 + (size_t)(t0 + (lane & 15)) * 64 + 8 * kq);
        const f32x4 a0 = ar[0], a1 = ar[1], a2 = ar[8], a3 = ar[9];
        const f16x8f af0 = {(_Float16)a0[0], (_Float16)a0[1], (_Float16)a0[2], (_Float16)a0[3], (_Float16)a1[0], (_Float16)a1[1], (_Float16)a1[2], (_Float16)a1[3]};
        const f16x8f af1 = {(_Float16)a2[0], (_Float16)a2[1], (_Float16)a2[2], (_Float16)a2[3], (_Float16)a3[0], (_Float16)a3[1], (_Float16)a3[2], (_Float16)a3[3]};
        f32x4 acc = {0.f, 0.f, 0.f, 0.f};
        acc = __builtin_amdgcn_mfma_f32_16x16x32_f16(af0, bfr[0], acc, 0, 0, 0);
        acc = __builtin_amdgcn_mfma_f32_16x16x32_f16(af1, bfr[1], acc, 0, 0, 0);
        f32x4 o;
#pragma unroll
        for (int r = 0; r < 4; ++r) o[r] = acc[r] * __expf(-((float)(t0 + 4 * kq + r) / (float)(SEQ - 1)) * dlt);
        typedef _Float16 f16x4_ __attribute__((ext_vector_type(4)));
        *(f16x4_*)(HF + (size_t)col * SEQ + t0 + 4 * kq) = (f16x4_){(_Float16)o[0], (_Float16)o[1], (_Float16)o[2], (_Float16)o[3]}; }
}

__device__ __forceinline__ void transpose_item(const Args& a, int item, int lane) {
    const int lt = item & 127, ct = (item >> 7) & 7, b = item >> 10;
    const bf16_t* src = (const bf16_t*)(a.ws + WS_YHYT) + ((size_t)b * HYW + 64 * ct) * SEQ + 64 * lt + lane;
    bf16_t* dst = (bf16_t*)(a.ws + WS_MIX) + ((size_t)b * SEQ + 64 * lt + lane) * 1024 + 512 + 64 * ct;
    unsigned short v[64];
#pragma unroll
    for (int cc = 0; cc < 64; ++cc) v[cc] = src[(size_t)cc * SEQ];
#pragma unroll
    for (int q = 0; q < 8; ++q)
        *(u32x4*)(dst + 8 * q) = (u32x4){(unsigned)v[8 * q] | ((unsigned)v[8 * q + 1] << 16), (unsigned)v[8 * q + 2] | ((unsigned)v[8 * q + 3] << 16),
                                         (unsigned)v[8 * q + 4] | ((unsigned)v[8 * q + 5] << 16), (unsigned)v[8 * q + 6] | ((unsigned)v[8 * q + 7] << 16)};
}
}

__device__ __forceinline__ void p0_mod_and_filter(const Args& a, LAS unsigned char* lds) {
    const int tid = threadIdx.x, lane = tid & 63, wave = tid >> 6;
    const float* c = a.in[I_C]; const float* cctx = a.in[I_CCTX]; const float* adaw = a.in[I_ADAW]; const float* adab = a.in[I_ADAB];
    float* mod = (float*)(a.ws + WS_MOD);
    LAS float* sl = (LAS float*)lds;
    LAS float* pt = (LAS float*)lds + 5 * 1024;
    for (int i = tid; i < 5 * 1024; i += NTHREADS) { const int r = i >> 10, k = i & 1023; sl[i] = silu_f(r < 4 ? c[r * 1024 + k] : cctx[k]); }
    for (int it = blockIdx.x; it < 256; it += gridDim.x) {
        __syncthreads();
        if (tid < 504) {
            const int col = tid % 24, ks = tid / 24, n = it * 24 + col, kbeg = ks * 49, kend = (kbeg + 49 < 1024) ? kbeg + 49 : 1024;
            float acc[5] = {0.f, 0.f, 0.f, 0.f, 0.f};
#pragma unroll 7
            for (int k = kbeg; k < kend; ++k) { const float w = adaw[(size_t)k * 6144 + n];
#pragma unroll
                for (int r = 0; r < 5; ++r) acc[r] += sl[r * 1024 + k] * w; }
#pragma unroll
            for (int r = 0; r < 5; ++r) pt[(ks * 5 + r) * 24 + col] = acc[r];
        }
        __syncthreads();
        if (tid < 120) { const int r = tid / 24, col = tid % 24, n = it * 24 + col; float s = adab[n];
            for (int ks = 0; ks < 21; ++ks) s += pt[(ks * 5 + r) * 24 + col];
            mod[r * 6144 + n] = s; }
    }
    __syncthreads();
    const float* w1 = a.in[I_FW1]; const float* b1 = a.in[I_FB1]; const float* w2 = a.in[I_FW2]; const float* b2 = a.in[I_FB2]; const float* fq = a.in[I_FFREQ];
    float* hid2 = (float*)(a.ws + WS_HID2);
    LAS float* zs = (LAS float*)lds + 8192 + wave * 128;
    const float frq = fq[lane], bb1 = b1[lane], bb2 = b2[lane];
    for (int t = (blockIdx.x * NWAVES + wave); t < SEQ; t += gridDim.x * NWAVES) {
        float z = 0.f;
        if (lane == 0) z = (float)t / (float)(SEQ - 1);
        else if (lane < 33) { const int i = (lane - 1) & 15; const float f = 1e-4f + (float)i * ((15.f - 1e-4f) / 15.f);
            const float ang = (6.283185307179586f * (float)t / (float)SEQ) * f; z = (lane < 17) ? cosf(ang) : -sinf(ang); }
        if (lane < 33) zs[lane] = z;
        __builtin_amdgcn_wave_barrier(); asm volatile("s_waitcnt lgkmcnt(0)" ::: "memory");
        float s = bb1;
#pragma unroll
        for (int e = 0; e < 33; ++e) s += zs[e] * w1[e * 64 + lane];
        const float h1 = sinf(frq * s);
        zs[64 + lane] = h1;
        __builtin_amdgcn_wave_barrier(); asm volatile("s_waitcnt lgkmcnt(0)" ::: "memory");
        float s2 = bb2;
#pragma unroll 16
        for (int g = 0; g < 64; ++g) s2 += zs[64 + g] * w2[g * 64 + lane];
        hid2[(size_t)t * 64 + lane] = sinf(frq * s2);
        __builtin_amdgcn_wave_barrier(); asm volatile("s_waitcnt lgkmcnt(0)" ::: "memory");
    }
}

template <bool FP8 = false>
__device__ __forceinline__ void tr_item(const float* W, int ldw, int k0, int c0, int cstride, float scale, bf16_t* dstrow0, LAS float* scr, int lane) {
    float wv_[32];
#pragma unroll
    for (int i = 0; i < 32; ++i) wv_[i] = W[(size_t)(k0 + 2 * i + (lane >> 5)) * ldw + c0 + (lane & 31) * cstride];
#pragma unroll
    for (int i = 0; i < 32; ++i) scr[(2 * i + (lane >> 5)) * 33 + (lane & 31)] = wv_[i] * scale;
    asm volatile("s_waitcnt lgkmcnt(0)" ::: "memory"); __builtin_amdgcn_wave_barrier();
    const int c = lane & 7;
#pragma unroll
    for (int j = 0; j < 4; ++j) { const int n = (lane >> 3) + 8 * j; const LAS float* s = scr + (8 * c) * 33 + n;
        if (FP8) { u32x2 o; o.x = gm::pk4_fp8(s[0 * 33], s[1 * 33], s[2 * 33], s[3 * 33]); o.y = gm::pk4_fp8(s[4 * 33], s[5 * 33], s[6 * 33], s[7 * 33]);
            *(u32x2*)((unsigned char*)dstrow0 + (size_t)n * 1024 + k0 + 8 * c) = o; }
        else { u32x4 o; o.x = pk2(s[0 * 33], s[1 * 33]); o.y = pk2(s[2 * 33], s[3 * 33]); o.z = pk2(s[4 * 33], s[5 * 33]); o.w = pk2(s[6 * 33], s[7 * 33]);
            *(u32x4*)(dstrow0 + (size_t)n * 1024 + k0 + 8 * c) = o; } }
    asm volatile("s_waitcnt lgkmcnt(0)" ::: "memory"); __builtin_amdgcn_wave_barrier();
}
__device__ __forceinline__ void fold_item(const float* win, const float* wa, int dir, int k0, int j0, bf16_t* dstrow0, LAS float* scr, int lane) {
#pragma unroll 4
    for (int i = 0; i < 32; ++i) { const int kk = 2 * i + (lane >> 5); const float* wr = win + (size_t)(k0 + kk) * INW + 1536 + 16 * dir; float s = 0.f;
#pragma unroll
        for (int r = 0; r < 16; ++r) s += wr[r] * wa[r * 256 + j0 + (lane & 31)];
        scr[kk * 33 + (lane & 31)] = s; }
    asm volatile("s_waitcnt lgkmcnt(0)" ::: "memory"); __builtin_amdgcn_wave_barrier();
    const int c = lane & 7;
#pragma unroll
    for (int j = 0; j < 4; ++j) { const int n = (lane >> 3) + 8 * j; const LAS float* s = scr + (8 * c) * 33 + n;
        u32x4 o; o.x = pk2(s[0 * 33], s[1 * 33]); o.y = pk2(s[2 * 33], s[3 * 33]); o.z = pk2(s[4 * 33], s[5 * 33]); o.w = pk2(s[6 * 33], s[7 * 33]);
        *(u32x4*)(dstrow0 + (size_t)n * 1024 + k0 + 8 * c) = o; }
    asm volatile("s_waitcnt lgkmcnt(0)" ::: "memory"); __builtin_amdgcn_wave_barrier();
}
__device__ __forceinline__ void ln_mod_row(const float* xrow, const float* shift, const float* scale, bf16_t* orow, int lane) {
    const f32x4* xr = (const f32x4*)xrow + lane;
    f32x4 v[4]; float s = 0.f;
#pragma unroll
    for (int j = 0; j < 4; ++j) { v[j] = xr[64 * j]; s += (v[j][0] + v[j][1]) + (v[j][2] + v[j][3]); }
    const float mean = wave_sum(s) * (1.f / D); float s2 = 0.f;
#pragma unroll
    for (int j = 0; j < 4; ++j) { v[j] = v[j] - mean; s2 += (v[j][0] * v[j][0] + v[j][1] * v[j][1]) + (v[j][2] * v[j][2] + v[j][3] * v[j][3]); }
    const float rstd = 1.f / sqrtf(wave_sum(s2) * (1.f / D) + LN_EPS);
    u32x2* o8 = (u32x2*)orow + lane;
#pragma unroll
    for (int j = 0; j < 4; ++j) { const f32x4 sh = ((const f32x4*)shift)[64 * j + lane], sc = ((const f32x4*)scale)[64 * j + lane];
        const f32x4 y = v[j] * rstd * (sc + 1.f) + sh;
        u32x2 w; w.x = pk2(y[0], y[1]); w.y = pk2(y[2], y[3]); o8[64 * j] = w; }
}
constexpr int PREP_I_IN = 16 * 96, PREP_I_FOLD = 16 * 8 * 2, PREP_I_OUT = 16 * 32, PREP_I_W1 = NE * 16 * 64, PREP_I_W2 = NE * 16 * 32;
constexpr int PREP_NITEMS = PREP_I_IN + PREP_I_FOLD + PREP_I_OUT + PREP_I_W1 + PREP_I_W2;
constexpr int PREP_DEFER = 10880;
__device__ __forceinline__ void prep_items(const Args& a, LAS float* scr, int first, int last, int rank, int nranks, int lane) {
    constexpr int I_IN = PREP_I_IN, I_FOLD = PREP_I_FOLD, I_OUT = PREP_I_OUT, I_W1 = PREP_I_W1;
    const float* win = a.in[I_WIN];
    bf16_t* btin = (bf16_t*)(a.ws + WS_BTIN); bf16_t* btout = (bf16_t*)(a.ws + WS_BTOUT); bf16_t* w1t = (bf16_t*)(a.ws + WS_W1T); bf16_t* w2t = (bf16_t*)(a.ws + WS_W2T);
    for (int it = first + rank; it < last; it += nranks) {
        int r = it;
        if (r < I_IN) {
            const int kb = r / 96, nb = r % 96;
            if (nb < 48) tr_item(win, INW, 64 * kb, 32 * nb, 1, nb < 8 ? 0.125f : 1.f, btin + (size_t)(32 * nb) * 1024, scr, lane);
            else tr_item(win, INW, 64 * kb, 1568 + 32 * (nb - 48), 1, 1.f, btin + (size_t)(2048 + 32 * (nb - 48)) * 1024, scr, lane);
            continue; }
        r -= I_IN;
        if (r < I_FOLD) { const int dir = r & 1, jb = (r >> 1) & 7, kb = r >> 4;
            fold_item(win, dir ? a.in[I_WAB] : a.in[I_WAF], dir, 64 * kb, 32 * jb, btin + (size_t)(1536 + 256 * dir + 32 * jb) * 1024, scr, lane); continue; }
        r -= I_FOLD;
        if (r < I_OUT) { const int kb = r / 32, nb = r % 32; tr_item(a.in[I_WOUT], 1024, 64 * kb, 32 * nb, 1, 1.f, btout + (size_t)(32 * nb) * 1024, scr, lane); continue; }
        r -= I_OUT;
        if (r < I_W1) {
            const int e = r / 1024, q = r % 1024, s = q & 1, nb = (q >> 1) & 31, kb = q >> 6;
            const int ct = nb >> 2, jj0 = (nb & 3) * 32;
            tr_item<true>(a.in[I_EW1] + (size_t)e * 1024 * 2048, 2048, 64 * kb, 2 * (128 * ct + jj0) + s, 2, gm::S_W, (bf16_t*)((unsigned char*)w1t + ((size_t)e * 2048 + 256 * ct + 128 * s + jj0) * 1024), scr, lane);
            continue; }
        r -= I_W1;
        { const int e = r / 512, q = r % 512, kb = q / 32, nb = q % 32;
          tr_item<true>(a.in[I_EW2] + (size_t)e * 1024 * 1024, 1024, 64 * kb, 32 * nb, 1, gm::S_W, (bf16_t*)((unsigned char*)w2t + ((size_t)e * 1024 + 32 * nb) * 1024), scr, lane); }
    }
}
__device__ __forceinline__ void p1_prep(const Args& a, LAS unsigned char* lds) {
    const int tid = threadIdx.x, lane = tid & 63, wave = tid >> 6;
    LAS float* scr = (LAS float*)(lds + wave * 16384);
    const int gw = blockIdx.x * NWAVES + wave, NGW = gridDim.x * NWAVES;
    const float* win = a.in[I_WIN];
    bf16_t* btin = (bf16_t*)(a.ws + WS_BTIN); bf16_t* btout = (bf16_t*)(a.ws + WS_BTOUT); bf16_t* w1t = (bf16_t*)(a.ws + WS_W1T); bf16_t* w2t = (bf16_t*)(a.ws + WS_W2T);
    const float* mod = (const float*)(a.ws + WS_MOD);
    bf16_t* H = (bf16_t*)(a.ws + WS_H);
#pragma unroll 2
    for (int row = gw; row < TT; row += NGW) {
        const float* xr; int mr;
        if (row < T) { xr = a.in[I_X] + (size_t)row * D; mr = row >> 13; } else { xr = a.in[I_CTX] + (size_t)(row - T) * D; mr = 4; }
        ln_mod_row(xr, mod + mr * 6144, mod + mr * 6144 + 1024, H + (size_t)row * D, lane);
    }
    prep_items(a, scr, 0, PREP_I_IN + PREP_I_FOLD + PREP_I_OUT, gw, NGW, lane);
    prep_items(a, scr, PREP_I_IN + PREP_I_FOLD + PREP_I_OUT + PREP_I_W1, PREP_NITEMS - PREP_DEFER, gw, NGW, lane);
    for (int it = gw; it < 2048; it += NGW) hy::filter_item(a, it, lane);
    float* b1r = (float*)(a.ws + WS_B1R); const float* eb1 = a.in[I_EB1];
    for (int i = blockIdx.x * NTHREADS + tid; i < NE * 2048; i += gridDim.x * NTHREADS) {
        const int e = i >> 11, n = i & 2047, ct = n >> 8, s = (n >> 7) & 1, jj = n & 127;
        b1r[i] = eb1[(size_t)e * 2048 + 2 * (128 * ct + jj) + s];
    }
}

namespace gla {
constexpr int RS = 72;
constexpr int L_TOTF = 0, L_TOTB = 2048, L_SSQ = 4096;
constexpr int L_T0 = 8192;
constexpr int L_T1 = L_T0 + 9216, L_T2 = L_T1 + 9216, L_T3 = L_T2 + 9216;
constexpr int L_VT = L_T3 + 9216;
constexpr int L_P  = L_VT + 18432;
constexpr int L_SF = L_P + 9216, L_SB = L_SF + 18432;
constexpr int L_END = L_SB + 18432;

__device__ __forceinline__ bf16x8 frag(const LAS unsigned char* tile, int row, int k0, int lane) {
    return *(const LAS bf16x8*)(tile + ((row + (lane & 15)) * RS + k0 + 8 * (lane >> 4)) * 2);
}
__device__ __forceinline__ void chunk_cums_pre(LAS unsigned char* L, const float (&gf)[8], const float (&gb)[8], int wave, int lane, float (&cumf)[8], float (&cumb)[8], float& allf, float& allb) {
    LAS float* totf = (LAS float*)(L + L_TOTF); LAS float* totb = (LAS float*)(L + L_TOTB);
    cumf[0] = gf[0];
#pragma unroll
    for (int r = 1; r < 8; ++r) cumf[r] = cumf[r - 1] + gf[r];
    cumb[7] = gb[7];
#pragma unroll
    for (int r = 6; r >= 0; --r) cumb[r] = cumb[r + 1] + gb[r];
    totf[wave * 64 + lane] = cumf[7]; totb[wave * 64 + lane] = cumb[0];
    __syncthreads();
    float of = 0.f, ob = 0.f, af = 0.f, ab = 0.f;
#pragma unroll
    for (int w = 0; w < 8; ++w) { const float tf = totf[w * 64 + lane], tb = totb[w * 64 + lane]; af += tf; ab += tb; of += (w < wave) ? tf : 0.f; ob += (w > wave) ? tb : 0.f; }
#pragma unroll
    for (int r = 0; r < 8; ++r) { cumf[r] += of; cumb[r] += ob; }
    allf = af; allb = ab;
}
__device__ __forceinline__ void chunk_cums(LAS unsigned char* L, const _Float16* GF, const _Float16* GB, size_t tok0, int h, int wave, int lane, float (&cumf)[8], float (&cumb)[8], float& allf, float& allb) {
    float gf[8], gb[8];
#pragma unroll
    for (int r = 0; r < 8; ++r) { const size_t o = (tok0 + 8 * wave + r) * 256 + h * 64 + lane; gf[r] = (float)GF[o]; gb[r] = (float)GB[o]; }
    chunk_cums_pre(L, gf, gb, wave, lane, cumf, cumb, allf, allb);
}
__device__ __forceinline__ void store_vt(LAS unsigned char* L, const u32x4 (&vr)[2], int tid) {
    LAS bf16_t* vt = (LAS bf16_t*)(L + L_VT);
    const int j = tid >> 3, c8 = tid & 7;
#pragma unroll
    for (int q = 0; q < 2; ++q) { const int dv0 = 8 * (c8 + 8 * q);
        const unsigned ww[4] = {vr[q].x, vr[q].y, vr[q].z, vr[q].w};
#pragma unroll
        for (int e = 0; e < 4; ++e) { vt[(dv0 + 2 * e) * RS + j] = (bf16_t)(ww[e] & 0xffffu); vt[(dv0 + 2 * e + 1) * RS + j] = (bf16_t)(ww[e] >> 16); } }
}
__device__ __forceinline__ void load_vt(LAS unsigned char* L, const bf16_t* V, size_t tok0, int h, int tid) {
    const int j = tid >> 3, c8 = tid & 7; u32x4 vr[2];
#pragma unroll
    for (int q = 0; q < 2; ++q) vr[q] = *(const u32x4*)(V + (tok0 + j) * 512 + h * 128 + 8 * (c8 + 8 * q));
    store_vt(L, vr, tid);
}

__device__ __forceinline__ void g1_unit(const Args& a, LAS unsigned char* L, int bh, int chunk  ) {
    const int tid = threadIdx.x, lane = tid & 63, wave = __builtin_amdgcn_readfirstlane(tid >> 6);
    const int b = bh >> 2, h = bh & 3;
    const size_t tok0 = chunk < NCHUNK ? (size_t)b * SEQ + (size_t)chunk * CH : (size_t)T + (size_t)b * CTXL + (size_t)(chunk - NCHUNK) * CH;
    const _Float16* GF = (const _Float16*)(a.ws + WS_GF); const _Float16* GB = (const _Float16*)(a.ws + WS_GB);
    const bf16_t* Kb = (const bf16_t*)(a.ws + WS_K); const bf16_t* Vb = (const bf16_t*)(a.ws + WS_V);
    float cumf[8], cumb[8], allf, allb;
    __syncthreads();
    chunk_cums(L, GF, GB, tok0, h, wave, lane, cumf, cumb, allf, allb);
    LAS bf16_t* ketf = (LAS bf16_t*)(L + L_T0); LAS bf16_t* ketb = (LAS bf16_t*)(L + L_T1);
#pragma unroll
    for (int r = 0; r < 8; ++r) { const int i = 8 * wave + r; const float kv = bf2f(Kb[(tok0 + i) * 256 + h * 64 + lane]);
        ketf[lane * RS + i] = f2bf(kv * __expf(allf - cumf[r])); ketb[lane * RS + i] = f2bf(kv * __expf(allb - cumb[r])); }
    load_vt(L, Vb, tok0, h, tid);
    if (wave == 0) { float* av = (float*)(a.ws + WS_AV); av[((size_t)(0 * 16 + bh) * NCT + chunk) * 64 + lane] = __expf(allf); av[((size_t)(1 * 16 + bh) * NCT + chunk) * 64 + lane] = __expf(allb); }
    __syncthreads();
    bf16_t* KV = (bf16_t*)(a.ws + WS_KV);
#pragma unroll
    for (int dir = 0; dir < 2; ++dir) {
        const LAS unsigned char* ket = L + (dir ? L_T1 : L_T0);
        bf16_t* dst = KV + ((size_t)(dir * 16 + bh) * NCT + chunk) * 8192;
#pragma unroll
        for (int nt = 0; nt < 4; ++nt) { f32x4 acc = {0.f, 0.f, 0.f, 0.f};
#pragma unroll
            for (int ks = 0; ks < 2; ++ks) acc = __builtin_amdgcn_mfma_f32_16x16x32_bf16(frag(L + L_VT, 16 * wave, 32 * ks, lane), frag(ket, 16 * nt, 32 * ks, lane), acc, 0, 0, 0);
#pragma unroll
            for (int r = 0; r < 4; ++r) dst[(16 * wave + 4 * (lane >> 4) + r) * 64 + 16 * nt + (lane & 15)] = f2bf(acc[r]); }
    }
}

__device__ __forceinline__ void g2_scan(const Args& a) {
    const bf16_t* KV = (const bf16_t*)(a.ws + WS_KV); const float* AV = (const float*)(a.ws + WS_AV); bf16_t* SP = (bf16_t*)(a.ws + WS_SP);
    for (int id = blockIdx.x * NTHREADS + threadIdx.x; id < 32 * 4096; id += gridDim.x * NTHREADS) {
        const int db = id >> 12, e2 = id & 4095, dir = db >> 4, dk = (2 * e2) & 63;
        const unsigned* kv = (const unsigned*)(KV + (size_t)db * NCT * 8192) + e2;
        const float* av = AV + (size_t)db * NCT * 64 + dk;
        unsigned* sp = (unsigned*)(SP + (size_t)db * NCHUNK * 8192) + e2;
        float s0 = 0.f, s1 = 0.f;
#pragma unroll
        for (int q = 0; q < NCC; ++q) { const int c = NCHUNK + (dir ? (NCC - 1 - q) : q);
            const unsigned w = kv[(size_t)c * 4096]; const f32x2 aa = *(const f32x2*)(av + (size_t)c * 64);
            s0 = aa[0] * s0 + bflo(w); s1 = aa[1] * s1 + bfhi(w); }
        for (int q0 = 0; q0 < NCHUNK; q0 += 16) {
            unsigned w[16]; f32x2 aa[16];
#pragma unroll
            for (int u = 0; u < 16; ++u) { const int c = dir ? (NCHUNK - 1 - (q0 + u)) : (q0 + u); w[u] = kv[(size_t)c * 4096]; aa[u] = *(const f32x2*)(av + (size_t)c * 64); }
#pragma unroll
            for (int u = 0; u < 16; ++u) { const int c = dir ? (NCHUNK - 1 - (q0 + u)) : (q0 + u);
                sp[(size_t)c * 4096] = pk2(s0, s1);
                s0 = aa[u][0] * s0 + bflo(w[u]); s1 = aa[u][1] * s1 + bfhi(w[u]); }
        }
    }
}

struct G3In { float gf[8], gb[8]; bf16_t q[8], k[8]; u32x4 v[2]; u32x4 sraw[4]; bf16_t gr[4][4]; };
__device__ __forceinline__ void g3_load(const Args& a, int bh, int chunk, G3In& in) {
    const int tid = threadIdx.x, lane = tid & 63, wave = __builtin_amdgcn_readfirstlane(tid >> 6);
    const int b = bh >> 2, h = bh & 3;
    const size_t tok0 = (size_t)b * SEQ + (size_t)chunk * CH;
    const _Float16* GF = (const _Float16*)(a.ws + WS_GF); const _Float16* GB = (const _Float16*)(a.ws + WS_GB);
    const bf16_t* Qb = (const bf16_t*)(a.ws + WS_Q); const bf16_t* Kb = (const bf16_t*)(a.ws + WS_K); const bf16_t* Vb = (const bf16_t*)(a.ws + WS_V);
#pragma unroll
    for (int r = 0; r < 8; ++r) { const size_t o = (tok0 + 8 * wave + r) * 256 + h * 64 + lane; in.gf[r] = (float)GF[o]; in.gb[r] = (float)GB[o]; in.q[r] = Qb[o]; in.k[r] = Kb[o]; }
#pragma unroll
    for (int q = 0; q < 2; ++q) in.v[q] = *(const u32x4*)(Vb + (tok0 + (tid >> 3)) * 512 + h * 128 + 8 * ((tid & 7) + 8 * q));
    const bf16_t* SPf = (const bf16_t*)(a.ws + WS_SP) + ((size_t)(0 * 16 + bh) * NCHUNK + chunk) * 8192;
    const bf16_t* SPb = (const bf16_t*)(a.ws + WS_SP) + ((size_t)(1 * 16 + bh) * NCHUNK + chunk) * 8192;
    in.sraw[0] = *(const u32x4*)(SPf + 16 * tid); in.sraw[1] = *(const u32x4*)(SPf + 16 * tid + 8);
    in.sraw[2] = *(const u32x4*)(SPb + 16 * tid); in.sraw[3] = *(const u32x4*)(SPb + 16 * tid + 8);
    const bf16_t* Gt = (const bf16_t*)(a.ws + WS_G);
    const int mt = wave >> 1, fr = lane & 15, fq = lane >> 4;
#pragma unroll
    for (int q = 0; q < 4; ++q)
#pragma unroll
        for (int r = 0; r < 4; ++r) in.gr[r][q] = Gt[(tok0 + 16 * mt + 4 * fq + r) * 512 + h * 128 + 16 * (4 * (wave & 1) + q) + fr];
}
__device__ __forceinline__ void g3_unit(const Args& a, LAS unsigned char* L, int bh, int chunk  , const G3In& in, hy::CvState& cvs) {
    const int tid = threadIdx.x, lane = tid & 63, wave = __builtin_amdgcn_readfirstlane(tid >> 6);
    const int b = bh >> 2, h = bh & 3;
    const size_t tok0 = (size_t)b * SEQ + (size_t)chunk * CH;
    const int mt = wave >> 1, fr = lane & 15, fq = lane >> 4;
    float cumf[8], cumb[8], allf, allb;
    hy::cv_step(a, cvs, lane);
    __syncthreads();
    chunk_cums_pre(L, in.gf, in.gb, wave, lane, cumf, cumb, allf, allb);
    LAS bf16_t* qf = (LAS bf16_t*)(L + L_T0); LAS bf16_t* kf = (LAS bf16_t*)(L + L_T1); LAS bf16_t* qb = (LAS bf16_t*)(L + L_T2); LAS bf16_t* kb = (LAS bf16_t*)(L + L_T3);
#pragma unroll
    for (int r = 0; r < 8; ++r) { const int i = 8 * wave + r;
        const float qv = bf2f(in.q[r]), kv = bf2f(in.k[r]);
        qf[i * RS + lane] = f2bf(qv * __expf(cumf[r])); kf[i * RS + lane] = f2bf(kv * __expf(-cumf[r]));
        qb[i * RS + lane] = f2bf(qv * __expf(cumb[r])); kb[i * RS + lane] = f2bf(kv * __expf(-cumb[r])); }
    store_vt(L, in.v, tid);
    {
      LAS unsigned char* sf_ = L + L_SF + ((tid >> 2) * RS + 16 * (tid & 3)) * 2; LAS unsigned char* sb_ = L + L_SB + ((tid >> 2) * RS + 16 * (tid & 3)) * 2;
      *(LAS u32x4*)sf_ = in.sraw[0]; *(LAS u32x4*)(sf_ + 16) = in.sraw[1]; *(LAS u32x4*)sb_ = in.sraw[2]; *(LAS u32x4*)(sb_ + 16) = in.sraw[3]; }
    hy::cv_step(a, cvs, lane);
    __syncthreads();
    {
        LAS bf16_t* P = (LAS bf16_t*)(L + L_P);
#pragma unroll
        for (int q = 0; q < 2; ++q) { const int nt = 2 * (wave & 1) + q;
            f32x4 sf = {0.f, 0.f, 0.f, 0.f}, sb = {0.f, 0.f, 0.f, 0.f};
#pragma unroll
            for (int ks = 0; ks < 2; ++ks) {
                sf = __builtin_amdgcn_mfma_f32_16x16x32_bf16(frag(L + L_T0, 16 * mt, 32 * ks, lane), frag(L + L_T1, 16 * nt, 32 * ks, lane), sf, 0, 0, 0);
                sb = __builtin_amdgcn_mfma_f32_16x16x32_bf16(frag(L + L_T2, 16 * mt, 32 * ks, lane), frag(L + L_T3, 16 * nt, 32 * ks, lane), sb, 0, 0, 0); }
#pragma unroll
            for (int r = 0; r < 4; ++r) { const int i = 16 * mt + 4 * fq + r, j = 16 * nt + fr;
                P[i * RS + j] = f2bf((j <= i ? sf[r] : 0.f) + (j >= i ? sb[r] : 0.f)); } }
    }
    hy::cv_step(a, cvs, lane);
    __syncthreads();
    f32x4 o[4]; float ssq[4] = {0.f, 0.f, 0.f, 0.f};
#pragma unroll
    for (int q = 0; q < 4; ++q) { const int nt = 4 * (wave & 1) + q;
        f32x4 acc = {0.f, 0.f, 0.f, 0.f};
#pragma unroll
        for (int ks = 0; ks < 2; ++ks) {
            acc = __builtin_amdgcn_mfma_f32_16x16x32_bf16(frag(L + L_P, 16 * mt, 32 * ks, lane), frag(L + L_VT, 16 * nt, 32 * ks, lane), acc, 0, 0, 0);
            acc = __builtin_amdgcn_mfma_f32_16x16x32_bf16(frag(L + L_T0, 16 * mt, 32 * ks, lane), frag(L + L_SF, 16 * nt, 32 * ks, lane), acc, 0, 0, 0);
            acc = __builtin_amdgcn_mfma_f32_16x16x32_bf16(frag(L + L_T2, 16 * mt, 32 * ks, lane), frag(L + L_SB, 16 * nt, 32 * ks, lane), acc, 0, 0, 0); }
        o[q] = acc;
#pragma unroll
        for (int r = 0; r < 4; ++r) ssq[r] += acc[r] * acc[r]; }
    LAS float* SSQ = (LAS float*)(L + L_SSQ);
#pragma unroll
    for (int r = 0; r < 4; ++r) { float s = ssq[r]; s += __shfl_xor(s, 1); s += __shfl_xor(s, 2); s += __shfl_xor(s, 4); s += __shfl_xor(s, 8); ssq[r] = s; }
    if (fr == 0) {
#pragma unroll
        for (int r = 0; r < 4; ++r) SSQ[(wave & 1) * 64 + 16 * mt + 4 * fq + r] = ssq[r]; }
    hy::cv_step(a, cvs, lane);
    __syncthreads();
    const float* ng = a.in[I_NORMG];
    bf16_t* mix = (bf16_t*)(a.ws + WS_MIX);
#pragma unroll
    for (int r = 0; r < 4; ++r) { const int i = 16 * mt + 4 * fq + r;
        const float rstd = 1.f / sqrtf((SSQ[i] + SSQ[64 + i]) * (1.f / DV) + LN_EPS);
#pragma unroll
        for (int q = 0; q < 4; ++q) { const int dv = 16 * (4 * (wave & 1) + q) + fr;
            const float g = bf2f(in.gr[r][q]);
            mix[(tok0 + i) * 1024 + h * 128 + dv] = f2bf(o[q][r] * rstd * ng[dv] * silu_f(g)); } }
}
}

namespace rt {
constexpr int HS = 1028;
constexpr int L_H2 = 0;
constexpr int L_PART = 65792;
constexpr int L_LCNT = L_PART + 16384;
constexpr int L_REC = L_LCNT + 256;

__device__ __forceinline__ void phase(const Args& a, LAS unsigned char* lds) {
    const int tid = threadIdx.x, lane = tid & 63, wave = __builtin_amdgcn_readfirstlane(tid >> 6);
    bf16_t* xmid = (bf16_t*)(a.ws + WS_PRE1); bf16_t* H2 = (bf16_t*)(a.ws + WS_H2); const bf16_t* FG = (const bf16_t*)(a.ws + WS_FG);
    const float* mod = (const float*)(a.ws + WS_MOD);
    const float* rw = a.in[I_RW]; const float* rb = a.in[I_RB];
    LAS float* h2s = (LAS float*)(lds + L_H2); LAS float* part = (LAS float*)(lds + L_PART);
    LAS int* lcnt = (LAS int*)(lds + L_LCNT); LAS int* lbase = lcnt + 32; LAS int* rec = (LAS int*)(lds + L_REC);
    unsigned* cnt = (unsigned*)(a.ws + WS_CNT); int* list = (int*)(a.ws + WS_LIST); float* pw = (float*)(a.ws + WS_PW); int* ploc = (int*)(a.ws + WS_PLOC);
    float rwr[32][2];
#pragma unroll
    for (int s = 0; s < 32; ++s)
#pragma unroll
        for (int nt = 0; nt < 2; ++nt) rwr[s][nt] = rw[(size_t)(128 * wave + 4 * s + (lane >> 4)) * 32 + 16 * nt + (lane & 15)];
    const f32x4* g1 = (const f32x4*)a.in[I_LN1G]; const f32x4* bb1 = (const f32x4*)a.in[I_LN1B];
    if (tid < 32) lcnt[tid] = 0;
    f32x4 xq[2][4]; u32x2 fq_[2][4];
#define RT_LOAD(g_) do { _Pragma("unroll") for (int rr = 0; rr < 2; ++rr) { const int t_ = (g_) * 16 + 2 * wave + rr; \
        const f32x4* xr_ = (const f32x4*)(a.in[I_X] + (size_t)t_ * D) + lane; const u32x2* fr_ = (const u32x2*)(FG + (size_t)t_ * D) + lane; \
        _Pragma("unroll") for (int j = 0; j < 4; ++j) { xq[rr][j] = xr_[64 * j]; fq_[rr][j] = fr_[64 * j]; } } } while (0)
    if ((int)blockIdx.x < T / 16) RT_LOAD((int)blockIdx.x);
    for (int grp = blockIdx.x; grp < T / 16; grp += gridDim.x) {
        __syncthreads();
        f32x4 xv_[2][4]; u32x2 fv_[2][4];
#pragma unroll
        for (int rr = 0; rr < 2; ++rr)
#pragma unroll
            for (int j = 0; j < 4; ++j) { xv_[rr][j] = xq[rr][j]; fv_[rr][j] = fq_[rr][j]; }
        if (grp + (int)gridDim.x < T / 16) RT_LOAD(grp + (int)gridDim.x);
#pragma unroll
        for (int rr = 0; rr < 2; ++rr) {
            const int lr = 2 * wave + rr, t = grp * 16 + lr, b = t >> 13;
            u32x2* pr = (u32x2*)(xmid + (size_t)t * D) + lane;
            f32x4 v[4]; float s = 0.f;
#pragma unroll
            for (int j = 0; j < 4; ++j) { const u32x2 fw = fv_[rr][j]; const f32x4 ff = {bflo(fw.x), bfhi(fw.x), bflo(fw.y), bfhi(fw.y)};
                v[j] = xv_[rr][j] * ALPHA + ff; s += (v[j][0] + v[j][1]) + (v[j][2] + v[j][3]); }
            float mean = wave_sum(s) * (1.f / D), s2 = 0.f;
#pragma unroll
            for (int j = 0; j < 4; ++j) { v[j] = v[j] - mean; s2 += (v[j][0] * v[j][0] + v[j][1] * v[j][1]) + (v[j][2] * v[j][2] + v[j][3] * v[j][3]); }
            float rstd = 1.f / sqrtf(wave_sum(s2) * (1.f / D) + LN_EPS);
            s = 0.f;
#pragma unroll
            for (int j = 0; j < 4; ++j) { v[j] = v[j] * rstd * g1[64 * j + lane] + bb1[64 * j + lane]; u32x2 w; w.x = pk2(v[j][0], v[j][1]); w.y = pk2(v[j][2], v[j][3]); pr[64 * j] = w;
                v[j] = (f32x4){bflo(w.x), bfhi(w.x), bflo(w.y), bfhi(w.y)}; s += (v[j][0] + v[j][1]) + (v[j][2] + v[j][3]); }
            mean = wave_sum(s) * (1.f / D); s2 = 0.f;
#pragma unroll
            for (int j = 0; j < 4; ++j) { v[j] = v[j] - mean; s2 += (v[j][0] * v[j][0] + v[j][1] * v[j][1]) + (v[j][2] * v[j][2] + v[j][3] * v[j][3]); }
            rstd = 1.f / sqrtf(wave_sum(s2) * (1.f / D) + LN_EPS);
            const f32x4* sh = (const f32x4*)(mod + b * 6144 + 3 * 1024); const f32x4* sc = (const f32x4*)(mod + b * 6144 + 4 * 1024);
            unsigned* o4 = (unsigned*)((unsigned char*)H2 + (size_t)t * D) + lane;
#pragma unroll
            for (int j = 0; j < 4; ++j) { const f32x4 y = v[j] * rstd * (sc[64 * j + lane] + 1.f) + sh[64 * j + lane];
                o4[64 * j] = gm::pk4_fp8(y[0] * gm::S_H2, y[1] * gm::S_H2, y[2] * gm::S_H2, y[3] * gm::S_H2);
                *(LAS f32x4*)(h2s + lr * HS + 256 * j + 4 * lane) = y; }
        }
        __syncthreads();
        {
            f32x4 acc0 = {0.f, 0.f, 0.f, 0.f}, acc1 = {0.f, 0.f, 0.f, 0.f};
            const LAS float* ap = h2s + (lane & 15) * HS + 128 * wave + (lane >> 4);
#pragma unroll
            for (int s = 0; s < 32; ++s) { const float av = ap[4 * s];
                acc0 = __builtin_amdgcn_mfma_f32_16x16x4f32(av, rwr[s][0], acc0, 0, 0, 0);
                acc1 = __builtin_amdgcn_mfma_f32_16x16x4f32(av, rwr[s][1], acc1, 0, 0, 0); }
#pragma unroll
            for (int r = 0; r < 4; ++r) { part[(wave * 16 + 4 * (lane >> 4) + r) * 32 + (lane & 15)] = acc0[r]; part[(wave * 16 + 4 * (lane >> 4) + r) * 32 + 16 + (lane & 15)] = acc1[r]; }
        }
        __syncthreads();
        {
            const int lr = 2 * wave + (lane >> 5), e = lane & 31, t = grp * 16 + lr;
            float lg = rb[e];
#pragma unroll
            for (int w = 0; w < 8; ++w) lg += part[(w * 16 + lr) * 32 + e];
            float cur = lg, tv[4]; int ti[4];
#pragma unroll
            for (int k = 0; k < 4; ++k) { float bv = cur; int bi = e;
#pragma unroll
                for (int o = 1; o < 32; o <<= 1) { const float ov = __shfl_xor(bv, o); const int oi = __shfl_xor(bi, o); if (ov > bv || (ov == bv && oi < bi)) { bv = ov; bi = oi; } }
                tv[k] = bv; ti[k] = bi; if (bi == e) cur = -3.0e38f; }
            const float e1 = __expf(tv[1] - tv[0]), e2 = __expf(tv[2] - tv[0]), e3 = __expf(tv[3] - tv[0]);
            const float inv = 1.f / (1.f + e1 + e2 + e3);
            if (e < 4) { const float wk = (e == 0 ? 1.f : (e == 1 ? e1 : (e == 2 ? e2 : e3))) * inv; const int ek = (e == 0 ? ti[0] : (e == 1 ? ti[1] : (e == 2 ? ti[2] : ti[3])));
                const int pair = t * 4 + e;
                pw[pair] = wk;
                const int rank = __hip_atomic_fetch_add((LAS int*)&lcnt[ek], 1, __ATOMIC_RELAXED, __HIP_MEMORY_SCOPE_WORKGROUP);
                rec[lr * 4 + e] = ek | (rank << 8); }
        }
        __syncthreads();
        if (tid < 32) { const int n = lcnt[tid]; lbase[tid] = n ? (int)atomicAdd(&cnt[tid], (unsigned)n) : 0; }
        __syncthreads();
        if (tid < 64) { const int rc = rec[tid], ek = rc & 255, rank = rc >> 8, pos = lbase[ek] + rank, pair = (grp * 16 + (tid >> 2)) * 4 + (tid & 3);
            list[(size_t)ek * CAP + pos] = pair; ploc[pair] = ek | (pos << 5); }
        __syncthreads();
        if (tid < 32) lcnt[tid] = 0;
    }
#undef RT_LOAD
}
}

__device__ __forceinline__ void p_final(const Args& a, LAS unsigned char* lds) {
    const int tid = threadIdx.x, lane = tid & 63, wave = tid >> 6;
    const bf16_t* xm = (const bf16_t*)(a.ws + WS_PRE1); const unsigned char* slots = (const unsigned char*)(a.ws + WS_SLOTS); const float* mod = (const float*)(a.ws + WS_MOD);
    const int* ploc = (const int*)(a.ws + WS_PLOC); const float* pw = (const float*)(a.ws + WS_PW);
    const f32x4* g2 = (const f32x4*)a.in[I_LN2G]; const f32x4* b2 = (const f32x4*)a.in[I_LN2B];
    LAS int* tstart = (LAS int*)lds;
    __syncthreads();
    if (tid == 0) { const unsigned* cnt = (const unsigned*)(a.ws + WS_CNT); int nrt = 0; for (int e = 0; e < NE; ++e) { tstart[e] = 256 * nrt; nrt += ((int)cnt[e] + 255) >> 8; } }
    __syncthreads();
    const int tstep = gridDim.x * NWAVES; int t = blockIdx.x * NWAVES + wave;
    if (t < T) {
        int plc[4], pln[4]; float wc_[4], wn_[4]; unsigned qc[4][4], qn[4][4]; u32x2 xc[4], xn[4];
#define PF_IDX(tt, pl, ww) do { _Pragma("unroll") for (int sl = 0; sl < 4; ++sl) { pl[sl] = ploc[(tt) * 4 + sl]; ww[sl] = pw[(tt) * 4 + sl] * (1.f / gm::S_SL); } } while (0)
#define PF_DATA(tt, pl, qq, xx) do { _Pragma("unroll") for (int sl = 0; sl < 4; ++sl) { const unsigned* sr_ = (const unsigned*)(slots + (size_t)(tstart[pl[sl] & 31] + (pl[sl] >> 5)) * D) + lane; \
            _Pragma("unroll") for (int j = 0; j < 4; ++j) qq[sl][j] = sr_[64 * j]; } \
        { const u32x2* xr_ = (const u32x2*)(xm + (size_t)(tt) * D) + lane; _Pragma("unroll") for (int j = 0; j < 4; ++j) xx[j] = xr_[64 * j]; } } while (0)
        PF_IDX(t, plc, wc_); PF_DATA(t, plc, qc, xc);
        int tn = t + tstep; const bool hn0 = tn < T;
        if (hn0) PF_IDX(tn, pln, wn_);
        for (;;) {
            const bool hn = tn < T;
            if (hn) PF_DATA(tn, pln, qn, xn);
            int pl2[4]; float w2[4]; const int tn2 = tn + tstep; const bool hn2 = hn && tn2 < T;
            if (hn2) PF_IDX(tn2, pl2, w2);
            {
                const int b = t >> 13; const f32x4* gt = (const f32x4*)(mod + b * 6144 + 5 * 1024);
                f32x4 v[4]; float s = 0.f;
#pragma unroll
                for (int j = 0; j < 4; ++j) { f32x4 y = {0.f, 0.f, 0.f, 0.f};
#pragma unroll
                    for (int sl = 0; sl < 4; ++sl) { const int q = (int)qc[sl][j];
                        y[0] += wc_[sl] * __builtin_amdgcn_cvt_f32_fp8(q, 0); y[1] += wc_[sl] * __builtin_amdgcn_cvt_f32_fp8(q, 1); y[2] += wc_[sl] * __builtin_amdgcn_cvt_f32_fp8(q, 2); y[3] += wc_[sl] * __builtin_amdgcn_cvt_f32_fp8(q, 3); }
                    const f32x4 xv = {bflo(xc[j].x), bfhi(xc[j].x), bflo(xc[j].y), bfhi(xc[j].y)};
                    v[j] = xv * ALPHA + gt[64 * j + lane] * y; s += (v[j][0] + v[j][1]) + (v[j][2] + v[j][3]); }
                const float mean = wave_sum(s) * (1.f / D); float s2 = 0.f;
#pragma unroll
                for (int j = 0; j < 4; ++j) { v[j] = v[j] - mean; s2 += (v[j][0] * v[j][0] + v[j][1] * v[j][1]) + (v[j][2] * v[j][2] + v[j][3] * v[j][3]); }
                const float rstd = 1.f / sqrtf(wave_sum(s2) * (1.f / D) + LN_EPS);
                f32x4* o = (f32x4*)(a.out + (size_t)t * D) + lane;
#pragma unroll
                for (int j = 0; j < 4; ++j) o[64 * j] = v[j] * rstd * g2[64 * j + lane] + b2[64 * j + lane];
            }
            if (!hn) break;
            t = tn; tn = tn2;
#pragma unroll
            for (int sl = 0; sl < 4; ++sl) { plc[sl] = pln[sl]; wc_[sl] = wn_[sl]; pln[sl] = pl2[sl]; wn_[sl] = w2[sl];
#pragma unroll
                for (int j = 0; j < 4; ++j) qc[sl][j] = qn[sl][j]; }
#pragma unroll
            for (int j = 0; j < 4; ++j) xc[j] = xn[j];
        }
#undef PF_IDX
#undef PF_DATA
    }
}


constexpr int N_PHASES = 11;
__global__ void __launch_bounds__(NTHREADS, 2) mega_fwd(Args a) {
    extern __shared__ __attribute__((aligned(16))) unsigned char lds_raw[];
    LAS unsigned char* lds = (LAS unsigned char*)lds_raw;
    const int tid = threadIdx.x;
    volatile LAS unsigned* misc = (volatile LAS unsigned*)(lds + LDS_MISC);
    if (tid < 4) misc[tid] = 0u;
    __syncthreads();
    XcdBarrier bar; bar.bar = (unsigned*)(a.ws + WS_BAR); bar.x = 0; bar.st = misc;
    const bool multi = (a.ph_hi - a.ph_lo) > 1;
    if (multi) bar = xcd_barrier_post((unsigned*)(a.ws + WS_BAR), misc);
    const int lo = a.ph_lo, hi = a.ph_hi;
#define vcu ((gridDim.x % 8 == 0) ? (int)((blockIdx.x % 8) * (gridDim.x / 8) + blockIdx.x / 8) : (int)blockIdx.x)
#ifdef ONLY_PHASE
#define IN(k) ((k) == ONLY_PHASE && lo <= (k) && (k) < hi)
#else
#define IN(k) (lo <= (k) && (k) < hi)
#endif
#define SEAM(k) do { if (IN(k) && IN((k) + 1)) xcd_barrier(bar); } while (0)

#ifndef REPEAT_PHASE
#define REPEAT_PHASE -1
#endif
#ifdef PROF_REP
#define RUNPH(k, ...) do { if (IN(k)) { const int nrep_ = (a.rep_k == (k)) ? 2 : 1; for (int rep_ = 0; rep_ < nrep_; ++rep_) { if (rep_) xcd_barrier(bar); __VA_ARGS__; } } } while (0)
#else
#define RUNPH(k, ...) do { if (IN(k)) { __VA_ARGS__; if (REPEAT_PHASE == (k)) { xcd_barrier(bar); __VA_ARGS__; } } } while (0)
#endif
    RUNPH(0, p0_mod_and_filter(a, lds));
    SEAM(0);
    RUNPH(1, p1_prep(a, lds));
    SEAM(1);
    RUNPH(2, { gm::SchedIn S{a.ws, (int)gridDim.x, vcu, a.in[I_BAF], a.in[I_BAB]}; gm::EpiIn E{a.ws}; gm::gemm_stream<false, 0, false>(lds, S, E);
        {
          const int G = (int)gridDim.x, rounds = (1812 + G - 1) / G, extra = 1812 - (rounds - 1) * G, v = vcu;
          if (v >= extra || extra == G) { const int nidle = (extra == G) ? G : G - extra, ridle = (extra == G) ? v : v - extra; __syncthreads();
              prep_items(a, (LAS float*)(lds + (tid >> 6) * 16384), PREP_NITEMS - PREP_DEFER, PREP_NITEMS, ridle * NWAVES + (tid >> 6), nidle * NWAVES, tid & 63); } } });
    SEAM(2);
    RUNPH(3, { for (int u = blockIdx.x; u < 16 * NCT; u += gridDim.x) gla::g1_unit(a, lds, u / NCT, u % NCT); });
    SEAM(3);
    RUNPH(4, { gla::g2_scan(a);
        hy::CvState cvs; cvs.jb.mi = -1; cvs.next = (int)blockIdx.x * NWAVES + (tid >> 6); cvs.stride = (int)gridDim.x * NWAVES; cvs.end = hy::CV_SPLIT;
        for (int c = blockIdx.x; c < HYW; c += gridDim.x) hy::channel(a, lds, c, a.ws + WS_HSPEC + (size_t)blockIdx.x * HSPEC_PER_WG, cvs);
        while (cvs.jb.mi >= 0 || cvs.next < cvs.end) hy::cv_step(a, cvs, tid & 63); });
    SEAM(4);
    RUNPH(5, { hy::CvState cvs; cvs.jb.mi = -1; cvs.stride = (int)gridDim.x * NWAVES; cvs.end = hy::CV_ITEMS;
        { const int w0_ = (int)blockIdx.x * NWAVES + (tid >> 6), half_ = hy::CV_SPLIT; cvs.next = half_ + ((w0_ - half_ % cvs.stride) % cvs.stride + cvs.stride) % cvs.stride; }
        { int u = blockIdx.x; gla::G3In cur, nxt;
            if (u < 16 * NCHUNK) { gla::g3_load(a, u >> 7, u & 127, cur);
                for (;;) { const int un = u + (int)gridDim.x; const bool hn = un < 16 * NCHUNK; if (hn) gla::g3_load(a, un >> 7, un & 127, nxt);
                    gla::g3_unit(a, lds, u >> 7, u & 127, cur, cvs); if (!hn) break; cur = nxt; u = un; } } }
        while (cvs.jb.mi >= 0 || cvs.next < cvs.end) hy::cv_step(a, cvs, tid & 63);
        const int wave = tid >> 6;
        for (int it = blockIdx.x * NWAVES + wave; it < 4096; it += gridDim.x * NWAVES) hy::transpose_item(a, it, tid & 63); });
    SEAM(5);
    RUNPH(6, { gm::SchedOut S{a.ws, (int)gridDim.x, vcu}; gm::EpiOut E{a.ws}; gm::gemm_stream<false, 0, false>(lds, S, E); });
    SEAM(6);
    RUNPH(7, rt::phase(a, lds));
    SEAM(7);
    if (IN(8) || IN(9)) {
        LAS int* tab = (LAS int*)(lds + gm::LDS_TAB);
        __syncthreads();
        if (tid == 0) { const unsigned* cnt = (const unsigned*)(a.ws + WS_CNT); int nrt = 0;
            for (int e = 0; e < NE; ++e) { const int n = (int)cnt[e]; tab[e] = n; const int nt = (n + 255) >> 8; for (int k = 0; k < nt; ++k) tab[64 + nrt + k] = e | (k << 8); nrt += nt; }
            tab[32] = nrt; }
        __syncthreads();
    }
    RUNPH(8, { gm::SchedMoe<1> S{a.ws, (const LAS int*)(lds + gm::LDS_TAB), (int)gridDim.x, vcu, a.in[I_EB2]}; gm::EpiMoe1 E{a.ws}; gm::gemm_stream<true, 2, true>(lds, S, E); });
    SEAM(8);
    RUNPH(9, { gm::SchedMoe<2> S{a.ws, (const LAS int*)(lds + gm::LDS_TAB), (int)gridDim.x, vcu, a.in[I_EB2]}; gm::EpiMoe2 E{a.ws}; gm::gemm_stream<false, 0, true>(lds, S, E); });
    SEAM(9);
    RUNPH(10, p_final(a, lds));
#undef RUNPH
#undef vcu
#undef IN
#undef SEAM
}

extern "C" void kernel_launch(void* const* d_in, const int* in_sizes, int n_in, void* d_out, int out_size, void* d_ws, size_t ws_size, hipStream_t stream) {
    static int grid = 0;
    if (grid == 0) {
        if (n_in != 32 || out_size != T * D || ws_size < WS_END) { fprintf(stderr, "kernel_launch: unexpected shapes (n_in %d out %d ws %zu need %zu)\n", n_in, out_size, ws_size, (size_t)WS_END); grid = -1; return; }
        int dev = 0, cus = 0;
        if (hipGetDevice(&dev) != hipSuccess || hipDeviceGetAttribute(&cus, hipDeviceAttributeMultiprocessorCount, dev) != hipSuccess) { grid = -1; return; }
        if (hipFuncSetAttribute((const void*)mega_fwd, hipFuncAttributeMaxDynamicSharedMemorySize, LDS_BYTES) != hipSuccess) { fprintf(stderr, "kernel_launch: hipFuncSetAttribute failed\n"); grid = -1; return; }
        int per_cu = 0;
        if (hipOccupancyMaxActiveBlocksPerMultiprocessor(&per_cu, (const void*)mega_fwd, NTHREADS, LDS_BYTES) != hipSuccess || per_cu < 1) fprintf(stderr, "kernel_launch: occupancy query says %d\n", per_cu);
        (void)hipGetLastError();
        grid = cus;
        if (grid > MAX_GRID) grid = MAX_GRID;
    }
    if (grid < 0) return;
    (void)hipMemsetAsync(d_ws, 0, WS_ZERO_BYTES, stream);
    Args a{};
    for (int i = 0; i < 32; ++i) a.in[i] = (const float*)d_in[i];
    a.out = (float*)d_out; a.ws = (unsigned char*)d_ws;
#ifdef DBG
    (void)hipMemsetAsync((char*)d_ws + WS_DBG, 0, 512, stream);
    for (int p = 0; p < N_PHASES; ++p) { a.ph_lo = p; a.ph_hi = p + 1; hipLaunchKernelGGL(mega_fwd, dim3(grid), dim3(NTHREADS), LDS_BYTES, stream, a);
        hipLaunchKernelGGL(dbg_check, dim3(64), dim3(512), 0, stream, a, p); }
    hipLaunchKernelGGL(dbg_encode, dim3(1024), dim3(256), 0, stream, a);
#elif N_LAUNCH_PER_PHASE
    for (int p = 0; p < N_PHASES; ++p) { a.ph_lo = p; a.ph_hi = p + 1; hipLaunchKernelGGL(mega_fwd, dim3(grid), dim3(NTHREADS), LDS_BYTES, stream, a); }
#else
    a.ph_lo = 0; a.ph_hi = N_PHASES;
#ifdef PROF_REP
    a.rep_k = PROF_REP;
#endif
    hipLaunchKernelGGL(mega_fwd, dim3(grid), dim3(NTHREADS), LDS_BYTES, stream, a);
#endif
}
```

```cpp
#include <hip/hip_runtime.h>
#include <cstdio>
#include <cstdint>
#include <cstddef>

#define LAS __attribute__((address_space(3)))
#define GAS __attribute__((address_space(1)))
typedef unsigned short bf16_t;
typedef short bf16x8 __attribute__((ext_vector_type(8)));
typedef float f32x4 __attribute__((ext_vector_type(4)));
typedef float f32x2 __attribute__((ext_vector_type(2)));
typedef unsigned u32x4 __attribute__((ext_vector_type(4)));
typedef unsigned u32x2 __attribute__((ext_vector_type(2)));

#ifndef N_LAUNCH_PER_PHASE
#define N_LAUNCH_PER_PHASE 0
#endif

constexpr int D = 1024, NB = 4, SEQ = 8192, T = NB * SEQ, CTXL = 256, TC = NB * CTXL, TT = T + TC;
constexpr int NH = 4, DK = 64, DV = 128, CH = 64, NCHUNK = SEQ / CH, NCC = CTXL / CH, NCT = NCHUNK + NCC;
constexpr int HYW = 512, HYC = 3 * HYW, INW = 3104;
constexpr int NE = 32, DE = 1024, CAP = T;
constexpr float LN_EPS = 1e-6f, ALPHA = 1.189207115002721f;
constexpr int NTHREADS = 512, NWAVES = 8;
constexpr int FFTN = 16384;

constexpr size_t al256(size_t x) { return (x + 255) & ~(size_t)255; }
constexpr size_t WS_BAR   = 0;
constexpr size_t WS_MOD   = 16384;
constexpr size_t WS_CNT   = WS_MOD + 5 * 6144 * 4;
constexpr size_t WS_ZERO_BYTES = al256(WS_CNT + 256);
constexpr size_t WS_LIST  = 262144;
constexpr size_t WS_PW    = WS_LIST + (size_t)NE * CAP * 4;
constexpr size_t WS_PLOC  = WS_PW + (size_t)T * 4 * 4;
constexpr size_t WS_B1R   = WS_PLOC + (size_t)T * 4 * 4;
constexpr size_t WS_HID2  = WS_B1R + (size_t)NE * 2048 * 4;
constexpr size_t WS_BTIN  = WS_HID2 + (size_t)SEQ * 64 * 4;
constexpr size_t WS_BTOUT = WS_BTIN + (size_t)3584 * 1024 * 2;
constexpr size_t WS_W1T   = WS_BTOUT + (size_t)1024 * 1024 * 2;
constexpr size_t WS_W2T   = WS_W1T + (size_t)NE * 2048 * 1024 * 2;
constexpr size_t WS_PRE1  = WS_W2T + (size_t)NE * 1024 * 1024 * 2;
constexpr size_t WS_RA    = WS_PRE1 + (size_t)T * 1024 * 4;
constexpr size_t WS_H     = WS_RA;
constexpr size_t WS_Q     = WS_H + (size_t)TT * 1024 * 2;
constexpr size_t WS_K     = WS_Q + (size_t)T * 256 * 2;
constexpr size_t WS_V     = WS_K + (size_t)TT * 256 * 2;
constexpr size_t WS_G     = WS_V + (size_t)TT * 512 * 2;
constexpr size_t WS_GF    = WS_G + (size_t)T * 512 * 2;
constexpr size_t WS_GB    = WS_GF + (size_t)TT * 256 * 4;
constexpr size_t WS_UT    = WS_GB + (size_t)TT * 256 * 4;
constexpr size_t WS_RA_END= WS_UT + (size_t)NB * HYC * SEQ * 2;
constexpr size_t WS_H2    = WS_RA;
constexpr size_t WS_FG    = WS_RA + (size_t)T * 1024 * 2;
constexpr size_t WS_SLOTS = WS_RA;
constexpr size_t SORTED_BYTES_ = (size_t)(T * 4 / 256 + NE) * 256 * 1024 * 2;
constexpr size_t WS_RB    = al256(WS_RA_END > WS_RA + SORTED_BYTES_ ? WS_RA_END : WS_RA + SORTED_BYTES_);
constexpr size_t WS_KV    = WS_RB;
constexpr size_t WS_AV    = WS_KV + (size_t)2 * 16 * NCT * 8192 * 2;
constexpr size_t WS_SP    = WS_AV + (size_t)2 * 16 * NCT * 64 * 4;
constexpr size_t WS_HSPEC = WS_SP + (size_t)2 * 16 * NCHUNK * 8192 * 2;
constexpr size_t HSPEC_PER_WG = (size_t)2 * FFTN * 8;
constexpr int MAX_GRID = 256;
constexpr size_t WS_YHYT  = WS_HSPEC + (size_t)MAX_GRID * HSPEC_PER_WG;
constexpr size_t WS_MIX   = WS_YHYT + (size_t)NB * HYW * SEQ * 2;
constexpr size_t WS_RB_END= WS_MIX + (size_t)T * 1024 * 2;
constexpr size_t WS_HF    = WS_MIX;
constexpr size_t WS_ACT   = WS_RB;
constexpr size_t SORTED_BYTES = (size_t)(T * 4 / 256 + NE) * 256 * 1024 * 2;
constexpr size_t WS_END   = al256(WS_RB_END > WS_RB + SORTED_BYTES ? WS_RB_END : WS_RB + SORTED_BYTES);

constexpr int LDS_BYTES = 147456;
constexpr int LDS_MISC  = 145408;

typedef __bf16 bf16n2 __attribute__((ext_vector_type(2)));
__device__ __forceinline__ unsigned pk2(float lo, float hi) { bf16n2 v = {(__bf16)lo, (__bf16)hi}; return __builtin_bit_cast(unsigned, v); }
__device__ __forceinline__ bf16_t f2bf(float f) { __bf16 b = (__bf16)f; return __builtin_bit_cast(unsigned short, b); }
__device__ __forceinline__ float bf2f(bf16_t b) { return __uint_as_float(((unsigned)b) << 16); }
__device__ __forceinline__ float bflo(unsigned w) { return __uint_as_float(w << 16); }
__device__ __forceinline__ float bfhi(unsigned w) { return __uint_as_float(w & 0xffff0000u); }
__device__ __forceinline__ float wave_sum(float v) {
#pragma unroll
    for (int o = 1; o < 64; o <<= 1) v += __shfl_xor(v, o);
    return v;
}
__device__ __forceinline__ float silu_f(float x) { return x * __builtin_amdgcn_rcpf(1.f + __expf(-x)); }
__device__ __forceinline__ float log_sigmoid_f(float z) { return fminf(z, 0.f) - __logf(1.f + __expf(-fabsf(z))); }

#define XB_TMO      128
#define XB_XCNT(j)  (256  + 64 * (j))
#define XB_XSUB(j)  (1280 + 64 * (j))
#define XB_XGEN(j)  (2304 + 64 * (j))
#define XB_TOP      3328
#define XB_TOPGEN   3392
#define XCD_BAR_WORDS 3456
#define XB_SPIN_CAP (1u << 22)
__device__ __forceinline__ unsigned xb_ld(unsigned* p)              { return __hip_atomic_load(p, __ATOMIC_RELAXED, __HIP_MEMORY_SCOPE_AGENT); }
__device__ __forceinline__ unsigned xb_add(unsigned* p, unsigned v) { return __hip_atomic_fetch_add(p, v, __ATOMIC_RELAXED, __HIP_MEMORY_SCOPE_AGENT); }
__device__ __forceinline__ unsigned xb_xcc_id() { return (unsigned)__builtin_amdgcn_s_getreg((3 << 11) | 20) & 0xFu; }
#define XB_SPIN(cond, bar) do { unsigned _sp = 0; while (cond) { __builtin_amdgcn_s_sleep(1); \
    if ((++_sp & 255u) == 0u) { if (xb_ld(&(bar)[XB_TMO])) break; if (_sp > XB_SPIN_CAP) { atomicAdd(&(bar)[XB_TMO], 1u); break; } } } } while (0)
struct XcdBarrier { unsigned* bar; unsigned x; volatile LAS unsigned* st; };
__device__ __forceinline__ XcdBarrier xcd_barrier_post(unsigned* bar, volatile LAS unsigned* st) {
    XcdBarrier b; b.bar = bar; b.x = xb_xcc_id(); b.st = st;
    if (threadIdx.x == 0) (void)xb_add(&bar[XB_XCNT(b.x)], 1u);
    return b;
}
__device__ __forceinline__ void xcd_barrier_complete(unsigned* bar, unsigned x, unsigned& nloc, unsigned& nx) {
    const unsigned G = gridDim.x * gridDim.y * gridDim.z;
    unsigned sum, cnt, mine, sp = 0u;
    for (;;) {
        sum = 0u; cnt = 0u; mine = 0u;
#pragma unroll
        for (unsigned j = 0; j < 16; ++j) { const unsigned c = xb_ld(&bar[XB_XCNT(j)]); sum += c; cnt += (c > 0u) ? 1u : 0u; mine = (j == x) ? c : mine; }
        if (sum == G) break;
        __builtin_amdgcn_s_sleep(1);
        if ((++sp & 255u) == 0u) { if (xb_ld(&bar[XB_TMO])) break; if (sp > XB_SPIN_CAP) { atomicAdd(&bar[XB_TMO], 1u); break; } }
    }
    nloc = mine > 0u ? mine : 1u; nx = cnt > 0u ? cnt : 1u;
}
__device__ __forceinline__ void xcd_barrier(const XcdBarrier& b) {
    asm volatile("s_waitcnt vmcnt(0)" ::: "memory");
    __syncthreads();
    if (threadIdx.x == 0) {
        unsigned* bar = b.bar;
        __builtin_amdgcn_s_waitcnt(0);
        unsigned nloc = b.st[0], nx = b.st[1];
        if (nloc == 0u) { xcd_barrier_complete(bar, b.x, nloc, nx); b.st[0] = nloc; b.st[1] = nx; }
        const unsigned old = xb_add(&bar[XB_XSUB(b.x)], 1u);
        const unsigned gen = old / nloc;
        if (old + 1u == (gen + 1u) * nloc) {
            __builtin_amdgcn_fence(__ATOMIC_RELEASE, "agent");
            asm volatile("s_waitcnt vmcnt(0)" ::: "memory");
            const unsigned og = xb_add(&bar[XB_TOP], 1u);
            const unsigned tg = og / nx;
            if (og + 1u == (tg + 1u) * nx) xb_add(&bar[XB_TOPGEN], 1u);
            else XB_SPIN(xb_ld(&bar[XB_TOPGEN]) == tg, bar);
            __builtin_amdgcn_fence(__ATOMIC_ACQUIRE, "agent");
            xb_add(&bar[XB_XGEN(b.x)], 1u);
            asm volatile("s_waitcnt vmcnt(0)" ::: "memory");
        } else {
            XB_SPIN(xb_ld(&bar[XB_XGEN(b.x)]) == gen, bar);
            __builtin_amdgcn_fence(__ATOMIC_ACQUIRE, "agent");
            asm volatile("s_waitcnt vmcnt(0)" ::: "memory");
        }
    }
    __syncthreads();
}

struct Args {
    const float* in[32];
    float* out;
    unsigned char* ws;
    int ph_lo, ph_hi;
    int rep_k, pad_;
};
enum { I_X = 0, I_C, I_CTX, I_CCTX, I_ADAW, I_ADAB, I_WIN, I_WAF, I_BAF, I_WAB, I_BAB, I_NORMG, I_CONVW, I_CONVB, I_FW1, I_FB1, I_FW2, I_FB2, I_FWOUT, I_FFREQ,
       I_BIASD, I_WOUT, I_LN1G, I_LN1B, I_RW, I_RB, I_EW1, I_EB1, I_EW2, I_EB2, I_LN2G, I_LN2B };


namespace gm {
constexpr int BM = 256, BK = 64, HALF = 128, HTB = HALF * BK * 2, STAGE_BYTES = 8 * HTB, KD = 1024, NT = KD / BK;
constexpr int ROWB = KD * 2;
typedef int i32x8 __attribute__((ext_vector_type(8)));
__device__ __forceinline__ int gray2(int q) { return q ^ (q >> 1); }
__device__ __forceinline__ int lds_off8(int r, int fq) { const int rr = r & 15; return ((r >> 4) * 2 + (fq >> 1)) * 1024 + rr * 64 + 16 * ((2 * (fq & 1)) ^ gray2(rr >> 2)); }
__device__ __forceinline__ void stage_rc8(int b, int& R, int& C) { const int st = b / 1024, sb = b % 1024, swz = sb ^ (gray2((sb >> 8) & 3) << 4); R = (st >> 1) * 16 + swz / 64; C = (st & 1) * 32 + (swz % 64) / 2; }
__device__ __forceinline__ int lds_byte(int r, int c) { const int st = (r >> 4) * 2 + (c >> 5), rr = r & 15, cc = c & 31, ob = rr * 64 + cc * 2; return st * 1024 + (ob ^ (((ob >> 9) & 1) << 5)); }
__device__ __forceinline__ void stage_rc(int b, int& R, int& C) { const int st = b / 1024, sb = b % 1024, swz = sb ^ (((sb >> 9) & 1) << 5); R = (st >> 1) * 16 + swz / 64; C = (st & 1) * 32 + (swz % 64) / 2; }
__device__ __forceinline__ int perm32(int rho) { const int n = rho >> 4, i = rho & 15; return 8 * (i >> 2) + 4 * n + (i & 3); }

constexpr int LDS_BIAS = STAGE_BYTES + 4096;
struct Unit {
    const char* A;
    const char* B;
    const int* list;
    int type, row0, col0, valid, aux;
};

__device__ __forceinline__ i32x8 cat8(bf16x8 lo, bf16x8 hi) { typedef int i32x4 __attribute__((ext_vector_type(4))); const i32x4 a = __builtin_bit_cast(i32x4, lo), b = __builtin_bit_cast(i32x4, hi); return (i32x8){a[0], a[1], a[2], a[3], b[0], b[1], b[2], b[3]}; }
template <bool GATHER, int GSHIFT, int RB, bool FP8>
__device__ __forceinline__ void a_offsets(const Unit& u, unsigned (&o)[2][2]) {
    int R[2], Cb[2];
    int tz = threadIdx.x; asm volatile("" : "+v"(tz));
#pragma unroll
    for (int i = 0; i < 2; ++i) { int r, c; if (FP8) stage_rc8(tz * 16 + i * 8192, r, c); else stage_rc(tz * 16 + i * 8192, r, c); R[i] = r; Cb[i] = c * 2; }
#pragma unroll
    for (int h = 0; h < 2; ++h)
#pragma unroll
        for (int i = 0; i < 2; ++i) {
            const int r = h * HALF + R[i];
            if (!GATHER) o[h][i] = (unsigned)(r * RB + Cb[i]);
            else { const int idx = u.list[r < u.valid ? r : 0]; o[h][i] = (unsigned)(idx >> GSHIFT) * (unsigned)RB + (unsigned)Cb[i]; }
        }
}

template <bool GATHER, int GSHIFT, bool FP8, class Sched, class Epi>
__device__ __forceinline__ void gemm_stream(LAS unsigned char* lds, const Sched& S, const Epi& E) {
    constexpr int RB = FP8 ? KD : ROWB, NTL = FP8 ? NT / 2 : NT;
    const int tid = threadIdx.x, wid = __builtin_amdgcn_readfirstlane(tid >> 6), lane = tid & 63, wr = wid >> 2, wc = wid & 3, fr = lane & 15, fq = lane >> 4;
    unsigned voffB[2], voffA[2];
#pragma unroll
    for (int i = 0; i < 2; ++i) { int r, c; if (FP8) stage_rc8(tid * 16 + i * 8192, r, c); else stage_rc(tid * 16 + i * 8192, r, c); const int rb = (r & ~31) + perm32(r & 31); voffB[i] = (unsigned)(rb * RB + c * 2); voffA[i] = (unsigned)(r * RB + c * 2); }
    const size_t kstep = (size_t)(BK * 2), hstep = (size_t)HALF * RB;
    const unsigned ldsw = (unsigned)wid * 1024u;
    const int aoff = FP8 ? lds_off8(wr * 64 + fr, fq) : lds_byte(wr * 64 + fr, fq * 8), boff = FP8 ? lds_off8(wc * 32 + fr, fq) : lds_byte(wc * 32 + fr, fq * 8);
    const int aoffh = aoff ^ 16, boffh = boff ^ 16;
#define GM_SA(b, h) (((b) * 2 + (h)) * HTB)
#define GM_SB(b, h) ((4 + (b) * 2 + (h)) * HTB)
#define GM_STAGE(bufoff, gbase, vo0, vo1) do { \
        __builtin_amdgcn_global_load_lds((const unsigned*)((const char*)(gbase) + (vo0)), (LAS unsigned*)(lds + (bufoff) + ldsw), 16, 0, 0); \
        __builtin_amdgcn_global_load_lds((const unsigned*)((const char*)(gbase) + (vo1)), (LAS unsigned*)(lds + (bufoff) + ldsw + 8192), 16, 0, 0); } while (0)
#define GM_STAGE_A(bufoff, gbase, h, o0, o1) do { if constexpr (GATHER) GM_STAGE(bufoff, gbase, o0, o1); else GM_STAGE(bufoff, (gbase) + (h) * hstep, voffA[0], voffA[1]); } while (0)
#define GM_LD32(p, ol, oh) ({ const i32x4 lo_ = *(const LAS i32x4*)((p) + (ol)), hi_ = *(const LAS i32x4*)((p) + (oh)); (i32x8){lo_[0], lo_[1], lo_[2], lo_[3], hi_[0], hi_[1], hi_[2], hi_[3]}; })
#define GM_LDA(dst, b, h) do { if constexpr (FP8) { _Pragma("unroll") for (int m = 0; m < 4; ++m) dst##8[m] = GM_LD32(lds + GM_SA(b, h) + m * 2048, aoff, aoffh); } \
        else { _Pragma("unroll") for (int m = 0; m < 4; ++m) _Pragma("unroll") for (int k = 0; k < 2; ++k) dst[m][k] = *(const LAS bf16x8*)(lds + GM_SA(b, h) + aoff + m * 2048 + k * 1024); } } while (0)
#define GM_LDB(dst, b, h) do { if constexpr (FP8) { _Pragma("unroll") for (int n = 0; n < 2; ++n) dst##8[n] = GM_LD32(lds + GM_SB(b, h) + n * 2048, boff, boffh); } \
        else { _Pragma("unroll") for (int n = 0; n < 2; ++n) _Pragma("unroll") for (int k = 0; k < 2; ++k) dst[n][k] = *(const LAS bf16x8*)(lds + GM_SB(b, h) + boff + n * 2048 + k * 1024); } } while (0)
#define GM_MMA(ai, bj, At, Bt) do { __builtin_amdgcn_s_setprio(1); _Pragma("unroll") for (int m = 0; m < 4; ++m) _Pragma("unroll") for (int n = 0; n < 2; ++n) { \
        if constexpr (FP8) asm volatile("v_mfma_scale_f32_16x16x128_f8f6f4 %0, %1, %2, %0, %3, %3 op_sel_hi:[0,0,0]" : "+v"(acc[ai][bj][m][n]) : "v"(Bt##8[n]), "v"(At##8[m]), "v"(sc1_)); \
        else { _Pragma("unroll") for (int k = 0; k < 2; ++k) acc[ai][bj][m][n] = __builtin_amdgcn_mfma_f32_16x16x32_bf16(Bt[n][k], At[m][k], acc[ai][bj][m][n], 0, 0, 0); } } \
        __builtin_amdgcn_s_setprio(0); } while (0)
#define GM_WAIT_V(n) asm volatile("s_waitcnt vmcnt(" #n ")" ::: "memory")
#define GM_WAIT_L(n) asm volatile("s_waitcnt lgkmcnt(" #n ")" ::: "memory")
#define GM_BAR __builtin_amdgcn_s_barrier()
#define GM_SCHED __builtin_amdgcn_sched_barrier(0)
    Unit cur, nxt; int ui = 0;
    if (!S.next(0, cur)) return;
    f32x4 acc[2][2][4][2];
#pragma unroll
    for (int a = 0; a < 2; ++a)
#pragma unroll
        for (int b = 0; b < 2; ++b)
#pragma unroll
            for (int m = 0; m < 4; ++m)
#pragma unroll
                for (int n = 0; n < 2; ++n) acc[a][b][m][n] = (f32x4){0.f, 0.f, 0.f, 0.f};
    typedef int i32x4 __attribute__((ext_vector_type(4)));
    int sc1_ = 0x7f7f7f7f; asm volatile("" : "+v"(sc1_));
    bf16x8 At[4][2], B0[2][2], B1[2][2];
    i32x8 At8[4], B08[2], B18[2];
    unsigned ca[2][2], na[2][2];
    if constexpr (GATHER) a_offsets<GATHER, GSHIFT, RB, FP8>(cur, ca);
    const char* cA = cur.A; const char* cB = cur.B;
    GM_STAGE(GM_SB(0, 0), cB, voffB[0], voffB[1]); GM_STAGE_A(GM_SA(0, 0), cA, 0, ca[0][0], ca[0][1]); GM_STAGE(GM_SB(0, 1), cB + hstep, voffB[0], voffB[1]); GM_STAGE_A(GM_SA(0, 1), cA, 1, ca[1][0], ca[1][1]);
    if (wr == 1) GM_BAR;
    GM_WAIT_V(4); GM_BAR;
    GM_STAGE(GM_SB(1, 0), cB + kstep, voffB[0], voffB[1]); GM_STAGE_A(GM_SA(1, 0), cA + kstep, 0, ca[0][0], ca[0][1]); GM_STAGE(GM_SB(1, 1), cB + hstep + kstep, voffB[0], voffB[1]);
    GM_WAIT_V(6); GM_BAR;
    for (;;) {
        const bool has_next = S.next(ui + 1, nxt);
        if constexpr (GATHER) {
            if (has_next) a_offsets<GATHER, GSHIFT, RB, FP8>(nxt, na);
            else {
#pragma unroll
                for (int h = 0; h < 2; ++h)
#pragma unroll
                    for (int i = 0; i < 2; ++i) na[h][i] = ca[h][i];
            }
        }
        const char* nA = has_next ? nxt.A : cA; const char* nB = has_next ? nxt.B : cB;
        if (wid == 0)
            __builtin_amdgcn_global_load_lds((const unsigned*)(S.bias(cur) + 4 * lane), (LAS unsigned*)(lds + LDS_BIAS + (ui & 1) * 1024), 16, 0, 0);
        for (int t = 0; t < NTL; t += 2) {
            const bool last = (t == NTL - 2);

            const char* a1 = cA + (size_t)(t + 1) * kstep;
            const char* a2 = last ? nA : cA + (size_t)(t + 2) * kstep; const char* b2 = last ? nB : cB + (size_t)(t + 2) * kstep;
            const char* a3 = a2 + kstep; const char* b3 = b2 + kstep;
            unsigned x00 = 0, x01 = 0, x10 = 0, x11 = 0;
            if constexpr (GATHER) { x00 = last ? na[0][0] : ca[0][0]; x01 = last ? na[0][1] : ca[0][1]; x10 = last ? na[1][0] : ca[1][0]; x11 = last ? na[1][1] : ca[1][1]; }
            GM_LDB(B0, 0, 0); GM_SCHED; GM_LDA(At, 0, 0); GM_STAGE_A(GM_SA(1, 1), a1, 1, ca[1][0], ca[1][1]);
            GM_WAIT_L(8); GM_BAR; GM_WAIT_L(0); GM_MMA(0, 0, At, B0); GM_BAR; GM_SCHED;
            GM_LDB(B1, 0, 1); GM_STAGE(GM_SB(0, 0), b2, voffB[0], voffB[1]);
            GM_BAR; GM_WAIT_L(0); GM_MMA(0, 1, At, B1); GM_BAR;
            GM_LDA(At, 0, 1); GM_STAGE_A(GM_SA(0, 0), a2, 0, x00, x01);
            GM_BAR; GM_WAIT_L(0); GM_MMA(1, 0, At, B0); GM_BAR; GM_SCHED;
            GM_STAGE(GM_SB(0, 1), b2 + hstep, voffB[0], voffB[1]);
            GM_WAIT_V(6); GM_BAR; GM_MMA(1, 1, At, B1); GM_BAR;
            GM_LDB(B0, 1, 0); GM_SCHED; GM_LDA(At, 1, 0); GM_STAGE_A(GM_SA(0, 1), a2, 1, x10, x11);
            GM_WAIT_L(8); GM_BAR; GM_WAIT_L(0); GM_MMA(0, 0, At, B0); GM_BAR; GM_SCHED;
            GM_LDB(B1, 1, 1); GM_STAGE(GM_SB(1, 0), b3, voffB[0], voffB[1]);
            GM_BAR; GM_WAIT_L(0); GM_MMA(0, 1, At, B1); GM_BAR;
            GM_LDA(At, 1, 1); GM_STAGE_A(GM_SA(1, 0), a3, 0, x00, x01);
            GM_BAR; GM_WAIT_L(0); GM_MMA(1, 0, At, B0); GM_BAR; GM_SCHED;
            GM_STAGE(GM_SB(1, 1), b3 + hstep, voffB[0], voffB[1]);
            GM_WAIT_V(6); GM_BAR; GM_MMA(1, 1, At, B1); GM_BAR;
        }
        if constexpr (FP8) asm volatile("s_nop 7\n\ts_nop 7" ::: "memory");
        {
          int tz = threadIdx.x; asm volatile("" : "+v"(tz)); const int wz = tz >> 6, lz = tz & 63;
          E(acc, cur, wz >> 2, wz & 3, lz & 15, lz >> 4, (const LAS float*)(lds + LDS_BIAS + (ui & 1) * 1024)); }
        if (!has_next) break;
#pragma unroll
        for (int a = 0; a < 2; ++a)
#pragma unroll
            for (int b = 0; b < 2; ++b)
#pragma unroll
                for (int m = 0; m < 4; ++m)
#pragma unroll
                    for (int n = 0; n < 2; ++n) acc[a][b][m][n] = (f32x4){0.f, 0.f, 0.f, 0.f};
        cur = nxt; cA = nA; cB = nB; ++ui;
        if constexpr (GATHER) {
#pragma unroll
            for (int h = 0; h < 2; ++h)
#pragma unroll
                for (int i = 0; i < 2; ++i) ca[h][i] = na[h][i];
        }
    }
    GM_WAIT_V(0);
    if (wr == 0) GM_BAR;
    GM_BAR;
#undef GM_SA
#undef GM_SB
#undef GM_STAGE
#undef GM_STAGE_A
#undef GM_LD32
#undef GM_LDA
#undef GM_LDB
#undef GM_MMA
#undef GM_WAIT_V
#undef GM_WAIT_L
#undef GM_BAR
#undef GM_SCHED
}

__device__ __forceinline__ u32x4 pack8(f32x4 a, f32x4 b) { u32x4 w; w.x = pk2(a[0], a[1]); w.y = pk2(a[2], a[3]); w.z = pk2(b[0], b[1]); w.w = pk2(b[2], b[3]); return w; }

struct SchedIn {
    unsigned char* ws; int G, c; const float* baf; const float* bab;
    __device__ __forceinline__ bool next(int i, Unit& u) const {
        int L = i * G + c;
        u.list = nullptr; u.valid = 256; u.aux = 0;
        if (L < 768) {
            const int pa = L % 6, pb = L / 6;
            u.A = (const char*)(ws + WS_BTIN) + (size_t)(2048 + 256 * pa) * ROWB; u.B = (const char*)(ws + WS_H) + (size_t)(256 * pb) * ROWB;
            u.type = 2; u.row0 = 256 * pa; u.col0 = 256 * pb; return true;
        }
        L -= 768;
        if (L < 1024) {
            const int pm = L >> 3, pn = ((L & 7) + (L >> 8)) & 7;
            u.A = (const char*)(ws + WS_H) + (size_t)(256 * pm) * ROWB; u.B = (const char*)(ws + WS_BTIN) + (size_t)(256 * pn) * ROWB;
            u.type = pn < 6 ? 0 : 1; u.row0 = 256 * pm; u.col0 = pn; return true;
        }
        L -= 1024;
        if (L < 20) {
            const int pm = L / 5, j = L % 5, pn = j == 0 ? 1 : (j == 1 ? 2 : (j == 2 ? 3 : (j == 3 ? 6 : 7)));
            u.A = (const char*)(ws + WS_H) + (size_t)(T + 256 * pm) * ROWB; u.B = (const char*)(ws + WS_BTIN) + (size_t)(256 * pn) * ROWB;
            u.type = pn < 6 ? 0 : 1; u.row0 = T + 256 * pm; u.col0 = pn; return true;
        }
        return false;
    }
    __device__ __forceinline__ const float* bias(const Unit& u) const { return (u.type == 1 && u.col0 == 7) ? bab : baf; }
};
struct EpiIn {
    unsigned char* ws;
    __device__ __forceinline__ void operator()(const f32x4 (&acc)[2][2][4][2], const Unit& u, int wr, int wc, int fr, int fq, const LAS float* bs) const {
        const int rl = wr * 64 + fr, cl = wc * 32 + 8 * fq;
        if (u.type == 0) {
            const int pn = u.col0;
            bf16_t* dst; int ld, cb;
            if (pn == 0) { dst = (bf16_t*)(ws + WS_Q); ld = 256; cb = 0; }
            else if (pn == 1) { dst = (bf16_t*)(ws + WS_K); ld = 256; cb = 0; }
            else if (pn < 4) { dst = (bf16_t*)(ws + WS_V); ld = 512; cb = (pn - 2) * 256; }
            else { dst = (bf16_t*)(ws + WS_G); ld = 512; cb = (pn - 4) * 256; }
#pragma unroll
            for (int ai = 0; ai < 2; ++ai)
#pragma unroll
                for (int m = 0; m < 4; ++m) { bf16_t* rowp = dst + (size_t)(u.row0 + rl + ai * 128 + m * 16) * ld + cb + cl;
#pragma unroll
                    for (int bj = 0; bj < 2; ++bj) *(u32x4*)(rowp + bj * 128) = pack8(acc[ai][bj][m][0], acc[ai][bj][m][1]); }
        } else if (u.type == 1) {
            _Float16* dst = (_Float16*)(ws + (u.col0 == 6 ? WS_GF : WS_GB));
            f32x4 bv[2][2];
#pragma unroll
            for (int bj = 0; bj < 2; ++bj)
#pragma unroll
                for (int n = 0; n < 2; ++n) bv[bj][n] = *(const LAS f32x4*)(bs + cl + bj * 128 + 4 * n);
            typedef _Float16 f16x8_ __attribute__((ext_vector_type(8)));
#pragma unroll
            for (int ai = 0; ai < 2; ++ai)
#pragma unroll
                for (int m = 0; m < 4; ++m) { _Float16* rowp = dst + (size_t)(u.row0 + rl + ai * 128 + m * 16) * 256 + cl;
#pragma unroll
                    for (int bj = 0; bj < 2; ++bj) { f16x8_ o;
#pragma unroll
                        for (int n = 0; n < 2; ++n) { const f32x4 z = acc[ai][bj][m][n] + bv[bj][n];
#pragma unroll
                            for (int j = 0; j < 4; ++j) o[4 * n + j] = (_Float16)(log_sigmoid_f(z[j]) * (1.f / 16.f)); }
                        *(f16x8_*)(rowp + bj * 128) = o; } }
        } else {
            const int b = u.col0 >> 13, l0 = u.col0 & 8191;
            bf16_t* dst = (bf16_t*)(ws + WS_UT) + ((size_t)b * HYC) * SEQ + l0 + cl;
#pragma unroll
            for (int ai = 0; ai < 2; ++ai)
#pragma unroll
                for (int m = 0; m < 4; ++m) { bf16_t* rowp = dst + (size_t)(u.row0 + rl + ai * 128 + m * 16) * SEQ;
#pragma unroll
                    for (int bj = 0; bj < 2; ++bj) *(u32x4*)(rowp + bj * 128) = pack8(acc[ai][bj][m][0], acc[ai][bj][m][1]); }
        }
    }
};

struct SchedOut {
    unsigned char* ws; int G, c;
    __device__ __forceinline__ bool next(int i, Unit& u) const {
        const int L = i * G + c; if (L >= 512) return false;
        const int pm = L >> 2, pn = L & 3;
        u.A = (const char*)(ws + WS_MIX) + (size_t)(256 * pm) * ROWB; u.B = (const char*)(ws + WS_BTOUT) + (size_t)(256 * pn) * ROWB;
        u.list = nullptr; u.valid = 256; u.aux = 0; u.type = 3; u.row0 = 256 * pm; u.col0 = 256 * pn; return true;
    }
    __device__ __forceinline__ const float* bias(const Unit& u) const { return (const float*)(ws + WS_MOD) + (u.row0 >> 13) * 6144 + 2 * 1024 + u.col0; }
};
struct EpiOut {
    unsigned char* ws;
    __device__ __forceinline__ void operator()(const f32x4 (&acc)[2][2][4][2], const Unit& u, int wr, int wc, int fr, int fq, const LAS float* bs) const {
        const int rl = wr * 64 + fr, cl = u.col0 + wc * 32 + 8 * fq;
        bf16_t* fg = (bf16_t*)(ws + WS_FG);
        f32x4 gv[2][2];
#pragma unroll
        for (int bj = 0; bj < 2; ++bj)
#pragma unroll
            for (int n = 0; n < 2; ++n) gv[bj][n] = *(const LAS f32x4*)(bs + wc * 32 + 8 * fq + bj * 128 + 4 * n);
#pragma unroll
        for (int ai = 0; ai < 2; ++ai)
#pragma unroll
            for (int m = 0; m < 4; ++m) { bf16_t* rowp = fg + (size_t)(u.row0 + rl + ai * 128 + m * 16) * 1024 + cl;
#pragma unroll
                for (int bj = 0; bj < 2; ++bj) *(u32x4*)(rowp + bj * 128) = pack8(gv[bj][0] * acc[ai][bj][m][0], gv[bj][1] * acc[ai][bj][m][1]); }
    }
};

constexpr int LDS_TAB = STAGE_BYTES;
template <int WHICH>
struct SchedMoe {
    unsigned char* ws; const LAS int* tab; int G, c; const float* b2;
    __device__ __forceinline__ bool next(int i, Unit& u) const {
        constexpr int NCT_ = WHICH == 1 ? 8 : 4;
        const int L = i * G + c; const int nrt = __builtin_amdgcn_readfirstlane(tab[32]);
        if (L >= nrt * NCT_) return false;
        const int rt = L / NCT_, ct = L % NCT_;
        const int info = __builtin_amdgcn_readfirstlane(tab[64 + rt]), e = info & 255, r0 = (info >> 8) * 256;
        const int cnt = __builtin_amdgcn_readfirstlane(tab[e]);
        u.valid = (cnt - r0) < 256 ? (cnt - r0) : 256;
        u.list = (const int*)(ws + WS_LIST) + (size_t)e * CAP + r0;
        u.A = (WHICH == 1) ? (const char*)(ws + WS_H2) : (const char*)(ws + WS_ACT) + (size_t)(256 * rt) * KD;
        u.B = (const char*)(ws + (WHICH == 1 ? WS_W1T : WS_W2T)) + ((size_t)e * (WHICH == 1 ? 2048 : 1024) + 256 * ct) * KD;
        u.type = 3 + WHICH; u.row0 = 256 * rt; u.col0 = ct; u.aux = e; return true;
    }
    __device__ __forceinline__ const float* bias(const Unit& u) const { return (WHICH == 1) ? (const float*)(ws + WS_B1R) + (size_t)u.aux * 2048 + 256 * u.col0 : b2 + (size_t)u.aux * 1024 + 256 * u.col0; }
};
__device__ __forceinline__ float swiglu_f(float glu, float lin) {
    glu = fminf(glu, 7.f); lin = fminf(fmaxf(lin, -7.f), 7.f);
    return glu * __builtin_amdgcn_rcpf(1.f + __expf(-1.702f * glu)) * (lin + 1.f);
}
constexpr float S_H2 = 4.f, S_ACT = 8.f, S_W = 64.f;
__device__ __forceinline__ f32x2 swiglu2(f32x2 ag, f32x2 al, f32x2 bg, f32x2 bl) {
    f32x2 g = ag * (1.f / (S_H2 * S_W)) + bg, l = al * (1.f / (S_H2 * S_W)) + bl;
    g[0] = fminf(g[0], 7.f); g[1] = fminf(g[1], 7.f);
    l[0] = __builtin_amdgcn_fmed3f(l[0], -7.f, 7.f); l[1] = __builtin_amdgcn_fmed3f(l[1], -7.f, 7.f);
    const f32x2 t = g * (-1.702f * 1.4426950408889634f);
    const f32x2 d = (f32x2){__builtin_amdgcn_exp2f(t[0]), __builtin_amdgcn_exp2f(t[1])} + 1.f;
    const f32x2 r = {__builtin_amdgcn_rcpf(d[0]), __builtin_amdgcn_rcpf(d[1])};
    return (g * r) * (l * S_ACT + S_ACT);
}
__device__ __forceinline__ unsigned pk4_fp8(float a, float b, float c, float d) {
    a = fminf(fmaxf(a, -448.f), 448.f); b = fminf(fmaxf(b, -448.f), 448.f); c = fminf(fmaxf(c, -448.f), 448.f); d = fminf(fmaxf(d, -448.f), 448.f);
    int p = __builtin_amdgcn_cvt_pk_fp8_f32(a, b, 0, false); p = __builtin_amdgcn_cvt_pk_fp8_f32(c, d, p, true); return (unsigned)p; }
__device__ __forceinline__ unsigned pk4_fp8_nc(float a, float b, float c, float d) { int p = __builtin_amdgcn_cvt_pk_fp8_f32(a, b, 0, false); p = __builtin_amdgcn_cvt_pk_fp8_f32(c, d, p, true); return (unsigned)p; }
struct EpiMoe1 {
    unsigned char* ws;
    __device__ __forceinline__ void operator()(const f32x4 (&acc)[2][2][4][2], const Unit& u, int wr, int wc, int fr, int fq, const LAS float* bs) const {
        const int rl = wr * 64 + fr, cl = wc * 32 + 8 * fq, ct = u.col0;
        const LAS float* b1 = bs + cl;
        unsigned char* act = (unsigned char*)(ws + WS_ACT) + (size_t)u.row0 * 1024 + 128 * ct + cl;
        f32x4 bg[2], bl[2];
#pragma unroll
        for (int n = 0; n < 2; ++n) { bg[n] = *(const LAS f32x4*)(b1 + 4 * n); bl[n] = *(const LAS f32x4*)(b1 + 128 + 4 * n); }
#pragma unroll
        for (int ai = 0; ai < 2; ++ai)
#pragma unroll
            for (int mp = 0; mp < 2; ++mp) {
                u32x2 w[2];
#pragma unroll
                for (int mm = 0; mm < 2; ++mm) { const int m = 2 * mp + mm;
#pragma unroll
                    for (int n = 0; n < 2; ++n) { int p = 0;
#pragma unroll
                        for (int hh = 0; hh < 2; ++hh) {
                            const f32x2 o = swiglu2((f32x2){acc[ai][0][m][n][2 * hh], acc[ai][0][m][n][2 * hh + 1]}, (f32x2){acc[ai][1][m][n][2 * hh], acc[ai][1][m][n][2 * hh + 1]},
                                                    (f32x2){bg[n][2 * hh], bg[n][2 * hh + 1]}, (f32x2){bl[n][2 * hh], bl[n][2 * hh + 1]});
                            p = hh ? __builtin_amdgcn_cvt_pk_fp8_f32(o[0], o[1], p, true) : __builtin_amdgcn_cvt_pk_fp8_f32(o[0], o[1], p, false); }
                        if (n == 0) w[mm].x = (unsigned)p; else w[mm].y = (unsigned)p; } }
                const auto sx = __builtin_amdgcn_permlane16_swap(w[0].x, w[1].x, false, false); const auto sy = __builtin_amdgcn_permlane16_swap(w[0].y, w[1].y, false, false);
                const int r = rl + ai * 128 + (2 * mp + (fq & 1)) * 16;
                *(u32x4*)(act + (size_t)r * 1024 - 8 * (fq & 1)) = (u32x4){sx[0], sy[0], sx[1], sy[1]}; }
    }
};
constexpr float S_SL = 16.f;
struct EpiMoe2 {
    unsigned char* ws;
    __device__ __forceinline__ void operator()(const f32x4 (&acc)[2][2][4][2], const Unit& u, int wr, int wc, int fr, int fq, const LAS float* bs) const {
        const int rl = wr * 64 + fr, cl = wc * 32 + 8 * fq, ct = u.col0;
        const LAS float* bb = bs + cl;
        unsigned char* slots = (unsigned char*)(ws + WS_SLOTS) + (size_t)u.row0 * 1024 + 256 * ct + cl;
        f32x4 bv[2][2];
#pragma unroll
        for (int bj = 0; bj < 2; ++bj)
#pragma unroll
            for (int n = 0; n < 2; ++n) bv[bj][n] = *(const LAS f32x4*)(bb + bj * 128 + 4 * n) * S_SL;
#pragma unroll
        for (int ai = 0; ai < 2; ++ai)
#pragma unroll
            for (int m = 0; m < 4; ++m) { const int r = rl + ai * 128 + m * 16;
                u32x2 w[2];
#pragma unroll
                for (int bj = 0; bj < 2; ++bj) { const f32x4 y0 = acc[ai][bj][m][0] * (S_SL / (S_ACT * S_W)) + bv[bj][0], y1 = acc[ai][bj][m][1] * (S_SL / (S_ACT * S_W)) + bv[bj][1];
                    w[bj].x = pk4_fp8(y0[0], y0[1], y0[2], y0[3]); w[bj].y = pk4_fp8(y1[0], y1[1], y1[2], y1[3]); }
                const auto sx = __builtin_amdgcn_permlane16_swap(w[0].x, w[1].x, false, false); const auto sy = __builtin_amdgcn_permlane16_swap(w[0].y, w[1].y, false, false);
                *(u32x4*)(slots + (size_t)r * 1024 + ((fq & 1) ? 128 - 8 : 0)) = (u32x4){sx[0], sy[0], sx[1], sy[1]}; }
    }
};
}

namespace hy {
__device__ __forceinline__ int phys(int n) { return n + (n >> 4) + ((n >> 9) << 4); }
constexpr int XSIZE = 16384 + 1024 + 512;

__device__ __forceinline__ float tw_c(int i) {
    constexpr float t[16] = {1.f, 0.98078528040323043f, 0.92387953251128674f, 0.83146961230254524f, 0.70710678118654752f, 0.55557023301960218f, 0.38268343236508977f, 0.19509032201612825f,
                             0.f, -0.19509032201612825f, -0.38268343236508977f, -0.55557023301960218f, -0.70710678118654752f, -0.83146961230254524f, -0.92387953251128674f, -0.98078528040323043f};
    return t[i];
}
__device__ __forceinline__ float tw_s(int i) {
    constexpr float t[16] = {0.f, 0.19509032201612825f, 0.38268343236508977f, 0.55557023301960218f, 0.70710678118654752f, 0.83146961230254524f, 0.92387953251128674f, 0.98078528040323043f,
                             1.f, 0.98078528040323043f, 0.92387953251128674f, 0.83146961230254524f, 0.70710678118654752f, 0.55557023301960218f, 0.38268343236508977f, 0.19509032201612825f};
    return t[i];
}
__host__ __device__ constexpr int brev(int p, int bits) { int r = 0; for (int i = 0; i < bits; ++i) r |= ((p >> i) & 1) << (bits - 1 - i); return r; }

__device__ __forceinline__ f32x2 cmul(f32x2 a, f32x2 w) { f32x2 r;
    asm("v_pk_mul_f32 %0, %1, %2 op_sel_hi:[1,0]\n\tv_pk_fma_f32 %0, %1, %2, %0 op_sel:[1,1,0] op_sel_hi:[0,1,1] neg_lo:[0,1,0]" : "=&v"(r) : "v"(a), "v"(w)); return r; }
__device__ __forceinline__ void cmul_chain(f32x2 a, f32x2 w, f32x2 w1, f32x2& o, f32x2& wn) {
    asm("v_pk_mul_f32 %0, %2, %3 op_sel_hi:[1,0]\n\tv_pk_mul_f32 %1, %3, %4 op_sel_hi:[1,0]\n\t"
        "v_pk_fma_f32 %0, %2, %3, %0 op_sel:[1,1,0] op_sel_hi:[0,1,1] neg_lo:[0,1,0]\n\tv_pk_fma_f32 %1, %3, %4, %1 op_sel:[1,1,0] op_sel_hi:[0,1,1] neg_lo:[0,1,0]"
        : "=&v"(o), "=&v"(wn) : "v"(a), "v"(w), "v"(w1)); }
template <int TI, bool INV>
__device__ __forceinline__ void bf_tw(f32x2& a, f32x2& b) {
    constexpr int T7 = TI < 8 ? TI : 16 - TI;
    const f32x2 W = {tw_c(T7), tw_s(T7)};
    f32x2 sum, o;
#define HY_BF(NEGR, NEGI) asm("v_pk_add_f32 %0, %3, %2\n\tv_pk_add_f32 %2, %3, %2 neg_lo:[0,1] neg_hi:[0,1]\n\tv_pk_mul_f32 %1, %2, %4 op_sel_hi:[1,0]" NEGR "\n\tv_pk_fma_f32 %1, %2, %4, %1 op_sel:[1,1,0] op_sel_hi:[0,1,1] " NEGI : "=&v"(sum), "=&v"(o), "+v"(b) : "v"(a), "s"(W))
    if (TI < 8) { if (!INV) HY_BF("", "neg_hi:[0,1,0]"); else HY_BF("", "neg_lo:[0,1,0]"); }
    else        { if (!INV) HY_BF(" neg_lo:[0,1] neg_hi:[0,1]", "neg_hi:[0,1,0]"); else HY_BF(" neg_lo:[0,1] neg_hi:[0,1]", "neg_lo:[0,1,0]"); }
#undef HY_BF
    a = sum; b = o;
}
template <int TI, bool INV>
__device__ __forceinline__ f32x2 tw_mul(f32x2 t) {
    constexpr int T7 = TI < 8 ? TI : 16 - TI;
    const f32x2 W = {tw_c(T7), tw_s(T7)};
    f32x2 r;
#define HY_TW(NEGR, NEGI) asm("v_pk_mul_f32 %0, %1, %2 op_sel_hi:[1,0]" NEGR "\n\tv_pk_fma_f32 %0, %1, %2, %0 op_sel:[1,1,0] op_sel_hi:[0,1,1] " NEGI : "=&v"(r) : "v"(t), "s"(W))
    if (TI < 8) { if (!INV) HY_TW("", "neg_hi:[0,1,0]"); else HY_TW("", "neg_lo:[0,1,0]"); }
    else        { if (!INV) HY_TW(" neg_lo:[0,1] neg_hi:[0,1]", "neg_hi:[0,1,0]"); else HY_TW(" neg_lo:[0,1] neg_hi:[0,1]", "neg_lo:[0,1,0]"); }
#undef HY_TW
    return r;
}
template <bool INV>
__device__ __forceinline__ void bf_rot(f32x2& a, f32x2& b) { f32x2 sum, o;
    if (!INV) asm("v_pk_add_f32 %0, %2, %3\n\tv_pk_add_f32 %1, %2, %3 op_sel:[1,1] op_sel_hi:[0,0] neg_lo:[0,1] neg_hi:[1,0]" : "=&v"(sum), "=&v"(o) : "v"(a), "v"(b));
    else      asm("v_pk_add_f32 %0, %2, %3\n\tv_pk_add_f32 %1, %2, %3 op_sel:[1,1] op_sel_hi:[0,0] neg_lo:[1,0] neg_hi:[0,1]" : "=&v"(sum), "=&v"(o) : "v"(a), "v"(b));
    a = sum; b = o; }
__device__ __forceinline__ void bf_plain(f32x2& a, f32x2& b) { f32x2 sum, o;
    asm("v_pk_add_f32 %0, %2, %3\n\tv_pk_add_f32 %1, %2, %3 neg_lo:[0,1] neg_hi:[0,1]" : "=&v"(sum), "=&v"(o) : "v"(a), "v"(b));
    a = sum; b = o; }
template <bool INV>
__device__ __forceinline__ f32x2 rot_i(f32x2 t) { f32x2 r;
    if (!INV) asm("v_pk_mul_f32 %0, %1, 1.0 op_sel:[1,0] op_sel_hi:[0,0] neg_hi:[1,0]" : "=v"(r) : "v"(t));
    else      asm("v_pk_mul_f32 %0, %1, 1.0 op_sel:[1,0] op_sel_hi:[0,0] neg_lo:[1,0]" : "=v"(r) : "v"(t));
    return r; }

template <int R, bool INV, bool ZP, int S, int J>
__device__ __forceinline__ void fft_bfly(f32x2 (&v)[R]) {
    constexpr int g = (J / S) * 2 * S, k = J % S, ti = k * (16 / S), i0 = g + k, i1 = g + k + S;
    if constexpr (ZP && S == R / 2) {
        if constexpr (ti == 0) v[i1] = v[i0]; else if constexpr (ti == 8) v[i1] = rot_i<INV>(v[i0]); else v[i1] = tw_mul<ti, INV>(v[i0]);
    } else {
        if constexpr (ti == 0) bf_plain(v[i0], v[i1]); else if constexpr (ti == 8) bf_rot<INV>(v[i0], v[i1]); else bf_tw<ti, INV>(v[i0], v[i1]);
    }
}
template <int R, bool INV, bool ZP, int S, int J>
__device__ __forceinline__ void fft_stage(f32x2 (&v)[R]) { if constexpr (J < R / 2) { fft_bfly<R, INV, ZP, S, J>(v); fft_stage<R, INV, ZP, S, J + 1>(v); } }
template <int R, bool INV, bool ZP, int S>
__device__ __forceinline__ void fft_stages(f32x2 (&v)[R]) { if constexpr (S >= 1) { fft_stage<R, INV, ZP, S, 0>(v); fft_stages<R, INV, ZP, S / 2>(v); } }
template <int R, bool INV, bool ZP = false>
__device__ __forceinline__ void fft_reg(f32x2 (&v)[R]) { fft_stages<R, INV, ZP, R / 2>(v); }
#define XV(X) ((const volatile LAS f32x2*)(X))
template <int M, bool ZPAD = false>
__device__ __forceinline__ void pass_fwd32(LAS f32x2* X, int tid) {
    int j = (M == 512) ? (16 * ((tid >> 5) + 16 * ((tid >> 4) & 1)) + (tid & 15)) : (tid & 15);
    asm volatile("" : "+v"(j));
    const int p0 = (M == 512) ? (j + (j >> 4)) : (560 * (tid >> 4) + (tid & 15));
    constexpr int PS = (M == 512) ? 560 : 17;
    f32x2 v[32];
#pragma unroll
    for (int r = 0; r < 32; ++r) { if (ZPAD && r >= 16) v[r] = (f32x2){0.f, 0.f}; else v[r] = XV(X)[p0 + PS * r]; }
    fft_reg<32, false, ZPAD>(v);
    float sn, cs; sincospif(-2.f * (float)j / (float)(32 * M), &sn, &cs);
    const f32x2 w1 = {cs, sn}; f32x2 w = w1;
    X[p0] = v[0];
#pragma unroll
    for (int rp = 1; rp < 32; ++rp) { if (rp < 31) { f32x2 o_, wn_; cmul_chain(v[brev(rp, 5)], w, w1, o_, wn_); X[p0 + PS * rp] = o_; w = wn_; } else X[p0 + PS * rp] = cmul(v[brev(rp, 5)], w); }
}
template <int M, bool HALF = false>
__device__ __forceinline__ void pass_inv32(LAS f32x2* X, int tid) {
    int j = (M == 512) ? (16 * ((tid >> 5) + 16 * ((tid >> 4) & 1)) + (tid & 15)) : (tid & 15);
    asm volatile("" : "+v"(j));
    const int p0 = (M == 512) ? (j + (j >> 4)) : (560 * (tid >> 4) + (tid & 15));
    constexpr int PS = (M == 512) ? 560 : 17;
    float sn, cs; sincospif(2.f * (float)j / (float)(32 * M), &sn, &cs);
    const f32x2 w1 = {cs, sn}; f32x2 w = w1;
    f32x2 v[32];
    v[0] = XV(X)[p0];
#pragma unroll
    for (int rp = 1; rp < 32; ++rp) { if (rp < 31) { f32x2 wn_; cmul_chain(XV(X)[p0 + PS * rp], w, w1, v[rp], wn_); w = wn_; } else v[rp] = cmul(XV(X)[p0 + PS * rp], w); }
    fft_reg<32, true>(v);
#pragma unroll
    for (int p = 0; p < 32; ++p) { if (!HALF || brev(p, 5) < 16) X[p0 + PS * brev(p, 5)] = v[p]; }
}
typedef _Float16 f16x8h __attribute__((ext_vector_type(8)));
__device__ __forceinline__ void pass_c_store(const LAS f32x2* X, f32x2* Hs_, int tid, float scale) {
    _Float16* Hs = (_Float16*)Hs_; (void)scale;
#pragma unroll
    for (int u = 0; u < 2; ++u) { const int blk = tid + 512 * u, p0 = 17 * blk + 16 * (blk >> 5);
        f32x2 v[16];
#pragma unroll
        for (int r = 0; r < 16; ++r) v[r] = XV(X)[p0 + r];
        fft_reg<16, false>(v);
#pragma unroll
        for (int q = 0; q < 4; ++q) { f16x8h o;
#pragma unroll
            for (int e = 0; e < 4; ++e) { const f32x2 x = v[brev(4 * q + e, 4)]; o[2 * e] = (_Float16)x[0]; o[2 * e + 1] = (_Float16)x[1]; }
            *(f16x8h*)(Hs + 2 * (16 * blk + 4 * q)) = o; } }
}
__device__ __forceinline__ void pass_c_mul_inv(LAS f32x2* X, const f32x2* Hs_, int tid) {
    const _Float16* Hs = (const _Float16*)Hs_;
#pragma unroll
    for (int u = 0; u < 2; ++u) { const int blk = tid + 512 * u, p0 = 17 * blk + 16 * (blk >> 5);
        f32x2 v[16], w[16];
#pragma unroll
        for (int r = 0; r < 16; ++r) v[r] = XV(X)[p0 + r];
        f16x8h hh[4];
#pragma unroll
        for (int q = 0; q < 4; ++q) hh[q] = *(const f16x8h*)(Hs + 2 * (16 * blk + 4 * q));
        fft_reg<16, false>(v);
#pragma unroll
        for (int q = 0; q < 4; ++q)
#pragma unroll
            for (int e = 0; e < 4; ++e) w[4 * q + e] = cmul(v[brev(4 * q + e, 4)], (f32x2){(float)hh[q][2 * e], (float)hh[q][2 * e + 1]});
        fft_reg<16, true>(w);
#pragma unroll
        for (int p = 0; p < 16; ++p) X[p0 + brev(p, 4)] = w[p]; }
}
__device__ __forceinline__ void load16(const bf16_t* u, float (&e)[16]) {
    const u32x4 a = *(const u32x4*)u, b = *(const u32x4*)(u + 8);
    e[0] = bflo(a.x); e[1] = bfhi(a.x); e[2] = bflo(a.y); e[3] = bfhi(a.y); e[4] = bflo(a.z); e[5] = bfhi(a.z); e[6] = bflo(a.w); e[7] = bfhi(a.w);
    e[8] = bflo(b.x); e[9] = bfhi(b.x); e[10] = bflo(b.y); e[11] = bfhi(b.y); e[12] = bflo(b.z); e[13] = bfhi(b.z); e[14] = bflo(b.w); e[15] = bfhi(b.w);
}
__device__ __forceinline__ void sconv16(const bf16_t* u, int tid, float w0, float w1, float w2, float bias, float (&o)[16]) {
    float e[16]; load16(u + 16 * tid, e);
    float lf = __shfl_up(e[15], 1), rt = __shfl_down(e[0], 1);
    if ((tid & 3) == 0) lf = 0.f;
    if ((tid & 3) == 3) rt = 0.f;
    o[0] = w0 * lf + w1 * e[0] + w2 * e[1] + bias;
#pragma unroll
    for (int i = 1; i < 15; ++i) o[i] = w0 * e[i - 1] + w1 * e[i] + w2 * e[i + 1] + bias;
    o[15] = w0 * e[14] + w1 * e[15] + w2 * rt + bias;
}

constexpr int CV_SPLIT = NE * 128 * 20;
constexpr int CV_ITEMS = NE * 128 * 32;
struct CvJob { float v[8]; int mi; };
__device__ __forceinline__ void cv_issue(const Args& a, CvJob& jb, int mi, int lane) {
    jb.mi = mi;
    if (mi >= 0) { const int e = mi >> 12, kg = (mi >> 5) & 127, nb = mi & 31;
        const float* src = a.in[I_EW1] + ((size_t)e * 1024 + 8 * kg) * 2048 + 64 * nb + lane;
#pragma unroll
        for (int i = 0; i < 8; ++i) jb.v[i] = src[(size_t)i * 2048]; }
}
__device__ __forceinline__ void cv_finish(const Args& a, const CvJob& jb, int lane) {
    if (jb.mi >= 0) { const int mi = jb.mi, e = mi >> 12, kg = (mi >> 5) & 127, nb = mi & 31;
        const int cs = 64 * nb + lane, sgl = cs & 1, ac = cs >> 1, ct = ac >> 7, jj = ac & 127;
        unsigned char* dst = (unsigned char*)(a.ws + WS_W1T) + ((size_t)e * 2048 + 256 * ct + 128 * sgl + jj) * 1024 + 8 * kg;
        u32x2 o; o.x = gm::pk4_fp8_nc(jb.v[0] * gm::S_W, jb.v[1] * gm::S_W, jb.v[2] * gm::S_W, jb.v[3] * gm::S_W); o.y = gm::pk4_fp8_nc(jb.v[4] * gm::S_W, jb.v[5] * gm::S_W, jb.v[6] * gm::S_W, jb.v[7] * gm::S_W);
        *(u32x2*)dst = o; }
}
struct CvState { CvJob jb; int next, stride, end; };
__device__ __forceinline__ void cv_step(const Args& a, CvState& st, int lane) {
    cv_finish(a, st.jb, lane);
    const int mi = st.next < st.end ? st.next : -1;
    cv_issue(a, st.jb, mi, lane);
    st.next += st.stride;
}

__device__ __forceinline__ void channel(const Args& a, LAS unsigned char* lds, int c, unsigned char* scratch, CvState& cvs) {
    const int tid = threadIdx.x;
#define CV_STEP() cv_step(a, cvs, tid & 63)
    LAS f32x2* X = (LAS f32x2*)lds;
    f32x2* Hs = (f32x2*)scratch;
    const _Float16* HF = (const _Float16*)(a.ws + WS_HF);
    const int pc = 17 * tid + 16 * (tid >> 5);
    __syncthreads();
#pragma unroll 1
    for (int o = 0; o < 2; ++o) {
        typedef _Float16 f16x8_ __attribute__((ext_vector_type(8)));
        const f16x8_* hf = (const f16x8_*)(HF + ((size_t)(2 * o) * HYW + c) * SEQ + 16 * tid); const f16x8_* hb = (const f16x8_*)(HF + ((size_t)(2 * o + 1) * HYW + c) * SEQ + 16 * tid);
#pragma unroll
        for (int q = 0; q < 2; ++q) { const f16x8_ f = hf[q], b = hb[q];
#pragma unroll
            for (int e = 0; e < 8; ++e) { const int i = 8 * q + e, t = 16 * tid + i;
                X[pc + i] = (f32x2){(float)f[e], 0.f};
                if (t >= 1) X[phys(FFTN - t)] = (f32x2){(float)b[e], 0.f}; } }
        if (tid == 0) X[phys(SEQ)] = (f32x2){0.f, 0.f};
        __syncthreads();
        CV_STEP(); pass_fwd32<512>(X, tid); __syncthreads(); CV_STEP(); pass_fwd32<16>(X, tid); __syncthreads(); pass_c_store(X, Hs + (size_t)o * (FFTN / 2), tid, 1.f); __syncthreads();
    }
    const float* cw = a.in[I_CONVW]; const float* cbv = a.in[I_CONVB]; const float* dbias = a.in[I_BIASD];
    const float d1 = dbias[c], d2 = dbias[HYW + c];
    constexpr float INVN = 1.f / (float)FFTN;
    float wv[3][3], bv[3];
#pragma unroll
    for (int s = 0; s < 3; ++s) { bv[s] = cbv[s * HYW + c];
#pragma unroll
        for (int i = 0; i < 3; ++i) wv[s][i] = cw[i * HYC + s * HYW + c]; }
    const bf16_t* UT = (const bf16_t*)(a.ws + WS_UT);
    bf16_t* YT = (bf16_t*)(a.ws + WS_YHYT);
#pragma unroll 1
    for (int bp = 0; bp < 2; ++bp) {
        const bf16_t* u0 = UT + ((size_t)(2 * bp) * HYC + c) * SEQ; const bf16_t* u1 = UT + ((size_t)(2 * bp + 1) * HYC + c) * SEQ;
        float z0[16], z1[16];
        {
            float v0[16], v1[16]; sconv16(u0, tid, wv[0][0], wv[0][1], wv[0][2], bv[0], v0); sconv16(u1, tid, wv[0][0], wv[0][1], wv[0][2], bv[0], v1);
#pragma unroll
            for (int i = 0; i < 16; ++i) X[pc + i] = (f32x2){v0[i], v1[i]};
        }
        __syncthreads();
        CV_STEP(); pass_fwd32<512, true>(X, tid); __syncthreads(); CV_STEP(); pass_fwd32<16>(X, tid); __syncthreads(); pass_c_mul_inv(X, Hs, tid); __syncthreads(); CV_STEP(); pass_inv32<16>(X, tid); __syncthreads(); CV_STEP(); pass_inv32<512, true>(X, tid); __syncthreads();
        {
            float v0[16], v1[16], x0[16], x1[16];
            sconv16(u0, tid, wv[0][0], wv[0][1], wv[0][2], bv[0], v0); sconv16(u1, tid, wv[0][0], wv[0][1], wv[0][2], bv[0], v1);
            sconv16(u0 + (size_t)HYW * SEQ, tid, wv[1][0], wv[1][1], wv[1][2], bv[1], x0); sconv16(u1 + (size_t)HYW * SEQ, tid, wv[1][0], wv[1][1], wv[1][2], bv[1], x1);
#pragma unroll
            for (int i = 0; i < 16; ++i) { const f32x2 y1 = X[pc + i]; z0[i] = x0[i] * (y1[0] * INVN + d1 * v0[i]); z1[i] = x1[i] * (y1[1] * INVN + d1 * v1[i]); X[pc + i] = (f32x2){z0[i], z1[i]}; }
        }
        __syncthreads();
        CV_STEP(); pass_fwd32<512, true>(X, tid); __syncthreads(); CV_STEP(); pass_fwd32<16>(X, tid); __syncthreads(); pass_c_mul_inv(X, Hs + FFTN / 2, tid); __syncthreads(); CV_STEP(); pass_inv32<16>(X, tid); __syncthreads(); CV_STEP(); pass_inv32<512, true>(X, tid); __syncthreads();
        {
            float x0[16], x1[16];
            sconv16(u0 + (size_t)2 * HYW * SEQ, tid, wv[2][0], wv[2][1], wv[2][2], bv[2], x0); sconv16(u1 + (size_t)2 * HYW * SEQ, tid, wv[2][0], wv[2][1], wv[2][2], bv[2], x1);
            unsigned w0[8], w1[8];
#pragma unroll
            for (int i = 0; i < 8; ++i) { const f32x2 ya = X[pc + 2 * i], yb = X[pc + 2 * i + 1];
                w0[i] = pk2(x0[2 * i] * (ya[0] * INVN + d2 * z0[2 * i]), x0[2 * i + 1] * (yb[0] * INVN + d2 * z0[2 * i + 1]));
                w1[i] = pk2(x1[2 * i] * (ya[1] * INVN + d2 * z1[2 * i]), x1[2 * i + 1] * (yb[1] * INVN + d2 * z1[2 * i + 1])); }
            u32x4* y0p = (u32x4*)(YT + ((size_t)(2 * bp) * HYW + c) * SEQ + 16 * tid); u32x4* y1p = (u32x4*)(YT + ((size_t)(2 * bp + 1) * HYW + c) * SEQ + 16 * tid);
            y0p[0] = (u32x4){w0[0], w0[1], w0[2], w0[3]}; y0p[1] = (u32x4){w0[4], w0[5], w0[6], w0[7]};
            y1p[0] = (u32x4){w1[0], w1[1], w1[2], w1[3]}; y1p[1] = (u32x4){w1[4], w1[5], w1[6], w1[7]};
        }
        __syncthreads();
    }
#undef CV_STEP
}

__device__ __forceinline__ void filter_item(const Args& a, int item, int lane) {
    const int ct = item & 127, tc = item >> 7;
    const float* hid2 = (const float*)(a.ws + WS_HID2); const float* wout = a.in[I_FWOUT]; _Float16* HF = (_Float16*)(a.ws + WS_HF);
    const int col = 16 * ct + (lane & 15), kq = lane >> 4, cch = col & 511;
    typedef _Float16 f16x8f __attribute__((ext_vector_type(8)));
    f16x8f bfr[2];
#pragma unroll
    for (int s = 0; s < 2; ++s)
#pragma unroll
        for (int i = 0; i < 8; ++i) bfr[s][i] = (_Float16)wout[(size_t)(32 * s + 8 * kq + i) * 2048 + col];
    const float dlt = fabsf(-3.0701134573253945f + (float)cch * ((-15.350567286626973f + 3.0701134573253945f) / 511.f));
#pragma unroll 4
    for (int tt = 0; tt < 32; ++tt) { const int t0 = 512 * tc + 16 * tt;
        const f32x4* ar = (const f32x4*)(hid2 + (size_t)(t0 + (lane & 15)) * 64 + 8 * kq);
        const f32x4 a0 = ar[0], a1 = ar[1], a2 = ar[8], a3 = ar[9];
        const f16x8f af0 = {(_Float16)a0[0], (_Float16)a0[1], (_Float16)a0[2], (_Float16)a0[3], (_Float16)a1[0], (_Float16)a1[1], (_Float16)a1[2], (_Float16)a1[3]};
        const f16x8f af1 = {(_Float16)a2[0], (_Float16)a2[1], (_Float16)a2[2], (_Float16)a2[3], (_Float16)a3[0], (_Float16)a3[1], (_Float16)a3[2], (_Float16)a3[3]};
        f32x4 acc = {0.f, 0.f, 0.f, 0.f};
        acc = __builtin_amdgcn_mfma_f32_16x16x32_f16(af0, bfr[0], acc, 0, 0, 0);
        acc = __builtin_amdgcn_mfma_f32_16x16x32_f16(af1, bfr[1], acc, 0, 0, 0);
        f32x4 o;
#pragma unroll
        for (int r = 0; r < 4; ++r) o[r] = acc[r] * __expf(-((float)(t0 + 4 * kq + r) / (float)(SEQ - 1)) * dlt);
        typedef _Float16 f16x4_ __attribute__((ext_vector_type(4)));
        *(f16x4_*)(HF + (size_t)col * SEQ + t0 + 4 * kq) = (f16x4_){(_Float16)o[0], (_Float16)o[1], (_Float16)o[2], (_Float16)o[3]}; }
}

__device__ __forceinline__ void transpose_item(const Args& a, int item, int lane) {
    const int lt = item & 127, ct = (item >> 7) & 7, b = item >> 10;
    const bf16_t* src = (const bf16_t*)(a.ws + WS_YHYT) + ((size_t)b * HYW + 64 * ct) * SEQ + 64 * lt + lane;
    bf16_t* dst = (bf16_t*)(a.ws + WS_MIX) + ((size_t)b * SEQ + 64 * lt + lane) * 1024 + 512 + 64 * ct;
    unsigned short v[64];
#pragma unroll
    for (int cc = 0; cc < 64; ++cc) v[cc] = src[(size_t)cc * SEQ];
#pragma unroll
    for (int q = 0; q < 8; ++q)
        *(u32x4*)(dst + 8 * q) = (u32x4){(unsigned)v[8 * q] | ((unsigned)v[8 * q + 1] << 16), (unsigned)v[8 * q + 2] | ((unsigned)v[8 * q + 3] << 16),
                                         (unsigned)v[8 * q + 4] | ((unsigned)v[8 * q + 5] << 16), (unsigned)v[8 * q + 6] | ((unsigned)v[8 * q + 7] << 16)};
}
}

__device__ __forceinline__ void p0_mod_and_filter(const Args& a, LAS unsigned char* lds) {
    const int tid = threadIdx.x, lane = tid & 63, wave = tid >> 6;
    const float* c = a.in[I_C]; const float* cctx = a.in[I_CCTX]; const float* adaw = a.in[I_ADAW]; const float* adab = a.in[I_ADAB];
    float* mod = (float*)(a.ws + WS_MOD);
    LAS float* sl = (LAS float*)lds;
    LAS float* pt = (LAS float*)lds + 5 * 1024;
    for (int i = tid; i < 5 * 1024; i += NTHREADS) { const int r = i >> 10, k = i & 1023; sl[i] = silu_f(r < 4 ? c[r * 1024 + k] : cctx[k]); }
    for (int it = blockIdx.x; it < 256; it += gridDim.x) {
        __syncthreads();
        if (tid < 504) {
            const int col = tid % 24, ks = tid / 24, n = it * 24 + col, kbeg = ks * 49, kend = (kbeg + 49 < 1024) ? kbeg + 49 : 1024;
            float acc[5] = {0.f, 0.f, 0.f, 0.f, 0.f};
#pragma unroll 7
            for (int k = kbeg; k < kend; ++k) { const float w = adaw[(size_t)k * 6144 + n];
#pragma unroll
                for (int r = 0; r < 5; ++r) acc[r] += sl[r * 1024 + k] * w; }
#pragma unroll
            for (int r = 0; r < 5; ++r) pt[(ks * 5 + r) * 24 + col] = acc[r];
        }
        __syncthreads();
        if (tid < 120) { const int r = tid / 24, col = tid % 24, n = it * 24 + col; float s = adab[n];
            for (int ks = 0; ks < 21; ++ks) s += pt[(ks * 5 + r) * 24 + col];
            mod[r * 6144 + n] = s; }
    }
    __syncthreads();
    const float* w1 = a.in[I_FW1]; const float* b1 = a.in[I_FB1]; const float* w2 = a.in[I_FW2]; const float* b2 = a.in[I_FB2]; const float* fq = a.in[I_FFREQ];
    float* hid2 = (float*)(a.ws + WS_HID2);
    LAS float* zs = (LAS float*)lds + 8192 + wave * 128;
    const float frq = fq[lane], bb1 = b1[lane], bb2 = b2[lane];
    for (int t = (blockIdx.x * NWAVES + wave); t < SEQ; t += gridDim.x * NWAVES) {
        float z = 0.f;
        if (lane == 0) z = (float)t / (float)(SEQ - 1);
        else if (lane < 33) { const int i = (lane - 1) & 15; const float f = 1e-4f + (float)i * ((15.f - 1e-4f) / 15.f);
            const float ang = (6.283185307179586f * (float)t / (float)SEQ) * f; z = (lane < 17) ? cosf(ang) : -sinf(ang); }
        if (lane < 33) zs[lane] = z;
        __builtin_amdgcn_wave_barrier(); asm volatile("s_waitcnt lgkmcnt(0)" ::: "memory");
        float s = bb1;
#pragma unroll
        for (int e = 0; e < 33; ++e) s += zs[e] * w1[e * 64 + lane];
        const float h1 = sinf(frq * s);
        zs[64 + lane] = h1;
        __builtin_amdgcn_wave_barrier(); asm volatile("s_waitcnt lgkmcnt(0)" ::: "memory");
        float s2 = bb2;
#pragma unroll 16
        for (int g = 0; g < 64; ++g) s2 += zs[64 + g] * w2[g * 64 + lane];
        hid2[(size_t)t * 64 + lane] = sinf(frq * s2);
        __builtin_amdgcn_wave_barrier(); asm volatile("s_waitcnt lgkmcnt(0)" ::: "memory");
    }
}

template <bool FP8 = false>
__device__ __forceinline__ void tr_item(const float* W, int ldw, int k0, int c0, int cstride, float scale, bf16_t* dstrow0, LAS float* scr, int lane) {
    float wv_[32];
#pragma unroll
    for (int i = 0; i < 32; ++i) wv_[i] = W[(size_t)(k0 + 2 * i + (lane >> 5)) * ldw + c0 + (lane & 31) * cstride];
#pragma unroll
    for (int i = 0; i < 32; ++i) scr[(2 * i + (lane >> 5)) * 33 + (lane & 31)] = wv_[i] * scale;
    asm volatile("s_waitcnt lgkmcnt(0)" ::: "memory"); __builtin_amdgcn_wave_barrier();
    const int c = lane & 7;
#pragma unroll
    for (int j = 0; j < 4; ++j) { const int n = (lane >> 3) + 8 * j; const LAS float* s = scr + (8 * c) * 33 + n;
        if (FP8) { u32x2 o; o.x = gm::pk4_fp8(s[0 * 33], s[1 * 33], s[2 * 33], s[3 * 33]); o.y = gm::pk4_fp8(s[4 * 33], s[5 * 33], s[6 * 33], s[7 * 33]);
            *(u32x2*)((unsigned char*)dstrow0 + (size_t)n * 1024 + k0 + 8 * c) = o; }
        else { u32x4 o; o.x = pk2(s[0 * 33], s[1 * 33]); o.y = pk2(s[2 * 33], s[3 * 33]); o.z = pk2(s[4 * 33], s[5 * 33]); o.w = pk2(s[6 * 33], s[7 * 33]);
            *(u32x4*)(dstrow0 + (size_t)n * 1024 + k0 + 8 * c) = o; } }
    asm volatile("s_waitcnt lgkmcnt(0)" ::: "memory"); __builtin_amdgcn_wave_barrier();
}
__device__ __forceinline__ void fold_item(const float* win, const float* wa, int dir, int k0, int j0, bf16_t* dstrow0, LAS float* scr, int lane) {
#pragma unroll 4
    for (int i = 0; i < 32; ++i) { const int kk = 2 * i + (lane >> 5); const float* wr = win + (size_t)(k0 + kk) * INW + 1536 + 16 * dir; float s = 0.f;
#pragma unroll
        for (int r = 0; r < 16; ++r) s += wr[r] * wa[r * 256 + j0 + (lane & 31)];
        scr[kk * 33 + (lane & 31)] = s; }
    asm volatile("s_waitcnt lgkmcnt(0)" ::: "memory"); __builtin_amdgcn_wave_barrier();
    const int c = lane & 7;
#pragma unroll
    for (int j = 0; j < 4; ++j) { const int n = (lane >> 3) + 8 * j; const LAS float* s = scr + (8 * c) * 33 + n;
        u32x4 o; o.x = pk2(s[0 * 33], s[1 * 33]); o.y = pk2(s[2 * 33], s[3 * 33]); o.z = pk2(s[4 * 33], s[5 * 33]); o.w = pk2(s[6 * 33], s[7 * 33]);
        *(u32x4*)(dstrow0 + (size_t)n * 1024 + k0 + 8 * c) = o; }
    asm volatile("s_waitcnt lgkmcnt(0)" ::: "memory"); __builtin_amdgcn_wave_barrier();
}
__device__ __forceinline__ void ln_mod_row(const float* xrow, const float* shift, const float* scale, bf16_t* orow, int lane) {
    const f32x4* xr = (const f32x4*)xrow + lane;
    f32x4 v[4]; float s = 0.f;
#pragma unroll
    for (int j = 0; j < 4; ++j) { v[j] = xr[64 * j]; s += (v[j][0] + v[j][1]) + (v[j][2] + v[j][3]); }
    const float mean = wave_sum(s) * (1.f / D); float s2 = 0.f;
#pragma unroll
    for (int j = 0; j < 4; ++j) { v[j] = v[j] - mean; s2 += (v[j][0] * v[j][0] + v[j][1] * v[j][1]) + (v[j][2] * v[j][2] + v[j][3] * v[j][3]); }
    const float rstd = 1.f / sqrtf(wave_sum(s2) * (1.f / D) + LN_EPS);
    u32x2* o8 = (u32x2*)orow + lane;
#pragma unroll
    for (int j = 0; j < 4; ++j) { const f32x4 sh = ((const f32x4*)shift)[64 * j + lane], sc = ((const f32x4*)scale)[64 * j + lane];
        const f32x4 y = v[j] * rstd * (sc + 1.f) + sh;
        u32x2 w; w.x = pk2(y[0], y[1]); w.y = pk2(y[2], y[3]); o8[64 * j] = w; }
}
constexpr int PREP_I_IN = 16 * 96, PREP_I_FOLD = 16 * 8 * 2, PREP_I_OUT = 16 * 32, PREP_I_W1 = NE * 16 * 64, PREP_I_W2 = NE * 16 * 32;
constexpr int PREP_NITEMS = PREP_I_IN + PREP_I_FOLD + PREP_I_OUT + PREP_I_W1 + PREP_I_W2;
constexpr int PREP_DEFER = 10880;
__device__ __forceinline__ void prep_items(const Args& a, LAS float* scr, int first, int last, int rank, int nranks, int lane) {
    constexpr int I_IN = PREP_I_IN, I_FOLD = PREP_I_FOLD, I_OUT = PREP_I_OUT, I_W1 = PREP_I_W1;
    const float* win = a.in[I_WIN];
    bf16_t* btin = (bf16_t*)(a.ws + WS_BTIN); bf16_t* btout = (bf16_t*)(a.ws + WS_BTOUT); bf16_t* w1t = (bf16_t*)(a.ws + WS_W1T); bf16_t* w2t = (bf16_t*)(a.ws + WS_W2T);
    for (int it = first + rank; it < last; it += nranks) {
        int r = it;
        if (r < I_IN) {
            const int kb = r / 96, nb = r % 96;
            if (nb < 48) tr_item(win, INW, 64 * kb, 32 * nb, 1, nb < 8 ? 0.125f : 1.f, btin + (size_t)(32 * nb) * 1024, scr, lane);
            else tr_item(win, INW, 64 * kb, 1568 + 32 * (nb - 48), 1, 1.f, btin + (size_t)(2048 + 32 * (nb - 48)) * 1024, scr, lane);
            continue; }
        r -= I_IN;
        if (r < I_FOLD) { const int dir = r & 1, jb = (r >> 1) & 7, kb = r >> 4;
            fold_item(win, dir ? a.in[I_WAB] : a.in[I_WAF], dir, 64 * kb, 32 * jb, btin + (size_t)(1536 + 256 * dir + 32 * jb) * 1024, scr, lane); continue; }
        r -= I_FOLD;
        if (r < I_OUT) { const int kb = r / 32, nb = r % 32; tr_item(a.in[I_WOUT], 1024, 64 * kb, 32 * nb, 1, 1.f, btout + (size_t)(32 * nb) * 1024, scr, lane); continue; }
        r -= I_OUT;
        if (r < I_W1) {
            const int e = r / 1024, q = r % 1024, s = q & 1, nb = (q >> 1) & 31, kb = q >> 6;
            const int ct = nb >> 2, jj0 = (nb & 3) * 32;
            tr_item<true>(a.in[I_EW1] + (size_t)e * 1024 * 2048, 2048, 64 * kb, 2 * (128 * ct + jj0) + s, 2, gm::S_W, (bf16_t*)((unsigned char*)w1t + ((size_t)e * 2048 + 256 * ct + 128 * s + jj0) * 1024), scr, lane);
            continue; }
        r -= I_W1;
        { const int e = r / 512, q = r % 512, kb = q / 32, nb = q % 32;
          tr_item<true>(a.in[I_EW2] + (size_t)e * 1024 * 1024, 1024, 64 * kb, 32 * nb, 1, gm::S_W, (bf16_t*)((unsigned char*)w2t + ((size_t)e * 1024 + 32 * nb) * 1024), scr, lane); }
    }
}
__device__ __forceinline__ void p1_prep(const Args& a, LAS unsigned char* lds) {
    const int tid = threadIdx.x, lane = tid & 63, wave = tid >> 6;
    LAS float* scr = (LAS float*)(lds + wave * 16384);
    const int gw = blockIdx.x * NWAVES + wave, NGW = gridDim.x * NWAVES;
    const float* win = a.in[I_WIN];
    bf16_t* btin = (bf16_t*)(a.ws + WS_BTIN); bf16_t* btout = (bf16_t*)(a.ws + WS_BTOUT); bf16_t* w1t = (bf16_t*)(a.ws + WS_W1T); bf16_t* w2t = (bf16_t*)(a.ws + WS_W2T);
    const float* mod = (const float*)(a.ws + WS_MOD);
    bf16_t* H = (bf16_t*)(a.ws + WS_H);
    { int cur_mr = -1; f32x4 shv[4], scv[4];
#pragma unroll
      for (int j = 0; j < 4; ++j) { shv[j] = (f32x4){0.f, 0.f, 0.f, 0.f}; scv[j] = shv[j]; }
      for (int row0 = gw; row0 < TT; row0 += 4 * NGW) {
        f32x4 xv[4][4];
#pragma unroll
        for (int i = 0; i < 4; ++i) { const int row = row0 + i * NGW;
            if (row < TT) { const f32x4* xr = (const f32x4*)(row < T ? a.in[I_X] + (size_t)row * D : a.in[I_CTX] + (size_t)(row - T) * D) + lane;
#pragma unroll
                for (int j = 0; j < 4; ++j) xv[i][j] = xr[64 * j]; } }
#pragma unroll
        for (int i = 0; i < 4; ++i) { const int row = row0 + i * NGW;
            if (row < TT) { const int mr = row < T ? row >> 13 : 4;
                if (mr != cur_mr) { cur_mr = mr;
#pragma unroll
                    for (int j = 0; j < 4; ++j) { shv[j] = ((const f32x4*)(mod + mr * 6144))[64 * j + lane]; scv[j] = ((const f32x4*)(mod + mr * 6144 + 1024))[64 * j + lane]; } }
                f32x4 v[4]; float s = 0.f;
#pragma unroll
                for (int j = 0; j < 4; ++j) { v[j] = xv[i][j]; s += (v[j][0] + v[j][1]) + (v[j][2] + v[j][3]); }
                const float mean = wave_sum(s) * (1.f / D); float s2 = 0.f;
#pragma unroll
                for (int j = 0; j < 4; ++j) { v[j] = v[j] - mean; s2 += (v[j][0] * v[j][0] + v[j][1] * v[j][1]) + (v[j][2] * v[j][2] + v[j][3] * v[j][3]); }
                const float rstd = 1.f / sqrtf(wave_sum(s2) * (1.f / D) + LN_EPS);
                u32x2* o8 = (u32x2*)(H + (size_t)row * D) + lane;
#pragma unroll
                for (int j = 0; j < 4; ++j) { const f32x4 y = v[j] * rstd * (scv[j] + 1.f) + shv[j];
                    u32x2 w; w.x = pk2(y[0], y[1]); w.y = pk2(y[2], y[3]); o8[64 * j] = w; } } }
      } }
    prep_items(a, scr, 0, PREP_I_IN + PREP_I_FOLD + PREP_I_OUT, gw, NGW, lane);
    prep_items(a, scr, PREP_I_IN + PREP_I_FOLD + PREP_I_OUT + PREP_I_W1, PREP_NITEMS - PREP_DEFER, gw, NGW, lane);
    for (int it = gw; it < 2048; it += NGW) hy::filter_item(a, it, lane);
    float* b1r = (float*)(a.ws + WS_B1R); const float* eb1 = a.in[I_EB1];
    for (int i = blockIdx.x * NTHREADS + tid; i < NE * 2048; i += gridDim.x * NTHREADS) {
        const int e = i >> 11, n = i & 2047, ct = n >> 8, s = (n >> 7) & 1, jj = n & 127;
        b1r[i] = eb1[(size_t)e * 2048 + 2 * (128 * ct + jj) + s];
    }
}

namespace gla {
constexpr int RS = 72;
constexpr int L_TOTF = 0, L_TOTB = 2048, L_SSQ = 4096;
constexpr int L_T0 = 8192;
constexpr int L_T1 = L_T0 + 9216, L_T2 = L_T1 + 9216, L_T3 = L_T2 + 9216;
constexpr int L_VT = L_T3 + 9216;
constexpr int L_P  = L_VT + 18432;
constexpr int L_SF = L_P + 9216, L_SB = L_SF + 18432;
constexpr int L_END = L_SB + 18432;

__device__ __forceinline__ bf16x8 frag(const LAS unsigned char* tile, int row, int k0, int lane) {
    return *(const LAS bf16x8*)(tile + ((row + (lane & 15)) * RS + k0 + 8 * (lane >> 4)) * 2);
}
__device__ __forceinline__ void chunk_cums_pre(LAS unsigned char* L, const float (&gf)[8], const float (&gb)[8], int wave, int lane, float (&cumf)[8], float (&cumb)[8], float& allf, float& allb) {
    LAS float* totf = (LAS float*)(L + L_TOTF); LAS float* totb = (LAS float*)(L + L_TOTB);
    cumf[0] = gf[0];
#pragma unroll
    for (int r = 1; r < 8; ++r) cumf[r] = cumf[r - 1] + gf[r];
    cumb[7] = gb[7];
#pragma unroll
    for (int r = 6; r >= 0; --r) cumb[r] = cumb[r + 1] + gb[r];
    totf[wave * 64 + lane] = cumf[7]; totb[wave * 64 + lane] = cumb[0];
    __syncthreads();
    float of = 0.f, ob = 0.f, af = 0.f, ab = 0.f;
#pragma unroll
    for (int w = 0; w < 8; ++w) { const float tf = totf[w * 64 + lane], tb = totb[w * 64 + lane]; af += tf; ab += tb; of += (w < wave) ? tf : 0.f; ob += (w > wave) ? tb : 0.f; }
#pragma unroll
    for (int r = 0; r < 8; ++r) { cumf[r] += of; cumb[r] += ob; }
    allf = af; allb = ab;
}
__device__ __forceinline__ void chunk_cums(LAS unsigned char* L, const _Float16* GF, const _Float16* GB, size_t tok0, int h, int wave, int lane, float (&cumf)[8], float (&cumb)[8], float& allf, float& allb) {
    float gf[8], gb[8];
#pragma unroll
    for (int r = 0; r < 8; ++r) { const size_t o = (tok0 + 8 * wave + r) * 256 + h * 64 + lane; gf[r] = (float)GF[o]; gb[r] = (float)GB[o]; }
    chunk_cums_pre(L, gf, gb, wave, lane, cumf, cumb, allf, allb);
}
__device__ __forceinline__ void store_vt(LAS unsigned char* L, const u32x4 (&vr)[2], int tid) {
    LAS bf16_t* vt = (LAS bf16_t*)(L + L_VT);
    const int j = tid >> 3, c8 = tid & 7;
#pragma unroll
    for (int q = 0; q < 2; ++q) { const int dv0 = 8 * (c8 + 8 * q);
        const unsigned ww[4] = {vr[q].x, vr[q].y, vr[q].z, vr[q].w};
#pragma unroll
        for (int e = 0; e < 4; ++e) { vt[(dv0 + 2 * e) * RS + j] = (bf16_t)(ww[e] & 0xffffu); vt[(dv0 + 2 * e + 1) * RS + j] = (bf16_t)(ww[e] >> 16); } }
}
__device__ __forceinline__ void load_vt(LAS unsigned char* L, const bf16_t* V, size_t tok0, int h, int tid) {
    const int j = tid >> 3, c8 = tid & 7; u32x4 vr[2];
#pragma unroll
    for (int q = 0; q < 2; ++q) vr[q] = *(const u32x4*)(V + (tok0 + j) * 512 + h * 128 + 8 * (c8 + 8 * q));
    store_vt(L, vr, tid);
}

__device__ __forceinline__ void g1_unit(const Args& a, LAS unsigned char* L, int bh, int chunk  ) {
    const int tid = threadIdx.x, lane = tid & 63, wave = __builtin_amdgcn_readfirstlane(tid >> 6);
    const int b = bh >> 2, h = bh & 3;
    const size_t tok0 = chunk < NCHUNK ? (size_t)b * SEQ + (size_t)chunk * CH : (size_t)T + (size_t)b * CTXL + (size_t)(chunk - NCHUNK) * CH;
    const _Float16* GF = (const _Float16*)(a.ws + WS_GF); const _Float16* GB = (const _Float16*)(a.ws + WS_GB);
    const bf16_t* Kb = (const bf16_t*)(a.ws + WS_K); const bf16_t* Vb = (const bf16_t*)(a.ws + WS_V);
    float cumf[8], cumb[8], allf, allb;
    __syncthreads();
    chunk_cums(L, GF, GB, tok0, h, wave, lane, cumf, cumb, allf, allb);
    LAS bf16_t* ketf = (LAS bf16_t*)(L + L_T0); LAS bf16_t* ketb = (LAS bf16_t*)(L + L_T1);
#pragma unroll
    for (int r = 0; r < 8; ++r) { const int i = 8 * wave + r; const float kv = bf2f(Kb[(tok0 + i) * 256 + h * 64 + lane]);
        ketf[lane * RS + i] = f2bf(kv * __expf(allf - cumf[r])); ketb[lane * RS + i] = f2bf(kv * __expf(allb - cumb[r])); }
    load_vt(L, Vb, tok0, h, tid);
    if (wave == 0) { float* av = (float*)(a.ws + WS_AV); av[((size_t)(0 * 16 + bh) * NCT + chunk) * 64 + lane] = __expf(allf); av[((size_t)(1 * 16 + bh) * NCT + chunk) * 64 + lane] = __expf(allb); }
    __syncthreads();
    bf16_t* KV = (bf16_t*)(a.ws + WS_KV);
#pragma unroll
    for (int dir = 0; dir < 2; ++dir) {
        const LAS unsigned char* ket = L + (dir ? L_T1 : L_T0);
        bf16_t* dst = KV + ((size_t)(dir * 16 + bh) * NCT + chunk) * 8192;
#pragma unroll
        for (int nt = 0; nt < 4; ++nt) { f32x4 acc = {0.f, 0.f, 0.f, 0.f};
#pragma unroll
            for (int ks = 0; ks < 2; ++ks) acc = __builtin_amdgcn_mfma_f32_16x16x32_bf16(frag(L + L_VT, 16 * wave, 32 * ks, lane), frag(ket, 16 * nt, 32 * ks, lane), acc, 0, 0, 0);
#pragma unroll
            for (int r = 0; r < 4; ++r) dst[(16 * wave + 4 * (lane >> 4) + r) * 64 + 16 * nt + (lane & 15)] = f2bf(acc[r]); }
    }
}

__device__ __forceinline__ void g2_scan(const Args& a) {
    const bf16_t* KV = (const bf16_t*)(a.ws + WS_KV); const float* AV = (const float*)(a.ws + WS_AV); bf16_t* SP = (bf16_t*)(a.ws + WS_SP);
    for (int id = blockIdx.x * NTHREADS + threadIdx.x; id < 32 * 4096; id += gridDim.x * NTHREADS) {
        const int db = id >> 12, e2 = id & 4095, dir = db >> 4, dk = (2 * e2) & 63;
        const unsigned* kv = (const unsigned*)(KV + (size_t)db * NCT * 8192) + e2;
        const float* av = AV + (size_t)db * NCT * 64 + dk;
        unsigned* sp = (unsigned*)(SP + (size_t)db * NCHUNK * 8192) + e2;
        float s0 = 0.f, s1 = 0.f;
#pragma unroll
        for (int q = 0; q < NCC; ++q) { const int c = NCHUNK + (dir ? (NCC - 1 - q) : q);
            const unsigned w = kv[(size_t)c * 4096]; const f32x2 aa = *(const f32x2*)(av + (size_t)c * 64);
            s0 = aa[0] * s0 + bflo(w); s1 = aa[1] * s1 + bfhi(w); }
        for (int q0 = 0; q0 < NCHUNK; q0 += 16) {
            unsigned w[16]; f32x2 aa[16];
#pragma unroll
            for (int u = 0; u < 16; ++u) { const int c = dir ? (NCHUNK - 1 - (q0 + u)) : (q0 + u); w[u] = kv[(size_t)c * 4096]; aa[u] = *(const f32x2*)(av + (size_t)c * 64); }
#pragma unroll
            for (int u = 0; u < 16; ++u) { const int c = dir ? (NCHUNK - 1 - (q0 + u)) : (q0 + u);
                sp[(size_t)c * 4096] = pk2(s0, s1);
                s0 = aa[u][0] * s0 + bflo(w[u]); s1 = aa[u][1] * s1 + bfhi(w[u]); }
        }
    }
}

struct G3In { float gf[8], gb[8]; bf16_t q[8], k[8]; u32x4 v[2]; u32x4 sraw[4]; bf16_t gr[4][4]; };
__device__ __forceinline__ void g3_load(const Args& a, int bh, int chunk, G3In& in) {
    const int tid = threadIdx.x, lane = tid & 63, wave = __builtin_amdgcn_readfirstlane(tid >> 6);
    const int b = bh >> 2, h = bh & 3;
    const size_t tok0 = (size_t)b * SEQ + (size_t)chunk * CH;
    const _Float16* GF = (const _Float16*)(a.ws + WS_GF); const _Float16* GB = (const _Float16*)(a.ws + WS_GB);
    const bf16_t* Qb = (const bf16_t*)(a.ws + WS_Q); const bf16_t* Kb = (const bf16_t*)(a.ws + WS_K); const bf16_t* Vb = (const bf16_t*)(a.ws + WS_V);
#pragma unroll
    for (int r = 0; r < 8; ++r) { const size_t o = (tok0 + 8 * wave + r) * 256 + h * 64 + lane; in.gf[r] = (float)GF[o]; in.gb[r] = (float)GB[o]; in.q[r] = Qb[o]; in.k[r] = Kb[o]; }
#pragma unroll
    for (int q = 0; q < 2; ++q) in.v[q] = *(const u32x4*)(Vb + (tok0 + (tid >> 3)) * 512 + h * 128 + 8 * ((tid & 7) + 8 * q));
    const bf16_t* SPf = (const bf16_t*)(a.ws + WS_SP) + ((size_t)(0 * 16 + bh) * NCHUNK + chunk) * 8192;
    const bf16_t* SPb = (const bf16_t*)(a.ws + WS_SP) + ((size_t)(1 * 16 + bh) * NCHUNK + chunk) * 8192;
    in.sraw[0] = *(const u32x4*)(SPf + 16 * tid); in.sraw[1] = *(const u32x4*)(SPf + 16 * tid + 8);
    in.sraw[2] = *(const u32x4*)(SPb + 16 * tid); in.sraw[3] = *(const u32x4*)(SPb + 16 * tid + 8);
    const bf16_t* Gt = (const bf16_t*)(a.ws + WS_G);
    const int mt = wave >> 1, fr = lane & 15, fq = lane >> 4;
#pragma unroll
    for (int q = 0; q < 4; ++q)
#pragma unroll
        for (int r = 0; r < 4; ++r) in.gr[r][q] = Gt[(tok0 + 16 * mt + 4 * fq + r) * 512 + h * 128 + 16 * (4 * (wave & 1) + q) + fr];
}
__device__ __forceinline__ void g3_unit(const Args& a, LAS unsigned char* L, int bh, int chunk  , const G3In& in, hy::CvState& cvs) {
    const int tid = threadIdx.x, lane = tid & 63, wave = __builtin_amdgcn_readfirstlane(tid >> 6);
    const int b = bh >> 2, h = bh & 3;
    const size_t tok0 = (size_t)b * SEQ + (size_t)chunk * CH;
    const int mt = wave >> 1, fr = lane & 15, fq = lane >> 4;
    float cumf[8], cumb[8], allf, allb;
    hy::cv_step(a, cvs, lane);
    __syncthreads();
    chunk_cums_pre(L, in.gf, in.gb, wave, lane, cumf, cumb, allf, allb);
    LAS bf16_t* qf = (LAS bf16_t*)(L + L_T0); LAS bf16_t* kf = (LAS bf16_t*)(L + L_T1); LAS bf16_t* qb = (LAS bf16_t*)(L + L_T2); LAS bf16_t* kb = (LAS bf16_t*)(L + L_T3);
#pragma unroll
    for (int r = 0; r < 8; ++r) { const int i = 8 * wave + r;
        const float qv = bf2f(in.q[r]), kv = bf2f(in.k[r]);
        qf[i * RS + lane] = f2bf(qv * __expf(cumf[r])); kf[i * RS + lane] = f2bf(kv * __expf(-cumf[r]));
        qb[i * RS + lane] = f2bf(qv * __expf(cumb[r])); kb[i * RS + lane] = f2bf(kv * __expf(-cumb[r])); }
    store_vt(L, in.v, tid);
    {
      LAS unsigned char* sf_ = L + L_SF + ((tid >> 2) * RS + 16 * (tid & 3)) * 2; LAS unsigned char* sb_ = L + L_SB + ((tid >> 2) * RS + 16 * (tid & 3)) * 2;
      *(LAS u32x4*)sf_ = in.sraw[0]; *(LAS u32x4*)(sf_ + 16) = in.sraw[1]; *(LAS u32x4*)sb_ = in.sraw[2]; *(LAS u32x4*)(sb_ + 16) = in.sraw[3]; }
    hy::cv_step(a, cvs, lane);
    __syncthreads();
    {
        LAS bf16_t* P = (LAS bf16_t*)(L + L_P);
#pragma unroll
        for (int q = 0; q < 2; ++q) { const int nt = 2 * (wave & 1) + q;
            f32x4 sf = {0.f, 0.f, 0.f, 0.f}, sb = {0.f, 0.f, 0.f, 0.f};
#pragma unroll
            for (int ks = 0; ks < 2; ++ks) {
                sf = __builtin_amdgcn_mfma_f32_16x16x32_bf16(frag(L + L_T0, 16 * mt, 32 * ks, lane), frag(L + L_T1, 16 * nt, 32 * ks, lane), sf, 0, 0, 0);
                sb = __builtin_amdgcn_mfma_f32_16x16x32_bf16(frag(L + L_T2, 16 * mt, 32 * ks, lane), frag(L + L_T3, 16 * nt, 32 * ks, lane), sb, 0, 0, 0); }
#pragma unroll
            for (int r = 0; r < 4; ++r) { const int i = 16 * mt + 4 * fq + r, j = 16 * nt + fr;
                P[i * RS + j] = f2bf((j <= i ? sf[r] : 0.f) + (j >= i ? sb[r] : 0.f)); } }
    }
    hy::cv_step(a, cvs, lane);
    __syncthreads();
    f32x4 o[4]; float ssq[4] = {0.f, 0.f, 0.f, 0.f};
#pragma unroll
    for (int q = 0; q < 4; ++q) { const int nt = 4 * (wave & 1) + q;
        f32x4 acc = {0.f, 0.f, 0.f, 0.f};
#pragma unroll
        for (int ks = 0; ks < 2; ++ks) {
            acc = __builtin_amdgcn_mfma_f32_16x16x32_bf16(frag(L + L_P, 16 * mt, 32 * ks, lane), frag(L + L_VT, 16 * nt, 32 * ks, lane), acc, 0, 0, 0);
            acc = __builtin_amdgcn_mfma_f32_16x16x32_bf16(frag(L + L_T0, 16 * mt, 32 * ks, lane), frag(L + L_SF, 16 * nt, 32 * ks, lane), acc, 0, 0, 0);
            acc = __builtin_amdgcn_mfma_f32_16x16x32_bf16(frag(L + L_T2, 16 * mt, 32 * ks, lane), frag(L + L_SB, 16 * nt, 32 * ks, lane), acc, 0, 0, 0); }
        o[q] = acc;
#pragma unroll
        for (int r = 0; r < 4; ++r) ssq[r] += acc[r] * acc[r]; }
    LAS float* SSQ = (LAS float*)(L + L_SSQ);
#pragma unroll
    for (int r = 0; r < 4; ++r) { float s = ssq[r]; s += __shfl_xor(s, 1); s += __shfl_xor(s, 2); s += __shfl_xor(s, 4); s += __shfl_xor(s, 8); ssq[r] = s; }
    if (fr == 0) {
#pragma unroll
        for (int r = 0; r < 4; ++r) SSQ[(wave & 1) * 64 + 16 * mt + 4 * fq + r] = ssq[r]; }
    hy::cv_step(a, cvs, lane);
    __syncthreads();
    const float* ng = a.in[I_NORMG];
    bf16_t* mix = (bf16_t*)(a.ws + WS_MIX);
#pragma unroll
    for (int r = 0; r < 4; ++r) { const int i = 16 * mt + 4 * fq + r;
        const float rstd = 1.f / sqrtf((SSQ[i] + SSQ[64 + i]) * (1.f / DV) + LN_EPS);
#pragma unroll
        for (int q = 0; q < 4; ++q) { const int dv = 16 * (4 * (wave & 1) + q) + fr;
            const float g = bf2f(in.gr[r][q]);
            mix[(tok0 + i) * 1024 + h * 128 + dv] = f2bf(o[q][r] * rstd * ng[dv] * silu_f(g)); } }
}
}

namespace rt {
constexpr int HS = 1028;
constexpr int L_H2 = 0;
constexpr int L_PART = 65792;
constexpr int L_LCNT = L_PART + 16384;
constexpr int L_REC = L_LCNT + 256;
constexpr int L_TAB = 86016;

__device__ __forceinline__ void phase(const Args& a, LAS unsigned char* lds) {
    const int tid = threadIdx.x, lane = tid & 63, wave = __builtin_amdgcn_readfirstlane(tid >> 6);
    bf16_t* xmid = (bf16_t*)(a.ws + WS_PRE1); bf16_t* H2 = (bf16_t*)(a.ws + WS_H2); const bf16_t* FG = (const bf16_t*)(a.ws + WS_FG);
    const float* mod = (const float*)(a.ws + WS_MOD);
    const float* rw = a.in[I_RW]; const float* rb = a.in[I_RB];
    LAS float* h2s = (LAS float*)(lds + L_H2); LAS float* part = (LAS float*)(lds + L_PART);
    LAS int* lcnt = (LAS int*)(lds + L_LCNT); LAS int* lbase = lcnt + 32; LAS int* rec = (LAS int*)(lds + L_REC);
    unsigned* cnt = (unsigned*)(a.ws + WS_CNT); int* list = (int*)(a.ws + WS_LIST); float* pw = (float*)(a.ws + WS_PW); int* ploc = (int*)(a.ws + WS_PLOC);
    float rwr[32][2];
#pragma unroll
    for (int s = 0; s < 32; ++s)
#pragma unroll
        for (int nt = 0; nt < 2; ++nt) rwr[s][nt] = rw[(size_t)(128 * wave + 4 * s + (lane >> 4)) * 32 + 16 * nt + (lane & 15)];
    LAS f32x4* g1 = (LAS f32x4*)(lds + L_TAB); LAS f32x4* bb1 = g1 + 256; LAS f32x4* shT = bb1 + 256; LAS f32x4* scT = shT + 4 * 256;
    if (tid < 256) { g1[tid] = ((const f32x4*)a.in[I_LN1G])[tid]; bb1[tid] = ((const f32x4*)a.in[I_LN1B])[tid]; }
    for (int i = tid; i < 4 * 256; i += NTHREADS) { shT[i] = ((const f32x4*)(mod + (i >> 8) * 6144 + 3 * 1024))[i & 255]; scT[i] = ((const f32x4*)(mod + (i >> 8) * 6144 + 4 * 1024))[i & 255]; }
    const float rbe = rb[lane & 31];
    if (tid < 32) lcnt[tid] = 0;
    int pend = 0, pgrp = -1;
    f32x4 xq[2][4]; u32x2 fq_[2][4];
#define RT_LOAD(g_) do { _Pragma("unroll") for (int rr = 0; rr < 2; ++rr) { const int t_ = (g_) * 16 + 2 * wave + rr; \
        const f32x4* xr_ = (const f32x4*)(a.in[I_X] + (size_t)t_ * D) + lane; const u32x2* fr_ = (const u32x2*)(FG + (size_t)t_ * D) + lane; \
        _Pragma("unroll") for (int j = 0; j < 4; ++j) { xq[rr][j] = xr_[64 * j]; fq_[rr][j] = fr_[64 * j]; } } } while (0)
    if ((int)blockIdx.x < T / 16) RT_LOAD((int)blockIdx.x);
    for (int grp = blockIdx.x; grp < T / 16; grp += gridDim.x) {
        __syncthreads();
        f32x4 xv_[2][4]; u32x2 fv_[2][4];
#pragma unroll
        for (int rr = 0; rr < 2; ++rr)
#pragma unroll
            for (int j = 0; j < 4; ++j) { xv_[rr][j] = xq[rr][j]; fv_[rr][j] = fq_[rr][j]; }
        if (pgrp >= 0) { if (tid < 32) lbase[tid] = pend; __syncthreads();
            if (tid < 64) { const int rc = rec[tid], ek = rc & 255, rank = rc >> 8, pos = lbase[ek] + rank, pair = (pgrp * 16 + (tid >> 2)) * 4 + (tid & 3);
                list[(size_t)ek * CAP + pos] = pair; ploc[pair] = ek | (pos << 5); } }
        if (grp + (int)gridDim.x < T / 16) RT_LOAD(grp + (int)gridDim.x);
#pragma unroll
        for (int rr = 0; rr < 2; ++rr) {
            const int lr = 2 * wave + rr, t = grp * 16 + lr, b = t >> 13;
            u32x2* pr = (u32x2*)(xmid + (size_t)t * D) + lane;
            f32x4 v[4]; float s = 0.f;
#pragma unroll
            for (int j = 0; j < 4; ++j) { const u32x2 fw = fv_[rr][j]; const f32x4 ff = {bflo(fw.x), bfhi(fw.x), bflo(fw.y), bfhi(fw.y)};
                v[j] = xv_[rr][j] * ALPHA + ff; s += (v[j][0] + v[j][1]) + (v[j][2] + v[j][3]); }
            float mean = wave_sum(s) * (1.f / D), s2 = 0.f;
#pragma unroll
            for (int j = 0; j < 4; ++j) { v[j] = v[j] - mean; s2 += (v[j][0] * v[j][0] + v[j][1] * v[j][1]) + (v[j][2] * v[j][2] + v[j][3] * v[j][3]); }
            float rstd = 1.f / sqrtf(wave_sum(s2) * (1.f / D) + LN_EPS);
            s = 0.f;
#pragma unroll
            for (int j = 0; j < 4; ++j) { v[j] = v[j] * rstd * g1[64 * j + lane] + bb1[64 * j + lane]; u32x2 w; w.x = pk2(v[j][0], v[j][1]); w.y = pk2(v[j][2], v[j][3]); pr[64 * j] = w;
                v[j] = (f32x4){bflo(w.x), bfhi(w.x), bflo(w.y), bfhi(w.y)}; s += (v[j][0] + v[j][1]) + (v[j][2] + v[j][3]); }
            mean = wave_sum(s) * (1.f / D); s2 = 0.f;
#pragma unroll
            for (int j = 0; j < 4; ++j) { v[j] = v[j] - mean; s2 += (v[j][0] * v[j][0] + v[j][1] * v[j][1]) + (v[j][2] * v[j][2] + v[j][3] * v[j][3]); }
            rstd = 1.f / sqrtf(wave_sum(s2) * (1.f / D) + LN_EPS);
            const LAS f32x4* sh = shT + b * 256; const LAS f32x4* sc = scT + b * 256;
            unsigned* o4 = (unsigned*)((unsigned char*)H2 + (size_t)t * D) + lane;
#pragma unroll
            for (int j = 0; j < 4; ++j) { const f32x4 y = v[j] * rstd * (sc[64 * j + lane] + 1.f) + sh[64 * j + lane];
                o4[64 * j] = gm::pk4_fp8(y[0] * gm::S_H2, y[1] * gm::S_H2, y[2] * gm::S_H2, y[3] * gm::S_H2);
                *(LAS f32x4*)(h2s + lr * HS + 256 * j + 4 * lane) = y; }
        }
        __syncthreads();
        {
            f32x4 acc0 = {0.f, 0.f, 0.f, 0.f}, acc1 = {0.f, 0.f, 0.f, 0.f};
            const LAS float* ap = h2s + (lane & 15) * HS + 128 * wave + (lane >> 4);
#pragma unroll
            for (int s = 0; s < 32; ++s) { const float av = ap[4 * s];
                acc0 = __builtin_amdgcn_mfma_f32_16x16x4f32(av, rwr[s][0], acc0, 0, 0, 0);
                acc1 = __builtin_amdgcn_mfma_f32_16x16x4f32(av, rwr[s][1], acc1, 0, 0, 0); }
#pragma unroll
            for (int r = 0; r < 4; ++r) { part[(wave * 16 + 4 * (lane >> 4) + r) * 32 + (lane & 15)] = acc0[r]; part[(wave * 16 + 4 * (lane >> 4) + r) * 32 + 16 + (lane & 15)] = acc1[r]; }
        }
        __syncthreads();
        {
            const int lr = 2 * wave + (lane >> 5), e = lane & 31, t = grp * 16 + lr;
            float lg = rbe;
#pragma unroll
            for (int w = 0; w < 8; ++w) lg += part[(w * 16 + lr) * 32 + e];
            float cur = lg, tv[4]; int ti[4];
#pragma unroll
            for (int k = 0; k < 4; ++k) { float bv = cur; int bi = e;
#pragma unroll
                for (int o = 1; o < 32; o <<= 1) { const float ov = __shfl_xor(bv, o); const int oi = __shfl_xor(bi, o); if (ov > bv || (ov == bv && oi < bi)) { bv = ov; bi = oi; } }
                tv[k] = bv; ti[k] = bi; if (bi == e) cur = -3.0e38f; }
            const float e1 = __expf(tv[1] - tv[0]), e2 = __expf(tv[2] - tv[0]), e3 = __expf(tv[3] - tv[0]);
            const float inv = 1.f / (1.f + e1 + e2 + e3);
            if (e < 4) { const float wk = (e == 0 ? 1.f : (e == 1 ? e1 : (e == 2 ? e2 : e3))) * inv; const int ek = (e == 0 ? ti[0] : (e == 1 ? ti[1] : (e == 2 ? ti[2] : ti[3])));
                const int pair = t * 4 + e;
                pw[pair] = wk;
                const int rank = __hip_atomic_fetch_add((LAS int*)&lcnt[ek], 1, __ATOMIC_RELAXED, __HIP_MEMORY_SCOPE_WORKGROUP);
                rec[lr * 4 + e] = ek | (rank << 8); }
        }
        __syncthreads();
        if (tid < 32) { const int n = lcnt[tid]; pend = n ? (int)atomicAdd(&cnt[tid], (unsigned)n) : 0; lcnt[tid] = 0; }
        pgrp = grp;
    }
    if (pgrp >= 0) { __syncthreads(); if (tid < 32) lbase[tid] = pend; __syncthreads();
        if (tid < 64) { const int rc = rec[tid], ek = rc & 255, rank = rc >> 8, pos = lbase[ek] + rank, pair = (pgrp * 16 + (tid >> 2)) * 4 + (tid & 3);
            list[(size_t)ek * CAP + pos] = pair; ploc[pair] = ek | (pos << 5); } }
#undef RT_LOAD
}
}

__device__ __forceinline__ void p_final(const Args& a, LAS unsigned char* lds) {
    const int tid = threadIdx.x, lane = tid & 63, wave = tid >> 6;
    const bf16_t* xm = (const bf16_t*)(a.ws + WS_PRE1); const unsigned char* slots = (const unsigned char*)(a.ws + WS_SLOTS); const float* mod = (const float*)(a.ws + WS_MOD);
    const int* ploc = (const int*)(a.ws + WS_PLOC); const float* pw = (const float*)(a.ws + WS_PW);
    const f32x4* g2 = (const f32x4*)a.in[I_LN2G]; const f32x4* b2 = (const f32x4*)a.in[I_LN2B];
    LAS int* tstart = (LAS int*)lds;
    __syncthreads();
    if (tid == 0) { const unsigned* cnt = (const unsigned*)(a.ws + WS_CNT); int nrt = 0; for (int e = 0; e < NE; ++e) { tstart[e] = 256 * nrt; nrt += ((int)cnt[e] + 255) >> 8; } }
    LAS f32x4* Lg2 = (LAS f32x4*)(lds + 1024); LAS f32x4* Lb2 = Lg2 + 256; LAS f32x4* Lgt = Lb2 + 256;
    if (tid < 256) { Lg2[tid] = g2[tid]; Lb2[tid] = b2[tid]; }
    for (int i = tid; i < 4 * 256; i += NTHREADS) Lgt[i] = ((const f32x4*)(mod + (i >> 8) * 6144 + 5 * 1024))[i & 255];
    __syncthreads();
    const int tstep = gridDim.x * NWAVES; int t = blockIdx.x * NWAVES + wave;
    if (t < T) {
        int plc[4], pln[4]; float wc_[4], wn_[4]; unsigned qc[4][4], qn[4][4]; u32x2 xc[4], xn[4];
#define PF_IDX(tt, pl, ww) do { _Pragma("unroll") for (int sl = 0; sl < 4; ++sl) { pl[sl] = ploc[(tt) * 4 + sl]; ww[sl] = pw[(tt) * 4 + sl] * (1.f / gm::S_SL); } } while (0)
#define PF_DATA(tt, pl, qq, xx) do { _Pragma("unroll") for (int sl = 0; sl < 4; ++sl) { const unsigned* sr_ = (const unsigned*)(slots + (size_t)(tstart[pl[sl] & 31] + (pl[sl] >> 5)) * D) + lane; \
            _Pragma("unroll") for (int j = 0; j < 4; ++j) qq[sl][j] = sr_[64 * j]; } \
        { const u32x2* xr_ = (const u32x2*)(xm + (size_t)(tt) * D) + lane; _Pragma("unroll") for (int j = 0; j < 4; ++j) xx[j] = xr_[64 * j]; } } while (0)
        PF_IDX(t, plc, wc_); PF_DATA(t, plc, qc, xc);
        int tn = t + tstep; const bool hn0 = tn < T;
        if (hn0) PF_IDX(tn, pln, wn_);
        for (;;) {
            const bool hn = tn < T;
            if (hn) PF_DATA(tn, pln, qn, xn);
            int pl2[4]; float w2[4]; const int tn2 = tn + tstep; const bool hn2 = hn && tn2 < T;
            if (hn2) PF_IDX(tn2, pl2, w2);
            {
                const int b = t >> 13; const LAS f32x4* gt = Lgt + b * 256;
                f32x4 v[4]; float s = 0.f;
#pragma unroll
                for (int j = 0; j < 4; ++j) { f32x4 y = {0.f, 0.f, 0.f, 0.f};
#pragma unroll
                    for (int sl = 0; sl < 4; ++sl) { const int q = (int)qc[sl][j];
                        y[0] += wc_[sl] * __builtin_amdgcn_cvt_f32_fp8(q, 0); y[1] += wc_[sl] * __builtin_amdgcn_cvt_f32_fp8(q, 1); y[2] += wc_[sl] * __builtin_amdgcn_cvt_f32_fp8(q, 2); y[3] += wc_[sl] * __builtin_amdgcn_cvt_f32_fp8(q, 3); }
                    const f32x4 xv = {bflo(xc[j].x), bfhi(xc[j].x), bflo(xc[j].y), bfhi(xc[j].y)};
                    v[j] = xv * ALPHA + gt[64 * j + lane] * y; s += (v[j][0] + v[j][1]) + (v[j][2] + v[j][3]); }
                const float mean = wave_sum(s) * (1.f / D); float s2 = 0.f;
#pragma unroll
                for (int j = 0; j < 4; ++j) { v[j] = v[j] - mean; s2 += (v[j][0] * v[j][0] + v[j][1] * v[j][1]) + (v[j][2] * v[j][2] + v[j][3] * v[j][3]); }
                const float rstd = 1.f / sqrtf(wave_sum(s2) * (1.f / D) + LN_EPS);
                f32x4* o = (f32x4*)(a.out + (size_t)t * D) + lane;
#pragma unroll
                for (int j = 0; j < 4; ++j) o[64 * j] = v[j] * rstd * Lg2[64 * j + lane] + Lb2[64 * j + lane];
            }
            if (!hn) break;
            t = tn; tn = tn2;
#pragma unroll
            for (int sl = 0; sl < 4; ++sl) { plc[sl] = pln[sl]; wc_[sl] = wn_[sl]; pln[sl] = pl2[sl]; wn_[sl] = w2[sl];
#pragma unroll
                for (int j = 0; j < 4; ++j) qc[sl][j] = qn[sl][j]; }
#pragma unroll
            for (int j = 0; j < 4; ++j) xc[j] = xn[j];
        }
#undef PF_IDX
#undef PF_DATA
    }
}


constexpr int N_PHASES = 11;
__global__ void __launch_bounds__(NTHREADS, 2) mega_fwd(Args a) {
    extern __shared__ __attribute__((aligned(16))) unsigned char lds_raw[];
    LAS unsigned char* lds = (LAS unsigned char*)lds_raw;
    const int tid = threadIdx.x;
    volatile LAS unsigned* misc = (volatile LAS unsigned*)(lds + LDS_MISC);
    if (tid < 4) misc[tid] = 0u;
    __syncthreads();
    XcdBarrier bar; bar.bar = (unsigned*)(a.ws + WS_BAR); bar.x = 0; bar.st = misc;
    const bool multi = (a.ph_hi - a.ph_lo) > 1;
    if (multi) bar = xcd_barrier_post((unsigned*)(a.ws + WS_BAR), misc);
    const int lo = a.ph_lo, hi = a.ph_hi;
#define vcu ((gridDim.x % 8 == 0) ? (int)((blockIdx.x % 8) * (gridDim.x / 8) + blockIdx.x / 8) : (int)blockIdx.x)
#ifdef ONLY_PHASE
#define IN(k) ((k) == ONLY_PHASE && lo <= (k) && (k) < hi)
#else
#define IN(k) (lo <= (k) && (k) < hi)
#endif
#define SEAM(k) do { if (IN(k) && IN((k) + 1)) xcd_barrier(bar); } while (0)

#ifndef REPEAT_PHASE
#define REPEAT_PHASE -1
#endif
#ifdef PROF_REP
#define RUNPH(k, ...) do { if (IN(k)) { const int nrep_ = (a.rep_k == (k)) ? 2 : 1; for (int rep_ = 0; rep_ < nrep_; ++rep_) { if (rep_) xcd_barrier(bar); __VA_ARGS__; } } } while (0)
#else
#define RUNPH(k, ...) do { if (IN(k)) { __VA_ARGS__; if (REPEAT_PHASE == (k)) { xcd_barrier(bar); __VA_ARGS__; } } } while (0)
#endif
    RUNPH(0, p0_mod_and_filter(a, lds));
    SEAM(0);
    RUNPH(1, p1_prep(a, lds));
    SEAM(1);
    RUNPH(2, { gm::SchedIn S{a.ws, (int)gridDim.x, vcu, a.in[I_BAF], a.in[I_BAB]}; gm::EpiIn E{a.ws}; gm::gemm_stream<false, 0, false>(lds, S, E);
        {
          const int G = (int)gridDim.x, rounds = (1812 + G - 1) / G, extra = 1812 - (rounds - 1) * G, v = vcu;
          if (v >= extra || extra == G) { const int nidle = (extra == G) ? G : G - extra, ridle = (extra == G) ? v : v - extra; __syncthreads();
              prep_items(a, (LAS float*)(lds + (tid >> 6) * 16384), PREP_NITEMS - PREP_DEFER, PREP_NITEMS, ridle * NWAVES + (tid >> 6), nidle * NWAVES, tid & 63); } } });
    SEAM(2);
    RUNPH(3, { for (int u = blockIdx.x; u < 16 * NCT; u += gridDim.x) gla::g1_unit(a, lds, u / NCT, u % NCT); });
    SEAM(3);
    RUNPH(4, { gla::g2_scan(a);
        hy::CvState cvs; cvs.jb.mi = -1; cvs.next = (int)blockIdx.x * NWAVES + (tid >> 6); cvs.stride = (int)gridDim.x * NWAVES; cvs.end = hy::CV_SPLIT;
        for (int c = blockIdx.x; c < HYW; c += gridDim.x) hy::channel(a, lds, c, a.ws + WS_HSPEC + (size_t)blockIdx.x * HSPEC_PER_WG, cvs);
        while (cvs.jb.mi >= 0 || cvs.next < cvs.end) hy::cv_step(a, cvs, tid & 63); });
    SEAM(4);
    RUNPH(5, { hy::CvState cvs; cvs.jb.mi = -1; cvs.stride = (int)gridDim.x * NWAVES; cvs.end = hy::CV_ITEMS;
        { const int w0_ = (int)blockIdx.x * NWAVES + (tid >> 6), half_ = hy::CV_SPLIT; cvs.next = half_ + ((w0_ - half_ % cvs.stride) % cvs.stride + cvs.stride) % cvs.stride; }
        { int u = blockIdx.x; gla::G3In cur, nxt;
            if (u < 16 * NCHUNK) { gla::g3_load(a, u >> 7, u & 127, cur);
                for (;;) { const int un = u + (int)gridDim.x; const bool hn = un < 16 * NCHUNK; if (hn) gla::g3_load(a, un >> 7, un & 127, nxt);
                    gla::g3_unit(a, lds, u >> 7, u & 127, cur, cvs); if (!hn) break; cur = nxt; u = un; } } }
        while (cvs.jb.mi >= 0 || cvs.next < cvs.end) hy::cv_step(a, cvs, tid & 63);
        const int wave = tid >> 6;
        for (int it = blockIdx.x * NWAVES + wave; it < 4096; it += gridDim.x * NWAVES) hy::transpose_item(a, it, tid & 63); });
    SEAM(5);
    RUNPH(6, { gm::SchedOut S{a.ws, (int)gridDim.x, vcu}; gm::EpiOut E{a.ws}; gm::gemm_stream<false, 0, false>(lds, S, E); });
    SEAM(6);
    RUNPH(7, rt::phase(a, lds));
    SEAM(7);
    if (IN(8) || IN(9)) {
        LAS int* tab = (LAS int*)(lds + gm::LDS_TAB);
        __syncthreads();
        if (tid == 0) { const unsigned* cnt = (const unsigned*)(a.ws + WS_CNT); int nrt = 0;
            for (int e = 0; e < NE; ++e) { const int n = (int)cnt[e]; tab[e] = n; const int nt = (n + 255) >> 8; for (int k = 0; k < nt; ++k) tab[64 + nrt + k] = e | (k << 8); nrt += nt; }
            tab[32] = nrt; }
        __syncthreads();
    }
    RUNPH(8, { gm::SchedMoe<1> S{a.ws, (const LAS int*)(lds + gm::LDS_TAB), (int)gridDim.x, vcu, a.in[I_EB2]}; gm::EpiMoe1 E{a.ws}; gm::gemm_stream<true, 2, true>(lds, S, E); });
    SEAM(8);
    RUNPH(9, { gm::SchedMoe<2> S{a.ws, (const LAS int*)(lds + gm::LDS_TAB), (int)gridDim.x, vcu, a.in[I_EB2]}; gm::EpiMoe2 E{a.ws}; gm::gemm_stream<false, 0, true>(lds, S, E); });
    SEAM(9);
    RUNPH(10, p_final(a, lds));
#undef RUNPH
#undef vcu
#undef IN
#undef SEAM
}

extern "C" void kernel_launch(void* const* d_in, const int* in_sizes, int n_in, void* d_out, int out_size, void* d_ws, size_t ws_size, hipStream_t stream) {
    static int grid = 0;
    if (grid == 0) {
        if (n_in != 32 || out_size != T * D || ws_size < WS_END) { fprintf(stderr, "kernel_launch: unexpected shapes (n_in %d out %d ws %zu need %zu)\n", n_in, out_size, ws_size, (size_t)WS_END); grid = -1; return; }
        int dev = 0, cus = 0;
        if (hipGetDevice(&dev) != hipSuccess || hipDeviceGetAttribute(&cus, hipDeviceAttributeMultiprocessorCount, dev) != hipSuccess) { grid = -1; return; }
        if (hipFuncSetAttribute((const void*)mega_fwd, hipFuncAttributeMaxDynamicSharedMemorySize, LDS_BYTES) != hipSuccess) { fprintf(stderr, "kernel_launch: hipFuncSetAttribute failed\n"); grid = -1; return; }
        int per_cu = 0;
        if (hipOccupancyMaxActiveBlocksPerMultiprocessor(&per_cu, (const void*)mega_fwd, NTHREADS, LDS_BYTES) != hipSuccess || per_cu < 1) fprintf(stderr, "kernel_launch: occupancy query says %d\n", per_cu);
        (void)hipGetLastError();
        grid = cus;
        if (grid > MAX_GRID) grid = MAX_GRID;
    }
    if (grid < 0) return;
    (void)hipMemsetAsync(d_ws, 0, WS_ZERO_BYTES, stream);
    Args a{};
    for (int i = 0; i < 32; ++i) a.in[i] = (const float*)d_in[i];
    a.out = (float*)d_out; a.ws = (unsigned char*)d_ws;
#ifdef DBG
    (void)hipMemsetAsync((char*)d_ws + WS_DBG, 0, 512, stream);
    for (int p = 0; p < N_PHASES; ++p) { a.ph_lo = p; a.ph_hi = p + 1; hipLaunchKernelGGL(mega_fwd, dim3(grid), dim3(NTHREADS), LDS_BYTES, stream, a);
        hipLaunchKernelGGL(dbg_check, dim3(64), dim3(512), 0, stream, a, p); }
    hipLaunchKernelGGL(dbg_encode, dim3(1024), dim3(256), 0, stream, a);
#elif N_LAUNCH_PER_PHASE
    for (int p = 0; p < N_PHASES; ++p) { a.ph_lo = p; a.ph_hi = p + 1; hipLaunchKernelGGL(mega_fwd, dim3(grid), dim3(NTHREADS), LDS_BYTES, stream, a); }
#else
    a.ph_lo = 0; a.ph_hi = N_PHASES;
#ifdef PROF_REP
    a.rep_k = PROF_REP;
#endif
    hipLaunchKernelGGL(mega_fwd, dim3(grid), dim3(NTHREADS), LDS_BYTES, stream, a);
#endif
}
```

```cpp
#include <hip/hip_runtime.h>
#include <cstdio>
#include <cstdint>
#include <cstddef>

#define LAS __attribute__((address_space(3)))
#define GAS __attribute__((address_space(1)))
typedef unsigned short bf16_t;
typedef short bf16x8 __attribute__((ext_vector_type(8)));
typedef float f32x4 __attribute__((ext_vector_type(4)));
typedef float f32x2 __attribute__((ext_vector_type(2)));
typedef unsigned u32x4 __attribute__((ext_vector_type(4)));
typedef unsigned u32x2 __attribute__((ext_vector_type(2)));

#ifndef N_LAUNCH_PER_PHASE
#define N_LAUNCH_PER_PHASE 0
#endif

constexpr int D = 1024, NB = 4, SEQ = 8192, T = NB * SEQ, CTXL = 256, TC = NB * CTXL, TT = T + TC;
constexpr int NH = 4, DK = 64, DV = 128, CH = 64, NCHUNK = SEQ / CH, NCC = CTXL / CH, NCT = NCHUNK + NCC;
constexpr int HYW = 512, HYC = 3 * HYW, INW = 3104;
constexpr int NE = 32, DE = 1024, CAP = T;
constexpr float LN_EPS = 1e-6f, ALPHA = 1.189207115002721f;
constexpr int NTHREADS = 512, NWAVES = 8;
constexpr int FFTN = 16384;

constexpr size_t al256(size_t x) { return (x + 255) & ~(size_t)255; }
constexpr size_t WS_BAR   = 0;
constexpr size_t WS_MOD   = 16384;
constexpr size_t WS_CNT   = WS_MOD + 5 * 6144 * 4;
constexpr size_t WS_ZERO_BYTES = al256(WS_CNT + 256);
constexpr size_t WS_LIST  = 262144;
constexpr size_t WS_PW    = WS_LIST + (size_t)NE * CAP * 4;
constexpr size_t WS_PLOC  = WS_PW + (size_t)T * 4 * 4;
constexpr size_t WS_B1R   = WS_PLOC + (size_t)T * 4 * 4;
constexpr size_t WS_HID2  = WS_B1R + (size_t)NE * 2048 * 4;
constexpr size_t WS_BTIN  = WS_HID2 + (size_t)SEQ * 64 * 4;
constexpr size_t WS_BTOUT = WS_BTIN + (size_t)3584 * 1024 * 2;
constexpr size_t WS_W1T   = WS_BTOUT + (size_t)1024 * 1024 * 2;
constexpr size_t WS_W2T   = WS_W1T + (size_t)NE * 2048 * 1024 * 2;
constexpr size_t WS_PRE1  = WS_W2T + (size_t)NE * 1024 * 1024 * 2;
constexpr size_t WS_RA    = WS_PRE1 + (size_t)T * 1024 * 4;
constexpr size_t WS_H     = WS_RA;
constexpr size_t WS_Q     = WS_H + (size_t)TT * 1024 * 2;
constexpr size_t WS_K     = WS_Q + (size_t)T * 256 * 2;
constexpr size_t WS_V     = WS_K + (size_t)TT * 256 * 2;
constexpr size_t WS_G     = WS_V + (size_t)TT * 512 * 2;
constexpr size_t WS_GF    = WS_G + (size_t)T * 512 * 2;
constexpr size_t WS_GB    = WS_GF + (size_t)TT * 256 * 4;
constexpr size_t WS_UT    = WS_GB + (size_t)TT * 256 * 4;
constexpr size_t WS_RA_END= WS_UT + (size_t)NB * HYC * SEQ * 2;
constexpr size_t WS_H2    = WS_RA;
constexpr size_t WS_FG    = WS_RA + (size_t)T * 1024 * 2;
constexpr size_t WS_SLOTS = WS_RA;
constexpr size_t SORTED_BYTES_ = (size_t)(T * 4 / 256 + NE) * 256 * 1024 * 2;
constexpr size_t WS_RB    = al256(WS_RA_END > WS_RA + SORTED_BYTES_ ? WS_RA_END : WS_RA + SORTED_BYTES_);
constexpr size_t WS_KV    = WS_RB;
constexpr size_t WS_AV    = WS_KV + (size_t)2 * 16 * NCT * 8192 * 2;
constexpr size_t WS_SP    = WS_AV + (size_t)2 * 16 * NCT * 64 * 4;
constexpr size_t WS_HSPEC = WS_SP + (size_t)2 * 16 * NCHUNK * 8192 * 2;
constexpr size_t HSPEC_PER_WG = (size_t)2 * FFTN * 8;
constexpr int MAX_GRID = 256;
constexpr size_t WS_YHYT  = WS_HSPEC + (size_t)MAX_GRID * HSPEC_PER_WG;
constexpr size_t WS_MIX   = WS_YHYT + (size_t)NB * HYW * SEQ * 2;
constexpr size_t WS_RB_END= WS_MIX + (size_t)T * 1024 * 2;
constexpr size_t WS_HF    = WS_MIX;
constexpr size_t WS_ACT   = WS_RB;
constexpr size_t SORTED_BYTES = (size_t)(T * 4 / 256 + NE) * 256 * 1024 * 2;
constexpr size_t WS_END   = al256(WS_RB_END > WS_RB + SORTED_BYTES ? WS_RB_END : WS_RB + SORTED_BYTES);

constexpr int LDS_BYTES = 147456;
constexpr int LDS_MISC  = 145408;

typedef __bf16 bf16n2 __attribute__((ext_vector_type(2)));
__device__ __forceinline__ unsigned pk2(float lo, float hi) { bf16n2 v = {(__bf16)lo, (__bf16)hi}; return __builtin_bit_cast(unsigned, v); }
__device__ __forceinline__ bf16_t f2bf(float f) { __bf16 b = (__bf16)f; return __builtin_bit_cast(unsigned short, b); }
__device__ __forceinline__ float bf2f(bf16_t b) { return __uint_as_float(((unsigned)b) << 16); }
__device__ __forceinline__ float bflo(unsigned w) { return __uint_as_float(w << 16); }
__device__ __forceinline__ float bfhi(unsigned w) { return __uint_as_float(w & 0xffff0000u); }
__device__ __forceinline__ float wave_sum(float v) {
#pragma unroll
    for (int o = 1; o < 64; o <<= 1) v += __shfl_xor(v, o);
    return v;
}
__device__ __forceinline__ float silu_f(float x) { return x * __builtin_amdgcn_rcpf(1.f + __expf(-x)); }
__device__ __forceinline__ float log_sigmoid_f(float z) { return fminf(z, 0.f) - __logf(1.f + __expf(-fabsf(z))); }

#define XB_TMO      128
#define XB_XCNT(j)  (256  + 64 * (j))
#define XB_XSUB(j)  (1280 + 64 * (j))
#define XB_XGEN(j)  (2304 + 64 * (j))
#define XB_TOP      3328
#define XB_TOPGEN   3392
#define XCD_BAR_WORDS 3456
#define XB_SPIN_CAP (1u << 22)
__device__ __forceinline__ unsigned xb_ld(unsigned* p)              { return __hip_atomic_load(p, __ATOMIC_RELAXED, __HIP_MEMORY_SCOPE_AGENT); }
__device__ __forceinline__ unsigned xb_add(unsigned* p, unsigned v) { return __hip_atomic_fetch_add(p, v, __ATOMIC_RELAXED, __HIP_MEMORY_SCOPE_AGENT); }
__device__ __forceinline__ unsigned xb_xcc_id() { return (unsigned)__builtin_amdgcn_s_getreg((3 << 11) | 20) & 0xFu; }
#define XB_SPIN(cond, bar) do { unsigned _sp = 0; while (cond) { __builtin_amdgcn_s_sleep(1); \
    if ((++_sp & 255u) == 0u) { if (xb_ld(&(bar)[XB_TMO])) break; if (_sp > XB_SPIN_CAP) { atomicAdd(&(bar)[XB_TMO], 1u); break; } } } } while (0)
struct XcdBarrier { unsigned* bar; unsigned x; volatile LAS unsigned* st; };
__device__ __forceinline__ XcdBarrier xcd_barrier_post(unsigned* bar, volatile LAS unsigned* st) {
    XcdBarrier b; b.bar = bar; b.x = xb_xcc_id(); b.st = st;
    if (threadIdx.x == 0) (void)xb_add(&bar[XB_XCNT(b.x)], 1u);
    return b;
}
__device__ __forceinline__ void xcd_barrier_complete(unsigned* bar, unsigned x, unsigned& nloc, unsigned& nx) {
    const unsigned G = gridDim.x * gridDim.y * gridDim.z;
    unsigned sum, cnt, mine, sp = 0u;
    for (;;) {
        sum = 0u; cnt = 0u; mine = 0u;
#pragma unroll
        for (unsigned j = 0; j < 16; ++j) { const unsigned c = xb_ld(&bar[XB_XCNT(j)]); sum += c; cnt += (c > 0u) ? 1u : 0u; mine = (j == x) ? c : mine; }
        if (sum == G) break;
        __builtin_amdgcn_s_sleep(1);
        if ((++sp & 255u) == 0u) { if (xb_ld(&bar[XB_TMO])) break; if (sp > XB_SPIN_CAP) { atomicAdd(&bar[XB_TMO], 1u); break; } }
    }
    nloc = mine > 0u ? mine : 1u; nx = cnt > 0u ? cnt : 1u;
}
__device__ __forceinline__ void xcd_barrier(const XcdBarrier& b) {
    asm volatile("s_waitcnt vmcnt(0)" ::: "memory");
    __syncthreads();
    if (threadIdx.x == 0) {
        unsigned* bar = b.bar;
        __builtin_amdgcn_s_waitcnt(0);
        unsigned nloc = b.st[0], nx = b.st[1];
        if (nloc == 0u) { xcd_barrier_complete(bar, b.x, nloc, nx); b.st[0] = nloc; b.st[1] = nx; }
        const unsigned old = xb_add(&bar[XB_XSUB(b.x)], 1u);
        const unsigned gen = old / nloc;
        if (old + 1u == (gen + 1u) * nloc) {
            __builtin_amdgcn_fence(__ATOMIC_RELEASE, "agent");
            asm volatile("s_waitcnt vmcnt(0)" ::: "memory");
            const unsigned og = xb_add(&bar[XB_TOP], 1u);
            const unsigned tg = og / nx;
            if (og + 1u == (tg + 1u) * nx) xb_add(&bar[XB_TOPGEN], 1u);
            else XB_SPIN(xb_ld(&bar[XB_TOPGEN]) == tg, bar);
            __builtin_amdgcn_fence(__ATOMIC_ACQUIRE, "agent");
            xb_add(&bar[XB_XGEN(b.x)], 1u);
            asm volatile("s_waitcnt vmcnt(0)" ::: "memory");
        } else {
            XB_SPIN(xb_ld(&bar[XB_XGEN(b.x)]) == gen, bar);
            __builtin_amdgcn_fence(__ATOMIC_ACQUIRE, "agent");
            asm volatile("s_waitcnt vmcnt(0)" ::: "memory");
        }
    }
    __syncthreads();
}

struct Args {
    const float* in[32];
    float* out;
    unsigned char* ws;
    int ph_lo, ph_hi;
    int rep_k, pad_;
};
enum { I_X = 0, I_C, I_CTX, I_CCTX, I_ADAW, I_ADAB, I_WIN, I_WAF, I_BAF, I_WAB, I_BAB, I_NORMG, I_CONVW, I_CONVB, I_FW1, I_FB1, I_FW2, I_FB2, I_FWOUT, I_FFREQ,
       I_BIASD, I_WOUT, I_LN1G, I_LN1B, I_RW, I_RB, I_EW1, I_EB1, I_EW2, I_EB2, I_LN2G, I_LN2B };


namespace gm {
constexpr int BM = 256, BK = 64, HALF = 128, HTB = HALF * BK * 2, STAGE_BYTES = 8 * HTB, KD = 1024, NT = KD / BK;
constexpr int ROWB = KD * 2;
typedef int i32x8 __attribute__((ext_vector_type(8)));
__device__ __forceinline__ int gray2(int q) { return q ^ (q >> 1); }
__device__ __forceinline__ int lds_off8(int r, int fq) { const int rr = r & 15; return ((r >> 4) * 2 + (fq >> 1)) * 1024 + rr * 64 + 16 * ((2 * (fq & 1)) ^ gray2(rr >> 2)); }
__device__ __forceinline__ void stage_rc8(int b, int& R, int& C) { const int st = b / 1024, sb = b % 1024, swz = sb ^ (gray2((sb >> 8) & 3) << 4); R = (st >> 1) * 16 + swz / 64; C = (st & 1) * 32 + (swz % 64) / 2; }
__device__ __forceinline__ int lds_byte(int r, int c) { const int st = (r >> 4) * 2 + (c >> 5), rr = r & 15, cc = c & 31, ob = rr * 64 + cc * 2; return st * 1024 + (ob ^ (((ob >> 9) & 1) << 5)); }
__device__ __forceinline__ void stage_rc(int b, int& R, int& C) { const int st = b / 1024, sb = b % 1024, swz = sb ^ (((sb >> 9) & 1) << 5); R = (st >> 1) * 16 + swz / 64; C = (st & 1) * 32 + (swz % 64) / 2; }
__device__ __forceinline__ int perm32(int rho) { const int n = rho >> 4, i = rho & 15; return 8 * (i >> 2) + 4 * n + (i & 3); }

constexpr int LDS_BIAS = STAGE_BYTES + 4096;
struct Unit {
    const char* A;
    const char* B;
    const int* list;
    int type, row0, col0, valid, aux;
};

__device__ __forceinline__ i32x8 cat8(bf16x8 lo, bf16x8 hi) { typedef int i32x4 __attribute__((ext_vector_type(4))); const i32x4 a = __builtin_bit_cast(i32x4, lo), b = __builtin_bit_cast(i32x4, hi); return (i32x8){a[0], a[1], a[2], a[3], b[0], b[1], b[2], b[3]}; }
template <bool GATHER, int GSHIFT, int RB, bool FP8>
__device__ __forceinline__ void a_offsets(const Unit& u, unsigned (&o)[2][2]) {
    int R[2], Cb[2];
    int tz = threadIdx.x; asm volatile("" : "+v"(tz));
#pragma unroll
    for (int i = 0; i < 2; ++i) { int r, c; if (FP8) stage_rc8(tz * 16 + i * 8192, r, c); else stage_rc(tz * 16 + i * 8192, r, c); R[i] = r; Cb[i] = c * 2; }
#pragma unroll
    for (int h = 0; h < 2; ++h)
#pragma unroll
        for (int i = 0; i < 2; ++i) {
            const int r = h * HALF + R[i];
            if (!GATHER) o[h][i] = (unsigned)(r * RB + Cb[i]);
            else { const int idx = u.list[r < u.valid ? r : 0]; o[h][i] = (unsigned)(idx >> GSHIFT) * (unsigned)RB + (unsigned)Cb[i]; }
        }
}

template <bool GATHER, int GSHIFT, bool FP8, class Sched, class Epi>
__device__ __forceinline__ void gemm_stream(LAS unsigned char* lds, const Sched& S, const Epi& E) {
    constexpr int RB = FP8 ? KD : ROWB, NTL = FP8 ? NT / 2 : NT;
    const int tid = threadIdx.x, wid = __builtin_amdgcn_readfirstlane(tid >> 6), lane = tid & 63, wr = wid >> 2, wc = wid & 3, fr = lane & 15, fq = lane >> 4;
    unsigned voffB[2], voffA[2];
#pragma unroll
    for (int i = 0; i < 2; ++i) { int r, c; if (FP8) stage_rc8(tid * 16 + i * 8192, r, c); else stage_rc(tid * 16 + i * 8192, r, c); const int rb = (r & ~31) + perm32(r & 31); voffB[i] = (unsigned)(rb * RB + c * 2); voffA[i] = (unsigned)(r * RB + c * 2); }
    const size_t kstep = (size_t)(BK * 2), hstep = (size_t)HALF * RB;
    const unsigned ldsw = (unsigned)wid * 1024u;
    const int aoff = FP8 ? lds_off8(wr * 64 + fr, fq) : lds_byte(wr * 64 + fr, fq * 8), boff = FP8 ? lds_off8(wc * 32 + fr, fq) : lds_byte(wc * 32 + fr, fq * 8);
    const int aoffh = aoff ^ 16, boffh = boff ^ 16;
#define GM_SA(b, h) (((b) * 2 + (h)) * HTB)
#define GM_SB(b, h) ((4 + (b) * 2 + (h)) * HTB)
#define GM_STAGE(bufoff, gbase, vo0, vo1) do { \
        __builtin_amdgcn_global_load_lds((const unsigned*)((const char*)(gbase) + (vo0)), (LAS unsigned*)(lds + (bufoff) + ldsw), 16, 0, 0); \
        __builtin_amdgcn_global_load_lds((const unsigned*)((const char*)(gbase) + (vo1)), (LAS unsigned*)(lds + (bufoff) + ldsw + 8192), 16, 0, 0); } while (0)
#define GM_STAGE_A(bufoff, gbase, h, o0, o1) do { if constexpr (GATHER) GM_STAGE(bufoff, gbase, o0, o1); else GM_STAGE(bufoff, (gbase) + (h) * hstep, voffA[0], voffA[1]); } while (0)
#define GM_LD32(p, ol, oh) ({ const i32x4 lo_ = *(const LAS i32x4*)((p) + (ol)), hi_ = *(const LAS i32x4*)((p) + (oh)); (i32x8){lo_[0], lo_[1], lo_[2], lo_[3], hi_[0], hi_[1], hi_[2], hi_[3]}; })
#define GM_LDA(dst, b, h) do { if constexpr (FP8) { _Pragma("unroll") for (int m = 0; m < 4; ++m) dst##8[m] = GM_LD32(lds + GM_SA(b, h) + m * 2048, aoff, aoffh); } \
        else { _Pragma("unroll") for (int m = 0; m < 4; ++m) _Pragma("unroll") for (int k = 0; k < 2; ++k) dst[m][k] = *(const LAS bf16x8*)(lds + GM_SA(b, h) + aoff + m * 2048 + k * 1024); } } while (0)
#define GM_LDB(dst, b, h) do { if constexpr (FP8) { _Pragma("unroll") for (int n = 0; n < 2; ++n) dst##8[n] = GM_LD32(lds + GM_SB(b, h) + n * 2048, boff, boffh); } \
        else { _Pragma("unroll") for (int n = 0; n < 2; ++n) _Pragma("unroll") for (int k = 0; k < 2; ++k) dst[n][k] = *(const LAS bf16x8*)(lds + GM_SB(b, h) + boff + n * 2048 + k * 1024); } } while (0)
#define GM_MMA(ai, bj, At, Bt) do { __builtin_amdgcn_s_setprio(1); _Pragma("unroll") for (int m = 0; m < 4; ++m) _Pragma("unroll") for (int n = 0; n < 2; ++n) { \
        if constexpr (FP8) asm volatile("v_mfma_scale_f32_16x16x128_f8f6f4 %0, %1, %2, %0, %3, %3 op_sel_hi:[0,0,0]" : "+v"(acc[ai][bj][m][n]) : "v"(Bt##8[n]), "v"(At##8[m]), "v"(sc1_)); \
        else { _Pragma("unroll") for (int k = 0; k < 2; ++k) acc[ai][bj][m][n] = __builtin_amdgcn_mfma_f32_16x16x32_bf16(Bt[n][k], At[m][k], acc[ai][bj][m][n], 0, 0, 0); } } \
        __builtin_amdgcn_s_setprio(0); } while (0)
#define GM_WAIT_V(n) asm volatile("s_waitcnt vmcnt(" #n ")" ::: "memory")
#define GM_WAIT_L(n) asm volatile("s_waitcnt lgkmcnt(" #n ")" ::: "memory")
#define GM_BAR __builtin_amdgcn_s_barrier()
#define GM_SCHED __builtin_amdgcn_sched_barrier(0)
    Unit cur, nxt; int ui = 0;
    if (!S.next(0, cur)) return;
    f32x4 acc[2][2][4][2];
#pragma unroll
    for (int a = 0; a < 2; ++a)
#pragma unroll
        for (int b = 0; b < 2; ++b)
#pragma unroll
            for (int m = 0; m < 4; ++m)
#pragma unroll
                for (int n = 0; n < 2; ++n) acc[a][b][m][n] = (f32x4){0.f, 0.f, 0.f, 0.f};
    typedef int i32x4 __attribute__((ext_vector_type(4)));
    int sc1_ = 0x7f7f7f7f; asm volatile("" : "+v"(sc1_));
    bf16x8 At[4][2], B0[2][2], B1[2][2];
    i32x8 At8[4], B08[2], B18[2];
    unsigned ca[2][2], na[2][2];
    if constexpr (GATHER) a_offsets<GATHER, GSHIFT, RB, FP8>(cur, ca);
    const char* cA = cur.A; const char* cB = cur.B;
    GM_STAGE(GM_SB(0, 0), cB, voffB[0], voffB[1]); GM_STAGE_A(GM_SA(0, 0), cA, 0, ca[0][0], ca[0][1]); GM_STAGE(GM_SB(0, 1), cB + hstep, voffB[0], voffB[1]); GM_STAGE_A(GM_SA(0, 1), cA, 1, ca[1][0], ca[1][1]);
    if (wr == 1) GM_BAR;
    GM_WAIT_V(4); GM_BAR;
    GM_STAGE(GM_SB(1, 0), cB + kstep, voffB[0], voffB[1]); GM_STAGE_A(GM_SA(1, 0), cA + kstep, 0, ca[0][0], ca[0][1]); GM_STAGE(GM_SB(1, 1), cB + hstep + kstep, voffB[0], voffB[1]);
    GM_WAIT_V(6); GM_BAR;
    for (;;) {
        const bool has_next = S.next(ui + 1, nxt);
        if constexpr (GATHER) {
            if (has_next) a_offsets<GATHER, GSHIFT, RB, FP8>(nxt, na);
            else {
#pragma unroll
                for (int h = 0; h < 2; ++h)
#pragma unroll
                    for (int i = 0; i < 2; ++i) na[h][i] = ca[h][i];
            }
        }
        const char* nA = has_next ? nxt.A : cA; const char* nB = has_next ? nxt.B : cB;
        if (wid == 0)
            __builtin_amdgcn_global_load_lds((const unsigned*)(S.bias(cur) + 4 * lane), (LAS unsigned*)(lds + LDS_BIAS + (ui & 1) * 1024), 16, 0, 0);
        for (int t = 0; t < NTL; t += 2) {
            const bool last = (t == NTL - 2);

            const char* a1 = cA + (size_t)(t + 1) * kstep;
            const char* a2 = last ? nA : cA + (size_t)(t + 2) * kstep; const char* b2 = last ? nB : cB + (size_t)(t + 2) * kstep;
            const char* a3 = a2 + kstep; const char* b3 = b2 + kstep;
            unsigned x00 = 0, x01 = 0, x10 = 0, x11 = 0;
            if constexpr (GATHER) { x00 = last ? na[0][0] : ca[0][0]; x01 = last ? na[0][1] : ca[0][1]; x10 = last ? na[1][0] : ca[1][0]; x11 = last ? na[1][1] : ca[1][1]; }
            GM_LDB(B0, 0, 0); GM_SCHED; GM_LDA(At, 0, 0); GM_STAGE_A(GM_SA(1, 1), a1, 1, ca[1][0], ca[1][1]);
            GM_WAIT_L(8); GM_BAR; GM_WAIT_L(0); GM_MMA(0, 0, At, B0); GM_BAR; GM_SCHED;
            GM_LDB(B1, 0, 1); GM_STAGE(GM_SB(0, 0), b2, voffB[0], voffB[1]);
            GM_BAR; GM_WAIT_L(0); GM_MMA(0, 1, At, B1); GM_BAR;
            GM_LDA(At, 0, 1); GM_STAGE_A(GM_SA(0, 0), a2, 0, x00, x01);
            GM_BAR; GM_WAIT_L(0); GM_MMA(1, 0, At, B0); GM_BAR; GM_SCHED;
            GM_STAGE(GM_SB(0, 1), b2 + hstep, voffB[0], voffB[1]);
            GM_WAIT_V(6); GM_BAR; GM_MMA(1, 1, At, B1); GM_BAR;
            GM_LDB(B0, 1, 0); GM_SCHED; GM_LDA(At, 1, 0); GM_STAGE_A(GM_SA(0, 1), a2, 1, x10, x11);
            GM_WAIT_L(8); GM_BAR; GM_WAIT_L(0); GM_MMA(0, 0, At, B0); GM_BAR; GM_SCHED;
            GM_LDB(B1, 1, 1); GM_STAGE(GM_SB(1, 0), b3, voffB[0], voffB[1]);
            GM_BAR; GM_WAIT_L(0); GM_MMA(0, 1, At, B1); GM_BAR;
            GM_LDA(At, 1, 1); GM_STAGE_A(GM_SA(1, 0), a3, 0, x00, x01);
            GM_BAR; GM_WAIT_L(0); GM_MMA(1, 0, At, B0); GM_BAR; GM_SCHED;
            GM_STAGE(GM_SB(1, 1), b3 + hstep, voffB[0], voffB[1]);
            GM_WAIT_V(6); GM_BAR; GM_MMA(1, 1, At, B1); GM_BAR;
        }
        if constexpr (FP8) asm volatile("s_nop 7\n\ts_nop 7" ::: "memory");
        {
          int tz = threadIdx.x; asm volatile("" : "+v"(tz)); const int wz = tz >> 6, lz = tz & 63;
          E(acc, cur, wz >> 2, wz & 3, lz & 15, lz >> 4, (const LAS float*)(lds + LDS_BIAS + (ui & 1) * 1024)); }
        if (!has_next) break;
#pragma unroll
        for (int a = 0; a < 2; ++a)
#pragma unroll
            for (int b = 0; b < 2; ++b)
#pragma unroll
                for (int m = 0; m < 4; ++m)
#pragma unroll
                    for (int n = 0; n < 2; ++n) acc[a][b][m][n] = (f32x4){0.f, 0.f, 0.f, 0.f};
        cur = nxt; cA = nA; cB = nB; ++ui;
        if constexpr (GATHER) {
#pragma unroll
            for (int h = 0; h < 2; ++h)
#pragma unroll
                for (int i = 0; i < 2; ++i) ca[h][i] = na[h][i];
        }
    }
    GM_WAIT_V(0);
    if (wr == 0) GM_BAR;
    GM_BAR;
#undef GM_SA
#undef GM_SB
#undef GM_STAGE
#undef GM_STAGE_A
#undef GM_LD32
#undef GM_LDA
#undef GM_LDB
#undef GM_MMA
#undef GM_WAIT_V
#undef GM_WAIT_L
#undef GM_BAR
#undef GM_SCHED
}

__device__ __forceinline__ u32x4 pack8(f32x4 a, f32x4 b) { u32x4 w; w.x = pk2(a[0], a[1]); w.y = pk2(a[2], a[3]); w.z = pk2(b[0], b[1]); w.w = pk2(b[2], b[3]); return w; }

struct SchedIn {
    unsigned char* ws; int G, c; const float* baf; const float* bab;
    __device__ __forceinline__ bool next(int i, Unit& u) const {
        int L = i * G + c;
        u.list = nullptr; u.valid = 256; u.aux = 0;
        if (L < 768) {
            const int pa = L % 6, pb = L / 6;
            u.A = (const char*)(ws + WS_BTIN) + (size_t)(2048 + 256 * pa) * ROWB; u.B = (const char*)(ws + WS_H) + (size_t)(256 * pb) * ROWB;
            u.type = 2; u.row0 = 256 * pa; u.col0 = 256 * pb; return true;
        }
        L -= 768;
        if (L < 1024) {
            const int pm = L >> 3, pn = ((L & 7) + (L >> 8)) & 7;
            u.A = (const char*)(ws + WS_H) + (size_t)(256 * pm) * ROWB; u.B = (const char*)(ws + WS_BTIN) + (size_t)(256 * pn) * ROWB;
            u.type = pn < 6 ? 0 : 1; u.row0 = 256 * pm; u.col0 = pn; return true;
        }
        L -= 1024;
        if (L < 20) {
            const int pm = L / 5, j = L % 5, pn = j == 0 ? 1 : (j == 1 ? 2 : (j == 2 ? 3 : (j == 3 ? 6 : 7)));
            u.A = (const char*)(ws + WS_H) + (size_t)(T + 256 * pm) * ROWB; u.B = (const char*)(ws + WS_BTIN) + (size_t)(256 * pn) * ROWB;
            u.type = pn < 6 ? 0 : 1; u.row0 = T + 256 * pm; u.col0 = pn; return true;
        }
        return false;
    }
    __device__ __forceinline__ const float* bias(const Unit& u) const { return (u.type == 1 && u.col0 == 7) ? bab : baf; }
};
struct EpiIn {
    unsigned char* ws;
    __device__ __forceinline__ void operator()(const f32x4 (&acc)[2][2][4][2], const Unit& u, int wr, int wc, int fr, int fq, const LAS float* bs) const {
        const int rl = wr * 64 + fr, cl = wc * 32 + 8 * fq;
        if (u.type == 0) {
            const int pn = u.col0;
            bf16_t* dst; int ld, cb;
            if (pn == 0) { dst = (bf16_t*)(ws + WS_Q); ld = 256; cb = 0; }
            else if (pn == 1) { dst = (bf16_t*)(ws + WS_K); ld = 256; cb = 0; }
            else if (pn < 4) { dst = (bf16_t*)(ws + WS_V); ld = 512; cb = (pn - 2) * 256; }
            else { dst = (bf16_t*)(ws + WS_G); ld = 512; cb = (pn - 4) * 256; }
#pragma unroll
            for (int ai = 0; ai < 2; ++ai)
#pragma unroll
                for (int m = 0; m < 4; ++m) { bf16_t* rowp = dst + (size_t)(u.row0 + rl + ai * 128 + m * 16) * ld + cb + cl;
#pragma unroll
                    for (int bj = 0; bj < 2; ++bj) *(u32x4*)(rowp + bj * 128) = pack8(acc[ai][bj][m][0], acc[ai][bj][m][1]); }
        } else if (u.type == 1) {
            _Float16* dst = (_Float16*)(ws + (u.col0 == 6 ? WS_GF : WS_GB));
            f32x4 bv[2][2];
#pragma unroll
            for (int bj = 0; bj < 2; ++bj)
#pragma unroll
                for (int n = 0; n < 2; ++n) bv[bj][n] = *(const LAS f32x4*)(bs + cl + bj * 128 + 4 * n);
            typedef _Float16 f16x8_ __attribute__((ext_vector_type(8)));
#pragma unroll
            for (int ai = 0; ai < 2; ++ai)
#pragma unroll
                for (int m = 0; m < 4; ++m) { _Float16* rowp = dst + (size_t)(u.row0 + rl + ai * 128 + m * 16) * 256 + cl;
#pragma unroll
                    for (int bj = 0; bj < 2; ++bj) { f16x8_ o;
#pragma unroll
                        for (int n = 0; n < 2; ++n) { const f32x4 z = acc[ai][bj][m][n] + bv[bj][n];
#pragma unroll
                            for (int j = 0; j < 4; ++j) o[4 * n + j] = (_Float16)(log_sigmoid_f(z[j]) * (1.f / 16.f)); }
                        *(f16x8_*)(rowp + bj * 128) = o; } }
        } else {
            const int b = u.col0 >> 13, l0 = u.col0 & 8191;
            bf16_t* dst = (bf16_t*)(ws + WS_UT) + ((size_t)b * HYC) * SEQ + l0 + cl;
#pragma unroll
            for (int ai = 0; ai < 2; ++ai)
#pragma unroll
                for (int m = 0; m < 4; ++m) { bf16_t* rowp = dst + (size_t)(u.row0 + rl + ai * 128 + m * 16) * SEQ;
#pragma unroll
                    for (int bj = 0; bj < 2; ++bj) *(u32x4*)(rowp + bj * 128) = pack8(acc[ai][bj][m][0], acc[ai][bj][m][1]); }
        }
    }
};

struct SchedOut {
    unsigned char* ws; int G, c;
    __device__ __forceinline__ bool next(int i, Unit& u) const {
        const int L = i * G + c; if (L >= 512) return false;
        const int pm = L >> 2, pn = L & 3;
        u.A = (const char*)(ws + WS_MIX) + (size_t)(256 * pm) * ROWB; u.B = (const char*)(ws + WS_BTOUT) + (size_t)(256 * pn) * ROWB;
        u.list = nullptr; u.valid = 256; u.aux = 0; u.type = 3; u.row0 = 256 * pm; u.col0 = 256 * pn; return true;
    }
    __device__ __forceinline__ const float* bias(const Unit& u) const { return (const float*)(ws + WS_MOD) + (u.row0 >> 13) * 6144 + 2 * 1024 + u.col0; }
};
struct EpiOut {
    unsigned char* ws;
    __device__ __forceinline__ void operator()(const f32x4 (&acc)[2][2][4][2], const Unit& u, int wr, int wc, int fr, int fq, const LAS float* bs) const {
        const int rl = wr * 64 + fr, cl = u.col0 + wc * 32 + 8 * fq;
        bf16_t* fg = (bf16_t*)(ws + WS_FG);
        f32x4 gv[2][2];
#pragma unroll
        for (int bj = 0; bj < 2; ++bj)
#pragma unroll
            for (int n = 0; n < 2; ++n) gv[bj][n] = *(const LAS f32x4*)(bs + wc * 32 + 8 * fq + bj * 128 + 4 * n);
#pragma unroll
        for (int ai = 0; ai < 2; ++ai)
#pragma unroll
            for (int m = 0; m < 4; ++m) { bf16_t* rowp = fg + (size_t)(u.row0 + rl + ai * 128 + m * 16) * 1024 + cl;
#pragma unroll
                for (int bj = 0; bj < 2; ++bj) *(u32x4*)(rowp + bj * 128) = pack8(gv[bj][0] * acc[ai][bj][m][0], gv[bj][1] * acc[ai][bj][m][1]); }
    }
};

constexpr int LDS_TAB = STAGE_BYTES;
template <int WHICH>
struct SchedMoe {
    unsigned char* ws; const LAS int* tab; int G, c; const float* b2;
    __device__ __forceinline__ bool next(int i, Unit& u) const {
        constexpr int NCT_ = WHICH == 1 ? 8 : 4;
        const int L = i * G + c; const int nrt = __builtin_amdgcn_readfirstlane(tab[32]);
        if (L >= nrt * NCT_) return false;
        const int rt = L / NCT_, ct = L % NCT_;
        const int info = __builtin_amdgcn_readfirstlane(tab[64 + rt]), e = info & 255, r0 = (info >> 8) * 256;
        const int cnt = __builtin_amdgcn_readfirstlane(tab[e]);
        u.valid = (cnt - r0) < 256 ? (cnt - r0) : 256;
        u.list = (const int*)(ws + WS_LIST) + (size_t)e * CAP + r0;
        u.A = (WHICH == 1) ? (const char*)(ws + WS_H2) : (const char*)(ws + WS_ACT) + (size_t)(256 * rt) * KD;
        u.B = (const char*)(ws + (WHICH == 1 ? WS_W1T : WS_W2T)) + ((size_t)e * (WHICH == 1 ? 2048 : 1024) + 256 * ct) * KD;
        u.type = 3 + WHICH; u.row0 = 256 * rt; u.col0 = ct; u.aux = e; return true;
    }
    __device__ __forceinline__ const float* bias(const Unit& u) const { return (WHICH == 1) ? (const float*)(ws + WS_B1R) + (size_t)u.aux * 2048 + 256 * u.col0 : b2 + (size_t)u.aux * 1024 + 256 * u.col0; }
};
__device__ __forceinline__ float swiglu_f(float glu, float lin) {
    glu = fminf(glu, 7.f); lin = fminf(fmaxf(lin, -7.f), 7.f);
    return glu * __builtin_amdgcn_rcpf(1.f + __expf(-1.702f * glu)) * (lin + 1.f);
}
constexpr float S_H2 = 4.f, S_ACT = 8.f, S_W = 64.f;
__device__ __forceinline__ f32x2 swiglu2(f32x2 ag, f32x2 al, f32x2 bg, f32x2 bl) {
    f32x2 g = ag * (1.f / (S_H2 * S_W)) + bg, l = al * (1.f / (S_H2 * S_W)) + bl;
    g[0] = fminf(g[0], 7.f); g[1] = fminf(g[1], 7.f);
    l[0] = __builtin_amdgcn_fmed3f(l[0], -7.f, 7.f); l[1] = __builtin_amdgcn_fmed3f(l[1], -7.f, 7.f);
    const f32x2 t = g * (-1.702f * 1.4426950408889634f);
    const f32x2 d = (f32x2){__builtin_amdgcn_exp2f(t[0]), __builtin_amdgcn_exp2f(t[1])} + 1.f;
    const f32x2 r = {__builtin_amdgcn_rcpf(d[0]), __builtin_amdgcn_rcpf(d[1])};
    return (g * r) * (l * S_ACT + S_ACT);
}
__device__ __forceinline__ unsigned pk4_fp8(float a, float b, float c, float d) {
    a = fminf(fmaxf(a, -448.f), 448.f); b = fminf(fmaxf(b, -448.f), 448.f); c = fminf(fmaxf(c, -448.f), 448.f); d = fminf(fmaxf(d, -448.f), 448.f);
    int p = __builtin_amdgcn_cvt_pk_fp8_f32(a, b, 0, false); p = __builtin_amdgcn_cvt_pk_fp8_f32(c, d, p, true); return (unsigned)p; }
__device__ __forceinline__ unsigned pk4_fp8_nc(float a, float b, float c, float d) { int p = __builtin_amdgcn_cvt_pk_fp8_f32(a, b, 0, false); p = __builtin_amdgcn_cvt_pk_fp8_f32(c, d, p, true); return (unsigned)p; }
struct EpiMoe1 {
    unsigned char* ws;
    __device__ __forceinline__ void operator()(const f32x4 (&acc)[2][2][4][2], const Unit& u, int wr, int wc, int fr, int fq, const LAS float* bs) const {
        const int rl = wr * 64 + fr, cl = wc * 32 + 8 * fq, ct = u.col0;
        const LAS float* b1 = bs + cl;
        unsigned char* act = (unsigned char*)(ws + WS_ACT) + (size_t)u.row0 * 1024 + 128 * ct + cl;
        f32x4 bg[2], bl[2];
#pragma unroll
        for (int n = 0; n < 2; ++n) { bg[n] = *(const LAS f32x4*)(b1 + 4 * n); bl[n] = *(const LAS f32x4*)(b1 + 128 + 4 * n); }
#pragma unroll
        for (int ai = 0; ai < 2; ++ai)
#pragma unroll
            for (int mp = 0; mp < 2; ++mp) {
                u32x2 w[2];
#pragma unroll
                for (int mm = 0; mm < 2; ++mm) { const int m = 2 * mp + mm;
#pragma unroll
                    for (int n = 0; n < 2; ++n) { int p = 0;
#pragma unroll
                        for (int hh = 0; hh < 2; ++hh) {
                            const f32x2 o = swiglu2((f32x2){acc[ai][0][m][n][2 * hh], acc[ai][0][m][n][2 * hh + 1]}, (f32x2){acc[ai][1][m][n][2 * hh], acc[ai][1][m][n][2 * hh + 1]},
                                                    (f32x2){bg[n][2 * hh], bg[n][2 * hh + 1]}, (f32x2){bl[n][2 * hh], bl[n][2 * hh + 1]});
                            p = hh ? __builtin_amdgcn_cvt_pk_fp8_f32(o[0], o[1], p, true) : __builtin_amdgcn_cvt_pk_fp8_f32(o[0], o[1], p, false); }
                        if (n == 0) w[mm].x = (unsigned)p; else w[mm].y = (unsigned)p; } }
                const auto sx = __builtin_amdgcn_permlane16_swap(w[0].x, w[1].x, false, false); const auto sy = __builtin_amdgcn_permlane16_swap(w[0].y, w[1].y, false, false);
                const int r = rl + ai * 128 + (2 * mp + (fq & 1)) * 16;
                *(u32x4*)(act + (size_t)r * 1024 - 8 * (fq & 1)) = (u32x4){sx[0], sy[0], sx[1], sy[1]}; }
    }
};
constexpr float S_SL = 16.f;
struct EpiMoe2 {
    unsigned char* ws;
    __device__ __forceinline__ void operator()(const f32x4 (&acc)[2][2][4][2], const Unit& u, int wr, int wc, int fr, int fq, const LAS float* bs) const {
        const int rl = wr * 64 + fr, cl = wc * 32 + 8 * fq, ct = u.col0;
        const LAS float* bb = bs + cl;
        unsigned char* slots = (unsigned char*)(ws + WS_SLOTS) + (size_t)u.row0 * 1024 + 256 * ct + cl;
        f32x4 bv[2][2];
#pragma unroll
        for (int bj = 0; bj < 2; ++bj)
#pragma unroll
            for (int n = 0; n < 2; ++n) bv[bj][n] = *(const LAS f32x4*)(bb + bj * 128 + 4 * n) * S_SL;
#pragma unroll
        for (int ai = 0; ai < 2; ++ai)
#pragma unroll
            for (int m = 0; m < 4; ++m) { const int r = rl + ai * 128 + m * 16;
                u32x2 w[2];
#pragma unroll
                for (int bj = 0; bj < 2; ++bj) {
#pragma unroll
                    for (int n = 0; n < 2; ++n) { int p = 0;
#pragma unroll
                        for (int hh = 0; hh < 2; ++hh) { f32x2 y = (f32x2){acc[ai][bj][m][n][2 * hh], acc[ai][bj][m][n][2 * hh + 1]} * (S_SL / (S_ACT * S_W)) + (f32x2){bv[bj][n][2 * hh], bv[bj][n][2 * hh + 1]};
                            y[0] = __builtin_amdgcn_fmed3f(y[0], -448.f, 448.f); y[1] = __builtin_amdgcn_fmed3f(y[1], -448.f, 448.f);
                            p = hh ? __builtin_amdgcn_cvt_pk_fp8_f32(y[0], y[1], p, true) : __builtin_amdgcn_cvt_pk_fp8_f32(y[0], y[1], p, false); }
                        if (n == 0) w[bj].x = (unsigned)p; else w[bj].y = (unsigned)p; } }
                const auto sx = __builtin_amdgcn_permlane16_swap(w[0].x, w[1].x, false, false); const auto sy = __builtin_amdgcn_permlane16_swap(w[0].y, w[1].y, false, false);
                *(u32x4*)(slots + (size_t)r * 1024 + ((fq & 1) ? 128 - 8 : 0)) = (u32x4){sx[0], sy[0], sx[1], sy[1]}; }
    }
};
}

namespace hy {
__device__ __forceinline__ int phys(int n) { return n + (n >> 4) + ((n >> 9) << 4); }
constexpr int XSIZE = 16384 + 1024 + 512;

__device__ __forceinline__ float tw_c(int i) {
    constexpr float t[16] = {1.f, 0.98078528040323043f, 0.92387953251128674f, 0.83146961230254524f, 0.70710678118654752f, 0.55557023301960218f, 0.38268343236508977f, 0.19509032201612825f,
                             0.f, -0.19509032201612825f, -0.38268343236508977f, -0.55557023301960218f, -0.70710678118654752f, -0.83146961230254524f, -0.92387953251128674f, -0.98078528040323043f};
    return t[i];
}
__device__ __forceinline__ float tw_s(int i) {
    constexpr float t[16] = {0.f, 0.19509032201612825f, 0.38268343236508977f, 0.55557023301960218f, 0.70710678118654752f, 0.83146961230254524f, 0.92387953251128674f, 0.98078528040323043f,
                             1.f, 0.98078528040323043f, 0.92387953251128674f, 0.83146961230254524f, 0.70710678118654752f, 0.55557023301960218f, 0.38268343236508977f, 0.19509032201612825f};
    return t[i];
}
__host__ __device__ constexpr int brev(int p, int bits) { int r = 0; for (int i = 0; i < bits; ++i) r |= ((p >> i) & 1) << (bits - 1 - i); return r; }

__device__ __forceinline__ f32x2 cmul(f32x2 a, f32x2 w) { f32x2 r;
    asm("v_pk_mul_f32 %0, %1, %2 op_sel_hi:[1,0]\n\tv_pk_fma_f32 %0, %1, %2, %0 op_sel:[1,1,0] op_sel_hi:[0,1,1] neg_lo:[0,1,0]" : "=&v"(r) : "v"(a), "v"(w)); return r; }
__device__ __forceinline__ void cmul_chain(f32x2 a, f32x2 w, f32x2 w1, f32x2& o, f32x2& wn) {
    asm("v_pk_mul_f32 %0, %2, %3 op_sel_hi:[1,0]\n\tv_pk_mul_f32 %1, %3, %4 op_sel_hi:[1,0]\n\t"
        "v_pk_fma_f32 %0, %2, %3, %0 op_sel:[1,1,0] op_sel_hi:[0,1,1] neg_lo:[0,1,0]\n\tv_pk_fma_f32 %1, %3, %4, %1 op_sel:[1,1,0] op_sel_hi:[0,1,1] neg_lo:[0,1,0]"
        : "=&v"(o), "=&v"(wn) : "v"(a), "v"(w), "v"(w1)); }
template <int TI, bool INV>
__device__ __forceinline__ void bf_tw(f32x2& a, f32x2& b) {
    constexpr int T7 = TI < 8 ? TI : 16 - TI;
    const f32x2 W = {tw_c(T7), tw_s(T7)};
    f32x2 sum, o;
#define HY_BF(NEGR, NEGI) asm("v_pk_add_f32 %0, %3, %2\n\tv_pk_add_f32 %2, %3, %2 neg_lo:[0,1] neg_hi:[0,1]\n\tv_pk_mul_f32 %1, %2, %4 op_sel_hi:[1,0]" NEGR "\n\tv_pk_fma_f32 %1, %2, %4, %1 op_sel:[1,1,0] op_sel_hi:[0,1,1] " NEGI : "=&v"(sum), "=&v"(o), "+v"(b) : "v"(a), "s"(W))
    if (TI < 8) { if (!INV) HY_BF("", "neg_hi:[0,1,0]"); else HY_BF("", "neg_lo:[0,1,0]"); }
    else        { if (!INV) HY_BF(" neg_lo:[0,1] neg_hi:[0,1]", "neg_hi:[0,1,0]"); else HY_BF(" neg_lo:[0,1] neg_hi:[0,1]", "neg_lo:[0,1,0]"); }
#undef HY_BF
    a = sum; b = o;
}
template <int TI, bool INV>
__device__ __forceinline__ f32x2 tw_mul(f32x2 t) {
    constexpr int T7 = TI < 8 ? TI : 16 - TI;
    const f32x2 W = {tw_c(T7), tw_s(T7)};
    f32x2 r;
#define HY_TW(NEGR, NEGI) asm("v_pk_mul_f32 %0, %1, %2 op_sel_hi:[1,0]" NEGR "\n\tv_pk_fma_f32 %0, %1, %2, %0 op_sel:[1,1,0] op_sel_hi:[0,1,1] " NEGI : "=&v"(r) : "v"(t), "s"(W))
    if (TI < 8) { if (!INV) HY_TW("", "neg_hi:[0,1,0]"); else HY_TW("", "neg_lo:[0,1,0]"); }
    else        { if (!INV) HY_TW(" neg_lo:[0,1] neg_hi:[0,1]", "neg_hi:[0,1,0]"); else HY_TW(" neg_lo:[0,1] neg_hi:[0,1]", "neg_lo:[0,1,0]"); }
#undef HY_TW
    return r;
}
template <bool INV>
__device__ __forceinline__ void bf_rot(f32x2& a, f32x2& b) { f32x2 sum, o;
    if (!INV) asm("v_pk_add_f32 %0, %2, %3\n\tv_pk_add_f32 %1, %2, %3 op_sel:[1,1] op_sel_hi:[0,0] neg_lo:[0,1] neg_hi:[1,0]" : "=&v"(sum), "=&v"(o) : "v"(a), "v"(b));
    else      asm("v_pk_add_f32 %0, %2, %3\n\tv_pk_add_f32 %1, %2, %3 op_sel:[1,1] op_sel_hi:[0,0] neg_lo:[1,0] neg_hi:[0,1]" : "=&v"(sum), "=&v"(o) : "v"(a), "v"(b));
    a = sum; b = o; }
__device__ __forceinline__ void bf_plain(f32x2& a, f32x2& b) { f32x2 sum, o;
    asm("v_pk_add_f32 %0, %2, %3\n\tv_pk_add_f32 %1, %2, %3 neg_lo:[0,1] neg_hi:[0,1]" : "=&v"(sum), "=&v"(o) : "v"(a), "v"(b));
    a = sum; b = o; }
template <bool INV>
__device__ __forceinline__ f32x2 rot_i(f32x2 t) { f32x2 r;
    if (!INV) asm("v_pk_mul_f32 %0, %1, 1.0 op_sel:[1,0] op_sel_hi:[0,0] neg_hi:[1,0]" : "=v"(r) : "v"(t));
    else      asm("v_pk_mul_f32 %0, %1, 1.0 op_sel:[1,0] op_sel_hi:[0,0] neg_lo:[1,0]" : "=v"(r) : "v"(t));
    return r; }

template <int R, bool INV, bool ZP, int S, int J>
__device__ __forceinline__ void fft_bfly(f32x2 (&v)[R]) {
    constexpr int g = (J / S) * 2 * S, k = J % S, ti = k * (16 / S), i0 = g + k, i1 = g + k + S;
    if constexpr (ZP && S == R / 2) {
        if constexpr (ti == 0) v[i1] = v[i0]; else if constexpr (ti == 8) v[i1] = rot_i<INV>(v[i0]); else v[i1] = tw_mul<ti, INV>(v[i0]);
    } else {
        if constexpr (ti == 0) bf_plain(v[i0], v[i1]); else if constexpr (ti == 8) bf_rot<INV>(v[i0], v[i1]); else bf_tw<ti, INV>(v[i0], v[i1]);
    }
}
template <int R, bool INV, bool ZP, int S, int J>
__device__ __forceinline__ void fft_stage(f32x2 (&v)[R]) { if constexpr (J < R / 2) { fft_bfly<R, INV, ZP, S, J>(v); fft_stage<R, INV, ZP, S, J + 1>(v); } }
template <int R, bool INV, bool ZP, int S>
__device__ __forceinline__ void fft_stages(f32x2 (&v)[R]) { if constexpr (S >= 1) { fft_stage<R, INV, ZP, S, 0>(v); fft_stages<R, INV, ZP, S / 2>(v); } }
template <int R, bool INV, bool ZP = false>
__device__ __forceinline__ void fft_reg(f32x2 (&v)[R]) { fft_stages<R, INV, ZP, R / 2>(v); }
#define XV(X) ((const volatile LAS f32x2*)(X))
template <int M, bool ZPAD = false>
__device__ __forceinline__ void pass_fwd32(LAS f32x2* X, int tid) {
    int j = (M == 512) ? (16 * ((tid >> 5) + 16 * ((tid >> 4) & 1)) + (tid & 15)) : (tid & 15);
    asm volatile("" : "+v"(j));
    const int p0 = (M == 512) ? (j + (j >> 4)) : (560 * (tid >> 4) + (tid & 15));
    constexpr int PS = (M == 512) ? 560 : 17;
    f32x2 v[32];
#pragma unroll
    for (int r = 0; r < 32; ++r) { if (ZPAD && r >= 16) v[r] = (f32x2){0.f, 0.f}; else v[r] = XV(X)[p0 + PS * r]; }
    fft_reg<32, false, ZPAD>(v);
    float sn, cs; sincospif(-2.f * (float)j / (float)(32 * M), &sn, &cs);
    const f32x2 w1 = {cs, sn}; f32x2 w = w1;
    X[p0] = v[0];
#pragma unroll
    for (int rp = 1; rp < 32; ++rp) { if (rp < 31) { f32x2 o_, wn_; cmul_chain(v[brev(rp, 5)], w, w1, o_, wn_); X[p0 + PS * rp] = o_; w = wn_; } else X[p0 + PS * rp] = cmul(v[brev(rp, 5)], w); }
}
template <int M, bool HALF = false>
__device__ __forceinline__ void pass_inv32(LAS f32x2* X, int tid) {
    int j = (M == 512) ? (16 * ((tid >> 5) + 16 * ((tid >> 4) & 1)) + (tid & 15)) : (tid & 15);
    asm volatile("" : "+v"(j));
    const int p0 = (M == 512) ? (j + (j >> 4)) : (560 * (tid >> 4) + (tid & 15));
    constexpr int PS = (M == 512) ? 560 : 17;
    float sn, cs; sincospif(2.f * (float)j / (float)(32 * M), &sn, &cs);
    const f32x2 w1 = {cs, sn}; f32x2 w = w1;
    f32x2 v[32];
    v[0] = XV(X)[p0];
#pragma unroll
    for (int rp = 1; rp < 32; ++rp) { if (rp < 31) { f32x2 wn_; cmul_chain(XV(X)[p0 + PS * rp], w, w1, v[rp], wn_); w = wn_; } else v[rp] = cmul(XV(X)[p0 + PS * rp], w); }
    fft_reg<32, true>(v);
#pragma unroll
    for (int p = 0; p < 32; ++p) { if (!HALF || brev(p, 5) < 16) X[p0 + PS * brev(p, 5)] = v[p]; }
}
typedef _Float16 f16x8h __attribute__((ext_vector_type(8)));
__device__ __forceinline__ void pass_c_store(const LAS f32x2* X, f32x2* Hs_, int tid, float scale) {
    _Float16* Hs = (_Float16*)Hs_; (void)scale;
#pragma unroll
    for (int u = 0; u < 2; ++u) { const int blk = tid + 512 * u, p0 = 17 * blk + 16 * (blk >> 5);
        f32x2 v[16];
#pragma unroll
        for (int r = 0; r < 16; ++r) v[r] = XV(X)[p0 + r];
        fft_reg<16, false>(v);
#pragma unroll
        for (int q = 0; q < 4; ++q) { f16x8h o;
#pragma unroll
            for (int e = 0; e < 4; ++e) { const f32x2 x = v[brev(4 * q + e, 4)]; o[2 * e] = (_Float16)x[0]; o[2 * e + 1] = (_Float16)x[1]; }
            *(f16x8h*)(Hs + 2 * (16 * blk + 4 * q)) = o; } }
}
__device__ __forceinline__ void pass_c_mul_inv(LAS f32x2* X, const f32x2* Hs_, int tid) {
    const _Float16* Hs = (const _Float16*)Hs_;
#pragma unroll
    for (int u = 0; u < 2; ++u) { const int blk = tid + 512 * u, p0 = 17 * blk + 16 * (blk >> 5);
        f32x2 v[16], w[16];
#pragma unroll
        for (int r = 0; r < 16; ++r) v[r] = XV(X)[p0 + r];
        f16x8h hh[4];
#pragma unroll
        for (int q = 0; q < 4; ++q) hh[q] = *(const f16x8h*)(Hs + 2 * (16 * blk + 4 * q));
        fft_reg<16, false>(v);
#pragma unroll
        for (int q = 0; q < 4; ++q)
#pragma unroll
            for (int e = 0; e < 4; ++e) w[4 * q + e] = cmul(v[brev(4 * q + e, 4)], (f32x2){(float)hh[q][2 * e], (float)hh[q][2 * e + 1]});
        fft_reg<16, true>(w);
#pragma unroll
        for (int p = 0; p < 16; ++p) X[p0 + brev(p, 4)] = w[p]; }
}
__device__ __forceinline__ void load16(const bf16_t* u, float (&e)[16]) {
    const u32x4 a = *(const u32x4*)u, b = *(const u32x4*)(u + 8);
    e[0] = bflo(a.x); e[1] = bfhi(a.x); e[2] = bflo(a.y); e[3] = bfhi(a.y); e[4] = bflo(a.z); e[5] = bfhi(a.z); e[6] = bflo(a.w); e[7] = bfhi(a.w);
    e[8] = bflo(b.x); e[9] = bfhi(b.x); e[10] = bflo(b.y); e[11] = bfhi(b.y); e[12] = bflo(b.z); e[13] = bfhi(b.z); e[14] = bflo(b.w); e[15] = bfhi(b.w);
}
__device__ __forceinline__ void sconv16(const bf16_t* u, int tid, float w0, float w1, float w2, float bias, float (&o)[16]) {
    float e[16]; load16(u + 16 * tid, e);
    float lf = __shfl_up(e[15], 1), rt = __shfl_down(e[0], 1);
    if ((tid & 3) == 0) lf = 0.f;
    if ((tid & 3) == 3) rt = 0.f;
    o[0] = w0 * lf + w1 * e[0] + w2 * e[1] + bias;
#pragma unroll
    for (int i = 1; i < 15; ++i) o[i] = w0 * e[i - 1] + w1 * e[i] + w2 * e[i + 1] + bias;
    o[15] = w0 * e[14] + w1 * e[15] + w2 * rt + bias;
}

constexpr int CV_SPLIT = NE * 128 * 20;
constexpr int CV_ITEMS = NE * 128 * 32;
struct CvJob { float v[8]; int mi; };
__device__ __forceinline__ void cv_issue(const Args& a, CvJob& jb, int mi, int lane) {
    jb.mi = mi;
    if (mi >= 0) { const int e = mi >> 12, kg = (mi >> 5) & 127, nb = mi & 31;
        const float* src = a.in[I_EW1] + ((size_t)e * 1024 + 8 * kg) * 2048 + 64 * nb + lane;
#pragma unroll
        for (int i = 0; i < 8; ++i) jb.v[i] = src[(size_t)i * 2048]; }
}
__device__ __forceinline__ void cv_finish(const Args& a, const CvJob& jb, int lane) {
    if (jb.mi >= 0) { const int mi = jb.mi, e = mi >> 12, kg = (mi >> 5) & 127, nb = mi & 31;
        const int cs = 64 * nb + lane, sgl = cs & 1, ac = cs >> 1, ct = ac >> 7, jj = ac & 127;
        unsigned char* dst = (unsigned char*)(a.ws + WS_W1T) + ((size_t)e * 2048 + 256 * ct + 128 * sgl + jj) * 1024 + 8 * kg;
        u32x2 o; o.x = gm::pk4_fp8_nc(jb.v[0] * gm::S_W, jb.v[1] * gm::S_W, jb.v[2] * gm::S_W, jb.v[3] * gm::S_W); o.y = gm::pk4_fp8_nc(jb.v[4] * gm::S_W, jb.v[5] * gm::S_W, jb.v[6] * gm::S_W, jb.v[7] * gm::S_W);
        *(u32x2*)dst = o; }
}
struct CvState { CvJob jb; int next, stride, end; };
__device__ __forceinline__ void cv_step(const Args& a, CvState& st, int lane) {
    cv_finish(a, st.jb, lane);
    const int mi = st.next < st.end ? st.next : -1;
    cv_issue(a, st.jb, mi, lane);
    st.next += st.stride;
}

__device__ __forceinline__ void channel(const Args& a, LAS unsigned char* lds, int c, unsigned char* scratch, CvState& cvs) {
    const int tid = threadIdx.x;
#define CV_STEP() cv_step(a, cvs, tid & 63)
    LAS f32x2* X = (LAS f32x2*)lds;
    f32x2* Hs = (f32x2*)scratch;
    const _Float16* HF = (const _Float16*)(a.ws + WS_HF);
    const int pc = 17 * tid + 16 * (tid >> 5);
    __syncthreads();
#pragma unroll 1
    for (int o = 0; o < 2; ++o) {
        typedef _Float16 f16x8_ __attribute__((ext_vector_type(8)));
        const f16x8_* hf = (const f16x8_*)(HF + ((size_t)(2 * o) * HYW + c) * SEQ + 16 * tid); const f16x8_* hb = (const f16x8_*)(HF + ((size_t)(2 * o + 1) * HYW + c) * SEQ + 16 * tid);
#pragma unroll
        for (int q = 0; q < 2; ++q) { const f16x8_ f = hf[q], b = hb[q];
#pragma unroll
            for (int e = 0; e < 8; ++e) { const int i = 8 * q + e, t = 16 * tid + i;
                X[pc + i] = (f32x2){(float)f[e], 0.f};
                if (t >= 1) X[phys(FFTN - t)] = (f32x2){(float)b[e], 0.f}; } }
        if (tid == 0) X[phys(SEQ)] = (f32x2){0.f, 0.f};
        __syncthreads();
        CV_STEP(); pass_fwd32<512>(X, tid); __syncthreads(); CV_STEP(); pass_fwd32<16>(X, tid); __syncthreads(); pass_c_store(X, Hs + (size_t)o * (FFTN / 2), tid, 1.f); __syncthreads();
    }
    const float* cw = a.in[I_CONVW]; const float* cbv = a.in[I_CONVB]; const float* dbias = a.in[I_BIASD];
    const float d1 = dbias[c], d2 = dbias[HYW + c];
    constexpr float INVN = 1.f / (float)FFTN;
    float wv[3][3], bv[3];
#pragma unroll
    for (int s = 0; s < 3; ++s) { bv[s] = cbv[s * HYW + c];
#pragma unroll
        for (int i = 0; i < 3; ++i) wv[s][i] = cw[i * HYC + s * HYW + c]; }
    const bf16_t* UT = (const bf16_t*)(a.ws + WS_UT);
    bf16_t* YT = (bf16_t*)(a.ws + WS_YHYT);
#pragma unroll 1
    for (int bp = 0; bp < 2; ++bp) {
        const bf16_t* u0 = UT + ((size_t)(2 * bp) * HYC + c) * SEQ; const bf16_t* u1 = UT + ((size_t)(2 * bp + 1) * HYC + c) * SEQ;
        float z0[16], z1[16];
        {
            float v0[16], v1[16]; sconv16(u0, tid, wv[0][0], wv[0][1], wv[0][2], bv[0], v0); sconv16(u1, tid, wv[0][0], wv[0][1], wv[0][2], bv[0], v1);
#pragma unroll
            for (int i = 0; i < 16; ++i) X[pc + i] = (f32x2){v0[i], v1[i]};
        }
        __syncthreads();
        CV_STEP(); pass_fwd32<512, true>(X, tid); __syncthreads(); CV_STEP(); pass_fwd32<16>(X, tid); __syncthreads(); pass_c_mul_inv(X, Hs, tid); __syncthreads(); CV_STEP(); pass_inv32<16>(X, tid); __syncthreads(); CV_STEP(); pass_inv32<512, true>(X, tid); __syncthreads();
        {
            float v0[16], v1[16], x0[16], x1[16];
            sconv16(u0, tid, wv[0][0], wv[0][1], wv[0][2], bv[0], v0); sconv16(u1, tid, wv[0][0], wv[0][1], wv[0][2], bv[0], v1);
            sconv16(u0 + (size_t)HYW * SEQ, tid, wv[1][0], wv[1][1], wv[1][2], bv[1], x0); sconv16(u1 + (size_t)HYW * SEQ, tid, wv[1][0], wv[1][1], wv[1][2], bv[1], x1);
#pragma unroll
            for (int i = 0; i < 16; ++i) { const f32x2 y1 = X[pc + i]; z0[i] = x0[i] * (y1[0] * INVN + d1 * v0[i]); z1[i] = x1[i] * (y1[1] * INVN + d1 * v1[i]); X[pc + i] = (f32x2){z0[i], z1[i]}; }
        }
        __syncthreads();
        CV_STEP(); pass_fwd32<512, true>(X, tid); __syncthreads(); CV_STEP(); pass_fwd32<16>(X, tid); __syncthreads(); pass_c_mul_inv(X, Hs + FFTN / 2, tid); __syncthreads(); CV_STEP(); pass_inv32<16>(X, tid); __syncthreads(); CV_STEP(); pass_inv32<512, true>(X, tid); __syncthreads();
        {
            float x0[16], x1[16];
            sconv16(u0 + (size_t)2 * HYW * SEQ, tid, wv[2][0], wv[2][1], wv[2][2], bv[2], x0); sconv16(u1 + (size_t)2 * HYW * SEQ, tid, wv[2][0], wv[2][1], wv[2][2], bv[2], x1);
            unsigned w0[8], w1[8];
#pragma unroll
            for (int i = 0; i < 8; ++i) { const f32x2 ya = X[pc + 2 * i], yb = X[pc + 2 * i + 1];
                w0[i] = pk2(x0[2 * i] * (ya[0] * INVN + d2 * z0[2 * i]), x0[2 * i + 1] * (yb[0] * INVN + d2 * z0[2 * i + 1]));
                w1[i] = pk2(x1[2 * i] * (ya[1] * INVN + d2 * z1[2 * i]), x1[2 * i + 1] * (yb[1] * INVN + d2 * z1[2 * i + 1])); }
            u32x4* y0p = (u32x4*)(YT + ((size_t)(2 * bp) * HYW + c) * SEQ + 16 * tid); u32x4* y1p = (u32x4*)(YT + ((size_t)(2 * bp + 1) * HYW + c) * SEQ + 16 * tid);
            y0p[0] = (u32x4){w0[0], w0[1], w0[2], w0[3]}; y0p[1] = (u32x4){w0[4], w0[5], w0[6], w0[7]};
            y1p[0] = (u32x4){w1[0], w1[1], w1[2], w1[3]}; y1p[1] = (u32x4){w1[4], w1[5], w1[6], w1[7]};
        }
        __syncthreads();
    }
#undef CV_STEP
}

__device__ __forceinline__ void filter_item(const Args& a, int item, int lane) {
    const int ct = item & 127, tc = item >> 7;
    const float* hid2 = (const float*)(a.ws + WS_HID2); const float* wout = a.in[I_FWOUT]; _Float16* HF = (_Float16*)(a.ws + WS_HF);
    const int col = 16 * ct + (lane & 15), kq = lane >> 4, cch = col & 511;
    typedef _Float16 f16x8f __attribute__((ext_vector_type(8)));
    f16x8f bfr[2];
#pragma unroll
    for (int s = 0; s < 2; ++s)
#pragma unroll
        for (int i = 0; i < 8; ++i) bfr[s][i] = (_Float16)wout[(size_t)(32 * s + 8 * kq + i) * 2048 + col];
    const float dlt = fabsf(-3.0701134573253945f + (float)cch * ((-15.350567286626973f + 3.0701134573253945f) / 511.f));
#pragma unroll 4
    for (int tt = 0; tt < 32; ++tt) { const int t0 = 512 * tc + 16 * tt;
        const f32x4* ar = (const f32x4*)(hid2 + (size_t)(t0 + (lane & 15)) * 64 + 8 * kq);
        const f32x4 a0 = ar[0], a1 = ar[1], a2 = ar[8], a3 = ar[9];
        const f16x8f af0 = {(_Float16)a0[0], (_Float16)a0[1], (_Float16)a0[2], (_Float16)a0[3], (_Float16)a1[0], (_Float16)a1[1], (_Float16)a1[2], (_Float16)a1[3]};
        const f16x8f af1 = {(_Float16)a2[0], (_Float16)a2[1], (_Float16)a2[2], (_Float16)a2[3], (_Float16)a3[0], (_Float16)a3[1], (_Float16)a3[2], (_Float16)a3[3]};
        f32x4 acc = {0.f, 0.f, 0.f, 0.f};
        acc = __builtin_amdgcn_mfma_f32_16x16x32_f16(af0, bfr[0], acc, 0, 0, 0);
        acc = __builtin_amdgcn_mfma_f32_16x16x32_f16(af1, bfr[1], acc, 0, 0, 0);
        f32x4 o;
#pragma unroll
        for (int r = 0; r < 4; ++r) o[r] = acc[r] * __expf(-((float)(t0 + 4 * kq + r) / (float)(SEQ - 1)) * dlt);
        typedef _Float16 f16x4_ __attribute__((ext_vector_type(4)));
        *(f16x4_*)(HF + (size_t)col * SEQ + t0 + 4 * kq) = (f16x4_){(_Float16)o[0], (_Float16)o[1], (_Float16)o[2], (_Float16)o[3]}; }
}

__device__ __forceinline__ void transpose_item(const Args& a, int item, int lane) {
    const int lt = item & 127, ct = (item >> 7) & 7, b = item >> 10;
    const bf16_t* src = (const bf16_t*)(a.ws + WS_YHYT) + ((size_t)b * HYW + 64 * ct) * SEQ + 64 * lt + lane;
    bf16_t* dst = (bf16_t*)(a.ws + WS_MIX) + ((size_t)b * SEQ + 64 * lt + lane) * 1024 + 512 + 64 * ct;
    unsigned short v[64];
#pragma unroll
    for (int cc = 0; cc < 64; ++cc) v[cc] = src[(size_t)cc * SEQ];
#pragma unroll
    for (int q = 0; q < 8; ++q)
        *(u32x4*)(dst + 8 * q) = (u32x4){(unsigned)v[8 * q] | ((unsigned)v[8 * q + 1] << 16), (unsigned)v[8 * q + 2] | ((unsigned)v[8 * q + 3] << 16),
                                         (unsigned)v[8 * q + 4] | ((unsigned)v[8 * q + 5] << 16), (unsigned)v[8 * q + 6] | ((unsigned)v[8 * q + 7] << 16)};
}
}

__device__ __forceinline__ void p0_mod_and_filter(const Args& a, LAS unsigned char* lds) {
    const int tid = threadIdx.x, lane = tid & 63, wave = tid >> 6;
    const float* c = a.in[I_C]; const float* cctx = a.in[I_CCTX]; const float* adaw = a.in[I_ADAW]; const float* adab = a.in[I_ADAB];
    float* mod = (float*)(a.ws + WS_MOD);
    LAS float* sl = (LAS float*)lds;
    LAS float* pt = (LAS float*)lds + 5 * 1024;
    for (int i = tid; i < 5 * 1024; i += NTHREADS) { const int r = i >> 10, k = i & 1023; sl[i] = silu_f(r < 4 ? c[r * 1024 + k] : cctx[k]); }
    for (int it = blockIdx.x; it < 256; it += gridDim.x) {
        __syncthreads();
        if (tid < 504) {
            const int col = tid % 24, ks = tid / 24, n = it * 24 + col, kbeg = ks * 49, kend = (kbeg + 49 < 1024) ? kbeg + 49 : 1024;
            float acc[5] = {0.f, 0.f, 0.f, 0.f, 0.f};
#pragma unroll 7
            for (int k = kbeg; k < kend; ++k) { const float w = adaw[(size_t)k * 6144 + n];
#pragma unroll
                for (int r = 0; r < 5; ++r) acc[r] += sl[r * 1024 + k] * w; }
#pragma unroll
            for (int r = 0; r < 5; ++r) pt[(ks * 5 + r) * 24 + col] = acc[r];
        }
        __syncthreads();
        if (tid < 120) { const int r = tid / 24, col = tid % 24, n = it * 24 + col; float s = adab[n];
            for (int ks = 0; ks < 21; ++ks) s += pt[(ks * 5 + r) * 24 + col];
            mod[r * 6144 + n] = s; }
    }
    __syncthreads();
    const float* w1 = a.in[I_FW1]; const float* b1 = a.in[I_FB1]; const float* w2 = a.in[I_FW2]; const float* b2 = a.in[I_FB2]; const float* fq = a.in[I_FFREQ];
    float* hid2 = (float*)(a.ws + WS_HID2);
    LAS float* zs = (LAS float*)lds + 8192 + wave * 128;
    const float frq = fq[lane], bb1 = b1[lane], bb2 = b2[lane];
    for (int t = (blockIdx.x * NWAVES + wave); t < SEQ; t += gridDim.x * NWAVES) {
        float z = 0.f;
        if (lane == 0) z = (float)t / (float)(SEQ - 1);
        else if (lane < 33) { const int i = (lane - 1) & 15; const float f = 1e-4f + (float)i * ((15.f - 1e-4f) / 15.f);
            const float ang = (6.283185307179586f * (float)t / (float)SEQ) * f; z = (lane < 17) ? cosf(ang) : -sinf(ang); }
        if (lane < 33) zs[lane] = z;
        __builtin_amdgcn_wave_barrier(); asm volatile("s_waitcnt lgkmcnt(0)" ::: "memory");
        float s = bb1;
#pragma unroll
        for (int e = 0; e < 33; ++e) s += zs[e] * w1[e * 64 + lane];
        const float h1 = sinf(frq * s);
        zs[64 + lane] = h1;
        __builtin_amdgcn_wave_barrier(); asm volatile("s_waitcnt lgkmcnt(0)" ::: "memory");
        float s2 = bb2;
#pragma unroll 16
        for (int g = 0; g < 64; ++g) s2 += zs[64 + g] * w2[g * 64 + lane];
        hid2[(size_t)t * 64 + lane] = sinf(frq * s2);
        __builtin_amdgcn_wave_barrier(); asm volatile("s_waitcnt lgkmcnt(0)" ::: "memory");
    }
}

template <bool FP8 = false>
__device__ __forceinline__ void tr_item(const float* W, int ldw, int k0, int c0, int cstride, float scale, bf16_t* dstrow0, LAS float* scr, int lane) {
    float wv_[32];
#pragma unroll
    for (int i = 0; i < 32; ++i) wv_[i] = W[(size_t)(k0 + 2 * i + (lane >> 5)) * ldw + c0 + (lane & 31) * cstride];
#pragma unroll
    for (int i = 0; i < 32; ++i) scr[(2 * i + (lane >> 5)) * 33 + (lane & 31)] = wv_[i] * scale;
    asm volatile("s_waitcnt lgkmcnt(0)" ::: "memory"); __builtin_amdgcn_wave_barrier();
    const int c = lane & 7;
#pragma unroll
    for (int j = 0; j < 4; ++j) { const int n = (lane >> 3) + 8 * j; const LAS float* s = scr + (8 * c) * 33 + n;
        if (FP8) { u32x2 o; o.x = gm::pk4_fp8(s[0 * 33], s[1 * 33], s[2 * 33], s[3 * 33]); o.y = gm::pk4_fp8(s[4 * 33], s[5 * 33], s[6 * 33], s[7 * 33]);
            *(u32x2*)((unsigned char*)dstrow0 + (size_t)n * 1024 + k0 + 8 * c) = o; }
        else { u32x4 o; o.x = pk2(s[0 * 33], s[1 * 33]); o.y = pk2(s[2 * 33], s[3 * 33]); o.z = pk2(s[4 * 33], s[5 * 33]); o.w = pk2(s[6 * 33], s[7 * 33]);
            *(u32x4*)(dstrow0 + (size_t)n * 1024 + k0 + 8 * c) = o; } }
    asm volatile("s_waitcnt lgkmcnt(0)" ::: "memory"); __builtin_amdgcn_wave_barrier();
}
__device__ __forceinline__ void fold_item(const float* win, const float* wa, int dir, int k0, int j0, bf16_t* dstrow0, LAS float* scr, int lane) {
#pragma unroll 4
    for (int i = 0; i < 32; ++i) { const int kk = 2 * i + (lane >> 5); const float* wr = win + (size_t)(k0 + kk) * INW + 1536 + 16 * dir; float s = 0.f;
#pragma unroll
        for (int r = 0; r < 16; ++r) s += wr[r] * wa[r * 256 + j0 + (lane & 31)];
        scr[kk * 33 + (lane & 31)] = s; }
    asm volatile("s_waitcnt lgkmcnt(0)" ::: "memory"); __builtin_amdgcn_wave_barrier();
    const int c = lane & 7;
#pragma unroll
    for (int j = 0; j < 4; ++j) { const int n = (lane >> 3) + 8 * j; const LAS float* s = scr + (8 * c) * 33 + n;
        u32x4 o; o.x = pk2(s[0 * 33], s[1 * 33]); o.y = pk2(s[2 * 33], s[3 * 33]); o.z = pk2(s[4 * 33], s[5 * 33]); o.w = pk2(s[6 * 33], s[7 * 33]);
        *(u32x4*)(dstrow0 + (size_t)n * 1024 + k0 + 8 * c) = o; }
    asm volatile("s_waitcnt lgkmcnt(0)" ::: "memory"); __builtin_amdgcn_wave_barrier();
}
__device__ __forceinline__ void ln_mod_row(const float* xrow, const float* shift, const float* scale, bf16_t* orow, int lane) {
    const f32x4* xr = (const f32x4*)xrow + lane;
    f32x4 v[4]; float s = 0.f;
#pragma unroll
    for (int j = 0; j < 4; ++j) { v[j] = xr[64 * j]; s += (v[j][0] + v[j][1]) + (v[j][2] + v[j][3]); }
    const float mean = wave_sum(s) * (1.f / D); float s2 = 0.f;
#pragma unroll
    for (int j = 0; j < 4; ++j) { v[j] = v[j] - mean; s2 += (v[j][0] * v[j][0] + v[j][1] * v[j][1]) + (v[j][2] * v[j][2] + v[j][3] * v[j][3]); }
    const float rstd = 1.f / sqrtf(wave_sum(s2) * (1.f / D) + LN_EPS);
    u32x2* o8 = (u32x2*)orow + lane;
#pragma unroll
    for (int j = 0; j < 4; ++j) { const f32x4 sh = ((const f32x4*)shift)[64 * j + lane], sc = ((const f32x4*)scale)[64 * j + lane];
        const f32x4 y = v[j] * rstd * (sc + 1.f) + sh;
        u32x2 w; w.x = pk2(y[0], y[1]); w.y = pk2(y[2], y[3]); o8[64 * j] = w; }
}
constexpr int PREP_I_IN = 16 * 96, PREP_I_FOLD = 16 * 8 * 2, PREP_I_OUT = 16 * 32, PREP_I_W1 = NE * 16 * 64, PREP_I_W2 = NE * 16 * 32;
constexpr int PREP_NITEMS = PREP_I_IN + PREP_I_FOLD + PREP_I_OUT + PREP_I_W1 + PREP_I_W2;
constexpr int PREP_DEFER = 10880;
__device__ __forceinline__ void prep_items(const Args& a, LAS float* scr, int first, int last, int rank, int nranks, int lane) {
    constexpr int I_IN = PREP_I_IN, I_FOLD = PREP_I_FOLD, I_OUT = PREP_I_OUT, I_W1 = PREP_I_W1;
    const float* win = a.in[I_WIN];
    bf16_t* btin = (bf16_t*)(a.ws + WS_BTIN); bf16_t* btout = (bf16_t*)(a.ws + WS_BTOUT); bf16_t* w1t = (bf16_t*)(a.ws + WS_W1T); bf16_t* w2t = (bf16_t*)(a.ws + WS_W2T);
    for (int it = first + rank; it < last; it += nranks) {
        int r = it;
        if (r < I_IN) {
            const int kb = r / 96, nb = r % 96;
            if (nb < 48) tr_item(win, INW, 64 * kb, 32 * nb, 1, nb < 8 ? 0.125f : 1.f, btin + (size_t)(32 * nb) * 1024, scr, lane);
            else tr_item(win, INW, 64 * kb, 1568 + 32 * (nb - 48), 1, 1.f, btin + (size_t)(2048 + 32 * (nb - 48)) * 1024, scr, lane);
            continue; }
        r -= I_IN;
        if (r < I_FOLD) { const int dir = r & 1, jb = (r >> 1) & 7, kb = r >> 4;
            fold_item(win, dir ? a.in[I_WAB] : a.in[I_WAF], dir, 64 * kb, 32 * jb, btin + (size_t)(1536 + 256 * dir + 32 * jb) * 1024, scr, lane); continue; }
        r -= I_FOLD;
        if (r < I_OUT) { const int kb = r / 32, nb = r % 32; tr_item(a.in[I_WOUT], 1024, 64 * kb, 32 * nb, 1, 1.f, btout + (size_t)(32 * nb) * 1024, scr, lane); continue; }
        r -= I_OUT;
        if (r < I_W1) {
            const int e = r / 1024, q = r % 1024, s = q & 1, nb = (q >> 1) & 31, kb = q >> 6;
            const int ct = nb >> 2, jj0 = (nb & 3) * 32;
            tr_item<true>(a.in[I_EW1] + (size_t)e * 1024 * 2048, 2048, 64 * kb, 2 * (128 * ct + jj0) + s, 2, gm::S_W, (bf16_t*)((unsigned char*)w1t + ((size_t)e * 2048 + 256 * ct + 128 * s + jj0) * 1024), scr, lane);
            continue; }
        r -= I_W1;
        { const int e = r / 512, q = r % 512, kb = q / 32, nb = q % 32;
          tr_item<true>(a.in[I_EW2] + (size_t)e * 1024 * 1024, 1024, 64 * kb, 32 * nb, 1, gm::S_W, (bf16_t*)((unsigned char*)w2t + ((size_t)e * 1024 + 32 * nb) * 1024), scr, lane); }
    }
}
__device__ __forceinline__ void p1_prep(const Args& a, LAS unsigned char* lds) {
    const int tid = threadIdx.x, lane = tid & 63, wave = tid >> 6;
    LAS float* scr = (LAS float*)(lds + wave * 16384);
    const int gw = blockIdx.x * NWAVES + wave, NGW = gridDim.x * NWAVES;
    const float* win = a.in[I_WIN];
    bf16_t* btin = (bf16_t*)(a.ws + WS_BTIN); bf16_t* btout = (bf16_t*)(a.ws + WS_BTOUT); bf16_t* w1t = (bf16_t*)(a.ws + WS_W1T); bf16_t* w2t = (bf16_t*)(a.ws + WS_W2T);
    const float* mod = (const float*)(a.ws + WS_MOD);
    bf16_t* H = (bf16_t*)(a.ws + WS_H);
    { int cur_mr = -1; f32x4 shv[4], scv[4];
#pragma unroll
      for (int j = 0; j < 4; ++j) { shv[j] = (f32x4){0.f, 0.f, 0.f, 0.f}; scv[j] = shv[j]; }
      for (int row0 = gw; row0 < TT; row0 += 4 * NGW) {
        f32x4 xv[4][4];
#pragma unroll
        for (int i = 0; i < 4; ++i) { const int row = row0 + i * NGW;
            if (row < TT) { const f32x4* xr = (const f32x4*)(row < T ? a.in[I_X] + (size_t)row * D : a.in[I_CTX] + (size_t)(row - T) * D) + lane;
#pragma unroll
                for (int j = 0; j < 4; ++j) xv[i][j] = xr[64 * j]; } }
#pragma unroll
        for (int i = 0; i < 4; ++i) { const int row = row0 + i * NGW;
            if (row < TT) { const int mr = row < T ? row >> 13 : 4;
                if (mr != cur_mr) { cur_mr = mr;
#pragma unroll
                    for (int j = 0; j < 4; ++j) { shv[j] = ((const f32x4*)(mod + mr * 6144))[64 * j + lane]; scv[j] = ((const f32x4*)(mod + mr * 6144 + 1024))[64 * j + lane]; } }
                f32x4 v[4]; float s = 0.f;
#pragma unroll
                for (int j = 0; j < 4; ++j) { v[j] = xv[i][j]; s += (v[j][0] + v[j][1]) + (v[j][2] + v[j][3]); }
                const float mean = wave_sum(s) * (1.f / D); float s2 = 0.f;
#pragma unroll
                for (int j = 0; j < 4; ++j) { v[j] = v[j] - mean; s2 += (v[j][0] * v[j][0] + v[j][1] * v[j][1]) + (v[j][2] * v[j][2] + v[j][3] * v[j][3]); }
                const float rstd = 1.f / sqrtf(wave_sum(s2) * (1.f / D) + LN_EPS);
                u32x2* o8 = (u32x2*)(H + (size_t)row * D) + lane;
#pragma unroll
                for (int j = 0; j < 4; ++j) { const f32x4 y = v[j] * rstd * (scv[j] + 1.f) + shv[j];
                    u32x2 w; w.x = pk2(y[0], y[1]); w.y = pk2(y[2], y[3]); o8[64 * j] = w; } } }
      } }
    prep_items(a, scr, 0, PREP_I_IN + PREP_I_FOLD + PREP_I_OUT, gw, NGW, lane);
    prep_items(a, scr, PREP_I_IN + PREP_I_FOLD + PREP_I_OUT + PREP_I_W1, PREP_NITEMS - PREP_DEFER, gw, NGW, lane);
    for (int it = gw; it < 2048; it += NGW) hy::filter_item(a, it, lane);
    float* b1r = (float*)(a.ws + WS_B1R); const float* eb1 = a.in[I_EB1];
    for (int i = blockIdx.x * NTHREADS + tid; i < NE * 2048; i += gridDim.x * NTHREADS) {
        const int e = i >> 11, n = i & 2047, ct = n >> 8, s = (n >> 7) & 1, jj = n & 127;
        b1r[i] = eb1[(size_t)e * 2048 + 2 * (128 * ct + jj) + s];
    }
}

namespace gla {
constexpr int RS = 72;
constexpr int L_TOTF = 0, L_TOTB = 2048, L_SSQ = 4096;
constexpr int L_T0 = 8192;
constexpr int L_T1 = L_T0 + 9216, L_T2 = L_T1 + 9216, L_T3 = L_T2 + 9216;
constexpr int L_VT = L_T3 + 9216;
constexpr int L_P  = L_VT + 18432;
constexpr int L_SF = L_P + 9216, L_SB = L_SF + 18432;
constexpr int L_END = L_SB + 18432;

__device__ __forceinline__ bf16x8 frag(const LAS unsigned char* tile, int row, int k0, int lane) {
    return *(const LAS bf16x8*)(tile + ((row + (lane & 15)) * RS + k0 + 8 * (lane >> 4)) * 2);
}
__device__ __forceinline__ void chunk_cums_pre(LAS unsigned char* L, const float (&gf)[8], const float (&gb)[8], int wave, int lane, float (&cumf)[8], float (&cumb)[8], float& allf, float& allb) {
    LAS float* totf = (LAS float*)(L + L_TOTF); LAS float* totb = (LAS float*)(L + L_TOTB);
    cumf[0] = gf[0];
#pragma unroll
    for (int r = 1; r < 8; ++r) cumf[r] = cumf[r - 1] + gf[r];
    cumb[7] = gb[7];
#pragma unroll
    for (int r = 6; r >= 0; --r) cumb[r] = cumb[r + 1] + gb[r];
    totf[wave * 64 + lane] = cumf[7]; totb[wave * 64 + lane] = cumb[0];
    __syncthreads();
    float of = 0.f, ob = 0.f, af = 0.f, ab = 0.f;
#pragma unroll
    for (int w = 0; w < 8; ++w) { const float tf = totf[w * 64 + lane], tb = totb[w * 64 + lane]; af += tf; ab += tb; of += (w < wave) ? tf : 0.f; ob += (w > wave) ? tb : 0.f; }
#pragma unroll
    for (int r = 0; r < 8; ++r) { cumf[r] += of; cumb[r] += ob; }
    allf = af; allb = ab;
}
__device__ __forceinline__ void chunk_cums(LAS unsigned char* L, const _Float16* GF, const _Float16* GB, size_t tok0, int h, int wave, int lane, float (&cumf)[8], float (&cumb)[8], float& allf, float& allb) {
    float gf[8], gb[8];
#pragma unroll
    for (int r = 0; r < 8; ++r) { const size_t o = (tok0 + 8 * wave + r) * 256 + h * 64 + lane; gf[r] = (float)GF[o]; gb[r] = (float)GB[o]; }
    chunk_cums_pre(L, gf, gb, wave, lane, cumf, cumb, allf, allb);
}
__device__ __forceinline__ void store_vt(LAS unsigned char* L, const u32x4 (&vr)[2], int tid) {
    LAS bf16_t* vt = (LAS bf16_t*)(L + L_VT);
    const int j = tid >> 3, c8 = tid & 7;
#pragma unroll
    for (int q = 0; q < 2; ++q) { const int dv0 = 8 * (c8 + 8 * q);
        const unsigned ww[4] = {vr[q].x, vr[q].y, vr[q].z, vr[q].w};
#pragma unroll
        for (int e = 0; e < 4; ++e) { vt[(dv0 + 2 * e) * RS + j] = (bf16_t)(ww[e] & 0xffffu); vt[(dv0 + 2 * e + 1) * RS + j] = (bf16_t)(ww[e] >> 16); } }
}
__device__ __forceinline__ void load_vt(LAS unsigned char* L, const bf16_t* V, size_t tok0, int h, int tid) {
    const int j = tid >> 3, c8 = tid & 7; u32x4 vr[2];
#pragma unroll
    for (int q = 0; q < 2; ++q) vr[q] = *(const u32x4*)(V + (tok0 + j) * 512 + h * 128 + 8 * (c8 + 8 * q));
    store_vt(L, vr, tid);
}

__device__ __forceinline__ void g1_unit(const Args& a, LAS unsigned char* L, int bh, int chunk  ) {
    const int tid = threadIdx.x, lane = tid & 63, wave = __builtin_amdgcn_readfirstlane(tid >> 6);
    const int b = bh >> 2, h = bh & 3;
    const size_t tok0 = chunk < NCHUNK ? (size_t)b * SEQ + (size_t)chunk * CH : (size_t)T + (size_t)b * CTXL + (size_t)(chunk - NCHUNK) * CH;
    const _Float16* GF = (const _Float16*)(a.ws + WS_GF); const _Float16* GB = (const _Float16*)(a.ws + WS_GB);
    const bf16_t* Kb = (const bf16_t*)(a.ws + WS_K); const bf16_t* Vb = (const bf16_t*)(a.ws + WS_V);
    float cumf[8], cumb[8], allf, allb;
    __syncthreads();
    chunk_cums(L, GF, GB, tok0, h, wave, lane, cumf, cumb, allf, allb);
    LAS bf16_t* ketf = (LAS bf16_t*)(L + L_T0); LAS bf16_t* ketb = (LAS bf16_t*)(L + L_T1);
#pragma unroll
    for (int r = 0; r < 8; ++r) { const int i = 8 * wave + r; const float kv = bf2f(Kb[(tok0 + i) * 256 + h * 64 + lane]);
        ketf[lane * RS + i] = f2bf(kv * __expf(allf - cumf[r])); ketb[lane * RS + i] = f2bf(kv * __expf(allb - cumb[r])); }
    load_vt(L, Vb, tok0, h, tid);
    if (wave == 0) { float* av = (float*)(a.ws + WS_AV); av[((size_t)(0 * 16 + bh) * NCT + chunk) * 64 + lane] = __expf(allf); av[((size_t)(1 * 16 + bh) * NCT + chunk) * 64 + lane] = __expf(allb); }
    __syncthreads();
    bf16_t* KV = (bf16_t*)(a.ws + WS_KV);
#pragma unroll
    for (int dir = 0; dir < 2; ++dir) {
        const LAS unsigned char* ket = L + (dir ? L_T1 : L_T0);
        bf16_t* dst = KV + ((size_t)(dir * 16 + bh) * NCT + chunk) * 8192;
#pragma unroll
        for (int nt = 0; nt < 4; ++nt) { f32x4 acc = {0.f, 0.f, 0.f, 0.f};
#pragma unroll
            for (int ks = 0; ks < 2; ++ks) acc = __builtin_amdgcn_mfma_f32_16x16x32_bf16(frag(ket, 16 * nt, 32 * ks, lane), frag(L + L_VT, 16 * wave, 32 * ks, lane), acc, 0, 0, 0);
            u32x2 w; w.x = pk2(acc[0], acc[1]); w.y = pk2(acc[2], acc[3]);
            *(u32x2*)(dst + (16 * wave + (lane & 15)) * 64 + 16 * nt + 4 * (lane >> 4)) = w; }
    }
}

__device__ __forceinline__ void g2_scan(const Args& a) {
    const bf16_t* KV = (const bf16_t*)(a.ws + WS_KV); const float* AV = (const float*)(a.ws + WS_AV); bf16_t* SP = (bf16_t*)(a.ws + WS_SP);
    for (int id = blockIdx.x * NTHREADS + threadIdx.x; id < 32 * 4096; id += gridDim.x * NTHREADS) {
        const int db = id >> 12, e2 = id & 4095, dir = db >> 4, dk = (2 * e2) & 63;
        const unsigned* kv = (const unsigned*)(KV + (size_t)db * NCT * 8192) + e2;
        const float* av = AV + (size_t)db * NCT * 64 + dk;
        unsigned* sp = (unsigned*)(SP + (size_t)db * NCHUNK * 8192) + e2;
        float s0 = 0.f, s1 = 0.f;
#pragma unroll
        for (int q = 0; q < NCC; ++q) { const int c = NCHUNK + (dir ? (NCC - 1 - q) : q);
            const unsigned w = kv[(size_t)c * 4096]; const f32x2 aa = *(const f32x2*)(av + (size_t)c * 64);
            s0 = aa[0] * s0 + bflo(w); s1 = aa[1] * s1 + bfhi(w); }
        for (int q0 = 0; q0 < NCHUNK; q0 += 16) {
            unsigned w[16]; f32x2 aa[16];
#pragma unroll
            for (int u = 0; u < 16; ++u) { const int c = dir ? (NCHUNK - 1 - (q0 + u)) : (q0 + u); w[u] = kv[(size_t)c * 4096]; aa[u] = *(const f32x2*)(av + (size_t)c * 64); }
#pragma unroll
            for (int u = 0; u < 16; ++u) { const int c = dir ? (NCHUNK - 1 - (q0 + u)) : (q0 + u);
                sp[(size_t)c * 4096] = pk2(s0, s1);
                s0 = aa[u][0] * s0 + bflo(w[u]); s1 = aa[u][1] * s1 + bfhi(w[u]); }
        }
    }
}

struct G3In { float gf[8], gb[8]; bf16_t q[8], k[8]; u32x4 v[2]; u32x4 sraw[4]; bf16_t gr[4][4]; };
__device__ __forceinline__ void g3_load(const Args& a, int bh, int chunk, G3In& in) {
    const int tid = threadIdx.x, lane = tid & 63, wave = __builtin_amdgcn_readfirstlane(tid >> 6);
    const int b = bh >> 2, h = bh & 3;
    const size_t tok0 = (size_t)b * SEQ + (size_t)chunk * CH;
    const _Float16* GF = (const _Float16*)(a.ws + WS_GF); const _Float16* GB = (const _Float16*)(a.ws + WS_GB);
    const bf16_t* Qb = (const bf16_t*)(a.ws + WS_Q); const bf16_t* Kb = (const bf16_t*)(a.ws + WS_K); const bf16_t* Vb = (const bf16_t*)(a.ws + WS_V);
#pragma unroll
    for (int r = 0; r < 8; ++r) { const size_t o = (tok0 + 8 * wave + r) * 256 + h * 64 + lane; in.gf[r] = (float)GF[o]; in.gb[r] = (float)GB[o]; in.q[r] = Qb[o]; in.k[r] = Kb[o]; }
#pragma unroll
    for (int q = 0; q < 2; ++q) in.v[q] = *(const u32x4*)(Vb + (tok0 + (tid >> 3)) * 512 + h * 128 + 8 * ((tid & 7) + 8 * q));
    const bf16_t* SPf = (const bf16_t*)(a.ws + WS_SP) + ((size_t)(0 * 16 + bh) * NCHUNK + chunk) * 8192;
    const bf16_t* SPb = (const bf16_t*)(a.ws + WS_SP) + ((size_t)(1 * 16 + bh) * NCHUNK + chunk) * 8192;
    in.sraw[0] = *(const u32x4*)(SPf + 16 * tid); in.sraw[1] = *(const u32x4*)(SPf + 16 * tid + 8);
    in.sraw[2] = *(const u32x4*)(SPb + 16 * tid); in.sraw[3] = *(const u32x4*)(SPb + 16 * tid + 8);
    const bf16_t* Gt = (const bf16_t*)(a.ws + WS_G);
    const int mt = wave >> 1, fr = lane & 15, fq = lane >> 4;
#pragma unroll
    for (int q = 0; q < 4; ++q)
#pragma unroll
        for (int r = 0; r < 4; ++r) in.gr[r][q] = Gt[(tok0 + 16 * mt + 4 * fq + r) * 512 + h * 128 + 16 * (4 * (wave & 1) + q) + fr];
}
__device__ __forceinline__ void g3_unit(const Args& a, LAS unsigned char* L, int bh, int chunk  , const G3In& in, hy::CvState& cvs) {
    const int tid = threadIdx.x, lane = tid & 63, wave = __builtin_amdgcn_readfirstlane(tid >> 6);
    const int b = bh >> 2, h = bh & 3;
    const size_t tok0 = (size_t)b * SEQ + (size_t)chunk * CH;
    const int mt = wave >> 1, fr = lane & 15, fq = lane >> 4;
    float cumf[8], cumb[8], allf, allb;
    hy::cv_step(a, cvs, lane);
    __syncthreads();
    chunk_cums_pre(L, in.gf, in.gb, wave, lane, cumf, cumb, allf, allb);
    LAS bf16_t* qf = (LAS bf16_t*)(L + L_T0); LAS bf16_t* kf = (LAS bf16_t*)(L + L_T1); LAS bf16_t* qb = (LAS bf16_t*)(L + L_T2); LAS bf16_t* kb = (LAS bf16_t*)(L + L_T3);
#pragma unroll
    for (int r = 0; r < 8; ++r) { const int i = 8 * wave + r;
        const float qv = bf2f(in.q[r]), kv = bf2f(in.k[r]);
        qf[i * RS + lane] = f2bf(qv * __expf(cumf[r])); kf[i * RS + lane] = f2bf(kv * __expf(-cumf[r]));
        qb[i * RS + lane] = f2bf(qv * __expf(cumb[r])); kb[i * RS + lane] = f2bf(kv * __expf(-cumb[r])); }
    store_vt(L, in.v, tid);
    {
      LAS unsigned char* sf_ = L + L_SF + ((tid >> 2) * RS + 16 * (tid & 3)) * 2; LAS unsigned char* sb_ = L + L_SB + ((tid >> 2) * RS + 16 * (tid & 3)) * 2;
      *(LAS u32x4*)sf_ = in.sraw[0]; *(LAS u32x4*)(sf_ + 16) = in.sraw[1]; *(LAS u32x4*)sb_ = in.sraw[2]; *(LAS u32x4*)(sb_ + 16) = in.sraw[3]; }
    hy::cv_step(a, cvs, lane);
    __syncthreads();
    {
        LAS bf16_t* P = (LAS bf16_t*)(L + L_P);
#pragma unroll
        for (int q = 0; q < 2; ++q) { const int nt = 2 * (wave & 1) + q;
            f32x4 sf = {0.f, 0.f, 0.f, 0.f}, sb = {0.f, 0.f, 0.f, 0.f};
#pragma unroll
            for (int ks = 0; ks < 2; ++ks) {
                sf = __builtin_amdgcn_mfma_f32_16x16x32_bf16(frag(L + L_T0, 16 * mt, 32 * ks, lane), frag(L + L_T1, 16 * nt, 32 * ks, lane), sf, 0, 0, 0);
                sb = __builtin_amdgcn_mfma_f32_16x16x32_bf16(frag(L + L_T2, 16 * mt, 32 * ks, lane), frag(L + L_T3, 16 * nt, 32 * ks, lane), sb, 0, 0, 0); }
#pragma unroll
            for (int r = 0; r < 4; ++r) { const int i = 16 * mt + 4 * fq + r, j = 16 * nt + fr;
                P[i * RS + j] = f2bf((j <= i ? sf[r] : 0.f) + (j >= i ? sb[r] : 0.f)); } }
    }
    hy::cv_step(a, cvs, lane);
    __syncthreads();
    f32x4 o[4]; float ssq[4] = {0.f, 0.f, 0.f, 0.f};
#pragma unroll
    for (int q = 0; q < 4; ++q) { const int nt = 4 * (wave & 1) + q;
        f32x4 acc = {0.f, 0.f, 0.f, 0.f};
#pragma unroll
        for (int ks = 0; ks < 2; ++ks) {
            acc = __builtin_amdgcn_mfma_f32_16x16x32_bf16(frag(L + L_P, 16 * mt, 32 * ks, lane), frag(L + L_VT, 16 * nt, 32 * ks, lane), acc, 0, 0, 0);
            acc = __builtin_amdgcn_mfma_f32_16x16x32_bf16(frag(L + L_T0, 16 * mt, 32 * ks, lane), frag(L + L_SF, 16 * nt, 32 * ks, lane), acc, 0, 0, 0);
            acc = __builtin_amdgcn_mfma_f32_16x16x32_bf16(frag(L + L_T2, 16 * mt, 32 * ks, lane), frag(L + L_SB, 16 * nt, 32 * ks, lane), acc, 0, 0, 0); }
        o[q] = acc;
#pragma unroll
        for (int r = 0; r < 4; ++r) ssq[r] += acc[r] * acc[r]; }
    LAS float* SSQ = (LAS float*)(L + L_SSQ);
#pragma unroll
    for (int r = 0; r < 4; ++r) { float s = ssq[r]; s += __shfl_xor(s, 1); s += __shfl_xor(s, 2); s += __shfl_xor(s, 4); s += __shfl_xor(s, 8); ssq[r] = s; }
    if (fr == 0) {
#pragma unroll
        for (int r = 0; r < 4; ++r) SSQ[(wave & 1) * 64 + 16 * mt + 4 * fq + r] = ssq[r]; }
    hy::cv_step(a, cvs, lane);
    __syncthreads();
    const float* ng = a.in[I_NORMG];
    bf16_t* mix = (bf16_t*)(a.ws + WS_MIX);
#pragma unroll
    for (int r = 0; r < 4; ++r) { const int i = 16 * mt + 4 * fq + r;
        const float rstd = 1.f / sqrtf((SSQ[i] + SSQ[64 + i]) * (1.f / DV) + LN_EPS);
#pragma unroll
        for (int q = 0; q < 4; ++q) { const int dv = 16 * (4 * (wave & 1) + q) + fr;
            const float g = bf2f(in.gr[r][q]);
            mix[(tok0 + i) * 1024 + h * 128 + dv] = f2bf(o[q][r] * rstd * ng[dv] * silu_f(g)); } }
}
}

namespace rt {
constexpr int HS = 1028;
constexpr int L_H2 = 0;
constexpr int L_PART = 65792;
constexpr int L_LCNT = L_PART + 16384;
constexpr int L_REC = L_LCNT + 256;
constexpr int L_TAB = 86016;

__device__ __forceinline__ void phase(const Args& a, LAS unsigned char* lds) {
    const int tid = threadIdx.x, lane = tid & 63, wave = __builtin_amdgcn_readfirstlane(tid >> 6);
    bf16_t* xmid = (bf16_t*)(a.ws + WS_PRE1); bf16_t* H2 = (bf16_t*)(a.ws + WS_H2); const bf16_t* FG = (const bf16_t*)(a.ws + WS_FG);
    const float* mod = (const float*)(a.ws + WS_MOD);
    const float* rw = a.in[I_RW]; const float* rb = a.in[I_RB];
    LAS float* h2s = (LAS float*)(lds + L_H2); LAS float* part = (LAS float*)(lds + L_PART);
    LAS int* lcnt = (LAS int*)(lds + L_LCNT); LAS int* lbase = lcnt + 32; LAS int* rec = (LAS int*)(lds + L_REC);
    unsigned* cnt = (unsigned*)(a.ws + WS_CNT); int* list = (int*)(a.ws + WS_LIST); float* pw = (float*)(a.ws + WS_PW); int* ploc = (int*)(a.ws + WS_PLOC);
    bf16x8 rwh[4][2], rwl[4][2];
#pragma unroll
    for (int s = 0; s < 4; ++s)
#pragma unroll
        for (int nt = 0; nt < 2; ++nt)
#pragma unroll
            for (int i = 0; i < 8; ++i) { const float x = rw[(size_t)(128 * wave + 32 * s + 8 * (lane >> 4) + i) * 32 + 16 * nt + (lane & 15)];
                const unsigned hb = __float_as_uint(x) & 0xffff0000u; rwh[s][nt][i] = (short)(hb >> 16); rwl[s][nt][i] = (short)f2bf(x - __uint_as_float(hb)); }
    LAS f32x4* g1 = (LAS f32x4*)(lds + L_TAB); LAS f32x4* bb1 = g1 + 256; LAS f32x4* shT = bb1 + 256; LAS f32x4* scT = shT + 4 * 256;
    if (tid < 256) { g1[tid] = ((const f32x4*)a.in[I_LN1G])[tid]; bb1[tid] = ((const f32x4*)a.in[I_LN1B])[tid]; }
    for (int i = tid; i < 4 * 256; i += NTHREADS) { shT[i] = ((const f32x4*)(mod + (i >> 8) * 6144 + 3 * 1024))[i & 255]; scT[i] = ((const f32x4*)(mod + (i >> 8) * 6144 + 4 * 1024))[i & 255]; }
    const float rbe = rb[lane & 31];
    if (tid < 32) lcnt[tid] = 0;
    int pend = 0, pgrp = -1;
    f32x4 xq[2][4]; u32x2 fq_[2][4];
#define RT_LOAD(g_) do { _Pragma("unroll") for (int rr = 0; rr < 2; ++rr) { const int t_ = (g_) * 16 + 2 * wave + rr; \
        const f32x4* xr_ = (const f32x4*)(a.in[I_X] + (size_t)t_ * D) + lane; const u32x2* fr_ = (const u32x2*)(FG + (size_t)t_ * D) + lane; \
        _Pragma("unroll") for (int j = 0; j < 4; ++j) { xq[rr][j] = xr_[64 * j]; fq_[rr][j] = fr_[64 * j]; } } } while (0)
    if ((int)blockIdx.x < T / 16) RT_LOAD((int)blockIdx.x);
    for (int grp = blockIdx.x; grp < T / 16; grp += gridDim.x) {
        __syncthreads();
        f32x4 xv_[2][4]; u32x2 fv_[2][4];
#pragma unroll
        for (int rr = 0; rr < 2; ++rr)
#pragma unroll
            for (int j = 0; j < 4; ++j) { xv_[rr][j] = xq[rr][j]; fv_[rr][j] = fq_[rr][j]; }
        if (pgrp >= 0) { if (tid < 32) lbase[tid] = pend; __syncthreads();
            if (tid < 64) { const int rc = rec[tid], ek = rc & 255, rank = rc >> 8, pos = lbase[ek] + rank, pair = (pgrp * 16 + (tid >> 2)) * 4 + (tid & 3);
                list[(size_t)ek * CAP + pos] = pair; ploc[pair] = ek | (pos << 5); } }
        if (grp + (int)gridDim.x < T / 16) RT_LOAD(grp + (int)gridDim.x);
#pragma unroll
        for (int rr = 0; rr < 2; ++rr) {
            const int lr = 2 * wave + rr, t = grp * 16 + lr, b = t >> 13;
            u32x2* pr = (u32x2*)(xmid + (size_t)t * D) + lane;
            f32x4 v[4]; float s = 0.f;
#pragma unroll
            for (int j = 0; j < 4; ++j) { const u32x2 fw = fv_[rr][j]; const f32x4 ff = {bflo(fw.x), bfhi(fw.x), bflo(fw.y), bfhi(fw.y)};
                v[j] = xv_[rr][j] * ALPHA + ff; s += (v[j][0] + v[j][1]) + (v[j][2] + v[j][3]); }
            float mean = wave_sum(s) * (1.f / D), s2 = 0.f;
#pragma unroll
            for (int j = 0; j < 4; ++j) { v[j] = v[j] - mean; s2 += (v[j][0] * v[j][0] + v[j][1] * v[j][1]) + (v[j][2] * v[j][2] + v[j][3] * v[j][3]); }
            float rstd = 1.f / sqrtf(wave_sum(s2) * (1.f / D) + LN_EPS);
            s = 0.f;
#pragma unroll
            for (int j = 0; j < 4; ++j) { v[j] = v[j] * rstd * g1[64 * j + lane] + bb1[64 * j + lane]; u32x2 w; w.x = pk2(v[j][0], v[j][1]); w.y = pk2(v[j][2], v[j][3]); pr[64 * j] = w;
                v[j] = (f32x4){bflo(w.x), bfhi(w.x), bflo(w.y), bfhi(w.y)}; s += (v[j][0] + v[j][1]) + (v[j][2] + v[j][3]); }
            mean = wave_sum(s) * (1.f / D); s2 = 0.f;
#pragma unroll
            for (int j = 0; j < 4; ++j) { v[j] = v[j] - mean; s2 += (v[j][0] * v[j][0] + v[j][1] * v[j][1]) + (v[j][2] * v[j][2] + v[j][3] * v[j][3]); }
            rstd = 1.f / sqrtf(wave_sum(s2) * (1.f / D) + LN_EPS);
            const LAS f32x4* sh = shT + b * 256; const LAS f32x4* sc = scT + b * 256;
            unsigned* o4 = (unsigned*)((unsigned char*)H2 + (size_t)t * D) + lane;
#pragma unroll
            for (int j = 0; j < 4; ++j) { const f32x4 y = v[j] * rstd * (sc[64 * j + lane] + 1.f) + sh[64 * j + lane];
                o4[64 * j] = gm::pk4_fp8(y[0] * gm::S_H2, y[1] * gm::S_H2, y[2] * gm::S_H2, y[3] * gm::S_H2);
                *(LAS f32x4*)(h2s + lr * HS + 256 * j + 4 * lane) = y; }
        }
        __syncthreads();
        {
            f32x4 acc0 = {0.f, 0.f, 0.f, 0.f}, acc1 = {0.f, 0.f, 0.f, 0.f};
            const LAS float* ap = h2s + (lane & 15) * HS + 128 * wave + 8 * (lane >> 4);
#pragma unroll
            for (int s = 0; s < 4; ++s) { const f32x4 x0 = *(const LAS f32x4*)(ap + 32 * s), x1 = *(const LAS f32x4*)(ap + 32 * s + 4);
                bf16x8 ah, al;
#pragma unroll
                for (int i = 0; i < 8; ++i) { const float x = i < 4 ? x0[i] : x1[i - 4]; const unsigned hb = __float_as_uint(x) & 0xffff0000u; ah[i] = (short)(hb >> 16); al[i] = (short)f2bf(x - __uint_as_float(hb)); }
                acc0 = __builtin_amdgcn_mfma_f32_16x16x32_bf16(ah, rwh[s][0], acc0, 0, 0, 0); acc1 = __builtin_amdgcn_mfma_f32_16x16x32_bf16(ah, rwh[s][1], acc1, 0, 0, 0);
                acc0 = __builtin_amdgcn_mfma_f32_16x16x32_bf16(ah, rwl[s][0], acc0, 0, 0, 0); acc1 = __builtin_amdgcn_mfma_f32_16x16x32_bf16(ah, rwl[s][1], acc1, 0, 0, 0);
                acc0 = __builtin_amdgcn_mfma_f32_16x16x32_bf16(al, rwh[s][0], acc0, 0, 0, 0); acc1 = __builtin_amdgcn_mfma_f32_16x16x32_bf16(al, rwh[s][1], acc1, 0, 0, 0); }
#pragma unroll
            for (int r = 0; r < 4; ++r) { part[(wave * 16 + 4 * (lane >> 4) + r) * 32 + (lane & 15)] = acc0[r]; part[(wave * 16 + 4 * (lane >> 4) + r) * 32 + 16 + (lane & 15)] = acc1[r]; }
        }
        __syncthreads();
        {
            const int lr = 2 * wave + (lane >> 5), e = lane & 31, t = grp * 16 + lr;
            float lg = rbe;
#pragma unroll
            for (int w = 0; w < 8; ++w) lg += part[(w * 16 + lr) * 32 + e];
            float cur = lg, tv[4]; int ti[4];
#pragma unroll
            for (int k = 0; k < 4; ++k) { float bv = cur; int bi = e;
#pragma unroll
                for (int o = 1; o < 32; o <<= 1) { const float ov = __shfl_xor(bv, o); const int oi = __shfl_xor(bi, o); if (ov > bv || (ov == bv && oi < bi)) { bv = ov; bi = oi; } }
                tv[k] = bv; ti[k] = bi; if (bi == e) cur = -3.0e38f; }
            const float e1 = __expf(tv[1] - tv[0]), e2 = __expf(tv[2] - tv[0]), e3 = __expf(tv[3] - tv[0]);
            const float inv = 1.f / (1.f + e1 + e2 + e3);
            if (e < 4) { const float wk = (e == 0 ? 1.f : (e == 1 ? e1 : (e == 2 ? e2 : e3))) * inv; const int ek = (e == 0 ? ti[0] : (e == 1 ? ti[1] : (e == 2 ? ti[2] : ti[3])));
                const int pair = t * 4 + e;
                pw[pair] = wk;
                const int rank = __hip_atomic_fetch_add((LAS int*)&lcnt[ek], 1, __ATOMIC_RELAXED, __HIP_MEMORY_SCOPE_WORKGROUP);
                rec[lr * 4 + e] = ek | (rank << 8); }
        }
        __syncthreads();
        if (tid < 32) { const int n = lcnt[tid]; pend = n ? (int)atomicAdd(&cnt[tid], (unsigned)n) : 0; lcnt[tid] = 0; }
        pgrp = grp;
    }
    if (pgrp >= 0) { __syncthreads(); if (tid < 32) lbase[tid] = pend; __syncthreads();
        if (tid < 64) { const int rc = rec[tid], ek = rc & 255, rank = rc >> 8, pos = lbase[ek] + rank, pair = (pgrp * 16 + (tid >> 2)) * 4 + (tid & 3);
            list[(size_t)ek * CAP + pos] = pair; ploc[pair] = ek | (pos << 5); } }
#undef RT_LOAD
}
}

__device__ __forceinline__ void p_final(const Args& a, LAS unsigned char* lds) {
    const int tid = threadIdx.x, lane = tid & 63, wave = tid >> 6;
    const bf16_t* xm = (const bf16_t*)(a.ws + WS_PRE1); const unsigned char* slots = (const unsigned char*)(a.ws + WS_SLOTS); const float* mod = (const float*)(a.ws + WS_MOD);
    const int* ploc = (const int*)(a.ws + WS_PLOC); const float* pw = (const float*)(a.ws + WS_PW);
    const f32x4* g2 = (const f32x4*)a.in[I_LN2G]; const f32x4* b2 = (const f32x4*)a.in[I_LN2B];
    LAS int* tstart = (LAS int*)lds;
    __syncthreads();
    if (tid == 0) { const unsigned* cnt = (const unsigned*)(a.ws + WS_CNT); int nrt = 0; for (int e = 0; e < NE; ++e) { tstart[e] = 256 * nrt; nrt += ((int)cnt[e] + 255) >> 8; } }
    LAS f32x4* Lg2 = (LAS f32x4*)(lds + 1024); LAS f32x4* Lb2 = Lg2 + 256; LAS f32x4* Lgt = Lb2 + 256;
    if (tid < 256) { Lg2[tid] = g2[tid]; Lb2[tid] = b2[tid]; }
    for (int i = tid; i < 4 * 256; i += NTHREADS) Lgt[i] = ((const f32x4*)(mod + (i >> 8) * 6144 + 5 * 1024))[i & 255];
    __syncthreads();
    const int tstep = gridDim.x * NWAVES; int t = blockIdx.x * NWAVES + wave;
    if (t < T) {
        int plc[4], pln[4]; float wc_[4], wn_[4]; unsigned qc[4][4], qn[4][4]; u32x2 xc[4], xn[4];
#define PF_IDX(tt, pl, ww) do { _Pragma("unroll") for (int sl = 0; sl < 4; ++sl) { pl[sl] = ploc[(tt) * 4 + sl]; ww[sl] = pw[(tt) * 4 + sl] * (1.f / gm::S_SL); } } while (0)
#define PF_DATA(tt, pl, qq, xx) do { _Pragma("unroll") for (int sl = 0; sl < 4; ++sl) { const unsigned* sr_ = (const unsigned*)(slots + (size_t)(tstart[pl[sl] & 31] + (pl[sl] >> 5)) * D) + lane; \
            _Pragma("unroll") for (int j = 0; j < 4; ++j) qq[sl][j] = sr_[64 * j]; } \
        { const u32x2* xr_ = (const u32x2*)(xm + (size_t)(tt) * D) + lane; _Pragma("unroll") for (int j = 0; j < 4; ++j) xx[j] = xr_[64 * j]; } } while (0)
        PF_IDX(t, plc, wc_); PF_DATA(t, plc, qc, xc);
        int tn = t + tstep; const bool hn0 = tn < T;
        if (hn0) PF_IDX(tn, pln, wn_);
        for (;;) {
            const bool hn = tn < T;
            if (hn) PF_DATA(tn, pln, qn, xn);
            int pl2[4]; float w2[4]; const int tn2 = tn + tstep; const bool hn2 = hn && tn2 < T;
            if (hn2) PF_IDX(tn2, pl2, w2);
            {
                const int b = t >> 13; const LAS f32x4* gt = Lgt + b * 256;
                f32x4 v[4]; float s = 0.f;
#pragma unroll
                for (int j = 0; j < 4; ++j) { f32x4 y = {0.f, 0.f, 0.f, 0.f};
#pragma unroll
                    for (int sl = 0; sl < 4; ++sl) { const int q = (int)qc[sl][j];
                        y[0] += wc_[sl] * __builtin_amdgcn_cvt_f32_fp8(q, 0); y[1] += wc_[sl] * __builtin_amdgcn_cvt_f32_fp8(q, 1); y[2] += wc_[sl] * __builtin_amdgcn_cvt_f32_fp8(q, 2); y[3] += wc_[sl] * __builtin_amdgcn_cvt_f32_fp8(q, 3); }
                    const f32x4 xv = {bflo(xc[j].x), bfhi(xc[j].x), bflo(xc[j].y), bfhi(xc[j].y)};
                    v[j] = xv * ALPHA + gt[64 * j + lane] * y; s += (v[j][0] + v[j][1]) + (v[j][2] + v[j][3]); }
                const float mean = wave_sum(s) * (1.f / D); float s2 = 0.f;
#pragma unroll
                for (int j = 0; j < 4; ++j) { v[j] = v[j] - mean; s2 += (v[j][0] * v[j][0] + v[j][1] * v[j][1]) + (v[j][2] * v[j][2] + v[j][3] * v[j][3]); }
                const float rstd = 1.f / sqrtf(wave_sum(s2) * (1.f / D) + LN_EPS);
                f32x4* o = (f32x4*)(a.out + (size_t)t * D) + lane;
#pragma unroll
                for (int j = 0; j < 4; ++j) o[64 * j] = v[j] * rstd * Lg2[64 * j + lane] + Lb2[64 * j + lane];
            }
            if (!hn) break;
            t = tn; tn = tn2;
#pragma unroll
            for (int sl = 0; sl < 4; ++sl) { plc[sl] = pln[sl]; wc_[sl] = wn_[sl]; pln[sl] = pl2[sl]; wn_[sl] = w2[sl];
#pragma unroll
                for (int j = 0; j < 4; ++j) qc[sl][j] = qn[sl][j]; }
#pragma unroll
            for (int j = 0; j < 4; ++j) xc[j] = xn[j];
        }
#undef PF_IDX
#undef PF_DATA
    }
}


constexpr int N_PHASES = 11;
__global__ void __launch_bounds__(NTHREADS, 2) mega_fwd(Args a) {
    extern __shared__ __attribute__((aligned(16))) unsigned char lds_raw[];
    LAS unsigned char* lds = (LAS unsigned char*)lds_raw;
    const int tid = threadIdx.x;
    volatile LAS unsigned* misc = (volatile LAS unsigned*)(lds + LDS_MISC);
    if (tid < 4) misc[tid] = 0u;
    __syncthreads();
    XcdBarrier bar; bar.bar = (unsigned*)(a.ws + WS_BAR); bar.x = 0; bar.st = misc;
    const bool multi = (a.ph_hi - a.ph_lo) > 1;
    if (multi) bar = xcd_barrier_post((unsigned*)(a.ws + WS_BAR), misc);
    const int lo = a.ph_lo, hi = a.ph_hi;
#define vcu ((gridDim.x % 8 == 0) ? (int)((blockIdx.x % 8) * (gridDim.x / 8) + blockIdx.x / 8) : (int)blockIdx.x)
#ifdef ONLY_PHASE
#define IN(k) ((k) == ONLY_PHASE && lo <= (k) && (k) < hi)
#else
#define IN(k) (lo <= (k) && (k) < hi)
#endif
#define SEAM(k) do { if (IN(k) && IN((k) + 1)) xcd_barrier(bar); } while (0)

#ifndef REPEAT_PHASE
#define REPEAT_PHASE -1
#endif
#ifdef PROF_REP
#define RUNPH(k, ...) do { if (IN(k)) { const int nrep_ = (a.rep_k == (k)) ? 2 : 1; for (int rep_ = 0; rep_ < nrep_; ++rep_) { if (rep_) xcd_barrier(bar); __VA_ARGS__; } } } while (0)
#else
#define RUNPH(k, ...) do { if (IN(k)) { __VA_ARGS__; if (REPEAT_PHASE == (k)) { xcd_barrier(bar); __VA_ARGS__; } } } while (0)
#endif
    RUNPH(0, p0_mod_and_filter(a, lds));
    SEAM(0);
    RUNPH(1, p1_prep(a, lds));
    SEAM(1);
    RUNPH(2, { gm::SchedIn S{a.ws, (int)gridDim.x, vcu, a.in[I_BAF], a.in[I_BAB]}; gm::EpiIn E{a.ws}; gm::gemm_stream<false, 0, false>(lds, S, E);
        {
          const int G = (int)gridDim.x, rounds = (1812 + G - 1) / G, extra = 1812 - (rounds - 1) * G, v = vcu;
          if (v >= extra || extra == G) { const int nidle = (extra == G) ? G : G - extra, ridle = (extra == G) ? v : v - extra; __syncthreads();
              prep_items(a, (LAS float*)(lds + (tid >> 6) * 16384), PREP_NITEMS - PREP_DEFER, PREP_NITEMS, ridle * NWAVES + (tid >> 6), nidle * NWAVES, tid & 63); } } });
    SEAM(2);
    RUNPH(3, { for (int u = blockIdx.x; u < 16 * NCT; u += gridDim.x) gla::g1_unit(a, lds, u / NCT, u % NCT); });
    SEAM(3);
    RUNPH(4, { gla::g2_scan(a);
        hy::CvState cvs; cvs.jb.mi = -1; cvs.next = (int)blockIdx.x * NWAVES + (tid >> 6); cvs.stride = (int)gridDim.x * NWAVES; cvs.end = hy::CV_SPLIT;
        for (int c = blockIdx.x; c < HYW; c += gridDim.x) hy::channel(a, lds, c, a.ws + WS_HSPEC + (size_t)blockIdx.x * HSPEC_PER_WG, cvs);
        while (cvs.jb.mi >= 0 || cvs.next < cvs.end) hy::cv_step(a, cvs, tid & 63); });
    SEAM(4);
    RUNPH(5, { hy::CvState cvs; cvs.jb.mi = -1; cvs.stride = (int)gridDim.x * NWAVES; cvs.end = hy::CV_ITEMS;
        { const int w0_ = (int)blockIdx.x * NWAVES + (tid >> 6), half_ = hy::CV_SPLIT; cvs.next = half_ + ((w0_ - half_ % cvs.stride) % cvs.stride + cvs.stride) % cvs.stride; }
        { int u = blockIdx.x; gla::G3In cur, nxt;
            if (u < 16 * NCHUNK) { gla::g3_load(a, u >> 7, u & 127, cur);
                for (;;) { const int un = u + (int)gridDim.x; const bool hn = un < 16 * NCHUNK; if (hn) gla::g3_load(a, un >> 7, un & 127, nxt);
                    gla::g3_unit(a, lds, u >> 7, u & 127, cur, cvs); if (!hn) break; cur = nxt; u = un; } } }
        while (cvs.jb.mi >= 0 || cvs.next < cvs.end) hy::cv_step(a, cvs, tid & 63);
        const int wave = tid >> 6;
        for (int it = blockIdx.x * NWAVES + wave; it < 4096; it += gridDim.x * NWAVES) hy::transpose_item(a, it, tid & 63); });
    SEAM(5);
    RUNPH(6, { gm::SchedOut S{a.ws, (int)gridDim.x, vcu}; gm::EpiOut E{a.ws}; gm::gemm_stream<false, 0, false>(lds, S, E); });
    SEAM(6);
    RUNPH(7, rt::phase(a, lds));
    SEAM(7);
    if (IN(8) || IN(9)) {
        LAS int* tab = (LAS int*)(lds + gm::LDS_TAB);
        __syncthreads();
        if (tid == 0) { const unsigned* cnt = (const unsigned*)(a.ws + WS_CNT); int nrt = 0;
            for (int e = 0; e < NE; ++e) { const int n = (int)cnt[e]; tab[e] = n; const int nt = (n + 255) >> 8; for (int k = 0; k < nt; ++k) tab[64 + nrt + k] = e | (k << 8); nrt += nt; }
            tab[32] = nrt; }
        __syncthreads();
    }
    RUNPH(8, { gm::SchedMoe<1> S{a.ws, (const LAS int*)(lds + gm::LDS_TAB), (int)gridDim.x, vcu, a.in[I_EB2]}; gm::EpiMoe1 E{a.ws}; gm::gemm_stream<true, 2, true>(lds, S, E); });
    SEAM(8);
    RUNPH(9, { gm::SchedMoe<2> S{a.ws, (const LAS int*)(lds + gm::LDS_TAB), (int)gridDim.x, vcu, a.in[I_EB2]}; gm::EpiMoe2 E{a.ws}; gm::gemm_stream<false, 0, true>(lds, S, E); });
    SEAM(9);
    RUNPH(10, p_final(a, lds));
#undef RUNPH
#undef vcu
#undef IN
#undef SEAM
}

extern "C" void kernel_launch(void* const* d_in, const int* in_sizes, int n_in, void* d_out, int out_size, void* d_ws, size_t ws_size, hipStream_t stream) {
    static int grid = 0;
    if (grid == 0) {
        if (n_in != 32 || out_size != T * D || ws_size < WS_END) { fprintf(stderr, "kernel_launch: unexpected shapes (n_in %d out %d ws %zu need %zu)\n", n_in, out_size, ws_size, (size_t)WS_END); grid = -1; return; }
        int dev = 0, cus = 0;
        if (hipGetDevice(&dev) != hipSuccess || hipDeviceGetAttribute(&cus, hipDeviceAttributeMultiprocessorCount, dev) != hipSuccess) { grid = -1; return; }
        if (hipFuncSetAttribute((const void*)mega_fwd, hipFuncAttributeMaxDynamicSharedMemorySize, LDS_BYTES) != hipSuccess) { fprintf(stderr, "kernel_launch: hipFuncSetAttribute failed\n"); grid = -1; return; }
        int per_cu = 0;
        if (hipOccupancyMaxActiveBlocksPerMultiprocessor(&per_cu, (const void*)mega_fwd, NTHREADS, LDS_BYTES) != hipSuccess || per_cu < 1) fprintf(stderr, "kernel_launch: occupancy query says %d\n", per_cu);
        (void)hipGetLastError();
        grid = cus;
        if (grid > MAX_GRID) grid = MAX_GRID;
    }
    if (grid < 0) return;
    (void)hipMemsetAsync(d_ws, 0, WS_ZERO_BYTES, stream);
    Args a{};
    for (int i = 0; i < 32; ++i) a.in[i] = (const float*)d_in[i];
    a.out = (float*)d_out; a.ws = (unsigned char*)d_ws;
#ifdef DBG
    (void)hipMemsetAsync((char*)d_ws + WS_DBG, 0, 512, stream);
    for (int p = 0; p < N_PHASES; ++p) { a.ph_lo = p; a.ph_hi = p + 1; hipLaunchKernelGGL(mega_fwd, dim3(grid), dim3(NTHREADS), LDS_BYTES, stream, a);
        hipLaunchKernelGGL(dbg_check, dim3(64), dim3(512), 0, stream, a, p); }
    hipLaunchKernelGGL(dbg_encode, dim3(1024), dim3(256), 0, stream, a);
#elif N_LAUNCH_PER_PHASE
    for (int p = 0; p < N_PHASES; ++p) { a.ph_lo = p; a.ph_hi = p + 1; hipLaunchKernelGGL(mega_fwd, dim3(grid), dim3(NTHREADS), LDS_BYTES, stream, a); }
#else
    a.ph_lo = 0; a.ph_hi = N_PHASES;
#ifdef PROF_REP
    a.rep_k = PROF_REP;
#endif
    hipLaunchKernelGGL(mega_fwd, dim3(grid), dim3(NTHREADS), LDS_BYTES, stream, a);
#endif
}
```

```cpp
#include <hip/hip_runtime.h>
#include <cstdio>
#include <cstdint>
#include <cstddef>

#define LAS __attribute__((address_space(3)))
#define GAS __attribute__((address_space(1)))
typedef unsigned short bf16_t;
typedef short bf16x8 __attribute__((ext_vector_type(8)));
typedef float f32x4 __attribute__((ext_vector_type(4)));
typedef float f32x2 __attribute__((ext_vector_type(2)));
typedef unsigned u32x4 __attribute__((ext_vector_type(4)));
typedef unsigned u32x2 __attribute__((ext_vector_type(2)));

#ifndef N_LAUNCH_PER_PHASE
#define N_LAUNCH_PER_PHASE 0
#endif

constexpr int D = 1024, NB = 4, SEQ = 8192, T = NB * SEQ, CTXL = 256, TC = NB * CTXL, TT = T + TC;
constexpr int NH = 4, DK = 64, DV = 128, CH = 64, NCHUNK = SEQ / CH, NCC = CTXL / CH, NCT = NCHUNK + NCC;
constexpr int HYW = 512, HYC = 3 * HYW, INW = 3104;
constexpr int NE = 32, DE = 1024, CAP = T;
constexpr float LN_EPS = 1e-6f, ALPHA = 1.189207115002721f;
constexpr int NTHREADS = 512, NWAVES = 8;
constexpr int FFTN = 16384;

constexpr size_t al256(size_t x) { return (x + 255) & ~(size_t)255; }
constexpr size_t WS_BAR   = 0;
constexpr size_t WS_MOD   = 16384;
constexpr size_t WS_CNT   = WS_MOD + 5 * 6144 * 4;
constexpr size_t WS_ZERO_BYTES = al256(WS_CNT + 256);
constexpr size_t WS_LIST  = 262144;
constexpr size_t WS_PW    = WS_LIST + (size_t)NE * CAP * 4;
constexpr size_t WS_PLOC  = WS_PW + (size_t)T * 4 * 4;
constexpr size_t WS_B1R   = WS_PLOC + (size_t)T * 4 * 4;
constexpr size_t WS_HID2  = WS_B1R + (size_t)NE * 2048 * 4;
constexpr size_t WS_BTIN  = WS_HID2 + (size_t)SEQ * 64 * 4;
constexpr size_t WS_BTOUT = WS_BTIN + (size_t)3584 * 1024 * 2;
constexpr size_t WS_W1T   = WS_BTOUT + (size_t)1024 * 1024 * 2;
constexpr size_t WS_W2T   = WS_W1T + (size_t)NE * 2048 * 1024 * 2;
constexpr size_t WS_PRE1  = WS_W2T + (size_t)NE * 1024 * 1024 * 2;
constexpr size_t WS_RA    = WS_PRE1 + (size_t)T * 1024 * 4;
constexpr size_t WS_H     = WS_RA;
constexpr size_t WS_Q     = WS_H + (size_t)TT * 1024 * 2;
constexpr size_t WS_K     = WS_Q + (size_t)T * 256 * 2;
constexpr size_t WS_V     = WS_K + (size_t)TT * 256 * 2;
constexpr size_t WS_G     = WS_V + (size_t)TT * 512 * 2;
constexpr size_t WS_GF    = WS_G + (size_t)T * 512 * 2;
constexpr size_t WS_GB    = WS_GF + (size_t)TT * 256 * 4;
constexpr size_t WS_UT    = WS_GB + (size_t)TT * 256 * 4;
constexpr size_t WS_RA_END= WS_UT + (size_t)NB * HYC * SEQ * 2;
constexpr size_t WS_H2    = WS_RA;
constexpr size_t WS_FG    = WS_RA + (size_t)T * 1024 * 2;
constexpr size_t WS_SLOTS = WS_RA;
constexpr size_t SORTED_BYTES_ = (size_t)(T * 4 / 256 + NE) * 256 * 1024 * 2;
constexpr size_t WS_RB    = al256(WS_RA_END > WS_RA + SORTED_BYTES_ ? WS_RA_END : WS_RA + SORTED_BYTES_);
constexpr size_t WS_KV    = WS_RB;
constexpr size_t WS_AV    = WS_KV + (size_t)2 * 16 * NCT * 8192 * 2;
constexpr size_t WS_SP    = WS_AV + (size_t)2 * 16 * NCT * 64 * 4;
constexpr size_t WS_HSPEC = WS_SP + (size_t)2 * 16 * NCHUNK * 8192 * 2;
constexpr size_t HSPEC_PER_WG = (size_t)2 * FFTN * 8;
constexpr int MAX_GRID = 256;
constexpr size_t WS_YHYT  = WS_HSPEC + (size_t)MAX_GRID * HSPEC_PER_WG;
constexpr size_t WS_MIX   = WS_YHYT + (size_t)NB * HYW * SEQ * 2;
constexpr size_t WS_RB_END= WS_MIX + (size_t)T * 1024 * 2;
constexpr size_t WS_HF    = WS_MIX;
constexpr size_t WS_ACT   = WS_RB;
constexpr size_t SORTED_BYTES = (size_t)(T * 4 / 256 + NE) * 256 * 1024 * 2;
constexpr size_t WS_END   = al256(WS_RB_END > WS_RB + SORTED_BYTES ? WS_RB_END : WS_RB + SORTED_BYTES);

constexpr int LDS_BYTES = 147456;
constexpr int LDS_MISC  = 145408;

typedef __bf16 bf16n2 __attribute__((ext_vector_type(2)));
__device__ __forceinline__ unsigned pk2(float lo, float hi) { bf16n2 v = {(__bf16)lo, (__bf16)hi}; return __builtin_bit_cast(unsigned, v); }
__device__ __forceinline__ bf16_t f2bf(float f) { __bf16 b = (__bf16)f; return __builtin_bit_cast(unsigned short, b); }
__device__ __forceinline__ float bf2f(bf16_t b) { return __uint_as_float(((unsigned)b) << 16); }
__device__ __forceinline__ float bflo(unsigned w) { return __uint_as_float(w << 16); }
__device__ __forceinline__ float bfhi(unsigned w) { return __uint_as_float(w & 0xffff0000u); }
__device__ __forceinline__ float wave_sum(float v) {
#pragma unroll
    for (int o = 1; o < 64; o <<= 1) v += __shfl_xor(v, o);
    return v;
}
__device__ __forceinline__ float silu_f(float x) { return x * __builtin_amdgcn_rcpf(1.f + __expf(-x)); }
__device__ __forceinline__ float log_sigmoid_f(float z) { return fminf(z, 0.f) - __logf(1.f + __expf(-fabsf(z))); }

#define XB_TMO      128
#define XB_XCNT(j)  (256  + 64 * (j))
#define XB_XSUB(j)  (1280 + 64 * (j))
#define XB_XGEN(j)  (2304 + 64 * (j))
#define XB_TOP      3328
#define XB_TOPGEN   3392
#define XCD_BAR_WORDS 3456
#define XB_SPIN_CAP (1u << 22)
__device__ __forceinline__ unsigned xb_ld(unsigned* p)              { return __hip_atomic_load(p, __ATOMIC_RELAXED, __HIP_MEMORY_SCOPE_AGENT); }
__device__ __forceinline__ unsigned xb_add(unsigned* p, unsigned v) { return __hip_atomic_fetch_add(p, v, __ATOMIC_RELAXED, __HIP_MEMORY_SCOPE_AGENT); }
__device__ __forceinline__ unsigned xb_xcc_id() { return (unsigned)__builtin_amdgcn_s_getreg((3 << 11) | 20) & 0xFu; }
#define XB_SPIN(cond, bar) do { unsigned _sp = 0; while (cond) { __builtin_amdgcn_s_sleep(1); \
    if ((++_sp & 255u) == 0u) { if (xb_ld(&(bar)[XB_TMO])) break; if (_sp > XB_SPIN_CAP) { atomicAdd(&(bar)[XB_TMO], 1u); break; } } } } while (0)
struct XcdBarrier { unsigned* bar; unsigned x; volatile LAS unsigned* st; };
__device__ __forceinline__ XcdBarrier xcd_barrier_post(unsigned* bar, volatile LAS unsigned* st) {
    XcdBarrier b; b.bar = bar; b.x = xb_xcc_id(); b.st = st;
    if (threadIdx.x == 0) (void)xb_add(&bar[XB_XCNT(b.x)], 1u);
    return b;
}
__device__ __forceinline__ void xcd_barrier_complete(unsigned* bar, unsigned x, unsigned& nloc, unsigned& nx) {
    const unsigned G = gridDim.x * gridDim.y * gridDim.z;
    unsigned sum, cnt, mine, sp = 0u;
    for (;;) {
        sum = 0u; cnt = 0u; mine = 0u;
#pragma unroll
        for (unsigned j = 0; j < 16; ++j) { const unsigned c = xb_ld(&bar[XB_XCNT(j)]); sum += c; cnt += (c > 0u) ? 1u : 0u; mine = (j == x) ? c : mine; }
        if (sum == G) break;
        __builtin_amdgcn_s_sleep(1);
        if ((++sp & 255u) == 0u) { if (xb_ld(&bar[XB_TMO])) break; if (sp > XB_SPIN_CAP) { atomicAdd(&bar[XB_TMO], 1u); break; } }
    }
    nloc = mine > 0u ? mine : 1u; nx = cnt > 0u ? cnt : 1u;
}
__device__ __forceinline__ void xcd_barrier(const XcdBarrier& b) {
    asm volatile("s_waitcnt vmcnt(0)" ::: "memory");
    __syncthreads();
    if (threadIdx.x == 0) {
        unsigned* bar = b.bar;
        __builtin_amdgcn_s_waitcnt(0);
        unsigned nloc = b.st[0], nx = b.st[1];
        if (nloc == 0u) { xcd_barrier_complete(bar, b.x, nloc, nx); b.st[0] = nloc; b.st[1] = nx; }
        const unsigned old = xb_add(&bar[XB_XSUB(b.x)], 1u);
        const unsigned gen = old / nloc;
        if (old + 1u == (gen + 1u) * nloc) {
            __builtin_amdgcn_fence(__ATOMIC_RELEASE, "agent");
            asm volatile("s_waitcnt vmcnt(0)" ::: "memory");
            const unsigned og = xb_add(&bar[XB_TOP], 1u);
            const unsigned tg = og / nx;
            if (og + 1u == (tg + 1u) * nx) xb_add(&bar[XB_TOPGEN], 1u);
            else XB_SPIN(xb_ld(&bar[XB_TOPGEN]) == tg, bar);
            __builtin_amdgcn_fence(__ATOMIC_ACQUIRE, "agent");
            xb_add(&bar[XB_XGEN(b.x)], 1u);
            asm volatile("s_waitcnt vmcnt(0)" ::: "memory");
        } else {
            XB_SPIN(xb_ld(&bar[XB_XGEN(b.x)]) == gen, bar);
            __builtin_amdgcn_fence(__ATOMIC_ACQUIRE, "agent");
            asm volatile("s_waitcnt vmcnt(0)" ::: "memory");
        }
    }
    __syncthreads();
}

struct Args {
    const float* in[32];
    float* out;
    unsigned char* ws;
    int ph_lo, ph_hi;
    int rep_k, pad_;
};
enum { I_X = 0, I_C, I_CTX, I_CCTX, I_ADAW, I_ADAB, I_WIN, I_WAF, I_BAF, I_WAB, I_BAB, I_NORMG, I_CONVW, I_CONVB, I_FW1, I_FB1, I_FW2, I_FB2, I_FWOUT, I_FFREQ,
       I_BIASD, I_WOUT, I_LN1G, I_LN1B, I_RW, I_RB, I_EW1, I_EB1, I_EW2, I_EB2, I_LN2G, I_LN2B };


namespace gm {
constexpr int BM = 256, BK = 64, HALF = 128, HTB = HALF * BK * 2, STAGE_BYTES = 8 * HTB, KD = 1024, NT = KD / BK;
constexpr int ROWB = KD * 2;
typedef int i32x8 __attribute__((ext_vector_type(8)));
__device__ __forceinline__ int gray2(int q) { return q ^ (q >> 1); }
__device__ __forceinline__ int lds_off8(int r, int fq) { const int rr = r & 15; return ((r >> 4) * 2 + (fq >> 1)) * 1024 + rr * 64 + 16 * ((2 * (fq & 1)) ^ gray2(rr >> 2)); }
__device__ __forceinline__ void stage_rc8(int b, int& R, int& C) { const int st = b / 1024, sb = b % 1024, swz = sb ^ (gray2((sb >> 8) & 3) << 4); R = (st >> 1) * 16 + swz / 64; C = (st & 1) * 32 + (swz % 64) / 2; }
__device__ __forceinline__ int lds_byte(int r, int c) { const int st = (r >> 4) * 2 + (c >> 5), rr = r & 15, cc = c & 31, ob = rr * 64 + cc * 2; return st * 1024 + (ob ^ (((ob >> 9) & 1) << 5)); }
__device__ __forceinline__ void stage_rc(int b, int& R, int& C) { const int st = b / 1024, sb = b % 1024, swz = sb ^ (((sb >> 9) & 1) << 5); R = (st >> 1) * 16 + swz / 64; C = (st & 1) * 32 + (swz % 64) / 2; }
__device__ __forceinline__ int perm32(int rho) { const int n = rho >> 4, i = rho & 15; return 8 * (i >> 2) + 4 * n + (i & 3); }

constexpr int LDS_BIAS = STAGE_BYTES + 4096;
struct Unit {
    const char* A;
    const char* B;
    const int* list;
    int type, row0, col0, valid, aux;
};

__device__ __forceinline__ i32x8 cat8(bf16x8 lo, bf16x8 hi) { typedef int i32x4 __attribute__((ext_vector_type(4))); const i32x4 a = __builtin_bit_cast(i32x4, lo), b = __builtin_bit_cast(i32x4, hi); return (i32x8){a[0], a[1], a[2], a[3], b[0], b[1], b[2], b[3]}; }
template <bool GATHER, int GSHIFT, int RB, bool FP8>
__device__ __forceinline__ void a_offsets(const Unit& u, unsigned (&o)[2][2]) {
    int R[2], Cb[2];
    int tz = threadIdx.x; asm volatile("" : "+v"(tz));
#pragma unroll
    for (int i = 0; i < 2; ++i) { int r, c; if (FP8) stage_rc8(tz * 16 + i * 8192, r, c); else stage_rc(tz * 16 + i * 8192, r, c); R[i] = r; Cb[i] = c * 2; }
#pragma unroll
    for (int h = 0; h < 2; ++h)
#pragma unroll
        for (int i = 0; i < 2; ++i) {
            const int r = h * HALF + R[i];
            if (!GATHER) o[h][i] = (unsigned)(r * RB + Cb[i]);
            else { const int idx = u.list[r < u.valid ? r : 0]; o[h][i] = (unsigned)(idx >> GSHIFT) * (unsigned)RB + (unsigned)Cb[i]; }
        }
}

template <bool GATHER, int GSHIFT, bool FP8, class Sched, class Epi>
__device__ __forceinline__ void gemm_stream(LAS unsigned char* lds, const Sched& S, const Epi& E) {
    constexpr int RB = FP8 ? KD : ROWB, NTL = FP8 ? NT / 2 : NT;
    const int tid = threadIdx.x, wid = __builtin_amdgcn_readfirstlane(tid >> 6), lane = tid & 63, wr = wid >> 2, wc = wid & 3, fr = lane & 15, fq = lane >> 4;
    unsigned voffB[2], voffA[2];
#pragma unroll
    for (int i = 0; i < 2; ++i) { int r, c; if (FP8) stage_rc8(tid * 16 + i * 8192, r, c); else stage_rc(tid * 16 + i * 8192, r, c); const int rb = (r & ~31) + perm32(r & 31); voffB[i] = (unsigned)(rb * RB + c * 2); voffA[i] = (unsigned)(r * RB + c * 2); }
    const size_t kstep = (size_t)(BK * 2), hstep = (size_t)HALF * RB;
    const unsigned ldsw = (unsigned)wid * 1024u;
    const int aoff = FP8 ? lds_off8(wr * 64 + fr, fq) : lds_byte(wr * 64 + fr, fq * 8), boff = FP8 ? lds_off8(wc * 32 + fr, fq) : lds_byte(wc * 32 + fr, fq * 8);
    const int aoffh = aoff ^ 16, boffh = boff ^ 16;
#define GM_SA(b, h) (((b) * 2 + (h)) * HTB)
#define GM_SB(b, h) ((4 + (b) * 2 + (h)) * HTB)
#define GM_STAGE(bufoff, gbase, vo0, vo1) do { \
        __builtin_amdgcn_global_load_lds((const unsigned*)((const char*)(gbase) + (vo0)), (LAS unsigned*)(lds + (bufoff) + ldsw), 16, 0, 0); \
        __builtin_amdgcn_global_load_lds((const unsigned*)((const char*)(gbase) + (vo1)), (LAS unsigned*)(lds + (bufoff) + ldsw + 8192), 16, 0, 0); } while (0)
#define GM_STAGE_A(bufoff, gbase, h, o0, o1) do { if constexpr (GATHER) GM_STAGE(bufoff, gbase, o0, o1); else GM_STAGE(bufoff, (gbase) + (h) * hstep, voffA[0], voffA[1]); } while (0)
#define GM_LD32(p, ol, oh) ({ const i32x4 lo_ = *(const LAS i32x4*)((p) + (ol)), hi_ = *(const LAS i32x4*)((p) + (oh)); (i32x8){lo_[0], lo_[1], lo_[2], lo_[3], hi_[0], hi_[1], hi_[2], hi_[3]}; })
#define GM_LDA(dst, b, h) do { if constexpr (FP8) { _Pragma("unroll") for (int m = 0; m < 4; ++m) dst##8[m] = GM_LD32(lds + GM_SA(b, h) + m * 2048, aoff, aoffh); } \
        else { _Pragma("unroll") for (int m = 0; m < 4; ++m) _Pragma("unroll") for (int k = 0; k < 2; ++k) dst[m][k] = *(const LAS bf16x8*)(lds + GM_SA(b, h) + aoff + m * 2048 + k * 1024); } } while (0)
#define GM_LDB(dst, b, h) do { if constexpr (FP8) { _Pragma("unroll") for (int n = 0; n < 2; ++n) dst##8[n] = GM_LD32(lds + GM_SB(b, h) + n * 2048, boff, boffh); } \
        else { _Pragma("unroll") for (int n = 0; n < 2; ++n) _Pragma("unroll") for (int k = 0; k < 2; ++k) dst[n][k] = *(const LAS bf16x8*)(lds + GM_SB(b, h) + boff + n * 2048 + k * 1024); } } while (0)
#define GM_MMA(ai, bj, At, Bt) do { __builtin_amdgcn_s_setprio(1); _Pragma("unroll") for (int m = 0; m < 4; ++m) _Pragma("unroll") for (int n = 0; n < 2; ++n) { \
        if constexpr (FP8) asm volatile("v_mfma_scale_f32_16x16x128_f8f6f4 %0, %1, %2, %0, %3, %3 op_sel_hi:[0,0,0]" : "+v"(acc[ai][bj][m][n]) : "v"(Bt##8[n]), "v"(At##8[m]), "v"(sc1_)); \
        else { _Pragma("unroll") for (int k = 0; k < 2; ++k) acc[ai][bj][m][n] = __builtin_amdgcn_mfma_f32_16x16x32_bf16(Bt[n][k], At[m][k], acc[ai][bj][m][n], 0, 0, 0); } } \
        __builtin_amdgcn_s_setprio(0); } while (0)
#define GM_WAIT_V(n) asm volatile("s_waitcnt vmcnt(" #n ")" ::: "memory")
#define GM_WAIT_L(n) asm volatile("s_waitcnt lgkmcnt(" #n ")" ::: "memory")
#define GM_BAR __builtin_amdgcn_s_barrier()
#define GM_SCHED __builtin_amdgcn_sched_barrier(0)
    Unit cur, nxt; int ui = 0;
    if (!S.next(0, cur)) return;
    f32x4 acc[2][2][4][2];
#pragma unroll
    for (int a = 0; a < 2; ++a)
#pragma unroll
        for (int b = 0; b < 2; ++b)
#pragma unroll
            for (int m = 0; m < 4; ++m)
#pragma unroll
                for (int n = 0; n < 2; ++n) acc[a][b][m][n] = (f32x4){0.f, 0.f, 0.f, 0.f};
    typedef int i32x4 __attribute__((ext_vector_type(4)));
    int sc1_ = 0x7f7f7f7f; asm volatile("" : "+v"(sc1_));
    bf16x8 At[4][2], B0[2][2], B1[2][2];
    i32x8 At8[4], B08[2], B18[2];
    unsigned ca[2][2], na[2][2];
    if constexpr (GATHER) a_offsets<GATHER, GSHIFT, RB, FP8>(cur, ca);
    const char* cA = cur.A; const char* cB = cur.B;
    GM_STAGE(GM_SB(0, 0), cB, voffB[0], voffB[1]); GM_STAGE_A(GM_SA(0, 0), cA, 0, ca[0][0], ca[0][1]); GM_STAGE(GM_SB(0, 1), cB + hstep, voffB[0], voffB[1]); GM_STAGE_A(GM_SA(0, 1), cA, 1, ca[1][0], ca[1][1]);
    if (wr == 1) GM_BAR;
    GM_WAIT_V(4); GM_BAR;
    GM_STAGE(GM_SB(1, 0), cB + kstep, voffB[0], voffB[1]); GM_STAGE_A(GM_SA(1, 0), cA + kstep, 0, ca[0][0], ca[0][1]); GM_STAGE(GM_SB(1, 1), cB + hstep + kstep, voffB[0], voffB[1]);
    GM_WAIT_V(6); GM_BAR;
    for (;;) {
        const bool has_next = S.next(ui + 1, nxt);
        if constexpr (GATHER) {
            if (has_next) a_offsets<GATHER, GSHIFT, RB, FP8>(nxt, na);
            else {
#pragma unroll
                for (int h = 0; h < 2; ++h)
#pragma unroll
                    for (int i = 0; i < 2; ++i) na[h][i] = ca[h][i];
            }
        }
        const char* nA = has_next ? nxt.A : cA; const char* nB = has_next ? nxt.B : cB;
        if (wid == 0)
            __builtin_amdgcn_global_load_lds((const unsigned*)(S.bias(cur) + 4 * lane), (LAS unsigned*)(lds + LDS_BIAS + (ui & 1) * 1024), 16, 0, 0);
        for (int t = 0; t < NTL; t += 2) {
            const bool last = (t == NTL - 2);

            const char* a1 = cA + (size_t)(t + 1) * kstep;
            const char* a2 = last ? nA : cA + (size_t)(t + 2) * kstep; const char* b2 = last ? nB : cB + (size_t)(t + 2) * kstep;
            const char* a3 = a2 + kstep; const char* b3 = b2 + kstep;
            unsigned x00 = 0, x01 = 0, x10 = 0, x11 = 0;
            if constexpr (GATHER) { x00 = last ? na[0][0] : ca[0][0]; x01 = last ? na[0][1] : ca[0][1]; x10 = last ? na[1][0] : ca[1][0]; x11 = last ? na[1][1] : ca[1][1]; }
            GM_LDB(B0, 0, 0); GM_SCHED; GM_LDA(At, 0, 0); GM_STAGE_A(GM_SA(1, 1), a1, 1, ca[1][0], ca[1][1]);
            GM_WAIT_L(8); GM_BAR; GM_WAIT_L(0); GM_MMA(0, 0, At, B0); GM_BAR; GM_SCHED;
            GM_LDB(B1, 0, 1); GM_STAGE(GM_SB(0, 0), b2, voffB[0], voffB[1]);
            GM_BAR; GM_WAIT_L(0); GM_MMA(0, 1, At, B1); GM_BAR;
            GM_LDA(At, 0, 1); GM_STAGE_A(GM_SA(0, 0), a2, 0, x00, x01);
            GM_BAR; GM_WAIT_L(0); GM_MMA(1, 0, At, B0); GM_BAR; GM_SCHED;
            GM_STAGE(GM_SB(0, 1), b2 + hstep, voffB[0], voffB[1]);
            GM_WAIT_V(6); GM_BAR; GM_MMA(1, 1, At, B1); GM_BAR;
            GM_LDB(B0, 1, 0); GM_SCHED; GM_LDA(At, 1, 0); GM_STAGE_A(GM_SA(0, 1), a2, 1, x10, x11);
            GM_WAIT_L(8); GM_BAR; GM_WAIT_L(0); GM_MMA(0, 0, At, B0); GM_BAR; GM_SCHED;
            GM_LDB(B1, 1, 1); GM_STAGE(GM_SB(1, 0), b3, voffB[0], voffB[1]);
            GM_BAR; GM_WAIT_L(0); GM_MMA(0, 1, At, B1); GM_BAR;
            GM_LDA(At, 1, 1); GM_STAGE_A(GM_SA(1, 0), a3, 0, x00, x01);
            GM_BAR; GM_WAIT_L(0); GM_MMA(1, 0, At, B0); GM_BAR; GM_SCHED;
            GM_STAGE(GM_SB(1, 1), b3 + hstep, voffB[0], voffB[1]);
            GM_WAIT_V(6); GM_BAR; GM_MMA(1, 1, At, B1); GM_BAR;
        }
        if constexpr (FP8) asm volatile("s_nop 7\n\ts_nop 7" ::: "memory");
        {
          int tz = threadIdx.x; asm volatile("" : "+v"(tz)); const int wz = tz >> 6, lz = tz & 63;
          E(acc, cur, wz >> 2, wz & 3, lz & 15, lz >> 4, (const LAS float*)(lds + LDS_BIAS + (ui & 1) * 1024)); }
        if (!has_next) break;
#pragma unroll
        for (int a = 0; a < 2; ++a)
#pragma unroll
            for (int b = 0; b < 2; ++b)
#pragma unroll
                for (int m = 0; m < 4; ++m)
#pragma unroll
                    for (int n = 0; n < 2; ++n) acc[a][b][m][n] = (f32x4){0.f, 0.f, 0.f, 0.f};
        cur = nxt; cA = nA; cB = nB; ++ui;
        if constexpr (GATHER) {
#pragma unroll
            for (int h = 0; h < 2; ++h)
#pragma unroll
                for (int i = 0; i < 2; ++i) ca[h][i] = na[h][i];
        }
    }
    GM_WAIT_V(0);
    if (wr == 0) GM_BAR;
    GM_BAR;
#undef GM_SA
#undef GM_SB
#undef GM_STAGE
#undef GM_STAGE_A
#undef GM_LD32
#undef GM_LDA
#undef GM_LDB
#undef GM_MMA
#undef GM_WAIT_V
#undef GM_WAIT_L
#undef GM_BAR
#undef GM_SCHED
}

__device__ __forceinline__ u32x4 pack8(f32x4 a, f32x4 b) { u32x4 w; w.x = pk2(a[0], a[1]); w.y = pk2(a[2], a[3]); w.z = pk2(b[0], b[1]); w.w = pk2(b[2], b[3]); return w; }

struct SchedIn {
    unsigned char* ws; int G, c; const float* baf; const float* bab;
    __device__ __forceinline__ bool next(int i, Unit& u) const {
        int L = i * G + c;
        u.list = nullptr; u.valid = 256; u.aux = 0;
        if (L < 768) {
            const int pa = L % 6, pb = L / 6;
            u.A = (const char*)(ws + WS_BTIN) + (size_t)(2048 + 256 * pa) * ROWB; u.B = (const char*)(ws + WS_H) + (size_t)(256 * pb) * ROWB;
            u.type = 2; u.row0 = 256 * pa; u.col0 = 256 * pb; return true;
        }
        L -= 768;
        if (L < 1024) {
            const int pm = L >> 3, pn = ((L & 7) + (L >> 8)) & 7;
            u.A = (const char*)(ws + WS_H) + (size_t)(256 * pm) * ROWB; u.B = (const char*)(ws + WS_BTIN) + (size_t)(256 * pn) * ROWB;
            u.type = pn < 6 ? 0 : 1; u.row0 = 256 * pm; u.col0 = pn; return true;
        }
        L -= 1024;
        if (L < 20) {
            const int pm = L / 5, j = L % 5, pn = j == 0 ? 1 : (j == 1 ? 2 : (j == 2 ? 3 : (j == 3 ? 6 : 7)));
            u.A = (const char*)(ws + WS_H) + (size_t)(T + 256 * pm) * ROWB; u.B = (const char*)(ws + WS_BTIN) + (size_t)(256 * pn) * ROWB;
            u.type = pn < 6 ? 0 : 1; u.row0 = T + 256 * pm; u.col0 = pn; return true;
        }
        return false;
    }
    __device__ __forceinline__ const float* bias(const Unit& u) const { return (u.type == 1 && u.col0 == 7) ? bab : baf; }
};
struct EpiIn {
    unsigned char* ws;
    __device__ __forceinline__ void operator()(const f32x4 (&acc)[2][2][4][2], const Unit& u, int wr, int wc, int fr, int fq, const LAS float* bs) const {
        const int rl = wr * 64 + fr, cl = wc * 32 + 8 * fq;
        if (u.type == 0) {
            const int pn = u.col0;
            bf16_t* dst; int ld, cb;
            if (pn == 0) { dst = (bf16_t*)(ws + WS_Q); ld = 256; cb = 0; }
            else if (pn == 1) { dst = (bf16_t*)(ws + WS_K); ld = 256; cb = 0; }
            else if (pn < 4) { dst = (bf16_t*)(ws + WS_V); ld = 512; cb = (pn - 2) * 256; }
            else { dst = (bf16_t*)(ws + WS_G); ld = 512; cb = (pn - 4) * 256; }
#pragma unroll
            for (int ai = 0; ai < 2; ++ai)
#pragma unroll
                for (int m = 0; m < 4; ++m) { bf16_t* rowp = dst + (size_t)(u.row0 + rl + ai * 128 + m * 16) * ld + cb + cl;
#pragma unroll
                    for (int bj = 0; bj < 2; ++bj) *(u32x4*)(rowp + bj * 128) = pack8(acc[ai][bj][m][0], acc[ai][bj][m][1]); }
        } else if (u.type == 1) {
            _Float16* dst = (_Float16*)(ws + (u.col0 == 6 ? WS_GF : WS_GB));
            f32x4 bv[2][2];
#pragma unroll
            for (int bj = 0; bj < 2; ++bj)
#pragma unroll
                for (int n = 0; n < 2; ++n) bv[bj][n] = *(const LAS f32x4*)(bs + cl + bj * 128 + 4 * n);
            typedef _Float16 f16x8_ __attribute__((ext_vector_type(8)));
#pragma unroll
            for (int ai = 0; ai < 2; ++ai)
#pragma unroll
                for (int m = 0; m < 4; ++m) { _Float16* rowp = dst + (size_t)(u.row0 + rl + ai * 128 + m * 16) * 256 + cl;
#pragma unroll
                    for (int bj = 0; bj < 2; ++bj) { f16x8_ o;
#pragma unroll
                        for (int n = 0; n < 2; ++n) { const f32x4 z = acc[ai][bj][m][n] + bv[bj][n];
#pragma unroll
                            for (int j = 0; j < 4; ++j) o[4 * n + j] = (_Float16)(log_sigmoid_f(z[j]) * (1.f / 16.f)); }
                        *(f16x8_*)(rowp + bj * 128) = o; } }
        } else {
            const int b = u.col0 >> 13, l0 = u.col0 & 8191;
            bf16_t* dst = (bf16_t*)(ws + WS_UT) + ((size_t)b * HYC) * SEQ + l0 + cl;
#pragma unroll
            for (int ai = 0; ai < 2; ++ai)
#pragma unroll
                for (int m = 0; m < 4; ++m) { bf16_t* rowp = dst + (size_t)(u.row0 + rl + ai * 128 + m * 16) * SEQ;
#pragma unroll
                    for (int bj = 0; bj < 2; ++bj) *(u32x4*)(rowp + bj * 128) = pack8(acc[ai][bj][m][0], acc[ai][bj][m][1]); }
        }
    }
};

struct SchedOut {
    unsigned char* ws; int G, c;
    __device__ __forceinline__ bool next(int i, Unit& u) const {
        const int L = i * G + c; if (L >= 512) return false;
        const int pm = L >> 2, pn = L & 3;
        u.A = (const char*)(ws + WS_MIX) + (size_t)(256 * pm) * ROWB; u.B = (const char*)(ws + WS_BTOUT) + (size_t)(256 * pn) * ROWB;
        u.list = nullptr; u.valid = 256; u.aux = 0; u.type = 3; u.row0 = 256 * pm; u.col0 = 256 * pn; return true;
    }
    __device__ __forceinline__ const float* bias(const Unit& u) const { return (const float*)(ws + WS_MOD) + (u.row0 >> 13) * 6144 + 2 * 1024 + u.col0; }
};
struct EpiOut {
    unsigned char* ws;
    __device__ __forceinline__ void operator()(const f32x4 (&acc)[2][2][4][2], const Unit& u, int wr, int wc, int fr, int fq, const LAS float* bs) const {
        const int rl = wr * 64 + fr, cl = u.col0 + wc * 32 + 8 * fq;
        bf16_t* fg = (bf16_t*)(ws + WS_FG);
        f32x4 gv[2][2];
#pragma unroll
        for (int bj = 0; bj < 2; ++bj)
#pragma unroll
            for (int n = 0; n < 2; ++n) gv[bj][n] = *(const LAS f32x4*)(bs + wc * 32 + 8 * fq + bj * 128 + 4 * n);
#pragma unroll
        for (int ai = 0; ai < 2; ++ai)
#pragma unroll
            for (int m = 0; m < 4; ++m) { bf16_t* rowp = fg + (size_t)(u.row0 + rl + ai * 128 + m * 16) * 1024 + cl;
#pragma unroll
                for (int bj = 0; bj < 2; ++bj) *(u32x4*)(rowp + bj * 128) = pack8(gv[bj][0] * acc[ai][bj][m][0], gv[bj][1] * acc[ai][bj][m][1]); }
    }
};

constexpr int LDS_TAB = STAGE_BYTES;
template <int WHICH>
struct SchedMoe {
    unsigned char* ws; const LAS int* tab; int G, c; const float* b2;
    __device__ __forceinline__ bool next(int i, Unit& u) const {
        constexpr int NCT_ = WHICH == 1 ? 8 : 4;
        const int L = i * G + c; const int nrt = __builtin_amdgcn_readfirstlane(tab[32]);
        if (L >= nrt * NCT_) return false;
        const int rt = L / NCT_, ct = L % NCT_;
        const int info = __builtin_amdgcn_readfirstlane(tab[64 + rt]), e = info & 255, r0 = (info >> 8) * 256;
        const int cnt = __builtin_amdgcn_readfirstlane(tab[e]);
        u.valid = (cnt - r0) < 256 ? (cnt - r0) : 256;
        u.list = (const int*)(ws + WS_LIST) + (size_t)e * CAP + r0;
        u.A = (WHICH == 1) ? (const char*)(ws + WS_H2) : (const char*)(ws + WS_ACT) + (size_t)(256 * rt) * KD;
        u.B = (const char*)(ws + (WHICH == 1 ? WS_W1T : WS_W2T)) + ((size_t)e * (WHICH == 1 ? 2048 : 1024) + 256 * ct) * KD;
        u.type = 3 + WHICH; u.row0 = 256 * rt; u.col0 = ct; u.aux = e; return true;
    }
    __device__ __forceinline__ const float* bias(const Unit& u) const { return (WHICH == 1) ? (const float*)(ws + WS_B1R) + (size_t)u.aux * 2048 + 256 * u.col0 : b2 + (size_t)u.aux * 1024 + 256 * u.col0; }
};
__device__ __forceinline__ float swiglu_f(float glu, float lin) {
    glu = fminf(glu, 7.f); lin = fminf(fmaxf(lin, -7.f), 7.f);
    return glu * __builtin_amdgcn_rcpf(1.f + __expf(-1.702f * glu)) * (lin + 1.f);
}
constexpr float S_H2 = 4.f, S_ACT = 8.f, S_W = 64.f;
__device__ __forceinline__ f32x2 swiglu2(f32x2 ag, f32x2 al, f32x2 bg, f32x2 bl) {
    f32x2 g = ag * (1.f / (S_H2 * S_W)) + bg, l = al * (1.f / (S_H2 * S_W)) + bl;
    g[0] = fminf(g[0], 7.f); g[1] = fminf(g[1], 7.f);
    l[0] = __builtin_amdgcn_fmed3f(l[0], -7.f, 7.f); l[1] = __builtin_amdgcn_fmed3f(l[1], -7.f, 7.f);
    const f32x2 t = g * (-1.702f * 1.4426950408889634f);
    const f32x2 d = (f32x2){__builtin_amdgcn_exp2f(t[0]), __builtin_amdgcn_exp2f(t[1])} + 1.f;
    const f32x2 r = {__builtin_amdgcn_rcpf(d[0]), __builtin_amdgcn_rcpf(d[1])};
    return (g * r) * (l * S_ACT + S_ACT);
}
__device__ __forceinline__ unsigned pk4_fp8(float a, float b, float c, float d) {
    a = fminf(fmaxf(a, -448.f), 448.f); b = fminf(fmaxf(b, -448.f), 448.f); c = fminf(fmaxf(c, -448.f), 448.f); d = fminf(fmaxf(d, -448.f), 448.f);
    int p = __builtin_amdgcn_cvt_pk_fp8_f32(a, b, 0, false); p = __builtin_amdgcn_cvt_pk_fp8_f32(c, d, p, true); return (unsigned)p; }
__device__ __forceinline__ unsigned pk4_fp8_nc(float a, float b, float c, float d) { int p = __builtin_amdgcn_cvt_pk_fp8_f32(a, b, 0, false); p = __builtin_amdgcn_cvt_pk_fp8_f32(c, d, p, true); return (unsigned)p; }
struct EpiMoe1 {
    unsigned char* ws;
    __device__ __forceinline__ void operator()(const f32x4 (&acc)[2][2][4][2], const Unit& u, int wr, int wc, int fr, int fq, const LAS float* bs) const {
        const int rl = wr * 64 + fr, cl = wc * 32 + 8 * fq, ct = u.col0;
        const LAS float* b1 = bs + cl;
        unsigned char* act = (unsigned char*)(ws + WS_ACT) + (size_t)u.row0 * 1024 + 128 * ct + cl;
        f32x4 bg[2], bl[2];
#pragma unroll
        for (int n = 0; n < 2; ++n) { bg[n] = *(const LAS f32x4*)(b1 + 4 * n); bl[n] = *(const LAS f32x4*)(b1 + 128 + 4 * n); }
#pragma unroll
        for (int ai = 0; ai < 2; ++ai)
#pragma unroll
            for (int mp = 0; mp < 2; ++mp) {
                u32x2 w[2];
#pragma unroll
                for (int mm = 0; mm < 2; ++mm) { const int m = 2 * mp + mm;
#pragma unroll
                    for (int n = 0; n < 2; ++n) { int p = 0;
#pragma unroll
                        for (int hh = 0; hh < 2; ++hh) {
                            const f32x2 o = swiglu2((f32x2){acc[ai][0][m][n][2 * hh], acc[ai][0][m][n][2 * hh + 1]}, (f32x2){acc[ai][1][m][n][2 * hh], acc[ai][1][m][n][2 * hh + 1]},
                                                    (f32x2){bg[n][2 * hh], bg[n][2 * hh + 1]}, (f32x2){bl[n][2 * hh], bl[n][2 * hh + 1]});
                            p = hh ? __builtin_amdgcn_cvt_pk_fp8_f32(o[0], o[1], p, true) : __builtin_amdgcn_cvt_pk_fp8_f32(o[0], o[1], p, false); }
                        if (n == 0) w[mm].x = (unsigned)p; else w[mm].y = (unsigned)p; } }
                const auto sx = __builtin_amdgcn_permlane16_swap(w[0].x, w[1].x, false, false); const auto sy = __builtin_amdgcn_permlane16_swap(w[0].y, w[1].y, false, false);
                const int r = rl + ai * 128 + (2 * mp + (fq & 1)) * 16;
                *(u32x4*)(act + (size_t)r * 1024 - 8 * (fq & 1)) = (u32x4){sx[0], sy[0], sx[1], sy[1]}; }
    }
};
constexpr float S_SL = 16.f;
struct EpiMoe2 {
    unsigned char* ws;
    __device__ __forceinline__ void operator()(const f32x4 (&acc)[2][2][4][2], const Unit& u, int wr, int wc, int fr, int fq, const LAS float* bs) const {
        const int rl = wr * 64 + fr, cl = wc * 32 + 8 * fq, ct = u.col0;
        const LAS float* bb = bs + cl;
        unsigned char* slots = (unsigned char*)(ws + WS_SLOTS) + (size_t)u.row0 * 1024 + 256 * ct + cl;
        f32x4 bv[2][2];
#pragma unroll
        for (int bj = 0; bj < 2; ++bj)
#pragma unroll
            for (int n = 0; n < 2; ++n) bv[bj][n] = *(const LAS f32x4*)(bb + bj * 128 + 4 * n) * S_SL;
#pragma unroll
        for (int ai = 0; ai < 2; ++ai)
#pragma unroll
            for (int m = 0; m < 4; ++m) { const int r = rl + ai * 128 + m * 16;
                u32x2 w[2];
#pragma unroll
                for (int bj = 0; bj < 2; ++bj) {
#pragma unroll
                    for (int n = 0; n < 2; ++n) { int p = 0;
#pragma unroll
                        for (int hh = 0; hh < 2; ++hh) { f32x2 y = (f32x2){acc[ai][bj][m][n][2 * hh], acc[ai][bj][m][n][2 * hh + 1]} * (S_SL / (S_ACT * S_W)) + (f32x2){bv[bj][n][2 * hh], bv[bj][n][2 * hh + 1]};
                            y[0] = __builtin_amdgcn_fmed3f(y[0], -448.f, 448.f); y[1] = __builtin_amdgcn_fmed3f(y[1], -448.f, 448.f);
                            p = hh ? __builtin_amdgcn_cvt_pk_fp8_f32(y[0], y[1], p, true) : __builtin_amdgcn_cvt_pk_fp8_f32(y[0], y[1], p, false); }
                        if (n == 0) w[bj].x = (unsigned)p; else w[bj].y = (unsigned)p; } }
                const auto sx = __builtin_amdgcn_permlane16_swap(w[0].x, w[1].x, false, false); const auto sy = __builtin_amdgcn_permlane16_swap(w[0].y, w[1].y, false, false);
                *(u32x4*)(slots + (size_t)r * 1024 + ((fq & 1) ? 128 - 8 : 0)) = (u32x4){sx[0], sy[0], sx[1], sy[1]}; }
    }
};
}

namespace hy {
__device__ __forceinline__ int phys(int n) { return n + (n >> 4) + ((n >> 9) << 4); }
constexpr int XSIZE = 16384 + 1024 + 512;

__device__ __forceinline__ float tw_c(int i) {
    constexpr float t[16] = {1.f, 0.98078528040323043f, 0.92387953251128674f, 0.83146961230254524f, 0.70710678118654752f, 0.55557023301960218f, 0.38268343236508977f, 0.19509032201612825f,
                             0.f, -0.19509032201612825f, -0.38268343236508977f, -0.55557023301960218f, -0.70710678118654752f, -0.83146961230254524f, -0.92387953251128674f, -0.98078528040323043f};
    return t[i];
}
__device__ __forceinline__ float tw_s(int i) {
    constexpr float t[16] = {0.f, 0.19509032201612825f, 0.38268343236508977f, 0.55557023301960218f, 0.70710678118654752f, 0.83146961230254524f, 0.92387953251128674f, 0.98078528040323043f,
                             1.f, 0.98078528040323043f, 0.92387953251128674f, 0.83146961230254524f, 0.70710678118654752f, 0.55557023301960218f, 0.38268343236508977f, 0.19509032201612825f};
    return t[i];
}
__host__ __device__ constexpr int brev(int p, int bits) { int r = 0; for (int i = 0; i < bits; ++i) r |= ((p >> i) & 1) << (bits - 1 - i); return r; }

__device__ __forceinline__ f32x2 cmul(f32x2 a, f32x2 w) { f32x2 r;
    asm("v_pk_mul_f32 %0, %1, %2 op_sel_hi:[1,0]\n\tv_pk_fma_f32 %0, %1, %2, %0 op_sel:[1,1,0] op_sel_hi:[0,1,1] neg_lo:[0,1,0]" : "=&v"(r) : "v"(a), "v"(w)); return r; }
__device__ __forceinline__ void cmul_chain(f32x2 a, f32x2 w, f32x2 w1, f32x2& o, f32x2& wn) {
    asm("v_pk_mul_f32 %0, %2, %3 op_sel_hi:[1,0]\n\tv_pk_mul_f32 %1, %3, %4 op_sel_hi:[1,0]\n\t"
        "v_pk_fma_f32 %0, %2, %3, %0 op_sel:[1,1,0] op_sel_hi:[0,1,1] neg_lo:[0,1,0]\n\tv_pk_fma_f32 %1, %3, %4, %1 op_sel:[1,1,0] op_sel_hi:[0,1,1] neg_lo:[0,1,0]"
        : "=&v"(o), "=&v"(wn) : "v"(a), "v"(w), "v"(w1)); }
template <int TI, bool INV>
__device__ __forceinline__ void bf_tw(f32x2& a, f32x2& b) {
    constexpr int T7 = TI < 8 ? TI : 16 - TI;
    const f32x2 W = {tw_c(T7), tw_s(T7)};
    f32x2 sum, o;
#define HY_BF(NEGR, NEGI) asm("v_pk_add_f32 %0, %3, %2\n\tv_pk_add_f32 %2, %3, %2 neg_lo:[0,1] neg_hi:[0,1]\n\tv_pk_mul_f32 %1, %2, %4 op_sel_hi:[1,0]" NEGR "\n\tv_pk_fma_f32 %1, %2, %4, %1 op_sel:[1,1,0] op_sel_hi:[0,1,1] " NEGI : "=&v"(sum), "=&v"(o), "+v"(b) : "v"(a), "s"(W))
    if (TI < 8) { if (!INV) HY_BF("", "neg_hi:[0,1,0]"); else HY_BF("", "neg_lo:[0,1,0]"); }
    else        { if (!INV) HY_BF(" neg_lo:[0,1] neg_hi:[0,1]", "neg_hi:[0,1,0]"); else HY_BF(" neg_lo:[0,1] neg_hi:[0,1]", "neg_lo:[0,1,0]"); }
#undef HY_BF
    a = sum; b = o;
}
template <int TI, bool INV>
__device__ __forceinline__ f32x2 tw_mul(f32x2 t) {
    constexpr int T7 = TI < 8 ? TI : 16 - TI;
    const f32x2 W = {tw_c(T7), tw_s(T7)};
    f32x2 r;
#define HY_TW(NEGR, NEGI) asm("v_pk_mul_f32 %0, %1, %2 op_sel_hi:[1,0]" NEGR "\n\tv_pk_fma_f32 %0, %1, %2, %0 op_sel:[1,1,0] op_sel_hi:[0,1,1] " NEGI : "=&v"(r) : "v"(t), "s"(W))
    if (TI < 8) { if (!INV) HY_TW("", "neg_hi:[0,1,0]"); else HY_TW("", "neg_lo:[0,1,0]"); }
    else        { if (!INV) HY_TW(" neg_lo:[0,1] neg_hi:[0,1]", "neg_hi:[0,1,0]"); else HY_TW(" neg_lo:[0,1] neg_hi:[0,1]", "neg_lo:[0,1,0]"); }
#undef HY_TW
    return r;
}
template <bool INV>
__device__ __forceinline__ void bf_rot(f32x2& a, f32x2& b) { f32x2 sum, o;
    if (!INV) asm("v_pk_add_f32 %0, %2, %3\n\tv_pk_add_f32 %1, %2, %3 op_sel:[1,1] op_sel_hi:[0,0] neg_lo:[0,1] neg_hi:[1,0]" : "=&v"(sum), "=&v"(o) : "v"(a), "v"(b));
    else      asm("v_pk_add_f32 %0, %2, %3\n\tv_pk_add_f32 %1, %2, %3 op_sel:[1,1] op_sel_hi:[0,0] neg_lo:[1,0] neg_hi:[0,1]" : "=&v"(sum), "=&v"(o) : "v"(a), "v"(b));
    a = sum; b = o; }
__device__ __forceinline__ void bf_plain(f32x2& a, f32x2& b) { f32x2 sum, o;
    asm("v_pk_add_f32 %0, %2, %3\n\tv_pk_add_f32 %1, %2, %3 neg_lo:[0,1] neg_hi:[0,1]" : "=&v"(sum), "=&v"(o) : "v"(a), "v"(b));
    a = sum; b = o; }
template <bool INV>
__device__ __forceinline__ f32x2 rot_i(f32x2 t) { f32x2 r;
    if (!INV) asm("v_pk_mul_f32 %0, %1, 1.0 op_sel:[1,0] op_sel_hi:[0,0] neg_hi:[1,0]" : "=v"(r) : "v"(t));
    else      asm("v_pk_mul_f32 %0, %1, 1.0 op_sel:[1,0] op_sel_hi:[0,0] neg_lo:[1,0]" : "=v"(r) : "v"(t));
    return r; }

template <int R, bool INV, bool ZP, int S, int J>
__device__ __forceinline__ void fft_bfly(f32x2 (&v)[R]) {
    constexpr int g = (J / S) * 2 * S, k = J % S, ti = k * (16 / S), i0 = g + k, i1 = g + k + S;
    if constexpr (ZP && S == R / 2) {
        if constexpr (ti == 0) v[i1] = v[i0]; else if constexpr (ti == 8) v[i1] = rot_i<INV>(v[i0]); else v[i1] = tw_mul<ti, INV>(v[i0]);
    } else {
        if constexpr (ti == 0) bf_plain(v[i0], v[i1]); else if constexpr (ti == 8) bf_rot<INV>(v[i0], v[i1]); else bf_tw<ti, INV>(v[i0], v[i1]);
    }
}
template <int R, bool INV, bool ZP, int S, int J>
__device__ __forceinline__ void fft_stage(f32x2 (&v)[R]) { if constexpr (J < R / 2) { fft_bfly<R, INV, ZP, S, J>(v); fft_stage<R, INV, ZP, S, J + 1>(v); } }
template <int R, bool INV, bool ZP, int S>
__device__ __forceinline__ void fft_stages(f32x2 (&v)[R]) { if constexpr (S >= 1) { fft_stage<R, INV, ZP, S, 0>(v); fft_stages<R, INV, ZP, S / 2>(v); } }
template <int R, bool INV, bool ZP = false>
__device__ __forceinline__ void fft_reg(f32x2 (&v)[R]) { fft_stages<R, INV, ZP, R / 2>(v); }
#define XV(X) ((const volatile LAS f32x2*)(X))
template <int M, bool ZPAD = false>
__device__ __forceinline__ void pass_fwd32(LAS f32x2* X, int tid) {
    int j = (M == 512) ? (16 * ((tid >> 5) + 16 * ((tid >> 4) & 1)) + (tid & 15)) : (tid & 15);
    asm volatile("" : "+v"(j));
    const int p0 = (M == 512) ? (j + (j >> 4)) : (560 * (tid >> 4) + (tid & 15));
    constexpr int PS = (M == 512) ? 560 : 17;
    f32x2 v[32];
#pragma unroll
    for (int r = 0; r < 32; ++r) { if (ZPAD && r >= 16) v[r] = (f32x2){0.f, 0.f}; else v[r] = XV(X)[p0 + PS * r]; }
    fft_reg<32, false, ZPAD>(v);
    float sn, cs; sincospif(-2.f * (float)j / (float)(32 * M), &sn, &cs);
    const f32x2 w1 = {cs, sn}; f32x2 w = w1;
    X[p0] = v[0];
#pragma unroll
    for (int rp = 1; rp < 32; ++rp) { if (rp < 31) { f32x2 o_, wn_; cmul_chain(v[brev(rp, 5)], w, w1, o_, wn_); X[p0 + PS * rp] = o_; w = wn_; } else X[p0 + PS * rp] = cmul(v[brev(rp, 5)], w); }
}
template <int M, bool HALF = false>
__device__ __forceinline__ void pass_inv32(LAS f32x2* X, int tid) {
    int j = (M == 512) ? (16 * ((tid >> 5) + 16 * ((tid >> 4) & 1)) + (tid & 15)) : (tid & 15);
    asm volatile("" : "+v"(j));
    const int p0 = (M == 512) ? (j + (j >> 4)) : (560 * (tid >> 4) + (tid & 15));
    constexpr int PS = (M == 512) ? 560 : 17;
    float sn, cs; sincospif(2.f * (float)j / (float)(32 * M), &sn, &cs);
    const f32x2 w1 = {cs, sn}; f32x2 w = w1;
    f32x2 v[32];
    v[0] = XV(X)[p0];
#pragma unroll
    for (int rp = 1; rp < 32; ++rp) { if (rp < 31) { f32x2 wn_; cmul_chain(XV(X)[p0 + PS * rp], w, w1, v[rp], wn_); w = wn_; } else v[rp] = cmul(XV(X)[p0 + PS * rp], w); }
    fft_reg<32, true>(v);
#pragma unroll
    for (int p = 0; p < 32; ++p) { if (!HALF || brev(p, 5) < 16) X[p0 + PS * brev(p, 5)] = v[p]; }
}
typedef _Float16 f16x8h __attribute__((ext_vector_type(8)));
__device__ __forceinline__ void pass_c_store(const LAS f32x2* X, f32x2* Hs_, int tid, float scale) {
    _Float16* Hs = (_Float16*)Hs_; (void)scale;
#pragma unroll
    for (int u = 0; u < 2; ++u) { const int blk = tid + 512 * u, p0 = 17 * blk + 16 * (blk >> 5);
        f32x2 v[16];
#pragma unroll
        for (int r = 0; r < 16; ++r) v[r] = XV(X)[p0 + r];
        fft_reg<16, false>(v);
#pragma unroll
        for (int q = 0; q < 4; ++q) { f16x8h o;
#pragma unroll
            for (int e = 0; e < 4; ++e) { const f32x2 x = v[brev(4 * q + e, 4)]; o[2 * e] = (_Float16)x[0]; o[2 * e + 1] = (_Float16)x[1]; }
            *(f16x8h*)(Hs + 2 * (16 * blk + 4 * q)) = o; } }
}
__device__ __forceinline__ void pass_c_mul_inv(LAS f32x2* X, const f32x2* Hs_, int tid) {
    const _Float16* Hs = (const _Float16*)Hs_;
#pragma unroll
    for (int u = 0; u < 2; ++u) { const int blk = tid + 512 * u, p0 = 17 * blk + 16 * (blk >> 5);
        f32x2 v[16], w[16];
#pragma unroll
        for (int r = 0; r < 16; ++r) v[r] = XV(X)[p0 + r];
        f16x8h hh[4];
#pragma unroll
        for (int q = 0; q < 4; ++q) hh[q] = *(const f16x8h*)(Hs + 2 * (16 * blk + 4 * q));
        fft_reg<16, false>(v);
#pragma unroll
        for (int q = 0; q < 4; ++q)
#pragma unroll
            for (int e = 0; e < 4; ++e) w[4 * q + e] = cmul(v[brev(4 * q + e, 4)], (f32x2){(float)hh[q][2 * e], (float)hh[q][2 * e + 1]});
        fft_reg<16, true>(w);
#pragma unroll
        for (int p = 0; p < 16; ++p) X[p0 + brev(p, 4)] = w[p]; }
}
__device__ __forceinline__ void load16(const bf16_t* u, float (&e)[16]) {
    const u32x4 a = *(const u32x4*)u, b = *(const u32x4*)(u + 8);
    e[0] = bflo(a.x); e[1] = bfhi(a.x); e[2] = bflo(a.y); e[3] = bfhi(a.y); e[4] = bflo(a.z); e[5] = bfhi(a.z); e[6] = bflo(a.w); e[7] = bfhi(a.w);
    e[8] = bflo(b.x); e[9] = bfhi(b.x); e[10] = bflo(b.y); e[11] = bfhi(b.y); e[12] = bflo(b.z); e[13] = bfhi(b.z); e[14] = bflo(b.w); e[15] = bfhi(b.w);
}
__device__ __forceinline__ void sconv16(const bf16_t* u, int tid, float w0, float w1, float w2, float bias, float (&o)[16]) {
    float e[16]; load16(u + 16 * tid, e);
    float lf = __shfl_up(e[15], 1), rt = __shfl_down(e[0], 1);
    if ((tid & 3) == 0) lf = 0.f;
    if ((tid & 3) == 3) rt = 0.f;
    o[0] = w0 * lf + w1 * e[0] + w2 * e[1] + bias;
#pragma unroll
    for (int i = 1; i < 15; ++i) o[i] = w0 * e[i - 1] + w1 * e[i] + w2 * e[i + 1] + bias;
    o[15] = w0 * e[14] + w1 * e[15] + w2 * rt + bias;
}

constexpr int CV_SPLIT = NE * 64 * 32;
constexpr int CV_ITEMS = NE * 64 * 32;
struct CvJob { float v[16]; int mi; };
__device__ __forceinline__ void cv_issue(const Args& a, CvJob& jb, int mi, int lane) {
    jb.mi = mi;
    if (mi >= 0) { const int e = mi >> 11, kg = (mi >> 5) & 63, nb = mi & 31;
        const float* src = a.in[I_EW1] + ((size_t)e * 1024 + 16 * kg) * 2048 + 64 * nb + lane;
#pragma unroll
        for (int i = 0; i < 16; ++i) jb.v[i] = src[(size_t)i * 2048]; }
}
__device__ __forceinline__ void cv_finish(const Args& a, const CvJob& jb, int lane) {
    if (jb.mi >= 0) { const int mi = jb.mi, e = mi >> 11, kg = (mi >> 5) & 63, nb = mi & 31;
        const int cs = 64 * nb + lane, sgl = cs & 1, ac = cs >> 1, ct = ac >> 7, jj = ac & 127;
        unsigned char* dst = (unsigned char*)(a.ws + WS_W1T) + ((size_t)e * 2048 + 256 * ct + 128 * sgl + jj) * 1024 + 16 * kg;
        u32x4 o;
        o.x = gm::pk4_fp8_nc(jb.v[0] * gm::S_W, jb.v[1] * gm::S_W, jb.v[2] * gm::S_W, jb.v[3] * gm::S_W); o.y = gm::pk4_fp8_nc(jb.v[4] * gm::S_W, jb.v[5] * gm::S_W, jb.v[6] * gm::S_W, jb.v[7] * gm::S_W);
        o.z = gm::pk4_fp8_nc(jb.v[8] * gm::S_W, jb.v[9] * gm::S_W, jb.v[10] * gm::S_W, jb.v[11] * gm::S_W); o.w = gm::pk4_fp8_nc(jb.v[12] * gm::S_W, jb.v[13] * gm::S_W, jb.v[14] * gm::S_W, jb.v[15] * gm::S_W);
        *(u32x4*)dst = o; }
}
struct CvState { CvJob jb; int next, stride, end; };
__device__ __forceinline__ void cv_step(const Args& a, CvState& st, int lane) {
    cv_finish(a, st.jb, lane);
    const int mi = st.next < st.end ? st.next : -1;
    cv_issue(a, st.jb, mi, lane);
    st.next += st.stride;
}

__device__ __forceinline__ void channel(const Args& a, LAS unsigned char* lds, int c, unsigned char* scratch, CvState& cvs) {
    const int tid = threadIdx.x;
#define CV_STEP() cv_step(a, cvs, tid & 63)
    LAS f32x2* X = (LAS f32x2*)lds;
    f32x2* Hs = (f32x2*)scratch;
    const _Float16* HF = (const _Float16*)(a.ws + WS_HF);
    const int pc = 17 * tid + 16 * (tid >> 5);
    __syncthreads();
#pragma unroll 1
    for (int o = 0; o < 2; ++o) {
        typedef _Float16 f16x8_ __attribute__((ext_vector_type(8)));
        const f16x8_* hf = (const f16x8_*)(HF + ((size_t)(2 * o) * HYW + c) * SEQ + 16 * tid); const f16x8_* hb = (const f16x8_*)(HF + ((size_t)(2 * o + 1) * HYW + c) * SEQ + 16 * tid);
#pragma unroll
        for (int q = 0; q < 2; ++q) { const f16x8_ f = hf[q], b = hb[q];
#pragma unroll
            for (int e = 0; e < 8; ++e) { const int i = 8 * q + e, t = 16 * tid + i;
                X[pc + i] = (f32x2){(float)f[e], 0.f};
                if (t >= 1) X[phys(FFTN - t)] = (f32x2){(float)b[e], 0.f}; } }
        if (tid == 0) X[phys(SEQ)] = (f32x2){0.f, 0.f};
        __syncthreads();
        CV_STEP(); pass_fwd32<512>(X, tid); __syncthreads(); CV_STEP(); pass_fwd32<16>(X, tid); __syncthreads(); pass_c_store(X, Hs + (size_t)o * (FFTN / 2), tid, 1.f); __syncthreads();
    }
    const float* cw = a.in[I_CONVW]; const float* cbv = a.in[I_CONVB]; const float* dbias = a.in[I_BIASD];
    const float d1 = dbias[c], d2 = dbias[HYW + c];
    constexpr float INVN = 1.f / (float)FFTN;
    float wv[3][3], bv[3];
#pragma unroll
    for (int s = 0; s < 3; ++s) { bv[s] = cbv[s * HYW + c];
#pragma unroll
        for (int i = 0; i < 3; ++i) wv[s][i] = cw[i * HYC + s * HYW + c]; }
    const bf16_t* UT = (const bf16_t*)(a.ws + WS_UT);
    bf16_t* YT = (bf16_t*)(a.ws + WS_YHYT);
#pragma unroll 1
    for (int bp = 0; bp < 2; ++bp) {
        const bf16_t* u0 = UT + ((size_t)(2 * bp) * HYC + c) * SEQ; const bf16_t* u1 = UT + ((size_t)(2 * bp + 1) * HYC + c) * SEQ;
        float z0[16], z1[16];
        {
            float v0[16], v1[16]; sconv16(u0, tid, wv[0][0], wv[0][1], wv[0][2], bv[0], v0); sconv16(u1, tid, wv[0][0], wv[0][1], wv[0][2], bv[0], v1);
#pragma unroll
            for (int i = 0; i < 16; ++i) X[pc + i] = (f32x2){v0[i], v1[i]};
        }
        __syncthreads();
        CV_STEP(); pass_fwd32<512, true>(X, tid); __syncthreads(); CV_STEP(); pass_fwd32<16>(X, tid); __syncthreads(); pass_c_mul_inv(X, Hs, tid); __syncthreads(); CV_STEP(); pass_inv32<16>(X, tid); __syncthreads(); CV_STEP(); pass_inv32<512, true>(X, tid); __syncthreads();
        {
            float v0[16], v1[16], x0[16], x1[16];
            sconv16(u0, tid, wv[0][0], wv[0][1], wv[0][2], bv[0], v0); sconv16(u1, tid, wv[0][0], wv[0][1], wv[0][2], bv[0], v1);
            sconv16(u0 + (size_t)HYW * SEQ, tid, wv[1][0], wv[1][1], wv[1][2], bv[1], x0); sconv16(u1 + (size_t)HYW * SEQ, tid, wv[1][0], wv[1][1], wv[1][2], bv[1], x1);
#pragma unroll
            for (int i = 0; i < 16; ++i) { const f32x2 y1 = X[pc + i]; z0[i] = x0[i] * (y1[0] * INVN + d1 * v0[i]); z1[i] = x1[i] * (y1[1] * INVN + d1 * v1[i]); X[pc + i] = (f32x2){z0[i], z1[i]}; }
        }
        __syncthreads();
        CV_STEP(); pass_fwd32<512, true>(X, tid); __syncthreads(); CV_STEP(); pass_fwd32<16>(X, tid); __syncthreads(); pass_c_mul_inv(X, Hs + FFTN / 2, tid); __syncthreads(); CV_STEP(); pass_inv32<16>(X, tid); __syncthreads(); CV_STEP(); pass_inv32<512, true>(X, tid); __syncthreads();
        {
            float x0[16], x1[16];
            sconv16(u0 + (size_t)2 * HYW * SEQ, tid, wv[2][0], wv[2][1], wv[2][2], bv[2], x0); sconv16(u1 + (size_t)2 * HYW * SEQ, tid, wv[2][0], wv[2][1], wv[2][2], bv[2], x1);
            unsigned w0[8], w1[8];
#pragma unroll
            for (int i = 0; i < 8; ++i) { const f32x2 ya = X[pc + 2 * i], yb = X[pc + 2 * i + 1];
                w0[i] = pk2(x0[2 * i] * (ya[0] * INVN + d2 * z0[2 * i]), x0[2 * i + 1] * (yb[0] * INVN + d2 * z0[2 * i + 1]));
                w1[i] = pk2(x1[2 * i] * (ya[1] * INVN + d2 * z1[2 * i]), x1[2 * i + 1] * (yb[1] * INVN + d2 * z1[2 * i + 1])); }
            u32x4* y0p = (u32x4*)(YT + ((size_t)(2 * bp) * HYW + c) * SEQ + 16 * tid); u32x4* y1p = (u32x4*)(YT + ((size_t)(2 * bp + 1) * HYW + c) * SEQ + 16 * tid);
            y0p[0] = (u32x4){w0[0], w0[1], w0[2], w0[3]}; y0p[1] = (u32x4){w0[4], w0[5], w0[6], w0[7]};
            y1p[0] = (u32x4){w1[0], w1[1], w1[2], w1[3]}; y1p[1] = (u32x4){w1[4], w1[5], w1[6], w1[7]};
        }
        __syncthreads();
    }
#undef CV_STEP
}

__device__ __forceinline__ void filter_item(const Args& a, int item, int lane) {
    const int ct = item & 127, tc = item >> 7;
    const float* hid2 = (const float*)(a.ws + WS_HID2); const float* wout = a.in[I_FWOUT]; _Float16* HF = (_Float16*)(a.ws + WS_HF);
    const int col = 16 * ct + (lane & 15), kq = lane >> 4, cch = col & 511;
    typedef _Float16 f16x8f __attribute__((ext_vector_type(8)));
    f16x8f bfr[2];
#pragma unroll
    for (int s = 0; s < 2; ++s)
#pragma unroll
        for (int i = 0; i < 8; ++i) bfr[s][i] = (_Float16)wout[(size_t)(32 * s + 8 * kq + i) * 2048 + col];
    const float dlt = fabsf(-3.0701134573253945f + (float)cch * ((-15.350567286626973f + 3.0701134573253945f) / 511.f));
#pragma unroll 4
    for (int tt = 0; tt < 32; ++tt) { const int t0 = 512 * tc + 16 * tt;
        const f32x4* ar = (const f32x4*)(hid2 + (size_t)(t0 + (lane & 15)) * 64 + 8 * kq);
        const f32x4 a0 = ar[0], a1 = ar[1], a2 = ar[8], a3 = ar[9];
        const f16x8f af0 = {(_Float16)a0[0], (_Float16)a0[1], (_Float16)a0[2], (_Float16)a0[3], (_Float16)a1[0], (_Float16)a1[1], (_Float16)a1[2], (_Float16)a1[3]};
        const f16x8f af1 = {(_Float16)a2[0], (_Float16)a2[1], (_Float16)a2[2], (_Float16)a2[3], (_Float16)a3[0], (_Float16)a3[1], (_Float16)a3[2], (_Float16)a3[3]};
        f32x4 acc = {0.f, 0.f, 0.f, 0.f};
        acc = __builtin_amdgcn_mfma_f32_16x16x32_f16(af0, bfr[0], acc, 0, 0, 0);
        acc = __builtin_amdgcn_mfma_f32_16x16x32_f16(af1, bfr[1], acc, 0, 0, 0);
        f32x4 o;
#pragma unroll
        for (int r = 0; r < 4; ++r) o[r] = acc[r] * __expf(-((float)(t0 + 4 * kq + r) / (float)(SEQ - 1)) * dlt);
        typedef _Float16 f16x4_ __attribute__((ext_vector_type(4)));
        *(f16x4_*)(HF + (size_t)col * SEQ + t0 + 4 * kq) = (f16x4_){(_Float16)o[0], (_Float16)o[1], (_Float16)o[2], (_Float16)o[3]}; }
}

__device__ __forceinline__ void transpose_item(const Args& a, int item, int lane) {
    const int lt = item & 127, ct = (item >> 7) & 7, b = item >> 10;
    const bf16_t* src = (const bf16_t*)(a.ws + WS_YHYT) + ((size_t)b * HYW + 64 * ct) * SEQ + 64 * lt + lane;
    bf16_t* dst = (bf16_t*)(a.ws + WS_MIX) + ((size_t)b * SEQ + 64 * lt + lane) * 1024 + 512 + 64 * ct;
    unsigned short v[64];
#pragma unroll
    for (int cc = 0; cc < 64; ++cc) v[cc] = src[(size_t)cc * SEQ];
#pragma unroll
    for (int q = 0; q < 8; ++q)
        *(u32x4*)(dst + 8 * q) = (u32x4){(unsigned)v[8 * q] | ((unsigned)v[8 * q + 1] << 16), (unsigned)v[8 * q + 2] | ((unsigned)v[8 * q + 3] << 16),
                                         (unsigned)v[8 * q + 4] | ((unsigned)v[8 * q + 5] << 16), (unsigned)v[8 * q + 6] | ((unsigned)v[8 * q + 7] << 16)};
}
}

__device__ __forceinline__ void p0_mod_and_filter(const Args& a, LAS unsigned char* lds) {
    const int tid = threadIdx.x, lane = tid & 63, wave = tid >> 6;
    const float* c = a.in[I_C]; const float* cctx = a.in[I_CCTX]; const float* adaw = a.in[I_ADAW]; const float* adab = a.in[I_ADAB];
    float* mod = (float*)(a.ws + WS_MOD);
    LAS float* sl = (LAS float*)lds;
    LAS float* pt = (LAS float*)lds + 5 * 1024;
    for (int i = tid; i < 5 * 1024; i += NTHREADS) { const int r = i >> 10, k = i & 1023; sl[i] = silu_f(r < 4 ? c[r * 1024 + k] : cctx[k]); }
    for (int it = blockIdx.x; it < 256; it += gridDim.x) {
        __syncthreads();
        if (tid < 504) {
            const int col = tid % 24, ks = tid / 24, n = it * 24 + col, kbeg = ks * 49, kend = (kbeg + 49 < 1024) ? kbeg + 49 : 1024;
            float acc[5] = {0.f, 0.f, 0.f, 0.f, 0.f};
#pragma unroll 7
            for (int k = kbeg; k < kend; ++k) { const float w = adaw[(size_t)k * 6144 + n];
#pragma unroll
                for (int r = 0; r < 5; ++r) acc[r] += sl[r * 1024 + k] * w; }
#pragma unroll
            for (int r = 0; r < 5; ++r) pt[(ks * 5 + r) * 24 + col] = acc[r];
        }
        __syncthreads();
        if (tid < 120) { const int r = tid / 24, col = tid % 24, n = it * 24 + col; float s = adab[n];
            for (int ks = 0; ks < 21; ++ks) s += pt[(ks * 5 + r) * 24 + col];
            mod[r * 6144 + n] = s; }
    }
    __syncthreads();
    const float* w1 = a.in[I_FW1]; const float* b1 = a.in[I_FB1]; const float* w2 = a.in[I_FW2]; const float* b2 = a.in[I_FB2]; const float* fq = a.in[I_FFREQ];
    float* hid2 = (float*)(a.ws + WS_HID2);
    LAS float* zs = (LAS float*)lds + 8192 + wave * 128;
    const float frq = fq[lane], bb1 = b1[lane], bb2 = b2[lane];
    for (int t = (blockIdx.x * NWAVES + wave); t < SEQ; t += gridDim.x * NWAVES) {
        float z = 0.f;
        if (lane == 0) z = (float)t / (float)(SEQ - 1);
        else if (lane < 33) { const int i = (lane - 1) & 15; const float f = 1e-4f + (float)i * ((15.f - 1e-4f) / 15.f);
            const float ang = (6.283185307179586f * (float)t / (float)SEQ) * f; z = (lane < 17) ? cosf(ang) : -sinf(ang); }
        if (lane < 33) zs[lane] = z;
        __builtin_amdgcn_wave_barrier(); asm volatile("s_waitcnt lgkmcnt(0)" ::: "memory");
        float s = bb1;
#pragma unroll
        for (int e = 0; e < 33; ++e) s += zs[e] * w1[e * 64 + lane];
        const float h1 = sinf(frq * s);
        zs[64 + lane] = h1;
        __builtin_amdgcn_wave_barrier(); asm volatile("s_waitcnt lgkmcnt(0)" ::: "memory");
        float s2 = bb2;
#pragma unroll 16
        for (int g = 0; g < 64; ++g) s2 += zs[64 + g] * w2[g * 64 + lane];
        hid2[(size_t)t * 64 + lane] = sinf(frq * s2);
        __builtin_amdgcn_wave_barrier(); asm volatile("s_waitcnt lgkmcnt(0)" ::: "memory");
    }
}

template <bool FP8 = false>
__device__ __forceinline__ void tr_item(const float* W, int ldw, int k0, int c0, int cstride, float scale, bf16_t* dstrow0, LAS float* scr, int lane) {
    float wv_[32];
#pragma unroll
    for (int i = 0; i < 32; ++i) wv_[i] = W[(size_t)(k0 + 2 * i + (lane >> 5)) * ldw + c0 + (lane & 31) * cstride];
#pragma unroll
    for (int i = 0; i < 32; ++i) scr[(2 * i + (lane >> 5)) * 33 + (lane & 31)] = wv_[i] * scale;
    asm volatile("s_waitcnt lgkmcnt(0)" ::: "memory"); __builtin_amdgcn_wave_barrier();
    const int c = lane & 7;
#pragma unroll
    for (int j = 0; j < 4; ++j) { const int n = (lane >> 3) + 8 * j; const LAS float* s = scr + (8 * c) * 33 + n;
        if (FP8) { u32x2 o; o.x = gm::pk4_fp8(s[0 * 33], s[1 * 33], s[2 * 33], s[3 * 33]); o.y = gm::pk4_fp8(s[4 * 33], s[5 * 33], s[6 * 33], s[7 * 33]);
            *(u32x2*)((unsigned char*)dstrow0 + (size_t)n * 1024 + k0 + 8 * c) = o; }
        else { u32x4 o; o.x = pk2(s[0 * 33], s[1 * 33]); o.y = pk2(s[2 * 33], s[3 * 33]); o.z = pk2(s[4 * 33], s[5 * 33]); o.w = pk2(s[6 * 33], s[7 * 33]);
            *(u32x4*)(dstrow0 + (size_t)n * 1024 + k0 + 8 * c) = o; } }
    asm volatile("s_waitcnt lgkmcnt(0)" ::: "memory"); __builtin_amdgcn_wave_barrier();
}
__device__ __forceinline__ void fold_item(const float* win, const float* wa, int dir, int k0, int j0, bf16_t* dstrow0, LAS float* scr, int lane) {
#pragma unroll 4
    for (int i = 0; i < 32; ++i) { const int kk = 2 * i + (lane >> 5); const float* wr = win + (size_t)(k0 + kk) * INW + 1536 + 16 * dir; float s = 0.f;
#pragma unroll
        for (int r = 0; r < 16; ++r) s += wr[r] * wa[r * 256 + j0 + (lane & 31)];
        scr[kk * 33 + (lane & 31)] = s; }
    asm volatile("s_waitcnt lgkmcnt(0)" ::: "memory"); __builtin_amdgcn_wave_barrier();
    const int c = lane & 7;
#pragma unroll
    for (int j = 0; j < 4; ++j) { const int n = (lane >> 3) + 8 * j; const LAS float* s = scr + (8 * c) * 33 + n;
        u32x4 o; o.x = pk2(s[0 * 33], s[1 * 33]); o.y = pk2(s[2 * 33], s[3 * 33]); o.z = pk2(s[4 * 33], s[5 * 33]); o.w = pk2(s[6 * 33], s[7 * 33]);
        *(u32x4*)(dstrow0 + (size_t)n * 1024 + k0 + 8 * c) = o; }
    asm volatile("s_waitcnt lgkmcnt(0)" ::: "memory"); __builtin_amdgcn_wave_barrier();
}
__device__ __forceinline__ void ln_mod_row(const float* xrow, const float* shift, const float* scale, bf16_t* orow, int lane) {
    const f32x4* xr = (const f32x4*)xrow + lane;
    f32x4 v[4]; float s = 0.f;
#pragma unroll
    for (int j = 0; j < 4; ++j) { v[j] = xr[64 * j]; s += (v[j][0] + v[j][1]) + (v[j][2] + v[j][3]); }
    const float mean = wave_sum(s) * (1.f / D); float s2 = 0.f;
#pragma unroll
    for (int j = 0; j < 4; ++j) { v[j] = v[j] - mean; s2 += (v[j][0] * v[j][0] + v[j][1] * v[j][1]) + (v[j][2] * v[j][2] + v[j][3] * v[j][3]); }
    const float rstd = 1.f / sqrtf(wave_sum(s2) * (1.f / D) + LN_EPS);
    u32x2* o8 = (u32x2*)orow + lane;
#pragma unroll
    for (int j = 0; j < 4; ++j) { const f32x4 sh = ((const f32x4*)shift)[64 * j + lane], sc = ((const f32x4*)scale)[64 * j + lane];
        const f32x4 y = v[j] * rstd * (sc + 1.f) + sh;
        u32x2 w; w.x = pk2(y[0], y[1]); w.y = pk2(y[2], y[3]); o8[64 * j] = w; }
}
constexpr int PREP_I_IN = 16 * 96, PREP_I_FOLD = 16 * 8 * 2, PREP_I_OUT = 16 * 32, PREP_I_W1 = NE * 16 * 64, PREP_I_W2 = NE * 16 * 32;
constexpr int PREP_NITEMS = PREP_I_IN + PREP_I_FOLD + PREP_I_OUT + PREP_I_W1 + PREP_I_W2;
constexpr int PREP_DEFER = 10880;
__device__ __forceinline__ void prep_items(const Args& a, LAS float* scr, int first, int last, int rank, int nranks, int lane) {
    constexpr int I_IN = PREP_I_IN, I_FOLD = PREP_I_FOLD, I_OUT = PREP_I_OUT, I_W1 = PREP_I_W1;
    const float* win = a.in[I_WIN];
    bf16_t* btin = (bf16_t*)(a.ws + WS_BTIN); bf16_t* btout = (bf16_t*)(a.ws + WS_BTOUT); bf16_t* w1t = (bf16_t*)(a.ws + WS_W1T); bf16_t* w2t = (bf16_t*)(a.ws + WS_W2T);
    for (int it = first + rank; it < last; it += nranks) {
        int r = it;
        if (r < I_IN) {
            const int kb = r / 96, nb = r % 96;
            if (nb < 48) tr_item(win, INW, 64 * kb, 32 * nb, 1, nb < 8 ? 0.125f : 1.f, btin + (size_t)(32 * nb) * 1024, scr, lane);
            else tr_item(win, INW, 64 * kb, 1568 + 32 * (nb - 48), 1, 1.f, btin + (size_t)(2048 + 32 * (nb - 48)) * 1024, scr, lane);
            continue; }
        r -= I_IN;
        if (r < I_FOLD) { const int dir = r & 1, jb = (r >> 1) & 7, kb = r >> 4;
            fold_item(win, dir ? a.in[I_WAB] : a.in[I_WAF], dir, 64 * kb, 32 * jb, btin + (size_t)(1536 + 256 * dir + 32 * jb) * 1024, scr, lane); continue; }
        r -= I_FOLD;
        if (r < I_OUT) { const int kb = r / 32, nb = r % 32; tr_item(a.in[I_WOUT], 1024, 64 * kb, 32 * nb, 1, 1.f, btout + (size_t)(32 * nb) * 1024, scr, lane); continue; }
        r -= I_OUT;
        if (r < I_W1) {
            const int e = r / 1024, q = r % 1024, s = q & 1, nb = (q >> 1) & 31, kb = q >> 6;
            const int ct = nb >> 2, jj0 = (nb & 3) * 32;
            tr_item<true>(a.in[I_EW1] + (size_t)e * 1024 * 2048, 2048, 64 * kb, 2 * (128 * ct + jj0) + s, 2, gm::S_W, (bf16_t*)((unsigned char*)w1t + ((size_t)e * 2048 + 256 * ct + 128 * s + jj0) * 1024), scr, lane);
            continue; }
        r -= I_W1;
        { const int e = r / 512, q = r % 512, kb = q / 32, nb = q % 32;
          tr_item<true>(a.in[I_EW2] + (size_t)e * 1024 * 1024, 1024, 64 * kb, 32 * nb, 1, gm::S_W, (bf16_t*)((unsigned char*)w2t + ((size_t)e * 1024 + 32 * nb) * 1024), scr, lane); }
    }
}
__device__ __forceinline__ void p1_prep(const Args& a, LAS unsigned char* lds) {
    const int tid = threadIdx.x, lane = tid & 63, wave = tid >> 6;
    LAS float* scr = (LAS float*)(lds + wave * 16384);
    const int gw = blockIdx.x * NWAVES + wave, NGW = gridDim.x * NWAVES;
    const float* win = a.in[I_WIN];
    bf16_t* btin = (bf16_t*)(a.ws + WS_BTIN); bf16_t* btout = (bf16_t*)(a.ws + WS_BTOUT); bf16_t* w1t = (bf16_t*)(a.ws + WS_W1T); bf16_t* w2t = (bf16_t*)(a.ws + WS_W2T);
    const float* mod = (const float*)(a.ws + WS_MOD);
    bf16_t* H = (bf16_t*)(a.ws + WS_H);
    { int cur_mr = -1; f32x4 shv[4], scv[4];
#pragma unroll
      for (int j = 0; j < 4; ++j) { shv[j] = (f32x4){0.f, 0.f, 0.f, 0.f}; scv[j] = shv[j]; }
      for (int row0 = gw; row0 < TT; row0 += 4 * NGW) {
        f32x4 xv[4][4];
#pragma unroll
        for (int i = 0; i < 4; ++i) { const int row = row0 + i * NGW;
            if (row < TT) { const f32x4* xr = (const f32x4*)(row < T ? a.in[I_X] + (size_t)row * D : a.in[I_CTX] + (size_t)(row - T) * D) + lane;
#pragma unroll
                for (int j = 0; j < 4; ++j) xv[i][j] = xr[64 * j]; } }
#pragma unroll
        for (int i = 0; i < 4; ++i) { const int row = row0 + i * NGW;
            if (row < TT) { const int mr = row < T ? row >> 13 : 4;
                if (mr != cur_mr) { cur_mr = mr;
#pragma unroll
                    for (int j = 0; j < 4; ++j) { shv[j] = ((const f32x4*)(mod + mr * 6144))[64 * j + lane]; scv[j] = ((const f32x4*)(mod + mr * 6144 + 1024))[64 * j + lane]; } }
                f32x4 v[4]; float s = 0.f;
#pragma unroll
                for (int j = 0; j < 4; ++j) { v[j] = xv[i][j]; s += (v[j][0] + v[j][1]) + (v[j][2] + v[j][3]); }
                const float mean = wave_sum(s) * (1.f / D); float s2 = 0.f;
#pragma unroll
                for (int j = 0; j < 4; ++j) { v[j] = v[j] - mean; s2 += (v[j][0] * v[j][0] + v[j][1] * v[j][1]) + (v[j][2] * v[j][2] + v[j][3] * v[j][3]); }
                const float rstd = 1.f / sqrtf(wave_sum(s2) * (1.f / D) + LN_EPS);
                u32x2* o8 = (u32x2*)(H + (size_t)row * D) + lane;
#pragma unroll
                for (int j = 0; j < 4; ++j) { const f32x4 y = v[j] * rstd * (scv[j] + 1.f) + shv[j];
                    u32x2 w; w.x = pk2(y[0], y[1]); w.y = pk2(y[2], y[3]); o8[64 * j] = w; } } }
      } }
    prep_items(a, scr, 0, PREP_I_IN + PREP_I_FOLD + PREP_I_OUT, gw, NGW, lane);
    prep_items(a, scr, PREP_I_IN + PREP_I_FOLD + PREP_I_OUT + PREP_I_W1, PREP_NITEMS - PREP_DEFER, gw, NGW, lane);
    for (int it = gw; it < 2048; it += NGW) hy::filter_item(a, it, lane);
    float* b1r = (float*)(a.ws + WS_B1R); const float* eb1 = a.in[I_EB1];
    for (int i = blockIdx.x * NTHREADS + tid; i < NE * 2048; i += gridDim.x * NTHREADS) {
        const int e = i >> 11, n = i & 2047, ct = n >> 8, s = (n >> 7) & 1, jj = n & 127;
        b1r[i] = eb1[(size_t)e * 2048 + 2 * (128 * ct + jj) + s];
    }
}

namespace gla {
constexpr int RS = 72;
constexpr int L_TOTF = 0, L_TOTB = 2048, L_SSQ = 4096;
constexpr int L_T0 = 8192;
constexpr int L_T1 = L_T0 + 9216, L_T2 = L_T1 + 9216, L_T3 = L_T2 + 9216;
constexpr int L_VT = L_T3 + 9216;
constexpr int L_P  = L_VT + 18432;
constexpr int L_SF = L_P + 9216, L_SB = L_SF + 18432;
constexpr int L_END = L_SB + 18432;

__device__ __forceinline__ bf16x8 frag(const LAS unsigned char* tile, int row, int k0, int lane) {
    return *(const LAS bf16x8*)(tile + ((row + (lane & 15)) * RS + k0 + 8 * (lane >> 4)) * 2);
}
__device__ __forceinline__ void chunk_cums_pre(LAS unsigned char* L, const float (&gf)[8], const float (&gb)[8], int wave, int lane, float (&cumf)[8], float (&cumb)[8], float& allf, float& allb) {
    LAS float* totf = (LAS float*)(L + L_TOTF); LAS float* totb = (LAS float*)(L + L_TOTB);
    cumf[0] = gf[0];
#pragma unroll
    for (int r = 1; r < 8; ++r) cumf[r] = cumf[r - 1] + gf[r];
    cumb[7] = gb[7];
#pragma unroll
    for (int r = 6; r >= 0; --r) cumb[r] = cumb[r + 1] + gb[r];
    totf[wave * 64 + lane] = cumf[7]; totb[wave * 64 + lane] = cumb[0];
    __syncthreads();
    float of = 0.f, ob = 0.f, af = 0.f, ab = 0.f;
#pragma unroll
    for (int w = 0; w < 8; ++w) { const float tf = totf[w * 64 + lane], tb = totb[w * 64 + lane]; af += tf; ab += tb; of += (w < wave) ? tf : 0.f; ob += (w > wave) ? tb : 0.f; }
#pragma unroll
    for (int r = 0; r < 8; ++r) { cumf[r] += of; cumb[r] += ob; }
    allf = af; allb = ab;
}
__device__ __forceinline__ void chunk_cums(LAS unsigned char* L, const _Float16* GF, const _Float16* GB, size_t tok0, int h, int wave, int lane, float (&cumf)[8], float (&cumb)[8], float& allf, float& allb) {
    float gf[8], gb[8];
#pragma unroll
    for (int r = 0; r < 8; ++r) { const size_t o = (tok0 + 8 * wave + r) * 256 + h * 64 + lane; gf[r] = (float)GF[o]; gb[r] = (float)GB[o]; }
    chunk_cums_pre(L, gf, gb, wave, lane, cumf, cumb, allf, allb);
}
__device__ __forceinline__ void store_vt(LAS unsigned char* L, const u32x4 (&vr)[2], int tid) {
    LAS bf16_t* vt = (LAS bf16_t*)(L + L_VT);
    const int j = tid >> 3, c8 = tid & 7;
#pragma unroll
    for (int q = 0; q < 2; ++q) { const int dv0 = 8 * (c8 + 8 * q);
        const unsigned ww[4] = {vr[q].x, vr[q].y, vr[q].z, vr[q].w};
#pragma unroll
        for (int e = 0; e < 4; ++e) { vt[(dv0 + 2 * e) * RS + j] = (bf16_t)(ww[e] & 0xffffu); vt[(dv0 + 2 * e + 1) * RS + j] = (bf16_t)(ww[e] >> 16); } }
}
__device__ __forceinline__ void load_vt(LAS unsigned char* L, const bf16_t* V, size_t tok0, int h, int tid) {
    const int j = tid >> 3, c8 = tid & 7; u32x4 vr[2];
#pragma unroll
    for (int q = 0; q < 2; ++q) vr[q] = *(const u32x4*)(V + (tok0 + j) * 512 + h * 128 + 8 * (c8 + 8 * q));
    store_vt(L, vr, tid);
}

__device__ __forceinline__ void g1_unit(const Args& a, LAS unsigned char* L, int bh, int chunk  ) {
    const int tid = threadIdx.x, lane = tid & 63, wave = __builtin_amdgcn_readfirstlane(tid >> 6);
    const int b = bh >> 2, h = bh & 3;
    const size_t tok0 = chunk < NCHUNK ? (size_t)b * SEQ + (size_t)chunk * CH : (size_t)T + (size_t)b * CTXL + (size_t)(chunk - NCHUNK) * CH;
    const _Float16* GF = (const _Float16*)(a.ws + WS_GF); const _Float16* GB = (const _Float16*)(a.ws + WS_GB);
    const bf16_t* Kb = (const bf16_t*)(a.ws + WS_K); const bf16_t* Vb = (const bf16_t*)(a.ws + WS_V);
    float cumf[8], cumb[8], allf, allb;
    __syncthreads();
    chunk_cums(L, GF, GB, tok0, h, wave, lane, cumf, cumb, allf, allb);
    LAS bf16_t* ketf = (LAS bf16_t*)(L + L_T0); LAS bf16_t* ketb = (LAS bf16_t*)(L + L_T1);
#pragma unroll
    for (int r = 0; r < 8; ++r) { const int i = 8 * wave + r; const float kv = bf2f(Kb[(tok0 + i) * 256 + h * 64 + lane]);
        ketf[lane * RS + i] = f2bf(kv * __expf(allf - cumf[r])); ketb[lane * RS + i] = f2bf(kv * __expf(allb - cumb[r])); }
    load_vt(L, Vb, tok0, h, tid);
    if (wave == 0) { float* av = (float*)(a.ws + WS_AV); av[((size_t)(0 * 16 + bh) * NCT + chunk) * 64 + lane] = __expf(allf); av[((size_t)(1 * 16 + bh) * NCT + chunk) * 64 + lane] = __expf(allb); }
    __syncthreads();
    bf16_t* KV = (bf16_t*)(a.ws + WS_KV);
#pragma unroll
    for (int dir = 0; dir < 2; ++dir) {
        const LAS unsigned char* ket = L + (dir ? L_T1 : L_T0);
        bf16_t* dst = KV + ((size_t)(dir * 16 + bh) * NCT + chunk) * 8192;
#pragma unroll
        for (int nt = 0; nt < 4; ++nt) { f32x4 acc = {0.f, 0.f, 0.f, 0.f};
#pragma unroll
            for (int ks = 0; ks < 2; ++ks) acc = __builtin_amdgcn_mfma_f32_16x16x32_bf16(frag(ket, 16 * nt, 32 * ks, lane), frag(L + L_VT, 16 * wave, 32 * ks, lane), acc, 0, 0, 0);
            u32x2 w; w.x = pk2(acc[0], acc[1]); w.y = pk2(acc[2], acc[3]);
            *(u32x2*)(dst + (16 * wave + (lane & 15)) * 64 + 16 * nt + 4 * (lane >> 4)) = w; }
    }
}

__device__ __forceinline__ void g2_scan(const Args& a) {
    const bf16_t* KV = (const bf16_t*)(a.ws + WS_KV); const float* AV = (const float*)(a.ws + WS_AV); bf16_t* SP = (bf16_t*)(a.ws + WS_SP);
    for (int id = blockIdx.x * NTHREADS + threadIdx.x; id < 32 * 4096; id += gridDim.x * NTHREADS) {
        const int db = id >> 12, e2 = id & 4095, dir = db >> 4, dk = (2 * e2) & 63;
        const unsigned* kv = (const unsigned*)(KV + (size_t)db * NCT * 8192) + e2;
        const float* av = AV + (size_t)db * NCT * 64 + dk;
        unsigned* sp = (unsigned*)(SP + (size_t)db * NCHUNK * 8192) + e2;
        float s0 = 0.f, s1 = 0.f;
#pragma unroll
        for (int q = 0; q < NCC; ++q) { const int c = NCHUNK + (dir ? (NCC - 1 - q) : q);
            const unsigned w = kv[(size_t)c * 4096]; const f32x2 aa = *(const f32x2*)(av + (size_t)c * 64);
            s0 = aa[0] * s0 + bflo(w); s1 = aa[1] * s1 + bfhi(w); }
        for (int q0 = 0; q0 < NCHUNK; q0 += 16) {
            unsigned w[16]; f32x2 aa[16];
#pragma unroll
            for (int u = 0; u < 16; ++u) { const int c = dir ? (NCHUNK - 1 - (q0 + u)) : (q0 + u); w[u] = kv[(size_t)c * 4096]; aa[u] = *(const f32x2*)(av + (size_t)c * 64); }
#pragma unroll
            for (int u = 0; u < 16; ++u) { const int c = dir ? (NCHUNK - 1 - (q0 + u)) : (q0 + u);
                sp[(size_t)c * 4096] = pk2(s0, s1);
                s0 = aa[u][0] * s0 + bflo(w[u]); s1 = aa[u][1] * s1 + bfhi(w[u]); }
        }
    }
}

struct G3In { float gf[8], gb[8]; bf16_t q[8], k[8]; u32x4 v[2]; u32x4 sraw[4]; bf16_t gr[4][4]; };
__device__ __forceinline__ void g3_load(const Args& a, int bh, int chunk, G3In& in) {
    const int tid = threadIdx.x, lane = tid & 63, wave = __builtin_amdgcn_readfirstlane(tid >> 6);
    const int b = bh >> 2, h = bh & 3;
    const size_t tok0 = (size_t)b * SEQ + (size_t)chunk * CH;
    const _Float16* GF = (const _Float16*)(a.ws + WS_GF); const _Float16* GB = (const _Float16*)(a.ws + WS_GB);
    const bf16_t* Qb = (const bf16_t*)(a.ws + WS_Q); const bf16_t* Kb = (const bf16_t*)(a.ws + WS_K); const bf16_t* Vb = (const bf16_t*)(a.ws + WS_V);
#pragma unroll
    for (int r = 0; r < 8; ++r) { const size_t o = (tok0 + 8 * wave + r) * 256 + h * 64 + lane; in.gf[r] = (float)GF[o]; in.gb[r] = (float)GB[o]; in.q[r] = Qb[o]; in.k[r] = Kb[o]; }
#pragma unroll
    for (int q = 0; q < 2; ++q) in.v[q] = *(const u32x4*)(Vb + (tok0 + (tid >> 3)) * 512 + h * 128 + 8 * ((tid & 7) + 8 * q));
    const bf16_t* SPf = (const bf16_t*)(a.ws + WS_SP) + ((size_t)(0 * 16 + bh) * NCHUNK + chunk) * 8192;
    const bf16_t* SPb = (const bf16_t*)(a.ws + WS_SP) + ((size_t)(1 * 16 + bh) * NCHUNK + chunk) * 8192;
    in.sraw[0] = *(const u32x4*)(SPf + 16 * tid); in.sraw[1] = *(const u32x4*)(SPf + 16 * tid + 8);
    in.sraw[2] = *(const u32x4*)(SPb + 16 * tid); in.sraw[3] = *(const u32x4*)(SPb + 16 * tid + 8);
    const bf16_t* Gt = (const bf16_t*)(a.ws + WS_G);
    const int mt = wave >> 1, fr = lane & 15, fq = lane >> 4;
#pragma unroll
    for (int q = 0; q < 4; ++q)
#pragma unroll
        for (int r = 0; r < 4; ++r) in.gr[r][q] = Gt[(tok0 + 16 * mt + 4 * fq + r) * 512 + h * 128 + 16 * (4 * (wave & 1) + q) + fr];
}
__device__ __forceinline__ void g3_unit(const Args& a, LAS unsigned char* L, int bh, int chunk  , const G3In& in) {
    const int tid = threadIdx.x, lane = tid & 63, wave = __builtin_amdgcn_readfirstlane(tid >> 6);
    const int b = bh >> 2, h = bh & 3;
    const size_t tok0 = (size_t)b * SEQ + (size_t)chunk * CH;
    const int mt = wave >> 1, fr = lane & 15, fq = lane >> 4;
    float cumf[8], cumb[8], allf, allb;
    __syncthreads();
    chunk_cums_pre(L, in.gf, in.gb, wave, lane, cumf, cumb, allf, allb);
    LAS bf16_t* qf = (LAS bf16_t*)(L + L_T0); LAS bf16_t* kf = (LAS bf16_t*)(L + L_T1); LAS bf16_t* qb = (LAS bf16_t*)(L + L_T2); LAS bf16_t* kb = (LAS bf16_t*)(L + L_T3);
#pragma unroll
    for (int r = 0; r < 8; ++r) { const int i = 8 * wave + r;
        const float qv = bf2f(in.q[r]), kv = bf2f(in.k[r]);
        qf[i * RS + lane] = f2bf(qv * __expf(cumf[r])); kf[i * RS + lane] = f2bf(kv * __expf(-cumf[r]));
        qb[i * RS + lane] = f2bf(qv * __expf(cumb[r])); kb[i * RS + lane] = f2bf(kv * __expf(-cumb[r])); }
    store_vt(L, in.v, tid);
    {
      LAS unsigned char* sf_ = L + L_SF + ((tid >> 2) * RS + 16 * (tid & 3)) * 2; LAS unsigned char* sb_ = L + L_SB + ((tid >> 2) * RS + 16 * (tid & 3)) * 2;
      *(LAS u32x4*)sf_ = in.sraw[0]; *(LAS u32x4*)(sf_ + 16) = in.sraw[1]; *(LAS u32x4*)sb_ = in.sraw[2]; *(LAS u32x4*)(sb_ + 16) = in.sraw[3]; }
    __syncthreads();
    {
        LAS bf16_t* P = (LAS bf16_t*)(L + L_P);
#pragma unroll
        for (int q = 0; q < 2; ++q) { const int nt = 2 * (wave & 1) + q;
            f32x4 sf = {0.f, 0.f, 0.f, 0.f}, sb = {0.f, 0.f, 0.f, 0.f};
#pragma unroll
            for (int ks = 0; ks < 2; ++ks) {
                sf = __builtin_amdgcn_mfma_f32_16x16x32_bf16(frag(L + L_T0, 16 * mt, 32 * ks, lane), frag(L + L_T1, 16 * nt, 32 * ks, lane), sf, 0, 0, 0);
                sb = __builtin_amdgcn_mfma_f32_16x16x32_bf16(frag(L + L_T2, 16 * mt, 32 * ks, lane), frag(L + L_T3, 16 * nt, 32 * ks, lane), sb, 0, 0, 0); }
#pragma unroll
            for (int r = 0; r < 4; ++r) { const int i = 16 * mt + 4 * fq + r, j = 16 * nt + fr;
                P[i * RS + j] = f2bf((j <= i ? sf[r] : 0.f) + (j >= i ? sb[r] : 0.f)); } }
    }
    __syncthreads();
    f32x4 o[4]; float ssq[4] = {0.f, 0.f, 0.f, 0.f};
#pragma unroll
    for (int q = 0; q < 4; ++q) { const int nt = 4 * (wave & 1) + q;
        f32x4 acc = {0.f, 0.f, 0.f, 0.f};
#pragma unroll
        for (int ks = 0; ks < 2; ++ks) {
            acc = __builtin_amdgcn_mfma_f32_16x16x32_bf16(frag(L + L_P, 16 * mt, 32 * ks, lane), frag(L + L_VT, 16 * nt, 32 * ks, lane), acc, 0, 0, 0);
            acc = __builtin_amdgcn_mfma_f32_16x16x32_bf16(frag(L + L_T0, 16 * mt, 32 * ks, lane), frag(L + L_SF, 16 * nt, 32 * ks, lane), acc, 0, 0, 0);
            acc = __builtin_amdgcn_mfma_f32_16x16x32_bf16(frag(L + L_T2, 16 * mt, 32 * ks, lane), frag(L + L_SB, 16 * nt, 32 * ks, lane), acc, 0, 0, 0); }
        o[q] = acc;
#pragma unroll
        for (int r = 0; r < 4; ++r) ssq[r] += acc[r] * acc[r]; }
    LAS float* SSQ = (LAS float*)(L + L_SSQ);
#pragma unroll
    for (int r = 0; r < 4; ++r) { float s = ssq[r]; s += __shfl_xor(s, 1); s += __shfl_xor(s, 2); s += __shfl_xor(s, 4); s += __shfl_xor(s, 8); ssq[r] = s; }
    if (fr == 0) {
#pragma unroll
        for (int r = 0; r < 4; ++r) SSQ[(wave & 1) * 64 + 16 * mt + 4 * fq + r] = ssq[r]; }
    __syncthreads();
    const float* ng = a.in[I_NORMG];
    bf16_t* mix = (bf16_t*)(a.ws + WS_MIX);
#pragma unroll
    for (int r = 0; r < 4; ++r) { const int i = 16 * mt + 4 * fq + r;
        const float rstd = 1.f / sqrtf((SSQ[i] + SSQ[64 + i]) * (1.f / DV) + LN_EPS);
#pragma unroll
        for (int q = 0; q < 4; ++q) { const int dv = 16 * (4 * (wave & 1) + q) + fr;
            const float g = bf2f(in.gr[r][q]);
            mix[(tok0 + i) * 1024 + h * 128 + dv] = f2bf(o[q][r] * rstd * ng[dv] * silu_f(g)); } }
}
}

namespace rt {
constexpr int HS = 1028;
constexpr int L_H2 = 0;
constexpr int L_PART = 65792;
constexpr int L_LCNT = L_PART + 16384;
constexpr int L_REC = L_LCNT + 256;
constexpr int L_TAB = 86016;

__device__ __forceinline__ void phase(const Args& a, LAS unsigned char* lds) {
    const int tid = threadIdx.x, lane = tid & 63, wave = __builtin_amdgcn_readfirstlane(tid >> 6);
    bf16_t* xmid = (bf16_t*)(a.ws + WS_PRE1); bf16_t* H2 = (bf16_t*)(a.ws + WS_H2); const bf16_t* FG = (const bf16_t*)(a.ws + WS_FG);
    const float* mod = (const float*)(a.ws + WS_MOD);
    const float* rw = a.in[I_RW]; const float* rb = a.in[I_RB];
    LAS float* h2s = (LAS float*)(lds + L_H2); LAS float* part = (LAS float*)(lds + L_PART);
    LAS int* lcnt = (LAS int*)(lds + L_LCNT); LAS int* lbase = lcnt + 32; LAS int* rec = (LAS int*)(lds + L_REC);
    unsigned* cnt = (unsigned*)(a.ws + WS_CNT); int* list = (int*)(a.ws + WS_LIST); float* pw = (float*)(a.ws + WS_PW); int* ploc = (int*)(a.ws + WS_PLOC);
    bf16x8 rwh[4][2], rwl[4][2];
#pragma unroll
    for (int s = 0; s < 4; ++s)
#pragma unroll
        for (int nt = 0; nt < 2; ++nt)
#pragma unroll
            for (int i = 0; i < 8; ++i) { const float x = rw[(size_t)(128 * wave + 32 * s + 8 * (lane >> 4) + i) * 32 + 16 * nt + (lane & 15)];
                const unsigned hb = __float_as_uint(x) & 0xffff0000u; rwh[s][nt][i] = (short)(hb >> 16); rwl[s][nt][i] = (short)f2bf(x - __uint_as_float(hb)); }
    LAS f32x4* g1 = (LAS f32x4*)(lds + L_TAB); LAS f32x4* bb1 = g1 + 256; LAS f32x4* shT = bb1 + 256; LAS f32x4* scT = shT + 4 * 256;
    if (tid < 256) { g1[tid] = ((const f32x4*)a.in[I_LN1G])[tid]; bb1[tid] = ((const f32x4*)a.in[I_LN1B])[tid]; }
    for (int i = tid; i < 4 * 256; i += NTHREADS) { shT[i] = ((const f32x4*)(mod + (i >> 8) * 6144 + 3 * 1024))[i & 255]; scT[i] = ((const f32x4*)(mod + (i >> 8) * 6144 + 4 * 1024))[i & 255]; }
    const float rbe = rb[lane & 31];
    if (tid < 32) lcnt[tid] = 0;
    int pend = 0, pgrp = -1;
    f32x4 xq[2][4]; u32x2 fq_[2][4];
#define RT_LOAD(g_) do { _Pragma("unroll") for (int rr = 0; rr < 2; ++rr) { const int t_ = (g_) * 16 + 2 * wave + rr; \
        const f32x4* xr_ = (const f32x4*)(a.in[I_X] + (size_t)t_ * D) + lane; const u32x2* fr_ = (const u32x2*)(FG + (size_t)t_ * D) + lane; \
        _Pragma("unroll") for (int j = 0; j < 4; ++j) { xq[rr][j] = xr_[64 * j]; fq_[rr][j] = fr_[64 * j]; } } } while (0)
    if ((int)blockIdx.x < T / 16) RT_LOAD((int)blockIdx.x);
    for (int grp = blockIdx.x; grp < T / 16; grp += gridDim.x) {
        __syncthreads();
        f32x4 xv_[2][4]; u32x2 fv_[2][4];
#pragma unroll
        for (int rr = 0; rr < 2; ++rr)
#pragma unroll
            for (int j = 0; j < 4; ++j) { xv_[rr][j] = xq[rr][j]; fv_[rr][j] = fq_[rr][j]; }
        if (pgrp >= 0) { if (tid < 32) lbase[tid] = pend; __syncthreads();
            if (tid < 64) { const int rc = rec[tid], ek = rc & 255, rank = rc >> 8, pos = lbase[ek] + rank, pair = (pgrp * 16 + (tid >> 2)) * 4 + (tid & 3);
                list[(size_t)ek * CAP + pos] = pair; ploc[pair] = ek | (pos << 5); } }
        if (grp + (int)gridDim.x < T / 16) RT_LOAD(grp + (int)gridDim.x);
#pragma unroll
        for (int rr = 0; rr < 2; ++rr) {
            const int lr = 2 * wave + rr, t = grp * 16 + lr, b = t >> 13;
            u32x2* pr = (u32x2*)(xmid + (size_t)t * D) + lane;
            f32x4 v[4]; float s = 0.f;
#pragma unroll
            for (int j = 0; j < 4; ++j) { const u32x2 fw = fv_[rr][j]; const f32x4 ff = {bflo(fw.x), bfhi(fw.x), bflo(fw.y), bfhi(fw.y)};
                v[j] = xv_[rr][j] * ALPHA + ff; s += (v[j][0] + v[j][1]) + (v[j][2] + v[j][3]); }
            float mean = wave_sum(s) * (1.f / D), s2 = 0.f;
#pragma unroll
            for (int j = 0; j < 4; ++j) { v[j] = v[j] - mean; s2 += (v[j][0] * v[j][0] + v[j][1] * v[j][1]) + (v[j][2] * v[j][2] + v[j][3] * v[j][3]); }
            float rstd = 1.f / sqrtf(wave_sum(s2) * (1.f / D) + LN_EPS);
            s = 0.f;
#pragma unroll
            for (int j = 0; j < 4; ++j) { v[j] = v[j] * rstd * g1[64 * j + lane] + bb1[64 * j + lane]; u32x2 w; w.x = pk2(v[j][0], v[j][1]); w.y = pk2(v[j][2], v[j][3]); pr[64 * j] = w;
                v[j] = (f32x4){bflo(w.x), bfhi(w.x), bflo(w.y), bfhi(w.y)}; s += (v[j][0] + v[j][1]) + (v[j][2] + v[j][3]); }
            mean = wave_sum(s) * (1.f / D); s2 = 0.f;
#pragma unroll
            for (int j = 0; j < 4; ++j) { v[j] = v[j] - mean; s2 += (v[j][0] * v[j][0] + v[j][1] * v[j][1]) + (v[j][2] * v[j][2] + v[j][3] * v[j][3]); }
            rstd = 1.f / sqrtf(wave_sum(s2) * (1.f / D) + LN_EPS);
            const LAS f32x4* sh = shT + b * 256; const LAS f32x4* sc = scT + b * 256;
            unsigned* o4 = (unsigned*)((unsigned char*)H2 + (size_t)t * D) + lane;
#pragma unroll
            for (int j = 0; j < 4; ++j) { const f32x4 y = v[j] * rstd * (sc[64 * j + lane] + 1.f) + sh[64 * j + lane];
                o4[64 * j] = gm::pk4_fp8(y[0] * gm::S_H2, y[1] * gm::S_H2, y[2] * gm::S_H2, y[3] * gm::S_H2);
                *(LAS f32x4*)(h2s + lr * HS + 256 * j + 4 * lane) = y; }
        }
        __syncthreads();
        {
            f32x4 acc0 = {0.f, 0.f, 0.f, 0.f}, acc1 = {0.f, 0.f, 0.f, 0.f};
            const LAS float* ap = h2s + (lane & 15) * HS + 128 * wave + 8 * (lane >> 4);
#pragma unroll
            for (int s = 0; s < 4; ++s) { const f32x4 x0 = *(const LAS f32x4*)(ap + 32 * s), x1 = *(const LAS f32x4*)(ap + 32 * s + 4);
                bf16x8 ah, al;
#pragma unroll
                for (int i = 0; i < 8; ++i) { const float x = i < 4 ? x0[i] : x1[i - 4]; const unsigned hb = __float_as_uint(x) & 0xffff0000u; ah[i] = (short)(hb >> 16); al[i] = (short)f2bf(x - __uint_as_float(hb)); }
                acc0 = __builtin_amdgcn_mfma_f32_16x16x32_bf16(ah, rwh[s][0], acc0, 0, 0, 0); acc1 = __builtin_amdgcn_mfma_f32_16x16x32_bf16(ah, rwh[s][1], acc1, 0, 0, 0);
                acc0 = __builtin_amdgcn_mfma_f32_16x16x32_bf16(ah, rwl[s][0], acc0, 0, 0, 0); acc1 = __builtin_amdgcn_mfma_f32_16x16x32_bf16(ah, rwl[s][1], acc1, 0, 0, 0);
                acc0 = __builtin_amdgcn_mfma_f32_16x16x32_bf16(al, rwh[s][0], acc0, 0, 0, 0); acc1 = __builtin_amdgcn_mfma_f32_16x16x32_bf16(al, rwh[s][1], acc1, 0, 0, 0); }
#pragma unroll
            for (int r = 0; r < 4; ++r) { part[(wave * 16 + 4 * (lane >> 4) + r) * 32 + (lane & 15)] = acc0[r]; part[(wave * 16 + 4 * (lane >> 4) + r) * 32 + 16 + (lane & 15)] = acc1[r]; }
        }
        __syncthreads();
        {
            const int lr = 2 * wave + (lane >> 5), e = lane & 31, t = grp * 16 + lr;
            float lg = rbe;
#pragma unroll
            for (int w = 0; w < 8; ++w) lg += part[(w * 16 + lr) * 32 + e];
            float cur = lg, tv[4]; int ti[4];
#pragma unroll
            for (int k = 0; k < 4; ++k) { float bv = cur; int bi = e;
#pragma unroll
                for (int o = 1; o < 32; o <<= 1) { const float ov = __shfl_xor(bv, o); const int oi = __shfl_xor(bi, o); if (ov > bv || (ov == bv && oi < bi)) { bv = ov; bi = oi; } }
                tv[k] = bv; ti[k] = bi; if (bi == e) cur = -3.0e38f; }
            const float e1 = __expf(tv[1] - tv[0]), e2 = __expf(tv[2] - tv[0]), e3 = __expf(tv[3] - tv[0]);
            const float inv = 1.f / (1.f + e1 + e2 + e3);
            if (e < 4) { const float wk = (e == 0 ? 1.f : (e == 1 ? e1 : (e == 2 ? e2 : e3))) * inv; const int ek = (e == 0 ? ti[0] : (e == 1 ? ti[1] : (e == 2 ? ti[2] : ti[3])));
                const int pair = t * 4 + e;
                pw[pair] = wk;
                const int rank = __hip_atomic_fetch_add((LAS int*)&lcnt[ek], 1, __ATOMIC_RELAXED, __HIP_MEMORY_SCOPE_WORKGROUP);
                rec[lr * 4 + e] = ek | (rank << 8); }
        }
        __syncthreads();
        if (tid < 32) { const int n = lcnt[tid]; pend = n ? (int)atomicAdd(&cnt[tid], (unsigned)n) : 0; lcnt[tid] = 0; }
        pgrp = grp;
    }
    if (pgrp >= 0) { __syncthreads(); if (tid < 32) lbase[tid] = pend; __syncthreads();
        if (tid < 64) { const int rc = rec[tid], ek = rc & 255, rank = rc >> 8, pos = lbase[ek] + rank, pair = (pgrp * 16 + (tid >> 2)) * 4 + (tid & 3);
            list[(size_t)ek * CAP + pos] = pair; ploc[pair] = ek | (pos << 5); } }
#undef RT_LOAD
}
}

__device__ __forceinline__ void p_final(const Args& a, LAS unsigned char* lds) {
    const int tid = threadIdx.x, lane = tid & 63, wave = tid >> 6;
    const bf16_t* xm = (const bf16_t*)(a.ws + WS_PRE1); const unsigned char* slots = (const unsigned char*)(a.ws + WS_SLOTS); const float* mod = (const float*)(a.ws + WS_MOD);
    const int* ploc = (const int*)(a.ws + WS_PLOC); const float* pw = (const float*)(a.ws + WS_PW);
    const f32x4* g2 = (const f32x4*)a.in[I_LN2G]; const f32x4* b2 = (const f32x4*)a.in[I_LN2B];
    LAS int* tstart = (LAS int*)lds;
    __syncthreads();
    if (tid == 0) { const unsigned* cnt = (const unsigned*)(a.ws + WS_CNT); int nrt = 0; for (int e = 0; e < NE; ++e) { tstart[e] = 256 * nrt; nrt += ((int)cnt[e] + 255) >> 8; } }
    LAS f32x4* Lg2 = (LAS f32x4*)(lds + 1024); LAS f32x4* Lb2 = Lg2 + 256; LAS f32x4* Lgt = Lb2 + 256;
    if (tid < 256) { Lg2[tid] = g2[tid]; Lb2[tid] = b2[tid]; }
    for (int i = tid; i < 4 * 256; i += NTHREADS) Lgt[i] = ((const f32x4*)(mod + (i >> 8) * 6144 + 5 * 1024))[i & 255];
    __syncthreads();
    const int tstep = gridDim.x * NWAVES; int t = blockIdx.x * NWAVES + wave;
    if (t < T) {
        int plc[4], pln[4]; float wc_[4], wn_[4]; unsigned qc[4][4], qn[4][4]; u32x2 xc[4], xn[4];
#define PF_IDX(tt, pl, ww) do { _Pragma("unroll") for (int sl = 0; sl < 4; ++sl) { pl[sl] = ploc[(tt) * 4 + sl]; ww[sl] = pw[(tt) * 4 + sl] * (1.f / gm::S_SL); } } while (0)
#define PF_DATA(tt, pl, qq, xx) do { _Pragma("unroll") for (int sl = 0; sl < 4; ++sl) { const unsigned* sr_ = (const unsigned*)(slots + (size_t)(tstart[pl[sl] & 31] + (pl[sl] >> 5)) * D) + lane; \
            _Pragma("unroll") for (int j = 0; j < 4; ++j) qq[sl][j] = sr_[64 * j]; } \
        { const u32x2* xr_ = (const u32x2*)(xm + (size_t)(tt) * D) + lane; _Pragma("unroll") for (int j = 0; j < 4; ++j) xx[j] = xr_[64 * j]; } } while (0)
        PF_IDX(t, plc, wc_); PF_DATA(t, plc, qc, xc);
        int tn = t + tstep; const bool hn0 = tn < T;
        if (hn0) PF_IDX(tn, pln, wn_);
        for (;;) {
            const bool hn = tn < T;
            if (hn) PF_DATA(tn, pln, qn, xn);
            int pl2[4]; float w2[4]; const int tn2 = tn + tstep; const bool hn2 = hn && tn2 < T;
            if (hn2) PF_IDX(tn2, pl2, w2);
            {
                const int b = t >> 13; const LAS f32x4* gt = Lgt + b * 256;
                f32x4 v[4]; float s = 0.f;
#pragma unroll
                for (int j = 0; j < 4; ++j) { f32x4 y = {0.f, 0.f, 0.f, 0.f};
#pragma unroll
                    for (int sl = 0; sl < 4; ++sl) { const int q = (int)qc[sl][j];
                        y[0] += wc_[sl] * __builtin_amdgcn_cvt_f32_fp8(q, 0); y[1] += wc_[sl] * __builtin_amdgcn_cvt_f32_fp8(q, 1); y[2] += wc_[sl] * __builtin_amdgcn_cvt_f32_fp8(q, 2); y[3] += wc_[sl] * __builtin_amdgcn_cvt_f32_fp8(q, 3); }
                    const f32x4 xv = {bflo(xc[j].x), bfhi(xc[j].x), bflo(xc[j].y), bfhi(xc[j].y)};
                    v[j] = xv * ALPHA + gt[64 * j + lane] * y; s += (v[j][0] + v[j][1]) + (v[j][2] + v[j][3]); }
                const float mean = wave_sum(s) * (1.f / D); float s2 = 0.f;
#pragma unroll
                for (int j = 0; j < 4; ++j) { v[j] = v[j] - mean; s2 += (v[j][0] * v[j][0] + v[j][1] * v[j][1]) + (v[j][2] * v[j][2] + v[j][3] * v[j][3]); }
                const float rstd = 1.f / sqrtf(wave_sum(s2) * (1.f / D) + LN_EPS);
                f32x4* o = (f32x4*)(a.out + (size_t)t * D) + lane;
#pragma unroll
                for (int j = 0; j < 4; ++j) o[64 * j] = v[j] * rstd * Lg2[64 * j + lane] + Lb2[64 * j + lane];
            }
            if (!hn) break;
            t = tn; tn = tn2;
#pragma unroll
            for (int sl = 0; sl < 4; ++sl) { plc[sl] = pln[sl]; wc_[sl] = wn_[sl]; pln[sl] = pl2[sl]; wn_[sl] = w2[sl];
#pragma unroll
                for (int j = 0; j < 4; ++j) qc[sl][j] = qn[sl][j]; }
#pragma unroll
            for (int j = 0; j < 4; ++j) xc[j] = xn[j];
        }
#undef PF_IDX
#undef PF_DATA
    }
}


constexpr int N_PHASES = 11;
__global__ void __launch_bounds__(NTHREADS, 2) mega_fwd(Args a) {
    extern __shared__ __attribute__((aligned(16))) unsigned char lds_raw[];
    LAS unsigned char* lds = (LAS unsigned char*)lds_raw;
    const int tid = threadIdx.x;
    volatile LAS unsigned* misc = (volatile LAS unsigned*)(lds + LDS_MISC);
    if (tid < 4) misc[tid] = 0u;
    __syncthreads();
    XcdBarrier bar; bar.bar = (unsigned*)(a.ws + WS_BAR); bar.x = 0; bar.st = misc;
    const bool multi = (a.ph_hi - a.ph_lo) > 1;
    if (multi) bar = xcd_barrier_post((unsigned*)(a.ws + WS_BAR), misc);
    const int lo = a.ph_lo, hi = a.ph_hi;
#define vcu ((gridDim.x % 8 == 0) ? (int)((blockIdx.x % 8) * (gridDim.x / 8) + blockIdx.x / 8) : (int)blockIdx.x)
#ifdef ONLY_PHASE
#define IN(k) ((k) == ONLY_PHASE && lo <= (k) && (k) < hi)
#else
#define IN(k) (lo <= (k) && (k) < hi)
#endif
#define SEAM(k) do { if (IN(k) && IN((k) + 1)) xcd_barrier(bar); } while (0)

#ifndef REPEAT_PHASE
#define REPEAT_PHASE -1
#endif
#ifdef PROF_REP
#define RUNPH(k, ...) do { if (IN(k)) { const int nrep_ = (a.rep_k == (k)) ? 2 : 1; for (int rep_ = 0; rep_ < nrep_; ++rep_) { if (rep_) xcd_barrier(bar); __VA_ARGS__; } } } while (0)
#else
#define RUNPH(k, ...) do { if (IN(k)) { __VA_ARGS__; if (REPEAT_PHASE == (k)) { xcd_barrier(bar); __VA_ARGS__; } } } while (0)
#endif
    RUNPH(0, p0_mod_and_filter(a, lds));
    SEAM(0);
    RUNPH(1, p1_prep(a, lds));
    SEAM(1);
    RUNPH(2, { gm::SchedIn S{a.ws, (int)gridDim.x, vcu, a.in[I_BAF], a.in[I_BAB]}; gm::EpiIn E{a.ws}; gm::gemm_stream<false, 0, false>(lds, S, E);
        {
          const int G = (int)gridDim.x, rounds = (1812 + G - 1) / G, extra = 1812 - (rounds - 1) * G, v = vcu;
          if (v >= extra || extra == G) { const int nidle = (extra == G) ? G : G - extra, ridle = (extra == G) ? v : v - extra; __syncthreads();
              prep_items(a, (LAS float*)(lds + (tid >> 6) * 16384), PREP_NITEMS - PREP_DEFER, PREP_NITEMS, ridle * NWAVES + (tid >> 6), nidle * NWAVES, tid & 63); } } });
    SEAM(2);
    RUNPH(3, { for (int u = blockIdx.x; u < 16 * NCT; u += gridDim.x) gla::g1_unit(a, lds, u / NCT, u % NCT); });
    SEAM(3);
    RUNPH(4, { gla::g2_scan(a);
        hy::CvState cvs; cvs.jb.mi = -1; cvs.next = (int)blockIdx.x * NWAVES + (tid >> 6); cvs.stride = (int)gridDim.x * NWAVES; cvs.end = hy::CV_SPLIT;
        for (int c = blockIdx.x; c < HYW; c += gridDim.x) hy::channel(a, lds, c, a.ws + WS_HSPEC + (size_t)blockIdx.x * HSPEC_PER_WG, cvs);
        while (cvs.jb.mi >= 0 || cvs.next < cvs.end) hy::cv_step(a, cvs, tid & 63); });
    SEAM(4);
    RUNPH(5, { { int u = blockIdx.x; gla::G3In cur, nxt;
            if (u < 16 * NCHUNK) { gla::g3_load(a, u >> 7, u & 127, cur);
                for (;;) { const int un = u + (int)gridDim.x; const bool hn = un < 16 * NCHUNK; if (hn) gla::g3_load(a, un >> 7, un & 127, nxt);
                    gla::g3_unit(a, lds, u >> 7, u & 127, cur); if (!hn) break; cur = nxt; u = un; } } }
        const int wave = tid >> 6;
        for (int it = blockIdx.x * NWAVES + wave; it < 4096; it += gridDim.x * NWAVES) hy::transpose_item(a, it, tid & 63); });
    SEAM(5);
    RUNPH(6, { gm::SchedOut S{a.ws, (int)gridDim.x, vcu}; gm::EpiOut E{a.ws}; gm::gemm_stream<false, 0, false>(lds, S, E); });
    SEAM(6);
    RUNPH(7, rt::phase(a, lds));
    SEAM(7);
    if (IN(8) || IN(9)) {
        LAS int* tab = (LAS int*)(lds + gm::LDS_TAB);
        __syncthreads();
        if (tid == 0) { const unsigned* cnt = (const unsigned*)(a.ws + WS_CNT); int nrt = 0;
            for (int e = 0; e < NE; ++e) { const int n = (int)cnt[e]; tab[e] = n; const int nt = (n + 255) >> 8; for (int k = 0; k < nt; ++k) tab[64 + nrt + k] = e | (k << 8); nrt += nt; }
            tab[32] = nrt; }
        __syncthreads();
    }
    RUNPH(8, { gm::SchedMoe<1> S{a.ws, (const LAS int*)(lds + gm::LDS_TAB), (int)gridDim.x, vcu, a.in[I_EB2]}; gm::EpiMoe1 E{a.ws}; gm::gemm_stream<true, 2, true>(lds, S, E); });
    SEAM(8);
    RUNPH(9, { gm::SchedMoe<2> S{a.ws, (const LAS int*)(lds + gm::LDS_TAB), (int)gridDim.x, vcu, a.in[I_EB2]}; gm::EpiMoe2 E{a.ws}; gm::gemm_stream<false, 0, true>(lds, S, E); });
    SEAM(9);
    RUNPH(10, p_final(a, lds));
#undef RUNPH
#undef vcu
#undef IN
#undef SEAM
}

extern "C" void kernel_launch(void* const* d_in, const int* in_sizes, int n_in, void* d_out, int out_size, void* d_ws, size_t ws_size, hipStream_t stream) {
    static int grid = 0;
    if (grid == 0) {
        if (n_in != 32 || out_size != T * D || ws_size < WS_END) { fprintf(stderr, "kernel_launch: unexpected shapes (n_in %d out %d ws %zu need %zu)\n", n_in, out_size, ws_size, (size_t)WS_END); grid = -1; return; }
        int dev = 0, cus = 0;
        if (hipGetDevice(&dev) != hipSuccess || hipDeviceGetAttribute(&cus, hipDeviceAttributeMultiprocessorCount, dev) != hipSuccess) { grid = -1; return; }
        if (hipFuncSetAttribute((const void*)mega_fwd, hipFuncAttributeMaxDynamicSharedMemorySize, LDS_BYTES) != hipSuccess) { fprintf(stderr, "kernel_launch: hipFuncSetAttribute failed\n"); grid = -1; return; }
        int per_cu = 0;
        if (hipOccupancyMaxActiveBlocksPerMultiprocessor(&per_cu, (const void*)mega_fwd, NTHREADS, LDS_BYTES) != hipSuccess || per_cu < 1) fprintf(stderr, "kernel_launch: occupancy query says %d\n", per_cu);
        (void)hipGetLastError();
        grid = cus;
        if (grid > MAX_GRID) grid = MAX_GRID;
    }
    if (grid < 0) return;
    (void)hipMemsetAsync(d_ws, 0, WS_ZERO_BYTES, stream);
    Args a{};
    for (int i = 0; i < 32; ++i) a.in[i] = (const float*)d_in[i];
    a.out = (float*)d_out; a.ws = (unsigned char*)d_ws;
#ifdef DBG
    (void)hipMemsetAsync((char*)d_ws + WS_DBG, 0, 512, stream);
    for (int p = 0; p < N_PHASES; ++p) { a.ph_lo = p; a.ph_hi = p + 1; hipLaunchKernelGGL(mega_fwd, dim3(grid), dim3(NTHREADS), LDS_BYTES, stream, a);
        hipLaunchKernelGGL(dbg_check, dim3(64), dim3(512), 0, stream, a, p); }
    hipLaunchKernelGGL(dbg_encode, dim3(1024), dim3(256), 0, stream, a);
#elif N_LAUNCH_PER_PHASE
    for (int p = 0; p < N_PHASES; ++p) { a.ph_lo = p; a.ph_hi = p + 1; hipLaunchKernelGGL(mega_fwd, dim3(grid), dim3(NTHREADS), LDS_BYTES, stream, a); }
#else
    a.ph_lo = 0; a.ph_hi = N_PHASES;
#ifdef PROF_REP
    a.rep_k = PROF_REP;
#endif
    hipLaunchKernelGGL(mega_fwd, dim3(grid), dim3(NTHREADS), LDS_BYTES, stream, a);
#endif
}
```

```cpp
#include <hip/hip_runtime.h>
#include <cstdio>
#include <cstdint>
#include <cstddef>

#define LAS __attribute__((address_space(3)))
#define GAS __attribute__((address_space(1)))
typedef unsigned short bf16_t;
typedef short bf16x8 __attribute__((ext_vector_type(8)));
typedef float f32x4 __attribute__((ext_vector_type(4)));
typedef float f32x2 __attribute__((ext_vector_type(2)));
typedef unsigned u32x4 __attribute__((ext_vector_type(4)));
typedef unsigned u32x2 __attribute__((ext_vector_type(2)));

#ifndef N_LAUNCH_PER_PHASE
#define N_LAUNCH_PER_PHASE 0
#endif

constexpr int D = 1024, NB = 4, SEQ = 8192, T = NB * SEQ, CTXL = 256, TC = NB * CTXL, TT = T + TC;
constexpr int NH = 4, DK = 64, DV = 128, CH = 64, NCHUNK = SEQ / CH, NCC = CTXL / CH, NCT = NCHUNK + NCC;
constexpr int HYW = 512, HYC = 3 * HYW, INW = 3104;
constexpr int NE = 32, DE = 1024, CAP = T;
constexpr float LN_EPS = 1e-6f, ALPHA = 1.189207115002721f;
constexpr int NTHREADS = 512, NWAVES = 8;
constexpr int FFTN = 16384;

constexpr size_t al256(size_t x) { return (x + 255) & ~(size_t)255; }
constexpr size_t WS_BAR   = 0;
constexpr size_t WS_MOD   = 16384;
constexpr size_t WS_CNT   = WS_MOD + 5 * 6144 * 4;
constexpr size_t WS_ZERO_BYTES = al256(WS_CNT + 256);
constexpr size_t WS_LIST  = 262144;
constexpr size_t WS_PW    = WS_LIST + (size_t)NE * CAP * 4;
constexpr size_t WS_PLOC  = WS_PW + (size_t)T * 4 * 4;
constexpr size_t WS_B1R   = WS_PLOC + (size_t)T * 4 * 4;
constexpr size_t WS_HID2  = WS_B1R + (size_t)NE * 2048 * 4;
constexpr size_t WS_BTIN  = WS_HID2 + (size_t)SEQ * 64 * 4;
constexpr size_t WS_BTOUT = WS_BTIN + (size_t)3584 * 1024 * 2;
constexpr size_t WS_W1T   = WS_BTOUT + (size_t)1024 * 1024 * 2;
constexpr size_t WS_W2T   = WS_W1T + (size_t)NE * 2048 * 1024 * 2;
constexpr size_t WS_PRE1  = WS_W2T + (size_t)NE * 1024 * 1024 * 2;
constexpr size_t WS_RA    = WS_PRE1 + (size_t)T * 1024 * 4;
constexpr size_t WS_H     = WS_RA;
constexpr size_t WS_Q     = WS_H + (size_t)TT * 1024 * 2;
constexpr size_t WS_K     = WS_Q + (size_t)T * 256 * 2;
constexpr size_t WS_V     = WS_K + (size_t)TT * 256 * 2;
constexpr size_t WS_G     = WS_V + (size_t)TT * 512 * 2;
constexpr size_t WS_GF    = WS_G + (size_t)T * 512 * 2;
constexpr size_t WS_GB    = WS_GF + (size_t)TT * 256 * 4;
constexpr size_t WS_UT    = WS_GB + (size_t)TT * 256 * 4;
constexpr size_t WS_RA_END= WS_UT + (size_t)NB * HYC * SEQ * 2;
constexpr size_t WS_H2    = WS_RA;
constexpr size_t WS_FG    = WS_RA + (size_t)T * 1024 * 2;
constexpr size_t WS_SLOTS = WS_RA;
constexpr size_t SORTED_BYTES_ = (size_t)(T * 4 / 256 + NE) * 256 * 1024 * 2;
constexpr size_t WS_RB    = al256(WS_RA_END > WS_RA + SORTED_BYTES_ ? WS_RA_END : WS_RA + SORTED_BYTES_);
constexpr size_t WS_KV    = WS_RB;
constexpr size_t WS_AV    = WS_KV + (size_t)2 * 16 * NCT * 8192 * 2;
constexpr size_t WS_SP    = WS_AV + (size_t)2 * 16 * NCT * 64 * 4;
constexpr size_t WS_HSPEC = WS_SP + (size_t)2 * 16 * NCHUNK * 8192 * 2;
constexpr size_t HSPEC_PER_WG = (size_t)2 * FFTN * 8;
constexpr int MAX_GRID = 256;
constexpr size_t WS_YHYT  = WS_HSPEC + (size_t)MAX_GRID * HSPEC_PER_WG;
constexpr size_t WS_MIX   = WS_YHYT + (size_t)NB * HYW * SEQ * 2;
constexpr size_t WS_RB_END= WS_MIX + (size_t)T * 1024 * 2;
constexpr size_t WS_HF    = WS_MIX;
constexpr size_t WS_ACT   = WS_RB;
constexpr size_t SORTED_BYTES = (size_t)(T * 4 / 256 + NE) * 256 * 1024 * 2;
constexpr size_t WS_END   = al256(WS_RB_END > WS_RB + SORTED_BYTES ? WS_RB_END : WS_RB + SORTED_BYTES);

constexpr int LDS_BYTES = 147456;
constexpr int LDS_MISC  = 145408;

typedef __bf16 bf16n2 __attribute__((ext_vector_type(2)));
__device__ __forceinline__ unsigned pk2(float lo, float hi) { bf16n2 v = {(__bf16)lo, (__bf16)hi}; return __builtin_bit_cast(unsigned, v); }
__device__ __forceinline__ bf16_t f2bf(float f) { __bf16 b = (__bf16)f; return __builtin_bit_cast(unsigned short, b); }
__device__ __forceinline__ float bf2f(bf16_t b) { return __uint_as_float(((unsigned)b) << 16); }
__device__ __forceinline__ float bflo(unsigned w) { return __uint_as_float(w << 16); }
__device__ __forceinline__ float bfhi(unsigned w) { return __uint_as_float(w & 0xffff0000u); }
__device__ __forceinline__ float wave_sum(float v) {
#pragma unroll
    for (int o = 1; o < 64; o <<= 1) v += __shfl_xor(v, o);
    return v;
}
__device__ __forceinline__ float silu_f(float x) { return x * __builtin_amdgcn_rcpf(1.f + __expf(-x)); }
__device__ __forceinline__ float log_sigmoid_f(float z) { return fminf(z, 0.f) - __logf(1.f + __expf(-fabsf(z))); }

#define XB_TMO      128
#define XB_XCNT(j)  (256  + 64 * (j))
#define XB_XSUB(j)  (1280 + 64 * (j))
#define XB_XGEN(j)  (2304 + 64 * (j))
#define XB_TOP      3328
#define XB_TOPGEN   3392
#define XCD_BAR_WORDS 3456
#define XB_SPIN_CAP (1u << 22)
__device__ __forceinline__ unsigned xb_ld(unsigned* p)              { return __hip_atomic_load(p, __ATOMIC_RELAXED, __HIP_MEMORY_SCOPE_AGENT); }
__device__ __forceinline__ unsigned xb_add(unsigned* p, unsigned v) { return __hip_atomic_fetch_add(p, v, __ATOMIC_RELAXED, __HIP_MEMORY_SCOPE_AGENT); }
__device__ __forceinline__ unsigned xb_xcc_id() { return (unsigned)__builtin_amdgcn_s_getreg((3 << 11) | 20) & 0xFu; }
#define XB_SPIN(cond, bar) do { unsigned _sp = 0; while (cond) { __builtin_amdgcn_s_sleep(1); \
    if ((++_sp & 255u) == 0u) { if (xb_ld(&(bar)[XB_TMO])) break; if (_sp > XB_SPIN_CAP) { atomicAdd(&(bar)[XB_TMO], 1u); break; } } } } while (0)
struct XcdBarrier { unsigned* bar; unsigned x; volatile LAS unsigned* st; };
__device__ __forceinline__ XcdBarrier xcd_barrier_post(unsigned* bar, volatile LAS unsigned* st) {
    XcdBarrier b; b.bar = bar; b.x = xb_xcc_id(); b.st = st;
    if (threadIdx.x == 0) (void)xb_add(&bar[XB_XCNT(b.x)], 1u);
    return b;
}
__device__ __forceinline__ void xcd_barrier_complete(unsigned* bar, unsigned x, unsigned& nloc, unsigned& nx) {
    const unsigned G = gridDim.x * gridDim.y * gridDim.z;
    unsigned sum, cnt, mine, sp = 0u;
    for (;;) {
        sum = 0u; cnt = 0u; mine = 0u;
#pragma unroll
        for (unsigned j = 0; j < 16; ++j) { const unsigned c = xb_ld(&bar[XB_XCNT(j)]); sum += c; cnt += (c > 0u) ? 1u : 0u; mine = (j == x) ? c : mine; }
        if (sum == G) break;
        __builtin_amdgcn_s_sleep(1);
        if ((++sp & 255u) == 0u) { if (xb_ld(&bar[XB_TMO])) break; if (sp > XB_SPIN_CAP) { atomicAdd(&bar[XB_TMO], 1u); break; } }
    }
    nloc = mine > 0u ? mine : 1u; nx = cnt > 0u ? cnt : 1u;
}
__device__ __forceinline__ void xcd_barrier(const XcdBarrier& b) {
    asm volatile("s_waitcnt vmcnt(0)" ::: "memory");
    __syncthreads();
    if (threadIdx.x == 0) {
        unsigned* bar = b.bar;
        __builtin_amdgcn_s_waitcnt(0);
        unsigned nloc = b.st[0], nx = b.st[1];
        if (nloc == 0u) { xcd_barrier_complete(bar, b.x, nloc, nx); b.st[0] = nloc; b.st[1] = nx; }
        const unsigned old = xb_add(&bar[XB_XSUB(b.x)], 1u);
        const unsigned gen = old / nloc;
        if (old + 1u == (gen + 1u) * nloc) {
            __builtin_amdgcn_fence(__ATOMIC_RELEASE, "agent");
            asm volatile("s_waitcnt vmcnt(0)" ::: "memory");
            const unsigned og = xb_add(&bar[XB_TOP], 1u);
            const unsigned tg = og / nx;
            if (og + 1u == (tg + 1u) * nx) xb_add(&bar[XB_TOPGEN], 1u);
            else XB_SPIN(xb_ld(&bar[XB_TOPGEN]) == tg, bar);
            __builtin_amdgcn_fence(__ATOMIC_ACQUIRE, "agent");
            xb_add(&bar[XB_XGEN(b.x)], 1u);
            asm volatile("s_waitcnt vmcnt(0)" ::: "memory");
        } else {
            XB_SPIN(xb_ld(&bar[XB_XGEN(b.x)]) == gen, bar);
            __builtin_amdgcn_fence(__ATOMIC_ACQUIRE, "agent");
            asm volatile("s_waitcnt vmcnt(0)" ::: "memory");
        }
    }
    __syncthreads();
}

struct Args {
    const float* in[32];
    float* out;
    unsigned char* ws;
    int ph_lo, ph_hi;
    int rep_k, pad_;
};
enum { I_X = 0, I_C, I_CTX, I_CCTX, I_ADAW, I_ADAB, I_WIN, I_WAF, I_BAF, I_WAB, I_BAB, I_NORMG, I_CONVW, I_CONVB, I_FW1, I_FB1, I_FW2, I_FB2, I_FWOUT, I_FFREQ,
       I_BIASD, I_WOUT, I_LN1G, I_LN1B, I_RW, I_RB, I_EW1, I_EB1, I_EW2, I_EB2, I_LN2G, I_LN2B };


namespace gm {
constexpr int BM = 256, BK = 64, HALF = 128, HTB = HALF * BK * 2, STAGE_BYTES = 8 * HTB, KD = 1024, NT = KD / BK;
constexpr int ROWB = KD * 2;
typedef int i32x8 __attribute__((ext_vector_type(8)));
__device__ __forceinline__ int gray2(int q) { return q ^ (q >> 1); }
__device__ __forceinline__ int lds_off8(int r, int fq) { const int rr = r & 15; return ((r >> 4) * 2 + (fq >> 1)) * 1024 + rr * 64 + 16 * ((2 * (fq & 1)) ^ gray2(rr >> 2)); }
__device__ __forceinline__ void stage_rc8(int b, int& R, int& C) { const int st = b / 1024, sb = b % 1024, swz = sb ^ (gray2((sb >> 8) & 3) << 4); R = (st >> 1) * 16 + swz / 64; C = (st & 1) * 32 + (swz % 64) / 2; }
__device__ __forceinline__ int lds_byte(int r, int c) { const int st = (r >> 4) * 2 + (c >> 5), rr = r & 15, cc = c & 31, ob = rr * 64 + cc * 2; return st * 1024 + (ob ^ (((ob >> 9) & 1) << 5)); }
__device__ __forceinline__ void stage_rc(int b, int& R, int& C) { const int st = b / 1024, sb = b % 1024, swz = sb ^ (((sb >> 9) & 1) << 5); R = (st >> 1) * 16 + swz / 64; C = (st & 1) * 32 + (swz % 64) / 2; }
__device__ __forceinline__ int perm32(int rho) { const int n = rho >> 4, i = rho & 15; return 8 * (i >> 2) + 4 * n + (i & 3); }

constexpr int LDS_BIAS = STAGE_BYTES + 4096;
struct Unit {
    const char* A;
    const char* B;
    const int* list;
    int type, row0, col0, valid, aux;
};

__device__ __forceinline__ i32x8 cat8(bf16x8 lo, bf16x8 hi) { typedef int i32x4 __attribute__((ext_vector_type(4))); const i32x4 a = __builtin_bit_cast(i32x4, lo), b = __builtin_bit_cast(i32x4, hi); return (i32x8){a[0], a[1], a[2], a[3], b[0], b[1], b[2], b[3]}; }
template <bool GATHER, int GSHIFT, int RB, bool FP8>
__device__ __forceinline__ void a_offsets(const Unit& u, unsigned (&o)[2][2]) {
    int R[2], Cb[2];
    int tz = threadIdx.x; asm volatile("" : "+v"(tz));
#pragma unroll
    for (int i = 0; i < 2; ++i) { int r, c; if (FP8) stage_rc8(tz * 16 + i * 8192, r, c); else stage_rc(tz * 16 + i * 8192, r, c); R[i] = r; Cb[i] = c * 2; }
#pragma unroll
    for (int h = 0; h < 2; ++h)
#pragma unroll
        for (int i = 0; i < 2; ++i) {
            const int r = h * HALF + R[i];
            if (!GATHER) o[h][i] = (unsigned)(r * RB + Cb[i]);
            else { const int idx = u.list[r < u.valid ? r : 0]; o[h][i] = (unsigned)(idx >> GSHIFT) * (unsigned)RB + (unsigned)Cb[i]; }
        }
}

template <bool GATHER, int GSHIFT, bool FP8, class Sched, class Epi>
__device__ __forceinline__ void gemm_stream(LAS unsigned char* lds, const Sched& S, const Epi& E) {
    constexpr int RB = FP8 ? KD : ROWB, NTL = FP8 ? NT / 2 : NT;
    const int tid = threadIdx.x, wid = __builtin_amdgcn_readfirstlane(tid >> 6), lane = tid & 63, wr = wid >> 2, wc = wid & 3, fr = lane & 15, fq = lane >> 4;
    unsigned voffB[2], voffA[2];
#pragma unroll
    for (int i = 0; i < 2; ++i) { int r, c; if (FP8) stage_rc8(tid * 16 + i * 8192, r, c); else stage_rc(tid * 16 + i * 8192, r, c); const int rb = (r & ~31) + perm32(r & 31); voffB[i] = (unsigned)(rb * RB + c * 2); voffA[i] = (unsigned)(r * RB + c * 2); }
    const size_t kstep = (size_t)(BK * 2), hstep = (size_t)HALF * RB;
    const unsigned ldsw = (unsigned)wid * 1024u;
    const int aoff = FP8 ? lds_off8(wr * 64 + fr, fq) : lds_byte(wr * 64 + fr, fq * 8), boff = FP8 ? lds_off8(wc * 32 + fr, fq) : lds_byte(wc * 32 + fr, fq * 8);
    const int aoffh = aoff ^ 16, boffh = boff ^ 16;
#define GM_SA(b, h) (((b) * 2 + (h)) * HTB)
#define GM_SB(b, h) ((4 + (b) * 2 + (h)) * HTB)
#define GM_STAGE(bufoff, gbase, vo0, vo1) do { \
        __builtin_amdgcn_global_load_lds((const unsigned*)((const char*)(gbase) + (vo0)), (LAS unsigned*)(lds + (bufoff) + ldsw), 16, 0, 0); \
        __builtin_amdgcn_global_load_lds((const unsigned*)((const char*)(gbase) + (vo1)), (LAS unsigned*)(lds + (bufoff) + ldsw + 8192), 16, 0, 0); } while (0)
#define GM_STAGE_A(bufoff, gbase, h, o0, o1) do { if constexpr (GATHER) GM_STAGE(bufoff, gbase, o0, o1); else GM_STAGE(bufoff, (gbase) + (h) * hstep, voffA[0], voffA[1]); } while (0)
#define GM_LD32(p, ol, oh) ({ const i32x4 lo_ = *(const LAS i32x4*)((p) + (ol)), hi_ = *(const LAS i32x4*)((p) + (oh)); (i32x8){lo_[0], lo_[1], lo_[2], lo_[3], hi_[0], hi_[1], hi_[2], hi_[3]}; })
#define GM_LDA(dst, b, h) do { if constexpr (FP8) { _Pragma("unroll") for (int m = 0; m < 4; ++m) dst##8[m] = GM_LD32(lds + GM_SA(b, h) + m * 2048, aoff, aoffh); } \
        else { _Pragma("unroll") for (int m = 0; m < 4; ++m) _Pragma("unroll") for (int k = 0; k < 2; ++k) dst[m][k] = *(const LAS bf16x8*)(lds + GM_SA(b, h) + aoff + m * 2048 + k * 1024); } } while (0)
#define GM_LDB(dst, b, h) do { if constexpr (FP8) { _Pragma("unroll") for (int n = 0; n < 2; ++n) dst##8[n] = GM_LD32(lds + GM_SB(b, h) + n * 2048, boff, boffh); } \
        else { _Pragma("unroll") for (int n = 0; n < 2; ++n) _Pragma("unroll") for (int k = 0; k < 2; ++k) dst[n][k] = *(const LAS bf16x8*)(lds + GM_SB(b, h) + boff + n * 2048 + k * 1024); } } while (0)
#define GM_MMA(ai, bj, At, Bt) do { __builtin_amdgcn_s_setprio(1); _Pragma("unroll") for (int m = 0; m < 4; ++m) _Pragma("unroll") for (int n = 0; n < 2; ++n) { \
        if constexpr (FP8) asm volatile("v_mfma_scale_f32_16x16x128_f8f6f4 %0, %1, %2, %0, %3, %3 op_sel_hi:[0,0,0]" : "+v"(acc[ai][bj][m][n]) : "v"(Bt##8[n]), "v"(At##8[m]), "v"(sc1_)); \
        else { _Pragma("unroll") for (int k = 0; k < 2; ++k) acc[ai][bj][m][n] = __builtin_amdgcn_mfma_f32_16x16x32_bf16(Bt[n][k], At[m][k], acc[ai][bj][m][n], 0, 0, 0); } } \
        __builtin_amdgcn_s_setprio(0); } while (0)
#define GM_WAIT_V(n) asm volatile("s_waitcnt vmcnt(" #n ")" ::: "memory")
#define GM_WAIT_L(n) asm volatile("s_waitcnt lgkmcnt(" #n ")" ::: "memory")
#define GM_BAR __builtin_amdgcn_s_barrier()
#define GM_SCHED __builtin_amdgcn_sched_barrier(0)
    Unit cur, nxt; int ui = 0;
    if (!S.next(0, cur)) return;
    f32x4 acc[2][2][4][2];
#pragma unroll
    for (int a = 0; a < 2; ++a)
#pragma unroll
        for (int b = 0; b < 2; ++b)
#pragma unroll
            for (int m = 0; m < 4; ++m)
#pragma unroll
                for (int n = 0; n < 2; ++n) acc[a][b][m][n] = (f32x4){0.f, 0.f, 0.f, 0.f};
    typedef int i32x4 __attribute__((ext_vector_type(4)));
    int sc1_ = 0x7f7f7f7f; asm volatile("" : "+v"(sc1_));
    bf16x8 At[4][2], B0[2][2], B1[2][2];
    i32x8 At8[4], B08[2], B18[2];
    unsigned ca[2][2], na[2][2];
    if constexpr (GATHER) a_offsets<GATHER, GSHIFT, RB, FP8>(cur, ca);
    const char* cA = cur.A; const char* cB = cur.B;
    GM_STAGE(GM_SB(0, 0), cB, voffB[0], voffB[1]); GM_STAGE_A(GM_SA(0, 0), cA, 0, ca[0][0], ca[0][1]); GM_STAGE(GM_SB(0, 1), cB + hstep, voffB[0], voffB[1]); GM_STAGE_A(GM_SA(0, 1), cA, 1, ca[1][0], ca[1][1]);
    if (wr == 1) GM_BAR;
    GM_WAIT_V(4); GM_BAR;
    GM_STAGE(GM_SB(1, 0), cB + kstep, voffB[0], voffB[1]); GM_STAGE_A(GM_SA(1, 0), cA + kstep, 0, ca[0][0], ca[0][1]); GM_STAGE(GM_SB(1, 1), cB + hstep + kstep, voffB[0], voffB[1]);
    GM_WAIT_V(6); GM_BAR;
    for (;;) {
        const bool has_next = S.next(ui + 1, nxt);
        if constexpr (GATHER) {
            if (has_next) a_offsets<GATHER, GSHIFT, RB, FP8>(nxt, na);
            else {
#pragma unroll
                for (int h = 0; h < 2; ++h)
#pragma unroll
                    for (int i = 0; i < 2; ++i) na[h][i] = ca[h][i];
            }
        }
        const char* nA = has_next ? nxt.A : cA; const char* nB = has_next ? nxt.B : cB;
        if (wid == 0)
            __builtin_amdgcn_global_load_lds((const unsigned*)(S.bias(cur) + 4 * lane), (LAS unsigned*)(lds + LDS_BIAS + (ui & 1) * 1024), 16, 0, 0);
        for (int t = 0; t < NTL; t += 2) {
            const bool last = (t == NTL - 2);

            const char* a1 = cA + (size_t)(t + 1) * kstep;
            const char* a2 = last ? nA : cA + (size_t)(t + 2) * kstep; const char* b2 = last ? nB : cB + (size_t)(t + 2) * kstep;
            const char* a3 = a2 + kstep; const char* b3 = b2 + kstep;
            unsigned x00 = 0, x01 = 0, x10 = 0, x11 = 0;
            if constexpr (GATHER) { x00 = last ? na[0][0] : ca[0][0]; x01 = last ? na[0][1] : ca[0][1]; x10 = last ? na[1][0] : ca[1][0]; x11 = last ? na[1][1] : ca[1][1]; }
            GM_LDB(B0, 0, 0); GM_SCHED; GM_LDA(At, 0, 0); GM_STAGE_A(GM_SA(1, 1), a1, 1, ca[1][0], ca[1][1]);
            GM_WAIT_L(8); GM_BAR; GM_WAIT_L(0); GM_MMA(0, 0, At, B0); GM_BAR; GM_SCHED;
            GM_LDB(B1, 0, 1); GM_STAGE(GM_SB(0, 0), b2, voffB[0], voffB[1]);
            GM_BAR; GM_WAIT_L(0); GM_MMA(0, 1, At, B1); GM_BAR;
            GM_LDA(At, 0, 1); GM_STAGE_A(GM_SA(0, 0), a2, 0, x00, x01);
            GM_BAR; GM_WAIT_L(0); GM_MMA(1, 0, At, B0); GM_BAR; GM_SCHED;
            GM_STAGE(GM_SB(0, 1), b2 + hstep, voffB[0], voffB[1]);
            GM_WAIT_V(6); GM_BAR; GM_MMA(1, 1, At, B1); GM_BAR;
            GM_LDB(B0, 1, 0); GM_SCHED; GM_LDA(At, 1, 0); GM_STAGE_A(GM_SA(0, 1), a2, 1, x10, x11);
            GM_WAIT_L(8); GM_BAR; GM_WAIT_L(0); GM_MMA(0, 0, At, B0); GM_BAR; GM_SCHED;
            GM_LDB(B1, 1, 1); GM_STAGE(GM_SB(1, 0), b3, voffB[0], voffB[1]);
            GM_BAR; GM_WAIT_L(0); GM_MMA(0, 1, At, B1); GM_BAR;
            GM_LDA(At, 1, 1); GM_STAGE_A(GM_SA(1, 0), a3, 0, x00, x01);
            GM_BAR; GM_WAIT_L(0); GM_MMA(1, 0, At, B0); GM_BAR; GM_SCHED;
            GM_STAGE(GM_SB(1, 1), b3 + hstep, voffB[0], voffB[1]);
            GM_WAIT_V(6); GM_BAR; GM_MMA(1, 1, At, B1); GM_BAR;
        }
        if constexpr (FP8) asm volatile("s_nop 7\n\ts_nop 7" ::: "memory");
        {
          int tz = threadIdx.x; asm volatile("" : "+v"(tz)); const int wz = tz >> 6, lz = tz & 63;
          E(acc, cur, wz >> 2, wz & 3, lz & 15, lz >> 4, (const LAS float*)(lds + LDS_BIAS + (ui & 1) * 1024)); }
        if (!has_next) break;
#pragma unroll
        for (int a = 0; a < 2; ++a)
#pragma unroll
            for (int b = 0; b < 2; ++b)
#pragma unroll
                for (int m = 0; m < 4; ++m)
#pragma unroll
                    for (int n = 0; n < 2; ++n) acc[a][b][m][n] = (f32x4){0.f, 0.f, 0.f, 0.f};
        cur = nxt; cA = nA; cB = nB; ++ui;
        if constexpr (GATHER) {
#pragma unroll
            for (int h = 0; h < 2; ++h)
#pragma unroll
                for (int i = 0; i < 2; ++i) ca[h][i] = na[h][i];
        }
    }
    GM_WAIT_V(0);
    if (wr == 0) GM_BAR;
    GM_BAR;
#undef GM_SA
#undef GM_SB
#undef GM_STAGE
#undef GM_STAGE_A
#undef GM_LD32
#undef GM_LDA
#undef GM_LDB
#undef GM_MMA
#undef GM_WAIT_V
#undef GM_WAIT_L
#undef GM_BAR
#undef GM_SCHED
}

__device__ __forceinline__ u32x4 pack8(f32x4 a, f32x4 b) { u32x4 w; w.x = pk2(a[0], a[1]); w.y = pk2(a[2], a[3]); w.z = pk2(b[0], b[1]); w.w = pk2(b[2], b[3]); return w; }

struct SchedIn {
    unsigned char* ws; int G, c; const float* baf; const float* bab;
    __device__ __forceinline__ bool next(int i, Unit& u) const {
        int L = i * G + c;
        u.list = nullptr; u.valid = 256; u.aux = 0;
        if (L < 768) {
            const int pa = L % 6, pb = L / 6;
            u.A = (const char*)(ws + WS_BTIN) + (size_t)(2048 + 256 * pa) * ROWB; u.B = (const char*)(ws + WS_H) + (size_t)(256 * pb) * ROWB;
            u.type = 2; u.row0 = 256 * pa; u.col0 = 256 * pb; return true;
        }
        L -= 768;
        if (L < 1024) {
            const int pm = L >> 3, pn = ((L & 7) + (L >> 8)) & 7;
            u.A = (const char*)(ws + WS_H) + (size_t)(256 * pm) * ROWB; u.B = (const char*)(ws + WS_BTIN) + (size_t)(256 * pn) * ROWB;
            u.type = pn < 6 ? 0 : 1; u.row0 = 256 * pm; u.col0 = pn; return true;
        }
        L -= 1024;
        if (L < 20) {
            const int pm = L / 5, j = L % 5, pn = j == 0 ? 1 : (j == 1 ? 2 : (j == 2 ? 3 : (j == 3 ? 6 : 7)));
            u.A = (const char*)(ws + WS_H) + (size_t)(T + 256 * pm) * ROWB; u.B = (const char*)(ws + WS_BTIN) + (size_t)(256 * pn) * ROWB;
            u.type = pn < 6 ? 0 : 1; u.row0 = T + 256 * pm; u.col0 = pn; return true;
        }
        return false;
    }
    __device__ __forceinline__ const float* bias(const Unit& u) const { return (u.type == 1 && u.col0 == 7) ? bab : baf; }
};
struct EpiIn {
    unsigned char* ws;
    __device__ __forceinline__ void operator()(const f32x4 (&acc)[2][2][4][2], const Unit& u, int wr, int wc, int fr, int fq, const LAS float* bs) const {
        const int rl = wr * 64 + fr, cl = wc * 32 + 8 * fq;
        if (u.type == 0) {
            const int pn = u.col0;
            bf16_t* dst; int ld, cb;
            if (pn == 0) { dst = (bf16_t*)(ws + WS_Q); ld = 256; cb = 0; }
            else if (pn == 1) { dst = (bf16_t*)(ws + WS_K); ld = 256; cb = 0; }
            else if (pn < 4) { dst = (bf16_t*)(ws + WS_V); ld = 512; cb = (pn - 2) * 256; }
            else { dst = (bf16_t*)(ws + WS_G); ld = 512; cb = (pn - 4) * 256; }
#pragma unroll
            for (int ai = 0; ai < 2; ++ai)
#pragma unroll
                for (int m = 0; m < 4; ++m) { bf16_t* rowp = dst + (size_t)(u.row0 + rl + ai * 128 + m * 16) * ld + cb + cl;
#pragma unroll
                    for (int bj = 0; bj < 2; ++bj) *(u32x4*)(rowp + bj * 128) = pack8(acc[ai][bj][m][0], acc[ai][bj][m][1]); }
        } else if (u.type == 1) {
            _Float16* dst = (_Float16*)(ws + (u.col0 == 6 ? WS_GF : WS_GB));
            f32x4 bv[2][2];
#pragma unroll
            for (int bj = 0; bj < 2; ++bj)
#pragma unroll
                for (int n = 0; n < 2; ++n) bv[bj][n] = *(const LAS f32x4*)(bs + cl + bj * 128 + 4 * n);
            typedef _Float16 f16x8_ __attribute__((ext_vector_type(8)));
#pragma unroll
            for (int ai = 0; ai < 2; ++ai)
#pragma unroll
                for (int m = 0; m < 4; ++m) { _Float16* rowp = dst + (size_t)(u.row0 + rl + ai * 128 + m * 16) * 256 + cl;
#pragma unroll
                    for (int bj = 0; bj < 2; ++bj) { f16x8_ o;
#pragma unroll
                        for (int n = 0; n < 2; ++n) { const f32x4 z = acc[ai][bj][m][n] + bv[bj][n];
#pragma unroll
                            for (int j = 0; j < 4; ++j) o[4 * n + j] = (_Float16)(log_sigmoid_f(z[j]) * (1.f / 16.f)); }
                        *(f16x8_*)(rowp + bj * 128) = o; } }
        } else {
            const int b = u.col0 >> 13, l0 = u.col0 & 8191;
            bf16_t* dst = (bf16_t*)(ws + WS_UT) + ((size_t)b * HYC) * SEQ + l0 + cl;
#pragma unroll
            for (int ai = 0; ai < 2; ++ai)
#pragma unroll
                for (int m = 0; m < 4; ++m) { bf16_t* rowp = dst + (size_t)(u.row0 + rl + ai * 128 + m * 16) * SEQ;
#pragma unroll
                    for (int bj = 0; bj < 2; ++bj) *(u32x4*)(rowp + bj * 128) = pack8(acc[ai][bj][m][0], acc[ai][bj][m][1]); }
        }
    }
};

struct SchedOut {
    unsigned char* ws; int G, c;
    __device__ __forceinline__ bool next(int i, Unit& u) const {
        const int L = i * G + c; if (L >= 512) return false;
        const int pm = L >> 2, pn = L & 3;
        u.A = (const char*)(ws + WS_MIX) + (size_t)(256 * pm) * ROWB; u.B = (const char*)(ws + WS_BTOUT) + (size_t)(256 * pn) * ROWB;
        u.list = nullptr; u.valid = 256; u.aux = 0; u.type = 3; u.row0 = 256 * pm; u.col0 = 256 * pn; return true;
    }
    __device__ __forceinline__ const float* bias(const Unit& u) const { return (const float*)(ws + WS_MOD) + (u.row0 >> 13) * 6144 + 2 * 1024 + u.col0; }
};
struct EpiOut {
    unsigned char* ws;
    __device__ __forceinline__ void operator()(const f32x4 (&acc)[2][2][4][2], const Unit& u, int wr, int wc, int fr, int fq, const LAS float* bs) const {
        const int rl = wr * 64 + fr, cl = u.col0 + wc * 32 + 8 * fq;
        bf16_t* fg = (bf16_t*)(ws + WS_FG);
        f32x4 gv[2][2];
#pragma unroll
        for (int bj = 0; bj < 2; ++bj)
#pragma unroll
            for (int n = 0; n < 2; ++n) gv[bj][n] = *(const LAS f32x4*)(bs + wc * 32 + 8 * fq + bj * 128 + 4 * n);
#pragma unroll
        for (int ai = 0; ai < 2; ++ai)
#pragma unroll
            for (int m = 0; m < 4; ++m) { bf16_t* rowp = fg + (size_t)(u.row0 + rl + ai * 128 + m * 16) * 1024 + cl;
#pragma unroll
                for (int bj = 0; bj < 2; ++bj) *(u32x4*)(rowp + bj * 128) = pack8(gv[bj][0] * acc[ai][bj][m][0], gv[bj][1] * acc[ai][bj][m][1]); }
    }
};

constexpr int LDS_TAB = STAGE_BYTES;
template <int WHICH>
struct SchedMoe {
    unsigned char* ws; const LAS int* tab; int G, c; const float* b2;
    __device__ __forceinline__ bool next(int i, Unit& u) const {
        constexpr int NCT_ = WHICH == 1 ? 8 : 4;
        const int L = i * G + c; const int nrt = __builtin_amdgcn_readfirstlane(tab[32]);
        if (L >= nrt * NCT_) return false;
        const int rt = L / NCT_, ct = L % NCT_;
        const int info = __builtin_amdgcn_readfirstlane(tab[64 + rt]), e = info & 255, r0 = (info >> 8) * 256;
        const int cnt = __builtin_amdgcn_readfirstlane(tab[e]);
        u.valid = (cnt - r0) < 256 ? (cnt - r0) : 256;
        u.list = (const int*)(ws + WS_LIST) + (size_t)e * CAP + r0;
        u.A = (WHICH == 1) ? (const char*)(ws + WS_H2) : (const char*)(ws + WS_ACT) + (size_t)(256 * rt) * KD;
        u.B = (const char*)(ws + (WHICH == 1 ? WS_W1T : WS_W2T)) + ((size_t)e * (WHICH == 1 ? 2048 : 1024) + 256 * ct) * KD;
        u.type = 3 + WHICH; u.row0 = 256 * rt; u.col0 = ct; u.aux = e; return true;
    }
    __device__ __forceinline__ const float* bias(const Unit& u) const { return (WHICH == 1) ? (const float*)(ws + WS_B1R) + (size_t)u.aux * 2048 + 256 * u.col0 : b2 + (size_t)u.aux * 1024 + 256 * u.col0; }
};
__device__ __forceinline__ float swiglu_f(float glu, float lin) {
    glu = fminf(glu, 7.f); lin = fminf(fmaxf(lin, -7.f), 7.f);
    return glu * __builtin_amdgcn_rcpf(1.f + __expf(-1.702f * glu)) * (lin + 1.f);
}
constexpr float S_H2 = 4.f, S_ACT = 8.f, S_W = 64.f;
__device__ __forceinline__ f32x2 swiglu2(f32x2 ag, f32x2 al, f32x2 bg, f32x2 bl) {
    f32x2 g = ag * (1.f / (S_H2 * S_W)) + bg, l = al * (1.f / (S_H2 * S_W)) + bl;
    g[0] = fminf(g[0], 7.f); g[1] = fminf(g[1], 7.f);
    l[0] = __builtin_amdgcn_fmed3f(l[0], -7.f, 7.f); l[1] = __builtin_amdgcn_fmed3f(l[1], -7.f, 7.f);
    const f32x2 t = g * (-1.702f * 1.4426950408889634f);
    const f32x2 d = (f32x2){__builtin_amdgcn_exp2f(t[0]), __builtin_amdgcn_exp2f(t[1])} + 1.f;
    const f32x2 r = {__builtin_amdgcn_rcpf(d[0]), __builtin_amdgcn_rcpf(d[1])};
    return (g * r) * (l * S_ACT + S_ACT);
}
__device__ __forceinline__ unsigned pk4_fp8(float a, float b, float c, float d) {
    a = fminf(fmaxf(a, -448.f), 448.f); b = fminf(fmaxf(b, -448.f), 448.f); c = fminf(fmaxf(c, -448.f), 448.f); d = fminf(fmaxf(d, -448.f), 448.f);
    int p = __builtin_amdgcn_cvt_pk_fp8_f32(a, b, 0, false); p = __builtin_amdgcn_cvt_pk_fp8_f32(c, d, p, true); return (unsigned)p; }
__device__ __forceinline__ unsigned pk4_fp8_nc(float a, float b, float c, float d) { int p = __builtin_amdgcn_cvt_pk_fp8_f32(a, b, 0, false); p = __builtin_amdgcn_cvt_pk_fp8_f32(c, d, p, true); return (unsigned)p; }
struct EpiMoe1 {
    unsigned char* ws;
    __device__ __forceinline__ void operator()(const f32x4 (&acc)[2][2][4][2], const Unit& u, int wr, int wc, int fr, int fq, const LAS float* bs) const {
        const int rl = wr * 64 + fr, cl = wc * 32 + 8 * fq, ct = u.col0;
        const LAS float* b1 = bs + cl;
        unsigned char* act = (unsigned char*)(ws + WS_ACT) + (size_t)u.row0 * 1024 + 128 * ct + cl;
        f32x4 bg[2], bl[2];
#pragma unroll
        for (int n = 0; n < 2; ++n) { bg[n] = *(const LAS f32x4*)(b1 + 4 * n); bl[n] = *(const LAS f32x4*)(b1 + 128 + 4 * n); }
#pragma unroll
        for (int ai = 0; ai < 2; ++ai)
#pragma unroll
            for (int mp = 0; mp < 2; ++mp) {
                u32x2 w[2];
#pragma unroll
                for (int mm = 0; mm < 2; ++mm) { const int m = 2 * mp + mm;
#pragma unroll
                    for (int n = 0; n < 2; ++n) { int p = 0;
#pragma unroll
                        for (int hh = 0; hh < 2; ++hh) {
                            const f32x2 o = swiglu2((f32x2){acc[ai][0][m][n][2 * hh], acc[ai][0][m][n][2 * hh + 1]}, (f32x2){acc[ai][1][m][n][2 * hh], acc[ai][1][m][n][2 * hh + 1]},
                                                    (f32x2){bg[n][2 * hh], bg[n][2 * hh + 1]}, (f32x2){bl[n][2 * hh], bl[n][2 * hh + 1]});
                            p = hh ? __builtin_amdgcn_cvt_pk_fp8_f32(o[0], o[1], p, true) : __builtin_amdgcn_cvt_pk_fp8_f32(o[0], o[1], p, false); }
                        if (n == 0) w[mm].x = (unsigned)p; else w[mm].y = (unsigned)p; } }
                const auto sx = __builtin_amdgcn_permlane16_swap(w[0].x, w[1].x, false, false); const auto sy = __builtin_amdgcn_permlane16_swap(w[0].y, w[1].y, false, false);
                const int r = rl + ai * 128 + (2 * mp + (fq & 1)) * 16;
                *(u32x4*)(act + (size_t)r * 1024 - 8 * (fq & 1)) = (u32x4){sx[0], sy[0], sx[1], sy[1]}; }
    }
};
constexpr float S_SL = 16.f;
struct EpiMoe2 {
    unsigned char* ws;
    __device__ __forceinline__ void operator()(const f32x4 (&acc)[2][2][4][2], const Unit& u, int wr, int wc, int fr, int fq, const LAS float* bs) const {
        const int rl = wr * 64 + fr, cl = wc * 32 + 8 * fq, ct = u.col0;
        const LAS float* bb = bs + cl;
        unsigned char* slots = (unsigned char*)(ws + WS_SLOTS) + (size_t)u.row0 * 1024 + 256 * ct + cl;
        f32x4 bv[2][2];
#pragma unroll
        for (int bj = 0; bj < 2; ++bj)
#pragma unroll
            for (int n = 0; n < 2; ++n) bv[bj][n] = *(const LAS f32x4*)(bb + bj * 128 + 4 * n) * S_SL;
#pragma unroll
        for (int ai = 0; ai < 2; ++ai)
#pragma unroll
            for (int m = 0; m < 4; ++m) { const int r = rl + ai * 128 + m * 16;
                u32x2 w[2];
#pragma unroll
                for (int bj = 0; bj < 2; ++bj) {
#pragma unroll
                    for (int n = 0; n < 2; ++n) { int p = 0;
#pragma unroll
                        for (int hh = 0; hh < 2; ++hh) { f32x2 y = (f32x2){acc[ai][bj][m][n][2 * hh], acc[ai][bj][m][n][2 * hh + 1]} * (S_SL / (S_ACT * S_W)) + (f32x2){bv[bj][n][2 * hh], bv[bj][n][2 * hh + 1]};
                            y[0] = __builtin_amdgcn_fmed3f(y[0], -448.f, 448.f); y[1] = __builtin_amdgcn_fmed3f(y[1], -448.f, 448.f);
                            p = hh ? __builtin_amdgcn_cvt_pk_fp8_f32(y[0], y[1], p, true) : __builtin_amdgcn_cvt_pk_fp8_f32(y[0], y[1], p, false); }
                        if (n == 0) w[bj].x = (unsigned)p; else w[bj].y = (unsigned)p; } }
                const auto sx = __builtin_amdgcn_permlane16_swap(w[0].x, w[1].x, false, false); const auto sy = __builtin_amdgcn_permlane16_swap(w[0].y, w[1].y, false, false);
                *(u32x4*)(slots + (size_t)r * 1024 + ((fq & 1) ? 128 - 8 : 0)) = (u32x4){sx[0], sy[0], sx[1], sy[1]}; }
    }
};
}

namespace hy {
__device__ __forceinline__ int phys(int n) { return n + (n >> 4) + ((n >> 9) << 4); }
constexpr int XSIZE = 16384 + 1024 + 512;

__device__ __forceinline__ float tw_c(int i) {
    constexpr float t[16] = {1.f, 0.98078528040323043f, 0.92387953251128674f, 0.83146961230254524f, 0.70710678118654752f, 0.55557023301960218f, 0.38268343236508977f, 0.19509032201612825f,
                             0.f, -0.19509032201612825f, -0.38268343236508977f, -0.55557023301960218f, -0.70710678118654752f, -0.83146961230254524f, -0.92387953251128674f, -0.98078528040323043f};
    return t[i];
}
__device__ __forceinline__ float tw_s(int i) {
    constexpr float t[16] = {0.f, 0.19509032201612825f, 0.38268343236508977f, 0.55557023301960218f, 0.70710678118654752f, 0.83146961230254524f, 0.92387953251128674f, 0.98078528040323043f,
                             1.f, 0.98078528040323043f, 0.92387953251128674f, 0.83146961230254524f, 0.70710678118654752f, 0.55557023301960218f, 0.38268343236508977f, 0.19509032201612825f};
    return t[i];
}
__host__ __device__ constexpr int brev(int p, int bits) { int r = 0; for (int i = 0; i < bits; ++i) r |= ((p >> i) & 1) << (bits - 1 - i); return r; }

__device__ __forceinline__ f32x2 cmul(f32x2 a, f32x2 w) { f32x2 r;
    asm("v_pk_mul_f32 %0, %1, %2 op_sel_hi:[1,0]\n\tv_pk_fma_f32 %0, %1, %2, %0 op_sel:[1,1,0] op_sel_hi:[0,1,1] neg_lo:[0,1,0]" : "=&v"(r) : "v"(a), "v"(w)); return r; }
__device__ __forceinline__ void cmul_chain(f32x2 a, f32x2 w, f32x2 w1, f32x2& o, f32x2& wn) {
    asm("v_pk_mul_f32 %0, %2, %3 op_sel_hi:[1,0]\n\tv_pk_mul_f32 %1, %3, %4 op_sel_hi:[1,0]\n\t"
        "v_pk_fma_f32 %0, %2, %3, %0 op_sel:[1,1,0] op_sel_hi:[0,1,1] neg_lo:[0,1,0]\n\tv_pk_fma_f32 %1, %3, %4, %1 op_sel:[1,1,0] op_sel_hi:[0,1,1] neg_lo:[0,1,0]"
        : "=&v"(o), "=&v"(wn) : "v"(a), "v"(w), "v"(w1)); }
template <int TI, bool INV>
__device__ __forceinline__ void bf_tw(f32x2& a, f32x2& b) {
    constexpr int T7 = TI < 8 ? TI : 16 - TI;
    const f32x2 W = {tw_c(T7), tw_s(T7)};
    f32x2 sum, o;
#define HY_BF(NEGR, NEGI) asm("v_pk_add_f32 %0, %3, %2\n\tv_pk_add_f32 %2, %3, %2 neg_lo:[0,1] neg_hi:[0,1]\n\tv_pk_mul_f32 %1, %2, %4 op_sel_hi:[1,0]" NEGR "\n\tv_pk_fma_f32 %1, %2, %4, %1 op_sel:[1,1,0] op_sel_hi:[0,1,1] " NEGI : "=&v"(sum), "=&v"(o), "+v"(b) : "v"(a), "s"(W))
    if (TI < 8) { if (!INV) HY_BF("", "neg_hi:[0,1,0]"); else HY_BF("", "neg_lo:[0,1,0]"); }
    else        { if (!INV) HY_BF(" neg_lo:[0,1] neg_hi:[0,1]", "neg_hi:[0,1,0]"); else HY_BF(" neg_lo:[0,1] neg_hi:[0,1]", "neg_lo:[0,1,0]"); }
#undef HY_BF
    a = sum; b = o;
}
template <int TI, bool INV>
__device__ __forceinline__ f32x2 tw_mul(f32x2 t) {
    constexpr int T7 = TI < 8 ? TI : 16 - TI;
    const f32x2 W = {tw_c(T7), tw_s(T7)};
    f32x2 r;
#define HY_TW(NEGR, NEGI) asm("v_pk_mul_f32 %0, %1, %2 op_sel_hi:[1,0]" NEGR "\n\tv_pk_fma_f32 %0, %1, %2, %0 op_sel:[1,1,0] op_sel_hi:[0,1,1] " NEGI : "=&v"(r) : "v"(t), "s"(W))
    if (TI < 8) { if (!INV) HY_TW("", "neg_hi:[0,1,0]"); else HY_TW("", "neg_lo:[0,1,0]"); }
    else        { if (!INV) HY_TW(" neg_lo:[0,1] neg_hi:[0,1]", "neg_hi:[0,1,0]"); else HY_TW(" neg_lo:[0,1] neg_hi:[0,1]", "neg_lo:[0,1,0]"); }
#undef HY_TW
    return r;
}
template <bool INV>
__device__ __forceinline__ void bf_rot(f32x2& a, f32x2& b) { f32x2 sum, o;
    if (!INV) asm("v_pk_add_f32 %0, %2, %3\n\tv_pk_add_f32 %1, %2, %3 op_sel:[1,1] op_sel_hi:[0,0] neg_lo:[0,1] neg_hi:[1,0]" : "=&v"(sum), "=&v"(o) : "v"(a), "v"(b));
    else      asm("v_pk_add_f32 %0, %2, %3\n\tv_pk_add_f32 %1, %2, %3 op_sel:[1,1] op_sel_hi:[0,0] neg_lo:[1,0] neg_hi:[0,1]" : "=&v"(sum), "=&v"(o) : "v"(a), "v"(b));
    a = sum; b = o; }
__device__ __forceinline__ void bf_plain(f32x2& a, f32x2& b) { f32x2 sum, o;
    asm("v_pk_add_f32 %0, %2, %3\n\tv_pk_add_f32 %1, %2, %3 neg_lo:[0,1] neg_hi:[0,1]" : "=&v"(sum), "=&v"(o) : "v"(a), "v"(b));
    a = sum; b = o; }
template <bool INV>
__device__ __forceinline__ f32x2 rot_i(f32x2 t) { f32x2 r;
    if (!INV) asm("v_pk_mul_f32 %0, %1, 1.0 op_sel:[1,0] op_sel_hi:[0,0] neg_hi:[1,0]" : "=v"(r) : "v"(t));
    else      asm("v_pk_mul_f32 %0, %1, 1.0 op_sel:[1,0] op_sel_hi:[0,0] neg_lo:[1,0]" : "=v"(r) : "v"(t));
    return r; }

template <int R, bool INV, bool ZP, int S, int J>
__device__ __forceinline__ void fft_bfly(f32x2 (&v)[R]) {
    constexpr int g = (J / S) * 2 * S, k = J % S, ti = k * (16 / S), i0 = g + k, i1 = g + k + S;
    if constexpr (ZP && S == R / 2) {
        if constexpr (ti == 0) v[i1] = v[i0]; else if constexpr (ti == 8) v[i1] = rot_i<INV>(v[i0]); else v[i1] = tw_mul<ti, INV>(v[i0]);
    } else {
        if constexpr (ti == 0) bf_plain(v[i0], v[i1]); else if constexpr (ti == 8) bf_rot<INV>(v[i0], v[i1]); else bf_tw<ti, INV>(v[i0], v[i1]);
    }
}
template <int R, bool INV, bool ZP, int S, int J>
__device__ __forceinline__ void fft_stage(f32x2 (&v)[R]) { if constexpr (J < R / 2) { fft_bfly<R, INV, ZP, S, J>(v); fft_stage<R, INV, ZP, S, J + 1>(v); } }
template <int R, bool INV, bool ZP, int S>
__device__ __forceinline__ void fft_stages(f32x2 (&v)[R]) { if constexpr (S >= 1) { fft_stage<R, INV, ZP, S, 0>(v); fft_stages<R, INV, ZP, S / 2>(v); } }
template <int R, bool INV, bool ZP = false>
__device__ __forceinline__ void fft_reg(f32x2 (&v)[R]) { fft_stages<R, INV, ZP, R / 2>(v); }
#define XV(X) ((const volatile LAS f32x2*)(X))
template <int M, bool ZPAD = false>
__device__ __forceinline__ void pass_fwd32(LAS f32x2* X, int tid) {
    int j = (M == 512) ? (16 * ((tid >> 5) + 16 * ((tid >> 4) & 1)) + (tid & 15)) : (tid & 15);
    asm volatile("" : "+v"(j));
    const int p0 = (M == 512) ? (j + (j >> 4)) : (560 * (tid >> 4) + (tid & 15));
    constexpr int PS = (M == 512) ? 560 : 17;
    f32x2 v[32];
#pragma unroll
    for (int r = 0; r < 32; ++r) { if (ZPAD && r >= 16) v[r] = (f32x2){0.f, 0.f}; else v[r] = XV(X)[p0 + PS * r]; }
    fft_reg<32, false, ZPAD>(v);
    float sn, cs; sincospif(-2.f * (float)j / (float)(32 * M), &sn, &cs);
    const f32x2 w1 = {cs, sn}; f32x2 w = w1;
    X[p0] = v[0];
#pragma unroll
    for (int rp = 1; rp < 32; ++rp) { if (rp < 31) { f32x2 o_, wn_; cmul_chain(v[brev(rp, 5)], w, w1, o_, wn_); X[p0 + PS * rp] = o_; w = wn_; } else X[p0 + PS * rp] = cmul(v[brev(rp, 5)], w); }
}
template <int M, bool HALF = false>
__device__ __forceinline__ void pass_inv32(LAS f32x2* X, int tid) {
    int j = (M == 512) ? (16 * ((tid >> 5) + 16 * ((tid >> 4) & 1)) + (tid & 15)) : (tid & 15);
    asm volatile("" : "+v"(j));
    const int p0 = (M == 512) ? (j + (j >> 4)) : (560 * (tid >> 4) + (tid & 15));
    constexpr int PS = (M == 512) ? 560 : 17;
    float sn, cs; sincospif(2.f * (float)j / (float)(32 * M), &sn, &cs);
    const f32x2 w1 = {cs, sn}; f32x2 w = w1;
    f32x2 v[32];
    v[0] = XV(X)[p0];
#pragma unroll
    for (int rp = 1; rp < 32; ++rp) { if (rp < 31) { f32x2 wn_; cmul_chain(XV(X)[p0 + PS * rp], w, w1, v[rp], wn_); w = wn_; } else v[rp] = cmul(XV(X)[p0 + PS * rp], w); }
    fft_reg<32, true>(v);
#pragma unroll
    for (int p = 0; p < 32; ++p) { if (!HALF || brev(p, 5) < 16) X[p0 + PS * brev(p, 5)] = v[p]; }
}
typedef _Float16 f16x8h __attribute__((ext_vector_type(8)));
__device__ __forceinline__ void pass_c_store(const LAS f32x2* X, f32x2* Hs_, int tid, float scale) {
    _Float16* Hs = (_Float16*)Hs_; (void)scale;
#pragma unroll
    for (int u = 0; u < 2; ++u) { const int blk = tid + 512 * u, p0 = 17 * blk + 16 * (blk >> 5);
        f32x2 v[16];
#pragma unroll
        for (int r = 0; r < 16; ++r) v[r] = XV(X)[p0 + r];
        fft_reg<16, false>(v);
#pragma unroll
        for (int q = 0; q < 4; ++q) { f16x8h o;
#pragma unroll
            for (int e = 0; e < 4; ++e) { const f32x2 x = v[brev(4 * q + e, 4)]; o[2 * e] = (_Float16)x[0]; o[2 * e + 1] = (_Float16)x[1]; }
            *(f16x8h*)(Hs + 2 * (16 * blk + 4 * q)) = o; } }
}
__device__ __forceinline__ void pass_c_mul_inv(LAS f32x2* X, const f32x2* Hs_, int tid) {
    const _Float16* Hs = (const _Float16*)Hs_;
#pragma unroll
    for (int u = 0; u < 2; ++u) { const int blk = tid + 512 * u, p0 = 17 * blk + 16 * (blk >> 5);
        f32x2 v[16], w[16];
#pragma unroll
        for (int r = 0; r < 16; ++r) v[r] = XV(X)[p0 + r];
        f16x8h hh[4];
#pragma unroll
        for (int q = 0; q < 4; ++q) hh[q] = *(const f16x8h*)(Hs + 2 * (16 * blk + 4 * q));
        fft_reg<16, false>(v);
#pragma unroll
        for (int q = 0; q < 4; ++q)
#pragma unroll
            for (int e = 0; e < 4; ++e) w[4 * q + e] = cmul(v[brev(4 * q + e, 4)], (f32x2){(float)hh[q][2 * e], (float)hh[q][2 * e + 1]});
        fft_reg<16, true>(w);
#pragma unroll
        for (int p = 0; p < 16; ++p) X[p0 + brev(p, 4)] = w[p]; }
}
__device__ __forceinline__ void load16(const bf16_t* u, float (&e)[16]) {
    const u32x4 a = *(const u32x4*)u, b = *(const u32x4*)(u + 8);
    e[0] = bflo(a.x); e[1] = bfhi(a.x); e[2] = bflo(a.y); e[3] = bfhi(a.y); e[4] = bflo(a.z); e[5] = bfhi(a.z); e[6] = bflo(a.w); e[7] = bfhi(a.w);
    e[8] = bflo(b.x); e[9] = bfhi(b.x); e[10] = bflo(b.y); e[11] = bfhi(b.y); e[12] = bflo(b.z); e[13] = bfhi(b.z); e[14] = bflo(b.w); e[15] = bfhi(b.w);
}
__device__ __forceinline__ void sconv16(const bf16_t* u, int tid, float w0, float w1, float w2, float bias, float (&o)[16]) {
    float e[16]; load16(u + 16 * tid, e);
    float lf = __shfl_up(e[15], 1), rt = __shfl_down(e[0], 1);
    if ((tid & 3) == 0) lf = 0.f;
    if ((tid & 3) == 3) rt = 0.f;
    o[0] = w0 * lf + w1 * e[0] + w2 * e[1] + bias;
#pragma unroll
    for (int i = 1; i < 15; ++i) o[i] = w0 * e[i - 1] + w1 * e[i] + w2 * e[i + 1] + bias;
    o[15] = w0 * e[14] + w1 * e[15] + w2 * rt + bias;
}

constexpr int CV_W1 = NE * 64 * 32;
constexpr int CV_W2E = 11;
constexpr int CV_ITEMS = CV_W1 + CV_W2E * 1024;
struct CvJob { float v[16]; int mi; };
__device__ __forceinline__ void cv_issue(const Args& a, CvJob& jb, int mi, int lane) {
    jb.mi = mi;
    if (mi >= 0) {
        const float* src; size_t rs;
        if (mi < CV_W1) { const int e = mi >> 11, kg = (mi >> 5) & 63, nb = mi & 31; src = a.in[I_EW1] + ((size_t)e * 1024 + 16 * kg) * 2048 + 64 * nb + lane; rs = 2048; }
        else { const int m2 = mi - CV_W1, e = m2 >> 10, kg = (m2 >> 4) & 63, nb = m2 & 15; src = a.in[I_EW2] + ((size_t)e * 1024 + 16 * kg) * 1024 + 64 * nb + lane; rs = 1024; }
#pragma unroll
        for (int i = 0; i < 16; ++i) jb.v[i] = src[(size_t)i * rs]; }
}
__device__ __forceinline__ void cv_finish(const Args& a, const CvJob& jb, int lane) {
    if (jb.mi >= 0) { const int mi = jb.mi;
        unsigned char* dst;
        if (mi < CV_W1) { const int e = mi >> 11, kg = (mi >> 5) & 63, nb = mi & 31;
            const int cs = 64 * nb + lane, sgl = cs & 1, ac = cs >> 1, ct = ac >> 7, jj = ac & 127;
            dst = (unsigned char*)(a.ws + WS_W1T) + ((size_t)e * 2048 + 256 * ct + 128 * sgl + jj) * 1024 + 16 * kg; }
        else { const int m2 = mi - CV_W1, e = m2 >> 10, kg = (m2 >> 4) & 63, nb = m2 & 15;
            dst = (unsigned char*)(a.ws + WS_W2T) + ((size_t)e * 1024 + 64 * nb + lane) * 1024 + 16 * kg; }
        u32x4 o;
        o.x = gm::pk4_fp8_nc(jb.v[0] * gm::S_W, jb.v[1] * gm::S_W, jb.v[2] * gm::S_W, jb.v[3] * gm::S_W); o.y = gm::pk4_fp8_nc(jb.v[4] * gm::S_W, jb.v[5] * gm::S_W, jb.v[6] * gm::S_W, jb.v[7] * gm::S_W);
        o.z = gm::pk4_fp8_nc(jb.v[8] * gm::S_W, jb.v[9] * gm::S_W, jb.v[10] * gm::S_W, jb.v[11] * gm::S_W); o.w = gm::pk4_fp8_nc(jb.v[12] * gm::S_W, jb.v[13] * gm::S_W, jb.v[14] * gm::S_W, jb.v[15] * gm::S_W);
        *(u32x4*)dst = o; }
}
struct CvState { CvJob jb; int next, stride, end; };
__device__ __forceinline__ void cv_step(const Args& a, CvState& st, int lane) {
    cv_finish(a, st.jb, lane);
    const int mi = st.next < st.end ? st.next : -1;
    cv_issue(a, st.jb, mi, lane);
    st.next += st.stride;
}

__device__ __forceinline__ void channel(const Args& a, LAS unsigned char* lds, int c, unsigned char* scratch, CvState& cvs) {
    const int tid = threadIdx.x;
#define CV_STEP() cv_step(a, cvs, tid & 63)
    LAS f32x2* X = (LAS f32x2*)lds;
    f32x2* Hs = (f32x2*)scratch;
    const _Float16* HF = (const _Float16*)(a.ws + WS_HF);
    const int pc = 17 * tid + 16 * (tid >> 5);
    __syncthreads();
#pragma unroll 1
    for (int o = 0; o < 2; ++o) {
        typedef _Float16 f16x8_ __attribute__((ext_vector_type(8)));
        const f16x8_* hf = (const f16x8_*)(HF + ((size_t)(2 * o) * HYW + c) * SEQ + 16 * tid); const f16x8_* hb = (const f16x8_*)(HF + ((size_t)(2 * o + 1) * HYW + c) * SEQ + 16 * tid);
#pragma unroll
        for (int q = 0; q < 2; ++q) { const f16x8_ f = hf[q], b = hb[q];
#pragma unroll
            for (int e = 0; e < 8; ++e) { const int i = 8 * q + e, t = 16 * tid + i;
                X[pc + i] = (f32x2){(float)f[e], 0.f};
                if (t >= 1) X[phys(FFTN - t)] = (f32x2){(float)b[e], 0.f}; } }
        if (tid == 0) X[phys(SEQ)] = (f32x2){0.f, 0.f};
        __syncthreads();
        CV_STEP(); pass_fwd32<512>(X, tid); __syncthreads(); CV_STEP(); pass_fwd32<16>(X, tid); __syncthreads(); pass_c_store(X, Hs + (size_t)o * (FFTN / 2), tid, 1.f); __syncthreads();
    }
    const float* cw = a.in[I_CONVW]; const float* cbv = a.in[I_CONVB]; const float* dbias = a.in[I_BIASD];
    const float d1 = dbias[c], d2 = dbias[HYW + c];
    constexpr float INVN = 1.f / (float)FFTN;
    float wv[3][3], bv[3];
#pragma unroll
    for (int s = 0; s < 3; ++s) { bv[s] = cbv[s * HYW + c];
#pragma unroll
        for (int i = 0; i < 3; ++i) wv[s][i] = cw[i * HYC + s * HYW + c]; }
    const bf16_t* UT = (const bf16_t*)(a.ws + WS_UT);
    bf16_t* YT = (bf16_t*)(a.ws + WS_YHYT);
#pragma unroll 1
    for (int bp = 0; bp < 2; ++bp) {
        const bf16_t* u0 = UT + ((size_t)(2 * bp) * HYC + c) * SEQ; const bf16_t* u1 = UT + ((size_t)(2 * bp + 1) * HYC + c) * SEQ;
        float z0[16], z1[16];
        {
            float v0[16], v1[16]; sconv16(u0, tid, wv[0][0], wv[0][1], wv[0][2], bv[0], v0); sconv16(u1, tid, wv[0][0], wv[0][1], wv[0][2], bv[0], v1);
#pragma unroll
            for (int i = 0; i < 16; ++i) X[pc + i] = (f32x2){v0[i], v1[i]};
        }
        __syncthreads();
        CV_STEP(); pass_fwd32<512, true>(X, tid); __syncthreads(); CV_STEP(); pass_fwd32<16>(X, tid); __syncthreads(); pass_c_mul_inv(X, Hs, tid); __syncthreads(); CV_STEP(); pass_inv32<16>(X, tid); __syncthreads(); CV_STEP(); pass_inv32<512, true>(X, tid); __syncthreads();
        {
            float v0[16], v1[16], x0[16], x1[16];
            sconv16(u0, tid, wv[0][0], wv[0][1], wv[0][2], bv[0], v0); sconv16(u1, tid, wv[0][0], wv[0][1], wv[0][2], bv[0], v1);
            sconv16(u0 + (size_t)HYW * SEQ, tid, wv[1][0], wv[1][1], wv[1][2], bv[1], x0); sconv16(u1 + (size_t)HYW * SEQ, tid, wv[1][0], wv[1][1], wv[1][2], bv[1], x1);
#pragma unroll
            for (int i = 0; i < 16; ++i) { const f32x2 y1 = X[pc + i]; z0[i] = x0[i] * (y1[0] * INVN + d1 * v0[i]); z1[i] = x1[i] * (y1[1] * INVN + d1 * v1[i]); X[pc + i] = (f32x2){z0[i], z1[i]}; }
        }
        __syncthreads();
        CV_STEP(); pass_fwd32<512, true>(X, tid); __syncthreads(); CV_STEP(); pass_fwd32<16>(X, tid); __syncthreads(); pass_c_mul_inv(X, Hs + FFTN / 2, tid); __syncthreads(); CV_STEP(); pass_inv32<16>(X, tid); __syncthreads(); CV_STEP(); pass_inv32<512, true>(X, tid); __syncthreads();
        {
            float x0[16], x1[16];
            sconv16(u0 + (size_t)2 * HYW * SEQ, tid, wv[2][0], wv[2][1], wv[2][2], bv[2], x0); sconv16(u1 + (size_t)2 * HYW * SEQ, tid, wv[2][0], wv[2][1], wv[2][2], bv[2], x1);
            unsigned w0[8], w1[8];
#pragma unroll
            for (int i = 0; i < 8; ++i) { const f32x2 ya = X[pc + 2 * i], yb = X[pc + 2 * i + 1];
                w0[i] = pk2(x0[2 * i] * (ya[0] * INVN + d2 * z0[2 * i]), x0[2 * i + 1] * (yb[0] * INVN + d2 * z0[2 * i + 1]));
                w1[i] = pk2(x1[2 * i] * (ya[1] * INVN + d2 * z1[2 * i]), x1[2 * i + 1] * (yb[1] * INVN + d2 * z1[2 * i + 1])); }
            u32x4* y0p = (u32x4*)(YT + ((size_t)(2 * bp) * HYW + c) * SEQ + 16 * tid); u32x4* y1p = (u32x4*)(YT + ((size_t)(2 * bp + 1) * HYW + c) * SEQ + 16 * tid);
            y0p[0] = (u32x4){w0[0], w0[1], w0[2], w0[3]}; y0p[1] = (u32x4){w0[4], w0[5], w0[6], w0[7]};
            y1p[0] = (u32x4){w1[0], w1[1], w1[2], w1[3]}; y1p[1] = (u32x4){w1[4], w1[5], w1[6], w1[7]};
        }
        __syncthreads();
    }
#undef CV_STEP
}

constexpr int FILT_RS = 68;
__device__ __forceinline__ void filter_item(const Args& a, int item, int lane, const LAS float* hs) {
    const int ct = item & 127, tc = item >> 7;
    const float* wout = a.in[I_FWOUT]; _Float16* HF = (_Float16*)(a.ws + WS_HF);
    const int col = 16 * ct + (lane & 15), kq = lane >> 4, cch = col & 511;
    typedef _Float16 f16x8f __attribute__((ext_vector_type(8)));
    f16x8f bfr[2];
#pragma unroll
    for (int s = 0; s < 2; ++s)
#pragma unroll
        for (int i = 0; i < 8; ++i) bfr[s][i] = (_Float16)wout[(size_t)(32 * s + 8 * kq + i) * 2048 + col];
    const float dlt = fabsf(-3.0701134573253945f + (float)cch * ((-15.350567286626973f + 3.0701134573253945f) / 511.f));
#pragma unroll 4
    for (int tt = 0; tt < 32; ++tt) { const int t0 = 512 * tc + 16 * tt;
        const LAS f32x4* ar = (const LAS f32x4*)(hs + (16 * tt + (lane & 15)) * FILT_RS + 8 * kq);
        const f32x4 a0 = ar[0], a1 = ar[1], a2 = ar[8], a3 = ar[9];
        const f16x8f af0 = {(_Float16)a0[0], (_Float16)a0[1], (_Float16)a0[2], (_Float16)a0[3], (_Float16)a1[0], (_Float16)a1[1], (_Float16)a1[2], (_Float16)a1[3]};
        const f16x8f af1 = {(_Float16)a2[0], (_Float16)a2[1], (_Float16)a2[2], (_Float16)a2[3], (_Float16)a3[0], (_Float16)a3[1], (_Float16)a3[2], (_Float16)a3[3]};
        f32x4 acc = {0.f, 0.f, 0.f, 0.f};
        acc = __builtin_amdgcn_mfma_f32_16x16x32_f16(af0, bfr[0], acc, 0, 0, 0);
        acc = __builtin_amdgcn_mfma_f32_16x16x32_f16(af1, bfr[1], acc, 0, 0, 0);
        f32x4 o;
#pragma unroll
        for (int r = 0; r < 4; ++r) o[r] = acc[r] * __expf(-((float)(t0 + 4 * kq + r) / (float)(SEQ - 1)) * dlt);
        typedef _Float16 f16x4_ __attribute__((ext_vector_type(4)));
        *(f16x4_*)(HF + (size_t)col * SEQ + t0 + 4 * kq) = (f16x4_){(_Float16)o[0], (_Float16)o[1], (_Float16)o[2], (_Float16)o[3]}; }
}

__device__ __forceinline__ void transpose_item(const Args& a, int item, int lane) {
    const int lt = item & 127, ct = (item >> 7) & 7, b = item >> 10;
    const bf16_t* src = (const bf16_t*)(a.ws + WS_YHYT) + ((size_t)b * HYW + 64 * ct) * SEQ + 64 * lt + lane;
    bf16_t* dst = (bf16_t*)(a.ws + WS_MIX) + ((size_t)b * SEQ + 64 * lt + lane) * 1024 + 512 + 64 * ct;
    unsigned short v[64];
#pragma unroll
    for (int cc = 0; cc < 64; ++cc) v[cc] = src[(size_t)cc * SEQ];
#pragma unroll
    for (int q = 0; q < 8; ++q)
        *(u32x4*)(dst + 8 * q) = (u32x4){(unsigned)v[8 * q] | ((unsigned)v[8 * q + 1] << 16), (unsigned)v[8 * q + 2] | ((unsigned)v[8 * q + 3] << 16),
                                         (unsigned)v[8 * q + 4] | ((unsigned)v[8 * q + 5] << 16), (unsigned)v[8 * q + 6] | ((unsigned)v[8 * q + 7] << 16)};
}
}

__device__ __forceinline__ void p0_mod_and_filter(const Args& a, LAS unsigned char* lds) {
    const int tid = threadIdx.x, lane = tid & 63, wave = tid >> 6;
    const float* c = a.in[I_C]; const float* cctx = a.in[I_CCTX]; const float* adaw = a.in[I_ADAW]; const float* adab = a.in[I_ADAB];
    float* mod = (float*)(a.ws + WS_MOD);
    LAS float* sl = (LAS float*)lds;
    LAS float* pt = (LAS float*)lds + 5 * 1024;
    for (int i = tid; i < 5 * 1024; i += NTHREADS) { const int r = i >> 10, k = i & 1023; sl[i] = silu_f(r < 4 ? c[r * 1024 + k] : cctx[k]); }
    for (int it = blockIdx.x; it < 256; it += gridDim.x) {
        __syncthreads();
        if (tid < 504) {
            const int col = tid % 24, ks = tid / 24, n = it * 24 + col, kbeg = ks * 49, kend = (kbeg + 49 < 1024) ? kbeg + 49 : 1024;
            float acc[5] = {0.f, 0.f, 0.f, 0.f, 0.f};
#pragma unroll 7
            for (int k = kbeg; k < kend; ++k) { const float w = adaw[(size_t)k * 6144 + n];
#pragma unroll
                for (int r = 0; r < 5; ++r) acc[r] += sl[r * 1024 + k] * w; }
#pragma unroll
            for (int r = 0; r < 5; ++r) pt[(ks * 5 + r) * 24 + col] = acc[r];
        }
        __syncthreads();
        if (tid < 120) { const int r = tid / 24, col = tid % 24, n = it * 24 + col; float s = adab[n];
            for (int ks = 0; ks < 21; ++ks) s += pt[(ks * 5 + r) * 24 + col];
            mod[r * 6144 + n] = s; }
    }
    __syncthreads();
    const float* w1 = a.in[I_FW1]; const float* b1 = a.in[I_FB1]; const float* w2 = a.in[I_FW2]; const float* b2 = a.in[I_FB2]; const float* fq = a.in[I_FFREQ];
    float* hid2 = (float*)(a.ws + WS_HID2);
    LAS float* zs = (LAS float*)lds + 8192 + wave * 128;
    const float frq = fq[lane], bb1 = b1[lane], bb2 = b2[lane];
    for (int t = (blockIdx.x * NWAVES + wave); t < SEQ; t += gridDim.x * NWAVES) {
        float z = 0.f;
        if (lane == 0) z = (float)t / (float)(SEQ - 1);
        else if (lane < 33) { const int i = (lane - 1) & 15; const float f = 1e-4f + (float)i * ((15.f - 1e-4f) / 15.f);
            const float ang = (6.283185307179586f * (float)t / (float)SEQ) * f; z = (lane < 17) ? cosf(ang) : -sinf(ang); }
        if (lane < 33) zs[lane] = z;
        __builtin_amdgcn_wave_barrier(); asm volatile("s_waitcnt lgkmcnt(0)" ::: "memory");
        float s = bb1;
#pragma unroll
        for (int e = 0; e < 33; ++e) s += zs[e] * w1[e * 64 + lane];
        const float h1 = sinf(frq * s);
        zs[64 + lane] = h1;
        __builtin_amdgcn_wave_barrier(); asm volatile("s_waitcnt lgkmcnt(0)" ::: "memory");
        float s2 = bb2;
#pragma unroll 16
        for (int g = 0; g < 64; ++g) s2 += zs[64 + g] * w2[g * 64 + lane];
        hid2[(size_t)t * 64 + lane] = sinf(frq * s2);
        __builtin_amdgcn_wave_barrier(); asm volatile("s_waitcnt lgkmcnt(0)" ::: "memory");
    }
}

template <bool FP8 = false>
__device__ __forceinline__ void tr_item(const float* W, int ldw, int k0, int c0, int cstride, float scale, bf16_t* dstrow0, LAS float* scr, int lane) {
    float wv_[32];
#pragma unroll
    for (int i = 0; i < 32; ++i) wv_[i] = W[(size_t)(k0 + 2 * i + (lane >> 5)) * ldw + c0 + (lane & 31) * cstride];
#pragma unroll
    for (int i = 0; i < 32; ++i) scr[(2 * i + (lane >> 5)) * 33 + (lane & 31)] = wv_[i] * scale;
    asm volatile("s_waitcnt lgkmcnt(0)" ::: "memory"); __builtin_amdgcn_wave_barrier();
    const int c = lane & 7;
#pragma unroll
    for (int j = 0; j < 4; ++j) { const int n = (lane >> 3) + 8 * j; const LAS float* s = scr + (8 * c) * 33 + n;
        if (FP8) { u32x2 o; o.x = gm::pk4_fp8(s[0 * 33], s[1 * 33], s[2 * 33], s[3 * 33]); o.y = gm::pk4_fp8(s[4 * 33], s[5 * 33], s[6 * 33], s[7 * 33]);
            *(u32x2*)((unsigned char*)dstrow0 + (size_t)n * 1024 + k0 + 8 * c) = o; }
        else { u32x4 o; o.x = pk2(s[0 * 33], s[1 * 33]); o.y = pk2(s[2 * 33], s[3 * 33]); o.z = pk2(s[4 * 33], s[5 * 33]); o.w = pk2(s[6 * 33], s[7 * 33]);
            *(u32x4*)(dstrow0 + (size_t)n * 1024 + k0 + 8 * c) = o; } }
    asm volatile("s_waitcnt lgkmcnt(0)" ::: "memory"); __builtin_amdgcn_wave_barrier();
}
__device__ __forceinline__ void fold_item(const float* win, const float* wa, int dir, int k0, int j0, bf16_t* dstrow0, LAS float* scr, int lane) {
#pragma unroll 4
    for (int i = 0; i < 32; ++i) { const int kk = 2 * i + (lane >> 5); const float* wr = win + (size_t)(k0 + kk) * INW + 1536 + 16 * dir; float s = 0.f;
#pragma unroll
        for (int r = 0; r < 16; ++r) s += wr[r] * wa[r * 256 + j0 + (lane & 31)];
        scr[kk * 33 + (lane & 31)] = s; }
    asm volatile("s_waitcnt lgkmcnt(0)" ::: "memory"); __builtin_amdgcn_wave_barrier();
    const int c = lane & 7;
#pragma unroll
    for (int j = 0; j < 4; ++j) { const int n = (lane >> 3) + 8 * j; const LAS float* s = scr + (8 * c) * 33 + n;
        u32x4 o; o.x = pk2(s[0 * 33], s[1 * 33]); o.y = pk2(s[2 * 33], s[3 * 33]); o.z = pk2(s[4 * 33], s[5 * 33]); o.w = pk2(s[6 * 33], s[7 * 33]);
        *(u32x4*)(dstrow0 + (size_t)n * 1024 + k0 + 8 * c) = o; }
    asm volatile("s_waitcnt lgkmcnt(0)" ::: "memory"); __builtin_amdgcn_wave_barrier();
}
__device__ __forceinline__ void ln_mod_row(const float* xrow, const float* shift, const float* scale, bf16_t* orow, int lane) {
    const f32x4* xr = (const f32x4*)xrow + lane;
    f32x4 v[4]; float s = 0.f;
#pragma unroll
    for (int j = 0; j < 4; ++j) { v[j] = xr[64 * j]; s += (v[j][0] + v[j][1]) + (v[j][2] + v[j][3]); }
    const float mean = wave_sum(s) * (1.f / D); float s2 = 0.f;
#pragma unroll
    for (int j = 0; j < 4; ++j) { v[j] = v[j] - mean; s2 += (v[j][0] * v[j][0] + v[j][1] * v[j][1]) + (v[j][2] * v[j][2] + v[j][3] * v[j][3]); }
    const float rstd = 1.f / sqrtf(wave_sum(s2) * (1.f / D) + LN_EPS);
    u32x2* o8 = (u32x2*)orow + lane;
#pragma unroll
    for (int j = 0; j < 4; ++j) { const f32x4 sh = ((const f32x4*)shift)[64 * j + lane], sc = ((const f32x4*)scale)[64 * j + lane];
        const f32x4 y = v[j] * rstd * (sc + 1.f) + sh;
        u32x2 w; w.x = pk2(y[0], y[1]); w.y = pk2(y[2], y[3]); o8[64 * j] = w; }
}
constexpr int PREP_I_IN = 16 * 96, PREP_I_FOLD = 16 * 8 * 2, PREP_I_OUT = 16 * 32, PREP_I_W1 = NE * 16 * 64, PREP_I_W2 = NE * 16 * 32;
constexpr int PREP_NITEMS = PREP_I_IN + PREP_I_FOLD + PREP_I_OUT + PREP_I_W1 + PREP_I_W2;
constexpr int PREP_DEFER = PREP_I_W2 - hy::CV_W2E * 512;
__device__ __forceinline__ void prep_items(const Args& a, LAS float* scr, int first, int last, int rank, int nranks, int lane) {
    constexpr int I_IN = PREP_I_IN, I_FOLD = PREP_I_FOLD, I_OUT = PREP_I_OUT, I_W1 = PREP_I_W1;
    const float* win = a.in[I_WIN];
    bf16_t* btin = (bf16_t*)(a.ws + WS_BTIN); bf16_t* btout = (bf16_t*)(a.ws + WS_BTOUT); bf16_t* w1t = (bf16_t*)(a.ws + WS_W1T); bf16_t* w2t = (bf16_t*)(a.ws + WS_W2T);
    for (int it = first + rank; it < last; it += nranks) {
        int r = it;
        if (r < I_IN) {
            const int kb = r / 96, nb = r % 96;
            if (nb < 48) tr_item(win, INW, 64 * kb, 32 * nb, 1, nb < 8 ? 0.125f : 1.f, btin + (size_t)(32 * nb) * 1024, scr, lane);
            else tr_item(win, INW, 64 * kb, 1568 + 32 * (nb - 48), 1, 1.f, btin + (size_t)(2048 + 32 * (nb - 48)) * 1024, scr, lane);
            continue; }
        r -= I_IN;
        if (r < I_FOLD) { const int dir = r & 1, jb = (r >> 1) & 7, kb = r >> 4;
            fold_item(win, dir ? a.in[I_WAB] : a.in[I_WAF], dir, 64 * kb, 32 * jb, btin + (size_t)(1536 + 256 * dir + 32 * jb) * 1024, scr, lane); continue; }
        r -= I_FOLD;
        if (r < I_OUT) { const int kb = r / 32, nb = r % 32; tr_item(a.in[I_WOUT], 1024, 64 * kb, 32 * nb, 1, 1.f, btout + (size_t)(32 * nb) * 1024, scr, lane); continue; }
        r -= I_OUT;
        if (r < I_W1) {
            const int e = r / 1024, q = r % 1024, s = q & 1, nb = (q >> 1) & 31, kb = q >> 6;
            const int ct = nb >> 2, jj0 = (nb & 3) * 32;
            tr_item<true>(a.in[I_EW1] + (size_t)e * 1024 * 2048, 2048, 64 * kb, 2 * (128 * ct + jj0) + s, 2, gm::S_W, (bf16_t*)((unsigned char*)w1t + ((size_t)e * 2048 + 256 * ct + 128 * s + jj0) * 1024), scr, lane);
            continue; }
        r -= I_W1;
        { const int e = r / 512, q = r % 512, kb = q / 32, nb = q % 32;
          tr_item<true>(a.in[I_EW2] + (size_t)e * 1024 * 1024, 1024, 64 * kb, 32 * nb, 1, gm::S_W, (bf16_t*)((unsigned char*)w2t + ((size_t)e * 1024 + 32 * nb) * 1024), scr, lane); }
    }
}
__device__ __forceinline__ void p1_prep(const Args& a, LAS unsigned char* lds) {
    const int tid = threadIdx.x, lane = tid & 63, wave = tid >> 6;
    LAS float* scr = (LAS float*)(lds + wave * 16384);
    const int gw = blockIdx.x * NWAVES + wave, NGW = gridDim.x * NWAVES;
    const float* win = a.in[I_WIN];
    bf16_t* btin = (bf16_t*)(a.ws + WS_BTIN); bf16_t* btout = (bf16_t*)(a.ws + WS_BTOUT); bf16_t* w1t = (bf16_t*)(a.ws + WS_W1T); bf16_t* w2t = (bf16_t*)(a.ws + WS_W2T);
    const float* mod = (const float*)(a.ws + WS_MOD);
    bf16_t* H = (bf16_t*)(a.ws + WS_H);
    { int cur_mr = -1; f32x4 shv[4], scv[4];
#pragma unroll
      for (int j = 0; j < 4; ++j) { shv[j] = (f32x4){0.f, 0.f, 0.f, 0.f}; scv[j] = shv[j]; }
      for (int row0 = gw; row0 < TT; row0 += 4 * NGW) {
        f32x4 xv[4][4];
#pragma unroll
        for (int i = 0; i < 4; ++i) { const int row = row0 + i * NGW;
            if (row < TT) { const f32x4* xr = (const f32x4*)(row < T ? a.in[I_X] + (size_t)row * D : a.in[I_CTX] + (size_t)(row - T) * D) + lane;
#pragma unroll
                for (int j = 0; j < 4; ++j) xv[i][j] = xr[64 * j]; } }
#pragma unroll
        for (int i = 0; i < 4; ++i) { const int row = row0 + i * NGW;
            if (row < TT) { const int mr = row < T ? row >> 13 : 4;
                if (mr != cur_mr) { cur_mr = mr;
#pragma unroll
                    for (int j = 0; j < 4; ++j) { shv[j] = ((const f32x4*)(mod + mr * 6144))[64 * j + lane]; scv[j] = ((const f32x4*)(mod + mr * 6144 + 1024))[64 * j + lane]; } }
                f32x4 v[4]; float s = 0.f;
#pragma unroll
                for (int j = 0; j < 4; ++j) { v[j] = xv[i][j]; s += (v[j][0] + v[j][1]) + (v[j][2] + v[j][3]); }
                const float mean = wave_sum(s) * (1.f / D); float s2 = 0.f;
#pragma unroll
                for (int j = 0; j < 4; ++j) { v[j] = v[j] - mean; s2 += (v[j][0] * v[j][0] + v[j][1] * v[j][1]) + (v[j][2] * v[j][2] + v[j][3] * v[j][3]); }
                const float rstd = 1.f / sqrtf(wave_sum(s2) * (1.f / D) + LN_EPS);
                u32x2* o8 = (u32x2*)(H + (size_t)row * D) + lane;
#pragma unroll
                for (int j = 0; j < 4; ++j) { const f32x4 y = v[j] * rstd * (scv[j] + 1.f) + shv[j];
                    u32x2 w; w.x = pk2(y[0], y[1]); w.y = pk2(y[2], y[3]); o8[64 * j] = w; } } }
      } }
    prep_items(a, scr, 0, PREP_I_IN + PREP_I_FOLD + PREP_I_OUT, gw, NGW, lane);
    for (int it0 = blockIdx.x * NWAVES; it0 < 2048; it0 += NGW) {
        __syncthreads();
        { const f32x4* src = (const f32x4*)((const float*)(a.ws + WS_HID2) + (size_t)(it0 >> 7) * 512 * 64); LAS float* hs = (LAS float*)lds;
#pragma unroll
          for (int i = 0; i < 16; ++i) { const int pz = tid + NTHREADS * i; *(LAS f32x4*)(hs + (pz >> 4) * hy::FILT_RS + 4 * (pz & 15)) = src[pz]; } }
        __syncthreads();
        hy::filter_item(a, it0 + wave, lane, (const LAS float*)lds);
    }
    float* b1r = (float*)(a.ws + WS_B1R); const float* eb1 = a.in[I_EB1];
    for (int i = blockIdx.x * NTHREADS + tid; i < NE * 2048; i += gridDim.x * NTHREADS) {
        const int e = i >> 11, n = i & 2047, ct = n >> 8, s = (n >> 7) & 1, jj = n & 127;
        b1r[i] = eb1[(size_t)e * 2048 + 2 * (128 * ct + jj) + s];
    }
}

namespace gla {
constexpr int RS = 72;
constexpr int L_TOTF = 0, L_TOTB = 2048, L_SSQ = 4096;
constexpr int L_T0 = 8192;
constexpr int L_T1 = L_T0 + 9216, L_T2 = L_T1 + 9216, L_T3 = L_T2 + 9216;
constexpr int L_VT = L_T3 + 9216;
constexpr int L_P  = L_VT + 18432;
constexpr int L_SF = L_P + 9216, L_SB = L_SF + 18432;
constexpr int L_END = L_SB + 18432;

__device__ __forceinline__ bf16x8 frag(const LAS unsigned char* tile, int row, int k0, int lane) {
    return *(const LAS bf16x8*)(tile + ((row + (lane & 15)) * RS + k0 + 8 * (lane >> 4)) * 2);
}
__device__ __forceinline__ void chunk_cums_pre(LAS unsigned char* L, const float (&gf)[8], const float (&gb)[8], int wave, int lane, float (&cumf)[8], float (&cumb)[8], float& allf, float& allb) {
    LAS float* totf = (LAS float*)(L + L_TOTF); LAS float* totb = (LAS float*)(L + L_TOTB);
    cumf[0] = gf[0];
#pragma unroll
    for (int r = 1; r < 8; ++r) cumf[r] = cumf[r - 1] + gf[r];
    cumb[7] = gb[7];
#pragma unroll
    for (int r = 6; r >= 0; --r) cumb[r] = cumb[r + 1] + gb[r];
    totf[wave * 64 + lane] = cumf[7]; totb[wave * 64 + lane] = cumb[0];
    __syncthreads();
    float of = 0.f, ob = 0.f, af = 0.f, ab = 0.f;
#pragma unroll
    for (int w = 0; w < 8; ++w) { const float tf = totf[w * 64 + lane], tb = totb[w * 64 + lane]; af += tf; ab += tb; of += (w < wave) ? tf : 0.f; ob += (w > wave) ? tb : 0.f; }
#pragma unroll
    for (int r = 0; r < 8; ++r) { cumf[r] += of; cumb[r] += ob; }
    allf = af; allb = ab;
}
__device__ __forceinline__ void chunk_cums(LAS unsigned char* L, const _Float16* GF, const _Float16* GB, size_t tok0, int h, int wave, int lane, float (&cumf)[8], float (&cumb)[8], float& allf, float& allb) {
    float gf[8], gb[8];
#pragma unroll
    for (int r = 0; r < 8; ++r) { const size_t o = (tok0 + 8 * wave + r) * 256 + h * 64 + lane; gf[r] = (float)GF[o]; gb[r] = (float)GB[o]; }
    chunk_cums_pre(L, gf, gb, wave, lane, cumf, cumb, allf, allb);
}
__device__ __forceinline__ void store_vt(LAS unsigned char* L, const u32x4 (&vr)[2], int tid) {
    LAS bf16_t* vt = (LAS bf16_t*)(L + L_VT);
    const int j = tid >> 3, c8 = tid & 7;
#pragma unroll
    for (int q = 0; q < 2; ++q) { const int dv0 = 8 * (c8 + 8 * q);
        const unsigned ww[4] = {vr[q].x, vr[q].y, vr[q].z, vr[q].w};
#pragma unroll
        for (int e = 0; e < 4; ++e) { vt[(dv0 + 2 * e) * RS + j] = (bf16_t)(ww[e] & 0xffffu); vt[(dv0 + 2 * e + 1) * RS + j] = (bf16_t)(ww[e] >> 16); } }
}
__device__ __forceinline__ void load_vt(LAS unsigned char* L, const bf16_t* V, size_t tok0, int h, int tid) {
    const int j = tid >> 3, c8 = tid & 7; u32x4 vr[2];
#pragma unroll
    for (int q = 0; q < 2; ++q) vr[q] = *(const u32x4*)(V + (tok0 + j) * 512 + h * 128 + 8 * (c8 + 8 * q));
    store_vt(L, vr, tid);
}

__device__ __forceinline__ void g1_unit(const Args& a, LAS unsigned char* L, int bh, int chunk  ) {
    const int tid = threadIdx.x, lane = tid & 63, wave = __builtin_amdgcn_readfirstlane(tid >> 6);
    const int b = bh >> 2, h = bh & 3;
    const size_t tok0 = chunk < NCHUNK ? (size_t)b * SEQ + (size_t)chunk * CH : (size_t)T + (size_t)b * CTXL + (size_t)(chunk - NCHUNK) * CH;
    const _Float16* GF = (const _Float16*)(a.ws + WS_GF); const _Float16* GB = (const _Float16*)(a.ws + WS_GB);
    const bf16_t* Kb = (const bf16_t*)(a.ws + WS_K); const bf16_t* Vb = (const bf16_t*)(a.ws + WS_V);
    float cumf[8], cumb[8], allf, allb;
    __syncthreads();
    chunk_cums(L, GF, GB, tok0, h, wave, lane, cumf, cumb, allf, allb);
    LAS bf16_t* ketf = (LAS bf16_t*)(L + L_T0); LAS bf16_t* ketb = (LAS bf16_t*)(L + L_T1);
#pragma unroll
    for (int r = 0; r < 8; ++r) { const int i = 8 * wave + r; const float kv = bf2f(Kb[(tok0 + i) * 256 + h * 64 + lane]);
        ketf[lane * RS + i] = f2bf(kv * __expf(allf - cumf[r])); ketb[lane * RS + i] = f2bf(kv * __expf(allb - cumb[r])); }
    load_vt(L, Vb, tok0, h, tid);
    if (wave == 0) { float* av = (float*)(a.ws + WS_AV); av[((size_t)(0 * 16 + bh) * NCT + chunk) * 64 + lane] = __expf(allf); av[((size_t)(1 * 16 + bh) * NCT + chunk) * 64 + lane] = __expf(allb); }
    __syncthreads();
    bf16_t* KV = (bf16_t*)(a.ws + WS_KV);
#pragma unroll
    for (int dir = 0; dir < 2; ++dir) {
        const LAS unsigned char* ket = L + (dir ? L_T1 : L_T0);
        bf16_t* dst = KV + ((size_t)(dir * 16 + bh) * NCT + chunk) * 8192;
#pragma unroll
        for (int nt = 0; nt < 4; ++nt) { f32x4 acc = {0.f, 0.f, 0.f, 0.f};
#pragma unroll
            for (int ks = 0; ks < 2; ++ks) acc = __builtin_amdgcn_mfma_f32_16x16x32_bf16(frag(ket, 16 * nt, 32 * ks, lane), frag(L + L_VT, 16 * wave, 32 * ks, lane), acc, 0, 0, 0);
            u32x2 w; w.x = pk2(acc[0], acc[1]); w.y = pk2(acc[2], acc[3]);
            *(u32x2*)(dst + (16 * wave + (lane & 15)) * 64 + 16 * nt + 4 * (lane >> 4)) = w; }
    }
}

__device__ __forceinline__ void g2_scan(const Args& a, LAS unsigned char* L) {
    const bf16_t* KV = (const bf16_t*)(a.ws + WS_KV); const float* AV = (const float*)(a.ws + WS_AV); bf16_t* SP = (bf16_t*)(a.ws + WS_SP);
    LAS float* avs = (LAS float*)L;
    for (int id0 = blockIdx.x * NTHREADS; id0 < 32 * 4096; id0 += gridDim.x * NTHREADS) {
        const int id = id0 + threadIdx.x;
        const int db = id >> 12, e2 = id & 4095, dir = db >> 4, dk = (2 * e2) & 63;
        __syncthreads();
        for (int i = threadIdx.x; i < NCT * 64 / 4; i += NTHREADS) ((LAS f32x4*)avs)[i] = ((const f32x4*)(AV + (size_t)db * NCT * 64))[i];
        __syncthreads();
        const unsigned* kv = (const unsigned*)(KV + (size_t)db * NCT * 8192) + e2;
        const LAS float* av = avs + dk;
        unsigned* sp = (unsigned*)(SP + (size_t)db * NCHUNK * 8192) + e2;
        float s0 = 0.f, s1 = 0.f;
#pragma unroll
        for (int q = 0; q < NCC; ++q) { const int c = NCHUNK + (dir ? (NCC - 1 - q) : q);
            const unsigned w = kv[(size_t)c * 4096]; const f32x2 aa = *(const LAS f32x2*)(av + c * 64);
            s0 = aa[0] * s0 + bflo(w); s1 = aa[1] * s1 + bfhi(w); }
        for (int q0 = 0; q0 < NCHUNK; q0 += 16) {
            unsigned w[16];
#pragma unroll
            for (int u = 0; u < 16; ++u) { const int c = dir ? (NCHUNK - 1 - (q0 + u)) : (q0 + u); w[u] = kv[(size_t)c * 4096]; }
#pragma unroll
            for (int u = 0; u < 16; ++u) { const int c = dir ? (NCHUNK - 1 - (q0 + u)) : (q0 + u);
                const f32x2 aa = *(const LAS f32x2*)(av + c * 64);
                sp[(size_t)c * 4096] = pk2(s0, s1);
                s0 = aa[0] * s0 + bflo(w[u]); s1 = aa[1] * s1 + bfhi(w[u]); }
        }
    }
}

struct G3In { float gf[8], gb[8]; bf16_t q[8], k[8]; u32x4 v[2]; u32x4 sraw[4]; bf16_t gr[4][4]; };
__device__ __forceinline__ void g3_load(const Args& a, int bh, int chunk, G3In& in) {
    const int tid = threadIdx.x, lane = tid & 63, wave = __builtin_amdgcn_readfirstlane(tid >> 6);
    const int b = bh >> 2, h = bh & 3;
    const size_t tok0 = (size_t)b * SEQ + (size_t)chunk * CH;
    const _Float16* GF = (const _Float16*)(a.ws + WS_GF); const _Float16* GB = (const _Float16*)(a.ws + WS_GB);
    const bf16_t* Qb = (const bf16_t*)(a.ws + WS_Q); const bf16_t* Kb = (const bf16_t*)(a.ws + WS_K); const bf16_t* Vb = (const bf16_t*)(a.ws + WS_V);
#pragma unroll
    for (int r = 0; r < 8; ++r) { const size_t o = (tok0 + 8 * wave + r) * 256 + h * 64 + lane; in.gf[r] = (float)GF[o]; in.gb[r] = (float)GB[o]; in.q[r] = Qb[o]; in.k[r] = Kb[o]; }
#pragma unroll
    for (int q = 0; q < 2; ++q) in.v[q] = *(const u32x4*)(Vb + (tok0 + (tid >> 3)) * 512 + h * 128 + 8 * ((tid & 7) + 8 * q));
    const bf16_t* SPf = (const bf16_t*)(a.ws + WS_SP) + ((size_t)(0 * 16 + bh) * NCHUNK + chunk) * 8192;
    const bf16_t* SPb = (const bf16_t*)(a.ws + WS_SP) + ((size_t)(1 * 16 + bh) * NCHUNK + chunk) * 8192;
    in.sraw[0] = *(const u32x4*)(SPf + 16 * tid); in.sraw[1] = *(const u32x4*)(SPf + 16 * tid + 8);
    in.sraw[2] = *(const u32x4*)(SPb + 16 * tid); in.sraw[3] = *(const u32x4*)(SPb + 16 * tid + 8);
    const bf16_t* Gt = (const bf16_t*)(a.ws + WS_G);
    const int mt = wave >> 1, fr = lane & 15, fq = lane >> 4;
#pragma unroll
    for (int q = 0; q < 4; ++q)
#pragma unroll
        for (int r = 0; r < 4; ++r) in.gr[r][q] = Gt[(tok0 + 16 * mt + 4 * fq + r) * 512 + h * 128 + 16 * (4 * (wave & 1) + q) + fr];
}
__device__ __forceinline__ void g3_unit(const Args& a, LAS unsigned char* L, int bh, int chunk  , const G3In& in) {
    const int tid = threadIdx.x, lane = tid & 63, wave = __builtin_amdgcn_readfirstlane(tid >> 6);
    const int b = bh >> 2, h = bh & 3;
    const size_t tok0 = (size_t)b * SEQ + (size_t)chunk * CH;
    const int mt = wave >> 1, fr = lane & 15, fq = lane >> 4;
    float cumf[8], cumb[8], allf, allb;
    __syncthreads();
    chunk_cums_pre(L, in.gf, in.gb, wave, lane, cumf, cumb, allf, allb);
    LAS bf16_t* qf = (LAS bf16_t*)(L + L_T0); LAS bf16_t* kf = (LAS bf16_t*)(L + L_T1); LAS bf16_t* qb = (LAS bf16_t*)(L + L_T2); LAS bf16_t* kb = (LAS bf16_t*)(L + L_T3);
#pragma unroll
    for (int r = 0; r < 8; ++r) { const int i = 8 * wave + r;
        const float qv = bf2f(in.q[r]), kv = bf2f(in.k[r]);
        qf[i * RS + lane] = f2bf(qv * __expf(cumf[r])); kf[i * RS + lane] = f2bf(kv * __expf(-cumf[r]));
        qb[i * RS + lane] = f2bf(qv * __expf(cumb[r])); kb[i * RS + lane] = f2bf(kv * __expf(-cumb[r])); }
    store_vt(L, in.v, tid);
    {
      LAS unsigned char* sf_ = L + L_SF + ((tid >> 2) * RS + 16 * (tid & 3)) * 2; LAS unsigned char* sb_ = L + L_SB + ((tid >> 2) * RS + 16 * (tid & 3)) * 2;
      *(LAS u32x4*)sf_ = in.sraw[0]; *(LAS u32x4*)(sf_ + 16) = in.sraw[1]; *(LAS u32x4*)sb_ = in.sraw[2]; *(LAS u32x4*)(sb_ + 16) = in.sraw[3]; }
    __syncthreads();
    {
        LAS bf16_t* P = (LAS bf16_t*)(L + L_P);
#pragma unroll
        for (int q = 0; q < 2; ++q) { const int nt = 2 * (wave & 1) + q;
            f32x4 sf = {0.f, 0.f, 0.f, 0.f}, sb = {0.f, 0.f, 0.f, 0.f};
#pragma unroll
            for (int ks = 0; ks < 2; ++ks) {
                sf = __builtin_amdgcn_mfma_f32_16x16x32_bf16(frag(L + L_T0, 16 * mt, 32 * ks, lane), frag(L + L_T1, 16 * nt, 32 * ks, lane), sf, 0, 0, 0);
                sb = __builtin_amdgcn_mfma_f32_16x16x32_bf16(frag(L + L_T2, 16 * mt, 32 * ks, lane), frag(L + L_T3, 16 * nt, 32 * ks, lane), sb, 0, 0, 0); }
#pragma unroll
            for (int r = 0; r < 4; ++r) { const int i = 16 * mt + 4 * fq + r, j = 16 * nt + fr;
                P[i * RS + j] = f2bf((j <= i ? sf[r] : 0.f) + (j >= i ? sb[r] : 0.f)); } }
    }
    __syncthreads();
    f32x4 o[4]; float ssq[4] = {0.f, 0.f, 0.f, 0.f};
#pragma unroll
    for (int q = 0; q < 4; ++q) { const int nt = 4 * (wave & 1) + q;
        f32x4 acc = {0.f, 0.f, 0.f, 0.f};
#pragma unroll
        for (int ks = 0; ks < 2; ++ks) {
            acc = __builtin_amdgcn_mfma_f32_16x16x32_bf16(frag(L + L_P, 16 * mt, 32 * ks, lane), frag(L + L_VT, 16 * nt, 32 * ks, lane), acc, 0, 0, 0);
            acc = __builtin_amdgcn_mfma_f32_16x16x32_bf16(frag(L + L_T0, 16 * mt, 32 * ks, lane), frag(L + L_SF, 16 * nt, 32 * ks, lane), acc, 0, 0, 0);
            acc = __builtin_amdgcn_mfma_f32_16x16x32_bf16(frag(L + L_T2, 16 * mt, 32 * ks, lane), frag(L + L_SB, 16 * nt, 32 * ks, lane), acc, 0, 0, 0); }
        o[q] = acc;
#pragma unroll
        for (int r = 0; r < 4; ++r) ssq[r] += acc[r] * acc[r]; }
    LAS float* SSQ = (LAS float*)(L + L_SSQ);
#pragma unroll
    for (int r = 0; r < 4; ++r) { float s = ssq[r]; s += __shfl_xor(s, 1); s += __shfl_xor(s, 2); s += __shfl_xor(s, 4); s += __shfl_xor(s, 8); ssq[r] = s; }
    if (fr == 0) {
#pragma unroll
        for (int r = 0; r < 4; ++r) SSQ[(wave & 1) * 64 + 16 * mt + 4 * fq + r] = ssq[r]; }
    __syncthreads();
    const float* ng = a.in[I_NORMG];
    bf16_t* mix = (bf16_t*)(a.ws + WS_MIX);
#pragma unroll
    for (int r = 0; r < 4; ++r) { const int i = 16 * mt + 4 * fq + r;
        const float rstd = 1.f / sqrtf((SSQ[i] + SSQ[64 + i]) * (1.f / DV) + LN_EPS);
#pragma unroll
        for (int q = 0; q < 4; ++q) { const int dv = 16 * (4 * (wave & 1) + q) + fr;
            const float g = bf2f(in.gr[r][q]);
            mix[(tok0 + i) * 1024 + h * 128 + dv] = f2bf(o[q][r] * rstd * ng[dv] * silu_f(g)); } }
}
}

namespace rt {
constexpr int HS = 1028;
constexpr int L_H2 = 0;
constexpr int L_PART = 65792;
constexpr int L_LCNT = L_PART + 16384;
constexpr int L_REC = L_LCNT + 256;
constexpr int L_TAB = 86016;

__device__ __forceinline__ void phase(const Args& a, LAS unsigned char* lds) {
    const int tid = threadIdx.x, lane = tid & 63, wave = __builtin_amdgcn_readfirstlane(tid >> 6);
    bf16_t* xmid = (bf16_t*)(a.ws + WS_PRE1); bf16_t* H2 = (bf16_t*)(a.ws + WS_H2); const bf16_t* FG = (const bf16_t*)(a.ws + WS_FG);
    const float* mod = (const float*)(a.ws + WS_MOD);
    const float* rw = a.in[I_RW]; const float* rb = a.in[I_RB];
    LAS float* h2s = (LAS float*)(lds + L_H2); LAS float* part = (LAS float*)(lds + L_PART);
    LAS int* lcnt = (LAS int*)(lds + L_LCNT); LAS int* lbase = lcnt + 32; LAS int* rec = (LAS int*)(lds + L_REC);
    unsigned* cnt = (unsigned*)(a.ws + WS_CNT); int* list = (int*)(a.ws + WS_LIST); float* pw = (float*)(a.ws + WS_PW); int* ploc = (int*)(a.ws + WS_PLOC);
    bf16x8 rwh[4][2], rwl[4][2];
#pragma unroll
    for (int s = 0; s < 4; ++s)
#pragma unroll
        for (int nt = 0; nt < 2; ++nt)
#pragma unroll
            for (int i = 0; i < 8; ++i) { const float x = rw[(size_t)(128 * wave + 32 * s + 8 * (lane >> 4) + i) * 32 + 16 * nt + (lane & 15)];
                const unsigned hb = __float_as_uint(x) & 0xffff0000u; rwh[s][nt][i] = (short)(hb >> 16); rwl[s][nt][i] = (short)f2bf(x - __uint_as_float(hb)); }
    LAS f32x4* g1 = (LAS f32x4*)(lds + L_TAB); LAS f32x4* bb1 = g1 + 256; LAS f32x4* shT = bb1 + 256; LAS f32x4* scT = shT + 4 * 256;
    if (tid < 256) { g1[tid] = ((const f32x4*)a.in[I_LN1G])[tid]; bb1[tid] = ((const f32x4*)a.in[I_LN1B])[tid]; }
    for (int i = tid; i < 4 * 256; i += NTHREADS) { shT[i] = ((const f32x4*)(mod + (i >> 8) * 6144 + 3 * 1024))[i & 255]; scT[i] = ((const f32x4*)(mod + (i >> 8) * 6144 + 4 * 1024))[i & 255]; }
    const float rbe = rb[lane & 31];
    if (tid < 32) lcnt[tid] = 0;
    int pend = 0, pgrp = -1;
    f32x4 xq[2][4]; u32x2 fq_[2][4];
#define RT_LOAD(g_) do { _Pragma("unroll") for (int rr = 0; rr < 2; ++rr) { const int t_ = (g_) * 16 + 2 * wave + rr; \
        const f32x4* xr_ = (const f32x4*)(a.in[I_X] + (size_t)t_ * D) + lane; const u32x2* fr_ = (const u32x2*)(FG + (size_t)t_ * D) + lane; \
        _Pragma("unroll") for (int j = 0; j < 4; ++j) { xq[rr][j] = xr_[64 * j]; fq_[rr][j] = fr_[64 * j]; } } } while (0)
    if ((int)blockIdx.x < T / 16) RT_LOAD((int)blockIdx.x);
    for (int grp = blockIdx.x; grp < T / 16; grp += gridDim.x) {
        __syncthreads();
        f32x4 xv_[2][4]; u32x2 fv_[2][4];
#pragma unroll
        for (int rr = 0; rr < 2; ++rr)
#pragma unroll
            for (int j = 0; j < 4; ++j) { xv_[rr][j] = xq[rr][j]; fv_[rr][j] = fq_[rr][j]; }
        if (pgrp >= 0) { if (tid < 32) lbase[tid] = pend; __syncthreads();
            if (tid < 64) { const int rc = rec[tid], ek = rc & 255, rank = rc >> 8, pos = lbase[ek] + rank, pair = (pgrp * 16 + (tid >> 2)) * 4 + (tid & 3);
                list[(size_t)ek * CAP + pos] = pair; ploc[pair] = ek | (pos << 5); } }
        if (grp + (int)gridDim.x < T / 16) RT_LOAD(grp + (int)gridDim.x);
#pragma unroll
        for (int rr = 0; rr < 2; ++rr) {
            const int lr = 2 * wave + rr, t = grp * 16 + lr, b = t >> 13;
            u32x2* pr = (u32x2*)(xmid + (size_t)t * D) + lane;
            f32x4 v[4]; float s = 0.f;
#pragma unroll
            for (int j = 0; j < 4; ++j) { const u32x2 fw = fv_[rr][j]; const f32x4 ff = {bflo(fw.x), bfhi(fw.x), bflo(fw.y), bfhi(fw.y)};
                v[j] = xv_[rr][j] * ALPHA + ff; s += (v[j][0] + v[j][1]) + (v[j][2] + v[j][3]); }
            float mean = wave_sum(s) * (1.f / D), s2 = 0.f;
#pragma unroll
            for (int j = 0; j < 4; ++j) { v[j] = v[j] - mean; s2 += (v[j][0] * v[j][0] + v[j][1] * v[j][1]) + (v[j][2] * v[j][2] + v[j][3] * v[j][3]); }
            float rstd = 1.f / sqrtf(wave_sum(s2) * (1.f / D) + LN_EPS);
            s = 0.f;
#pragma unroll
            for (int j = 0; j < 4; ++j) { v[j] = v[j] * rstd * g1[64 * j + lane] + bb1[64 * j + lane]; u32x2 w; w.x = pk2(v[j][0], v[j][1]); w.y = pk2(v[j][2], v[j][3]); pr[64 * j] = w;
                v[j] = (f32x4){bflo(w.x), bfhi(w.x), bflo(w.y), bfhi(w.y)}; s += (v[j][0] + v[j][1]) + (v[j][2] + v[j][3]); }
            mean = wave_sum(s) * (1.f / D); s2 = 0.f;
#pragma unroll
            for (int j = 0; j < 4; ++j) { v[j] = v[j] - mean; s2 += (v[j][0] * v[j][0] + v[j][1] * v[j][1]) + (v[j][2] * v[j][2] + v[j][3] * v[j][3]); }
            rstd = 1.f / sqrtf(wave_sum(s2) * (1.f / D) + LN_EPS);
            const LAS f32x4* sh = shT + b * 256; const LAS f32x4* sc = scT + b * 256;
            unsigned* o4 = (unsigned*)((unsigned char*)H2 + (size_t)t * D) + lane;
#pragma unroll
            for (int j = 0; j < 4; ++j) { const f32x4 y = v[j] * rstd * (sc[64 * j + lane] + 1.f) + sh[64 * j + lane];
                o4[64 * j] = gm::pk4_fp8(y[0] * gm::S_H2, y[1] * gm::S_H2, y[2] * gm::S_H2, y[3] * gm::S_H2);
                *(LAS f32x4*)(h2s + lr * HS + 256 * j + 4 * lane) = y; }
        }
        __syncthreads();
        {
            f32x4 acc0 = {0.f, 0.f, 0.f, 0.f}, acc1 = {0.f, 0.f, 0.f, 0.f};
            const LAS float* ap = h2s + (lane & 15) * HS + 128 * wave + 8 * (lane >> 4);
#pragma unroll
            for (int s = 0; s < 4; ++s) { const f32x4 x0 = *(const LAS f32x4*)(ap + 32 * s), x1 = *(const LAS f32x4*)(ap + 32 * s + 4);
                bf16x8 ah, al;
#pragma unroll
                for (int i = 0; i < 8; ++i) { const float x = i < 4 ? x0[i] : x1[i - 4]; const unsigned hb = __float_as_uint(x) & 0xffff0000u; ah[i] = (short)(hb >> 16); al[i] = (short)f2bf(x - __uint_as_float(hb)); }
                acc0 = __builtin_amdgcn_mfma_f32_16x16x32_bf16(ah, rwh[s][0], acc0, 0, 0, 0); acc1 = __builtin_amdgcn_mfma_f32_16x16x32_bf16(ah, rwh[s][1], acc1, 0, 0, 0);
                acc0 = __builtin_amdgcn_mfma_f32_16x16x32_bf16(ah, rwl[s][0], acc0, 0, 0, 0); acc1 = __builtin_amdgcn_mfma_f32_16x16x32_bf16(ah, rwl[s][1], acc1, 0, 0, 0);
                acc0 = __builtin_amdgcn_mfma_f32_16x16x32_bf16(al, rwh[s][0], acc0, 0, 0, 0); acc1 = __builtin_amdgcn_mfma_f32_16x16x32_bf16(al, rwh[s][1], acc1, 0, 0, 0); }
#pragma unroll
            for (int r = 0; r < 4; ++r) { part[(wave * 16 + 4 * (lane >> 4) + r) * 32 + (lane & 15)] = acc0[r]; part[(wave * 16 + 4 * (lane >> 4) + r) * 32 + 16 + (lane & 15)] = acc1[r]; }
        }
        __syncthreads();
        {
            const int lr = 2 * wave + (lane >> 5), e = lane & 31, t = grp * 16 + lr;
            float lg = rbe;
#pragma unroll
            for (int w = 0; w < 8; ++w) lg += part[(w * 16 + lr) * 32 + e];
            float cur = lg, tv[4]; int ti[4];
#pragma unroll
            for (int k = 0; k < 4; ++k) { float bv = cur; int bi = e;
#pragma unroll
                for (int o = 1; o < 32; o <<= 1) { const float ov = __shfl_xor(bv, o); const int oi = __shfl_xor(bi, o); if (ov > bv || (ov == bv && oi < bi)) { bv = ov; bi = oi; } }
                tv[k] = bv; ti[k] = bi; if (bi == e) cur = -3.0e38f; }
            const float e1 = __expf(tv[1] - tv[0]), e2 = __expf(tv[2] - tv[0]), e3 = __expf(tv[3] - tv[0]);
            const float inv = 1.f / (1.f + e1 + e2 + e3);
            if (e < 4) { const float wk = (e == 0 ? 1.f : (e == 1 ? e1 : (e == 2 ? e2 : e3))) * inv; const int ek = (e == 0 ? ti[0] : (e == 1 ? ti[1] : (e == 2 ? ti[2] : ti[3])));
                const int pair = t * 4 + e;
                pw[pair] = wk;
                const int rank = __hip_atomic_fetch_add((LAS int*)&lcnt[ek], 1, __ATOMIC_RELAXED, __HIP_MEMORY_SCOPE_WORKGROUP);
                rec[lr * 4 + e] = ek | (rank << 8); }
        }
        __syncthreads();
        if (tid < 32) { const int n = lcnt[tid]; pend = n ? (int)atomicAdd(&cnt[tid], (unsigned)n) : 0; lcnt[tid] = 0; }
        pgrp = grp;
    }
    if (pgrp >= 0) { __syncthreads(); if (tid < 32) lbase[tid] = pend; __syncthreads();
        if (tid < 64) { const int rc = rec[tid], ek = rc & 255, rank = rc >> 8, pos = lbase[ek] + rank, pair = (pgrp * 16 + (tid >> 2)) * 4 + (tid & 3);
            list[(size_t)ek * CAP + pos] = pair; ploc[pair] = ek | (pos << 5); } }
#undef RT_LOAD
}
}

__device__ __forceinline__ void p_final(const Args& a, LAS unsigned char* lds) {
    const int tid = threadIdx.x, lane = tid & 63, wave = tid >> 6;
    const bf16_t* xm = (const bf16_t*)(a.ws + WS_PRE1); const unsigned char* slots = (const unsigned char*)(a.ws + WS_SLOTS); const float* mod = (const float*)(a.ws + WS_MOD);
    const int* ploc = (const int*)(a.ws + WS_PLOC); const float* pw = (const float*)(a.ws + WS_PW);
    const f32x4* g2 = (const f32x4*)a.in[I_LN2G]; const f32x4* b2 = (const f32x4*)a.in[I_LN2B];
    LAS int* tstart = (LAS int*)lds;
    __syncthreads();
    if (tid == 0) { const unsigned* cnt = (const unsigned*)(a.ws + WS_CNT); int nrt = 0; for (int e = 0; e < NE; ++e) { tstart[e] = 256 * nrt; nrt += ((int)cnt[e] + 255) >> 8; } }
    LAS f32x4* Lg2 = (LAS f32x4*)(lds + 1024); LAS f32x4* Lb2 = Lg2 + 256; LAS f32x4* Lgt = Lb2 + 256;
    if (tid < 256) { Lg2[tid] = g2[tid]; Lb2[tid] = b2[tid]; }
    for (int i = tid; i < 4 * 256; i += NTHREADS) Lgt[i] = ((const f32x4*)(mod + (i >> 8) * 6144 + 5 * 1024))[i & 255];
    __syncthreads();
    const int tstep = gridDim.x * NWAVES; int t = blockIdx.x * NWAVES + wave;
    if (t < T) {
        int plc[4], pln[4]; float wc_[4], wn_[4]; unsigned qc[4][4], qn[4][4]; u32x2 xc[4], xn[4];
#define PF_IDX(tt, pl, ww) do { _Pragma("unroll") for (int sl = 0; sl < 4; ++sl) { pl[sl] = ploc[(tt) * 4 + sl]; ww[sl] = pw[(tt) * 4 + sl] * (1.f / gm::S_SL); } } while (0)
#define PF_DATA(tt, pl, qq, xx) do { _Pragma("unroll") for (int sl = 0; sl < 4; ++sl) { const unsigned* sr_ = (const unsigned*)(slots + (size_t)(tstart[pl[sl] & 31] + (pl[sl] >> 5)) * D) + lane; \
            _Pragma("unroll") for (int j = 0; j < 4; ++j) qq[sl][j] = sr_[64 * j]; } \
        { const u32x2* xr_ = (const u32x2*)(xm + (size_t)(tt) * D) + lane; _Pragma("unroll") for (int j = 0; j < 4; ++j) xx[j] = xr_[64 * j]; } } while (0)
        PF_IDX(t, plc, wc_); PF_DATA(t, plc, qc, xc);
        int tn = t + tstep; const bool hn0 = tn < T;
        if (hn0) PF_IDX(tn, pln, wn_);
        for (;;) {
            const bool hn = tn < T;
            if (hn) PF_DATA(tn, pln, qn, xn);
            int pl2[4]; float w2[4]; const int tn2 = tn + tstep; const bool hn2 = hn && tn2 < T;
            if (hn2) PF_IDX(tn2, pl2, w2);
            {
                const int b = t >> 13; const LAS f32x4* gt = Lgt + b * 256;
                f32x4 v[4]; float s = 0.f;
#pragma unroll
                for (int j = 0; j < 4; ++j) { f32x4 y = {0.f, 0.f, 0.f, 0.f};
#pragma unroll
                    for (int sl = 0; sl < 4; ++sl) { const int q = (int)qc[sl][j];
                        y[0] += wc_[sl] * __builtin_amdgcn_cvt_f32_fp8(q, 0); y[1] += wc_[sl] * __builtin_amdgcn_cvt_f32_fp8(q, 1); y[2] += wc_[sl] * __builtin_amdgcn_cvt_f32_fp8(q, 2); y[3] += wc_[sl] * __builtin_amdgcn_cvt_f32_fp8(q, 3); }
                    const f32x4 xv = {bflo(xc[j].x), bfhi(xc[j].x), bflo(xc[j].y), bfhi(xc[j].y)};
                    v[j] = xv * ALPHA + gt[64 * j + lane] * y; s += (v[j][0] + v[j][1]) + (v[j][2] + v[j][3]); }
                const float mean = wave_sum(s) * (1.f / D); float s2 = 0.f;
#pragma unroll
                for (int j = 0; j < 4; ++j) { v[j] = v[j] - mean; s2 += (v[j][0] * v[j][0] + v[j][1] * v[j][1]) + (v[j][2] * v[j][2] + v[j][3] * v[j][3]); }
                const float rstd = 1.f / sqrtf(wave_sum(s2) * (1.f / D) + LN_EPS);
                f32x4* o = (f32x4*)(a.out + (size_t)t * D) + lane;
#pragma unroll
                for (int j = 0; j < 4; ++j) o[64 * j] = v[j] * rstd * Lg2[64 * j + lane] + Lb2[64 * j + lane];
            }
            if (!hn) break;
            t = tn; tn = tn2;
#pragma unroll
            for (int sl = 0; sl < 4; ++sl) { plc[sl] = pln[sl]; wc_[sl] = wn_[sl]; pln[sl] = pl2[sl]; wn_[sl] = w2[sl];
#pragma unroll
                for (int j = 0; j < 4; ++j) qc[sl][j] = qn[sl][j]; }
#pragma unroll
            for (int j = 0; j < 4; ++j) xc[j] = xn[j];
        }
#undef PF_IDX
#undef PF_DATA
    }
}


constexpr int N_PHASES = 11;
__global__ void __launch_bounds__(NTHREADS, 2) mega_fwd(Args a) {
    extern __shared__ __attribute__((aligned(16))) unsigned char lds_raw[];
    LAS unsigned char* lds = (LAS unsigned char*)lds_raw;
    const int tid = threadIdx.x;
    volatile LAS unsigned* misc = (volatile LAS unsigned*)(lds + LDS_MISC);
    if (tid < 4) misc[tid] = 0u;
    __syncthreads();
    XcdBarrier bar; bar.bar = (unsigned*)(a.ws + WS_BAR); bar.x = 0; bar.st = misc;
    const bool multi = (a.ph_hi - a.ph_lo) > 1;
    if (multi) bar = xcd_barrier_post((unsigned*)(a.ws + WS_BAR), misc);
    const int lo = a.ph_lo, hi = a.ph_hi;
#define vcu ((gridDim.x % 8 == 0) ? (int)((blockIdx.x % 8) * (gridDim.x / 8) + blockIdx.x / 8) : (int)blockIdx.x)
#ifdef ONLY_PHASE
#define IN(k) ((k) == ONLY_PHASE && lo <= (k) && (k) < hi)
#else
#define IN(k) (lo <= (k) && (k) < hi)
#endif
#define SEAM(k) do { if (IN(k) && IN((k) + 1)) xcd_barrier(bar); } while (0)

#ifndef REPEAT_PHASE
#define REPEAT_PHASE -1
#endif
#ifdef PROF_REP
#define RUNPH(k, ...) do { if (IN(k)) { const int nrep_ = (a.rep_k == (k)) ? 2 : 1; for (int rep_ = 0; rep_ < nrep_; ++rep_) { if (rep_) xcd_barrier(bar); __VA_ARGS__; } } } while (0)
#else
#define RUNPH(k, ...) do { if (IN(k)) { __VA_ARGS__; if (REPEAT_PHASE == (k)) { xcd_barrier(bar); __VA_ARGS__; } } } while (0)
#endif
    RUNPH(0, p0_mod_and_filter(a, lds));
    SEAM(0);
    RUNPH(1, p1_prep(a, lds));
    SEAM(1);
    RUNPH(2, { gm::SchedIn S{a.ws, (int)gridDim.x, vcu, a.in[I_BAF], a.in[I_BAB]}; gm::EpiIn E{a.ws}; gm::gemm_stream<false, 0, false>(lds, S, E);
        {
          const int G = (int)gridDim.x, rounds = (1812 + G - 1) / G, extra = 1812 - (rounds - 1) * G, v = vcu;
          if (v >= extra || extra == G) { const int nidle = (extra == G) ? G : G - extra, ridle = (extra == G) ? v : v - extra; __syncthreads();
              prep_items(a, (LAS float*)(lds + (tid >> 6) * 16384), PREP_NITEMS - PREP_DEFER, PREP_NITEMS, ridle * NWAVES + (tid >> 6), nidle * NWAVES, tid & 63); } } });
    SEAM(2);
    RUNPH(3, { for (int u = blockIdx.x; u < 16 * NCT; u += gridDim.x) gla::g1_unit(a, lds, u / NCT, u % NCT); });
    SEAM(3);
    RUNPH(4, { gla::g2_scan(a, lds);
        hy::CvState cvs; cvs.jb.mi = -1; cvs.next = (int)blockIdx.x * NWAVES + (tid >> 6); cvs.stride = (int)gridDim.x * NWAVES; cvs.end = hy::CV_ITEMS;
        for (int c = blockIdx.x; c < HYW; c += gridDim.x) hy::channel(a, lds, c, a.ws + WS_HSPEC + (size_t)blockIdx.x * HSPEC_PER_WG, cvs);
        while (cvs.jb.mi >= 0 || cvs.next < cvs.end) hy::cv_step(a, cvs, tid & 63); });
    SEAM(4);
    RUNPH(5, { { int u = blockIdx.x; gla::G3In cur, nxt;
            if (u < 16 * NCHUNK) { gla::g3_load(a, u >> 7, u & 127, cur);
                for (;;) { const int un = u + (int)gridDim.x; const bool hn = un < 16 * NCHUNK; if (hn) gla::g3_load(a, un >> 7, un & 127, nxt);
                    gla::g3_unit(a, lds, u >> 7, u & 127, cur); if (!hn) break; cur = nxt; u = un; } } }
        const int wave = tid >> 6;
        for (int it = blockIdx.x * NWAVES + wave; it < 4096; it += gridDim.x * NWAVES) hy::transpose_item(a, it, tid & 63); });
    SEAM(5);
    RUNPH(6, { gm::SchedOut S{a.ws, (int)gridDim.x, vcu}; gm::EpiOut E{a.ws}; gm::gemm_stream<false, 0, false>(lds, S, E); });
    SEAM(6);
    RUNPH(7, rt::phase(a, lds));
    SEAM(7);
    if (IN(8) || IN(9)) {
        LAS int* tab = (LAS int*)(lds + gm::LDS_TAB);
        __syncthreads();
        if (tid == 0) { const unsigned* cnt = (const unsigned*)(a.ws + WS_CNT); int nrt = 0;
            for (int e = 0; e < NE; ++e) { const int n = (int)cnt[e]; tab[e] = n; const int nt = (n + 255) >> 8; for (int k = 0; k < nt; ++k) tab[64 + nrt + k] = e | (k << 8); nrt += nt; }
            tab[32] = nrt; }
        __syncthreads();
    }
    RUNPH(8, { gm::SchedMoe<1> S{a.ws, (const LAS int*)(lds + gm::LDS_TAB), (int)gridDim.x, vcu, a.in[I_EB2]}; gm::EpiMoe1 E{a.ws}; gm::gemm_stream<true, 2, true>(lds, S, E); });
    SEAM(8);
    RUNPH(9, { gm::SchedMoe<2> S{a.ws, (const LAS int*)(lds + gm::LDS_TAB), (int)gridDim.x, vcu, a.in[I_EB2]}; gm::EpiMoe2 E{a.ws}; gm::gemm_stream<false, 0, true>(lds, S, E); });
    SEAM(9);
    RUNPH(10, p_final(a, lds));
#undef RUNPH
#undef vcu
#undef IN
#undef SEAM
}

extern "C" void kernel_launch(void* const* d_in, const int* in_sizes, int n_in, void* d_out, int out_size, void* d_ws, size_t ws_size, hipStream_t stream) {
    static int grid = 0;
    if (grid == 0) {
        if (n_in != 32 || out_size != T * D || ws_size < WS_END) { fprintf(stderr, "kernel_launch: unexpected shapes (n_in %d out %d ws %zu need %zu)\n", n_in, out_size, ws_size, (size_t)WS_END); grid = -1; return; }
        int dev = 0, cus = 0;
        if (hipGetDevice(&dev) != hipSuccess || hipDeviceGetAttribute(&cus, hipDeviceAttributeMultiprocessorCount, dev) != hipSuccess) { grid = -1; return; }
        if (hipFuncSetAttribute((const void*)mega_fwd, hipFuncAttributeMaxDynamicSharedMemorySize, LDS_BYTES) != hipSuccess) { fprintf(stderr, "kernel_launch: hipFuncSetAttribute failed\n"); grid = -1; return; }
        int per_cu = 0;
        if (hipOccupancyMaxActiveBlocksPerMultiprocessor(&per_cu, (const void*)mega_fwd, NTHREADS, LDS_BYTES) != hipSuccess || per_cu < 1) fprintf(stderr, "kernel_launch: occupancy query says %d\n", per_cu);
        (void)hipGetLastError();
        grid = cus;
        if (grid > MAX_GRID) grid = MAX_GRID;
    }
    if (grid < 0) return;
    (void)hipMemsetAsync(d_ws, 0, WS_ZERO_BYTES, stream);
    Args a{};
    for (int i = 0; i < 32; ++i) a.in[i] = (const float*)d_in[i];
    a.out = (float*)d_out; a.ws = (unsigned char*)d_ws;
#ifdef DBG
    (void)hipMemsetAsync((char*)d_ws + WS_DBG, 0, 512, stream);
    for (int p = 0; p < N_PHASES; ++p) { a.ph_lo = p; a.ph_hi = p + 1; hipLaunchKernelGGL(mega_fwd, dim3(grid), dim3(NTHREADS), LDS_BYTES, stream, a);
        hipLaunchKernelGGL(dbg_check, dim3(64), dim3(512), 0, stream, a, p); }
    hipLaunchKernelGGL(dbg_encode, dim3(1024), dim3(256), 0, stream, a);
#elif N_LAUNCH_PER_PHASE
    for (int p = 0; p < N_PHASES; ++p) { a.ph_lo = p; a.ph_hi = p + 1; hipLaunchKernelGGL(mega_fwd, dim3(grid), dim3(NTHREADS), LDS_BYTES, stream, a); }
#else
    a.ph_lo = 0; a.ph_hi = N_PHASES;
#ifdef PROF_REP
    a.rep_k = PROF_REP;
#endif
    hipLaunchKernelGGL(mega_fwd, dim3(grid), dim3(NTHREADS), LDS_BYTES, stream, a);
#endif
}
```

```cpp
#include <hip/hip_runtime.h>
#include <cstdio>
#include <cstdint>
#include <cstddef>

#define LAS __attribute__((address_space(3)))
#define GAS __attribute__((address_space(1)))
typedef unsigned short bf16_t;
typedef short bf16x8 __attribute__((ext_vector_type(8)));
typedef float f32x4 __attribute__((ext_vector_type(4)));
typedef float f32x2 __attribute__((ext_vector_type(2)));
typedef unsigned u32x4 __attribute__((ext_vector_type(4)));
typedef unsigned u32x2 __attribute__((ext_vector_type(2)));

#ifndef N_LAUNCH_PER_PHASE
#define N_LAUNCH_PER_PHASE 0
#endif

constexpr int D = 1024, NB = 4, SEQ = 8192, T = NB * SEQ, CTXL = 256, TC = NB * CTXL, TT = T + TC;
constexpr int NH = 4, DK = 64, DV = 128, CH = 64, NCHUNK = SEQ / CH, NCC = CTXL / CH, NCT = NCHUNK + NCC;
constexpr int HYW = 512, HYC = 3 * HYW, INW = 3104;
constexpr int NE = 32, DE = 1024, CAP = T;
constexpr float LN_EPS = 1e-6f, ALPHA = 1.189207115002721f;
constexpr int NTHREADS = 512, NWAVES = 8;
constexpr int FFTN = 16384;

constexpr size_t al256(size_t x) { return (x + 255) & ~(size_t)255; }
constexpr size_t WS_BAR   = 0;
constexpr size_t WS_MOD   = 16384;
constexpr size_t WS_CNT   = WS_MOD + 5 * 6144 * 4;
constexpr size_t WS_ZERO_BYTES = al256(WS_CNT + 256);
constexpr size_t WS_LIST  = 262144;
constexpr size_t WS_PW    = WS_LIST + (size_t)NE * CAP * 4;
constexpr size_t WS_PLOC  = WS_PW + (size_t)T * 4 * 4;
constexpr size_t WS_B1R   = WS_PLOC + (size_t)T * 4 * 4;
constexpr size_t WS_HID2  = WS_B1R + (size_t)NE * 2048 * 4;
constexpr size_t WS_BTIN  = WS_HID2 + (size_t)SEQ * 64 * 4;
constexpr size_t WS_BTOUT = WS_BTIN + (size_t)3584 * 1024 * 2;
constexpr size_t WS_W1T   = WS_BTOUT + (size_t)1024 * 1024 * 2;
constexpr size_t WS_W2T   = WS_W1T + (size_t)NE * 2048 * 1024 * 2;
constexpr size_t WS_PRE1  = WS_W2T + (size_t)NE * 1024 * 1024 * 2;
constexpr size_t WS_RA    = WS_PRE1 + (size_t)T * 1024 * 4;
constexpr size_t WS_H     = WS_RA;
constexpr size_t WS_Q     = WS_H + (size_t)TT * 1024 * 2;
constexpr size_t WS_K     = WS_Q + (size_t)T * 256 * 2;
constexpr size_t WS_V     = WS_K + (size_t)TT * 256 * 2;
constexpr size_t WS_G     = WS_V + (size_t)TT * 512 * 2;
constexpr size_t WS_GF    = WS_G + (size_t)T * 512 * 2;
constexpr size_t WS_GB    = WS_GF + (size_t)TT * 256 * 4;
constexpr size_t WS_UT    = WS_GB + (size_t)TT * 256 * 4;
constexpr size_t WS_RA_END= WS_UT + (size_t)NB * HYC * SEQ * 2;
constexpr size_t WS_H2    = WS_RA;
constexpr size_t WS_FG    = WS_RA + (size_t)T * 1024 * 2;
constexpr size_t WS_SLOTS = WS_RA;
constexpr size_t SORTED_BYTES_ = (size_t)(T * 4 / 256 + NE) * 256 * 1024 * 2;
constexpr size_t WS_RB    = al256(WS_RA_END > WS_RA + SORTED_BYTES_ ? WS_RA_END : WS_RA + SORTED_BYTES_);
constexpr size_t WS_KV    = WS_RB;
constexpr size_t WS_AV    = WS_KV + (size_t)2 * 16 * NCT * 8192 * 2;
constexpr size_t WS_SP    = WS_AV + (size_t)2 * 16 * NCT * 64 * 4;
constexpr size_t WS_HSPEC = WS_SP + (size_t)2 * 16 * NCHUNK * 8192 * 2;
constexpr size_t HSPEC_PER_WG = (size_t)2 * FFTN * 8;
constexpr int MAX_GRID = 256;
constexpr size_t WS_YHYT  = WS_HSPEC + (size_t)MAX_GRID * HSPEC_PER_WG;
constexpr size_t WS_MIX   = WS_YHYT + (size_t)NB * HYW * SEQ * 2;
constexpr size_t WS_RB_END= WS_MIX + (size_t)T * 1024 * 2;
constexpr size_t WS_HF    = WS_MIX;
constexpr size_t WS_ACT   = WS_RB;
constexpr size_t SORTED_BYTES = (size_t)(T * 4 / 256 + NE) * 256 * 1024 * 2;
constexpr size_t WS_END   = al256(WS_RB_END > WS_RB + SORTED_BYTES ? WS_RB_END : WS_RB + SORTED_BYTES);

constexpr int LDS_BYTES = 147456;
constexpr int LDS_MISC  = 145408;

typedef __bf16 bf16n2 __attribute__((ext_vector_type(2)));
__device__ __forceinline__ unsigned pk2(float lo, float hi) { bf16n2 v = {(__bf16)lo, (__bf16)hi}; return __builtin_bit_cast(unsigned, v); }
__device__ __forceinline__ bf16_t f2bf(float f) { __bf16 b = (__bf16)f; return __builtin_bit_cast(unsigned short, b); }
__device__ __forceinline__ float bf2f(bf16_t b) { return __uint_as_float(((unsigned)b) << 16); }
__device__ __forceinline__ float bflo(unsigned w) { return __uint_as_float(w << 16); }
__device__ __forceinline__ float bfhi(unsigned w) { return __uint_as_float(w & 0xffff0000u); }
__device__ __forceinline__ float wave_sum(float v) {
#pragma unroll
    for (int o = 1; o < 64; o <<= 1) v += __shfl_xor(v, o);
    return v;
}
__device__ __forceinline__ float silu_f(float x) { return x * __builtin_amdgcn_rcpf(1.f + __expf(-x)); }
__device__ __forceinline__ float log_sigmoid_f(float z) { return fminf(z, 0.f) - __logf(1.f + __expf(-fabsf(z))); }

#define XB_TMO      128
#define XB_XCNT(j)  (256  + 64 * (j))
#define XB_XSUB(j)  (1280 + 64 * (j))
#define XB_XGEN(j)  (2304 + 64 * (j))
#define XB_TOP      3328
#define XB_TOPGEN   3392
#define XCD_BAR_WORDS 3456
#define XB_SPIN_CAP (1u << 22)
__device__ __forceinline__ unsigned xb_ld(unsigned* p)              { return __hip_atomic_load(p, __ATOMIC_RELAXED, __HIP_MEMORY_SCOPE_AGENT); }
__device__ __forceinline__ unsigned xb_add(unsigned* p, unsigned v) { return __hip_atomic_fetch_add(p, v, __ATOMIC_RELAXED, __HIP_MEMORY_SCOPE_AGENT); }
__device__ __forceinline__ unsigned xb_xcc_id() { return (unsigned)__builtin_amdgcn_s_getreg((3 << 11) | 20) & 0xFu; }
#define XB_SPIN(cond, bar) do { unsigned _sp = 0; while (cond) { __builtin_amdgcn_s_sleep(1); \
    if ((++_sp & 255u) == 0u) { if (xb_ld(&(bar)[XB_TMO])) break; if (_sp > XB_SPIN_CAP) { atomicAdd(&(bar)[XB_TMO], 1u); break; } } } } while (0)
struct XcdBarrier { unsigned* bar; unsigned x; volatile LAS unsigned* st; };
__device__ __forceinline__ XcdBarrier xcd_barrier_post(unsigned* bar, volatile LAS unsigned* st) {
    XcdBarrier b; b.bar = bar; b.x = xb_xcc_id(); b.st = st;
    if (threadIdx.x == 0) (void)xb_add(&bar[XB_XCNT(b.x)], 1u);
    return b;
}
__device__ __forceinline__ void xcd_barrier_complete(unsigned* bar, unsigned x, unsigned& nloc, unsigned& nx) {
    const unsigned G = gridDim.x * gridDim.y * gridDim.z;
    unsigned sum, cnt, mine, sp = 0u;
    for (;;) {
        sum = 0u; cnt = 0u; mine = 0u;
#pragma unroll
        for (unsigned j = 0; j < 16; ++j) { const unsigned c = xb_ld(&bar[XB_XCNT(j)]); sum += c; cnt += (c > 0u) ? 1u : 0u; mine = (j == x) ? c : mine; }
        if (sum == G) break;
        __builtin_amdgcn_s_sleep(1);
        if ((++sp & 255u) == 0u) { if (xb_ld(&bar[XB_TMO])) break; if (sp > XB_SPIN_CAP) { atomicAdd(&bar[XB_TMO], 1u); break; } }
    }
    nloc = mine > 0u ? mine : 1u; nx = cnt > 0u ? cnt : 1u;
}
__device__ __forceinline__ void xcd_barrier(const XcdBarrier& b) {
    asm volatile("s_waitcnt vmcnt(0)" ::: "memory");
    __syncthreads();
    if (threadIdx.x == 0) {
        unsigned* bar = b.bar;
        __builtin_amdgcn_s_waitcnt(0);
        unsigned nloc = b.st[0], nx = b.st[1];
        if (nloc == 0u) { xcd_barrier_complete(bar, b.x, nloc, nx); b.st[0] = nloc; b.st[1] = nx; }
        const unsigned old = xb_add(&bar[XB_XSUB(b.x)], 1u);
        const unsigned gen = old / nloc;
        if (old + 1u == (gen + 1u) * nloc) {
            __builtin_amdgcn_fence(__ATOMIC_RELEASE, "agent");
            asm volatile("s_waitcnt vmcnt(0)" ::: "memory");
            const unsigned og = xb_add(&bar[XB_TOP], 1u);
            const unsigned tg = og / nx;
            if (og + 1u == (tg + 1u) * nx) xb_add(&bar[XB_TOPGEN], 1u);
            else XB_SPIN(xb_ld(&bar[XB_TOPGEN]) == tg, bar);
            __builtin_amdgcn_fence(__ATOMIC_ACQUIRE, "agent");
            xb_add(&bar[XB_XGEN(b.x)], 1u);
            asm volatile("s_waitcnt vmcnt(0)" ::: "memory");
        } else {
            XB_SPIN(xb_ld(&bar[XB_XGEN(b.x)]) == gen, bar);
            __builtin_amdgcn_fence(__ATOMIC_ACQUIRE, "agent");
            asm volatile("s_waitcnt vmcnt(0)" ::: "memory");
        }
    }
    __syncthreads();
}

struct Args {
    const float* in[32];
    float* out;
    unsigned char* ws;
    int ph_lo, ph_hi;
    int rep_k, pad_;
};
enum { I_X = 0, I_C, I_CTX, I_CCTX, I_ADAW, I_ADAB, I_WIN, I_WAF, I_BAF, I_WAB, I_BAB, I_NORMG, I_CONVW, I_CONVB, I_FW1, I_FB1, I_FW2, I_FB2, I_FWOUT, I_FFREQ,
       I_BIASD, I_WOUT, I_LN1G, I_LN1B, I_RW, I_RB, I_EW1, I_EB1, I_EW2, I_EB2, I_LN2G, I_LN2B };


namespace gm {
constexpr int BM = 256, BK = 64, HALF = 128, HTB = HALF * BK * 2, STAGE_BYTES = 8 * HTB, KD = 1024, NT = KD / BK;
constexpr int ROWB = KD * 2;
typedef int i32x8 __attribute__((ext_vector_type(8)));
__device__ __forceinline__ int gray2(int q) { return q ^ (q >> 1); }
__device__ __forceinline__ int lds_off8(int r, int fq) { const int rr = r & 15; return ((r >> 4) * 2 + (fq >> 1)) * 1024 + rr * 64 + 16 * ((2 * (fq & 1)) ^ gray2(rr >> 2)); }
__device__ __forceinline__ void stage_rc8(int b, int& R, int& C) { const int st = b / 1024, sb = b % 1024, swz = sb ^ (gray2((sb >> 8) & 3) << 4); R = (st >> 1) * 16 + swz / 64; C = (st & 1) * 32 + (swz % 64) / 2; }
__device__ __forceinline__ int lds_byte(int r, int c) { const int st = (r >> 4) * 2 + (c >> 5), rr = r & 15, cc = c & 31, ob = rr * 64 + cc * 2; return st * 1024 + (ob ^ (((ob >> 9) & 1) << 5)); }
__device__ __forceinline__ void stage_rc(int b, int& R, int& C) { const int st = b / 1024, sb = b % 1024, swz = sb ^ (((sb >> 9) & 1) << 5); R = (st >> 1) * 16 + swz / 64; C = (st & 1) * 32 + (swz % 64) / 2; }
__device__ __forceinline__ int perm32(int rho) { const int n = rho >> 4, i = rho & 15; return 8 * (i >> 2) + 4 * n + (i & 3); }

constexpr int LDS_BIAS = STAGE_BYTES + 4096;
struct Unit {
    const char* A;
    const char* B;
    const int* list;
    int type, row0, col0, valid, aux;
};

__device__ __forceinline__ i32x8 cat8(bf16x8 lo, bf16x8 hi) { typedef int i32x4 __attribute__((ext_vector_type(4))); const i32x4 a = __builtin_bit_cast(i32x4, lo), b = __builtin_bit_cast(i32x4, hi); return (i32x8){a[0], a[1], a[2], a[3], b[0], b[1], b[2], b[3]}; }
template <bool GATHER, int GSHIFT, int RB, bool FP8>
__device__ __forceinline__ void a_offsets(const Unit& u, unsigned (&o)[2][2]) {
    int R[2], Cb[2];
    int tz = threadIdx.x; asm volatile("" : "+v"(tz));
#pragma unroll
    for (int i = 0; i < 2; ++i) { int r, c; if (FP8) stage_rc8(tz * 16 + i * 8192, r, c); else stage_rc(tz * 16 + i * 8192, r, c); R[i] = r; Cb[i] = c * 2; }
#pragma unroll
    for (int h = 0; h < 2; ++h)
#pragma unroll
        for (int i = 0; i < 2; ++i) {
            const int r = h * HALF + R[i];
            if (!GATHER) o[h][i] = (unsigned)(r * RB + Cb[i]);
            else { const int idx = u.list[r < u.valid ? r : 0]; o[h][i] = (unsigned)(idx >> GSHIFT) * (unsigned)RB + (unsigned)Cb[i]; }
        }
}

template <bool GATHER, int GSHIFT, bool FP8, class Sched, class Epi>
__device__ __forceinline__ void gemm_stream(LAS unsigned char* lds, const Sched& S, const Epi& E) {
    constexpr int RB = FP8 ? KD : ROWB, NTL = FP8 ? NT / 2 : NT;
    const int tid = threadIdx.x, wid = __builtin_amdgcn_readfirstlane(tid >> 6), lane = tid & 63, wr = wid >> 2, wc = wid & 3, fr = lane & 15, fq = lane >> 4;
    unsigned voffB[2], voffA[2];
#pragma unroll
    for (int i = 0; i < 2; ++i) { int r, c; if (FP8) stage_rc8(tid * 16 + i * 8192, r, c); else stage_rc(tid * 16 + i * 8192, r, c); const int rb = (r & ~31) + perm32(r & 31); voffB[i] = (unsigned)(rb * RB + c * 2); voffA[i] = (unsigned)(r * RB + c * 2); }
    const size_t kstep = (size_t)(BK * 2), hstep = (size_t)HALF * RB;
    const unsigned ldsw = (unsigned)wid * 1024u;
    const int aoff = FP8 ? lds_off8(wr * 64 + fr, fq) : lds_byte(wr * 64 + fr, fq * 8), boff = FP8 ? lds_off8(wc * 32 + fr, fq) : lds_byte(wc * 32 + fr, fq * 8);
    const int aoffh = aoff ^ 16, boffh = boff ^ 16;
#define GM_SA(b, h) (((b) * 2 + (h)) * HTB)
#define GM_SB(b, h) ((4 + (b) * 2 + (h)) * HTB)
#define GM_STAGE(bufoff, gbase, vo0, vo1) do { \
        __builtin_amdgcn_global_load_lds((const unsigned*)((const char*)(gbase) + (vo0)), (LAS unsigned*)(lds + (bufoff) + ldsw), 16, 0, 0); \
        __builtin_amdgcn_global_load_lds((const unsigned*)((const char*)(gbase) + (vo1)), (LAS unsigned*)(lds + (bufoff) + ldsw + 8192), 16, 0, 0); } while (0)
#define GM_STAGE_A(bufoff, gbase, h, o0, o1) do { if constexpr (GATHER) GM_STAGE(bufoff, gbase, o0, o1); else GM_STAGE(bufoff, (gbase) + (h) * hstep, voffA[0], voffA[1]); } while (0)
#define GM_LD32(p, ol, oh) ({ const i32x4 lo_ = *(const LAS i32x4*)((p) + (ol)), hi_ = *(const LAS i32x4*)((p) + (oh)); (i32x8){lo_[0], lo_[1], lo_[2], lo_[3], hi_[0], hi_[1], hi_[2], hi_[3]}; })
#define GM_LDA(dst, b, h) do { if constexpr (FP8) { _Pragma("unroll") for (int m = 0; m < 4; ++m) dst##8[m] = GM_LD32(lds + GM_SA(b, h) + m * 2048, aoff, aoffh); } \
        else { _Pragma("unroll") for (int m = 0; m < 4; ++m) _Pragma("unroll") for (int k = 0; k < 2; ++k) dst[m][k] = *(const LAS bf16x8*)(lds + GM_SA(b, h) + aoff + m * 2048 + k * 1024); } } while (0)
#define GM_LDB(dst, b, h) do { if constexpr (FP8) { _Pragma("unroll") for (int n = 0; n < 2; ++n) dst##8[n] = GM_LD32(lds + GM_SB(b, h) + n * 2048, boff, boffh); } \
        else { _Pragma("unroll") for (int n = 0; n < 2; ++n) _Pragma("unroll") for (int k = 0; k < 2; ++k) dst[n][k] = *(const LAS bf16x8*)(lds + GM_SB(b, h) + boff + n * 2048 + k * 1024); } } while (0)
#define GM_MMA(ai, bj, At, Bt) do { __builtin_amdgcn_s_setprio(1); _Pragma("unroll") for (int m = 0; m < 4; ++m) _Pragma("unroll") for (int n = 0; n < 2; ++n) { \
        if constexpr (FP8) asm volatile("v_mfma_scale_f32_16x16x128_f8f6f4 %0, %1, %2, %0, %3, %3 op_sel_hi:[0,0,0]" : "+v"(acc[ai][bj][m][n]) : "v"(Bt##8[n]), "v"(At##8[m]), "v"(sc1_)); \
        else { _Pragma("unroll") for (int k = 0; k < 2; ++k) acc[ai][bj][m][n] = __builtin_amdgcn_mfma_f32_16x16x32_bf16(Bt[n][k], At[m][k], acc[ai][bj][m][n], 0, 0, 0); } } \
        __builtin_amdgcn_s_setprio(0); } while (0)
#define GM_WAIT_V(n) asm volatile("s_waitcnt vmcnt(" #n ")" ::: "memory")
#define GM_WAIT_L(n) asm volatile("s_waitcnt lgkmcnt(" #n ")" ::: "memory")
#define GM_BAR __builtin_amdgcn_s_barrier()
#define GM_SCHED __builtin_amdgcn_sched_barrier(0)
    Unit cur, nxt; int ui = 0;
    if (!S.next(0, cur)) return;
    f32x4 acc[2][2][4][2];
#pragma unroll
    for (int a = 0; a < 2; ++a)
#pragma unroll
        for (int b = 0; b < 2; ++b)
#pragma unroll
            for (int m = 0; m < 4; ++m)
#pragma unroll
                for (int n = 0; n < 2; ++n) acc[a][b][m][n] = (f32x4){0.f, 0.f, 0.f, 0.f};
    typedef int i32x4 __attribute__((ext_vector_type(4)));
    int sc1_ = 0x7f7f7f7f; asm volatile("" : "+v"(sc1_));
    bf16x8 At[4][2], B0[2][2], B1[2][2];
    i32x8 At8[4], B08[2], B18[2];
    unsigned ca[2][2], na[2][2];
    if constexpr (GATHER) a_offsets<GATHER, GSHIFT, RB, FP8>(cur, ca);
    const char* cA = cur.A; const char* cB = cur.B;
    GM_STAGE(GM_SB(0, 0), cB, voffB[0], voffB[1]); GM_STAGE_A(GM_SA(0, 0), cA, 0, ca[0][0], ca[0][1]); GM_STAGE(GM_SB(0, 1), cB + hstep, voffB[0], voffB[1]); GM_STAGE_A(GM_SA(0, 1), cA, 1, ca[1][0], ca[1][1]);
    if (wr == 1) GM_BAR;
    GM_WAIT_V(4); GM_BAR;
    GM_STAGE(GM_SB(1, 0), cB + kstep, voffB[0], voffB[1]); GM_STAGE_A(GM_SA(1, 0), cA + kstep, 0, ca[0][0], ca[0][1]); GM_STAGE(GM_SB(1, 1), cB + hstep + kstep, voffB[0], voffB[1]);
    GM_WAIT_V(6); GM_BAR;
    for (;;) {
        const bool has_next = S.next(ui + 1, nxt);
        if constexpr (GATHER) {
            if (has_next) a_offsets<GATHER, GSHIFT, RB, FP8>(nxt, na);
            else {
#pragma unroll
                for (int h = 0; h < 2; ++h)
#pragma unroll
                    for (int i = 0; i < 2; ++i) na[h][i] = ca[h][i];
            }
        }
        const char* nA = has_next ? nxt.A : cA; const char* nB = has_next ? nxt.B : cB;
        if (wid == 0)
            __builtin_amdgcn_global_load_lds((const unsigned*)(S.bias(cur) + 4 * lane), (LAS unsigned*)(lds + LDS_BIAS + (ui & 1) * 1024), 16, 0, 0);
        for (int t = 0; t < NTL; t += 2) {
            const bool last = (t == NTL - 2);

            const char* a1 = cA + (size_t)(t + 1) * kstep;
            const char* a2 = last ? nA : cA + (size_t)(t + 2) * kstep; const char* b2 = last ? nB : cB + (size_t)(t + 2) * kstep;
            const char* a3 = a2 + kstep; const char* b3 = b2 + kstep;
            unsigned x00 = 0, x01 = 0, x10 = 0, x11 = 0;
            if constexpr (GATHER) { x00 = last ? na[0][0] : ca[0][0]; x01 = last ? na[0][1] : ca[0][1]; x10 = last ? na[1][0] : ca[1][0]; x11 = last ? na[1][1] : ca[1][1]; }
            GM_LDB(B0, 0, 0); GM_SCHED; GM_LDA(At, 0, 0); GM_STAGE_A(GM_SA(1, 1), a1, 1, ca[1][0], ca[1][1]);
            GM_WAIT_L(8); GM_BAR; GM_WAIT_L(0); GM_MMA(0, 0, At, B0); GM_BAR; GM_SCHED;
            GM_LDB(B1, 0, 1); GM_STAGE(GM_SB(0, 0), b2, voffB[0], voffB[1]);
            GM_BAR; GM_WAIT_L(0); GM_MMA(0, 1, At, B1); GM_BAR;
            GM_LDA(At, 0, 1); GM_STAGE_A(GM_SA(0, 0), a2, 0, x00, x01);
            GM_BAR; GM_WAIT_L(0); GM_MMA(1, 0, At, B0); GM_BAR; GM_SCHED;
            GM_STAGE(GM_SB(0, 1), b2 + hstep, voffB[0], voffB[1]);
            GM_WAIT_V(6); GM_BAR; GM_MMA(1, 1, At, B1); GM_BAR;
            GM_LDB(B0, 1, 0); GM_SCHED; GM_LDA(At, 1, 0); GM_STAGE_A(GM_SA(0, 1), a2, 1, x10, x11);
            GM_WAIT_L(8); GM_BAR; GM_WAIT_L(0); GM_MMA(0, 0, At, B0); GM_BAR; GM_SCHED;
            GM_LDB(B1, 1, 1); GM_STAGE(GM_SB(1, 0), b3, voffB[0], voffB[1]);
            GM_BAR; GM_WAIT_L(0); GM_MMA(0, 1, At, B1); GM_BAR;
            GM_LDA(At, 1, 1); GM_STAGE_A(GM_SA(1, 0), a3, 0, x00, x01);
            GM_BAR; GM_WAIT_L(0); GM_MMA(1, 0, At, B0); GM_BAR; GM_SCHED;
            GM_STAGE(GM_SB(1, 1), b3 + hstep, voffB[0], voffB[1]);
            GM_WAIT_V(6); GM_BAR; GM_MMA(1, 1, At, B1); GM_BAR;
        }
        if constexpr (FP8) asm volatile("s_nop 7\n\ts_nop 7" ::: "memory");
        {
          int tz = threadIdx.x; asm volatile("" : "+v"(tz)); const int wz = tz >> 6, lz = tz & 63;
          E(acc, cur, wz >> 2, wz & 3, lz & 15, lz >> 4, (const LAS float*)(lds + LDS_BIAS + (ui & 1) * 1024)); }
        if (!has_next) break;
#pragma unroll
        for (int a = 0; a < 2; ++a)
#pragma unroll
            for (int b = 0; b < 2; ++b)
#pragma unroll
                for (int m = 0; m < 4; ++m)
#pragma unroll
                    for (int n = 0; n < 2; ++n) acc[a][b][m][n] = (f32x4){0.f, 0.f, 0.f, 0.f};
        cur = nxt; cA = nA; cB = nB; ++ui;
        if constexpr (GATHER) {
#pragma unroll
            for (int h = 0; h < 2; ++h)
#pragma unroll
                for (int i = 0; i < 2; ++i) ca[h][i] = na[h][i];
        }
    }
    GM_WAIT_V(0);
    if (wr == 0) GM_BAR;
    GM_BAR;
#undef GM_SA
#undef GM_SB
#undef GM_STAGE
#undef GM_STAGE_A
#undef GM_LD32
#undef GM_LDA
#undef GM_LDB
#undef GM_MMA
#undef GM_WAIT_V
#undef GM_WAIT_L
#undef GM_BAR
#undef GM_SCHED
}

__device__ __forceinline__ u32x4 pack8(f32x4 a, f32x4 b) { u32x4 w; w.x = pk2(a[0], a[1]); w.y = pk2(a[2], a[3]); w.z = pk2(b[0], b[1]); w.w = pk2(b[2], b[3]); return w; }

struct SchedIn {
    unsigned char* ws; int G, c; const float* baf; const float* bab;
    __device__ __forceinline__ bool next(int i, Unit& u) const {
        int L = i * G + c;
        u.list = nullptr; u.valid = 256; u.aux = 0;
        if (L < 768) {
            const int pa = L % 6, pb = L / 6;
            u.A = (const char*)(ws + WS_BTIN) + (size_t)(2048 + 256 * pa) * ROWB; u.B = (const char*)(ws + WS_H) + (size_t)(256 * pb) * ROWB;
            u.type = 2; u.row0 = 256 * pa; u.col0 = 256 * pb; return true;
        }
        L -= 768;
        if (L < 1024) {
            const int pm = L >> 3, pn = ((L & 7) + (L >> 8)) & 7;
            u.A = (const char*)(ws + WS_H) + (size_t)(256 * pm) * ROWB; u.B = (const char*)(ws + WS_BTIN) + (size_t)(256 * pn) * ROWB;
            u.type = pn < 6 ? 0 : 1; u.row0 = 256 * pm; u.col0 = pn; return true;
        }
        L -= 1024;
        if (L < 20) {
            const int pm = L / 5, j = L % 5, pn = j == 0 ? 1 : (j == 1 ? 2 : (j == 2 ? 3 : (j == 3 ? 6 : 7)));
            u.A = (const char*)(ws + WS_H) + (size_t)(T + 256 * pm) * ROWB; u.B = (const char*)(ws + WS_BTIN) + (size_t)(256 * pn) * ROWB;
            u.type = pn < 6 ? 0 : 1; u.row0 = T + 256 * pm; u.col0 = pn; return true;
        }
        return false;
    }
    __device__ __forceinline__ const float* bias(const Unit& u) const { return (u.type == 1 && u.col0 == 7) ? bab : baf; }
};
struct EpiIn {
    unsigned char* ws;
    __device__ __forceinline__ void operator()(const f32x4 (&acc)[2][2][4][2], const Unit& u, int wr, int wc, int fr, int fq, const LAS float* bs) const {
        const int rl = wr * 64 + fr, cl = wc * 32 + 8 * fq;
        if (u.type == 0) {
            const int pn = u.col0;
            bf16_t* dst; int ld, cb;
            if (pn == 0) { dst = (bf16_t*)(ws + WS_Q); ld = 256; cb = 0; }
            else if (pn == 1) { dst = (bf16_t*)(ws + WS_K); ld = 256; cb = 0; }
            else if (pn < 4) { dst = (bf16_t*)(ws + WS_V); ld = 512; cb = (pn - 2) * 256; }
            else { dst = (bf16_t*)(ws + WS_G); ld = 512; cb = (pn - 4) * 256; }
#pragma unroll
            for (int ai = 0; ai < 2; ++ai)
#pragma unroll
                for (int m = 0; m < 4; ++m) { bf16_t* rowp = dst + (size_t)(u.row0 + rl + ai * 128 + m * 16) * ld + cb + cl;
#pragma unroll
                    for (int bj = 0; bj < 2; ++bj) *(u32x4*)(rowp + bj * 128) = pack8(acc[ai][bj][m][0], acc[ai][bj][m][1]); }
        } else if (u.type == 1) {
            _Float16* dst = (_Float16*)(ws + (u.col0 == 6 ? WS_GF : WS_GB));
            f32x4 bv[2][2];
#pragma unroll
            for (int bj = 0; bj < 2; ++bj)
#pragma unroll
                for (int n = 0; n < 2; ++n) bv[bj][n] = *(const LAS f32x4*)(bs + cl + bj * 128 + 4 * n);
            typedef _Float16 f16x8_ __attribute__((ext_vector_type(8)));
#pragma unroll
            for (int ai = 0; ai < 2; ++ai)
#pragma unroll
                for (int m = 0; m < 4; ++m) { _Float16* rowp = dst + (size_t)(u.row0 + rl + ai * 128 + m * 16) * 256 + cl;
#pragma unroll
                    for (int bj = 0; bj < 2; ++bj) { f16x8_ o;
#pragma unroll
                        for (int n = 0; n < 2; ++n) { const f32x4 z = acc[ai][bj][m][n] + bv[bj][n];
#pragma unroll
                            for (int j = 0; j < 4; ++j) o[4 * n + j] = (_Float16)(log_sigmoid_f(z[j]) * (1.f / 16.f)); }
                        *(f16x8_*)(rowp + bj * 128) = o; } }
        } else {
            const int b = u.col0 >> 13, l0 = u.col0 & 8191;
            bf16_t* dst = (bf16_t*)(ws + WS_UT) + ((size_t)b * HYC) * SEQ + l0 + cl;
#pragma unroll
            for (int ai = 0; ai < 2; ++ai)
#pragma unroll
                for (int m = 0; m < 4; ++m) { bf16_t* rowp = dst + (size_t)(u.row0 + rl + ai * 128 + m * 16) * SEQ;
#pragma unroll
                    for (int bj = 0; bj < 2; ++bj) *(u32x4*)(rowp + bj * 128) = pack8(acc[ai][bj][m][0], acc[ai][bj][m][1]); }
        }
    }
};

struct SchedOut {
    unsigned char* ws; int G, c;
    __device__ __forceinline__ bool next(int i, Unit& u) const {
        const int L = i * G + c; if (L >= 512) return false;
        const int pm = L >> 2, pn = L & 3;
        u.A = (const char*)(ws + WS_MIX) + (size_t)(256 * pm) * ROWB; u.B = (const char*)(ws + WS_BTOUT) + (size_t)(256 * pn) * ROWB;
        u.list = nullptr; u.valid = 256; u.aux = 0; u.type = 3; u.row0 = 256 * pm; u.col0 = 256 * pn; return true;
    }
    __device__ __forceinline__ const float* bias(const Unit& u) const { return (const float*)(ws + WS_MOD) + (u.row0 >> 13) * 6144 + 2 * 1024 + u.col0; }
};
struct EpiOut {
    unsigned char* ws;
    __device__ __forceinline__ void operator()(const f32x4 (&acc)[2][2][4][2], const Unit& u, int wr, int wc, int fr, int fq, const LAS float* bs) const {
        const int rl = wr * 64 + fr, cl = u.col0 + wc * 32 + 8 * fq;
        bf16_t* fg = (bf16_t*)(ws + WS_FG);
        f32x4 gv[2][2];
#pragma unroll
        for (int bj = 0; bj < 2; ++bj)
#pragma unroll
            for (int n = 0; n < 2; ++n) gv[bj][n] = *(const LAS f32x4*)(bs + wc * 32 + 8 * fq + bj * 128 + 4 * n);
#pragma unroll
        for (int ai = 0; ai < 2; ++ai)
#pragma unroll
            for (int m = 0; m < 4; ++m) { bf16_t* rowp = fg + (size_t)(u.row0 + rl + ai * 128 + m * 16) * 1024 + cl;
#pragma unroll
                for (int bj = 0; bj < 2; ++bj) *(u32x4*)(rowp + bj * 128) = pack8(gv[bj][0] * acc[ai][bj][m][0], gv[bj][1] * acc[ai][bj][m][1]); }
    }
};

constexpr int LDS_TAB = STAGE_BYTES;
template <int WHICH>
struct SchedMoe {
    unsigned char* ws; const LAS int* tab; int G, c; const float* b2;
    __device__ __forceinline__ bool next(int i, Unit& u) const {
        constexpr int NCT_ = WHICH == 1 ? 8 : 4;
        const int L = i * G + c; const int nrt = __builtin_amdgcn_readfirstlane(tab[32]);
        if (L >= nrt * NCT_) return false;
        const int rt = L / NCT_, ct = L % NCT_;
        const int info = __builtin_amdgcn_readfirstlane(tab[64 + rt]), e = info & 255, r0 = (info >> 8) * 256;
        const int cnt = __builtin_amdgcn_readfirstlane(tab[e]);
        u.valid = (cnt - r0) < 256 ? (cnt - r0) : 256;
        u.list = (const int*)(ws + WS_LIST) + (size_t)e * CAP + r0;
        u.A = (WHICH == 1) ? (const char*)(ws + WS_H2) : (const char*)(ws + WS_ACT) + (size_t)(256 * rt) * KD;
        u.B = (const char*)(ws + (WHICH == 1 ? WS_W1T : WS_W2T)) + ((size_t)e * (WHICH == 1 ? 2048 : 1024) + 256 * ct) * KD;
        u.type = 3 + WHICH; u.row0 = 256 * rt; u.col0 = ct; u.aux = e; return true;
    }
    __device__ __forceinline__ const float* bias(const Unit& u) const { return (WHICH == 1) ? (const float*)(ws + WS_B1R) + (size_t)u.aux * 2048 + 256 * u.col0 : b2 + (size_t)u.aux * 1024 + 256 * u.col0; }
};
__device__ __forceinline__ float swiglu_f(float glu, float lin) {
    glu = fminf(glu, 7.f); lin = fminf(fmaxf(lin, -7.f), 7.f);
    return glu * __builtin_amdgcn_rcpf(1.f + __expf(-1.702f * glu)) * (lin + 1.f);
}
constexpr float S_H2 = 4.f, S_ACT = 8.f, S_W = 64.f;
__device__ __forceinline__ f32x2 swiglu2(f32x2 ag, f32x2 al, f32x2 bg, f32x2 bl) {
    f32x2 g = ag * (1.f / (S_H2 * S_W)) + bg, l = al * (1.f / (S_H2 * S_W)) + bl;
    g[0] = fminf(g[0], 7.f); g[1] = fminf(g[1], 7.f);
    l[0] = __builtin_amdgcn_fmed3f(l[0], -7.f, 7.f); l[1] = __builtin_amdgcn_fmed3f(l[1], -7.f, 7.f);
    const f32x2 t = g * (-1.702f * 1.4426950408889634f);
    const f32x2 d = (f32x2){__builtin_amdgcn_exp2f(t[0]), __builtin_amdgcn_exp2f(t[1])} + 1.f;
    const f32x2 r = {__builtin_amdgcn_rcpf(d[0]), __builtin_amdgcn_rcpf(d[1])};
    return (g * r) * (l * S_ACT + S_ACT);
}
__device__ __forceinline__ unsigned pk4_fp8(float a, float b, float c, float d) {
    a = fminf(fmaxf(a, -448.f), 448.f); b = fminf(fmaxf(b, -448.f), 448.f); c = fminf(fmaxf(c, -448.f), 448.f); d = fminf(fmaxf(d, -448.f), 448.f);
    int p = __builtin_amdgcn_cvt_pk_fp8_f32(a, b, 0, false); p = __builtin_amdgcn_cvt_pk_fp8_f32(c, d, p, true); return (unsigned)p; }
__device__ __forceinline__ unsigned pk4_fp8_nc(float a, float b, float c, float d) { int p = __builtin_amdgcn_cvt_pk_fp8_f32(a, b, 0, false); p = __builtin_amdgcn_cvt_pk_fp8_f32(c, d, p, true); return (unsigned)p; }
struct EpiMoe1 {
    unsigned char* ws;
    __device__ __forceinline__ void operator()(const f32x4 (&acc)[2][2][4][2], const Unit& u, int wr, int wc, int fr, int fq, const LAS float* bs) const {
        const int rl = wr * 64 + fr, cl = wc * 32 + 8 * fq, ct = u.col0;
        const LAS float* b1 = bs + cl;
        unsigned char* act = (unsigned char*)(ws + WS_ACT) + (size_t)u.row0 * 1024 + 128 * ct + cl;
        f32x4 bg[2], bl[2];
#pragma unroll
        for (int n = 0; n < 2; ++n) { bg[n] = *(const LAS f32x4*)(b1 + 4 * n); bl[n] = *(const LAS f32x4*)(b1 + 128 + 4 * n); }
#pragma unroll
        for (int ai = 0; ai < 2; ++ai)
#pragma unroll
            for (int mp = 0; mp < 2; ++mp) {
                u32x2 w[2];
#pragma unroll
                for (int mm = 0; mm < 2; ++mm) { const int m = 2 * mp + mm;
#pragma unroll
                    for (int n = 0; n < 2; ++n) { int p = 0;
#pragma unroll
                        for (int hh = 0; hh < 2; ++hh) {
                            const f32x2 o = swiglu2((f32x2){acc[ai][0][m][n][2 * hh], acc[ai][0][m][n][2 * hh + 1]}, (f32x2){acc[ai][1][m][n][2 * hh], acc[ai][1][m][n][2 * hh + 1]},
                                                    (f32x2){bg[n][2 * hh], bg[n][2 * hh + 1]}, (f32x2){bl[n][2 * hh], bl[n][2 * hh + 1]});
                            p = hh ? __builtin_amdgcn_cvt_pk_fp8_f32(o[0], o[1], p, true) : __builtin_amdgcn_cvt_pk_fp8_f32(o[0], o[1], p, false); }
                        if (n == 0) w[mm].x = (unsigned)p; else w[mm].y = (unsigned)p; } }
                const auto sx = __builtin_amdgcn_permlane16_swap(w[0].x, w[1].x, false, false); const auto sy = __builtin_amdgcn_permlane16_swap(w[0].y, w[1].y, false, false);
                const int r = rl + ai * 128 + (2 * mp + (fq & 1)) * 16;
                *(u32x4*)(act + (size_t)r * 1024 - 8 * (fq & 1)) = (u32x4){sx[0], sy[0], sx[1], sy[1]}; }
    }
};
constexpr float S_SL = 16.f;
struct EpiMoe2 {
    unsigned char* ws;
    __device__ __forceinline__ void operator()(const f32x4 (&acc)[2][2][4][2], const Unit& u, int wr, int wc, int fr, int fq, const LAS float* bs) const {
        const int rl = wr * 64 + fr, cl = wc * 32 + 8 * fq, ct = u.col0;
        const LAS float* bb = bs + cl;
        unsigned char* slots = (unsigned char*)(ws + WS_SLOTS) + (size_t)u.row0 * 1024 + 256 * ct + cl;
        f32x4 bv[2][2];
#pragma unroll
        for (int bj = 0; bj < 2; ++bj)
#pragma unroll
            for (int n = 0; n < 2; ++n) bv[bj][n] = *(const LAS f32x4*)(bb + bj * 128 + 4 * n) * S_SL;
#pragma unroll
        for (int ai = 0; ai < 2; ++ai)
#pragma unroll
            for (int m = 0; m < 4; ++m) { const int r = rl + ai * 128 + m * 16;
                u32x2 w[2];
#pragma unroll
                for (int bj = 0; bj < 2; ++bj) {
#pragma unroll
                    for (int n = 0; n < 2; ++n) { int p = 0;
#pragma unroll
                        for (int hh = 0; hh < 2; ++hh) { f32x2 y = (f32x2){acc[ai][bj][m][n][2 * hh], acc[ai][bj][m][n][2 * hh + 1]} * (S_SL / (S_ACT * S_W)) + (f32x2){bv[bj][n][2 * hh], bv[bj][n][2 * hh + 1]};
                            y[0] = __builtin_amdgcn_fmed3f(y[0], -448.f, 448.f); y[1] = __builtin_amdgcn_fmed3f(y[1], -448.f, 448.f);
                            p = hh ? __builtin_amdgcn_cvt_pk_fp8_f32(y[0], y[1], p, true) : __builtin_amdgcn_cvt_pk_fp8_f32(y[0], y[1], p, false); }
                        if (n == 0) w[bj].x = (unsigned)p; else w[bj].y = (unsigned)p; } }
                const auto sx = __builtin_amdgcn_permlane16_swap(w[0].x, w[1].x, false, false); const auto sy = __builtin_amdgcn_permlane16_swap(w[0].y, w[1].y, false, false);
                *(u32x4*)(slots + (size_t)r * 1024 + ((fq & 1) ? 128 - 8 : 0)) = (u32x4){sx[0], sy[0], sx[1], sy[1]}; }
    }
};
}

namespace hy {
__device__ __forceinline__ int phys(int n) { return n + (n >> 4) + ((n >> 9) << 4); }
constexpr int XSIZE = 16384 + 1024 + 512;

__device__ __forceinline__ float tw_c(int i) {
    constexpr float t[16] = {1.f, 0.98078528040323043f, 0.92387953251128674f, 0.83146961230254524f, 0.70710678118654752f, 0.55557023301960218f, 0.38268343236508977f, 0.19509032201612825f,
                             0.f, -0.19509032201612825f, -0.38268343236508977f, -0.55557023301960218f, -0.70710678118654752f, -0.83146961230254524f, -0.92387953251128674f, -0.98078528040323043f};
    return t[i];
}
__device__ __forceinline__ float tw_s(int i) {
    constexpr float t[16] = {0.f, 0.19509032201612825f, 0.38268343236508977f, 0.55557023301960218f, 0.70710678118654752f, 0.83146961230254524f, 0.92387953251128674f, 0.98078528040323043f,
                             1.f, 0.98078528040323043f, 0.92387953251128674f, 0.83146961230254524f, 0.70710678118654752f, 0.55557023301960218f, 0.38268343236508977f, 0.19509032201612825f};
    return t[i];
}
__host__ __device__ constexpr int brev(int p, int bits) { int r = 0; for (int i = 0; i < bits; ++i) r |= ((p >> i) & 1) << (bits - 1 - i); return r; }

__device__ __forceinline__ f32x2 cmul(f32x2 a, f32x2 w) { f32x2 r;
    asm("v_pk_mul_f32 %0, %1, %2 op_sel_hi:[1,0]\n\tv_pk_fma_f32 %0, %1, %2, %0 op_sel:[1,1,0] op_sel_hi:[0,1,1] neg_lo:[0,1,0]" : "=&v"(r) : "v"(a), "v"(w)); return r; }
__device__ __forceinline__ void cmul_chain(f32x2 a, f32x2 w, f32x2 w1, f32x2& o, f32x2& wn) {
    asm("v_pk_mul_f32 %0, %2, %3 op_sel_hi:[1,0]\n\tv_pk_mul_f32 %1, %3, %4 op_sel_hi:[1,0]\n\t"
        "v_pk_fma_f32 %0, %2, %3, %0 op_sel:[1,1,0] op_sel_hi:[0,1,1] neg_lo:[0,1,0]\n\tv_pk_fma_f32 %1, %3, %4, %1 op_sel:[1,1,0] op_sel_hi:[0,1,1] neg_lo:[0,1,0]"
        : "=&v"(o), "=&v"(wn) : "v"(a), "v"(w), "v"(w1)); }
template <int TI, bool INV>
__device__ __forceinline__ void bf_tw(f32x2& a, f32x2& b) {
    constexpr int T7 = TI < 8 ? TI : 16 - TI;
    const f32x2 W = {tw_c(T7), tw_s(T7)};
    f32x2 sum, o;
#define HY_BF(NEGR, NEGI) asm("v_pk_add_f32 %0, %3, %2\n\tv_pk_add_f32 %2, %3, %2 neg_lo:[0,1] neg_hi:[0,1]\n\tv_pk_mul_f32 %1, %2, %4 op_sel_hi:[1,0]" NEGR "\n\tv_pk_fma_f32 %1, %2, %4, %1 op_sel:[1,1,0] op_sel_hi:[0,1,1] " NEGI : "=&v"(sum), "=&v"(o), "+v"(b) : "v"(a), "s"(W))
    if (TI < 8) { if (!INV) HY_BF("", "neg_hi:[0,1,0]"); else HY_BF("", "neg_lo:[0,1,0]"); }
    else        { if (!INV) HY_BF(" neg_lo:[0,1] neg_hi:[0,1]", "neg_hi:[0,1,0]"); else HY_BF(" neg_lo:[0,1] neg_hi:[0,1]", "neg_lo:[0,1,0]"); }
#undef HY_BF
    a = sum; b = o;
}
template <int TI, bool INV>
__device__ __forceinline__ f32x2 tw_mul(f32x2 t) {
    constexpr int T7 = TI < 8 ? TI : 16 - TI;
    const f32x2 W = {tw_c(T7), tw_s(T7)};
    f32x2 r;
#define HY_TW(NEGR, NEGI) asm("v_pk_mul_f32 %0, %1, %2 op_sel_hi:[1,0]" NEGR "\n\tv_pk_fma_f32 %0, %1, %2, %0 op_sel:[1,1,0] op_sel_hi:[0,1,1] " NEGI : "=&v"(r) : "v"(t), "s"(W))
    if (TI < 8) { if (!INV) HY_TW("", "neg_hi:[0,1,0]"); else HY_TW("", "neg_lo:[0,1,0]"); }
    else        { if (!INV) HY_TW(" neg_lo:[0,1] neg_hi:[0,1]", "neg_hi:[0,1,0]"); else HY_TW(" neg_lo:[0,1] neg_hi:[0,1]", "neg_lo:[0,1,0]"); }
#undef HY_TW
    return r;
}
template <bool INV>
__device__ __forceinline__ void bf_rot(f32x2& a, f32x2& b) { f32x2 sum, o;
    if (!INV) asm("v_pk_add_f32 %0, %2, %3\n\tv_pk_add_f32 %1, %2, %3 op_sel:[1,1] op_sel_hi:[0,0] neg_lo:[0,1] neg_hi:[1,0]" : "=&v"(sum), "=&v"(o) : "v"(a), "v"(b));
    else      asm("v_pk_add_f32 %0, %2, %3\n\tv_pk_add_f32 %1, %2, %3 op_sel:[1,1] op_sel_hi:[0,0] neg_lo:[1,0] neg_hi:[0,1]" : "=&v"(sum), "=&v"(o) : "v"(a), "v"(b));
    a = sum; b = o; }
__device__ __forceinline__ void bf_plain(f32x2& a, f32x2& b) { f32x2 sum, o;
    asm("v_pk_add_f32 %0, %2, %3\n\tv_pk_add_f32 %1, %2, %3 neg_lo:[0,1] neg_hi:[0,1]" : "=&v"(sum), "=&v"(o) : "v"(a), "v"(b));
    a = sum; b = o; }
template <bool INV>
__device__ __forceinline__ f32x2 rot_i(f32x2 t) { f32x2 r;
    if (!INV) asm("v_pk_mul_f32 %0, %1, 1.0 op_sel:[1,0] op_sel_hi:[0,0] neg_hi:[1,0]" : "=v"(r) : "v"(t));
    else      asm("v_pk_mul_f32 %0, %1, 1.0 op_sel:[1,0] op_sel_hi:[0,0] neg_lo:[1,0]" : "=v"(r) : "v"(t));
    return r; }

template <int R, bool INV, bool ZP, int S, int J>
__device__ __forceinline__ void fft_bfly(f32x2 (&v)[R]) {
    constexpr int g = (J / S) * 2 * S, k = J % S, ti = k * (16 / S), i0 = g + k, i1 = g + k + S;
    if constexpr (ZP && S == R / 2) {
        if constexpr (ti == 0) v[i1] = v[i0]; else if constexpr (ti == 8) v[i1] = rot_i<INV>(v[i0]); else v[i1] = tw_mul<ti, INV>(v[i0]);
    } else {
        if constexpr (ti == 0) bf_plain(v[i0], v[i1]); else if constexpr (ti == 8) bf_rot<INV>(v[i0], v[i1]); else bf_tw<ti, INV>(v[i0], v[i1]);
    }
}
template <int R, bool INV, bool ZP, int S, int J>
__device__ __forceinline__ void fft_stage(f32x2 (&v)[R]) { if constexpr (J < R / 2) { fft_bfly<R, INV, ZP, S, J>(v); fft_stage<R, INV, ZP, S, J + 1>(v); } }
template <int R, bool INV, bool ZP, int S>
__device__ __forceinline__ void fft_stages(f32x2 (&v)[R]) { if constexpr (S >= 1) { fft_stage<R, INV, ZP, S, 0>(v); fft_stages<R, INV, ZP, S / 2>(v); } }
template <int R, bool INV, bool ZP = false>
__device__ __forceinline__ void fft_reg(f32x2 (&v)[R]) { fft_stages<R, INV, ZP, R / 2>(v); }
#define XV(X) ((const volatile LAS f32x2*)(X))
template <int M, bool ZPAD = false>
__device__ __forceinline__ void pass_fwd32(LAS f32x2* X, int tid) {
    int j = (M == 512) ? (16 * ((tid >> 5) + 16 * ((tid >> 4) & 1)) + (tid & 15)) : (tid & 15);
    asm volatile("" : "+v"(j));
    const int p0 = (M == 512) ? (j + (j >> 4)) : (560 * (tid >> 4) + (tid & 15));
    constexpr int PS = (M == 512) ? 560 : 17;
    f32x2 v[32];
#pragma unroll
    for (int r = 0; r < 32; ++r) { if (ZPAD && r >= 16) v[r] = (f32x2){0.f, 0.f}; else v[r] = XV(X)[p0 + PS * r]; }
    fft_reg<32, false, ZPAD>(v);
    const float rev = -(float)j * (1.f / (float)(32 * M)); const float sn = __builtin_amdgcn_sinf(rev), cs = __builtin_amdgcn_cosf(rev);
    const f32x2 w1 = {cs, sn}; f32x2 w = w1;
    X[p0] = v[0];
#pragma unroll
    for (int rp = 1; rp < 32; ++rp) { if (rp < 31) { f32x2 o_, wn_; cmul_chain(v[brev(rp, 5)], w, w1, o_, wn_); X[p0 + PS * rp] = o_; w = wn_; } else X[p0 + PS * rp] = cmul(v[brev(rp, 5)], w); }
}
template <int M, bool HALF = false>
__device__ __forceinline__ void pass_inv32(LAS f32x2* X, int tid) {
    int j = (M == 512) ? (16 * ((tid >> 5) + 16 * ((tid >> 4) & 1)) + (tid & 15)) : (tid & 15);
    asm volatile("" : "+v"(j));
    const int p0 = (M == 512) ? (j + (j >> 4)) : (560 * (tid >> 4) + (tid & 15));
    constexpr int PS = (M == 512) ? 560 : 17;
    const float rev = (float)j * (1.f / (float)(32 * M)); const float sn = __builtin_amdgcn_sinf(rev), cs = __builtin_amdgcn_cosf(rev);
    const f32x2 w1 = {cs, sn}; f32x2 w = w1;
    f32x2 v[32];
    v[0] = XV(X)[p0];
#pragma unroll
    for (int rp = 1; rp < 32; ++rp) { if (rp < 31) { f32x2 wn_; cmul_chain(XV(X)[p0 + PS * rp], w, w1, v[rp], wn_); w = wn_; } else v[rp] = cmul(XV(X)[p0 + PS * rp], w); }
    fft_reg<32, true>(v);
#pragma unroll
    for (int p = 0; p < 32; ++p) { if (!HALF || brev(p, 5) < 16) X[p0 + PS * brev(p, 5)] = v[p]; }
}
typedef _Float16 f16x8h __attribute__((ext_vector_type(8)));
__device__ __forceinline__ void pass_c_store(const LAS f32x2* X, f32x2* Hs_, int tid, float scale) {
    _Float16* Hs = (_Float16*)Hs_; (void)scale;
#pragma unroll
    for (int u = 0; u < 2; ++u) { const int blk = tid + 512 * u, p0 = 17 * blk + 16 * (blk >> 5);
        f32x2 v[16];
#pragma unroll
        for (int r = 0; r < 16; ++r) v[r] = XV(X)[p0 + r];
        fft_reg<16, false>(v);
#pragma unroll
        for (int q = 0; q < 4; ++q) { f16x8h o;
#pragma unroll
            for (int e = 0; e < 4; ++e) { const f32x2 x = v[brev(4 * q + e, 4)]; o[2 * e] = (_Float16)x[0]; o[2 * e + 1] = (_Float16)x[1]; }
            *(f16x8h*)(Hs + 2 * (16 * blk + 4 * q)) = o; } }
}
__device__ __forceinline__ void pass_c_mul_inv(LAS f32x2* X, const f32x2* Hs_, int tid) {
    const _Float16* Hs = (const _Float16*)Hs_;
#pragma unroll
    for (int u = 0; u < 2; ++u) { const int blk = tid + 512 * u, p0 = 17 * blk + 16 * (blk >> 5);
        f32x2 v[16], w[16];
#pragma unroll
        for (int r = 0; r < 16; ++r) v[r] = XV(X)[p0 + r];
        f16x8h hh[4];
#pragma unroll
        for (int q = 0; q < 4; ++q) hh[q] = *(const f16x8h*)(Hs + 2 * (16 * blk + 4 * q));
        fft_reg<16, false>(v);
#pragma unroll
        for (int q = 0; q < 4; ++q)
#pragma unroll
            for (int e = 0; e < 4; ++e) w[4 * q + e] = cmul(v[brev(4 * q + e, 4)], (f32x2){(float)hh[q][2 * e], (float)hh[q][2 * e + 1]});
        fft_reg<16, true>(w);
#pragma unroll
        for (int p = 0; p < 16; ++p) X[p0 + brev(p, 4)] = w[p]; }
}
__device__ __forceinline__ void load16(const bf16_t* u, float (&e)[16]) {
    const u32x4 a = *(const u32x4*)u, b = *(const u32x4*)(u + 8);
    e[0] = bflo(a.x); e[1] = bfhi(a.x); e[2] = bflo(a.y); e[3] = bfhi(a.y); e[4] = bflo(a.z); e[5] = bfhi(a.z); e[6] = bflo(a.w); e[7] = bfhi(a.w);
    e[8] = bflo(b.x); e[9] = bfhi(b.x); e[10] = bflo(b.y); e[11] = bfhi(b.y); e[12] = bflo(b.z); e[13] = bfhi(b.z); e[14] = bflo(b.w); e[15] = bfhi(b.w);
}
__device__ __forceinline__ void sconv16(const bf16_t* u, int tid, float w0, float w1, float w2, float bias, float (&o)[16]) {
    float e[16]; load16(u + 16 * tid, e);
    float lf = __shfl_up(e[15], 1), rt = __shfl_down(e[0], 1);
    if ((tid & 3) == 0) lf = 0.f;
    if ((tid & 3) == 3) rt = 0.f;
    o[0] = w0 * lf + w1 * e[0] + w2 * e[1] + bias;
#pragma unroll
    for (int i = 1; i < 15; ++i) o[i] = w0 * e[i - 1] + w1 * e[i] + w2 * e[i + 1] + bias;
    o[15] = w0 * e[14] + w1 * e[15] + w2 * rt + bias;
}

constexpr int CV_W1 = NE * 64 * 32;
constexpr int CV_W2E = 11;
constexpr int CV_ITEMS = CV_W1 + CV_W2E * 1024;
struct CvJob { float v[16]; int mi; };
__device__ __forceinline__ void cv_issue(const Args& a, CvJob& jb, int mi, int lane) {
    jb.mi = mi;
    if (mi >= 0) {
        const float* src; size_t rs;
        if (mi < CV_W1) { const int e = mi >> 11, kg = (mi >> 5) & 63, nb = mi & 31; src = a.in[I_EW1] + ((size_t)e * 1024 + 16 * kg) * 2048 + 64 * nb + lane; rs = 2048; }
        else { const int m2 = mi - CV_W1, e = m2 >> 10, kg = (m2 >> 4) & 63, nb = m2 & 15; src = a.in[I_EW2] + ((size_t)e * 1024 + 16 * kg) * 1024 + 64 * nb + lane; rs = 1024; }
#pragma unroll
        for (int i = 0; i < 16; ++i) jb.v[i] = src[(size_t)i * rs]; }
}
__device__ __forceinline__ void cv_finish(const Args& a, const CvJob& jb, int lane) {
    if (jb.mi >= 0) { const int mi = jb.mi;
        unsigned char* dst;
        if (mi < CV_W1) { const int e = mi >> 11, kg = (mi >> 5) & 63, nb = mi & 31;
            const int cs = 64 * nb + lane, sgl = cs & 1, ac = cs >> 1, ct = ac >> 7, jj = ac & 127;
            dst = (unsigned char*)(a.ws + WS_W1T) + ((size_t)e * 2048 + 256 * ct + 128 * sgl + jj) * 1024 + 16 * kg; }
        else { const int m2 = mi - CV_W1, e = m2 >> 10, kg = (m2 >> 4) & 63, nb = m2 & 15;
            dst = (unsigned char*)(a.ws + WS_W2T) + ((size_t)e * 1024 + 64 * nb + lane) * 1024 + 16 * kg; }
        u32x4 o;
        o.x = gm::pk4_fp8_nc(jb.v[0] * gm::S_W, jb.v[1] * gm::S_W, jb.v[2] * gm::S_W, jb.v[3] * gm::S_W); o.y = gm::pk4_fp8_nc(jb.v[4] * gm::S_W, jb.v[5] * gm::S_W, jb.v[6] * gm::S_W, jb.v[7] * gm::S_W);
        o.z = gm::pk4_fp8_nc(jb.v[8] * gm::S_W, jb.v[9] * gm::S_W, jb.v[10] * gm::S_W, jb.v[11] * gm::S_W); o.w = gm::pk4_fp8_nc(jb.v[12] * gm::S_W, jb.v[13] * gm::S_W, jb.v[14] * gm::S_W, jb.v[15] * gm::S_W);
        *(u32x4*)dst = o; }
}
struct CvState { CvJob jb; int next, stride, end; };
__device__ __forceinline__ void cv_step(const Args& a, CvState& st, int lane) {
    cv_finish(a, st.jb, lane);
    const int mi = st.next < st.end ? st.next : -1;
    cv_issue(a, st.jb, mi, lane);
    st.next += st.stride;
}

__device__ __forceinline__ void channel(const Args& a, LAS unsigned char* lds, int c, unsigned char* scratch, CvState& cvs) {
    const int tid = threadIdx.x;
#define CV_STEP() cv_step(a, cvs, tid & 63)
    LAS f32x2* X = (LAS f32x2*)lds;
    f32x2* Hs = (f32x2*)scratch;
    const _Float16* HF = (const _Float16*)(a.ws + WS_HF);
    const int pc = 17 * tid + 16 * (tid >> 5);
    __syncthreads();
#pragma unroll 1
    for (int o = 0; o < 2; ++o) {
        typedef _Float16 f16x8_ __attribute__((ext_vector_type(8)));
        const f16x8_* hf = (const f16x8_*)(HF + ((size_t)(2 * o) * HYW + c) * SEQ + 16 * tid); const f16x8_* hb = (const f16x8_*)(HF + ((size_t)(2 * o + 1) * HYW + c) * SEQ + 16 * tid);
#pragma unroll
        for (int q = 0; q < 2; ++q) { const f16x8_ f = hf[q], b = hb[q];
#pragma unroll
            for (int e = 0; e < 8; ++e) { const int i = 8 * q + e, t = 16 * tid + i;
                X[pc + i] = (f32x2){(float)f[e], 0.f};
                if (t >= 1) X[phys(FFTN - t)] = (f32x2){(float)b[e], 0.f}; } }
        if (tid == 0) X[phys(SEQ)] = (f32x2){0.f, 0.f};
        __syncthreads();
        CV_STEP(); pass_fwd32<512>(X, tid); __syncthreads(); CV_STEP(); pass_fwd32<16>(X, tid); __syncthreads(); pass_c_store(X, Hs + (size_t)o * (FFTN / 2), tid, 1.f); __syncthreads();
    }
    const float* cw = a.in[I_CONVW]; const float* cbv = a.in[I_CONVB]; const float* dbias = a.in[I_BIASD];
    const float d1 = dbias[c], d2 = dbias[HYW + c];
    constexpr float INVN = 1.f / (float)FFTN;
    float wv[3][3], bv[3];
#pragma unroll
    for (int s = 0; s < 3; ++s) { bv[s] = cbv[s * HYW + c];
#pragma unroll
        for (int i = 0; i < 3; ++i) wv[s][i] = cw[i * HYC + s * HYW + c]; }
    const bf16_t* UT = (const bf16_t*)(a.ws + WS_UT);
    bf16_t* YT = (bf16_t*)(a.ws + WS_YHYT);
#pragma unroll 1
    for (int bp = 0; bp < 2; ++bp) {
        const bf16_t* u0 = UT + ((size_t)(2 * bp) * HYC + c) * SEQ; const bf16_t* u1 = UT + ((size_t)(2 * bp + 1) * HYC + c) * SEQ;
        float z0[16], z1[16];
        {
            float v0[16], v1[16]; sconv16(u0, tid, wv[0][0], wv[0][1], wv[0][2], bv[0], v0); sconv16(u1, tid, wv[0][0], wv[0][1], wv[0][2], bv[0], v1);
#pragma unroll
            for (int i = 0; i < 16; ++i) X[pc + i] = (f32x2){v0[i], v1[i]};
        }
        __syncthreads();
        CV_STEP(); pass_fwd32<512, true>(X, tid); __syncthreads(); CV_STEP(); pass_fwd32<16>(X, tid); __syncthreads(); pass_c_mul_inv(X, Hs, tid); __syncthreads(); CV_STEP(); pass_inv32<16>(X, tid); __syncthreads(); CV_STEP(); pass_inv32<512, true>(X, tid); __syncthreads();
        {
            float v0[16], v1[16], x0[16], x1[16];
            sconv16(u0, tid, wv[0][0], wv[0][1], wv[0][2], bv[0], v0); sconv16(u1, tid, wv[0][0], wv[0][1], wv[0][2], bv[0], v1);
            sconv16(u0 + (size_t)HYW * SEQ, tid, wv[1][0], wv[1][1], wv[1][2], bv[1], x0); sconv16(u1 + (size_t)HYW * SEQ, tid, wv[1][0], wv[1][1], wv[1][2], bv[1], x1);
#pragma unroll
            for (int i = 0; i < 16; ++i) { const f32x2 y1 = X[pc + i]; z0[i] = x0[i] * (y1[0] * INVN + d1 * v0[i]); z1[i] = x1[i] * (y1[1] * INVN + d1 * v1[i]); X[pc + i] = (f32x2){z0[i], z1[i]}; }
        }
        __syncthreads();
        CV_STEP(); pass_fwd32<512, true>(X, tid); __syncthreads(); CV_STEP(); pass_fwd32<16>(X, tid); __syncthreads(); pass_c_mul_inv(X, Hs + FFTN / 2, tid); __syncthreads(); CV_STEP(); pass_inv32<16>(X, tid); __syncthreads(); CV_STEP(); pass_inv32<512, true>(X, tid); __syncthreads();
        {
            float x0[16], x1[16];
            sconv16(u0 + (size_t)2 * HYW * SEQ, tid, wv[2][0], wv[2][1], wv[2][2], bv[2], x0); sconv16(u1 + (size_t)2 * HYW * SEQ, tid, wv[2][0], wv[2][1], wv[2][2], bv[2], x1);
            unsigned w0[8], w1[8];
#pragma unroll
            for (int i = 0; i < 8; ++i) { const f32x2 ya = X[pc + 2 * i], yb = X[pc + 2 * i + 1];
                w0[i] = pk2(x0[2 * i] * (ya[0] * INVN + d2 * z0[2 * i]), x0[2 * i + 1] * (yb[0] * INVN + d2 * z0[2 * i + 1]));
                w1[i] = pk2(x1[2 * i] * (ya[1] * INVN + d2 * z1[2 * i]), x1[2 * i + 1] * (yb[1] * INVN + d2 * z1[2 * i + 1])); }
            u32x4* y0p = (u32x4*)(YT + ((size_t)(2 * bp) * HYW + c) * SEQ + 16 * tid); u32x4* y1p = (u32x4*)(YT + ((size_t)(2 * bp + 1) * HYW + c) * SEQ + 16 * tid);
            y0p[0] = (u32x4){w0[0], w0[1], w0[2], w0[3]}; y0p[1] = (u32x4){w0[4], w0[5], w0[6], w0[7]};
            y1p[0] = (u32x4){w1[0], w1[1], w1[2], w1[3]}; y1p[1] = (u32x4){w1[4], w1[5], w1[6], w1[7]};
        }
        __syncthreads();
    }
#undef CV_STEP
}

constexpr int FILT_RS = 68;
__device__ __forceinline__ void filter_item(const Args& a, int item, int lane, const LAS float* hs) {
    const int ct = item & 127, tc = item >> 7;
    const float* wout = a.in[I_FWOUT]; _Float16* HF = (_Float16*)(a.ws + WS_HF);
    const int col = 16 * ct + (lane & 15), kq = lane >> 4, cch = col & 511;
    typedef _Float16 f16x8f __attribute__((ext_vector_type(8)));
    f16x8f bfr[2];
#pragma unroll
    for (int s = 0; s < 2; ++s)
#pragma unroll
        for (int i = 0; i < 8; ++i) bfr[s][i] = (_Float16)wout[(size_t)(32 * s + 8 * kq + i) * 2048 + col];
    const float dlt = fabsf(-3.0701134573253945f + (float)cch * ((-15.350567286626973f + 3.0701134573253945f) / 511.f));
#pragma unroll 4
    for (int tt = 0; tt < 32; ++tt) { const int t0 = 512 * tc + 16 * tt;
        const LAS f32x4* ar = (const LAS f32x4*)(hs + (16 * tt + (lane & 15)) * FILT_RS + 8 * kq);
        const f32x4 a0 = ar[0], a1 = ar[1], a2 = ar[8], a3 = ar[9];
        const f16x8f af0 = {(_Float16)a0[0], (_Float16)a0[1], (_Float16)a0[2], (_Float16)a0[3], (_Float16)a1[0], (_Float16)a1[1], (_Float16)a1[2], (_Float16)a1[3]};
        const f16x8f af1 = {(_Float16)a2[0], (_Float16)a2[1], (_Float16)a2[2], (_Float16)a2[3], (_Float16)a3[0], (_Float16)a3[1], (_Float16)a3[2], (_Float16)a3[3]};
        f32x4 acc = {0.f, 0.f, 0.f, 0.f};
        acc = __builtin_amdgcn_mfma_f32_16x16x32_f16(af0, bfr[0], acc, 0, 0, 0);
        acc = __builtin_amdgcn_mfma_f32_16x16x32_f16(af1, bfr[1], acc, 0, 0, 0);
        f32x4 o;
#pragma unroll
        for (int r = 0; r < 4; ++r) o[r] = acc[r] * __expf(-((float)(t0 + 4 * kq + r) / (float)(SEQ - 1)) * dlt);
        typedef _Float16 f16x4_ __attribute__((ext_vector_type(4)));
        *(f16x4_*)(HF + (size_t)col * SEQ + t0 + 4 * kq) = (f16x4_){(_Float16)o[0], (_Float16)o[1], (_Float16)o[2], (_Float16)o[3]}; }
}

__device__ __forceinline__ void transpose_item(const Args& a, int item, int lane) {
    const int lt = item & 127, ct = (item >> 7) & 7, b = item >> 10;
    const bf16_t* src = (const bf16_t*)(a.ws + WS_YHYT) + ((size_t)b * HYW + 64 * ct) * SEQ + 64 * lt + lane;
    bf16_t* dst = (bf16_t*)(a.ws + WS_MIX) + ((size_t)b * SEQ + 64 * lt + lane) * 1024 + 512 + 64 * ct;
    unsigned short v[64];
#pragma unroll
    for (int cc = 0; cc < 64; ++cc) v[cc] = src[(size_t)cc * SEQ];
#pragma unroll
    for (int q = 0; q < 8; ++q)
        *(u32x4*)(dst + 8 * q) = (u32x4){(unsigned)v[8 * q] | ((unsigned)v[8 * q + 1] << 16), (unsigned)v[8 * q + 2] | ((unsigned)v[8 * q + 3] << 16),
                                         (unsigned)v[8 * q + 4] | ((unsigned)v[8 * q + 5] << 16), (unsigned)v[8 * q + 6] | ((unsigned)v[8 * q + 7] << 16)};
}
}

__device__ __forceinline__ void p0_mod_and_filter(const Args& a, LAS unsigned char* lds) {
    const int tid = threadIdx.x, lane = tid & 63, wave = tid >> 6;
    const float* c = a.in[I_C]; const float* cctx = a.in[I_CCTX]; const float* adaw = a.in[I_ADAW]; const float* adab = a.in[I_ADAB];
    float* mod = (float*)(a.ws + WS_MOD);
    LAS float* sl = (LAS float*)lds;
    LAS float* pt = (LAS float*)lds + 5 * 1024;
    for (int i = tid; i < 5 * 1024; i += NTHREADS) { const int r = i >> 10, k = i & 1023; sl[i] = silu_f(r < 4 ? c[r * 1024 + k] : cctx[k]); }
    for (int it = blockIdx.x; it < 256; it += gridDim.x) {
        __syncthreads();
        if (tid < 504) {
            const int col = tid % 24, ks = tid / 24, n = it * 24 + col, kbeg = ks * 49, kend = (kbeg + 49 < 1024) ? kbeg + 49 : 1024;
            float acc[5] = {0.f, 0.f, 0.f, 0.f, 0.f};
#pragma unroll 7
            for (int k = kbeg; k < kend; ++k) { const float w = adaw[(size_t)k * 6144 + n];
#pragma unroll
                for (int r = 0; r < 5; ++r) acc[r] += sl[r * 1024 + k] * w; }
#pragma unroll
            for (int r = 0; r < 5; ++r) pt[(ks * 5 + r) * 24 + col] = acc[r];
        }
        __syncthreads();
        if (tid < 120) { const int r = tid / 24, col = tid % 24, n = it * 24 + col; float s = adab[n];
            for (int ks = 0; ks < 21; ++ks) s += pt[(ks * 5 + r) * 24 + col];
            mod[r * 6144 + n] = s; }
    }
    __syncthreads();
    const float* w1 = a.in[I_FW1]; const float* b1 = a.in[I_FB1]; const float* w2 = a.in[I_FW2]; const float* b2 = a.in[I_FB2]; const float* fq = a.in[I_FFREQ];
    float* hid2 = (float*)(a.ws + WS_HID2);
    LAS float* zs = (LAS float*)lds + 8192 + wave * 128;
    const float frq = fq[lane], bb1 = b1[lane], bb2 = b2[lane];
    for (int t = (blockIdx.x * NWAVES + wave); t < SEQ; t += gridDim.x * NWAVES) {
        float z = 0.f;
        if (lane == 0) z = (float)t / (float)(SEQ - 1);
        else if (lane < 33) { const int i = (lane - 1) & 15; const float f = 1e-4f + (float)i * ((15.f - 1e-4f) / 15.f);
            const float ang = (6.283185307179586f * (float)t / (float)SEQ) * f; z = (lane < 17) ? cosf(ang) : -sinf(ang); }
        if (lane < 33) zs[lane] = z;
        __builtin_amdgcn_wave_barrier(); asm volatile("s_waitcnt lgkmcnt(0)" ::: "memory");
        float s = bb1;
#pragma unroll
        for (int e = 0; e < 33; ++e) s += zs[e] * w1[e * 64 + lane];
        const float h1 = sinf(frq * s);
        zs[64 + lane] = h1;
        __builtin_amdgcn_wave_barrier(); asm volatile("s_waitcnt lgkmcnt(0)" ::: "memory");
        float s2 = bb2;
#pragma unroll 16
        for (int g = 0; g < 64; ++g) s2 += zs[64 + g] * w2[g * 64 + lane];
        hid2[(size_t)t * 64 + lane] = sinf(frq * s2);
        __builtin_amdgcn_wave_barrier(); asm volatile("s_waitcnt lgkmcnt(0)" ::: "memory");
    }
}

template <bool FP8 = false>
__device__ __forceinline__ void tr_item(const float* W, int ldw, int k0, int c0, int cstride, float scale, bf16_t* dstrow0, LAS float* scr, int lane) {
    float wv_[32];
#pragma unroll
    for (int i = 0; i < 32; ++i) wv_[i] = W[(size_t)(k0 + 2 * i + (lane >> 5)) * ldw + c0 + (lane & 31) * cstride];
#pragma unroll
    for (int i = 0; i < 32; ++i) scr[(2 * i + (lane >> 5)) * 33 + (lane & 31)] = wv_[i] * scale;
    asm volatile("s_waitcnt lgkmcnt(0)" ::: "memory"); __builtin_amdgcn_wave_barrier();
    const int c = lane & 7;
#pragma unroll
    for (int j = 0; j < 4; ++j) { const int n = (lane >> 3) + 8 * j; const LAS float* s = scr + (8 * c) * 33 + n;
        if (FP8) { u32x2 o; o.x = gm::pk4_fp8(s[0 * 33], s[1 * 33], s[2 * 33], s[3 * 33]); o.y = gm::pk4_fp8(s[4 * 33], s[5 * 33], s[6 * 33], s[7 * 33]);
            *(u32x2*)((unsigned char*)dstrow0 + (size_t)n * 1024 + k0 + 8 * c) = o; }
        else { u32x4 o; o.x = pk2(s[0 * 33], s[1 * 33]); o.y = pk2(s[2 * 33], s[3 * 33]); o.z = pk2(s[4 * 33], s[5 * 33]); o.w = pk2(s[6 * 33], s[7 * 33]);
            *(u32x4*)(dstrow0 + (size_t)n * 1024 + k0 + 8 * c) = o; } }
    asm volatile("s_waitcnt lgkmcnt(0)" ::: "memory"); __builtin_amdgcn_wave_barrier();
}
__device__ __forceinline__ void fold_item(const float* win, const float* wa, int dir, int k0, int j0, bf16_t* dstrow0, LAS float* scr, int lane) {
#pragma unroll 4
    for (int i = 0; i < 32; ++i) { const int kk = 2 * i + (lane >> 5); const float* wr = win + (size_t)(k0 + kk) * INW + 1536 + 16 * dir; float s = 0.f;
#pragma unroll
        for (int r = 0; r < 16; ++r) s += wr[r] * wa[r * 256 + j0 + (lane & 31)];
        scr[kk * 33 + (lane & 31)] = s; }
    asm volatile("s_waitcnt lgkmcnt(0)" ::: "memory"); __builtin_amdgcn_wave_barrier();
    const int c = lane & 7;
#pragma unroll
    for (int j = 0; j < 4; ++j) { const int n = (lane >> 3) + 8 * j; const LAS float* s = scr + (8 * c) * 33 + n;
        u32x4 o; o.x = pk2(s[0 * 33], s[1 * 33]); o.y = pk2(s[2 * 33], s[3 * 33]); o.z = pk2(s[4 * 33], s[5 * 33]); o.w = pk2(s[6 * 33], s[7 * 33]);
        *(u32x4*)(dstrow0 + (size_t)n * 1024 + k0 + 8 * c) = o; }
    asm volatile("s_waitcnt lgkmcnt(0)" ::: "memory"); __builtin_amdgcn_wave_barrier();
}
__device__ __forceinline__ void ln_mod_row(const float* xrow, const float* shift, const float* scale, bf16_t* orow, int lane) {
    const f32x4* xr = (const f32x4*)xrow + lane;
    f32x4 v[4]; float s = 0.f;
#pragma unroll
    for (int j = 0; j < 4; ++j) { v[j] = xr[64 * j]; s += (v[j][0] + v[j][1]) + (v[j][2] + v[j][3]); }
    const float mean = wave_sum(s) * (1.f / D); float s2 = 0.f;
#pragma unroll
    for (int j = 0; j < 4; ++j) { v[j] = v[j] - mean; s2 += (v[j][0] * v[j][0] + v[j][1] * v[j][1]) + (v[j][2] * v[j][2] + v[j][3] * v[j][3]); }
    const float rstd = 1.f / sqrtf(wave_sum(s2) * (1.f / D) + LN_EPS);
    u32x2* o8 = (u32x2*)orow + lane;
#pragma unroll
    for (int j = 0; j < 4; ++j) { const f32x4 sh = ((const f32x4*)shift)[64 * j + lane], sc = ((const f32x4*)scale)[64 * j + lane];
        const f32x4 y = v[j] * rstd * (sc + 1.f) + sh;
        u32x2 w; w.x = pk2(y[0], y[1]); w.y = pk2(y[2], y[3]); o8[64 * j] = w; }
}
constexpr int PREP_I_IN = 16 * 96, PREP_I_FOLD = 16 * 8 * 2, PREP_I_OUT = 16 * 32, PREP_I_W1 = NE * 16 * 64, PREP_I_W2 = NE * 16 * 32;
constexpr int PREP_NITEMS = PREP_I_IN + PREP_I_FOLD + PREP_I_OUT + PREP_I_W1 + PREP_I_W2;
constexpr int PREP_DEFER = PREP_I_W2 - hy::CV_W2E * 512;
__device__ __forceinline__ void prep_items(const Args& a, LAS float* scr, int first, int last, int rank, int nranks, int lane) {
    constexpr int I_IN = PREP_I_IN, I_FOLD = PREP_I_FOLD, I_OUT = PREP_I_OUT, I_W1 = PREP_I_W1;
    const float* win = a.in[I_WIN];
    bf16_t* btin = (bf16_t*)(a.ws + WS_BTIN); bf16_t* btout = (bf16_t*)(a.ws + WS_BTOUT); bf16_t* w1t = (bf16_t*)(a.ws + WS_W1T); bf16_t* w2t = (bf16_t*)(a.ws + WS_W2T);
    for (int it = first + rank; it < last; it += nranks) {
        int r = it;
        if (r < I_IN) {
            const int kb = r / 96, nb = r % 96;
            if (nb < 48) tr_item(win, INW, 64 * kb, 32 * nb, 1, nb < 8 ? 0.125f : 1.f, btin + (size_t)(32 * nb) * 1024, scr, lane);
            else tr_item(win, INW, 64 * kb, 1568 + 32 * (nb - 48), 1, 1.f, btin + (size_t)(2048 + 32 * (nb - 48)) * 1024, scr, lane);
            continue; }
        r -= I_IN;
        if (r < I_FOLD) { const int dir = r & 1, jb = (r >> 1) & 7, kb = r >> 4;
            fold_item(win, dir ? a.in[I_WAB] : a.in[I_WAF], dir, 64 * kb, 32 * jb, btin + (size_t)(1536 + 256 * dir + 32 * jb) * 1024, scr, lane); continue; }
        r -= I_FOLD;
        if (r < I_OUT) { const int kb = r / 32, nb = r % 32; tr_item(a.in[I_WOUT], 1024, 64 * kb, 32 * nb, 1, 1.f, btout + (size_t)(32 * nb) * 1024, scr, lane); continue; }
        r -= I_OUT;
        if (r < I_W1) {
            const int e = r / 1024, q = r % 1024, s = q & 1, nb = (q >> 1) & 31, kb = q >> 6;
            const int ct = nb >> 2, jj0 = (nb & 3) * 32;
            tr_item<true>(a.in[I_EW1] + (size_t)e * 1024 * 2048, 2048, 64 * kb, 2 * (128 * ct + jj0) + s, 2, gm::S_W, (bf16_t*)((unsigned char*)w1t + ((size_t)e * 2048 + 256 * ct + 128 * s + jj0) * 1024), scr, lane);
            continue; }
        r -= I_W1;
        { const int e = r / 512, q = r % 512, kb = q / 32, nb = q % 32;
          tr_item<true>(a.in[I_EW2] + (size_t)e * 1024 * 1024, 1024, 64 * kb, 32 * nb, 1, gm::S_W, (bf16_t*)((unsigned char*)w2t + ((size_t)e * 1024 + 32 * nb) * 1024), scr, lane); }
    }
}
__device__ __forceinline__ void p1_prep(const Args& a, LAS unsigned char* lds) {
    const int tid = threadIdx.x, lane = tid & 63, wave = tid >> 6;
    LAS float* scr = (LAS float*)(lds + wave * 16384);
    const int gw = blockIdx.x * NWAVES + wave, NGW = gridDim.x * NWAVES;
    const float* win = a.in[I_WIN];
    bf16_t* btin = (bf16_t*)(a.ws + WS_BTIN); bf16_t* btout = (bf16_t*)(a.ws + WS_BTOUT); bf16_t* w1t = (bf16_t*)(a.ws + WS_W1T); bf16_t* w2t = (bf16_t*)(a.ws + WS_W2T);
    const float* mod = (const float*)(a.ws + WS_MOD);
    bf16_t* H = (bf16_t*)(a.ws + WS_H);
    { int cur_mr = -1; f32x4 shv[4], scv[4];
#pragma unroll
      for (int j = 0; j < 4; ++j) { shv[j] = (f32x4){0.f, 0.f, 0.f, 0.f}; scv[j] = shv[j]; }
      for (int row0 = gw; row0 < TT; row0 += 4 * NGW) {
        f32x4 xv[4][4];
#pragma unroll
        for (int i = 0; i < 4; ++i) { const int row = row0 + i * NGW;
            if (row < TT) { const f32x4* xr = (const f32x4*)(row < T ? a.in[I_X] + (size_t)row * D : a.in[I_CTX] + (size_t)(row - T) * D) + lane;
#pragma unroll
                for (int j = 0; j < 4; ++j) xv[i][j] = xr[64 * j]; } }
#pragma unroll
        for (int i = 0; i < 4; ++i) { const int row = row0 + i * NGW;
            if (row < TT) { const int mr = row < T ? row >> 13 : 4;
                if (mr != cur_mr) { cur_mr = mr;
#pragma unroll
                    for (int j = 0; j < 4; ++j) { shv[j] = ((const f32x4*)(mod + mr * 6144))[64 * j + lane]; scv[j] = ((const f32x4*)(mod + mr * 6144 + 1024))[64 * j + lane]; } }
                f32x4 v[4]; float s = 0.f;
#pragma unroll
                for (int j = 0; j < 4; ++j) { v[j] = xv[i][j]; s += (v[j][0] + v[j][1]) + (v[j][2] + v[j][3]); }
                const float mean = wave_sum(s) * (1.f / D); float s2 = 0.f;
#pragma unroll
                for (int j = 0; j < 4; ++j) { v[j] = v[j] - mean; s2 += (v[j][0] * v[j][0] + v[j][1] * v[j][1]) + (v[j][2] * v[j][2] + v[j][3] * v[j][3]); }
                const float rstd = 1.f / sqrtf(wave_sum(s2) * (1.f / D) + LN_EPS);
                u32x2* o8 = (u32x2*)(H + (size_t)row * D) + lane;
#pragma unroll
                for (int j = 0; j < 4; ++j) { const f32x4 y = v[j] * rstd * (scv[j] + 1.f) + shv[j];
                    u32x2 w; w.x = pk2(y[0], y[1]); w.y = pk2(y[2], y[3]); o8[64 * j] = w; } } }
      } }
    prep_items(a, scr, 0, PREP_I_IN + PREP_I_FOLD + PREP_I_OUT, gw, NGW, lane);
    for (int it0 = blockIdx.x * NWAVES; it0 < 2048; it0 += NGW) {
        __syncthreads();
        { const f32x4* src = (const f32x4*)((const float*)(a.ws + WS_HID2) + (size_t)(it0 >> 7) * 512 * 64); LAS float* hs = (LAS float*)lds;
#pragma unroll
          for (int i = 0; i < 16; ++i) { const int pz = tid + NTHREADS * i; *(LAS f32x4*)(hs + (pz >> 4) * hy::FILT_RS + 4 * (pz & 15)) = src[pz]; } }
        __syncthreads();
        hy::filter_item(a, it0 + wave, lane, (const LAS float*)lds);
    }
    float* b1r = (float*)(a.ws + WS_B1R); const float* eb1 = a.in[I_EB1];
    for (int i = blockIdx.x * NTHREADS + tid; i < NE * 2048; i += gridDim.x * NTHREADS) {
        const int e = i >> 11, n = i & 2047, ct = n >> 8, s = (n >> 7) & 1, jj = n & 127;
        b1r[i] = eb1[(size_t)e * 2048 + 2 * (128 * ct + jj) + s];
    }
}

namespace gla {
constexpr int RS = 72;
constexpr int L_TOTF = 0, L_TOTB = 2048, L_SSQ = 4096;
constexpr int L_T0 = 8192;
constexpr int L_T1 = L_T0 + 9216, L_T2 = L_T1 + 9216, L_T3 = L_T2 + 9216;
constexpr int L_VT = L_T3 + 9216;
constexpr int L_P  = L_VT + 18432;
constexpr int L_SF = L_P + 9216, L_SB = L_SF + 18432;
constexpr int L_END = L_SB + 18432;

__device__ __forceinline__ bf16x8 frag(const LAS unsigned char* tile, int row, int k0, int lane) {
    return *(const LAS bf16x8*)(tile + ((row + (lane & 15)) * RS + k0 + 8 * (lane >> 4)) * 2);
}
__device__ __forceinline__ void chunk_cums_pre(LAS unsigned char* L, const float (&gf)[8], const float (&gb)[8], int wave, int lane, float (&cumf)[8], float (&cumb)[8], float& allf, float& allb) {
    LAS float* totf = (LAS float*)(L + L_TOTF); LAS float* totb = (LAS float*)(L + L_TOTB);
    cumf[0] = gf[0];
#pragma unroll
    for (int r = 1; r < 8; ++r) cumf[r] = cumf[r - 1] + gf[r];
    cumb[7] = gb[7];
#pragma unroll
    for (int r = 6; r >= 0; --r) cumb[r] = cumb[r + 1] + gb[r];
    totf[wave * 64 + lane] = cumf[7]; totb[wave * 64 + lane] = cumb[0];
    __syncthreads();
    float of = 0.f, ob = 0.f, af = 0.f, ab = 0.f;
#pragma unroll
    for (int w = 0; w < 8; ++w) { const float tf = totf[w * 64 + lane], tb = totb[w * 64 + lane]; af += tf; ab += tb; of += (w < wave) ? tf : 0.f; ob += (w > wave) ? tb : 0.f; }
#pragma unroll
    for (int r = 0; r < 8; ++r) { cumf[r] += of; cumb[r] += ob; }
    allf = af; allb = ab;
}
__device__ __forceinline__ void chunk_cums(LAS unsigned char* L, const _Float16* GF, const _Float16* GB, size_t tok0, int h, int wave, int lane, float (&cumf)[8], float (&cumb)[8], float& allf, float& allb) {
    float gf[8], gb[8];
#pragma unroll
    for (int r = 0; r < 8; ++r) { const size_t o = (tok0 + 8 * wave + r) * 256 + h * 64 + lane; gf[r] = (float)GF[o]; gb[r] = (float)GB[o]; }
    chunk_cums_pre(L, gf, gb, wave, lane, cumf, cumb, allf, allb);
}
__device__ __forceinline__ void store_vt(LAS unsigned char* L, const u32x4 (&vr)[2], int tid) {
    LAS bf16_t* vt = (LAS bf16_t*)(L + L_VT);
    const int j = tid >> 3, c8 = tid & 7;
#pragma unroll
    for (int q = 0; q < 2; ++q) { const int dv0 = 8 * (c8 + 8 * q);
        const unsigned ww[4] = {vr[q].x, vr[q].y, vr[q].z, vr[q].w};
#pragma unroll
        for (int e = 0; e < 4; ++e) { vt[(dv0 + 2 * e) * RS + j] = (bf16_t)(ww[e] & 0xffffu); vt[(dv0 + 2 * e + 1) * RS + j] = (bf16_t)(ww[e] >> 16); } }
}
__device__ __forceinline__ void load_vt(LAS unsigned char* L, const bf16_t* V, size_t tok0, int h, int tid) {
    const int j = tid >> 3, c8 = tid & 7; u32x4 vr[2];
#pragma unroll
    for (int q = 0; q < 2; ++q) vr[q] = *(const u32x4*)(V + (tok0 + j) * 512 + h * 128 + 8 * (c8 + 8 * q));
    store_vt(L, vr, tid);
}

__device__ __forceinline__ void g1_unit(const Args& a, LAS unsigned char* L, int bh, int chunk  ) {
    const int tid = threadIdx.x, lane = tid & 63, wave = __builtin_amdgcn_readfirstlane(tid >> 6);
    const int b = bh >> 2, h = bh & 3;
    const size_t tok0 = chunk < NCHUNK ? (size_t)b * SEQ + (size_t)chunk * CH : (size_t)T + (size_t)b * CTXL + (size_t)(chunk - NCHUNK) * CH;
    const _Float16* GF = (const _Float16*)(a.ws + WS_GF); const _Float16* GB = (const _Float16*)(a.ws + WS_GB);
    const bf16_t* Kb = (const bf16_t*)(a.ws + WS_K); const bf16_t* Vb = (const bf16_t*)(a.ws + WS_V);
    float cumf[8], cumb[8], allf, allb;
    __syncthreads();
    chunk_cums(L, GF, GB, tok0, h, wave, lane, cumf, cumb, allf, allb);
    LAS bf16_t* ketf = (LAS bf16_t*)(L + L_T0); LAS bf16_t* ketb = (LAS bf16_t*)(L + L_T1);
#pragma unroll
    for (int r = 0; r < 8; ++r) { const int i = 8 * wave + r; const float kv = bf2f(Kb[(tok0 + i) * 256 + h * 64 + lane]);
        ketf[lane * RS + i] = f2bf(kv * __expf(allf - cumf[r])); ketb[lane * RS + i] = f2bf(kv * __expf(allb - cumb[r])); }
    load_vt(L, Vb, tok0, h, tid);
    if (wave == 0) { float* av = (float*)(a.ws + WS_AV); av[((size_t)(0 * 16 + bh) * NCT + chunk) * 64 + lane] = __expf(allf); av[((size_t)(1 * 16 + bh) * NCT + chunk) * 64 + lane] = __expf(allb); }
    __syncthreads();
    bf16_t* KV = (bf16_t*)(a.ws + WS_KV);
#pragma unroll
    for (int dir = 0; dir < 2; ++dir) {
        const LAS unsigned char* ket = L + (dir ? L_T1 : L_T0);
        bf16_t* dst = KV + ((size_t)(dir * 16 + bh) * NCT + chunk) * 8192;
#pragma unroll
        for (int nt = 0; nt < 4; ++nt) { f32x4 acc = {0.f, 0.f, 0.f, 0.f};
#pragma unroll
            for (int ks = 0; ks < 2; ++ks) acc = __builtin_amdgcn_mfma_f32_16x16x32_bf16(frag(ket, 16 * nt, 32 * ks, lane), frag(L + L_VT, 16 * wave, 32 * ks, lane), acc, 0, 0, 0);
            u32x2 w; w.x = pk2(acc[0], acc[1]); w.y = pk2(acc[2], acc[3]);
            *(u32x2*)(dst + (16 * wave + (lane & 15)) * 64 + 16 * nt + 4 * (lane >> 4)) = w; }
    }
}

__device__ __forceinline__ void g2_scan(const Args& a, LAS unsigned char* L) {
    const bf16_t* KV = (const bf16_t*)(a.ws + WS_KV); const float* AV = (const float*)(a.ws + WS_AV); bf16_t* SP = (bf16_t*)(a.ws + WS_SP);
    LAS float* avs = (LAS float*)L;
    for (int id0 = blockIdx.x * NTHREADS; id0 < 32 * 4096; id0 += gridDim.x * NTHREADS) {
        const int id = id0 + threadIdx.x;
        const int db = id >> 12, e2 = id & 4095, dir = db >> 4, dk = (2 * e2) & 63;
        __syncthreads();
        for (int i = threadIdx.x; i < NCT * 64 / 4; i += NTHREADS) ((LAS f32x4*)avs)[i] = ((const f32x4*)(AV + (size_t)db * NCT * 64))[i];
        __syncthreads();
        const unsigned* kv = (const unsigned*)(KV + (size_t)db * NCT * 8192) + e2;
        const LAS float* av = avs + dk;
        unsigned* sp = (unsigned*)(SP + (size_t)db * NCHUNK * 8192) + e2;
        float s0 = 0.f, s1 = 0.f;
#pragma unroll
        for (int q = 0; q < NCC; ++q) { const int c = NCHUNK + (dir ? (NCC - 1 - q) : q);
            const unsigned w = kv[(size_t)c * 4096]; const f32x2 aa = *(const LAS f32x2*)(av + c * 64);
            s0 = aa[0] * s0 + bflo(w); s1 = aa[1] * s1 + bfhi(w); }
        for (int q0 = 0; q0 < NCHUNK; q0 += 16) {
            unsigned w[16];
#pragma unroll
            for (int u = 0; u < 16; ++u) { const int c = dir ? (NCHUNK - 1 - (q0 + u)) : (q0 + u); w[u] = kv[(size_t)c * 4096]; }
#pragma unroll
            for (int u = 0; u < 16; ++u) { const int c = dir ? (NCHUNK - 1 - (q0 + u)) : (q0 + u);
                const f32x2 aa = *(const LAS f32x2*)(av + c * 64);
                sp[(size_t)c * 4096] = pk2(s0, s1);
                s0 = aa[0] * s0 + bflo(w[u]); s1 = aa[1] * s1 + bfhi(w[u]); }
        }
    }
}

struct G3In { float gf[8], gb[8]; bf16_t q[8], k[8]; u32x4 v[2]; u32x4 sraw[4]; u32x2 gr[4]; };
__device__ __forceinline__ void g3_load(const Args& a, int bh, int chunk, G3In& in) {
    const int tid = threadIdx.x, lane = tid & 63, wave = __builtin_amdgcn_readfirstlane(tid >> 6);
    const int b = bh >> 2, h = bh & 3;
    const size_t tok0 = (size_t)b * SEQ + (size_t)chunk * CH;
    const _Float16* GF = (const _Float16*)(a.ws + WS_GF); const _Float16* GB = (const _Float16*)(a.ws + WS_GB);
    const bf16_t* Qb = (const bf16_t*)(a.ws + WS_Q); const bf16_t* Kb = (const bf16_t*)(a.ws + WS_K); const bf16_t* Vb = (const bf16_t*)(a.ws + WS_V);
#pragma unroll
    for (int r = 0; r < 8; ++r) { const size_t o = (tok0 + 8 * wave + r) * 256 + h * 64 + lane; in.gf[r] = (float)GF[o]; in.gb[r] = (float)GB[o]; in.q[r] = Qb[o]; in.k[r] = Kb[o]; }
#pragma unroll
    for (int q = 0; q < 2; ++q) in.v[q] = *(const u32x4*)(Vb + (tok0 + (tid >> 3)) * 512 + h * 128 + 8 * ((tid & 7) + 8 * q));
    const bf16_t* SPf = (const bf16_t*)(a.ws + WS_SP) + ((size_t)(0 * 16 + bh) * NCHUNK + chunk) * 8192;
    const bf16_t* SPb = (const bf16_t*)(a.ws + WS_SP) + ((size_t)(1 * 16 + bh) * NCHUNK + chunk) * 8192;
    in.sraw[0] = *(const u32x4*)(SPf + 16 * tid); in.sraw[1] = *(const u32x4*)(SPf + 16 * tid + 8);
    in.sraw[2] = *(const u32x4*)(SPb + 16 * tid); in.sraw[3] = *(const u32x4*)(SPb + 16 * tid + 8);
    const bf16_t* Gt = (const bf16_t*)(a.ws + WS_G);
    const int mt = wave >> 1, fr = lane & 15, fq = lane >> 4;
#pragma unroll
    for (int q = 0; q < 4; ++q) in.gr[q] = *(const u32x2*)(Gt + (tok0 + 16 * mt + fr) * 512 + h * 128 + 16 * (4 * (wave & 1) + q) + 4 * fq);
}
__device__ __forceinline__ void g3_unit(const Args& a, LAS unsigned char* L, int bh, int chunk  , const G3In& in) {
    const int tid = threadIdx.x, lane = tid & 63, wave = __builtin_amdgcn_readfirstlane(tid >> 6);
    const int b = bh >> 2, h = bh & 3;
    const size_t tok0 = (size_t)b * SEQ + (size_t)chunk * CH;
    const int mt = wave >> 1, fr = lane & 15, fq = lane >> 4;
    float cumf[8], cumb[8], allf, allb;
    __syncthreads();
    chunk_cums_pre(L, in.gf, in.gb, wave, lane, cumf, cumb, allf, allb);
    LAS bf16_t* qf = (LAS bf16_t*)(L + L_T0); LAS bf16_t* kf = (LAS bf16_t*)(L + L_T1); LAS bf16_t* qb = (LAS bf16_t*)(L + L_T2); LAS bf16_t* kb = (LAS bf16_t*)(L + L_T3);
#pragma unroll
    for (int r = 0; r < 8; ++r) { const int i = 8 * wave + r;
        const float qv = bf2f(in.q[r]), kv = bf2f(in.k[r]);
        qf[i * RS + lane] = f2bf(qv * __expf(cumf[r])); kf[i * RS + lane] = f2bf(kv * __expf(-cumf[r]));
        qb[i * RS + lane] = f2bf(qv * __expf(cumb[r])); kb[i * RS + lane] = f2bf(kv * __expf(-cumb[r])); }
    store_vt(L, in.v, tid);
    {
      LAS unsigned char* sf_ = L + L_SF + ((tid >> 2) * RS + 16 * (tid & 3)) * 2; LAS unsigned char* sb_ = L + L_SB + ((tid >> 2) * RS + 16 * (tid & 3)) * 2;
      *(LAS u32x4*)sf_ = in.sraw[0]; *(LAS u32x4*)(sf_ + 16) = in.sraw[1]; *(LAS u32x4*)sb_ = in.sraw[2]; *(LAS u32x4*)(sb_ + 16) = in.sraw[3]; }
    __syncthreads();
    {
        LAS bf16_t* P = (LAS bf16_t*)(L + L_P);
#pragma unroll
        for (int q = 0; q < 2; ++q) { const int nt = 2 * (wave & 1) + q;
            f32x4 sf = {0.f, 0.f, 0.f, 0.f}, sb = {0.f, 0.f, 0.f, 0.f};
#pragma unroll
            for (int ks = 0; ks < 2; ++ks) {
                sf = __builtin_amdgcn_mfma_f32_16x16x32_bf16(frag(L + L_T0, 16 * mt, 32 * ks, lane), frag(L + L_T1, 16 * nt, 32 * ks, lane), sf, 0, 0, 0);
                sb = __builtin_amdgcn_mfma_f32_16x16x32_bf16(frag(L + L_T2, 16 * mt, 32 * ks, lane), frag(L + L_T3, 16 * nt, 32 * ks, lane), sb, 0, 0, 0); }
#pragma unroll
            for (int r = 0; r < 4; ++r) { const int i = 16 * mt + 4 * fq + r, j = 16 * nt + fr;
                P[i * RS + j] = f2bf((j <= i ? sf[r] : 0.f) + (j >= i ? sb[r] : 0.f)); } }
    }
    __syncthreads();
    f32x4 o[4]; float ssq = 0.f;
#pragma unroll
    for (int q = 0; q < 4; ++q) { const int nt = 4 * (wave & 1) + q;
        f32x4 acc = {0.f, 0.f, 0.f, 0.f};
#pragma unroll
        for (int ks = 0; ks < 2; ++ks) {
            acc = __builtin_amdgcn_mfma_f32_16x16x32_bf16(frag(L + L_VT, 16 * nt, 32 * ks, lane), frag(L + L_P, 16 * mt, 32 * ks, lane), acc, 0, 0, 0);
            acc = __builtin_amdgcn_mfma_f32_16x16x32_bf16(frag(L + L_SF, 16 * nt, 32 * ks, lane), frag(L + L_T0, 16 * mt, 32 * ks, lane), acc, 0, 0, 0);
            acc = __builtin_amdgcn_mfma_f32_16x16x32_bf16(frag(L + L_SB, 16 * nt, 32 * ks, lane), frag(L + L_T2, 16 * mt, 32 * ks, lane), acc, 0, 0, 0); }
        o[q] = acc;
        ssq += (acc[0] * acc[0] + acc[1] * acc[1]) + (acc[2] * acc[2] + acc[3] * acc[3]); }
    LAS float* SSQ = (LAS float*)(L + L_SSQ);
    ssq += __shfl_xor(ssq, 16); ssq += __shfl_xor(ssq, 32);
    if (fq == 0) SSQ[(wave & 1) * 64 + 16 * mt + fr] = ssq;
    __syncthreads();
    const float* ng = a.in[I_NORMG];
    bf16_t* mix = (bf16_t*)(a.ws + WS_MIX);
    { const int i = 16 * mt + fr;
      const float rstd = 1.f / sqrtf((SSQ[i] + SSQ[64 + i]) * (1.f / DV) + LN_EPS);
#pragma unroll
      for (int q = 0; q < 4; ++q) { const int dv0 = 16 * (4 * (wave & 1) + q) + 4 * fq;
          const f32x4 gn = *(const f32x4*)(ng + dv0); const u32x2 gw = in.gr[q];
          const float g0 = bflo(gw.x), g1 = bfhi(gw.x), g2 = bflo(gw.y), g3 = bfhi(gw.y);
          u32x2 w; w.x = pk2(o[q][0] * rstd * gn[0] * silu_f(g0), o[q][1] * rstd * gn[1] * silu_f(g1)); w.y = pk2(o[q][2] * rstd * gn[2] * silu_f(g2), o[q][3] * rstd * gn[3] * silu_f(g3));
          *(u32x2*)(mix + (tok0 + i) * 1024 + h * 128 + dv0) = w; } }
}
}

namespace rt {
constexpr int HS = 1028;
constexpr int L_H2 = 0;
constexpr int L_PART = 65792;
constexpr int L_LCNT = L_PART + 16384;
constexpr int L_REC = L_LCNT + 256;
constexpr int L_TAB = 86016;

__device__ __forceinline__ void phase(const Args& a, LAS unsigned char* lds) {
    const int tid = threadIdx.x, lane = tid & 63, wave = __builtin_amdgcn_readfirstlane(tid >> 6);
    bf16_t* xmid = (bf16_t*)(a.ws + WS_PRE1); bf16_t* H2 = (bf16_t*)(a.ws + WS_H2); const bf16_t* FG = (const bf16_t*)(a.ws + WS_FG);
    const float* mod = (const float*)(a.ws + WS_MOD);
    const float* rw = a.in[I_RW]; const float* rb = a.in[I_RB];
    LAS float* h2s = (LAS float*)(lds + L_H2); LAS float* part = (LAS float*)(lds + L_PART);
    LAS int* lcnt = (LAS int*)(lds + L_LCNT); LAS int* lbase = lcnt + 32; LAS int* rec = (LAS int*)(lds + L_REC);
    unsigned* cnt = (unsigned*)(a.ws + WS_CNT); int* list = (int*)(a.ws + WS_LIST); float* pw = (float*)(a.ws + WS_PW); int* ploc = (int*)(a.ws + WS_PLOC);
    bf16x8 rwh[4][2], rwl[4][2];
#pragma unroll
    for (int s = 0; s < 4; ++s)
#pragma unroll
        for (int nt = 0; nt < 2; ++nt)
#pragma unroll
            for (int i = 0; i < 8; ++i) { const float x = rw[(size_t)(128 * wave + 32 * s + 8 * (lane >> 4) + i) * 32 + 16 * nt + (lane & 15)];
                const unsigned hb = __float_as_uint(x) & 0xffff0000u; rwh[s][nt][i] = (short)(hb >> 16); rwl[s][nt][i] = (short)f2bf(x - __uint_as_float(hb)); }
    LAS f32x4* g1 = (LAS f32x4*)(lds + L_TAB); LAS f32x4* bb1 = g1 + 256; LAS f32x4* shT = bb1 + 256; LAS f32x4* scT = shT + 4 * 256;
    if (tid < 256) { g1[tid] = ((const f32x4*)a.in[I_LN1G])[tid]; bb1[tid] = ((const f32x4*)a.in[I_LN1B])[tid]; }
    for (int i = tid; i < 4 * 256; i += NTHREADS) { shT[i] = ((const f32x4*)(mod + (i >> 8) * 6144 + 3 * 1024))[i & 255]; scT[i] = ((const f32x4*)(mod + (i >> 8) * 6144 + 4 * 1024))[i & 255]; }
    const float rbe = rb[lane & 31];
    if (tid < 32) lcnt[tid] = 0;
    int pend = 0, pgrp = -1;
    f32x4 xq[2][4]; u32x2 fq_[2][4];
#define RT_LOAD(g_) do { _Pragma("unroll") for (int rr = 0; rr < 2; ++rr) { const int t_ = (g_) * 16 + 2 * wave + rr; \
        const f32x4* xr_ = (const f32x4*)(a.in[I_X] + (size_t)t_ * D) + lane; const u32x2* fr_ = (const u32x2*)(FG + (size_t)t_ * D) + lane; \
        _Pragma("unroll") for (int j = 0; j < 4; ++j) { xq[rr][j] = xr_[64 * j]; fq_[rr][j] = fr_[64 * j]; } } } while (0)
    if ((int)blockIdx.x < T / 16) RT_LOAD((int)blockIdx.x);
    for (int grp = blockIdx.x; grp < T / 16; grp += gridDim.x) {
        __syncthreads();
        f32x4 xv_[2][4]; u32x2 fv_[2][4];
#pragma unroll
        for (int rr = 0; rr < 2; ++rr)
#pragma unroll
            for (int j = 0; j < 4; ++j) { xv_[rr][j] = xq[rr][j]; fv_[rr][j] = fq_[rr][j]; }
        if (pgrp >= 0) { if (tid < 32) lbase[tid] = pend; __syncthreads();
            if (tid < 64) { const int rc = rec[tid], ek = rc & 255, rank = rc >> 8, pos = lbase[ek] + rank, pair = (pgrp * 16 + (tid >> 2)) * 4 + (tid & 3);
                list[(size_t)ek * CAP + pos] = pair; ploc[pair] = ek | (pos << 5); } }
        if (grp + (int)gridDim.x < T / 16) RT_LOAD(grp + (int)gridDim.x);
#pragma unroll
        for (int rr = 0; rr < 2; ++rr) {
            const int lr = 2 * wave + rr, t = grp * 16 + lr, b = t >> 13;
            u32x2* pr = (u32x2*)(xmid + (size_t)t * D) + lane;
            f32x4 v[4]; float s = 0.f;
#pragma unroll
            for (int j = 0; j < 4; ++j) { const u32x2 fw = fv_[rr][j]; const f32x4 ff = {bflo(fw.x), bfhi(fw.x), bflo(fw.y), bfhi(fw.y)};
                v[j] = xv_[rr][j] * ALPHA + ff; s += (v[j][0] + v[j][1]) + (v[j][2] + v[j][3]); }
            float mean = wave_sum(s) * (1.f / D), s2 = 0.f;
#pragma unroll
            for (int j = 0; j < 4; ++j) { v[j] = v[j] - mean; s2 += (v[j][0] * v[j][0] + v[j][1] * v[j][1]) + (v[j][2] * v[j][2] + v[j][3] * v[j][3]); }
            float rstd = 1.f / sqrtf(wave_sum(s2) * (1.f / D) + LN_EPS);
            s = 0.f;
#pragma unroll
            for (int j = 0; j < 4; ++j) { v[j] = v[j] * rstd * g1[64 * j + lane] + bb1[64 * j + lane]; u32x2 w; w.x = pk2(v[j][0], v[j][1]); w.y = pk2(v[j][2], v[j][3]); pr[64 * j] = w;
                v[j] = (f32x4){bflo(w.x), bfhi(w.x), bflo(w.y), bfhi(w.y)}; s += (v[j][0] + v[j][1]) + (v[j][2] + v[j][3]); }
            mean = wave_sum(s) * (1.f / D); s2 = 0.f;
#pragma unroll
            for (int j = 0; j < 4; ++j) { v[j] = v[j] - mean; s2 += (v[j][0] * v[j][0] + v[j][1] * v[j][1]) + (v[j][2] * v[j][2] + v[j][3] * v[j][3]); }
            rstd = 1.f / sqrtf(wave_sum(s2) * (1.f / D) + LN_EPS);
            const LAS f32x4* sh = shT + b * 256; const LAS f32x4* sc = scT + b * 256;
            unsigned* o4 = (unsigned*)((unsigned char*)H2 + (size_t)t * D) + lane;
#pragma unroll
            for (int j = 0; j < 4; ++j) { const f32x4 y = v[j] * rstd * (sc[64 * j + lane] + 1.f) + sh[64 * j + lane];
                o4[64 * j] = gm::pk4_fp8(y[0] * gm::S_H2, y[1] * gm::S_H2, y[2] * gm::S_H2, y[3] * gm::S_H2);
                *(LAS f32x4*)(h2s + lr * HS + 256 * j + 4 * lane) = y; }
        }
        __syncthreads();
        {
            f32x4 acc0 = {0.f, 0.f, 0.f, 0.f}, acc1 = {0.f, 0.f, 0.f, 0.f};
            const LAS float* ap = h2s + (lane & 15) * HS + 128 * wave + 8 * (lane >> 4);
#pragma unroll
            for (int s = 0; s < 4; ++s) { const f32x4 x0 = *(const LAS f32x4*)(ap + 32 * s), x1 = *(const LAS f32x4*)(ap + 32 * s + 4);
                bf16x8 ah, al;
#pragma unroll
                for (int i = 0; i < 8; ++i) { const float x = i < 4 ? x0[i] : x1[i - 4]; const unsigned hb = __float_as_uint(x) & 0xffff0000u; ah[i] = (short)(hb >> 16); al[i] = (short)f2bf(x - __uint_as_float(hb)); }
                acc0 = __builtin_amdgcn_mfma_f32_16x16x32_bf16(ah, rwh[s][0], acc0, 0, 0, 0); acc1 = __builtin_amdgcn_mfma_f32_16x16x32_bf16(ah, rwh[s][1], acc1, 0, 0, 0);
                acc0 = __builtin_amdgcn_mfma_f32_16x16x32_bf16(ah, rwl[s][0], acc0, 0, 0, 0); acc1 = __builtin_amdgcn_mfma_f32_16x16x32_bf16(ah, rwl[s][1], acc1, 0, 0, 0);
                acc0 = __builtin_amdgcn_mfma_f32_16x16x32_bf16(al, rwh[s][0], acc0, 0, 0, 0); acc1 = __builtin_amdgcn_mfma_f32_16x16x32_bf16(al, rwh[s][1], acc1, 0, 0, 0); }
#pragma unroll
            for (int r = 0; r < 4; ++r) { part[(wave * 16 + 4 * (lane >> 4) + r) * 32 + (lane & 15)] = acc0[r]; part[(wave * 16 + 4 * (lane >> 4) + r) * 32 + 16 + (lane & 15)] = acc1[r]; }
        }
        __syncthreads();
        {
            const int lr = 2 * wave + (lane >> 5), e = lane & 31, t = grp * 16 + lr;
            float lg = rbe;
#pragma unroll
            for (int w = 0; w < 8; ++w) lg += part[(w * 16 + lr) * 32 + e];
            float cur = lg, tv[4]; int ti[4];
#pragma unroll
            for (int k = 0; k < 4; ++k) { float bv = cur; int bi = e;
#pragma unroll
                for (int o = 1; o < 32; o <<= 1) { const float ov = __shfl_xor(bv, o); const int oi = __shfl_xor(bi, o); if (ov > bv || (ov == bv && oi < bi)) { bv = ov; bi = oi; } }
                tv[k] = bv; ti[k] = bi; if (bi == e) cur = -3.0e38f; }
            const float e1 = __expf(tv[1] - tv[0]), e2 = __expf(tv[2] - tv[0]), e3 = __expf(tv[3] - tv[0]);
            const float inv = 1.f / (1.f + e1 + e2 + e3);
            if (e < 4) { const float wk = (e == 0 ? 1.f : (e == 1 ? e1 : (e == 2 ? e2 : e3))) * inv; const int ek = (e == 0 ? ti[0] : (e == 1 ? ti[1] : (e == 2 ? ti[2] : ti[3])));
                const int pair = t * 4 + e;
                pw[pair] = wk;
                const int rank = __hip_atomic_fetch_add((LAS int*)&lcnt[ek], 1, __ATOMIC_RELAXED, __HIP_MEMORY_SCOPE_WORKGROUP);
                rec[lr * 4 + e] = ek | (rank << 8); }
        }
        __syncthreads();
        if (tid < 32) { const int n = lcnt[tid]; pend = n ? (int)atomicAdd(&cnt[tid], (unsigned)n) : 0; lcnt[tid] = 0; }
        pgrp = grp;
    }
    if (pgrp >= 0) { __syncthreads(); if (tid < 32) lbase[tid] = pend; __syncthreads();
        if (tid < 64) { const int rc = rec[tid], ek = rc & 255, rank = rc >> 8, pos = lbase[ek] + rank, pair = (pgrp * 16 + (tid >> 2)) * 4 + (tid & 3);
            list[(size_t)ek * CAP + pos] = pair; ploc[pair] = ek | (pos << 5); } }
#undef RT_LOAD
}
}

__device__ __forceinline__ void p_final(const Args& a, LAS unsigned char* lds) {
    const int tid = threadIdx.x, lane = tid & 63, wave = tid >> 6;
    const bf16_t* xm = (const bf16_t*)(a.ws + WS_PRE1); const unsigned char* slots = (const unsigned char*)(a.ws + WS_SLOTS); const float* mod = (const float*)(a.ws + WS_MOD);
    const int* ploc = (const int*)(a.ws + WS_PLOC); const float* pw = (const float*)(a.ws + WS_PW);
    const f32x4* g2 = (const f32x4*)a.in[I_LN2G]; const f32x4* b2 = (const f32x4*)a.in[I_LN2B];
    LAS int* tstart = (LAS int*)lds;
    __syncthreads();
    if (tid == 0) { const unsigned* cnt = (const unsigned*)(a.ws + WS_CNT); int nrt = 0; for (int e = 0; e < NE; ++e) { tstart[e] = 256 * nrt; nrt += ((int)cnt[e] + 255) >> 8; } }
    LAS f32x4* Lg2 = (LAS f32x4*)(lds + 1024); LAS f32x4* Lb2 = Lg2 + 256; LAS f32x4* Lgt = Lb2 + 256;
    if (tid < 256) { Lg2[tid] = g2[tid]; Lb2[tid] = b2[tid]; }
    for (int i = tid; i < 4 * 256; i += NTHREADS) Lgt[i] = ((const f32x4*)(mod + (i >> 8) * 6144 + 5 * 1024))[i & 255];
    __syncthreads();
    const int tstep = gridDim.x * NWAVES; int t = blockIdx.x * NWAVES + wave;
    if (t < T) {
        int plc[4], pln[4]; float wc_[4], wn_[4]; unsigned qc[4][4], qn[4][4]; u32x2 xc[4], xn[4];
#define PF_IDX(tt, pl, ww) do { _Pragma("unroll") for (int sl = 0; sl < 4; ++sl) { pl[sl] = ploc[(tt) * 4 + sl]; ww[sl] = pw[(tt) * 4 + sl] * (1.f / gm::S_SL); } } while (0)
#define PF_DATA(tt, pl, qq, xx) do { _Pragma("unroll") for (int sl = 0; sl < 4; ++sl) { const unsigned* sr_ = (const unsigned*)(slots + (size_t)(tstart[pl[sl] & 31] + (pl[sl] >> 5)) * D) + lane; \
            _Pragma("unroll") for (int j = 0; j < 4; ++j) qq[sl][j] = sr_[64 * j]; } \
        { const u32x2* xr_ = (const u32x2*)(xm + (size_t)(tt) * D) + lane; _Pragma("unroll") for (int j = 0; j < 4; ++j) xx[j] = xr_[64 * j]; } } while (0)
        PF_IDX(t, plc, wc_); PF_DATA(t, plc, qc, xc);
        int tn = t + tstep; const bool hn0 = tn < T;
        if (hn0) PF_IDX(tn, pln, wn_);
        for (;;) {
            const bool hn = tn < T;
            if (hn) PF_DATA(tn, pln, qn, xn);
            int pl2[4]; float w2[4]; const int tn2 = tn + tstep; const bool hn2 = hn && tn2 < T;
            if (hn2) PF_IDX(tn2, pl2, w2);
            {
                const int b = t >> 13; const LAS f32x4* gt = Lgt + b * 256;
                f32x4 v[4]; float s = 0.f;
#pragma unroll
                for (int j = 0; j < 4; ++j) { f32x4 y = {0.f, 0.f, 0.f, 0.f};
#pragma unroll
                    for (int sl = 0; sl < 4; ++sl) { const int q = (int)qc[sl][j];
                        const f32x2 lo_ = __builtin_amdgcn_cvt_pk_f32_fp8(q, false) * wc_[sl], hi_ = __builtin_amdgcn_cvt_pk_f32_fp8(q, true) * wc_[sl]; y[0] += lo_[0]; y[1] += lo_[1]; y[2] += hi_[0]; y[3] += hi_[1]; }
                    const f32x4 xv = {bflo(xc[j].x), bfhi(xc[j].x), bflo(xc[j].y), bfhi(xc[j].y)};
                    v[j] = xv * ALPHA + gt[64 * j + lane] * y; s += (v[j][0] + v[j][1]) + (v[j][2] + v[j][3]); }
                const float mean = wave_sum(s) * (1.f / D); float s2 = 0.f;
#pragma unroll
                for (int j = 0; j < 4; ++j) { v[j] = v[j] - mean; s2 += (v[j][0] * v[j][0] + v[j][1] * v[j][1]) + (v[j][2] * v[j][2] + v[j][3] * v[j][3]); }
                const float rstd = 1.f / sqrtf(wave_sum(s2) * (1.f / D) + LN_EPS);
                f32x4* o = (f32x4*)(a.out + (size_t)t * D) + lane;
#pragma unroll
                for (int j = 0; j < 4; ++j) o[64 * j] = v[j] * rstd * Lg2[64 * j + lane] + Lb2[64 * j + lane];
            }
            if (!hn) break;
            t = tn; tn = tn2;
#pragma unroll
            for (int sl = 0; sl < 4; ++sl) { plc[sl] = pln[sl]; wc_[sl] = wn_[sl]; pln[sl] = pl2[sl]; wn_[sl] = w2[sl];
#pragma unroll
                for (int j = 0; j < 4; ++j) qc[sl][j] = qn[sl][j]; }
#pragma unroll
            for (int j = 0; j < 4; ++j) xc[j] = xn[j];
        }
#undef PF_IDX
#undef PF_DATA
    }
}


constexpr int N_PHASES = 11;
__global__ void __launch_bounds__(NTHREADS, 2) mega_fwd(Args a) {
    extern __shared__ __attribute__((aligned(16))) unsigned char lds_raw[];
    LAS unsigned char* lds = (LAS unsigned char*)lds_raw;
    const int tid = threadIdx.x;
    volatile LAS unsigned* misc = (volatile LAS unsigned*)(lds + LDS_MISC);
    if (tid < 4) misc[tid] = 0u;
    __syncthreads();
    XcdBarrier bar; bar.bar = (unsigned*)(a.ws + WS_BAR); bar.x = 0; bar.st = misc;
    const bool multi = (a.ph_hi - a.ph_lo) > 1;
    if (multi) bar = xcd_barrier_post((unsigned*)(a.ws + WS_BAR), misc);
    const int lo = a.ph_lo, hi = a.ph_hi;
#define vcu ((gridDim.x % 8 == 0) ? (int)((blockIdx.x % 8) * (gridDim.x / 8) + blockIdx.x / 8) : (int)blockIdx.x)
#ifdef ONLY_PHASE
#define IN(k) ((k) == ONLY_PHASE && lo <= (k) && (k) < hi)
#else
#define IN(k) (lo <= (k) && (k) < hi)
#endif
#define SEAM(k) do { if (IN(k) && IN((k) + 1)) xcd_barrier(bar); } while (0)

#ifndef REPEAT_PHASE
#define REPEAT_PHASE -1
#endif
#ifdef PROF_REP
#define RUNPH(k, ...) do { if (IN(k)) { const int nrep_ = (a.rep_k == (k)) ? 2 : 1; for (int rep_ = 0; rep_ < nrep_; ++rep_) { if (rep_) xcd_barrier(bar); __VA_ARGS__; } } } while (0)
#else
#define RUNPH(k, ...) do { if (IN(k)) { __VA_ARGS__; if (REPEAT_PHASE == (k)) { xcd_barrier(bar); __VA_ARGS__; } } } while (0)
#endif
    RUNPH(0, p0_mod_and_filter(a, lds));
    SEAM(0);
    RUNPH(1, p1_prep(a, lds));
    SEAM(1);
    RUNPH(2, { gm::SchedIn S{a.ws, (int)gridDim.x, vcu, a.in[I_BAF], a.in[I_BAB]}; gm::EpiIn E{a.ws}; gm::gemm_stream<false, 0, false>(lds, S, E);
        {
          const int G = (int)gridDim.x, rounds = (1812 + G - 1) / G, extra = 1812 - (rounds - 1) * G, v = vcu;
          if (v >= extra || extra == G) { const int nidle = (extra == G) ? G : G - extra, ridle = (extra == G) ? v : v - extra; __syncthreads();
              prep_items(a, (LAS float*)(lds + (tid >> 6) * 16384), PREP_NITEMS - PREP_DEFER, PREP_NITEMS, ridle * NWAVES + (tid >> 6), nidle * NWAVES, tid & 63); } } });
    SEAM(2);
    RUNPH(3, { for (int u = blockIdx.x; u < 16 * NCT; u += gridDim.x) gla::g1_unit(a, lds, u / NCT, u % NCT); });
    SEAM(3);
    RUNPH(4, { gla::g2_scan(a, lds);
        hy::CvState cvs; cvs.jb.mi = -1; cvs.next = (int)blockIdx.x * NWAVES + (tid >> 6); cvs.stride = (int)gridDim.x * NWAVES; cvs.end = hy::CV_ITEMS;
        for (int c = blockIdx.x; c < HYW; c += gridDim.x) hy::channel(a, lds, c, a.ws + WS_HSPEC + (size_t)blockIdx.x * HSPEC_PER_WG, cvs);
        while (cvs.jb.mi >= 0 || cvs.next < cvs.end) hy::cv_step(a, cvs, tid & 63); });
    SEAM(4);
    RUNPH(5, { { int u = blockIdx.x; gla::G3In cur, nxt;
            if (u < 16 * NCHUNK) { gla::g3_load(a, u >> 7, u & 127, cur);
                for (;;) { const int un = u + (int)gridDim.x; const bool hn = un < 16 * NCHUNK; if (hn) gla::g3_load(a, un >> 7, un & 127, nxt);
                    gla::g3_unit(a, lds, u >> 7, u & 127, cur); if (!hn) break; cur = nxt; u = un; } } }
        const int wave = tid >> 6;
        for (int it = blockIdx.x * NWAVES + wave; it < 4096; it += gridDim.x * NWAVES) hy::transpose_item(a, it, tid & 63); });
    SEAM(5);
    RUNPH(6, { gm::SchedOut S{a.ws, (int)gridDim.x, vcu}; gm::EpiOut E{a.ws}; gm::gemm_stream<false, 0, false>(lds, S, E); });
    SEAM(6);
    RUNPH(7, rt::phase(a, lds));
    SEAM(7);
    if (IN(8) || IN(9)) {
        LAS int* tab = (LAS int*)(lds + gm::LDS_TAB);
        __syncthreads();
        if (tid == 0) { const unsigned* cnt = (const unsigned*)(a.ws + WS_CNT); int nrt = 0;
            for (int e = 0; e < NE; ++e) { const int n = (int)cnt[e]; tab[e] = n; const int nt = (n + 255) >> 8; for (int k = 0; k < nt; ++k) tab[64 + nrt + k] = e | (k << 8); nrt += nt; }
            tab[32] = nrt; }
        __syncthreads();
    }
    RUNPH(8, { gm::SchedMoe<1> S{a.ws, (const LAS int*)(lds + gm::LDS_TAB), (int)gridDim.x, vcu, a.in[I_EB2]}; gm::EpiMoe1 E{a.ws}; gm::gemm_stream<true, 2, true>(lds, S, E); });
    SEAM(8);
    RUNPH(9, { gm::SchedMoe<2> S{a.ws, (const LAS int*)(lds + gm::LDS_TAB), (int)gridDim.x, vcu, a.in[I_EB2]}; gm::EpiMoe2 E{a.ws}; gm::gemm_stream<false, 0, true>(lds, S, E); });
    SEAM(9);
    RUNPH(10, p_final(a, lds));
#undef RUNPH
#undef vcu
#undef IN
#undef SEAM
}

extern "C" void kernel_launch(void* const* d_in, const int* in_sizes, int n_in, void* d_out, int out_size, void* d_ws, size_t ws_size, hipStream_t stream) {
    static int grid = 0;
    if (grid == 0) {
        if (n_in != 32 || out_size != T * D || ws_size < WS_END) { fprintf(stderr, "kernel_launch: unexpected shapes (n_in %d out %d ws %zu need %zu)\n", n_in, out_size, ws_size, (size_t)WS_END); grid = -1; return; }
        int dev = 0, cus = 0;
        if (hipGetDevice(&dev) != hipSuccess || hipDeviceGetAttribute(&cus, hipDeviceAttributeMultiprocessorCount, dev) != hipSuccess) { grid = -1; return; }
        if (hipFuncSetAttribute((const void*)mega_fwd, hipFuncAttributeMaxDynamicSharedMemorySize, LDS_BYTES) != hipSuccess) { fprintf(stderr, "kernel_launch: hipFuncSetAttribute failed\n"); grid = -1; return; }
        int per_cu = 0;
        if (hipOccupancyMaxActiveBlocksPerMultiprocessor(&per_cu, (const void*)mega_fwd, NTHREADS, LDS_BYTES) != hipSuccess || per_cu < 1) fprintf(stderr, "kernel_launch: occupancy query says %d\n", per_cu);
        (void)hipGetLastError();
        grid = cus;
        if (grid > MAX_GRID) grid = MAX_GRID;
    }
    if (grid < 0) return;
    (void)hipMemsetAsync(d_ws, 0, WS_ZERO_BYTES, stream);
    Args a{};
    for (int i = 0; i < 32; ++i) a.in[i] = (const float*)d_in[i];
    a.out = (float*)d_out; a.ws = (unsigned char*)d_ws;
#ifdef DBG
    (void)hipMemsetAsync((char*)d_ws + WS_DBG, 0, 512, stream);
    for (int p = 0; p < N_PHASES; ++p) { a.ph_lo = p; a.ph_hi = p + 1; hipLaunchKernelGGL(mega_fwd, dim3(grid), dim3(NTHREADS), LDS_BYTES, stream, a);
        hipLaunchKernelGGL(dbg_check, dim3(64), dim3(512), 0, stream, a, p); }
    hipLaunchKernelGGL(dbg_encode, dim3(1024), dim3(256), 0, stream, a);
#elif N_LAUNCH_PER_PHASE
    for (int p = 0; p < N_PHASES; ++p) { a.ph_lo = p; a.ph_hi = p + 1; hipLaunchKernelGGL(mega_fwd, dim3(grid), dim3(NTHREADS), LDS_BYTES, stream, a); }
#else
    a.ph_lo = 0; a.ph_hi = N_PHASES;
#ifdef PROF_REP
    a.rep_k = PROF_REP;
#endif
    hipLaunchKernelGGL(mega_fwd, dim3(grid), dim3(NTHREADS), LDS_BYTES, stream, a);
#endif
}
```

```cpp
#include <hip/hip_runtime.h>
#include <cstdio>
#include <cstdint>
#include <cstddef>

#define LAS __attribute__((address_space(3)))
#define GAS __attribute__((address_space(1)))
typedef unsigned short bf16_t;
typedef short bf16x8 __attribute__((ext_vector_type(8)));
typedef float f32x4 __attribute__((ext_vector_type(4)));
typedef float f32x2 __attribute__((ext_vector_type(2)));
typedef unsigned u32x4 __attribute__((ext_vector_type(4)));
typedef unsigned u32x2 __attribute__((ext_vector_type(2)));

#ifndef N_LAUNCH_PER_PHASE
#define N_LAUNCH_PER_PHASE 0
#endif

constexpr int D = 1024, NB = 4, SEQ = 8192, T = NB * SEQ, CTXL = 256, TC = NB * CTXL, TT = T + TC;
constexpr int NH = 4, DK = 64, DV = 128, CH = 64, NCHUNK = SEQ / CH, NCC = CTXL / CH, NCT = NCHUNK + NCC;
constexpr int HYW = 512, HYC = 3 * HYW, INW = 3104;
constexpr int NE = 32, DE = 1024, CAP = T;
constexpr float LN_EPS = 1e-6f, ALPHA = 1.189207115002721f;
constexpr int NTHREADS = 512, NWAVES = 8;
constexpr int FFTN = 16384;

constexpr size_t al256(size_t x) { return (x + 255) & ~(size_t)255; }
constexpr size_t WS_BAR   = 0;
constexpr size_t WS_MOD   = 16384;
constexpr int CNT_STRIDE = 256;
constexpr size_t WS_CNT   = WS_MOD + 5 * 6144 * 4;
constexpr size_t WS_HOA   = WS_CNT + (size_t)NE * CNT_STRIDE * 4;
constexpr size_t WS_HOB   = WS_HOA + 256;
constexpr size_t WS_HOX   = WS_HOB + 256;
constexpr size_t WS_HOXB  = WS_HOX + 16 * 256;
constexpr size_t WS_HOFA  = WS_HOXB + 16 * 256;
constexpr size_t WS_HOFB  = WS_HOFA + 16 * 256;
constexpr size_t WS_ZERO_BYTES = al256(WS_HOFB + 16 * 256);
constexpr size_t WS_LIST  = 262144;
constexpr size_t WS_PW    = WS_LIST + (size_t)NE * CAP * 4;
constexpr size_t WS_PLOC  = WS_PW + (size_t)T * 4 * 4;
constexpr size_t WS_B1R   = WS_PLOC + (size_t)T * 4 * 4;
constexpr size_t WS_HID2  = WS_B1R + (size_t)NE * 2048 * 4;
constexpr size_t WS_BTIN  = WS_HID2 + (size_t)SEQ * 64 * 4;
constexpr size_t WS_BTOUT = WS_BTIN + (size_t)3584 * 1024 * 2;
constexpr size_t WS_W1T   = WS_BTOUT + (size_t)1024 * 1024 * 2;
constexpr size_t WS_W2T   = WS_W1T + (size_t)NE * 2048 * 1024 * 2;
constexpr size_t WS_PRE1  = WS_W2T + (size_t)NE * 1024 * 1024 * 2;
constexpr size_t WS_RA    = WS_PRE1 + (size_t)T * 1024 * 4;
constexpr size_t WS_H     = WS_RA;
constexpr size_t WS_Q     = WS_H + (size_t)TT * 1024 * 2;
constexpr size_t WS_K     = WS_Q + (size_t)T * 256 * 2;
constexpr size_t WS_V     = WS_K + (size_t)TT * 256 * 2;
constexpr size_t WS_G     = WS_V + (size_t)TT * 512 * 2;
constexpr size_t WS_GF    = WS_G + (size_t)T * 512 * 2;
constexpr size_t WS_GB    = WS_GF + (size_t)TT * 256 * 4;
constexpr size_t WS_UT    = WS_GB + (size_t)TT * 256 * 4;
constexpr size_t WS_H8    = WS_UT + (size_t)NB * HYC * SEQ * 2;
constexpr size_t WS_RA_END= WS_H8 + (size_t)TT * 1024;
constexpr size_t WS_H2    = WS_RA;
constexpr size_t WS_FG    = WS_RA + (size_t)T * 1024 * 2;
constexpr size_t WS_SLOTS = WS_RA + (size_t)T * 1024;
constexpr size_t SORTED_BYTES_ = (size_t)(T * 4 / 256 + NE) * 256 * 1024 * 2;
constexpr size_t WS_RB    = al256(WS_RA_END > WS_RA + SORTED_BYTES_ ? WS_RA_END : WS_RA + SORTED_BYTES_);
constexpr size_t WS_KV    = WS_RB;
constexpr size_t WS_AV    = WS_KV + (size_t)2 * 16 * NCT * 8192 * 2;
constexpr size_t WS_SP    = WS_AV + (size_t)2 * 16 * NCT * 64 * 4;
constexpr size_t WS_HSPEC = WS_SP + (size_t)2 * 16 * NCHUNK * 8192 * 2;
constexpr size_t HSPEC_PER_WG = (size_t)2 * FFTN * 8;
constexpr int MAX_GRID = 256;
constexpr size_t WS_YHYT  = WS_HSPEC + (size_t)MAX_GRID * HSPEC_PER_WG;
constexpr size_t WS_MIX   = WS_YHYT + (size_t)NB * HYW * SEQ * 2;
constexpr size_t WS_RB_END= WS_MIX + (size_t)T * 1024 * 2;
constexpr size_t WS_HF    = WS_MIX;
constexpr size_t WS_ACT   = WS_RB;
constexpr size_t SORTED_BYTES = (size_t)(T * 4 / 256 + NE) * 256 * 1024 * 2;
constexpr size_t WS_END   = al256(WS_RB_END > WS_RB + SORTED_BYTES ? WS_RB_END : WS_RB + SORTED_BYTES);

constexpr int LDS_BYTES = 147456;
constexpr int LDS_MISC  = 145408;

typedef __bf16 bf16n2 __attribute__((ext_vector_type(2)));
__device__ __forceinline__ unsigned pk2(float lo, float hi) { bf16n2 v = {(__bf16)lo, (__bf16)hi}; return __builtin_bit_cast(unsigned, v); }
__device__ __forceinline__ bf16_t f2bf(float f) { __bf16 b = (__bf16)f; return __builtin_bit_cast(unsigned short, b); }
__device__ __forceinline__ float bf2f(bf16_t b) { return __uint_as_float(((unsigned)b) << 16); }
__device__ __forceinline__ float bflo(unsigned w) { return __uint_as_float(w << 16); }
__device__ __forceinline__ float bfhi(unsigned w) { return __uint_as_float(w & 0xffff0000u); }
template <int CTRL> __device__ __forceinline__ float dpp_f(float v) { return __builtin_bit_cast(float, __builtin_amdgcn_update_dpp(0, __builtin_bit_cast(int, v), CTRL, 0xf, 0xf, true)); }
template <int CTRL> __device__ __forceinline__ int dpp_i(int v) { return __builtin_amdgcn_update_dpp(0, v, CTRL, 0xf, 0xf, true); }
constexpr int DPP_X1 = 0xB1, DPP_X2 = 0x4E, DPP_HM = 0x141, DPP_RM = 0x140;
__device__ __forceinline__ void swap16_same(unsigned v, unsigned& a, unsigned& b) { a = v; b = v; asm("s_nop 1\n\tv_permlane16_swap_b32 %0, %1" : "+v"(a), "+v"(b)); }
__device__ __forceinline__ void swap32_same(unsigned v, unsigned& a, unsigned& b) { a = v; b = v; asm("s_nop 1\n\tv_permlane32_swap_b32 %0, %1" : "+v"(a), "+v"(b)); }
__device__ __forceinline__ float xrow16_sum(float v) { unsigned a, b; swap16_same(__builtin_bit_cast(unsigned, v), a, b); return __builtin_bit_cast(float, a) + __builtin_bit_cast(float, b); }
__device__ __forceinline__ float xrow32_sum(float v) { unsigned a, b; swap32_same(__builtin_bit_cast(unsigned, v), a, b); return __builtin_bit_cast(float, a) + __builtin_bit_cast(float, b); }
__device__ __forceinline__ float wave_sum(float v) {
    v += dpp_f<DPP_X1>(v); v += dpp_f<DPP_X2>(v); v += dpp_f<DPP_HM>(v); v += dpp_f<DPP_RM>(v);
    return xrow32_sum(xrow16_sum(v));
}
__device__ __forceinline__ float silu_f(float x) { return x * __builtin_amdgcn_rcpf(1.f + __expf(-x)); }
__device__ __forceinline__ float log_sigmoid_f(float z) { return fminf(z, 0.f) - __logf(1.f + __expf(-fabsf(z))); }

#define XB_TMO      128
#define XB_XCNT(j)  (256  + 64 * (j))
#define XB_XSUB(j)  (1280 + 64 * (j))
#define XB_XGEN(j)  (2304 + 64 * (j))
#define XB_TOP      3328
#define XB_TOPGEN   3392
#define XCD_BAR_WORDS 3456
#define XB_SPIN_CAP (1u << 22)
__device__ __forceinline__ unsigned xb_ld(unsigned* p)              { return __hip_atomic_load(p, __ATOMIC_RELAXED, __HIP_MEMORY_SCOPE_AGENT); }
__device__ __forceinline__ unsigned xb_add(unsigned* p, unsigned v) { return __hip_atomic_fetch_add(p, v, __ATOMIC_RELAXED, __HIP_MEMORY_SCOPE_AGENT); }
__device__ __forceinline__ unsigned xb_xcc_id() { return (unsigned)__builtin_amdgcn_s_getreg((3 << 11) | 20) & 0xFu; }
#define XB_SPIN(cond, bar) do { unsigned _sp = 0; while (cond) { __builtin_amdgcn_s_sleep(1); \
    if ((++_sp & 255u) == 0u) { if (xb_ld(&(bar)[XB_TMO])) break; if (_sp > XB_SPIN_CAP) { atomicAdd(&(bar)[XB_TMO], 1u); break; } } } } while (0)
struct XcdBarrier { unsigned* bar; unsigned x; volatile LAS unsigned* st; };
__device__ __forceinline__ XcdBarrier xcd_barrier_post(unsigned* bar, volatile LAS unsigned* st) {
    XcdBarrier b; b.bar = bar; b.x = xb_xcc_id(); b.st = st;
    if (threadIdx.x == 0) (void)xb_add(&bar[XB_XCNT(b.x)], 1u);
    return b;
}
__device__ __forceinline__ void xcd_barrier_complete(unsigned* bar, unsigned x, unsigned& nloc, unsigned& nx) {
    const unsigned G = gridDim.x * gridDim.y * gridDim.z;
    unsigned sum, cnt, mine, sp = 0u;
    for (;;) {
        sum = 0u; cnt = 0u; mine = 0u;
#pragma unroll
        for (unsigned j = 0; j < 16; ++j) { const unsigned c = xb_ld(&bar[XB_XCNT(j)]); sum += c; cnt += (c > 0u) ? 1u : 0u; mine = (j == x) ? c : mine; }
        if (sum == G) break;
        __builtin_amdgcn_s_sleep(1);
        if ((++sp & 255u) == 0u) { if (xb_ld(&bar[XB_TMO])) break; if (sp > XB_SPIN_CAP) { atomicAdd(&bar[XB_TMO], 1u); break; } }
    }
    nloc = mine > 0u ? mine : 1u; nx = cnt > 0u ? cnt : 1u;
}
__device__ __forceinline__ void xcd_barrier(const XcdBarrier& b) {
    asm volatile("s_waitcnt vmcnt(0)" ::: "memory");
    __syncthreads();
    if (threadIdx.x == 0) {
        unsigned* bar = b.bar;
        __builtin_amdgcn_s_waitcnt(0);
        unsigned nloc = b.st[0], nx = b.st[1];
        if (nloc == 0u) { xcd_barrier_complete(bar, b.x, nloc, nx); b.st[0] = nloc; b.st[1] = nx; }
        const unsigned old = xb_add(&bar[XB_XSUB(b.x)], 1u);
        const unsigned gen = old / nloc;
        if (old + 1u == (gen + 1u) * nloc) {
            __builtin_amdgcn_fence(__ATOMIC_RELEASE, "agent");
            asm volatile("s_waitcnt vmcnt(0)" ::: "memory");
            const unsigned og = xb_add(&bar[XB_TOP], 1u);
            asm volatile("buffer_inv sc1" ::: "memory");
            const unsigned tg = og / nx;
            if (og + 1u == (tg + 1u) * nx) xb_add(&bar[XB_TOPGEN], 1u);
            else XB_SPIN(xb_ld(&bar[XB_TOPGEN]) == tg, bar);
            asm volatile("s_waitcnt vmcnt(0)" ::: "memory");
            xb_add(&bar[XB_XGEN(b.x)], 1u);
            asm volatile("s_waitcnt vmcnt(0)" ::: "memory");
        } else {
            asm volatile("buffer_inv sc1" ::: "memory");
            XB_SPIN(xb_ld(&bar[XB_XGEN(b.x)]) == gen, bar);
            asm volatile("s_waitcnt vmcnt(0)" ::: "memory");
        }
    }
    __syncthreads();
}

struct Args {
    const float* in[32];
    float* out;
    unsigned char* ws;
    int ph_lo, ph_hi;
    int rep_k, pad_;
};
enum { I_X = 0, I_C, I_CTX, I_CCTX, I_ADAW, I_ADAB, I_WIN, I_WAF, I_BAF, I_WAB, I_BAB, I_NORMG, I_CONVW, I_CONVB, I_FW1, I_FB1, I_FW2, I_FB2, I_FWOUT, I_FFREQ,
       I_BIASD, I_WOUT, I_LN1G, I_LN1B, I_RW, I_RB, I_EW1, I_EB1, I_EW2, I_EB2, I_LN2G, I_LN2B };


namespace gm {
constexpr int BM = 256, BK = 64, HALF = 128, HTB = HALF * BK * 2, STAGE_BYTES = 8 * HTB, KD = 1024, NT = KD / BK;
constexpr int ROWB = KD * 2;
typedef int i32x8 __attribute__((ext_vector_type(8)));
__device__ __forceinline__ int gray2(int q) { return q ^ (q >> 1); }
__device__ __forceinline__ int lds_off8(int r, int fq) { const int rr = r & 15; return ((r >> 4) * 2 + (fq >> 1)) * 1024 + rr * 64 + 16 * ((2 * (fq & 1)) ^ gray2(rr >> 2)); }
__device__ __forceinline__ void stage_rc8(int b, int& R, int& C) { const int st = b / 1024, sb = b % 1024, swz = sb ^ (gray2((sb >> 8) & 3) << 4); R = (st >> 1) * 16 + swz / 64; C = (st & 1) * 32 + (swz % 64) / 2; }
__device__ __forceinline__ int lds_byte(int r, int c) { const int st = (r >> 4) * 2 + (c >> 5), rr = r & 15, cc = c & 31, ob = rr * 64 + cc * 2; return st * 1024 + (ob ^ (((ob >> 9) & 1) << 5)); }
__device__ __forceinline__ void stage_rc(int b, int& R, int& C) { const int st = b / 1024, sb = b % 1024, swz = sb ^ (((sb >> 9) & 1) << 5); R = (st >> 1) * 16 + swz / 64; C = (st & 1) * 32 + (swz % 64) / 2; }
__device__ __forceinline__ int perm32(int rho) { const int n = rho >> 4, i = rho & 15; return 8 * (i >> 2) + 4 * n + (i & 3); }

constexpr int LDS_BIAS = STAGE_BYTES + 4096;
struct Unit {
    const char* A;
    const char* B;
    const int* list;
    int type, row0, col0, valid, aux;
};

__device__ __forceinline__ i32x8 cat8(bf16x8 lo, bf16x8 hi) { typedef int i32x4 __attribute__((ext_vector_type(4))); const i32x4 a = __builtin_bit_cast(i32x4, lo), b = __builtin_bit_cast(i32x4, hi); return (i32x8){a[0], a[1], a[2], a[3], b[0], b[1], b[2], b[3]}; }
template <bool GATHER, int GSHIFT, int RB, bool FP8>
__device__ __forceinline__ void a_offsets(const Unit& u, unsigned (&o)[2][2]) {
    int R[2], Cb[2];
    int tz = threadIdx.x; asm volatile("" : "+v"(tz));
#pragma unroll
    for (int i = 0; i < 2; ++i) { int r, c; if (FP8) stage_rc8(tz * 16 + i * 8192, r, c); else stage_rc(tz * 16 + i * 8192, r, c); R[i] = r; Cb[i] = c * 2; }
#pragma unroll
    for (int h = 0; h < 2; ++h)
#pragma unroll
        for (int i = 0; i < 2; ++i) {
            const int r = h * HALF + R[i];
            if (!GATHER) o[h][i] = (unsigned)(r * RB + Cb[i]);
            else { const int idx = u.list[r < u.valid ? r : 0]; o[h][i] = (unsigned)(idx >> GSHIFT) * (unsigned)RB + (unsigned)Cb[i]; }
        }
}

template <bool GATHER, int GSHIFT, bool FP8, class Sched, class Epi>
__device__ __forceinline__ void gemm_stream(LAS unsigned char* lds, const Sched& S, const Epi& E) {
    constexpr int RB = FP8 ? KD : ROWB, NTL = FP8 ? NT / 2 : NT;
    const int tid = threadIdx.x, wid = __builtin_amdgcn_readfirstlane(tid >> 6), lane = tid & 63, wr = wid >> 2, wc = wid & 3, fr = lane & 15, fq = lane >> 4;
    unsigned voffB[2], voffA[2];
#pragma unroll
    for (int i = 0; i < 2; ++i) { int r, c; if (FP8) stage_rc8(tid * 16 + i * 8192, r, c); else stage_rc(tid * 16 + i * 8192, r, c); const int rb = (r & ~31) + perm32(r & 31); voffB[i] = (unsigned)(rb * RB + c * 2); voffA[i] = (unsigned)(r * RB + c * 2); }
    const size_t kstep = (size_t)(BK * 2), hstep = (size_t)HALF * RB;
    const unsigned ldsw = (unsigned)wid * 1024u;
    const int aoff = FP8 ? lds_off8(wr * 64 + fr, fq) : lds_byte(wr * 64 + fr, fq * 8), boff = FP8 ? lds_off8(wc * 32 + fr, fq) : lds_byte(wc * 32 + fr, fq * 8);
    const int aoffh = aoff ^ 16, boffh = boff ^ 16;
#define GM_SA(b, h) (((b) * 2 + (h)) * HTB)
#define GM_SB(b, h) ((4 + (b) * 2 + (h)) * HTB)
#define GM_STAGE(bufoff, gbase, vo0, vo1) do { \
        __builtin_amdgcn_global_load_lds((const unsigned*)((const char*)(gbase) + (vo0)), (LAS unsigned*)(lds + (bufoff) + ldsw), 16, 0, 0); \
        __builtin_amdgcn_global_load_lds((const unsigned*)((const char*)(gbase) + (vo1)), (LAS unsigned*)(lds + (bufoff) + ldsw + 8192), 16, 0, 0); } while (0)
#define GM_STAGE_A(bufoff, gbase, h, o0, o1) do { if constexpr (GATHER) GM_STAGE(bufoff, gbase, o0, o1); else GM_STAGE(bufoff, (gbase) + (h) * hstep, voffA[0], voffA[1]); } while (0)
#define GM_LD32(p, ol, oh) ({ const i32x4 lo_ = *(const LAS i32x4*)((p) + (ol)), hi_ = *(const LAS i32x4*)((p) + (oh)); (i32x8){lo_[0], lo_[1], lo_[2], lo_[3], hi_[0], hi_[1], hi_[2], hi_[3]}; })
#define GM_LDA(dst, b, h) do { if constexpr (FP8) { _Pragma("unroll") for (int m = 0; m < 4; ++m) dst##8[m] = GM_LD32(lds + GM_SA(b, h) + m * 2048, aoff, aoffh); } \
        else { _Pragma("unroll") for (int m = 0; m < 4; ++m) _Pragma("unroll") for (int k = 0; k < 2; ++k) dst[m][k] = *(const LAS bf16x8*)(lds + GM_SA(b, h) + aoff + m * 2048 + k * 1024); } } while (0)
#define GM_LDB(dst, b, h) do { if constexpr (FP8) { _Pragma("unroll") for (int n = 0; n < 2; ++n) dst##8[n] = GM_LD32(lds + GM_SB(b, h) + n * 2048, boff, boffh); } \
        else { _Pragma("unroll") for (int n = 0; n < 2; ++n) _Pragma("unroll") for (int k = 0; k < 2; ++k) dst[n][k] = *(const LAS bf16x8*)(lds + GM_SB(b, h) + boff + n * 2048 + k * 1024); } } while (0)
#define GM_MMA(ai, bj, At, Bt) do { __builtin_amdgcn_s_setprio(1); _Pragma("unroll") for (int m = 0; m < 4; ++m) _Pragma("unroll") for (int n = 0; n < 2; ++n) { \
        if constexpr (FP8) asm volatile("v_mfma_f32_16x16x128_f8f6f4 %0, %1, %2, %0" : "+v"(acc[ai][bj][m][n]) : "v"(Bt##8[n]), "v"(At##8[m]));        \
        else { _Pragma("unroll") for (int k = 0; k < 2; ++k) acc[ai][bj][m][n] = __builtin_amdgcn_mfma_f32_16x16x32_bf16(Bt[n][k], At[m][k], acc[ai][bj][m][n], 0, 0, 0); } } \
        __builtin_amdgcn_s_setprio(0); } while (0)
#define GM_MMA0(ai, bj, At, Bt) do { __builtin_amdgcn_s_setprio(1); _Pragma("unroll") for (int m = 0; m < 4; ++m) _Pragma("unroll") for (int n = 0; n < 2; ++n) { \
        if constexpr (FP8) asm volatile("v_mfma_f32_16x16x128_f8f6f4 %0, %1, %2, 0" : "+v"(acc[ai][bj][m][n]) : "v"(Bt##8[n]), "v"(At##8[m]));        \
        else { acc[ai][bj][m][n] = __builtin_amdgcn_mfma_f32_16x16x32_bf16(Bt[n][0], At[m][0], (f32x4){0.f, 0.f, 0.f, 0.f}, 0, 0, 0); acc[ai][bj][m][n] = __builtin_amdgcn_mfma_f32_16x16x32_bf16(Bt[n][1], At[m][1], acc[ai][bj][m][n], 0, 0, 0); } } \
        __builtin_amdgcn_s_setprio(0); } while (0)
#define GM_MMAX(first, ai, bj, At, Bt) do { if (FP8 && (first)) GM_MMA0(ai, bj, At, Bt); else GM_MMA(ai, bj, At, Bt); } while (0)
#define GM_WAIT_V(n) asm volatile("s_waitcnt vmcnt(" #n ")" ::: "memory")
#define GM_WAIT_L(n) asm volatile("s_waitcnt lgkmcnt(" #n ")" ::: "memory")
#define GM_BAR __builtin_amdgcn_s_barrier()
#define GM_SCHED __builtin_amdgcn_sched_barrier(0)
    Unit cur, nxt; int ui = 0;
    if (!S.next(0, cur)) return;
    f32x4 acc[2][2][4][2];
    if constexpr (!FP8) {
#pragma unroll
    for (int a = 0; a < 2; ++a)
#pragma unroll
        for (int b = 0; b < 2; ++b)
#pragma unroll
            for (int m = 0; m < 4; ++m)
#pragma unroll
                for (int n = 0; n < 2; ++n) acc[a][b][m][n] = (f32x4){0.f, 0.f, 0.f, 0.f};
    }
    typedef int i32x4 __attribute__((ext_vector_type(4)));
    bf16x8 At[4][2], B0[2][2], B1[2][2];
    i32x8 At8[4], B08[2], B18[2];
    unsigned ca[2][2], na[2][2];
    if constexpr (GATHER) a_offsets<GATHER, GSHIFT, RB, FP8>(cur, ca);
    const char* cA = cur.A; const char* cB = cur.B;
    GM_STAGE(GM_SB(0, 0), cB, voffB[0], voffB[1]); GM_STAGE_A(GM_SA(0, 0), cA, 0, ca[0][0], ca[0][1]); GM_STAGE(GM_SB(0, 1), cB + hstep, voffB[0], voffB[1]); GM_STAGE_A(GM_SA(0, 1), cA, 1, ca[1][0], ca[1][1]);
    if (wr == 1) GM_BAR;
    GM_WAIT_V(4); GM_BAR;
    GM_STAGE(GM_SB(1, 0), cB + kstep, voffB[0], voffB[1]); GM_STAGE_A(GM_SA(1, 0), cA + kstep, 0, ca[0][0], ca[0][1]); GM_STAGE(GM_SB(1, 1), cB + hstep + kstep, voffB[0], voffB[1]);
    GM_WAIT_V(6); GM_BAR;
    for (;;) {
        const bool has_next = S.next(ui + 1, nxt);
        if constexpr (GATHER) {
            if (has_next) a_offsets<GATHER, GSHIFT, RB, FP8>(nxt, na);
            else {
#pragma unroll
                for (int h = 0; h < 2; ++h)
#pragma unroll
                    for (int i = 0; i < 2; ++i) na[h][i] = ca[h][i];
            }
        }
        const char* nA = has_next ? nxt.A : cA; const char* nB = has_next ? nxt.B : cB;
        if (wid == 0)
            __builtin_amdgcn_global_load_lds((const unsigned*)(S.bias(cur) + 4 * lane), (LAS unsigned*)(lds + LDS_BIAS + (ui & 1) * 1024), 16, 0, 0);
        for (int t = 0; t < NTL; t += 2) {
            const bool last = (t == NTL - 2);

            const char* a1 = cA + (size_t)(t + 1) * kstep;
            const char* a2 = last ? nA : cA + (size_t)(t + 2) * kstep; const char* b2 = last ? nB : cB + (size_t)(t + 2) * kstep;
            const char* a3 = a2 + kstep; const char* b3 = b2 + kstep;
            unsigned x00 = 0, x01 = 0, x10 = 0, x11 = 0;
            if constexpr (GATHER) { x00 = last ? na[0][0] : ca[0][0]; x01 = last ? na[0][1] : ca[0][1]; x10 = last ? na[1][0] : ca[1][0]; x11 = last ? na[1][1] : ca[1][1]; }
            const bool first = (t == 0);
            GM_LDB(B0, 0, 0); GM_SCHED; GM_LDA(At, 0, 0); GM_STAGE_A(GM_SA(1, 1), a1, 1, ca[1][0], ca[1][1]);
            GM_WAIT_L(8); GM_BAR; GM_WAIT_L(0); GM_MMAX(first, 0, 0, At, B0); GM_BAR; GM_SCHED;
            GM_LDB(B1, 0, 1); GM_STAGE(GM_SB(0, 0), b2, voffB[0], voffB[1]);
            GM_BAR; GM_WAIT_L(0); GM_MMAX(first, 0, 1, At, B1); GM_BAR;
            GM_LDA(At, 0, 1); GM_STAGE_A(GM_SA(0, 0), a2, 0, x00, x01);
            GM_BAR; GM_WAIT_L(0); GM_MMAX(first, 1, 0, At, B0); GM_BAR; GM_SCHED;
            GM_STAGE(GM_SB(0, 1), b2 + hstep, voffB[0], voffB[1]);
            GM_WAIT_V(6); GM_BAR; GM_MMAX(first, 1, 1, At, B1); GM_BAR;
            GM_LDB(B0, 1, 0); GM_SCHED; GM_LDA(At, 1, 0); GM_STAGE_A(GM_SA(0, 1), a2, 1, x10, x11);
            GM_WAIT_L(8); GM_BAR; GM_WAIT_L(0); GM_MMA(0, 0, At, B0); GM_BAR; GM_SCHED;
            GM_LDB(B1, 1, 1); GM_STAGE(GM_SB(1, 0), b3, voffB[0], voffB[1]);
            GM_BAR; GM_WAIT_L(0); GM_MMA(0, 1, At, B1); GM_BAR;
            GM_LDA(At, 1, 1); GM_STAGE_A(GM_SA(1, 0), a3, 0, x00, x01);
            GM_BAR; GM_WAIT_L(0); GM_MMA(1, 0, At, B0); GM_BAR; GM_SCHED;
            GM_STAGE(GM_SB(1, 1), b3 + hstep, voffB[0], voffB[1]);
            GM_WAIT_V(6); GM_BAR; GM_MMA(1, 1, At, B1); GM_BAR;
        }
        if constexpr (FP8) asm volatile("s_nop 7\n\ts_nop 7" ::: "memory");
        {
          int tz = threadIdx.x; asm volatile("" : "+v"(tz)); const int wz = tz >> 6, lz = tz & 63;
          E(acc, cur, wz >> 2, wz & 3, lz & 15, lz >> 4, (const LAS float*)(lds + LDS_BIAS + (ui & 1) * 1024)); }
        S.done(ui);
        if (!has_next) break;
        if constexpr (!FP8) {
#pragma unroll
    for (int a = 0; a < 2; ++a)
#pragma unroll
        for (int b = 0; b < 2; ++b)
#pragma unroll
            for (int m = 0; m < 4; ++m)
#pragma unroll
                for (int n = 0; n < 2; ++n) acc[a][b][m][n] = (f32x4){0.f, 0.f, 0.f, 0.f};
        }
        cur = nxt; cA = nA; cB = nB; ++ui;
        if constexpr (GATHER) {
#pragma unroll
            for (int h = 0; h < 2; ++h)
#pragma unroll
                for (int i = 0; i < 2; ++i) ca[h][i] = na[h][i];
        }
    }
    GM_WAIT_V(0);
    if (wr == 0) GM_BAR;
    GM_BAR;
#undef GM_SA
#undef GM_SB
#undef GM_STAGE
#undef GM_STAGE_A
#undef GM_LD32
#undef GM_LDA
#undef GM_LDB
#undef GM_MMA
#undef GM_MMA0
#undef GM_MMAX
#undef GM_WAIT_V
#undef GM_WAIT_L
#undef GM_BAR
#undef GM_SCHED
}

__device__ __forceinline__ u32x4 pack8(f32x4 a, f32x4 b) { u32x4 w; w.x = pk2(a[0], a[1]); w.y = pk2(a[2], a[3]); w.z = pk2(b[0], b[1]); w.w = pk2(b[2], b[3]); return w; }

template <bool HYPART>
struct SchedIn {
    unsigned char* ws; int G, c; const float* baf; const float* bab;
    __device__ __forceinline__ bool next(int i, Unit& u) const {
        int L = i * G + c;
        u.list = nullptr; u.valid = 256; u.aux = 0;
        if (HYPART) {
            if (L >= 768) return false;
            const int pa = L % 6, pb = L / 6;
            u.A = (const char*)(ws + WS_BTIN) + (size_t)2048 * KD + (size_t)(256 * pa) * ROWB; u.B = (const char*)(ws + WS_H) + (size_t)(256 * pb) * ROWB;
            u.type = 2; u.row0 = 256 * pa; u.col0 = 256 * pb; return true;
        }
        if (L < 1024) {
            const int pm = L >> 3, pn = ((L & 7) + (L >> 8)) & 7;
            u.A = (const char*)(ws + WS_H8) + (size_t)(256 * pm) * KD; u.B = (const char*)(ws + WS_BTIN) + (size_t)(256 * pn) * KD;
            u.type = pn < 6 ? 0 : 1; u.row0 = 256 * pm; u.col0 = pn; return true;
        }
        L -= 1024;
        if (L < 20) {
            const int pm = L / 5, j = L % 5, pn = j == 0 ? 1 : (j == 1 ? 2 : (j == 2 ? 3 : (j == 3 ? 6 : 7)));
            u.A = (const char*)(ws + WS_H8) + (size_t)(T + 256 * pm) * KD; u.B = (const char*)(ws + WS_BTIN) + (size_t)(256 * pn) * KD;
            u.type = pn < 6 ? 0 : 1; u.row0 = T + 256 * pm; u.col0 = pn; return true;
        }
        return false;
    }
    __device__ __forceinline__ const float* bias(const Unit& u) const { return (u.type == 1 && u.col0 == 7) ? bab : baf; }
    __device__ __forceinline__ void done(int) const {}
};
constexpr float S_HIN = 16.f, S_WIN = 64.f;
struct EpiIn {
    unsigned char* ws;
    __device__ __forceinline__ void operator()(const f32x4 (&acc)[2][2][4][2], const Unit& u, int wr, int wc, int fr, int fq, const LAS float* bs) const {
        const int rl = wr * 64 + fr, cl = wc * 32 + 8 * fq;
        constexpr float SC = 1.f / (S_HIN * S_WIN);
        if (u.type == 0) {
            const int pn = u.col0; const float sc = pn == 0 ? 0.125f * SC : SC;
            bf16_t* dst; int ld, cb;
            if (pn == 0) { dst = (bf16_t*)(ws + WS_Q); ld = 256; cb = 0; }
            else if (pn == 1) { dst = (bf16_t*)(ws + WS_K); ld = 256; cb = 0; }
            else if (pn < 4) { dst = (bf16_t*)(ws + WS_V); ld = 512; cb = (pn - 2) * 256; }
            else { dst = (bf16_t*)(ws + WS_G); ld = 512; cb = (pn - 4) * 256; }
#pragma unroll
            for (int ai = 0; ai < 2; ++ai)
#pragma unroll
                for (int m = 0; m < 4; ++m) { bf16_t* rowp = dst + (size_t)(u.row0 + rl + ai * 128 + m * 16) * ld + cb + cl;
#pragma unroll
                    for (int bj = 0; bj < 2; ++bj) *(u32x4*)(rowp + bj * 128) = pack8(acc[ai][bj][m][0] * sc, acc[ai][bj][m][1] * sc); }
        } else if (u.type == 1) {
            _Float16* dst = (_Float16*)(ws + (u.col0 == 6 ? WS_GF : WS_GB));
            f32x4 bv[2][2];
#pragma unroll
            for (int bj = 0; bj < 2; ++bj)
#pragma unroll
                for (int n = 0; n < 2; ++n) bv[bj][n] = *(const LAS f32x4*)(bs + cl + bj * 128 + 4 * n);
            typedef _Float16 f16x8_ __attribute__((ext_vector_type(8)));
#pragma unroll
            for (int ai = 0; ai < 2; ++ai)
#pragma unroll
                for (int m = 0; m < 4; ++m) { _Float16* rowp = dst + (size_t)(u.row0 + rl + ai * 128 + m * 16) * 256 + cl;
#pragma unroll
                    for (int bj = 0; bj < 2; ++bj) { f16x8_ o;
#pragma unroll
                        for (int n = 0; n < 2; ++n) { const f32x4 z = acc[ai][bj][m][n] * SC + bv[bj][n];
#pragma unroll
                            for (int j = 0; j < 4; ++j) o[4 * n + j] = (_Float16)(log_sigmoid_f(z[j]) * (1.f / 16.f)); }
                        *(f16x8_*)(rowp + bj * 128) = o; } }
        } else {
            const int b = u.col0 >> 13, l0 = u.col0 & 8191;
            bf16_t* dst = (bf16_t*)(ws + WS_UT) + ((size_t)b * HYC) * SEQ + l0 + cl;
#pragma unroll
            for (int ai = 0; ai < 2; ++ai)
#pragma unroll
                for (int m = 0; m < 4; ++m) { bf16_t* rowp = dst + (size_t)(u.row0 + rl + ai * 128 + m * 16) * SEQ;
#pragma unroll
                    for (int bj = 0; bj < 2; ++bj) *(u32x4*)(rowp + bj * 128) = pack8(acc[ai][bj][m][0], acc[ai][bj][m][1]); }
        }
    }
};

struct SchedOut {
    unsigned char* ws; int G, c;
    __device__ __forceinline__ bool next(int i, Unit& u) const {
        const int L = i * G + c; if (L >= 512) return false;
        const int pm = L >> 2, pn = L & 3;
        u.A = (const char*)(ws + WS_MIX) + (size_t)(256 * pm) * ROWB; u.B = (const char*)(ws + WS_BTOUT) + (size_t)(256 * pn) * ROWB;
        u.list = nullptr; u.valid = 256; u.aux = 0; u.type = 3; u.row0 = 256 * pm; u.col0 = 256 * pn; return true;
    }
    __device__ __forceinline__ const float* bias(const Unit& u) const { return (const float*)(ws + WS_MOD) + (u.row0 >> 13) * 6144 + 2 * 1024 + u.col0; }
    __device__ __forceinline__ void done(int) const {}
};
struct EpiOut {
    unsigned char* ws;
    __device__ __forceinline__ void operator()(const f32x4 (&acc)[2][2][4][2], const Unit& u, int wr, int wc, int fr, int fq, const LAS float* bs) const {
        const int rl = wr * 64 + fr, cl = u.col0 + wc * 32 + 8 * fq;
        bf16_t* fg = (bf16_t*)(ws + WS_FG);
        f32x4 gv[2][2];
#pragma unroll
        for (int bj = 0; bj < 2; ++bj)
#pragma unroll
            for (int n = 0; n < 2; ++n) gv[bj][n] = *(const LAS f32x4*)(bs + wc * 32 + 8 * fq + bj * 128 + 4 * n);
#pragma unroll
        for (int ai = 0; ai < 2; ++ai)
#pragma unroll
            for (int m = 0; m < 4; ++m) { bf16_t* rowp = fg + (size_t)(u.row0 + rl + ai * 128 + m * 16) * 1024 + cl;
#pragma unroll
                for (int bj = 0; bj < 2; ++bj) *(u32x4*)(rowp + bj * 128) = pack8(gv[bj][0] * acc[ai][bj][m][0], gv[bj][1] * acc[ai][bj][m][1]); }
    }
};

constexpr int LDS_TAB = STAGE_BYTES;
template <int WHICH>
struct SchedMoe {
    unsigned char* ws; const LAS int* tab; int G, c; const float* b2;
    unsigned xcc, nlw, nxc;
    int uiA, N1; unsigned xw;
    __device__ __forceinline__ bool next(int i, Unit& u) const {
        constexpr int NCT_ = WHICH == 1 ? 8 : 4;
        const int L = i * G + c; const int nrt = __builtin_amdgcn_readfirstlane(tab[32]);
        if (L >= nrt * NCT_) return false;
        if (WHICH == 2 && L >= N1 && xw > 0u) {
            unsigned* hb = (unsigned*)(ws + WS_HOB); unsigned* bar = (unsigned*)(ws + WS_BAR); unsigned sp = 0u;
            while ((unsigned)__builtin_amdgcn_readfirstlane(xb_ld(hb)) < xw) { __builtin_amdgcn_s_sleep(1);
                if ((++sp & 255u) == 0u) { if (__builtin_amdgcn_readfirstlane(xb_ld(&bar[XB_TMO]))) break; if (sp > XB_SPIN_CAP) { if ((threadIdx.x & 63) == 0) atomicAdd(&bar[XB_TMO], 1u); break; } } }
            volatile LAS unsigned* lf = (volatile LAS unsigned*)((LAS unsigned char*)tab - LDS_TAB + LDS_MISC + 8);
            if (__builtin_amdgcn_readfirstlane(lf[0]) == 0u) { __builtin_amdgcn_fence(__ATOMIC_ACQUIRE, "agent"); asm volatile("s_waitcnt vmcnt(0)" ::: "memory"); if ((threadIdx.x & 63) == 0) lf[0] = 1u; } }
        const int rt = L / NCT_, ct = L % NCT_;
        const int info = __builtin_amdgcn_readfirstlane(tab[64 + rt]), e = info & 255, r0 = (info >> 8) * 256;
        const int cnt = __builtin_amdgcn_readfirstlane(tab[e]);
        u.valid = (cnt - r0) < 256 ? (cnt - r0) : 256;
        u.list = (const int*)(ws + WS_LIST) + (size_t)e * CAP + r0;
        u.A = (WHICH == 1) ? (const char*)(ws + WS_H2) : (const char*)(ws + WS_ACT) + (size_t)(256 * rt) * KD;
        u.B = (const char*)(ws + (WHICH == 1 ? WS_W1T : WS_W2T)) + ((size_t)e * (WHICH == 1 ? 2048 : 1024) + 256 * ct) * KD;
        u.type = 3 + WHICH; u.row0 = 256 * rt; u.col0 = ct; u.aux = e; return true;
    }
    __device__ __forceinline__ const float* bias(const Unit& u) const { return (WHICH == 1) ? (const float*)(ws + WS_B1R) + (size_t)u.aux * 2048 + 256 * u.col0 : b2 + (size_t)u.aux * 1024 + 256 * u.col0; }
    __device__ __forceinline__ void done(int ui) const {
        if (WHICH == 1 && (ui == uiA || ui == uiA + 1)) {
            const bool has_last = (uiA + 1) * G + c < __builtin_amdgcn_readfirstlane(tab[32]) * 8;
            asm volatile("s_waitcnt vmcnt(0)" ::: "memory");
            if ((threadIdx.x & 63) == 0) {
                if (ui == uiA) { const unsigned old = xb_add((unsigned*)(ws + WS_HOX) + 64 * xcc, 1u);
                    if (old + 1u == nlw) { __builtin_amdgcn_fence(__ATOMIC_RELEASE, "agent"); asm volatile("s_waitcnt vmcnt(0)" ::: "memory"); (void)xb_add((unsigned*)(ws + WS_HOA), 1u); } }
                if (ui == uiA + 1 || !has_last) { const unsigned old = xb_add((unsigned*)(ws + WS_HOXB) + 64 * xcc, 1u);
                    if (old + 1u == nlw) { __builtin_amdgcn_fence(__ATOMIC_RELEASE, "agent"); asm volatile("s_waitcnt vmcnt(0)" ::: "memory"); (void)xb_add((unsigned*)(ws + WS_HOB), 1u); } } } }
    }
};
__device__ __forceinline__ float swiglu_f(float glu, float lin) {
    glu = fminf(glu, 7.f); lin = fminf(fmaxf(lin, -7.f), 7.f);
    return glu * __builtin_amdgcn_rcpf(1.f + __expf(-1.702f * glu)) * (lin + 1.f);
}
constexpr float S_H2 = 4.f, S_ACT = 8.f, S_W = 64.f;
__device__ __forceinline__ f32x2 swiglu2(f32x2 ag, f32x2 al, f32x2 bg, f32x2 bl) {
    f32x2 g = ag * (1.f / (S_H2 * S_W)) + bg, l = al * (1.f / (S_H2 * S_W)) + bl;
    g[0] = fminf(g[0], 7.f); g[1] = fminf(g[1], 7.f);
    l[0] = __builtin_amdgcn_fmed3f(l[0], -7.f, 7.f); l[1] = __builtin_amdgcn_fmed3f(l[1], -7.f, 7.f);
    const f32x2 t = g * (-1.702f * 1.4426950408889634f);
    const f32x2 d = (f32x2){__builtin_amdgcn_exp2f(t[0]), __builtin_amdgcn_exp2f(t[1])} + 1.f;
    const f32x2 r = {__builtin_amdgcn_rcpf(d[0]), __builtin_amdgcn_rcpf(d[1])};
    return (g * r) * (l * S_ACT + S_ACT);
}
__device__ __forceinline__ unsigned pk4_fp8(float a, float b, float c, float d) {
    a = fminf(fmaxf(a, -448.f), 448.f); b = fminf(fmaxf(b, -448.f), 448.f); c = fminf(fmaxf(c, -448.f), 448.f); d = fminf(fmaxf(d, -448.f), 448.f);
    int p = __builtin_amdgcn_cvt_pk_fp8_f32(a, b, 0, false); p = __builtin_amdgcn_cvt_pk_fp8_f32(c, d, p, true); return (unsigned)p; }
__device__ __forceinline__ unsigned pk4_fp8_nc(float a, float b, float c, float d) { int p = __builtin_amdgcn_cvt_pk_fp8_f32(a, b, 0, false); p = __builtin_amdgcn_cvt_pk_fp8_f32(c, d, p, true); return (unsigned)p; }
struct EpiMoe1 {
    unsigned char* ws;
    __device__ __forceinline__ void operator()(const f32x4 (&acc)[2][2][4][2], const Unit& u, int wr, int wc, int fr, int fq, const LAS float* bs) const {
        const int rl = wr * 64 + fr, cl = wc * 32 + 8 * fq, ct = u.col0;
        const LAS float* b1 = bs + cl;
        unsigned char* act = (unsigned char*)(ws + WS_ACT) + (size_t)u.row0 * 1024 + 128 * ct + cl;
        f32x4 bg[2], bl[2];
#pragma unroll
        for (int n = 0; n < 2; ++n) { bg[n] = *(const LAS f32x4*)(b1 + 4 * n); bl[n] = *(const LAS f32x4*)(b1 + 128 + 4 * n); }
#pragma unroll
        for (int ai = 0; ai < 2; ++ai)
#pragma unroll
            for (int mp = 0; mp < 2; ++mp) {
                u32x2 w[2];
#pragma unroll
                for (int mm = 0; mm < 2; ++mm) { const int m = 2 * mp + mm;
#pragma unroll
                    for (int n = 0; n < 2; ++n) { int p = 0;
#pragma unroll
                        for (int hh = 0; hh < 2; ++hh) {
                            const f32x2 o = swiglu2((f32x2){acc[ai][0][m][n][2 * hh], acc[ai][0][m][n][2 * hh + 1]}, (f32x2){acc[ai][1][m][n][2 * hh], acc[ai][1][m][n][2 * hh + 1]},
                                                    (f32x2){bg[n][2 * hh], bg[n][2 * hh + 1]}, (f32x2){bl[n][2 * hh], bl[n][2 * hh + 1]});
                            p = hh ? __builtin_amdgcn_cvt_pk_fp8_f32(o[0], o[1], p, true) : __builtin_amdgcn_cvt_pk_fp8_f32(o[0], o[1], p, false); }
                        if (n == 0) w[mm].x = (unsigned)p; else w[mm].y = (unsigned)p; } }
                const auto sx = __builtin_amdgcn_permlane16_swap(w[0].x, w[1].x, false, false); const auto sy = __builtin_amdgcn_permlane16_swap(w[0].y, w[1].y, false, false);
                const int r = rl + ai * 128 + (2 * mp + (fq & 1)) * 16;
                *(u32x4*)(act + (size_t)r * 1024 - 8 * (fq & 1)) = (u32x4){sx[0], sy[0], sx[1], sy[1]}; }
    }
};
constexpr float S_SL = 16.f;
struct EpiMoe2 {
    unsigned char* ws;
    __device__ __forceinline__ void operator()(const f32x4 (&acc)[2][2][4][2], const Unit& u, int wr, int wc, int fr, int fq, const LAS float* bs) const {
        const int rl = wr * 64 + fr, cl = wc * 32 + 8 * fq, ct = u.col0;
        const LAS float* bb = bs + cl;
        unsigned char* slots = (unsigned char*)(ws + WS_SLOTS) + (size_t)u.row0 * 1024 + 256 * ct + cl;
        f32x4 bv[2][2];
#pragma unroll
        for (int bj = 0; bj < 2; ++bj)
#pragma unroll
            for (int n = 0; n < 2; ++n) bv[bj][n] = *(const LAS f32x4*)(bb + bj * 128 + 4 * n) * S_SL;
#pragma unroll
        for (int ai = 0; ai < 2; ++ai)
#pragma unroll
            for (int m = 0; m < 4; ++m) { const int r = rl + ai * 128 + m * 16;
                u32x2 w[2];
#pragma unroll
                for (int bj = 0; bj < 2; ++bj) {
#pragma unroll
                    for (int n = 0; n < 2; ++n) { int p = 0;
#pragma unroll
                        for (int hh = 0; hh < 2; ++hh) { f32x2 y = (f32x2){acc[ai][bj][m][n][2 * hh], acc[ai][bj][m][n][2 * hh + 1]} * (S_SL / (S_ACT * S_W)) + (f32x2){bv[bj][n][2 * hh], bv[bj][n][2 * hh + 1]};
                            y[0] = __builtin_amdgcn_fmed3f(y[0], -448.f, 448.f); y[1] = __builtin_amdgcn_fmed3f(y[1], -448.f, 448.f);
                            p = hh ? __builtin_amdgcn_cvt_pk_fp8_f32(y[0], y[1], p, true) : __builtin_amdgcn_cvt_pk_fp8_f32(y[0], y[1], p, false); }
                        if (n == 0) w[bj].x = (unsigned)p; else w[bj].y = (unsigned)p; } }
                const auto sx = __builtin_amdgcn_permlane16_swap(w[0].x, w[1].x, false, false); const auto sy = __builtin_amdgcn_permlane16_swap(w[0].y, w[1].y, false, false);
                *(u32x4*)(slots + (size_t)r * 1024 + ((fq & 1) ? 128 - 8 : 0)) = (u32x4){sx[0], sy[0], sx[1], sy[1]}; }
    }
};
}

namespace hy {
__device__ __forceinline__ int phys(int n) { return n + (n >> 4) + ((n >> 9) << 4); }
constexpr int XSIZE = 16384 + 1024 + 512;

__device__ __forceinline__ float tw_c(int i) {
    constexpr float t[16] = {1.f, 0.98078528040323043f, 0.92387953251128674f, 0.83146961230254524f, 0.70710678118654752f, 0.55557023301960218f, 0.38268343236508977f, 0.19509032201612825f,
                             0.f, -0.19509032201612825f, -0.38268343236508977f, -0.55557023301960218f, -0.70710678118654752f, -0.83146961230254524f, -0.92387953251128674f, -0.98078528040323043f};
    return t[i];
}
__device__ __forceinline__ float tw_s(int i) {
    constexpr float t[16] = {0.f, 0.19509032201612825f, 0.38268343236508977f, 0.55557023301960218f, 0.70710678118654752f, 0.83146961230254524f, 0.92387953251128674f, 0.98078528040323043f,
                             1.f, 0.98078528040323043f, 0.92387953251128674f, 0.83146961230254524f, 0.70710678118654752f, 0.55557023301960218f, 0.38268343236508977f, 0.19509032201612825f};
    return t[i];
}
__host__ __device__ constexpr int brev(int p, int bits) { int r = 0; for (int i = 0; i < bits; ++i) r |= ((p >> i) & 1) << (bits - 1 - i); return r; }

__device__ __forceinline__ f32x2 cmul(f32x2 a, f32x2 w) { f32x2 r;
    asm("v_pk_mul_f32 %0, %1, %2 op_sel_hi:[1,0]\n\tv_pk_fma_f32 %0, %1, %2, %0 op_sel:[1,1,0] op_sel_hi:[0,1,1] neg_lo:[0,1,0]" : "=&v"(r) : "v"(a), "v"(w)); return r; }
__device__ __forceinline__ void cmul_chain(f32x2 a, f32x2 w, f32x2 w1, f32x2& o, f32x2& wn) {
    asm("v_pk_mul_f32 %0, %2, %3 op_sel_hi:[1,0]\n\tv_pk_mul_f32 %1, %3, %4 op_sel_hi:[1,0]\n\t"
        "v_pk_fma_f32 %0, %2, %3, %0 op_sel:[1,1,0] op_sel_hi:[0,1,1] neg_lo:[0,1,0]\n\tv_pk_fma_f32 %1, %3, %4, %1 op_sel:[1,1,0] op_sel_hi:[0,1,1] neg_lo:[0,1,0]"
        : "=&v"(o), "=&v"(wn) : "v"(a), "v"(w), "v"(w1)); }
template <int TI, bool INV>
__device__ __forceinline__ void bf_tw(f32x2& a, f32x2& b) {
    constexpr int T7 = TI < 8 ? TI : 16 - TI;
    const f32x2 W = {tw_c(T7), tw_s(T7)};
    f32x2 sum, o;
#define HY_BF(NEGR, NEGI) asm("v_pk_add_f32 %0, %3, %2\n\tv_pk_add_f32 %2, %3, %2 neg_lo:[0,1] neg_hi:[0,1]\n\tv_pk_mul_f32 %1, %2, %4 op_sel_hi:[1,0]" NEGR "\n\tv_pk_fma_f32 %1, %2, %4, %1 op_sel:[1,1,0] op_sel_hi:[0,1,1] " NEGI : "=&v"(sum), "=&v"(o), "+v"(b) : "v"(a), "s"(W))
    if (TI < 8) { if (!INV) HY_BF("", "neg_hi:[0,1,0]"); else HY_BF("", "neg_lo:[0,1,0]"); }
    else        { if (!INV) HY_BF(" neg_lo:[0,1] neg_hi:[0,1]", "neg_hi:[0,1,0]"); else HY_BF(" neg_lo:[0,1] neg_hi:[0,1]", "neg_lo:[0,1,0]"); }
#undef HY_BF
    a = sum; b = o;
}
template <int TI, bool INV>
__device__ __forceinline__ f32x2 tw_mul(f32x2 t) {
    constexpr int T7 = TI < 8 ? TI : 16 - TI;
    const f32x2 W = {tw_c(T7), tw_s(T7)};
    f32x2 r;
#define HY_TW(NEGR, NEGI) asm("v_pk_mul_f32 %0, %1, %2 op_sel_hi:[1,0]" NEGR "\n\tv_pk_fma_f32 %0, %1, %2, %0 op_sel:[1,1,0] op_sel_hi:[0,1,1] " NEGI : "=&v"(r) : "v"(t), "s"(W))
    if (TI < 8) { if (!INV) HY_TW("", "neg_hi:[0,1,0]"); else HY_TW("", "neg_lo:[0,1,0]"); }
    else        { if (!INV) HY_TW(" neg_lo:[0,1] neg_hi:[0,1]", "neg_hi:[0,1,0]"); else HY_TW(" neg_lo:[0,1] neg_hi:[0,1]", "neg_lo:[0,1,0]"); }
#undef HY_TW
    return r;
}
template <bool INV>
__device__ __forceinline__ void bf_rot(f32x2& a, f32x2& b) { f32x2 sum, o;
    if (!INV) asm("v_pk_add_f32 %0, %2, %3\n\tv_pk_add_f32 %1, %2, %3 op_sel:[1,1] op_sel_hi:[0,0] neg_lo:[0,1] neg_hi:[1,0]" : "=&v"(sum), "=&v"(o) : "v"(a), "v"(b));
    else      asm("v_pk_add_f32 %0, %2, %3\n\tv_pk_add_f32 %1, %2, %3 op_sel:[1,1] op_sel_hi:[0,0] neg_lo:[1,0] neg_hi:[0,1]" : "=&v"(sum), "=&v"(o) : "v"(a), "v"(b));
    a = sum; b = o; }
__device__ __forceinline__ void bf_plain(f32x2& a, f32x2& b) { f32x2 sum, o;
    asm("v_pk_add_f32 %0, %2, %3\n\tv_pk_add_f32 %1, %2, %3 neg_lo:[0,1] neg_hi:[0,1]" : "=&v"(sum), "=&v"(o) : "v"(a), "v"(b));
    a = sum; b = o; }
template <bool INV>
__device__ __forceinline__ f32x2 rot_i(f32x2 t) { f32x2 r;
    if (!INV) asm("v_pk_mul_f32 %0, %1, 1.0 op_sel:[1,0] op_sel_hi:[0,0] neg_hi:[1,0]" : "=v"(r) : "v"(t));
    else      asm("v_pk_mul_f32 %0, %1, 1.0 op_sel:[1,0] op_sel_hi:[0,0] neg_lo:[1,0]" : "=v"(r) : "v"(t));
    return r; }

template <int R, bool INV, bool ZP, int S, int J>
__device__ __forceinline__ void fft_bfly(f32x2 (&v)[R]) {
    constexpr int g = (J / S) * 2 * S, k = J % S, ti = k * (16 / S), i0 = g + k, i1 = g + k + S;
    if constexpr (ZP && S == R / 2) {
        if constexpr (ti == 0) v[i1] = v[i0]; else if constexpr (ti == 8) v[i1] = rot_i<INV>(v[i0]); else v[i1] = tw_mul<ti, INV>(v[i0]);
    } else {
        if constexpr (ti == 0) bf_plain(v[i0], v[i1]); else if constexpr (ti == 8) bf_rot<INV>(v[i0], v[i1]); else bf_tw<ti, INV>(v[i0], v[i1]);
    }
}
template <int R, bool INV, bool ZP, int S, int J>
__device__ __forceinline__ void fft_stage(f32x2 (&v)[R]) { if constexpr (J < R / 2) { fft_bfly<R, INV, ZP, S, J>(v); fft_stage<R, INV, ZP, S, J + 1>(v); } }
template <int R, bool INV, bool ZP, int S>
__device__ __forceinline__ void fft_stages(f32x2 (&v)[R]) { if constexpr (S >= 1) { fft_stage<R, INV, ZP, S, 0>(v); fft_stages<R, INV, ZP, S / 2>(v); } }
template <int R, bool INV, bool ZP = false>
__device__ __forceinline__ void fft_reg(f32x2 (&v)[R]) { fft_stages<R, INV, ZP, R / 2>(v); }
#define XV(X) ((const volatile LAS f32x2*)(X))
template <int M, bool ZPAD = false>
__device__ __forceinline__ void pass_fwd32(LAS f32x2* X, int tid) {
    int j = (M == 512) ? (16 * ((tid >> 5) + 16 * ((tid >> 4) & 1)) + (tid & 15)) : (tid & 15);
    asm volatile("" : "+v"(j));
    const int p0 = (M == 512) ? (j + (j >> 4)) : (560 * (tid >> 4) + (tid & 15));
    constexpr int PS = (M == 512) ? 560 : 17;
    f32x2 v[32];
#pragma unroll
    for (int r = 0; r < 32; ++r) { if (ZPAD && r >= 16) v[r] = (f32x2){0.f, 0.f}; else v[r] = XV(X)[p0 + PS * r]; }
    fft_reg<32, false, ZPAD>(v);
    const float rev = -(float)j * (1.f / (float)(32 * M)); const float sn = __builtin_amdgcn_sinf(rev), cs = __builtin_amdgcn_cosf(rev);
    const f32x2 w1 = {cs, sn}; f32x2 w = w1;
    X[p0] = v[0];
#pragma unroll
    for (int rp = 1; rp < 32; ++rp) { if (rp < 31) { f32x2 o_, wn_; cmul_chain(v[brev(rp, 5)], w, w1, o_, wn_); X[p0 + PS * rp] = o_; w = wn_; } else X[p0 + PS * rp] = cmul(v[brev(rp, 5)], w); }
}
template <int M, bool HALF = false>
__device__ __forceinline__ void pass_inv32(LAS f32x2* X, int tid) {
    int j = (M == 512) ? (16 * ((tid >> 5) + 16 * ((tid >> 4) & 1)) + (tid & 15)) : (tid & 15);
    asm volatile("" : "+v"(j));
    const int p0 = (M == 512) ? (j + (j >> 4)) : (560 * (tid >> 4) + (tid & 15));
    constexpr int PS = (M == 512) ? 560 : 17;
    const float rev = (float)j * (1.f / (float)(32 * M)); const float sn = __builtin_amdgcn_sinf(rev), cs = __builtin_amdgcn_cosf(rev);
    const f32x2 w1 = {cs, sn}; f32x2 w = w1;
    f32x2 v[32];
    v[0] = XV(X)[p0];
#pragma unroll
    for (int rp = 1; rp < 32; ++rp) { if (rp < 31) { f32x2 wn_; cmul_chain(XV(X)[p0 + PS * rp], w, w1, v[rp], wn_); w = wn_; } else v[rp] = cmul(XV(X)[p0 + PS * rp], w); }
    fft_reg<32, true>(v);
#pragma unroll
    for (int p = 0; p < 32; ++p) { if (!HALF || brev(p, 5) < 16) X[p0 + PS * brev(p, 5)] = v[p]; }
}
typedef _Float16 f16x8h __attribute__((ext_vector_type(8)));
__device__ __forceinline__ void pass_c_store(const LAS f32x2* X, f32x2* Hs_, int tid, float scale) {
    _Float16* Hs = (_Float16*)Hs_; (void)scale;
#pragma unroll
    for (int u = 0; u < 2; ++u) { const int blk = tid + 512 * u, p0 = 17 * blk + 16 * (blk >> 5);
        f32x2 v[16];
#pragma unroll
        for (int r = 0; r < 16; ++r) v[r] = XV(X)[p0 + r];
        fft_reg<16, false>(v);
#pragma unroll
        for (int q = 0; q < 4; ++q) { f16x8h o;
#pragma unroll
            for (int e = 0; e < 4; ++e) { const f32x2 x = v[brev(4 * q + e, 4)]; o[2 * e] = (_Float16)x[0]; o[2 * e + 1] = (_Float16)x[1]; }
            *(f16x8h*)(Hs + 2 * (16 * blk + 4 * q)) = o; } }
}
__device__ __forceinline__ void pass_c_mul_inv(LAS f32x2* X, const f32x2* Hs_, int tid) {
    const _Float16* Hs = (const _Float16*)Hs_;
#pragma unroll
    for (int u = 0; u < 2; ++u) { const int blk = tid + 512 * u, p0 = 17 * blk + 16 * (blk >> 5);
        f32x2 v[16], w[16];
#pragma unroll
        for (int r = 0; r < 16; ++r) v[r] = XV(X)[p0 + r];
        f16x8h hh[4];
#pragma unroll
        for (int q = 0; q < 4; ++q) hh[q] = *(const f16x8h*)(Hs + 2 * (16 * blk + 4 * q));
        fft_reg<16, false>(v);
#pragma unroll
        for (int q = 0; q < 4; ++q)
#pragma unroll
            for (int e = 0; e < 4; ++e) w[4 * q + e] = cmul(v[brev(4 * q + e, 4)], (f32x2){(float)hh[q][2 * e], (float)hh[q][2 * e + 1]});
        fft_reg<16, true>(w);
#pragma unroll
        for (int p = 0; p < 16; ++p) X[p0 + brev(p, 4)] = w[p]; }
}
__device__ __forceinline__ void load16(const bf16_t* u, float (&e)[16]) {
    const u32x4 a = *(const u32x4*)u, b = *(const u32x4*)(u + 8);
    e[0] = bflo(a.x); e[1] = bfhi(a.x); e[2] = bflo(a.y); e[3] = bfhi(a.y); e[4] = bflo(a.z); e[5] = bfhi(a.z); e[6] = bflo(a.w); e[7] = bfhi(a.w);
    e[8] = bflo(b.x); e[9] = bfhi(b.x); e[10] = bflo(b.y); e[11] = bfhi(b.y); e[12] = bflo(b.z); e[13] = bfhi(b.z); e[14] = bflo(b.w); e[15] = bfhi(b.w);
}
__device__ __forceinline__ void sconv16(const bf16_t* u, int tid, float w0, float w1, float w2, float bias, float (&o)[16]) {
    float e[16]; load16(u + 16 * tid, e);
    float lf = __shfl_up(e[15], 1), rt = __shfl_down(e[0], 1);
    if ((tid & 3) == 0) lf = 0.f;
    if ((tid & 3) == 3) rt = 0.f;
    o[0] = w0 * lf + w1 * e[0] + w2 * e[1] + bias;
#pragma unroll
    for (int i = 1; i < 15; ++i) o[i] = w0 * e[i - 1] + w1 * e[i] + w2 * e[i + 1] + bias;
    o[15] = w0 * e[14] + w1 * e[15] + w2 * rt + bias;
}

constexpr int CV_W1 = NE * 64 * 32;
constexpr int CV_W2E = 11;
constexpr int CV_ITEMS = CV_W1 + CV_W2E * 1024;
struct CvJob { float v[16]; int mi; };
__device__ __forceinline__ void cv_issue(const Args& a, CvJob& jb, int mi, int lane) {
    jb.mi = mi;
    if (mi >= 0) {
        const float* src; size_t rs;
        if (mi < CV_W1) { const int e = mi >> 11, kg = (mi >> 5) & 63, nb = mi & 31; src = a.in[I_EW1] + ((size_t)e * 1024 + 16 * kg) * 2048 + 64 * nb + lane; rs = 2048; }
        else { const int m2 = mi - CV_W1, e = m2 >> 10, kg = (m2 >> 4) & 63, nb = m2 & 15; src = a.in[I_EW2] + ((size_t)e * 1024 + 16 * kg) * 1024 + 64 * nb + lane; rs = 1024; }
#pragma unroll
        for (int i = 0; i < 16; ++i) jb.v[i] = src[(size_t)i * rs]; }
}
__device__ __forceinline__ void cv_finish(const Args& a, const CvJob& jb, int lane) {
    if (jb.mi >= 0) { const int mi = jb.mi;
        unsigned char* dst;
        if (mi < CV_W1) { const int e = mi >> 11, kg = (mi >> 5) & 63, nb = mi & 31;
            const int cs = 64 * nb + lane, sgl = cs & 1, ac = cs >> 1, ct = ac >> 7, jj = ac & 127;
            dst = (unsigned char*)(a.ws + WS_W1T) + ((size_t)e * 2048 + 256 * ct + 128 * sgl + jj) * 1024 + 16 * kg; }
        else { const int m2 = mi - CV_W1, e = m2 >> 10, kg = (m2 >> 4) & 63, nb = m2 & 15;
            dst = (unsigned char*)(a.ws + WS_W2T) + ((size_t)e * 1024 + 64 * nb + lane) * 1024 + 16 * kg; }
        u32x4 o;
        o.x = gm::pk4_fp8_nc(jb.v[0] * gm::S_W, jb.v[1] * gm::S_W, jb.v[2] * gm::S_W, jb.v[3] * gm::S_W); o.y = gm::pk4_fp8_nc(jb.v[4] * gm::S_W, jb.v[5] * gm::S_W, jb.v[6] * gm::S_W, jb.v[7] * gm::S_W);
        o.z = gm::pk4_fp8_nc(jb.v[8] * gm::S_W, jb.v[9] * gm::S_W, jb.v[10] * gm::S_W, jb.v[11] * gm::S_W); o.w = gm::pk4_fp8_nc(jb.v[12] * gm::S_W, jb.v[13] * gm::S_W, jb.v[14] * gm::S_W, jb.v[15] * gm::S_W);
        *(u32x4*)dst = o; }
}
struct CvState { CvJob jb; int next, stride, end; };
__device__ __forceinline__ void cv_step(const Args& a, CvState& st, int lane) {
    cv_finish(a, st.jb, lane);
    int mi = st.next < st.end ? st.next : -1;
    if (mi >= 0 && st.stride == 2048) {
        if (mi < CV_W1) { const int lo = mi & 2047, g = lo >> 3, wv = lo & 7; mi = (mi & ~2047) | ((((g >> 5) * 8 + wv) << 5) | (g & 31)); }
        else { const int m2 = mi - CV_W1, lo = m2 & 1023, g = lo >> 3, wv = lo & 7; mi = CV_W1 + ((m2 & ~1023) | ((((g >> 4) * 8 + wv) << 4) | (g & 15))); } }
    cv_issue(a, st.jb, mi, lane);
    st.next += st.stride;
}

__device__ __forceinline__ void channel(const Args& a, LAS unsigned char* lds, int c, unsigned char* scratch, CvState& cvs) {
    const int tid = threadIdx.x;
#define CV_STEP() cv_step(a, cvs, tid & 63)
    LAS f32x2* X = (LAS f32x2*)lds;
    f32x2* Hs = (f32x2*)scratch;
    const _Float16* HF = (const _Float16*)(a.ws + WS_HF);
    const int pc = 17 * tid + 16 * (tid >> 5);
    __syncthreads();
#pragma unroll 1
    for (int o = 0; o < 2; ++o) {
        typedef _Float16 f16x8_ __attribute__((ext_vector_type(8)));
        const f16x8_* hf = (const f16x8_*)(HF + ((size_t)(2 * o) * HYW + c) * SEQ + 16 * tid); const f16x8_* hb = (const f16x8_*)(HF + ((size_t)(2 * o + 1) * HYW + c) * SEQ + 16 * tid);
#pragma unroll
        for (int q = 0; q < 2; ++q) { const f16x8_ f = hf[q], b = hb[q];
#pragma unroll
            for (int e = 0; e < 8; ++e) { const int i = 8 * q + e, t = 16 * tid + i;
                X[pc + i] = (f32x2){(float)f[e], 0.f};
                if (t >= 1) X[phys(FFTN - t)] = (f32x2){(float)b[e], 0.f}; } }
        if (tid == 0) X[phys(SEQ)] = (f32x2){0.f, 0.f};
        __syncthreads();
        CV_STEP(); pass_fwd32<512>(X, tid); __syncthreads(); CV_STEP(); pass_fwd32<16>(X, tid); __syncthreads(); pass_c_store(X, Hs + (size_t)o * (FFTN / 2), tid, 1.f); __syncthreads();
    }
    const float* cw = a.in[I_CONVW]; const float* cbv = a.in[I_CONVB]; const float* dbias = a.in[I_BIASD];
    const float d1 = dbias[c], d2 = dbias[HYW + c];
    constexpr float INVN = 1.f / (float)FFTN;
    float wv[3][3], bv[3];
#pragma unroll
    for (int s = 0; s < 3; ++s) { bv[s] = cbv[s * HYW + c];
#pragma unroll
        for (int i = 0; i < 3; ++i) wv[s][i] = cw[i * HYC + s * HYW + c]; }
    const bf16_t* UT = (const bf16_t*)(a.ws + WS_UT);
    bf16_t* YT = (bf16_t*)(a.ws + WS_YHYT);
#pragma unroll 1
    for (int bp = 0; bp < 2; ++bp) {
        const bf16_t* u0 = UT + ((size_t)(2 * bp) * HYC + c) * SEQ; const bf16_t* u1 = UT + ((size_t)(2 * bp + 1) * HYC + c) * SEQ;
        float z0[16], z1[16];
        {
            float v0[16], v1[16]; sconv16(u0, tid, wv[0][0], wv[0][1], wv[0][2], bv[0], v0); sconv16(u1, tid, wv[0][0], wv[0][1], wv[0][2], bv[0], v1);
#pragma unroll
            for (int i = 0; i < 16; ++i) X[pc + i] = (f32x2){v0[i], v1[i]};
        }
        __syncthreads();
        CV_STEP(); pass_fwd32<512, true>(X, tid); __syncthreads(); CV_STEP(); pass_fwd32<16>(X, tid); __syncthreads(); pass_c_mul_inv(X, Hs, tid); __syncthreads(); CV_STEP(); pass_inv32<16>(X, tid); __syncthreads(); CV_STEP(); pass_inv32<512, true>(X, tid); __syncthreads();
        {
            float v0[16], v1[16], x0[16], x1[16];
            sconv16(u0, tid, wv[0][0], wv[0][1], wv[0][2], bv[0], v0); sconv16(u1, tid, wv[0][0], wv[0][1], wv[0][2], bv[0], v1);
            sconv16(u0 + (size_t)HYW * SEQ, tid, wv[1][0], wv[1][1], wv[1][2], bv[1], x0); sconv16(u1 + (size_t)HYW * SEQ, tid, wv[1][0], wv[1][1], wv[1][2], bv[1], x1);
#pragma unroll
            for (int i = 0; i < 16; ++i) { const f32x2 y1 = X[pc + i]; z0[i] = x0[i] * (y1[0] * INVN + d1 * v0[i]); z1[i] = x1[i] * (y1[1] * INVN + d1 * v1[i]); X[pc + i] = (f32x2){z0[i], z1[i]}; }
        }
        __syncthreads();
        CV_STEP(); pass_fwd32<512, true>(X, tid); __syncthreads(); CV_STEP(); pass_fwd32<16>(X, tid); __syncthreads(); pass_c_mul_inv(X, Hs + FFTN / 2, tid); __syncthreads(); CV_STEP(); pass_inv32<16>(X, tid); __syncthreads(); CV_STEP(); pass_inv32<512, true>(X, tid); __syncthreads();
        {
            float x0[16], x1[16];
            sconv16(u0 + (size_t)2 * HYW * SEQ, tid, wv[2][0], wv[2][1], wv[2][2], bv[2], x0); sconv16(u1 + (size_t)2 * HYW * SEQ, tid, wv[2][0], wv[2][1], wv[2][2], bv[2], x1);
            unsigned w0[8], w1[8];
#pragma unroll
            for (int i = 0; i < 8; ++i) { const f32x2 ya = X[pc + 2 * i], yb = X[pc + 2 * i + 1];
                w0[i] = pk2(x0[2 * i] * (ya[0] * INVN + d2 * z0[2 * i]), x0[2 * i + 1] * (yb[0] * INVN + d2 * z0[2 * i + 1]));
                w1[i] = pk2(x1[2 * i] * (ya[1] * INVN + d2 * z1[2 * i]), x1[2 * i + 1] * (yb[1] * INVN + d2 * z1[2 * i + 1])); }
            u32x4* y0p = (u32x4*)(YT + ((size_t)(2 * bp) * HYW + c) * SEQ + 16 * tid); u32x4* y1p = (u32x4*)(YT + ((size_t)(2 * bp + 1) * HYW + c) * SEQ + 16 * tid);
            y0p[0] = (u32x4){w0[0], w0[1], w0[2], w0[3]}; y0p[1] = (u32x4){w0[4], w0[5], w0[6], w0[7]};
            y1p[0] = (u32x4){w1[0], w1[1], w1[2], w1[3]}; y1p[1] = (u32x4){w1[4], w1[5], w1[6], w1[7]};
        }
        __syncthreads();
    }
#undef CV_STEP
}

constexpr int FILT_RS = 68;
__device__ __forceinline__ void filter_item(const Args& a, int item, int lane, const LAS float* hs) {
    const int ct = item & 127, tc = item >> 7;
    const float* wout = a.in[I_FWOUT]; _Float16* HF = (_Float16*)(a.ws + WS_HF);
    const int col = 16 * ct + (lane & 15), kq = lane >> 4, cch = col & 511;
    typedef _Float16 f16x8f __attribute__((ext_vector_type(8)));
    f16x8f bfr[2];
#pragma unroll
    for (int s = 0; s < 2; ++s)
#pragma unroll
        for (int i = 0; i < 8; ++i) bfr[s][i] = (_Float16)wout[(size_t)(32 * s + 8 * kq + i) * 2048 + col];
    const float dlt = fabsf(-3.0701134573253945f + (float)cch * ((-15.350567286626973f + 3.0701134573253945f) / 511.f));
#pragma unroll 4
    for (int tt = 0; tt < 32; ++tt) { const int t0 = 512 * tc + 16 * tt;
        const LAS f32x4* ar = (const LAS f32x4*)(hs + (16 * tt + (lane & 15)) * FILT_RS + 8 * kq);
        const f32x4 a0 = ar[0], a1 = ar[1], a2 = ar[8], a3 = ar[9];
        const f16x8f af0 = {(_Float16)a0[0], (_Float16)a0[1], (_Float16)a0[2], (_Float16)a0[3], (_Float16)a1[0], (_Float16)a1[1], (_Float16)a1[2], (_Float16)a1[3]};
        const f16x8f af1 = {(_Float16)a2[0], (_Float16)a2[1], (_Float16)a2[2], (_Float16)a2[3], (_Float16)a3[0], (_Float16)a3[1], (_Float16)a3[2], (_Float16)a3[3]};
        f32x4 acc = {0.f, 0.f, 0.f, 0.f};
        acc = __builtin_amdgcn_mfma_f32_16x16x32_f16(af0, bfr[0], acc, 0, 0, 0);
        acc = __builtin_amdgcn_mfma_f32_16x16x32_f16(af1, bfr[1], acc, 0, 0, 0);
        f32x4 o;
#pragma unroll
        for (int r = 0; r < 4; ++r) o[r] = acc[r] * __expf(-((float)(t0 + 4 * kq + r) / (float)(SEQ - 1)) * dlt);
        typedef _Float16 f16x4_ __attribute__((ext_vector_type(4)));
        *(f16x4_*)(HF + (size_t)col * SEQ + t0 + 4 * kq) = (f16x4_){(_Float16)o[0], (_Float16)o[1], (_Float16)o[2], (_Float16)o[3]}; }
}

__device__ __forceinline__ void transpose_item(const Args& a, int item, int lane) {
    const int lt = item & 31, ct = (item >> 5) & 15, b = item >> 9;
    const u32x2* src = (const u32x2*)((const bf16_t*)(a.ws + WS_YHYT) + ((size_t)b * HYW + 32 * ct) * SEQ + 256 * lt) + lane;
    bf16_t* dst = (bf16_t*)(a.ws + WS_MIX) + ((size_t)b * SEQ + 256 * lt + 4 * lane) * 1024 + 512 + 32 * ct;
    u32x2 v[32];
#pragma unroll
    for (int cc = 0; cc < 32; ++cc) v[cc] = src[(size_t)cc * (SEQ / 4)];
#pragma unroll
    for (int q = 0; q < 4; ++q) { u32x4 r0, r1, r2, r3;
#pragma unroll
        for (int e = 0; e < 4; ++e) { const u32x2 x = v[8 * q + 2 * e], y = v[8 * q + 2 * e + 1];
            r0[e] = (x.x & 0xffffu) | (y.x << 16); r1[e] = (x.x >> 16) | (y.x & 0xffff0000u); r2[e] = (x.y & 0xffffu) | (y.y << 16); r3[e] = (x.y >> 16) | (y.y & 0xffff0000u); }
        *(u32x4*)(dst + 8 * q) = r0; *(u32x4*)(dst + 1024 + 8 * q) = r1; *(u32x4*)(dst + 2048 + 8 * q) = r2; *(u32x4*)(dst + 3072 + 8 * q) = r3; }
}
}

__device__ __forceinline__ void p0_mod_and_filter(const Args& a, LAS unsigned char* lds) {
    const int tid = threadIdx.x, lane = tid & 63, wave = tid >> 6;
    const float* c = a.in[I_C]; const float* cctx = a.in[I_CCTX]; const float* adaw = a.in[I_ADAW]; const float* adab = a.in[I_ADAB];
    float* mod = (float*)(a.ws + WS_MOD);
    LAS float* sl = (LAS float*)lds;
    LAS float* pt = (LAS float*)lds + 5 * 1024;
    for (int i = tid; i < 5 * 1024; i += NTHREADS) { const int r = i >> 10, k = i & 1023; sl[i] = silu_f(r < 4 ? c[r * 1024 + k] : cctx[k]); }
    for (int it = blockIdx.x; it < 256; it += gridDim.x) {
        __syncthreads();
        if (tid < 504) {
            const int col = tid % 24, ks = tid / 24, n = it * 24 + col, kbeg = ks * 49, kend = (kbeg + 49 < 1024) ? kbeg + 49 : 1024;
            float acc[5] = {0.f, 0.f, 0.f, 0.f, 0.f};
#pragma unroll 7
            for (int k = kbeg; k < kend; ++k) { const float w = adaw[(size_t)k * 6144 + n];
#pragma unroll
                for (int r = 0; r < 5; ++r) acc[r] += sl[r * 1024 + k] * w; }
#pragma unroll
            for (int r = 0; r < 5; ++r) pt[(ks * 5 + r) * 24 + col] = acc[r];
        }
        __syncthreads();
        if (tid < 120) { const int r = tid / 24, col = tid % 24, n = it * 24 + col; float s = adab[n];
            for (int ks = 0; ks < 21; ++ks) s += pt[(ks * 5 + r) * 24 + col];
            mod[r * 6144 + n] = s; }
    }
    __syncthreads();
    const float* w1 = a.in[I_FW1]; const float* b1 = a.in[I_FB1]; const float* w2 = a.in[I_FW2]; const float* b2 = a.in[I_FB2]; const float* fq = a.in[I_FFREQ];
    float* hid2 = (float*)(a.ws + WS_HID2);
    LAS float* zs = (LAS float*)lds + 8192 + wave * 128;
    const float frq = fq[lane], bb1 = b1[lane], bb2 = b2[lane];
    for (int t = (blockIdx.x * NWAVES + wave); t < SEQ; t += gridDim.x * NWAVES) {
        float z = 0.f;
        if (lane == 0) z = (float)t / (float)(SEQ - 1);
        else if (lane < 33) { const int i = (lane - 1) & 15; const float f = 1e-4f + (float)i * ((15.f - 1e-4f) / 15.f);
            const float ang = (6.283185307179586f * (float)t / (float)SEQ) * f; z = (lane < 17) ? cosf(ang) : -sinf(ang); }
        if (lane < 33) zs[lane] = z;
        __builtin_amdgcn_wave_barrier(); asm volatile("s_waitcnt lgkmcnt(0)" ::: "memory");
        float s = bb1;
#pragma unroll
        for (int e = 0; e < 33; ++e) s += zs[e] * w1[e * 64 + lane];
        const float h1 = sinf(frq * s);
        zs[64 + lane] = h1;
        __builtin_amdgcn_wave_barrier(); asm volatile("s_waitcnt lgkmcnt(0)" ::: "memory");
        float s2 = bb2;
#pragma unroll 16
        for (int g = 0; g < 64; ++g) s2 += zs[64 + g] * w2[g * 64 + lane];
        hid2[(size_t)t * 64 + lane] = sinf(frq * s2);
        __builtin_amdgcn_wave_barrier(); asm volatile("s_waitcnt lgkmcnt(0)" ::: "memory");
    }
}

template <bool FP8 = false>
__device__ __forceinline__ void tr_item(const float* W, int ldw, int k0, int c0, int cstride, float scale, bf16_t* dstrow0, LAS float* scr, int lane) {
    float wv_[32];
#pragma unroll
    for (int i = 0; i < 32; ++i) wv_[i] = W[(size_t)(k0 + 2 * i + (lane >> 5)) * ldw + c0 + (lane & 31) * cstride];
#pragma unroll
    for (int i = 0; i < 32; ++i) scr[(2 * i + (lane >> 5)) * 33 + (lane & 31)] = wv_[i] * scale;
    asm volatile("s_waitcnt lgkmcnt(0)" ::: "memory"); __builtin_amdgcn_wave_barrier();
    const int c = lane & 7;
#pragma unroll
    for (int j = 0; j < 4; ++j) { const int n = (lane >> 3) + 8 * j; const LAS float* s = scr + (8 * c) * 33 + n;
        if (FP8) { u32x2 o; o.x = gm::pk4_fp8(s[0 * 33], s[1 * 33], s[2 * 33], s[3 * 33]); o.y = gm::pk4_fp8(s[4 * 33], s[5 * 33], s[6 * 33], s[7 * 33]);
            *(u32x2*)((unsigned char*)dstrow0 + (size_t)n * 1024 + k0 + 8 * c) = o; }
        else { u32x4 o; o.x = pk2(s[0 * 33], s[1 * 33]); o.y = pk2(s[2 * 33], s[3 * 33]); o.z = pk2(s[4 * 33], s[5 * 33]); o.w = pk2(s[6 * 33], s[7 * 33]);
            *(u32x4*)(dstrow0 + (size_t)n * 1024 + k0 + 8 * c) = o; } }
    asm volatile("s_waitcnt lgkmcnt(0)" ::: "memory"); __builtin_amdgcn_wave_barrier();
}
__device__ __forceinline__ void fold_item(const float* win, const float* wa, int dir, int k0, int j0, bf16_t* dstrow0, LAS float* scr, int lane) {
#pragma unroll 4
    for (int i = 0; i < 32; ++i) { const int kk = 2 * i + (lane >> 5); const float* wr = win + (size_t)(k0 + kk) * INW + 1536 + 16 * dir; float s = 0.f;
#pragma unroll
        for (int r = 0; r < 16; ++r) s += wr[r] * wa[r * 256 + j0 + (lane & 31)];
        scr[kk * 33 + (lane & 31)] = s * gm::S_WIN; }
    asm volatile("s_waitcnt lgkmcnt(0)" ::: "memory"); __builtin_amdgcn_wave_barrier();
    const int c = lane & 7;
#pragma unroll
    for (int j = 0; j < 4; ++j) { const int n = (lane >> 3) + 8 * j; const LAS float* s = scr + (8 * c) * 33 + n;
        u32x2 o; o.x = gm::pk4_fp8(s[0 * 33], s[1 * 33], s[2 * 33], s[3 * 33]); o.y = gm::pk4_fp8(s[4 * 33], s[5 * 33], s[6 * 33], s[7 * 33]);
        *(u32x2*)((unsigned char*)dstrow0 + (size_t)n * 1024 + k0 + 8 * c) = o; }
    asm volatile("s_waitcnt lgkmcnt(0)" ::: "memory"); __builtin_amdgcn_wave_barrier();
}
__device__ __forceinline__ void ln_mod_row(const float* xrow, const float* shift, const float* scale, bf16_t* orow, int lane) {
    const f32x4* xr = (const f32x4*)xrow + lane;
    f32x4 v[4]; float s = 0.f;
#pragma unroll
    for (int j = 0; j < 4; ++j) { v[j] = xr[64 * j]; s += (v[j][0] + v[j][1]) + (v[j][2] + v[j][3]); }
    const float mean = wave_sum(s) * (1.f / D); float s2 = 0.f;
#pragma unroll
    for (int j = 0; j < 4; ++j) { v[j] = v[j] - mean; s2 += (v[j][0] * v[j][0] + v[j][1] * v[j][1]) + (v[j][2] * v[j][2] + v[j][3] * v[j][3]); }
    const float rstd = 1.f / sqrtf(wave_sum(s2) * (1.f / D) + LN_EPS);
    u32x2* o8 = (u32x2*)orow + lane;
#pragma unroll
    for (int j = 0; j < 4; ++j) { const f32x4 sh = ((const f32x4*)shift)[64 * j + lane], sc = ((const f32x4*)scale)[64 * j + lane];
        const f32x4 y = v[j] * rstd * (sc + 1.f) + sh;
        u32x2 w; w.x = pk2(y[0], y[1]); w.y = pk2(y[2], y[3]); o8[64 * j] = w; }
}
constexpr int PREP_I_IN = 16 * 96, PREP_I_FOLD = 16 * 8 * 2, PREP_I_OUT = 16 * 32, PREP_I_W1 = NE * 16 * 64, PREP_I_W2 = NE * 16 * 32;
constexpr int PREP_NITEMS = PREP_I_IN + PREP_I_FOLD + PREP_I_OUT + PREP_I_W1 + PREP_I_W2;
constexpr int PREP_DEFER = PREP_I_W2 - hy::CV_W2E * 512;
__device__ __forceinline__ void prep_items(const Args& a, LAS float* scr, int first, int last, int rank, int nranks, int lane) {
    constexpr int I_IN = PREP_I_IN, I_FOLD = PREP_I_FOLD, I_OUT = PREP_I_OUT, I_W1 = PREP_I_W1;
    const float* win = a.in[I_WIN];
    bf16_t* btin = (bf16_t*)(a.ws + WS_BTIN); bf16_t* btout = (bf16_t*)(a.ws + WS_BTOUT); bf16_t* w1t = (bf16_t*)(a.ws + WS_W1T); bf16_t* w2t = (bf16_t*)(a.ws + WS_W2T);
    for (int it = first + rank; it < last; it += nranks) {
        int r = it;
        if (r < I_IN) {
            const int kb = r / 96, nb = r % 96;
            if (nb < 48) tr_item<true>(win, INW, 64 * kb, 32 * nb, 1, gm::S_WIN, (bf16_t*)((unsigned char*)btin + (size_t)(32 * nb) * 1024), scr, lane);
            else tr_item(win, INW, 64 * kb, 1568 + 32 * (nb - 48), 1, 1.f, (bf16_t*)((unsigned char*)btin + (size_t)2048 * 1024) + (size_t)(32 * (nb - 48)) * 1024, scr, lane);
            continue; }
        r -= I_IN;
        if (r < I_FOLD) { const int dir = r & 1, jb = (r >> 1) & 7, kb = r >> 4;
            fold_item(win, dir ? a.in[I_WAB] : a.in[I_WAF], dir, 64 * kb, 32 * jb, (bf16_t*)((unsigned char*)btin + (size_t)(1536 + 256 * dir + 32 * jb) * 1024), scr, lane); continue; }
        r -= I_FOLD;
        if (r < I_OUT) { const int kb = r / 32, nb = r % 32; tr_item(a.in[I_WOUT], 1024, 64 * kb, 32 * nb, 1, 1.f, btout + (size_t)(32 * nb) * 1024, scr, lane); continue; }
        r -= I_OUT;
        if (r < I_W1) {
            const int e = r / 1024, q = r % 1024, s = q & 1, nb = (q >> 1) & 31, kb = q >> 6;
            const int ct = nb >> 2, jj0 = (nb & 3) * 32;
            tr_item<true>(a.in[I_EW1] + (size_t)e * 1024 * 2048, 2048, 64 * kb, 2 * (128 * ct + jj0) + s, 2, gm::S_W, (bf16_t*)((unsigned char*)w1t + ((size_t)e * 2048 + 256 * ct + 128 * s + jj0) * 1024), scr, lane);
            continue; }
        r -= I_W1;
        { const int e = r / 512, q = r % 512, kb = q / 32, nb = q % 32;
          tr_item<true>(a.in[I_EW2] + (size_t)e * 1024 * 1024, 1024, 64 * kb, 32 * nb, 1, gm::S_W, (bf16_t*)((unsigned char*)w2t + ((size_t)e * 1024 + 32 * nb) * 1024), scr, lane); }
    }
}
__device__ __forceinline__ void p1_prep(const Args& a, LAS unsigned char* lds) {
    const int tid = threadIdx.x, lane = tid & 63, wave = tid >> 6;
    LAS float* scr = (LAS float*)(lds + wave * 16384);
    const int gw = blockIdx.x * NWAVES + wave, NGW = gridDim.x * NWAVES;
    const float* win = a.in[I_WIN];
    bf16_t* btin = (bf16_t*)(a.ws + WS_BTIN); bf16_t* btout = (bf16_t*)(a.ws + WS_BTOUT); bf16_t* w1t = (bf16_t*)(a.ws + WS_W1T); bf16_t* w2t = (bf16_t*)(a.ws + WS_W2T);
    const float* mod = (const float*)(a.ws + WS_MOD);
    bf16_t* H = (bf16_t*)(a.ws + WS_H);
    { int cur_mr = -1; f32x4 shv[4], scv[4];
#pragma unroll
      for (int j = 0; j < 4; ++j) { shv[j] = (f32x4){0.f, 0.f, 0.f, 0.f}; scv[j] = shv[j]; }
#define P1_LOAD(dst, r0_) do { _Pragma("unroll") for (int i = 0; i < 4; ++i) { const int row = (r0_) + i * NGW; \
            if (row < TT) { const f32x4* xr = (const f32x4*)(row < T ? a.in[I_X] + (size_t)row * D : a.in[I_CTX] + (size_t)(row - T) * D) + lane; \
                _Pragma("unroll") for (int j = 0; j < 4; ++j) dst[i][j] = xr[64 * j]; } } } while (0)
      f32x4 xv[4][4], xnx[4][4];
      P1_LOAD(xv, gw);
      for (int row0 = gw; row0 < TT; row0 += 4 * NGW) {
        if (row0 + 4 * NGW < TT) P1_LOAD(xnx, row0 + 4 * NGW);
#pragma unroll
        for (int i = 0; i < 4; ++i) { const int row = row0 + i * NGW;
            if (row < TT) { const int mr = row < T ? row >> 13 : 4;
                if (mr != cur_mr) { cur_mr = mr;
#pragma unroll
                    for (int j = 0; j < 4; ++j) { shv[j] = ((const f32x4*)(mod + mr * 6144))[64 * j + lane]; scv[j] = ((const f32x4*)(mod + mr * 6144 + 1024))[64 * j + lane]; } }
                f32x4 v[4]; float s = 0.f;
#pragma unroll
                for (int j = 0; j < 4; ++j) { v[j] = xv[i][j]; s += (v[j][0] + v[j][1]) + (v[j][2] + v[j][3]); }
                const float mean = wave_sum(s) * (1.f / D); float s2 = 0.f;
#pragma unroll
                for (int j = 0; j < 4; ++j) { v[j] = v[j] - mean; s2 += (v[j][0] * v[j][0] + v[j][1] * v[j][1]) + (v[j][2] * v[j][2] + v[j][3] * v[j][3]); }
                const float rstd = 1.f / sqrtf(wave_sum(s2) * (1.f / D) + LN_EPS);
                u32x2* o8 = (u32x2*)(H + (size_t)row * D) + lane;
                unsigned* o4 = (unsigned*)(a.ws + WS_H8 + (size_t)row * D) + lane;
#pragma unroll
                for (int j = 0; j < 4; ++j) { const f32x4 y = v[j] * rstd * (scv[j] + 1.f) + shv[j];
                    if (row < T) { u32x2 w; w.x = pk2(y[0], y[1]); w.y = pk2(y[2], y[3]); o8[64 * j] = w; }
                    o4[64 * j] = gm::pk4_fp8(y[0] * gm::S_HIN, y[1] * gm::S_HIN, y[2] * gm::S_HIN, y[3] * gm::S_HIN); } } }
#pragma unroll
        for (int i = 0; i < 4; ++i)
#pragma unroll
            for (int j = 0; j < 4; ++j) xv[i][j] = xnx[i][j];
      }
#undef P1_LOAD
    }
    prep_items(a, scr, 0, PREP_I_IN + PREP_I_FOLD + PREP_I_OUT, gw, NGW, lane);
    for (int it0 = blockIdx.x * NWAVES; it0 < 2048; it0 += NGW) {
        __syncthreads();
        { const f32x4* src = (const f32x4*)((const float*)(a.ws + WS_HID2) + (size_t)(it0 >> 7) * 512 * 64); LAS float* hs = (LAS float*)lds;
#pragma unroll
          for (int i = 0; i < 16; ++i) { const int pz = tid + NTHREADS * i; *(LAS f32x4*)(hs + (pz >> 4) * hy::FILT_RS + 4 * (pz & 15)) = src[pz]; } }
        __syncthreads();
        hy::filter_item(a, it0 + wave, lane, (const LAS float*)lds);
    }
    float* b1r = (float*)(a.ws + WS_B1R); const float* eb1 = a.in[I_EB1];
    for (int i = blockIdx.x * NTHREADS + tid; i < NE * 2048; i += gridDim.x * NTHREADS) {
        const int e = i >> 11, n = i & 2047, ct = n >> 8, s = (n >> 7) & 1, jj = n & 127;
        b1r[i] = eb1[(size_t)e * 2048 + 2 * (128 * ct + jj) + s];
    }
}

namespace gla {
constexpr int RS = 72;
constexpr int L_TOTF = 0, L_TOTB = 2048, L_SSQ = 4096;
constexpr int L_T0 = 8192;
constexpr int L_T1 = L_T0 + 9216, L_T2 = L_T1 + 9216, L_T3 = L_T2 + 9216;
constexpr int L_VT = L_T3 + 9216;
constexpr int L_P  = L_VT + 18432;
constexpr int L_SF = L_P + 9216, L_SB = L_SF + 18432;
constexpr int L_END = L_SB + 18432;

__device__ __forceinline__ bf16x8 frag(const LAS unsigned char* tile, int row, int k0, int lane) {
    return *(const LAS bf16x8*)(tile + ((row + (lane & 15)) * RS + k0 + 8 * (lane >> 4)) * 2);
}
__device__ __forceinline__ void chunk_cums_pre(LAS unsigned char* L, const float (&gf)[8], const float (&gb)[8], int wave, int lane, float (&cumf)[8], float (&cumb)[8], float& allf, float& allb) {
    LAS float* totf = (LAS float*)(L + L_TOTF); LAS float* totb = (LAS float*)(L + L_TOTB);
    cumf[0] = gf[0];
#pragma unroll
    for (int r = 1; r < 8; ++r) cumf[r] = cumf[r - 1] + gf[r];
    cumb[7] = gb[7];
#pragma unroll
    for (int r = 6; r >= 0; --r) cumb[r] = cumb[r + 1] + gb[r];
    totf[wave * 64 + lane] = cumf[7]; totb[wave * 64 + lane] = cumb[0];
    __syncthreads();
    float of = 0.f, ob = 0.f, af = 0.f, ab = 0.f;
#pragma unroll
    for (int w = 0; w < 8; ++w) { const float tf = totf[w * 64 + lane], tb = totb[w * 64 + lane]; af += tf; ab += tb; of += (w < wave) ? tf : 0.f; ob += (w > wave) ? tb : 0.f; }
#pragma unroll
    for (int r = 0; r < 8; ++r) { cumf[r] += of; cumb[r] += ob; }
    allf = af; allb = ab;
}
__device__ __forceinline__ void chunk_cums(LAS unsigned char* L, const _Float16* GF, const _Float16* GB, size_t tok0, int h, int wave, int lane, float (&cumf)[8], float (&cumb)[8], float& allf, float& allb) {
    float gf[8], gb[8];
#pragma unroll
    for (int r = 0; r < 8; ++r) { const size_t o = (tok0 + 8 * wave + r) * 256 + h * 64 + lane; gf[r] = (float)GF[o]; gb[r] = (float)GB[o]; }
    chunk_cums_pre(L, gf, gb, wave, lane, cumf, cumb, allf, allb);
}
__device__ __forceinline__ void store_vt(LAS unsigned char* L, const u32x4 (&vr)[2], int tid) {
    LAS bf16_t* vt = (LAS bf16_t*)(L + L_VT);
    const int j = tid >> 3, c8 = tid & 7;
#pragma unroll
    for (int q = 0; q < 2; ++q) { const int dv0 = 8 * (c8 + 8 * q);
        const unsigned ww[4] = {vr[q].x, vr[q].y, vr[q].z, vr[q].w};
#pragma unroll
        for (int e = 0; e < 4; ++e) { vt[(dv0 + 2 * e) * RS + j] = (bf16_t)(ww[e] & 0xffffu); vt[(dv0 + 2 * e + 1) * RS + j] = (bf16_t)(ww[e] >> 16); } }
}
__device__ __forceinline__ void load_vt(LAS unsigned char* L, const bf16_t* V, size_t tok0, int h, int tid) {
    const int j = tid >> 3, c8 = tid & 7; u32x4 vr[2];
#pragma unroll
    for (int q = 0; q < 2; ++q) vr[q] = *(const u32x4*)(V + (tok0 + j) * 512 + h * 128 + 8 * (c8 + 8 * q));
    store_vt(L, vr, tid);
}

__device__ __forceinline__ void g1_unit(const Args& a, LAS unsigned char* L, int bh, int chunk  ) {
    const int tid = threadIdx.x, lane = tid & 63, wave = __builtin_amdgcn_readfirstlane(tid >> 6);
    const int b = bh >> 2, h = bh & 3;
    const size_t tok0 = chunk < NCHUNK ? (size_t)b * SEQ + (size_t)chunk * CH : (size_t)T + (size_t)b * CTXL + (size_t)(chunk - NCHUNK) * CH;
    const _Float16* GF = (const _Float16*)(a.ws + WS_GF); const _Float16* GB = (const _Float16*)(a.ws + WS_GB);
    const bf16_t* Kb = (const bf16_t*)(a.ws + WS_K); const bf16_t* Vb = (const bf16_t*)(a.ws + WS_V);
    float cumf[8], cumb[8], allf, allb;
    __syncthreads();
    chunk_cums(L, GF, GB, tok0, h, wave, lane, cumf, cumb, allf, allb);
    LAS bf16_t* ketf = (LAS bf16_t*)(L + L_T0); LAS bf16_t* ketb = (LAS bf16_t*)(L + L_T1);
#pragma unroll
    for (int r = 0; r < 8; ++r) { const int i = 8 * wave + r; const float kv = bf2f(Kb[(tok0 + i) * 256 + h * 64 + lane]);
        ketf[lane * RS + i] = f2bf(kv * __expf(allf - cumf[r])); ketb[lane * RS + i] = f2bf(kv * __expf(allb - cumb[r])); }
    load_vt(L, Vb, tok0, h, tid);
    if (wave == 0) { float* av = (float*)(a.ws + WS_AV); av[((size_t)(0 * 16 + bh) * NCT + chunk) * 64 + lane] = __expf(allf); av[((size_t)(1 * 16 + bh) * NCT + chunk) * 64 + lane] = __expf(allb); }
    __syncthreads();
    bf16_t* KV = (bf16_t*)(a.ws + WS_KV);
#pragma unroll
    for (int dir = 0; dir < 2; ++dir) {
        const LAS unsigned char* ket = L + (dir ? L_T1 : L_T0);
        bf16_t* dst = KV + ((size_t)(dir * 16 + bh) * NCT + chunk) * 8192;
#pragma unroll
        for (int nt = 0; nt < 4; ++nt) { f32x4 acc = {0.f, 0.f, 0.f, 0.f};
#pragma unroll
            for (int ks = 0; ks < 2; ++ks) acc = __builtin_amdgcn_mfma_f32_16x16x32_bf16(frag(ket, 16 * nt, 32 * ks, lane), frag(L + L_VT, 16 * wave, 32 * ks, lane), acc, 0, 0, 0);
            u32x2 w; w.x = pk2(acc[0], acc[1]); w.y = pk2(acc[2], acc[3]);
            *(u32x2*)(dst + (16 * wave + (lane & 15)) * 64 + 16 * nt + 4 * (lane >> 4)) = w; }
    }
}

__device__ __forceinline__ void g2_scan(const Args& a, LAS unsigned char* L) {
    const bf16_t* KV = (const bf16_t*)(a.ws + WS_KV); const float* AV = (const float*)(a.ws + WS_AV); bf16_t* SP = (bf16_t*)(a.ws + WS_SP);
    LAS float* avs = (LAS float*)L;
    for (int id0 = blockIdx.x * NTHREADS; id0 < 32 * 4096; id0 += gridDim.x * NTHREADS) {
        const int id = id0 + threadIdx.x;
        const int db = id >> 12, e2 = id & 4095, dir = db >> 4, dk = (2 * e2) & 63;
        __syncthreads();
        for (int i = threadIdx.x; i < NCT * 64 / 4; i += NTHREADS) ((LAS f32x4*)avs)[i] = ((const f32x4*)(AV + (size_t)db * NCT * 64))[i];
        __syncthreads();
        const unsigned* kv = (const unsigned*)(KV + (size_t)db * NCT * 8192) + e2;
        const LAS float* av = avs + dk;
        unsigned* sp = (unsigned*)(SP + (size_t)db * NCHUNK * 8192) + e2;
        float s0 = 0.f, s1 = 0.f;
#pragma unroll
        for (int q = 0; q < NCC; ++q) { const int c = NCHUNK + (dir ? (NCC - 1 - q) : q);
            const unsigned w = kv[(size_t)c * 4096]; const f32x2 aa = *(const LAS f32x2*)(av + c * 64);
            s0 = aa[0] * s0 + bflo(w); s1 = aa[1] * s1 + bfhi(w); }
        for (int q0 = 0; q0 < NCHUNK; q0 += 32) {
            unsigned w[32];
#pragma unroll
            for (int u = 0; u < 32; ++u) { const int c = dir ? (NCHUNK - 1 - (q0 + u)) : (q0 + u); w[u] = kv[(size_t)c * 4096]; }
#pragma unroll
            for (int u = 0; u < 32; ++u) { const int c = dir ? (NCHUNK - 1 - (q0 + u)) : (q0 + u);
                const f32x2 aa = *(const LAS f32x2*)(av + c * 64);
                sp[(size_t)c * 4096] = pk2(s0, s1);
                s0 = aa[0] * s0 + bflo(w[u]); s1 = aa[1] * s1 + bfhi(w[u]); }
        }
    }
}

struct G3In { float gf[8], gb[8]; bf16_t q[8], k[8]; u32x4 v[2]; u32x4 sraw[4]; u32x2 gr[4]; };
__device__ __forceinline__ void g3_load(const Args& a, int bh, int chunk, G3In& in) {
    const int tid = threadIdx.x, lane = tid & 63, wave = __builtin_amdgcn_readfirstlane(tid >> 6);
    const int b = bh >> 2, h = bh & 3;
    const size_t tok0 = (size_t)b * SEQ + (size_t)chunk * CH;
    const _Float16* GF = (const _Float16*)(a.ws + WS_GF); const _Float16* GB = (const _Float16*)(a.ws + WS_GB);
    const bf16_t* Qb = (const bf16_t*)(a.ws + WS_Q); const bf16_t* Kb = (const bf16_t*)(a.ws + WS_K); const bf16_t* Vb = (const bf16_t*)(a.ws + WS_V);
#pragma unroll
    for (int r = 0; r < 8; ++r) { const size_t o = (tok0 + 8 * wave + r) * 256 + h * 64 + lane; in.gf[r] = (float)GF[o]; in.gb[r] = (float)GB[o]; in.q[r] = Qb[o]; in.k[r] = Kb[o]; }
#pragma unroll
    for (int q = 0; q < 2; ++q) in.v[q] = *(const u32x4*)(Vb + (tok0 + (tid >> 3)) * 512 + h * 128 + 8 * ((tid & 7) + 8 * q));
    const bf16_t* SPf = (const bf16_t*)(a.ws + WS_SP) + ((size_t)(0 * 16 + bh) * NCHUNK + chunk) * 8192;
    const bf16_t* SPb = (const bf16_t*)(a.ws + WS_SP) + ((size_t)(1 * 16 + bh) * NCHUNK + chunk) * 8192;
    in.sraw[0] = *(const u32x4*)(SPf + 16 * tid); in.sraw[1] = *(const u32x4*)(SPf + 16 * tid + 8);
    in.sraw[2] = *(const u32x4*)(SPb + 16 * tid); in.sraw[3] = *(const u32x4*)(SPb + 16 * tid + 8);
    const bf16_t* Gt = (const bf16_t*)(a.ws + WS_G);
    const int mt = wave >> 1, fr = lane & 15, fq = lane >> 4;
#pragma unroll
    for (int q = 0; q < 4; ++q) in.gr[q] = *(const u32x2*)(Gt + (tok0 + 16 * mt + fr) * 512 + h * 128 + 16 * (4 * (wave & 1) + q) + 4 * fq);
}
__device__ __forceinline__ void g3_unit(const Args& a, LAS unsigned char* L, int bh, int chunk  , const G3In& in) {
    const int tid = threadIdx.x, lane = tid & 63, wave = __builtin_amdgcn_readfirstlane(tid >> 6);
    const int b = bh >> 2, h = bh & 3;
    const size_t tok0 = (size_t)b * SEQ + (size_t)chunk * CH;
    const int mt = wave >> 1, fr = lane & 15, fq = lane >> 4;
    float cumf[8], cumb[8], allf, allb;
    __syncthreads();
    chunk_cums_pre(L, in.gf, in.gb, wave, lane, cumf, cumb, allf, allb);
    LAS bf16_t* qf = (LAS bf16_t*)(L + L_T0); LAS bf16_t* kf = (LAS bf16_t*)(L + L_T1); LAS bf16_t* qb = (LAS bf16_t*)(L + L_T2); LAS bf16_t* kb = (LAS bf16_t*)(L + L_T3);
#pragma unroll
    for (int r = 0; r < 8; ++r) { const int i = 8 * wave + r;
        const float qv = bf2f(in.q[r]), kv = bf2f(in.k[r]);
        qf[i * RS + lane] = f2bf(qv * __expf(cumf[r])); kf[i * RS + lane] = f2bf(kv * __expf(-cumf[r]));
        qb[i * RS + lane] = f2bf(qv * __expf(cumb[r])); kb[i * RS + lane] = f2bf(kv * __expf(-cumb[r])); }
    store_vt(L, in.v, tid);
    {
      LAS unsigned char* sf_ = L + L_SF + ((tid >> 2) * RS + 16 * (tid & 3)) * 2; LAS unsigned char* sb_ = L + L_SB + ((tid >> 2) * RS + 16 * (tid & 3)) * 2;
      *(LAS u32x4*)sf_ = in.sraw[0]; *(LAS u32x4*)(sf_ + 16) = in.sraw[1]; *(LAS u32x4*)sb_ = in.sraw[2]; *(LAS u32x4*)(sb_ + 16) = in.sraw[3]; }
    __syncthreads();
    {
        LAS bf16_t* P = (LAS bf16_t*)(L + L_P);
#pragma unroll
        for (int q = 0; q < 2; ++q) { const int nt = 2 * (wave & 1) + q;
            f32x4 sf = {0.f, 0.f, 0.f, 0.f}, sb = {0.f, 0.f, 0.f, 0.f};
#pragma unroll
            for (int ks = 0; ks < 2; ++ks) {
                sf = __builtin_amdgcn_mfma_f32_16x16x32_bf16(frag(L + L_T0, 16 * mt, 32 * ks, lane), frag(L + L_T1, 16 * nt, 32 * ks, lane), sf, 0, 0, 0);
                sb = __builtin_amdgcn_mfma_f32_16x16x32_bf16(frag(L + L_T2, 16 * mt, 32 * ks, lane), frag(L + L_T3, 16 * nt, 32 * ks, lane), sb, 0, 0, 0); }
#pragma unroll
            for (int r = 0; r < 4; ++r) { const int i = 16 * mt + 4 * fq + r, j = 16 * nt + fr;
                P[i * RS + j] = f2bf((j <= i ? sf[r] : 0.f) + (j >= i ? sb[r] : 0.f)); } }
    }
    __syncthreads();
    f32x4 o[4]; float ssq = 0.f;
#pragma unroll
    for (int q = 0; q < 4; ++q) { const int nt = 4 * (wave & 1) + q;
        f32x4 acc = {0.f, 0.f, 0.f, 0.f};
#pragma unroll
        for (int ks = 0; ks < 2; ++ks) {
            acc = __builtin_amdgcn_mfma_f32_16x16x32_bf16(frag(L + L_VT, 16 * nt, 32 * ks, lane), frag(L + L_P, 16 * mt, 32 * ks, lane), acc, 0, 0, 0);
            acc = __builtin_amdgcn_mfma_f32_16x16x32_bf16(frag(L + L_SF, 16 * nt, 32 * ks, lane), frag(L + L_T0, 16 * mt, 32 * ks, lane), acc, 0, 0, 0);
            acc = __builtin_amdgcn_mfma_f32_16x16x32_bf16(frag(L + L_SB, 16 * nt, 32 * ks, lane), frag(L + L_T2, 16 * mt, 32 * ks, lane), acc, 0, 0, 0); }
        o[q] = acc;
        ssq += (acc[0] * acc[0] + acc[1] * acc[1]) + (acc[2] * acc[2] + acc[3] * acc[3]); }
    LAS float* SSQ = (LAS float*)(L + L_SSQ);
    ssq = xrow32_sum(xrow16_sum(ssq));
    if (fq == 0) SSQ[(wave & 1) * 64 + 16 * mt + fr] = ssq;
    __syncthreads();
    const float* ng = a.in[I_NORMG];
    bf16_t* mix = (bf16_t*)(a.ws + WS_MIX);
    { const int i = 16 * mt + fr;
      const float rstd = 1.f / sqrtf((SSQ[i] + SSQ[64 + i]) * (1.f / DV) + LN_EPS);
#pragma unroll
      for (int q = 0; q < 4; ++q) { const int dv0 = 16 * (4 * (wave & 1) + q) + 4 * fq;
          const f32x4 gn = *(const f32x4*)(ng + dv0); const u32x2 gw = in.gr[q];
          const float g0 = bflo(gw.x), g1 = bfhi(gw.x), g2 = bflo(gw.y), g3 = bfhi(gw.y);
          u32x2 w; w.x = pk2(o[q][0] * rstd * gn[0] * silu_f(g0), o[q][1] * rstd * gn[1] * silu_f(g1)); w.y = pk2(o[q][2] * rstd * gn[2] * silu_f(g2), o[q][3] * rstd * gn[3] * silu_f(g3));
          *(u32x2*)(mix + (tok0 + i) * 1024 + h * 128 + dv0) = w; } }
}
}

namespace rt {
constexpr int HS = 1028;
constexpr int L_H2 = 0;
constexpr int L_PART = 65792;
constexpr int L_LCNT = L_PART + 16384;
constexpr int L_REC = L_LCNT + 256;
constexpr int L_RECALL = 126976;
constexpr int L_TAB = 86016;

__device__ __forceinline__ void phase(const Args& a, LAS unsigned char* lds) {
    const int tid = threadIdx.x, lane = tid & 63, wave = __builtin_amdgcn_readfirstlane(tid >> 6);
    bf16_t* xmid = (bf16_t*)(a.ws + WS_PRE1); bf16_t* H2 = (bf16_t*)(a.ws + WS_H2); const bf16_t* FG = (const bf16_t*)(a.ws + WS_FG);
    const float* mod = (const float*)(a.ws + WS_MOD);
    const float* rw = a.in[I_RW]; const float* rb = a.in[I_RB];
    LAS float* h2s = (LAS float*)(lds + L_H2); LAS float* part = (LAS float*)(lds + L_PART);
    LAS int* lcnt = (LAS int*)(lds + L_LCNT); LAS int* lbase = lcnt + 32; LAS int* rec = (LAS int*)(lds + L_RECALL);
    unsigned* cnt = (unsigned*)(a.ws + WS_CNT); int* list = (int*)(a.ws + WS_LIST); float* pw = (float*)(a.ws + WS_PW); int* ploc = (int*)(a.ws + WS_PLOC);
    bf16x8 rwh[4][2], rwl[4][2];
#pragma unroll
    for (int s = 0; s < 4; ++s)
#pragma unroll
        for (int nt = 0; nt < 2; ++nt)
#pragma unroll
            for (int i = 0; i < 8; ++i) { const float x = rw[(size_t)(128 * wave + 32 * s + 8 * (lane >> 4) + i) * 32 + 16 * nt + (lane & 15)];
                const unsigned hb = __float_as_uint(x) & 0xffff0000u; rwh[s][nt][i] = (short)(hb >> 16); rwl[s][nt][i] = (short)f2bf(x - __uint_as_float(hb)); }
    LAS f32x4* g1 = (LAS f32x4*)(lds + L_TAB); LAS f32x4* bb1 = g1 + 256; LAS f32x4* shT = bb1 + 256; LAS f32x4* scT = shT + 4 * 256;
    if (tid < 256) { g1[tid] = ((const f32x4*)a.in[I_LN1G])[tid]; bb1[tid] = ((const f32x4*)a.in[I_LN1B])[tid]; }
    for (int i = tid; i < 4 * 256; i += NTHREADS) { shT[i] = ((const f32x4*)(mod + (i >> 8) * 6144 + 3 * 1024))[i & 255]; scT[i] = ((const f32x4*)(mod + (i >> 8) * 6144 + 4 * 1024))[i & 255]; }
    const float rbe = rb[lane & 31];
    if (tid < 32) lcnt[tid] = 0;
    int gi = 0;
    f32x4 xq[2][4]; u32x2 fq_[2][4];
#define RT_LOAD(g_) do { _Pragma("unroll") for (int rr = 0; rr < 2; ++rr) { const int t_ = (g_) * 16 + 2 * wave + rr; \
        const f32x4* xr_ = (const f32x4*)(a.in[I_X] + (size_t)t_ * D) + lane; const u32x2* fr_ = (const u32x2*)(FG + (size_t)t_ * D) + lane; \
        _Pragma("unroll") for (int j = 0; j < 4; ++j) { xq[rr][j] = xr_[64 * j]; fq_[rr][j] = fr_[64 * j]; } } } while (0)
    if ((int)blockIdx.x < T / 16) RT_LOAD((int)blockIdx.x);
    for (int grp = blockIdx.x; grp < T / 16; grp += gridDim.x) {
        __syncthreads();
        f32x4 xv_[2][4]; u32x2 fv_[2][4];
#pragma unroll
        for (int rr = 0; rr < 2; ++rr)
#pragma unroll
            for (int j = 0; j < 4; ++j) { xv_[rr][j] = xq[rr][j]; fv_[rr][j] = fq_[rr][j]; }
        if (grp + (int)gridDim.x < T / 16) RT_LOAD(grp + (int)gridDim.x);
#pragma unroll
        for (int rr = 0; rr < 2; ++rr) {
            const int lr = 2 * wave + rr, t = grp * 16 + lr, b = t >> 13;
            u32x2* pr = (u32x2*)(xmid + (size_t)t * D) + lane;
            f32x4 v[4]; float s = 0.f;
#pragma unroll
            for (int j = 0; j < 4; ++j) { const u32x2 fw = fv_[rr][j]; const f32x4 ff = {bflo(fw.x), bfhi(fw.x), bflo(fw.y), bfhi(fw.y)};
                v[j] = xv_[rr][j] * ALPHA + ff; s += (v[j][0] + v[j][1]) + (v[j][2] + v[j][3]); }
            float mean = wave_sum(s) * (1.f / D), s2 = 0.f;
#pragma unroll
            for (int j = 0; j < 4; ++j) { v[j] = v[j] - mean; s2 += (v[j][0] * v[j][0] + v[j][1] * v[j][1]) + (v[j][2] * v[j][2] + v[j][3] * v[j][3]); }
            float rstd = 1.f / sqrtf(wave_sum(s2) * (1.f / D) + LN_EPS);
            s = 0.f;
#pragma unroll
            for (int j = 0; j < 4; ++j) { v[j] = v[j] * rstd * g1[64 * j + lane] + bb1[64 * j + lane]; u32x2 w; w.x = pk2(v[j][0], v[j][1]); w.y = pk2(v[j][2], v[j][3]); pr[64 * j] = w;
                v[j] = (f32x4){bflo(w.x), bfhi(w.x), bflo(w.y), bfhi(w.y)}; s += (v[j][0] + v[j][1]) + (v[j][2] + v[j][3]); }
            mean = wave_sum(s) * (1.f / D); s2 = 0.f;
#pragma unroll
            for (int j = 0; j < 4; ++j) { v[j] = v[j] - mean; s2 += (v[j][0] * v[j][0] + v[j][1] * v[j][1]) + (v[j][2] * v[j][2] + v[j][3] * v[j][3]); }
            rstd = 1.f / sqrtf(wave_sum(s2) * (1.f / D) + LN_EPS);
            const LAS f32x4* sh = shT + b * 256; const LAS f32x4* sc = scT + b * 256;
            unsigned* o4 = (unsigned*)((unsigned char*)H2 + (size_t)t * D) + lane;
#pragma unroll
            for (int j = 0; j < 4; ++j) { const f32x4 y = v[j] * rstd * (sc[64 * j + lane] + 1.f) + sh[64 * j + lane];
                o4[64 * j] = gm::pk4_fp8(y[0] * gm::S_H2, y[1] * gm::S_H2, y[2] * gm::S_H2, y[3] * gm::S_H2);
                *(LAS f32x4*)(h2s + lr * HS + 256 * j + 4 * lane) = y; }
        }
        __syncthreads();
        {
            f32x4 acc0 = {0.f, 0.f, 0.f, 0.f}, acc1 = {0.f, 0.f, 0.f, 0.f};
            const LAS float* ap = h2s + (lane & 15) * HS + 128 * wave + 8 * (lane >> 4);
#pragma unroll
            for (int s = 0; s < 4; ++s) { const f32x4 x0 = *(const LAS f32x4*)(ap + 32 * s), x1 = *(const LAS f32x4*)(ap + 32 * s + 4);
                bf16x8 ah, al;
#pragma unroll
                for (int i = 0; i < 8; ++i) { const float x = i < 4 ? x0[i] : x1[i - 4]; const unsigned hb = __float_as_uint(x) & 0xffff0000u; ah[i] = (short)(hb >> 16); al[i] = (short)f2bf(x - __uint_as_float(hb)); }
                acc0 = __builtin_amdgcn_mfma_f32_16x16x32_bf16(ah, rwh[s][0], acc0, 0, 0, 0); acc1 = __builtin_amdgcn_mfma_f32_16x16x32_bf16(ah, rwh[s][1], acc1, 0, 0, 0);
                acc0 = __builtin_amdgcn_mfma_f32_16x16x32_bf16(ah, rwl[s][0], acc0, 0, 0, 0); acc1 = __builtin_amdgcn_mfma_f32_16x16x32_bf16(ah, rwl[s][1], acc1, 0, 0, 0);
                acc0 = __builtin_amdgcn_mfma_f32_16x16x32_bf16(al, rwh[s][0], acc0, 0, 0, 0); acc1 = __builtin_amdgcn_mfma_f32_16x16x32_bf16(al, rwh[s][1], acc1, 0, 0, 0); }
#pragma unroll
            for (int r = 0; r < 4; ++r) { part[(wave * 16 + 4 * (lane >> 4) + r) * 32 + (lane & 15)] = acc0[r]; part[(wave * 16 + 4 * (lane >> 4) + r) * 32 + 16 + (lane & 15)] = acc1[r]; }
        }
        __syncthreads();
        {
            const int lr = 2 * wave + (lane >> 5), e = lane & 31, t = grp * 16 + lr;
            float lg = rbe;
#pragma unroll
            for (int w = 0; w < 8; ++w) lg += part[(w * 16 + lr) * 32 + e];
            float cur = lg, tv[4]; int ti[4];
#pragma unroll
            for (int k = 0; k < 4; ++k) { float bv = cur; int bi = e;
#pragma unroll
                for (int o = 0; o < 5; ++o) { float ov; int oi;
                    if (o == 0) { ov = dpp_f<DPP_X1>(bv); oi = dpp_i<DPP_X1>(bi); } else if (o == 1) { ov = dpp_f<DPP_X2>(bv); oi = dpp_i<DPP_X2>(bi); }
                    else if (o == 2) { ov = dpp_f<DPP_HM>(bv); oi = dpp_i<DPP_HM>(bi); } else if (o == 3) { ov = dpp_f<DPP_RM>(bv); oi = dpp_i<DPP_RM>(bi); }
                    else { unsigned pv0, pv1, pi0, pi1; swap16_same(__builtin_bit_cast(unsigned, bv), pv0, pv1); swap16_same((unsigned)bi, pi0, pi1);
                        const bool odd = (lane & 16) != 0; ov = __builtin_bit_cast(float, odd ? pv0 : pv1); oi = (int)(odd ? pi0 : pi1); }
                    if (ov > bv || (ov == bv && oi < bi)) { bv = ov; bi = oi; } }
                tv[k] = bv; ti[k] = bi; if (bi == e) cur = -3.0e38f; }
            const float e1 = __expf(tv[1] - tv[0]), e2 = __expf(tv[2] - tv[0]), e3 = __expf(tv[3] - tv[0]);
            const float inv = 1.f / (1.f + e1 + e2 + e3);
            if (e < 4) { const float wk = (e == 0 ? 1.f : (e == 1 ? e1 : (e == 2 ? e2 : e3))) * inv; const int ek = (e == 0 ? ti[0] : (e == 1 ? ti[1] : (e == 2 ? ti[2] : ti[3])));
                const int pair = t * 4 + e;
                pw[pair] = wk;
                const int rank = __hip_atomic_fetch_add((LAS int*)&lcnt[ek], 1, __ATOMIC_RELAXED, __HIP_MEMORY_SCOPE_WORKGROUP);
                rec[gi * 64 + lr * 4 + e] = ek | (rank << 8); }
        }
        ++gi;
    }
    __syncthreads();
    if (tid < 32) { const int n = lcnt[tid]; lbase[tid] = n ? (int)atomicAdd(&cnt[tid * CNT_STRIDE], (unsigned)n) : 0; }
    __syncthreads();
    for (int i = tid; i < gi * 64; i += NTHREADS) { const int rc = rec[i], ek = rc & 255, rank = rc >> 8, pos = lbase[ek] + rank, pair = (((int)blockIdx.x + (i >> 6) * (int)gridDim.x) * 16 + ((i & 63) >> 2)) * 4 + (i & 3);
        list[(size_t)ek * CAP + pos] = pair; ploc[pair] = ek | (pos << 5); }
#undef RT_LOAD
}
}

__device__ __forceinline__ void p_final(const Args& a, LAS unsigned char* lds) {
    const int tid = threadIdx.x, lane = tid & 63, wave = tid >> 6;
    const bf16_t* xm = (const bf16_t*)(a.ws + WS_PRE1); const unsigned char* slots = (const unsigned char*)(a.ws + WS_SLOTS); const float* mod = (const float*)(a.ws + WS_MOD);
    const int* ploc = (const int*)(a.ws + WS_PLOC); const float* pw = (const float*)(a.ws + WS_PW);
    const f32x4* g2 = (const f32x4*)a.in[I_LN2G]; const f32x4* b2 = (const f32x4*)a.in[I_LN2B];
    LAS int* tstart = (LAS int*)lds;
    __syncthreads();
    if (tid == 0) { const unsigned* cnt = (const unsigned*)(a.ws + WS_CNT); int nrt = 0; for (int e = 0; e < NE; ++e) { tstart[e] = 256 * nrt; nrt += ((int)cnt[e * CNT_STRIDE] + 255) >> 8; } }
    LAS f32x4* Lg2 = (LAS f32x4*)(lds + 1024); LAS f32x4* Lb2 = Lg2 + 256; LAS f32x4* Lgt = Lb2 + 256;
    if (tid < 256) { Lg2[tid] = g2[tid]; Lb2[tid] = b2[tid]; }
    for (int i = tid; i < 4 * 256; i += NTHREADS) Lgt[i] = ((const f32x4*)(mod + (i >> 8) * 6144 + 5 * 1024))[i & 255];
    __syncthreads();
    const int tstep = gridDim.x * NWAVES; int t = blockIdx.x * NWAVES + wave;
    if (t < T) {
        int plc[4], pln[4], plm[4]; float wc_[4], wn_[4], wm_[4]; unsigned qc[4][4], qn[4][4], qm[4][4]; u32x2 xc[4], xn[4], xm_[4];
#define PF_IDX(tt, pl, ww) do { _Pragma("unroll") for (int sl = 0; sl < 4; ++sl) { pl[sl] = ploc[(tt) * 4 + sl]; ww[sl] = pw[(tt) * 4 + sl] * (1.f / gm::S_SL); } } while (0)
#define PF_DATA(tt, pl, qq, xx) do { _Pragma("unroll") for (int sl = 0; sl < 4; ++sl) { const unsigned* sr_ = (const unsigned*)(slots + (size_t)(tstart[pl[sl] & 31] + (pl[sl] >> 5)) * D) + lane; \
            _Pragma("unroll") for (int j = 0; j < 4; ++j) qq[sl][j] = sr_[64 * j]; } \
        { const u32x2* xr_ = (const u32x2*)(xm + (size_t)(tt) * D) + lane; _Pragma("unroll") for (int j = 0; j < 4; ++j) xx[j] = xr_[64 * j]; } } while (0)
        PF_IDX(t, plc, wc_); PF_DATA(t, plc, qc, xc);
        int tn = t + tstep, tm = t + 2 * tstep;
        if (tn < T) { PF_IDX(tn, pln, wn_); PF_DATA(tn, pln, qn, xn); }
        if (tm < T) PF_IDX(tm, plm, wm_);
        for (;;) {
            const bool hn = tn < T, hm = tm < T;
            if (hm) PF_DATA(tm, plm, qm, xm_);
            int pl2[4]; float w2[4]; const int tn2 = tm + tstep; const bool hn2 = hm && tn2 < T;
            if (hn2) PF_IDX(tn2, pl2, w2);
            {
                const int b = t >> 13; const LAS f32x4* gt = Lgt + b * 256;
                f32x4 v[4]; float s = 0.f;
#pragma unroll
                for (int j = 0; j < 4; ++j) { f32x4 y = {0.f, 0.f, 0.f, 0.f};
#pragma unroll
                    for (int sl = 0; sl < 4; ++sl) { const int q = (int)qc[sl][j];
                        const f32x2 lo_ = __builtin_amdgcn_cvt_pk_f32_fp8(q, false) * wc_[sl], hi_ = __builtin_amdgcn_cvt_pk_f32_fp8(q, true) * wc_[sl]; y[0] += lo_[0]; y[1] += lo_[1]; y[2] += hi_[0]; y[3] += hi_[1]; }
                    const f32x4 xv = {bflo(xc[j].x), bfhi(xc[j].x), bflo(xc[j].y), bfhi(xc[j].y)};
                    v[j] = xv * ALPHA + gt[64 * j + lane] * y; s += (v[j][0] + v[j][1]) + (v[j][2] + v[j][3]); }
                const float mean = wave_sum(s) * (1.f / D); float s2 = 0.f;
#pragma unroll
                for (int j = 0; j < 4; ++j) { v[j] = v[j] - mean; s2 += (v[j][0] * v[j][0] + v[j][1] * v[j][1]) + (v[j][2] * v[j][2] + v[j][3] * v[j][3]); }
                const float rstd = 1.f / sqrtf(wave_sum(s2) * (1.f / D) + LN_EPS);
                f32x4* o = (f32x4*)(a.out + (size_t)t * D) + lane;
#pragma unroll
                for (int j = 0; j < 4; ++j) o[64 * j] = v[j] * rstd * Lg2[64 * j + lane] + Lb2[64 * j + lane];
            }
            if (!hn) break;
            t = tn; tn = tm; tm = tn2;
#pragma unroll
            for (int sl = 0; sl < 4; ++sl) { plc[sl] = pln[sl]; wc_[sl] = wn_[sl]; pln[sl] = plm[sl]; wn_[sl] = wm_[sl]; plm[sl] = pl2[sl]; wm_[sl] = w2[sl];
#pragma unroll
                for (int j = 0; j < 4; ++j) { qc[sl][j] = qn[sl][j]; qn[sl][j] = qm[sl][j]; } }
#pragma unroll
            for (int j = 0; j < 4; ++j) { xc[j] = xn[j]; xn[j] = xm_[j]; }
        }
#undef PF_IDX
#undef PF_DATA
    }
}


constexpr int N_PHASES = 11;
__global__ void __launch_bounds__(NTHREADS, 2) mega_fwd(Args a) {
    extern __shared__ __attribute__((aligned(16))) unsigned char lds_raw[];
    LAS unsigned char* lds = (LAS unsigned char*)lds_raw;
    const int tid = threadIdx.x;
    volatile LAS unsigned* misc = (volatile LAS unsigned*)(lds + LDS_MISC);
    if (tid < 4) misc[tid] = 0u;
    __syncthreads();
    XcdBarrier bar; bar.bar = (unsigned*)(a.ws + WS_BAR); bar.x = 0; bar.st = misc;
    const bool multi = (a.ph_hi - a.ph_lo) > 1;
    if (multi) bar = xcd_barrier_post((unsigned*)(a.ws + WS_BAR), misc);
    const int lo = a.ph_lo, hi = a.ph_hi;
#define vcu ((gridDim.x % 8 == 0) ? (int)((blockIdx.x % 8) * (gridDim.x / 8) + blockIdx.x / 8) : (int)blockIdx.x)
#ifdef ONLY_PHASE
#define IN(k) ((k) == ONLY_PHASE && lo <= (k) && (k) < hi)
#else
#define IN(k) (lo <= (k) && (k) < hi)
#endif
#define SEAM(k) do { if (IN(k) && IN((k) + 1)) xcd_barrier(bar); } while (0)

#ifndef REPEAT_PHASE
#define REPEAT_PHASE -1
#endif
#ifdef PROF_REP
#define RUNPH(k, ...) do { if (IN(k)) { const int nrep_ = (a.rep_k == (k)) ? 2 : 1; for (int rep_ = 0; rep_ < nrep_; ++rep_) { if (rep_) xcd_barrier(bar); __VA_ARGS__; } } } while (0)
#else
#define RUNPH(k, ...) do { if (IN(k)) { __VA_ARGS__; if (REPEAT_PHASE == (k)) { xcd_barrier(bar); __VA_ARGS__; } } } while (0)
#endif
    RUNPH(0, p0_mod_and_filter(a, lds));
    SEAM(0);
    RUNPH(1, p1_prep(a, lds));
    SEAM(1);
    RUNPH(2, { gm::EpiIn E{a.ws};
        { gm::SchedIn<true> S{a.ws, (int)gridDim.x, vcu, a.in[I_BAF], a.in[I_BAB]}; gm::gemm_stream<false, 0, false>(lds, S, E); }
        { gm::SchedIn<false> S{a.ws, (int)gridDim.x, vcu, a.in[I_BAF], a.in[I_BAB]}; gm::gemm_stream<false, 0, true>(lds, S, E); }
        {
          const int G = (int)gridDim.x, rounds = (1044 + G - 1) / G, extra = 1044 - (rounds - 1) * G, v = vcu;
          if (v >= extra || extra == G) { const int nidle = (extra == G) ? G : G - extra, ridle = (extra == G) ? v : v - extra; __syncthreads();
              prep_items(a, (LAS float*)(lds + (tid >> 6) * 16384), PREP_NITEMS - PREP_DEFER, PREP_NITEMS, ridle * NWAVES + (tid >> 6), nidle * NWAVES, tid & 63); } } });
    SEAM(2);
    RUNPH(3, { for (int u = blockIdx.x; u < 16 * NCT; u += gridDim.x) gla::g1_unit(a, lds, u / NCT, u % NCT); });
    SEAM(3);
    RUNPH(4, { gla::g2_scan(a, lds);
        hy::CvState cvs; cvs.jb.mi = -1; cvs.next = (int)blockIdx.x * NWAVES + (tid >> 6); cvs.stride = (int)gridDim.x * NWAVES; cvs.end = hy::CV_ITEMS;
        for (int c = blockIdx.x; c < HYW; c += gridDim.x) hy::channel(a, lds, c, a.ws + WS_HSPEC + (size_t)blockIdx.x * HSPEC_PER_WG, cvs);
        while (cvs.jb.mi >= 0 || cvs.next < cvs.end) hy::cv_step(a, cvs, tid & 63); });
    SEAM(4);
    RUNPH(5, { { int u = blockIdx.x; gla::G3In cur, nxt;
            if (u < 16 * NCHUNK) { gla::g3_load(a, u >> 7, u & 127, cur);
                for (;;) { const int un = u + (int)gridDim.x; const bool hn = un < 16 * NCHUNK; if (hn) gla::g3_load(a, un >> 7, un & 127, nxt);
                    gla::g3_unit(a, lds, u >> 7, u & 127, cur); if (!hn) break; cur = nxt; u = un; } } }
        const int wave = tid >> 6;
        for (int it = blockIdx.x * NWAVES + wave; it < 2048; it += gridDim.x * NWAVES) hy::transpose_item(a, it, tid & 63); });
    SEAM(5);
    RUNPH(6, { gm::SchedOut S{a.ws, (int)gridDim.x, vcu}; gm::EpiOut E{a.ws}; gm::gemm_stream<false, 0, false>(lds, S, E); });
    SEAM(6);
    RUNPH(7, rt::phase(a, lds));
    SEAM(7);
    if (IN(8) || IN(9)) {
        LAS int* tab = (LAS int*)(lds + gm::LDS_TAB);
        __syncthreads();
        if (tid == 0) { const unsigned* cnt = (const unsigned*)(a.ws + WS_CNT); int nrt = 0;
            for (int e = 0; e < NE; ++e) { const int n = (int)cnt[e * CNT_STRIDE]; tab[e] = n; const int nt = (n + 255) >> 8; for (int k = 0; k < nt; ++k) tab[64 + nrt + k] = e | (k << 8); nrt += nt; }
            tab[32] = nrt; }
        __syncthreads();
    }
#define HO_GEOM const int G_ = (int)gridDim.x, U8_ = ((const LAS int*)(lds + gm::LDS_TAB))[32] * 8, R_ = (U8_ + G_ - 1) / G_, A_ = (R_ - 1) * G_, x_ = U8_ - A_
    RUNPH(8, { HO_GEOM; (void)x_; gm::SchedMoe<1> S{a.ws, (const LAS int*)(lds + gm::LDS_TAB), G_, vcu, a.in[I_EB2], bar.x, 8u * bar.st[0], bar.st[1], R_ - 2, 0, 0u}; gm::EpiMoe1 E{a.ws}; gm::gemm_stream<true, 2, true>(lds, S, E); });
    RUNPH(9, { HO_GEOM; const int c2 = (vcu - x_ % G_ + G_) % G_;
        if (R_ >= 2) { if (tid == 0) { unsigned* ha = (unsigned*)(a.ws + WS_HOA); XB_SPIN(xb_ld(ha) < bar.st[1], bar.bar); __builtin_amdgcn_fence(__ATOMIC_ACQUIRE, "agent"); asm volatile("s_waitcnt vmcnt(0)" ::: "memory"); } }
        __syncthreads();
        gm::SchedMoe<2> S{a.ws, (const LAS int*)(lds + gm::LDS_TAB), G_, c2, a.in[I_EB2], bar.x, 0u, 0u, 0, (A_ / 8) * 4, (unsigned)bar.st[1]}; gm::EpiMoe2 E{a.ws}; gm::gemm_stream<false, 0, true>(lds, S, E); });
#undef HO_GEOM
    SEAM(9);
    RUNPH(10, p_final(a, lds));
#undef RUNPH
#undef vcu
#undef IN
#undef SEAM
}

extern "C" void kernel_launch(void* const* d_in, const int* in_sizes, int n_in, void* d_out, int out_size, void* d_ws, size_t ws_size, hipStream_t stream) {
    static int grid = 0;
    if (grid == 0) {
        if (n_in != 32 || out_size != T * D || ws_size < WS_END) { fprintf(stderr, "kernel_launch: unexpected shapes (n_in %d out %d ws %zu need %zu)\n", n_in, out_size, ws_size, (size_t)WS_END); grid = -1; return; }
        int dev = 0, cus = 0;
        if (hipGetDevice(&dev) != hipSuccess || hipDeviceGetAttribute(&cus, hipDeviceAttributeMultiprocessorCount, dev) != hipSuccess) { grid = -1; return; }
        if (hipFuncSetAttribute((const void*)mega_fwd, hipFuncAttributeMaxDynamicSharedMemorySize, LDS_BYTES) != hipSuccess) { fprintf(stderr, "kernel_launch: hipFuncSetAttribute failed\n"); grid = -1; return; }
        int per_cu = 0;
        if (hipOccupancyMaxActiveBlocksPerMultiprocessor(&per_cu, (const void*)mega_fwd, NTHREADS, LDS_BYTES) != hipSuccess || per_cu < 1) fprintf(stderr, "kernel_launch: occupancy query says %d\n", per_cu);
        (void)hipGetLastError();
        grid = cus;
        if (grid > MAX_GRID) grid = MAX_GRID;
    }
    if (grid < 0) return;
    (void)hipMemsetAsync(d_ws, 0, WS_ZERO_BYTES, stream);
    Args a{};
    for (int i = 0; i < 32; ++i) a.in[i] = (const float*)d_in[i];
    a.out = (float*)d_out; a.ws = (unsigned char*)d_ws;
#ifdef DBG
    (void)hipMemsetAsync((char*)d_ws + WS_DBG, 0, 512, stream);
    for (int p = 0; p < N_PHASES; ++p) { a.ph_lo = p; a.ph_hi = p + 1; hipLaunchKernelGGL(mega_fwd, dim3(grid), dim3(NTHREADS), LDS_BYTES, stream, a);
        hipLaunchKernelGGL(dbg_check, dim3(64), dim3(512), 0, stream, a, p); }
    hipLaunchKernelGGL(dbg_encode, dim3(1024), dim3(256), 0, stream, a);
#elif N_LAUNCH_PER_PHASE
    for (int p = 0; p < N_PHASES; ++p) { a.ph_lo = p; a.ph_hi = p + 1; hipLaunchKernelGGL(mega_fwd, dim3(grid), dim3(NTHREADS), LDS_BYTES, stream, a); }
#else
    a.ph_lo = 0; a.ph_hi = N_PHASES;
#ifdef PROF_REP
    a.rep_k = PROF_REP;
#endif
    hipLaunchKernelGGL(mega_fwd, dim3(grid), dim3(NTHREADS), LDS_BYTES, stream, a);
#endif
}
```
